# Optimizing an MI355X kernel written in HIP

```python
import math, functools
import jax, jax.numpy as jnp
from jax import lax
import numpy as np

D_MODEL = 1024
BATCH = 8
SEQ = 2048
DEPTH = 1
DEC_BATCH = 32
DEC_SEQ = 8
PAST_LEN = 8192
PAGE_SIZE = 128

N_HEADS = 8
N_KV_HEADS = 2
HEAD_DIM = 64
GROUP = N_HEADS // N_KV_HEADS
ATTN_WIDTH = N_HEADS * HEAD_DIM
KV_WIDTH = N_KV_HEADS * HEAD_DIM
ATTN_SCALE = HEAD_DIM ** -0.5
N_IDX_HEADS = 4
IDX_DIM = 64
IDX_SCALE = (IDX_DIM * N_IDX_HEADS) ** -0.5
TOPK_MAX = 256
Q_BLOCK = 128
N_BUCKETS = 32
MAX_DISTANCE = 128
D_CONV = 512
CONV_WIDTH = 3
N_KEYS = 128
N_EXPERTS = N_KEYS * N_KEYS
PEER_HEADS = 8
PEER_KEY_DIM = 128
PEER_HALF = PEER_KEY_DIM // 2
PEER_TOPK_HALF = 16
PEER_TOPK = 16
PEER_BLOCK = 128
DN_ALPHA = (2 * DEPTH) ** 0.25
DN_BETA = (8 * DEPTH) ** -0.25
LN_EPS = 1e-5
MIX_WIDTHS = (ATTN_WIDTH, KV_WIDTH, KV_WIDTH, N_IDX_HEADS * IDX_DIM, N_IDX_HEADS, IDX_DIM,
              D_CONV, D_CONV, D_CONV, D_MODEL, D_MODEL)
D_MIX_IN = sum(MIX_WIDTHS)

kernel_name = "dsa_shortconv_peer_deepnorm_adaln_step"


def layer_norm(x, g, b):
    xf = x.astype(jnp.float32)
    mu = jnp.mean(xf, axis=-1, keepdims=True)
    var = jnp.mean(jnp.square(xf - mu), axis=-1, keepdims=True)
    return ((xf - mu) * lax.rsqrt(var + LN_EPS)).astype(x.dtype) * g + b


def split_columns(proj):
    parts, start = [], 0
    for w in MIX_WIDTHS:
        parts.append(proj[..., start:start + w])
        start += w
    return parts


def t5_bucket(dist):
    n = jnp.maximum(dist, 0)
    max_exact = N_BUCKETS // 2
    nf = jnp.maximum(n, 1).astype(jnp.float32)
    large = max_exact + (jnp.log(nf / max_exact) / math.log(MAX_DISTANCE / max_exact)
                         * (N_BUCKETS - max_exact)).astype(jnp.int32)
    large = jnp.minimum(large, N_BUCKETS - 1)
    return jnp.where(n < max_exact, n, large)


def indexer_scores(qi, wi, ki, q_pos, k_pos):
    dots = jnp.einsum('bqhd,bld->bqhl', qi, ki).astype(jnp.float32)
    s = jnp.einsum('bqhl,bqh->bql', jax.nn.relu(dots), wi.astype(jnp.float32)) * IDX_SCALE
    mask = k_pos[None, :] <= q_pos[:, None]
    return jnp.where(mask[None], s, -jnp.inf)


def sparse_attend(q, kg, vg, q_pos, sel, rel_bias):
    logits = jnp.einsum('bqgrd,bqkgd->bqgrk', q, kg).astype(jnp.float32) * ATTN_SCALE
    dist = q_pos[None, :, None] - sel
    bias = rel_bias[t5_bucket(dist)]
    bias = bias.reshape(*sel.shape, N_KV_HEADS, GROUP).transpose(0, 1, 3, 4, 2)
    logits = jnp.where((dist >= 0)[:, :, None, None, :], logits + bias.astype(jnp.float32), -jnp.inf)
    p = jax.nn.softmax(logits, axis=-1).astype(vg.dtype)
    o = jnp.einsum('bqgrk,bqkgd->bqgrd', p, vg)
    return o.reshape(o.shape[0], o.shape[1], ATTN_WIDTH)


def attn_prompt(q, k, v, qi, wi, ki, rel_bias):
    B, S = q.shape[0], q.shape[1]
    n_sel = min(TOPK_MAX, S // 4)
    nblk = S // Q_BLOCK
    k_pos = jnp.arange(S)

    def block(args):
        qb, qib, wib, q_pos = args
        scores = indexer_scores(qib, wib, ki, q_pos, k_pos)
        _, sel = lax.top_k(scores, n_sel)
        kg = jax.vmap(lambda kk, ii: kk[ii])(k, sel)
        vg = jax.vmap(lambda vv, ii: vv[ii])(v, sel)
        return sparse_attend(qb, kg, vg, q_pos, sel, rel_bias)

    def to_blocks(a):
        return jnp.swapaxes(a.reshape(B, nblk, Q_BLOCK, *a.shape[2:]), 0, 1)

    pos = jnp.arange(S).reshape(nblk, Q_BLOCK)
    out = lax.map(block, (to_blocks(q), to_blocks(qi), to_blocks(wi), pos))
    return jnp.swapaxes(out, 0, 1).reshape(B, S, ATTN_WIDTH)


def gather_paged(pool, page_table, new_rows, sel):
    B, T, K = sel.shape
    past = page_table.shape[1] * PAGE_SIZE
    is_past = sel < past
    p = jnp.minimum(sel, past - 1)
    phys = jnp.take_along_axis(page_table, (p // PAGE_SIZE).reshape(B, T * K), axis=1).reshape(B, T, K)
    from_past = pool[phys, p % PAGE_SIZE]
    j = jnp.clip(sel - past, 0, new_rows.shape[1] - 1)
    from_new = jax.vmap(lambda n, i: n[i])(new_rows, j)
    return jnp.where(is_past[..., None, None], from_past, from_new)


def attn_sample(q, k_new, v_new, qi, wi, ki_new, cache_k, cache_v, cache_ki, page_table, rel_bias):
    B, T = q.shape[0], q.shape[1]
    past = page_table.shape[1] * PAGE_SIZE
    L = past + T
    n_sel = min(TOPK_MAX, L // 4)
    ki_past = cache_ki[page_table].reshape(B, past, IDX_DIM)
    ki_all = jnp.concatenate([ki_past, ki_new], axis=1)
    q_pos = past + jnp.arange(T)
    scores = indexer_scores(qi, wi, ki_all, q_pos, jnp.arange(L))
    _, sel = lax.top_k(scores, n_sel)
    kg = gather_paged(cache_k, page_table, k_new, sel)
    vg = gather_paged(cache_v, page_table, v_new, sel)
    return sparse_attend(q, kg, vg, q_pos, sel, rel_bias)


def short_conv(bg, cg, xin, prev, conv_w, conv_b):
    u = cg * xin
    up = jnp.concatenate([prev, u], axis=1)
    T = u.shape[1]
    y = conv_b + sum(up[:, j:j + T] * conv_w[j] for j in range(CONV_WIDTH))
    return bg * y, up[:, up.shape[1] - (CONV_WIDTH - 1):]


def peer_ffn(h, wq, k1, k2, u_tab, v_tab):
    lead = h.shape[:-1]
    hf = h.reshape(-1, D_MODEL)
    n = hf.shape[0]
    hf = jnp.pad(hf, ((0, (-n) % PEER_BLOCK), (0, 0)))

    def block(hb):
        q = (hb @ wq).reshape(-1, PEER_HEADS, 2, PEER_HALF)
        s1 = jnp.einsum('nhd,kd->nhk', q[:, :, 0], k1).astype(jnp.float32)
        s2 = jnp.einsum('nhd,kd->nhk', q[:, :, 1], k2).astype(jnp.float32)
        v1, i1 = lax.top_k(s1, PEER_TOPK_HALF)
        v2, i2 = lax.top_k(s2, PEER_TOPK_HALF)
        cand = (v1[..., :, None] + v2[..., None, :]).reshape(*v1.shape[:-1], -1)
        cidx = (i1[..., :, None] * N_KEYS + i2[..., None, :]).reshape(*i1.shape[:-1], -1)
        sv, si = lax.top_k(cand, PEER_TOPK)
        eidx = jnp.take_along_axis(cidx, si, axis=-1)
        g = jax.nn.softmax(sv, axis=-1)
        a = jnp.einsum('nd,nhkd->nhk', hb, u_tab[eidx])
        act = (jax.nn.gelu(a.astype(jnp.float32)) * g).astype(hb.dtype)
        return jnp.einsum('nhk,nhkd->nd', act, v_tab[eidx])

    out = lax.map(block, hf.reshape(-1, PEER_BLOCK, D_MODEL))
    return out.reshape(-1, D_MODEL)[:n].reshape(*lead, D_MODEL)


def decoder_layer(x, c, prev_conv, attn_fn, w_ada, b_ada, w_in, conv_w, conv_b, w_o_attn, w_o_conv,
                  w_out, ln1_g, ln1_b, ln2_g, ln2_b, peer_wq, peer_k1, peer_k2, peer_u, peer_v):
    B, T = x.shape[0], x.shape[1]
    mod = (c @ w_ada + b_ada)[:, None, :]
    sh1, sc1, g1, sh2, sc2, g2 = jnp.split(mod, 6, axis=-1)
    h = x * (1 + sc1) + sh1
    q, k, v, qi, wi, ki, bg, cg, xin, ga, gb = split_columns(h @ w_in)
    q = q.reshape(B, T, N_KV_HEADS, GROUP, HEAD_DIM)
    k = k.reshape(B, T, N_KV_HEADS, HEAD_DIM)
    v = v.reshape(B, T, N_KV_HEADS, HEAD_DIM)
    qi = qi.reshape(B, T, N_IDX_HEADS, IDX_DIM)
    o_attn = attn_fn(q, k, v, qi, wi, ki)
    o_conv, conv_state = short_conv(bg, cg, xin, prev_conv, conv_w, conv_b)
    merged = jax.nn.sigmoid(ga) * (o_attn @ w_o_attn) + jax.nn.sigmoid(gb) * (o_conv @ w_o_conv)
    x = layer_norm(DN_ALPHA * x + g1 * (merged @ w_out), ln1_g, ln1_b)
    h2 = x * (1 + sc2) + sh2
    x = layer_norm(DN_ALPHA * x + g2 * peer_ffn(h2, peer_wq, peer_k1, peer_k2, peer_u, peer_v), ln2_g, ln2_b)
    return x, k, v, ki, conv_state


def setup_inputs(seed: int = 0) -> dict:
    key = jax.random.key(seed)
    ks = jax.random.split(key, 32)
    f32 = jnp.float32

    def nrm(k, shape, s=1.0):
        return jax.random.normal(k, shape, f32) * s

    n_pages = PAST_LEN // PAGE_SIZE
    n_used = DEC_BATCH * n_pages
    n_pool = n_used + max(1, n_used // 4)
    page_table = jax.random.permutation(ks[0], n_pool)[:n_used].reshape(DEC_BATCH, n_pages).astype(jnp.int32)
    return {
        "x_prompt": nrm(ks[1], (BATCH, SEQ, D_MODEL)),
        "x_sample": nrm(ks[2], (DEC_BATCH, DEC_SEQ, D_MODEL)),
        "c_prompt": nrm(ks[3], (BATCH, D_MODEL)),
        "c_sample": nrm(ks[4], (DEC_BATCH, D_MODEL)),
        "cache_k": nrm(ks[5], (DEPTH, n_pool, PAGE_SIZE, N_KV_HEADS, HEAD_DIM)),
        "cache_v": nrm(ks[6], (DEPTH, n_pool, PAGE_SIZE, N_KV_HEADS, HEAD_DIM)),
        "cache_kidx": nrm(ks[7], (DEPTH, n_pool, PAGE_SIZE, IDX_DIM)),
        "state_conv": nrm(ks[8], (DEPTH, DEC_BATCH, CONV_WIDTH - 1, D_CONV)),
        "page_table": page_table,
        "rel_bias": nrm(ks[9], (N_BUCKETS, N_HEADS), 0.5),
        "w_ada": nrm(ks[10], (DEPTH, D_MODEL, 6 * D_MODEL), 0.5 * D_MODEL ** -0.5),
        "b_ada": nrm(ks[11], (DEPTH, 6 * D_MODEL), 0.01),
        "w_in": nrm(ks[12], (DEPTH, D_MODEL, D_MIX_IN), D_MODEL ** -0.5),
        "conv_w": nrm(ks[13], (DEPTH, CONV_WIDTH, D_CONV), CONV_WIDTH ** -0.5),
        "conv_b": nrm(ks[14], (DEPTH, D_CONV), 0.01),
        "w_o_attn": nrm(ks[15], (DEPTH, ATTN_WIDTH, D_MODEL), DN_BETA * ATTN_WIDTH ** -0.5),
        "w_o_conv": nrm(ks[16], (DEPTH, D_CONV, D_MODEL), DN_BETA * D_CONV ** -0.5),
        "w_out": nrm(ks[17], (DEPTH, D_MODEL, D_MODEL), DN_BETA * D_MODEL ** -0.5),
        "ln1_g": 1.0 + nrm(ks[18], (DEPTH, D_MODEL), 0.02),
        "ln1_b": nrm(ks[19], (DEPTH, D_MODEL), 0.02),
        "ln2_g": 1.0 + nrm(ks[20], (DEPTH, D_MODEL), 0.02),
        "ln2_b": nrm(ks[21], (DEPTH, D_MODEL), 0.02),
        "peer_wq": nrm(ks[22], (DEPTH, D_MODEL, PEER_HEADS * PEER_KEY_DIM), D_MODEL ** -0.5),
        "peer_k1": nrm(ks[23], (DEPTH, N_KEYS, PEER_HALF), PEER_HALF ** -0.5),
        "peer_k2": nrm(ks[24], (DEPTH, N_KEYS, PEER_HALF), PEER_HALF ** -0.5),
        "peer_u": nrm(ks[25], (DEPTH, N_EXPERTS, D_MODEL), D_MODEL ** -0.5),
        "peer_v": nrm(ks[26], (DEPTH, N_EXPERTS, D_MODEL), DN_BETA * (PEER_HEADS * PEER_TOPK) ** -0.5),
    }


def reference(x_prompt, x_sample, c_prompt, c_sample, cache_k, cache_v, cache_kidx, state_conv, page_table,
              rel_bias, w_ada, b_ada, w_in, conv_w, conv_b, w_o_attn, w_o_conv, w_out, ln1_g, ln1_b,
              ln2_g, ln2_b, peer_wq, peer_k1, peer_k2, peer_u, peer_v):
    xp, xs = x_prompt, x_sample
    kp_l, vp_l, kip_l, cp_l, ks_l, vs_l, kis_l, cs_l = [], [], [], [], [], [], [], []
    for l in range(DEPTH):
        lw = (w_ada[l], b_ada[l], w_in[l], conv_w[l], conv_b[l], w_o_attn[l], w_o_conv[l], w_out[l],
              ln1_g[l], ln1_b[l], ln2_g[l], ln2_b[l], peer_wq[l], peer_k1[l], peer_k2[l], peer_u[l], peer_v[l])
        prev0 = jnp.zeros((xp.shape[0], CONV_WIDTH - 1, D_CONV), xp.dtype)
        fn_p = functools.partial(attn_prompt, rel_bias=rel_bias)
        xp, kp, vp, kip, cp = decoder_layer(xp, c_prompt, prev0, fn_p, *lw)
        fn_s = functools.partial(attn_sample, cache_k=cache_k[l], cache_v=cache_v[l], cache_ki=cache_kidx[l],
                                 page_table=page_table, rel_bias=rel_bias)
        xs, ks_, vs_, kis, cs = decoder_layer(xs, c_sample, state_conv[l], fn_s, *lw)
        kp_l.append(kp); vp_l.append(vp); kip_l.append(kip); cp_l.append(cp)
        ks_l.append(ks_); vs_l.append(vs_); kis_l.append(kis); cs_l.append(cs)
    return (xp, xs, jnp.stack(kp_l), jnp.stack(vp_l), jnp.stack(kip_l), jnp.stack(cp_l),
            jnp.stack(ks_l), jnp.stack(vs_l), jnp.stack(kis_l), jnp.stack(cs_l))
```

```cpp
#include <hip/hip_runtime.h>
#include <cstdio>
#include <cstdint>

#ifndef N_LAUNCHES
#define N_LAUNCHES 0
#endif

typedef unsigned short bf16_t;
typedef short bf16x8 __attribute__((ext_vector_type(8)));
typedef float f32x4 __attribute__((ext_vector_type(4)));
typedef float f32x16 __attribute__((ext_vector_type(16)));
typedef unsigned u32x4 __attribute__((ext_vector_type(4)));
typedef unsigned u32x2 __attribute__((ext_vector_type(2)));
#define LAS __attribute__((address_space(3)))

constexpr int D = 1024, NB_P = 8, SEQ = 2048, NB_S = 32, TS = 8, PAST = 8192, PAGE = 128, NPAGES = 64;
constexpr int NTP = NB_P * SEQ;
constexpr int NTS = NB_S * TS;
constexpr int NT = NTP + NTS;
constexpr int NMIX = 4676, NMIXP = 4736;
constexpr int C_Q = 0, C_K = 512, C_V = 640, C_QI = 768, C_KI = 1024, C_BG = 1088, C_CG = 1600, C_XIN = 2112, C_GA = 2624, C_GB = 3648, C_WI = 4672;
constexpr int NSEL = 256;
constexpr float ATTN_SCALE = 0.125f, IDX_SCALE = 0.0625f;
constexpr float DN_ALPHA = 1.189207115002721f, LN_EPS = 1e-5f;
constexpr int NEXP_SEL = 128;

constexpr size_t O_YP = 0, O_YS = 16777216, O_KP = 17039360, O_VP = 19136512, O_KIP = 21233664, O_CP = 22282240,
                 O_KS = 22290432, O_VS = 22323200, O_KIS = 22355968, O_CS = 22372352, O_END = 22405120;

constexpr size_t MB = 1048576;
constexpr size_t WS_CTL = 0, WS_MOD = 1 * MB, WS_WIN = 2 * MB, WS_WOA = 12 * MB, WS_WOC = 13 * MB, WS_WOUT = 14 * MB, WS_WQ = 16 * MB,
                 WS_K1 = 18 * MB, WS_K2 = 18 * MB + 65536, WS_PU = 20 * MB, WS_PV = 52 * MB, WS_H1 = 84 * MB, WS_PROJ = 118 * MB,
                 WS_WI = 270 * MB, WS_SEL = 271 * MB, WS_OATT = 288 * MB, WS_OCONV = 305 * MB, WS_MERGED = 322 * MB, WS_T1 = 355 * MB,
                 WS_H2 = 420 * MB, WS_QP = 453 * MB, WS_EIDX = 486 * MB, WS_GW = 495 * MB, WS_SS = 504 * MB, WS_END = 513 * MB;
constexpr int CTL_ZERO_BYTES = 65536;

constexpr int NTHREADS = 512;
constexpr int LDS_BYTES = 160 * 1024 - 512;
constexpr int LDS_MISC = LDS_BYTES - 64;

__device__ __forceinline__ float bf2f(bf16_t b) { return __uint_as_float(((unsigned)b) << 16); }
__device__ __forceinline__ float bflo(unsigned p) { return __uint_as_float(p << 16); }
__device__ __forceinline__ float bfhi(unsigned p) { return __uint_as_float(p & 0xFFFF0000u); }
typedef __bf16 bf16x2_t __attribute__((ext_vector_type(2)));
typedef float f32x2_t __attribute__((ext_vector_type(2)));
__device__ __forceinline__ unsigned cvt_pk_bf16(float lo, float hi) { const f32x2_t f = {lo, hi}; const bf16x2_t b = __builtin_convertvector(f, bf16x2_t); unsigned r; __builtin_memcpy(&r, &b, 4); return r; }
__device__ __forceinline__ bf16_t f2bf(float f) { return (bf16_t)(cvt_pk_bf16(f, 0.f) & 0xFFFFu); }
__device__ __forceinline__ float wave_sum(float v) {
#pragma unroll
    for (int o = 32; o >= 1; o >>= 1) v += __shfl_xor(v, o);
    return v;
}
__device__ __forceinline__ float wave_max(float v) {
#pragma unroll
    for (int o = 32; o >= 1; o >>= 1) v = fmaxf(v, __shfl_xor(v, o));
    return v;
}
__device__ __forceinline__ float sigmoidf_(float x) { return 1.f / (1.f + __expf(-x)); }
__device__ __forceinline__ float gelu_tanh(float a) {
    const float z = 0.7978845608028654f * (a + 0.044715f * a * a * a);
    const float e = __expf(2.f * z);
    const float t = 1.f - 2.f / (e + 1.f);
    return 0.5f * a * (1.f + t);
}
__device__ __forceinline__ unsigned f2ord(float f) { const unsigned u = __float_as_uint(f); return (u & 0x80000000u) ? ~u : (u | 0x80000000u); }
__device__ __forceinline__ int t5_bucket(int n) {
    if (n < 16) return n;
    int b = 16;
    b += (n >= 19) + (n >= 21) + (n >= 24) + (n >= 27) + (n >= 31) + (n >= 35) + (n >= 40) + (n >= 46) + (n >= 52) + (n >= 59) + (n >= 67) + (n >= 77) + (n >= 87) + (n >= 99) + (n >= 113);
    return b;
}

#define XB_TMO      128
#define XB_XCNT(j)  (256  + 64 * (j))
#define XB_XSUB(j)  (1280 + 64 * (j))
#define XB_XGEN(j)  (2304 + 64 * (j))
#define XB_TOP      3328
#define XB_TOPGEN   3392
#define XCD_BAR_WORDS 3456
#define XB_SPIN_CAP (1u << 18)
__device__ __forceinline__ unsigned xb_ld(unsigned* p)              { return __hip_atomic_load(p, __ATOMIC_RELAXED, __HIP_MEMORY_SCOPE_AGENT); }
__device__ __forceinline__ unsigned xb_add(unsigned* p, unsigned v) { return __hip_atomic_fetch_add(p, v, __ATOMIC_RELAXED, __HIP_MEMORY_SCOPE_AGENT); }
__device__ __forceinline__ unsigned xb_xcc_id() { return (unsigned)__builtin_amdgcn_s_getreg((3 << 11) | 20) & 0xFu; }
#define XB_SPIN(cond, bar) do { unsigned _sp = 0; while (cond) { __builtin_amdgcn_s_sleep(1); \
    if ((++_sp & 255u) == 0u) { if (xb_ld(&(bar)[XB_TMO])) break; if (_sp > XB_SPIN_CAP) { atomicAdd(&(bar)[XB_TMO], 1u); break; } } } } while (0)
struct XcdBarrier { unsigned* bar; unsigned x; volatile LAS unsigned* st; };
__device__ __forceinline__ XcdBarrier xcd_barrier_post(unsigned* bar, volatile LAS unsigned* st) {
    XcdBarrier b; b.bar = bar; b.x = xb_xcc_id(); b.st = st;
    if (threadIdx.x == 0) (void)xb_add(&bar[XB_XCNT(b.x)], 1u);
    return b;
}
__device__ __forceinline__ void xcd_barrier_complete(unsigned* bar, unsigned x, unsigned& nloc, unsigned& nx) {
    const unsigned G = gridDim.x * gridDim.y * gridDim.z;
    unsigned sum, cnt, mine, sp = 0u;
    for (;;) {
        sum = 0u; cnt = 0u; mine = 0u;
#pragma unroll
        for (unsigned j = 0; j < 16; ++j) { const unsigned c = xb_ld(&bar[XB_XCNT(j)]); sum += c; cnt += (c > 0u) ? 1u : 0u; mine = (j == x) ? c : mine; }
        if (sum == G) break;
        __builtin_amdgcn_s_sleep(1);
        if ((++sp & 255u) == 0u) { if (xb_ld(&bar[XB_TMO])) break; if (sp > XB_SPIN_CAP) { atomicAdd(&bar[XB_TMO], 1u); break; } }
    }
    nloc = mine > 0u ? mine : 1u; nx = cnt > 0u ? cnt : 1u;
}
__device__ __forceinline__ void xcd_barrier(const XcdBarrier& b) {
    asm volatile("s_waitcnt vmcnt(0)" ::: "memory");
    __syncthreads();
    if (threadIdx.x == 0) {
        unsigned* bar = b.bar;
        __builtin_amdgcn_s_waitcnt(0);
        unsigned nloc = b.st[0], nx = b.st[1];
        if (nloc == 0u) { xcd_barrier_complete(bar, b.x, nloc, nx); b.st[0] = nloc; b.st[1] = nx; }
        const unsigned old = xb_add(&bar[XB_XSUB(b.x)], 1u);
        const unsigned gen = old / nloc;
        if (old + 1u == (gen + 1u) * nloc) {
            __builtin_amdgcn_fence(__ATOMIC_RELEASE, "agent");
            asm volatile("s_waitcnt vmcnt(0)" ::: "memory");
            const unsigned og = xb_add(&bar[XB_TOP], 1u);
            const unsigned tg = og / nx;
            if (og + 1u == (tg + 1u) * nx) xb_add(&bar[XB_TOPGEN], 1u);
            else XB_SPIN(xb_ld(&bar[XB_TOPGEN]) == tg, bar);
            __builtin_amdgcn_fence(__ATOMIC_ACQUIRE, "agent");
            xb_add(&bar[XB_XGEN(b.x)], 1u);
            asm volatile("s_waitcnt vmcnt(0)" ::: "memory");
        } else {
            XB_SPIN(xb_ld(&bar[XB_XGEN(b.x)]) == gen, bar);
            __builtin_amdgcn_fence(__ATOMIC_ACQUIRE, "agent");
            asm volatile("s_waitcnt vmcnt(0)" ::: "memory");
        }
    }
    __syncthreads();
}

struct Args { const void* in[27]; float* out; unsigned char* ws; int ph_lo, ph_hi; };
struct Core { LAS unsigned char* lds; int tid, lane, wave, G, bid; };
struct Frame {
    LAS unsigned char* lds;
    int tid, lane, wave, G, bid;
    const float *x_p, *x_s, *c_p, *c_s, *cache_k, *cache_v, *cache_ki, *state_conv, *rel_bias, *w_ada, *b_ada, *w_in, *conv_w, *conv_b,
                *w_o_attn, *w_o_conv, *w_out, *ln1_g, *ln1_b, *ln2_g, *ln2_b, *peer_wq, *peer_k1, *peer_k2, *peer_u, *peer_v;
    const int* page_table;
    float* out;
    float* MOD; bf16_t *WIN, *WOA, *WOC, *WOUT, *WQ, *K1, *K2, *PU, *PV, *H1, *PROJ, *OATT, *OCONV, *MERGED, *H2, *QP;
    float *WI, *T1, *GW; int *SEL, *EIDX;
};
constexpr int LDS_PTAB = LDS_BYTES - 512;
__device__ __forceinline__ unsigned char* ldptr(const Core& C, int k) {
    LAS const unsigned* p = (LAS const unsigned*)(C.lds + LDS_PTAB) + 2 * k;
    const unsigned lo = __builtin_amdgcn_readfirstlane(p[0]), hi = __builtin_amdgcn_readfirstlane(p[1]);
    return (unsigned char*)(((unsigned long long)hi << 32) | (unsigned long long)lo);
}
__device__ __forceinline__ void load_frame(Frame& F, const Core& C) {
    F.lds = C.lds; F.tid = C.tid; F.lane = C.lane; F.wave = C.wave; F.G = C.G; F.bid = C.bid;
    F.x_p = (const float*)ldptr(C, 0); F.x_s = (const float*)ldptr(C, 1); F.c_p = (const float*)ldptr(C, 2); F.c_s = (const float*)ldptr(C, 3);
    F.cache_k = (const float*)ldptr(C, 4); F.cache_v = (const float*)ldptr(C, 5); F.cache_ki = (const float*)ldptr(C, 6); F.state_conv = (const float*)ldptr(C, 7);
    F.page_table = (const int*)ldptr(C, 8); F.rel_bias = (const float*)ldptr(C, 9); F.w_ada = (const float*)ldptr(C, 10); F.b_ada = (const float*)ldptr(C, 11);
    F.w_in = (const float*)ldptr(C, 12); F.conv_w = (const float*)ldptr(C, 13); F.conv_b = (const float*)ldptr(C, 14); F.w_o_attn = (const float*)ldptr(C, 15);
    F.w_o_conv = (const float*)ldptr(C, 16); F.w_out = (const float*)ldptr(C, 17); F.ln1_g = (const float*)ldptr(C, 18); F.ln1_b = (const float*)ldptr(C, 19);
    F.ln2_g = (const float*)ldptr(C, 20); F.ln2_b = (const float*)ldptr(C, 21); F.peer_wq = (const float*)ldptr(C, 22); F.peer_k1 = (const float*)ldptr(C, 23);
    F.peer_k2 = (const float*)ldptr(C, 24); F.peer_u = (const float*)ldptr(C, 25); F.peer_v = (const float*)ldptr(C, 26);
    F.out = (float*)ldptr(C, 27);
    unsigned char* ws = ldptr(C, 28);
    F.MOD = (float*)(ws + WS_MOD); F.WIN = (bf16_t*)(ws + WS_WIN); F.WOA = (bf16_t*)(ws + WS_WOA); F.WOC = (bf16_t*)(ws + WS_WOC);
    F.WOUT = (bf16_t*)(ws + WS_WOUT); F.WQ = (bf16_t*)(ws + WS_WQ); F.K1 = (bf16_t*)(ws + WS_K1); F.K2 = (bf16_t*)(ws + WS_K2);
    F.PU = (bf16_t*)(ws + WS_PU); F.PV = (bf16_t*)(ws + WS_PV); F.H1 = (bf16_t*)(ws + WS_H1); F.PROJ = (bf16_t*)(ws + WS_PROJ);
    F.WI = (float*)(ws + WS_WI); F.SEL = (int*)(ws + WS_SEL); F.OATT = (bf16_t*)(ws + WS_OATT); F.OCONV = (bf16_t*)(ws + WS_OCONV);
    F.MERGED = (bf16_t*)(ws + WS_MERGED); F.T1 = (float*)(ws + WS_T1); F.H2 = (bf16_t*)(ws + WS_H2); F.QP = (bf16_t*)(ws + WS_QP);
    F.EIDX = (int*)(ws + WS_EIDX); F.GW = (float*)(ws + WS_GW);
}
__device__ __forceinline__ const float* x_row(const Frame& F, int m) { return m < NTP ? F.x_p + (size_t)m * D : F.x_s + (size_t)(m - NTP) * D; }
__device__ __forceinline__ int mod_row(int m) { return m < NTP ? (m >> 11) : NB_P + ((m - NTP) >> 3); }

constexpr int P0_MOD_ITEMS = 96;
constexpr int P0_T_WIN = 16 * 74, P0_T_WOA = 8 * 16, P0_T_WOC = 8 * 16, P0_T_WOUT = 16 * 16, P0_T_WQ = 16 * 16;
constexpr int P0_T_ITEMS = P0_T_WIN + P0_T_WOA + P0_T_WOC + P0_T_WOUT + P0_T_WQ;
constexpr int P0_CVT_ITEMS = 2 * (16384 * 1024 / 8192);
constexpr int P0_MISC_ITEMS = 1;
constexpr int P0_ITEMS = P0_MOD_ITEMS + P0_T_ITEMS + P0_CVT_ITEMS + P0_MISC_ITEMS;

__device__ __forceinline__ void p0_mod_item(const Frame& F, int ng) {
    LAS float* cs = (LAS float*)F.lds;
    LAS float* red = (LAS float*)(F.lds + 40 * 256 * 4);
    float acc[40];
#pragma unroll
    for (int r = 0; r < 40; ++r) acc[r] = 0.f;
    const int n = ng * 64 + F.lane;
    for (int kc = 0; kc < 4; ++kc) {
        __syncthreads();
        for (int e = F.tid; e < 40 * 256; e += NTHREADS) { const int r = e >> 8, k = e & 255; cs[e] = (r < 8) ? F.c_p[r * D + kc * 256 + k] : F.c_s[(r - 8) * D + kc * 256 + k]; }
        __syncthreads();
        for (int kk = 0; kk < 32; ++kk) {
            const int kl = F.wave * 32 + kk;
            const float wv = F.w_ada[(size_t)(kc * 256 + kl) * 6144 + n];
#pragma unroll
            for (int r = 0; r < 40; ++r) acc[r] += cs[r * 256 + kl] * wv;
        }
    }
#pragma unroll
    for (int r = 0; r < 40; ++r) red[(F.wave * 40 + r) * 64 + F.lane] = acc[r];
    __syncthreads();
    for (int e = F.tid; e < 40 * 64; e += NTHREADS) {
        const int r = e >> 6, l = e & 63; float s = F.b_ada[ng * 64 + l];
#pragma unroll
        for (int w = 0; w < 8; ++w) s += red[(w * 40 + r) * 64 + l];
        F.MOD[r * 6144 + ng * 64 + l] = s;
    }
    __syncthreads();
}
__device__ __forceinline__ void p0_transpose_tile(const Frame& F, const float* W, int N, int K, bf16_t* Wt, int kt, int nt, bool permute) {
    LAS bf16_t* tile = (LAS bf16_t*)F.lds;
    __syncthreads();
    { const int k = F.tid >> 3, c0 = (F.tid & 7) * 8;
#pragma unroll
      for (int j = 0; j < 8; ++j) { const int n = nt * 64 + c0 + j; const float v = (n < N) ? W[(size_t)(kt * 64 + k) * N + n] : 0.f; tile[k * 66 + c0 + j] = f2bf(v); } }
    __syncthreads();
    { const int nl = F.tid >> 3, k0 = (F.tid & 7) * 8; const int n = nt * 64 + nl;
      if (n < N) {
          int nd = n; if (permute) nd = (n < 1024) ? n : (n < 1028 ? C_WI + (n - 1024) : n - 4);
          unsigned p[4];
#pragma unroll
          for (int j = 0; j < 4; ++j) p[j] = (unsigned)tile[(k0 + 2 * j) * 66 + nl] | ((unsigned)tile[(k0 + 2 * j + 1) * 66 + nl] << 16);
          *(u32x4*)(Wt + (size_t)nd * K + kt * 64 + k0) = (u32x4){p[0], p[1], p[2], p[3]};
      } }
}
__device__ __forceinline__ void p0_prologue(const Core& C) {
    Frame F; load_frame(F, C);
    for (int it = F.bid; it < P0_ITEMS; it += F.G) {
        int i = it;
        if (i < P0_MOD_ITEMS) { p0_mod_item(F, i); continue; }
        i -= P0_MOD_ITEMS;
        if (i < P0_T_ITEMS) {
            if (i < P0_T_WIN) { p0_transpose_tile(F, F.w_in, NMIX, D, F.WIN, i / 74, i % 74, true); continue; }
            i -= P0_T_WIN;
            if (i < P0_T_WOA) { p0_transpose_tile(F, F.w_o_attn, D, 512, F.WOA, i / 16, i % 16, false); continue; }
            i -= P0_T_WOA;
            if (i < P0_T_WOC) { p0_transpose_tile(F, F.w_o_conv, D, 512, F.WOC, i / 16, i % 16, false); continue; }
            i -= P0_T_WOC;
            if (i < P0_T_WOUT) { p0_transpose_tile(F, F.w_out, D, D, F.WOUT, i / 16, i % 16, false); continue; }
            i -= P0_T_WOUT;
            p0_transpose_tile(F, F.peer_wq, D, D, F.WQ, i / 16, i % 16, false); continue;
        }
        i -= P0_T_ITEMS;
        if (i < P0_CVT_ITEMS) {
            const float* src = (i < 2048) ? F.peer_u : F.peer_v; bf16_t* dst = (i < 2048) ? F.PU : F.PV;
            const size_t base = (size_t)(i & 2047) * 8192 + (size_t)F.tid * 16;
            const f32x4 a = *(const f32x4*)(src + base), b = *(const f32x4*)(src + base + 4), c = *(const f32x4*)(src + base + 8), d = *(const f32x4*)(src + base + 12);
            *(u32x4*)(dst + base) = (u32x4){cvt_pk_bf16(a[0], a[1]), cvt_pk_bf16(a[2], a[3]), cvt_pk_bf16(b[0], b[1]), cvt_pk_bf16(b[2], b[3])};
            *(u32x4*)(dst + base + 8) = (u32x4){cvt_pk_bf16(c[0], c[1]), cvt_pk_bf16(c[2], c[3]), cvt_pk_bf16(d[0], d[1]), cvt_pk_bf16(d[2], d[3])};
            continue;
        }
        for (int e = F.tid; e < (NMIXP - NMIX) * D; e += NTHREADS) F.WIN[(size_t)NMIX * D + e] = 0;
        for (int e = F.tid; e < 128 * 64; e += NTHREADS) { F.K1[e] = f2bf(F.peer_k1[e]); F.K2[e] = f2bf(F.peer_k2[e]); }
    }
}

__device__ __forceinline__ void p1_modulate(const Core& C) {
    Frame F; load_frame(F, C);
    for (int m = F.bid * 8 + F.wave; m < NT; m += F.G * 8) {
        const float* xr = x_row(F, m); const float* mr = F.MOD + (size_t)mod_row(m) * 6144;
#pragma unroll
        for (int hlf = 0; hlf < 2; ++hlf) {
            const int e = hlf * 512 + F.lane * 8;
            const f32x4 x0 = *(const f32x4*)(xr + e), x1 = *(const f32x4*)(xr + e + 4);
            const f32x4 s0 = *(const f32x4*)(mr + 1024 + e), s1 = *(const f32x4*)(mr + 1024 + e + 4);
            const f32x4 h0 = *(const f32x4*)(mr + e), h1 = *(const f32x4*)(mr + e + 4);
            const f32x4 a = x0 * (s0 + 1.f) + h0, b = x1 * (s1 + 1.f) + h1;
            *(u32x4*)(F.H1 + (size_t)m * D + e) = (u32x4){cvt_pk_bf16(a[0], a[1]), cvt_pk_bf16(a[2], a[3]), cvt_pk_bf16(b[0], b[1]), cvt_pk_bf16(b[2], b[3])};
        }
    }
}

constexpr int BM = 256, BN = 128, BK = 64;
constexpr int XPANEL = BM * 32 + 32, WPANEL = BN * 32 + 32;
constexpr int XSTAGE = 4 * XPANEL, WSTAGE = 4 * WPANEL, GSTAGE = XSTAGE + WSTAGE;
__device__ __forceinline__ void gemm_accum(const Frame& F, f32x16 (&acc)[2][2], const bf16_t* __restrict__ X, int ldx, const bf16_t* __restrict__ W, int ldw, int K, int m0, int n0) {
    const int tid = F.tid, lane = F.lane, r = lane & 31, h = lane >> 5, wm = F.wave >> 1, wn = F.wave & 1;
    u32x4 xr[4], wr[2];
    const int nk = K / BK;
    const int crow = tid >> 3, ckc = tid & 7;
    const bf16_t* xg = X + (size_t)(m0 + crow) * ldx + ckc * 8;
    const bf16_t* wg = W + (size_t)(n0 + crow) * ldw + ckc * 8;
    const int ldso = (ckc >> 1) * 1  ;
    const int xoff = ldso * XPANEL + crow * 32 + (ckc & 1) * 16;
    const int woff = ldso * WPANEL + crow * 32 + (ckc & 1) * 16;
#pragma unroll
    for (int i = 0; i < 4; ++i) xr[i] = *(const u32x4*)(xg + (size_t)(64 * i) * ldx);
#pragma unroll
    for (int i = 0; i < 2; ++i) wr[i] = *(const u32x4*)(wg + (size_t)(64 * i) * ldw);
    __syncthreads();
    for (int kt = 0; kt < nk; ++kt) {
        LAS unsigned char* st = F.lds + (kt & 1) * GSTAGE;
#pragma unroll
        for (int i = 0; i < 4; ++i) *(LAS u32x4*)(st + xoff + i * 64 * 32) = xr[i];
#pragma unroll
        for (int i = 0; i < 2; ++i) *(LAS u32x4*)(st + XSTAGE + woff + i * 64 * 32) = wr[i];
        __syncthreads();
        if (kt + 1 < nk) {
#pragma unroll
            for (int i = 0; i < 4; ++i) xr[i] = *(const u32x4*)(xg + (size_t)(64 * i) * ldx + (kt + 1) * BK);
#pragma unroll
            for (int i = 0; i < 2; ++i) wr[i] = *(const u32x4*)(wg + (size_t)(64 * i) * ldw + (kt + 1) * BK);
        }
#pragma unroll
        for (int s = 0; s < 4; ++s) {
            bf16x8 a[2], b[2];
#pragma unroll
            for (int ni = 0; ni < 2; ++ni) a[ni] = *(LAS bf16x8*)(st + XSTAGE + s * WPANEL + (wn * 64 + ni * 32 + r) * 32 + h * 16);
#pragma unroll
            for (int mi = 0; mi < 2; ++mi) b[mi] = *(LAS bf16x8*)(st + s * XPANEL + (wm * 64 + mi * 32 + r) * 32 + h * 16);
#pragma unroll
            for (int mi = 0; mi < 2; ++mi)
#pragma unroll
                for (int ni = 0; ni < 2; ++ni) acc[mi][ni] = __builtin_amdgcn_mfma_f32_32x32x16_bf16(a[ni], b[mi], acc[mi][ni], 0, 0, 0);
        }
    }
}
#define GEMM_EPI_LOOP(...) \
    { const int r_ = F.lane & 31, h_ = F.lane >> 5, wm_ = F.wave >> 1, wn_ = F.wave & 1; \
      _Pragma("unroll") for (int mi = 0; mi < 2; ++mi) _Pragma("unroll") for (int ni = 0; ni < 2; ++ni) _Pragma("unroll") for (int g = 0; g < 4; ++g) { \
          const int m = m0 + wm_ * 64 + mi * 32 + r_; const int n = n0 + wn_ * 64 + ni * 32 + 8 * g + 4 * h_; __VA_ARGS__ } }
#define ACC4(A) ((f32x4){A[mi][ni][4 * g], A[mi][ni][4 * g + 1], A[mi][ni][4 * g + 2], A[mi][ni][4 * g + 3]})
__device__ __forceinline__ void zero_acc(f32x16 (&acc)[2][2]) {
#pragma unroll
    for (int mi = 0; mi < 2; ++mi)
#pragma unroll
        for (int ni = 0; ni < 2; ++ni)
#pragma unroll
            for (int e = 0; e < 16; ++e) acc[mi][ni][e] = 0.f;
}
__device__ __forceinline__ u32x2 pk4(const f32x4 v) { return (u32x2){cvt_pk_bf16(v[0], v[1]), cvt_pk_bf16(v[2], v[3])}; }

__device__ __forceinline__ void p2_gemm_in(const Core& C) {
    Frame F; load_frame(F, C);
    const int ntile = (NT / BM) * (NMIXP / BN);
    for (int t = F.bid; t < ntile; t += F.G) {
        const int m0 = (t / (NMIXP / BN)) * BM, n0 = (t % (NMIXP / BN)) * BN;
        f32x16 acc[2][2]; zero_acc(acc);
        gemm_accum(F, acc, F.H1, D, F.WIN, D, D, m0, n0);
        GEMM_EPI_LOOP({
            const f32x4 v = ACC4(acc);
            *(u32x2*)(F.PROJ + (size_t)m * NMIXP + n) = pk4(v);
            if (n >= C_K && n < C_QI) {
                float* o = (n < C_V) ? (m < NTP ? F.out + O_KP + (size_t)m * 128 + (n - C_K) : F.out + O_KS + (size_t)(m - NTP) * 128 + (n - C_K))
                                     : (m < NTP ? F.out + O_VP + (size_t)m * 128 + (n - C_V) : F.out + O_VS + (size_t)(m - NTP) * 128 + (n - C_V));
                *(f32x4*)o = v;
            } else if (n >= C_KI && n < C_BG) {
                float* o = m < NTP ? F.out + O_KIP + (size_t)m * 64 + (n - C_KI) : F.out + O_KIS + (size_t)(m - NTP) * 64 + (n - C_KI);
                *(f32x4*)o = v;
            } else if (n == C_WI) {
                *(f32x4*)(F.WI + (size_t)m * 4) = v;
            }
        })
    }
}

constexpr int SROW = 2052;
__device__ __forceinline__ int wave_sum_i(int v) {
#pragma unroll
    for (int o = 32; o >= 1; o >>= 1) v += __shfl_xor(v, o);
    return v;
}
__device__ __forceinline__ void cnt_ge(int& c, unsigned u, unsigned t) { asm("v_cmp_ge_u32_e32 vcc, %1, %2\n\tv_addc_co_u32_e32 %0, vcc, 0, %0, vcc" : "+v"(c) : "v"(u), "v"(t) : "vcc"); }
__device__ __forceinline__ void cnt_gt(int& c, unsigned u, unsigned t) { asm("v_cmp_gt_u32_e32 vcc, %1, %2\n\tv_addc_co_u32_e32 %0, vcc, 0, %0, vcc" : "+v"(c) : "v"(u), "v"(t) : "vcc"); }
__device__ __forceinline__ void cnt_eq(int& c, unsigned u, unsigned t) { asm("v_cmp_eq_u32_e32 vcc, %1, %2\n\tv_addc_co_u32_e32 %0, vcc, 0, %0, vcc" : "+v"(c) : "v"(u), "v"(t) : "vcc"); }
__device__ __forceinline__ void cnt_eq_pos(int& c, unsigned u, unsigned t, int L) {
    int tmp;
    asm("v_cmp_eq_u32_e32 vcc, %2, %3\n\tv_cndmask_b32_e32 %1, %5, %4, vcc\n\tv_cmp_lt_i32_e32 vcc, 0, %1\n\tv_addc_co_u32_e32 %0, vcc, 0, %0, vcc"
        : "+v"(c), "=&v"(tmp) : "v"(u), "v"(t), "v"(L), "v"(0x80000000) : "vcc");
}
template <int NV> __device__ __forceinline__ void select_topk(const unsigned (&u)[NV], int ksel, int idx_bits, int* sel, int lane) {
    unsigned T = 0;
#pragma unroll 1
    for (int bit = 31; bit >= 0; --bit) {
        const unsigned cand = T | (1u << bit);
        int c = 0;
#pragma unroll
        for (int i = 0; i < NV; ++i) cnt_ge(c, u[i], cand);
        c = wave_sum_i(c);
        if (c >= ksel) T = cand;
    }
    int cg = 0, ce = 0;
#pragma unroll
    for (int i = 0; i < NV; ++i) { cnt_gt(cg, u[i], T); cnt_eq(ce, u[i], T); }
    const int ngt = wave_sum_i(cg), neq = wave_sum_i(ce);
    const int need = ksel - ngt;
    int Jx = 0x3FFFFFFF;
    if (need < neq) {
        int Jb = 0;
#pragma unroll 1
        for (int bit = idx_bits - 1; bit >= 0; --bit) {
            const int cand = Jb | (1 << bit);
            const int L = cand - lane;
            int c = 0;
#pragma unroll
            for (int i = 0; i < NV; ++i) cnt_eq_pos(c, u[i], T, L - 64 * i);
            c = wave_sum_i(c);
            if (c < need) Jb = cand;
        }
        Jx = Jb + 1;
    }
    const int L = Jx - lane;
    int ct = 0;
#pragma unroll
    for (int i = 0; i < NV; ++i) cnt_eq_pos(ct, u[i], T, L - 64 * i);
    int ig = cg, it = ct;
#pragma unroll
    for (int o = 1; o < 64; o <<= 1) { const int a = __shfl_up(ig, o), b2 = __shfl_up(it, o); if (lane >= o) { ig += a; it += b2; } }
    int pg = ig - cg, pt = ngt + it - ct;
    int ev = lane, Lr = L;
#pragma unroll
    for (int i = 0; i < NV; ++i) {
        if (u[i] > T) { sel[pg] = ev; ++pg; }
        else if (u[i] == T && Lr > 0) { sel[pt] = ev; ++pt; }
        asm volatile("v_add_u32 %0, 64, %0\n\tv_add_u32 %1, -64, %1" : "+v"(ev), "+v"(Lr));
    }
}

__device__ __forceinline__ void p3_index_prompt_unit(const Frame& F, int b, int qt) {
    LAS float* S = (LAS float*)F.lds;
    const int lane = F.lane, r = lane & 15, q4 = lane >> 4;
    const int q0 = qt * 16; const size_t tok0 = (size_t)b * SEQ;
    __syncthreads();
    bf16x8 A[4][2];
#pragma unroll
    for (int hh = 0; hh < 4; ++hh)
#pragma unroll
        for (int s = 0; s < 2; ++s) A[hh][s] = *(const bf16x8*)(F.PROJ + (tok0 + q0 + r) * NMIXP + C_QI + hh * 64 + s * 32 + q4 * 8);
    float wv[4][4];
#pragma unroll
    for (int g = 0; g < 4; ++g) { const f32x4 w4 = *(const f32x4*)(F.WI + (tok0 + q0 + 4 * q4 + g) * 4);
#pragma unroll
        for (int hh = 0; hh < 4; ++hh) wv[g][hh] = w4[hh] * IDX_SCALE; }
    const int nkt = qt + 1;
    for (int kt = F.wave; kt < nkt; kt += 8) {
        const int key0 = kt * 16;
        bf16x8 B[2];
#pragma unroll
        for (int s = 0; s < 2; ++s) B[s] = *(const bf16x8*)(F.PROJ + (tok0 + key0 + r) * NMIXP + C_KI + s * 32 + q4 * 8);
        float sc[4] = {0.f, 0.f, 0.f, 0.f};
#pragma unroll
        for (int hh = 0; hh < 4; ++hh) {
            f32x4 c = {0.f, 0.f, 0.f, 0.f};
            c = __builtin_amdgcn_mfma_f32_16x16x32_bf16(A[hh][0], B[0], c, 0, 0, 0);
            c = __builtin_amdgcn_mfma_f32_16x16x32_bf16(A[hh][1], B[1], c, 0, 0, 0);
#pragma unroll
            for (int g = 0; g < 4; ++g) sc[g] += fmaxf(c[g], 0.f) * wv[g][hh];
        }
#pragma unroll
        for (int g = 0; g < 4; ++g) S[(4 * q4 + g) * SROW + key0 + r] = sc[g];
    }
    __syncthreads();
    for (int rr = 0; rr < 2; ++rr) {
        const int row = F.wave * 2 + rr; const int q = q0 + row; const int nvalid = q + 1;
        int* sel = F.SEL + (tok0 + q) * NSEL;
        if (nvalid <= NSEL) {
#pragma unroll
            for (int i = 0; i < 4; ++i) { const int j = lane + 64 * i; sel[j] = (j < nvalid) ? j : -1; }
            continue;
        }
        unsigned u[32];
#pragma unroll
        for (int i = 0; i < 32; ++i) { const int j = lane + 64 * i; u[i] = (j < nvalid) ? f2ord(S[row * SROW + j]) : 0u; }
        select_topk<32>(u, NSEL, 11, sel, lane);
    }
}

__device__ __forceinline__ void p3_index_sample_unit(const Frame& F, float* SS, int b) {
    const int lane = F.lane, r = lane & 31, h = lane >> 5;
    {
        bf16x8 A[4];
        { const int q = r >> 2, hh = r & 3;
#pragma unroll
          for (int s = 0; s < 4; ++s) A[s] = *(const bf16x8*)(F.PROJ + (size_t)(NTP + b * TS + q) * NMIXP + C_QI + hh * 64 + s * 16 + h * 8); }
        float wv[4][4];
#pragma unroll
        for (int g = 0; g < 4; ++g) { const f32x4 w4 = *(const f32x4*)(F.WI + (size_t)(NTP + b * TS + 2 * g + h) * 4);
#pragma unroll
            for (int hh = 0; hh < 4; ++hh) wv[g][hh] = w4[hh] * IDX_SCALE; }
#pragma unroll 1
        for (int tl = F.wave; tl < PAST / 32; tl += 8) {
            const int key0 = tl * 32; const int page = F.page_table[b * NPAGES + (key0 >> 7)];
            const float* kr = F.cache_ki + ((size_t)page * PAGE + (key0 & 127) + r) * 64;
            f32x16 c;
#pragma unroll
            for (int e = 0; e < 16; ++e) c[e] = 0.f;
#pragma unroll
            for (int s = 0; s < 4; ++s) {
                const f32x4 lo = *(const f32x4*)(kr + s * 16 + h * 8), hi = *(const f32x4*)(kr + s * 16 + h * 8 + 4);
                const u32x4 pk = (u32x4){cvt_pk_bf16(lo[0], lo[1]), cvt_pk_bf16(lo[2], lo[3]), cvt_pk_bf16(hi[0], hi[1]), cvt_pk_bf16(hi[2], hi[3])};
                bf16x8 Bf; __builtin_memcpy(&Bf, &pk, 16);
                c = __builtin_amdgcn_mfma_f32_32x32x16_bf16(A[s], Bf, c, 0, 0, 0);
            }
#pragma unroll
            for (int g = 0; g < 4; ++g) {
                float sc = 0.f;
#pragma unroll
                for (int hh = 0; hh < 4; ++hh) sc += fmaxf(c[4 * g + hh], 0.f) * wv[g][hh];
                SS[(size_t)(b * TS + 2 * g + h) * PAST + key0 + r] = sc;
            }
        }
    }
    asm volatile("s_waitcnt vmcnt(0)" ::: "memory");
    __syncthreads();
    {
        const int q = F.wave;
        unsigned u[129];
        const float* srow = SS + (size_t)(b * TS + q) * PAST;
#pragma unroll
        for (int i = 0; i < 128; ++i) u[i] = f2ord(srow[64 * i + lane]);
        float s = 0.f;
        if (lane < TS) {
            const bf16_t* kn = F.PROJ + (size_t)(NTP + b * TS + lane) * NMIXP + C_KI;
            const bf16_t* qn = F.PROJ + (size_t)(NTP + b * TS + q) * NMIXP + C_QI;
            const f32x4 w4 = *(const f32x4*)(F.WI + (size_t)(NTP + b * TS + q) * 4);
#pragma unroll 1
            for (int hh = 0; hh < 4; ++hh) {
                float d = 0.f;
#pragma unroll 4
                for (int e = 0; e < 64; ++e) d += bf2f(qn[hh * 64 + e]) * bf2f(kn[e]);
                s += fmaxf(d, 0.f) * (w4[hh] * IDX_SCALE);
            }
        }
        u[128] = (lane < TS && lane <= q) ? f2ord(s) : 0u;
        int* sel = F.SEL + (size_t)(NTP + b * TS + q) * NSEL;
        select_topk<129>(u, NSEL, 14, sel, lane);
    }
}
__device__ __forceinline__ void p3_index(const Core& C) {
    Frame F; load_frame(F, C);
    const int nunits = NB_S + NB_P * (SEQ / 16);
    float* SS = (float*)(ldptr(C, 28) + WS_SS);
    for (int it = F.bid; it < nunits; it += F.G) {
        if (it < NB_S) { p3_index_sample_unit(F, SS, it); continue; }
        const int i = it - NB_S; const int b = i & 7, qt = (SEQ / 16 - 1) - (i >> 3);
        p3_index_prompt_unit(F, b, qt);
    }
}

template <bool SAMPLE> __device__ __forceinline__ void p4_attn_query(const Frame& F, int tok, int slot, int g) {
    const int lane = F.lane;
    LAS unsigned char* wl = F.lds + (slot * 2 + g) * 8192;
    LAS f32x4* Pl = (LAS f32x4*)wl; LAS int* Il = (LAS int*)(wl + 4096); LAS unsigned* Ql = (LAS unsigned*)(wl + 5120);
    LAS float* RB = (LAS float*)(F.lds + 65536);
    LAS int* BT = (LAS int*)(F.lds + 65536 + 1024);
    int b, qpos;
    if (SAMPLE) { b = (tok - NTP) >> 3; qpos = PAST + ((tok - NTP) & 7); } else { b = tok >> 11; qpos = tok & 2047; }
    { const unsigned* qsrc = (const unsigned*)(F.PROJ + (size_t)tok * NMIXP + C_Q + g * 256);
      Ql[lane] = qsrc[lane]; Ql[lane + 64] = qsrc[lane + 64]; }
    const int* selp = F.SEL + (size_t)tok * NSEL;
#pragma unroll 1
    for (int i = 0; i < 4; ++i) {
        const int sraw = selp[lane + 64 * i];
        const int s = sraw < 0 ? 0 : sraw;
        float a0 = 0.f, a1 = 0.f, a2 = 0.f, a3 = 0.f;
        if (SAMPLE) {
            const float* kr;
            if (s < PAST) { const int page = F.page_table[b * NPAGES + (s >> 7)]; kr = F.cache_k + ((size_t)page * PAGE + (s & 127)) * 128 + g * 64; }
            else kr = F.out + O_KS + (size_t)(b * TS + (s - PAST)) * 128 + g * 64;
#pragma unroll
            for (int c = 0; c < 16; ++c) {
                const f32x4 kv = *(const f32x4*)(kr + c * 4);
#pragma unroll
                for (int e = 0; e < 2; ++e) {
                    const unsigned kp = cvt_pk_bf16(kv[2 * e], kv[2 * e + 1]);
                    const float k0 = bflo(kp), k1 = bfhi(kp);
                    const unsigned q0 = Ql[0 * 32 + c * 2 + e], q1 = Ql[1 * 32 + c * 2 + e], q2 = Ql[2 * 32 + c * 2 + e], q3 = Ql[3 * 32 + c * 2 + e];
                    a0 += bflo(q0) * k0 + bfhi(q0) * k1; a1 += bflo(q1) * k0 + bfhi(q1) * k1;
                    a2 += bflo(q2) * k0 + bfhi(q2) * k1; a3 += bflo(q3) * k0 + bfhi(q3) * k1;
                }
            }
        } else {
            const bf16_t* kr = F.PROJ + ((size_t)b * SEQ + s) * NMIXP + C_K + g * 64;
#pragma unroll
            for (int c = 0; c < 8; ++c) {
                const u32x4 kv = *(const u32x4*)(kr + c * 8);
#pragma unroll
                for (int e = 0; e < 4; ++e) {
                    const float k0 = bflo(kv[e]), k1 = bfhi(kv[e]);
                    const unsigned q0 = Ql[0 * 32 + c * 4 + e], q1 = Ql[1 * 32 + c * 4 + e], q2 = Ql[2 * 32 + c * 4 + e], q3 = Ql[3 * 32 + c * 4 + e];
                    a0 += bflo(q0) * k0 + bfhi(q0) * k1; a1 += bflo(q1) * k0 + bfhi(q1) * k1;
                    a2 += bflo(q2) * k0 + bfhi(q2) * k1; a3 += bflo(q3) * k0 + bfhi(q3) * k1;
                }
            }
        }
        f32x4 L;
        if (sraw < 0) L = (f32x4){-INFINITY, -INFINITY, -INFINITY, -INFINITY};
        else {
            const int dist = qpos - s; const int bk = dist < 128 ? BT[dist] : 31;
            L = (f32x4){a0 * ATTN_SCALE + RB[bk * 8 + g * 4 + 0], a1 * ATTN_SCALE + RB[bk * 8 + g * 4 + 1], a2 * ATTN_SCALE + RB[bk * 8 + g * 4 + 2], a3 * ATTN_SCALE + RB[bk * 8 + g * 4 + 3]};
        }
        Pl[lane + 64 * i] = L; Il[lane + 64 * i] = s;
    }
    f32x4 lg[4];
#pragma unroll
    for (int i = 0; i < 4; ++i) lg[i] = Pl[lane + 64 * i];
    float inv[4];
#pragma unroll
    for (int hh = 0; hh < 4; ++hh) {
        float m = fmaxf(fmaxf(lg[0][hh], lg[1][hh]), fmaxf(lg[2][hh], lg[3][hh])); m = wave_max(m);
        float sm = 0.f;
#pragma unroll
        for (int i = 0; i < 4; ++i) { lg[i][hh] = __expf(lg[i][hh] - m); sm += lg[i][hh]; }
        sm = wave_sum(sm); inv[hh] = 1.f / sm;
    }
#pragma unroll
    for (int i = 0; i < 4; ++i) Pl[lane + 64 * i] = (f32x4){lg[i][0] * inv[0], lg[i][1] * inv[1], lg[i][2] * inv[2], lg[i][3] * inv[3]};
    const int dp = lane & 31, kh = lane >> 5;
    float o[4][2];
#pragma unroll
    for (int hh = 0; hh < 4; ++hh) o[hh][0] = o[hh][1] = 0.f;
#pragma unroll 4
    for (int jj = 0; jj < 128; ++jj) {
        const int j = jj * 2 + kh; const int s = Il[j]; const f32x4 p = Pl[j];
        float v0, v1;
        if (SAMPLE) {
            const float* vr;
            if (s < PAST) { const int page = F.page_table[b * NPAGES + (s >> 7)]; vr = F.cache_v + ((size_t)page * PAGE + (s & 127)) * 128 + g * 64; }
            else vr = F.out + O_VS + (size_t)(b * TS + (s - PAST)) * 128 + g * 64;
            const float2 vv = *(const float2*)(vr + 2 * dp); v0 = bf2f(f2bf(vv.x)); v1 = bf2f(f2bf(vv.y));
        } else {
            const unsigned vv = *(const unsigned*)(F.PROJ + ((size_t)b * SEQ + s) * NMIXP + C_V + g * 64 + 2 * dp); v0 = bflo(vv); v1 = bfhi(vv);
        }
#pragma unroll
        for (int hh = 0; hh < 4; ++hh) { o[hh][0] += p[hh] * v0; o[hh][1] += p[hh] * v1; }
    }
#pragma unroll
    for (int hh = 0; hh < 4; ++hh) { o[hh][0] += __shfl_xor(o[hh][0], 32); o[hh][1] += __shfl_xor(o[hh][1], 32); }
    if (kh == 0) {
#pragma unroll
        for (int hh = 0; hh < 4; ++hh) *(unsigned*)(F.OATT + (size_t)tok * 512 + (g * 4 + hh) * 64 + 2 * dp) = cvt_pk_bf16(o[hh][0], o[hh][1]);
    }
}
__device__ __forceinline__ void p4_attention(const Core& C) {
    Frame F; load_frame(F, C);
    LAS float* RB = (LAS float*)(F.lds + 65536);
    __syncthreads();
    if (F.tid < 256) RB[F.tid] = F.rel_bias[F.tid];
    if (F.tid < 128) ((LAS int*)(F.lds + 65536 + 1024))[F.tid] = t5_bucket(F.tid);
    __syncthreads();
    const int slot = F.wave >> 1, g = F.wave & 1;
    for (int it = F.bid; it < NT / 4; it += F.G) {
        if (it < NTS / 4) p4_attn_query<true>(F, NTP + it * 4 + slot, slot, g);
        else p4_attn_query<false>(F, (it - NTS / 4) * 4 + slot, slot, g);
    }
    for (int m = F.bid * 8 + F.wave; m < NT; m += F.G * 8) {
        int t, T_, bsm; if (m < NTP) { t = m & 2047; T_ = SEQ; bsm = m >> 11; } else { t = (m - NTP) & 7; T_ = TS; bsm = (m - NTP) >> 3; }
        const int c0 = F.lane * 8;
        float u0[8], u1[8], u2[8];
        { const u32x4 cg = *(const u32x4*)(F.PROJ + (size_t)m * NMIXP + C_CG + c0), xi = *(const u32x4*)(F.PROJ + (size_t)m * NMIXP + C_XIN + c0);
#pragma unroll
          for (int e = 0; e < 4; ++e) { u0[2 * e] = bflo(cg[e]) * bflo(xi[e]); u0[2 * e + 1] = bfhi(cg[e]) * bfhi(xi[e]); } }
#pragma unroll
        for (int d = 1; d <= 2; ++d) {
            float* ud = (d == 1) ? u1 : u2;
            if (t - d >= 0) {
                const u32x4 cg = *(const u32x4*)(F.PROJ + (size_t)(m - d) * NMIXP + C_CG + c0), xi = *(const u32x4*)(F.PROJ + (size_t)(m - d) * NMIXP + C_XIN + c0);
#pragma unroll
                for (int e = 0; e < 4; ++e) { ud[2 * e] = bflo(cg[e]) * bflo(xi[e]); ud[2 * e + 1] = bfhi(cg[e]) * bfhi(xi[e]); }
            } else if (m >= NTP) {
                const float* pv = F.state_conv + ((size_t)bsm * 2 + (2 + t - d)) * 512 + c0;
#pragma unroll
                for (int e = 0; e < 8; ++e) ud[e] = pv[e];
            } else {
#pragma unroll
                for (int e = 0; e < 8; ++e) ud[e] = 0.f;
            }
        }
        const u32x4 bg = *(const u32x4*)(F.PROJ + (size_t)m * NMIXP + C_BG + c0);
        float y[8];
#pragma unroll
        for (int e = 0; e < 8; ++e) {
            const int c = c0 + e;
            const float yy = F.conv_b[c] + F.conv_w[c] * u2[e] + F.conv_w[512 + c] * u1[e] + F.conv_w[1024 + c] * u0[e];
            const float bgv = (e & 1) ? bfhi(bg[e >> 1]) : bflo(bg[e >> 1]);
            y[e] = bgv * yy;
        }
        *(u32x4*)(F.OCONV + (size_t)m * 512 + c0) = (u32x4){cvt_pk_bf16(y[0], y[1]), cvt_pk_bf16(y[2], y[3]), cvt_pk_bf16(y[4], y[5]), cvt_pk_bf16(y[6], y[7])};
        if (t >= T_ - 2) {
            float* o = (m < NTP ? F.out + O_CP : F.out + O_CS) + ((size_t)bsm * 2 + (t - (T_ - 2))) * 512 + c0;
            *(f32x4*)o = (f32x4){u0[0], u0[1], u0[2], u0[3]}; *(f32x4*)(o + 4) = (f32x4){u0[4], u0[5], u0[6], u0[7]};
        }
    }
}

__device__ __forceinline__ void p5_gemm_merge(const Core& C) {
    Frame F; load_frame(F, C);
    const int ntile = (NT / BM) * (D / BN);
    for (int t = F.bid; t < ntile; t += F.G) {
        const int m0 = (t / (D / BN)) * BM, n0 = (t % (D / BN)) * BN;
        f32x16 acc[2][2], acc2[2][2]; zero_acc(acc); zero_acc(acc2);
        gemm_accum(F, acc, F.OATT, 512, F.WOA, 512, 512, m0, n0);
        gemm_accum(F, acc2, F.OCONV, 512, F.WOC, 512, 512, m0, n0);
        GEMM_EPI_LOOP({
            const f32x4 va = ACC4(acc), vc = ACC4(acc2);
            const u32x2 ga = *(const u32x2*)(F.PROJ + (size_t)m * NMIXP + C_GA + n), gb = *(const u32x2*)(F.PROJ + (size_t)m * NMIXP + C_GB + n);
            f32x4 o;
            o[0] = sigmoidf_(bflo(ga[0])) * va[0] + sigmoidf_(bflo(gb[0])) * vc[0];
            o[1] = sigmoidf_(bfhi(ga[0])) * va[1] + sigmoidf_(bfhi(gb[0])) * vc[1];
            o[2] = sigmoidf_(bflo(ga[1])) * va[2] + sigmoidf_(bflo(gb[1])) * vc[2];
            o[3] = sigmoidf_(bfhi(ga[1])) * va[3] + sigmoidf_(bfhi(gb[1])) * vc[3];
            *(u32x2*)(F.MERGED + (size_t)m * D + n) = pk4(o);
        })
    }
}
__device__ __forceinline__ void p6_gemm_out(const Core& C) {
    Frame F; load_frame(F, C);
    const int ntile = (NT / BM) * (D / BN);
    for (int t = F.bid; t < ntile; t += F.G) {
        const int m0 = (t / (D / BN)) * BM, n0 = (t % (D / BN)) * BN;
        f32x16 acc[2][2]; zero_acc(acc);
        gemm_accum(F, acc, F.MERGED, D, F.WOUT, D, D, m0, n0);
        GEMM_EPI_LOOP({
            const f32x4 v = ACC4(acc);
            const f32x4 xv = *(const f32x4*)(x_row(F, m) + n);
            const f32x4 g1 = *(const f32x4*)(F.MOD + (size_t)mod_row(m) * 6144 + 2048 + n);
            *(f32x4*)(F.T1 + (size_t)m * D + n) = xv * DN_ALPHA + g1 * v;
        })
    }
}
__device__ __forceinline__ void p7_ln1(const Core& C) {
    Frame F; load_frame(F, C);
    for (int m = F.bid * 8 + F.wave; m < NT; m += F.G * 8) {
        float* tr = F.T1 + (size_t)m * D; const float* mr = F.MOD + (size_t)mod_row(m) * 6144;
        f32x4 v[4]; float s = 0.f;
#pragma unroll
        for (int i = 0; i < 4; ++i) { v[i] = *(const f32x4*)(tr + (i >> 1) * 512 + F.lane * 8 + (i & 1) * 4); s += v[i][0] + v[i][1] + v[i][2] + v[i][3]; }
        const float mean = wave_sum(s) * (1.f / D);
        float q = 0.f;
#pragma unroll
        for (int i = 0; i < 4; ++i) { v[i] = v[i] - mean; q += v[i][0] * v[i][0] + v[i][1] * v[i][1] + v[i][2] * v[i][2] + v[i][3] * v[i][3]; }
        const float rstd = rsqrtf(wave_sum(q) * (1.f / D) + LN_EPS);
#pragma unroll
        for (int hlf = 0; hlf < 2; ++hlf) {
            const int e = hlf * 512 + F.lane * 8;
            f32x4 a = v[2 * hlf] * rstd * *(const f32x4*)(F.ln1_g + e) + *(const f32x4*)(F.ln1_b + e);
            f32x4 b = v[2 * hlf + 1] * rstd * *(const f32x4*)(F.ln1_g + e + 4) + *(const f32x4*)(F.ln1_b + e + 4);
            *(f32x4*)(tr + e) = a; *(f32x4*)(tr + e + 4) = b;
            const f32x4 ha = a * (*(const f32x4*)(mr + 4096 + e) + 1.f) + *(const f32x4*)(mr + 3072 + e);
            const f32x4 hb = b * (*(const f32x4*)(mr + 4096 + e + 4) + 1.f) + *(const f32x4*)(mr + 3072 + e + 4);
            *(u32x4*)(F.H2 + (size_t)m * D + e) = (u32x4){cvt_pk_bf16(ha[0], ha[1]), cvt_pk_bf16(ha[2], ha[3]), cvt_pk_bf16(hb[0], hb[1]), cvt_pk_bf16(hb[2], hb[3])};
        }
    }
}
__device__ __forceinline__ void p8_gemm_q(const Core& C) {
    Frame F; load_frame(F, C);
    const int ntile = (NT / BM) * (D / BN);
    for (int t = F.bid; t < ntile; t += F.G) {
        const int m0 = (t / (D / BN)) * BM, n0 = (t % (D / BN)) * BN;
        f32x16 acc[2][2]; zero_acc(acc);
        gemm_accum(F, acc, F.H2, D, F.WQ, D, D, m0, n0);
        GEMM_EPI_LOOP({ *(u32x2*)(F.QP + (size_t)m * D + n) = pk4(ACC4(acc)); })
    }
}
constexpr int PR_ROW = 129;
__device__ __forceinline__ void p9_route(const Core& C) {
    Frame F; load_frame(F, C);
    LAS float* SC = (LAS float*)F.lds;
    LAS float* TV = (LAS float*)(F.lds + 32 * 8 * PR_ROW * 4);
    LAS unsigned char* TI = (LAS unsigned char*)(F.lds + 32 * 8 * PR_ROW * 4 + 256 * 17 * 4);
    const int lane = F.lane, r = lane & 31, h = lane >> 5;
    const int nunits = (NT / 32) * 2;
    for (int it = F.bid; it < nunits; it += F.G) {
        const int tok0 = (it >> 1) * 32, hg = it & 1;
        __syncthreads();
        {
            const int head = hg * 4 + (F.wave >> 1), half = F.wave & 1;
            const bf16_t* KK = half ? F.K2 : F.K1;
            bf16x8 Bq[4];
#pragma unroll
            for (int s = 0; s < 4; ++s) Bq[s] = *(const bf16x8*)(F.QP + (size_t)(tok0 + r) * D + head * 128 + half * 64 + s * 16 + h * 8);
#pragma unroll
            for (int kt = 0; kt < 4; ++kt) {
                f32x16 c;
#pragma unroll
                for (int e = 0; e < 16; ++e) c[e] = 0.f;
#pragma unroll
                for (int s = 0; s < 4; ++s) {
                    const bf16x8 Ak = *(const bf16x8*)(KK + (size_t)(kt * 32 + r) * 64 + s * 16 + h * 8);
                    c = __builtin_amdgcn_mfma_f32_32x32x16_bf16(Ak, Bq[s], c, 0, 0, 0);
                }
#pragma unroll
                for (int e = 0; e < 16; ++e) { const int key = kt * 32 + (e & 3) + 8 * (e >> 2) + 4 * h; SC[(r * 8 + F.wave) * PR_ROW + key] = c[e]; }
            }
        }
        __syncthreads();
        if (F.tid < 256) {
            LAS float* row = SC + F.tid * PR_ROW;
            for (int p = 0; p < 16; ++p) {
                float best = -INFINITY; int bi = 0;
                for (int j = 0; j < 128; ++j) { const float v = row[j]; if (v > best) { best = v; bi = j; } }
                row[bi] = -INFINITY; TV[F.tid * 17 + p] = best; TI[F.tid * 17 + p] = (unsigned char)bi;
            }
        }
        __syncthreads();
        if (F.tid < 128) {
            const int tk = F.tid >> 2, hs = F.tid & 3;
            const int r1 = (tk * 8 + hs * 2) * 17, r2 = r1 + 17;
            LAS float* cand = SC + F.tid * 51;
            int nc = 0;
            for (int i = 0; i < 16; ++i) { const int jm = 16 / (i + 1); for (int j = 0; j < jm; ++j) { cand[nc] = TV[r1 + i] + TV[r2 + j]; ++nc; } }
            float sv[16]; int se[16];
#pragma unroll
            for (int p = 0; p < 16; ++p) {
                float best = -INFINITY; int bc = 0, bi = 0, bj = 0, c = 0;
                for (int i = 0; i < 16; ++i) { const int jm = 16 / (i + 1); for (int j = 0; j < jm; ++j) { const float v = cand[c]; if (v > best) { best = v; bc = c; bi = i; bj = j; } ++c; } }
                cand[bc] = -INFINITY; sv[p] = best; se[p] = (int)TI[r1 + bi] * 128 + (int)TI[r2 + bj];
            }
            const float mx0 = sv[0]; float den = 0.f;
#pragma unroll
            for (int p = 0; p < 16; ++p) { sv[p] = __expf(sv[p] - mx0); den += sv[p]; }
            const float dinv = 1.f / den;
            const int head = hg * 4 + hs;
            int* eo = F.EIDX + (size_t)(tok0 + tk) * NEXP_SEL + head * 16; float* go = F.GW + (size_t)(tok0 + tk) * NEXP_SEL + head * 16;
#pragma unroll
            for (int p = 0; p < 16; ++p) { eo[p] = se[p]; go[p] = sv[p] * dinv; }
        }
    }
}

__device__ __forceinline__ void p10_peer(const Core& C) {
    Frame F; load_frame(F, C);
    const int lane = F.lane;
    for (int m = F.bid * 8 + F.wave; m < NT; m += F.G * 8) {
        float hv[16];
        { const u32x4 a = *(const u32x4*)(F.H2 + (size_t)m * D + lane * 8), b = *(const u32x4*)(F.H2 + (size_t)m * D + 512 + lane * 8);
#pragma unroll
          for (int e = 0; e < 4; ++e) { hv[2 * e] = bflo(a[e]); hv[2 * e + 1] = bfhi(a[e]); hv[8 + 2 * e] = bflo(b[e]); hv[8 + 2 * e + 1] = bfhi(b[e]); } }
        float acc[16];
#pragma unroll
        for (int e = 0; e < 16; ++e) acc[e] = 0.f;
        const int* ep = F.EIDX + (size_t)m * NEXP_SEL; const float* gp = F.GW + (size_t)m * NEXP_SEL;
        const int ev0 = ep[lane], ev1 = ep[64 + lane];
        const int gv0 = __float_as_int(gp[lane]), gv1 = __float_as_int(gp[64 + lane]);
#pragma unroll 1
        for (int j0 = 0; j0 < NEXP_SEL; j0 += 4) {
            u32x4 ua[4], ub[4], va[4], vb[4]; float gw[4];
            const int evs = (j0 < 64) ? ev0 : ev1, gvs = (j0 < 64) ? gv0 : gv1;
#pragma unroll
            for (int j = 0; j < 4; ++j) {
                const int e = __builtin_amdgcn_readlane(evs, (j0 & 63) + j); gw[j] = __int_as_float(__builtin_amdgcn_readlane(gvs, (j0 & 63) + j));
                const bf16_t* ur = F.PU + (size_t)e * D; const bf16_t* vr = F.PV + (size_t)e * D;
                ua[j] = *(const u32x4*)(ur + lane * 8); ub[j] = *(const u32x4*)(ur + 512 + lane * 8);
                va[j] = *(const u32x4*)(vr + lane * 8); vb[j] = *(const u32x4*)(vr + 512 + lane * 8);
            }
#pragma unroll
            for (int j = 0; j < 4; ++j) {
                float d = 0.f;
#pragma unroll
                for (int e = 0; e < 4; ++e) { d += hv[2 * e] * bflo(ua[j][e]) + hv[2 * e + 1] * bfhi(ua[j][e]); d += hv[8 + 2 * e] * bflo(ub[j][e]) + hv[8 + 2 * e + 1] * bfhi(ub[j][e]); }
                d = wave_sum(d);
                const float act = gelu_tanh(d) * gw[j];
#pragma unroll
                for (int e = 0; e < 4; ++e) { acc[2 * e] += act * bflo(va[j][e]); acc[2 * e + 1] += act * bfhi(va[j][e]); acc[8 + 2 * e] += act * bflo(vb[j][e]); acc[8 + 2 * e + 1] += act * bfhi(vb[j][e]); }
            }
        }
        const float* x1 = F.T1 + (size_t)m * D; const float* mr = F.MOD + (size_t)mod_row(m) * 6144 + 5120;
        float tv[16]; float s = 0.f;
#pragma unroll
        for (int hlf = 0; hlf < 2; ++hlf)
#pragma unroll
            for (int c = 0; c < 2; ++c) {
                const int e = hlf * 512 + lane * 8 + c * 4;
                const f32x4 xv = *(const f32x4*)(x1 + e), g2 = *(const f32x4*)(mr + e);
#pragma unroll
                for (int k = 0; k < 4; ++k) { const float t = xv[k] * DN_ALPHA + g2[k] * acc[hlf * 8 + c * 4 + k]; tv[hlf * 8 + c * 4 + k] = t; s += t; }
            }
        const float mean = wave_sum(s) * (1.f / D);
        float q = 0.f;
#pragma unroll
        for (int e = 0; e < 16; ++e) { tv[e] -= mean; q += tv[e] * tv[e]; }
        const float rstd = rsqrtf(wave_sum(q) * (1.f / D) + LN_EPS);
        float* yo = (m < NTP) ? F.out + O_YP + (size_t)m * D : F.out + O_YS + (size_t)(m - NTP) * D;
#pragma unroll
        for (int hlf = 0; hlf < 2; ++hlf)
#pragma unroll
            for (int c = 0; c < 2; ++c) {
                const int e = hlf * 512 + lane * 8 + c * 4;
                const f32x4 gg = *(const f32x4*)(F.ln2_g + e), bb = *(const f32x4*)(F.ln2_b + e);
                f32x4 o;
#pragma unroll
                for (int k = 0; k < 4; ++k) o[k] = tv[hlf * 8 + c * 4 + k] * rstd * gg[k] + bb[k];
                *(f32x4*)(yo + e) = o;
            }
    }
}

constexpr int N_PHASES = 11;
__global__ void __launch_bounds__(NTHREADS, 2) fwd_kernel(Args args) {
    extern __shared__ __attribute__((aligned(16))) unsigned char lds_raw[];
    Core F;
    F.lds = (LAS unsigned char*)lds_raw;
    F.tid = threadIdx.x; F.lane = F.tid & 63; F.wave = __builtin_amdgcn_readfirstlane(F.tid >> 6); F.G = gridDim.x; F.bid = blockIdx.x;
    if (F.tid == 0) {
        LAS unsigned long long* pt = (LAS unsigned long long*)(F.lds + LDS_PTAB);
#pragma unroll
        for (int i = 0; i < 27; ++i) pt[i] = (unsigned long long)args.in[i];
        pt[27] = (unsigned long long)args.out; pt[28] = (unsigned long long)args.ws;
    }
    unsigned char* ws = args.ws;
    volatile LAS unsigned* misc = (volatile LAS unsigned*)(F.lds + LDS_MISC);
    if (F.tid < 16) misc[F.tid] = 0u;
    __syncthreads();
    XcdBarrier bar; bar.bar = (unsigned*)(ws + WS_CTL); bar.x = 0; bar.st = misc;
    const int lo = args.ph_lo, hi = args.ph_hi;
    if (hi - lo > 1) bar = xcd_barrier_post((unsigned*)(ws + WS_CTL), misc);
#define IN(k) (lo <= (k) && (k) < hi)
#define SEAM(k) do { if (IN(k) && IN((k) + 1)) xcd_barrier(bar); } while (0)
    if (IN(0)) p0_prologue(F);       SEAM(0);
    if (IN(1)) p1_modulate(F);       SEAM(1);
    if (IN(2)) p2_gemm_in(F);        SEAM(2);
    if (IN(3)) p3_index(F);          SEAM(3);
    if (IN(4)) p4_attention(F);      SEAM(4);
    if (IN(5)) p5_gemm_merge(F);     SEAM(5);
    if (IN(6)) p6_gemm_out(F);       SEAM(6);
    if (IN(7)) p7_ln1(F);            SEAM(7);
    if (IN(8)) p8_gemm_q(F);         SEAM(8);
    if (IN(9)) p9_route(F);          SEAM(9);
    if (IN(10)) p10_peer(F);
#undef IN
#undef SEAM
}

extern "C" void kernel_launch(void* const* d_in, const int* in_sizes, int n_in, void* d_out, int out_size, void* d_ws, size_t ws_size, hipStream_t stream) {
    static int grid = 0;
    if (grid == 0) {
        if (n_in != 27 || (size_t)out_size != O_END || ws_size < WS_END) { fprintf(stderr, "kernel_launch: unexpected shapes (n_in %d out %d ws %zu)\n", n_in, out_size, ws_size); grid = -1; return; }
        int dev = 0, cus = 0;
        if (hipGetDevice(&dev) != hipSuccess || hipDeviceGetAttribute(&cus, hipDeviceAttributeMultiprocessorCount, dev) != hipSuccess) { grid = -1; return; }
        if (hipFuncSetAttribute((const void*)fwd_kernel, hipFuncAttributeMaxDynamicSharedMemorySize, LDS_BYTES) != hipSuccess) { fprintf(stderr, "kernel_launch: hipFuncSetAttribute failed\n"); grid = -1; return; }
        (void)hipGetLastError();
        grid = cus;
    }
    if (grid < 0) return;
    (void)hipMemsetAsync((char*)d_ws + WS_CTL, 0, CTL_ZERO_BYTES, stream);
    Args a{};
    for (int i = 0; i < 27; ++i) a.in[i] = d_in[i];
    a.out = (float*)d_out; a.ws = (unsigned char*)d_ws;
#if N_LAUNCHES == 1
    a.ph_lo = 0; a.ph_hi = N_PHASES;
    hipLaunchKernelGGL(fwd_kernel, dim3(grid), dim3(NTHREADS), LDS_BYTES, stream, a);
#else
    for (int p = 0; p < N_PHASES; ++p) { a.ph_lo = p; a.ph_hi = p + 1; hipLaunchKernelGGL(fwd_kernel, dim3(grid), dim3(NTHREADS), LDS_BYTES, stream, a); }
#endif
}
```

```cpp
#include <hip/hip_runtime.h>
#include <cstdio>
#include <cstdint>

#ifndef N_LAUNCHES
#define N_LAUNCHES 1
#endif

typedef unsigned short bf16_t;
typedef short bf16x8 __attribute__((ext_vector_type(8)));
typedef float f32x4 __attribute__((ext_vector_type(4)));
typedef float f32x16 __attribute__((ext_vector_type(16)));
typedef unsigned u32x4 __attribute__((ext_vector_type(4)));
typedef unsigned u32x2 __attribute__((ext_vector_type(2)));
#define LAS __attribute__((address_space(3)))

constexpr int D = 1024, NB_P = 8, SEQ = 2048, NB_S = 32, TS = 8, PAST = 8192, PAGE = 128, NPAGES = 64;
constexpr int NTP = NB_P * SEQ;
constexpr int NTS = NB_S * TS;
constexpr int NT = NTP + NTS;
constexpr int NMIX = 4676, NMIXP = 4736;
constexpr int C_Q = 0, C_K = 512, C_V = 640, C_QI = 768, C_KI = 1024, C_BG = 1088, C_CG = 1600, C_XIN = 2112, C_GA = 2624, C_GB = 3648, C_WI = 4672;
constexpr int NSEL = 256;
constexpr float ATTN_SCALE = 0.125f, IDX_SCALE = 0.0625f;
constexpr float DN_ALPHA = 1.189207115002721f, LN_EPS = 1e-5f;
constexpr int NEXP_SEL = 128;

constexpr size_t O_YP = 0, O_YS = 16777216, O_KP = 17039360, O_VP = 19136512, O_KIP = 21233664, O_CP = 22282240,
                 O_KS = 22290432, O_VS = 22323200, O_KIS = 22355968, O_CS = 22372352, O_END = 22405120;

constexpr size_t MB = 1048576;
constexpr size_t WS_CTL = 0, WS_MOD = 1 * MB, WS_WIN = 2 * MB, WS_WOA = 12 * MB, WS_WOC = 13 * MB, WS_WOUT = 14 * MB, WS_WQ = 16 * MB,
                 WS_K1 = 18 * MB, WS_K2 = 18 * MB + 65536, WS_PU = 20 * MB, WS_PV = 52 * MB, WS_H1 = 84 * MB, WS_PROJ = 118 * MB,
                 WS_WI = 270 * MB, WS_SEL = 271 * MB, WS_OATT = 288 * MB, WS_OCONV = 305 * MB, WS_MERGED = 322 * MB, WS_T1 = 355 * MB,
                 WS_H2 = 420 * MB, WS_QP = 453 * MB, WS_EIDX = 486 * MB, WS_GW = 495 * MB, WS_SS = 504 * MB, WS_END = 513 * MB;
constexpr int CTL_ZERO_BYTES = 65536;

constexpr int NTHREADS = 512;
constexpr int LDS_BYTES = 160 * 1024 - 512;
constexpr int LDS_MISC = LDS_BYTES - 64;

__device__ __forceinline__ float bf2f(bf16_t b) { return __uint_as_float(((unsigned)b) << 16); }
__device__ __forceinline__ float bflo(unsigned p) { return __uint_as_float(p << 16); }
__device__ __forceinline__ float bfhi(unsigned p) { return __uint_as_float(p & 0xFFFF0000u); }
typedef __bf16 bf16x2_t __attribute__((ext_vector_type(2)));
typedef float f32x2_t __attribute__((ext_vector_type(2)));
__device__ __forceinline__ unsigned cvt_pk_bf16(float lo, float hi) { const f32x2_t f = {lo, hi}; const bf16x2_t b = __builtin_convertvector(f, bf16x2_t); unsigned r; __builtin_memcpy(&r, &b, 4); return r; }
__device__ __forceinline__ bf16_t f2bf(float f) { return (bf16_t)(cvt_pk_bf16(f, 0.f) & 0xFFFFu); }
__device__ __forceinline__ float wave_sum(float v) {
#pragma unroll
    for (int o = 32; o >= 1; o >>= 1) v += __shfl_xor(v, o);
    return v;
}
__device__ __forceinline__ float wave_max(float v) {
#pragma unroll
    for (int o = 32; o >= 1; o >>= 1) v = fmaxf(v, __shfl_xor(v, o));
    return v;
}
__device__ __forceinline__ float sigmoidf_(float x) { return 1.f / (1.f + __expf(-x)); }
__device__ __forceinline__ float gelu_tanh(float a) {
    const float z = 0.7978845608028654f * (a + 0.044715f * a * a * a);
    const float e = __expf(2.f * z);
    const float t = 1.f - 2.f / (e + 1.f);
    return 0.5f * a * (1.f + t);
}
__device__ __forceinline__ unsigned f2ord(float f) { const unsigned u = __float_as_uint(f); return (u & 0x80000000u) ? ~u : (u | 0x80000000u); }
__device__ __forceinline__ int t5_bucket(int n) {
    if (n < 16) return n;
    int b = 16;
    b += (n >= 19) + (n >= 21) + (n >= 24) + (n >= 27) + (n >= 31) + (n >= 35) + (n >= 40) + (n >= 46) + (n >= 52) + (n >= 59) + (n >= 67) + (n >= 77) + (n >= 87) + (n >= 99) + (n >= 113);
    return b;
}

#define XB_TMO      128
#define XB_XCNT(j)  (256  + 64 * (j))
#define XB_XSUB(j)  (1280 + 64 * (j))
#define XB_XGEN(j)  (2304 + 64 * (j))
#define XB_TOP      3328
#define XB_TOPGEN   3392
#define XCD_BAR_WORDS 3456
#define XB_SPIN_CAP (1u << 18)
__device__ __forceinline__ unsigned xb_ld(unsigned* p)              { return __hip_atomic_load(p, __ATOMIC_RELAXED, __HIP_MEMORY_SCOPE_AGENT); }
__device__ __forceinline__ unsigned xb_add(unsigned* p, unsigned v) { return __hip_atomic_fetch_add(p, v, __ATOMIC_RELAXED, __HIP_MEMORY_SCOPE_AGENT); }
__device__ __forceinline__ unsigned xb_xcc_id() { return (unsigned)__builtin_amdgcn_s_getreg((3 << 11) | 20) & 0xFu; }
#define XB_SPIN(cond, bar) do { unsigned _sp = 0; while (cond) { __builtin_amdgcn_s_sleep(1); \
    if ((++_sp & 255u) == 0u) { if (xb_ld(&(bar)[XB_TMO])) break; if (_sp > XB_SPIN_CAP) { atomicAdd(&(bar)[XB_TMO], 1u); break; } } } } while (0)
struct XcdBarrier { unsigned* bar; unsigned x; volatile LAS unsigned* st; };
__device__ __forceinline__ XcdBarrier xcd_barrier_post(unsigned* bar, volatile LAS unsigned* st) {
    XcdBarrier b; b.bar = bar; b.x = xb_xcc_id(); b.st = st;
    if (threadIdx.x == 0) (void)xb_add(&bar[XB_XCNT(b.x)], 1u);
    return b;
}
__device__ __forceinline__ void xcd_barrier_complete(unsigned* bar, unsigned x, unsigned& nloc, unsigned& nx) {
    const unsigned G = gridDim.x * gridDim.y * gridDim.z;
    unsigned sum, cnt, mine, sp = 0u;
    for (;;) {
        sum = 0u; cnt = 0u; mine = 0u;
#pragma unroll
        for (unsigned j = 0; j < 16; ++j) { const unsigned c = xb_ld(&bar[XB_XCNT(j)]); sum += c; cnt += (c > 0u) ? 1u : 0u; mine = (j == x) ? c : mine; }
        if (sum == G) break;
        __builtin_amdgcn_s_sleep(1);
        if ((++sp & 255u) == 0u) { if (xb_ld(&bar[XB_TMO])) break; if (sp > XB_SPIN_CAP) { atomicAdd(&bar[XB_TMO], 1u); break; } }
    }
    nloc = mine > 0u ? mine : 1u; nx = cnt > 0u ? cnt : 1u;
}
__device__ __forceinline__ void xcd_barrier(const XcdBarrier& b) {
    asm volatile("s_waitcnt vmcnt(0)" ::: "memory");
    __syncthreads();
    if (threadIdx.x == 0) {
        unsigned* bar = b.bar;
        __builtin_amdgcn_s_waitcnt(0);
        unsigned nloc = b.st[0], nx = b.st[1];
        if (nloc == 0u) { xcd_barrier_complete(bar, b.x, nloc, nx); b.st[0] = nloc; b.st[1] = nx; }
        const unsigned old = xb_add(&bar[XB_XSUB(b.x)], 1u);
        const unsigned gen = old / nloc;
        if (old + 1u == (gen + 1u) * nloc) {
            __builtin_amdgcn_fence(__ATOMIC_RELEASE, "agent");
            asm volatile("s_waitcnt vmcnt(0)" ::: "memory");
            const unsigned og = xb_add(&bar[XB_TOP], 1u);
            const unsigned tg = og / nx;
            if (og + 1u == (tg + 1u) * nx) xb_add(&bar[XB_TOPGEN], 1u);
            else XB_SPIN(xb_ld(&bar[XB_TOPGEN]) == tg, bar);
            __builtin_amdgcn_fence(__ATOMIC_ACQUIRE, "agent");
            xb_add(&bar[XB_XGEN(b.x)], 1u);
            asm volatile("s_waitcnt vmcnt(0)" ::: "memory");
        } else {
            XB_SPIN(xb_ld(&bar[XB_XGEN(b.x)]) == gen, bar);
            __builtin_amdgcn_fence(__ATOMIC_ACQUIRE, "agent");
            asm volatile("s_waitcnt vmcnt(0)" ::: "memory");
        }
    }
    __syncthreads();
}

struct Args { const void* in[27]; float* out; unsigned char* ws; int ph_lo, ph_hi; };
struct Core { LAS unsigned char* lds; int tid, lane, wave, G, bid; };
struct Frame {
    LAS unsigned char* lds;
    int tid, lane, wave, G, bid;
    const float *x_p, *x_s, *c_p, *c_s, *cache_k, *cache_v, *cache_ki, *state_conv, *rel_bias, *w_ada, *b_ada, *w_in, *conv_w, *conv_b,
                *w_o_attn, *w_o_conv, *w_out, *ln1_g, *ln1_b, *ln2_g, *ln2_b, *peer_wq, *peer_k1, *peer_k2, *peer_u, *peer_v;
    const int* page_table;
    float* out;
    float* MOD; bf16_t *WIN, *WOA, *WOC, *WOUT, *WQ, *K1, *K2, *PU, *PV, *H1, *PROJ, *OATT, *OCONV, *MERGED, *H2, *QP;
    float *WI, *T1, *GW; int *SEL, *EIDX;
};
constexpr int LDS_PTAB = LDS_BYTES - 512;
__device__ __forceinline__ unsigned char* ldptr(const Core& C, int k) {
    LAS const unsigned* p = (LAS const unsigned*)(C.lds + LDS_PTAB) + 2 * k;
    const unsigned lo = __builtin_amdgcn_readfirstlane(p[0]), hi = __builtin_amdgcn_readfirstlane(p[1]);
    return (unsigned char*)(((unsigned long long)hi << 32) | (unsigned long long)lo);
}
__device__ __forceinline__ void load_frame(Frame& F, const Core& C) {
    F.lds = C.lds; F.tid = C.tid; F.lane = C.lane; F.wave = C.wave; F.G = C.G; F.bid = C.bid;
    F.x_p = (const float*)ldptr(C, 0); F.x_s = (const float*)ldptr(C, 1); F.c_p = (const float*)ldptr(C, 2); F.c_s = (const float*)ldptr(C, 3);
    F.cache_k = (const float*)ldptr(C, 4); F.cache_v = (const float*)ldptr(C, 5); F.cache_ki = (const float*)ldptr(C, 6); F.state_conv = (const float*)ldptr(C, 7);
    F.page_table = (const int*)ldptr(C, 8); F.rel_bias = (const float*)ldptr(C, 9); F.w_ada = (const float*)ldptr(C, 10); F.b_ada = (const float*)ldptr(C, 11);
    F.w_in = (const float*)ldptr(C, 12); F.conv_w = (const float*)ldptr(C, 13); F.conv_b = (const float*)ldptr(C, 14); F.w_o_attn = (const float*)ldptr(C, 15);
    F.w_o_conv = (const float*)ldptr(C, 16); F.w_out = (const float*)ldptr(C, 17); F.ln1_g = (const float*)ldptr(C, 18); F.ln1_b = (const float*)ldptr(C, 19);
    F.ln2_g = (const float*)ldptr(C, 20); F.ln2_b = (const float*)ldptr(C, 21); F.peer_wq = (const float*)ldptr(C, 22); F.peer_k1 = (const float*)ldptr(C, 23);
    F.peer_k2 = (const float*)ldptr(C, 24); F.peer_u = (const float*)ldptr(C, 25); F.peer_v = (const float*)ldptr(C, 26);
    F.out = (float*)ldptr(C, 27);
    unsigned char* ws = ldptr(C, 28);
    F.MOD = (float*)(ws + WS_MOD); F.WIN = (bf16_t*)(ws + WS_WIN); F.WOA = (bf16_t*)(ws + WS_WOA); F.WOC = (bf16_t*)(ws + WS_WOC);
    F.WOUT = (bf16_t*)(ws + WS_WOUT); F.WQ = (bf16_t*)(ws + WS_WQ); F.K1 = (bf16_t*)(ws + WS_K1); F.K2 = (bf16_t*)(ws + WS_K2);
    F.PU = (bf16_t*)(ws + WS_PU); F.PV = (bf16_t*)(ws + WS_PV); F.H1 = (bf16_t*)(ws + WS_H1); F.PROJ = (bf16_t*)(ws + WS_PROJ);
    F.WI = (float*)(ws + WS_WI); F.SEL = (int*)(ws + WS_SEL); F.OATT = (bf16_t*)(ws + WS_OATT); F.OCONV = (bf16_t*)(ws + WS_OCONV);
    F.MERGED = (bf16_t*)(ws + WS_MERGED); F.T1 = (float*)(ws + WS_T1); F.H2 = (bf16_t*)(ws + WS_H2); F.QP = (bf16_t*)(ws + WS_QP);
    F.EIDX = (int*)(ws + WS_EIDX); F.GW = (float*)(ws + WS_GW);
}
__device__ __forceinline__ const float* x_row(const Frame& F, int m) { return m < NTP ? F.x_p + (size_t)m * D : F.x_s + (size_t)(m - NTP) * D; }
__device__ __forceinline__ int mod_row(int m) { return m < NTP ? (m >> 11) : NB_P + ((m - NTP) >> 3); }

constexpr int P0_MOD_ITEMS = 96;
constexpr int P0_T_WIN = 16 * 74, P0_T_WOA = 8 * 16, P0_T_WOC = 8 * 16, P0_T_WOUT = 16 * 16, P0_T_WQ = 16 * 16;
constexpr int P0_T_ITEMS = P0_T_WIN + P0_T_WOA + P0_T_WOC + P0_T_WOUT + P0_T_WQ;
constexpr int P0_CVT_ITEMS = 2 * (16384 * 1024 / 8192);
constexpr int P0_MISC_ITEMS = 1;
constexpr int P0_ITEMS = P0_MOD_ITEMS + P0_T_ITEMS + P0_CVT_ITEMS + P0_MISC_ITEMS;

__device__ __forceinline__ void p0_mod_item(const Frame& F, int ng) {
    LAS float* cs = (LAS float*)F.lds;
    LAS float* red = (LAS float*)(F.lds + 40 * 256 * 4);
    float acc[40];
#pragma unroll
    for (int r = 0; r < 40; ++r) acc[r] = 0.f;
    const int n = ng * 64 + F.lane;
    for (int kc = 0; kc < 4; ++kc) {
        __syncthreads();
        for (int e = F.tid; e < 40 * 256; e += NTHREADS) { const int r = e >> 8, k = e & 255; cs[e] = (r < 8) ? F.c_p[r * D + kc * 256 + k] : F.c_s[(r - 8) * D + kc * 256 + k]; }
        __syncthreads();
        for (int kk = 0; kk < 32; ++kk) {
            const int kl = F.wave * 32 + kk;
            const float wv = F.w_ada[(size_t)(kc * 256 + kl) * 6144 + n];
#pragma unroll
            for (int r = 0; r < 40; ++r) acc[r] += cs[r * 256 + kl] * wv;
        }
    }
#pragma unroll
    for (int r = 0; r < 40; ++r) red[(F.wave * 40 + r) * 64 + F.lane] = acc[r];
    __syncthreads();
    for (int e = F.tid; e < 40 * 64; e += NTHREADS) {
        const int r = e >> 6, l = e & 63; float s = F.b_ada[ng * 64 + l];
#pragma unroll
        for (int w = 0; w < 8; ++w) s += red[(w * 40 + r) * 64 + l];
        F.MOD[r * 6144 + ng * 64 + l] = s;
    }
    __syncthreads();
}
__device__ __forceinline__ void p0_transpose_tile(const Frame& F, const float* W, int N, int K, bf16_t* Wt, int kt, int nt, bool permute) {
    LAS bf16_t* tile = (LAS bf16_t*)F.lds;
    __syncthreads();
    { const int k = F.tid >> 3, c0 = (F.tid & 7) * 8;
#pragma unroll
      for (int j = 0; j < 8; ++j) { const int n = nt * 64 + c0 + j; const float v = (n < N) ? W[(size_t)(kt * 64 + k) * N + n] : 0.f; tile[k * 66 + c0 + j] = f2bf(v); } }
    __syncthreads();
    { const int nl = F.tid >> 3, k0 = (F.tid & 7) * 8; const int n = nt * 64 + nl;
      if (n < N) {
          int nd = n; if (permute) nd = (n < 1024) ? n : (n < 1028 ? C_WI + (n - 1024) : n - 4);
          unsigned p[4];
#pragma unroll
          for (int j = 0; j < 4; ++j) p[j] = (unsigned)tile[(k0 + 2 * j) * 66 + nl] | ((unsigned)tile[(k0 + 2 * j + 1) * 66 + nl] << 16);
          *(u32x4*)(Wt + (size_t)nd * K + kt * 64 + k0) = (u32x4){p[0], p[1], p[2], p[3]};
      } }
}
__device__ __forceinline__ void p0_prologue(const Core& C) {
    Frame F; load_frame(F, C);
    for (int it = F.bid; it < P0_ITEMS; it += F.G) {
        int i = it;
        if (i < P0_MOD_ITEMS) { p0_mod_item(F, i); continue; }
        i -= P0_MOD_ITEMS;
        if (i < P0_T_ITEMS) {
            if (i < P0_T_WIN) { p0_transpose_tile(F, F.w_in, NMIX, D, F.WIN, i / 74, i % 74, true); continue; }
            i -= P0_T_WIN;
            if (i < P0_T_WOA) { p0_transpose_tile(F, F.w_o_attn, D, 512, F.WOA, i / 16, i % 16, false); continue; }
            i -= P0_T_WOA;
            if (i < P0_T_WOC) { p0_transpose_tile(F, F.w_o_conv, D, 512, F.WOC, i / 16, i % 16, false); continue; }
            i -= P0_T_WOC;
            if (i < P0_T_WOUT) { p0_transpose_tile(F, F.w_out, D, D, F.WOUT, i / 16, i % 16, false); continue; }
            i -= P0_T_WOUT;
            p0_transpose_tile(F, F.peer_wq, D, D, F.WQ, i / 16, i % 16, false); continue;
        }
        i -= P0_T_ITEMS;
        if (i < P0_CVT_ITEMS) {
            const float* src = (i < 2048) ? F.peer_u : F.peer_v; bf16_t* dst = (i < 2048) ? F.PU : F.PV;
            const size_t base = (size_t)(i & 2047) * 8192 + (size_t)F.tid * 16;
            const f32x4 a = *(const f32x4*)(src + base), b = *(const f32x4*)(src + base + 4), c = *(const f32x4*)(src + base + 8), d = *(const f32x4*)(src + base + 12);
            *(u32x4*)(dst + base) = (u32x4){cvt_pk_bf16(a[0], a[1]), cvt_pk_bf16(a[2], a[3]), cvt_pk_bf16(b[0], b[1]), cvt_pk_bf16(b[2], b[3])};
            *(u32x4*)(dst + base + 8) = (u32x4){cvt_pk_bf16(c[0], c[1]), cvt_pk_bf16(c[2], c[3]), cvt_pk_bf16(d[0], d[1]), cvt_pk_bf16(d[2], d[3])};
            continue;
        }
        for (int e = F.tid; e < (NMIXP - NMIX) * D; e += NTHREADS) F.WIN[(size_t)NMIX * D + e] = 0;
        for (int e = F.tid; e < 128 * 64; e += NTHREADS) { F.K1[e] = f2bf(F.peer_k1[e]); F.K2[e] = f2bf(F.peer_k2[e]); }
    }
}

__device__ __forceinline__ void p1_modulate(const Core& C) {
    Frame F; load_frame(F, C);
    for (int m = F.bid * 8 + F.wave; m < NT; m += F.G * 8) {
        const float* xr = x_row(F, m); const float* mr = F.MOD + (size_t)mod_row(m) * 6144;
#pragma unroll
        for (int hlf = 0; hlf < 2; ++hlf) {
            const int e = hlf * 512 + F.lane * 8;
            const f32x4 x0 = *(const f32x4*)(xr + e), x1 = *(const f32x4*)(xr + e + 4);
            const f32x4 s0 = *(const f32x4*)(mr + 1024 + e), s1 = *(const f32x4*)(mr + 1024 + e + 4);
            const f32x4 h0 = *(const f32x4*)(mr + e), h1 = *(const f32x4*)(mr + e + 4);
            const f32x4 a = x0 * (s0 + 1.f) + h0, b = x1 * (s1 + 1.f) + h1;
            *(u32x4*)(F.H1 + (size_t)m * D + e) = (u32x4){cvt_pk_bf16(a[0], a[1]), cvt_pk_bf16(a[2], a[3]), cvt_pk_bf16(b[0], b[1]), cvt_pk_bf16(b[2], b[3])};
        }
    }
}

constexpr int BM = 256, BN = 128, BK = 64;
constexpr int XPANEL = BM * 32 + 32, WPANEL = BN * 32 + 32;
constexpr int XSTAGE = 4 * XPANEL, WSTAGE = 4 * WPANEL, GSTAGE = XSTAGE + WSTAGE;
__device__ __forceinline__ void gemm_accum(const Frame& F, f32x16 (&acc)[2][2], const bf16_t* __restrict__ X, int ldx, const bf16_t* __restrict__ W, int ldw, int K, int m0, int n0) {
    const int tid = F.tid, lane = F.lane, r = lane & 31, h = lane >> 5, wm = F.wave >> 1, wn = F.wave & 1;
    u32x4 xr[4], wr[2];
    const int nk = K / BK;
    const int crow = tid >> 3, ckc = tid & 7;
    const bf16_t* xg = X + (size_t)(m0 + crow) * ldx + ckc * 8;
    const bf16_t* wg = W + (size_t)(n0 + crow) * ldw + ckc * 8;
    const int ldso = (ckc >> 1) * 1  ;
    const int xoff = ldso * XPANEL + crow * 32 + (ckc & 1) * 16;
    const int woff = ldso * WPANEL + crow * 32 + (ckc & 1) * 16;
#pragma unroll
    for (int i = 0; i < 4; ++i) xr[i] = *(const u32x4*)(xg + (size_t)(64 * i) * ldx);
#pragma unroll
    for (int i = 0; i < 2; ++i) wr[i] = *(const u32x4*)(wg + (size_t)(64 * i) * ldw);
    __syncthreads();
    for (int kt = 0; kt < nk; ++kt) {
        LAS unsigned char* st = F.lds + (kt & 1) * GSTAGE;
#pragma unroll
        for (int i = 0; i < 4; ++i) *(LAS u32x4*)(st + xoff + i * 64 * 32) = xr[i];
#pragma unroll
        for (int i = 0; i < 2; ++i) *(LAS u32x4*)(st + XSTAGE + woff + i * 64 * 32) = wr[i];
        __syncthreads();
        if (kt + 1 < nk) {
#pragma unroll
            for (int i = 0; i < 4; ++i) xr[i] = *(const u32x4*)(xg + (size_t)(64 * i) * ldx + (kt + 1) * BK);
#pragma unroll
            for (int i = 0; i < 2; ++i) wr[i] = *(const u32x4*)(wg + (size_t)(64 * i) * ldw + (kt + 1) * BK);
        }
#pragma unroll
        for (int s = 0; s < 4; ++s) {
            bf16x8 a[2], b[2];
#pragma unroll
            for (int ni = 0; ni < 2; ++ni) a[ni] = *(LAS bf16x8*)(st + XSTAGE + s * WPANEL + (wn * 64 + ni * 32 + r) * 32 + h * 16);
#pragma unroll
            for (int mi = 0; mi < 2; ++mi) b[mi] = *(LAS bf16x8*)(st + s * XPANEL + (wm * 64 + mi * 32 + r) * 32 + h * 16);
#pragma unroll
            for (int mi = 0; mi < 2; ++mi)
#pragma unroll
                for (int ni = 0; ni < 2; ++ni) acc[mi][ni] = __builtin_amdgcn_mfma_f32_32x32x16_bf16(a[ni], b[mi], acc[mi][ni], 0, 0, 0);
        }
    }
}
#define GEMM_EPI_LOOP(...) \
    { const int r_ = F.lane & 31, h_ = F.lane >> 5, wm_ = F.wave >> 1, wn_ = F.wave & 1; \
      _Pragma("unroll") for (int mi = 0; mi < 2; ++mi) _Pragma("unroll") for (int ni = 0; ni < 2; ++ni) _Pragma("unroll") for (int g = 0; g < 4; ++g) { \
          const int m = m0 + wm_ * 64 + mi * 32 + r_; const int n = n0 + wn_ * 64 + ni * 32 + 8 * g + 4 * h_; __VA_ARGS__ } }
#define ACC4(A) ((f32x4){A[mi][ni][4 * g], A[mi][ni][4 * g + 1], A[mi][ni][4 * g + 2], A[mi][ni][4 * g + 3]})
__device__ __forceinline__ void zero_acc(f32x16 (&acc)[2][2]) {
#pragma unroll
    for (int mi = 0; mi < 2; ++mi)
#pragma unroll
        for (int ni = 0; ni < 2; ++ni)
#pragma unroll
            for (int e = 0; e < 16; ++e) acc[mi][ni][e] = 0.f;
}
__device__ __forceinline__ u32x2 pk4(const f32x4 v) { return (u32x2){cvt_pk_bf16(v[0], v[1]), cvt_pk_bf16(v[2], v[3])}; }

__device__ __forceinline__ void p2_gemm_in(const Core& C) {
    Frame F; load_frame(F, C);
    const int ntile = (NT / BM) * (NMIXP / BN);
    for (int t = F.bid; t < ntile; t += F.G) {
        const int m0 = (t / (NMIXP / BN)) * BM, n0 = (t % (NMIXP / BN)) * BN;
        f32x16 acc[2][2]; zero_acc(acc);
        gemm_accum(F, acc, F.H1, D, F.WIN, D, D, m0, n0);
        GEMM_EPI_LOOP({
            const f32x4 v = ACC4(acc);
            *(u32x2*)(F.PROJ + (size_t)m * NMIXP + n) = pk4(v);
            if (n >= C_K && n < C_QI) {
                float* o = (n < C_V) ? (m < NTP ? F.out + O_KP + (size_t)m * 128 + (n - C_K) : F.out + O_KS + (size_t)(m - NTP) * 128 + (n - C_K))
                                     : (m < NTP ? F.out + O_VP + (size_t)m * 128 + (n - C_V) : F.out + O_VS + (size_t)(m - NTP) * 128 + (n - C_V));
                *(f32x4*)o = v;
            } else if (n >= C_KI && n < C_BG) {
                float* o = m < NTP ? F.out + O_KIP + (size_t)m * 64 + (n - C_KI) : F.out + O_KIS + (size_t)(m - NTP) * 64 + (n - C_KI);
                *(f32x4*)o = v;
            } else if (n == C_WI) {
                *(f32x4*)(F.WI + (size_t)m * 4) = v;
            }
        })
    }
}

constexpr int SROW = 2052;
__device__ __forceinline__ int wave_sum_i(int v) {
#pragma unroll
    for (int o = 32; o >= 1; o >>= 1) v += __shfl_xor(v, o);
    return v;
}
__device__ __forceinline__ void cnt_ge(int& c, unsigned u, unsigned t) { asm("v_cmp_ge_u32_e32 vcc, %1, %2\n\tv_addc_co_u32_e32 %0, vcc, 0, %0, vcc" : "+v"(c) : "v"(u), "v"(t) : "vcc"); }
__device__ __forceinline__ void cnt_gt(int& c, unsigned u, unsigned t) { asm("v_cmp_gt_u32_e32 vcc, %1, %2\n\tv_addc_co_u32_e32 %0, vcc, 0, %0, vcc" : "+v"(c) : "v"(u), "v"(t) : "vcc"); }
__device__ __forceinline__ void cnt_eq(int& c, unsigned u, unsigned t) { asm("v_cmp_eq_u32_e32 vcc, %1, %2\n\tv_addc_co_u32_e32 %0, vcc, 0, %0, vcc" : "+v"(c) : "v"(u), "v"(t) : "vcc"); }
__device__ __forceinline__ void cnt_eq_pos(int& c, unsigned u, unsigned t, int L) {
    int tmp;
    asm("v_cmp_eq_u32_e32 vcc, %2, %3\n\tv_cndmask_b32_e32 %1, %5, %4, vcc\n\tv_cmp_lt_i32_e32 vcc, 0, %1\n\tv_addc_co_u32_e32 %0, vcc, 0, %0, vcc"
        : "+v"(c), "=&v"(tmp) : "v"(u), "v"(t), "v"(L), "v"(0x80000000) : "vcc");
}
template <int NV> __device__ __forceinline__ void select_topk(const unsigned (&u)[NV], int ksel, int idx_bits, int* sel, int lane) {
    unsigned T = 0;
#pragma unroll 1
    for (int bit = 31; bit >= 0; --bit) {
        const unsigned cand = T | (1u << bit);
        int c = 0;
#pragma unroll
        for (int i = 0; i < NV; ++i) cnt_ge(c, u[i], cand);
        c = wave_sum_i(c);
        if (c >= ksel) T = cand;
    }
    int cg = 0, ce = 0;
#pragma unroll
    for (int i = 0; i < NV; ++i) { cnt_gt(cg, u[i], T); cnt_eq(ce, u[i], T); }
    const int ngt = wave_sum_i(cg), neq = wave_sum_i(ce);
    const int need = ksel - ngt;
    int Jx = 0x3FFFFFFF;
    if (need < neq) {
        int Jb = 0;
#pragma unroll 1
        for (int bit = idx_bits - 1; bit >= 0; --bit) {
            const int cand = Jb | (1 << bit);
            const int L = cand - lane;
            int c = 0;
#pragma unroll
            for (int i = 0; i < NV; ++i) cnt_eq_pos(c, u[i], T, L - 64 * i);
            c = wave_sum_i(c);
            if (c < need) Jb = cand;
        }
        Jx = Jb + 1;
    }
    const int L = Jx - lane;
    int ct = 0;
#pragma unroll
    for (int i = 0; i < NV; ++i) cnt_eq_pos(ct, u[i], T, L - 64 * i);
    int ig = cg, it = ct;
#pragma unroll
    for (int o = 1; o < 64; o <<= 1) { const int a = __shfl_up(ig, o), b2 = __shfl_up(it, o); if (lane >= o) { ig += a; it += b2; } }
    int pg = ig - cg, pt = ngt + it - ct;
    int ev = lane, Lr = L;
#pragma unroll
    for (int i = 0; i < NV; ++i) {
        if (u[i] > T) { sel[pg] = ev; ++pg; }
        else if (u[i] == T && Lr > 0) { sel[pt] = ev; ++pt; }
        asm volatile("v_add_u32 %0, 64, %0\n\tv_add_u32 %1, -64, %1" : "+v"(ev), "+v"(Lr));
    }
}

__device__ __forceinline__ void p3_index_prompt_unit(const Frame& F, int b, int qt) {
    LAS float* S = (LAS float*)F.lds;
    const int lane = F.lane, r = lane & 15, q4 = lane >> 4;
    const int q0 = qt * 16; const size_t tok0 = (size_t)b * SEQ;
    __syncthreads();
    bf16x8 A[4][2];
#pragma unroll
    for (int hh = 0; hh < 4; ++hh)
#pragma unroll
        for (int s = 0; s < 2; ++s) A[hh][s] = *(const bf16x8*)(F.PROJ + (tok0 + q0 + r) * NMIXP + C_QI + hh * 64 + s * 32 + q4 * 8);
    float wv[4][4];
#pragma unroll
    for (int g = 0; g < 4; ++g) { const f32x4 w4 = *(const f32x4*)(F.WI + (tok0 + q0 + 4 * q4 + g) * 4);
#pragma unroll
        for (int hh = 0; hh < 4; ++hh) wv[g][hh] = w4[hh] * IDX_SCALE; }
    const int nkt = qt + 1;
    for (int kt = F.wave; kt < nkt; kt += 8) {
        const int key0 = kt * 16;
        bf16x8 B[2];
#pragma unroll
        for (int s = 0; s < 2; ++s) B[s] = *(const bf16x8*)(F.PROJ + (tok0 + key0 + r) * NMIXP + C_KI + s * 32 + q4 * 8);
        float sc[4] = {0.f, 0.f, 0.f, 0.f};
#pragma unroll
        for (int hh = 0; hh < 4; ++hh) {
            f32x4 c = {0.f, 0.f, 0.f, 0.f};
            c = __builtin_amdgcn_mfma_f32_16x16x32_bf16(A[hh][0], B[0], c, 0, 0, 0);
            c = __builtin_amdgcn_mfma_f32_16x16x32_bf16(A[hh][1], B[1], c, 0, 0, 0);
#pragma unroll
            for (int g = 0; g < 4; ++g) sc[g] += fmaxf(c[g], 0.f) * wv[g][hh];
        }
#pragma unroll
        for (int g = 0; g < 4; ++g) S[(4 * q4 + g) * SROW + key0 + r] = sc[g];
    }
    __syncthreads();
    for (int rr = 0; rr < 2; ++rr) {
        const int row = F.wave * 2 + rr; const int q = q0 + row; const int nvalid = q + 1;
        int* sel = F.SEL + (tok0 + q) * NSEL;
        if (nvalid <= NSEL) {
#pragma unroll
            for (int i = 0; i < 4; ++i) { const int j = lane + 64 * i; sel[j] = (j < nvalid) ? j : -1; }
            continue;
        }
        unsigned u[32];
#pragma unroll
        for (int i = 0; i < 32; ++i) { const int j = lane + 64 * i; u[i] = (j < nvalid) ? f2ord(S[row * SROW + j]) : 0u; }
        select_topk<32>(u, NSEL, 11, sel, lane);
    }
}

__device__ __forceinline__ void p3_index_sample_unit(const Frame& F, float* SS, int b) {
    const int lane = F.lane, r = lane & 31, h = lane >> 5;
    {
        bf16x8 A[4];
        { const int q = r >> 2, hh = r & 3;
#pragma unroll
          for (int s = 0; s < 4; ++s) A[s] = *(const bf16x8*)(F.PROJ + (size_t)(NTP + b * TS + q) * NMIXP + C_QI + hh * 64 + s * 16 + h * 8); }
        float wv[4][4];
#pragma unroll
        for (int g = 0; g < 4; ++g) { const f32x4 w4 = *(const f32x4*)(F.WI + (size_t)(NTP + b * TS + 2 * g + h) * 4);
#pragma unroll
            for (int hh = 0; hh < 4; ++hh) wv[g][hh] = w4[hh] * IDX_SCALE; }
#pragma unroll 1
        for (int tl = F.wave; tl < PAST / 32; tl += 8) {
            const int key0 = tl * 32; const int page = F.page_table[b * NPAGES + (key0 >> 7)];
            const float* kr = F.cache_ki + ((size_t)page * PAGE + (key0 & 127) + r) * 64;
            f32x16 c;
#pragma unroll
            for (int e = 0; e < 16; ++e) c[e] = 0.f;
#pragma unroll
            for (int s = 0; s < 4; ++s) {
                const f32x4 lo = *(const f32x4*)(kr + s * 16 + h * 8), hi = *(const f32x4*)(kr + s * 16 + h * 8 + 4);
                const u32x4 pk = (u32x4){cvt_pk_bf16(lo[0], lo[1]), cvt_pk_bf16(lo[2], lo[3]), cvt_pk_bf16(hi[0], hi[1]), cvt_pk_bf16(hi[2], hi[3])};
                bf16x8 Bf; __builtin_memcpy(&Bf, &pk, 16);
                c = __builtin_amdgcn_mfma_f32_32x32x16_bf16(A[s], Bf, c, 0, 0, 0);
            }
#pragma unroll
            for (int g = 0; g < 4; ++g) {
                float sc = 0.f;
#pragma unroll
                for (int hh = 0; hh < 4; ++hh) sc += fmaxf(c[4 * g + hh], 0.f) * wv[g][hh];
                SS[(size_t)(b * TS + 2 * g + h) * PAST + key0 + r] = sc;
            }
        }
    }
    asm volatile("s_waitcnt vmcnt(0)" ::: "memory");
    __syncthreads();
    {
        const int q = F.wave;
        unsigned u[129];
        const float* srow = SS + (size_t)(b * TS + q) * PAST;
#pragma unroll
        for (int i = 0; i < 128; ++i) u[i] = f2ord(srow[64 * i + lane]);
        float s = 0.f;
        if (lane < TS) {
            const bf16_t* kn = F.PROJ + (size_t)(NTP + b * TS + lane) * NMIXP + C_KI;
            const bf16_t* qn = F.PROJ + (size_t)(NTP + b * TS + q) * NMIXP + C_QI;
            int vz; asm volatile("v_mov_b32 %0, 0" : "=v"(vz));
            const f32x4 w4 = *(const f32x4*)(F.WI + (size_t)(NTP + b * TS + q) * 4 + vz);
#pragma unroll 1
            for (int hh = 0; hh < 4; ++hh) {
                float d = 0.f;
#pragma unroll 4
                for (int e = 0; e < 64; ++e) d += bf2f(qn[hh * 64 + e]) * bf2f(kn[e]);
                s += fmaxf(d, 0.f) * (w4[hh] * IDX_SCALE);
            }
        }
        u[128] = (lane < TS && lane <= q) ? f2ord(s) : 0u;
        int* sel = F.SEL + (size_t)(NTP + b * TS + q) * NSEL;
        select_topk<129>(u, NSEL, 14, sel, lane);
    }
}
__device__ __forceinline__ void p3_index(const Core& C) {
    Frame F; load_frame(F, C);
    const int nunits = NB_S + NB_P * (SEQ / 16);
    float* SS = (float*)(ldptr(C, 28) + WS_SS);
    for (int it = F.bid; it < nunits; it += F.G) {
        if (it < NB_S) { p3_index_sample_unit(F, SS, it); continue; }
        const int i = it - NB_S; const int b = i & 7, qt = (SEQ / 16 - 1) - (i >> 3);
        p3_index_prompt_unit(F, b, qt);
    }
}

template <bool SAMPLE> __device__ __forceinline__ void p4_attn_query(const Frame& F, int tok, int slot, int g) {
    const int lane = F.lane;
    LAS unsigned char* wl = F.lds + (slot * 2 + g) * 8192;
    LAS f32x4* Pl = (LAS f32x4*)wl; LAS int* Il = (LAS int*)(wl + 4096); LAS unsigned* Ql = (LAS unsigned*)(wl + 5120);
    LAS float* RB = (LAS float*)(F.lds + 65536);
    LAS int* BT = (LAS int*)(F.lds + 65536 + 1024);
    int b, qpos;
    if (SAMPLE) { b = (tok - NTP) >> 3; qpos = PAST + ((tok - NTP) & 7); } else { b = tok >> 11; qpos = tok & 2047; }
    { const unsigned* qsrc = (const unsigned*)(F.PROJ + (size_t)tok * NMIXP + C_Q + g * 256);
      Ql[lane] = qsrc[lane]; Ql[lane + 64] = qsrc[lane + 64]; }
    const int* selp = F.SEL + (size_t)tok * NSEL;
#pragma unroll 1
    for (int i = 0; i < 4; ++i) {
        const int sraw = selp[lane + 64 * i];
        const int s = sraw < 0 ? 0 : sraw;
        float a0 = 0.f, a1 = 0.f, a2 = 0.f, a3 = 0.f;
        if (SAMPLE) {
            const float* kr;
            if (s < PAST) { const int page = F.page_table[b * NPAGES + (s >> 7)]; kr = F.cache_k + ((size_t)page * PAGE + (s & 127)) * 128 + g * 64; }
            else kr = F.out + O_KS + (size_t)(b * TS + (s - PAST)) * 128 + g * 64;
#pragma unroll
            for (int c = 0; c < 16; ++c) {
                const f32x4 kv = *(const f32x4*)(kr + c * 4);
#pragma unroll
                for (int e = 0; e < 2; ++e) {
                    const unsigned kp = cvt_pk_bf16(kv[2 * e], kv[2 * e + 1]);
                    const float k0 = bflo(kp), k1 = bfhi(kp);
                    const unsigned q0 = Ql[0 * 32 + c * 2 + e], q1 = Ql[1 * 32 + c * 2 + e], q2 = Ql[2 * 32 + c * 2 + e], q3 = Ql[3 * 32 + c * 2 + e];
                    a0 += bflo(q0) * k0 + bfhi(q0) * k1; a1 += bflo(q1) * k0 + bfhi(q1) * k1;
                    a2 += bflo(q2) * k0 + bfhi(q2) * k1; a3 += bflo(q3) * k0 + bfhi(q3) * k1;
                }
            }
        } else {
            const bf16_t* kr = F.PROJ + ((size_t)b * SEQ + s) * NMIXP + C_K + g * 64;
#pragma unroll
            for (int c = 0; c < 8; ++c) {
                const u32x4 kv = *(const u32x4*)(kr + c * 8);
#pragma unroll
                for (int e = 0; e < 4; ++e) {
                    const float k0 = bflo(kv[e]), k1 = bfhi(kv[e]);
                    const unsigned q0 = Ql[0 * 32 + c * 4 + e], q1 = Ql[1 * 32 + c * 4 + e], q2 = Ql[2 * 32 + c * 4 + e], q3 = Ql[3 * 32 + c * 4 + e];
                    a0 += bflo(q0) * k0 + bfhi(q0) * k1; a1 += bflo(q1) * k0 + bfhi(q1) * k1;
                    a2 += bflo(q2) * k0 + bfhi(q2) * k1; a3 += bflo(q3) * k0 + bfhi(q3) * k1;
                }
            }
        }
        f32x4 L;
        if (sraw < 0) L = (f32x4){-INFINITY, -INFINITY, -INFINITY, -INFINITY};
        else {
            const int dist = qpos - s; const int bk = dist < 128 ? BT[dist] : 31;
            L = (f32x4){a0 * ATTN_SCALE + RB[bk * 8 + g * 4 + 0], a1 * ATTN_SCALE + RB[bk * 8 + g * 4 + 1], a2 * ATTN_SCALE + RB[bk * 8 + g * 4 + 2], a3 * ATTN_SCALE + RB[bk * 8 + g * 4 + 3]};
        }
        Pl[lane + 64 * i] = L; Il[lane + 64 * i] = s;
    }
    f32x4 lg[4];
#pragma unroll
    for (int i = 0; i < 4; ++i) lg[i] = Pl[lane + 64 * i];
    float inv[4];
#pragma unroll
    for (int hh = 0; hh < 4; ++hh) {
        float m = fmaxf(fmaxf(lg[0][hh], lg[1][hh]), fmaxf(lg[2][hh], lg[3][hh])); m = wave_max(m);
        float sm = 0.f;
#pragma unroll
        for (int i = 0; i < 4; ++i) { lg[i][hh] = __expf(lg[i][hh] - m); sm += lg[i][hh]; }
        sm = wave_sum(sm); inv[hh] = 1.f / sm;
    }
#pragma unroll
    for (int i = 0; i < 4; ++i) Pl[lane + 64 * i] = (f32x4){lg[i][0] * inv[0], lg[i][1] * inv[1], lg[i][2] * inv[2], lg[i][3] * inv[3]};
    const int dp = lane & 31, kh = lane >> 5;
    float o[4][2];
#pragma unroll
    for (int hh = 0; hh < 4; ++hh) o[hh][0] = o[hh][1] = 0.f;
#pragma unroll 4
    for (int jj = 0; jj < 128; ++jj) {
        const int j = jj * 2 + kh; const int s = Il[j]; const f32x4 p = Pl[j];
        float v0, v1;
        if (SAMPLE) {
            const float* vr;
            if (s < PAST) { const int page = F.page_table[b * NPAGES + (s >> 7)]; vr = F.cache_v + ((size_t)page * PAGE + (s & 127)) * 128 + g * 64; }
            else vr = F.out + O_VS + (size_t)(b * TS + (s - PAST)) * 128 + g * 64;
            const float2 vv = *(const float2*)(vr + 2 * dp); v0 = bf2f(f2bf(vv.x)); v1 = bf2f(f2bf(vv.y));
        } else {
            const unsigned vv = *(const unsigned*)(F.PROJ + ((size_t)b * SEQ + s) * NMIXP + C_V + g * 64 + 2 * dp); v0 = bflo(vv); v1 = bfhi(vv);
        }
#pragma unroll
        for (int hh = 0; hh < 4; ++hh) { o[hh][0] += p[hh] * v0; o[hh][1] += p[hh] * v1; }
    }
#pragma unroll
    for (int hh = 0; hh < 4; ++hh) { o[hh][0] += __shfl_xor(o[hh][0], 32); o[hh][1] += __shfl_xor(o[hh][1], 32); }
    if (kh == 0) {
#pragma unroll
        for (int hh = 0; hh < 4; ++hh) *(unsigned*)(F.OATT + (size_t)tok * 512 + (g * 4 + hh) * 64 + 2 * dp) = cvt_pk_bf16(o[hh][0], o[hh][1]);
    }
}
__device__ __forceinline__ void p4_attention(const Core& C) {
    Frame F; load_frame(F, C);
    LAS float* RB = (LAS float*)(F.lds + 65536);
    __syncthreads();
    if (F.tid < 256) RB[F.tid] = F.rel_bias[F.tid];
    if (F.tid < 128) ((LAS int*)(F.lds + 65536 + 1024))[F.tid] = t5_bucket(F.tid);
    __syncthreads();
    const int slot = F.wave >> 1, g = F.wave & 1;
    for (int it = F.bid; it < NT / 4; it += F.G) {
        if (it < NTS / 4) p4_attn_query<true>(F, NTP + it * 4 + slot, slot, g);
        else p4_attn_query<false>(F, (it - NTS / 4) * 4 + slot, slot, g);
    }
    for (int m = F.bid * 8 + F.wave; m < NT; m += F.G * 8) {
        int t, T_, bsm; if (m < NTP) { t = m & 2047; T_ = SEQ; bsm = m >> 11; } else { t = (m - NTP) & 7; T_ = TS; bsm = (m - NTP) >> 3; }
        const int c0 = F.lane * 8;
        float u0[8], u1[8], u2[8];
        { const u32x4 cg = *(const u32x4*)(F.PROJ + (size_t)m * NMIXP + C_CG + c0), xi = *(const u32x4*)(F.PROJ + (size_t)m * NMIXP + C_XIN + c0);
#pragma unroll
          for (int e = 0; e < 4; ++e) { u0[2 * e] = bflo(cg[e]) * bflo(xi[e]); u0[2 * e + 1] = bfhi(cg[e]) * bfhi(xi[e]); } }
#pragma unroll
        for (int d = 1; d <= 2; ++d) {
            float* ud = (d == 1) ? u1 : u2;
            if (t - d >= 0) {
                const u32x4 cg = *(const u32x4*)(F.PROJ + (size_t)(m - d) * NMIXP + C_CG + c0), xi = *(const u32x4*)(F.PROJ + (size_t)(m - d) * NMIXP + C_XIN + c0);
#pragma unroll
                for (int e = 0; e < 4; ++e) { ud[2 * e] = bflo(cg[e]) * bflo(xi[e]); ud[2 * e + 1] = bfhi(cg[e]) * bfhi(xi[e]); }
            } else if (m >= NTP) {
                const float* pv = F.state_conv + ((size_t)bsm * 2 + (2 + t - d)) * 512 + c0;
#pragma unroll
                for (int e = 0; e < 8; ++e) ud[e] = pv[e];
            } else {
#pragma unroll
                for (int e = 0; e < 8; ++e) ud[e] = 0.f;
            }
        }
        const u32x4 bg = *(const u32x4*)(F.PROJ + (size_t)m * NMIXP + C_BG + c0);
        float y[8];
#pragma unroll
        for (int e = 0; e < 8; ++e) {
            const int c = c0 + e;
            const float yy = F.conv_b[c] + F.conv_w[c] * u2[e] + F.conv_w[512 + c] * u1[e] + F.conv_w[1024 + c] * u0[e];
            const float bgv = (e & 1) ? bfhi(bg[e >> 1]) : bflo(bg[e >> 1]);
            y[e] = bgv * yy;
        }
        *(u32x4*)(F.OCONV + (size_t)m * 512 + c0) = (u32x4){cvt_pk_bf16(y[0], y[1]), cvt_pk_bf16(y[2], y[3]), cvt_pk_bf16(y[4], y[5]), cvt_pk_bf16(y[6], y[7])};
        if (t >= T_ - 2) {
            float* o = (m < NTP ? F.out + O_CP : F.out + O_CS) + ((size_t)bsm * 2 + (t - (T_ - 2))) * 512 + c0;
            *(f32x4*)o = (f32x4){u0[0], u0[1], u0[2], u0[3]}; *(f32x4*)(o + 4) = (f32x4){u0[4], u0[5], u0[6], u0[7]};
        }
    }
}

__device__ __forceinline__ void p5_gemm_merge(const Core& C) {
    Frame F; load_frame(F, C);
    const int ntile = (NT / BM) * (D / BN);
    for (int t = F.bid; t < ntile; t += F.G) {
        const int m0 = (t / (D / BN)) * BM, n0 = (t % (D / BN)) * BN;
        f32x16 acc[2][2], acc2[2][2]; zero_acc(acc); zero_acc(acc2);
        gemm_accum(F, acc, F.OATT, 512, F.WOA, 512, 512, m0, n0);
        gemm_accum(F, acc2, F.OCONV, 512, F.WOC, 512, 512, m0, n0);
        GEMM_EPI_LOOP({
            const f32x4 va = ACC4(acc), vc = ACC4(acc2);
            const u32x2 ga = *(const u32x2*)(F.PROJ + (size_t)m * NMIXP + C_GA + n), gb = *(const u32x2*)(F.PROJ + (size_t)m * NMIXP + C_GB + n);
            f32x4 o;
            o[0] = sigmoidf_(bflo(ga[0])) * va[0] + sigmoidf_(bflo(gb[0])) * vc[0];
            o[1] = sigmoidf_(bfhi(ga[0])) * va[1] + sigmoidf_(bfhi(gb[0])) * vc[1];
            o[2] = sigmoidf_(bflo(ga[1])) * va[2] + sigmoidf_(bflo(gb[1])) * vc[2];
            o[3] = sigmoidf_(bfhi(ga[1])) * va[3] + sigmoidf_(bfhi(gb[1])) * vc[3];
            *(u32x2*)(F.MERGED + (size_t)m * D + n) = pk4(o);
        })
    }
}
__device__ __forceinline__ void p6_gemm_out(const Core& C) {
    Frame F; load_frame(F, C);
    const int ntile = (NT / BM) * (D / BN);
    for (int t = F.bid; t < ntile; t += F.G) {
        const int m0 = (t / (D / BN)) * BM, n0 = (t % (D / BN)) * BN;
        f32x16 acc[2][2]; zero_acc(acc);
        gemm_accum(F, acc, F.MERGED, D, F.WOUT, D, D, m0, n0);
        GEMM_EPI_LOOP({
            const f32x4 v = ACC4(acc);
            const f32x4 xv = *(const f32x4*)(x_row(F, m) + n);
            const f32x4 g1 = *(const f32x4*)(F.MOD + (size_t)mod_row(m) * 6144 + 2048 + n);
            *(f32x4*)(F.T1 + (size_t)m * D + n) = xv * DN_ALPHA + g1 * v;
        })
    }
}
__device__ __forceinline__ void p7_ln1(const Core& C) {
    Frame F; load_frame(F, C);
    for (int m = F.bid * 8 + F.wave; m < NT; m += F.G * 8) {
        float* tr = F.T1 + (size_t)m * D; const float* mr = F.MOD + (size_t)mod_row(m) * 6144;
        f32x4 v[4]; float s = 0.f;
#pragma unroll
        for (int i = 0; i < 4; ++i) { v[i] = *(const f32x4*)(tr + (i >> 1) * 512 + F.lane * 8 + (i & 1) * 4); s += v[i][0] + v[i][1] + v[i][2] + v[i][3]; }
        const float mean = wave_sum(s) * (1.f / D);
        float q = 0.f;
#pragma unroll
        for (int i = 0; i < 4; ++i) { v[i] = v[i] - mean; q += v[i][0] * v[i][0] + v[i][1] * v[i][1] + v[i][2] * v[i][2] + v[i][3] * v[i][3]; }
        const float rstd = rsqrtf(wave_sum(q) * (1.f / D) + LN_EPS);
#pragma unroll
        for (int hlf = 0; hlf < 2; ++hlf) {
            const int e = hlf * 512 + F.lane * 8;
            f32x4 a = v[2 * hlf] * rstd * *(const f32x4*)(F.ln1_g + e) + *(const f32x4*)(F.ln1_b + e);
            f32x4 b = v[2 * hlf + 1] * rstd * *(const f32x4*)(F.ln1_g + e + 4) + *(const f32x4*)(F.ln1_b + e + 4);
            *(f32x4*)(tr + e) = a; *(f32x4*)(tr + e + 4) = b;
            const f32x4 ha = a * (*(const f32x4*)(mr + 4096 + e) + 1.f) + *(const f32x4*)(mr + 3072 + e);
            const f32x4 hb = b * (*(const f32x4*)(mr + 4096 + e + 4) + 1.f) + *(const f32x4*)(mr + 3072 + e + 4);
            *(u32x4*)(F.H2 + (size_t)m * D + e) = (u32x4){cvt_pk_bf16(ha[0], ha[1]), cvt_pk_bf16(ha[2], ha[3]), cvt_pk_bf16(hb[0], hb[1]), cvt_pk_bf16(hb[2], hb[3])};
        }
    }
}
__device__ __forceinline__ void p8_gemm_q(const Core& C) {
    Frame F; load_frame(F, C);
    const int ntile = (NT / BM) * (D / BN);
    for (int t = F.bid; t < ntile; t += F.G) {
        const int m0 = (t / (D / BN)) * BM, n0 = (t % (D / BN)) * BN;
        f32x16 acc[2][2]; zero_acc(acc);
        gemm_accum(F, acc, F.H2, D, F.WQ, D, D, m0, n0);
        GEMM_EPI_LOOP({ *(u32x2*)(F.QP + (size_t)m * D + n) = pk4(ACC4(acc)); })
    }
}
constexpr int PR_ROW = 129;
__device__ __forceinline__ void p9_route(const Core& C) {
    Frame F; load_frame(F, C);
    LAS float* SC = (LAS float*)F.lds;
    LAS float* TV = (LAS float*)(F.lds + 32 * 8 * PR_ROW * 4);
    LAS unsigned char* TI = (LAS unsigned char*)(F.lds + 32 * 8 * PR_ROW * 4 + 256 * 17 * 4);
    const int lane = F.lane, r = lane & 31, h = lane >> 5;
    const int nunits = (NT / 32) * 2;
    for (int it = F.bid; it < nunits; it += F.G) {
        const int tok0 = (it >> 1) * 32, hg = it & 1;
        __syncthreads();
        {
            const int head = hg * 4 + (F.wave >> 1), half = F.wave & 1;
            const bf16_t* KK = half ? F.K2 : F.K1;
            bf16x8 Bq[4];
#pragma unroll
            for (int s = 0; s < 4; ++s) Bq[s] = *(const bf16x8*)(F.QP + (size_t)(tok0 + r) * D + head * 128 + half * 64 + s * 16 + h * 8);
#pragma unroll
            for (int kt = 0; kt < 4; ++kt) {
                f32x16 c;
#pragma unroll
                for (int e = 0; e < 16; ++e) c[e] = 0.f;
#pragma unroll
                for (int s = 0; s < 4; ++s) {
                    const bf16x8 Ak = *(const bf16x8*)(KK + (size_t)(kt * 32 + r) * 64 + s * 16 + h * 8);
                    c = __builtin_amdgcn_mfma_f32_32x32x16_bf16(Ak, Bq[s], c, 0, 0, 0);
                }
#pragma unroll
                for (int e = 0; e < 16; ++e) { const int key = kt * 32 + (e & 3) + 8 * (e >> 2) + 4 * h; SC[(r * 8 + F.wave) * PR_ROW + key] = c[e]; }
            }
        }
        __syncthreads();
        if (F.tid < 256) {
            LAS float* row = SC + F.tid * PR_ROW;
            for (int p = 0; p < 16; ++p) {
                float best = -INFINITY; int bi = 0;
                for (int j = 0; j < 128; ++j) { const float v = row[j]; if (v > best) { best = v; bi = j; } }
                row[bi] = -INFINITY; TV[F.tid * 17 + p] = best; TI[F.tid * 17 + p] = (unsigned char)bi;
            }
        }
        __syncthreads();
        if (F.tid < 128) {
            const int tk = F.tid >> 2, hs = F.tid & 3;
            const int r1 = (tk * 8 + hs * 2) * 17, r2 = r1 + 17;
            LAS float* cand = SC + F.tid * 51;
            int nc = 0;
            for (int i = 0; i < 16; ++i) { const int jm = 16 / (i + 1); for (int j = 0; j < jm; ++j) { cand[nc] = TV[r1 + i] + TV[r2 + j]; ++nc; } }
            float sv[16]; int se[16];
#pragma unroll
            for (int p = 0; p < 16; ++p) {
                float best = -INFINITY; int bc = 0, bi = 0, bj = 0, c = 0;
                for (int i = 0; i < 16; ++i) { const int jm = 16 / (i + 1); for (int j = 0; j < jm; ++j) { const float v = cand[c]; if (v > best) { best = v; bc = c; bi = i; bj = j; } ++c; } }
                cand[bc] = -INFINITY; sv[p] = best; se[p] = (int)TI[r1 + bi] * 128 + (int)TI[r2 + bj];
            }
            const float mx0 = sv[0]; float den = 0.f;
#pragma unroll
            for (int p = 0; p < 16; ++p) { sv[p] = __expf(sv[p] - mx0); den += sv[p]; }
            const float dinv = 1.f / den;
            const int head = hg * 4 + hs;
            int* eo = F.EIDX + (size_t)(tok0 + tk) * NEXP_SEL + head * 16; float* go = F.GW + (size_t)(tok0 + tk) * NEXP_SEL + head * 16;
#pragma unroll
            for (int p = 0; p < 16; ++p) { eo[p] = se[p]; go[p] = sv[p] * dinv; }
        }
    }
}

__device__ __forceinline__ void p10_peer(const Core& C) {
    Frame F; load_frame(F, C);
    const int lane = F.lane;
    for (int m = F.bid * 8 + F.wave; m < NT; m += F.G * 8) {
        float hv[16];
        { const u32x4 a = *(const u32x4*)(F.H2 + (size_t)m * D + lane * 8), b = *(const u32x4*)(F.H2 + (size_t)m * D + 512 + lane * 8);
#pragma unroll
          for (int e = 0; e < 4; ++e) { hv[2 * e] = bflo(a[e]); hv[2 * e + 1] = bfhi(a[e]); hv[8 + 2 * e] = bflo(b[e]); hv[8 + 2 * e + 1] = bfhi(b[e]); } }
        float acc[16];
#pragma unroll
        for (int e = 0; e < 16; ++e) acc[e] = 0.f;
        const int* ep = F.EIDX + (size_t)m * NEXP_SEL; const float* gp = F.GW + (size_t)m * NEXP_SEL;
        const int ev0 = ep[lane], ev1 = ep[64 + lane];
        const int gv0 = __float_as_int(gp[lane]), gv1 = __float_as_int(gp[64 + lane]);
#pragma unroll 1
        for (int j0 = 0; j0 < NEXP_SEL; j0 += 4) {
            u32x4 ua[4], ub[4], va[4], vb[4]; float gw[4];
            const int evs = (j0 < 64) ? ev0 : ev1, gvs = (j0 < 64) ? gv0 : gv1;
#pragma unroll
            for (int j = 0; j < 4; ++j) {
                const int e = __builtin_amdgcn_readlane(evs, (j0 & 63) + j); gw[j] = __int_as_float(__builtin_amdgcn_readlane(gvs, (j0 & 63) + j));
                const bf16_t* ur = F.PU + (size_t)e * D; const bf16_t* vr = F.PV + (size_t)e * D;
                ua[j] = *(const u32x4*)(ur + lane * 8); ub[j] = *(const u32x4*)(ur + 512 + lane * 8);
                va[j] = *(const u32x4*)(vr + lane * 8); vb[j] = *(const u32x4*)(vr + 512 + lane * 8);
            }
#pragma unroll
            for (int j = 0; j < 4; ++j) {
                float d = 0.f;
#pragma unroll
                for (int e = 0; e < 4; ++e) { d += hv[2 * e] * bflo(ua[j][e]) + hv[2 * e + 1] * bfhi(ua[j][e]); d += hv[8 + 2 * e] * bflo(ub[j][e]) + hv[8 + 2 * e + 1] * bfhi(ub[j][e]); }
                d = wave_sum(d);
                const float act = gelu_tanh(d) * gw[j];
#pragma unroll
                for (int e = 0; e < 4; ++e) { acc[2 * e] += act * bflo(va[j][e]); acc[2 * e + 1] += act * bfhi(va[j][e]); acc[8 + 2 * e] += act * bflo(vb[j][e]); acc[8 + 2 * e + 1] += act * bfhi(vb[j][e]); }
            }
        }
        const float* x1 = F.T1 + (size_t)m * D; const float* mr = F.MOD + (size_t)mod_row(m) * 6144 + 5120;
        float tv[16]; float s = 0.f;
#pragma unroll
        for (int hlf = 0; hlf < 2; ++hlf)
#pragma unroll
            for (int c = 0; c < 2; ++c) {
                const int e = hlf * 512 + lane * 8 + c * 4;
                const f32x4 xv = *(const f32x4*)(x1 + e), g2 = *(const f32x4*)(mr + e);
#pragma unroll
                for (int k = 0; k < 4; ++k) { const float t = xv[k] * DN_ALPHA + g2[k] * acc[hlf * 8 + c * 4 + k]; tv[hlf * 8 + c * 4 + k] = t; s += t; }
            }
        const float mean = wave_sum(s) * (1.f / D);
        float q = 0.f;
#pragma unroll
        for (int e = 0; e < 16; ++e) { tv[e] -= mean; q += tv[e] * tv[e]; }
        const float rstd = rsqrtf(wave_sum(q) * (1.f / D) + LN_EPS);
        float* yo = (m < NTP) ? F.out + O_YP + (size_t)m * D : F.out + O_YS + (size_t)(m - NTP) * D;
#pragma unroll
        for (int hlf = 0; hlf < 2; ++hlf)
#pragma unroll
            for (int c = 0; c < 2; ++c) {
                const int e = hlf * 512 + lane * 8 + c * 4;
                const f32x4 gg = *(const f32x4*)(F.ln2_g + e), bb = *(const f32x4*)(F.ln2_b + e);
                f32x4 o;
#pragma unroll
                for (int k = 0; k < 4; ++k) o[k] = tv[hlf * 8 + c * 4 + k] * rstd * gg[k] + bb[k];
                *(f32x4*)(yo + e) = o;
            }
    }
}

constexpr int N_PHASES = 11;
__global__ void __launch_bounds__(NTHREADS, 2) fwd_kernel(Args args) {
    extern __shared__ __attribute__((aligned(16))) unsigned char lds_raw[];
    Core F;
    F.lds = (LAS unsigned char*)lds_raw;
    F.tid = threadIdx.x; F.lane = F.tid & 63; F.wave = __builtin_amdgcn_readfirstlane(F.tid >> 6); F.G = gridDim.x; F.bid = blockIdx.x;
    if (F.tid == 0) {
        LAS unsigned long long* pt = (LAS unsigned long long*)(F.lds + LDS_PTAB);
#pragma unroll
        for (int i = 0; i < 27; ++i) pt[i] = (unsigned long long)args.in[i];
        pt[27] = (unsigned long long)args.out; pt[28] = (unsigned long long)args.ws;
    }
    unsigned char* ws = args.ws;
    volatile LAS unsigned* misc = (volatile LAS unsigned*)(F.lds + LDS_MISC);
    if (F.tid < 16) misc[F.tid] = 0u;
    __syncthreads();
    XcdBarrier bar; bar.bar = (unsigned*)(ws + WS_CTL); bar.x = 0; bar.st = misc;
    const int lo = args.ph_lo, hi = args.ph_hi;
    if (hi - lo > 1) bar = xcd_barrier_post((unsigned*)(ws + WS_CTL), misc);
#define IN(k) (lo <= (k) && (k) < hi)
#define SEAM(k) do { if (IN(k) && IN((k) + 1)) xcd_barrier(bar); } while (0)
    if (IN(0)) p0_prologue(F);       SEAM(0);
    if (IN(1)) p1_modulate(F);       SEAM(1);
    if (IN(2)) p2_gemm_in(F);        SEAM(2);
    if (IN(3)) p3_index(F);          SEAM(3);
    if (IN(4)) p4_attention(F);      SEAM(4);
    if (IN(5)) p5_gemm_merge(F);     SEAM(5);
    if (IN(6)) p6_gemm_out(F);       SEAM(6);
    if (IN(7)) p7_ln1(F);            SEAM(7);
    if (IN(8)) p8_gemm_q(F);         SEAM(8);
    if (IN(9)) p9_route(F);          SEAM(9);
    if (IN(10)) p10_peer(F);
#undef IN
#undef SEAM
}

extern "C" void kernel_launch(void* const* d_in, const int* in_sizes, int n_in, void* d_out, int out_size, void* d_ws, size_t ws_size, hipStream_t stream) {
    static int grid = 0;
    if (grid == 0) {
        if (n_in != 27 || (size_t)out_size != O_END || ws_size < WS_END) { fprintf(stderr, "kernel_launch: unexpected shapes (n_in %d out %d ws %zu)\n", n_in, out_size, ws_size); grid = -1; return; }
        int dev = 0, cus = 0;
        if (hipGetDevice(&dev) != hipSuccess || hipDeviceGetAttribute(&cus, hipDeviceAttributeMultiprocessorCount, dev) != hipSuccess) { grid = -1; return; }
        if (hipFuncSetAttribute((const void*)fwd_kernel, hipFuncAttributeMaxDynamicSharedMemorySize, LDS_BYTES) != hipSuccess) { fprintf(stderr, "kernel_launch: hipFuncSetAttribute failed\n"); grid = -1; return; }
        (void)hipGetLastError();
        grid = cus;
    }
    if (grid < 0) return;
    (void)hipMemsetAsync((char*)d_ws + WS_CTL, 0, CTL_ZERO_BYTES, stream);
    Args a{};
    for (int i = 0; i < 27; ++i) a.in[i] = d_in[i];
    a.out = (float*)d_out; a.ws = (unsigned char*)d_ws;
#if N_LAUNCHES == 1
    a.ph_lo = 0; a.ph_hi = N_PHASES;
    hipLaunchKernelGGL(fwd_kernel, dim3(grid), dim3(NTHREADS), LDS_BYTES, stream, a);
#else
    for (int p = 0; p < N_PHASES; ++p) { a.ph_lo = p; a.ph_hi = p + 1; hipLaunchKernelGGL(fwd_kernel, dim3(grid), dim3(NTHREADS), LDS_BYTES, stream, a); }
#endif
}
```

```cpp
#include <hip/hip_runtime.h>
#include <cstdio>
#include <cstdint>

#ifndef N_LAUNCHES
#define N_LAUNCHES 1
#endif

typedef unsigned short bf16_t;
typedef short bf16x8 __attribute__((ext_vector_type(8)));
typedef float f32x4 __attribute__((ext_vector_type(4)));
typedef float f32x16 __attribute__((ext_vector_type(16)));
typedef unsigned u32x4 __attribute__((ext_vector_type(4)));
typedef unsigned u32x2 __attribute__((ext_vector_type(2)));
#define LAS __attribute__((address_space(3)))

constexpr int D = 1024, NB_P = 8, SEQ = 2048, NB_S = 32, TS = 8, PAST = 8192, PAGE = 128, NPAGES = 64;
constexpr int NTP = NB_P * SEQ;
constexpr int NTS = NB_S * TS;
constexpr int NT = NTP + NTS;
constexpr int NMIX = 4676, NMIXP = 4736;
constexpr int C_Q = 0, C_K = 512, C_V = 640, C_QI = 768, C_KI = 1024, C_BG = 1088, C_CG = 1600, C_XIN = 2112, C_GA = 2624, C_GB = 3648, C_WI = 4672;
constexpr int NSEL = 256;
constexpr float ATTN_SCALE = 0.125f, IDX_SCALE = 0.0625f;
constexpr float DN_ALPHA = 1.189207115002721f, LN_EPS = 1e-5f;
constexpr int NEXP_SEL = 128;

constexpr size_t O_YP = 0, O_YS = 16777216, O_KP = 17039360, O_VP = 19136512, O_KIP = 21233664, O_CP = 22282240,
                 O_KS = 22290432, O_VS = 22323200, O_KIS = 22355968, O_CS = 22372352, O_END = 22405120;

constexpr size_t MB = 1048576;
constexpr size_t WS_CTL = 0, WS_MOD = 1 * MB, WS_WIN = 2 * MB, WS_WOA = 12 * MB, WS_WOC = 13 * MB, WS_WOUT = 14 * MB, WS_WQ = 16 * MB,
                 WS_K1 = 18 * MB, WS_K2 = 18 * MB + 65536, WS_PU = 20 * MB, WS_PV = 52 * MB, WS_H1 = 84 * MB, WS_PROJ = 118 * MB,
                 WS_WI = 270 * MB, WS_SEL = 271 * MB, WS_OATT = 288 * MB, WS_OCONV = 305 * MB, WS_MERGED = 322 * MB, WS_T1 = 355 * MB,
                 WS_H2 = 420 * MB, WS_QP = 453 * MB, WS_EIDX = 486 * MB, WS_GW = 495 * MB, WS_SS = 504 * MB, WS_SE = 513 * MB, WS_SG = 523 * MB, WS_END = 533 * MB;
constexpr int CTL_ZERO_BYTES = 65536;

constexpr int NTHREADS = 512;
constexpr int LDS_BYTES = 160 * 1024 - 512;
constexpr int LDS_MISC = LDS_BYTES - 64;

__device__ __forceinline__ float bf2f(bf16_t b) { return __uint_as_float(((unsigned)b) << 16); }
__device__ __forceinline__ float bflo(unsigned p) { return __uint_as_float(p << 16); }
__device__ __forceinline__ float bfhi(unsigned p) { return __uint_as_float(p & 0xFFFF0000u); }
typedef __bf16 bf16x2_t __attribute__((ext_vector_type(2)));
typedef float f32x2_t __attribute__((ext_vector_type(2)));
__device__ __forceinline__ unsigned cvt_pk_bf16(float lo, float hi) { const f32x2_t f = {lo, hi}; const bf16x2_t b = __builtin_convertvector(f, bf16x2_t); unsigned r; __builtin_memcpy(&r, &b, 4); return r; }
__device__ __forceinline__ bf16_t f2bf(float f) { return (bf16_t)(cvt_pk_bf16(f, 0.f) & 0xFFFFu); }
__device__ __forceinline__ float wave_sum(float v) {
#pragma unroll
    for (int o = 32; o >= 1; o >>= 1) v += __shfl_xor(v, o);
    return v;
}
__device__ __forceinline__ float wave_sum_dpp(float v) {
    int x;
    x = __builtin_amdgcn_update_dpp(0, __float_as_int(v), 0xB1, 0xF, 0xF, false);  v += __int_as_float(x);
    x = __builtin_amdgcn_update_dpp(0, __float_as_int(v), 0x4E, 0xF, 0xF, false);  v += __int_as_float(x);
    x = __builtin_amdgcn_update_dpp(0, __float_as_int(v), 0x141, 0xF, 0xF, false); v += __int_as_float(x);
    x = __builtin_amdgcn_update_dpp(0, __float_as_int(v), 0x140, 0xF, 0xF, false); v += __int_as_float(x);
    x = __builtin_amdgcn_update_dpp(0, __float_as_int(v), 0x142, 0xA, 0xF, false); v += __int_as_float(x);
    x = __builtin_amdgcn_update_dpp(0, __float_as_int(v), 0x143, 0xC, 0xF, false); v += __int_as_float(x);
    return __int_as_float(__builtin_amdgcn_readlane(__float_as_int(v), 63));
}
__device__ __forceinline__ float wave_max(float v) {
#pragma unroll
    for (int o = 32; o >= 1; o >>= 1) v = fmaxf(v, __shfl_xor(v, o));
    return v;
}
__device__ __forceinline__ float sigmoidf_(float x) { return 1.f / (1.f + __expf(-x)); }
__device__ __forceinline__ float gelu_tanh(float a) {
    const float z = 0.7978845608028654f * (a + 0.044715f * a * a * a);
    const float e = __expf(2.f * z);
    const float t = 1.f - 2.f * __builtin_amdgcn_rcpf(e + 1.f);
    return 0.5f * a * (1.f + t);
}
__device__ __forceinline__ unsigned f2ord(float f) { const unsigned u = __float_as_uint(f); return (u & 0x80000000u) ? ~u : (u | 0x80000000u); }
__device__ __forceinline__ int t5_bucket(int n) {
    if (n < 16) return n;
    int b = 16;
    b += (n >= 19) + (n >= 21) + (n >= 24) + (n >= 27) + (n >= 31) + (n >= 35) + (n >= 40) + (n >= 46) + (n >= 52) + (n >= 59) + (n >= 67) + (n >= 77) + (n >= 87) + (n >= 99) + (n >= 113);
    return b;
}

#define XB_TMO      128
#define XB_XCNT(j)  (256  + 64 * (j))
#define XB_XSUB(j)  (1280 + 64 * (j))
#define XB_XGEN(j)  (2304 + 64 * (j))
#define XB_TOP      3328
#define XB_TOPGEN   3392
#define XCD_BAR_WORDS 3456
#define XB_SPIN_CAP (1u << 18)
__device__ __forceinline__ unsigned xb_ld(unsigned* p)              { return __hip_atomic_load(p, __ATOMIC_RELAXED, __HIP_MEMORY_SCOPE_AGENT); }
__device__ __forceinline__ unsigned xb_add(unsigned* p, unsigned v) { return __hip_atomic_fetch_add(p, v, __ATOMIC_RELAXED, __HIP_MEMORY_SCOPE_AGENT); }
__device__ __forceinline__ unsigned xb_xcc_id() { return (unsigned)__builtin_amdgcn_s_getreg((3 << 11) | 20) & 0xFu; }
#define XB_SPIN(cond, bar) do { unsigned _sp = 0; while (cond) { __builtin_amdgcn_s_sleep(1); \
    if ((++_sp & 255u) == 0u) { if (xb_ld(&(bar)[XB_TMO])) break; if (_sp > XB_SPIN_CAP) { atomicAdd(&(bar)[XB_TMO], 1u); break; } } } } while (0)
struct XcdBarrier { unsigned* bar; unsigned x; volatile LAS unsigned* st; };
__device__ __forceinline__ XcdBarrier xcd_barrier_post(unsigned* bar, volatile LAS unsigned* st) {
    XcdBarrier b; b.bar = bar; b.x = xb_xcc_id(); b.st = st;
    if (threadIdx.x == 0) (void)xb_add(&bar[XB_XCNT(b.x)], 1u);
    return b;
}
__device__ __forceinline__ void xcd_barrier_complete(unsigned* bar, unsigned x, unsigned& nloc, unsigned& nx) {
    const unsigned G = gridDim.x * gridDim.y * gridDim.z;
    unsigned sum, cnt, mine, sp = 0u;
    for (;;) {
        sum = 0u; cnt = 0u; mine = 0u;
#pragma unroll
        for (unsigned j = 0; j < 16; ++j) { const unsigned c = xb_ld(&bar[XB_XCNT(j)]); sum += c; cnt += (c > 0u) ? 1u : 0u; mine = (j == x) ? c : mine; }
        if (sum == G) break;
        __builtin_amdgcn_s_sleep(1);
        if ((++sp & 255u) == 0u) { if (xb_ld(&bar[XB_TMO])) break; if (sp > XB_SPIN_CAP) { atomicAdd(&bar[XB_TMO], 1u); break; } }
    }
    nloc = mine > 0u ? mine : 1u; nx = cnt > 0u ? cnt : 1u;
}
__device__ __forceinline__ void xcd_barrier(const XcdBarrier& b) {
    asm volatile("s_waitcnt vmcnt(0)" ::: "memory");
    __syncthreads();
    if (threadIdx.x == 0) {
        unsigned* bar = b.bar;
        __builtin_amdgcn_s_waitcnt(0);
        unsigned nloc = b.st[0], nx = b.st[1];
        if (nloc == 0u) { xcd_barrier_complete(bar, b.x, nloc, nx); b.st[0] = nloc; b.st[1] = nx; }
        const unsigned old = xb_add(&bar[XB_XSUB(b.x)], 1u);
        const unsigned gen = old / nloc;
        if (old + 1u == (gen + 1u) * nloc) {
            __builtin_amdgcn_fence(__ATOMIC_RELEASE, "agent");
            asm volatile("s_waitcnt vmcnt(0)" ::: "memory");
            const unsigned og = xb_add(&bar[XB_TOP], 1u);
            const unsigned tg = og / nx;
            if (og + 1u == (tg + 1u) * nx) xb_add(&bar[XB_TOPGEN], 1u);
            else XB_SPIN(xb_ld(&bar[XB_TOPGEN]) == tg, bar);
            __builtin_amdgcn_fence(__ATOMIC_ACQUIRE, "agent");
            xb_add(&bar[XB_XGEN(b.x)], 1u);
            asm volatile("s_waitcnt vmcnt(0)" ::: "memory");
        } else {
            XB_SPIN(xb_ld(&bar[XB_XGEN(b.x)]) == gen, bar);
            __builtin_amdgcn_fence(__ATOMIC_ACQUIRE, "agent");
            asm volatile("s_waitcnt vmcnt(0)" ::: "memory");
        }
    }
    __syncthreads();
}

struct Args { const void* in[27]; float* out; unsigned char* ws; int ph_lo, ph_hi; };
struct Core { LAS unsigned char* lds; int tid, lane, wave, G, bid; };
struct Frame {
    LAS unsigned char* lds;
    int tid, lane, wave, G, bid;
    const float *x_p, *x_s, *c_p, *c_s, *cache_k, *cache_v, *cache_ki, *state_conv, *rel_bias, *w_ada, *b_ada, *w_in, *conv_w, *conv_b,
                *w_o_attn, *w_o_conv, *w_out, *ln1_g, *ln1_b, *ln2_g, *ln2_b, *peer_wq, *peer_k1, *peer_k2, *peer_u, *peer_v;
    const int* page_table;
    float* out; unsigned char* ws;
    float* MOD; bf16_t *WIN, *WOA, *WOC, *WOUT, *WQ, *K1, *K2, *PU, *PV, *H1, *PROJ, *OATT, *OCONV, *MERGED, *H2, *QP;
    float *WI, *T1, *GW; int *SEL, *EIDX;
};
constexpr int LDS_PTAB = LDS_BYTES - 512;
__device__ __forceinline__ unsigned char* ldptr(const Core& C, int k) {
    LAS const unsigned* p = (LAS const unsigned*)(C.lds + LDS_PTAB) + 2 * k;
    const unsigned lo = __builtin_amdgcn_readfirstlane(p[0]), hi = __builtin_amdgcn_readfirstlane(p[1]);
    return (unsigned char*)(((unsigned long long)hi << 32) | (unsigned long long)lo);
}
__device__ __forceinline__ void load_frame(Frame& F, const Core& C) {
    F.lds = C.lds; F.tid = C.tid; F.lane = C.lane; F.wave = C.wave; F.G = C.G; F.bid = C.bid;
    F.x_p = (const float*)ldptr(C, 0); F.x_s = (const float*)ldptr(C, 1); F.c_p = (const float*)ldptr(C, 2); F.c_s = (const float*)ldptr(C, 3);
    F.cache_k = (const float*)ldptr(C, 4); F.cache_v = (const float*)ldptr(C, 5); F.cache_ki = (const float*)ldptr(C, 6); F.state_conv = (const float*)ldptr(C, 7);
    F.page_table = (const int*)ldptr(C, 8); F.rel_bias = (const float*)ldptr(C, 9); F.w_ada = (const float*)ldptr(C, 10); F.b_ada = (const float*)ldptr(C, 11);
    F.w_in = (const float*)ldptr(C, 12); F.conv_w = (const float*)ldptr(C, 13); F.conv_b = (const float*)ldptr(C, 14); F.w_o_attn = (const float*)ldptr(C, 15);
    F.w_o_conv = (const float*)ldptr(C, 16); F.w_out = (const float*)ldptr(C, 17); F.ln1_g = (const float*)ldptr(C, 18); F.ln1_b = (const float*)ldptr(C, 19);
    F.ln2_g = (const float*)ldptr(C, 20); F.ln2_b = (const float*)ldptr(C, 21); F.peer_wq = (const float*)ldptr(C, 22); F.peer_k1 = (const float*)ldptr(C, 23);
    F.peer_k2 = (const float*)ldptr(C, 24); F.peer_u = (const float*)ldptr(C, 25); F.peer_v = (const float*)ldptr(C, 26);
    F.out = (float*)ldptr(C, 27);
    unsigned char* ws = ldptr(C, 28);
    F.MOD = (float*)(ws + WS_MOD); F.WIN = (bf16_t*)(ws + WS_WIN); F.WOA = (bf16_t*)(ws + WS_WOA); F.WOC = (bf16_t*)(ws + WS_WOC);
    F.WOUT = (bf16_t*)(ws + WS_WOUT); F.WQ = (bf16_t*)(ws + WS_WQ); F.K1 = (bf16_t*)(ws + WS_K1); F.K2 = (bf16_t*)(ws + WS_K2);
    F.PU = (bf16_t*)(ws + WS_PU); F.PV = (bf16_t*)(ws + WS_PV); F.H1 = (bf16_t*)(ws + WS_H1); F.PROJ = (bf16_t*)(ws + WS_PROJ);
    F.WI = (float*)(ws + WS_WI); F.SEL = (int*)(ws + WS_SEL); F.OATT = (bf16_t*)(ws + WS_OATT); F.OCONV = (bf16_t*)(ws + WS_OCONV);
    F.MERGED = (bf16_t*)(ws + WS_MERGED); F.T1 = (float*)(ws + WS_T1); F.H2 = (bf16_t*)(ws + WS_H2); F.QP = (bf16_t*)(ws + WS_QP);
    F.EIDX = (int*)(ws + WS_EIDX); F.GW = (float*)(ws + WS_GW);
}
__device__ __forceinline__ const float* x_row(const Frame& F, int m) { return m < NTP ? F.x_p + (size_t)m * D : F.x_s + (size_t)(m - NTP) * D; }
__device__ __forceinline__ int mod_row(int m) { return m < NTP ? (m >> 11) : NB_P + ((m - NTP) >> 3); }

constexpr int P0_MOD_ITEMS = 96;
constexpr int P0_T_WIN = 16 * 74, P0_T_WOA = 8 * 16, P0_T_WOC = 8 * 16, P0_T_WOUT = 16 * 16, P0_T_WQ = 16 * 16;
constexpr int P0_T_ITEMS = P0_T_WIN + P0_T_WOA + P0_T_WOC + P0_T_WOUT + P0_T_WQ;
constexpr int P0_CVT_ITEMS = 2 * (16384 * 1024 / 8192);
constexpr int P0_MISC_ITEMS = 1;
constexpr int P0_ITEMS = P0_MOD_ITEMS + P0_T_ITEMS + P0_CVT_ITEMS + P0_MISC_ITEMS;

__device__ __forceinline__ void p0_mod_item(const Frame& F, int ng) {
    LAS float* cs = (LAS float*)F.lds;
    LAS float* red = (LAS float*)(F.lds + 40 * 256 * 4);
    float acc[40];
#pragma unroll
    for (int r = 0; r < 40; ++r) acc[r] = 0.f;
    const int n = ng * 64 + F.lane;
    for (int kc = 0; kc < 4; ++kc) {
        __syncthreads();
        for (int e = F.tid; e < 40 * 256; e += NTHREADS) { const int r = e >> 8, k = e & 255; cs[e] = (r < 8) ? F.c_p[r * D + kc * 256 + k] : F.c_s[(r - 8) * D + kc * 256 + k]; }
        __syncthreads();
        for (int kk = 0; kk < 32; ++kk) {
            const int kl = F.wave * 32 + kk;
            const float wv = F.w_ada[(size_t)(kc * 256 + kl) * 6144 + n];
#pragma unroll
            for (int r = 0; r < 40; ++r) acc[r] += cs[r * 256 + kl] * wv;
        }
    }
#pragma unroll
    for (int r = 0; r < 40; ++r) red[(F.wave * 40 + r) * 64 + F.lane] = acc[r];
    __syncthreads();
    for (int e = F.tid; e < 40 * 64; e += NTHREADS) {
        const int r = e >> 6, l = e & 63; float s = F.b_ada[ng * 64 + l];
#pragma unroll
        for (int w = 0; w < 8; ++w) s += red[(w * 40 + r) * 64 + l];
        F.MOD[r * 6144 + ng * 64 + l] = s;
    }
    __syncthreads();
}
__device__ __forceinline__ void p0_transpose_tile(const Frame& F, const float* W, int N, int K, bf16_t* Wt, int kt, int nt, bool permute) {
    LAS bf16_t* tile = (LAS bf16_t*)F.lds;
    __syncthreads();
    { const int k = F.tid >> 3, c0 = (F.tid & 7) * 8;
#pragma unroll
      for (int j = 0; j < 8; ++j) { const int n = nt * 64 + c0 + j; const float v = (n < N) ? W[(size_t)(kt * 64 + k) * N + n] : 0.f; tile[k * 66 + c0 + j] = f2bf(v); } }
    __syncthreads();
    { const int nl = F.tid >> 3, k0 = (F.tid & 7) * 8; const int n = nt * 64 + nl;
      if (n < N) {
          int nd = n; if (permute) nd = (n < 1024) ? n : (n < 1028 ? C_WI + (n - 1024) : n - 4);
          unsigned p[4];
#pragma unroll
          for (int j = 0; j < 4; ++j) p[j] = (unsigned)tile[(k0 + 2 * j) * 66 + nl] | ((unsigned)tile[(k0 + 2 * j + 1) * 66 + nl] << 16);
          *(u32x4*)(Wt + (size_t)nd * K + kt * 64 + k0) = (u32x4){p[0], p[1], p[2], p[3]};
      } }
}
__device__ __forceinline__ void p0_prologue(const Frame& F) {
    for (int it = F.bid; it < P0_ITEMS; it += F.G) {
        int i = it;
        if (i < P0_MOD_ITEMS) { p0_mod_item(F, i); continue; }
        i -= P0_MOD_ITEMS;
        if (i < P0_T_ITEMS) {
            if (i < P0_T_WIN) { p0_transpose_tile(F, F.w_in, NMIX, D, F.WIN, i / 74, i % 74, true); continue; }
            i -= P0_T_WIN;
            if (i < P0_T_WOA) { p0_transpose_tile(F, F.w_o_attn, D, 512, F.WOA, i / 16, i % 16, false); continue; }
            i -= P0_T_WOA;
            if (i < P0_T_WOC) { p0_transpose_tile(F, F.w_o_conv, D, 512, F.WOC, i / 16, i % 16, false); continue; }
            i -= P0_T_WOC;
            if (i < P0_T_WOUT) { p0_transpose_tile(F, F.w_out, D, D, F.WOUT, i / 16, i % 16, false); continue; }
            i -= P0_T_WOUT;
            p0_transpose_tile(F, F.peer_wq, D, D, F.WQ, i / 16, i % 16, false); continue;
        }
        i -= P0_T_ITEMS;
        if (i < P0_CVT_ITEMS) {
            const float* src = (i < 2048) ? F.peer_u : F.peer_v; bf16_t* dst = (i < 2048) ? F.PU : F.PV;
            const size_t base = (size_t)(i & 2047) * 8192 + (size_t)F.tid * 16;
            const f32x4 a = *(const f32x4*)(src + base), b = *(const f32x4*)(src + base + 4), c = *(const f32x4*)(src + base + 8), d = *(const f32x4*)(src + base + 12);
            *(u32x4*)(dst + base) = (u32x4){cvt_pk_bf16(a[0], a[1]), cvt_pk_bf16(a[2], a[3]), cvt_pk_bf16(b[0], b[1]), cvt_pk_bf16(b[2], b[3])};
            *(u32x4*)(dst + base + 8) = (u32x4){cvt_pk_bf16(c[0], c[1]), cvt_pk_bf16(c[2], c[3]), cvt_pk_bf16(d[0], d[1]), cvt_pk_bf16(d[2], d[3])};
            continue;
        }
        for (int e = F.tid; e < (NMIXP - NMIX) * D; e += NTHREADS) F.WIN[(size_t)NMIX * D + e] = 0;
        for (int e = F.tid; e < 128 * 64; e += NTHREADS) { F.K1[e] = f2bf(F.peer_k1[e]); F.K2[e] = f2bf(F.peer_k2[e]); }
    }
}

__device__ __forceinline__ void p1_modulate(const Frame& F) {
    for (int m = F.bid * 8 + F.wave; m < NT; m += F.G * 8) {
        const float* xr = x_row(F, m); const float* mr = F.MOD + (size_t)mod_row(m) * 6144;
#pragma unroll
        for (int hlf = 0; hlf < 2; ++hlf) {
            const int e = hlf * 512 + F.lane * 8;
            const f32x4 x0 = *(const f32x4*)(xr + e), x1 = *(const f32x4*)(xr + e + 4);
            const f32x4 s0 = *(const f32x4*)(mr + 1024 + e), s1 = *(const f32x4*)(mr + 1024 + e + 4);
            const f32x4 h0 = *(const f32x4*)(mr + e), h1 = *(const f32x4*)(mr + e + 4);
            const f32x4 a = x0 * (s0 + 1.f) + h0, b = x1 * (s1 + 1.f) + h1;
            *(u32x4*)(F.H1 + (size_t)m * D + e) = (u32x4){cvt_pk_bf16(a[0], a[1]), cvt_pk_bf16(a[2], a[3]), cvt_pk_bf16(b[0], b[1]), cvt_pk_bf16(b[2], b[3])};
        }
    }
}

constexpr int BM = 256, BN = 128, BK = 64;
constexpr int XPANEL = BM * 32 + 32, WPANEL = BN * 32 + 32;
constexpr int XSTAGE = 4 * XPANEL, WSTAGE = 4 * WPANEL, GSTAGE = XSTAGE + WSTAGE;
__device__ __forceinline__ void gemm_accum(const Frame& F, f32x16 (&acc)[2][2], const bf16_t* __restrict__ X, int ldx, const bf16_t* __restrict__ W, int ldw, int K, int m0, int n0) {
    const int tid = F.tid, lane = F.lane, r = lane & 31, h = lane >> 5, wm = F.wave >> 1, wn = F.wave & 1;
    u32x4 xr[4], wr[2];
    const int nk = K / BK;
    const int crow = tid >> 3, ckc = tid & 7;
    const bf16_t* xg = X + (size_t)(m0 + crow) * ldx + ckc * 8;
    const bf16_t* wg = W + (size_t)(n0 + crow) * ldw + ckc * 8;
    const int ldso = (ckc >> 1) * 1  ;
    const int xoff = ldso * XPANEL + crow * 32 + (ckc & 1) * 16;
    const int woff = ldso * WPANEL + crow * 32 + (ckc & 1) * 16;
#pragma unroll
    for (int i = 0; i < 4; ++i) xr[i] = *(const u32x4*)(xg + (size_t)(64 * i) * ldx);
#pragma unroll
    for (int i = 0; i < 2; ++i) wr[i] = *(const u32x4*)(wg + (size_t)(64 * i) * ldw);
    __syncthreads();
    for (int kt = 0; kt < nk; ++kt) {
        LAS unsigned char* st = F.lds + (kt & 1) * GSTAGE;
#pragma unroll
        for (int i = 0; i < 4; ++i) *(LAS u32x4*)(st + xoff + i * 64 * 32) = xr[i];
#pragma unroll
        for (int i = 0; i < 2; ++i) *(LAS u32x4*)(st + XSTAGE + woff + i * 64 * 32) = wr[i];
        __syncthreads();
        if (kt + 1 < nk) {
#pragma unroll
            for (int i = 0; i < 4; ++i) xr[i] = *(const u32x4*)(xg + (size_t)(64 * i) * ldx + (kt + 1) * BK);
#pragma unroll
            for (int i = 0; i < 2; ++i) wr[i] = *(const u32x4*)(wg + (size_t)(64 * i) * ldw + (kt + 1) * BK);
        }
#pragma unroll
        for (int s = 0; s < 4; ++s) {
            bf16x8 a[2], b[2];
#pragma unroll
            for (int ni = 0; ni < 2; ++ni) a[ni] = *(LAS bf16x8*)(st + XSTAGE + s * WPANEL + (wn * 64 + ni * 32 + r) * 32 + h * 16);
#pragma unroll
            for (int mi = 0; mi < 2; ++mi) b[mi] = *(LAS bf16x8*)(st + s * XPANEL + (wm * 64 + mi * 32 + r) * 32 + h * 16);
#pragma unroll
            for (int mi = 0; mi < 2; ++mi)
#pragma unroll
                for (int ni = 0; ni < 2; ++ni) acc[mi][ni] = __builtin_amdgcn_mfma_f32_32x32x16_bf16(a[ni], b[mi], acc[mi][ni], 0, 0, 0);
        }
    }
}
#define GEMM_EPI_LOOP(...) \
    { const int r_ = F.lane & 31, h_ = F.lane >> 5, wm_ = F.wave >> 1, wn_ = F.wave & 1; \
      _Pragma("unroll") for (int mi = 0; mi < 2; ++mi) _Pragma("unroll") for (int ni = 0; ni < 2; ++ni) _Pragma("unroll") for (int g = 0; g < 4; ++g) { \
          const int m = m0 + wm_ * 64 + mi * 32 + r_; const int n = n0 + wn_ * 64 + ni * 32 + 8 * g + 4 * h_; __VA_ARGS__ } }
#define ACC4(A) ((f32x4){A[mi][ni][4 * g], A[mi][ni][4 * g + 1], A[mi][ni][4 * g + 2], A[mi][ni][4 * g + 3]})
__device__ __forceinline__ void zero_acc(f32x16 (&acc)[2][2]) {
#pragma unroll
    for (int mi = 0; mi < 2; ++mi)
#pragma unroll
        for (int ni = 0; ni < 2; ++ni)
#pragma unroll
            for (int e = 0; e < 16; ++e) acc[mi][ni][e] = 0.f;
}
__device__ __forceinline__ u32x2 pk4(const f32x4 v) { return (u32x2){cvt_pk_bf16(v[0], v[1]), cvt_pk_bf16(v[2], v[3])}; }

__device__ __forceinline__ void p2_gemm_in(const Frame& F) {
    const int ntile = (NT / BM) * (NMIXP / BN);
    for (int t = F.bid; t < ntile; t += F.G) {
        const int m0 = (t / (NMIXP / BN)) * BM, n0 = (t % (NMIXP / BN)) * BN;
        f32x16 acc[2][2]; zero_acc(acc);
        gemm_accum(F, acc, F.H1, D, F.WIN, D, D, m0, n0);
        GEMM_EPI_LOOP({
            const f32x4 v = ACC4(acc);
            *(u32x2*)(F.PROJ + (size_t)m * NMIXP + n) = pk4(v);
            if (n >= C_K && n < C_QI) {
                float* o = (n < C_V) ? (m < NTP ? F.out + O_KP + (size_t)m * 128 + (n - C_K) : F.out + O_KS + (size_t)(m - NTP) * 128 + (n - C_K))
                                     : (m < NTP ? F.out + O_VP + (size_t)m * 128 + (n - C_V) : F.out + O_VS + (size_t)(m - NTP) * 128 + (n - C_V));
                *(f32x4*)o = v;
            } else if (n >= C_KI && n < C_BG) {
                float* o = m < NTP ? F.out + O_KIP + (size_t)m * 64 + (n - C_KI) : F.out + O_KIS + (size_t)(m - NTP) * 64 + (n - C_KI);
                *(f32x4*)o = v;
            } else if (n == C_WI) {
                *(f32x4*)(F.WI + (size_t)m * 4) = v;
            }
        })
    }
}

constexpr int SROW = 2052;
__device__ __forceinline__ int wave_sum_i(int v) {
#pragma unroll
    for (int o = 32; o >= 1; o >>= 1) v += __shfl_xor(v, o);
    return v;
}
__device__ __forceinline__ void cnt_ge(int& c, unsigned u, unsigned t) { asm("v_cmp_ge_u32_e32 vcc, %1, %2\n\tv_addc_co_u32_e32 %0, vcc, 0, %0, vcc" : "+v"(c) : "v"(u), "v"(t) : "vcc"); }
__device__ __forceinline__ void cnt_gt(int& c, unsigned u, unsigned t) { asm("v_cmp_gt_u32_e32 vcc, %1, %2\n\tv_addc_co_u32_e32 %0, vcc, 0, %0, vcc" : "+v"(c) : "v"(u), "v"(t) : "vcc"); }
__device__ __forceinline__ void cnt_eq(int& c, unsigned u, unsigned t) { asm("v_cmp_eq_u32_e32 vcc, %1, %2\n\tv_addc_co_u32_e32 %0, vcc, 0, %0, vcc" : "+v"(c) : "v"(u), "v"(t) : "vcc"); }
__device__ __forceinline__ void cnt_eq_pos(int& c, unsigned u, unsigned t, int L) {
    int tmp;
    asm("v_cmp_eq_u32_e32 vcc, %2, %3\n\tv_cndmask_b32_e32 %1, %5, %4, vcc\n\tv_cmp_lt_i32_e32 vcc, 0, %1\n\tv_addc_co_u32_e32 %0, vcc, 0, %0, vcc"
        : "+v"(c), "=&v"(tmp) : "v"(u), "v"(t), "v"(L), "v"(0x80000000) : "vcc");
}
template <int NV> __device__ __forceinline__ void select_topk(const unsigned (&u)[NV], int ksel, int idx_bits, int* sel, int lane) {
    unsigned T = 0;
#pragma unroll 1
    for (int bit = 31; bit >= 0; --bit) {
        const unsigned cand = T | (1u << bit);
        int c = 0;
#pragma unroll
        for (int i = 0; i < NV; ++i) cnt_ge(c, u[i], cand);
        c = wave_sum_i(c);
        if (c >= ksel) T = cand;
    }
    int cg = 0, ce = 0;
#pragma unroll
    for (int i = 0; i < NV; ++i) { cnt_gt(cg, u[i], T); cnt_eq(ce, u[i], T); }
    const int ngt = wave_sum_i(cg), neq = wave_sum_i(ce);
    const int need = ksel - ngt;
    int Jx = 0x3FFFFFFF;
    if (need < neq) {
        int Jb = 0;
#pragma unroll 1
        for (int bit = idx_bits - 1; bit >= 0; --bit) {
            const int cand = Jb | (1 << bit);
            const int L = cand - lane;
            int c = 0;
#pragma unroll
            for (int i = 0; i < NV; ++i) cnt_eq_pos(c, u[i], T, L - 64 * i);
            c = wave_sum_i(c);
            if (c < need) Jb = cand;
        }
        Jx = Jb + 1;
    }
    const int L = Jx - lane;
    int ct = 0;
#pragma unroll
    for (int i = 0; i < NV; ++i) cnt_eq_pos(ct, u[i], T, L - 64 * i);
    int ig = cg, it = ct;
#pragma unroll
    for (int o = 1; o < 64; o <<= 1) { const int a = __shfl_up(ig, o), b2 = __shfl_up(it, o); if (lane >= o) { ig += a; it += b2; } }
    int pg = ig - cg, pt = ngt + it - ct;
    int ev = lane, Lr = L;
#pragma unroll
    for (int i = 0; i < NV; ++i) {
        if (u[i] > T) { sel[pg] = ev; ++pg; }
        else if (u[i] == T && Lr > 0) { sel[pt] = ev; ++pt; }
        asm volatile("v_add_u32 %0, 64, %0\n\tv_add_u32 %1, -64, %1" : "+v"(ev), "+v"(Lr));
    }
}

__device__ __forceinline__ void p3_index_prompt_unit(const Frame& F, int b, int qt) {
    LAS float* S = (LAS float*)F.lds;
    const int lane = F.lane, r = lane & 15, q4 = lane >> 4;
    const int q0 = qt * 16; const size_t tok0 = (size_t)b * SEQ;
    __syncthreads();
    bf16x8 A[4][2];
#pragma unroll
    for (int hh = 0; hh < 4; ++hh)
#pragma unroll
        for (int s = 0; s < 2; ++s) A[hh][s] = *(const bf16x8*)(F.PROJ + (tok0 + q0 + r) * NMIXP + C_QI + hh * 64 + s * 32 + q4 * 8);
    float wv[4][4];
#pragma unroll
    for (int g = 0; g < 4; ++g) { const f32x4 w4 = *(const f32x4*)(F.WI + (tok0 + q0 + 4 * q4 + g) * 4);
#pragma unroll
        for (int hh = 0; hh < 4; ++hh) wv[g][hh] = w4[hh] * IDX_SCALE; }
    const int nkt = qt + 1;
    for (int kt = F.wave; kt < nkt; kt += 8) {
        const int key0 = kt * 16;
        bf16x8 B[2];
#pragma unroll
        for (int s = 0; s < 2; ++s) B[s] = *(const bf16x8*)(F.PROJ + (tok0 + key0 + r) * NMIXP + C_KI + s * 32 + q4 * 8);
        float sc[4] = {0.f, 0.f, 0.f, 0.f};
#pragma unroll
        for (int hh = 0; hh < 4; ++hh) {
            f32x4 c = {0.f, 0.f, 0.f, 0.f};
            c = __builtin_amdgcn_mfma_f32_16x16x32_bf16(A[hh][0], B[0], c, 0, 0, 0);
            c = __builtin_amdgcn_mfma_f32_16x16x32_bf16(A[hh][1], B[1], c, 0, 0, 0);
#pragma unroll
            for (int g = 0; g < 4; ++g) sc[g] += fmaxf(c[g], 0.f) * wv[g][hh];
        }
#pragma unroll
        for (int g = 0; g < 4; ++g) S[(4 * q4 + g) * SROW + key0 + r] = sc[g];
    }
    __syncthreads();
    for (int rr = 0; rr < 2; ++rr) {
        const int row = F.wave * 2 + rr; const int q = q0 + row; const int nvalid = q + 1;
        int* sel = F.SEL + (tok0 + q) * NSEL;
        if (nvalid <= NSEL) {
#pragma unroll
            for (int i = 0; i < 4; ++i) { const int j = lane + 64 * i; sel[j] = (j < nvalid) ? j : -1; }
            continue;
        }
        unsigned u[32];
#pragma unroll
        for (int i = 0; i < 32; ++i) { const int j = lane + 64 * i; u[i] = (j < nvalid) ? f2ord(S[row * SROW + j]) : 0u; }
        select_topk<32>(u, NSEL, 11, sel, lane);
    }
}

__device__ __forceinline__ void p3_index_sample_unit(const Frame& F, float* SS, int b) {
    const int lane = F.lane, r = lane & 31, h = lane >> 5;
    {
        bf16x8 A[4];
        { const int q = r >> 2, hh = r & 3;
#pragma unroll
          for (int s = 0; s < 4; ++s) A[s] = *(const bf16x8*)(F.PROJ + (size_t)(NTP + b * TS + q) * NMIXP + C_QI + hh * 64 + s * 16 + h * 8); }
        float wv[4][4];
#pragma unroll
        for (int g = 0; g < 4; ++g) { const f32x4 w4 = *(const f32x4*)(F.WI + (size_t)(NTP + b * TS + 2 * g + h) * 4);
#pragma unroll
            for (int hh = 0; hh < 4; ++hh) wv[g][hh] = w4[hh] * IDX_SCALE; }
#pragma unroll 1
        for (int tl = F.wave; tl < PAST / 32; tl += 8) {
            const int key0 = tl * 32; const int page = F.page_table[b * NPAGES + (key0 >> 7)];
            const float* kr = F.cache_ki + ((size_t)page * PAGE + (key0 & 127) + r) * 64;
            f32x16 c;
#pragma unroll
            for (int e = 0; e < 16; ++e) c[e] = 0.f;
#pragma unroll
            for (int s = 0; s < 4; ++s) {
                const f32x4 lo = *(const f32x4*)(kr + s * 16 + h * 8), hi = *(const f32x4*)(kr + s * 16 + h * 8 + 4);
                const u32x4 pk = (u32x4){cvt_pk_bf16(lo[0], lo[1]), cvt_pk_bf16(lo[2], lo[3]), cvt_pk_bf16(hi[0], hi[1]), cvt_pk_bf16(hi[2], hi[3])};
                bf16x8 Bf; __builtin_memcpy(&Bf, &pk, 16);
                c = __builtin_amdgcn_mfma_f32_32x32x16_bf16(A[s], Bf, c, 0, 0, 0);
            }
#pragma unroll
            for (int g = 0; g < 4; ++g) {
                float sc = 0.f;
#pragma unroll
                for (int hh = 0; hh < 4; ++hh) sc += fmaxf(c[4 * g + hh], 0.f) * wv[g][hh];
                SS[(size_t)(b * TS + 2 * g + h) * PAST + key0 + r] = sc;
            }
        }
    }
    asm volatile("s_waitcnt vmcnt(0)" ::: "memory");
    __syncthreads();
    {
        const int q = F.wave;
        unsigned u[129];
        const float* srow = SS + (size_t)(b * TS + q) * PAST;
#pragma unroll
        for (int i = 0; i < 128; ++i) u[i] = f2ord(srow[64 * i + lane]);
        float s = 0.f;
        if (lane < TS) {
            const bf16_t* kn = F.PROJ + (size_t)(NTP + b * TS + lane) * NMIXP + C_KI;
            const bf16_t* qn = F.PROJ + (size_t)(NTP + b * TS + q) * NMIXP + C_QI;
            int vz; asm volatile("v_mov_b32 %0, 0" : "=v"(vz));
            const f32x4 w4 = *(const f32x4*)(F.WI + (size_t)(NTP + b * TS + q) * 4 + vz);
#pragma unroll 1
            for (int hh = 0; hh < 4; ++hh) {
                float d = 0.f;
#pragma unroll 4
                for (int e = 0; e < 64; ++e) d += bf2f(qn[hh * 64 + e]) * bf2f(kn[e]);
                s += fmaxf(d, 0.f) * (w4[hh] * IDX_SCALE);
            }
        }
        u[128] = (lane < TS && lane <= q) ? f2ord(s) : 0u;
        int* sel = F.SEL + (size_t)(NTP + b * TS + q) * NSEL;
        select_topk<129>(u, NSEL, 14, sel, lane);
    }
}
__device__ __forceinline__ void p3_index(const Frame& F) {
    const int nunits = NB_S + NB_P * (SEQ / 16);
    float* SS = (float*)(F.ws + WS_SS);
    for (int it = F.bid; it < nunits; it += F.G) {
        if (it < NB_S) { p3_index_sample_unit(F, SS, it); continue; }
        const int i = it - NB_S; const int b = i & 7, qt = (SEQ / 16 - 1) - (i >> 3);
        p3_index_prompt_unit(F, b, qt);
    }
}

template <bool SAMPLE> __device__ __forceinline__ void p4_attn_query(const Frame& F, int tok, int slot, int g) {
    const int lane = F.lane;
    LAS unsigned char* wl = F.lds + (slot * 2 + g) * 8192;
    LAS f32x4* Pl = (LAS f32x4*)wl; LAS int* Il = (LAS int*)(wl + 4096); LAS unsigned* Ql = (LAS unsigned*)(wl + 5120);
    LAS float* RB = (LAS float*)(F.lds + 65536);
    LAS int* BT = (LAS int*)(F.lds + 65536 + 1024);
    int b, qpos;
    if (SAMPLE) { b = (tok - NTP) >> 3; qpos = PAST + ((tok - NTP) & 7); } else { b = tok >> 11; qpos = tok & 2047; }
    { const unsigned* qsrc = (const unsigned*)(F.PROJ + (size_t)tok * NMIXP + C_Q + g * 256);
      Ql[lane] = qsrc[lane]; Ql[lane + 64] = qsrc[lane + 64]; }
    const int* selp = F.SEL + (size_t)tok * NSEL;
#pragma unroll 1
    for (int i = 0; i < 4; ++i) {
        const int sraw = selp[lane + 64 * i];
        const int s = sraw < 0 ? 0 : sraw;
        float a0 = 0.f, a1 = 0.f, a2 = 0.f, a3 = 0.f;
        if (SAMPLE) {
            const float* kr;
            if (s < PAST) { const int page = F.page_table[b * NPAGES + (s >> 7)]; kr = F.cache_k + ((size_t)page * PAGE + (s & 127)) * 128 + g * 64; }
            else kr = F.out + O_KS + (size_t)(b * TS + (s - PAST)) * 128 + g * 64;
#pragma unroll
            for (int c = 0; c < 16; ++c) {
                const f32x4 kv = *(const f32x4*)(kr + c * 4);
#pragma unroll
                for (int e = 0; e < 2; ++e) {
                    const unsigned kp = cvt_pk_bf16(kv[2 * e], kv[2 * e + 1]);
                    const float k0 = bflo(kp), k1 = bfhi(kp);
                    const unsigned q0 = Ql[0 * 32 + c * 2 + e], q1 = Ql[1 * 32 + c * 2 + e], q2 = Ql[2 * 32 + c * 2 + e], q3 = Ql[3 * 32 + c * 2 + e];
                    a0 += bflo(q0) * k0 + bfhi(q0) * k1; a1 += bflo(q1) * k0 + bfhi(q1) * k1;
                    a2 += bflo(q2) * k0 + bfhi(q2) * k1; a3 += bflo(q3) * k0 + bfhi(q3) * k1;
                }
            }
        } else {
            const bf16_t* kr = F.PROJ + ((size_t)b * SEQ + s) * NMIXP + C_K + g * 64;
#pragma unroll
            for (int c = 0; c < 8; ++c) {
                const u32x4 kv = *(const u32x4*)(kr + c * 8);
#pragma unroll
                for (int e = 0; e < 4; ++e) {
                    const float k0 = bflo(kv[e]), k1 = bfhi(kv[e]);
                    const unsigned q0 = Ql[0 * 32 + c * 4 + e], q1 = Ql[1 * 32 + c * 4 + e], q2 = Ql[2 * 32 + c * 4 + e], q3 = Ql[3 * 32 + c * 4 + e];
                    a0 += bflo(q0) * k0 + bfhi(q0) * k1; a1 += bflo(q1) * k0 + bfhi(q1) * k1;
                    a2 += bflo(q2) * k0 + bfhi(q2) * k1; a3 += bflo(q3) * k0 + bfhi(q3) * k1;
                }
            }
        }
        f32x4 L;
        if (sraw < 0) L = (f32x4){-INFINITY, -INFINITY, -INFINITY, -INFINITY};
        else {
            const int dist = qpos - s; const int bk = dist < 128 ? BT[dist] : 31;
            L = (f32x4){a0 * ATTN_SCALE + RB[bk * 8 + g * 4 + 0], a1 * ATTN_SCALE + RB[bk * 8 + g * 4 + 1], a2 * ATTN_SCALE + RB[bk * 8 + g * 4 + 2], a3 * ATTN_SCALE + RB[bk * 8 + g * 4 + 3]};
        }
        Pl[lane + 64 * i] = L; Il[lane + 64 * i] = s;
    }
    f32x4 lg[4];
#pragma unroll
    for (int i = 0; i < 4; ++i) lg[i] = Pl[lane + 64 * i];
    float inv[4];
#pragma unroll
    for (int hh = 0; hh < 4; ++hh) {
        float m = fmaxf(fmaxf(lg[0][hh], lg[1][hh]), fmaxf(lg[2][hh], lg[3][hh])); m = wave_max(m);
        float sm = 0.f;
#pragma unroll
        for (int i = 0; i < 4; ++i) { lg[i][hh] = __expf(lg[i][hh] - m); sm += lg[i][hh]; }
        sm = wave_sum(sm); inv[hh] = 1.f / sm;
    }
#pragma unroll
    for (int i = 0; i < 4; ++i) Pl[lane + 64 * i] = (f32x4){lg[i][0] * inv[0], lg[i][1] * inv[1], lg[i][2] * inv[2], lg[i][3] * inv[3]};
    const int dp = lane & 31, kh = lane >> 5;
    float o[4][2];
#pragma unroll
    for (int hh = 0; hh < 4; ++hh) o[hh][0] = o[hh][1] = 0.f;
#pragma unroll 4
    for (int jj = 0; jj < 128; ++jj) {
        const int j = jj * 2 + kh; const int s = Il[j]; const f32x4 p = Pl[j];
        float v0, v1;
        if (SAMPLE) {
            const float* vr;
            if (s < PAST) { const int page = F.page_table[b * NPAGES + (s >> 7)]; vr = F.cache_v + ((size_t)page * PAGE + (s & 127)) * 128 + g * 64; }
            else vr = F.out + O_VS + (size_t)(b * TS + (s - PAST)) * 128 + g * 64;
            const float2 vv = *(const float2*)(vr + 2 * dp); v0 = bf2f(f2bf(vv.x)); v1 = bf2f(f2bf(vv.y));
        } else {
            const unsigned vv = *(const unsigned*)(F.PROJ + ((size_t)b * SEQ + s) * NMIXP + C_V + g * 64 + 2 * dp); v0 = bflo(vv); v1 = bfhi(vv);
        }
#pragma unroll
        for (int hh = 0; hh < 4; ++hh) { o[hh][0] += p[hh] * v0; o[hh][1] += p[hh] * v1; }
    }
#pragma unroll
    for (int hh = 0; hh < 4; ++hh) { o[hh][0] += __shfl_xor(o[hh][0], 32); o[hh][1] += __shfl_xor(o[hh][1], 32); }
    if (kh == 0) {
#pragma unroll
        for (int hh = 0; hh < 4; ++hh) *(unsigned*)(F.OATT + (size_t)tok * 512 + (g * 4 + hh) * 64 + 2 * dp) = cvt_pk_bf16(o[hh][0], o[hh][1]);
    }
}
__device__ __forceinline__ void p4_attention(const Frame& F) {
    LAS float* RB = (LAS float*)(F.lds + 65536);
    __syncthreads();
    if (F.tid < 256) RB[F.tid] = F.rel_bias[F.tid];
    if (F.tid < 128) ((LAS int*)(F.lds + 65536 + 1024))[F.tid] = t5_bucket(F.tid);
    __syncthreads();
    const int slot = F.wave >> 1, g = F.wave & 1;
    for (int it = F.bid; it < NT / 4; it += F.G) {
        if (it < NTS / 4) p4_attn_query<true>(F, NTP + it * 4 + slot, slot, g);
        else p4_attn_query<false>(F, (it - NTS / 4) * 4 + slot, slot, g);
    }
    for (int m = F.bid * 8 + F.wave; m < NT; m += F.G * 8) {
        int t, T_, bsm; if (m < NTP) { t = m & 2047; T_ = SEQ; bsm = m >> 11; } else { t = (m - NTP) & 7; T_ = TS; bsm = (m - NTP) >> 3; }
        const int c0 = F.lane * 8;
        float u0[8], u1[8], u2[8];
        { const u32x4 cg = *(const u32x4*)(F.PROJ + (size_t)m * NMIXP + C_CG + c0), xi = *(const u32x4*)(F.PROJ + (size_t)m * NMIXP + C_XIN + c0);
#pragma unroll
          for (int e = 0; e < 4; ++e) { u0[2 * e] = bflo(cg[e]) * bflo(xi[e]); u0[2 * e + 1] = bfhi(cg[e]) * bfhi(xi[e]); } }
#pragma unroll
        for (int d = 1; d <= 2; ++d) {
            float* ud = (d == 1) ? u1 : u2;
            if (t - d >= 0) {
                const u32x4 cg = *(const u32x4*)(F.PROJ + (size_t)(m - d) * NMIXP + C_CG + c0), xi = *(const u32x4*)(F.PROJ + (size_t)(m - d) * NMIXP + C_XIN + c0);
#pragma unroll
                for (int e = 0; e < 4; ++e) { ud[2 * e] = bflo(cg[e]) * bflo(xi[e]); ud[2 * e + 1] = bfhi(cg[e]) * bfhi(xi[e]); }
            } else if (m >= NTP) {
                const float* pv = F.state_conv + ((size_t)bsm * 2 + (2 + t - d)) * 512 + c0;
#pragma unroll
                for (int e = 0; e < 8; ++e) ud[e] = pv[e];
            } else {
#pragma unroll
                for (int e = 0; e < 8; ++e) ud[e] = 0.f;
            }
        }
        const u32x4 bg = *(const u32x4*)(F.PROJ + (size_t)m * NMIXP + C_BG + c0);
        float y[8];
#pragma unroll
        for (int e = 0; e < 8; ++e) {
            const int c = c0 + e;
            const float yy = F.conv_b[c] + F.conv_w[c] * u2[e] + F.conv_w[512 + c] * u1[e] + F.conv_w[1024 + c] * u0[e];
            const float bgv = (e & 1) ? bfhi(bg[e >> 1]) : bflo(bg[e >> 1]);
            y[e] = bgv * yy;
        }
        *(u32x4*)(F.OCONV + (size_t)m * 512 + c0) = (u32x4){cvt_pk_bf16(y[0], y[1]), cvt_pk_bf16(y[2], y[3]), cvt_pk_bf16(y[4], y[5]), cvt_pk_bf16(y[6], y[7])};
        if (t >= T_ - 2) {
            float* o = (m < NTP ? F.out + O_CP : F.out + O_CS) + ((size_t)bsm * 2 + (t - (T_ - 2))) * 512 + c0;
            *(f32x4*)o = (f32x4){u0[0], u0[1], u0[2], u0[3]}; *(f32x4*)(o + 4) = (f32x4){u0[4], u0[5], u0[6], u0[7]};
        }
    }
}

__device__ __forceinline__ void p5_gemm_merge(const Frame& F) {
    const int ntile = (NT / BM) * (D / BN);
    for (int t = F.bid; t < ntile; t += F.G) {
        const int m0 = (t / (D / BN)) * BM, n0 = (t % (D / BN)) * BN;
        f32x16 acc[2][2], acc2[2][2]; zero_acc(acc); zero_acc(acc2);
        gemm_accum(F, acc, F.OATT, 512, F.WOA, 512, 512, m0, n0);
        gemm_accum(F, acc2, F.OCONV, 512, F.WOC, 512, 512, m0, n0);
        GEMM_EPI_LOOP({
            const f32x4 va = ACC4(acc), vc = ACC4(acc2);
            const u32x2 ga = *(const u32x2*)(F.PROJ + (size_t)m * NMIXP + C_GA + n), gb = *(const u32x2*)(F.PROJ + (size_t)m * NMIXP + C_GB + n);
            f32x4 o;
            o[0] = sigmoidf_(bflo(ga[0])) * va[0] + sigmoidf_(bflo(gb[0])) * vc[0];
            o[1] = sigmoidf_(bfhi(ga[0])) * va[1] + sigmoidf_(bfhi(gb[0])) * vc[1];
            o[2] = sigmoidf_(bflo(ga[1])) * va[2] + sigmoidf_(bflo(gb[1])) * vc[2];
            o[3] = sigmoidf_(bfhi(ga[1])) * va[3] + sigmoidf_(bfhi(gb[1])) * vc[3];
            *(u32x2*)(F.MERGED + (size_t)m * D + n) = pk4(o);
        })
    }
}
__device__ __forceinline__ void p6_gemm_out(const Frame& F) {
    const int ntile = (NT / BM) * (D / BN);
    for (int t = F.bid; t < ntile; t += F.G) {
        const int m0 = (t / (D / BN)) * BM, n0 = (t % (D / BN)) * BN;
        f32x16 acc[2][2]; zero_acc(acc);
        gemm_accum(F, acc, F.MERGED, D, F.WOUT, D, D, m0, n0);
        GEMM_EPI_LOOP({
            const f32x4 v = ACC4(acc);
            const f32x4 xv = *(const f32x4*)(x_row(F, m) + n);
            const f32x4 g1 = *(const f32x4*)(F.MOD + (size_t)mod_row(m) * 6144 + 2048 + n);
            *(f32x4*)(F.T1 + (size_t)m * D + n) = xv * DN_ALPHA + g1 * v;
        })
    }
}
__device__ __forceinline__ void p7_ln1(const Frame& F) {
    for (int m = F.bid * 8 + F.wave; m < NT; m += F.G * 8) {
        float* tr = F.T1 + (size_t)m * D; const float* mr = F.MOD + (size_t)mod_row(m) * 6144;
        f32x4 v[4]; float s = 0.f;
#pragma unroll
        for (int i = 0; i < 4; ++i) { v[i] = *(const f32x4*)(tr + (i >> 1) * 512 + F.lane * 8 + (i & 1) * 4); s += v[i][0] + v[i][1] + v[i][2] + v[i][3]; }
        const float mean = wave_sum(s) * (1.f / D);
        float q = 0.f;
#pragma unroll
        for (int i = 0; i < 4; ++i) { v[i] = v[i] - mean; q += v[i][0] * v[i][0] + v[i][1] * v[i][1] + v[i][2] * v[i][2] + v[i][3] * v[i][3]; }
        const float rstd = rsqrtf(wave_sum(q) * (1.f / D) + LN_EPS);
#pragma unroll
        for (int hlf = 0; hlf < 2; ++hlf) {
            const int e = hlf * 512 + F.lane * 8;
            f32x4 a = v[2 * hlf] * rstd * *(const f32x4*)(F.ln1_g + e) + *(const f32x4*)(F.ln1_b + e);
            f32x4 b = v[2 * hlf + 1] * rstd * *(const f32x4*)(F.ln1_g + e + 4) + *(const f32x4*)(F.ln1_b + e + 4);
            *(f32x4*)(tr + e) = a; *(f32x4*)(tr + e + 4) = b;
            const f32x4 ha = a * (*(const f32x4*)(mr + 4096 + e) + 1.f) + *(const f32x4*)(mr + 3072 + e);
            const f32x4 hb = b * (*(const f32x4*)(mr + 4096 + e + 4) + 1.f) + *(const f32x4*)(mr + 3072 + e + 4);
            *(u32x4*)(F.H2 + (size_t)m * D + e) = (u32x4){cvt_pk_bf16(ha[0], ha[1]), cvt_pk_bf16(ha[2], ha[3]), cvt_pk_bf16(hb[0], hb[1]), cvt_pk_bf16(hb[2], hb[3])};
        }
    }
}
__device__ __forceinline__ void p8_gemm_q(const Frame& F) {
    const int ntile = (NT / BM) * (D / BN);
    for (int t = F.bid; t < ntile; t += F.G) {
        const int m0 = (t / (D / BN)) * BM, n0 = (t % (D / BN)) * BN;
        f32x16 acc[2][2]; zero_acc(acc);
        gemm_accum(F, acc, F.H2, D, F.WQ, D, D, m0, n0);
        GEMM_EPI_LOOP({ *(u32x2*)(F.QP + (size_t)m * D + n) = pk4(ACC4(acc)); })
    }
}
constexpr int PR_ROW = 129;
__device__ __forceinline__ void p9_route(const Frame& F) {
    LAS float* SC = (LAS float*)F.lds;
    LAS float* TV = (LAS float*)(F.lds + 32 * 8 * PR_ROW * 4);
    LAS unsigned char* TI = (LAS unsigned char*)(F.lds + 32 * 8 * PR_ROW * 4 + 256 * 17 * 4);
    const int lane = F.lane, r = lane & 31, h = lane >> 5;
    const int nunits = (NT / 32) * 2;
    for (int it = F.bid; it < nunits; it += F.G) {
        const int tok0 = (it >> 1) * 32, hg = it & 1;
        __syncthreads();
        {
            const int head = hg * 4 + (F.wave >> 1), half = F.wave & 1;
            const bf16_t* KK = half ? F.K2 : F.K1;
            bf16x8 Bq[4];
#pragma unroll
            for (int s = 0; s < 4; ++s) Bq[s] = *(const bf16x8*)(F.QP + (size_t)(tok0 + r) * D + head * 128 + half * 64 + s * 16 + h * 8);
#pragma unroll
            for (int kt = 0; kt < 4; ++kt) {
                f32x16 c;
#pragma unroll
                for (int e = 0; e < 16; ++e) c[e] = 0.f;
#pragma unroll
                for (int s = 0; s < 4; ++s) {
                    const bf16x8 Ak = *(const bf16x8*)(KK + (size_t)(kt * 32 + r) * 64 + s * 16 + h * 8);
                    c = __builtin_amdgcn_mfma_f32_32x32x16_bf16(Ak, Bq[s], c, 0, 0, 0);
                }
#pragma unroll
                for (int e = 0; e < 16; ++e) { const int key = kt * 32 + (e & 3) + 8 * (e >> 2) + 4 * h; SC[(r * 8 + F.wave) * PR_ROW + key] = c[e]; }
            }
        }
        __syncthreads();
        if (F.tid < 256) {
            LAS float* row = SC + F.tid * PR_ROW;
            float gm[16];
#pragma unroll
            for (int gidx = 0; gidx < 16; ++gidx) {
                float m = row[gidx * 8];
#pragma unroll
                for (int k = 1; k < 8; ++k) m = fmaxf(m, row[gidx * 8 + k]);
                gm[gidx] = m;
            }
#pragma unroll 1
            for (int p = 0; p < 16; ++p) {
                float best = gm[0]; int bg = 0;
#pragma unroll
                for (int gidx = 1; gidx < 16; ++gidx) { const bool gt = gm[gidx] > best; best = gt ? gm[gidx] : best; bg = gt ? gidx : bg; }
                float v[8];
#pragma unroll
                for (int k = 0; k < 8; ++k) v[k] = row[bg * 8 + k];
                int bk = 7;
#pragma unroll
                for (int k = 6; k >= 0; --k) bk = (v[k] == best) ? k : bk;
                float nm = -INFINITY;
#pragma unroll
                for (int k = 0; k < 8; ++k) nm = fmaxf(nm, (k == bk) ? -INFINITY : v[k]);
                row[bg * 8 + bk] = -INFINITY;
#pragma unroll
                for (int gidx = 0; gidx < 16; ++gidx) gm[gidx] = (gidx == bg) ? nm : gm[gidx];
                TV[F.tid * 17 + p] = best; TI[F.tid * 17 + p] = (unsigned char)(bg * 8 + bk);
            }
        }
        __syncthreads();
        if (F.tid < 128) {
            const int tk = F.tid >> 2, hs = F.tid & 3;
            const int r1 = (tk * 8 + hs * 2) * 17, r2 = r1 + 17;
            LAS float* cand = SC + F.tid * 51;
            {
                float t1[16], t2[16];
#pragma unroll
                for (int i = 0; i < 16; ++i) { t1[i] = TV[r1 + i]; t2[i] = TV[r2 + i]; }
                int nc = 0;
#pragma unroll
                for (int i = 0; i < 16; ++i) {
#pragma unroll
                    for (int j = 0; j < 16 / (i + 1); ++j) { cand[nc] = t1[i] + t2[j]; ++nc; }
                }
            }
            float sv[16]; int se[16];
#pragma unroll
            for (int p = 0; p < 16; ++p) {
                float best = -INFINITY; int bc = 0, bij = 0, c = 0;
#pragma unroll
                for (int i = 0; i < 16; ++i) {
#pragma unroll
                    for (int j = 0; j < 16 / (i + 1); ++j) { const float v = cand[c]; const bool gt = v > best; best = gt ? v : best; bc = gt ? c : bc; bij = gt ? (i * 16 + j) : bij; ++c; }
                }
                cand[bc] = -INFINITY; sv[p] = best; se[p] = (int)TI[r1 + (bij >> 4)] * 128 + (int)TI[r2 + (bij & 15)];
            }
            const float mx0 = sv[0]; float den = 0.f;
#pragma unroll
            for (int p = 0; p < 16; ++p) { sv[p] = __expf(sv[p] - mx0); den += sv[p]; }
            const float dinv = 1.f / den;
            const int head = hg * 4 + hs;
            int* eo = F.EIDX + (size_t)(tok0 + tk) * NEXP_SEL + head * 16; float* go = F.GW + (size_t)(tok0 + tk) * NEXP_SEL + head * 16;
#pragma unroll
            for (int p = 0; p < 16; ++p) { eo[p] = se[p]; go[p] = sv[p] * dinv; }
        }
    }
}

constexpr int TPW = 65, PAIRS_MAX = 9 * 128;
typedef __bf16 bf16x2v __attribute__((ext_vector_type(2)));
__device__ __forceinline__ float dot2bf(unsigned a, unsigned b, float c) { bf16x2v x, y; __builtin_memcpy(&x, &a, 4); __builtin_memcpy(&y, &b, 4); return __builtin_amdgcn_fdot2_f32_bf16(x, y, c, false); }
struct PeerRows { u32x4 ua, ub, va, vb; };
__device__ __forceinline__ void peer_load(PeerRows& R, const Frame& F, int wv, int j, int lane) {
    const int e = __builtin_amdgcn_readlane(wv, j) & 16383;
    const bf16_t* ur = F.PU + (size_t)e * D; const bf16_t* vr = F.PV + (size_t)e * D;
    R.ua = *(const u32x4*)(ur + lane * 8); R.ub = *(const u32x4*)(ur + 512 + lane * 8);
    R.va = *(const u32x4*)(vr + lane * 8); R.vb = *(const u32x4*)(vr + 512 + lane * 8);
}
constexpr int PK = 4;
template <int K> __device__ __forceinline__ void peer_acc(float (&acc)[PK][16], const float (&vf)[16], float act, int kl) {
    const float aK = (kl == K) ? act : 0.f;
#pragma unroll
    for (int e = 0; e < 16; ++e) acc[K][e] += aK * vf[e];
}
__device__ __forceinline__ void peer_compute(float (&acc)[PK][16], const PeerRows& R, const Frame& F, int wv, int gv, int j, int lane, int kbase) {
    const int w = __builtin_amdgcn_readlane(wv, j);
    const int kk = w >> 14;
    LAS const unsigned char* hr = F.lds + (F.wave + 8 * kk) * 2048 + lane * 16;
    const u32x4 ha = *(LAS const u32x4*)hr, hb = *(LAS const u32x4*)(hr + 1024);
    float s0 = 0.f, s1 = 0.f;
#pragma unroll
    for (int e = 0; e < 4; ++e) { s0 = dot2bf(ha[e], R.ua[e], s0); s1 = dot2bf(hb[e], R.ub[e], s1); }
    const float d = wave_sum_dpp(s0 + s1);
    const float g = __int_as_float(__builtin_amdgcn_readlane(gv, j));
    const float act = gelu_tanh(d) * g;
    const int kl = kk - kbase;
    float vf[16];
#pragma unroll
    for (int e = 0; e < 4; ++e) { vf[2 * e] = bflo(R.va[e]); vf[2 * e + 1] = bfhi(R.va[e]); vf[8 + 2 * e] = bflo(R.vb[e]); vf[8 + 2 * e + 1] = bfhi(R.vb[e]); }
    peer_acc<0>(acc, vf, act, kl); peer_acc<1>(acc, vf, act, kl); peer_acc<2>(acc, vf, act, kl); peer_acc<3>(acc, vf, act, kl);
}
__device__ __forceinline__ void p10_peer(const Frame& F) {
    const int lane = F.lane, w = F.wave;
    unsigned char* ws = F.ws;
    const int tok0 = F.bid * TPW;
    if (tok0 >= NT) return;
    __syncthreads();
    for (int c = F.tid; c < TPW * 128; c += NTHREADS) *(LAS u32x4*)(F.lds + c * 16) = *(const u32x4*)(F.H2 + (size_t)tok0 * D + (size_t)c * 8);
    __syncthreads();
    LAS unsigned* hist = (LAS unsigned*)(F.lds + TPW * 2048) + w * 128;
    unsigned* SE0 = (unsigned*)(ws + WS_SE) + ((size_t)F.bid * 8 + w) * PAIRS_MAX;
    float* SG0 = (float*)(ws + WS_SG) + ((size_t)F.bid * 8 + w) * PAIRS_MAX;
    const int ntok = (w == 0) ? 9 : 8;
#pragma unroll 1
    for (int pass = 0; pass < 3; ++pass) {
        const int kbase = pass * PK, nk = (ntok - kbase < PK) ? ntok - kbase : PK, npairs = nk * 128;
        if (nk <= 0) break;
        unsigned* SE = SE0 + pass * (PK * 128); float* SG = SG0 + pass * (PK * 128);
        hist[lane] = 0u; hist[lane + 64] = 0u;
        int ex[8];
#pragma unroll
        for (int i = 0; i < 8; ++i) {
            const int p = lane + 64 * i;
            ex[i] = -1;
            if (p < npairs) { ex[i] = F.EIDX[(size_t)(tok0 + w + 8 * (kbase + (p >> 7))) * NEXP_SEL + (p & 127)]; atomicAdd((unsigned*)&hist[ex[i] >> 7], 1u); }
        }
        {
            const unsigned c0 = hist[2 * lane], c1 = hist[2 * lane + 1];
            unsigned incl = c0 + c1;
#pragma unroll
            for (int o = 1; o < 64; o <<= 1) { const unsigned t = __shfl_up(incl, o); if (lane >= o) incl += t; }
            const unsigned excl = incl - (c0 + c1);
            hist[2 * lane] = excl; hist[2 * lane + 1] = excl + c0;
        }
#pragma unroll
        for (int i = 0; i < 8; ++i) {
            const int p = lane + 64 * i;
            if (p < npairs) {
                const unsigned pos = atomicAdd((unsigned*)&hist[ex[i] >> 7], 1u);
                SE[pos] = (unsigned)ex[i] | ((unsigned)(kbase + (p >> 7)) << 14);
                SG[pos] = F.GW[(size_t)(tok0 + w + 8 * (kbase + (p >> 7))) * NEXP_SEL + (p & 127)];
            }
        }
        asm volatile("s_waitcnt vmcnt(0)" ::: "memory");
        float acc[PK][16];
#pragma unroll
        for (int k = 0; k < PK; ++k)
#pragma unroll
            for (int e = 0; e < 16; ++e) acc[k][e] = 0.f;
#pragma unroll 1
        for (int c0 = 0; c0 < npairs; c0 += 64) {
            const int wv = (int)SE[c0 + lane]; const int gv = __float_as_int(SG[c0 + lane]);
            PeerRows R0, R1, R2, R3;
            peer_load(R0, F, wv, 0, lane); peer_load(R1, F, wv, 1, lane); peer_load(R2, F, wv, 2, lane); peer_load(R3, F, wv, 3, lane);
#pragma unroll 1
            for (int j = 0; j < 64; j += 4) {
                peer_compute(acc, R0, F, wv, gv, j + 0, lane, kbase); __builtin_amdgcn_sched_barrier(0); peer_load(R0, F, wv, (j + 4) & 63, lane); __builtin_amdgcn_sched_barrier(0);
                peer_compute(acc, R1, F, wv, gv, j + 1, lane, kbase); __builtin_amdgcn_sched_barrier(0); peer_load(R1, F, wv, (j + 5) & 63, lane); __builtin_amdgcn_sched_barrier(0);
                peer_compute(acc, R2, F, wv, gv, j + 2, lane, kbase); __builtin_amdgcn_sched_barrier(0); peer_load(R2, F, wv, (j + 6) & 63, lane); __builtin_amdgcn_sched_barrier(0);
                peer_compute(acc, R3, F, wv, gv, j + 3, lane, kbase); __builtin_amdgcn_sched_barrier(0); peer_load(R3, F, wv, (j + 7) & 63, lane); __builtin_amdgcn_sched_barrier(0);
            }
        }
#pragma unroll
        for (int k = 0; k < PK; ++k) {
            if (k >= nk) continue;
            const int m = tok0 + w + 8 * (kbase + k);
            const float* x1 = F.T1 + (size_t)m * D; const float* mr = F.MOD + (size_t)mod_row(m) * 6144 + 5120;
            float tv[16]; float s = 0.f;
#pragma unroll
            for (int hlf = 0; hlf < 2; ++hlf)
#pragma unroll
                for (int c = 0; c < 2; ++c) {
                    const int e = hlf * 512 + lane * 8 + c * 4;
                    const f32x4 xv = *(const f32x4*)(x1 + e), g2 = *(const f32x4*)(mr + e);
#pragma unroll
                    for (int kx = 0; kx < 4; ++kx) { const float t = xv[kx] * DN_ALPHA + g2[kx] * acc[k][hlf * 8 + c * 4 + kx]; tv[hlf * 8 + c * 4 + kx] = t; s += t; }
                }
            const float mean = wave_sum(s) * (1.f / D);
            float q = 0.f;
#pragma unroll
            for (int e = 0; e < 16; ++e) { tv[e] -= mean; q += tv[e] * tv[e]; }
            const float rstd = rsqrtf(wave_sum(q) * (1.f / D) + LN_EPS);
            float* yo = (m < NTP) ? F.out + O_YP + (size_t)m * D : F.out + O_YS + (size_t)(m - NTP) * D;
#pragma unroll
            for (int hlf = 0; hlf < 2; ++hlf)
#pragma unroll
                for (int c = 0; c < 2; ++c) {
                    const int e = hlf * 512 + lane * 8 + c * 4;
                    const f32x4 gg = *(const f32x4*)(F.ln2_g + e), bb = *(const f32x4*)(F.ln2_b + e);
                    f32x4 o;
#pragma unroll
                    for (int kx = 0; kx < 4; ++kx) o[kx] = tv[hlf * 8 + c * 4 + kx] * rstd * gg[kx] + bb[kx];
                    *(f32x4*)(yo + e) = o;
                }
        }
    }
}

constexpr int N_PHASES = 11;
__global__ void __launch_bounds__(NTHREADS, 2) fwd_kernel(Args args) {
    extern __shared__ __attribute__((aligned(16))) unsigned char lds_raw[];
    Frame F;
    F.lds = (LAS unsigned char*)lds_raw;
    F.tid = threadIdx.x; F.lane = F.tid & 63; F.wave = __builtin_amdgcn_readfirstlane(F.tid >> 6); F.G = gridDim.x; F.bid = blockIdx.x;
    F.x_p = (const float*)args.in[0]; F.x_s = (const float*)args.in[1]; F.c_p = (const float*)args.in[2]; F.c_s = (const float*)args.in[3];
    F.cache_k = (const float*)args.in[4]; F.cache_v = (const float*)args.in[5]; F.cache_ki = (const float*)args.in[6]; F.state_conv = (const float*)args.in[7];
    F.page_table = (const int*)args.in[8]; F.rel_bias = (const float*)args.in[9]; F.w_ada = (const float*)args.in[10]; F.b_ada = (const float*)args.in[11];
    F.w_in = (const float*)args.in[12]; F.conv_w = (const float*)args.in[13]; F.conv_b = (const float*)args.in[14]; F.w_o_attn = (const float*)args.in[15];
    F.w_o_conv = (const float*)args.in[16]; F.w_out = (const float*)args.in[17]; F.ln1_g = (const float*)args.in[18]; F.ln1_b = (const float*)args.in[19];
    F.ln2_g = (const float*)args.in[20]; F.ln2_b = (const float*)args.in[21]; F.peer_wq = (const float*)args.in[22]; F.peer_k1 = (const float*)args.in[23];
    F.peer_k2 = (const float*)args.in[24]; F.peer_u = (const float*)args.in[25]; F.peer_v = (const float*)args.in[26];
    F.out = args.out;
    unsigned char* ws = args.ws; F.ws = ws;
    F.MOD = (float*)(ws + WS_MOD); F.WIN = (bf16_t*)(ws + WS_WIN); F.WOA = (bf16_t*)(ws + WS_WOA); F.WOC = (bf16_t*)(ws + WS_WOC);
    F.WOUT = (bf16_t*)(ws + WS_WOUT); F.WQ = (bf16_t*)(ws + WS_WQ); F.K1 = (bf16_t*)(ws + WS_K1); F.K2 = (bf16_t*)(ws + WS_K2);
    F.PU = (bf16_t*)(ws + WS_PU); F.PV = (bf16_t*)(ws + WS_PV); F.H1 = (bf16_t*)(ws + WS_H1); F.PROJ = (bf16_t*)(ws + WS_PROJ);
    F.WI = (float*)(ws + WS_WI); F.SEL = (int*)(ws + WS_SEL); F.OATT = (bf16_t*)(ws + WS_OATT); F.OCONV = (bf16_t*)(ws + WS_OCONV);
    F.MERGED = (bf16_t*)(ws + WS_MERGED); F.T1 = (float*)(ws + WS_T1); F.H2 = (bf16_t*)(ws + WS_H2); F.QP = (bf16_t*)(ws + WS_QP);
    F.EIDX = (int*)(ws + WS_EIDX); F.GW = (float*)(ws + WS_GW);
    volatile LAS unsigned* misc = (volatile LAS unsigned*)(F.lds + LDS_MISC);
    if (F.tid < 16) misc[F.tid] = 0u;
    __syncthreads();
    XcdBarrier bar; bar.bar = (unsigned*)(ws + WS_CTL); bar.x = 0; bar.st = misc;
    const int lo = args.ph_lo, hi = args.ph_hi;
    if (hi - lo > 1) bar = xcd_barrier_post((unsigned*)(ws + WS_CTL), misc);
#define IN(k) (lo <= (k) && (k) < hi)
#define SEAM(k) do { if (IN(k) && IN((k) + 1)) xcd_barrier(bar); } while (0)
    if (IN(0)) p0_prologue(F);       SEAM(0);
    if (IN(1)) p1_modulate(F);       SEAM(1);
    if (IN(2)) p2_gemm_in(F);        SEAM(2);
    if (IN(3)) p3_index(F);          SEAM(3);
    if (IN(4)) p4_attention(F);      SEAM(4);
    if (IN(5)) p5_gemm_merge(F);     SEAM(5);
    if (IN(6)) p6_gemm_out(F);       SEAM(6);
    if (IN(7)) p7_ln1(F);            SEAM(7);
    if (IN(8)) p8_gemm_q(F);         SEAM(8);
    if (IN(9)) p9_route(F);          SEAM(9);
    if (IN(10)) p10_peer(F);
#undef IN
#undef SEAM
}

extern "C" void kernel_launch(void* const* d_in, const int* in_sizes, int n_in, void* d_out, int out_size, void* d_ws, size_t ws_size, hipStream_t stream) {
    static int grid = 0;
    if (grid == 0) {
        if (n_in != 27 || (size_t)out_size != O_END || ws_size < WS_END) { fprintf(stderr, "kernel_launch: unexpected shapes (n_in %d out %d ws %zu)\n", n_in, out_size, ws_size); grid = -1; return; }
        int dev = 0, cus = 0;
        if (hipGetDevice(&dev) != hipSuccess || hipDeviceGetAttribute(&cus, hipDeviceAttributeMultiprocessorCount, dev) != hipSuccess) { grid = -1; return; }
        if (hipFuncSetAttribute((const void*)fwd_kernel, hipFuncAttributeMaxDynamicSharedMemorySize, LDS_BYTES) != hipSuccess) { fprintf(stderr, "kernel_launch: hipFuncSetAttribute failed\n"); grid = -1; return; }
        (void)hipGetLastError();
        grid = cus;
    }
    if (grid < 0) return;
    (void)hipMemsetAsync((char*)d_ws + WS_CTL, 0, CTL_ZERO_BYTES, stream);
    Args a{};
    for (int i = 0; i < 27; ++i) a.in[i] = d_in[i];
    a.out = (float*)d_out; a.ws = (unsigned char*)d_ws;
#if N_LAUNCHES == 1
    a.ph_lo = 0; a.ph_hi = N_PHASES;
    hipLaunchKernelGGL(fwd_kernel, dim3(grid), dim3(NTHREADS), LDS_BYTES, stream, a);
#else
    for (int p = 0; p < N_PHASES; ++p) { a.ph_lo = p; a.ph_hi = p + 1; hipLaunchKernelGGL(fwd_kernel, dim3(grid), dim3(NTHREADS), LDS_BYTES, stream, a); }
#endif
}
```

```cpp
#include <hip/hip_runtime.h>
#include <cstdio>
#include <cstdint>

#ifndef N_LAUNCHES
#define N_LAUNCHES 1
#endif

typedef unsigned short bf16_t;
typedef short bf16x8 __attribute__((ext_vector_type(8)));
typedef float f32x4 __attribute__((ext_vector_type(4)));
typedef float f32x16 __attribute__((ext_vector_type(16)));
typedef unsigned u32x4 __attribute__((ext_vector_type(4)));
typedef unsigned u32x2 __attribute__((ext_vector_type(2)));
#define LAS __attribute__((address_space(3)))

constexpr int D = 1024, NB_P = 8, SEQ = 2048, NB_S = 32, TS = 8, PAST = 8192, PAGE = 128, NPAGES = 64;
constexpr int NTP = NB_P * SEQ;
constexpr int NTS = NB_S * TS;
constexpr int NT = NTP + NTS;
constexpr int NMIX = 4676, NMIXP = 4736;
constexpr int C_Q = 0, C_K = 512, C_V = 640, C_QI = 768, C_KI = 1024, C_BG = 1088, C_CG = 1600, C_XIN = 2112, C_GA = 2624, C_GB = 3648, C_WI = 4672;
constexpr int NSEL = 256;
constexpr float ATTN_SCALE = 0.125f, IDX_SCALE = 0.0625f;
constexpr float DN_ALPHA = 1.189207115002721f, LN_EPS = 1e-5f;
constexpr int NEXP_SEL = 128;

constexpr size_t O_YP = 0, O_YS = 16777216, O_KP = 17039360, O_VP = 19136512, O_KIP = 21233664, O_CP = 22282240,
                 O_KS = 22290432, O_VS = 22323200, O_KIS = 22355968, O_CS = 22372352, O_END = 22405120;

constexpr size_t MB = 1048576;
constexpr size_t WS_CTL = 0, WS_MOD = 1 * MB, WS_WIN = 2 * MB, WS_WOA = 12 * MB, WS_WOC = 13 * MB, WS_WOUT = 14 * MB, WS_WQ = 16 * MB,
                 WS_K1 = 18 * MB, WS_K2 = 18 * MB + 65536, WS_PU = 20 * MB, WS_PV = 52 * MB, WS_H1 = 84 * MB, WS_PROJ = 118 * MB,
                 WS_WI = 270 * MB, WS_SEL = 271 * MB, WS_OATT = 288 * MB, WS_OCONV = 305 * MB, WS_MERGED = 322 * MB, WS_T1 = 355 * MB,
                 WS_H2 = 420 * MB, WS_QP = 453 * MB, WS_EIDX = 486 * MB, WS_GW = 495 * MB, WS_SS = 504 * MB, WS_SE = 513 * MB, WS_SG = 523 * MB, WS_VT = 533 * MB, WS_CGX = 538 * MB, WS_END = 539 * MB;
constexpr int CTL_ZERO_BYTES = 65536;

constexpr int NTHREADS = 512;
constexpr int LDS_BYTES = 160 * 1024 - 512;
constexpr int LDS_MISC = LDS_BYTES - 64;

__device__ __forceinline__ float bf2f(bf16_t b) { return __uint_as_float(((unsigned)b) << 16); }
__device__ __forceinline__ float bflo(unsigned p) { return __uint_as_float(p << 16); }
__device__ __forceinline__ float bfhi(unsigned p) { return __uint_as_float(p & 0xFFFF0000u); }
typedef __bf16 bf16x2_t __attribute__((ext_vector_type(2)));
typedef float f32x2_t __attribute__((ext_vector_type(2)));
__device__ __forceinline__ unsigned cvt_pk_bf16(float lo, float hi) { const f32x2_t f = {lo, hi}; const bf16x2_t b = __builtin_convertvector(f, bf16x2_t); unsigned r; __builtin_memcpy(&r, &b, 4); return r; }
__device__ __forceinline__ bf16_t f2bf(float f) { return (bf16_t)(cvt_pk_bf16(f, 0.f) & 0xFFFFu); }
__device__ __forceinline__ float wave_sum(float v) {
#pragma unroll
    for (int o = 32; o >= 1; o >>= 1) v += __shfl_xor(v, o);
    return v;
}
__device__ __forceinline__ float wave_sum_dpp(float v) {
    int x;
    x = __builtin_amdgcn_update_dpp(0, __float_as_int(v), 0xB1, 0xF, 0xF, false);  v += __int_as_float(x);
    x = __builtin_amdgcn_update_dpp(0, __float_as_int(v), 0x4E, 0xF, 0xF, false);  v += __int_as_float(x);
    x = __builtin_amdgcn_update_dpp(0, __float_as_int(v), 0x141, 0xF, 0xF, false); v += __int_as_float(x);
    x = __builtin_amdgcn_update_dpp(0, __float_as_int(v), 0x140, 0xF, 0xF, false); v += __int_as_float(x);
    x = __builtin_amdgcn_update_dpp(0, __float_as_int(v), 0x142, 0xA, 0xF, false); v += __int_as_float(x);
    x = __builtin_amdgcn_update_dpp(0, __float_as_int(v), 0x143, 0xC, 0xF, false); v += __int_as_float(x);
    return __int_as_float(__builtin_amdgcn_readlane(__float_as_int(v), 63));
}
__device__ __forceinline__ float wave_max(float v) {
#pragma unroll
    for (int o = 32; o >= 1; o >>= 1) v = fmaxf(v, __shfl_xor(v, o));
    return v;
}
__device__ __forceinline__ float sigmoidf_(float x) { return 1.f / (1.f + __expf(-x)); }
__device__ __forceinline__ float gelu_tanh(float a) {
    const float z = 0.7978845608028654f * (a + 0.044715f * a * a * a);
    const float e = __expf(2.f * z);
    const float t = 1.f - 2.f * __builtin_amdgcn_rcpf(e + 1.f);
    return 0.5f * a * (1.f + t);
}
__device__ __forceinline__ unsigned f2ord(float f) { const unsigned u = __float_as_uint(f); return (u & 0x80000000u) ? ~u : (u | 0x80000000u); }
__device__ __forceinline__ int t5_bucket(int n) {
    if (n < 16) return n;
    int b = 16;
    b += (n >= 19) + (n >= 21) + (n >= 24) + (n >= 27) + (n >= 31) + (n >= 35) + (n >= 40) + (n >= 46) + (n >= 52) + (n >= 59) + (n >= 67) + (n >= 77) + (n >= 87) + (n >= 99) + (n >= 113);
    return b;
}

#define XB_TMO      128
#define XB_XCNT(j)  (256  + 64 * (j))
#define XB_XSUB(j)  (1280 + 64 * (j))
#define XB_XGEN(j)  (2304 + 64 * (j))
#define XB_TOP      3328
#define XB_TOPGEN   3392
#define XCD_BAR_WORDS 3456
#define XB_SPIN_CAP (1u << 18)
__device__ __forceinline__ unsigned xb_ld(unsigned* p)              { return __hip_atomic_load(p, __ATOMIC_RELAXED, __HIP_MEMORY_SCOPE_AGENT); }
__device__ __forceinline__ unsigned xb_add(unsigned* p, unsigned v) { return __hip_atomic_fetch_add(p, v, __ATOMIC_RELAXED, __HIP_MEMORY_SCOPE_AGENT); }
__device__ __forceinline__ unsigned xb_xcc_id() { return (unsigned)__builtin_amdgcn_s_getreg((3 << 11) | 20) & 0xFu; }
#define XB_SPIN(cond, bar) do { unsigned _sp = 0; while (cond) { __builtin_amdgcn_s_sleep(1); \
    if ((++_sp & 255u) == 0u) { if (xb_ld(&(bar)[XB_TMO])) break; if (_sp > XB_SPIN_CAP) { atomicAdd(&(bar)[XB_TMO], 1u); break; } } } } while (0)
struct XcdBarrier { unsigned* bar; unsigned x; volatile LAS unsigned* st; };
__device__ __forceinline__ XcdBarrier xcd_barrier_post(unsigned* bar, volatile LAS unsigned* st) {
    XcdBarrier b; b.bar = bar; b.x = xb_xcc_id(); b.st = st;
    if (threadIdx.x == 0) (void)xb_add(&bar[XB_XCNT(b.x)], 1u);
    return b;
}
__device__ __forceinline__ void xcd_barrier_complete(unsigned* bar, unsigned x, unsigned& nloc, unsigned& nx) {
    const unsigned G = gridDim.x * gridDim.y * gridDim.z;
    unsigned sum, cnt, mine, sp = 0u;
    for (;;) {
        sum = 0u; cnt = 0u; mine = 0u;
#pragma unroll
        for (unsigned j = 0; j < 16; ++j) { const unsigned c = xb_ld(&bar[XB_XCNT(j)]); sum += c; cnt += (c > 0u) ? 1u : 0u; mine = (j == x) ? c : mine; }
        if (sum == G) break;
        __builtin_amdgcn_s_sleep(1);
        if ((++sp & 255u) == 0u) { if (xb_ld(&bar[XB_TMO])) break; if (sp > XB_SPIN_CAP) { atomicAdd(&bar[XB_TMO], 1u); break; } }
    }
    nloc = mine > 0u ? mine : 1u; nx = cnt > 0u ? cnt : 1u;
}
__device__ __forceinline__ void xcd_barrier(const XcdBarrier& b) {
    asm volatile("s_waitcnt vmcnt(0)" ::: "memory");
    __syncthreads();
    if (threadIdx.x == 0) {
        unsigned* bar = b.bar;
        __builtin_amdgcn_s_waitcnt(0);
        unsigned nloc = b.st[0], nx = b.st[1];
        if (nloc == 0u) { xcd_barrier_complete(bar, b.x, nloc, nx); b.st[0] = nloc; b.st[1] = nx; }
        const unsigned old = xb_add(&bar[XB_XSUB(b.x)], 1u);
        const unsigned gen = old / nloc;
        if (old + 1u == (gen + 1u) * nloc) {
            __builtin_amdgcn_fence(__ATOMIC_RELEASE, "agent");
            asm volatile("s_waitcnt vmcnt(0)" ::: "memory");
            const unsigned og = xb_add(&bar[XB_TOP], 1u);
            const unsigned tg = og / nx;
            if (og + 1u == (tg + 1u) * nx) xb_add(&bar[XB_TOPGEN], 1u);
            else XB_SPIN(xb_ld(&bar[XB_TOPGEN]) == tg, bar);
            __builtin_amdgcn_fence(__ATOMIC_ACQUIRE, "agent");
            xb_add(&bar[XB_XGEN(b.x)], 1u);
            asm volatile("s_waitcnt vmcnt(0)" ::: "memory");
        } else {
            XB_SPIN(xb_ld(&bar[XB_XGEN(b.x)]) == gen, bar);
            __builtin_amdgcn_fence(__ATOMIC_ACQUIRE, "agent");
            asm volatile("s_waitcnt vmcnt(0)" ::: "memory");
        }
    }
    __syncthreads();
}

struct Args { const void* in[27]; float* out; unsigned char* ws; int ph_lo, ph_hi; };
struct Core { LAS unsigned char* lds; int tid, lane, wave, G, bid; };
struct Frame {
    LAS unsigned char* lds;
    int tid, lane, wave, G, bid;
    const float *x_p, *x_s, *c_p, *c_s, *cache_k, *cache_v, *cache_ki, *state_conv, *rel_bias, *w_ada, *b_ada, *w_in, *conv_w, *conv_b,
                *w_o_attn, *w_o_conv, *w_out, *ln1_g, *ln1_b, *ln2_g, *ln2_b, *peer_wq, *peer_k1, *peer_k2, *peer_u, *peer_v;
    const int* page_table;
    float* out; unsigned char* ws;
    float* MOD; bf16_t *WIN, *WOA, *WOC, *WOUT, *WQ, *K1, *K2, *PU, *PV, *H1, *PROJ, *OATT, *OCONV, *MERGED, *H2, *QP;
    float *WI, *T1, *GW; int *SEL, *EIDX;
};
constexpr int LDS_PTAB = LDS_BYTES - 512;
__device__ __forceinline__ unsigned char* ldptr(const Core& C, int k) {
    LAS const unsigned* p = (LAS const unsigned*)(C.lds + LDS_PTAB) + 2 * k;
    const unsigned lo = __builtin_amdgcn_readfirstlane(p[0]), hi = __builtin_amdgcn_readfirstlane(p[1]);
    return (unsigned char*)(((unsigned long long)hi << 32) | (unsigned long long)lo);
}
__device__ __forceinline__ void load_frame(Frame& F, const Core& C) {
    F.lds = C.lds; F.tid = C.tid; F.lane = C.lane; F.wave = C.wave; F.G = C.G; F.bid = C.bid;
    F.x_p = (const float*)ldptr(C, 0); F.x_s = (const float*)ldptr(C, 1); F.c_p = (const float*)ldptr(C, 2); F.c_s = (const float*)ldptr(C, 3);
    F.cache_k = (const float*)ldptr(C, 4); F.cache_v = (const float*)ldptr(C, 5); F.cache_ki = (const float*)ldptr(C, 6); F.state_conv = (const float*)ldptr(C, 7);
    F.page_table = (const int*)ldptr(C, 8); F.rel_bias = (const float*)ldptr(C, 9); F.w_ada = (const float*)ldptr(C, 10); F.b_ada = (const float*)ldptr(C, 11);
    F.w_in = (const float*)ldptr(C, 12); F.conv_w = (const float*)ldptr(C, 13); F.conv_b = (const float*)ldptr(C, 14); F.w_o_attn = (const float*)ldptr(C, 15);
    F.w_o_conv = (const float*)ldptr(C, 16); F.w_out = (const float*)ldptr(C, 17); F.ln1_g = (const float*)ldptr(C, 18); F.ln1_b = (const float*)ldptr(C, 19);
    F.ln2_g = (const float*)ldptr(C, 20); F.ln2_b = (const float*)ldptr(C, 21); F.peer_wq = (const float*)ldptr(C, 22); F.peer_k1 = (const float*)ldptr(C, 23);
    F.peer_k2 = (const float*)ldptr(C, 24); F.peer_u = (const float*)ldptr(C, 25); F.peer_v = (const float*)ldptr(C, 26);
    F.out = (float*)ldptr(C, 27);
    unsigned char* ws = ldptr(C, 28);
    F.MOD = (float*)(ws + WS_MOD); F.WIN = (bf16_t*)(ws + WS_WIN); F.WOA = (bf16_t*)(ws + WS_WOA); F.WOC = (bf16_t*)(ws + WS_WOC);
    F.WOUT = (bf16_t*)(ws + WS_WOUT); F.WQ = (bf16_t*)(ws + WS_WQ); F.K1 = (bf16_t*)(ws + WS_K1); F.K2 = (bf16_t*)(ws + WS_K2);
    F.PU = (bf16_t*)(ws + WS_PU); F.PV = (bf16_t*)(ws + WS_PV); F.H1 = (bf16_t*)(ws + WS_H1); F.PROJ = (bf16_t*)(ws + WS_PROJ);
    F.WI = (float*)(ws + WS_WI); F.SEL = (int*)(ws + WS_SEL); F.OATT = (bf16_t*)(ws + WS_OATT); F.OCONV = (bf16_t*)(ws + WS_OCONV);
    F.MERGED = (bf16_t*)(ws + WS_MERGED); F.T1 = (float*)(ws + WS_T1); F.H2 = (bf16_t*)(ws + WS_H2); F.QP = (bf16_t*)(ws + WS_QP);
    F.EIDX = (int*)(ws + WS_EIDX); F.GW = (float*)(ws + WS_GW);
}
__device__ __forceinline__ const float* x_row(const Frame& F, int m) { return m < NTP ? F.x_p + (size_t)m * D : F.x_s + (size_t)(m - NTP) * D; }
__device__ __forceinline__ int mod_row(int m) { return m < NTP ? (m >> 11) : NB_P + ((m - NTP) >> 3); }

constexpr int P0_MOD_ITEMS = 96;
constexpr int P0_T_WIN = 16 * 74, P0_T_WOA = 8 * 16, P0_T_WOC = 8 * 16, P0_T_WOUT = 16 * 16, P0_T_WQ = 16 * 16;
constexpr int P0_T_ITEMS = P0_T_WIN + P0_T_WOA + P0_T_WOC + P0_T_WOUT + P0_T_WQ;
constexpr int P0_CVT_ITEMS = 2 * (16384 * 1024 / 8192);
constexpr int P0_MISC_ITEMS = 1;
constexpr int P0_ITEMS = P0_MOD_ITEMS + P0_T_ITEMS + P0_CVT_ITEMS + P0_MISC_ITEMS;

__device__ __forceinline__ void p0_mod_item(const Frame& F, int ng) {
    LAS float* cs = (LAS float*)F.lds;
    LAS float* red = (LAS float*)(F.lds + 40 * 256 * 4);
    float acc[40];
#pragma unroll
    for (int r = 0; r < 40; ++r) acc[r] = 0.f;
    const int n = ng * 64 + F.lane;
    for (int kc = 0; kc < 4; ++kc) {
        __syncthreads();
        for (int e = F.tid; e < 40 * 256; e += NTHREADS) { const int r = e >> 8, k = e & 255; cs[e] = (r < 8) ? F.c_p[r * D + kc * 256 + k] : F.c_s[(r - 8) * D + kc * 256 + k]; }
        __syncthreads();
        for (int kk = 0; kk < 32; ++kk) {
            const int kl = F.wave * 32 + kk;
            const float wv = F.w_ada[(size_t)(kc * 256 + kl) * 6144 + n];
#pragma unroll
            for (int r = 0; r < 40; ++r) acc[r] += cs[r * 256 + kl] * wv;
        }
    }
#pragma unroll
    for (int r = 0; r < 40; ++r) red[(F.wave * 40 + r) * 64 + F.lane] = acc[r];
    __syncthreads();
    for (int e = F.tid; e < 40 * 64; e += NTHREADS) {
        const int r = e >> 6, l = e & 63; float s = F.b_ada[ng * 64 + l];
#pragma unroll
        for (int w = 0; w < 8; ++w) s += red[(w * 40 + r) * 64 + l];
        F.MOD[r * 6144 + ng * 64 + l] = s;
    }
    __syncthreads();
}
__device__ __forceinline__ void p0_transpose_tile(const Frame& F, const float* W, int N, int K, bf16_t* Wt, int kt, int nt, bool permute) {
    LAS bf16_t* tile = (LAS bf16_t*)F.lds;
    __syncthreads();
    { const int k = F.tid >> 3, c0 = (F.tid & 7) * 8;
#pragma unroll
      for (int j = 0; j < 8; ++j) { const int n = nt * 64 + c0 + j; const float v = (n < N) ? W[(size_t)(kt * 64 + k) * N + n] : 0.f; tile[k * 66 + c0 + j] = f2bf(v); } }
    __syncthreads();
    { const int nl = F.tid >> 3, k0 = (F.tid & 7) * 8; const int n = nt * 64 + nl;
      if (n < N) {
          int nd = n; if (permute) nd = (n < 1024) ? n : (n < 1028 ? C_WI + (n - 1024) : n - 4);
          unsigned p[4];
#pragma unroll
          for (int j = 0; j < 4; ++j) p[j] = (unsigned)tile[(k0 + 2 * j) * 66 + nl] | ((unsigned)tile[(k0 + 2 * j + 1) * 66 + nl] << 16);
          *(u32x4*)(Wt + (size_t)nd * K + kt * 64 + k0) = (u32x4){p[0], p[1], p[2], p[3]};
      } }
}
__device__ __forceinline__ void p0_prologue(const Frame& F) {
    for (int it = F.bid; it < P0_ITEMS; it += F.G) {
        int i = it;
        if (i < P0_MOD_ITEMS) { p0_mod_item(F, i); continue; }
        i -= P0_MOD_ITEMS;
        if (i < P0_T_ITEMS) {
            if (i < P0_T_WIN) { p0_transpose_tile(F, F.w_in, NMIX, D, F.WIN, i / 74, i % 74, true); continue; }
            i -= P0_T_WIN;
            if (i < P0_T_WOA) { p0_transpose_tile(F, F.w_o_attn, D, 512, F.WOA, i / 16, i % 16, false); continue; }
            i -= P0_T_WOA;
            if (i < P0_T_WOC) { p0_transpose_tile(F, F.w_o_conv, D, 512, F.WOC, i / 16, i % 16, false); continue; }
            i -= P0_T_WOC;
            if (i < P0_T_WOUT) { p0_transpose_tile(F, F.w_out, D, D, F.WOUT, i / 16, i % 16, false); continue; }
            i -= P0_T_WOUT;
            p0_transpose_tile(F, F.peer_wq, D, D, F.WQ, i / 16, i % 16, false); continue;
        }
        i -= P0_T_ITEMS;
        if (i < P0_CVT_ITEMS) {
            const float* src = (i < 2048) ? F.peer_u : F.peer_v; bf16_t* dst = (i < 2048) ? F.PU : F.PV;
            const size_t base = (size_t)(i & 2047) * 8192 + (size_t)F.tid * 16;
            const f32x4 a = *(const f32x4*)(src + base), b = *(const f32x4*)(src + base + 4), c = *(const f32x4*)(src + base + 8), d = *(const f32x4*)(src + base + 12);
            *(u32x4*)(dst + base) = (u32x4){cvt_pk_bf16(a[0], a[1]), cvt_pk_bf16(a[2], a[3]), cvt_pk_bf16(b[0], b[1]), cvt_pk_bf16(b[2], b[3])};
            *(u32x4*)(dst + base + 8) = (u32x4){cvt_pk_bf16(c[0], c[1]), cvt_pk_bf16(c[2], c[3]), cvt_pk_bf16(d[0], d[1]), cvt_pk_bf16(d[2], d[3])};
            continue;
        }
        for (int e = F.tid; e < (NMIXP - NMIX) * D; e += NTHREADS) F.WIN[(size_t)NMIX * D + e] = 0;
        for (int e = F.tid; e < 128 * 64; e += NTHREADS) { F.K1[e] = f2bf(F.peer_k1[e]); F.K2[e] = f2bf(F.peer_k2[e]); }
    }
}

__device__ __forceinline__ void p1_modulate(const Frame& F) {
    for (int m = F.bid * 8 + F.wave; m < NT; m += F.G * 8) {
        const float* xr = x_row(F, m); const float* mr = F.MOD + (size_t)mod_row(m) * 6144;
#pragma unroll
        for (int hlf = 0; hlf < 2; ++hlf) {
            const int e = hlf * 512 + F.lane * 8;
            const f32x4 x0 = *(const f32x4*)(xr + e), x1 = *(const f32x4*)(xr + e + 4);
            const f32x4 s0 = *(const f32x4*)(mr + 1024 + e), s1 = *(const f32x4*)(mr + 1024 + e + 4);
            const f32x4 h0 = *(const f32x4*)(mr + e), h1 = *(const f32x4*)(mr + e + 4);
            const f32x4 a = x0 * (s0 + 1.f) + h0, b = x1 * (s1 + 1.f) + h1;
            *(u32x4*)(F.H1 + (size_t)m * D + e) = (u32x4){cvt_pk_bf16(a[0], a[1]), cvt_pk_bf16(a[2], a[3]), cvt_pk_bf16(b[0], b[1]), cvt_pk_bf16(b[2], b[3])};
        }
    }
}

constexpr int BM = 256, BN = 128, BK = 64;
constexpr int XPANEL = BM * 32 + 32, WPANEL = BN * 32 + 32;
constexpr int XSTAGE = 4 * XPANEL, WSTAGE = 4 * WPANEL, GSTAGE = XSTAGE + WSTAGE;
__device__ __forceinline__ void gemm_accum(const Frame& F, f32x16 (&acc)[2][2], const bf16_t* __restrict__ X, int ldx, const bf16_t* __restrict__ W, int ldw, int K, int m0, int n0) {
    const int tid = F.tid, lane = F.lane, r = lane & 31, h = lane >> 5, wm = F.wave >> 1, wn = F.wave & 1;
    u32x4 xr[4], wr[2];
    const int nk = K / BK;
    const int crow = tid >> 3, ckc = tid & 7;
    const bf16_t* xg = X + (size_t)(m0 + crow) * ldx + ckc * 8;
    const bf16_t* wg = W + (size_t)(n0 + crow) * ldw + ckc * 8;
    const int ldso = (ckc >> 1) * 1  ;
    const int xoff = ldso * XPANEL + crow * 32 + (ckc & 1) * 16;
    const int woff = ldso * WPANEL + crow * 32 + (ckc & 1) * 16;
#pragma unroll
    for (int i = 0; i < 4; ++i) xr[i] = *(const u32x4*)(xg + (size_t)(64 * i) * ldx);
#pragma unroll
    for (int i = 0; i < 2; ++i) wr[i] = *(const u32x4*)(wg + (size_t)(64 * i) * ldw);
    __syncthreads();
    for (int kt = 0; kt < nk; ++kt) {
        LAS unsigned char* st = F.lds + (kt & 1) * GSTAGE;
#pragma unroll
        for (int i = 0; i < 4; ++i) *(LAS u32x4*)(st + xoff + i * 64 * 32) = xr[i];
#pragma unroll
        for (int i = 0; i < 2; ++i) *(LAS u32x4*)(st + XSTAGE + woff + i * 64 * 32) = wr[i];
        __syncthreads();
        if (kt + 1 < nk) {
#pragma unroll
            for (int i = 0; i < 4; ++i) xr[i] = *(const u32x4*)(xg + (size_t)(64 * i) * ldx + (kt + 1) * BK);
#pragma unroll
            for (int i = 0; i < 2; ++i) wr[i] = *(const u32x4*)(wg + (size_t)(64 * i) * ldw + (kt + 1) * BK);
        }
#pragma unroll
        for (int s = 0; s < 4; ++s) {
            bf16x8 a[2], b[2];
#pragma unroll
            for (int ni = 0; ni < 2; ++ni) a[ni] = *(LAS bf16x8*)(st + XSTAGE + s * WPANEL + (wn * 64 + ni * 32 + r) * 32 + h * 16);
#pragma unroll
            for (int mi = 0; mi < 2; ++mi) b[mi] = *(LAS bf16x8*)(st + s * XPANEL + (wm * 64 + mi * 32 + r) * 32 + h * 16);
#pragma unroll
            for (int mi = 0; mi < 2; ++mi)
#pragma unroll
                for (int ni = 0; ni < 2; ++ni) acc[mi][ni] = __builtin_amdgcn_mfma_f32_32x32x16_bf16(a[ni], b[mi], acc[mi][ni], 0, 0, 0);
        }
    }
}
#define GEMM_EPI_LOOP(...) \
    { const int r_ = F.lane & 31, h_ = F.lane >> 5, wm_ = F.wave >> 1, wn_ = F.wave & 1; \
      _Pragma("unroll") for (int mi = 0; mi < 2; ++mi) _Pragma("unroll") for (int ni = 0; ni < 2; ++ni) _Pragma("unroll") for (int g = 0; g < 4; ++g) { \
          const int m = m0 + wm_ * 64 + mi * 32 + r_; const int n = n0 + wn_ * 64 + ni * 32 + 8 * g + 4 * h_; __VA_ARGS__ } }
#define ACC4(A) ((f32x4){A[mi][ni][4 * g], A[mi][ni][4 * g + 1], A[mi][ni][4 * g + 2], A[mi][ni][4 * g + 3]})
__device__ __forceinline__ void zero_acc(f32x16 (&acc)[2][2]) {
#pragma unroll
    for (int mi = 0; mi < 2; ++mi)
#pragma unroll
        for (int ni = 0; ni < 2; ++ni)
#pragma unroll
            for (int e = 0; e < 16; ++e) acc[mi][ni][e] = 0.f;
}
__device__ __forceinline__ u32x2 pk4(const f32x4 v) { return (u32x2){cvt_pk_bf16(v[0], v[1]), cvt_pk_bf16(v[2], v[3])}; }

__device__ __forceinline__ void p2_gemm_in(const Frame& F) {
    const int ntile = (NT / BM) * (NMIXP / BN);
    for (int t = F.bid; t < ntile; t += F.G) {
        const int m0 = (t / (NMIXP / BN)) * BM, n0 = (t % (NMIXP / BN)) * BN;
        f32x16 acc[2][2]; zero_acc(acc);
        gemm_accum(F, acc, F.H1, D, F.WIN, D, D, m0, n0);
        GEMM_EPI_LOOP({
            const f32x4 v = ACC4(acc);
            *(u32x2*)(F.PROJ + (size_t)m * NMIXP + n) = pk4(v);
            if (n >= C_K && n < C_QI) {
                float* o = (n < C_V) ? (m < NTP ? F.out + O_KP + (size_t)m * 128 + (n - C_K) : F.out + O_KS + (size_t)(m - NTP) * 128 + (n - C_K))
                                     : (m < NTP ? F.out + O_VP + (size_t)m * 128 + (n - C_V) : F.out + O_VS + (size_t)(m - NTP) * 128 + (n - C_V));
                *(f32x4*)o = v;
                if (n >= C_V && m < NTP) {
                    bf16_t* vt = (bf16_t*)(F.ws + WS_VT) + ((size_t)((m >> 11) * 2 + ((n - C_V) >> 6)) * 64 + ((n - C_V) & 63)) * SEQ + (m & 2047);
                    vt[0] = f2bf(v[0]); vt[SEQ] = f2bf(v[1]); vt[2 * SEQ] = f2bf(v[2]); vt[3 * SEQ] = f2bf(v[3]);
                }
            } else if (n >= C_KI && n < C_BG) {
                float* o = m < NTP ? F.out + O_KIP + (size_t)m * 64 + (n - C_KI) : F.out + O_KIS + (size_t)(m - NTP) * 64 + (n - C_KI);
                *(f32x4*)o = v;
            } else if (n == C_WI) {
                *(f32x4*)(F.WI + (size_t)m * 4) = v;
            } else if (n >= C_CG && n < C_GA) {
                const int tt = (m < NTP) ? (m & 2047) - (SEQ - 2) : ((m - NTP) & 7) - (TS - 2);
                if (tt >= 0) {
                    const int rowi = (m < NTP) ? (m >> 11) * 2 + tt : 2 * NB_P + ((m - NTP) >> 3) * 2 + tt;
                    *(f32x4*)((float*)(F.ws + WS_CGX) + (size_t)rowi * 1024 + (n - C_CG)) = v;
                }
            }
        })
    }
}

constexpr int SROW = 2052;
__device__ __forceinline__ int wave_sum_i(int v) {
#pragma unroll
    for (int o = 32; o >= 1; o >>= 1) v += __shfl_xor(v, o);
    return v;
}
__device__ __forceinline__ void cnt_ge(int& c, unsigned u, unsigned t) { asm("v_cmp_ge_u32_e32 vcc, %1, %2\n\tv_addc_co_u32_e32 %0, vcc, 0, %0, vcc" : "+v"(c) : "v"(u), "v"(t) : "vcc"); }
__device__ __forceinline__ void cnt_gt(int& c, unsigned u, unsigned t) { asm("v_cmp_gt_u32_e32 vcc, %1, %2\n\tv_addc_co_u32_e32 %0, vcc, 0, %0, vcc" : "+v"(c) : "v"(u), "v"(t) : "vcc"); }
__device__ __forceinline__ void cnt_eq(int& c, unsigned u, unsigned t) { asm("v_cmp_eq_u32_e32 vcc, %1, %2\n\tv_addc_co_u32_e32 %0, vcc, 0, %0, vcc" : "+v"(c) : "v"(u), "v"(t) : "vcc"); }
__device__ __forceinline__ void cnt_eq_pos(int& c, unsigned u, unsigned t, int L) {
    int tmp;
    asm("v_cmp_eq_u32_e32 vcc, %2, %3\n\tv_cndmask_b32_e32 %1, %5, %4, vcc\n\tv_cmp_lt_i32_e32 vcc, 0, %1\n\tv_addc_co_u32_e32 %0, vcc, 0, %0, vcc"
        : "+v"(c), "=&v"(tmp) : "v"(u), "v"(t), "v"(L), "v"(0x80000000) : "vcc");
}
__device__ __forceinline__ int wave_sum_i_dpp(int v) {
    v += __builtin_amdgcn_update_dpp(0, v, 0xB1, 0xF, 0xF, false);
    v += __builtin_amdgcn_update_dpp(0, v, 0x4E, 0xF, 0xF, false);
    v += __builtin_amdgcn_update_dpp(0, v, 0x141, 0xF, 0xF, false);
    v += __builtin_amdgcn_update_dpp(0, v, 0x140, 0xF, 0xF, false);
    v += __builtin_amdgcn_update_dpp(0, v, 0x142, 0xA, 0xF, false);
    v += __builtin_amdgcn_update_dpp(0, v, 0x143, 0xC, 0xF, false);
    return __builtin_amdgcn_readlane(v, 63);
}
template <int NV> __device__ __forceinline__ void select_threshold(const unsigned (&u)[NV], int ksel, int idx_bits, int lane, unsigned& T_out, int& Jx_out, int& ngt_out) {
    unsigned T = 0;
#pragma unroll 1
    for (int bit = 31; bit >= 0; --bit) {
        const unsigned cand = T | (1u << bit);
        int c = 0;
#pragma unroll
        for (int i = 0; i < NV; ++i) cnt_ge(c, u[i], cand);
        c = wave_sum_i_dpp(c);
        if (c >= ksel) T = cand;
    }
    int cg = 0, ce = 0;
#pragma unroll
    for (int i = 0; i < NV; ++i) { cnt_gt(cg, u[i], T); cnt_eq(ce, u[i], T); }
    const int ngt = wave_sum_i_dpp(cg), neq = wave_sum_i_dpp(ce);
    const int need = ksel - ngt;
    int Jx = 0x3FFFFFFF;
    if (need < neq) {
        int Jb = 0;
#pragma unroll 1
        for (int bit = idx_bits - 1; bit >= 0; --bit) {
            const int cand = Jb | (1 << bit);
            const int L = cand - lane;
            int c = 0;
#pragma unroll
            for (int i = 0; i < NV; ++i) cnt_eq_pos(c, u[i], T, L - 64 * i);
            c = wave_sum_i_dpp(c);
            if (c < need) Jb = cand;
        }
        Jx = Jb + 1;
    }
    T_out = T; Jx_out = Jx; ngt_out = ngt;
}
template <int NV> __device__ __forceinline__ void select_topk(const unsigned (&u)[NV], int ksel, int idx_bits, int* sel, int lane) {
    unsigned T; int Jx, ngt;
    select_threshold<NV>(u, ksel, idx_bits, lane, T, Jx, ngt);
    const int L = Jx - lane;
    int cg = 0, ct = 0;
#pragma unroll
    for (int i = 0; i < NV; ++i) { cnt_gt(cg, u[i], T); cnt_eq_pos(ct, u[i], T, L - 64 * i); }
    int ig = cg, it = ct;
#pragma unroll
    for (int o = 1; o < 64; o <<= 1) { const int a = __shfl_up(ig, o), b2 = __shfl_up(it, o); if (lane >= o) { ig += a; it += b2; } }
    int pg = ig - cg, pt = ngt + it - ct;
    int ev = lane, Lr = L;
#pragma unroll
    for (int i = 0; i < NV; ++i) {
        if (u[i] > T) { sel[pg] = ev; ++pg; }
        else if (u[i] == T && Lr > 0) { sel[pt] = ev; ++pt; }
        asm volatile("v_add_u32 %0, 64, %0\n\tv_add_u32 %1, -64, %1" : "+v"(ev), "+v"(Lr));
    }
}

constexpr int PU_MB = 16 * SROW * 4;
constexpr int PU_RB = PU_MB + 16 * 64 * 4;
constexpr int PU_BT = PU_RB + 1024;
__device__ __forceinline__ int kappa32(int r) { return (r & 0x13) | ((r & 4) << 1) | ((r & 8) >> 1); }
__device__ __forceinline__ void p3_prompt_fused_unit(const Frame& F, const bf16_t* VT, int b, int qt) {
    LAS float* S = (LAS float*)F.lds;
    LAS unsigned* MB = (LAS unsigned*)(F.lds + PU_MB);
    LAS float* RB = (LAS float*)(F.lds + PU_RB);
    LAS int* BT = (LAS int*)(F.lds + PU_BT);
    const int lane = F.lane;
    const int q0 = qt * 16; const size_t tok0 = (size_t)b * SEQ;
    __syncthreads();
    {
        const int r = lane & 15, q4 = lane >> 4;
        bf16x8 A[4][2];
#pragma unroll
        for (int hh = 0; hh < 4; ++hh)
#pragma unroll
            for (int s2 = 0; s2 < 2; ++s2) A[hh][s2] = *(const bf16x8*)(F.PROJ + (tok0 + q0 + r) * NMIXP + C_QI + hh * 64 + s2 * 32 + q4 * 8);
        float wv[4][4];
#pragma unroll
        for (int g = 0; g < 4; ++g) { const f32x4 w4 = *(const f32x4*)(F.WI + (tok0 + q0 + 4 * q4 + g) * 4);
#pragma unroll
            for (int hh = 0; hh < 4; ++hh) wv[g][hh] = w4[hh] * IDX_SCALE; }
        const int nkt = qt + 1;
        bf16x8 Bn[2];
        if (F.wave < nkt) {
#pragma unroll
            for (int s2 = 0; s2 < 2; ++s2) Bn[s2] = *(const bf16x8*)(F.PROJ + (tok0 + F.wave * 16 + r) * NMIXP + C_KI + s2 * 32 + q4 * 8);
        }
        for (int kt = F.wave; kt < nkt; kt += 8) {
            const int key0 = kt * 16;
            bf16x8 B[2] = {Bn[0], Bn[1]};
            if (kt + 8 < nkt) {
#pragma unroll
                for (int s2 = 0; s2 < 2; ++s2) Bn[s2] = *(const bf16x8*)(F.PROJ + (tok0 + key0 + 128 + r) * NMIXP + C_KI + s2 * 32 + q4 * 8);
            }
            float sc[4] = {0.f, 0.f, 0.f, 0.f};
#pragma unroll
            for (int hh = 0; hh < 4; ++hh) {
                f32x4 c = {0.f, 0.f, 0.f, 0.f};
                c = __builtin_amdgcn_mfma_f32_16x16x32_bf16(A[hh][0], B[0], c, 0, 0, 0);
                c = __builtin_amdgcn_mfma_f32_16x16x32_bf16(A[hh][1], B[1], c, 0, 0, 0);
#pragma unroll
                for (int g = 0; g < 4; ++g) sc[g] += fmaxf(c[g], 0.f) * wv[g][hh];
            }
#pragma unroll
            for (int g = 0; g < 4; ++g) S[(4 * q4 + g) * SROW + key0 + r] = sc[g];
        }
    }
    __syncthreads();
#pragma unroll 1
    for (int rr = 0; rr < 2; ++rr) {
        const int row = F.wave * 2 + rr; const int q = q0 + row; const int nvalid = q + 1;
        if (nvalid <= NSEL) {
#pragma unroll
            for (int i = 0; i < 32; ++i) {
                const unsigned long long m = __ballot(lane + 64 * i < nvalid);
                if (lane == 0) { MB[row * 64 + 2 * i] = (unsigned)m; MB[row * 64 + 2 * i + 1] = (unsigned)(m >> 32); }
            }
            continue;
        }
        unsigned u[32];
#pragma unroll
        for (int i = 0; i < 32; ++i) { const int j = lane + 64 * i; u[i] = (j < nvalid) ? f2ord(S[row * SROW + j]) : 0u; }
        unsigned T; int Jx, ngt;
        select_threshold<32>(u, NSEL, 11, lane, T, Jx, ngt);
        const int L = Jx - lane;
#pragma unroll
        for (int i = 0; i < 32; ++i) {
            const bool take = (u[i] > T) || (u[i] == T && (L - 64 * i) > 0);
            const unsigned long long m = __ballot(take);
            if (lane == 0) { MB[row * 64 + 2 * i] = (unsigned)m; MB[row * 64 + 2 * i + 1] = (unsigned)(m >> 32); }
        }
    }
    __syncthreads();
    {
        const int g = F.wave & 1, rt = (F.wave >> 1) & 1, kh = F.wave >> 2;
        const int c = lane & 31, h = lane >> 5;
        const int ql = rt * 8 + (c >> 2), hd = g * 4 + (c & 3);
        const int q = q0 + ql; const size_t tok = tok0 + q;
        bf16x8 Qf[4];
#pragma unroll
        for (int s4 = 0; s4 < 4; ++s4) Qf[s4] = *(const bf16x8*)(F.PROJ + tok * NMIXP + C_Q + hd * 64 + s4 * 16 + h * 8);
        const float b31 = RB[31 * 8 + hd];
        const int ntile = ((q0 + rt * 8 + 7) >> 5) + 1;
        const bf16_t* Kb = F.PROJ + (tok0 + kappa32(c)) * NMIXP + C_K + g * 64 + h * 8;
        const bf16_t* Vb = VT + ((size_t)((b * 2 + g) * 64 + c)) * SEQ + h * 8;
        f32x16 O0, O1;
#pragma unroll
        for (int e = 0; e < 16; ++e) { O0[e] = 0.f; O1[e] = 0.f; }
        float lsum = 0.f;
        bf16x8 Kn[4], Vn[2][2];
        if (kh < ntile) {
            const int key0 = kh * 32;
#pragma unroll
            for (int s4 = 0; s4 < 4; ++s4) Kn[s4] = *(const bf16x8*)(Kb + (size_t)key0 * NMIXP + s4 * 16);
#pragma unroll
            for (int d = 0; d < 2; ++d)
#pragma unroll
                for (int s2 = 0; s2 < 2; ++s2) Vn[d][s2] = *(const bf16x8*)(Vb + (size_t)(32 * d) * SEQ + key0 + 16 * s2);
        }
#pragma unroll 1
        for (int kt = kh; kt < ntile; kt += 2) {
            const int key0 = kt * 32;
            bf16x8 Kf[4] = {Kn[0], Kn[1], Kn[2], Kn[3]}, Vf[2][2] = {{Vn[0][0], Vn[0][1]}, {Vn[1][0], Vn[1][1]}};
            if (kt + 2 < ntile) {
#pragma unroll
                for (int s4 = 0; s4 < 4; ++s4) Kn[s4] = *(const bf16x8*)(Kb + (size_t)(key0 + 64) * NMIXP + s4 * 16);
#pragma unroll
                for (int d = 0; d < 2; ++d)
#pragma unroll
                    for (int s2 = 0; s2 < 2; ++s2) Vn[d][s2] = *(const bf16x8*)(Vb + (size_t)(32 * d) * SEQ + key0 + 64 + 16 * s2);
            }
            f32x16 X;
#pragma unroll
            for (int e = 0; e < 16; ++e) X[e] = 0.f;
#pragma unroll
            for (int s4 = 0; s4 < 4; ++s4) X = __builtin_amdgcn_mfma_f32_32x32x16_bf16(Kf[s4], Qf[s4], X, 0, 0, 0);
            const unsigned word = MB[ql * 64 + kt];
            const unsigned bits = ((word >> (8 * h)) & 0xFFu) | (((word >> (16 + 8 * h)) & 0xFFu) << 8);
            const bool nearT = (q0 + rt * 8) - (key0 + 31) < 113;
            float P[16];
            if (nearT) {
#pragma unroll
                for (int e = 0; e < 16; ++e) {
                    const int key = key0 + (e & 7) + 16 * (e >> 3) + 8 * h;
                    int dist = q - key; dist = dist < 0 ? 0 : (dist > 127 ? 127 : dist);
                    const float bias = RB[BT[dist] * 8 + hd];
                    const float lg = fminf(X[e] * ATTN_SCALE + bias, 60.f);
                    P[e] = ((bits >> e) & 1u) ? __expf(lg) : 0.f;
                }
            } else {
#pragma unroll
                for (int e = 0; e < 16; ++e) {
                    const float lg = fminf(X[e] * ATTN_SCALE + b31, 60.f);
                    P[e] = ((bits >> e) & 1u) ? __expf(lg) : 0.f;
                }
            }
#pragma unroll
            for (int e = 0; e < 16; ++e) lsum += P[e];
            bf16x8 Pf[2];
#pragma unroll
            for (int s2 = 0; s2 < 2; ++s2) {
                const u32x4 pk = (u32x4){cvt_pk_bf16(P[8 * s2], P[8 * s2 + 1]), cvt_pk_bf16(P[8 * s2 + 2], P[8 * s2 + 3]), cvt_pk_bf16(P[8 * s2 + 4], P[8 * s2 + 5]), cvt_pk_bf16(P[8 * s2 + 6], P[8 * s2 + 7])};
                __builtin_memcpy(&Pf[s2], &pk, 16);
            }
#pragma unroll
            for (int s2 = 0; s2 < 2; ++s2) {
                O0 = __builtin_amdgcn_mfma_f32_32x32x16_bf16(Vf[0][s2], Pf[s2], O0, 0, 0, 0);
                O1 = __builtin_amdgcn_mfma_f32_32x32x16_bf16(Vf[1][s2], Pf[s2], O1, 0, 0, 0);
            }
        }
        LAS float* CB = (LAS float*)F.lds + (F.wave & 3) * (33 * 64);
        __syncthreads();
        if (kh == 1) {
#pragma unroll
            for (int e = 0; e < 16; ++e) { CB[e * 64 + lane] = O0[e]; CB[(16 + e) * 64 + lane] = O1[e]; }
            CB[32 * 64 + lane] = lsum;
        }
        __syncthreads();
        if (kh == 0) {
#pragma unroll
            for (int e = 0; e < 16; ++e) { O0[e] += CB[e * 64 + lane]; O1[e] += CB[(16 + e) * 64 + lane]; }
            lsum += CB[32 * 64 + lane];
            lsum += __shfl_xor(lsum, 32);
            const float inv = 1.f / lsum;
            bf16_t* orow = F.OATT + tok * 512 + hd * 64;
#pragma unroll
            for (int a4 = 0; a4 < 4; ++a4) {
                const f32x4 v0 = (f32x4){O0[4 * a4], O0[4 * a4 + 1], O0[4 * a4 + 2], O0[4 * a4 + 3]} * inv;
                const f32x4 v1 = (f32x4){O1[4 * a4], O1[4 * a4 + 1], O1[4 * a4 + 2], O1[4 * a4 + 3]} * inv;
                *(u32x2*)(orow + 8 * a4 + 4 * h) = pk4(v0);
                *(u32x2*)(orow + 32 + 8 * a4 + 4 * h) = pk4(v1);
            }
        }
    }
}

__device__ __forceinline__ void p3_index_sample_unit(const Frame& F, float* SS, int b) {
    const int lane = F.lane, r = lane & 31, h = lane >> 5;
    {
        bf16x8 A[4];
        { const int q = r >> 2, hh = r & 3;
#pragma unroll
          for (int s = 0; s < 4; ++s) A[s] = *(const bf16x8*)(F.PROJ + (size_t)(NTP + b * TS + q) * NMIXP + C_QI + hh * 64 + s * 16 + h * 8); }
        float wv[4][4];
#pragma unroll
        for (int g = 0; g < 4; ++g) { const f32x4 w4 = *(const f32x4*)(F.WI + (size_t)(NTP + b * TS + 2 * g + h) * 4);
#pragma unroll
            for (int hh = 0; hh < 4; ++hh) wv[g][hh] = w4[hh] * IDX_SCALE; }
#pragma unroll 1
        for (int tl = F.wave; tl < PAST / 32; tl += 8) {
            const int key0 = tl * 32; const int page = F.page_table[b * NPAGES + (key0 >> 7)];
            const float* kr = F.cache_ki + ((size_t)page * PAGE + (key0 & 127) + r) * 64;
            f32x16 c;
#pragma unroll
            for (int e = 0; e < 16; ++e) c[e] = 0.f;
#pragma unroll
            for (int s = 0; s < 4; ++s) {
                const f32x4 lo = *(const f32x4*)(kr + s * 16 + h * 8), hi = *(const f32x4*)(kr + s * 16 + h * 8 + 4);
                const u32x4 pk = (u32x4){cvt_pk_bf16(lo[0], lo[1]), cvt_pk_bf16(lo[2], lo[3]), cvt_pk_bf16(hi[0], hi[1]), cvt_pk_bf16(hi[2], hi[3])};
                bf16x8 Bf; __builtin_memcpy(&Bf, &pk, 16);
                c = __builtin_amdgcn_mfma_f32_32x32x16_bf16(A[s], Bf, c, 0, 0, 0);
            }
#pragma unroll
            for (int g = 0; g < 4; ++g) {
                float sc = 0.f;
#pragma unroll
                for (int hh = 0; hh < 4; ++hh) sc += fmaxf(c[4 * g + hh], 0.f) * wv[g][hh];
                SS[(size_t)(b * TS + 2 * g + h) * PAST + key0 + r] = sc;
            }
        }
    }
    asm volatile("s_waitcnt vmcnt(0)" ::: "memory");
    __syncthreads();
    {
        const int q = F.wave;
        unsigned u[129];
        const float* srow = SS + (size_t)(b * TS + q) * PAST;
#pragma unroll
        for (int i = 0; i < 128; ++i) u[i] = f2ord(srow[64 * i + lane]);
        float s = 0.f;
        if (lane < TS) {
            const bf16_t* kn = F.PROJ + (size_t)(NTP + b * TS + lane) * NMIXP + C_KI;
            const bf16_t* qn = F.PROJ + (size_t)(NTP + b * TS + q) * NMIXP + C_QI;
            int vz; asm volatile("v_mov_b32 %0, 0" : "=v"(vz));
            const f32x4 w4 = *(const f32x4*)(F.WI + (size_t)(NTP + b * TS + q) * 4 + vz);
#pragma unroll 1
            for (int hh = 0; hh < 4; ++hh) {
                float d = 0.f;
#pragma unroll 4
                for (int e = 0; e < 64; ++e) d += bf2f(qn[hh * 64 + e]) * bf2f(kn[e]);
                s += fmaxf(d, 0.f) * (w4[hh] * IDX_SCALE);
            }
        }
        u[128] = (lane < TS && lane <= q) ? f2ord(s) : 0u;
        int* sel = F.SEL + (size_t)(NTP + b * TS + q) * NSEL;
        select_topk<129>(u, NSEL, 14, sel, lane);
    }
}
__device__ __forceinline__ void p3_index(const Frame& F) {
    const int nunits = NB_S + NB_P * (SEQ / 16);
    float* SS = (float*)(F.ws + WS_SS);
    const bf16_t* VT = (const bf16_t*)(F.ws + WS_VT);
    __syncthreads();
    if (F.tid < 256) ((LAS float*)(F.lds + PU_RB))[F.tid] = F.rel_bias[F.tid];
    if (F.tid < 128) ((LAS int*)(F.lds + PU_BT))[F.tid] = t5_bucket(F.tid);
    __syncthreads();
    for (int it = F.bid; it < nunits; it += F.G) {
        if (it < NB_S) { p3_index_sample_unit(F, SS, it); continue; }
        const int i = it - NB_S; const int b = i & 7, sl = (i >> 3) & 31, rnd = i >> 8;
        const int qt = rnd == 0 ? 127 - sl : (rnd == 1 ? 64 + sl : (rnd == 2 ? 63 - sl : sl));
        p3_prompt_fused_unit(F, VT, b, qt);
    }
}

template <bool SAMPLE> __device__ __forceinline__ void p4_attn_query(const Frame& F, int tok, int slot, int g) {
    const int lane = F.lane;
    LAS unsigned char* wl = F.lds + (slot * 2 + g) * 8192;
    LAS f32x4* Pl = (LAS f32x4*)wl; LAS int* Il = (LAS int*)(wl + 4096); LAS unsigned* Ql = (LAS unsigned*)(wl + 5120);
    LAS float* RB = (LAS float*)(F.lds + 65536);
    LAS int* BT = (LAS int*)(F.lds + 65536 + 1024);
    int b, qpos;
    if (SAMPLE) { b = (tok - NTP) >> 3; qpos = PAST + ((tok - NTP) & 7); } else { b = tok >> 11; qpos = tok & 2047; }
    { const unsigned* qsrc = (const unsigned*)(F.PROJ + (size_t)tok * NMIXP + C_Q + g * 256);
      Ql[lane] = qsrc[lane]; Ql[lane + 64] = qsrc[lane + 64]; }
    const int* selp = F.SEL + (size_t)tok * NSEL;
#pragma unroll 1
    for (int i = 0; i < 4; ++i) {
        const int sraw = selp[lane + 64 * i];
        const int s = sraw < 0 ? 0 : sraw;
        float a0 = 0.f, a1 = 0.f, a2 = 0.f, a3 = 0.f;
        if (SAMPLE) {
            const float* kr;
            if (s < PAST) { const int page = F.page_table[b * NPAGES + (s >> 7)]; kr = F.cache_k + ((size_t)page * PAGE + (s & 127)) * 128 + g * 64; }
            else kr = F.out + O_KS + (size_t)(b * TS + (s - PAST)) * 128 + g * 64;
#pragma unroll
            for (int c = 0; c < 16; ++c) {
                const f32x4 kv = *(const f32x4*)(kr + c * 4);
#pragma unroll
                for (int e = 0; e < 2; ++e) {
                    const unsigned kp = cvt_pk_bf16(kv[2 * e], kv[2 * e + 1]);
                    const float k0 = bflo(kp), k1 = bfhi(kp);
                    const unsigned q0 = Ql[0 * 32 + c * 2 + e], q1 = Ql[1 * 32 + c * 2 + e], q2 = Ql[2 * 32 + c * 2 + e], q3 = Ql[3 * 32 + c * 2 + e];
                    a0 += bflo(q0) * k0 + bfhi(q0) * k1; a1 += bflo(q1) * k0 + bfhi(q1) * k1;
                    a2 += bflo(q2) * k0 + bfhi(q2) * k1; a3 += bflo(q3) * k0 + bfhi(q3) * k1;
                }
            }
        } else {
            const bf16_t* kr = F.PROJ + ((size_t)b * SEQ + s) * NMIXP + C_K + g * 64;
#pragma unroll
            for (int c = 0; c < 8; ++c) {
                const u32x4 kv = *(const u32x4*)(kr + c * 8);
#pragma unroll
                for (int e = 0; e < 4; ++e) {
                    const float k0 = bflo(kv[e]), k1 = bfhi(kv[e]);
                    const unsigned q0 = Ql[0 * 32 + c * 4 + e], q1 = Ql[1 * 32 + c * 4 + e], q2 = Ql[2 * 32 + c * 4 + e], q3 = Ql[3 * 32 + c * 4 + e];
                    a0 += bflo(q0) * k0 + bfhi(q0) * k1; a1 += bflo(q1) * k0 + bfhi(q1) * k1;
                    a2 += bflo(q2) * k0 + bfhi(q2) * k1; a3 += bflo(q3) * k0 + bfhi(q3) * k1;
                }
            }
        }
        f32x4 L;
        if (sraw < 0) L = (f32x4){-INFINITY, -INFINITY, -INFINITY, -INFINITY};
        else {
            const int dist = qpos - s; const int bk = dist < 128 ? BT[dist] : 31;
            L = (f32x4){a0 * ATTN_SCALE + RB[bk * 8 + g * 4 + 0], a1 * ATTN_SCALE + RB[bk * 8 + g * 4 + 1], a2 * ATTN_SCALE + RB[bk * 8 + g * 4 + 2], a3 * ATTN_SCALE + RB[bk * 8 + g * 4 + 3]};
        }
        Pl[lane + 64 * i] = L; Il[lane + 64 * i] = s;
    }
    f32x4 lg[4];
#pragma unroll
    for (int i = 0; i < 4; ++i) lg[i] = Pl[lane + 64 * i];
    float inv[4];
#pragma unroll
    for (int hh = 0; hh < 4; ++hh) {
        float m = fmaxf(fmaxf(lg[0][hh], lg[1][hh]), fmaxf(lg[2][hh], lg[3][hh])); m = wave_max(m);
        float sm = 0.f;
#pragma unroll
        for (int i = 0; i < 4; ++i) { lg[i][hh] = __expf(lg[i][hh] - m); sm += lg[i][hh]; }
        sm = wave_sum(sm); inv[hh] = 1.f / sm;
    }
#pragma unroll
    for (int i = 0; i < 4; ++i) Pl[lane + 64 * i] = (f32x4){lg[i][0] * inv[0], lg[i][1] * inv[1], lg[i][2] * inv[2], lg[i][3] * inv[3]};
    const int dp = lane & 31, kh = lane >> 5;
    float o[4][2];
#pragma unroll
    for (int hh = 0; hh < 4; ++hh) o[hh][0] = o[hh][1] = 0.f;
#pragma unroll 4
    for (int jj = 0; jj < 128; ++jj) {
        const int j = jj * 2 + kh; const int s = Il[j]; const f32x4 p = Pl[j];
        float v0, v1;
        if (SAMPLE) {
            const float* vr;
            if (s < PAST) { const int page = F.page_table[b * NPAGES + (s >> 7)]; vr = F.cache_v + ((size_t)page * PAGE + (s & 127)) * 128 + g * 64; }
            else vr = F.out + O_VS + (size_t)(b * TS + (s - PAST)) * 128 + g * 64;
            const float2 vv = *(const float2*)(vr + 2 * dp); v0 = bf2f(f2bf(vv.x)); v1 = bf2f(f2bf(vv.y));
        } else {
            const unsigned vv = *(const unsigned*)(F.PROJ + ((size_t)b * SEQ + s) * NMIXP + C_V + g * 64 + 2 * dp); v0 = bflo(vv); v1 = bfhi(vv);
        }
#pragma unroll
        for (int hh = 0; hh < 4; ++hh) { o[hh][0] += p[hh] * v0; o[hh][1] += p[hh] * v1; }
    }
#pragma unroll
    for (int hh = 0; hh < 4; ++hh) { o[hh][0] += __shfl_xor(o[hh][0], 32); o[hh][1] += __shfl_xor(o[hh][1], 32); }
    if (kh == 0) {
#pragma unroll
        for (int hh = 0; hh < 4; ++hh) *(unsigned*)(F.OATT + (size_t)tok * 512 + (g * 4 + hh) * 64 + 2 * dp) = cvt_pk_bf16(o[hh][0], o[hh][1]);
    }
}
__device__ __forceinline__ void p4_attention(const Frame& F) {
    LAS float* RB = (LAS float*)(F.lds + 65536);
    __syncthreads();
    if (F.tid < 256) RB[F.tid] = F.rel_bias[F.tid];
    if (F.tid < 128) ((LAS int*)(F.lds + 65536 + 1024))[F.tid] = t5_bucket(F.tid);
    __syncthreads();
    const int slot = F.wave >> 1, g = F.wave & 1;
    for (int it = F.bid; it < NTS / 4; it += F.G) p4_attn_query<true>(F, NTP + it * 4 + slot, slot, g);
    for (int m = F.bid * 8 + F.wave; m < NT; m += F.G * 8) {
        int t, T_, bsm; if (m < NTP) { t = m & 2047; T_ = SEQ; bsm = m >> 11; } else { t = (m - NTP) & 7; T_ = TS; bsm = (m - NTP) >> 3; }
        const int c0 = F.lane * 8;
        float u0[8], u1[8], u2[8];
        { const u32x4 cg = *(const u32x4*)(F.PROJ + (size_t)m * NMIXP + C_CG + c0), xi = *(const u32x4*)(F.PROJ + (size_t)m * NMIXP + C_XIN + c0);
#pragma unroll
          for (int e = 0; e < 4; ++e) { u0[2 * e] = bflo(cg[e]) * bflo(xi[e]); u0[2 * e + 1] = bfhi(cg[e]) * bfhi(xi[e]); } }
#pragma unroll
        for (int d = 1; d <= 2; ++d) {
            float* ud = (d == 1) ? u1 : u2;
            if (t - d >= 0) {
                const u32x4 cg = *(const u32x4*)(F.PROJ + (size_t)(m - d) * NMIXP + C_CG + c0), xi = *(const u32x4*)(F.PROJ + (size_t)(m - d) * NMIXP + C_XIN + c0);
#pragma unroll
                for (int e = 0; e < 4; ++e) { ud[2 * e] = bflo(cg[e]) * bflo(xi[e]); ud[2 * e + 1] = bfhi(cg[e]) * bfhi(xi[e]); }
            } else if (m >= NTP) {
                const float* pv = F.state_conv + ((size_t)bsm * 2 + (2 + t - d)) * 512 + c0;
#pragma unroll
                for (int e = 0; e < 8; ++e) ud[e] = pv[e];
            } else {
#pragma unroll
                for (int e = 0; e < 8; ++e) ud[e] = 0.f;
            }
        }
        const u32x4 bg = *(const u32x4*)(F.PROJ + (size_t)m * NMIXP + C_BG + c0);
        float y[8];
#pragma unroll
        for (int e = 0; e < 8; ++e) {
            const int c = c0 + e;
            const float yy = F.conv_b[c] + F.conv_w[c] * u2[e] + F.conv_w[512 + c] * u1[e] + F.conv_w[1024 + c] * u0[e];
            const float bgv = (e & 1) ? bfhi(bg[e >> 1]) : bflo(bg[e >> 1]);
            y[e] = bgv * yy;
        }
        *(u32x4*)(F.OCONV + (size_t)m * 512 + c0) = (u32x4){cvt_pk_bf16(y[0], y[1]), cvt_pk_bf16(y[2], y[3]), cvt_pk_bf16(y[4], y[5]), cvt_pk_bf16(y[6], y[7])};
        if (t >= T_ - 2) {
            float* o = (m < NTP ? F.out + O_CP : F.out + O_CS) + ((size_t)bsm * 2 + (t - (T_ - 2))) * 512 + c0;
            const int rowi = (m < NTP) ? bsm * 2 + (t - (T_ - 2)) : 2 * NB_P + bsm * 2 + (t - (T_ - 2));
            const float* cx = (const float*)(F.ws + WS_CGX) + (size_t)rowi * 1024 + c0;
            const f32x4 ca = *(const f32x4*)cx, cb = *(const f32x4*)(cx + 4), xa = *(const f32x4*)(cx + 512), xb = *(const f32x4*)(cx + 516);
            *(f32x4*)o = ca * xa; *(f32x4*)(o + 4) = cb * xb;
        }
    }
}

__device__ __forceinline__ void p5_gemm_merge(const Frame& F) {
    const int ntile = (NT / BM) * (D / BN);
    for (int t = F.bid; t < ntile; t += F.G) {
        const int m0 = (t / (D / BN)) * BM, n0 = (t % (D / BN)) * BN;
        f32x16 acc[2][2], acc2[2][2]; zero_acc(acc); zero_acc(acc2);
        gemm_accum(F, acc, F.OATT, 512, F.WOA, 512, 512, m0, n0);
        gemm_accum(F, acc2, F.OCONV, 512, F.WOC, 512, 512, m0, n0);
        GEMM_EPI_LOOP({
            const f32x4 va = ACC4(acc), vc = ACC4(acc2);
            const u32x2 ga = *(const u32x2*)(F.PROJ + (size_t)m * NMIXP + C_GA + n), gb = *(const u32x2*)(F.PROJ + (size_t)m * NMIXP + C_GB + n);
            f32x4 o;
            o[0] = sigmoidf_(bflo(ga[0])) * va[0] + sigmoidf_(bflo(gb[0])) * vc[0];
            o[1] = sigmoidf_(bfhi(ga[0])) * va[1] + sigmoidf_(bfhi(gb[0])) * vc[1];
            o[2] = sigmoidf_(bflo(ga[1])) * va[2] + sigmoidf_(bflo(gb[1])) * vc[2];
            o[3] = sigmoidf_(bfhi(ga[1])) * va[3] + sigmoidf_(bfhi(gb[1])) * vc[3];
            *(u32x2*)(F.MERGED + (size_t)m * D + n) = pk4(o);
        })
    }
}
__device__ __forceinline__ void p6_gemm_out(const Frame& F) {
    const int ntile = (NT / BM) * (D / BN);
    for (int t = F.bid; t < ntile; t += F.G) {
        const int m0 = (t / (D / BN)) * BM, n0 = (t % (D / BN)) * BN;
        f32x16 acc[2][2]; zero_acc(acc);
        gemm_accum(F, acc, F.MERGED, D, F.WOUT, D, D, m0, n0);
        GEMM_EPI_LOOP({
            const f32x4 v = ACC4(acc);
            const f32x4 xv = *(const f32x4*)(x_row(F, m) + n);
            const f32x4 g1 = *(const f32x4*)(F.MOD + (size_t)mod_row(m) * 6144 + 2048 + n);
            *(f32x4*)(F.T1 + (size_t)m * D + n) = xv * DN_ALPHA + g1 * v;
        })
    }
}
__device__ __forceinline__ void p7_ln1(const Frame& F) {
    for (int m = F.bid * 8 + F.wave; m < NT; m += F.G * 8) {
        float* tr = F.T1 + (size_t)m * D; const float* mr = F.MOD + (size_t)mod_row(m) * 6144;
        f32x4 v[4]; float s = 0.f;
#pragma unroll
        for (int i = 0; i < 4; ++i) { v[i] = *(const f32x4*)(tr + (i >> 1) * 512 + F.lane * 8 + (i & 1) * 4); s += v[i][0] + v[i][1] + v[i][2] + v[i][3]; }
        const float mean = wave_sum(s) * (1.f / D);
        float q = 0.f;
#pragma unroll
        for (int i = 0; i < 4; ++i) { v[i] = v[i] - mean; q += v[i][0] * v[i][0] + v[i][1] * v[i][1] + v[i][2] * v[i][2] + v[i][3] * v[i][3]; }
        const float rstd = rsqrtf(wave_sum(q) * (1.f / D) + LN_EPS);
#pragma unroll
        for (int hlf = 0; hlf < 2; ++hlf) {
            const int e = hlf * 512 + F.lane * 8;
            f32x4 a = v[2 * hlf] * rstd * *(const f32x4*)(F.ln1_g + e) + *(const f32x4*)(F.ln1_b + e);
            f32x4 b = v[2 * hlf + 1] * rstd * *(const f32x4*)(F.ln1_g + e + 4) + *(const f32x4*)(F.ln1_b + e + 4);
            *(f32x4*)(tr + e) = a; *(f32x4*)(tr + e + 4) = b;
            const f32x4 ha = a * (*(const f32x4*)(mr + 4096 + e) + 1.f) + *(const f32x4*)(mr + 3072 + e);
            const f32x4 hb = b * (*(const f32x4*)(mr + 4096 + e + 4) + 1.f) + *(const f32x4*)(mr + 3072 + e + 4);
            *(u32x4*)(F.H2 + (size_t)m * D + e) = (u32x4){cvt_pk_bf16(ha[0], ha[1]), cvt_pk_bf16(ha[2], ha[3]), cvt_pk_bf16(hb[0], hb[1]), cvt_pk_bf16(hb[2], hb[3])};
        }
    }
}
__device__ __forceinline__ void p8_gemm_q(const Frame& F) {
    const int ntile = (NT / BM) * (D / BN);
    for (int t = F.bid; t < ntile; t += F.G) {
        const int m0 = (t / (D / BN)) * BM, n0 = (t % (D / BN)) * BN;
        f32x16 acc[2][2]; zero_acc(acc);
        gemm_accum(F, acc, F.H2, D, F.WQ, D, D, m0, n0);
        GEMM_EPI_LOOP({ *(u32x2*)(F.QP + (size_t)m * D + n) = pk4(ACC4(acc)); })
    }
}
constexpr int PR_ROW = 129;
__device__ __forceinline__ void p9_route(const Frame& F) {
    LAS float* SC = (LAS float*)F.lds;
    LAS float* TV = (LAS float*)(F.lds + 32 * 8 * PR_ROW * 4);
    LAS unsigned char* TI = (LAS unsigned char*)(F.lds + 32 * 8 * PR_ROW * 4 + 256 * 17 * 4);
    const int lane = F.lane, r = lane & 31, h = lane >> 5;
    const int nunits = (NT / 32) * 2;
    for (int it = F.bid; it < nunits; it += F.G) {
        const int tok0 = (it >> 1) * 32, hg = it & 1;
        __syncthreads();
        {
            const int head = hg * 4 + (F.wave >> 1), half = F.wave & 1;
            const bf16_t* KK = half ? F.K2 : F.K1;
            bf16x8 Bq[4];
#pragma unroll
            for (int s = 0; s < 4; ++s) Bq[s] = *(const bf16x8*)(F.QP + (size_t)(tok0 + r) * D + head * 128 + half * 64 + s * 16 + h * 8);
#pragma unroll
            for (int kt = 0; kt < 4; ++kt) {
                f32x16 c;
#pragma unroll
                for (int e = 0; e < 16; ++e) c[e] = 0.f;
#pragma unroll
                for (int s = 0; s < 4; ++s) {
                    const bf16x8 Ak = *(const bf16x8*)(KK + (size_t)(kt * 32 + r) * 64 + s * 16 + h * 8);
                    c = __builtin_amdgcn_mfma_f32_32x32x16_bf16(Ak, Bq[s], c, 0, 0, 0);
                }
#pragma unroll
                for (int e = 0; e < 16; ++e) { const int key = kt * 32 + (e & 3) + 8 * (e >> 2) + 4 * h; SC[(r * 8 + F.wave) * PR_ROW + key] = c[e]; }
            }
        }
        __syncthreads();
        if (F.tid < 256) {
            LAS float* row = SC + F.tid * PR_ROW;
            float gm[16];
#pragma unroll
            for (int gidx = 0; gidx < 16; ++gidx) {
                float m = row[gidx * 8];
#pragma unroll
                for (int k = 1; k < 8; ++k) m = fmaxf(m, row[gidx * 8 + k]);
                gm[gidx] = m;
            }
#pragma unroll 1
            for (int p = 0; p < 16; ++p) {
                float best = gm[0]; int bg = 0;
#pragma unroll
                for (int gidx = 1; gidx < 16; ++gidx) { const bool gt = gm[gidx] > best; best = gt ? gm[gidx] : best; bg = gt ? gidx : bg; }
                float v[8];
#pragma unroll
                for (int k = 0; k < 8; ++k) v[k] = row[bg * 8 + k];
                int bk = 7;
#pragma unroll
                for (int k = 6; k >= 0; --k) bk = (v[k] == best) ? k : bk;
                float nm = -INFINITY;
#pragma unroll
                for (int k = 0; k < 8; ++k) nm = fmaxf(nm, (k == bk) ? -INFINITY : v[k]);
                row[bg * 8 + bk] = -INFINITY;
#pragma unroll
                for (int gidx = 0; gidx < 16; ++gidx) gm[gidx] = (gidx == bg) ? nm : gm[gidx];
                TV[F.tid * 17 + p] = best; TI[F.tid * 17 + p] = (unsigned char)(bg * 8 + bk);
            }
        }
        __syncthreads();
        if (F.tid < 128) {
            const int tk = F.tid >> 2, hs = F.tid & 3;
            const int r1 = (tk * 8 + hs * 2) * 17, r2 = r1 + 17;
            LAS float* cand = SC + F.tid * 51;
            {
                float t1[16], t2[16];
#pragma unroll
                for (int i = 0; i < 16; ++i) { t1[i] = TV[r1 + i]; t2[i] = TV[r2 + i]; }
                int nc = 0;
#pragma unroll
                for (int i = 0; i < 16; ++i) {
#pragma unroll
                    for (int j = 0; j < 16 / (i + 1); ++j) { cand[nc] = t1[i] + t2[j]; ++nc; }
                }
            }
            float sv[16]; int se[16];
#pragma unroll
            for (int p = 0; p < 16; ++p) {
                float best = -INFINITY; int bc = 0, bij = 0, c = 0;
#pragma unroll
                for (int i = 0; i < 16; ++i) {
#pragma unroll
                    for (int j = 0; j < 16 / (i + 1); ++j) { const float v = cand[c]; const bool gt = v > best; best = gt ? v : best; bc = gt ? c : bc; bij = gt ? (i * 16 + j) : bij; ++c; }
                }
                cand[bc] = -INFINITY; sv[p] = best; se[p] = (int)TI[r1 + (bij >> 4)] * 128 + (int)TI[r2 + (bij & 15)];
            }
            const float mx0 = sv[0]; float den = 0.f;
#pragma unroll
            for (int p = 0; p < 16; ++p) { sv[p] = __expf(sv[p] - mx0); den += sv[p]; }
            const float dinv = 1.f / den;
            const int head = hg * 4 + hs;
            int* eo = F.EIDX + (size_t)(tok0 + tk) * NEXP_SEL + head * 16; float* go = F.GW + (size_t)(tok0 + tk) * NEXP_SEL + head * 16;
#pragma unroll
            for (int p = 0; p < 16; ++p) { eo[p] = se[p]; go[p] = sv[p] * dinv; }
        }
    }
}

constexpr int TPW = 65, PAIRS_MAX = 9 * 128;
typedef __bf16 bf16x2v __attribute__((ext_vector_type(2)));
__device__ __forceinline__ float dot2bf(unsigned a, unsigned b, float c) { bf16x2v x, y; __builtin_memcpy(&x, &a, 4); __builtin_memcpy(&y, &b, 4); return __builtin_amdgcn_fdot2_f32_bf16(x, y, c, false); }
struct PeerRows { u32x4 ua, ub, va, vb; };
__device__ __forceinline__ void peer_load(PeerRows& R, const Frame& F, int wv, int j, int lane) {
    const int e = __builtin_amdgcn_readlane(wv, j) & 16383;
    const bf16_t* ur = F.PU + (size_t)e * D; const bf16_t* vr = F.PV + (size_t)e * D;
    R.ua = *(const u32x4*)(ur + lane * 8); R.ub = *(const u32x4*)(ur + 512 + lane * 8);
    R.va = *(const u32x4*)(vr + lane * 8); R.vb = *(const u32x4*)(vr + 512 + lane * 8);
}
constexpr int PK = 4;
template <int K> __device__ __forceinline__ void peer_acc(float (&acc)[PK][16], const float (&vf)[16], float act, int kl) {
    const float aK = (kl == K) ? act : 0.f;
#pragma unroll
    for (int e = 0; e < 16; ++e) acc[K][e] += aK * vf[e];
}
__device__ __forceinline__ void peer_compute(float (&acc)[PK][16], const PeerRows& R, const Frame& F, int wv, int gv, int j, int lane, int kbase) {
    const int w = __builtin_amdgcn_readlane(wv, j);
    const int kk = w >> 14;
    LAS const unsigned char* hr = F.lds + (F.wave + 8 * kk) * 2048 + lane * 16;
    const u32x4 ha = *(LAS const u32x4*)hr, hb = *(LAS const u32x4*)(hr + 1024);
    float s0 = 0.f, s1 = 0.f;
#pragma unroll
    for (int e = 0; e < 4; ++e) { s0 = dot2bf(ha[e], R.ua[e], s0); s1 = dot2bf(hb[e], R.ub[e], s1); }
    const float d = wave_sum_dpp(s0 + s1);
    const float g = __int_as_float(__builtin_amdgcn_readlane(gv, j));
    const float act = gelu_tanh(d) * g;
    const int kl = kk - kbase;
    float vf[16];
#pragma unroll
    for (int e = 0; e < 4; ++e) { vf[2 * e] = bflo(R.va[e]); vf[2 * e + 1] = bfhi(R.va[e]); vf[8 + 2 * e] = bflo(R.vb[e]); vf[8 + 2 * e + 1] = bfhi(R.vb[e]); }
    peer_acc<0>(acc, vf, act, kl); peer_acc<1>(acc, vf, act, kl); peer_acc<2>(acc, vf, act, kl); peer_acc<3>(acc, vf, act, kl);
}
__device__ __forceinline__ void p10_peer(const Frame& F) {
    const int lane = F.lane, w = F.wave;
    unsigned char* ws = F.ws;
    const int tok0 = F.bid * TPW;
    if (tok0 >= NT) return;
    __syncthreads();
    for (int c = F.tid; c < TPW * 128; c += NTHREADS) *(LAS u32x4*)(F.lds + c * 16) = *(const u32x4*)(F.H2 + (size_t)tok0 * D + (size_t)c * 8);
    __syncthreads();
    LAS unsigned* hist = (LAS unsigned*)(F.lds + TPW * 2048) + w * 128;
    unsigned* SE0 = (unsigned*)(ws + WS_SE) + ((size_t)F.bid * 8 + w) * PAIRS_MAX;
    float* SG0 = (float*)(ws + WS_SG) + ((size_t)F.bid * 8 + w) * PAIRS_MAX;
    const int ntok = (w == 0) ? 9 : 8;
#pragma unroll 1
    for (int pass = 0; pass < 3; ++pass) {
        const int kbase = pass * PK, nk = (ntok - kbase < PK) ? ntok - kbase : PK, npairs = nk * 128;
        if (nk <= 0) break;
        unsigned* SE = SE0 + pass * (PK * 128); float* SG = SG0 + pass * (PK * 128);
        hist[lane] = 0u; hist[lane + 64] = 0u;
        int ex[8];
#pragma unroll
        for (int i = 0; i < 8; ++i) {
            const int p = lane + 64 * i;
            ex[i] = -1;
            if (p < npairs) { ex[i] = F.EIDX[(size_t)(tok0 + w + 8 * (kbase + (p >> 7))) * NEXP_SEL + (p & 127)]; atomicAdd((unsigned*)&hist[ex[i] >> 7], 1u); }
        }
        {
            const unsigned c0 = hist[2 * lane], c1 = hist[2 * lane + 1];
            unsigned incl = c0 + c1;
#pragma unroll
            for (int o = 1; o < 64; o <<= 1) { const unsigned t = __shfl_up(incl, o); if (lane >= o) incl += t; }
            const unsigned excl = incl - (c0 + c1);
            hist[2 * lane] = excl; hist[2 * lane + 1] = excl + c0;
        }
#pragma unroll
        for (int i = 0; i < 8; ++i) {
            const int p = lane + 64 * i;
            if (p < npairs) {
                const unsigned pos = atomicAdd((unsigned*)&hist[ex[i] >> 7], 1u);
                SE[pos] = (unsigned)ex[i] | ((unsigned)(kbase + (p >> 7)) << 14);
                SG[pos] = F.GW[(size_t)(tok0 + w + 8 * (kbase + (p >> 7))) * NEXP_SEL + (p & 127)];
            }
        }
        asm volatile("s_waitcnt vmcnt(0)" ::: "memory");
        float acc[PK][16];
#pragma unroll
        for (int k = 0; k < PK; ++k)
#pragma unroll
            for (int e = 0; e < 16; ++e) acc[k][e] = 0.f;
#pragma unroll 1
        for (int c0 = 0; c0 < npairs; c0 += 64) {
            const int wv = (int)SE[c0 + lane]; const int gv = __float_as_int(SG[c0 + lane]);
            PeerRows R0, R1, R2, R3;
            peer_load(R0, F, wv, 0, lane); peer_load(R1, F, wv, 1, lane); peer_load(R2, F, wv, 2, lane); peer_load(R3, F, wv, 3, lane);
#pragma unroll 1
            for (int j = 0; j < 64; j += 4) {
                peer_compute(acc, R0, F, wv, gv, j + 0, lane, kbase); __builtin_amdgcn_sched_barrier(0); peer_load(R0, F, wv, (j + 4) & 63, lane); __builtin_amdgcn_sched_barrier(0);
                peer_compute(acc, R1, F, wv, gv, j + 1, lane, kbase); __builtin_amdgcn_sched_barrier(0); peer_load(R1, F, wv, (j + 5) & 63, lane); __builtin_amdgcn_sched_barrier(0);
                peer_compute(acc, R2, F, wv, gv, j + 2, lane, kbase); __builtin_amdgcn_sched_barrier(0); peer_load(R2, F, wv, (j + 6) & 63, lane); __builtin_amdgcn_sched_barrier(0);
                peer_compute(acc, R3, F, wv, gv, j + 3, lane, kbase); __builtin_amdgcn_sched_barrier(0); peer_load(R3, F, wv, (j + 7) & 63, lane); __builtin_amdgcn_sched_barrier(0);
            }
        }
#pragma unroll
        for (int k = 0; k < PK; ++k) {
            if (k >= nk) continue;
            const int m = tok0 + w + 8 * (kbase + k);
            const float* x1 = F.T1 + (size_t)m * D; const float* mr = F.MOD + (size_t)mod_row(m) * 6144 + 5120;
            float tv[16]; float s = 0.f;
#pragma unroll
            for (int hlf = 0; hlf < 2; ++hlf)
#pragma unroll
                for (int c = 0; c < 2; ++c) {
                    const int e = hlf * 512 + lane * 8 + c * 4;
                    const f32x4 xv = *(const f32x4*)(x1 + e), g2 = *(const f32x4*)(mr + e);
#pragma unroll
                    for (int kx = 0; kx < 4; ++kx) { const float t = xv[kx] * DN_ALPHA + g2[kx] * acc[k][hlf * 8 + c * 4 + kx]; tv[hlf * 8 + c * 4 + kx] = t; s += t; }
                }
            const float mean = wave_sum(s) * (1.f / D);
            float q = 0.f;
#pragma unroll
            for (int e = 0; e < 16; ++e) { tv[e] -= mean; q += tv[e] * tv[e]; }
            const float rstd = rsqrtf(wave_sum(q) * (1.f / D) + LN_EPS);
            float* yo = (m < NTP) ? F.out + O_YP + (size_t)m * D : F.out + O_YS + (size_t)(m - NTP) * D;
#pragma unroll
            for (int hlf = 0; hlf < 2; ++hlf)
#pragma unroll
                for (int c = 0; c < 2; ++c) {
                    const int e = hlf * 512 + lane * 8 + c * 4;
                    const f32x4 gg = *(const f32x4*)(F.ln2_g + e), bb = *(const f32x4*)(F.ln2_b + e);
                    f32x4 o;
#pragma unroll
                    for (int kx = 0; kx < 4; ++kx) o[kx] = tv[hlf * 8 + c * 4 + kx] * rstd * gg[kx] + bb[kx];
                    *(f32x4*)(yo + e) = o;
                }
        }
    }
}

constexpr int N_PHASES = 11;
__global__ void __launch_bounds__(NTHREADS, 2) fwd_kernel(Args args) {
    extern __shared__ __attribute__((aligned(16))) unsigned char lds_raw[];
    Frame F;
    F.lds = (LAS unsigned char*)lds_raw;
    F.tid = threadIdx.x; F.lane = F.tid & 63; F.wave = __builtin_amdgcn_readfirstlane(F.tid >> 6); F.G = gridDim.x; F.bid = blockIdx.x;
    F.x_p = (const float*)args.in[0]; F.x_s = (const float*)args.in[1]; F.c_p = (const float*)args.in[2]; F.c_s = (const float*)args.in[3];
    F.cache_k = (const float*)args.in[4]; F.cache_v = (const float*)args.in[5]; F.cache_ki = (const float*)args.in[6]; F.state_conv = (const float*)args.in[7];
    F.page_table = (const int*)args.in[8]; F.rel_bias = (const float*)args.in[9]; F.w_ada = (const float*)args.in[10]; F.b_ada = (const float*)args.in[11];
    F.w_in = (const float*)args.in[12]; F.conv_w = (const float*)args.in[13]; F.conv_b = (const float*)args.in[14]; F.w_o_attn = (const float*)args.in[15];
    F.w_o_conv = (const float*)args.in[16]; F.w_out = (const float*)args.in[17]; F.ln1_g = (const float*)args.in[18]; F.ln1_b = (const float*)args.in[19];
    F.ln2_g = (const float*)args.in[20]; F.ln2_b = (const float*)args.in[21]; F.peer_wq = (const float*)args.in[22]; F.peer_k1 = (const float*)args.in[23];
    F.peer_k2 = (const float*)args.in[24]; F.peer_u = (const float*)args.in[25]; F.peer_v = (const float*)args.in[26];
    F.out = args.out;
    unsigned char* ws = args.ws; F.ws = ws;
    F.MOD = (float*)(ws + WS_MOD); F.WIN = (bf16_t*)(ws + WS_WIN); F.WOA = (bf16_t*)(ws + WS_WOA); F.WOC = (bf16_t*)(ws + WS_WOC);
    F.WOUT = (bf16_t*)(ws + WS_WOUT); F.WQ = (bf16_t*)(ws + WS_WQ); F.K1 = (bf16_t*)(ws + WS_K1); F.K2 = (bf16_t*)(ws + WS_K2);
    F.PU = (bf16_t*)(ws + WS_PU); F.PV = (bf16_t*)(ws + WS_PV); F.H1 = (bf16_t*)(ws + WS_H1); F.PROJ = (bf16_t*)(ws + WS_PROJ);
    F.WI = (float*)(ws + WS_WI); F.SEL = (int*)(ws + WS_SEL); F.OATT = (bf16_t*)(ws + WS_OATT); F.OCONV = (bf16_t*)(ws + WS_OCONV);
    F.MERGED = (bf16_t*)(ws + WS_MERGED); F.T1 = (float*)(ws + WS_T1); F.H2 = (bf16_t*)(ws + WS_H2); F.QP = (bf16_t*)(ws + WS_QP);
    F.EIDX = (int*)(ws + WS_EIDX); F.GW = (float*)(ws + WS_GW);
    volatile LAS unsigned* misc = (volatile LAS unsigned*)(F.lds + LDS_MISC);
    if (F.tid < 16) misc[F.tid] = 0u;
    __syncthreads();
    XcdBarrier bar; bar.bar = (unsigned*)(ws + WS_CTL); bar.x = 0; bar.st = misc;
    const int lo = args.ph_lo, hi = args.ph_hi;
    if (hi - lo > 1) bar = xcd_barrier_post((unsigned*)(ws + WS_CTL), misc);
#define IN(k) (lo <= (k) && (k) < hi)
#define SEAM(k) do { if (IN(k) && IN((k) + 1)) xcd_barrier(bar); } while (0)
    if (IN(0)) p0_prologue(F);       SEAM(0);
    if (IN(1)) p1_modulate(F);       SEAM(1);
    if (IN(2)) p2_gemm_in(F);        SEAM(2);
    if (IN(3)) p3_index(F);          SEAM(3);
    if (IN(4)) p4_attention(F);      SEAM(4);
    if (IN(5)) p5_gemm_merge(F);     SEAM(5);
    if (IN(6)) p6_gemm_out(F);       SEAM(6);
    if (IN(7)) p7_ln1(F);            SEAM(7);
    if (IN(8)) p8_gemm_q(F);         SEAM(8);
    if (IN(9)) p9_route(F);          SEAM(9);
    if (IN(10)) p10_peer(F);
#undef IN
#undef SEAM
}

extern "C" void kernel_launch(void* const* d_in, const int* in_sizes, int n_in, void* d_out, int out_size, void* d_ws, size_t ws_size, hipStream_t stream) {
    static int grid = 0;
    if (grid == 0) {
        if (n_in != 27 || (size_t)out_size != O_END || ws_size < WS_END) { fprintf(stderr, "kernel_launch: unexpected shapes (n_in %d out %d ws %zu)\n", n_in, out_size, ws_size); grid = -1; return; }
        int dev = 0, cus = 0;
        if (hipGetDevice(&dev) != hipSuccess || hipDeviceGetAttribute(&cus, hipDeviceAttributeMultiprocessorCount, dev) != hipSuccess) { grid = -1; return; }
        if (hipFuncSetAttribute((const void*)fwd_kernel, hipFuncAttributeMaxDynamicSharedMemorySize, LDS_BYTES) != hipSuccess) { fprintf(stderr, "kernel_launch: hipFuncSetAttribute failed\n"); grid = -1; return; }
        (void)hipGetLastError();
        grid = cus;
    }
    if (grid < 0) return;
    (void)hipMemsetAsync((char*)d_ws + WS_CTL, 0, CTL_ZERO_BYTES, stream);
    Args a{};
    for (int i = 0; i < 27; ++i) a.in[i] = d_in[i];
    a.out = (float*)d_out; a.ws = (unsigned char*)d_ws;
#if N_LAUNCHES == 1
    a.ph_lo = 0; a.ph_hi = N_PHASES;
    hipLaunchKernelGGL(fwd_kernel, dim3(grid), dim3(NTHREADS), LDS_BYTES, stream, a);
#else
    for (int p = 0; p < N_PHASES; ++p) { a.ph_lo = p; a.ph_hi = p + 1; hipLaunchKernelGGL(fwd_kernel, dim3(grid), dim3(NTHREADS), LDS_BYTES, stream, a); }
#endif
}
```

```cpp
#include <hip/hip_runtime.h>
#include <cstdio>
#include <cstdint>

#ifndef N_LAUNCHES
#define N_LAUNCHES 1
#endif

typedef unsigned short bf16_t;
typedef short bf16x8 __attribute__((ext_vector_type(8)));
typedef float f32x4 __attribute__((ext_vector_type(4)));
typedef float f32x16 __attribute__((ext_vector_type(16)));
typedef unsigned u32x4 __attribute__((ext_vector_type(4)));
typedef unsigned u32x2 __attribute__((ext_vector_type(2)));
#define LAS __attribute__((address_space(3)))

constexpr int D = 1024, NB_P = 8, SEQ = 2048, NB_S = 32, TS = 8, PAST = 8192, PAGE = 128, NPAGES = 64;
constexpr int NTP = NB_P * SEQ;
constexpr int NTS = NB_S * TS;
constexpr int NT = NTP + NTS;
constexpr int NMIX = 4676, NMIXP = 4736;
constexpr int C_Q = 0, C_K = 512, C_V = 640, C_QI = 768, C_KI = 1024, C_BG = 1088, C_CG = 1600, C_XIN = 2112, C_GA = 2624, C_GB = 3648, C_WI = 4672;
constexpr int NSEL = 256;
constexpr float ATTN_SCALE = 0.125f, IDX_SCALE = 0.0625f;
constexpr float DN_ALPHA = 1.189207115002721f, LN_EPS = 1e-5f;
constexpr int NEXP_SEL = 128;

constexpr size_t O_YP = 0, O_YS = 16777216, O_KP = 17039360, O_VP = 19136512, O_KIP = 21233664, O_CP = 22282240,
                 O_KS = 22290432, O_VS = 22323200, O_KIS = 22355968, O_CS = 22372352, O_END = 22405120;

constexpr size_t MB = 1048576;
constexpr size_t WS_CTL = 0, WS_MOD = 1 * MB, WS_WIN = 2 * MB, WS_WOA = 12 * MB, WS_WOC = 13 * MB, WS_WOUT = 14 * MB, WS_WQ = 16 * MB,
                 WS_K1 = 18 * MB, WS_K2 = 18 * MB + 65536, WS_PU = 20 * MB, WS_PV = 52 * MB, WS_H1 = 84 * MB, WS_PROJ = 118 * MB,
                 WS_WI = 270 * MB, WS_SEL = 271 * MB, WS_OATT = 288 * MB, WS_OCONV = 305 * MB, WS_MERGED = 322 * MB, WS_T1 = 355 * MB,
                 WS_H2 = 420 * MB, WS_QP = 453 * MB, WS_EIDX = 486 * MB, WS_GW = 495 * MB, WS_SS = 504 * MB, WS_SE = 513 * MB, WS_SG = 523 * MB, WS_VT = 533 * MB, WS_CGX = 538 * MB, WS_END = 539 * MB;
constexpr size_t WS_PU8 = WS_PU, WS_PV8 = WS_PU + 16 * MB, WS_SU = WS_PV, WS_SV = WS_PV + 65536, WS_H8 = WS_PV + 1 * MB, WS_SH = WS_PV + 20 * MB;
constexpr int CTL_ZERO_BYTES = 65536;

constexpr int NTHREADS = 512;
constexpr int LDS_BYTES = 160 * 1024 - 512;
constexpr int LDS_MISC = LDS_BYTES - 64;

__device__ __forceinline__ float bf2f(bf16_t b) { return __uint_as_float(((unsigned)b) << 16); }
__device__ __forceinline__ float bflo(unsigned p) { return __uint_as_float(p << 16); }
__device__ __forceinline__ float bfhi(unsigned p) { return __uint_as_float(p & 0xFFFF0000u); }
typedef __bf16 bf16x2_t __attribute__((ext_vector_type(2)));
typedef float f32x2_t __attribute__((ext_vector_type(2)));
__device__ __forceinline__ unsigned cvt_pk_bf16(float lo, float hi) { const f32x2_t f = {lo, hi}; const bf16x2_t b = __builtin_convertvector(f, bf16x2_t); unsigned r; __builtin_memcpy(&r, &b, 4); return r; }
__device__ __forceinline__ bf16_t f2bf(float f) { return (bf16_t)(cvt_pk_bf16(f, 0.f) & 0xFFFFu); }
__device__ __forceinline__ float wave_sum(float v) {
#pragma unroll
    for (int o = 32; o >= 1; o >>= 1) v += __shfl_xor(v, o);
    return v;
}
__device__ __forceinline__ float wave_sum_dpp(float v) {
    int x;
    x = __builtin_amdgcn_update_dpp(0, __float_as_int(v), 0xB1, 0xF, 0xF, false);  v += __int_as_float(x);
    x = __builtin_amdgcn_update_dpp(0, __float_as_int(v), 0x4E, 0xF, 0xF, false);  v += __int_as_float(x);
    x = __builtin_amdgcn_update_dpp(0, __float_as_int(v), 0x141, 0xF, 0xF, false); v += __int_as_float(x);
    x = __builtin_amdgcn_update_dpp(0, __float_as_int(v), 0x140, 0xF, 0xF, false); v += __int_as_float(x);
    x = __builtin_amdgcn_update_dpp(0, __float_as_int(v), 0x142, 0xA, 0xF, false); v += __int_as_float(x);
    x = __builtin_amdgcn_update_dpp(0, __float_as_int(v), 0x143, 0xC, 0xF, false); v += __int_as_float(x);
    return __int_as_float(__builtin_amdgcn_readlane(__float_as_int(v), 63));
}
__device__ __forceinline__ float wave_max(float v) {
#pragma unroll
    for (int o = 32; o >= 1; o >>= 1) v = fmaxf(v, __shfl_xor(v, o));
    return v;
}
__device__ __forceinline__ float sigmoidf_(float x) { return 1.f / (1.f + __expf(-x)); }
__device__ __forceinline__ float gelu_tanh(float a) {
    const float z = 0.7978845608028654f * (a + 0.044715f * a * a * a);
    const float e = __expf(2.f * z);
    const float t = 1.f - 2.f * __builtin_amdgcn_rcpf(e + 1.f);
    return 0.5f * a * (1.f + t);
}
__device__ __forceinline__ unsigned f2ord(float f) { const unsigned u = __float_as_uint(f); return (u & 0x80000000u) ? ~u : (u | 0x80000000u); }
__device__ __forceinline__ int t5_bucket(int n) {
    if (n < 16) return n;
    int b = 16;
    b += (n >= 19) + (n >= 21) + (n >= 24) + (n >= 27) + (n >= 31) + (n >= 35) + (n >= 40) + (n >= 46) + (n >= 52) + (n >= 59) + (n >= 67) + (n >= 77) + (n >= 87) + (n >= 99) + (n >= 113);
    return b;
}

#define XB_TMO      128
#define XB_XCNT(j)  (256  + 64 * (j))
#define XB_XSUB(j)  (1280 + 64 * (j))
#define XB_XGEN(j)  (2304 + 64 * (j))
#define XB_TOP      3328
#define XB_TOPGEN   3392
#define XCD_BAR_WORDS 3456
#define XB_SPIN_CAP (1u << 18)
__device__ __forceinline__ unsigned xb_ld(unsigned* p)              { return __hip_atomic_load(p, __ATOMIC_RELAXED, __HIP_MEMORY_SCOPE_AGENT); }
__device__ __forceinline__ unsigned xb_add(unsigned* p, unsigned v) { return __hip_atomic_fetch_add(p, v, __ATOMIC_RELAXED, __HIP_MEMORY_SCOPE_AGENT); }
__device__ __forceinline__ unsigned xb_xcc_id() { return (unsigned)__builtin_amdgcn_s_getreg((3 << 11) | 20) & 0xFu; }
#define XB_SPIN(cond, bar) do { unsigned _sp = 0; while (cond) { __builtin_amdgcn_s_sleep(1); \
    if ((++_sp & 255u) == 0u) { if (xb_ld(&(bar)[XB_TMO])) break; if (_sp > XB_SPIN_CAP) { atomicAdd(&(bar)[XB_TMO], 1u); break; } } } } while (0)
struct XcdBarrier { unsigned* bar; unsigned x; volatile LAS unsigned* st; };
__device__ __forceinline__ XcdBarrier xcd_barrier_post(unsigned* bar, volatile LAS unsigned* st) {
    XcdBarrier b; b.bar = bar; b.x = xb_xcc_id(); b.st = st;
    if (threadIdx.x == 0) (void)xb_add(&bar[XB_XCNT(b.x)], 1u);
    return b;
}
__device__ __forceinline__ void xcd_barrier_complete(unsigned* bar, unsigned x, unsigned& nloc, unsigned& nx) {
    const unsigned G = gridDim.x * gridDim.y * gridDim.z;
    unsigned sum, cnt, mine, sp = 0u;
    for (;;) {
        sum = 0u; cnt = 0u; mine = 0u;
#pragma unroll
        for (unsigned j = 0; j < 16; ++j) { const unsigned c = xb_ld(&bar[XB_XCNT(j)]); sum += c; cnt += (c > 0u) ? 1u : 0u; mine = (j == x) ? c : mine; }
        if (sum == G) break;
        __builtin_amdgcn_s_sleep(1);
        if ((++sp & 255u) == 0u) { if (xb_ld(&bar[XB_TMO])) break; if (sp > XB_SPIN_CAP) { atomicAdd(&bar[XB_TMO], 1u); break; } }
    }
    nloc = mine > 0u ? mine : 1u; nx = cnt > 0u ? cnt : 1u;
}
__device__ __forceinline__ void xcd_barrier(const XcdBarrier& b) {
    asm volatile("s_waitcnt vmcnt(0)" ::: "memory");
    __syncthreads();
    if (threadIdx.x == 0) {
        unsigned* bar = b.bar;
        __builtin_amdgcn_s_waitcnt(0);
        unsigned nloc = b.st[0], nx = b.st[1];
        if (nloc == 0u) { xcd_barrier_complete(bar, b.x, nloc, nx); b.st[0] = nloc; b.st[1] = nx; }
        const unsigned old = xb_add(&bar[XB_XSUB(b.x)], 1u);
        const unsigned gen = old / nloc;
        if (old + 1u == (gen + 1u) * nloc) {
            __builtin_amdgcn_fence(__ATOMIC_RELEASE, "agent");
            asm volatile("s_waitcnt vmcnt(0)" ::: "memory");
            const unsigned og = xb_add(&bar[XB_TOP], 1u);
            const unsigned tg = og / nx;
            if (og + 1u == (tg + 1u) * nx) xb_add(&bar[XB_TOPGEN], 1u);
            else XB_SPIN(xb_ld(&bar[XB_TOPGEN]) == tg, bar);
            __builtin_amdgcn_fence(__ATOMIC_ACQUIRE, "agent");
            xb_add(&bar[XB_XGEN(b.x)], 1u);
            asm volatile("s_waitcnt vmcnt(0)" ::: "memory");
        } else {
            XB_SPIN(xb_ld(&bar[XB_XGEN(b.x)]) == gen, bar);
            __builtin_amdgcn_fence(__ATOMIC_ACQUIRE, "agent");
            asm volatile("s_waitcnt vmcnt(0)" ::: "memory");
        }
    }
    __syncthreads();
}

struct Args { const void* in[27]; float* out; unsigned char* ws; int ph_lo, ph_hi; };
struct Core { LAS unsigned char* lds; int tid, lane, wave, G, bid; };
struct Frame {
    LAS unsigned char* lds;
    int tid, lane, wave, G, bid;
    const float *x_p, *x_s, *c_p, *c_s, *cache_k, *cache_v, *cache_ki, *state_conv, *rel_bias, *w_ada, *b_ada, *w_in, *conv_w, *conv_b,
                *w_o_attn, *w_o_conv, *w_out, *ln1_g, *ln1_b, *ln2_g, *ln2_b, *peer_wq, *peer_k1, *peer_k2, *peer_u, *peer_v;
    const int* page_table;
    float* out; unsigned char* ws;
    float* MOD; bf16_t *WIN, *WOA, *WOC, *WOUT, *WQ, *K1, *K2, *PU, *PV, *H1, *PROJ, *OATT, *OCONV, *MERGED, *H2, *QP;
    float *WI, *T1, *GW; int *SEL, *EIDX;
};
constexpr int LDS_PTAB = LDS_BYTES - 512;
__device__ __forceinline__ unsigned char* ldptr(const Core& C, int k) {
    LAS const unsigned* p = (LAS const unsigned*)(C.lds + LDS_PTAB) + 2 * k;
    const unsigned lo = __builtin_amdgcn_readfirstlane(p[0]), hi = __builtin_amdgcn_readfirstlane(p[1]);
    return (unsigned char*)(((unsigned long long)hi << 32) | (unsigned long long)lo);
}
__device__ __forceinline__ void load_frame(Frame& F, const Core& C) {
    F.lds = C.lds; F.tid = C.tid; F.lane = C.lane; F.wave = C.wave; F.G = C.G; F.bid = C.bid;
    F.x_p = (const float*)ldptr(C, 0); F.x_s = (const float*)ldptr(C, 1); F.c_p = (const float*)ldptr(C, 2); F.c_s = (const float*)ldptr(C, 3);
    F.cache_k = (const float*)ldptr(C, 4); F.cache_v = (const float*)ldptr(C, 5); F.cache_ki = (const float*)ldptr(C, 6); F.state_conv = (const float*)ldptr(C, 7);
    F.page_table = (const int*)ldptr(C, 8); F.rel_bias = (const float*)ldptr(C, 9); F.w_ada = (const float*)ldptr(C, 10); F.b_ada = (const float*)ldptr(C, 11);
    F.w_in = (const float*)ldptr(C, 12); F.conv_w = (const float*)ldptr(C, 13); F.conv_b = (const float*)ldptr(C, 14); F.w_o_attn = (const float*)ldptr(C, 15);
    F.w_o_conv = (const float*)ldptr(C, 16); F.w_out = (const float*)ldptr(C, 17); F.ln1_g = (const float*)ldptr(C, 18); F.ln1_b = (const float*)ldptr(C, 19);
    F.ln2_g = (const float*)ldptr(C, 20); F.ln2_b = (const float*)ldptr(C, 21); F.peer_wq = (const float*)ldptr(C, 22); F.peer_k1 = (const float*)ldptr(C, 23);
    F.peer_k2 = (const float*)ldptr(C, 24); F.peer_u = (const float*)ldptr(C, 25); F.peer_v = (const float*)ldptr(C, 26);
    F.out = (float*)ldptr(C, 27);
    unsigned char* ws = ldptr(C, 28);
    F.MOD = (float*)(ws + WS_MOD); F.WIN = (bf16_t*)(ws + WS_WIN); F.WOA = (bf16_t*)(ws + WS_WOA); F.WOC = (bf16_t*)(ws + WS_WOC);
    F.WOUT = (bf16_t*)(ws + WS_WOUT); F.WQ = (bf16_t*)(ws + WS_WQ); F.K1 = (bf16_t*)(ws + WS_K1); F.K2 = (bf16_t*)(ws + WS_K2);
    F.PU = (bf16_t*)(ws + WS_PU); F.PV = (bf16_t*)(ws + WS_PV); F.H1 = (bf16_t*)(ws + WS_H1); F.PROJ = (bf16_t*)(ws + WS_PROJ);
    F.WI = (float*)(ws + WS_WI); F.SEL = (int*)(ws + WS_SEL); F.OATT = (bf16_t*)(ws + WS_OATT); F.OCONV = (bf16_t*)(ws + WS_OCONV);
    F.MERGED = (bf16_t*)(ws + WS_MERGED); F.T1 = (float*)(ws + WS_T1); F.H2 = (bf16_t*)(ws + WS_H2); F.QP = (bf16_t*)(ws + WS_QP);
    F.EIDX = (int*)(ws + WS_EIDX); F.GW = (float*)(ws + WS_GW);
}
__device__ __forceinline__ const float* x_row(const Frame& F, int m) { return m < NTP ? F.x_p + (size_t)m * D : F.x_s + (size_t)(m - NTP) * D; }
__device__ __forceinline__ int mod_row(int m) { return m < NTP ? (m >> 11) : NB_P + ((m - NTP) >> 3); }

constexpr int P0_MOD_ITEMS = 96;
constexpr int P0_T_WIN = 16 * 74, P0_T_WOA = 8 * 16, P0_T_WOC = 8 * 16, P0_T_WOUT = 16 * 16, P0_T_WQ = 16 * 16;
constexpr int P0_T_ITEMS = P0_T_WIN + P0_T_WOA + P0_T_WOC + P0_T_WOUT + P0_T_WQ;
constexpr int P0_CVT_ITEMS = 2 * (16384 * 1024 / 8192);
constexpr int P0_MISC_ITEMS = 1;
constexpr int P0_ITEMS = P0_MOD_ITEMS + P0_T_ITEMS + P0_CVT_ITEMS + P0_MISC_ITEMS;

__device__ __forceinline__ void p0_mod_item(const Frame& F, int ng) {
    LAS float* cs = (LAS float*)F.lds;
    LAS float* red = (LAS float*)(F.lds + 40 * 256 * 4);
    float acc[40];
#pragma unroll
    for (int r = 0; r < 40; ++r) acc[r] = 0.f;
    const int n = ng * 64 + F.lane;
    for (int kc = 0; kc < 4; ++kc) {
        __syncthreads();
        for (int e = F.tid; e < 40 * 256; e += NTHREADS) { const int r = e >> 8, k = e & 255; cs[e] = (r < 8) ? F.c_p[r * D + kc * 256 + k] : F.c_s[(r - 8) * D + kc * 256 + k]; }
        __syncthreads();
        for (int kk = 0; kk < 32; ++kk) {
            const int kl = F.wave * 32 + kk;
            const float wv = F.w_ada[(size_t)(kc * 256 + kl) * 6144 + n];
#pragma unroll
            for (int r = 0; r < 40; ++r) acc[r] += cs[r * 256 + kl] * wv;
        }
    }
#pragma unroll
    for (int r = 0; r < 40; ++r) red[(F.wave * 40 + r) * 64 + F.lane] = acc[r];
    __syncthreads();
    for (int e = F.tid; e < 40 * 64; e += NTHREADS) {
        const int r = e >> 6, l = e & 63; float s = F.b_ada[ng * 64 + l];
#pragma unroll
        for (int w = 0; w < 8; ++w) s += red[(w * 40 + r) * 64 + l];
        F.MOD[r * 6144 + ng * 64 + l] = s;
    }
    __syncthreads();
}
__device__ __forceinline__ void p0_transpose_tile(const Frame& F, const float* W, int N, int K, bf16_t* Wt, int kt, int nt, bool permute) {
    LAS bf16_t* tile = (LAS bf16_t*)F.lds;
    __syncthreads();
    { const int k = F.tid >> 3, c0 = (F.tid & 7) * 8;
#pragma unroll
      for (int j = 0; j < 8; ++j) { const int n = nt * 64 + c0 + j; const float v = (n < N) ? W[(size_t)(kt * 64 + k) * N + n] : 0.f; tile[k * 66 + c0 + j] = f2bf(v); } }
    __syncthreads();
    { const int nl = F.tid >> 3, k0 = (F.tid & 7) * 8; const int n = nt * 64 + nl;
      if (n < N) {
          int nd = n; if (permute) nd = (n < 1024) ? n : (n < 1028 ? C_WI + (n - 1024) : n - 4);
          unsigned p[4];
#pragma unroll
          for (int j = 0; j < 4; ++j) p[j] = (unsigned)tile[(k0 + 2 * j) * 66 + nl] | ((unsigned)tile[(k0 + 2 * j + 1) * 66 + nl] << 16);
          *(u32x4*)(Wt + (size_t)nd * K + kt * 64 + k0) = (u32x4){p[0], p[1], p[2], p[3]};
      } }
}
__device__ __forceinline__ void p0_prologue(const Frame& F) {
    for (int it = F.bid; it < P0_ITEMS; it += F.G) {
        int i = it;
        if (i < P0_MOD_ITEMS) { p0_mod_item(F, i); continue; }
        i -= P0_MOD_ITEMS;
        if (i < P0_T_ITEMS) {
            if (i < P0_T_WIN) { p0_transpose_tile(F, F.w_in, NMIX, D, F.WIN, i / 74, i % 74, true); continue; }
            i -= P0_T_WIN;
            if (i < P0_T_WOA) { p0_transpose_tile(F, F.w_o_attn, D, 512, F.WOA, i / 16, i % 16, false); continue; }
            i -= P0_T_WOA;
            if (i < P0_T_WOC) { p0_transpose_tile(F, F.w_o_conv, D, 512, F.WOC, i / 16, i % 16, false); continue; }
            i -= P0_T_WOC;
            if (i < P0_T_WOUT) { p0_transpose_tile(F, F.w_out, D, D, F.WOUT, i / 16, i % 16, false); continue; }
            i -= P0_T_WOUT;
            p0_transpose_tile(F, F.peer_wq, D, D, F.WQ, i / 16, i % 16, false); continue;
        }
        i -= P0_T_ITEMS;
        if (i < P0_CVT_ITEMS) {
            const float* src = (i < 2048) ? F.peer_u : F.peer_v;
            unsigned char* dst = F.ws + ((i < 2048) ? WS_PU8 : WS_PV8); float* sinv = (float*)(F.ws + ((i < 2048) ? WS_SU : WS_SV));
            const int row = (i & 2047) * 8 + F.wave;
            const float* rp = src + (size_t)row * D + F.lane * 16;
            const f32x4 a = *(const f32x4*)rp, b2 = *(const f32x4*)(rp + 4), c = *(const f32x4*)(rp + 8), d = *(const f32x4*)(rp + 12);
            float am = 0.f;
#pragma unroll
            for (int e = 0; e < 4; ++e) am = fmaxf(am, fmaxf(fmaxf(fabsf(a[e]), fabsf(b2[e])), fmaxf(fabsf(c[e]), fabsf(d[e]))));
            am = wave_max(am);
            const float sc = am > 0.f ? 224.f / am : 1.f;
            int w0 = 0, w1 = 0, w2 = 0, w3 = 0;
            w0 = __builtin_amdgcn_cvt_pk_fp8_f32(a[0] * sc, a[1] * sc, w0, false); w0 = __builtin_amdgcn_cvt_pk_fp8_f32(a[2] * sc, a[3] * sc, w0, true);
            w1 = __builtin_amdgcn_cvt_pk_fp8_f32(b2[0] * sc, b2[1] * sc, w1, false); w1 = __builtin_amdgcn_cvt_pk_fp8_f32(b2[2] * sc, b2[3] * sc, w1, true);
            w2 = __builtin_amdgcn_cvt_pk_fp8_f32(c[0] * sc, c[1] * sc, w2, false); w2 = __builtin_amdgcn_cvt_pk_fp8_f32(c[2] * sc, c[3] * sc, w2, true);
            w3 = __builtin_amdgcn_cvt_pk_fp8_f32(d[0] * sc, d[1] * sc, w3, false); w3 = __builtin_amdgcn_cvt_pk_fp8_f32(d[2] * sc, d[3] * sc, w3, true);
            *(u32x4*)(dst + (size_t)row * D + F.lane * 16) = (u32x4){(unsigned)w0, (unsigned)w1, (unsigned)w2, (unsigned)w3};
            if (F.lane == 0) sinv[row] = am > 0.f ? am * (1.f / 224.f) : 1.f;
            continue;
        }
        for (int e = F.tid; e < (NMIXP - NMIX) * D; e += NTHREADS) F.WIN[(size_t)NMIX * D + e] = 0;
        for (int e = F.tid; e < 128 * 64; e += NTHREADS) { F.K1[e] = f2bf(F.peer_k1[e]); F.K2[e] = f2bf(F.peer_k2[e]); }
    }
}

__device__ __forceinline__ void p1_modulate(const Frame& F) {
    for (int m = F.bid * 8 + F.wave; m < NT; m += F.G * 8) {
        const float* xr = x_row(F, m); const float* mr = F.MOD + (size_t)mod_row(m) * 6144;
#pragma unroll
        for (int hlf = 0; hlf < 2; ++hlf) {
            const int e = hlf * 512 + F.lane * 8;
            const f32x4 x0 = *(const f32x4*)(xr + e), x1 = *(const f32x4*)(xr + e + 4);
            const f32x4 s0 = *(const f32x4*)(mr + 1024 + e), s1 = *(const f32x4*)(mr + 1024 + e + 4);
            const f32x4 h0 = *(const f32x4*)(mr + e), h1 = *(const f32x4*)(mr + e + 4);
            const f32x4 a = x0 * (s0 + 1.f) + h0, b = x1 * (s1 + 1.f) + h1;
            *(u32x4*)(F.H1 + (size_t)m * D + e) = (u32x4){cvt_pk_bf16(a[0], a[1]), cvt_pk_bf16(a[2], a[3]), cvt_pk_bf16(b[0], b[1]), cvt_pk_bf16(b[2], b[3])};
        }
    }
}

constexpr int BM = 256, BN = 128, BK = 64;
constexpr int XPANEL = BM * 32 + 32, WPANEL = BN * 32 + 32;
constexpr int XSTAGE = 4 * XPANEL, WSTAGE = 4 * WPANEL, GSTAGE = XSTAGE + WSTAGE;
__device__ __forceinline__ void gemm_accum(const Frame& F, f32x16 (&acc)[2][2], const bf16_t* __restrict__ X, int ldx, const bf16_t* __restrict__ W, int ldw, int K, int m0, int n0) {
    const int tid = F.tid, lane = F.lane, r = lane & 31, h = lane >> 5, wm = F.wave >> 1, wn = F.wave & 1;
    u32x4 xr[4], wr[2];
    const int nk = K / BK;
    const int crow = tid >> 3, ckc = tid & 7;
    const bf16_t* xg = X + (size_t)(m0 + crow) * ldx + ckc * 8;
    const bf16_t* wg = W + (size_t)(n0 + crow) * ldw + ckc * 8;
    const int ldso = (ckc >> 1) * 1  ;
    const int xoff = ldso * XPANEL + crow * 32 + (ckc & 1) * 16;
    const int woff = ldso * WPANEL + crow * 32 + (ckc & 1) * 16;
#pragma unroll
    for (int i = 0; i < 4; ++i) xr[i] = *(const u32x4*)(xg + (size_t)(64 * i) * ldx);
#pragma unroll
    for (int i = 0; i < 2; ++i) wr[i] = *(const u32x4*)(wg + (size_t)(64 * i) * ldw);
    __syncthreads();
    for (int kt = 0; kt < nk; ++kt) {
        LAS unsigned char* st = F.lds + (kt & 1) * GSTAGE;
#pragma unroll
        for (int i = 0; i < 4; ++i) *(LAS u32x4*)(st + xoff + i * 64 * 32) = xr[i];
#pragma unroll
        for (int i = 0; i < 2; ++i) *(LAS u32x4*)(st + XSTAGE + woff + i * 64 * 32) = wr[i];
        __syncthreads();
        if (kt + 1 < nk) {
#pragma unroll
            for (int i = 0; i < 4; ++i) xr[i] = *(const u32x4*)(xg + (size_t)(64 * i) * ldx + (kt + 1) * BK);
#pragma unroll
            for (int i = 0; i < 2; ++i) wr[i] = *(const u32x4*)(wg + (size_t)(64 * i) * ldw + (kt + 1) * BK);
        }
#pragma unroll
        for (int s = 0; s < 4; ++s) {
            bf16x8 a[2], b[2];
#pragma unroll
            for (int ni = 0; ni < 2; ++ni) a[ni] = *(LAS bf16x8*)(st + XSTAGE + s * WPANEL + (wn * 64 + ni * 32 + r) * 32 + h * 16);
#pragma unroll
            for (int mi = 0; mi < 2; ++mi) b[mi] = *(LAS bf16x8*)(st + s * XPANEL + (wm * 64 + mi * 32 + r) * 32 + h * 16);
#pragma unroll
            for (int mi = 0; mi < 2; ++mi)
#pragma unroll
                for (int ni = 0; ni < 2; ++ni) acc[mi][ni] = __builtin_amdgcn_mfma_f32_32x32x16_bf16(a[ni], b[mi], acc[mi][ni], 0, 0, 0);
        }
    }
}
#define GEMM_EPI_LOOP(...) \
    { const int r_ = F.lane & 31, h_ = F.lane >> 5, wm_ = F.wave >> 1, wn_ = F.wave & 1; \
      _Pragma("unroll") for (int mi = 0; mi < 2; ++mi) _Pragma("unroll") for (int ni = 0; ni < 2; ++ni) _Pragma("unroll") for (int g = 0; g < 4; ++g) { \
          const int m = m0 + wm_ * 64 + mi * 32 + r_; const int n = n0 + wn_ * 64 + ni * 32 + 8 * g + 4 * h_; __VA_ARGS__ } }
#define ACC4(A) ((f32x4){A[mi][ni][4 * g], A[mi][ni][4 * g + 1], A[mi][ni][4 * g + 2], A[mi][ni][4 * g + 3]})
__device__ __forceinline__ void zero_acc(f32x16 (&acc)[2][2]) {
#pragma unroll
    for (int mi = 0; mi < 2; ++mi)
#pragma unroll
        for (int ni = 0; ni < 2; ++ni)
#pragma unroll
            for (int e = 0; e < 16; ++e) acc[mi][ni][e] = 0.f;
}
__device__ __forceinline__ u32x2 pk4(const f32x4 v) { return (u32x2){cvt_pk_bf16(v[0], v[1]), cvt_pk_bf16(v[2], v[3])}; }

__device__ __forceinline__ void p2_gemm_in(const Frame& F) {
    const int ntile = (NT / BM) * (NMIXP / BN);
    for (int t = F.bid; t < ntile; t += F.G) {
        const int m0 = (t / (NMIXP / BN)) * BM, n0 = (t % (NMIXP / BN)) * BN;
        f32x16 acc[2][2]; zero_acc(acc);
        gemm_accum(F, acc, F.H1, D, F.WIN, D, D, m0, n0);
        GEMM_EPI_LOOP({
            const f32x4 v = ACC4(acc);
            *(u32x2*)(F.PROJ + (size_t)m * NMIXP + n) = pk4(v);
            if (n >= C_K && n < C_QI) {
                float* o = (n < C_V) ? (m < NTP ? F.out + O_KP + (size_t)m * 128 + (n - C_K) : F.out + O_KS + (size_t)(m - NTP) * 128 + (n - C_K))
                                     : (m < NTP ? F.out + O_VP + (size_t)m * 128 + (n - C_V) : F.out + O_VS + (size_t)(m - NTP) * 128 + (n - C_V));
                *(f32x4*)o = v;
                if (n >= C_V && m < NTP) {
                    bf16_t* vt = (bf16_t*)(F.ws + WS_VT) + ((size_t)((m >> 11) * 2 + ((n - C_V) >> 6)) * 64 + ((n - C_V) & 63)) * SEQ + (m & 2047);
                    vt[0] = f2bf(v[0]); vt[SEQ] = f2bf(v[1]); vt[2 * SEQ] = f2bf(v[2]); vt[3 * SEQ] = f2bf(v[3]);
                }
            } else if (n >= C_KI && n < C_BG) {
                float* o = m < NTP ? F.out + O_KIP + (size_t)m * 64 + (n - C_KI) : F.out + O_KIS + (size_t)(m - NTP) * 64 + (n - C_KI);
                *(f32x4*)o = v;
            } else if (n == C_WI) {
                *(f32x4*)(F.WI + (size_t)m * 4) = v;
            } else if (n >= C_CG && n < C_GA) {
                const int tt = (m < NTP) ? (m & 2047) - (SEQ - 2) : ((m - NTP) & 7) - (TS - 2);
                if (tt >= 0) {
                    const int rowi = (m < NTP) ? (m >> 11) * 2 + tt : 2 * NB_P + ((m - NTP) >> 3) * 2 + tt;
                    *(f32x4*)((float*)(F.ws + WS_CGX) + (size_t)rowi * 1024 + (n - C_CG)) = v;
                }
            }
        })
    }
}

constexpr int SROW = 2052;
__device__ __forceinline__ int wave_sum_i(int v) {
#pragma unroll
    for (int o = 32; o >= 1; o >>= 1) v += __shfl_xor(v, o);
    return v;
}
__device__ __forceinline__ void cnt_ge(int& c, unsigned u, unsigned t) { asm("v_cmp_ge_u32_e32 vcc, %1, %2\n\tv_addc_co_u32_e32 %0, vcc, 0, %0, vcc" : "+v"(c) : "v"(u), "v"(t) : "vcc"); }
__device__ __forceinline__ void cnt_gt(int& c, unsigned u, unsigned t) { asm("v_cmp_gt_u32_e32 vcc, %1, %2\n\tv_addc_co_u32_e32 %0, vcc, 0, %0, vcc" : "+v"(c) : "v"(u), "v"(t) : "vcc"); }
__device__ __forceinline__ void cnt_eq(int& c, unsigned u, unsigned t) { asm("v_cmp_eq_u32_e32 vcc, %1, %2\n\tv_addc_co_u32_e32 %0, vcc, 0, %0, vcc" : "+v"(c) : "v"(u), "v"(t) : "vcc"); }
__device__ __forceinline__ void cnt_eq_pos(int& c, unsigned u, unsigned t, int L) {
    int tmp;
    asm("v_cmp_eq_u32_e32 vcc, %2, %3\n\tv_cndmask_b32_e32 %1, %5, %4, vcc\n\tv_cmp_lt_i32_e32 vcc, 0, %1\n\tv_addc_co_u32_e32 %0, vcc, 0, %0, vcc"
        : "+v"(c), "=&v"(tmp) : "v"(u), "v"(t), "v"(L), "v"(0x80000000) : "vcc");
}
__device__ __forceinline__ int wave_sum_i_dpp(int v) {
    v += __builtin_amdgcn_update_dpp(0, v, 0xB1, 0xF, 0xF, false);
    v += __builtin_amdgcn_update_dpp(0, v, 0x4E, 0xF, 0xF, false);
    v += __builtin_amdgcn_update_dpp(0, v, 0x141, 0xF, 0xF, false);
    v += __builtin_amdgcn_update_dpp(0, v, 0x140, 0xF, 0xF, false);
    v += __builtin_amdgcn_update_dpp(0, v, 0x142, 0xA, 0xF, false);
    v += __builtin_amdgcn_update_dpp(0, v, 0x143, 0xC, 0xF, false);
    return __builtin_amdgcn_readlane(v, 63);
}
template <int NV> __device__ __forceinline__ void select_threshold(const unsigned (&u)[NV], int ksel, int idx_bits, int lane, unsigned& T_out, int& Jx_out, int& ngt_out) {
    unsigned T = 0;
#pragma unroll 1
    for (int bit = 31; bit >= 0; --bit) {
        const unsigned cand = T | (1u << bit);
        int c = 0;
#pragma unroll
        for (int i = 0; i < NV; ++i) cnt_ge(c, u[i], cand);
        c = wave_sum_i_dpp(c);
        if (c >= ksel) T = cand;
    }
    int cg = 0, ce = 0;
#pragma unroll
    for (int i = 0; i < NV; ++i) { cnt_gt(cg, u[i], T); cnt_eq(ce, u[i], T); }
    const int ngt = wave_sum_i_dpp(cg), neq = wave_sum_i_dpp(ce);
    const int need = ksel - ngt;
    int Jx = 0x3FFFFFFF;
    if (need < neq) {
        int Jb = 0;
#pragma unroll 1
        for (int bit = idx_bits - 1; bit >= 0; --bit) {
            const int cand = Jb | (1 << bit);
            const int L = cand - lane;
            int c = 0;
#pragma unroll
            for (int i = 0; i < NV; ++i) cnt_eq_pos(c, u[i], T, L - 64 * i);
            c = wave_sum_i_dpp(c);
            if (c < need) Jb = cand;
        }
        Jx = Jb + 1;
    }
    T_out = T; Jx_out = Jx; ngt_out = ngt;
}
template <int NV> __device__ __forceinline__ void select_threshold2(const unsigned (&ua)[NV], const unsigned (&ub)[NV], int ksel, int idx_bits, int lane,
                                                                   unsigned& Ta_out, int& Jxa_out, unsigned& Tb_out, int& Jxb_out) {
    unsigned Ta = 0, Tb = 0;
#pragma unroll 1
    for (int bit = 31; bit >= 0; --bit) {
        const unsigned ca = Ta | (1u << bit), cb = Tb | (1u << bit);
        int a0 = 0, a1 = 0, b0 = 0, b1 = 0;
#pragma unroll
        for (int i = 0; i < NV; i += 2) { cnt_ge(a0, ua[i], ca); cnt_ge(b0, ub[i], cb); cnt_ge(a1, ua[i + 1], ca); cnt_ge(b1, ub[i + 1], cb); }
        const int na = wave_sum_i_dpp(a0 + a1), nb = wave_sum_i_dpp(b0 + b1);
        if (na >= ksel) Ta = ca;
        if (nb >= ksel) Tb = cb;
    }
    int ga = 0, ea = 0, gb = 0, eb = 0;
#pragma unroll
    for (int i = 0; i < NV; ++i) { cnt_gt(ga, ua[i], Ta); cnt_eq(ea, ua[i], Ta); cnt_gt(gb, ub[i], Tb); cnt_eq(eb, ub[i], Tb); }
    const int needa = ksel - wave_sum_i_dpp(ga), neqa = wave_sum_i_dpp(ea), needb = ksel - wave_sum_i_dpp(gb), neqb = wave_sum_i_dpp(eb);
    int Jxa = 0x3FFFFFFF, Jxb = 0x3FFFFFFF;
    if (needa < neqa) {
        int Jb = 0;
#pragma unroll 1
        for (int bit = idx_bits - 1; bit >= 0; --bit) {
            const int cand = Jb | (1 << bit); const int L = cand - lane; int c = 0;
#pragma unroll
            for (int i = 0; i < NV; ++i) cnt_eq_pos(c, ua[i], Ta, L - 64 * i);
            if (wave_sum_i_dpp(c) < needa) Jb = cand;
        }
        Jxa = Jb + 1;
    }
    if (needb < neqb) {
        int Jb = 0;
#pragma unroll 1
        for (int bit = idx_bits - 1; bit >= 0; --bit) {
            const int cand = Jb | (1 << bit); const int L = cand - lane; int c = 0;
#pragma unroll
            for (int i = 0; i < NV; ++i) cnt_eq_pos(c, ub[i], Tb, L - 64 * i);
            if (wave_sum_i_dpp(c) < needb) Jb = cand;
        }
        Jxb = Jb + 1;
    }
    Ta_out = Ta; Jxa_out = Jxa; Tb_out = Tb; Jxb_out = Jxb;
}
template <int NV> __device__ __forceinline__ void select_topk(const unsigned (&u)[NV], int ksel, int idx_bits, int* sel, int lane) {
    unsigned T; int Jx, ngt;
    select_threshold<NV>(u, ksel, idx_bits, lane, T, Jx, ngt);
    const int L = Jx - lane;
    int cg = 0, ct = 0;
#pragma unroll
    for (int i = 0; i < NV; ++i) { cnt_gt(cg, u[i], T); cnt_eq_pos(ct, u[i], T, L - 64 * i); }
    int ig = cg, it = ct;
#pragma unroll
    for (int o = 1; o < 64; o <<= 1) { const int a = __shfl_up(ig, o), b2 = __shfl_up(it, o); if (lane >= o) { ig += a; it += b2; } }
    int pg = ig - cg, pt = ngt + it - ct;
    int ev = lane, Lr = L;
#pragma unroll
    for (int i = 0; i < NV; ++i) {
        if (u[i] > T) { sel[pg] = ev; ++pg; }
        else if (u[i] == T && Lr > 0) { sel[pt] = ev; ++pt; }
        asm volatile("v_add_u32 %0, 64, %0\n\tv_add_u32 %1, -64, %1" : "+v"(ev), "+v"(Lr));
    }
}

constexpr int PU_MB = 16 * SROW * 4;
constexpr int PU_RB = PU_MB + 16 * 64 * 4;
constexpr int PU_BT = PU_RB + 1024;
constexpr int PU_QT = PU_BT + 512, PU_QROW = 1040;
__device__ __forceinline__ int kappa32(int r) { return (r & 0x13) | ((r & 4) << 1) | ((r & 8) >> 1); }
__device__ __forceinline__ void p3_prompt_fused_unit(const Frame& F, const bf16_t* VT, int b, int qt) {
    LAS float* S = (LAS float*)F.lds;
    LAS unsigned* MB = (LAS unsigned*)(F.lds + PU_MB);
    LAS float* RB = (LAS float*)(F.lds + PU_RB);
    LAS int* BT = (LAS int*)(F.lds + PU_BT);
    const int lane = F.lane;
    const int q0 = qt * 16; const size_t tok0 = (size_t)b * SEQ;
    __syncthreads();
    for (int ch = F.tid; ch < 16 * 64; ch += NTHREADS)
        *(LAS u32x4*)(F.lds + PU_QT + (ch >> 6) * PU_QROW + (ch & 63) * 16) = *(const u32x4*)(F.PROJ + (tok0 + q0 + (ch >> 6)) * NMIXP + C_Q + (ch & 63) * 8);
    {
        const int r = lane & 15, q4 = lane >> 4;
        bf16x8 A[4][2];
#pragma unroll
        for (int hh = 0; hh < 4; ++hh)
#pragma unroll
            for (int s2 = 0; s2 < 2; ++s2) A[hh][s2] = *(const bf16x8*)(F.PROJ + (tok0 + q0 + r) * NMIXP + C_QI + hh * 64 + s2 * 32 + q4 * 8);
        float wv[4][4];
#pragma unroll
        for (int g = 0; g < 4; ++g) { const f32x4 w4 = *(const f32x4*)(F.WI + (tok0 + q0 + 4 * q4 + g) * 4);
#pragma unroll
            for (int hh = 0; hh < 4; ++hh) wv[g][hh] = w4[hh] * IDX_SCALE; }
        const int nkt = qt + 1;
        bf16x8 Bn[2][2];
        {
            const int t0 = 2 * F.wave;
#pragma unroll
            for (int p = 0; p < 2; ++p)
#pragma unroll
                for (int s2 = 0; s2 < 2; ++s2) { const int key = (t0 + p < nkt ? t0 + p : 0) * 16 + r; Bn[p][s2] = *(const bf16x8*)(F.PROJ + (tok0 + key) * NMIXP + C_KI + s2 * 32 + q4 * 8); }
        }
#pragma unroll 1
        for (int t0 = 2 * F.wave; t0 < nkt; t0 += 16) {
            bf16x8 B[2][2] = {{Bn[0][0], Bn[0][1]}, {Bn[1][0], Bn[1][1]}};
            {
                const int tn = t0 + 16;
#pragma unroll
                for (int p = 0; p < 2; ++p)
#pragma unroll
                    for (int s2 = 0; s2 < 2; ++s2) { const int key = (tn + p < nkt ? tn + p : 0) * 16 + r; Bn[p][s2] = *(const bf16x8*)(F.PROJ + (tok0 + key) * NMIXP + C_KI + s2 * 32 + q4 * 8); }
            }
#pragma unroll
            for (int p = 0; p < 2; ++p) {
                if (t0 + p >= nkt) continue;
                float sc[4] = {0.f, 0.f, 0.f, 0.f};
#pragma unroll
                for (int hh = 0; hh < 4; ++hh) {
                    f32x4 c = {0.f, 0.f, 0.f, 0.f};
                    c = __builtin_amdgcn_mfma_f32_16x16x32_bf16(A[hh][0], B[p][0], c, 0, 0, 0);
                    c = __builtin_amdgcn_mfma_f32_16x16x32_bf16(A[hh][1], B[p][1], c, 0, 0, 0);
#pragma unroll
                    for (int g = 0; g < 4; ++g) sc[g] += fmaxf(c[g], 0.f) * wv[g][hh];
                }
#pragma unroll
                for (int g = 0; g < 4; ++g) S[(4 * q4 + g) * SROW + (t0 + p) * 16 + r] = sc[g];
            }
        }
    }
    __syncthreads();
    {
        const int rowa = F.wave * 2, rowb = rowa + 1;
        const int nva = q0 + rowa + 1, nvb = nva + 1;
        if (nvb <= NSEL) {
#pragma unroll
            for (int i = 0; i < 32; ++i) {
                const unsigned long long ma = __ballot(lane + 64 * i < nva), mb = __ballot(lane + 64 * i < nvb);
                if (lane == 0) { MB[rowa * 64 + 2 * i] = (unsigned)ma; MB[rowa * 64 + 2 * i + 1] = (unsigned)(ma >> 32); MB[rowb * 64 + 2 * i] = (unsigned)mb; MB[rowb * 64 + 2 * i + 1] = (unsigned)(mb >> 32); }
            }
        } else {
            unsigned ua[32], ub[32];
#pragma unroll
            for (int i = 0; i < 32; ++i) { const int j = lane + 64 * i; ua[i] = (j < nva) ? f2ord(S[rowa * SROW + j]) : 0u; ub[i] = (j < nvb) ? f2ord(S[rowb * SROW + j]) : 0u; }
            unsigned Ta, Tb; int Jxa, Jxb;
            select_threshold2<32>(ua, ub, NSEL, 11, lane, Ta, Jxa, Tb, Jxb);
            const int La = Jxa - lane, Lb = Jxb - lane;
#pragma unroll
            for (int i = 0; i < 32; ++i) {
                const bool ta = (ua[i] > Ta) || (ua[i] == Ta && (La - 64 * i) > 0), tb = (ub[i] > Tb) || (ub[i] == Tb && (Lb - 64 * i) > 0);
                const unsigned long long ma = __ballot(ta), mb = __ballot(tb);
                if (lane == 0) { MB[rowa * 64 + 2 * i] = (unsigned)ma; MB[rowa * 64 + 2 * i + 1] = (unsigned)(ma >> 32); MB[rowb * 64 + 2 * i] = (unsigned)mb; MB[rowb * 64 + 2 * i + 1] = (unsigned)(mb >> 32); }
            }
        }
    }
    __syncthreads();
    {
        const int g = F.wave & 1, kq = F.wave >> 1;
        const int c = lane & 31, h = lane >> 5;
        const int hd = g * 4 + (c & 3);
        LAS const unsigned char* Qb = F.lds + PU_QT + (c >> 2) * PU_QROW + (hd * 64 + h * 8) * 2;
        const float b31 = RB[31 * 8 + hd];
        const int ntile = ((q0 + 15) >> 5) + 1;
        const bf16_t* Kb = F.PROJ + (tok0 + kappa32(c)) * NMIXP + C_K + g * 64 + h * 8;
        const bf16_t* Vb = VT + ((size_t)((b * 2 + g) * 64 + c)) * SEQ + h * 8;
        f32x16 O[2][2];
#pragma unroll
        for (int rt = 0; rt < 2; ++rt)
#pragma unroll
            for (int d = 0; d < 2; ++d)
#pragma unroll
                for (int e = 0; e < 16; ++e) O[rt][d][e] = 0.f;
        float lsum[2] = {0.f, 0.f};
        bf16x8 Kn[4];
        {
            const int key0 = (kq < ntile ? kq : 0) * 32;
#pragma unroll
            for (int s4 = 0; s4 < 4; ++s4) Kn[s4] = *(const bf16x8*)(Kb + (size_t)key0 * NMIXP + s4 * 16);
        }
#pragma unroll 1
        for (int kt = kq; kt < ntile; kt += 4) {
            const int key0 = kt * 32;
            bf16x8 Kf[4] = {Kn[0], Kn[1], Kn[2], Kn[3]}, Vf[2][2];
#pragma unroll
            for (int d = 0; d < 2; ++d)
#pragma unroll
                for (int s2 = 0; s2 < 2; ++s2) Vf[d][s2] = *(const bf16x8*)(Vb + (size_t)(32 * d) * SEQ + key0 + 16 * s2);
            {
                const int keyn = (kt + 4 < ntile ? kt + 4 : 0) * 32;
#pragma unroll
                for (int s4 = 0; s4 < 4; ++s4) Kn[s4] = *(const bf16x8*)(Kb + (size_t)keyn * NMIXP + s4 * 16);
            }
#pragma unroll
            for (int rt = 0; rt < 2; ++rt) {
                const int ql = rt * 8 + (c >> 2), q = q0 + ql;
                f32x16 X;
#pragma unroll
                for (int e = 0; e < 16; ++e) X[e] = 0.f;
#pragma unroll
                for (int s4 = 0; s4 < 4; ++s4) X = __builtin_amdgcn_mfma_f32_32x32x16_bf16(Kf[s4], *(LAS const bf16x8*)(Qb + rt * 8 * PU_QROW + s4 * 32), X, 0, 0, 0);
                const unsigned word = MB[ql * 64 + kt];
                const unsigned bits = ((word >> (8 * h)) & 0xFFu) | (((word >> (16 + 8 * h)) & 0xFFu) << 8);
                const bool nearT = (q0 + rt * 8) - (key0 + 31) < 113;
#pragma unroll
                for (int s2 = 0; s2 < 2; ++s2) {
                    float P[8];
                    if (nearT) {
#pragma unroll
                        for (int e8 = 0; e8 < 8; ++e8) {
                            const int e = 8 * s2 + e8;
                            const int key = key0 + e8 + 16 * s2 + 8 * h;
                            int dist = q - key; dist = dist < 0 ? 0 : (dist > 127 ? 127 : dist);
                            const float bias = RB[BT[dist] * 8 + hd];
                            const float lg = fminf(X[e] * ATTN_SCALE + bias, 60.f);
                            P[e8] = ((bits >> e) & 1u) ? __expf(lg) : 0.f;
                        }
                    } else {
#pragma unroll
                        for (int e8 = 0; e8 < 8; ++e8) {
                            const int e = 8 * s2 + e8;
                            const float lg = fminf(X[e] * ATTN_SCALE + b31, 60.f);
                            P[e8] = ((bits >> e) & 1u) ? __expf(lg) : 0.f;
                        }
                    }
#pragma unroll
                    for (int e8 = 0; e8 < 8; ++e8) lsum[rt] += P[e8];
                    const u32x4 pk = (u32x4){cvt_pk_bf16(P[0], P[1]), cvt_pk_bf16(P[2], P[3]), cvt_pk_bf16(P[4], P[5]), cvt_pk_bf16(P[6], P[7])};
                    bf16x8 Pf; __builtin_memcpy(&Pf, &pk, 16);
                    O[rt][0] = __builtin_amdgcn_mfma_f32_32x32x16_bf16(Vf[0][s2], Pf, O[rt][0], 0, 0, 0);
                    O[rt][1] = __builtin_amdgcn_mfma_f32_32x32x16_bf16(Vf[1][s2], Pf, O[rt][1], 0, 0, 0);
                }
                __builtin_amdgcn_sched_barrier(0);
            }
        }
        LAS float* CB = (LAS float*)F.lds + (g * 3 + (kq > 0 ? kq - 1 : 0)) * (66 * 64);
        __syncthreads();
        if (kq > 0) {
#pragma unroll
            for (int rt = 0; rt < 2; ++rt) {
#pragma unroll
                for (int d = 0; d < 2; ++d)
#pragma unroll
                    for (int e = 0; e < 16; ++e) CB[((rt * 2 + d) * 16 + e) * 64 + lane] = O[rt][d][e];
                CB[(64 + rt) * 64 + lane] = lsum[rt];
            }
        }
        __syncthreads();
        if (kq == 0) {
#pragma unroll 1
            for (int p = 0; p < 3; ++p) {
                LAS const float* CP = (LAS const float*)F.lds + (g * 3 + p) * (66 * 64);
#pragma unroll
                for (int rt = 0; rt < 2; ++rt) {
#pragma unroll
                    for (int d = 0; d < 2; ++d)
#pragma unroll
                        for (int e = 0; e < 16; ++e) O[rt][d][e] += CP[((rt * 2 + d) * 16 + e) * 64 + lane];
                    lsum[rt] += CP[(64 + rt) * 64 + lane];
                }
            }
#pragma unroll
            for (int rt = 0; rt < 2; ++rt) {
                float l = lsum[rt]; l += __shfl_xor(l, 32);
                const float inv = 1.f / l;
                bf16_t* orow = F.OATT + (tok0 + q0 + rt * 8 + (c >> 2)) * 512 + hd * 64;
#pragma unroll
                for (int a4 = 0; a4 < 4; ++a4) {
                    const f32x4 v0 = (f32x4){O[rt][0][4 * a4], O[rt][0][4 * a4 + 1], O[rt][0][4 * a4 + 2], O[rt][0][4 * a4 + 3]} * inv;
                    const f32x4 v1 = (f32x4){O[rt][1][4 * a4], O[rt][1][4 * a4 + 1], O[rt][1][4 * a4 + 2], O[rt][1][4 * a4 + 3]} * inv;
                    *(u32x2*)(orow + 8 * a4 + 4 * h) = pk4(v0);
                    *(u32x2*)(orow + 32 + 8 * a4 + 4 * h) = pk4(v1);
                }
            }
        }
    }
}

__device__ __forceinline__ void p3_sample_score_unit(const Frame& F, float* SS, int b, int ch) {
    const int lane = F.lane, r = lane & 31, h = lane >> 5;
    bf16x8 A[4];
    { const int q = r >> 2, hh = r & 3;
#pragma unroll
      for (int s4 = 0; s4 < 4; ++s4) A[s4] = *(const bf16x8*)(F.PROJ + (size_t)(NTP + b * TS + q) * NMIXP + C_QI + hh * 64 + s4 * 16 + h * 8); }
    float wv[4][4];
#pragma unroll
    for (int g = 0; g < 4; ++g) { const f32x4 w4 = *(const f32x4*)(F.WI + (size_t)(NTP + b * TS + 2 * g + h) * 4);
#pragma unroll
        for (int hh = 0; hh < 4; ++hh) wv[g][hh] = w4[hh] * IDX_SCALE; }
    f32x4 kn[8];
    { const int key0 = ch * 1024 + F.wave * 32; const int page = F.page_table[b * NPAGES + (key0 >> 7)];
      const float* kr = F.cache_ki + ((size_t)page * PAGE + (key0 & 127) + r) * 64 + h * 8;
#pragma unroll
      for (int s4 = 0; s4 < 4; ++s4) { kn[2 * s4] = *(const f32x4*)(kr + s4 * 16); kn[2 * s4 + 1] = *(const f32x4*)(kr + s4 * 16 + 4); } }
#pragma unroll 1
    for (int tl = F.wave; tl < 32; tl += 8) {
        const int key0 = ch * 1024 + tl * 32;
        f32x4 kc[8];
#pragma unroll
        for (int i = 0; i < 8; ++i) kc[i] = kn[i];
        if (tl + 8 < 32) {
            const int keyn = key0 + 256; const int page = F.page_table[b * NPAGES + (keyn >> 7)];
            const float* kr = F.cache_ki + ((size_t)page * PAGE + (keyn & 127) + r) * 64 + h * 8;
#pragma unroll
            for (int s4 = 0; s4 < 4; ++s4) { kn[2 * s4] = *(const f32x4*)(kr + s4 * 16); kn[2 * s4 + 1] = *(const f32x4*)(kr + s4 * 16 + 4); }
        }
        f32x16 c;
#pragma unroll
        for (int e = 0; e < 16; ++e) c[e] = 0.f;
#pragma unroll
        for (int s4 = 0; s4 < 4; ++s4) {
            const f32x4 lo = kc[2 * s4], hi = kc[2 * s4 + 1];
            const u32x4 pk = (u32x4){cvt_pk_bf16(lo[0], lo[1]), cvt_pk_bf16(lo[2], lo[3]), cvt_pk_bf16(hi[0], hi[1]), cvt_pk_bf16(hi[2], hi[3])};
            bf16x8 Bf; __builtin_memcpy(&Bf, &pk, 16);
            c = __builtin_amdgcn_mfma_f32_32x32x16_bf16(A[s4], Bf, c, 0, 0, 0);
        }
#pragma unroll
        for (int g = 0; g < 4; ++g) {
            float sc = 0.f;
#pragma unroll
            for (int hh = 0; hh < 4; ++hh) sc += fmaxf(c[4 * g + hh], 0.f) * wv[g][hh];
            SS[(size_t)(b * TS + 2 * g + h) * PAST + key0 + r] = sc;
        }
    }
}
__device__ __forceinline__ void p3_index(const Frame& F) {
    constexpr int NSU = NB_S * 8;
    const int nunits = NSU + NB_P * (SEQ / 16);
    float* SS = (float*)(F.ws + WS_SS);
    const bf16_t* VT = (const bf16_t*)(F.ws + WS_VT);
    __syncthreads();
    if (F.tid < 256) ((LAS float*)(F.lds + PU_RB))[F.tid] = F.rel_bias[F.tid];
    if (F.tid < 128) ((LAS int*)(F.lds + PU_BT))[F.tid] = t5_bucket(F.tid);
    __syncthreads();
    for (int it = F.bid; it < nunits; it += F.G) {
        if (it < NSU) { p3_sample_score_unit(F, SS, it >> 3, it & 7); continue; }
        const int i = it - NSU; const int b = i & 7, sl = (i >> 3) & 31, rnd = i >> 8;
        const int qt = rnd == 0 ? 127 - sl : (rnd == 1 ? 64 + sl : (rnd == 2 ? 63 - sl : sl));
        p3_prompt_fused_unit(F, VT, b, qt);
    }
}

constexpr int SQ_CNT = 0;
constexpr int SQ_SEL = 1024;
constexpr int SQ_Q = 2048;
constexpr int SQ_P = 4096;
constexpr int SQ_RB = 16384;
constexpr int SQ_BT = 17408;
__device__ __forceinline__ int wg_sum8(const Frame& F, LAS unsigned* slot, int v) {
    if (F.lane == 0) slot[F.wave] = (unsigned)v;
    __syncthreads();
    int t = 0;
#pragma unroll
    for (int w = 0; w < 8; ++w) t += (int)slot[w];
    return t;
}
__device__ __forceinline__ void p4_sample_query_unit(const Frame& F, const float* SS, int b, int t) {
    const int lane = F.lane, w = F.wave;
    LAS unsigned* CNT = (LAS unsigned*)(F.lds + SQ_CNT);
    LAS int* SELL = (LAS int*)(F.lds + SQ_SEL);
    LAS unsigned* QL = (LAS unsigned*)(F.lds + SQ_Q);
    LAS float* PL = (LAS float*)(F.lds + SQ_P) + w * 256;
    LAS float* RB = (LAS float*)(F.lds + SQ_RB);
    LAS int* BT = (LAS int*)(F.lds + SQ_BT);
    const int tok = NTP + b * TS + t;
    __syncthreads();
    if (F.tid < 256) QL[F.tid] = ((const unsigned*)(F.PROJ + (size_t)tok * NMIXP + C_Q))[F.tid];
    unsigned u[17];
    { const float* srow = SS + (size_t)(b * TS + t) * PAST + w * 1024;
#pragma unroll
      for (int i = 0; i < 16; ++i) u[i] = f2ord(srow[64 * i + lane]); }
    u[16] = 0u;
    if (w == 7) {
        float sc = 0.f;
        if (lane < TS) {
            const bf16_t* kn = F.PROJ + (size_t)(NTP + b * TS + lane) * NMIXP + C_KI;
            const bf16_t* qn = F.PROJ + (size_t)tok * NMIXP + C_QI;
            int vz; asm volatile("v_mov_b32 %0, 0" : "=v"(vz));
            const f32x4 w4 = *(const f32x4*)(F.WI + (size_t)tok * 4 + vz);
#pragma unroll 1
            for (int hh = 0; hh < 4; ++hh) {
                float d = 0.f;
#pragma unroll 8
                for (int e = 0; e < 64; ++e) d += bf2f(qn[hh * 64 + e]) * bf2f(kn[e]);
                sc += fmaxf(d, 0.f) * (w4[hh] * IDX_SCALE);
            }
        }
        u[16] = (lane < TS && lane <= t) ? f2ord(sc) : 0u;
    }
    unsigned T = 0;
#pragma unroll 1
    for (int bit = 31; bit >= 0; --bit) {
        const unsigned cand = T | (1u << bit);
        int c = 0;
#pragma unroll
        for (int i = 0; i < 17; ++i) cnt_ge(c, u[i], cand);
        c = wg_sum8(F, CNT + (bit & 1) * 24, wave_sum_i_dpp(c));
        if (c >= NSEL) T = cand;
    }
    int cg = 0, ce = 0;
#pragma unroll
    for (int i = 0; i < 17; ++i) { cnt_gt(cg, u[i], T); cnt_eq(ce, u[i], T); }
    const int cgw = wave_sum_i_dpp(cg);
    const int ngt = wg_sum8(F, CNT + 8, cgw);
    const int neq = wg_sum8(F, CNT + 16, wave_sum_i_dpp(ce));
    const int need = NSEL - ngt;
    int Jx = 0x3FFFFFFF;
    if (need < neq) {
        int Jb = 0;
#pragma unroll 1
        for (int bit = 13; bit >= 0; --bit) {
            const int cand = Jb | (1 << bit);
            const int L = cand - lane - 1024 * w;
            int c = 0;
#pragma unroll
            for (int i = 0; i < 17; ++i) cnt_eq_pos(c, u[i], T, L - 64 * i);
            c = wg_sum8(F, CNT + (bit & 1) * 24, wave_sum_i_dpp(c));
            if (c < need) Jb = cand;
        }
        Jx = Jb + 1;
    }
    {
        const int L = Jx - lane - 1024 * w;
        int ct = 0;
#pragma unroll
        for (int i = 0; i < 17; ++i) cnt_eq_pos(ct, u[i], T, L - 64 * i);
        const int ctw = wave_sum_i_dpp(ct);
        __syncthreads();
        if (lane == 0) { CNT[w] = (unsigned)cgw; CNT[8 + w] = (unsigned)ctw; }
        __syncthreads();
        int bg = 0, bt = ngt;
#pragma unroll
        for (int ww = 0; ww < 8; ++ww) { if (ww < w) { bg += (int)CNT[ww]; bt += (int)CNT[8 + ww]; } }
        int ig = cg, it2 = ct;
#pragma unroll
        for (int o = 1; o < 64; o <<= 1) { const int a = __shfl_up(ig, o), b2 = __shfl_up(it2, o); if (lane >= o) { ig += a; it2 += b2; } }
        int pg = bg + ig - cg, pt = bt + it2 - ct;
        int ev = 1024 * w + lane, Lr = L;
#pragma unroll
        for (int i = 0; i < 17; ++i) {
            if (u[i] > T) { SELL[pg] = ev; ++pg; }
            else if (u[i] == T && Lr > 0) { SELL[pt] = ev; ++pt; }
            asm volatile("v_add_u32 %0, 64, %0\n\tv_add_u32 %1, -64, %1" : "+v"(ev), "+v"(Lr));
        }
    }
    __syncthreads();
    {
        const int hd = w, g = w >> 2, qpos = PAST + t;
        float lg[4]; int sk[4];
#pragma unroll 1
        for (int i = 0; i < 4; ++i) {
            const int sraw = SELL[lane + 64 * i]; sk[i] = sraw;
            const float* kr;
            if (sraw < PAST) { const int page = F.page_table[b * NPAGES + (sraw >> 7)]; kr = F.cache_k + ((size_t)page * PAGE + (sraw & 127)) * 128 + g * 64; }
            else kr = F.out + O_KS + (size_t)(b * TS + (sraw - PAST)) * 128 + g * 64;
            float a0 = 0.f, a1 = 0.f;
#pragma unroll
            for (int c = 0; c < 16; ++c) {
                const f32x4 kv = *(const f32x4*)(kr + c * 4);
                const unsigned q0 = QL[hd * 32 + c * 2], q1 = QL[hd * 32 + c * 2 + 1];
                a0 += bflo(q0) * kv[0] + bfhi(q0) * kv[1]; a1 += bflo(q1) * kv[2] + bfhi(q1) * kv[3];
            }
            const int dist = qpos - sraw; const int bk = dist < 128 ? BT[dist] : 31;
            lg[i] = (a0 + a1) * ATTN_SCALE + RB[bk * 8 + hd];
        }
        float m = fmaxf(fmaxf(lg[0], lg[1]), fmaxf(lg[2], lg[3])); m = wave_max(m);
        float sm = 0.f;
#pragma unroll
        for (int i = 0; i < 4; ++i) { lg[i] = __expf(lg[i] - m); sm += lg[i]; }
        const float inv = 1.f / wave_sum_dpp(sm);
#pragma unroll
        for (int i = 0; i < 4; ++i) PL[lane + 64 * i] = lg[i] * inv;
        float o = 0.f;
#pragma unroll 8
        for (int j = 0; j < 256; ++j) {
            const int sraw = SELL[j]; const float p = PL[j];
            const float* vr;
            if (sraw < PAST) { const int page = F.page_table[b * NPAGES + (sraw >> 7)]; vr = F.cache_v + ((size_t)page * PAGE + (sraw & 127)) * 128 + g * 64; }
            else vr = F.out + O_VS + (size_t)(b * TS + (sraw - PAST)) * 128 + g * 64;
            o += p * vr[lane];
        }
        F.OATT[(size_t)tok * 512 + hd * 64 + lane] = f2bf(o);
    }
}
__device__ __forceinline__ void p4_attention(const Frame& F) {
    const float* SS = (const float*)(F.ws + WS_SS);
    __syncthreads();
    if (F.tid < 256) ((LAS float*)(F.lds + SQ_RB))[F.tid] = F.rel_bias[F.tid];
    if (F.tid < 128) ((LAS int*)(F.lds + SQ_BT))[F.tid] = t5_bucket(F.tid);
    __syncthreads();
    for (int it = F.bid; it < NTS; it += F.G) p4_sample_query_unit(F, SS, it >> 3, it & 7);
    for (int m = F.bid * 8 + F.wave; m < NT; m += F.G * 8) {
        int t, T_, bsm; if (m < NTP) { t = m & 2047; T_ = SEQ; bsm = m >> 11; } else { t = (m - NTP) & 7; T_ = TS; bsm = (m - NTP) >> 3; }
        const int c0 = F.lane * 8;
        float u0[8], u1[8], u2[8];
        { const u32x4 cg = *(const u32x4*)(F.PROJ + (size_t)m * NMIXP + C_CG + c0), xi = *(const u32x4*)(F.PROJ + (size_t)m * NMIXP + C_XIN + c0);
#pragma unroll
          for (int e = 0; e < 4; ++e) { u0[2 * e] = bflo(cg[e]) * bflo(xi[e]); u0[2 * e + 1] = bfhi(cg[e]) * bfhi(xi[e]); } }
#pragma unroll
        for (int d = 1; d <= 2; ++d) {
            float* ud = (d == 1) ? u1 : u2;
            if (t - d >= 0) {
                const u32x4 cg = *(const u32x4*)(F.PROJ + (size_t)(m - d) * NMIXP + C_CG + c0), xi = *(const u32x4*)(F.PROJ + (size_t)(m - d) * NMIXP + C_XIN + c0);
#pragma unroll
                for (int e = 0; e < 4; ++e) { ud[2 * e] = bflo(cg[e]) * bflo(xi[e]); ud[2 * e + 1] = bfhi(cg[e]) * bfhi(xi[e]); }
            } else if (m >= NTP) {
                const float* pv = F.state_conv + ((size_t)bsm * 2 + (2 + t - d)) * 512 + c0;
#pragma unroll
                for (int e = 0; e < 8; ++e) ud[e] = pv[e];
            } else {
#pragma unroll
                for (int e = 0; e < 8; ++e) ud[e] = 0.f;
            }
        }
        const u32x4 bg = *(const u32x4*)(F.PROJ + (size_t)m * NMIXP + C_BG + c0);
        float y[8];
#pragma unroll
        for (int e = 0; e < 8; ++e) {
            const int c = c0 + e;
            const float yy = F.conv_b[c] + F.conv_w[c] * u2[e] + F.conv_w[512 + c] * u1[e] + F.conv_w[1024 + c] * u0[e];
            const float bgv = (e & 1) ? bfhi(bg[e >> 1]) : bflo(bg[e >> 1]);
            y[e] = bgv * yy;
        }
        *(u32x4*)(F.OCONV + (size_t)m * 512 + c0) = (u32x4){cvt_pk_bf16(y[0], y[1]), cvt_pk_bf16(y[2], y[3]), cvt_pk_bf16(y[4], y[5]), cvt_pk_bf16(y[6], y[7])};
        if (t >= T_ - 2) {
            float* o = (m < NTP ? F.out + O_CP : F.out + O_CS) + ((size_t)bsm * 2 + (t - (T_ - 2))) * 512 + c0;
            const int rowi = (m < NTP) ? bsm * 2 + (t - (T_ - 2)) : 2 * NB_P + bsm * 2 + (t - (T_ - 2));
            const float* cx = (const float*)(F.ws + WS_CGX) + (size_t)rowi * 1024 + c0;
            const f32x4 ca = *(const f32x4*)cx, cb = *(const f32x4*)(cx + 4), xa = *(const f32x4*)(cx + 512), xb = *(const f32x4*)(cx + 516);
            *(f32x4*)o = ca * xa; *(f32x4*)(o + 4) = cb * xb;
        }
    }
}

__device__ __forceinline__ void p5_gemm_merge(const Frame& F) {
    const int ntile = (NT / BM) * (D / BN);
    for (int t = F.bid; t < ntile; t += F.G) {
        const int m0 = (t / (D / BN)) * BM, n0 = (t % (D / BN)) * BN;
        f32x16 acc[2][2], acc2[2][2]; zero_acc(acc); zero_acc(acc2);
        gemm_accum(F, acc, F.OATT, 512, F.WOA, 512, 512, m0, n0);
        gemm_accum(F, acc2, F.OCONV, 512, F.WOC, 512, 512, m0, n0);
        GEMM_EPI_LOOP({
            const f32x4 va = ACC4(acc), vc = ACC4(acc2);
            const u32x2 ga = *(const u32x2*)(F.PROJ + (size_t)m * NMIXP + C_GA + n), gb = *(const u32x2*)(F.PROJ + (size_t)m * NMIXP + C_GB + n);
            f32x4 o;
            o[0] = sigmoidf_(bflo(ga[0])) * va[0] + sigmoidf_(bflo(gb[0])) * vc[0];
            o[1] = sigmoidf_(bfhi(ga[0])) * va[1] + sigmoidf_(bfhi(gb[0])) * vc[1];
            o[2] = sigmoidf_(bflo(ga[1])) * va[2] + sigmoidf_(bflo(gb[1])) * vc[2];
            o[3] = sigmoidf_(bfhi(ga[1])) * va[3] + sigmoidf_(bfhi(gb[1])) * vc[3];
            *(u32x2*)(F.MERGED + (size_t)m * D + n) = pk4(o);
        })
    }
}
__device__ __forceinline__ void p6_gemm_out(const Frame& F) {
    const int ntile = (NT / BM) * (D / BN);
    for (int t = F.bid; t < ntile; t += F.G) {
        const int m0 = (t / (D / BN)) * BM, n0 = (t % (D / BN)) * BN;
        f32x16 acc[2][2]; zero_acc(acc);
        gemm_accum(F, acc, F.MERGED, D, F.WOUT, D, D, m0, n0);
        GEMM_EPI_LOOP({
            const f32x4 v = ACC4(acc);
            const f32x4 xv = *(const f32x4*)(x_row(F, m) + n);
            const f32x4 g1 = *(const f32x4*)(F.MOD + (size_t)mod_row(m) * 6144 + 2048 + n);
            *(f32x4*)(F.T1 + (size_t)m * D + n) = xv * DN_ALPHA + g1 * v;
        })
    }
}
__device__ __forceinline__ void p7_ln1(const Frame& F) {
    for (int m = F.bid * 8 + F.wave; m < NT; m += F.G * 8) {
        float* tr = F.T1 + (size_t)m * D; const float* mr = F.MOD + (size_t)mod_row(m) * 6144;
        f32x4 v[4]; float s = 0.f;
#pragma unroll
        for (int i = 0; i < 4; ++i) { v[i] = *(const f32x4*)(tr + (i >> 1) * 512 + F.lane * 8 + (i & 1) * 4); s += v[i][0] + v[i][1] + v[i][2] + v[i][3]; }
        const float mean = wave_sum(s) * (1.f / D);
        float q = 0.f;
#pragma unroll
        for (int i = 0; i < 4; ++i) { v[i] = v[i] - mean; q += v[i][0] * v[i][0] + v[i][1] * v[i][1] + v[i][2] * v[i][2] + v[i][3] * v[i][3]; }
        const float rstd = rsqrtf(wave_sum(q) * (1.f / D) + LN_EPS);
        f32x4 hv[2][2];
#pragma unroll
        for (int hlf = 0; hlf < 2; ++hlf) {
            const int e = hlf * 512 + F.lane * 8;
            f32x4 a = v[2 * hlf] * rstd * *(const f32x4*)(F.ln1_g + e) + *(const f32x4*)(F.ln1_b + e);
            f32x4 b = v[2 * hlf + 1] * rstd * *(const f32x4*)(F.ln1_g + e + 4) + *(const f32x4*)(F.ln1_b + e + 4);
            *(f32x4*)(tr + e) = a; *(f32x4*)(tr + e + 4) = b;
            const f32x4 ha = a * (*(const f32x4*)(mr + 4096 + e) + 1.f) + *(const f32x4*)(mr + 3072 + e);
            const f32x4 hb = b * (*(const f32x4*)(mr + 4096 + e + 4) + 1.f) + *(const f32x4*)(mr + 3072 + e + 4);
            *(u32x4*)(F.H2 + (size_t)m * D + e) = (u32x4){cvt_pk_bf16(ha[0], ha[1]), cvt_pk_bf16(ha[2], ha[3]), cvt_pk_bf16(hb[0], hb[1]), cvt_pk_bf16(hb[2], hb[3])};
            hv[hlf][0] = ha; hv[hlf][1] = hb;
        }
        float am = 0.f;
#pragma unroll
        for (int i = 0; i < 2; ++i)
#pragma unroll
            for (int j = 0; j < 2; ++j)
#pragma unroll
                for (int e = 0; e < 4; ++e) am = fmaxf(am, fabsf(hv[i][j][e]));
        am = wave_max(am);
        const float sc = am > 0.f ? 224.f / am : 1.f;
#pragma unroll
        for (int hlf = 0; hlf < 2; ++hlf) {
            int w0 = 0, w1 = 0;
            w0 = __builtin_amdgcn_cvt_pk_fp8_f32(hv[hlf][0][0] * sc, hv[hlf][0][1] * sc, w0, false); w0 = __builtin_amdgcn_cvt_pk_fp8_f32(hv[hlf][0][2] * sc, hv[hlf][0][3] * sc, w0, true);
            w1 = __builtin_amdgcn_cvt_pk_fp8_f32(hv[hlf][1][0] * sc, hv[hlf][1][1] * sc, w1, false); w1 = __builtin_amdgcn_cvt_pk_fp8_f32(hv[hlf][1][2] * sc, hv[hlf][1][3] * sc, w1, true);
            *(u32x2*)(F.ws + WS_H8 + (size_t)m * D + hlf * 512 + F.lane * 8) = (u32x2){(unsigned)w0, (unsigned)w1};
        }
        if (F.lane == 0) ((float*)(F.ws + WS_SH))[m] = am > 0.f ? am * (1.f / 224.f) : 1.f;
    }
}
__device__ __forceinline__ void p8_gemm_q(const Frame& F) {
    const int ntile = (NT / BM) * (D / BN);
    for (int t = F.bid; t < ntile; t += F.G) {
        const int m0 = (t / (D / BN)) * BM, n0 = (t % (D / BN)) * BN;
        f32x16 acc[2][2]; zero_acc(acc);
        gemm_accum(F, acc, F.H2, D, F.WQ, D, D, m0, n0);
        GEMM_EPI_LOOP({ *(u32x2*)(F.QP + (size_t)m * D + n) = pk4(ACC4(acc)); })
    }
}
constexpr int PR_ROW = 129;
__device__ __forceinline__ void p9_route(const Frame& F) {
    LAS float* SC = (LAS float*)F.lds;
    LAS float* TV = (LAS float*)(F.lds + 32 * 8 * PR_ROW * 4);
    LAS unsigned char* TI = (LAS unsigned char*)(F.lds + 32 * 8 * PR_ROW * 4 + 256 * 17 * 4);
    const int lane = F.lane, r = lane & 31, h = lane >> 5;
    const int nunits = (NT / 32) * 2;
    for (int it = F.bid; it < nunits; it += F.G) {
        const int tok0 = (it >> 1) * 32, hg = it & 1;
        __syncthreads();
        {
            const int head = hg * 4 + (F.wave >> 1), half = F.wave & 1;
            const bf16_t* KK = half ? F.K2 : F.K1;
            bf16x8 Bq[4];
#pragma unroll
            for (int s = 0; s < 4; ++s) Bq[s] = *(const bf16x8*)(F.QP + (size_t)(tok0 + r) * D + head * 128 + half * 64 + s * 16 + h * 8);
#pragma unroll
            for (int kt = 0; kt < 4; ++kt) {
                f32x16 c;
#pragma unroll
                for (int e = 0; e < 16; ++e) c[e] = 0.f;
#pragma unroll
                for (int s = 0; s < 4; ++s) {
                    const bf16x8 Ak = *(const bf16x8*)(KK + (size_t)(kt * 32 + r) * 64 + s * 16 + h * 8);
                    c = __builtin_amdgcn_mfma_f32_32x32x16_bf16(Ak, Bq[s], c, 0, 0, 0);
                }
#pragma unroll
                for (int e = 0; e < 16; ++e) { const int key = kt * 32 + (e & 3) + 8 * (e >> 2) + 4 * h; SC[(r * 8 + F.wave) * PR_ROW + key] = c[e]; }
            }
        }
        __syncthreads();
        if (F.tid < 256) {
            LAS float* row = SC + F.tid * PR_ROW;
            float gm[16];
#pragma unroll
            for (int gidx = 0; gidx < 16; ++gidx) {
                float m = row[gidx * 8];
#pragma unroll
                for (int k = 1; k < 8; ++k) m = fmaxf(m, row[gidx * 8 + k]);
                gm[gidx] = m;
            }
#pragma unroll 1
            for (int p = 0; p < 16; ++p) {
                float best = gm[0]; int bg = 0;
#pragma unroll
                for (int gidx = 1; gidx < 16; ++gidx) { const bool gt = gm[gidx] > best; best = gt ? gm[gidx] : best; bg = gt ? gidx : bg; }
                float v[8];
#pragma unroll
                for (int k = 0; k < 8; ++k) v[k] = row[bg * 8 + k];
                int bk = 7;
#pragma unroll
                for (int k = 6; k >= 0; --k) bk = (v[k] == best) ? k : bk;
                float nm = -INFINITY;
#pragma unroll
                for (int k = 0; k < 8; ++k) nm = fmaxf(nm, (k == bk) ? -INFINITY : v[k]);
                row[bg * 8 + bk] = -INFINITY;
#pragma unroll
                for (int gidx = 0; gidx < 16; ++gidx) gm[gidx] = (gidx == bg) ? nm : gm[gidx];
                TV[F.tid * 17 + p] = best; TI[F.tid * 17 + p] = (unsigned char)(bg * 8 + bk);
            }
        }
        __syncthreads();
        if (F.tid < 128) {
            const int tk = F.tid >> 2, hs = F.tid & 3;
            const int r1 = (tk * 8 + hs * 2) * 17, r2 = r1 + 17;
            LAS float* cand = SC + F.tid * 51;
            {
                float t1[16], t2[16];
#pragma unroll
                for (int i = 0; i < 16; ++i) { t1[i] = TV[r1 + i]; t2[i] = TV[r2 + i]; }
                int nc = 0;
#pragma unroll
                for (int i = 0; i < 16; ++i) {
#pragma unroll
                    for (int j = 0; j < 16 / (i + 1); ++j) { cand[nc] = t1[i] + t2[j]; ++nc; }
                }
            }
            float sv[16]; int se[16];
#pragma unroll
            for (int p = 0; p < 16; ++p) {
                float best = -INFINITY; int bc = 0, bij = 0, c = 0;
#pragma unroll
                for (int i = 0; i < 16; ++i) {
#pragma unroll
                    for (int j = 0; j < 16 / (i + 1); ++j) { const float v = cand[c]; const bool gt = v > best; best = gt ? v : best; bc = gt ? c : bc; bij = gt ? (i * 16 + j) : bij; ++c; }
                }
                cand[bc] = -INFINITY; sv[p] = best; se[p] = (int)TI[r1 + (bij >> 4)] * 128 + (int)TI[r2 + (bij & 15)];
            }
            const float mx0 = sv[0]; float den = 0.f;
#pragma unroll
            for (int p = 0; p < 16; ++p) { sv[p] = __expf(sv[p] - mx0); den += sv[p]; }
            const float dinv = 1.f / den;
            const int head = hg * 4 + hs;
            int* eo = F.EIDX + (size_t)(tok0 + tk) * NEXP_SEL + head * 16; float* go = F.GW + (size_t)(tok0 + tk) * NEXP_SEL + head * 16;
#pragma unroll
            for (int p = 0; p < 16; ++p) { eo[p] = se[p]; go[p] = sv[p] * dinv; }
        }
    }
}

constexpr int TPW = 65, PAIRS_MAX = 9 * 128, PK = 4;
constexpr int P10_HROW = 1024 + 64;
constexpr int P10_H = 0;
constexpr int P10_SH = 32 * P10_HROW;
constexpr int P10_VROW = 2048 + 64;
constexpr int P10_STG = P10_SH + 128;
constexpr int P10_HIST = P10_STG + 8 * 4 * P10_VROW;
typedef short s16x4 __attribute__((ext_vector_type(4)));
__device__ __forceinline__ long pack64(unsigned lo, unsigned hi) { return (long)(((unsigned long long)hi << 32) | (unsigned long long)lo); }
__device__ __forceinline__ void fp8x16_to_bf16(const u32x4 v, u32x4& lo, u32x4& hi) {
    unsigned o[8];
#pragma unroll
    for (int i = 0; i < 4; ++i) {
        const f32x2_t a = __builtin_amdgcn_cvt_pk_f32_fp8((int)v[i], false), b2 = __builtin_amdgcn_cvt_pk_f32_fp8((int)v[i], true);
        o[2 * i] = cvt_pk_bf16(a[0], a[1]); o[2 * i + 1] = cvt_pk_bf16(b2[0], b2[1]);
    }
    lo = (u32x4){o[0], o[1], o[2], o[3]}; hi = (u32x4){o[4], o[5], o[6], o[7]};
}
__device__ __forceinline__ void p10_peer(const Frame& F) {
    const int lane = F.lane, w = F.wave;
    unsigned char* ws = F.ws;
    const unsigned char* PU8 = ws + WS_PU8; const unsigned char* PV8 = ws + WS_PV8;
    const float* SU = (const float*)(ws + WS_SU); const float* SV = (const float*)(ws + WS_SV);
    const unsigned char* H8 = ws + WS_H8; const float* SH = (const float*)(ws + WS_SH);
    const int tok0 = F.bid * TPW;
    LAS unsigned* hist = (LAS unsigned*)(F.lds + P10_HIST) + w * 128;
    LAS unsigned char* stg = F.lds + P10_STG + w * (4 * P10_VROW);
    LAS float* SHl = (LAS float*)(F.lds + P10_SH);
    unsigned* SE0 = (unsigned*)(ws + WS_SE) + ((size_t)F.bid * 8 + w) * PAIRS_MAX;
    float* SG0 = (float*)(ws + WS_SG) + ((size_t)F.bid * 8 + w) * PAIRS_MAX;
    const int ntok = (w == 0) ? 9 : 8;
    const int r16 = lane & 15, q4 = lane >> 4;
#pragma unroll 1
    for (int pass = 0; pass < 3; ++pass) {
        const int kbase = pass * PK, nk = (ntok - kbase < PK) ? (ntok - kbase > 0 ? ntok - kbase : 0) : PK, npairs = nk * 128;
        __syncthreads();
        for (int c = F.tid; c < 32 * 64; c += NTHREADS) {
            const int row = c >> 6, tl = 32 * pass + row;
            if (tl < TPW) *(LAS u32x4*)(F.lds + P10_H + row * P10_HROW + (c & 63) * 16) = *(const u32x4*)(H8 + (size_t)(tok0 + tl) * D + (size_t)(c & 63) * 16);
        }
        if (F.tid < 32 && 32 * pass + F.tid < TPW) SHl[F.tid] = SH[tok0 + 32 * pass + F.tid];
        __syncthreads();
        if (nk <= 0) continue;
        unsigned* SE = SE0 + pass * (PK * 128); float* SG = SG0 + pass * (PK * 128);
        hist[lane] = 0u; hist[lane + 64] = 0u;
        int ex[8];
#pragma unroll
        for (int i = 0; i < 8; ++i) {
            const int p = lane + 64 * i;
            ex[i] = -1;
            if (p < npairs) { ex[i] = F.EIDX[(size_t)(tok0 + w + 8 * (kbase + (p >> 7))) * NEXP_SEL + (p & 127)]; atomicAdd((unsigned*)&hist[ex[i] >> 7], 1u); }
        }
        {
            const unsigned c0 = hist[2 * lane], c1 = hist[2 * lane + 1];
            unsigned incl = c0 + c1;
#pragma unroll
            for (int o = 1; o < 64; o <<= 1) { const unsigned t = __shfl_up(incl, o); if (lane >= o) incl += t; }
            const unsigned excl = incl - (c0 + c1);
            hist[2 * lane] = excl; hist[2 * lane + 1] = excl + c0;
        }
#pragma unroll
        for (int i = 0; i < 8; ++i) {
            const int p = lane + 64 * i;
            if (p < npairs) {
                const unsigned pos = atomicAdd((unsigned*)&hist[ex[i] >> 7], 1u);
                SE[pos] = (unsigned)ex[i] | ((unsigned)(p >> 7) << 14);
                SG[pos] = F.GW[(size_t)(tok0 + w + 8 * (kbase + (p >> 7))) * NEXP_SEL + (p & 127)];
            }
        }
        asm volatile("s_waitcnt vmcnt(0)" ::: "memory");
        f32x4 acc[16];
#pragma unroll
        for (int c = 0; c < 16; ++c) acc[c] = (f32x4){0.f, 0.f, 0.f, 0.f};
#pragma unroll 1
        for (int c0 = 0; c0 < npairs; c0 += 64) {
            const int wv = (int)SE[c0 + lane]; const int gv = __float_as_int(SG[c0 + lane]);
#pragma unroll 1
            for (int j0 = 0; j0 < 64; j0 += 16) {
                const int wr = __shfl(wv, j0 + r16);
                const int er = wr & 16383, sr = wr >> 14;
                const float gr = __int_as_float(__shfl(gv, j0 + r16));
                const unsigned char* ur = PU8 + (size_t)er * D + q4 * 16;
                u32x4 Ub[16];
#pragma unroll
                for (int t = 0; t < 16; ++t) Ub[t] = *(const u32x4*)(ur + t * 64);
                const float suv = SU[er], svv = SV[er];
                u32x4 V8[2][4];
#pragma unroll
                for (int k = 0; k < 4; ++k) V8[0][k] = *(const u32x4*)(PV8 + (size_t)(__builtin_amdgcn_readlane(wv, j0 + k) & 16383) * D + lane * 16);
                LAS const unsigned char* hr = F.lds + P10_H + (w + 8 * sr) * P10_HROW + q4 * 16;
                const float shv = SHl[w + 8 * sr];
                f32x4 C0 = {0.f, 0.f, 0.f, 0.f}, C1 = {0.f, 0.f, 0.f, 0.f};
#pragma unroll
                for (int t = 0; t < 16; ++t) {
                    const u32x4 hh = *(LAS const u32x4*)(hr + t * 64);
                    C0 = __builtin_amdgcn_mfma_f32_16x16x32_fp8_fp8(pack64(hh[0], hh[1]), pack64(Ub[t][0], Ub[t][1]), C0, 0, 0, 0);
                    C1 = __builtin_amdgcn_mfma_f32_16x16x32_fp8_fp8(pack64(hh[2], hh[3]), pack64(Ub[t][2], Ub[t][3]), C1, 0, 0, 0);
                }
                C0 = C0 + C1;
                const int rsel = lane & 3;
                const float dv = (rsel == 0 ? C0[0] : (rsel == 1 ? C0[1] : (rsel == 2 ? C0[2] : C0[3]))) * (suv * shv);
                const int actv = __float_as_int(gelu_tanh(dv) * (gr * svv));
#pragma unroll
                for (int sg = 0; sg < 4; ++sg) {
                    if (sg + 1 < 4) {
#pragma unroll
                        for (int k = 0; k < 4; ++k) V8[(sg + 1) & 1][k] = *(const u32x4*)(PV8 + (size_t)(__builtin_amdgcn_readlane(wv, j0 + 4 * (sg + 1) + k) & 16383) * D + lane * 16);
                    }
#pragma unroll
                    for (int k = 0; k < 4; ++k) {
                        u32x4 lo, hi; fp8x16_to_bf16(V8[sg & 1][k], lo, hi);
                        *(LAS u32x4*)(stg + k * P10_VROW + lane * 32) = lo;
                        *(LAS u32x4*)(stg + k * P10_VROW + lane * 32 + 16) = hi;
                    }
                    float a4[4];
#pragma unroll
                    for (int k = 0; k < 4; ++k) {
                        const int p = 4 * sg + k;
                        const float actk = __int_as_float(__builtin_amdgcn_readlane(actv, 16 * (p >> 2) + p));
                        const int slot = __builtin_amdgcn_readlane(wv, j0 + p) >> 14;
                        a4[k] = (slot == (lane & 3)) ? actk : 0.f;
                    }
                    const u32x2 apk = (u32x2){cvt_pk_bf16(a4[0], a4[1]), cvt_pk_bf16(a4[2], a4[3])};
                    s16x4 Aop; __builtin_memcpy(&Aop, &apk, 8);
                    LAS const unsigned char* tb = stg + ((lane & 15) >> 2) * P10_VROW + ((lane >> 4) * 16 + (lane & 3) * 4) * 2;
#pragma unroll
                    for (int c = 0; c < 16; ++c) {
                        const s16x4 Bop = __builtin_amdgcn_ds_read_tr16_b64_v4i16((LAS s16x4*)(tb + c * 128));
                        acc[c] = __builtin_amdgcn_mfma_f32_4x4x4bf16_1k(Aop, Bop, acc[c], 0, 0, 0);
                    }
                }
            }
        }
#pragma unroll
        for (int k = 0; k < PK; ++k) {
            if (k >= nk) continue;
            const int m = tok0 + w + 8 * (kbase + k);
            const float* x1 = F.T1 + (size_t)m * D; const float* mr = F.MOD + (size_t)mod_row(m) * 6144 + 5120;
            float tv[16]; float s = 0.f;
#pragma unroll
            for (int c = 0; c < 16; ++c) { const float t = x1[c * 64 + lane] * DN_ALPHA + mr[c * 64 + lane] * acc[c][k]; tv[c] = t; s += t; }
            const float mean = wave_sum(s) * (1.f / D);
            float q = 0.f;
#pragma unroll
            for (int c = 0; c < 16; ++c) { tv[c] -= mean; q += tv[c] * tv[c]; }
            const float rstd = rsqrtf(wave_sum(q) * (1.f / D) + LN_EPS);
            float* yo = (m < NTP) ? F.out + O_YP + (size_t)m * D : F.out + O_YS + (size_t)(m - NTP) * D;
#pragma unroll
            for (int c = 0; c < 16; ++c) yo[c * 64 + lane] = tv[c] * rstd * F.ln2_g[c * 64 + lane] + F.ln2_b[c * 64 + lane];
        }
    }
}

constexpr int N_PHASES = 11;
__global__ void __launch_bounds__(NTHREADS, 2) fwd_kernel(Args args) {
    extern __shared__ __attribute__((aligned(16))) unsigned char lds_raw[];
    Frame F;
    F.lds = (LAS unsigned char*)lds_raw;
    F.tid = threadIdx.x; F.lane = F.tid & 63; F.wave = __builtin_amdgcn_readfirstlane(F.tid >> 6); F.G = gridDim.x; F.bid = blockIdx.x;
    F.x_p = (const float*)args.in[0]; F.x_s = (const float*)args.in[1]; F.c_p = (const float*)args.in[2]; F.c_s = (const float*)args.in[3];
    F.cache_k = (const float*)args.in[4]; F.cache_v = (const float*)args.in[5]; F.cache_ki = (const float*)args.in[6]; F.state_conv = (const float*)args.in[7];
    F.page_table = (const int*)args.in[8]; F.rel_bias = (const float*)args.in[9]; F.w_ada = (const float*)args.in[10]; F.b_ada = (const float*)args.in[11];
    F.w_in = (const float*)args.in[12]; F.conv_w = (const float*)args.in[13]; F.conv_b = (const float*)args.in[14]; F.w_o_attn = (const float*)args.in[15];
    F.w_o_conv = (const float*)args.in[16]; F.w_out = (const float*)args.in[17]; F.ln1_g = (const float*)args.in[18]; F.ln1_b = (const float*)args.in[19];
    F.ln2_g = (const float*)args.in[20]; F.ln2_b = (const float*)args.in[21]; F.peer_wq = (const float*)args.in[22]; F.peer_k1 = (const float*)args.in[23];
    F.peer_k2 = (const float*)args.in[24]; F.peer_u = (const float*)args.in[25]; F.peer_v = (const float*)args.in[26];
    F.out = args.out;
    unsigned char* ws = args.ws; F.ws = ws;
    F.MOD = (float*)(ws + WS_MOD); F.WIN = (bf16_t*)(ws + WS_WIN); F.WOA = (bf16_t*)(ws + WS_WOA); F.WOC = (bf16_t*)(ws + WS_WOC);
    F.WOUT = (bf16_t*)(ws + WS_WOUT); F.WQ = (bf16_t*)(ws + WS_WQ); F.K1 = (bf16_t*)(ws + WS_K1); F.K2 = (bf16_t*)(ws + WS_K2);
    F.PU = (bf16_t*)(ws + WS_PU); F.PV = (bf16_t*)(ws + WS_PV); F.H1 = (bf16_t*)(ws + WS_H1); F.PROJ = (bf16_t*)(ws + WS_PROJ);
    F.WI = (float*)(ws + WS_WI); F.SEL = (int*)(ws + WS_SEL); F.OATT = (bf16_t*)(ws + WS_OATT); F.OCONV = (bf16_t*)(ws + WS_OCONV);
    F.MERGED = (bf16_t*)(ws + WS_MERGED); F.T1 = (float*)(ws + WS_T1); F.H2 = (bf16_t*)(ws + WS_H2); F.QP = (bf16_t*)(ws + WS_QP);
    F.EIDX = (int*)(ws + WS_EIDX); F.GW = (float*)(ws + WS_GW);
    volatile LAS unsigned* misc = (volatile LAS unsigned*)(F.lds + LDS_MISC);
    if (F.tid < 16) misc[F.tid] = 0u;
    __syncthreads();
    XcdBarrier bar; bar.bar = (unsigned*)(ws + WS_CTL); bar.x = 0; bar.st = misc;
    const int lo = args.ph_lo, hi = args.ph_hi;
    if (hi - lo > 1) bar = xcd_barrier_post((unsigned*)(ws + WS_CTL), misc);
#define IN(k) (lo <= (k) && (k) < hi)
#define SEAM(k) do { if (IN(k) && IN((k) + 1)) xcd_barrier(bar); } while (0)
    if (IN(0)) p0_prologue(F);       SEAM(0);
    if (IN(1)) p1_modulate(F);       SEAM(1);
    if (IN(2)) p2_gemm_in(F);        SEAM(2);
    if (IN(3)) p3_index(F);          SEAM(3);
    if (IN(4)) p4_attention(F);      SEAM(4);
    if (IN(5)) p5_gemm_merge(F);     SEAM(5);
    if (IN(6)) p6_gemm_out(F);       SEAM(6);
    if (IN(7)) p7_ln1(F);            SEAM(7);
    if (IN(8)) p8_gemm_q(F);         SEAM(8);
    if (IN(9)) p9_route(F);          SEAM(9);
    if (IN(10)) p10_peer(F);
#undef IN
#undef SEAM
}

extern "C" void kernel_launch(void* const* d_in, const int* in_sizes, int n_in, void* d_out, int out_size, void* d_ws, size_t ws_size, hipStream_t stream) {
    static int grid = 0;
    if (grid == 0) {
        if (n_in != 27 || (size_t)out_size != O_END || ws_size < WS_END) { fprintf(stderr, "kernel_launch: unexpected shapes (n_in %d out %d ws %zu)\n", n_in, out_size, ws_size); grid = -1; return; }
        int dev = 0, cus = 0;
        if (hipGetDevice(&dev) != hipSuccess || hipDeviceGetAttribute(&cus, hipDeviceAttributeMultiprocessorCount, dev) != hipSuccess) { grid = -1; return; }
        if (hipFuncSetAttribute((const void*)fwd_kernel, hipFuncAttributeMaxDynamicSharedMemorySize, LDS_BYTES) != hipSuccess) { fprintf(stderr, "kernel_launch: hipFuncSetAttribute failed\n"); grid = -1; return; }
        (void)hipGetLastError();
        grid = cus;
    }
    if (grid < 0) return;
    (void)hipMemsetAsync((char*)d_ws + WS_CTL, 0, CTL_ZERO_BYTES, stream);
    Args a{};
    for (int i = 0; i < 27; ++i) a.in[i] = d_in[i];
    a.out = (float*)d_out; a.ws = (unsigned char*)d_ws;
#if N_LAUNCHES == 1
    a.ph_lo = 0; a.ph_hi = N_PHASES;
    hipLaunchKernelGGL(fwd_kernel, dim3(grid), dim3(NTHREADS), LDS_BYTES, stream, a);
#else
    for (int p = 0; p < N_PHASES; ++p) { a.ph_lo = p; a.ph_hi = p + 1; hipLaunchKernelGGL(fwd_kernel, dim3(grid), dim3(NTHREADS), LDS_BYTES, stream, a); }
#endif
}
```

```cpp
#include <hip/hip_runtime.h>
#include <cstdio>
#include <cstdint>

#ifndef N_LAUNCHES
#define N_LAUNCHES 1
#endif

typedef unsigned short bf16_t;
typedef short bf16x8 __attribute__((ext_vector_type(8)));
typedef float f32x4 __attribute__((ext_vector_type(4)));
typedef float f32x16 __attribute__((ext_vector_type(16)));
typedef unsigned u32x4 __attribute__((ext_vector_type(4)));
typedef unsigned u32x2 __attribute__((ext_vector_type(2)));
#define LAS __attribute__((address_space(3)))

constexpr int D = 1024, NB_P = 8, SEQ = 2048, NB_S = 32, TS = 8, PAST = 8192, PAGE = 128, NPAGES = 64;
constexpr int NTP = NB_P * SEQ;
constexpr int NTS = NB_S * TS;
constexpr int NT = NTP + NTS;
constexpr int NMIX = 4676, NMIXP = 4736;
constexpr int C_Q = 0, C_K = 512, C_V = 640, C_QI = 768, C_KI = 1024, C_BG = 1088, C_CG = 1600, C_XIN = 2112, C_GA = 2624, C_GB = 3648, C_WI = 4672;
constexpr int NSEL = 256;
constexpr float ATTN_SCALE = 0.125f, IDX_SCALE = 0.0625f;
constexpr float DN_ALPHA = 1.189207115002721f, LN_EPS = 1e-5f;
constexpr int NEXP_SEL = 128;

constexpr size_t O_YP = 0, O_YS = 16777216, O_KP = 17039360, O_VP = 19136512, O_KIP = 21233664, O_CP = 22282240,
                 O_KS = 22290432, O_VS = 22323200, O_KIS = 22355968, O_CS = 22372352, O_END = 22405120;

constexpr size_t MB = 1048576;
constexpr size_t WS_CTL = 0, WS_MOD = 1 * MB, WS_WIN = 2 * MB, WS_WOA = 12 * MB, WS_WOC = 13 * MB, WS_WOUT = 14 * MB, WS_WQ = 16 * MB,
                 WS_K1 = 18 * MB, WS_K2 = 18 * MB + 65536, WS_PU = 20 * MB, WS_PV = 52 * MB, WS_H1 = 84 * MB, WS_PROJ = 118 * MB,
                 WS_WI = 270 * MB, WS_SEL = 271 * MB, WS_OATT = 288 * MB, WS_OCONV = 305 * MB, WS_MERGED = 322 * MB, WS_T1 = 355 * MB,
                 WS_H2 = 420 * MB, WS_QP = 453 * MB, WS_EIDX = 486 * MB, WS_GW = 495 * MB, WS_SS = 504 * MB, WS_SE = 513 * MB, WS_SG = 523 * MB, WS_VT = 533 * MB, WS_CGX = 538 * MB, WS_END = 539 * MB;
constexpr size_t WS_PU8 = WS_PU, WS_PV8 = WS_PU + 16 * MB, WS_SU = WS_PV, WS_SV = WS_PV + 65536, WS_H8 = WS_PV + 1 * MB, WS_SH = WS_PV + 20 * MB;
constexpr int CTL_ZERO_BYTES = 65536;

constexpr int NTHREADS = 512;
constexpr int LDS_BYTES = 160 * 1024 - 512;
constexpr int LDS_MISC = LDS_BYTES - 64;

__device__ __forceinline__ float bf2f(bf16_t b) { return __uint_as_float(((unsigned)b) << 16); }
__device__ __forceinline__ float bflo(unsigned p) { return __uint_as_float(p << 16); }
__device__ __forceinline__ float bfhi(unsigned p) { return __uint_as_float(p & 0xFFFF0000u); }
typedef __bf16 bf16x2_t __attribute__((ext_vector_type(2)));
typedef float f32x2_t __attribute__((ext_vector_type(2)));
__device__ __forceinline__ unsigned cvt_pk_bf16(float lo, float hi) { const f32x2_t f = {lo, hi}; const bf16x2_t b = __builtin_convertvector(f, bf16x2_t); unsigned r; __builtin_memcpy(&r, &b, 4); return r; }
__device__ __forceinline__ bf16_t f2bf(float f) { return (bf16_t)(cvt_pk_bf16(f, 0.f) & 0xFFFFu); }
__device__ __forceinline__ float wave_sum(float v) {
#pragma unroll
    for (int o = 32; o >= 1; o >>= 1) v += __shfl_xor(v, o);
    return v;
}
__device__ __forceinline__ float wave_sum_dpp(float v) {
    int x;
    x = __builtin_amdgcn_update_dpp(0, __float_as_int(v), 0xB1, 0xF, 0xF, false);  v += __int_as_float(x);
    x = __builtin_amdgcn_update_dpp(0, __float_as_int(v), 0x4E, 0xF, 0xF, false);  v += __int_as_float(x);
    x = __builtin_amdgcn_update_dpp(0, __float_as_int(v), 0x141, 0xF, 0xF, false); v += __int_as_float(x);
    x = __builtin_amdgcn_update_dpp(0, __float_as_int(v), 0x140, 0xF, 0xF, false); v += __int_as_float(x);
    x = __builtin_amdgcn_update_dpp(0, __float_as_int(v), 0x142, 0xA, 0xF, false); v += __int_as_float(x);
    x = __builtin_amdgcn_update_dpp(0, __float_as_int(v), 0x143, 0xC, 0xF, false); v += __int_as_float(x);
    return __int_as_float(__builtin_amdgcn_readlane(__float_as_int(v), 63));
}
__device__ __forceinline__ float wave_max(float v) {
#pragma unroll
    for (int o = 32; o >= 1; o >>= 1) v = fmaxf(v, __shfl_xor(v, o));
    return v;
}
__device__ __forceinline__ float sigmoidf_(float x) { return 1.f / (1.f + __expf(-x)); }
__device__ __forceinline__ float gelu_tanh(float a) {
    const float z = 0.7978845608028654f * (a + 0.044715f * a * a * a);
    const float e = __expf(2.f * z);
    const float t = 1.f - 2.f * __builtin_amdgcn_rcpf(e + 1.f);
    return 0.5f * a * (1.f + t);
}
__device__ __forceinline__ unsigned f2ord(float f) { const unsigned u = __float_as_uint(f); return (u & 0x80000000u) ? ~u : (u | 0x80000000u); }
__device__ __forceinline__ int t5_bucket(int n) {
    if (n < 16) return n;
    int b = 16;
    b += (n >= 19) + (n >= 21) + (n >= 24) + (n >= 27) + (n >= 31) + (n >= 35) + (n >= 40) + (n >= 46) + (n >= 52) + (n >= 59) + (n >= 67) + (n >= 77) + (n >= 87) + (n >= 99) + (n >= 113);
    return b;
}

#define XB_TMO      128
#define XB_XCNT(j)  (256  + 64 * (j))
#define XB_XSUB(j)  (1280 + 64 * (j))
#define XB_XGEN(j)  (2304 + 64 * (j))
#define XB_TOP      3328
#define XB_TOPGEN   3392
#define XCD_BAR_WORDS 3456
#define XB_SPIN_CAP (1u << 18)
__device__ __forceinline__ unsigned xb_ld(unsigned* p)              { return __hip_atomic_load(p, __ATOMIC_RELAXED, __HIP_MEMORY_SCOPE_AGENT); }
__device__ __forceinline__ unsigned xb_add(unsigned* p, unsigned v) { return __hip_atomic_fetch_add(p, v, __ATOMIC_RELAXED, __HIP_MEMORY_SCOPE_AGENT); }
__device__ __forceinline__ unsigned xb_xcc_id() { return (unsigned)__builtin_amdgcn_s_getreg((3 << 11) | 20) & 0xFu; }
#define XB_SPIN(cond, bar) do { unsigned _sp = 0; while (cond) { __builtin_amdgcn_s_sleep(1); \
    if ((++_sp & 255u) == 0u) { if (xb_ld(&(bar)[XB_TMO])) break; if (_sp > XB_SPIN_CAP) { atomicAdd(&(bar)[XB_TMO], 1u); break; } } } } while (0)
struct XcdBarrier { unsigned* bar; unsigned x; volatile LAS unsigned* st; };
__device__ __forceinline__ XcdBarrier xcd_barrier_post(unsigned* bar, volatile LAS unsigned* st) {
    XcdBarrier b; b.bar = bar; b.x = xb_xcc_id(); b.st = st;
    if (threadIdx.x == 0) (void)xb_add(&bar[XB_XCNT(b.x)], 1u);
    return b;
}
__device__ __forceinline__ void xcd_barrier_complete(unsigned* bar, unsigned x, unsigned& nloc, unsigned& nx) {
    const unsigned G = gridDim.x * gridDim.y * gridDim.z;
    unsigned sum, cnt, mine, sp = 0u;
    for (;;) {
        sum = 0u; cnt = 0u; mine = 0u;
#pragma unroll
        for (unsigned j = 0; j < 16; ++j) { const unsigned c = xb_ld(&bar[XB_XCNT(j)]); sum += c; cnt += (c > 0u) ? 1u : 0u; mine = (j == x) ? c : mine; }
        if (sum == G) break;
        __builtin_amdgcn_s_sleep(1);
        if ((++sp & 255u) == 0u) { if (xb_ld(&bar[XB_TMO])) break; if (sp > XB_SPIN_CAP) { atomicAdd(&bar[XB_TMO], 1u); break; } }
    }
    nloc = mine > 0u ? mine : 1u; nx = cnt > 0u ? cnt : 1u;
}
__device__ __forceinline__ void xcd_barrier(const XcdBarrier& b) {
    asm volatile("s_waitcnt vmcnt(0)" ::: "memory");
    __syncthreads();
    if (threadIdx.x == 0) {
        unsigned* bar = b.bar;
        __builtin_amdgcn_s_waitcnt(0);
        unsigned nloc = b.st[0], nx = b.st[1];
        if (nloc == 0u) { xcd_barrier_complete(bar, b.x, nloc, nx); b.st[0] = nloc; b.st[1] = nx; }
        const unsigned old = xb_add(&bar[XB_XSUB(b.x)], 1u);
        const unsigned gen = old / nloc;
        if (old + 1u == (gen + 1u) * nloc) {
            __builtin_amdgcn_fence(__ATOMIC_RELEASE, "agent");
            asm volatile("s_waitcnt vmcnt(0)" ::: "memory");
            const unsigned og = xb_add(&bar[XB_TOP], 1u);
            const unsigned tg = og / nx;
            if (og + 1u == (tg + 1u) * nx) xb_add(&bar[XB_TOPGEN], 1u);
            else XB_SPIN(xb_ld(&bar[XB_TOPGEN]) == tg, bar);
            __builtin_amdgcn_fence(__ATOMIC_ACQUIRE, "agent");
            xb_add(&bar[XB_XGEN(b.x)], 1u);
            asm volatile("s_waitcnt vmcnt(0)" ::: "memory");
        } else {
            XB_SPIN(xb_ld(&bar[XB_XGEN(b.x)]) == gen, bar);
            __builtin_amdgcn_fence(__ATOMIC_ACQUIRE, "agent");
            asm volatile("s_waitcnt vmcnt(0)" ::: "memory");
        }
    }
    __syncthreads();
}

struct Args { const void* in[27]; float* out; unsigned char* ws; int ph_lo, ph_hi; };
struct Core { LAS unsigned char* lds; int tid, lane, wave, G, bid; };
struct Frame {
    LAS unsigned char* lds;
    int tid, lane, wave, G, bid;
    const float *x_p, *x_s, *c_p, *c_s, *cache_k, *cache_v, *cache_ki, *state_conv, *rel_bias, *w_ada, *b_ada, *w_in, *conv_w, *conv_b,
                *w_o_attn, *w_o_conv, *w_out, *ln1_g, *ln1_b, *ln2_g, *ln2_b, *peer_wq, *peer_k1, *peer_k2, *peer_u, *peer_v;
    const int* page_table;
    float* out; unsigned char* ws;
    float* MOD; bf16_t *WIN, *WOA, *WOC, *WOUT, *WQ, *K1, *K2, *PU, *PV, *H1, *PROJ, *OATT, *OCONV, *MERGED, *H2, *QP;
    float *WI, *T1, *GW; int *SEL, *EIDX;
};
constexpr int LDS_PTAB = LDS_BYTES - 512;
__device__ __forceinline__ unsigned char* ldptr(const Core& C, int k) {
    LAS const unsigned* p = (LAS const unsigned*)(C.lds + LDS_PTAB) + 2 * k;
    const unsigned lo = __builtin_amdgcn_readfirstlane(p[0]), hi = __builtin_amdgcn_readfirstlane(p[1]);
    return (unsigned char*)(((unsigned long long)hi << 32) | (unsigned long long)lo);
}
__device__ __forceinline__ void load_frame(Frame& F, const Core& C) {
    F.lds = C.lds; F.tid = C.tid; F.lane = C.lane; F.wave = C.wave; F.G = C.G; F.bid = C.bid;
    F.x_p = (const float*)ldptr(C, 0); F.x_s = (const float*)ldptr(C, 1); F.c_p = (const float*)ldptr(C, 2); F.c_s = (const float*)ldptr(C, 3);
    F.cache_k = (const float*)ldptr(C, 4); F.cache_v = (const float*)ldptr(C, 5); F.cache_ki = (const float*)ldptr(C, 6); F.state_conv = (const float*)ldptr(C, 7);
    F.page_table = (const int*)ldptr(C, 8); F.rel_bias = (const float*)ldptr(C, 9); F.w_ada = (const float*)ldptr(C, 10); F.b_ada = (const float*)ldptr(C, 11);
    F.w_in = (const float*)ldptr(C, 12); F.conv_w = (const float*)ldptr(C, 13); F.conv_b = (const float*)ldptr(C, 14); F.w_o_attn = (const float*)ldptr(C, 15);
    F.w_o_conv = (const float*)ldptr(C, 16); F.w_out = (const float*)ldptr(C, 17); F.ln1_g = (const float*)ldptr(C, 18); F.ln1_b = (const float*)ldptr(C, 19);
    F.ln2_g = (const float*)ldptr(C, 20); F.ln2_b = (const float*)ldptr(C, 21); F.peer_wq = (const float*)ldptr(C, 22); F.peer_k1 = (const float*)ldptr(C, 23);
    F.peer_k2 = (const float*)ldptr(C, 24); F.peer_u = (const float*)ldptr(C, 25); F.peer_v = (const float*)ldptr(C, 26);
    F.out = (float*)ldptr(C, 27);
    unsigned char* ws = ldptr(C, 28);
    F.MOD = (float*)(ws + WS_MOD); F.WIN = (bf16_t*)(ws + WS_WIN); F.WOA = (bf16_t*)(ws + WS_WOA); F.WOC = (bf16_t*)(ws + WS_WOC);
    F.WOUT = (bf16_t*)(ws + WS_WOUT); F.WQ = (bf16_t*)(ws + WS_WQ); F.K1 = (bf16_t*)(ws + WS_K1); F.K2 = (bf16_t*)(ws + WS_K2);
    F.PU = (bf16_t*)(ws + WS_PU); F.PV = (bf16_t*)(ws + WS_PV); F.H1 = (bf16_t*)(ws + WS_H1); F.PROJ = (bf16_t*)(ws + WS_PROJ);
    F.WI = (float*)(ws + WS_WI); F.SEL = (int*)(ws + WS_SEL); F.OATT = (bf16_t*)(ws + WS_OATT); F.OCONV = (bf16_t*)(ws + WS_OCONV);
    F.MERGED = (bf16_t*)(ws + WS_MERGED); F.T1 = (float*)(ws + WS_T1); F.H2 = (bf16_t*)(ws + WS_H2); F.QP = (bf16_t*)(ws + WS_QP);
    F.EIDX = (int*)(ws + WS_EIDX); F.GW = (float*)(ws + WS_GW);
}
__device__ __forceinline__ const float* x_row(const Frame& F, int m) { return m < NTP ? F.x_p + (size_t)m * D : F.x_s + (size_t)(m - NTP) * D; }
__device__ __forceinline__ int mod_row(int m) { return m < NTP ? (m >> 11) : NB_P + ((m - NTP) >> 3); }

constexpr int P0_MOD_ITEMS = 96;
constexpr int P0_T_WIN = 16 * 74, P0_T_WOA = 8 * 16, P0_T_WOC = 8 * 16, P0_T_WOUT = 16 * 16, P0_T_WQ = 16 * 16;
constexpr int P0_T_ITEMS = P0_T_WIN + P0_T_WOA + P0_T_WOC + P0_T_WOUT + P0_T_WQ;
constexpr int P0_CVT_ITEMS = 2 * (16384 * 1024 / 8192);
constexpr int P0_MISC_ITEMS = 1;
constexpr int P0_ITEMS = P0_MOD_ITEMS + P0_T_ITEMS + P0_CVT_ITEMS + P0_MISC_ITEMS;

__device__ __forceinline__ void p0_mod_item(const Frame& F, int ng) {
    LAS float* cs = (LAS float*)F.lds;
    LAS float* red = (LAS float*)(F.lds + 40 * 256 * 4);
    float acc[40];
#pragma unroll
    for (int r = 0; r < 40; ++r) acc[r] = 0.f;
    const int n = ng * 64 + F.lane;
    for (int kc = 0; kc < 4; ++kc) {
        __syncthreads();
        for (int e = F.tid; e < 40 * 256; e += NTHREADS) { const int r = e >> 8, k = e & 255; cs[e] = (r < 8) ? F.c_p[r * D + kc * 256 + k] : F.c_s[(r - 8) * D + kc * 256 + k]; }
        __syncthreads();
        for (int kk = 0; kk < 32; ++kk) {
            const int kl = F.wave * 32 + kk;
            const float wv = F.w_ada[(size_t)(kc * 256 + kl) * 6144 + n];
#pragma unroll
            for (int r = 0; r < 40; ++r) acc[r] += cs[r * 256 + kl] * wv;
        }
    }
#pragma unroll
    for (int r = 0; r < 40; ++r) red[(F.wave * 40 + r) * 64 + F.lane] = acc[r];
    __syncthreads();
    for (int e = F.tid; e < 40 * 64; e += NTHREADS) {
        const int r = e >> 6, l = e & 63; float s = F.b_ada[ng * 64 + l];
#pragma unroll
        for (int w = 0; w < 8; ++w) s += red[(w * 40 + r) * 64 + l];
        F.MOD[r * 6144 + ng * 64 + l] = s;
    }
    __syncthreads();
}
__device__ __forceinline__ void p0_transpose_tile(const Frame& F, const float* W, int N, int K, bf16_t* Wt, int kt, int nt, bool permute) {
    LAS bf16_t* tile = (LAS bf16_t*)F.lds;
    __syncthreads();
    { const int k = F.tid >> 3, c0 = (F.tid & 7) * 8;
#pragma unroll
      for (int j = 0; j < 8; ++j) { const int n = nt * 64 + c0 + j; const float v = (n < N) ? W[(size_t)(kt * 64 + k) * N + n] : 0.f; tile[k * 66 + c0 + j] = f2bf(v); } }
    __syncthreads();
    { const int nl = F.tid >> 3, k0 = (F.tid & 7) * 8; const int n = nt * 64 + nl;
      if (n < N) {
          int nd = n; if (permute) nd = (n < 1024) ? n : (n < 1028 ? C_WI + (n - 1024) : n - 4);
          unsigned p[4];
#pragma unroll
          for (int j = 0; j < 4; ++j) p[j] = (unsigned)tile[(k0 + 2 * j) * 66 + nl] | ((unsigned)tile[(k0 + 2 * j + 1) * 66 + nl] << 16);
          *(u32x4*)(Wt + (size_t)nd * K + kt * 64 + k0) = (u32x4){p[0], p[1], p[2], p[3]};
      } }
}
__device__ __forceinline__ void p0_prologue(const Frame& F) {
    for (int it = F.bid; it < P0_ITEMS; it += F.G) {
        int i = it;
        if (i < P0_MOD_ITEMS) { p0_mod_item(F, i); continue; }
        i -= P0_MOD_ITEMS;
        if (i < P0_T_ITEMS) {
            if (i < P0_T_WIN) { p0_transpose_tile(F, F.w_in, NMIX, D, F.WIN, i / 74, i % 74, true); continue; }
            i -= P0_T_WIN;
            if (i < P0_T_WOA) { p0_transpose_tile(F, F.w_o_attn, D, 512, F.WOA, i / 16, i % 16, false); continue; }
            i -= P0_T_WOA;
            if (i < P0_T_WOC) { p0_transpose_tile(F, F.w_o_conv, D, 512, F.WOC, i / 16, i % 16, false); continue; }
            i -= P0_T_WOC;
            if (i < P0_T_WOUT) { p0_transpose_tile(F, F.w_out, D, D, F.WOUT, i / 16, i % 16, false); continue; }
            i -= P0_T_WOUT;
            p0_transpose_tile(F, F.peer_wq, D, D, F.WQ, i / 16, i % 16, false); continue;
        }
        i -= P0_T_ITEMS;
        if (i < P0_CVT_ITEMS) {
            const float* src = (i < 2048) ? F.peer_u : F.peer_v;
            unsigned char* dst = F.ws + ((i < 2048) ? WS_PU8 : WS_PV8); float* sinv = (float*)(F.ws + ((i < 2048) ? WS_SU : WS_SV));
            const int row = (i & 2047) * 8 + F.wave;
            const float* rp = src + (size_t)row * D + F.lane * 16;
            const f32x4 a = *(const f32x4*)rp, b2 = *(const f32x4*)(rp + 4), c = *(const f32x4*)(rp + 8), d = *(const f32x4*)(rp + 12);
            float am = 0.f;
#pragma unroll
            for (int e = 0; e < 4; ++e) am = fmaxf(am, fmaxf(fmaxf(fabsf(a[e]), fabsf(b2[e])), fmaxf(fabsf(c[e]), fabsf(d[e]))));
            am = wave_max(am);
            const float sc = am > 0.f ? 224.f / am : 1.f;
            int w0 = 0, w1 = 0, w2 = 0, w3 = 0;
            w0 = __builtin_amdgcn_cvt_pk_fp8_f32(a[0] * sc, a[1] * sc, w0, false); w0 = __builtin_amdgcn_cvt_pk_fp8_f32(a[2] * sc, a[3] * sc, w0, true);
            w1 = __builtin_amdgcn_cvt_pk_fp8_f32(b2[0] * sc, b2[1] * sc, w1, false); w1 = __builtin_amdgcn_cvt_pk_fp8_f32(b2[2] * sc, b2[3] * sc, w1, true);
            w2 = __builtin_amdgcn_cvt_pk_fp8_f32(c[0] * sc, c[1] * sc, w2, false); w2 = __builtin_amdgcn_cvt_pk_fp8_f32(c[2] * sc, c[3] * sc, w2, true);
            w3 = __builtin_amdgcn_cvt_pk_fp8_f32(d[0] * sc, d[1] * sc, w3, false); w3 = __builtin_amdgcn_cvt_pk_fp8_f32(d[2] * sc, d[3] * sc, w3, true);
            *(u32x4*)(dst + (size_t)row * D + F.lane * 16) = (u32x4){(unsigned)w0, (unsigned)w1, (unsigned)w2, (unsigned)w3};
            if (F.lane == 0) sinv[row] = am > 0.f ? am * (1.f / 224.f) : 1.f;
            continue;
        }
        for (int e = F.tid; e < (4864 - NMIX) * D; e += NTHREADS) F.WIN[(size_t)NMIX * D + e] = 0;
        for (int e = F.tid; e < 128 * 64; e += NTHREADS) { F.K1[e] = f2bf(F.peer_k1[e]); F.K2[e] = f2bf(F.peer_k2[e]); }
    }
}

__device__ __forceinline__ void p1_modulate(const Frame& F) {
    for (int m = F.bid * 8 + F.wave; m < NT; m += F.G * 8) {
        const float* xr = x_row(F, m); const float* mr = F.MOD + (size_t)mod_row(m) * 6144;
#pragma unroll
        for (int hlf = 0; hlf < 2; ++hlf) {
            const int e = hlf * 512 + F.lane * 8;
            const f32x4 x0 = *(const f32x4*)(xr + e), x1 = *(const f32x4*)(xr + e + 4);
            const f32x4 s0 = *(const f32x4*)(mr + 1024 + e), s1 = *(const f32x4*)(mr + 1024 + e + 4);
            const f32x4 h0 = *(const f32x4*)(mr + e), h1 = *(const f32x4*)(mr + e + 4);
            const f32x4 a = x0 * (s0 + 1.f) + h0, b = x1 * (s1 + 1.f) + h1;
            *(u32x4*)(F.H1 + (size_t)m * D + e) = (u32x4){cvt_pk_bf16(a[0], a[1]), cvt_pk_bf16(a[2], a[3]), cvt_pk_bf16(b[0], b[1]), cvt_pk_bf16(b[2], b[3])};
        }
    }
}

constexpr int BM = 256, BN = 128, BK = 64;
constexpr int XPANEL = BM * 32 + 32, WPANEL = BN * 32 + 32;
constexpr int XSTAGE = 4 * XPANEL, WSTAGE = 4 * WPANEL, GSTAGE = XSTAGE + WSTAGE;
__device__ __forceinline__ void gemm_accum(const Frame& F, f32x16 (&acc)[2][2], const bf16_t* __restrict__ X, int ldx, const bf16_t* __restrict__ W, int ldw, int K, int m0, int n0) {
    const int tid = F.tid, lane = F.lane, r = lane & 31, h = lane >> 5, wm = F.wave >> 1, wn = F.wave & 1;
    u32x4 xr[4], wr[2];
    const int nk = K / BK;
    const int crow = tid >> 3, ckc = tid & 7;
    const bf16_t* xg = X + (size_t)(m0 + crow) * ldx + ckc * 8;
    const bf16_t* wg = W + (size_t)(n0 + crow) * ldw + ckc * 8;
    const int ldso = (ckc >> 1) * 1  ;
    const int xoff = ldso * XPANEL + crow * 32 + (ckc & 1) * 16;
    const int woff = ldso * WPANEL + crow * 32 + (ckc & 1) * 16;
#pragma unroll
    for (int i = 0; i < 4; ++i) xr[i] = *(const u32x4*)(xg + (size_t)(64 * i) * ldx);
#pragma unroll
    for (int i = 0; i < 2; ++i) wr[i] = *(const u32x4*)(wg + (size_t)(64 * i) * ldw);
    __syncthreads();
    for (int kt = 0; kt < nk; ++kt) {
        LAS unsigned char* st = F.lds + (kt & 1) * GSTAGE;
#pragma unroll
        for (int i = 0; i < 4; ++i) *(LAS u32x4*)(st + xoff + i * 64 * 32) = xr[i];
#pragma unroll
        for (int i = 0; i < 2; ++i) *(LAS u32x4*)(st + XSTAGE + woff + i * 64 * 32) = wr[i];
        __syncthreads();
        if (kt + 1 < nk) {
#pragma unroll
            for (int i = 0; i < 4; ++i) xr[i] = *(const u32x4*)(xg + (size_t)(64 * i) * ldx + (kt + 1) * BK);
#pragma unroll
            for (int i = 0; i < 2; ++i) wr[i] = *(const u32x4*)(wg + (size_t)(64 * i) * ldw + (kt + 1) * BK);
        }
#pragma unroll
        for (int s = 0; s < 4; ++s) {
            bf16x8 a[2], b[2];
#pragma unroll
            for (int ni = 0; ni < 2; ++ni) a[ni] = *(LAS bf16x8*)(st + XSTAGE + s * WPANEL + (wn * 64 + ni * 32 + r) * 32 + h * 16);
#pragma unroll
            for (int mi = 0; mi < 2; ++mi) b[mi] = *(LAS bf16x8*)(st + s * XPANEL + (wm * 64 + mi * 32 + r) * 32 + h * 16);
#pragma unroll
            for (int mi = 0; mi < 2; ++mi)
#pragma unroll
                for (int ni = 0; ni < 2; ++ni) acc[mi][ni] = __builtin_amdgcn_mfma_f32_32x32x16_bf16(a[ni], b[mi], acc[mi][ni], 0, 0, 0);
        }
    }
}
#define GEMM_EPI_LOOP(...) \
    { const int r_ = F.lane & 31, h_ = F.lane >> 5, wm_ = F.wave >> 1, wn_ = F.wave & 1; \
      _Pragma("unroll") for (int mi = 0; mi < 2; ++mi) _Pragma("unroll") for (int ni = 0; ni < 2; ++ni) _Pragma("unroll") for (int g = 0; g < 4; ++g) { \
          const int m = m0 + wm_ * 64 + mi * 32 + r_; const int n = n0 + wn_ * 64 + ni * 32 + 8 * g + 4 * h_; __VA_ARGS__ } }
#define ACC4(A) ((f32x4){A[mi][ni][4 * g], A[mi][ni][4 * g + 1], A[mi][ni][4 * g + 2], A[mi][ni][4 * g + 3]})
__device__ __forceinline__ void zero_acc(f32x16 (&acc)[2][2]) {
#pragma unroll
    for (int mi = 0; mi < 2; ++mi)
#pragma unroll
        for (int ni = 0; ni < 2; ++ni)
#pragma unroll
            for (int e = 0; e < 16; ++e) acc[mi][ni][e] = 0.f;
}
__device__ __forceinline__ u32x2 pk4(const f32x4 v) { return (u32x2){cvt_pk_bf16(v[0], v[1]), cvt_pk_bf16(v[2], v[3])}; }

__device__ __forceinline__ void gemm_slice8(const Frame& F, f32x16 (&sacc)[1][1], const bf16_t* __restrict__ X, int ldx, const bf16_t* __restrict__ W, int ldw, int K, int m0, int n0) {
    const int r = F.lane & 31, h = F.lane >> 5, wq = F.wave & 3, kh = F.wave >> 2;
    const bf16_t* wp = W + (size_t)(n0 + 32 * wq + r) * ldw + kh * (K / 2) + h * 8;
    const bf16_t* xp = X + (size_t)(m0 + (r & 7)) * ldx + kh * (K / 2) + h * 8;
    f32x16 c;
#pragma unroll
    for (int e = 0; e < 16; ++e) c[e] = 0.f;
#pragma unroll 1
    for (int k0 = 0; k0 < K / 2; k0 += 128) {
        bf16x8 a[8], b[8];
#pragma unroll
        for (int t = 0; t < 8; ++t) { a[t] = *(const bf16x8*)(wp + k0 + t * 16); b[t] = *(const bf16x8*)(xp + k0 + t * 16); }
#pragma unroll
        for (int t = 0; t < 8; ++t) c = __builtin_amdgcn_mfma_f32_32x32x16_bf16(a[t], b[t], c, 0, 0, 0);
    }
    LAS float* cb = (LAS float*)F.lds + wq * (16 * 64);
    __syncthreads();
    if (kh == 1) {
#pragma unroll
        for (int e = 0; e < 16; ++e) cb[e * 64 + F.lane] = c[e];
    }
    __syncthreads();
    if (kh == 0) {
#pragma unroll
        for (int e = 0; e < 16; ++e) c[e] += cb[e * 64 + F.lane];
    }
    sacc[0][0] = c;
}
#define SLICE_EPI_LOOP(...) \
    if (F.wave < 4 && (F.lane & 31) < 8) { const int h_ = F.lane >> 5, wq_ = F.wave & 3; constexpr int mi = 0, ni = 0; \
      _Pragma("unroll") for (int g = 0; g < 4; ++g) { const int m = m0 + (F.lane & 31); const int n = n0 + wq_ * 32 + 8 * g + 4 * h_; __VA_ARGS__ } }

namespace pg8 {
#define PG8_LAS __attribute__((address_space(3)))
typedef unsigned short bf16_t;
typedef short bf16x8 __attribute__((ext_vector_type(8)));
typedef float f32x4 __attribute__((ext_vector_type(4)));
typedef unsigned u32x4 __attribute__((ext_vector_type(4)));
constexpr int BM = 256, BK = 64, HALF = 128, HTB = HALF * BK * 2  , STAGE_BYTES = 8 * HTB, NXCD = 8, WGM = 8;

__host__ __device__ __forceinline__ int lds_byte(int r, int c) { const int st = (r >> 4) * 2 + (c >> 5), rr = r & 15, cc = c & 31, ob = rr * 64 + cc * 2; return st * 1024 + (ob ^ (((ob >> 9) & 1) << 5)); }
__host__ __device__ __forceinline__ void stage_rc(int b, int& R, int& C) { const int st = b / 1024, sb = b % 1024, swz = sb ^ (((sb >> 9) & 1) << 5); R = (st >> 1) * 16 + swz / 64; C = (st & 1) * 32 + (swz % 64) / 2; }
__host__ __device__ __forceinline__ int perm32(int rho) { const int n = rho >> 4, i = rho & 15; return 8 * (i >> 2) + 4 * n + (i & 3); }

struct Unit { int pm, pn; };
struct Gemm { const bf16_t* A; const bf16_t* Bt; int M, N, K; };

struct StaticOrder {
    int nM, nN, nwg, G, c;
    __host__ __device__ void init(int M, int N, int G_, int c_) { nM = M / BM; nN = N / BM; nwg = nM * nN; G = G_; c = c_; }
    __host__ __device__ bool next(int i, Unit& u) const {
        const long L = (long)i * G + c; if (L >= nwg) return false;
        int wgid = (int)L; { const int q = nwg / NXCD, r = nwg % NXCD, xcd = wgid % NXCD, off = wgid / NXCD; wgid = (xcd < r ? xcd * (q + 1) : r * (q + 1) + (xcd - r) * q) + off; }
        const int nig = WGM * nN, gid = wgid / nig, fm = gid * WGM, gsz = (nM - fm) < WGM ? (nM - fm) : WGM;
        u.pm = fm + ((wgid % nig) % gsz); u.pn = (wgid % nig) / gsz; return true;
    }
    __device__ __forceinline__ void a_ready(const Unit&) const {}
    __device__ __forceinline__ void done(const Unit&) const {}
};

template <class Body> struct EpiRC {
    static constexpr bool PERM = false, AFTER_DRAIN = false;
    Body body;
    __device__ __forceinline__ void operator()(const f32x4 (&acc)[2][2][4][2], const Unit& u, int wr, int wc, int fr, int fq) const {
#pragma unroll
        for (int ai = 0; ai < 2; ++ai)
#pragma unroll
            for (int m = 0; m < 4; ++m) {
                const int row = u.pm * BM + ai * HALF + wr * 64 + m * 16 + fr;
#pragma unroll
                for (int bj = 0; bj < 2; ++bj)
#pragma unroll
                    for (int n = 0; n < 2; ++n) body(row, u.pn * BM + bj * HALF + wc * 32 + n * 16 + 4 * fq, acc[ai][bj][m][n]);
            }
    }
};
template <class Epi, class Sched, bool ALIGN_EPI = false, bool SP2 = false>
__device__ __forceinline__ void gemm_phase(PG8_LAS unsigned char* lds, const Gemm g, const Sched& S, const Epi& E) {
    const int tid = threadIdx.x, wid = __builtin_amdgcn_readfirstlane(tid >> 6), lane = tid & 63, wr = wid >> 2, wc = wid & 3, fr = lane & 15, fq = lane >> 4;
    const int K = g.K, nt = K / BK;
    unsigned voffA[2], voffB[2];
#pragma unroll
    for (int i = 0; i < 2; ++i) { int R, C; stage_rc(tid * 16 + i * 8192, R, C); const int Rb = Epi::PERM ? ((R & ~31) + perm32(R & 31)) : R;
        voffA[i] = (unsigned)(R * K + C) * 2u; voffB[i] = (unsigned)(Rb * K + C) * 2u; }
    const size_t kstep = (size_t)(BK * 2);
    const size_t hstep = (size_t)HALF * K * 2;
    const size_t tstep = 2 * hstep;
    const unsigned ldsw = (unsigned)wid * 1024u;
    const int aoff = lds_byte(wr * 64 + fr, fq * 8), boff = lds_byte(wc * 32 + fr, fq * 8);
#define PG8_SA(b, h) (((b) * 2 + (h)) * HTB)
#define PG8_SB(b, h) ((4 + (b) * 2 + (h)) * HTB)
#define PG8_STAGE(bufoff, gbase, voff) do { _Pragma("unroll") for (int _i = 0; _i < 2; ++_i) \
        __builtin_amdgcn_global_load_lds((const unsigned*)((const char*)(gbase) + (voff)[_i]), (PG8_LAS unsigned*)(lds + (bufoff) + ldsw + _i * 8192), 16, 0, 0); } while (0)
#define PG8_LDA(dst, b, h) do { _Pragma("unroll") for (int m = 0; m < 4; ++m) _Pragma("unroll") for (int k = 0; k < 2; ++k) dst[m][k] = *(const PG8_LAS bf16x8*)(lds + PG8_SA(b, h) + aoff + m * 2048 + k * 1024); } while (0)
#define PG8_LDB(dst, b, h) do { _Pragma("unroll") for (int n = 0; n < 2; ++n) _Pragma("unroll") for (int k = 0; k < 2; ++k) dst[n][k] = *(const PG8_LAS bf16x8*)(lds + PG8_SB(b, h) + boff + n * 2048 + k * 1024); } while (0)
#define PG8_MMA(ai, bj, At, Bt) do { __builtin_amdgcn_s_setprio(1); _Pragma("unroll") for (int m = 0; m < 4; ++m) _Pragma("unroll") for (int n = 0; n < 2; ++n) _Pragma("unroll") for (int k = 0; k < 2; ++k) \
        acc[ai][bj][m][n] = __builtin_amdgcn_mfma_f32_16x16x32_bf16(Bt[n][k], At[m][k], acc[ai][bj][m][n], 0, 0, 0); __builtin_amdgcn_s_setprio(0); } while (0)
#define PG8_WAIT_V(n) asm volatile("s_waitcnt vmcnt(" #n ")" ::: "memory")
#define PG8_WAIT_L(n) asm volatile("s_waitcnt lgkmcnt(" #n ")" ::: "memory")
#define PG8_BAR __builtin_amdgcn_s_barrier()
#define PG8_SCHED __builtin_amdgcn_sched_barrier(0)
    Unit cur, nxt; int ui = 0;
    if (!S.next(0, cur)) return;
    f32x4 acc[2][2][4][2];
#pragma unroll
    for (int a = 0; a < 2; ++a)
#pragma unroll
        for (int b = 0; b < 2; ++b)
#pragma unroll
            for (int m = 0; m < 4; ++m)
#pragma unroll
                for (int n = 0; n < 2; ++n) acc[a][b][m][n] = (f32x4){0.f, 0.f, 0.f, 0.f};
    bf16x8 At[4][2], B0[2][2], B1[2][2];
    const char* cA = (const char*)g.A + (size_t)cur.pm * tstep; const char* cB = (const char*)g.Bt + (size_t)cur.pn * tstep;
    S.a_ready(cur);
    if constexpr (SP2) {
        PG8_STAGE(PG8_SB(0, 0), cB, voffB); PG8_STAGE(PG8_SB(0, 1), cB + hstep, voffB); PG8_STAGE(PG8_SA(0, 0), cA, voffA); PG8_STAGE(PG8_SA(0, 1), cA + hstep, voffA);
        if (wr == 1) PG8_BAR;
        PG8_WAIT_V(2); PG8_BAR;
        PG8_STAGE(PG8_SB(1, 0), cB + kstep, voffB); PG8_STAGE(PG8_SA(1, 0), cA + kstep, voffA); PG8_STAGE(PG8_SB(1, 1), cB + hstep + kstep, voffB);
        PG8_WAIT_V(6); PG8_BAR;
    } else {
        PG8_STAGE(PG8_SB(0, 0), cB, voffB); PG8_STAGE(PG8_SA(0, 0), cA, voffA); PG8_STAGE(PG8_SB(0, 1), cB + hstep, voffB); PG8_STAGE(PG8_SA(0, 1), cA + hstep, voffA);
        if (wr == 1) PG8_BAR;
        PG8_WAIT_V(4); PG8_BAR;
        PG8_STAGE(PG8_SB(1, 0), cB + kstep, voffB); PG8_STAGE(PG8_SA(1, 0), cA + kstep, voffA); PG8_STAGE(PG8_SB(1, 1), cB + hstep + kstep, voffB);
        PG8_WAIT_V(6); PG8_BAR;
    }
    for (;;) {
        const bool has_next = S.next(ui + 1, nxt);
        const char* nA = has_next ? (const char*)g.A + (size_t)nxt.pm * tstep : cA; const char* nB = has_next ? (const char*)g.Bt + (size_t)nxt.pn * tstep : cB;
        for (int t = 0; t < nt; t += 2) {
            const bool last = (t == nt - 2);
            const char* a1 = cA + (size_t)(t + 1) * kstep;
            const char* a2 = last ? nA : cA + (size_t)(t + 2) * kstep; const char* b2 = last ? nB : cB + (size_t)(t + 2) * kstep;
            const char* a3 = a2 + kstep; const char* b3 = b2 + kstep;
            if (last && has_next) S.a_ready(nxt);
            if constexpr (SP2) {
            PG8_LDB(B0, 0, 0); PG8_LDB(B1, 0, 1); PG8_SCHED; PG8_LDA(At, 0, 0); PG8_STAGE(PG8_SA(1, 1), a1 + hstep, voffA);
            PG8_WAIT_V(8); PG8_WAIT_L(0); PG8_BAR; PG8_MMA(0, 0, At, B0); PG8_MMA(0, 1, At, B1); PG8_BAR; PG8_SCHED;
            PG8_LDA(At, 0, 1); PG8_STAGE(PG8_SB(0, 0), b2, voffB); PG8_STAGE(PG8_SB(0, 1), b2 + hstep, voffB); PG8_STAGE(PG8_SA(0, 0), a2, voffA);
            PG8_WAIT_V(8); PG8_WAIT_L(0); PG8_BAR; PG8_MMA(1, 0, At, B0); PG8_MMA(1, 1, At, B1); PG8_BAR; PG8_SCHED;
            PG8_LDB(B0, 1, 0); PG8_LDB(B1, 1, 1); PG8_SCHED; PG8_LDA(At, 1, 0); PG8_STAGE(PG8_SA(0, 1), a2 + hstep, voffA);
            PG8_WAIT_V(8); PG8_WAIT_L(0); PG8_BAR; PG8_MMA(0, 0, At, B0); PG8_MMA(0, 1, At, B1); PG8_BAR; PG8_SCHED;
            PG8_LDA(At, 1, 1); PG8_STAGE(PG8_SB(1, 0), b3, voffB); PG8_STAGE(PG8_SB(1, 1), b3 + hstep, voffB); PG8_STAGE(PG8_SA(1, 0), a3, voffA);
            PG8_WAIT_V(8); PG8_WAIT_L(0); PG8_BAR; PG8_MMA(1, 0, At, B0); PG8_MMA(1, 1, At, B1); PG8_BAR; PG8_SCHED;
            } else {
            PG8_LDB(B0, 0, 0); PG8_SCHED; PG8_LDA(At, 0, 0); PG8_STAGE(PG8_SA(1, 1), a1 + hstep, voffA);
            PG8_WAIT_L(8); PG8_BAR; PG8_WAIT_L(0); PG8_MMA(0, 0, At, B0); PG8_BAR; PG8_SCHED;
            PG8_LDB(B1, 0, 1); PG8_STAGE(PG8_SB(0, 0), b2, voffB);
            PG8_BAR; PG8_WAIT_L(0); PG8_MMA(0, 1, At, B1); PG8_BAR;
            PG8_LDA(At, 0, 1); PG8_STAGE(PG8_SA(0, 0), a2, voffA);
            PG8_BAR; PG8_WAIT_L(0); PG8_MMA(1, 0, At, B0); PG8_BAR; PG8_SCHED;
            PG8_STAGE(PG8_SB(0, 1), b2 + hstep, voffB);
            PG8_WAIT_V(6); PG8_BAR; PG8_MMA(1, 1, At, B1); PG8_BAR;
            PG8_LDB(B0, 1, 0); PG8_SCHED; PG8_LDA(At, 1, 0); PG8_STAGE(PG8_SA(0, 1), a2 + hstep, voffA);
            PG8_WAIT_L(8); PG8_BAR; PG8_WAIT_L(0); PG8_MMA(0, 0, At, B0); PG8_BAR; PG8_SCHED;
            PG8_LDB(B1, 1, 1); PG8_STAGE(PG8_SB(1, 0), b3, voffB);
            PG8_BAR; PG8_WAIT_L(0); PG8_MMA(0, 1, At, B1); PG8_BAR;
            PG8_LDA(At, 1, 1); PG8_STAGE(PG8_SA(1, 0), a3, voffA);
            PG8_BAR; PG8_WAIT_L(0); PG8_MMA(1, 0, At, B0); PG8_BAR; PG8_SCHED;
            PG8_STAGE(PG8_SB(1, 1), b3 + hstep, voffB);
            PG8_WAIT_V(6); PG8_BAR; PG8_MMA(1, 1, At, B1); PG8_BAR;
            }
        }
        if constexpr (ALIGN_EPI) { if (wr == 0) PG8_BAR; }
        if constexpr (!Epi::AFTER_DRAIN) { E(acc, cur, wr, wc, fr, fq); S.done(cur); }
        if (!has_next) break;
#pragma unroll
        for (int a = 0; a < 2; ++a)
#pragma unroll
            for (int b = 0; b < 2; ++b)
#pragma unroll
                for (int m = 0; m < 4; ++m)
#pragma unroll
                    for (int n = 0; n < 2; ++n) acc[a][b][m][n] = (f32x4){0.f, 0.f, 0.f, 0.f};
        cur = nxt; cA = nA; cB = nB; ++ui;
        if constexpr (ALIGN_EPI) { if (wr == 1) PG8_BAR; }
    }
    PG8_WAIT_V(0);
    if constexpr (!ALIGN_EPI) { if (wr == 0) PG8_BAR; }
    PG8_BAR;
    if constexpr (Epi::AFTER_DRAIN) { E.fused(acc, cur, wr, wc, fr, fq, lds, wid, lane); S.done(cur); }
#undef PG8_SA
#undef PG8_SB
#undef PG8_STAGE
#undef PG8_LDA
#undef PG8_LDB
#undef PG8_MMA
#undef PG8_WAIT_V
#undef PG8_WAIT_L
#undef PG8_BAR
#undef PG8_SCHED
}
}

constexpr int NMIXW = 4864;
struct P2Body {
    const Frame* Fp;
    __device__ __forceinline__ void operator()(int m, int n, const f32x4 v) const {
        const Frame& F = *Fp;
        if (n >= NMIXP) return;
        *(u32x2*)(F.PROJ + (size_t)m * NMIXP + n) = pk4(v);
        if (n >= C_K && n < C_QI) {
            float* o = (n < C_V) ? (m < NTP ? F.out + O_KP + (size_t)m * 128 + (n - C_K) : F.out + O_KS + (size_t)(m - NTP) * 128 + (n - C_K))
                                 : (m < NTP ? F.out + O_VP + (size_t)m * 128 + (n - C_V) : F.out + O_VS + (size_t)(m - NTP) * 128 + (n - C_V));
            *(f32x4*)o = v;
            if (n >= C_V && m < NTP) {
                bf16_t* vt = (bf16_t*)(F.ws + WS_VT) + ((size_t)((m >> 11) * 2 + ((n - C_V) >> 6)) * 64 + ((n - C_V) & 63)) * SEQ + (m & 2047);
                vt[0] = f2bf(v[0]); vt[SEQ] = f2bf(v[1]); vt[2 * SEQ] = f2bf(v[2]); vt[3 * SEQ] = f2bf(v[3]);
            }
        } else if (n >= C_KI && n < C_BG) {
            float* o = m < NTP ? F.out + O_KIP + (size_t)m * 64 + (n - C_KI) : F.out + O_KIS + (size_t)(m - NTP) * 64 + (n - C_KI);
            *(f32x4*)o = v;
        } else if (n == C_WI) {
            *(f32x4*)(F.WI + (size_t)m * 4) = v;
        } else if (n >= C_CG && n < C_GA) {
            const int tt = (m < NTP) ? (m & 2047) - (SEQ - 2) : ((m - NTP) & 7) - (TS - 2);
            if (tt >= 0) {
                const int rowi = (m < NTP) ? (m >> 11) * 2 + tt : 2 * NB_P + ((m - NTP) >> 3) * 2 + tt;
                *(f32x4*)((float*)(F.ws + WS_CGX) + (size_t)rowi * 1024 + (n - C_CG)) = v;
            }
        }
    }
};
__device__ __forceinline__ void p2_gemm_in(const Frame& F) {
    pg8::Gemm g{F.H1, F.WIN, NT, NMIXW, D};
    pg8::StaticOrder S; S.init(NT, NMIXW, F.G, F.bid);
    pg8::EpiRC<P2Body> E{P2Body{&F}};
    pg8::gemm_phase<pg8::EpiRC<P2Body>, pg8::StaticOrder, true, true>(F.lds, g, S, E);
}

constexpr int SROW = 2052;
__device__ __forceinline__ int wave_sum_i(int v) {
#pragma unroll
    for (int o = 32; o >= 1; o >>= 1) v += __shfl_xor(v, o);
    return v;
}
__device__ __forceinline__ void cnt_ge(int& c, unsigned u, unsigned t) { asm("v_cmp_ge_u32_e32 vcc, %1, %2\n\tv_addc_co_u32_e32 %0, vcc, 0, %0, vcc" : "+v"(c) : "v"(u), "v"(t) : "vcc"); }
__device__ __forceinline__ void cnt_gt(int& c, unsigned u, unsigned t) { asm("v_cmp_gt_u32_e32 vcc, %1, %2\n\tv_addc_co_u32_e32 %0, vcc, 0, %0, vcc" : "+v"(c) : "v"(u), "v"(t) : "vcc"); }
__device__ __forceinline__ void cnt_eq(int& c, unsigned u, unsigned t) { asm("v_cmp_eq_u32_e32 vcc, %1, %2\n\tv_addc_co_u32_e32 %0, vcc, 0, %0, vcc" : "+v"(c) : "v"(u), "v"(t) : "vcc"); }
__device__ __forceinline__ void cnt_eq_pos(int& c, unsigned u, unsigned t, int L) {
    int tmp;
    asm("v_cmp_eq_u32_e32 vcc, %2, %3\n\tv_cndmask_b32_e32 %1, %5, %4, vcc\n\tv_cmp_lt_i32_e32 vcc, 0, %1\n\tv_addc_co_u32_e32 %0, vcc, 0, %0, vcc"
        : "+v"(c), "=&v"(tmp) : "v"(u), "v"(t), "v"(L), "v"(0x80000000) : "vcc");
}
__device__ __forceinline__ int wave_sum_i_dpp(int v) {
    v += __builtin_amdgcn_update_dpp(0, v, 0xB1, 0xF, 0xF, false);
    v += __builtin_amdgcn_update_dpp(0, v, 0x4E, 0xF, 0xF, false);
    v += __builtin_amdgcn_update_dpp(0, v, 0x141, 0xF, 0xF, false);
    v += __builtin_amdgcn_update_dpp(0, v, 0x140, 0xF, 0xF, false);
    v += __builtin_amdgcn_update_dpp(0, v, 0x142, 0xA, 0xF, false);
    v += __builtin_amdgcn_update_dpp(0, v, 0x143, 0xC, 0xF, false);
    return __builtin_amdgcn_readlane(v, 63);
}
template <int NV> __device__ __forceinline__ void select_threshold(const unsigned (&u)[NV], int ksel, int idx_bits, int lane, unsigned& T_out, int& Jx_out, int& ngt_out) {
    unsigned T = 0;
#pragma unroll 1
    for (int bit = 31; bit >= 0; --bit) {
        const unsigned cand = T | (1u << bit);
        int c = 0;
#pragma unroll
        for (int i = 0; i < NV; ++i) cnt_ge(c, u[i], cand);
        c = wave_sum_i_dpp(c);
        if (c >= ksel) T = cand;
    }
    int cg = 0, ce = 0;
#pragma unroll
    for (int i = 0; i < NV; ++i) { cnt_gt(cg, u[i], T); cnt_eq(ce, u[i], T); }
    const int ngt = wave_sum_i_dpp(cg), neq = wave_sum_i_dpp(ce);
    const int need = ksel - ngt;
    int Jx = 0x3FFFFFFF;
    if (need < neq) {
        int Jb = 0;
#pragma unroll 1
        for (int bit = idx_bits - 1; bit >= 0; --bit) {
            const int cand = Jb | (1 << bit);
            const int L = cand - lane;
            int c = 0;
#pragma unroll
            for (int i = 0; i < NV; ++i) cnt_eq_pos(c, u[i], T, L - 64 * i);
            c = wave_sum_i_dpp(c);
            if (c < need) Jb = cand;
        }
        Jx = Jb + 1;
    }
    T_out = T; Jx_out = Jx; ngt_out = ngt;
}
template <int NV> __device__ __forceinline__ void select_threshold2(const unsigned (&ua)[NV], const unsigned (&ub)[NV], int ksel, int idx_bits, int lane,
                                                                   unsigned& Ta_out, int& Jxa_out, unsigned& Tb_out, int& Jxb_out) {
    unsigned Ta = 0, Tb = 0;
#pragma unroll 1
    for (int bit = 31; bit >= 0; --bit) {
        const unsigned ca = Ta | (1u << bit), cb = Tb | (1u << bit);
        int a0 = 0, a1 = 0, b0 = 0, b1 = 0;
#pragma unroll
        for (int i = 0; i < NV; i += 2) { cnt_ge(a0, ua[i], ca); cnt_ge(b0, ub[i], cb); cnt_ge(a1, ua[i + 1], ca); cnt_ge(b1, ub[i + 1], cb); }
        const int na = wave_sum_i_dpp(a0 + a1), nb = wave_sum_i_dpp(b0 + b1);
        if (na >= ksel) Ta = ca;
        if (nb >= ksel) Tb = cb;
    }
    int ga = 0, ea = 0, gb = 0, eb = 0;
#pragma unroll
    for (int i = 0; i < NV; ++i) { cnt_gt(ga, ua[i], Ta); cnt_eq(ea, ua[i], Ta); cnt_gt(gb, ub[i], Tb); cnt_eq(eb, ub[i], Tb); }
    const int needa = ksel - wave_sum_i_dpp(ga), neqa = wave_sum_i_dpp(ea), needb = ksel - wave_sum_i_dpp(gb), neqb = wave_sum_i_dpp(eb);
    int Jxa = 0x3FFFFFFF, Jxb = 0x3FFFFFFF;
    if (needa < neqa) {
        int Jb = 0;
#pragma unroll 1
        for (int bit = idx_bits - 1; bit >= 0; --bit) {
            const int cand = Jb | (1 << bit); const int L = cand - lane; int c = 0;
#pragma unroll
            for (int i = 0; i < NV; ++i) cnt_eq_pos(c, ua[i], Ta, L - 64 * i);
            if (wave_sum_i_dpp(c) < needa) Jb = cand;
        }
        Jxa = Jb + 1;
    }
    if (needb < neqb) {
        int Jb = 0;
#pragma unroll 1
        for (int bit = idx_bits - 1; bit >= 0; --bit) {
            const int cand = Jb | (1 << bit); const int L = cand - lane; int c = 0;
#pragma unroll
            for (int i = 0; i < NV; ++i) cnt_eq_pos(c, ub[i], Tb, L - 64 * i);
            if (wave_sum_i_dpp(c) < needb) Jb = cand;
        }
        Jxb = Jb + 1;
    }
    Ta_out = Ta; Jxa_out = Jxa; Tb_out = Tb; Jxb_out = Jxb;
}
template <int NV> __device__ __forceinline__ void select_topk(const unsigned (&u)[NV], int ksel, int idx_bits, int* sel, int lane) {
    unsigned T; int Jx, ngt;
    select_threshold<NV>(u, ksel, idx_bits, lane, T, Jx, ngt);
    const int L = Jx - lane;
    int cg = 0, ct = 0;
#pragma unroll
    for (int i = 0; i < NV; ++i) { cnt_gt(cg, u[i], T); cnt_eq_pos(ct, u[i], T, L - 64 * i); }
    int ig = cg, it = ct;
#pragma unroll
    for (int o = 1; o < 64; o <<= 1) { const int a = __shfl_up(ig, o), b2 = __shfl_up(it, o); if (lane >= o) { ig += a; it += b2; } }
    int pg = ig - cg, pt = ngt + it - ct;
    int ev = lane, Lr = L;
#pragma unroll
    for (int i = 0; i < NV; ++i) {
        if (u[i] > T) { sel[pg] = ev; ++pg; }
        else if (u[i] == T && Lr > 0) { sel[pt] = ev; ++pt; }
        asm volatile("v_add_u32 %0, 64, %0\n\tv_add_u32 %1, -64, %1" : "+v"(ev), "+v"(Lr));
    }
}

constexpr int PU_MB = 16 * SROW * 4;
constexpr int PU_RB = PU_MB + 16 * 64 * 4;
constexpr int PU_BT = PU_RB + 1024;
constexpr int PU_QT = PU_BT + 512, PU_QROW = 1040;
__device__ __forceinline__ int kappa32(int r) { return (r & 0x13) | ((r & 4) << 1) | ((r & 8) >> 1); }
__device__ __forceinline__ void p3_prompt_fused_unit(const Frame& F, const bf16_t* VT, int b, int qt) {
    LAS float* S = (LAS float*)F.lds;
    LAS unsigned* MB = (LAS unsigned*)(F.lds + PU_MB);
    LAS float* RB = (LAS float*)(F.lds + PU_RB);
    LAS int* BT = (LAS int*)(F.lds + PU_BT);
    const int lane = F.lane;
    const int q0 = qt * 16; const size_t tok0 = (size_t)b * SEQ;
    __syncthreads();
    for (int ch = F.tid; ch < 16 * 64; ch += NTHREADS)
        *(LAS u32x4*)(F.lds + PU_QT + (ch >> 6) * PU_QROW + (ch & 63) * 16) = *(const u32x4*)(F.PROJ + (tok0 + q0 + (ch >> 6)) * NMIXP + C_Q + (ch & 63) * 8);
    {
        const int r = lane & 15, q4 = lane >> 4;
        bf16x8 A[4][2];
#pragma unroll
        for (int hh = 0; hh < 4; ++hh)
#pragma unroll
            for (int s2 = 0; s2 < 2; ++s2) A[hh][s2] = *(const bf16x8*)(F.PROJ + (tok0 + q0 + r) * NMIXP + C_QI + hh * 64 + s2 * 32 + q4 * 8);
        float wv[4][4];
#pragma unroll
        for (int g = 0; g < 4; ++g) { const f32x4 w4 = *(const f32x4*)(F.WI + (tok0 + q0 + 4 * q4 + g) * 4);
#pragma unroll
            for (int hh = 0; hh < 4; ++hh) wv[g][hh] = w4[hh] * IDX_SCALE; }
        const int nkt = qt + 1;
        bf16x8 Bn[2][2];
        {
            const int t0 = 2 * F.wave;
#pragma unroll
            for (int p = 0; p < 2; ++p)
#pragma unroll
                for (int s2 = 0; s2 < 2; ++s2) { const int key = (t0 + p < nkt ? t0 + p : 0) * 16 + r; Bn[p][s2] = *(const bf16x8*)(F.PROJ + (tok0 + key) * NMIXP + C_KI + s2 * 32 + q4 * 8); }
        }
#pragma unroll 1
        for (int t0 = 2 * F.wave; t0 < nkt; t0 += 16) {
            bf16x8 B[2][2] = {{Bn[0][0], Bn[0][1]}, {Bn[1][0], Bn[1][1]}};
            {
                const int tn = t0 + 16;
#pragma unroll
                for (int p = 0; p < 2; ++p)
#pragma unroll
                    for (int s2 = 0; s2 < 2; ++s2) { const int key = (tn + p < nkt ? tn + p : 0) * 16 + r; Bn[p][s2] = *(const bf16x8*)(F.PROJ + (tok0 + key) * NMIXP + C_KI + s2 * 32 + q4 * 8); }
            }
#pragma unroll
            for (int p = 0; p < 2; ++p) {
                if (t0 + p >= nkt) continue;
                float sc[4] = {0.f, 0.f, 0.f, 0.f};
#pragma unroll
                for (int hh = 0; hh < 4; ++hh) {
                    f32x4 c = {0.f, 0.f, 0.f, 0.f};
                    c = __builtin_amdgcn_mfma_f32_16x16x32_bf16(A[hh][0], B[p][0], c, 0, 0, 0);
                    c = __builtin_amdgcn_mfma_f32_16x16x32_bf16(A[hh][1], B[p][1], c, 0, 0, 0);
#pragma unroll
                    for (int g = 0; g < 4; ++g) sc[g] += fmaxf(c[g], 0.f) * wv[g][hh];
                }
#pragma unroll
                for (int g = 0; g < 4; ++g) S[(4 * q4 + g) * SROW + (t0 + p) * 16 + r] = sc[g];
            }
        }
    }
    __syncthreads();
    {
        const int rowa = F.wave * 2, rowb = rowa + 1;
        const int nva = q0 + rowa + 1, nvb = nva + 1;
        if (nvb <= NSEL) {
#pragma unroll
            for (int i = 0; i < 32; ++i) {
                const unsigned long long ma = __ballot(lane + 64 * i < nva), mb = __ballot(lane + 64 * i < nvb);
                if (lane == 0) { MB[rowa * 64 + 2 * i] = (unsigned)ma; MB[rowa * 64 + 2 * i + 1] = (unsigned)(ma >> 32); MB[rowb * 64 + 2 * i] = (unsigned)mb; MB[rowb * 64 + 2 * i + 1] = (unsigned)(mb >> 32); }
            }
        } else {
            unsigned ua[32], ub[32];
#pragma unroll
            for (int i = 0; i < 32; ++i) { const int j = lane + 64 * i; ua[i] = (j < nva) ? f2ord(S[rowa * SROW + j]) : 0u; ub[i] = (j < nvb) ? f2ord(S[rowb * SROW + j]) : 0u; }
            unsigned Ta, Tb; int Jxa, Jxb;
            select_threshold2<32>(ua, ub, NSEL, 11, lane, Ta, Jxa, Tb, Jxb);
            const int La = Jxa - lane, Lb = Jxb - lane;
#pragma unroll
            for (int i = 0; i < 32; ++i) {
                const bool ta = (ua[i] > Ta) || (ua[i] == Ta && (La - 64 * i) > 0), tb = (ub[i] > Tb) || (ub[i] == Tb && (Lb - 64 * i) > 0);
                const unsigned long long ma = __ballot(ta), mb = __ballot(tb);
                if (lane == 0) { MB[rowa * 64 + 2 * i] = (unsigned)ma; MB[rowa * 64 + 2 * i + 1] = (unsigned)(ma >> 32); MB[rowb * 64 + 2 * i] = (unsigned)mb; MB[rowb * 64 + 2 * i + 1] = (unsigned)(mb >> 32); }
            }
        }
    }
    __syncthreads();
    {
        const int g = F.wave & 1, kq = F.wave >> 1;
        const int c = lane & 31, h = lane >> 5;
        const int hd = g * 4 + (c & 3);
        LAS const unsigned char* Qb = F.lds + PU_QT + (c >> 2) * PU_QROW + (hd * 64 + h * 8) * 2;
        const float b31 = RB[31 * 8 + hd];
        const int ntile = ((q0 + 15) >> 5) + 1;
        const bf16_t* Kb = F.PROJ + (tok0 + kappa32(c)) * NMIXP + C_K + g * 64 + h * 8;
        const bf16_t* Vb = VT + ((size_t)((b * 2 + g) * 64 + c)) * SEQ + h * 8;
        f32x16 O[2][2];
#pragma unroll
        for (int rt = 0; rt < 2; ++rt)
#pragma unroll
            for (int d = 0; d < 2; ++d)
#pragma unroll
                for (int e = 0; e < 16; ++e) O[rt][d][e] = 0.f;
        float lsum[2] = {0.f, 0.f};
        bf16x8 Kn[4];
        {
            const int key0 = (kq < ntile ? kq : 0) * 32;
#pragma unroll
            for (int s4 = 0; s4 < 4; ++s4) Kn[s4] = *(const bf16x8*)(Kb + (size_t)key0 * NMIXP + s4 * 16);
        }
#pragma unroll 1
        for (int kt = kq; kt < ntile; kt += 4) {
            const int key0 = kt * 32;
            bf16x8 Kf[4] = {Kn[0], Kn[1], Kn[2], Kn[3]}, Vf[2][2];
#pragma unroll
            for (int d = 0; d < 2; ++d)
#pragma unroll
                for (int s2 = 0; s2 < 2; ++s2) Vf[d][s2] = *(const bf16x8*)(Vb + (size_t)(32 * d) * SEQ + key0 + 16 * s2);
            {
                const int keyn = (kt + 4 < ntile ? kt + 4 : 0) * 32;
#pragma unroll
                for (int s4 = 0; s4 < 4; ++s4) Kn[s4] = *(const bf16x8*)(Kb + (size_t)keyn * NMIXP + s4 * 16);
            }
#pragma unroll
            for (int rt = 0; rt < 2; ++rt) {
                const int ql = rt * 8 + (c >> 2), q = q0 + ql;
                f32x16 X;
#pragma unroll
                for (int e = 0; e < 16; ++e) X[e] = 0.f;
#pragma unroll
                for (int s4 = 0; s4 < 4; ++s4) X = __builtin_amdgcn_mfma_f32_32x32x16_bf16(Kf[s4], *(LAS const bf16x8*)(Qb + rt * 8 * PU_QROW + s4 * 32), X, 0, 0, 0);
                const unsigned word = MB[ql * 64 + kt];
                const unsigned bits = ((word >> (8 * h)) & 0xFFu) | (((word >> (16 + 8 * h)) & 0xFFu) << 8);
                const bool nearT = (q0 + rt * 8) - (key0 + 31) < 113;
#pragma unroll
                for (int s2 = 0; s2 < 2; ++s2) {
                    float P[8];
                    if (nearT) {
#pragma unroll
                        for (int e8 = 0; e8 < 8; ++e8) {
                            const int e = 8 * s2 + e8;
                            const int key = key0 + e8 + 16 * s2 + 8 * h;
                            int dist = q - key; dist = dist < 0 ? 0 : (dist > 127 ? 127 : dist);
                            const float bias = RB[BT[dist] * 8 + hd];
                            const float lg = fminf(X[e] * ATTN_SCALE + bias, 60.f);
                            P[e8] = ((bits >> e) & 1u) ? __expf(lg) : 0.f;
                        }
                    } else {
#pragma unroll
                        for (int e8 = 0; e8 < 8; ++e8) {
                            const int e = 8 * s2 + e8;
                            const float lg = fminf(X[e] * ATTN_SCALE + b31, 60.f);
                            P[e8] = ((bits >> e) & 1u) ? __expf(lg) : 0.f;
                        }
                    }
#pragma unroll
                    for (int e8 = 0; e8 < 8; ++e8) lsum[rt] += P[e8];
                    const u32x4 pk = (u32x4){cvt_pk_bf16(P[0], P[1]), cvt_pk_bf16(P[2], P[3]), cvt_pk_bf16(P[4], P[5]), cvt_pk_bf16(P[6], P[7])};
                    bf16x8 Pf; __builtin_memcpy(&Pf, &pk, 16);
                    O[rt][0] = __builtin_amdgcn_mfma_f32_32x32x16_bf16(Vf[0][s2], Pf, O[rt][0], 0, 0, 0);
                    O[rt][1] = __builtin_amdgcn_mfma_f32_32x32x16_bf16(Vf[1][s2], Pf, O[rt][1], 0, 0, 0);
                }
                __builtin_amdgcn_sched_barrier(0);
            }
        }
        LAS float* CB = (LAS float*)F.lds + (g * 3 + (kq > 0 ? kq - 1 : 0)) * (66 * 64);
        __syncthreads();
        if (kq > 0) {
#pragma unroll
            for (int rt = 0; rt < 2; ++rt) {
#pragma unroll
                for (int d = 0; d < 2; ++d)
#pragma unroll
                    for (int e = 0; e < 16; ++e) CB[((rt * 2 + d) * 16 + e) * 64 + lane] = O[rt][d][e];
                CB[(64 + rt) * 64 + lane] = lsum[rt];
            }
        }
        __syncthreads();
        if (kq == 0) {
#pragma unroll 1
            for (int p = 0; p < 3; ++p) {
                LAS const float* CP = (LAS const float*)F.lds + (g * 3 + p) * (66 * 64);
#pragma unroll
                for (int rt = 0; rt < 2; ++rt) {
#pragma unroll
                    for (int d = 0; d < 2; ++d)
#pragma unroll
                        for (int e = 0; e < 16; ++e) O[rt][d][e] += CP[((rt * 2 + d) * 16 + e) * 64 + lane];
                    lsum[rt] += CP[(64 + rt) * 64 + lane];
                }
            }
#pragma unroll
            for (int rt = 0; rt < 2; ++rt) {
                float l = lsum[rt]; l += __shfl_xor(l, 32);
                const float inv = 1.f / l;
                bf16_t* orow = F.OATT + (tok0 + q0 + rt * 8 + (c >> 2)) * 512 + hd * 64;
#pragma unroll
                for (int a4 = 0; a4 < 4; ++a4) {
                    const f32x4 v0 = (f32x4){O[rt][0][4 * a4], O[rt][0][4 * a4 + 1], O[rt][0][4 * a4 + 2], O[rt][0][4 * a4 + 3]} * inv;
                    const f32x4 v1 = (f32x4){O[rt][1][4 * a4], O[rt][1][4 * a4 + 1], O[rt][1][4 * a4 + 2], O[rt][1][4 * a4 + 3]} * inv;
                    *(u32x2*)(orow + 8 * a4 + 4 * h) = pk4(v0);
                    *(u32x2*)(orow + 32 + 8 * a4 + 4 * h) = pk4(v1);
                }
            }
        }
    }
}

__device__ __forceinline__ void p3_sample_score_unit(const Frame& F, float* SS, int b, int ch) {
    const int lane = F.lane, r = lane & 31, h = lane >> 5;
    bf16x8 A[4];
    { const int q = r >> 2, hh = r & 3;
#pragma unroll
      for (int s4 = 0; s4 < 4; ++s4) A[s4] = *(const bf16x8*)(F.PROJ + (size_t)(NTP + b * TS + q) * NMIXP + C_QI + hh * 64 + s4 * 16 + h * 8); }
    float wv[4][4];
#pragma unroll
    for (int g = 0; g < 4; ++g) { const f32x4 w4 = *(const f32x4*)(F.WI + (size_t)(NTP + b * TS + 2 * g + h) * 4);
#pragma unroll
        for (int hh = 0; hh < 4; ++hh) wv[g][hh] = w4[hh] * IDX_SCALE; }
    f32x4 kn[8];
    { const int key0 = ch * 1024 + F.wave * 32; const int page = F.page_table[b * NPAGES + (key0 >> 7)];
      const float* kr = F.cache_ki + ((size_t)page * PAGE + (key0 & 127) + r) * 64 + h * 8;
#pragma unroll
      for (int s4 = 0; s4 < 4; ++s4) { kn[2 * s4] = *(const f32x4*)(kr + s4 * 16); kn[2 * s4 + 1] = *(const f32x4*)(kr + s4 * 16 + 4); } }
#pragma unroll 1
    for (int tl = F.wave; tl < 32; tl += 8) {
        const int key0 = ch * 1024 + tl * 32;
        f32x4 kc[8];
#pragma unroll
        for (int i = 0; i < 8; ++i) kc[i] = kn[i];
        if (tl + 8 < 32) {
            const int keyn = key0 + 256; const int page = F.page_table[b * NPAGES + (keyn >> 7)];
            const float* kr = F.cache_ki + ((size_t)page * PAGE + (keyn & 127) + r) * 64 + h * 8;
#pragma unroll
            for (int s4 = 0; s4 < 4; ++s4) { kn[2 * s4] = *(const f32x4*)(kr + s4 * 16); kn[2 * s4 + 1] = *(const f32x4*)(kr + s4 * 16 + 4); }
        }
        f32x16 c;
#pragma unroll
        for (int e = 0; e < 16; ++e) c[e] = 0.f;
#pragma unroll
        for (int s4 = 0; s4 < 4; ++s4) {
            const f32x4 lo = kc[2 * s4], hi = kc[2 * s4 + 1];
            const u32x4 pk = (u32x4){cvt_pk_bf16(lo[0], lo[1]), cvt_pk_bf16(lo[2], lo[3]), cvt_pk_bf16(hi[0], hi[1]), cvt_pk_bf16(hi[2], hi[3])};
            bf16x8 Bf; __builtin_memcpy(&Bf, &pk, 16);
            c = __builtin_amdgcn_mfma_f32_32x32x16_bf16(A[s4], Bf, c, 0, 0, 0);
        }
#pragma unroll
        for (int g = 0; g < 4; ++g) {
            float sc = 0.f;
#pragma unroll
            for (int hh = 0; hh < 4; ++hh) sc += fmaxf(c[4 * g + hh], 0.f) * wv[g][hh];
            SS[(size_t)(b * TS + 2 * g + h) * PAST + key0 + r] = sc;
        }
    }
}
__device__ __forceinline__ void p3_index(const Frame& F) {
    constexpr int NSU = NB_S * 8;
    const int nunits = NSU + NB_P * (SEQ / 16);
    float* SS = (float*)(F.ws + WS_SS);
    const bf16_t* VT = (const bf16_t*)(F.ws + WS_VT);
    __syncthreads();
    if (F.tid < 256) ((LAS float*)(F.lds + PU_RB))[F.tid] = F.rel_bias[F.tid];
    if (F.tid < 128) ((LAS int*)(F.lds + PU_BT))[F.tid] = t5_bucket(F.tid);
    __syncthreads();
    for (int it = F.bid; it < nunits; it += F.G) {
        if (it < NSU) { p3_sample_score_unit(F, SS, it >> 3, it & 7); continue; }
        const int i = it - NSU; const int b = i & 7, sl = (i >> 3) & 31, rnd = i >> 8;
        const int qt = rnd == 0 ? 127 - sl : (rnd == 1 ? 64 + sl : (rnd == 2 ? 63 - sl : sl));
        p3_prompt_fused_unit(F, VT, b, qt);
    }
}

constexpr int SQ_CNT = 0;
constexpr int SQ_SEL = 1024;
constexpr int SQ_Q = 2048;
constexpr int SQ_P = 4096;
constexpr int SQ_RB = 16384;
constexpr int SQ_BT = 17408;
__device__ __forceinline__ int wg_sum8(const Frame& F, LAS unsigned* slot, int v) {
    if (F.lane == 0) slot[F.wave] = (unsigned)v;
    __syncthreads();
    int t = 0;
#pragma unroll
    for (int w = 0; w < 8; ++w) t += (int)slot[w];
    return t;
}
__device__ __forceinline__ void p4_sample_query_unit(const Frame& F, const float* SS, int b, int t) {
    const int lane = F.lane, w = F.wave;
    LAS unsigned* CNT = (LAS unsigned*)(F.lds + SQ_CNT);
    LAS int* SELL = (LAS int*)(F.lds + SQ_SEL);
    LAS unsigned* QL = (LAS unsigned*)(F.lds + SQ_Q);
    LAS float* PL = (LAS float*)(F.lds + SQ_P) + w * 256;
    LAS float* RB = (LAS float*)(F.lds + SQ_RB);
    LAS int* BT = (LAS int*)(F.lds + SQ_BT);
    const int tok = NTP + b * TS + t;
    __syncthreads();
    if (F.tid < 256) QL[F.tid] = ((const unsigned*)(F.PROJ + (size_t)tok * NMIXP + C_Q))[F.tid];
    unsigned u[17];
    { const float* srow = SS + (size_t)(b * TS + t) * PAST + w * 1024;
#pragma unroll
      for (int i = 0; i < 16; ++i) u[i] = f2ord(srow[64 * i + lane]); }
    u[16] = 0u;
    if (w == 7) {
        float sc = 0.f;
        if (lane < TS) {
            const bf16_t* kn = F.PROJ + (size_t)(NTP + b * TS + lane) * NMIXP + C_KI;
            const bf16_t* qn = F.PROJ + (size_t)tok * NMIXP + C_QI;
            int vz; asm volatile("v_mov_b32 %0, 0" : "=v"(vz));
            const f32x4 w4 = *(const f32x4*)(F.WI + (size_t)tok * 4 + vz);
#pragma unroll 1
            for (int hh = 0; hh < 4; ++hh) {
                float d = 0.f;
#pragma unroll 8
                for (int e = 0; e < 64; ++e) d += bf2f(qn[hh * 64 + e]) * bf2f(kn[e]);
                sc += fmaxf(d, 0.f) * (w4[hh] * IDX_SCALE);
            }
        }
        u[16] = (lane < TS && lane <= t) ? f2ord(sc) : 0u;
    }
    unsigned T = 0;
#pragma unroll 1
    for (int bit = 31; bit >= 0; --bit) {
        const unsigned cand = T | (1u << bit);
        int c = 0;
#pragma unroll
        for (int i = 0; i < 17; ++i) cnt_ge(c, u[i], cand);
        c = wg_sum8(F, CNT + (bit & 1) * 24, wave_sum_i_dpp(c));
        if (c >= NSEL) T = cand;
    }
    int cg = 0, ce = 0;
#pragma unroll
    for (int i = 0; i < 17; ++i) { cnt_gt(cg, u[i], T); cnt_eq(ce, u[i], T); }
    const int cgw = wave_sum_i_dpp(cg);
    const int ngt = wg_sum8(F, CNT + 8, cgw);
    const int neq = wg_sum8(F, CNT + 16, wave_sum_i_dpp(ce));
    const int need = NSEL - ngt;
    int Jx = 0x3FFFFFFF;
    if (need < neq) {
        int Jb = 0;
#pragma unroll 1
        for (int bit = 13; bit >= 0; --bit) {
            const int cand = Jb | (1 << bit);
            const int L = cand - lane - 1024 * w;
            int c = 0;
#pragma unroll
            for (int i = 0; i < 17; ++i) cnt_eq_pos(c, u[i], T, L - 64 * i);
            c = wg_sum8(F, CNT + (bit & 1) * 24, wave_sum_i_dpp(c));
            if (c < need) Jb = cand;
        }
        Jx = Jb + 1;
    }
    {
        const int L = Jx - lane - 1024 * w;
        int ct = 0;
#pragma unroll
        for (int i = 0; i < 17; ++i) cnt_eq_pos(ct, u[i], T, L - 64 * i);
        const int ctw = wave_sum_i_dpp(ct);
        __syncthreads();
        if (lane == 0) { CNT[w] = (unsigned)cgw; CNT[8 + w] = (unsigned)ctw; }
        __syncthreads();
        int bg = 0, bt = ngt;
#pragma unroll
        for (int ww = 0; ww < 8; ++ww) { if (ww < w) { bg += (int)CNT[ww]; bt += (int)CNT[8 + ww]; } }
        int ig = cg, it2 = ct;
#pragma unroll
        for (int o = 1; o < 64; o <<= 1) { const int a = __shfl_up(ig, o), b2 = __shfl_up(it2, o); if (lane >= o) { ig += a; it2 += b2; } }
        int pg = bg + ig - cg, pt = bt + it2 - ct;
        int ev = 1024 * w + lane, Lr = L;
#pragma unroll
        for (int i = 0; i < 17; ++i) {
            if (u[i] > T) { SELL[pg] = ev; ++pg; }
            else if (u[i] == T && Lr > 0) { SELL[pt] = ev; ++pt; }
            asm volatile("v_add_u32 %0, 64, %0\n\tv_add_u32 %1, -64, %1" : "+v"(ev), "+v"(Lr));
        }
    }
    __syncthreads();
    {
        const int hd = w, g = w >> 2, qpos = PAST + t;
        float lg[4];
#pragma unroll 2
        for (int i = 0; i < 4; ++i) {
            const int sraw = SELL[lane + 64 * i];
            const float* kr;
            if (sraw < PAST) { const int page = F.page_table[b * NPAGES + (sraw >> 7)]; kr = F.cache_k + ((size_t)page * PAGE + (sraw & 127)) * 128 + g * 64; }
            else kr = F.out + O_KS + (size_t)(b * TS + (sraw - PAST)) * 128 + g * 64;
            float a0 = 0.f, a1 = 0.f;
#pragma unroll
            for (int c = 0; c < 16; ++c) {
                const f32x4 kv = *(const f32x4*)(kr + c * 4);
                const unsigned q0 = QL[hd * 32 + c * 2], q1 = QL[hd * 32 + c * 2 + 1];
                a0 += bflo(q0) * kv[0] + bfhi(q0) * kv[1]; a1 += bflo(q1) * kv[2] + bfhi(q1) * kv[3];
            }
            const int dist = qpos - sraw; const int bk = dist < 128 ? BT[dist] : 31;
            lg[i] = (a0 + a1) * ATTN_SCALE + RB[bk * 8 + hd];
        }
        float m = fmaxf(fmaxf(lg[0], lg[1]), fmaxf(lg[2], lg[3])); m = wave_max(m);
        float sm = 0.f;
#pragma unroll
        for (int i = 0; i < 4; ++i) { lg[i] = __expf(lg[i] - m); sm += lg[i]; }
        const float inv = 1.f / wave_sum_dpp(sm);
#pragma unroll
        for (int i = 0; i < 4; ++i) PL[lane + 64 * i] = lg[i] * inv;
        const int dq = lane & 15, ks = lane >> 4;
        f32x4 o4 = {0.f, 0.f, 0.f, 0.f};
#pragma unroll 1
        for (int j0 = 0; j0 < 256; j0 += 64) {
            f32x4 vv[16]; float pp[16];
#pragma unroll
            for (int jj = 0; jj < 16; ++jj) {
                const int j = j0 + jj * 4 + ks;
                const int sraw = SELL[j]; pp[jj] = PL[j];
                const float* vr;
                if (sraw < PAST) { const int page = F.page_table[b * NPAGES + (sraw >> 7)]; vr = F.cache_v + ((size_t)page * PAGE + (sraw & 127)) * 128 + g * 64; }
                else vr = F.out + O_VS + (size_t)(b * TS + (sraw - PAST)) * 128 + g * 64;
                vv[jj] = *(const f32x4*)(vr + 4 * dq);
            }
#pragma unroll
            for (int jj = 0; jj < 16; ++jj) o4 += vv[jj] * pp[jj];
        }
#pragma unroll
        for (int e = 0; e < 4; ++e) { o4[e] += __shfl_xor(o4[e], 16); o4[e] += __shfl_xor(o4[e], 32); }
        if (ks == 0) *(u32x2*)(F.OATT + (size_t)tok * 512 + hd * 64 + 4 * dq) = pk4(o4);
    }
}
__device__ __forceinline__ void p4_attention(const Frame& F) {
    const float* SS = (const float*)(F.ws + WS_SS);
    __syncthreads();
    if (F.tid < 256) ((LAS float*)(F.lds + SQ_RB))[F.tid] = F.rel_bias[F.tid];
    if (F.tid < 128) ((LAS int*)(F.lds + SQ_BT))[F.tid] = t5_bucket(F.tid);
    __syncthreads();
    for (int it = F.bid; it < NTS; it += F.G) p4_sample_query_unit(F, SS, it >> 3, it & 7);
    for (int m = F.bid * 8 + F.wave; m < NT; m += F.G * 8) {
        int t, T_, bsm; if (m < NTP) { t = m & 2047; T_ = SEQ; bsm = m >> 11; } else { t = (m - NTP) & 7; T_ = TS; bsm = (m - NTP) >> 3; }
        const int c0 = F.lane * 8;
        float u0[8], u1[8], u2[8];
        { const u32x4 cg = *(const u32x4*)(F.PROJ + (size_t)m * NMIXP + C_CG + c0), xi = *(const u32x4*)(F.PROJ + (size_t)m * NMIXP + C_XIN + c0);
#pragma unroll
          for (int e = 0; e < 4; ++e) { u0[2 * e] = bflo(cg[e]) * bflo(xi[e]); u0[2 * e + 1] = bfhi(cg[e]) * bfhi(xi[e]); } }
#pragma unroll
        for (int d = 1; d <= 2; ++d) {
            float* ud = (d == 1) ? u1 : u2;
            if (t - d >= 0) {
                const u32x4 cg = *(const u32x4*)(F.PROJ + (size_t)(m - d) * NMIXP + C_CG + c0), xi = *(const u32x4*)(F.PROJ + (size_t)(m - d) * NMIXP + C_XIN + c0);
#pragma unroll
                for (int e = 0; e < 4; ++e) { ud[2 * e] = bflo(cg[e]) * bflo(xi[e]); ud[2 * e + 1] = bfhi(cg[e]) * bfhi(xi[e]); }
            } else if (m >= NTP) {
                const float* pv = F.state_conv + ((size_t)bsm * 2 + (2 + t - d)) * 512 + c0;
#pragma unroll
                for (int e = 0; e < 8; ++e) ud[e] = pv[e];
            } else {
#pragma unroll
                for (int e = 0; e < 8; ++e) ud[e] = 0.f;
            }
        }
        const u32x4 bg = *(const u32x4*)(F.PROJ + (size_t)m * NMIXP + C_BG + c0);
        float y[8];
#pragma unroll
        for (int e = 0; e < 8; ++e) {
            const int c = c0 + e;
            const float yy = F.conv_b[c] + F.conv_w[c] * u2[e] + F.conv_w[512 + c] * u1[e] + F.conv_w[1024 + c] * u0[e];
            const float bgv = (e & 1) ? bfhi(bg[e >> 1]) : bflo(bg[e >> 1]);
            y[e] = bgv * yy;
        }
        *(u32x4*)(F.OCONV + (size_t)m * 512 + c0) = (u32x4){cvt_pk_bf16(y[0], y[1]), cvt_pk_bf16(y[2], y[3]), cvt_pk_bf16(y[4], y[5]), cvt_pk_bf16(y[6], y[7])};
        if (t >= T_ - 2) {
            float* o = (m < NTP ? F.out + O_CP : F.out + O_CS) + ((size_t)bsm * 2 + (t - (T_ - 2))) * 512 + c0;
            const int rowi = (m < NTP) ? bsm * 2 + (t - (T_ - 2)) : 2 * NB_P + bsm * 2 + (t - (T_ - 2));
            const float* cx = (const float*)(F.ws + WS_CGX) + (size_t)rowi * 1024 + c0;
            const f32x4 ca = *(const f32x4*)cx, cb = *(const f32x4*)(cx + 4), xa = *(const f32x4*)(cx + 512), xb = *(const f32x4*)(cx + 516);
            *(f32x4*)o = ca * xa; *(f32x4*)(o + 4) = cb * xb;
        }
    }
}

#define P5_EPI(A1, A2) { \
            const f32x4 va = ACC4(A1), vc = ACC4(A2); \
            const u32x2 ga = *(const u32x2*)(F.PROJ + (size_t)m * NMIXP + C_GA + n), gb = *(const u32x2*)(F.PROJ + (size_t)m * NMIXP + C_GB + n); \
            f32x4 o; \
            o[0] = sigmoidf_(bflo(ga[0])) * va[0] + sigmoidf_(bflo(gb[0])) * vc[0]; \
            o[1] = sigmoidf_(bfhi(ga[0])) * va[1] + sigmoidf_(bfhi(gb[0])) * vc[1]; \
            o[2] = sigmoidf_(bflo(ga[1])) * va[2] + sigmoidf_(bflo(gb[1])) * vc[2]; \
            o[3] = sigmoidf_(bfhi(ga[1])) * va[3] + sigmoidf_(bfhi(gb[1])) * vc[3]; \
            *(u32x2*)(F.MERGED + (size_t)m * D + n) = pk4(o); }
struct P5aBody {
    const Frame* Fp;
    __device__ __forceinline__ void operator()(int m, int n, const f32x4 v) const {
        const Frame& F = *Fp;
        const u32x2 ga = *(const u32x2*)(F.PROJ + (size_t)m * NMIXP + C_GA + n);
        const f32x4 o = (f32x4){sigmoidf_(bflo(ga[0])) * v[0], sigmoidf_(bfhi(ga[0])) * v[1], sigmoidf_(bflo(ga[1])) * v[2], sigmoidf_(bfhi(ga[1])) * v[3]};
        *(f32x4*)(F.T1 + (size_t)m * D + n) = o;
    }
};
struct P5bBody {
    const Frame* Fp;
    __device__ __forceinline__ void operator()(int m, int n, const f32x4 v) const {
        const Frame& F = *Fp;
        const u32x2 gb = *(const u32x2*)(F.PROJ + (size_t)m * NMIXP + C_GB + n);
        const f32x4 pa = *(const f32x4*)(F.T1 + (size_t)m * D + n);
        const f32x4 o = (f32x4){pa[0] + sigmoidf_(bflo(gb[0])) * v[0], pa[1] + sigmoidf_(bfhi(gb[0])) * v[1], pa[2] + sigmoidf_(bflo(gb[1])) * v[2], pa[3] + sigmoidf_(bfhi(gb[1])) * v[3]};
        *(u32x2*)(F.MERGED + (size_t)m * D + n) = pk4(o);
    }
};
__device__ __forceinline__ void p5_gemm_merge(const Frame& F) {
    {
        pg8::StaticOrder S; S.init(NTP, D, F.G, F.bid);
        { pg8::Gemm g{F.OATT, F.WOA, NTP, D, 512}; pg8::EpiRC<P5aBody> E{P5aBody{&F}}; pg8::gemm_phase<pg8::EpiRC<P5aBody>, pg8::StaticOrder, true, true>(F.lds, g, S, E); }
        asm volatile("s_waitcnt vmcnt(0)" ::: "memory"); __syncthreads();
        { pg8::Gemm g{F.OCONV, F.WOC, NTP, D, 512}; pg8::EpiRC<P5bBody> E{P5bBody{&F}}; pg8::gemm_phase<pg8::EpiRC<P5bBody>, pg8::StaticOrder, true, true>(F.lds, g, S, E); }
    }
    for (int sl = F.bid; sl < NTS / 8 * (D / BN); sl += F.G) {
        const int m0 = NTP + (sl >> 3) * 8, n0 = (sl & 7) * BN;
        f32x16 s1[1][1], s2[1][1];
        gemm_slice8(F, s1, F.OATT, 512, F.WOA, 512, 512, m0, n0);
        gemm_slice8(F, s2, F.OCONV, 512, F.WOC, 512, 512, m0, n0);
        SLICE_EPI_LOOP(P5_EPI(s1, s2))
    }
}
#define P6_EPI(A1) { \
            const f32x4 v = ACC4(A1); \
            const f32x4 xv = *(const f32x4*)(x_row(F, m) + n); \
            const f32x4 g1 = *(const f32x4*)(F.MOD + (size_t)mod_row(m) * 6144 + 2048 + n); \
            *(f32x4*)(F.T1 + (size_t)m * D + n) = xv * DN_ALPHA + g1 * v; }
struct P6Body {
    const Frame* Fp;
    __device__ __forceinline__ void operator()(int m, int n, const f32x4 v) const {
        const Frame& F = *Fp;
        const f32x4 xv = *(const f32x4*)(F.x_p + (size_t)m * D + n);
        const f32x4 g1 = *(const f32x4*)(F.MOD + (size_t)(m >> 11) * 6144 + 2048 + n);
        *(f32x4*)(F.T1 + (size_t)m * D + n) = xv * DN_ALPHA + g1 * v;
    }
};
__device__ __forceinline__ void p6_gemm_out(const Frame& F) {
    {
        pg8::Gemm g{F.MERGED, F.WOUT, NTP, D, D}; pg8::StaticOrder S; S.init(NTP, D, F.G, F.bid);
        pg8::EpiRC<P6Body> E{P6Body{&F}}; pg8::gemm_phase<pg8::EpiRC<P6Body>, pg8::StaticOrder, true, true>(F.lds, g, S, E);
    }
    for (int sl = F.bid; sl < NTS / 8 * (D / BN); sl += F.G) {
        const int m0 = NTP + (sl >> 3) * 8, n0 = (sl & 7) * BN;
        f32x16 s1[1][1];
        gemm_slice8(F, s1, F.MERGED, D, F.WOUT, D, D, m0, n0);
        SLICE_EPI_LOOP(P6_EPI(s1))
    }
}
__device__ __forceinline__ void p7_ln1(const Frame& F) {
    for (int m = F.bid * 8 + F.wave; m < NT; m += F.G * 8) {
        float* tr = F.T1 + (size_t)m * D; const float* mr = F.MOD + (size_t)mod_row(m) * 6144;
        f32x4 v[4]; float s = 0.f;
#pragma unroll
        for (int i = 0; i < 4; ++i) { v[i] = *(const f32x4*)(tr + (i >> 1) * 512 + F.lane * 8 + (i & 1) * 4); s += v[i][0] + v[i][1] + v[i][2] + v[i][3]; }
        const float mean = wave_sum(s) * (1.f / D);
        float q = 0.f;
#pragma unroll
        for (int i = 0; i < 4; ++i) { v[i] = v[i] - mean; q += v[i][0] * v[i][0] + v[i][1] * v[i][1] + v[i][2] * v[i][2] + v[i][3] * v[i][3]; }
        const float rstd = rsqrtf(wave_sum(q) * (1.f / D) + LN_EPS);
        f32x4 hv[2][2];
#pragma unroll
        for (int hlf = 0; hlf < 2; ++hlf) {
            const int e = hlf * 512 + F.lane * 8;
            f32x4 a = v[2 * hlf] * rstd * *(const f32x4*)(F.ln1_g + e) + *(const f32x4*)(F.ln1_b + e);
            f32x4 b = v[2 * hlf + 1] * rstd * *(const f32x4*)(F.ln1_g + e + 4) + *(const f32x4*)(F.ln1_b + e + 4);
            *(f32x4*)(tr + e) = a; *(f32x4*)(tr + e + 4) = b;
            const f32x4 ha = a * (*(const f32x4*)(mr + 4096 + e) + 1.f) + *(const f32x4*)(mr + 3072 + e);
            const f32x4 hb = b * (*(const f32x4*)(mr + 4096 + e + 4) + 1.f) + *(const f32x4*)(mr + 3072 + e + 4);
            *(u32x4*)(F.H2 + (size_t)m * D + e) = (u32x4){cvt_pk_bf16(ha[0], ha[1]), cvt_pk_bf16(ha[2], ha[3]), cvt_pk_bf16(hb[0], hb[1]), cvt_pk_bf16(hb[2], hb[3])};
            hv[hlf][0] = ha; hv[hlf][1] = hb;
        }
        float am = 0.f;
#pragma unroll
        for (int i = 0; i < 2; ++i)
#pragma unroll
            for (int j = 0; j < 2; ++j)
#pragma unroll
                for (int e = 0; e < 4; ++e) am = fmaxf(am, fabsf(hv[i][j][e]));
        am = wave_max(am);
        const float sc = am > 0.f ? 224.f / am : 1.f;
#pragma unroll
        for (int hlf = 0; hlf < 2; ++hlf) {
            int w0 = 0, w1 = 0;
            w0 = __builtin_amdgcn_cvt_pk_fp8_f32(hv[hlf][0][0] * sc, hv[hlf][0][1] * sc, w0, false); w0 = __builtin_amdgcn_cvt_pk_fp8_f32(hv[hlf][0][2] * sc, hv[hlf][0][3] * sc, w0, true);
            w1 = __builtin_amdgcn_cvt_pk_fp8_f32(hv[hlf][1][0] * sc, hv[hlf][1][1] * sc, w1, false); w1 = __builtin_amdgcn_cvt_pk_fp8_f32(hv[hlf][1][2] * sc, hv[hlf][1][3] * sc, w1, true);
            *(u32x2*)(F.ws + WS_H8 + (size_t)m * D + hlf * 512 + F.lane * 8) = (u32x2){(unsigned)w0, (unsigned)w1};
        }
        if (F.lane == 0) ((float*)(F.ws + WS_SH))[m] = am > 0.f ? am * (1.f / 224.f) : 1.f;
    }
}
struct P8Body {
    const Frame* Fp;
    __device__ __forceinline__ void operator()(int m, int n, const f32x4 v) const { *(u32x2*)(Fp->QP + (size_t)m * D + n) = pk4(v); }
};
__device__ __forceinline__ void p8_gemm_q(const Frame& F) {
    {
        pg8::Gemm g{F.H2, F.WQ, NTP, D, D}; pg8::StaticOrder S; S.init(NTP, D, F.G, F.bid);
        pg8::EpiRC<P8Body> E{P8Body{&F}}; pg8::gemm_phase<pg8::EpiRC<P8Body>, pg8::StaticOrder, true, true>(F.lds, g, S, E);
    }
    for (int sl = F.bid; sl < NTS / 8 * (D / BN); sl += F.G) {
        const int m0 = NTP + (sl >> 3) * 8, n0 = (sl & 7) * BN;
        f32x16 s1[1][1];
        gemm_slice8(F, s1, F.H2, D, F.WQ, D, D, m0, n0);
        SLICE_EPI_LOOP({ *(u32x2*)(F.QP + (size_t)m * D + n) = pk4(ACC4(s1)); })
    }
}
constexpr int PR_ROW = 129;
__device__ __forceinline__ void p9_route(const Frame& F) {
    LAS float* SC = (LAS float*)F.lds;
    LAS float* TV = (LAS float*)(F.lds + 32 * 8 * PR_ROW * 4);
    LAS unsigned char* TI = (LAS unsigned char*)(F.lds + 32 * 8 * PR_ROW * 4 + 256 * 17 * 4);
    const int lane = F.lane, r = lane & 31, h = lane >> 5;
    const int nunits = (NT / 32) * 2;
    for (int it = F.bid; it < nunits; it += F.G) {
        const int tok0 = (it >> 1) * 32, hg = it & 1;
        __syncthreads();
        {
            const int head = hg * 4 + (F.wave >> 1), half = F.wave & 1;
            const bf16_t* KK = half ? F.K2 : F.K1;
            bf16x8 Bq[4];
#pragma unroll
            for (int s = 0; s < 4; ++s) Bq[s] = *(const bf16x8*)(F.QP + (size_t)(tok0 + r) * D + head * 128 + half * 64 + s * 16 + h * 8);
#pragma unroll
            for (int kt = 0; kt < 4; ++kt) {
                f32x16 c;
#pragma unroll
                for (int e = 0; e < 16; ++e) c[e] = 0.f;
#pragma unroll
                for (int s = 0; s < 4; ++s) {
                    const bf16x8 Ak = *(const bf16x8*)(KK + (size_t)(kt * 32 + r) * 64 + s * 16 + h * 8);
                    c = __builtin_amdgcn_mfma_f32_32x32x16_bf16(Ak, Bq[s], c, 0, 0, 0);
                }
#pragma unroll
                for (int e = 0; e < 16; ++e) { const int key = kt * 32 + (e & 3) + 8 * (e >> 2) + 4 * h; SC[(r * 8 + F.wave) * PR_ROW + key] = c[e]; }
            }
        }
        __syncthreads();
        if (F.tid < 256) {
            LAS float* row = SC + F.tid * PR_ROW;
            float gm[16];
#pragma unroll
            for (int gidx = 0; gidx < 16; ++gidx) {
                float m = row[gidx * 8];
#pragma unroll
                for (int k = 1; k < 8; ++k) m = fmaxf(m, row[gidx * 8 + k]);
                gm[gidx] = m;
            }
#pragma unroll 1
            for (int p = 0; p < 16; ++p) {
                float best = gm[0]; int bg = 0;
#pragma unroll
                for (int gidx = 1; gidx < 16; ++gidx) { const bool gt = gm[gidx] > best; best = gt ? gm[gidx] : best; bg = gt ? gidx : bg; }
                float v[8];
#pragma unroll
                for (int k = 0; k < 8; ++k) v[k] = row[bg * 8 + k];
                int bk = 7;
#pragma unroll
                for (int k = 6; k >= 0; --k) bk = (v[k] == best) ? k : bk;
                float nm = -INFINITY;
#pragma unroll
                for (int k = 0; k < 8; ++k) nm = fmaxf(nm, (k == bk) ? -INFINITY : v[k]);
                row[bg * 8 + bk] = -INFINITY;
#pragma unroll
                for (int gidx = 0; gidx < 16; ++gidx) gm[gidx] = (gidx == bg) ? nm : gm[gidx];
                TV[F.tid * 17 + p] = best; TI[F.tid * 17 + p] = (unsigned char)(bg * 8 + bk);
            }
        }
        __syncthreads();
        if (F.tid < 128) {
            const int tk = F.tid >> 2, hs = F.tid & 3;
            const int r1 = (tk * 8 + hs * 2) * 17, r2 = r1 + 17;
            LAS float* cand = SC + F.tid * 51;
            {
                float t1[16], t2[16];
#pragma unroll
                for (int i = 0; i < 16; ++i) { t1[i] = TV[r1 + i]; t2[i] = TV[r2 + i]; }
                int nc = 0;
#pragma unroll
                for (int i = 0; i < 16; ++i) {
#pragma unroll
                    for (int j = 0; j < 16 / (i + 1); ++j) { cand[nc] = t1[i] + t2[j]; ++nc; }
                }
            }
            float sv[16]; int se[16];
#pragma unroll
            for (int p = 0; p < 16; ++p) {
                float best = -INFINITY; int bc = 0, bij = 0, c = 0;
#pragma unroll
                for (int i = 0; i < 16; ++i) {
#pragma unroll
                    for (int j = 0; j < 16 / (i + 1); ++j) { const float v = cand[c]; const bool gt = v > best; best = gt ? v : best; bc = gt ? c : bc; bij = gt ? (i * 16 + j) : bij; ++c; }
                }
                cand[bc] = -INFINITY; sv[p] = best; se[p] = (int)TI[r1 + (bij >> 4)] * 128 + (int)TI[r2 + (bij & 15)];
            }
            const float mx0 = sv[0]; float den = 0.f;
#pragma unroll
            for (int p = 0; p < 16; ++p) { sv[p] = __expf(sv[p] - mx0); den += sv[p]; }
            const float dinv = 1.f / den;
            const int head = hg * 4 + hs;
            int* eo = F.EIDX + (size_t)(tok0 + tk) * NEXP_SEL + head * 16; float* go = F.GW + (size_t)(tok0 + tk) * NEXP_SEL + head * 16;
#pragma unroll
            for (int p = 0; p < 16; ++p) { eo[p] = se[p]; go[p] = sv[p] * dinv; }
        }
    }
}

constexpr int TPW = 65, PAIRS_MAX = 9 * 128, PK = 4;
constexpr int P10_HROW = 1024 + 64;
constexpr int P10_H = 0;
constexpr int P10_SH = 32 * P10_HROW;
constexpr int P10_VROW = 2048 + 64;
constexpr int P10_STG = P10_SH + 128;
constexpr int P10_HIST = P10_STG + 8 * 4 * P10_VROW;
typedef short s16x4 __attribute__((ext_vector_type(4)));
__device__ __forceinline__ long pack64(unsigned lo, unsigned hi) { return (long)(((unsigned long long)hi << 32) | (unsigned long long)lo); }
__device__ __forceinline__ void fp8x16_to_bf16(const u32x4 v, u32x4& lo, u32x4& hi) {
    unsigned o[8];
#pragma unroll
    for (int i = 0; i < 4; ++i) {
        const f32x2_t a = __builtin_amdgcn_cvt_pk_f32_fp8((int)v[i], false), b2 = __builtin_amdgcn_cvt_pk_f32_fp8((int)v[i], true);
        o[2 * i] = cvt_pk_bf16(a[0], a[1]); o[2 * i + 1] = cvt_pk_bf16(b2[0], b2[1]);
    }
    lo = (u32x4){o[0], o[1], o[2], o[3]}; hi = (u32x4){o[4], o[5], o[6], o[7]};
}
__device__ __forceinline__ void p10_peer(const Frame& F) {
    const int lane = F.lane, w = F.wave;
    unsigned char* ws = F.ws;
    const unsigned char* PU8 = ws + WS_PU8; const unsigned char* PV8 = ws + WS_PV8;
    const float* SU = (const float*)(ws + WS_SU); const float* SV = (const float*)(ws + WS_SV);
    const unsigned char* H8 = ws + WS_H8; const float* SH = (const float*)(ws + WS_SH);
    const int tok0 = F.bid * TPW;
    LAS unsigned* hist = (LAS unsigned*)(F.lds + P10_HIST) + w * 128;
    LAS unsigned char* stg = F.lds + P10_STG + w * (4 * P10_VROW);
    LAS float* SHl = (LAS float*)(F.lds + P10_SH);
    unsigned* SE0 = (unsigned*)(ws + WS_SE) + ((size_t)F.bid * 8 + w) * PAIRS_MAX;
    float* SG0 = (float*)(ws + WS_SG) + ((size_t)F.bid * 8 + w) * PAIRS_MAX;
    const int ntok = (w == 0) ? 9 : 8;
    const int r16 = lane & 15, q4 = lane >> 4;
#pragma unroll 1
    for (int pass = 0; pass < 3; ++pass) {
        const int kbase = pass * PK, nk = (ntok - kbase < PK) ? (ntok - kbase > 0 ? ntok - kbase : 0) : PK, npairs = nk * 128;
        __syncthreads();
        for (int c = F.tid; c < 32 * 64; c += NTHREADS) {
            const int row = c >> 6, tl = 32 * pass + row;
            if (tl < TPW) *(LAS u32x4*)(F.lds + P10_H + row * P10_HROW + (c & 63) * 16) = *(const u32x4*)(H8 + (size_t)(tok0 + tl) * D + (size_t)(c & 63) * 16);
        }
        if (F.tid < 32 && 32 * pass + F.tid < TPW) SHl[F.tid] = SH[tok0 + 32 * pass + F.tid];
        __syncthreads();
        if (nk <= 0) continue;
        unsigned* SE = SE0 + pass * (PK * 128); float* SG = SG0 + pass * (PK * 128);
        hist[lane] = 0u; hist[lane + 64] = 0u;
        int ex[8];
#pragma unroll
        for (int i = 0; i < 8; ++i) {
            const int p = lane + 64 * i;
            ex[i] = -1;
            if (p < npairs) { ex[i] = F.EIDX[(size_t)(tok0 + w + 8 * (kbase + (p >> 7))) * NEXP_SEL + (p & 127)]; atomicAdd((unsigned*)&hist[ex[i] >> 7], 1u); }
        }
        {
            const unsigned c0 = hist[2 * lane], c1 = hist[2 * lane + 1];
            unsigned incl = c0 + c1;
#pragma unroll
            for (int o = 1; o < 64; o <<= 1) { const unsigned t = __shfl_up(incl, o); if (lane >= o) incl += t; }
            const unsigned excl = incl - (c0 + c1);
            hist[2 * lane] = excl; hist[2 * lane + 1] = excl + c0;
        }
#pragma unroll
        for (int i = 0; i < 8; ++i) {
            const int p = lane + 64 * i;
            if (p < npairs) {
                const unsigned pos = atomicAdd((unsigned*)&hist[ex[i] >> 7], 1u);
                SE[pos] = (unsigned)ex[i] | ((unsigned)(p >> 7) << 14);
                SG[pos] = F.GW[(size_t)(tok0 + w + 8 * (kbase + (p >> 7))) * NEXP_SEL + (p & 127)];
            }
        }
        asm volatile("s_waitcnt vmcnt(0)" ::: "memory");
        f32x4 acc[16];
#pragma unroll
        for (int c = 0; c < 16; ++c) acc[c] = (f32x4){0.f, 0.f, 0.f, 0.f};
#pragma unroll 1
        for (int c0 = 0; c0 < npairs; c0 += 64) {
            const int wv = (int)SE[c0 + lane]; const int gv = __float_as_int(SG[c0 + lane]);
#pragma unroll 1
            for (int j0 = 0; j0 < 64; j0 += 16) {
                const int wr = __shfl(wv, j0 + r16);
                const int er = wr & 16383, sr = wr >> 14;
                const float gr = __int_as_float(__shfl(gv, j0 + r16));
                const unsigned char* ur = PU8 + (size_t)er * D + q4 * 16;
                u32x4 Ub[16];
#pragma unroll
                for (int t = 0; t < 16; ++t) Ub[t] = *(const u32x4*)(ur + t * 64);
                const float suv = SU[er], svv = SV[er];
                u32x4 V8[2][4];
#pragma unroll
                for (int k = 0; k < 4; ++k) V8[0][k] = *(const u32x4*)(PV8 + (size_t)(__builtin_amdgcn_readlane(wv, j0 + k) & 16383) * D + lane * 16);
                LAS const unsigned char* hr = F.lds + P10_H + (w + 8 * sr) * P10_HROW + q4 * 16;
                const float shv = SHl[w + 8 * sr];
                f32x4 C0 = {0.f, 0.f, 0.f, 0.f}, C1 = {0.f, 0.f, 0.f, 0.f};
#pragma unroll
                for (int t = 0; t < 16; ++t) {
                    const u32x4 hh = *(LAS const u32x4*)(hr + t * 64);
                    C0 = __builtin_amdgcn_mfma_f32_16x16x32_fp8_fp8(pack64(hh[0], hh[1]), pack64(Ub[t][0], Ub[t][1]), C0, 0, 0, 0);
                    C1 = __builtin_amdgcn_mfma_f32_16x16x32_fp8_fp8(pack64(hh[2], hh[3]), pack64(Ub[t][2], Ub[t][3]), C1, 0, 0, 0);
                }
                C0 = C0 + C1;
                const int rsel = lane & 3;
                const float dv = (rsel == 0 ? C0[0] : (rsel == 1 ? C0[1] : (rsel == 2 ? C0[2] : C0[3]))) * (suv * shv);
                const int actv = __float_as_int(gelu_tanh(dv) * (gr * svv));
#pragma unroll
                for (int sg = 0; sg < 4; ++sg) {
                    if (sg + 1 < 4) {
#pragma unroll
                        for (int k = 0; k < 4; ++k) V8[(sg + 1) & 1][k] = *(const u32x4*)(PV8 + (size_t)(__builtin_amdgcn_readlane(wv, j0 + 4 * (sg + 1) + k) & 16383) * D + lane * 16);
                    }
#pragma unroll
                    for (int k = 0; k < 4; ++k) {
                        u32x4 lo, hi; fp8x16_to_bf16(V8[sg & 1][k], lo, hi);
                        *(LAS u32x4*)(stg + k * P10_VROW + lane * 32) = lo;
                        *(LAS u32x4*)(stg + k * P10_VROW + lane * 32 + 16) = hi;
                    }
                    float a4[4];
#pragma unroll
                    for (int k = 0; k < 4; ++k) {
                        const int p = 4 * sg + k;
                        const float actk = __int_as_float(__builtin_amdgcn_readlane(actv, 16 * (p >> 2) + p));
                        const int slot = __builtin_amdgcn_readlane(wv, j0 + p) >> 14;
                        a4[k] = (slot == (lane & 3)) ? actk : 0.f;
                    }
                    const u32x2 apk = (u32x2){cvt_pk_bf16(a4[0], a4[1]), cvt_pk_bf16(a4[2], a4[3])};
                    s16x4 Aop; __builtin_memcpy(&Aop, &apk, 8);
                    LAS const unsigned char* tb = stg + ((lane & 15) >> 2) * P10_VROW + ((lane >> 4) * 16 + (lane & 3) * 4) * 2;
#pragma unroll
                    for (int c = 0; c < 16; ++c) {
                        const s16x4 Bop = __builtin_amdgcn_ds_read_tr16_b64_v4i16((LAS s16x4*)(tb + c * 128));
                        acc[c] = __builtin_amdgcn_mfma_f32_4x4x4bf16_1k(Aop, Bop, acc[c], 0, 0, 0);
                    }
                }
            }
        }
#pragma unroll
        for (int k = 0; k < PK; ++k) {
            if (k >= nk) continue;
            const int m = tok0 + w + 8 * (kbase + k);
            const float* x1 = F.T1 + (size_t)m * D; const float* mr = F.MOD + (size_t)mod_row(m) * 6144 + 5120;
            float tv[16]; float s = 0.f;
#pragma unroll
            for (int c = 0; c < 16; ++c) { const float t = x1[c * 64 + lane] * DN_ALPHA + mr[c * 64 + lane] * acc[c][k]; tv[c] = t; s += t; }
            const float mean = wave_sum(s) * (1.f / D);
            float q = 0.f;
#pragma unroll
            for (int c = 0; c < 16; ++c) { tv[c] -= mean; q += tv[c] * tv[c]; }
            const float rstd = rsqrtf(wave_sum(q) * (1.f / D) + LN_EPS);
            float* yo = (m < NTP) ? F.out + O_YP + (size_t)m * D : F.out + O_YS + (size_t)(m - NTP) * D;
#pragma unroll
            for (int c = 0; c < 16; ++c) yo[c * 64 + lane] = tv[c] * rstd * F.ln2_g[c * 64 + lane] + F.ln2_b[c * 64 + lane];
        }
    }
}

constexpr int N_PHASES = 11;
__global__ void __launch_bounds__(NTHREADS, 2) fwd_kernel(Args args) {
    extern __shared__ __attribute__((aligned(16))) unsigned char lds_raw[];
    Frame F;
    F.lds = (LAS unsigned char*)lds_raw;
    F.tid = threadIdx.x; F.lane = F.tid & 63; F.wave = __builtin_amdgcn_readfirstlane(F.tid >> 6); F.G = gridDim.x; F.bid = blockIdx.x;
    F.x_p = (const float*)args.in[0]; F.x_s = (const float*)args.in[1]; F.c_p = (const float*)args.in[2]; F.c_s = (const float*)args.in[3];
    F.cache_k = (const float*)args.in[4]; F.cache_v = (const float*)args.in[5]; F.cache_ki = (const float*)args.in[6]; F.state_conv = (const float*)args.in[7];
    F.page_table = (const int*)args.in[8]; F.rel_bias = (const float*)args.in[9]; F.w_ada = (const float*)args.in[10]; F.b_ada = (const float*)args.in[11];
    F.w_in = (const float*)args.in[12]; F.conv_w = (const float*)args.in[13]; F.conv_b = (const float*)args.in[14]; F.w_o_attn = (const float*)args.in[15];
    F.w_o_conv = (const float*)args.in[16]; F.w_out = (const float*)args.in[17]; F.ln1_g = (const float*)args.in[18]; F.ln1_b = (const float*)args.in[19];
    F.ln2_g = (const float*)args.in[20]; F.ln2_b = (const float*)args.in[21]; F.peer_wq = (const float*)args.in[22]; F.peer_k1 = (const float*)args.in[23];
    F.peer_k2 = (const float*)args.in[24]; F.peer_u = (const float*)args.in[25]; F.peer_v = (const float*)args.in[26];
    F.out = args.out;
    unsigned char* ws = args.ws; F.ws = ws;
    F.MOD = (float*)(ws + WS_MOD); F.WIN = (bf16_t*)(ws + WS_WIN); F.WOA = (bf16_t*)(ws + WS_WOA); F.WOC = (bf16_t*)(ws + WS_WOC);
    F.WOUT = (bf16_t*)(ws + WS_WOUT); F.WQ = (bf16_t*)(ws + WS_WQ); F.K1 = (bf16_t*)(ws + WS_K1); F.K2 = (bf16_t*)(ws + WS_K2);
    F.PU = (bf16_t*)(ws + WS_PU); F.PV = (bf16_t*)(ws + WS_PV); F.H1 = (bf16_t*)(ws + WS_H1); F.PROJ = (bf16_t*)(ws + WS_PROJ);
    F.WI = (float*)(ws + WS_WI); F.SEL = (int*)(ws + WS_SEL); F.OATT = (bf16_t*)(ws + WS_OATT); F.OCONV = (bf16_t*)(ws + WS_OCONV);
    F.MERGED = (bf16_t*)(ws + WS_MERGED); F.T1 = (float*)(ws + WS_T1); F.H2 = (bf16_t*)(ws + WS_H2); F.QP = (bf16_t*)(ws + WS_QP);
    F.EIDX = (int*)(ws + WS_EIDX); F.GW = (float*)(ws + WS_GW);
    volatile LAS unsigned* misc = (volatile LAS unsigned*)(F.lds + LDS_MISC);
    if (F.tid < 16) misc[F.tid] = 0u;
    __syncthreads();
    XcdBarrier bar; bar.bar = (unsigned*)(ws + WS_CTL); bar.x = 0; bar.st = misc;
    const int lo = args.ph_lo, hi = args.ph_hi;
    if (hi - lo > 1) bar = xcd_barrier_post((unsigned*)(ws + WS_CTL), misc);
#define IN(k) (lo <= (k) && (k) < hi)
#define SEAM(k) do { if (IN(k) && IN((k) + 1)) xcd_barrier(bar); } while (0)
    if (IN(0)) p0_prologue(F);       SEAM(0);
    if (IN(1)) p1_modulate(F);       SEAM(1);
    if (IN(2)) p2_gemm_in(F);        SEAM(2);
    if (IN(3)) p3_index(F);          SEAM(3);
    if (IN(4)) p4_attention(F);      SEAM(4);
    if (IN(5)) p5_gemm_merge(F);     SEAM(5);
    if (IN(6)) p6_gemm_out(F);       SEAM(6);
    if (IN(7)) p7_ln1(F);            SEAM(7);
    if (IN(8)) p8_gemm_q(F);         SEAM(8);
    if (IN(9)) p9_route(F);          SEAM(9);
    if (IN(10)) p10_peer(F);
#undef IN
#undef SEAM
}

extern "C" void kernel_launch(void* const* d_in, const int* in_sizes, int n_in, void* d_out, int out_size, void* d_ws, size_t ws_size, hipStream_t stream) {
    static int grid = 0;
    if (grid == 0) {
        if (n_in != 27 || (size_t)out_size != O_END || ws_size < WS_END) { fprintf(stderr, "kernel_launch: unexpected shapes (n_in %d out %d ws %zu)\n", n_in, out_size, ws_size); grid = -1; return; }
        int dev = 0, cus = 0;
        if (hipGetDevice(&dev) != hipSuccess || hipDeviceGetAttribute(&cus, hipDeviceAttributeMultiprocessorCount, dev) != hipSuccess) { grid = -1; return; }
        if (hipFuncSetAttribute((const void*)fwd_kernel, hipFuncAttributeMaxDynamicSharedMemorySize, LDS_BYTES) != hipSuccess) { fprintf(stderr, "kernel_launch: hipFuncSetAttribute failed\n"); grid = -1; return; }
        (void)hipGetLastError();
        grid = cus;
    }
    if (grid < 0) return;
    (void)hipMemsetAsync((char*)d_ws + WS_CTL, 0, CTL_ZERO_BYTES, stream);
    Args a{};
    for (int i = 0; i < 27; ++i) a.in[i] = d_in[i];
    a.out = (float*)d_out; a.ws = (unsigned char*)d_ws;
#if N_LAUNCHES == 1
    a.ph_lo = 0; a.ph_hi = N_PHASES;
    hipLaunchKernelGGL(fwd_kernel, dim3(grid), dim3(NTHREADS), LDS_BYTES, stream, a);
#else
    for (int p = 0; p < N_PHASES; ++p) { a.ph_lo = p; a.ph_hi = p + 1; hipLaunchKernelGGL(fwd_kernel, dim3(grid), dim3(NTHREADS), LDS_BYTES, stream, a); }
#endif
}
```

```cpp
#include <hip/hip_runtime.h>
#include <cstdio>
#include <cstdint>

#ifndef N_LAUNCHES
#define N_LAUNCHES 1
#endif

typedef unsigned short bf16_t;
typedef short bf16x8 __attribute__((ext_vector_type(8)));
typedef float f32x4 __attribute__((ext_vector_type(4)));
typedef float f32x16 __attribute__((ext_vector_type(16)));
typedef unsigned u32x4 __attribute__((ext_vector_type(4)));
typedef unsigned u32x2 __attribute__((ext_vector_type(2)));
#define LAS __attribute__((address_space(3)))

constexpr int D = 1024, NB_P = 8, SEQ = 2048, NB_S = 32, TS = 8, PAST = 8192, PAGE = 128, NPAGES = 64;
constexpr int NTP = NB_P * SEQ;
constexpr int NTS = NB_S * TS;
constexpr int NT = NTP + NTS;
constexpr int NMIX = 4676, NMIXP = 4736;
constexpr int C_Q = 0, C_K = 512, C_V = 640, C_QI = 768, C_KI = 1024, C_BG = 1088, C_CG = 1600, C_XIN = 2112, C_GA = 2624, C_GB = 3648, C_WI = 4672;
constexpr int NSEL = 256;
constexpr float ATTN_SCALE = 0.125f, IDX_SCALE = 0.0625f;
constexpr float DN_ALPHA = 1.189207115002721f, LN_EPS = 1e-5f;
constexpr int NEXP_SEL = 128;

constexpr size_t O_YP = 0, O_YS = 16777216, O_KP = 17039360, O_VP = 19136512, O_KIP = 21233664, O_CP = 22282240,
                 O_KS = 22290432, O_VS = 22323200, O_KIS = 22355968, O_CS = 22372352, O_END = 22405120;

constexpr size_t MB = 1048576;
constexpr size_t WS_CTL = 0, WS_MOD = 1 * MB, WS_WIN = 2 * MB, WS_WOA = 12 * MB, WS_WOC = 13 * MB, WS_WOUT = 14 * MB, WS_WQ = 16 * MB,
                 WS_K1 = 18 * MB, WS_K2 = 18 * MB + 65536, WS_PU = 20 * MB, WS_PV = 52 * MB, WS_H1 = 84 * MB, WS_PROJ = 118 * MB,
                 WS_WI = 270 * MB, WS_SEL = 271 * MB, WS_OATT = 288 * MB, WS_OCONV = 305 * MB, WS_MERGED = 322 * MB, WS_T1 = 355 * MB,
                 WS_H2 = 420 * MB, WS_QP = 453 * MB, WS_EIDX = 486 * MB, WS_GW = 495 * MB, WS_SS = 504 * MB, WS_SE = 513 * MB, WS_SG = 523 * MB, WS_VT = 533 * MB, WS_CGX = 538 * MB, WS_END = 539 * MB;
constexpr size_t WS_PU8 = WS_PU, WS_PV8 = WS_PU + 16 * MB, WS_SU = WS_PV, WS_SV = WS_PV + 65536, WS_H8 = WS_PV + 1 * MB, WS_SH = WS_PV + 20 * MB;
constexpr int CTL_ZERO_BYTES = 65536;

constexpr int NTHREADS = 512;
constexpr int LDS_BYTES = 160 * 1024 - 512;
constexpr int LDS_MISC = LDS_BYTES - 64;

__device__ __forceinline__ float bf2f(bf16_t b) { return __uint_as_float(((unsigned)b) << 16); }
__device__ __forceinline__ float bflo(unsigned p) { return __uint_as_float(p << 16); }
__device__ __forceinline__ float bfhi(unsigned p) { return __uint_as_float(p & 0xFFFF0000u); }
typedef __bf16 bf16x2_t __attribute__((ext_vector_type(2)));
typedef float f32x2_t __attribute__((ext_vector_type(2)));
__device__ __forceinline__ unsigned cvt_pk_bf16(float lo, float hi) { const f32x2_t f = {lo, hi}; const bf16x2_t b = __builtin_convertvector(f, bf16x2_t); unsigned r; __builtin_memcpy(&r, &b, 4); return r; }
__device__ __forceinline__ bf16_t f2bf(float f) { return (bf16_t)(cvt_pk_bf16(f, 0.f) & 0xFFFFu); }
__device__ __forceinline__ float wave_sum(float v) {
#pragma unroll
    for (int o = 32; o >= 1; o >>= 1) v += __shfl_xor(v, o);
    return v;
}
__device__ __forceinline__ float wave_sum_dpp(float v) {
    int x;
    x = __builtin_amdgcn_update_dpp(0, __float_as_int(v), 0xB1, 0xF, 0xF, false);  v += __int_as_float(x);
    x = __builtin_amdgcn_update_dpp(0, __float_as_int(v), 0x4E, 0xF, 0xF, false);  v += __int_as_float(x);
    x = __builtin_amdgcn_update_dpp(0, __float_as_int(v), 0x141, 0xF, 0xF, false); v += __int_as_float(x);
    x = __builtin_amdgcn_update_dpp(0, __float_as_int(v), 0x140, 0xF, 0xF, false); v += __int_as_float(x);
    x = __builtin_amdgcn_update_dpp(0, __float_as_int(v), 0x142, 0xA, 0xF, false); v += __int_as_float(x);
    x = __builtin_amdgcn_update_dpp(0, __float_as_int(v), 0x143, 0xC, 0xF, false); v += __int_as_float(x);
    return __int_as_float(__builtin_amdgcn_readlane(__float_as_int(v), 63));
}
__device__ __forceinline__ float wave_max(float v) {
#pragma unroll
    for (int o = 32; o >= 1; o >>= 1) v = fmaxf(v, __shfl_xor(v, o));
    return v;
}
__device__ __forceinline__ float sigmoidf_(float x) { return 1.f / (1.f + __expf(-x)); }
__device__ __forceinline__ float gelu_tanh(float a) {
    const float z = 0.7978845608028654f * (a + 0.044715f * a * a * a);
    const float e = __expf(2.f * z);
    const float t = 1.f - 2.f * __builtin_amdgcn_rcpf(e + 1.f);
    return 0.5f * a * (1.f + t);
}
__device__ __forceinline__ unsigned f2ord(float f) { const unsigned u = __float_as_uint(f); return (u & 0x80000000u) ? ~u : (u | 0x80000000u); }
__device__ __forceinline__ int t5_bucket(int n) {
    if (n < 16) return n;
    int b = 16;
    b += (n >= 19) + (n >= 21) + (n >= 24) + (n >= 27) + (n >= 31) + (n >= 35) + (n >= 40) + (n >= 46) + (n >= 52) + (n >= 59) + (n >= 67) + (n >= 77) + (n >= 87) + (n >= 99) + (n >= 113);
    return b;
}

#define XB_TMO      128
#define XB_XCNT(j)  (256  + 64 * (j))
#define XB_XSUB(j)  (1280 + 64 * (j))
#define XB_XGEN(j)  (2304 + 64 * (j))
#define XB_TOP      3328
#define XB_TOPGEN   3392
#define XCD_BAR_WORDS 3456
#define XB_SPIN_CAP (1u << 18)
__device__ __forceinline__ unsigned xb_ld(unsigned* p)              { return __hip_atomic_load(p, __ATOMIC_RELAXED, __HIP_MEMORY_SCOPE_AGENT); }
__device__ __forceinline__ unsigned xb_add(unsigned* p, unsigned v) { return __hip_atomic_fetch_add(p, v, __ATOMIC_RELAXED, __HIP_MEMORY_SCOPE_AGENT); }
__device__ __forceinline__ unsigned xb_xcc_id() { return (unsigned)__builtin_amdgcn_s_getreg((3 << 11) | 20) & 0xFu; }
#define XB_SPIN(cond, bar) do { unsigned _sp = 0; while (cond) { __builtin_amdgcn_s_sleep(1); \
    if ((++_sp & 255u) == 0u) { if (xb_ld(&(bar)[XB_TMO])) break; if (_sp > XB_SPIN_CAP) { atomicAdd(&(bar)[XB_TMO], 1u); break; } } } } while (0)
struct XcdBarrier { unsigned* bar; unsigned x; volatile LAS unsigned* st; };
__device__ __forceinline__ XcdBarrier xcd_barrier_post(unsigned* bar, volatile LAS unsigned* st) {
    XcdBarrier b; b.bar = bar; b.x = xb_xcc_id(); b.st = st;
    if (threadIdx.x == 0) (void)xb_add(&bar[XB_XCNT(b.x)], 1u);
    return b;
}
__device__ __forceinline__ void xcd_barrier_complete(unsigned* bar, unsigned x, unsigned& nloc, unsigned& nx) {
    const unsigned G = gridDim.x * gridDim.y * gridDim.z;
    unsigned sum, cnt, mine, sp = 0u;
    for (;;) {
        sum = 0u; cnt = 0u; mine = 0u;
#pragma unroll
        for (unsigned j = 0; j < 16; ++j) { const unsigned c = xb_ld(&bar[XB_XCNT(j)]); sum += c; cnt += (c > 0u) ? 1u : 0u; mine = (j == x) ? c : mine; }
        if (sum == G) break;
        __builtin_amdgcn_s_sleep(1);
        if ((++sp & 255u) == 0u) { if (xb_ld(&bar[XB_TMO])) break; if (sp > XB_SPIN_CAP) { atomicAdd(&bar[XB_TMO], 1u); break; } }
    }
    nloc = mine > 0u ? mine : 1u; nx = cnt > 0u ? cnt : 1u;
}
__device__ __forceinline__ void xcd_barrier(const XcdBarrier& b) {
    asm volatile("s_waitcnt vmcnt(0)" ::: "memory");
    __syncthreads();
    if (threadIdx.x == 0) {
        unsigned* bar = b.bar;
        __builtin_amdgcn_s_waitcnt(0);
        unsigned nloc = b.st[0], nx = b.st[1];
        if (nloc == 0u) { xcd_barrier_complete(bar, b.x, nloc, nx); b.st[0] = nloc; b.st[1] = nx; }
        const unsigned old = xb_add(&bar[XB_XSUB(b.x)], 1u);
        const unsigned gen = old / nloc;
        if (old + 1u == (gen + 1u) * nloc) {
            __builtin_amdgcn_fence(__ATOMIC_RELEASE, "agent");
            asm volatile("s_waitcnt vmcnt(0)" ::: "memory");
            const unsigned og = xb_add(&bar[XB_TOP], 1u);
            const unsigned tg = og / nx;
            if (og + 1u == (tg + 1u) * nx) xb_add(&bar[XB_TOPGEN], 1u);
            else XB_SPIN(xb_ld(&bar[XB_TOPGEN]) == tg, bar);
            __builtin_amdgcn_fence(__ATOMIC_ACQUIRE, "agent");
            xb_add(&bar[XB_XGEN(b.x)], 1u);
            asm volatile("s_waitcnt vmcnt(0)" ::: "memory");
        } else {
            XB_SPIN(xb_ld(&bar[XB_XGEN(b.x)]) == gen, bar);
            __builtin_amdgcn_fence(__ATOMIC_ACQUIRE, "agent");
            asm volatile("s_waitcnt vmcnt(0)" ::: "memory");
        }
    }
    __syncthreads();
}

struct Args { const void* in[27]; float* out; unsigned char* ws; int ph_lo, ph_hi; };
struct Core { LAS unsigned char* lds; int tid, lane, wave, G, bid; };
struct Frame {
    LAS unsigned char* lds;
    int tid, lane, wave, G, bid;
    const float *x_p, *x_s, *c_p, *c_s, *cache_k, *cache_v, *cache_ki, *state_conv, *rel_bias, *w_ada, *b_ada, *w_in, *conv_w, *conv_b,
                *w_o_attn, *w_o_conv, *w_out, *ln1_g, *ln1_b, *ln2_g, *ln2_b, *peer_wq, *peer_k1, *peer_k2, *peer_u, *peer_v;
    const int* page_table;
    float* out; unsigned char* ws;
    float* MOD; bf16_t *WIN, *WOA, *WOC, *WOUT, *WQ, *K1, *K2, *PU, *PV, *H1, *PROJ, *OATT, *OCONV, *MERGED, *H2, *QP;
    float *WI, *T1, *GW; int *SEL, *EIDX;
};
constexpr int LDS_PTAB = LDS_BYTES - 512;
__device__ __forceinline__ unsigned char* ldptr(const Core& C, int k) {
    LAS const unsigned* p = (LAS const unsigned*)(C.lds + LDS_PTAB) + 2 * k;
    const unsigned lo = __builtin_amdgcn_readfirstlane(p[0]), hi = __builtin_amdgcn_readfirstlane(p[1]);
    return (unsigned char*)(((unsigned long long)hi << 32) | (unsigned long long)lo);
}
__device__ __forceinline__ void load_frame(Frame& F, const Core& C) {
    F.lds = C.lds; F.tid = C.tid; F.lane = C.lane; F.wave = C.wave; F.G = C.G; F.bid = C.bid;
    F.x_p = (const float*)ldptr(C, 0); F.x_s = (const float*)ldptr(C, 1); F.c_p = (const float*)ldptr(C, 2); F.c_s = (const float*)ldptr(C, 3);
    F.cache_k = (const float*)ldptr(C, 4); F.cache_v = (const float*)ldptr(C, 5); F.cache_ki = (const float*)ldptr(C, 6); F.state_conv = (const float*)ldptr(C, 7);
    F.page_table = (const int*)ldptr(C, 8); F.rel_bias = (const float*)ldptr(C, 9); F.w_ada = (const float*)ldptr(C, 10); F.b_ada = (const float*)ldptr(C, 11);
    F.w_in = (const float*)ldptr(C, 12); F.conv_w = (const float*)ldptr(C, 13); F.conv_b = (const float*)ldptr(C, 14); F.w_o_attn = (const float*)ldptr(C, 15);
    F.w_o_conv = (const float*)ldptr(C, 16); F.w_out = (const float*)ldptr(C, 17); F.ln1_g = (const float*)ldptr(C, 18); F.ln1_b = (const float*)ldptr(C, 19);
    F.ln2_g = (const float*)ldptr(C, 20); F.ln2_b = (const float*)ldptr(C, 21); F.peer_wq = (const float*)ldptr(C, 22); F.peer_k1 = (const float*)ldptr(C, 23);
    F.peer_k2 = (const float*)ldptr(C, 24); F.peer_u = (const float*)ldptr(C, 25); F.peer_v = (const float*)ldptr(C, 26);
    F.out = (float*)ldptr(C, 27);
    unsigned char* ws = ldptr(C, 28);
    F.MOD = (float*)(ws + WS_MOD); F.WIN = (bf16_t*)(ws + WS_WIN); F.WOA = (bf16_t*)(ws + WS_WOA); F.WOC = (bf16_t*)(ws + WS_WOC);
    F.WOUT = (bf16_t*)(ws + WS_WOUT); F.WQ = (bf16_t*)(ws + WS_WQ); F.K1 = (bf16_t*)(ws + WS_K1); F.K2 = (bf16_t*)(ws + WS_K2);
    F.PU = (bf16_t*)(ws + WS_PU); F.PV = (bf16_t*)(ws + WS_PV); F.H1 = (bf16_t*)(ws + WS_H1); F.PROJ = (bf16_t*)(ws + WS_PROJ);
    F.WI = (float*)(ws + WS_WI); F.SEL = (int*)(ws + WS_SEL); F.OATT = (bf16_t*)(ws + WS_OATT); F.OCONV = (bf16_t*)(ws + WS_OCONV);
    F.MERGED = (bf16_t*)(ws + WS_MERGED); F.T1 = (float*)(ws + WS_T1); F.H2 = (bf16_t*)(ws + WS_H2); F.QP = (bf16_t*)(ws + WS_QP);
    F.EIDX = (int*)(ws + WS_EIDX); F.GW = (float*)(ws + WS_GW);
}
__device__ __forceinline__ const float* x_row(const Frame& F, int m) { return m < NTP ? F.x_p + (size_t)m * D : F.x_s + (size_t)(m - NTP) * D; }
__device__ __forceinline__ int mod_row(int m) { return m < NTP ? (m >> 11) : NB_P + ((m - NTP) >> 3); }

constexpr int P0_MOD_ITEMS = 96;
constexpr int P0_T_WIN = 16 * 74, P0_T_WOA = 8 * 16, P0_T_WOC = 8 * 16, P0_T_WOUT = 16 * 16, P0_T_WQ = 16 * 16;
constexpr int P0_T_ITEMS = P0_T_WIN + P0_T_WOA + P0_T_WOC + P0_T_WOUT + P0_T_WQ;
constexpr int P0_CVT_ITEMS = 2 * (16384 * 1024 / 8192);
constexpr int P0_MISC_ITEMS = 1;
constexpr int P0_ITEMS = P0_MOD_ITEMS + P0_T_ITEMS + P0_CVT_ITEMS + P0_MISC_ITEMS;

__device__ __forceinline__ void p0_mod_item(const Frame& F, int ng) {
    LAS float* cs = (LAS float*)F.lds;
    LAS float* red = (LAS float*)(F.lds + 40 * 256 * 4);
    float acc[40];
#pragma unroll
    for (int r = 0; r < 40; ++r) acc[r] = 0.f;
    const int n = ng * 64 + F.lane;
    for (int kc = 0; kc < 4; ++kc) {
        __syncthreads();
        for (int e = F.tid; e < 40 * 256; e += NTHREADS) { const int r = e >> 8, k = e & 255; cs[e] = (r < 8) ? F.c_p[r * D + kc * 256 + k] : F.c_s[(r - 8) * D + kc * 256 + k]; }
        __syncthreads();
        for (int kk = 0; kk < 32; ++kk) {
            const int kl = F.wave * 32 + kk;
            const float wv = F.w_ada[(size_t)(kc * 256 + kl) * 6144 + n];
#pragma unroll
            for (int r = 0; r < 40; ++r) acc[r] += cs[r * 256 + kl] * wv;
        }
    }
#pragma unroll
    for (int r = 0; r < 40; ++r) red[(F.wave * 40 + r) * 64 + F.lane] = acc[r];
    __syncthreads();
    for (int e = F.tid; e < 40 * 64; e += NTHREADS) {
        const int r = e >> 6, l = e & 63; float s = F.b_ada[ng * 64 + l];
#pragma unroll
        for (int w = 0; w < 8; ++w) s += red[(w * 40 + r) * 64 + l];
        F.MOD[r * 6144 + ng * 64 + l] = s;
    }
    __syncthreads();
}
__device__ __forceinline__ void p0_transpose_tile(const Frame& F, const float* W, int N, int K, bf16_t* Wt, int kt, int nt, bool permute) {
    LAS bf16_t* tile = (LAS bf16_t*)F.lds;
    __syncthreads();
    { const int k = F.tid >> 3, c0 = (F.tid & 7) * 8;
#pragma unroll
      for (int j = 0; j < 8; ++j) { const int n = nt * 64 + c0 + j; const float v = (n < N) ? W[(size_t)(kt * 64 + k) * N + n] : 0.f; tile[k * 66 + c0 + j] = f2bf(v); } }
    __syncthreads();
    { const int nl = F.tid >> 3, k0 = (F.tid & 7) * 8; const int n = nt * 64 + nl;
      if (n < N) {
          int nd = n; if (permute) nd = (n < 1024) ? n : (n < 1028 ? C_WI + (n - 1024) : n - 4);
          unsigned p[4];
#pragma unroll
          for (int j = 0; j < 4; ++j) p[j] = (unsigned)tile[(k0 + 2 * j) * 66 + nl] | ((unsigned)tile[(k0 + 2 * j + 1) * 66 + nl] << 16);
          *(u32x4*)(Wt + (size_t)nd * K + kt * 64 + k0) = (u32x4){p[0], p[1], p[2], p[3]};
      } }
}
__device__ __forceinline__ void p0_prologue(const Frame& F) {
    for (int it = F.bid; it < P0_ITEMS; it += F.G) {
        int i = it;
        if (i < P0_MOD_ITEMS) { p0_mod_item(F, i); continue; }
        i -= P0_MOD_ITEMS;
        if (i < P0_T_ITEMS) {
            if (i < P0_T_WIN) { p0_transpose_tile(F, F.w_in, NMIX, D, F.WIN, i / 74, i % 74, true); continue; }
            i -= P0_T_WIN;
            if (i < P0_T_WOA) { p0_transpose_tile(F, F.w_o_attn, D, 512, F.WOA, i / 16, i % 16, false); continue; }
            i -= P0_T_WOA;
            if (i < P0_T_WOC) { p0_transpose_tile(F, F.w_o_conv, D, 512, F.WOC, i / 16, i % 16, false); continue; }
            i -= P0_T_WOC;
            if (i < P0_T_WOUT) { p0_transpose_tile(F, F.w_out, D, D, F.WOUT, i / 16, i % 16, false); continue; }
            i -= P0_T_WOUT;
            p0_transpose_tile(F, F.peer_wq, D, D, F.WQ, i / 16, i % 16, false); continue;
        }
        i -= P0_T_ITEMS;
        if (i < P0_CVT_ITEMS) {
            const float* src = (i < 2048) ? F.peer_u : F.peer_v;
            unsigned char* dst = F.ws + ((i < 2048) ? WS_PU8 : WS_PV8); float* sinv = (float*)(F.ws + ((i < 2048) ? WS_SU : WS_SV));
            const int row = (i & 2047) * 8 + F.wave;
            const float* rp = src + (size_t)row * D + F.lane * 16;
            const f32x4 a = *(const f32x4*)rp, b2 = *(const f32x4*)(rp + 4), c = *(const f32x4*)(rp + 8), d = *(const f32x4*)(rp + 12);
            float am = 0.f;
#pragma unroll
            for (int e = 0; e < 4; ++e) am = fmaxf(am, fmaxf(fmaxf(fabsf(a[e]), fabsf(b2[e])), fmaxf(fabsf(c[e]), fabsf(d[e]))));
            am = wave_max(am);
            const float sc = am > 0.f ? 224.f / am : 1.f;
            int w0 = 0, w1 = 0, w2 = 0, w3 = 0;
            w0 = __builtin_amdgcn_cvt_pk_fp8_f32(a[0] * sc, a[1] * sc, w0, false); w0 = __builtin_amdgcn_cvt_pk_fp8_f32(a[2] * sc, a[3] * sc, w0, true);
            w1 = __builtin_amdgcn_cvt_pk_fp8_f32(b2[0] * sc, b2[1] * sc, w1, false); w1 = __builtin_amdgcn_cvt_pk_fp8_f32(b2[2] * sc, b2[3] * sc, w1, true);
            w2 = __builtin_amdgcn_cvt_pk_fp8_f32(c[0] * sc, c[1] * sc, w2, false); w2 = __builtin_amdgcn_cvt_pk_fp8_f32(c[2] * sc, c[3] * sc, w2, true);
            w3 = __builtin_amdgcn_cvt_pk_fp8_f32(d[0] * sc, d[1] * sc, w3, false); w3 = __builtin_amdgcn_cvt_pk_fp8_f32(d[2] * sc, d[3] * sc, w3, true);
            *(u32x4*)(dst + (size_t)row * D + F.lane * 16) = (u32x4){(unsigned)w0, (unsigned)w1, (unsigned)w2, (unsigned)w3};
            if (F.lane == 0) sinv[row] = am > 0.f ? am * (1.f / 224.f) : 1.f;
            continue;
        }
        for (int e = F.tid; e < (4864 - NMIX) * D; e += NTHREADS) F.WIN[(size_t)NMIX * D + e] = 0;
        for (int e = F.tid; e < 128 * 64; e += NTHREADS) { F.K1[e] = f2bf(F.peer_k1[e]); F.K2[e] = f2bf(F.peer_k2[e]); }
    }
}

__device__ __forceinline__ void p1_modulate(const Frame& F) {
    for (int m = F.bid * 8 + F.wave; m < NT; m += F.G * 8) {
        const float* xr = x_row(F, m); const float* mr = F.MOD + (size_t)mod_row(m) * 6144;
#pragma unroll
        for (int hlf = 0; hlf < 2; ++hlf) {
            const int e = hlf * 512 + F.lane * 8;
            const f32x4 x0 = *(const f32x4*)(xr + e), x1 = *(const f32x4*)(xr + e + 4);
            const f32x4 s0 = *(const f32x4*)(mr + 1024 + e), s1 = *(const f32x4*)(mr + 1024 + e + 4);
            const f32x4 h0 = *(const f32x4*)(mr + e), h1 = *(const f32x4*)(mr + e + 4);
            const f32x4 a = x0 * (s0 + 1.f) + h0, b = x1 * (s1 + 1.f) + h1;
            *(u32x4*)(F.H1 + (size_t)m * D + e) = (u32x4){cvt_pk_bf16(a[0], a[1]), cvt_pk_bf16(a[2], a[3]), cvt_pk_bf16(b[0], b[1]), cvt_pk_bf16(b[2], b[3])};
        }
    }
}

constexpr int BM = 256, BN = 128, BK = 64;
constexpr int XPANEL = BM * 32 + 32, WPANEL = BN * 32 + 32;
constexpr int XSTAGE = 4 * XPANEL, WSTAGE = 4 * WPANEL, GSTAGE = XSTAGE + WSTAGE;
__device__ __forceinline__ void gemm_accum(const Frame& F, f32x16 (&acc)[2][2], const bf16_t* __restrict__ X, int ldx, const bf16_t* __restrict__ W, int ldw, int K, int m0, int n0) {
    const int tid = F.tid, lane = F.lane, r = lane & 31, h = lane >> 5, wm = F.wave >> 1, wn = F.wave & 1;
    u32x4 xr[4], wr[2];
    const int nk = K / BK;
    const int crow = tid >> 3, ckc = tid & 7;
    const bf16_t* xg = X + (size_t)(m0 + crow) * ldx + ckc * 8;
    const bf16_t* wg = W + (size_t)(n0 + crow) * ldw + ckc * 8;
    const int ldso = (ckc >> 1) * 1  ;
    const int xoff = ldso * XPANEL + crow * 32 + (ckc & 1) * 16;
    const int woff = ldso * WPANEL + crow * 32 + (ckc & 1) * 16;
#pragma unroll
    for (int i = 0; i < 4; ++i) xr[i] = *(const u32x4*)(xg + (size_t)(64 * i) * ldx);
#pragma unroll
    for (int i = 0; i < 2; ++i) wr[i] = *(const u32x4*)(wg + (size_t)(64 * i) * ldw);
    __syncthreads();
    for (int kt = 0; kt < nk; ++kt) {
        LAS unsigned char* st = F.lds + (kt & 1) * GSTAGE;
#pragma unroll
        for (int i = 0; i < 4; ++i) *(LAS u32x4*)(st + xoff + i * 64 * 32) = xr[i];
#pragma unroll
        for (int i = 0; i < 2; ++i) *(LAS u32x4*)(st + XSTAGE + woff + i * 64 * 32) = wr[i];
        __syncthreads();
        if (kt + 1 < nk) {
#pragma unroll
            for (int i = 0; i < 4; ++i) xr[i] = *(const u32x4*)(xg + (size_t)(64 * i) * ldx + (kt + 1) * BK);
#pragma unroll
            for (int i = 0; i < 2; ++i) wr[i] = *(const u32x4*)(wg + (size_t)(64 * i) * ldw + (kt + 1) * BK);
        }
#pragma unroll
        for (int s = 0; s < 4; ++s) {
            bf16x8 a[2], b[2];
#pragma unroll
            for (int ni = 0; ni < 2; ++ni) a[ni] = *(LAS bf16x8*)(st + XSTAGE + s * WPANEL + (wn * 64 + ni * 32 + r) * 32 + h * 16);
#pragma unroll
            for (int mi = 0; mi < 2; ++mi) b[mi] = *(LAS bf16x8*)(st + s * XPANEL + (wm * 64 + mi * 32 + r) * 32 + h * 16);
#pragma unroll
            for (int mi = 0; mi < 2; ++mi)
#pragma unroll
                for (int ni = 0; ni < 2; ++ni) acc[mi][ni] = __builtin_amdgcn_mfma_f32_32x32x16_bf16(a[ni], b[mi], acc[mi][ni], 0, 0, 0);
        }
    }
}
#define GEMM_EPI_LOOP(...) \
    { const int r_ = F.lane & 31, h_ = F.lane >> 5, wm_ = F.wave >> 1, wn_ = F.wave & 1; \
      _Pragma("unroll") for (int mi = 0; mi < 2; ++mi) _Pragma("unroll") for (int ni = 0; ni < 2; ++ni) _Pragma("unroll") for (int g = 0; g < 4; ++g) { \
          const int m = m0 + wm_ * 64 + mi * 32 + r_; const int n = n0 + wn_ * 64 + ni * 32 + 8 * g + 4 * h_; __VA_ARGS__ } }
#define ACC4(A) ((f32x4){A[mi][ni][4 * g], A[mi][ni][4 * g + 1], A[mi][ni][4 * g + 2], A[mi][ni][4 * g + 3]})
__device__ __forceinline__ void zero_acc(f32x16 (&acc)[2][2]) {
#pragma unroll
    for (int mi = 0; mi < 2; ++mi)
#pragma unroll
        for (int ni = 0; ni < 2; ++ni)
#pragma unroll
            for (int e = 0; e < 16; ++e) acc[mi][ni][e] = 0.f;
}
__device__ __forceinline__ u32x2 pk4(const f32x4 v) { return (u32x2){cvt_pk_bf16(v[0], v[1]), cvt_pk_bf16(v[2], v[3])}; }

__device__ __forceinline__ void gemm_slice8(const Frame& F, f32x16 (&sacc)[1][1], const bf16_t* __restrict__ X, int ldx, const bf16_t* __restrict__ W, int ldw, int K, int m0, int n0) {
    const int r = F.lane & 31, h = F.lane >> 5, wq = F.wave & 3, kh = F.wave >> 2;
    const bf16_t* wp = W + (size_t)(n0 + 32 * wq + r) * ldw + kh * (K / 2) + h * 8;
    const bf16_t* xp = X + (size_t)(m0 + (r & 7)) * ldx + kh * (K / 2) + h * 8;
    f32x16 c;
#pragma unroll
    for (int e = 0; e < 16; ++e) c[e] = 0.f;
#pragma unroll 1
    for (int k0 = 0; k0 < K / 2; k0 += 128) {
        bf16x8 a[8], b[8];
#pragma unroll
        for (int t = 0; t < 8; ++t) { a[t] = *(const bf16x8*)(wp + k0 + t * 16); b[t] = *(const bf16x8*)(xp + k0 + t * 16); }
#pragma unroll
        for (int t = 0; t < 8; ++t) c = __builtin_amdgcn_mfma_f32_32x32x16_bf16(a[t], b[t], c, 0, 0, 0);
    }
    LAS float* cb = (LAS float*)F.lds + wq * (16 * 64);
    __syncthreads();
    if (kh == 1) {
#pragma unroll
        for (int e = 0; e < 16; ++e) cb[e * 64 + F.lane] = c[e];
    }
    __syncthreads();
    if (kh == 0) {
#pragma unroll
        for (int e = 0; e < 16; ++e) c[e] += cb[e * 64 + F.lane];
    }
    sacc[0][0] = c;
}
#define SLICE_EPI_LOOP(...) \
    if (F.wave < 4 && (F.lane & 31) < 8) { const int h_ = F.lane >> 5, wq_ = F.wave & 3; constexpr int mi = 0, ni = 0; \
      _Pragma("unroll") for (int g = 0; g < 4; ++g) { const int m = m0 + (F.lane & 31); const int n = n0 + wq_ * 32 + 8 * g + 4 * h_; __VA_ARGS__ } }

namespace pg8 {
#define PG8_LAS __attribute__((address_space(3)))
typedef unsigned short bf16_t;
typedef short bf16x8 __attribute__((ext_vector_type(8)));
typedef float f32x4 __attribute__((ext_vector_type(4)));
typedef unsigned u32x4 __attribute__((ext_vector_type(4)));
constexpr int BM = 256, BK = 64, HALF = 128, HTB = HALF * BK * 2  , STAGE_BYTES = 8 * HTB, NXCD = 8, WGM = 8;

__host__ __device__ __forceinline__ int lds_byte(int r, int c) { const int st = (r >> 4) * 2 + (c >> 5), rr = r & 15, cc = c & 31, ob = rr * 64 + cc * 2; return st * 1024 + (ob ^ (((ob >> 9) & 1) << 5)); }
__host__ __device__ __forceinline__ void stage_rc(int b, int& R, int& C) { const int st = b / 1024, sb = b % 1024, swz = sb ^ (((sb >> 9) & 1) << 5); R = (st >> 1) * 16 + swz / 64; C = (st & 1) * 32 + (swz % 64) / 2; }
__host__ __device__ __forceinline__ int perm32(int rho) { const int n = rho >> 4, i = rho & 15; return 8 * (i >> 2) + 4 * n + (i & 3); }

struct Unit { int pm, pn; };
struct Gemm { const bf16_t* A; const bf16_t* Bt; int M, N, K; };

struct StaticOrder {
    int nM, nN, nwg, G, c;
    __host__ __device__ void init(int M, int N, int G_, int c_) { nM = M / BM; nN = N / BM; nwg = nM * nN; G = G_; c = c_; }
    __host__ __device__ bool next(int i, Unit& u) const {
        const long L = (long)i * G + c; if (L >= nwg) return false;
        int wgid = (int)L; { const int q = nwg / NXCD, r = nwg % NXCD, xcd = wgid % NXCD, off = wgid / NXCD; wgid = (xcd < r ? xcd * (q + 1) : r * (q + 1) + (xcd - r) * q) + off; }
        const int nig = WGM * nN, gid = wgid / nig, fm = gid * WGM, gsz = (nM - fm) < WGM ? (nM - fm) : WGM;
        u.pm = fm + ((wgid % nig) % gsz); u.pn = (wgid % nig) / gsz; return true;
    }
    __device__ __forceinline__ void a_ready(const Unit&) const {}
    __device__ __forceinline__ void done(const Unit&) const {}
};

template <class Body> struct EpiRC {
    static constexpr bool PERM = false, AFTER_DRAIN = false;
    Body body;
    __device__ __forceinline__ void operator()(const f32x4 (&acc)[2][2][4][2], const Unit& u, int wr, int wc, int fr, int fq) const {
#pragma unroll
        for (int ai = 0; ai < 2; ++ai)
#pragma unroll
            for (int m = 0; m < 4; ++m) {
                const int row = u.pm * BM + ai * HALF + wr * 64 + m * 16 + fr;
#pragma unroll
                for (int bj = 0; bj < 2; ++bj)
#pragma unroll
                    for (int n = 0; n < 2; ++n) body(row, u.pn * BM + bj * HALF + wc * 32 + n * 16 + 4 * fq, acc[ai][bj][m][n]);
            }
    }
};
template <class Epi, class Sched, bool ALIGN_EPI = false, bool SP2 = false>
__device__ __forceinline__ void gemm_phase(PG8_LAS unsigned char* lds, const Gemm g, const Sched& S, const Epi& E) {
    const int tid = threadIdx.x, wid = __builtin_amdgcn_readfirstlane(tid >> 6), lane = tid & 63, wr = wid >> 2, wc = wid & 3, fr = lane & 15, fq = lane >> 4;
    const int K = g.K, nt = K / BK;
    unsigned voffA[2], voffB[2];
#pragma unroll
    for (int i = 0; i < 2; ++i) { int R, C; stage_rc(tid * 16 + i * 8192, R, C); const int Rb = Epi::PERM ? ((R & ~31) + perm32(R & 31)) : R;
        voffA[i] = (unsigned)(R * K + C) * 2u; voffB[i] = (unsigned)(Rb * K + C) * 2u; }
    const size_t kstep = (size_t)(BK * 2);
    const size_t hstep = (size_t)HALF * K * 2;
    const size_t tstep = 2 * hstep;
    const unsigned ldsw = (unsigned)wid * 1024u;
    const int aoff = lds_byte(wr * 64 + fr, fq * 8), boff = lds_byte(wc * 32 + fr, fq * 8);
#define PG8_SA(b, h) (((b) * 2 + (h)) * HTB)
#define PG8_SB(b, h) ((4 + (b) * 2 + (h)) * HTB)
#define PG8_STAGE(bufoff, gbase, voff) do { _Pragma("unroll") for (int _i = 0; _i < 2; ++_i) \
        __builtin_amdgcn_global_load_lds((const unsigned*)((const char*)(gbase) + (voff)[_i]), (PG8_LAS unsigned*)(lds + (bufoff) + ldsw + _i * 8192), 16, 0, 0); } while (0)
#define PG8_LDA(dst, b, h) do { _Pragma("unroll") for (int m = 0; m < 4; ++m) _Pragma("unroll") for (int k = 0; k < 2; ++k) dst[m][k] = *(const PG8_LAS bf16x8*)(lds + PG8_SA(b, h) + aoff + m * 2048 + k * 1024); } while (0)
#define PG8_LDB(dst, b, h) do { _Pragma("unroll") for (int n = 0; n < 2; ++n) _Pragma("unroll") for (int k = 0; k < 2; ++k) dst[n][k] = *(const PG8_LAS bf16x8*)(lds + PG8_SB(b, h) + boff + n * 2048 + k * 1024); } while (0)
#define PG8_MMA(ai, bj, At, Bt) do { __builtin_amdgcn_s_setprio(1); _Pragma("unroll") for (int m = 0; m < 4; ++m) _Pragma("unroll") for (int n = 0; n < 2; ++n) _Pragma("unroll") for (int k = 0; k < 2; ++k) \
        acc[ai][bj][m][n] = __builtin_amdgcn_mfma_f32_16x16x32_bf16(Bt[n][k], At[m][k], acc[ai][bj][m][n], 0, 0, 0); __builtin_amdgcn_s_setprio(0); } while (0)
#define PG8_WAIT_V(n) asm volatile("s_waitcnt vmcnt(" #n ")" ::: "memory")
#define PG8_WAIT_L(n) asm volatile("s_waitcnt lgkmcnt(" #n ")" ::: "memory")
#define PG8_BAR __builtin_amdgcn_s_barrier()
#define PG8_SCHED __builtin_amdgcn_sched_barrier(0)
    Unit cur, nxt; int ui = 0;
    if (!S.next(0, cur)) return;
    f32x4 acc[2][2][4][2];
#pragma unroll
    for (int a = 0; a < 2; ++a)
#pragma unroll
        for (int b = 0; b < 2; ++b)
#pragma unroll
            for (int m = 0; m < 4; ++m)
#pragma unroll
                for (int n = 0; n < 2; ++n) acc[a][b][m][n] = (f32x4){0.f, 0.f, 0.f, 0.f};
    bf16x8 At[4][2], B0[2][2], B1[2][2];
    const char* cA = (const char*)g.A + (size_t)cur.pm * tstep; const char* cB = (const char*)g.Bt + (size_t)cur.pn * tstep;
    S.a_ready(cur);
    if constexpr (SP2) {
        PG8_STAGE(PG8_SB(0, 0), cB, voffB); PG8_STAGE(PG8_SB(0, 1), cB + hstep, voffB); PG8_STAGE(PG8_SA(0, 0), cA, voffA); PG8_STAGE(PG8_SA(0, 1), cA + hstep, voffA);
        if (wr == 1) PG8_BAR;
        PG8_WAIT_V(2); PG8_BAR;
        PG8_STAGE(PG8_SB(1, 0), cB + kstep, voffB); PG8_STAGE(PG8_SA(1, 0), cA + kstep, voffA); PG8_STAGE(PG8_SB(1, 1), cB + hstep + kstep, voffB);
        PG8_WAIT_V(6); PG8_BAR;
    } else {
        PG8_STAGE(PG8_SB(0, 0), cB, voffB); PG8_STAGE(PG8_SA(0, 0), cA, voffA); PG8_STAGE(PG8_SB(0, 1), cB + hstep, voffB); PG8_STAGE(PG8_SA(0, 1), cA + hstep, voffA);
        if (wr == 1) PG8_BAR;
        PG8_WAIT_V(4); PG8_BAR;
        PG8_STAGE(PG8_SB(1, 0), cB + kstep, voffB); PG8_STAGE(PG8_SA(1, 0), cA + kstep, voffA); PG8_STAGE(PG8_SB(1, 1), cB + hstep + kstep, voffB);
        PG8_WAIT_V(6); PG8_BAR;
    }
    for (;;) {
        const bool has_next = S.next(ui + 1, nxt);
        const char* nA = has_next ? (const char*)g.A + (size_t)nxt.pm * tstep : cA; const char* nB = has_next ? (const char*)g.Bt + (size_t)nxt.pn * tstep : cB;
        for (int t = 0; t < nt; t += 2) {
            const bool last = (t == nt - 2);
            const char* a1 = cA + (size_t)(t + 1) * kstep;
            const char* a2 = last ? nA : cA + (size_t)(t + 2) * kstep; const char* b2 = last ? nB : cB + (size_t)(t + 2) * kstep;
            const char* a3 = a2 + kstep; const char* b3 = b2 + kstep;
            if (last && has_next) S.a_ready(nxt);
            if constexpr (SP2) {
            PG8_LDB(B0, 0, 0); PG8_LDB(B1, 0, 1); PG8_SCHED; PG8_LDA(At, 0, 0); PG8_STAGE(PG8_SA(1, 1), a1 + hstep, voffA);
            PG8_WAIT_V(8); PG8_WAIT_L(0); PG8_BAR; PG8_MMA(0, 0, At, B0); PG8_MMA(0, 1, At, B1); PG8_BAR; PG8_SCHED;
            PG8_LDA(At, 0, 1); PG8_STAGE(PG8_SB(0, 0), b2, voffB); PG8_STAGE(PG8_SB(0, 1), b2 + hstep, voffB); PG8_STAGE(PG8_SA(0, 0), a2, voffA);
            PG8_WAIT_V(8); PG8_WAIT_L(0); PG8_BAR; PG8_MMA(1, 0, At, B0); PG8_MMA(1, 1, At, B1); PG8_BAR; PG8_SCHED;
            PG8_LDB(B0, 1, 0); PG8_LDB(B1, 1, 1); PG8_SCHED; PG8_LDA(At, 1, 0); PG8_STAGE(PG8_SA(0, 1), a2 + hstep, voffA);
            PG8_WAIT_V(8); PG8_WAIT_L(0); PG8_BAR; PG8_MMA(0, 0, At, B0); PG8_MMA(0, 1, At, B1); PG8_BAR; PG8_SCHED;
            PG8_LDA(At, 1, 1); PG8_STAGE(PG8_SB(1, 0), b3, voffB); PG8_STAGE(PG8_SB(1, 1), b3 + hstep, voffB); PG8_STAGE(PG8_SA(1, 0), a3, voffA);
            PG8_WAIT_V(8); PG8_WAIT_L(0); PG8_BAR; PG8_MMA(1, 0, At, B0); PG8_MMA(1, 1, At, B1); PG8_BAR; PG8_SCHED;
            } else {
            PG8_LDB(B0, 0, 0); PG8_SCHED; PG8_LDA(At, 0, 0); PG8_STAGE(PG8_SA(1, 1), a1 + hstep, voffA);
            PG8_WAIT_L(8); PG8_BAR; PG8_WAIT_L(0); PG8_MMA(0, 0, At, B0); PG8_BAR; PG8_SCHED;
            PG8_LDB(B1, 0, 1); PG8_STAGE(PG8_SB(0, 0), b2, voffB);
            PG8_BAR; PG8_WAIT_L(0); PG8_MMA(0, 1, At, B1); PG8_BAR;
            PG8_LDA(At, 0, 1); PG8_STAGE(PG8_SA(0, 0), a2, voffA);
            PG8_BAR; PG8_WAIT_L(0); PG8_MMA(1, 0, At, B0); PG8_BAR; PG8_SCHED;
            PG8_STAGE(PG8_SB(0, 1), b2 + hstep, voffB);
            PG8_WAIT_V(6); PG8_BAR; PG8_MMA(1, 1, At, B1); PG8_BAR;
            PG8_LDB(B0, 1, 0); PG8_SCHED; PG8_LDA(At, 1, 0); PG8_STAGE(PG8_SA(0, 1), a2 + hstep, voffA);
            PG8_WAIT_L(8); PG8_BAR; PG8_WAIT_L(0); PG8_MMA(0, 0, At, B0); PG8_BAR; PG8_SCHED;
            PG8_LDB(B1, 1, 1); PG8_STAGE(PG8_SB(1, 0), b3, voffB);
            PG8_BAR; PG8_WAIT_L(0); PG8_MMA(0, 1, At, B1); PG8_BAR;
            PG8_LDA(At, 1, 1); PG8_STAGE(PG8_SA(1, 0), a3, voffA);
            PG8_BAR; PG8_WAIT_L(0); PG8_MMA(1, 0, At, B0); PG8_BAR; PG8_SCHED;
            PG8_STAGE(PG8_SB(1, 1), b3 + hstep, voffB);
            PG8_WAIT_V(6); PG8_BAR; PG8_MMA(1, 1, At, B1); PG8_BAR;
            }
        }
        if constexpr (ALIGN_EPI) { if (wr == 0) PG8_BAR; }
        if constexpr (!Epi::AFTER_DRAIN) { E(acc, cur, wr, wc, fr, fq); S.done(cur); }
        if (!has_next) break;
#pragma unroll
        for (int a = 0; a < 2; ++a)
#pragma unroll
            for (int b = 0; b < 2; ++b)
#pragma unroll
                for (int m = 0; m < 4; ++m)
#pragma unroll
                    for (int n = 0; n < 2; ++n) acc[a][b][m][n] = (f32x4){0.f, 0.f, 0.f, 0.f};
        cur = nxt; cA = nA; cB = nB; ++ui;
        if constexpr (ALIGN_EPI) { if (wr == 1) PG8_BAR; }
    }
    PG8_WAIT_V(0);
    if constexpr (!ALIGN_EPI) { if (wr == 0) PG8_BAR; }
    PG8_BAR;
    if constexpr (Epi::AFTER_DRAIN) { E.fused(acc, cur, wr, wc, fr, fq, lds, wid, lane); S.done(cur); }
#undef PG8_SA
#undef PG8_SB
#undef PG8_STAGE
#undef PG8_LDA
#undef PG8_LDB
#undef PG8_MMA
#undef PG8_WAIT_V
#undef PG8_WAIT_L
#undef PG8_BAR
#undef PG8_SCHED
}
}

constexpr int NMIXW = 4864;
struct P2Body {
    const Frame* Fp;
    __device__ __forceinline__ void operator()(int m, int n, const f32x4 v) const {
        const Frame& F = *Fp;
        if (n >= NMIXP) return;
        *(u32x2*)(F.PROJ + (size_t)m * NMIXP + n) = pk4(v);
        if (n >= C_K && n < C_QI) {
            float* o = (n < C_V) ? (m < NTP ? F.out + O_KP + (size_t)m * 128 + (n - C_K) : F.out + O_KS + (size_t)(m - NTP) * 128 + (n - C_K))
                                 : (m < NTP ? F.out + O_VP + (size_t)m * 128 + (n - C_V) : F.out + O_VS + (size_t)(m - NTP) * 128 + (n - C_V));
            *(f32x4*)o = v;
            if (n >= C_V && m < NTP) {
                bf16_t* vt = (bf16_t*)(F.ws + WS_VT) + ((size_t)((m >> 11) * 2 + ((n - C_V) >> 6)) * 64 + ((n - C_V) & 63)) * SEQ + (m & 2047);
                vt[0] = f2bf(v[0]); vt[SEQ] = f2bf(v[1]); vt[2 * SEQ] = f2bf(v[2]); vt[3 * SEQ] = f2bf(v[3]);
            }
        } else if (n >= C_KI && n < C_BG) {
            float* o = m < NTP ? F.out + O_KIP + (size_t)m * 64 + (n - C_KI) : F.out + O_KIS + (size_t)(m - NTP) * 64 + (n - C_KI);
            *(f32x4*)o = v;
        } else if (n == C_WI) {
            *(f32x4*)(F.WI + (size_t)m * 4) = v;
        } else if (n >= C_CG && n < C_GA) {
            const int tt = (m < NTP) ? (m & 2047) - (SEQ - 2) : ((m - NTP) & 7) - (TS - 2);
            if (tt >= 0) {
                const int rowi = (m < NTP) ? (m >> 11) * 2 + tt : 2 * NB_P + ((m - NTP) >> 3) * 2 + tt;
                *(f32x4*)((float*)(F.ws + WS_CGX) + (size_t)rowi * 1024 + (n - C_CG)) = v;
            }
        }
    }
};
__device__ __forceinline__ void p2_gemm_in(const Frame& F) {
    pg8::Gemm g{F.H1, F.WIN, NT, NMIXW, D};
    pg8::StaticOrder S; S.init(NT, NMIXW, F.G, F.bid);
    pg8::EpiRC<P2Body> E{P2Body{&F}};
    pg8::gemm_phase<pg8::EpiRC<P2Body>, pg8::StaticOrder, true, true>(F.lds, g, S, E);
}

constexpr int SROW = 2052;
__device__ __forceinline__ int wave_sum_i(int v) {
#pragma unroll
    for (int o = 32; o >= 1; o >>= 1) v += __shfl_xor(v, o);
    return v;
}
__device__ __forceinline__ void cnt_ge(int& c, unsigned u, unsigned t) { asm("v_cmp_ge_u32_e32 vcc, %1, %2\n\tv_addc_co_u32_e32 %0, vcc, 0, %0, vcc" : "+v"(c) : "v"(u), "v"(t) : "vcc"); }
__device__ __forceinline__ void cnt_gt(int& c, unsigned u, unsigned t) { asm("v_cmp_gt_u32_e32 vcc, %1, %2\n\tv_addc_co_u32_e32 %0, vcc, 0, %0, vcc" : "+v"(c) : "v"(u), "v"(t) : "vcc"); }
__device__ __forceinline__ void cnt_eq(int& c, unsigned u, unsigned t) { asm("v_cmp_eq_u32_e32 vcc, %1, %2\n\tv_addc_co_u32_e32 %0, vcc, 0, %0, vcc" : "+v"(c) : "v"(u), "v"(t) : "vcc"); }
__device__ __forceinline__ void cnt_lt4(int& cl, unsigned u0, unsigned u1, unsigned u2, unsigned u3, unsigned t) {
    int d0, d1, d2, d3;
    asm("v_sub_u32 %1, %5, %9\n\tv_sub_u32 %2, %6, %9\n\tv_sub_u32 %3, %7, %9\n\tv_sub_u32 %4, %8, %9\n\t"
        "v_lshrrev_b32 %1, 31, %1\n\tv_lshrrev_b32 %2, 31, %2\n\tv_lshrrev_b32 %3, 31, %3\n\tv_lshrrev_b32 %4, 31, %4\n\t"
        "v_add3_u32 %0, %0, %1, %2\n\tv_add3_u32 %0, %0, %3, %4"
        : "+v"(cl), "=&v"(d0), "=&v"(d1), "=&v"(d2), "=&v"(d3) : "v"(u0), "v"(u1), "v"(u2), "v"(u3), "v"(t));
}
__device__ __forceinline__ void cnt_eq_pos(int& c, unsigned u, unsigned t, int L) {
    int tmp;
    asm("v_cmp_eq_u32_e32 vcc, %2, %3\n\tv_cndmask_b32_e32 %1, %5, %4, vcc\n\tv_cmp_lt_i32_e32 vcc, 0, %1\n\tv_addc_co_u32_e32 %0, vcc, 0, %0, vcc"
        : "+v"(c), "=&v"(tmp) : "v"(u), "v"(t), "v"(L), "v"(0x80000000) : "vcc");
}
__device__ __forceinline__ int wave_sum_i_dpp(int v) {
    v += __builtin_amdgcn_update_dpp(0, v, 0xB1, 0xF, 0xF, false);
    v += __builtin_amdgcn_update_dpp(0, v, 0x4E, 0xF, 0xF, false);
    v += __builtin_amdgcn_update_dpp(0, v, 0x141, 0xF, 0xF, false);
    v += __builtin_amdgcn_update_dpp(0, v, 0x140, 0xF, 0xF, false);
    v += __builtin_amdgcn_update_dpp(0, v, 0x142, 0xA, 0xF, false);
    v += __builtin_amdgcn_update_dpp(0, v, 0x143, 0xC, 0xF, false);
    return __builtin_amdgcn_readlane(v, 63);
}
template <int NV> __device__ __forceinline__ void select_threshold(const unsigned (&u)[NV], int ksel, int idx_bits, int lane, unsigned& T_out, int& Jx_out, int& ngt_out) {
    unsigned T = 0;
#pragma unroll 1
    for (int bit = 31; bit >= 0; --bit) {
        const unsigned cand = T | (1u << bit);
        int c = 0;
#pragma unroll
        for (int i = 0; i < NV; ++i) cnt_ge(c, u[i], cand);
        c = wave_sum_i_dpp(c);
        if (c >= ksel) T = cand;
    }
    int cg = 0, ce = 0;
#pragma unroll
    for (int i = 0; i < NV; ++i) { cnt_gt(cg, u[i], T); cnt_eq(ce, u[i], T); }
    const int ngt = wave_sum_i_dpp(cg), neq = wave_sum_i_dpp(ce);
    const int need = ksel - ngt;
    int Jx = 0x3FFFFFFF;
    if (need < neq) {
        int Jb = 0;
#pragma unroll 1
        for (int bit = idx_bits - 1; bit >= 0; --bit) {
            const int cand = Jb | (1 << bit);
            const int L = cand - lane;
            int c = 0;
#pragma unroll
            for (int i = 0; i < NV; ++i) cnt_eq_pos(c, u[i], T, L - 64 * i);
            c = wave_sum_i_dpp(c);
            if (c < need) Jb = cand;
        }
        Jx = Jb + 1;
    }
    T_out = T; Jx_out = Jx; ngt_out = ngt;
}
template <int NV> __device__ __forceinline__ void select_threshold2(const unsigned (&ua)[NV], const unsigned (&ub)[NV], int ksel, int idx_bits, int lane, int ng,
                                                                   unsigned& Ta_out, int& Jxa_out, unsigned& Tb_out, int& Jxb_out) {
    unsigned Ta = 0, Tb = 0;
    bool da = false, db = false;
#pragma unroll 1
    for (int bit = 30; bit >= 0 && !(da && db); --bit) {
        const unsigned ca = da ? Ta : (Ta | (1u << bit)), cb = db ? Tb : (Tb | (1u << bit));
        int la = 0, lb = 0;
#pragma unroll
        for (int i = 0; i < NV; i += 4) { if (i < 4 * ng) { cnt_lt4(la, ua[i], ua[i + 1], ua[i + 2], ua[i + 3], ca); cnt_lt4(lb, ub[i], ub[i + 1], ub[i + 2], ub[i + 3], cb); } }
        const int na = ng * 256 - wave_sum_i_dpp(la), nb = ng * 256 - wave_sum_i_dpp(lb);
        if (!da && na >= ksel) { Ta = ca; da = (na == ksel); }
        if (!db && nb >= ksel) { Tb = cb; db = (nb == ksel); }
    }
    int ga = 0, ea = 0, gb = 0, eb = 0;
#pragma unroll
    for (int i = 0; i < NV; ++i) { cnt_gt(ga, ua[i], Ta); cnt_eq(ea, ua[i], Ta); cnt_gt(gb, ub[i], Tb); cnt_eq(eb, ub[i], Tb); }
    const int needa = ksel - wave_sum_i_dpp(ga), neqa = wave_sum_i_dpp(ea), needb = ksel - wave_sum_i_dpp(gb), neqb = wave_sum_i_dpp(eb);
    int Jxa = 0x3FFFFFFF, Jxb = 0x3FFFFFFF;
    if (needa < neqa) {
        int Jb = 0;
#pragma unroll 1
        for (int bit = idx_bits - 1; bit >= 0; --bit) {
            const int cand = Jb | (1 << bit); const int L = cand - lane; int c = 0;
#pragma unroll
            for (int i = 0; i < NV; ++i) cnt_eq_pos(c, ua[i], Ta, L - 64 * i);
            if (wave_sum_i_dpp(c) < needa) Jb = cand;
        }
        Jxa = Jb + 1;
    }
    if (needb < neqb) {
        int Jb = 0;
#pragma unroll 1
        for (int bit = idx_bits - 1; bit >= 0; --bit) {
            const int cand = Jb | (1 << bit); const int L = cand - lane; int c = 0;
#pragma unroll
            for (int i = 0; i < NV; ++i) cnt_eq_pos(c, ub[i], Tb, L - 64 * i);
            if (wave_sum_i_dpp(c) < needb) Jb = cand;
        }
        Jxb = Jb + 1;
    }
    Ta_out = Ta; Jxa_out = Jxa; Tb_out = Tb; Jxb_out = Jxb;
}
template <int NV> __device__ __forceinline__ void select_topk(const unsigned (&u)[NV], int ksel, int idx_bits, int* sel, int lane) {
    unsigned T; int Jx, ngt;
    select_threshold<NV>(u, ksel, idx_bits, lane, T, Jx, ngt);
    const int L = Jx - lane;
    int cg = 0, ct = 0;
#pragma unroll
    for (int i = 0; i < NV; ++i) { cnt_gt(cg, u[i], T); cnt_eq_pos(ct, u[i], T, L - 64 * i); }
    int ig = cg, it = ct;
#pragma unroll
    for (int o = 1; o < 64; o <<= 1) { const int a = __shfl_up(ig, o), b2 = __shfl_up(it, o); if (lane >= o) { ig += a; it += b2; } }
    int pg = ig - cg, pt = ngt + it - ct;
    int ev = lane, Lr = L;
#pragma unroll
    for (int i = 0; i < NV; ++i) {
        if (u[i] > T) { sel[pg] = ev; ++pg; }
        else if (u[i] == T && Lr > 0) { sel[pt] = ev; ++pt; }
        asm volatile("v_add_u32 %0, 64, %0\n\tv_add_u32 %1, -64, %1" : "+v"(ev), "+v"(Lr));
    }
}

constexpr int PU_MB = 16 * SROW * 4;
constexpr int PU_RB = PU_MB + 16 * 64 * 4;
constexpr int PU_BT = PU_RB + 1024;
constexpr int PU_QT = PU_BT + 512, PU_QROW = 1040;
__device__ __forceinline__ int kappa32(int r) { return (r & 0x13) | ((r & 4) << 1) | ((r & 8) >> 1); }
__device__ __forceinline__ void p3_prompt_fused_unit(const Frame& F, const bf16_t* VT, int b, int qt) {
    LAS float* S = (LAS float*)F.lds;
    LAS unsigned* MB = (LAS unsigned*)(F.lds + PU_MB);
    LAS float* RB = (LAS float*)(F.lds + PU_RB);
    LAS int* BT = (LAS int*)(F.lds + PU_BT);
    const int lane = F.lane;
    const int q0 = qt * 16; const size_t tok0 = (size_t)b * SEQ;
    __syncthreads();
    for (int ch = F.tid; ch < 16 * 64; ch += NTHREADS) {
        const u32x4 qv = *(const u32x4*)(F.PROJ + (tok0 + q0 + (ch >> 6)) * NMIXP + C_Q + (ch & 63) * 8);
        constexpr float QS = ATTN_SCALE * 1.4426950408889634f;
        *(LAS u32x4*)(F.lds + PU_QT + (ch >> 6) * PU_QROW + (ch & 63) * 16) = (u32x4){cvt_pk_bf16(bflo(qv[0]) * QS, bfhi(qv[0]) * QS), cvt_pk_bf16(bflo(qv[1]) * QS, bfhi(qv[1]) * QS),
                                                                                    cvt_pk_bf16(bflo(qv[2]) * QS, bfhi(qv[2]) * QS), cvt_pk_bf16(bflo(qv[3]) * QS, bfhi(qv[3]) * QS)};
    }
    {
        const int r = lane & 15, q4 = lane >> 4;
        bf16x8 A[4][2];
#pragma unroll
        for (int hh = 0; hh < 4; ++hh)
#pragma unroll
            for (int s2 = 0; s2 < 2; ++s2) A[hh][s2] = *(const bf16x8*)(F.PROJ + (tok0 + q0 + r) * NMIXP + C_QI + hh * 64 + s2 * 32 + q4 * 8);
        float wv[4][4];
#pragma unroll
        for (int g = 0; g < 4; ++g) { const f32x4 w4 = *(const f32x4*)(F.WI + (tok0 + q0 + 4 * q4 + g) * 4);
#pragma unroll
            for (int hh = 0; hh < 4; ++hh) wv[g][hh] = w4[hh] * IDX_SCALE; }
        const int nkt = qt + 1;
        bf16x8 Bn[2][2];
        {
            const int t0 = 2 * F.wave;
#pragma unroll
            for (int p = 0; p < 2; ++p)
#pragma unroll
                for (int s2 = 0; s2 < 2; ++s2) { const int key = (t0 + p < nkt ? t0 + p : 0) * 16 + r; Bn[p][s2] = *(const bf16x8*)(F.PROJ + (tok0 + key) * NMIXP + C_KI + s2 * 32 + q4 * 8); }
        }
#pragma unroll 1
        for (int t0 = 2 * F.wave; t0 < nkt; t0 += 16) {
            bf16x8 B[2][2] = {{Bn[0][0], Bn[0][1]}, {Bn[1][0], Bn[1][1]}};
            {
                const int tn = t0 + 16;
#pragma unroll
                for (int p = 0; p < 2; ++p)
#pragma unroll
                    for (int s2 = 0; s2 < 2; ++s2) { const int key = (tn + p < nkt ? tn + p : 0) * 16 + r; Bn[p][s2] = *(const bf16x8*)(F.PROJ + (tok0 + key) * NMIXP + C_KI + s2 * 32 + q4 * 8); }
            }
#pragma unroll
            for (int p = 0; p < 2; ++p) {
                if (t0 + p >= nkt) continue;
                float sc[4] = {0.f, 0.f, 0.f, 0.f};
#pragma unroll
                for (int hh = 0; hh < 4; ++hh) {
                    f32x4 c = {0.f, 0.f, 0.f, 0.f};
                    c = __builtin_amdgcn_mfma_f32_16x16x32_bf16(A[hh][0], B[p][0], c, 0, 0, 0);
                    c = __builtin_amdgcn_mfma_f32_16x16x32_bf16(A[hh][1], B[p][1], c, 0, 0, 0);
#pragma unroll
                    for (int g = 0; g < 4; ++g) sc[g] += fmaxf(c[g], 0.f) * wv[g][hh];
                }
#pragma unroll
                for (int g = 0; g < 4; ++g) S[(4 * q4 + g) * SROW + (t0 + p) * 16 + r] = sc[g];
            }
        }
    }
    __syncthreads();
    {
        const int rowa = F.wave * 2, rowb = rowa + 1;
        const int nva = q0 + rowa + 1, nvb = nva + 1;
        if (nvb <= NSEL) {
#pragma unroll
            for (int i = 0; i < 32; ++i) {
                const unsigned long long ma = __ballot(lane + 64 * i < nva), mb = __ballot(lane + 64 * i < nvb);
                if (lane == 0) { MB[rowa * 64 + 2 * i] = (unsigned)ma; MB[rowa * 64 + 2 * i + 1] = (unsigned)(ma >> 32); MB[rowb * 64 + 2 * i] = (unsigned)mb; MB[rowb * 64 + 2 * i + 1] = (unsigned)(mb >> 32); }
            }
        } else {
            unsigned ua[32], ub[32];
#pragma unroll
            for (int i = 0; i < 32; ++i) { const int j = lane + 64 * i; ua[i] = (j < nva) ? (f2ord(S[rowa * SROW + j]) >> 1) : 0u; ub[i] = (j < nvb) ? (f2ord(S[rowb * SROW + j]) >> 1) : 0u; }
            unsigned Ta, Tb; int Jxa, Jxb;
            select_threshold2<32>(ua, ub, NSEL, 11, lane, (nvb + 255) >> 8, Ta, Jxa, Tb, Jxb);
            const int La = Jxa - lane, Lb = Jxb - lane;
#pragma unroll
            for (int i = 0; i < 32; ++i) {
                const bool ta = (ua[i] > Ta) || (ua[i] == Ta && (La - 64 * i) > 0), tb = (ub[i] > Tb) || (ub[i] == Tb && (Lb - 64 * i) > 0);
                const unsigned long long ma = __ballot(ta), mb = __ballot(tb);
                if (lane == 0) { MB[rowa * 64 + 2 * i] = (unsigned)ma; MB[rowa * 64 + 2 * i + 1] = (unsigned)(ma >> 32); MB[rowb * 64 + 2 * i] = (unsigned)mb; MB[rowb * 64 + 2 * i + 1] = (unsigned)(mb >> 32); }
            }
        }
    }
    __syncthreads();
    {
        const int g = F.wave & 1, kq = F.wave >> 1;
        const int c = lane & 31, h = lane >> 5;
        const int hd = g * 4 + (c & 3);
        LAS const unsigned char* Qb = F.lds + PU_QT + (c >> 2) * PU_QROW + (hd * 64 + h * 8) * 2;
        constexpr float L2E = 1.4426950408889634f;
        const float b31 = RB[31 * 8 + hd] * L2E;
        const int ntile = ((q0 + 15) >> 5) + 1;
        const bf16_t* Kb = F.PROJ + (tok0 + kappa32(c)) * NMIXP + C_K + g * 64 + h * 8;
        const bf16_t* Vb = VT + ((size_t)((b * 2 + g) * 64 + c)) * SEQ + h * 8;
        f32x16 O[2][2];
#pragma unroll
        for (int rt = 0; rt < 2; ++rt)
#pragma unroll
            for (int d = 0; d < 2; ++d)
#pragma unroll
                for (int e = 0; e < 16; ++e) O[rt][d][e] = 0.f;
        float lsum[2] = {0.f, 0.f};
        bf16x8 Kn[4];
        {
            const int key0 = (kq < ntile ? kq : 0) * 32;
#pragma unroll
            for (int s4 = 0; s4 < 4; ++s4) Kn[s4] = *(const bf16x8*)(Kb + (size_t)key0 * NMIXP + s4 * 16);
        }
#pragma unroll 1
        for (int kt = kq; kt < ntile; kt += 4) {
            const int key0 = kt * 32;
            bf16x8 Kf[4] = {Kn[0], Kn[1], Kn[2], Kn[3]}, Vf[2][2];
#pragma unroll
            for (int d = 0; d < 2; ++d)
#pragma unroll
                for (int s2 = 0; s2 < 2; ++s2) Vf[d][s2] = *(const bf16x8*)(Vb + (size_t)(32 * d) * SEQ + key0 + 16 * s2);
            {
                const int keyn = (kt + 4 < ntile ? kt + 4 : 0) * 32;
#pragma unroll
                for (int s4 = 0; s4 < 4; ++s4) Kn[s4] = *(const bf16x8*)(Kb + (size_t)keyn * NMIXP + s4 * 16);
            }
#pragma unroll
            for (int rt = 0; rt < 2; ++rt) {
                const int ql = rt * 8 + (c >> 2), q = q0 + ql;
                f32x16 X;
#pragma unroll
                for (int e = 0; e < 16; ++e) X[e] = 0.f;
#pragma unroll
                for (int s4 = 0; s4 < 4; ++s4) X = __builtin_amdgcn_mfma_f32_32x32x16_bf16(Kf[s4], *(LAS const bf16x8*)(Qb + rt * 8 * PU_QROW + s4 * 32), X, 0, 0, 0);
                const unsigned word = MB[ql * 64 + kt];
                const unsigned bits = ((word >> (8 * h)) & 0xFFu) | (((word >> (16 + 8 * h)) & 0xFFu) << 8);
                const bool nearT = (q0 + rt * 8) - (key0 + 31) < 113;
#pragma unroll
                for (int s2 = 0; s2 < 2; ++s2) {
                    float P[8];
                    if (nearT) {
#pragma unroll
                        for (int e8 = 0; e8 < 8; ++e8) {
                            const int e = 8 * s2 + e8;
                            const int key = key0 + e8 + 16 * s2 + 8 * h;
                            int dist = q - key; dist = dist < 0 ? 0 : (dist > 127 ? 127 : dist);
                            const float bias = RB[BT[dist] * 8 + hd] * L2E;
                            const float lg = fminf(X[e] + bias, 86.f);
                            P[e8] = __int_as_float(__float_as_int(__builtin_amdgcn_exp2f(lg)) & __builtin_amdgcn_sbfe((int)bits, e, 1));
                        }
                    } else {
#pragma unroll
                        for (int e8 = 0; e8 < 8; ++e8) {
                            const int e = 8 * s2 + e8;
                            const float lg = fminf(X[e] + b31, 86.f);
                            P[e8] = __int_as_float(__float_as_int(__builtin_amdgcn_exp2f(lg)) & __builtin_amdgcn_sbfe((int)bits, e, 1));
                        }
                    }
#pragma unroll
                    for (int e8 = 0; e8 < 8; ++e8) lsum[rt] += P[e8];
                    const u32x4 pk = (u32x4){cvt_pk_bf16(P[0], P[1]), cvt_pk_bf16(P[2], P[3]), cvt_pk_bf16(P[4], P[5]), cvt_pk_bf16(P[6], P[7])};
                    bf16x8 Pf; __builtin_memcpy(&Pf, &pk, 16);
                    O[rt][0] = __builtin_amdgcn_mfma_f32_32x32x16_bf16(Vf[0][s2], Pf, O[rt][0], 0, 0, 0);
                    O[rt][1] = __builtin_amdgcn_mfma_f32_32x32x16_bf16(Vf[1][s2], Pf, O[rt][1], 0, 0, 0);
                }
                __builtin_amdgcn_sched_barrier(0);
            }
        }
        LAS float* CB = (LAS float*)F.lds + (g * 3 + (kq > 0 ? kq - 1 : 0)) * (66 * 64);
        __syncthreads();
        if (kq > 0) {
#pragma unroll
            for (int rt = 0; rt < 2; ++rt) {
#pragma unroll
                for (int d = 0; d < 2; ++d)
#pragma unroll
                    for (int e = 0; e < 16; ++e) CB[((rt * 2 + d) * 16 + e) * 64 + lane] = O[rt][d][e];
                CB[(64 + rt) * 64 + lane] = lsum[rt];
            }
        }
        __syncthreads();
        if (kq == 0) {
#pragma unroll 1
            for (int p = 0; p < 3; ++p) {
                LAS const float* CP = (LAS const float*)F.lds + (g * 3 + p) * (66 * 64);
#pragma unroll
                for (int rt = 0; rt < 2; ++rt) {
#pragma unroll
                    for (int d = 0; d < 2; ++d)
#pragma unroll
                        for (int e = 0; e < 16; ++e) O[rt][d][e] += CP[((rt * 2 + d) * 16 + e) * 64 + lane];
                    lsum[rt] += CP[(64 + rt) * 64 + lane];
                }
            }
#pragma unroll
            for (int rt = 0; rt < 2; ++rt) {
                float l = lsum[rt]; l += __shfl_xor(l, 32);
                const float inv = 1.f / l;
                bf16_t* orow = F.OATT + (tok0 + q0 + rt * 8 + (c >> 2)) * 512 + hd * 64;
#pragma unroll
                for (int a4 = 0; a4 < 4; ++a4) {
                    const f32x4 v0 = (f32x4){O[rt][0][4 * a4], O[rt][0][4 * a4 + 1], O[rt][0][4 * a4 + 2], O[rt][0][4 * a4 + 3]} * inv;
                    const f32x4 v1 = (f32x4){O[rt][1][4 * a4], O[rt][1][4 * a4 + 1], O[rt][1][4 * a4 + 2], O[rt][1][4 * a4 + 3]} * inv;
                    *(u32x2*)(orow + 8 * a4 + 4 * h) = pk4(v0);
                    *(u32x2*)(orow + 32 + 8 * a4 + 4 * h) = pk4(v1);
                }
            }
        }
    }
}

__device__ __forceinline__ void p3_sample_score_unit(const Frame& F, float* SS, int b, int ch) {
    const int lane = F.lane, r = lane & 31, h = lane >> 5;
    bf16x8 A[4];
    { const int q = r >> 2, hh = r & 3;
#pragma unroll
      for (int s4 = 0; s4 < 4; ++s4) A[s4] = *(const bf16x8*)(F.PROJ + (size_t)(NTP + b * TS + q) * NMIXP + C_QI + hh * 64 + s4 * 16 + h * 8); }
    float wv[4][4];
#pragma unroll
    for (int g = 0; g < 4; ++g) { const f32x4 w4 = *(const f32x4*)(F.WI + (size_t)(NTP + b * TS + 2 * g + h) * 4);
#pragma unroll
        for (int hh = 0; hh < 4; ++hh) wv[g][hh] = w4[hh] * IDX_SCALE; }
    f32x4 kn[8];
    { const int key0 = ch * 1024 + F.wave * 32; const int page = F.page_table[b * NPAGES + (key0 >> 7)];
      const float* kr = F.cache_ki + ((size_t)page * PAGE + (key0 & 127) + r) * 64 + h * 8;
#pragma unroll
      for (int s4 = 0; s4 < 4; ++s4) { kn[2 * s4] = *(const f32x4*)(kr + s4 * 16); kn[2 * s4 + 1] = *(const f32x4*)(kr + s4 * 16 + 4); } }
#pragma unroll 1
    for (int tl = F.wave; tl < 32; tl += 8) {
        const int key0 = ch * 1024 + tl * 32;
        f32x4 kc[8];
#pragma unroll
        for (int i = 0; i < 8; ++i) kc[i] = kn[i];
        if (tl + 8 < 32) {
            const int keyn = key0 + 256; const int page = F.page_table[b * NPAGES + (keyn >> 7)];
            const float* kr = F.cache_ki + ((size_t)page * PAGE + (keyn & 127) + r) * 64 + h * 8;
#pragma unroll
            for (int s4 = 0; s4 < 4; ++s4) { kn[2 * s4] = *(const f32x4*)(kr + s4 * 16); kn[2 * s4 + 1] = *(const f32x4*)(kr + s4 * 16 + 4); }
        }
        f32x16 c;
#pragma unroll
        for (int e = 0; e < 16; ++e) c[e] = 0.f;
#pragma unroll
        for (int s4 = 0; s4 < 4; ++s4) {
            const f32x4 lo = kc[2 * s4], hi = kc[2 * s4 + 1];
            const u32x4 pk = (u32x4){cvt_pk_bf16(lo[0], lo[1]), cvt_pk_bf16(lo[2], lo[3]), cvt_pk_bf16(hi[0], hi[1]), cvt_pk_bf16(hi[2], hi[3])};
            bf16x8 Bf; __builtin_memcpy(&Bf, &pk, 16);
            c = __builtin_amdgcn_mfma_f32_32x32x16_bf16(A[s4], Bf, c, 0, 0, 0);
        }
#pragma unroll
        for (int g = 0; g < 4; ++g) {
            float sc = 0.f;
#pragma unroll
            for (int hh = 0; hh < 4; ++hh) sc += fmaxf(c[4 * g + hh], 0.f) * wv[g][hh];
            SS[(size_t)(b * TS + 2 * g + h) * PAST + key0 + r] = sc;
        }
    }
}
__device__ __forceinline__ void p3_index(const Frame& F) {
    constexpr int NSU = NB_S * 8;
    const int nunits = NSU + NB_P * (SEQ / 16);
    float* SS = (float*)(F.ws + WS_SS);
    const bf16_t* VT = (const bf16_t*)(F.ws + WS_VT);
    __syncthreads();
    if (F.tid < 256) ((LAS float*)(F.lds + PU_RB))[F.tid] = F.rel_bias[F.tid];
    if (F.tid < 128) ((LAS int*)(F.lds + PU_BT))[F.tid] = t5_bucket(F.tid);
    __syncthreads();
    for (int it = F.bid; it < nunits; it += F.G) {
        if (it < NSU) { p3_sample_score_unit(F, SS, it >> 3, it & 7); continue; }
        const int i = it - NSU; const int b = i & 7, sl = (i >> 3) & 31, rnd = i >> 8;
        const int qt = rnd == 0 ? 127 - sl : (rnd == 1 ? 64 + sl : (rnd == 2 ? 63 - sl : sl));
        p3_prompt_fused_unit(F, VT, b, qt);
    }
}

constexpr int SQ_CNT = 0;
constexpr int SQ_SEL = 1024;
constexpr int SQ_Q = 2048;
constexpr int SQ_P = 4096;
constexpr int SQ_RB = 16384;
constexpr int SQ_BT = 17408;
__device__ __forceinline__ int wg_sum8(const Frame& F, LAS unsigned* slot, int v) {
    if (F.lane == 0) slot[F.wave] = (unsigned)v;
    __syncthreads();
    int t = 0;
#pragma unroll
    for (int w = 0; w < 8; ++w) t += (int)slot[w];
    return t;
}
__device__ __forceinline__ void p4_sample_query_unit(const Frame& F, const float* SS, int b, int t) {
    const int lane = F.lane, w = F.wave;
    LAS unsigned* CNT = (LAS unsigned*)(F.lds + SQ_CNT);
    LAS int* SELL = (LAS int*)(F.lds + SQ_SEL);
    LAS unsigned* QL = (LAS unsigned*)(F.lds + SQ_Q);
    LAS float* PL = (LAS float*)(F.lds + SQ_P) + w * 256;
    LAS float* RB = (LAS float*)(F.lds + SQ_RB);
    LAS int* BT = (LAS int*)(F.lds + SQ_BT);
    const int tok = NTP + b * TS + t;
    __syncthreads();
    if (F.tid < 256) QL[F.tid] = ((const unsigned*)(F.PROJ + (size_t)tok * NMIXP + C_Q))[F.tid];
    unsigned u[17];
    { const float* srow = SS + (size_t)(b * TS + t) * PAST + w * 1024;
#pragma unroll
      for (int i = 0; i < 16; ++i) u[i] = f2ord(srow[64 * i + lane]); }
    u[16] = 0u;
    if (w == 7) {
        float sc = 0.f;
        if (lane < TS) {
            const bf16_t* kn = F.PROJ + (size_t)(NTP + b * TS + lane) * NMIXP + C_KI;
            const bf16_t* qn = F.PROJ + (size_t)tok * NMIXP + C_QI;
            int vz; asm volatile("v_mov_b32 %0, 0" : "=v"(vz));
            const f32x4 w4 = *(const f32x4*)(F.WI + (size_t)tok * 4 + vz);
#pragma unroll 1
            for (int hh = 0; hh < 4; ++hh) {
                float d = 0.f;
#pragma unroll 8
                for (int e = 0; e < 64; ++e) d += bf2f(qn[hh * 64 + e]) * bf2f(kn[e]);
                sc += fmaxf(d, 0.f) * (w4[hh] * IDX_SCALE);
            }
        }
        u[16] = (lane < TS && lane <= t) ? f2ord(sc) : 0u;
    }
    unsigned T = 0;
#pragma unroll 1
    for (int bit = 31; bit >= 0; --bit) {
        const unsigned cand = T | (1u << bit);
        int c = 0;
#pragma unroll
        for (int i = 0; i < 17; ++i) cnt_ge(c, u[i], cand);
        c = wg_sum8(F, CNT + (bit & 1) * 24, wave_sum_i_dpp(c));
        if (c >= NSEL) T = cand;
        if (c == NSEL) break;
    }
    int cg = 0, ce = 0;
#pragma unroll
    for (int i = 0; i < 17; ++i) { cnt_gt(cg, u[i], T); cnt_eq(ce, u[i], T); }
    const int cgw = wave_sum_i_dpp(cg);
    const int ngt = wg_sum8(F, CNT + 8, cgw);
    const int neq = wg_sum8(F, CNT + 16, wave_sum_i_dpp(ce));
    const int need = NSEL - ngt;
    int Jx = 0x3FFFFFFF;
    if (need < neq) {
        int Jb = 0;
#pragma unroll 1
        for (int bit = 13; bit >= 0; --bit) {
            const int cand = Jb | (1 << bit);
            const int L = cand - lane - 1024 * w;
            int c = 0;
#pragma unroll
            for (int i = 0; i < 17; ++i) cnt_eq_pos(c, u[i], T, L - 64 * i);
            c = wg_sum8(F, CNT + (bit & 1) * 24, wave_sum_i_dpp(c));
            if (c < need) Jb = cand;
        }
        Jx = Jb + 1;
    }
    {
        const int L = Jx - lane - 1024 * w;
        int ct = 0;
#pragma unroll
        for (int i = 0; i < 17; ++i) cnt_eq_pos(ct, u[i], T, L - 64 * i);
        const int ctw = wave_sum_i_dpp(ct);
        __syncthreads();
        if (lane == 0) { CNT[w] = (unsigned)cgw; CNT[8 + w] = (unsigned)ctw; }
        __syncthreads();
        int bg = 0, bt = ngt;
#pragma unroll
        for (int ww = 0; ww < 8; ++ww) { if (ww < w) { bg += (int)CNT[ww]; bt += (int)CNT[8 + ww]; } }
        int ig = cg, it2 = ct;
#pragma unroll
        for (int o = 1; o < 64; o <<= 1) { const int a = __shfl_up(ig, o), b2 = __shfl_up(it2, o); if (lane >= o) { ig += a; it2 += b2; } }
        int pg = bg + ig - cg, pt = bt + it2 - ct;
        int ev = 1024 * w + lane, Lr = L;
#pragma unroll
        for (int i = 0; i < 17; ++i) {
            if (u[i] > T) { SELL[pg] = ev; ++pg; }
            else if (u[i] == T && Lr > 0) { SELL[pt] = ev; ++pt; }
            asm volatile("v_add_u32 %0, 64, %0\n\tv_add_u32 %1, -64, %1" : "+v"(ev), "+v"(Lr));
        }
    }
    __syncthreads();
    {
        const int hd = w, g = w >> 2, qpos = PAST + t;
        float lg[4];
#pragma unroll 2
        for (int i = 0; i < 4; ++i) {
            const int sraw = SELL[lane + 64 * i];
            const float* kr;
            if (sraw < PAST) { const int page = F.page_table[b * NPAGES + (sraw >> 7)]; kr = F.cache_k + ((size_t)page * PAGE + (sraw & 127)) * 128 + g * 64; }
            else kr = F.out + O_KS + (size_t)(b * TS + (sraw - PAST)) * 128 + g * 64;
            float a0 = 0.f, a1 = 0.f;
#pragma unroll
            for (int c = 0; c < 16; ++c) {
                const f32x4 kv = *(const f32x4*)(kr + c * 4);
                const unsigned q0 = QL[hd * 32 + c * 2], q1 = QL[hd * 32 + c * 2 + 1];
                a0 += bflo(q0) * kv[0] + bfhi(q0) * kv[1]; a1 += bflo(q1) * kv[2] + bfhi(q1) * kv[3];
            }
            const int dist = qpos - sraw; const int bk = dist < 128 ? BT[dist] : 31;
            lg[i] = (a0 + a1) * ATTN_SCALE + RB[bk * 8 + hd];
        }
        float m = fmaxf(fmaxf(lg[0], lg[1]), fmaxf(lg[2], lg[3])); m = wave_max(m);
        float sm = 0.f;
#pragma unroll
        for (int i = 0; i < 4; ++i) { lg[i] = __expf(lg[i] - m); sm += lg[i]; }
        const float inv = 1.f / wave_sum_dpp(sm);
#pragma unroll
        for (int i = 0; i < 4; ++i) PL[lane + 64 * i] = lg[i] * inv;
        const int dq = lane & 15, ks = lane >> 4;
        f32x4 o4 = {0.f, 0.f, 0.f, 0.f};
#pragma unroll 1
        for (int j0 = 0; j0 < 256; j0 += 64) {
            f32x4 vv[16]; float pp[16];
#pragma unroll
            for (int jj = 0; jj < 16; ++jj) {
                const int j = j0 + jj * 4 + ks;
                const int sraw = SELL[j]; pp[jj] = PL[j];
                const float* vr;
                if (sraw < PAST) { const int page = F.page_table[b * NPAGES + (sraw >> 7)]; vr = F.cache_v + ((size_t)page * PAGE + (sraw & 127)) * 128 + g * 64; }
                else vr = F.out + O_VS + (size_t)(b * TS + (sraw - PAST)) * 128 + g * 64;
                vv[jj] = *(const f32x4*)(vr + 4 * dq);
            }
#pragma unroll
            for (int jj = 0; jj < 16; ++jj) o4 += vv[jj] * pp[jj];
        }
#pragma unroll
        for (int e = 0; e < 4; ++e) { o4[e] += __shfl_xor(o4[e], 16); o4[e] += __shfl_xor(o4[e], 32); }
        if (ks == 0) *(u32x2*)(F.OATT + (size_t)tok * 512 + hd * 64 + 4 * dq) = pk4(o4);
    }
}
__device__ __forceinline__ void p4_attention(const Frame& F) {
    const float* SS = (const float*)(F.ws + WS_SS);
    __syncthreads();
    if (F.tid < 256) ((LAS float*)(F.lds + SQ_RB))[F.tid] = F.rel_bias[F.tid];
    if (F.tid < 128) ((LAS int*)(F.lds + SQ_BT))[F.tid] = t5_bucket(F.tid);
    __syncthreads();
    for (int it = F.bid; it < NTS; it += F.G) p4_sample_query_unit(F, SS, it >> 3, it & 7);
    for (int m = F.bid * 8 + F.wave; m < NT; m += F.G * 8) {
        int t, T_, bsm; if (m < NTP) { t = m & 2047; T_ = SEQ; bsm = m >> 11; } else { t = (m - NTP) & 7; T_ = TS; bsm = (m - NTP) >> 3; }
        const int c0 = F.lane * 8;
        float u0[8], u1[8], u2[8];
        { const u32x4 cg = *(const u32x4*)(F.PROJ + (size_t)m * NMIXP + C_CG + c0), xi = *(const u32x4*)(F.PROJ + (size_t)m * NMIXP + C_XIN + c0);
#pragma unroll
          for (int e = 0; e < 4; ++e) { u0[2 * e] = bflo(cg[e]) * bflo(xi[e]); u0[2 * e + 1] = bfhi(cg[e]) * bfhi(xi[e]); } }
#pragma unroll
        for (int d = 1; d <= 2; ++d) {
            float* ud = (d == 1) ? u1 : u2;
            if (t - d >= 0) {
                const u32x4 cg = *(const u32x4*)(F.PROJ + (size_t)(m - d) * NMIXP + C_CG + c0), xi = *(const u32x4*)(F.PROJ + (size_t)(m - d) * NMIXP + C_XIN + c0);
#pragma unroll
                for (int e = 0; e < 4; ++e) { ud[2 * e] = bflo(cg[e]) * bflo(xi[e]); ud[2 * e + 1] = bfhi(cg[e]) * bfhi(xi[e]); }
            } else if (m >= NTP) {
                const float* pv = F.state_conv + ((size_t)bsm * 2 + (2 + t - d)) * 512 + c0;
#pragma unroll
                for (int e = 0; e < 8; ++e) ud[e] = pv[e];
            } else {
#pragma unroll
                for (int e = 0; e < 8; ++e) ud[e] = 0.f;
            }
        }
        const u32x4 bg = *(const u32x4*)(F.PROJ + (size_t)m * NMIXP + C_BG + c0);
        float y[8];
#pragma unroll
        for (int e = 0; e < 8; ++e) {
            const int c = c0 + e;
            const float yy = F.conv_b[c] + F.conv_w[c] * u2[e] + F.conv_w[512 + c] * u1[e] + F.conv_w[1024 + c] * u0[e];
            const float bgv = (e & 1) ? bfhi(bg[e >> 1]) : bflo(bg[e >> 1]);
            y[e] = bgv * yy;
        }
        *(u32x4*)(F.OCONV + (size_t)m * 512 + c0) = (u32x4){cvt_pk_bf16(y[0], y[1]), cvt_pk_bf16(y[2], y[3]), cvt_pk_bf16(y[4], y[5]), cvt_pk_bf16(y[6], y[7])};
        if (t >= T_ - 2) {
            float* o = (m < NTP ? F.out + O_CP : F.out + O_CS) + ((size_t)bsm * 2 + (t - (T_ - 2))) * 512 + c0;
            const int rowi = (m < NTP) ? bsm * 2 + (t - (T_ - 2)) : 2 * NB_P + bsm * 2 + (t - (T_ - 2));
            const float* cx = (const float*)(F.ws + WS_CGX) + (size_t)rowi * 1024 + c0;
            const f32x4 ca = *(const f32x4*)cx, cb = *(const f32x4*)(cx + 4), xa = *(const f32x4*)(cx + 512), xb = *(const f32x4*)(cx + 516);
            *(f32x4*)o = ca * xa; *(f32x4*)(o + 4) = cb * xb;
        }
    }
}

#define P5_EPI(A1, A2) { \
            const f32x4 va = ACC4(A1), vc = ACC4(A2); \
            const u32x2 ga = *(const u32x2*)(F.PROJ + (size_t)m * NMIXP + C_GA + n), gb = *(const u32x2*)(F.PROJ + (size_t)m * NMIXP + C_GB + n); \
            f32x4 o; \
            o[0] = sigmoidf_(bflo(ga[0])) * va[0] + sigmoidf_(bflo(gb[0])) * vc[0]; \
            o[1] = sigmoidf_(bfhi(ga[0])) * va[1] + sigmoidf_(bfhi(gb[0])) * vc[1]; \
            o[2] = sigmoidf_(bflo(ga[1])) * va[2] + sigmoidf_(bflo(gb[1])) * vc[2]; \
            o[3] = sigmoidf_(bfhi(ga[1])) * va[3] + sigmoidf_(bfhi(gb[1])) * vc[3]; \
            *(u32x2*)(F.MERGED + (size_t)m * D + n) = pk4(o); }
struct P5aBody {
    const Frame* Fp;
    __device__ __forceinline__ void operator()(int m, int n, const f32x4 v) const {
        const Frame& F = *Fp;
        const u32x2 ga = *(const u32x2*)(F.PROJ + (size_t)m * NMIXP + C_GA + n);
        const f32x4 o = (f32x4){sigmoidf_(bflo(ga[0])) * v[0], sigmoidf_(bfhi(ga[0])) * v[1], sigmoidf_(bflo(ga[1])) * v[2], sigmoidf_(bfhi(ga[1])) * v[3]};
        *(f32x4*)(F.T1 + (size_t)m * D + n) = o;
    }
};
struct P5bBody {
    const Frame* Fp;
    __device__ __forceinline__ void operator()(int m, int n, const f32x4 v) const {
        const Frame& F = *Fp;
        const u32x2 gb = *(const u32x2*)(F.PROJ + (size_t)m * NMIXP + C_GB + n);
        const f32x4 pa = *(const f32x4*)(F.T1 + (size_t)m * D + n);
        const f32x4 o = (f32x4){pa[0] + sigmoidf_(bflo(gb[0])) * v[0], pa[1] + sigmoidf_(bfhi(gb[0])) * v[1], pa[2] + sigmoidf_(bflo(gb[1])) * v[2], pa[3] + sigmoidf_(bfhi(gb[1])) * v[3]};
        *(u32x2*)(F.MERGED + (size_t)m * D + n) = pk4(o);
    }
};
__device__ __forceinline__ void p5_gemm_merge(const Frame& F) {
    {
        pg8::StaticOrder S; S.init(NTP, D, F.G, F.bid);
        { pg8::Gemm g{F.OATT, F.WOA, NTP, D, 512}; pg8::EpiRC<P5aBody> E{P5aBody{&F}}; pg8::gemm_phase<pg8::EpiRC<P5aBody>, pg8::StaticOrder, true, true>(F.lds, g, S, E); }
        asm volatile("s_waitcnt vmcnt(0)" ::: "memory"); __syncthreads();
        { pg8::Gemm g{F.OCONV, F.WOC, NTP, D, 512}; pg8::EpiRC<P5bBody> E{P5bBody{&F}}; pg8::gemm_phase<pg8::EpiRC<P5bBody>, pg8::StaticOrder, true, true>(F.lds, g, S, E); }
    }
    for (int sl = F.bid; sl < NTS / 8 * (D / BN); sl += F.G) {
        const int m0 = NTP + (sl >> 3) * 8, n0 = (sl & 7) * BN;
        f32x16 s1[1][1], s2[1][1];
        gemm_slice8(F, s1, F.OATT, 512, F.WOA, 512, 512, m0, n0);
        gemm_slice8(F, s2, F.OCONV, 512, F.WOC, 512, 512, m0, n0);
        SLICE_EPI_LOOP(P5_EPI(s1, s2))
    }
}
#define P6_EPI(A1) { \
            const f32x4 v = ACC4(A1); \
            const f32x4 xv = *(const f32x4*)(x_row(F, m) + n); \
            const f32x4 g1 = *(const f32x4*)(F.MOD + (size_t)mod_row(m) * 6144 + 2048 + n); \
            *(f32x4*)(F.T1 + (size_t)m * D + n) = xv * DN_ALPHA + g1 * v; }
struct P6Body {
    const Frame* Fp;
    __device__ __forceinline__ void operator()(int m, int n, const f32x4 v) const {
        const Frame& F = *Fp;
        const f32x4 xv = *(const f32x4*)(F.x_p + (size_t)m * D + n);
        const f32x4 g1 = *(const f32x4*)(F.MOD + (size_t)(m >> 11) * 6144 + 2048 + n);
        *(f32x4*)(F.T1 + (size_t)m * D + n) = xv * DN_ALPHA + g1 * v;
    }
};
__device__ __forceinline__ void p6_gemm_out(const Frame& F) {
    {
        pg8::Gemm g{F.MERGED, F.WOUT, NTP, D, D}; pg8::StaticOrder S; S.init(NTP, D, F.G, F.bid);
        pg8::EpiRC<P6Body> E{P6Body{&F}}; pg8::gemm_phase<pg8::EpiRC<P6Body>, pg8::StaticOrder, true, true>(F.lds, g, S, E);
    }
    for (int sl = F.bid; sl < NTS / 8 * (D / BN); sl += F.G) {
        const int m0 = NTP + (sl >> 3) * 8, n0 = (sl & 7) * BN;
        f32x16 s1[1][1];
        gemm_slice8(F, s1, F.MERGED, D, F.WOUT, D, D, m0, n0);
        SLICE_EPI_LOOP(P6_EPI(s1))
    }
}
__device__ __forceinline__ void p7_ln1(const Frame& F) {
    for (int m = F.bid * 8 + F.wave; m < NT; m += F.G * 8) {
        float* tr = F.T1 + (size_t)m * D; const float* mr = F.MOD + (size_t)mod_row(m) * 6144;
        f32x4 v[4]; float s = 0.f;
#pragma unroll
        for (int i = 0; i < 4; ++i) { v[i] = *(const f32x4*)(tr + (i >> 1) * 512 + F.lane * 8 + (i & 1) * 4); s += v[i][0] + v[i][1] + v[i][2] + v[i][3]; }
        const float mean = wave_sum(s) * (1.f / D);
        float q = 0.f;
#pragma unroll
        for (int i = 0; i < 4; ++i) { v[i] = v[i] - mean; q += v[i][0] * v[i][0] + v[i][1] * v[i][1] + v[i][2] * v[i][2] + v[i][3] * v[i][3]; }
        const float rstd = rsqrtf(wave_sum(q) * (1.f / D) + LN_EPS);
        f32x4 hv[2][2];
#pragma unroll
        for (int hlf = 0; hlf < 2; ++hlf) {
            const int e = hlf * 512 + F.lane * 8;
            f32x4 a = v[2 * hlf] * rstd * *(const f32x4*)(F.ln1_g + e) + *(const f32x4*)(F.ln1_b + e);
            f32x4 b = v[2 * hlf + 1] * rstd * *(const f32x4*)(F.ln1_g + e + 4) + *(const f32x4*)(F.ln1_b + e + 4);
            *(f32x4*)(tr + e) = a; *(f32x4*)(tr + e + 4) = b;
            const f32x4 ha = a * (*(const f32x4*)(mr + 4096 + e) + 1.f) + *(const f32x4*)(mr + 3072 + e);
            const f32x4 hb = b * (*(const f32x4*)(mr + 4096 + e + 4) + 1.f) + *(const f32x4*)(mr + 3072 + e + 4);
            *(u32x4*)(F.H2 + (size_t)m * D + e) = (u32x4){cvt_pk_bf16(ha[0], ha[1]), cvt_pk_bf16(ha[2], ha[3]), cvt_pk_bf16(hb[0], hb[1]), cvt_pk_bf16(hb[2], hb[3])};
            hv[hlf][0] = ha; hv[hlf][1] = hb;
        }
        float am = 0.f;
#pragma unroll
        for (int i = 0; i < 2; ++i)
#pragma unroll
            for (int j = 0; j < 2; ++j)
#pragma unroll
                for (int e = 0; e < 4; ++e) am = fmaxf(am, fabsf(hv[i][j][e]));
        am = wave_max(am);
        const float sc = am > 0.f ? 224.f / am : 1.f;
#pragma unroll
        for (int hlf = 0; hlf < 2; ++hlf) {
            int w0 = 0, w1 = 0;
            w0 = __builtin_amdgcn_cvt_pk_fp8_f32(hv[hlf][0][0] * sc, hv[hlf][0][1] * sc, w0, false); w0 = __builtin_amdgcn_cvt_pk_fp8_f32(hv[hlf][0][2] * sc, hv[hlf][0][3] * sc, w0, true);
            w1 = __builtin_amdgcn_cvt_pk_fp8_f32(hv[hlf][1][0] * sc, hv[hlf][1][1] * sc, w1, false); w1 = __builtin_amdgcn_cvt_pk_fp8_f32(hv[hlf][1][2] * sc, hv[hlf][1][3] * sc, w1, true);
            *(u32x2*)(F.ws + WS_H8 + (size_t)m * D + hlf * 512 + F.lane * 8) = (u32x2){(unsigned)w0, (unsigned)w1};
        }
        if (F.lane == 0) ((float*)(F.ws + WS_SH))[m] = am > 0.f ? am * (1.f / 224.f) : 1.f;
    }
}
struct P8Body {
    const Frame* Fp;
    __device__ __forceinline__ void operator()(int m, int n, const f32x4 v) const { *(u32x2*)(Fp->QP + (size_t)m * D + n) = pk4(v); }
};
__device__ __forceinline__ void p8_gemm_q(const Frame& F) {
    {
        pg8::Gemm g{F.H2, F.WQ, NTP, D, D}; pg8::StaticOrder S; S.init(NTP, D, F.G, F.bid);
        pg8::EpiRC<P8Body> E{P8Body{&F}}; pg8::gemm_phase<pg8::EpiRC<P8Body>, pg8::StaticOrder, true, true>(F.lds, g, S, E);
    }
    for (int sl = F.bid; sl < NTS / 8 * (D / BN); sl += F.G) {
        const int m0 = NTP + (sl >> 3) * 8, n0 = (sl & 7) * BN;
        f32x16 s1[1][1];
        gemm_slice8(F, s1, F.H2, D, F.WQ, D, D, m0, n0);
        SLICE_EPI_LOOP({ *(u32x2*)(F.QP + (size_t)m * D + n) = pk4(ACC4(s1)); })
    }
}
constexpr int PR_ROW = 129;
__device__ __forceinline__ void p9_route(const Frame& F) {
    LAS float* SC = (LAS float*)F.lds;
    LAS float* TV = (LAS float*)(F.lds + 32 * 8 * PR_ROW * 4);
    LAS unsigned char* TI = (LAS unsigned char*)(F.lds + 32 * 8 * PR_ROW * 4 + 256 * 17 * 4);
    const int lane = F.lane, r = lane & 31, h = lane >> 5;
    const int nunits = (NT / 32) * 2;
    for (int it = F.bid; it < nunits; it += F.G) {
        const int tok0 = (it >> 1) * 32, hg = it & 1;
        __syncthreads();
        {
            const int head = hg * 4 + (F.wave >> 1), half = F.wave & 1;
            const bf16_t* KK = half ? F.K2 : F.K1;
            bf16x8 Bq[4];
#pragma unroll
            for (int s = 0; s < 4; ++s) Bq[s] = *(const bf16x8*)(F.QP + (size_t)(tok0 + r) * D + head * 128 + half * 64 + s * 16 + h * 8);
#pragma unroll
            for (int kt = 0; kt < 4; ++kt) {
                f32x16 c;
#pragma unroll
                for (int e = 0; e < 16; ++e) c[e] = 0.f;
#pragma unroll
                for (int s = 0; s < 4; ++s) {
                    const bf16x8 Ak = *(const bf16x8*)(KK + (size_t)(kt * 32 + r) * 64 + s * 16 + h * 8);
                    c = __builtin_amdgcn_mfma_f32_32x32x16_bf16(Ak, Bq[s], c, 0, 0, 0);
                }
#pragma unroll
                for (int e = 0; e < 16; ++e) { const int key = kt * 32 + (e & 3) + 8 * (e >> 2) + 4 * h; SC[(r * 8 + F.wave) * PR_ROW + key] = c[e]; }
            }
        }
        __syncthreads();
        {
            const int rowi = F.tid >> 1, hf = F.tid & 1;
            LAS float* row = SC + rowi * PR_ROW;
            LAS float* rh = row + 64 * hf;
            float gm[8];
#pragma unroll
            for (int gidx = 0; gidx < 8; ++gidx) {
                float m = rh[gidx * 8];
#pragma unroll
                for (int k = 1; k < 8; ++k) m = fmaxf(m, rh[gidx * 8 + k]);
                gm[gidx] = m;
            }
            float ov[16]; int oi[16];
#pragma unroll
            for (int p = 0; p < 16; ++p) {
                float best = gm[0]; int bg = 0;
#pragma unroll
                for (int gidx = 1; gidx < 8; ++gidx) { const bool gt = gm[gidx] > best; best = gt ? gm[gidx] : best; bg = gt ? gidx : bg; }
                float v[8];
#pragma unroll
                for (int k = 0; k < 8; ++k) v[k] = rh[bg * 8 + k];
                int bk = 7;
#pragma unroll
                for (int k = 6; k >= 0; --k) bk = (v[k] == best) ? k : bk;
                float nm = -INFINITY;
#pragma unroll
                for (int k = 0; k < 8; ++k) nm = fmaxf(nm, (k == bk) ? -INFINITY : v[k]);
                rh[bg * 8 + bk] = -INFINITY;
#pragma unroll
                for (int gidx = 0; gidx < 8; ++gidx) gm[gidx] = (gidx == bg) ? nm : gm[gidx];
                ov[p] = best; oi[p] = 64 * hf + bg * 8 + bk;
            }
#pragma unroll
            for (int p = 0; p < 16; ++p) { rh[p] = ov[p]; rh[16 + p] = __int_as_float(oi[p]); }
            if (hf == 0) {
                int pa = 0, pb = 0;
#pragma unroll 1
                for (int p = 0; p < 16; ++p) {
                    const float va = row[pa], vb = row[64 + pb];
                    const bool ta = va >= vb;
                    TV[rowi * 17 + p] = ta ? va : vb;
                    TI[rowi * 17 + p] = (unsigned char)__float_as_int(ta ? row[16 + pa] : row[64 + 16 + pb]);
                    pa += ta ? 1 : 0; pb += ta ? 0 : 1;
                }
            }
        }
        __syncthreads();
        if (F.tid < 128) {
            const int tk = F.tid >> 2, hs = F.tid & 3;
            const int r1 = (tk * 8 + hs * 2) * 17, r2 = r1 + 17;
            float c[16];
            { const float v20 = TV[r2];
#pragma unroll
              for (int i = 0; i < 16; ++i) c[i] = TV[r1 + i] + v20; }
            unsigned long long ptrs = 0ull;
            float sv[16]; int se[16];
#pragma unroll
            for (int p = 0; p < 16; ++p) {
                float best = c[0]; int bi = 0;
#pragma unroll
                for (int i = 1; i < 16; ++i) { const bool gt = c[i] > best; best = gt ? c[i] : best; bi = gt ? i : bi; }
                const int bj = (int)((ptrs >> (4 * bi)) & 15ull);
                sv[p] = best; se[p] = (int)TI[r1 + bi] * 128 + (int)TI[r2 + bj];
                const float nv = (bj < 15) ? TV[r1 + bi] + TV[r2 + bj + 1] : -INFINITY;
                ptrs += (bj < 15) ? (1ull << (4 * bi)) : 0ull;
#pragma unroll
                for (int i = 0; i < 16; ++i) c[i] = (i == bi) ? nv : c[i];
            }
            const float mx0 = sv[0]; float den = 0.f;
#pragma unroll
            for (int p = 0; p < 16; ++p) { sv[p] = __expf(sv[p] - mx0); den += sv[p]; }
            const float dinv = 1.f / den;
            const int head = hg * 4 + hs;
            int* eo = F.EIDX + (size_t)(tok0 + tk) * NEXP_SEL + head * 16; float* go = F.GW + (size_t)(tok0 + tk) * NEXP_SEL + head * 16;
#pragma unroll
            for (int p = 0; p < 16; ++p) { eo[p] = se[p]; go[p] = sv[p] * dinv; }
        }
    }
}

constexpr int TPW = 65, PAIRS_MAX = 9 * 128, PK = 4;
constexpr int P10_HROW = 1024 + 64;
constexpr int P10_H = 0;
constexpr int P10_SH = 32 * P10_HROW;
constexpr int P10_VROW = 2048 + 64;
constexpr int P10_STG = P10_SH + 128;
constexpr int P10_HIST = P10_STG + 8 * 4 * P10_VROW;
typedef short s16x4 __attribute__((ext_vector_type(4)));
__device__ __forceinline__ long pack64(unsigned lo, unsigned hi) { return (long)(((unsigned long long)hi << 32) | (unsigned long long)lo); }
__device__ __forceinline__ void fp8x16_to_bf16(const u32x4 v, u32x4& lo, u32x4& hi) {
    unsigned o[8];
#pragma unroll
    for (int i = 0; i < 4; ++i) {
        const f32x2_t a = __builtin_amdgcn_cvt_pk_f32_fp8((int)v[i], false), b2 = __builtin_amdgcn_cvt_pk_f32_fp8((int)v[i], true);
        o[2 * i] = cvt_pk_bf16(a[0], a[1]); o[2 * i + 1] = cvt_pk_bf16(b2[0], b2[1]);
    }
    lo = (u32x4){o[0], o[1], o[2], o[3]}; hi = (u32x4){o[4], o[5], o[6], o[7]};
}
__device__ __forceinline__ void p10_peer(const Frame& F) {
    const int lane = F.lane, w = F.wave;
    unsigned char* ws = F.ws;
    const unsigned char* PU8 = ws + WS_PU8; const unsigned char* PV8 = ws + WS_PV8;
    const float* SU = (const float*)(ws + WS_SU); const float* SV = (const float*)(ws + WS_SV);
    const unsigned char* H8 = ws + WS_H8; const float* SH = (const float*)(ws + WS_SH);
  for (int blk = F.bid; blk < NT / TPW; blk += F.G) {
    const int tok0 = blk * TPW;
    LAS unsigned* hist = (LAS unsigned*)(F.lds + P10_HIST) + w * 128;
    LAS unsigned char* stg = F.lds + P10_STG + w * (4 * P10_VROW);
    LAS float* SHl = (LAS float*)(F.lds + P10_SH);
    unsigned* SE0 = (unsigned*)(ws + WS_SE) + ((size_t)blk * 8 + w) * PAIRS_MAX;
    float* SG0 = (float*)(ws + WS_SG) + ((size_t)blk * 8 + w) * PAIRS_MAX;
    const int ntok = (w == 0) ? 9 : 8;
    const int r16 = lane & 15, q4 = lane >> 4;
#pragma unroll 1
    for (int pass = 0; pass < 3; ++pass) {
        const int kbase = pass * PK, nk = (ntok - kbase < PK) ? (ntok - kbase > 0 ? ntok - kbase : 0) : PK, npairs = nk * 128;
        __syncthreads();
        for (int c = F.tid; c < 32 * 64; c += NTHREADS) {
            const int row = c >> 6, tl = 32 * pass + row;
            if (tl < TPW) *(LAS u32x4*)(F.lds + P10_H + row * P10_HROW + (c & 63) * 16) = *(const u32x4*)(H8 + (size_t)(tok0 + tl) * D + (size_t)(c & 63) * 16);
        }
        if (F.tid < 32 && 32 * pass + F.tid < TPW) SHl[F.tid] = SH[tok0 + 32 * pass + F.tid];
        __syncthreads();
        if (nk <= 0) continue;
        unsigned* SE = SE0 + pass * (PK * 128); float* SG = SG0 + pass * (PK * 128);
        hist[lane] = 0u; hist[lane + 64] = 0u;
        int ex[8];
#pragma unroll
        for (int i = 0; i < 8; ++i) {
            const int p = lane + 64 * i;
            ex[i] = -1;
            if (p < npairs) { ex[i] = F.EIDX[(size_t)(tok0 + w + 8 * (kbase + (p >> 7))) * NEXP_SEL + (p & 127)]; atomicAdd((unsigned*)&hist[ex[i] >> 7], 1u); }
        }
        {
            const unsigned c0 = hist[2 * lane], c1 = hist[2 * lane + 1];
            unsigned incl = c0 + c1;
#pragma unroll
            for (int o = 1; o < 64; o <<= 1) { const unsigned t = __shfl_up(incl, o); if (lane >= o) incl += t; }
            const unsigned excl = incl - (c0 + c1);
            hist[2 * lane] = excl; hist[2 * lane + 1] = excl + c0;
        }
#pragma unroll
        for (int i = 0; i < 8; ++i) {
            const int p = lane + 64 * i;
            if (p < npairs) {
                const unsigned pos = atomicAdd((unsigned*)&hist[ex[i] >> 7], 1u);
                SE[pos] = (unsigned)ex[i] | ((unsigned)(p >> 7) << 14);
                SG[pos] = F.GW[(size_t)(tok0 + w + 8 * (kbase + (p >> 7))) * NEXP_SEL + (p & 127)];
            }
        }
        asm volatile("s_waitcnt vmcnt(0)" ::: "memory");
        f32x4 acc[16];
#pragma unroll
        for (int c = 0; c < 16; ++c) acc[c] = (f32x4){0.f, 0.f, 0.f, 0.f};
#pragma unroll 1
        for (int c0 = 0; c0 < npairs; c0 += 64) {
            const int wv = (int)SE[c0 + lane]; const int gv = __float_as_int(SG[c0 + lane]);
#pragma unroll 1
            for (int j0 = 0; j0 < 64; j0 += 16) {
                const int wr = __shfl(wv, j0 + r16);
                const int er = wr & 16383, sr = wr >> 14;
                const float gr = __int_as_float(__shfl(gv, j0 + r16));
                const unsigned char* ur = PU8 + (size_t)er * D + q4 * 16;
                u32x4 Ub[16];
#pragma unroll
                for (int t = 0; t < 16; ++t) Ub[t] = *(const u32x4*)(ur + t * 64);
                const float suv = SU[er], svv = SV[er];
                u32x4 V8[2][4];
#pragma unroll
                for (int k = 0; k < 4; ++k) V8[0][k] = *(const u32x4*)(PV8 + (size_t)(__builtin_amdgcn_readlane(wv, j0 + k) & 16383) * D + lane * 16);
                LAS const unsigned char* hr = F.lds + P10_H + (w + 8 * sr) * P10_HROW + q4 * 16;
                const float shv = SHl[w + 8 * sr];
                f32x4 C0 = {0.f, 0.f, 0.f, 0.f}, C1 = {0.f, 0.f, 0.f, 0.f};
#pragma unroll
                for (int t = 0; t < 16; ++t) {
                    const u32x4 hh = *(LAS const u32x4*)(hr + t * 64);
                    C0 = __builtin_amdgcn_mfma_f32_16x16x32_fp8_fp8(pack64(hh[0], hh[1]), pack64(Ub[t][0], Ub[t][1]), C0, 0, 0, 0);
                    C1 = __builtin_amdgcn_mfma_f32_16x16x32_fp8_fp8(pack64(hh[2], hh[3]), pack64(Ub[t][2], Ub[t][3]), C1, 0, 0, 0);
                }
                C0 = C0 + C1;
                const int rsel = lane & 3;
                const float dv = (rsel == 0 ? C0[0] : (rsel == 1 ? C0[1] : (rsel == 2 ? C0[2] : C0[3]))) * (suv * shv);
                const int actv = __float_as_int(gelu_tanh(dv) * (gr * svv));
#pragma unroll
                for (int sg = 0; sg < 4; ++sg) {
                    if (sg + 1 < 4) {
#pragma unroll
                        for (int k = 0; k < 4; ++k) V8[(sg + 1) & 1][k] = *(const u32x4*)(PV8 + (size_t)(__builtin_amdgcn_readlane(wv, j0 + 4 * (sg + 1) + k) & 16383) * D + lane * 16);
                    }
#pragma unroll
                    for (int k = 0; k < 4; ++k) {
                        u32x4 lo, hi; fp8x16_to_bf16(V8[sg & 1][k], lo, hi);
                        *(LAS u32x4*)(stg + k * P10_VROW + lane * 32) = lo;
                        *(LAS u32x4*)(stg + k * P10_VROW + lane * 32 + 16) = hi;
                    }
                    float a4[4];
#pragma unroll
                    for (int k = 0; k < 4; ++k) {
                        const int p = 4 * sg + k;
                        const float actk = __int_as_float(__builtin_amdgcn_readlane(actv, 16 * (p >> 2) + p));
                        const int slot = __builtin_amdgcn_readlane(wv, j0 + p) >> 14;
                        a4[k] = (slot == (lane & 3)) ? actk : 0.f;
                    }
                    const u32x2 apk = (u32x2){cvt_pk_bf16(a4[0], a4[1]), cvt_pk_bf16(a4[2], a4[3])};
                    s16x4 Aop; __builtin_memcpy(&Aop, &apk, 8);
                    LAS const unsigned char* tb = stg + ((lane & 15) >> 2) * P10_VROW + ((lane >> 4) * 16 + (lane & 3) * 4) * 2;
#pragma unroll
                    for (int c = 0; c < 16; ++c) {
                        const s16x4 Bop = __builtin_amdgcn_ds_read_tr16_b64_v4i16((LAS s16x4*)(tb + c * 128));
                        acc[c] = __builtin_amdgcn_mfma_f32_4x4x4bf16_1k(Aop, Bop, acc[c], 0, 0, 0);
                    }
                }
            }
        }
#pragma unroll
        for (int k = 0; k < PK; ++k) {
            if (k >= nk) continue;
            const int m = tok0 + w + 8 * (kbase + k);
            const float* x1 = F.T1 + (size_t)m * D; const float* mr = F.MOD + (size_t)mod_row(m) * 6144 + 5120;
            float tv[16]; float s = 0.f;
#pragma unroll
            for (int c = 0; c < 16; ++c) { const float t = x1[c * 64 + lane] * DN_ALPHA + mr[c * 64 + lane] * acc[c][k]; tv[c] = t; s += t; }
            const float mean = wave_sum(s) * (1.f / D);
            float q = 0.f;
#pragma unroll
            for (int c = 0; c < 16; ++c) { tv[c] -= mean; q += tv[c] * tv[c]; }
            const float rstd = rsqrtf(wave_sum(q) * (1.f / D) + LN_EPS);
            float* yo = (m < NTP) ? F.out + O_YP + (size_t)m * D : F.out + O_YS + (size_t)(m - NTP) * D;
#pragma unroll
            for (int c = 0; c < 16; ++c) yo[c * 64 + lane] = tv[c] * rstd * F.ln2_g[c * 64 + lane] + F.ln2_b[c * 64 + lane];
        }
    }
  }
}

constexpr int N_PHASES = 11;
__global__ void __launch_bounds__(NTHREADS, 2) fwd_kernel(Args args) {
    extern __shared__ __attribute__((aligned(16))) unsigned char lds_raw[];
    Frame F;
    F.lds = (LAS unsigned char*)lds_raw;
    F.tid = threadIdx.x; F.lane = F.tid & 63; F.wave = __builtin_amdgcn_readfirstlane(F.tid >> 6); F.G = gridDim.x; F.bid = blockIdx.x;
    F.x_p = (const float*)args.in[0]; F.x_s = (const float*)args.in[1]; F.c_p = (const float*)args.in[2]; F.c_s = (const float*)args.in[3];
    F.cache_k = (const float*)args.in[4]; F.cache_v = (const float*)args.in[5]; F.cache_ki = (const float*)args.in[6]; F.state_conv = (const float*)args.in[7];
    F.page_table = (const int*)args.in[8]; F.rel_bias = (const float*)args.in[9]; F.w_ada = (const float*)args.in[10]; F.b_ada = (const float*)args.in[11];
    F.w_in = (const float*)args.in[12]; F.conv_w = (const float*)args.in[13]; F.conv_b = (const float*)args.in[14]; F.w_o_attn = (const float*)args.in[15];
    F.w_o_conv = (const float*)args.in[16]; F.w_out = (const float*)args.in[17]; F.ln1_g = (const float*)args.in[18]; F.ln1_b = (const float*)args.in[19];
    F.ln2_g = (const float*)args.in[20]; F.ln2_b = (const float*)args.in[21]; F.peer_wq = (const float*)args.in[22]; F.peer_k1 = (const float*)args.in[23];
    F.peer_k2 = (const float*)args.in[24]; F.peer_u = (const float*)args.in[25]; F.peer_v = (const float*)args.in[26];
    F.out = args.out;
    unsigned char* ws = args.ws; F.ws = ws;
    F.MOD = (float*)(ws + WS_MOD); F.WIN = (bf16_t*)(ws + WS_WIN); F.WOA = (bf16_t*)(ws + WS_WOA); F.WOC = (bf16_t*)(ws + WS_WOC);
    F.WOUT = (bf16_t*)(ws + WS_WOUT); F.WQ = (bf16_t*)(ws + WS_WQ); F.K1 = (bf16_t*)(ws + WS_K1); F.K2 = (bf16_t*)(ws + WS_K2);
    F.PU = (bf16_t*)(ws + WS_PU); F.PV = (bf16_t*)(ws + WS_PV); F.H1 = (bf16_t*)(ws + WS_H1); F.PROJ = (bf16_t*)(ws + WS_PROJ);
    F.WI = (float*)(ws + WS_WI); F.SEL = (int*)(ws + WS_SEL); F.OATT = (bf16_t*)(ws + WS_OATT); F.OCONV = (bf16_t*)(ws + WS_OCONV);
    F.MERGED = (bf16_t*)(ws + WS_MERGED); F.T1 = (float*)(ws + WS_T1); F.H2 = (bf16_t*)(ws + WS_H2); F.QP = (bf16_t*)(ws + WS_QP);
    F.EIDX = (int*)(ws + WS_EIDX); F.GW = (float*)(ws + WS_GW);
    volatile LAS unsigned* misc = (volatile LAS unsigned*)(F.lds + LDS_MISC);
    if (F.tid < 16) misc[F.tid] = 0u;
    __syncthreads();
    XcdBarrier bar; bar.bar = (unsigned*)(ws + WS_CTL); bar.x = 0; bar.st = misc;
    const int lo = args.ph_lo, hi = args.ph_hi;
    if (hi - lo > 1) bar = xcd_barrier_post((unsigned*)(ws + WS_CTL), misc);
#define IN(k) (lo <= (k) && (k) < hi)
#define SEAM(k) do { if (IN(k) && IN((k) + 1)) xcd_barrier(bar); } while (0)
    if (IN(0)) p0_prologue(F);       SEAM(0);
    if (IN(1)) p1_modulate(F);       SEAM(1);
    if (IN(2)) p2_gemm_in(F);        SEAM(2);
    if (IN(3)) p3_index(F);          SEAM(3);
    if (IN(4)) p4_attention(F);      SEAM(4);
    if (IN(5)) p5_gemm_merge(F);     SEAM(5);
    if (IN(6)) p6_gemm_out(F);       SEAM(6);
    if (IN(7)) p7_ln1(F);            SEAM(7);
    if (IN(8)) p8_gemm_q(F);         SEAM(8);
    if (IN(9)) p9_route(F);          SEAM(9);
    if (IN(10)) p10_peer(F);
#undef IN
#undef SEAM
}

extern "C" void kernel_launch(void* const* d_in, const int* in_sizes, int n_in, void* d_out, int out_size, void* d_ws, size_t ws_size, hipStream_t stream) {
    static int grid = 0;
    if (grid == 0) {
        if (n_in != 27 || (size_t)out_size != O_END || ws_size < WS_END) { fprintf(stderr, "kernel_launch: unexpected shapes (n_in %d out %d ws %zu)\n", n_in, out_size, ws_size); grid = -1; return; }
        int dev = 0, cus = 0;
        if (hipGetDevice(&dev) != hipSuccess || hipDeviceGetAttribute(&cus, hipDeviceAttributeMultiprocessorCount, dev) != hipSuccess) { grid = -1; return; }
        if (hipFuncSetAttribute((const void*)fwd_kernel, hipFuncAttributeMaxDynamicSharedMemorySize, LDS_BYTES) != hipSuccess) { fprintf(stderr, "kernel_launch: hipFuncSetAttribute failed\n"); grid = -1; return; }
        (void)hipGetLastError();
        grid = cus;
    }
    if (grid < 0) return;
    (void)hipMemsetAsync((char*)d_ws + WS_CTL, 0, CTL_ZERO_BYTES, stream);
    Args a{};
    for (int i = 0; i < 27; ++i) a.in[i] = d_in[i];
    a.out = (float*)d_out; a.ws = (unsigned char*)d_ws;
#if N_LAUNCHES == 1
    a.ph_lo = 0; a.ph_hi = N_PHASES;
    hipLaunchKernelGGL(fwd_kernel, dim3(grid), dim3(NTHREADS), LDS_BYTES, stream, a);
#else
    for (int p = 0; p < N_PHASES; ++p) { a.ph_lo = p; a.ph_hi = p + 1; hipLaunchKernelGGL(fwd_kernel, dim3(grid), dim3(NTHREADS), LDS_BYTES, stream, a); }
#endif
}
```

```cpp
#include <hip/hip_runtime.h>
#include <cstdio>
#include <cstdint>

#ifndef N_LAUNCHES
#define N_LAUNCHES 1
#endif

typedef unsigned short bf16_t;
typedef short bf16x8 __attribute__((ext_vector_type(8)));
typedef float f32x4 __attribute__((ext_vector_type(4)));
typedef float f32x16 __attribute__((ext_vector_type(16)));
typedef unsigned u32x4 __attribute__((ext_vector_type(4)));
typedef unsigned u32x2 __attribute__((ext_vector_type(2)));
#define LAS __attribute__((address_space(3)))

constexpr int D = 1024, NB_P = 8, SEQ = 2048, NB_S = 32, TS = 8, PAST = 8192, PAGE = 128, NPAGES = 64;
constexpr int NTP = NB_P * SEQ;
constexpr int NTS = NB_S * TS;
constexpr int NT = NTP + NTS;
constexpr int NMIX = 4676, NMIXP = 4736;
constexpr int C_Q = 0, C_K = 512, C_V = 640, C_QI = 768, C_KI = 1024, C_BG = 1088, C_CG = 1600, C_XIN = 2112, C_GA = 2624, C_GB = 3648, C_WI = 4672;
constexpr int NSEL = 256;
constexpr float ATTN_SCALE = 0.125f, IDX_SCALE = 0.0625f;
constexpr float DN_ALPHA = 1.189207115002721f, LN_EPS = 1e-5f;
constexpr int NEXP_SEL = 128;

constexpr size_t O_YP = 0, O_YS = 16777216, O_KP = 17039360, O_VP = 19136512, O_KIP = 21233664, O_CP = 22282240,
                 O_KS = 22290432, O_VS = 22323200, O_KIS = 22355968, O_CS = 22372352, O_END = 22405120;

constexpr size_t MB = 1048576;
constexpr size_t WS_CTL = 0, WS_MOD = 1 * MB, WS_WIN = 2 * MB, WS_WOA = 12 * MB, WS_WOC = 13 * MB, WS_WOUT = 14 * MB, WS_WQ = 16 * MB,
                 WS_K1 = 18 * MB, WS_K2 = 18 * MB + 65536, WS_PU = 20 * MB, WS_PV = 52 * MB, WS_H1 = 84 * MB, WS_PROJ = 118 * MB,
                 WS_WI = 270 * MB, WS_SEL = 271 * MB, WS_OATT = 288 * MB, WS_OCONV = 305 * MB, WS_MERGED = 322 * MB, WS_T1 = 355 * MB,
                 WS_H2 = 420 * MB, WS_QP = 453 * MB, WS_EIDX = 486 * MB, WS_GW = 495 * MB, WS_SS = 504 * MB, WS_SE = 513 * MB, WS_SG = 523 * MB, WS_VT = 533 * MB, WS_CGX = 538 * MB, WS_END = 539 * MB;
constexpr size_t WS_PU8 = WS_PU, WS_PV8 = WS_PU + 16 * MB, WS_SU = WS_PV, WS_SV = WS_PV + 65536, WS_H8 = WS_PV + 1 * MB, WS_SH = WS_PV + 20 * MB;
constexpr int CTL_ZERO_BYTES = 65536;

constexpr int NTHREADS = 512;
constexpr int LDS_BYTES = 160 * 1024 - 512;
constexpr int LDS_MISC = LDS_BYTES - 64;

__device__ __forceinline__ float bf2f(bf16_t b) { return __uint_as_float(((unsigned)b) << 16); }
__device__ __forceinline__ float bflo(unsigned p) { return __uint_as_float(p << 16); }
__device__ __forceinline__ float bfhi(unsigned p) { return __uint_as_float(p & 0xFFFF0000u); }
typedef __bf16 bf16x2_t __attribute__((ext_vector_type(2)));
typedef float f32x2_t __attribute__((ext_vector_type(2)));
__device__ __forceinline__ unsigned cvt_pk_bf16(float lo, float hi) { const f32x2_t f = {lo, hi}; const bf16x2_t b = __builtin_convertvector(f, bf16x2_t); unsigned r; __builtin_memcpy(&r, &b, 4); return r; }
__device__ __forceinline__ bf16_t f2bf(float f) { return (bf16_t)(cvt_pk_bf16(f, 0.f) & 0xFFFFu); }
__device__ __forceinline__ float wave_sum(float v) {
#pragma unroll
    for (int o = 32; o >= 1; o >>= 1) v += __shfl_xor(v, o);
    return v;
}
__device__ __forceinline__ float wave_sum_dpp(float v) {
    int x;
    x = __builtin_amdgcn_update_dpp(0, __float_as_int(v), 0xB1, 0xF, 0xF, false);  v += __int_as_float(x);
    x = __builtin_amdgcn_update_dpp(0, __float_as_int(v), 0x4E, 0xF, 0xF, false);  v += __int_as_float(x);
    x = __builtin_amdgcn_update_dpp(0, __float_as_int(v), 0x141, 0xF, 0xF, false); v += __int_as_float(x);
    x = __builtin_amdgcn_update_dpp(0, __float_as_int(v), 0x140, 0xF, 0xF, false); v += __int_as_float(x);
    x = __builtin_amdgcn_update_dpp(0, __float_as_int(v), 0x142, 0xA, 0xF, false); v += __int_as_float(x);
    x = __builtin_amdgcn_update_dpp(0, __float_as_int(v), 0x143, 0xC, 0xF, false); v += __int_as_float(x);
    return __int_as_float(__builtin_amdgcn_readlane(__float_as_int(v), 63));
}
__device__ __forceinline__ float wave_max(float v) {
#pragma unroll
    for (int o = 32; o >= 1; o >>= 1) v = fmaxf(v, __shfl_xor(v, o));
    return v;
}
__device__ __forceinline__ float sigmoidf_(float x) { return 1.f / (1.f + __expf(-x)); }
__device__ __forceinline__ float gelu_tanh(float a) {
    const float z = 0.7978845608028654f * (a + 0.044715f * a * a * a);
    const float e = __expf(2.f * z);
    const float t = 1.f - 2.f * __builtin_amdgcn_rcpf(e + 1.f);
    return 0.5f * a * (1.f + t);
}
__device__ __forceinline__ unsigned f2ord(float f) { const unsigned u = __float_as_uint(f); return (u & 0x80000000u) ? ~u : (u | 0x80000000u); }
__device__ __forceinline__ int t5_bucket(int n) {
    if (n < 16) return n;
    int b = 16;
    b += (n >= 19) + (n >= 21) + (n >= 24) + (n >= 27) + (n >= 31) + (n >= 35) + (n >= 40) + (n >= 46) + (n >= 52) + (n >= 59) + (n >= 67) + (n >= 77) + (n >= 87) + (n >= 99) + (n >= 113);
    return b;
}

#define XB_TMO      128
#define XB_XCNT(j)  (256  + 64 * (j))
#define XB_XSUB(j)  (1280 + 64 * (j))
#define XB_XGEN(j)  (2304 + 64 * (j))
#define XB_TOP      3328
#define XB_TOPGEN   3392
#define XCD_BAR_WORDS 3456
#define XB_SPIN_CAP (1u << 18)
__device__ __forceinline__ unsigned xb_ld(unsigned* p)              { return __hip_atomic_load(p, __ATOMIC_RELAXED, __HIP_MEMORY_SCOPE_AGENT); }
__device__ __forceinline__ unsigned xb_add(unsigned* p, unsigned v) { return __hip_atomic_fetch_add(p, v, __ATOMIC_RELAXED, __HIP_MEMORY_SCOPE_AGENT); }
__device__ __forceinline__ unsigned xb_xcc_id() { return (unsigned)__builtin_amdgcn_s_getreg((3 << 11) | 20) & 0xFu; }
#define XB_SPIN(cond, bar) do { unsigned _sp = 0; while (cond) { __builtin_amdgcn_s_sleep(1); \
    if ((++_sp & 255u) == 0u) { if (xb_ld(&(bar)[XB_TMO])) break; if (_sp > XB_SPIN_CAP) { atomicAdd(&(bar)[XB_TMO], 1u); break; } } } } while (0)
struct XcdBarrier { unsigned* bar; unsigned x; volatile LAS unsigned* st; };
__device__ __forceinline__ XcdBarrier xcd_barrier_post(unsigned* bar, volatile LAS unsigned* st) {
    XcdBarrier b; b.bar = bar; b.x = xb_xcc_id(); b.st = st;
    if (threadIdx.x == 0) (void)xb_add(&bar[XB_XCNT(b.x)], 1u);
    return b;
}
__device__ __forceinline__ void xcd_barrier_complete(unsigned* bar, unsigned x, unsigned& nloc, unsigned& nx) {
    const unsigned G = gridDim.x * gridDim.y * gridDim.z;
    unsigned sum, cnt, mine, sp = 0u;
    for (;;) {
        sum = 0u; cnt = 0u; mine = 0u;
#pragma unroll
        for (unsigned j = 0; j < 16; ++j) { const unsigned c = xb_ld(&bar[XB_XCNT(j)]); sum += c; cnt += (c > 0u) ? 1u : 0u; mine = (j == x) ? c : mine; }
        if (sum == G) break;
        __builtin_amdgcn_s_sleep(1);
        if ((++sp & 255u) == 0u) { if (xb_ld(&bar[XB_TMO])) break; if (sp > XB_SPIN_CAP) { atomicAdd(&bar[XB_TMO], 1u); break; } }
    }
    nloc = mine > 0u ? mine : 1u; nx = cnt > 0u ? cnt : 1u;
}
__device__ __forceinline__ void xcd_barrier(const XcdBarrier& b) {
    asm volatile("s_waitcnt vmcnt(0)" ::: "memory");
    __syncthreads();
    if (threadIdx.x == 0) {
        unsigned* bar = b.bar;
        __builtin_amdgcn_s_waitcnt(0);
        unsigned nloc = b.st[0], nx = b.st[1];
        if (nloc == 0u) { xcd_barrier_complete(bar, b.x, nloc, nx); b.st[0] = nloc; b.st[1] = nx; }
        const unsigned old = xb_add(&bar[XB_XSUB(b.x)], 1u);
        const unsigned gen = old / nloc;
        if (old + 1u == (gen + 1u) * nloc) {
            __builtin_amdgcn_fence(__ATOMIC_RELEASE, "agent");
            asm volatile("s_waitcnt vmcnt(0)" ::: "memory");
            const unsigned og = xb_add(&bar[XB_TOP], 1u);
            const unsigned tg = og / nx;
            if (og + 1u == (tg + 1u) * nx) xb_add(&bar[XB_TOPGEN], 1u);
            else XB_SPIN(xb_ld(&bar[XB_TOPGEN]) == tg, bar);
            __builtin_amdgcn_fence(__ATOMIC_ACQUIRE, "agent");
            xb_add(&bar[XB_XGEN(b.x)], 1u);
            asm volatile("s_waitcnt vmcnt(0)" ::: "memory");
        } else {
            XB_SPIN(xb_ld(&bar[XB_XGEN(b.x)]) == gen, bar);
            __builtin_amdgcn_fence(__ATOMIC_ACQUIRE, "agent");
            asm volatile("s_waitcnt vmcnt(0)" ::: "memory");
        }
    }
    __syncthreads();
}

struct Args { const void* in[27]; float* out; unsigned char* ws; int ph_lo, ph_hi; };
struct Core { LAS unsigned char* lds; int tid, lane, wave, G, bid; };
struct Frame {
    LAS unsigned char* lds;
    int tid, lane, wave, G, bid;
    const float *x_p, *x_s, *c_p, *c_s, *cache_k, *cache_v, *cache_ki, *state_conv, *rel_bias, *w_ada, *b_ada, *w_in, *conv_w, *conv_b,
                *w_o_attn, *w_o_conv, *w_out, *ln1_g, *ln1_b, *ln2_g, *ln2_b, *peer_wq, *peer_k1, *peer_k2, *peer_u, *peer_v;
    const int* page_table;
    float* out; unsigned char* ws;
    float* MOD; bf16_t *WIN, *WOA, *WOC, *WOUT, *WQ, *K1, *K2, *PU, *PV, *H1, *PROJ, *OATT, *OCONV, *MERGED, *H2, *QP;
    float *WI, *T1, *GW; int *SEL, *EIDX;
};
constexpr int LDS_PTAB = LDS_BYTES - 512;
__device__ __forceinline__ unsigned char* ldptr(const Core& C, int k) {
    LAS const unsigned* p = (LAS const unsigned*)(C.lds + LDS_PTAB) + 2 * k;
    const unsigned lo = __builtin_amdgcn_readfirstlane(p[0]), hi = __builtin_amdgcn_readfirstlane(p[1]);
    return (unsigned char*)(((unsigned long long)hi << 32) | (unsigned long long)lo);
}
__device__ __forceinline__ void load_frame(Frame& F, const Core& C) {
    F.lds = C.lds; F.tid = C.tid; F.lane = C.lane; F.wave = C.wave; F.G = C.G; F.bid = C.bid;
    F.x_p = (const float*)ldptr(C, 0); F.x_s = (const float*)ldptr(C, 1); F.c_p = (const float*)ldptr(C, 2); F.c_s = (const float*)ldptr(C, 3);
    F.cache_k = (const float*)ldptr(C, 4); F.cache_v = (const float*)ldptr(C, 5); F.cache_ki = (const float*)ldptr(C, 6); F.state_conv = (const float*)ldptr(C, 7);
    F.page_table = (const int*)ldptr(C, 8); F.rel_bias = (const float*)ldptr(C, 9); F.w_ada = (const float*)ldptr(C, 10); F.b_ada = (const float*)ldptr(C, 11);
    F.w_in = (const float*)ldptr(C, 12); F.conv_w = (const float*)ldptr(C, 13); F.conv_b = (const float*)ldptr(C, 14); F.w_o_attn = (const float*)ldptr(C, 15);
    F.w_o_conv = (const float*)ldptr(C, 16); F.w_out = (const float*)ldptr(C, 17); F.ln1_g = (const float*)ldptr(C, 18); F.ln1_b = (const float*)ldptr(C, 19);
    F.ln2_g = (const float*)ldptr(C, 20); F.ln2_b = (const float*)ldptr(C, 21); F.peer_wq = (const float*)ldptr(C, 22); F.peer_k1 = (const float*)ldptr(C, 23);
    F.peer_k2 = (const float*)ldptr(C, 24); F.peer_u = (const float*)ldptr(C, 25); F.peer_v = (const float*)ldptr(C, 26);
    F.out = (float*)ldptr(C, 27);
    unsigned char* ws = ldptr(C, 28);
    F.MOD = (float*)(ws + WS_MOD); F.WIN = (bf16_t*)(ws + WS_WIN); F.WOA = (bf16_t*)(ws + WS_WOA); F.WOC = (bf16_t*)(ws + WS_WOC);
    F.WOUT = (bf16_t*)(ws + WS_WOUT); F.WQ = (bf16_t*)(ws + WS_WQ); F.K1 = (bf16_t*)(ws + WS_K1); F.K2 = (bf16_t*)(ws + WS_K2);
    F.PU = (bf16_t*)(ws + WS_PU); F.PV = (bf16_t*)(ws + WS_PV); F.H1 = (bf16_t*)(ws + WS_H1); F.PROJ = (bf16_t*)(ws + WS_PROJ);
    F.WI = (float*)(ws + WS_WI); F.SEL = (int*)(ws + WS_SEL); F.OATT = (bf16_t*)(ws + WS_OATT); F.OCONV = (bf16_t*)(ws + WS_OCONV);
    F.MERGED = (bf16_t*)(ws + WS_MERGED); F.T1 = (float*)(ws + WS_T1); F.H2 = (bf16_t*)(ws + WS_H2); F.QP = (bf16_t*)(ws + WS_QP);
    F.EIDX = (int*)(ws + WS_EIDX); F.GW = (float*)(ws + WS_GW);
}
__device__ __forceinline__ const float* x_row(const Frame& F, int m) { return m < NTP ? F.x_p + (size_t)m * D : F.x_s + (size_t)(m - NTP) * D; }
__device__ __forceinline__ int mod_row(int m) { return m < NTP ? (m >> 11) : NB_P + ((m - NTP) >> 3); }

constexpr int P0_MOD_ITEMS = 96;
constexpr int P0_T_WIN = 16 * 74, P0_T_WOA = 8 * 16, P0_T_WOC = 8 * 16, P0_T_WOUT = 16 * 16, P0_T_WQ = 16 * 16;
constexpr int P0_T_ITEMS = P0_T_WIN + P0_T_WOA + P0_T_WOC + P0_T_WOUT + P0_T_WQ;
constexpr int P0_CVT_ITEMS = 2 * (16384 * 1024 / 8192);
constexpr int P0_MISC_ITEMS = 1;
constexpr int P0_ITEMS = P0_MOD_ITEMS + P0_T_ITEMS + P0_CVT_ITEMS + P0_MISC_ITEMS;

__device__ __forceinline__ void p0_mod_item(const Frame& F, int ng) {
    LAS float* cs = (LAS float*)F.lds;
    LAS float* red = (LAS float*)(F.lds + 40 * 256 * 4);
    float acc[40];
#pragma unroll
    for (int r = 0; r < 40; ++r) acc[r] = 0.f;
    const int n = ng * 64 + F.lane;
    for (int kc = 0; kc < 4; ++kc) {
        __syncthreads();
#pragma unroll 1
        for (int hb = 0; hb < 2; ++hb) {
            float cv[10];
#pragma unroll
            for (int i = 0; i < 10; ++i) { const int e = F.tid + (hb * 10 + i) * NTHREADS; const int r = e >> 8, k = e & 255; cv[i] = (r < 8) ? F.c_p[r * D + kc * 256 + k] : F.c_s[(r - 8) * D + kc * 256 + k]; }
#pragma unroll
            for (int i = 0; i < 10; ++i) cs[F.tid + (hb * 10 + i) * NTHREADS] = cv[i];
        }
        __syncthreads();
        float wvv[32];
#pragma unroll
        for (int kk = 0; kk < 32; ++kk) wvv[kk] = F.w_ada[(size_t)(kc * 256 + F.wave * 32 + kk) * 6144 + n];
#pragma unroll
        for (int kk = 0; kk < 32; ++kk) {
            const int kl = F.wave * 32 + kk;
#pragma unroll
            for (int r = 0; r < 40; ++r) acc[r] += cs[r * 256 + kl] * wvv[kk];
        }
    }
#pragma unroll
    for (int r = 0; r < 40; ++r) red[(F.wave * 40 + r) * 64 + F.lane] = acc[r];
    __syncthreads();
    for (int e = F.tid; e < 40 * 64; e += NTHREADS) {
        const int r = e >> 6, l = e & 63; float s = F.b_ada[ng * 64 + l];
#pragma unroll
        for (int w = 0; w < 8; ++w) s += red[(w * 40 + r) * 64 + l];
        F.MOD[r * 6144 + ng * 64 + l] = s;
    }
    __syncthreads();
}
__device__ __forceinline__ void p0_transpose_tile(const Frame& F, const float* W, int N, int K, bf16_t* Wt, int kt, int nt, bool permute) {
    LAS bf16_t* tile = (LAS bf16_t*)F.lds;
    __syncthreads();
    { const int k = F.tid >> 3, c0 = (F.tid & 7) * 8;
#pragma unroll
      for (int j = 0; j < 8; ++j) { const int n = nt * 64 + c0 + j; const float v = (n < N) ? W[(size_t)(kt * 64 + k) * N + n] : 0.f; tile[k * 66 + c0 + j] = f2bf(v); } }
    __syncthreads();
    { const int nl = F.tid >> 3, k0 = (F.tid & 7) * 8; const int n = nt * 64 + nl;
      if (n < N) {
          int nd = n; if (permute) nd = (n < 1024) ? n : (n < 1028 ? C_WI + (n - 1024) : n - 4);
          unsigned p[4];
#pragma unroll
          for (int j = 0; j < 4; ++j) p[j] = (unsigned)tile[(k0 + 2 * j) * 66 + nl] | ((unsigned)tile[(k0 + 2 * j + 1) * 66 + nl] << 16);
          *(u32x4*)(Wt + (size_t)nd * K + kt * 64 + k0) = (u32x4){p[0], p[1], p[2], p[3]};
      } }
}
constexpr int P0_CVT32_ITEMS = 2 * (16384 / 32);
constexpr int P0_OTHER = P0_T_ITEMS + P0_CVT32_ITEMS + 1;
__device__ __forceinline__ void p0_other_item(const Frame& F, int i) {
    if (i < P0_T_ITEMS) {
        if (i < P0_T_WIN) { p0_transpose_tile(F, F.w_in, NMIX, D, F.WIN, i / 74, i % 74, true); return; }
        i -= P0_T_WIN;
        if (i < P0_T_WOA) { p0_transpose_tile(F, F.w_o_attn, D, 512, F.WOA, i / 16, i % 16, false); return; }
        i -= P0_T_WOA;
        if (i < P0_T_WOC) { p0_transpose_tile(F, F.w_o_conv, D, 512, F.WOC, i / 16, i % 16, false); return; }
        i -= P0_T_WOC;
        if (i < P0_T_WOUT) { p0_transpose_tile(F, F.w_out, D, D, F.WOUT, i / 16, i % 16, false); return; }
        i -= P0_T_WOUT;
        p0_transpose_tile(F, F.peer_wq, D, D, F.WQ, i / 16, i % 16, false); return;
    }
    i -= P0_T_ITEMS;
    if (i < P0_CVT32_ITEMS) {
        const float* src = (i < 512) ? F.peer_u : F.peer_v;
        unsigned char* dst = F.ws + ((i < 512) ? WS_PU8 : WS_PV8); float* sinv = (float*)(F.ws + ((i < 512) ? WS_SU : WS_SV));
        const int row0 = (i & 511) * 32 + F.wave * 4;
        f32x4 v[4][4];
#pragma unroll
        for (int rr = 0; rr < 4; ++rr)
#pragma unroll
            for (int q = 0; q < 4; ++q) v[rr][q] = *(const f32x4*)(src + (size_t)(row0 + rr) * D + F.lane * 16 + q * 4);
#pragma unroll
        for (int rr = 0; rr < 4; ++rr) {
            float am = 0.f;
#pragma unroll
            for (int q = 0; q < 4; ++q)
#pragma unroll
                for (int e = 0; e < 4; ++e) am = fmaxf(am, fabsf(v[rr][q][e]));
            am = wave_max(am);
            const float sc = am > 0.f ? 224.f / am : 1.f;
            unsigned wd[4];
#pragma unroll
            for (int q = 0; q < 4; ++q) { int t = 0; t = __builtin_amdgcn_cvt_pk_fp8_f32(v[rr][q][0] * sc, v[rr][q][1] * sc, t, false); t = __builtin_amdgcn_cvt_pk_fp8_f32(v[rr][q][2] * sc, v[rr][q][3] * sc, t, true); wd[q] = (unsigned)t; }
            *(u32x4*)(dst + (size_t)(row0 + rr) * D + F.lane * 16) = (u32x4){wd[0], wd[1], wd[2], wd[3]};
            if (F.lane == 0) sinv[row0 + rr] = am > 0.f ? am * (1.f / 224.f) : 1.f;
        }
        return;
    }
    for (int e = F.tid; e < (4864 - NMIX) * D; e += NTHREADS) F.WIN[(size_t)NMIX * D + e] = 0;
    for (int e = F.tid; e < 128 * 64; e += NTHREADS) { F.K1[e] = f2bf(F.peer_k1[e]); F.K2[e] = f2bf(F.peer_k2[e]); }
}
__device__ __forceinline__ void p0_prologue(const Frame& F) {
    constexpr int NMODWG = P0_MOD_ITEMS, HEAD = 8;
    if (F.G <= NMODWG) {
        for (int it = F.bid; it < P0_MOD_ITEMS + P0_OTHER; it += F.G) { if (it < P0_MOD_ITEMS) p0_mod_item(F, it); else p0_other_item(F, it - P0_MOD_ITEMS); }
        return;
    }
    const int nfree = F.G - NMODWG;
    int head_items = HEAD * nfree; if (head_items > P0_OTHER) head_items = P0_OTHER;
    if (F.bid < NMODWG) p0_mod_item(F, F.bid);
    else for (int j = F.bid - NMODWG; j < head_items; j += nfree) p0_other_item(F, j);
    for (int j = head_items + F.bid; j < P0_OTHER; j += F.G) p0_other_item(F, j);
}

__device__ __forceinline__ void p1_modulate(const Frame& F) {
    const int stride = F.G * 8;
    for (int m0 = F.bid * 8 + F.wave; m0 < NT; m0 += 2 * stride) {
        f32x4 xv[2][4], sv[2][4], hv[2][4];
#pragma unroll
        for (int rr = 0; rr < 2; ++rr) {
            const int m = (m0 + rr * stride < NT) ? m0 + rr * stride : m0;
            const float* xr = x_row(F, m); const float* mr = F.MOD + (size_t)mod_row(m) * 6144;
#pragma unroll
            for (int q = 0; q < 4; ++q) {
                const int e = (q >> 1) * 512 + F.lane * 8 + (q & 1) * 4;
                xv[rr][q] = *(const f32x4*)(xr + e); sv[rr][q] = *(const f32x4*)(mr + 1024 + e); hv[rr][q] = *(const f32x4*)(mr + e);
            }
        }
#pragma unroll
        for (int rr = 0; rr < 2; ++rr) {
            const int m = m0 + rr * stride;
            if (m >= NT) continue;
#pragma unroll
            for (int hlf = 0; hlf < 2; ++hlf) {
                const f32x4 a = xv[rr][2 * hlf] * (sv[rr][2 * hlf] + 1.f) + hv[rr][2 * hlf], b2 = xv[rr][2 * hlf + 1] * (sv[rr][2 * hlf + 1] + 1.f) + hv[rr][2 * hlf + 1];
                *(u32x4*)(F.H1 + (size_t)m * D + hlf * 512 + F.lane * 8) = (u32x4){cvt_pk_bf16(a[0], a[1]), cvt_pk_bf16(a[2], a[3]), cvt_pk_bf16(b2[0], b2[1]), cvt_pk_bf16(b2[2], b2[3])};
            }
        }
    }
}

constexpr int BM = 256, BN = 128, BK = 64;
constexpr int XPANEL = BM * 32 + 32, WPANEL = BN * 32 + 32;
constexpr int XSTAGE = 4 * XPANEL, WSTAGE = 4 * WPANEL, GSTAGE = XSTAGE + WSTAGE;
__device__ __forceinline__ void gemm_accum(const Frame& F, f32x16 (&acc)[2][2], const bf16_t* __restrict__ X, int ldx, const bf16_t* __restrict__ W, int ldw, int K, int m0, int n0) {
    const int tid = F.tid, lane = F.lane, r = lane & 31, h = lane >> 5, wm = F.wave >> 1, wn = F.wave & 1;
    u32x4 xr[4], wr[2];
    const int nk = K / BK;
    const int crow = tid >> 3, ckc = tid & 7;
    const bf16_t* xg = X + (size_t)(m0 + crow) * ldx + ckc * 8;
    const bf16_t* wg = W + (size_t)(n0 + crow) * ldw + ckc * 8;
    const int ldso = (ckc >> 1) * 1  ;
    const int xoff = ldso * XPANEL + crow * 32 + (ckc & 1) * 16;
    const int woff = ldso * WPANEL + crow * 32 + (ckc & 1) * 16;
#pragma unroll
    for (int i = 0; i < 4; ++i) xr[i] = *(const u32x4*)(xg + (size_t)(64 * i) * ldx);
#pragma unroll
    for (int i = 0; i < 2; ++i) wr[i] = *(const u32x4*)(wg + (size_t)(64 * i) * ldw);
    __syncthreads();
    for (int kt = 0; kt < nk; ++kt) {
        LAS unsigned char* st = F.lds + (kt & 1) * GSTAGE;
#pragma unroll
        for (int i = 0; i < 4; ++i) *(LAS u32x4*)(st + xoff + i * 64 * 32) = xr[i];
#pragma unroll
        for (int i = 0; i < 2; ++i) *(LAS u32x4*)(st + XSTAGE + woff + i * 64 * 32) = wr[i];
        __syncthreads();
        if (kt + 1 < nk) {
#pragma unroll
            for (int i = 0; i < 4; ++i) xr[i] = *(const u32x4*)(xg + (size_t)(64 * i) * ldx + (kt + 1) * BK);
#pragma unroll
            for (int i = 0; i < 2; ++i) wr[i] = *(const u32x4*)(wg + (size_t)(64 * i) * ldw + (kt + 1) * BK);
        }
#pragma unroll
        for (int s = 0; s < 4; ++s) {
            bf16x8 a[2], b[2];
#pragma unroll
            for (int ni = 0; ni < 2; ++ni) a[ni] = *(LAS bf16x8*)(st + XSTAGE + s * WPANEL + (wn * 64 + ni * 32 + r) * 32 + h * 16);
#pragma unroll
            for (int mi = 0; mi < 2; ++mi) b[mi] = *(LAS bf16x8*)(st + s * XPANEL + (wm * 64 + mi * 32 + r) * 32 + h * 16);
#pragma unroll
            for (int mi = 0; mi < 2; ++mi)
#pragma unroll
                for (int ni = 0; ni < 2; ++ni) acc[mi][ni] = __builtin_amdgcn_mfma_f32_32x32x16_bf16(a[ni], b[mi], acc[mi][ni], 0, 0, 0);
        }
    }
}
#define GEMM_EPI_LOOP(...) \
    { const int r_ = F.lane & 31, h_ = F.lane >> 5, wm_ = F.wave >> 1, wn_ = F.wave & 1; \
      _Pragma("unroll") for (int mi = 0; mi < 2; ++mi) _Pragma("unroll") for (int ni = 0; ni < 2; ++ni) _Pragma("unroll") for (int g = 0; g < 4; ++g) { \
          const int m = m0 + wm_ * 64 + mi * 32 + r_; const int n = n0 + wn_ * 64 + ni * 32 + 8 * g + 4 * h_; __VA_ARGS__ } }
#define ACC4(A) ((f32x4){A[mi][ni][4 * g], A[mi][ni][4 * g + 1], A[mi][ni][4 * g + 2], A[mi][ni][4 * g + 3]})
__device__ __forceinline__ void zero_acc(f32x16 (&acc)[2][2]) {
#pragma unroll
    for (int mi = 0; mi < 2; ++mi)
#pragma unroll
        for (int ni = 0; ni < 2; ++ni)
#pragma unroll
            for (int e = 0; e < 16; ++e) acc[mi][ni][e] = 0.f;
}
__device__ __forceinline__ u32x2 pk4(const f32x4 v) { return (u32x2){cvt_pk_bf16(v[0], v[1]), cvt_pk_bf16(v[2], v[3])}; }

__device__ __forceinline__ void gemm_slice8(const Frame& F, f32x16 (&sacc)[1][1], const bf16_t* __restrict__ X, int ldx, const bf16_t* __restrict__ W, int ldw, int K, int m0, int n0) {
    const int r = F.lane & 31, h = F.lane >> 5, wq = F.wave & 3, kh = F.wave >> 2;
    const bf16_t* wp = W + (size_t)(n0 + 32 * wq + r) * ldw + kh * (K / 2) + h * 8;
    const bf16_t* xp = X + (size_t)(m0 + (r & 7)) * ldx + kh * (K / 2) + h * 8;
    f32x16 c;
#pragma unroll
    for (int e = 0; e < 16; ++e) c[e] = 0.f;
#pragma unroll 1
    for (int k0 = 0; k0 < K / 2; k0 += 128) {
        bf16x8 a[8], b[8];
#pragma unroll
        for (int t = 0; t < 8; ++t) { a[t] = *(const bf16x8*)(wp + k0 + t * 16); b[t] = *(const bf16x8*)(xp + k0 + t * 16); }
#pragma unroll
        for (int t = 0; t < 8; ++t) c = __builtin_amdgcn_mfma_f32_32x32x16_bf16(a[t], b[t], c, 0, 0, 0);
    }
    LAS float* cb = (LAS float*)F.lds + wq * (16 * 64);
    __syncthreads();
    if (kh == 1) {
#pragma unroll
        for (int e = 0; e < 16; ++e) cb[e * 64 + F.lane] = c[e];
    }
    __syncthreads();
    if (kh == 0) {
#pragma unroll
        for (int e = 0; e < 16; ++e) c[e] += cb[e * 64 + F.lane];
    }
    sacc[0][0] = c;
}
#define SLICE_EPI_LOOP(...) \
    if (F.wave < 4 && (F.lane & 31) < 8) { const int h_ = F.lane >> 5, wq_ = F.wave & 3; constexpr int mi = 0, ni = 0; \
      _Pragma("unroll") for (int g = 0; g < 4; ++g) { const int m = m0 + (F.lane & 31); const int n = n0 + wq_ * 32 + 8 * g + 4 * h_; __VA_ARGS__ } }

namespace pg8 {
#define PG8_LAS __attribute__((address_space(3)))
typedef unsigned short bf16_t;
typedef short bf16x8 __attribute__((ext_vector_type(8)));
typedef float f32x4 __attribute__((ext_vector_type(4)));
typedef unsigned u32x4 __attribute__((ext_vector_type(4)));
constexpr int BM = 256, BK = 64, HALF = 128, HTB = HALF * BK * 2  , STAGE_BYTES = 8 * HTB, NXCD = 8, WGM = 8;

__host__ __device__ __forceinline__ int lds_byte(int r, int c) { const int st = (r >> 4) * 2 + (c >> 5), rr = r & 15, cc = c & 31, ob = rr * 64 + cc * 2; return st * 1024 + (ob ^ (((ob >> 9) & 1) << 5)); }
__host__ __device__ __forceinline__ void stage_rc(int b, int& R, int& C) { const int st = b / 1024, sb = b % 1024, swz = sb ^ (((sb >> 9) & 1) << 5); R = (st >> 1) * 16 + swz / 64; C = (st & 1) * 32 + (swz % 64) / 2; }
__host__ __device__ __forceinline__ int perm32(int rho) { const int n = rho >> 4, i = rho & 15; return 8 * (i >> 2) + 4 * n + (i & 3); }

struct Unit { int pm, pn; };
struct Gemm { const bf16_t* A; const bf16_t* Bt; int M, N, K; };

struct StaticOrder {
    int nM, nN, nwg, G, c;
    __host__ __device__ void init(int M, int N, int G_, int c_) { nM = M / BM; nN = N / BM; nwg = nM * nN; G = G_; c = c_; }
    __host__ __device__ bool next(int i, Unit& u) const {
        const long L = (long)i * G + c; if (L >= nwg) return false;
        int wgid = (int)L; { const int q = nwg / NXCD, r = nwg % NXCD, xcd = wgid % NXCD, off = wgid / NXCD; wgid = (xcd < r ? xcd * (q + 1) : r * (q + 1) + (xcd - r) * q) + off; }
        const int nig = WGM * nN, gid = wgid / nig, fm = gid * WGM, gsz = (nM - fm) < WGM ? (nM - fm) : WGM;
        u.pm = fm + ((wgid % nig) % gsz); u.pn = (wgid % nig) / gsz; return true;
    }
    __device__ __forceinline__ void a_ready(const Unit&) const {}
    __device__ __forceinline__ void done(const Unit&) const {}
};

template <class Body> struct EpiRC {
    static constexpr bool PERM = false, AFTER_DRAIN = false;
    Body body;
    __device__ __forceinline__ void operator()(const f32x4 (&acc)[2][2][4][2], const Unit& u, int wr, int wc, int fr, int fq) const {
#pragma unroll
        for (int ai = 0; ai < 2; ++ai)
#pragma unroll
            for (int m = 0; m < 4; ++m) {
                const int row = u.pm * BM + ai * HALF + wr * 64 + m * 16 + fr;
#pragma unroll
                for (int bj = 0; bj < 2; ++bj)
#pragma unroll
                    for (int n = 0; n < 2; ++n) body(row, u.pn * BM + bj * HALF + wc * 32 + n * 16 + 4 * fq, acc[ai][bj][m][n]);
            }
    }
};
template <class Epi, class Sched, bool ALIGN_EPI = false, bool SP2 = false>
__device__ __forceinline__ void gemm_phase(PG8_LAS unsigned char* lds, const Gemm g, const Sched& S, const Epi& E) {
    const int tid = threadIdx.x, wid = __builtin_amdgcn_readfirstlane(tid >> 6), lane = tid & 63, wr = wid >> 2, wc = wid & 3, fr = lane & 15, fq = lane >> 4;
    const int K = g.K, nt = K / BK;
    unsigned voffA[2], voffB[2];
#pragma unroll
    for (int i = 0; i < 2; ++i) { int R, C; stage_rc(tid * 16 + i * 8192, R, C); const int Rb = Epi::PERM ? ((R & ~31) + perm32(R & 31)) : R;
        voffA[i] = (unsigned)(R * K + C) * 2u; voffB[i] = (unsigned)(Rb * K + C) * 2u; }
    const size_t kstep = (size_t)(BK * 2);
    const size_t hstep = (size_t)HALF * K * 2;
    const size_t tstep = 2 * hstep;
    const unsigned ldsw = (unsigned)wid * 1024u;
    const int aoff = lds_byte(wr * 64 + fr, fq * 8), boff = lds_byte(wc * 32 + fr, fq * 8);
#define PG8_SA(b, h) (((b) * 2 + (h)) * HTB)
#define PG8_SB(b, h) ((4 + (b) * 2 + (h)) * HTB)
#define PG8_STAGE(bufoff, gbase, voff) do { _Pragma("unroll") for (int _i = 0; _i < 2; ++_i) \
        __builtin_amdgcn_global_load_lds((const unsigned*)((const char*)(gbase) + (voff)[_i]), (PG8_LAS unsigned*)(lds + (bufoff) + ldsw + _i * 8192), 16, 0, 0); } while (0)
#define PG8_LDA(dst, b, h) do { _Pragma("unroll") for (int m = 0; m < 4; ++m) _Pragma("unroll") for (int k = 0; k < 2; ++k) dst[m][k] = *(const PG8_LAS bf16x8*)(lds + PG8_SA(b, h) + aoff + m * 2048 + k * 1024); } while (0)
#define PG8_LDB(dst, b, h) do { _Pragma("unroll") for (int n = 0; n < 2; ++n) _Pragma("unroll") for (int k = 0; k < 2; ++k) dst[n][k] = *(const PG8_LAS bf16x8*)(lds + PG8_SB(b, h) + boff + n * 2048 + k * 1024); } while (0)
#define PG8_MMA(ai, bj, At, Bt) do { __builtin_amdgcn_s_setprio(1); _Pragma("unroll") for (int m = 0; m < 4; ++m) _Pragma("unroll") for (int n = 0; n < 2; ++n) _Pragma("unroll") for (int k = 0; k < 2; ++k) \
        acc[ai][bj][m][n] = __builtin_amdgcn_mfma_f32_16x16x32_bf16(Bt[n][k], At[m][k], acc[ai][bj][m][n], 0, 0, 0); __builtin_amdgcn_s_setprio(0); } while (0)
#define PG8_WAIT_V(n) asm volatile("s_waitcnt vmcnt(" #n ")" ::: "memory")
#define PG8_WAIT_L(n) asm volatile("s_waitcnt lgkmcnt(" #n ")" ::: "memory")
#define PG8_BAR __builtin_amdgcn_s_barrier()
#define PG8_SCHED __builtin_amdgcn_sched_barrier(0)
    Unit cur, nxt; int ui = 0;
    if (!S.next(0, cur)) return;
    f32x4 acc[2][2][4][2];
#pragma unroll
    for (int a = 0; a < 2; ++a)
#pragma unroll
        for (int b = 0; b < 2; ++b)
#pragma unroll
            for (int m = 0; m < 4; ++m)
#pragma unroll
                for (int n = 0; n < 2; ++n) acc[a][b][m][n] = (f32x4){0.f, 0.f, 0.f, 0.f};
    bf16x8 At[4][2], B0[2][2], B1[2][2];
    const char* cA = (const char*)g.A + (size_t)cur.pm * tstep; const char* cB = (const char*)g.Bt + (size_t)cur.pn * tstep;
    S.a_ready(cur);
    if constexpr (SP2) {
        PG8_STAGE(PG8_SB(0, 0), cB, voffB); PG8_STAGE(PG8_SB(0, 1), cB + hstep, voffB); PG8_STAGE(PG8_SA(0, 0), cA, voffA); PG8_STAGE(PG8_SA(0, 1), cA + hstep, voffA);
        if (wr == 1) PG8_BAR;
        PG8_WAIT_V(2); PG8_BAR;
        PG8_STAGE(PG8_SB(1, 0), cB + kstep, voffB); PG8_STAGE(PG8_SA(1, 0), cA + kstep, voffA); PG8_STAGE(PG8_SB(1, 1), cB + hstep + kstep, voffB);
        PG8_WAIT_V(6); PG8_BAR;
    } else {
        PG8_STAGE(PG8_SB(0, 0), cB, voffB); PG8_STAGE(PG8_SA(0, 0), cA, voffA); PG8_STAGE(PG8_SB(0, 1), cB + hstep, voffB); PG8_STAGE(PG8_SA(0, 1), cA + hstep, voffA);
        if (wr == 1) PG8_BAR;
        PG8_WAIT_V(4); PG8_BAR;
        PG8_STAGE(PG8_SB(1, 0), cB + kstep, voffB); PG8_STAGE(PG8_SA(1, 0), cA + kstep, voffA); PG8_STAGE(PG8_SB(1, 1), cB + hstep + kstep, voffB);
        PG8_WAIT_V(6); PG8_BAR;
    }
    for (;;) {
        const bool has_next = S.next(ui + 1, nxt);
        const char* nA = has_next ? (const char*)g.A + (size_t)nxt.pm * tstep : cA; const char* nB = has_next ? (const char*)g.Bt + (size_t)nxt.pn * tstep : cB;
        for (int t = 0; t < nt; t += 2) {
            const bool last = (t == nt - 2);
            const char* a1 = cA + (size_t)(t + 1) * kstep;
            const char* a2 = last ? nA : cA + (size_t)(t + 2) * kstep; const char* b2 = last ? nB : cB + (size_t)(t + 2) * kstep;
            const char* a3 = a2 + kstep; const char* b3 = b2 + kstep;
            if (last && has_next) S.a_ready(nxt);
            if constexpr (SP2) {
            PG8_LDB(B0, 0, 0); PG8_LDB(B1, 0, 1); PG8_SCHED; PG8_LDA(At, 0, 0); PG8_STAGE(PG8_SA(1, 1), a1 + hstep, voffA);
            PG8_WAIT_V(8); PG8_WAIT_L(0); PG8_BAR; PG8_MMA(0, 0, At, B0); PG8_MMA(0, 1, At, B1); PG8_BAR; PG8_SCHED;
            PG8_LDA(At, 0, 1); PG8_STAGE(PG8_SB(0, 0), b2, voffB); PG8_STAGE(PG8_SB(0, 1), b2 + hstep, voffB); PG8_STAGE(PG8_SA(0, 0), a2, voffA);
            PG8_WAIT_V(8); PG8_WAIT_L(0); PG8_BAR; PG8_MMA(1, 0, At, B0); PG8_MMA(1, 1, At, B1); PG8_BAR; PG8_SCHED;
            PG8_LDB(B0, 1, 0); PG8_LDB(B1, 1, 1); PG8_SCHED; PG8_LDA(At, 1, 0); PG8_STAGE(PG8_SA(0, 1), a2 + hstep, voffA);
            PG8_WAIT_V(8); PG8_WAIT_L(0); PG8_BAR; PG8_MMA(0, 0, At, B0); PG8_MMA(0, 1, At, B1); PG8_BAR; PG8_SCHED;
            PG8_LDA(At, 1, 1); PG8_STAGE(PG8_SB(1, 0), b3, voffB); PG8_STAGE(PG8_SB(1, 1), b3 + hstep, voffB); PG8_STAGE(PG8_SA(1, 0), a3, voffA);
            PG8_WAIT_V(8); PG8_WAIT_L(0); PG8_BAR; PG8_MMA(1, 0, At, B0); PG8_MMA(1, 1, At, B1); PG8_BAR; PG8_SCHED;
            } else {
            PG8_LDB(B0, 0, 0); PG8_SCHED; PG8_LDA(At, 0, 0); PG8_STAGE(PG8_SA(1, 1), a1 + hstep, voffA);
            PG8_WAIT_L(8); PG8_BAR; PG8_WAIT_L(0); PG8_MMA(0, 0, At, B0); PG8_BAR; PG8_SCHED;
            PG8_LDB(B1, 0, 1); PG8_STAGE(PG8_SB(0, 0), b2, voffB);
            PG8_BAR; PG8_WAIT_L(0); PG8_MMA(0, 1, At, B1); PG8_BAR;
            PG8_LDA(At, 0, 1); PG8_STAGE(PG8_SA(0, 0), a2, voffA);
            PG8_BAR; PG8_WAIT_L(0); PG8_MMA(1, 0, At, B0); PG8_BAR; PG8_SCHED;
            PG8_STAGE(PG8_SB(0, 1), b2 + hstep, voffB);
            PG8_WAIT_V(6); PG8_BAR; PG8_MMA(1, 1, At, B1); PG8_BAR;
            PG8_LDB(B0, 1, 0); PG8_SCHED; PG8_LDA(At, 1, 0); PG8_STAGE(PG8_SA(0, 1), a2 + hstep, voffA);
            PG8_WAIT_L(8); PG8_BAR; PG8_WAIT_L(0); PG8_MMA(0, 0, At, B0); PG8_BAR; PG8_SCHED;
            PG8_LDB(B1, 1, 1); PG8_STAGE(PG8_SB(1, 0), b3, voffB);
            PG8_BAR; PG8_WAIT_L(0); PG8_MMA(0, 1, At, B1); PG8_BAR;
            PG8_LDA(At, 1, 1); PG8_STAGE(PG8_SA(1, 0), a3, voffA);
            PG8_BAR; PG8_WAIT_L(0); PG8_MMA(1, 0, At, B0); PG8_BAR; PG8_SCHED;
            PG8_STAGE(PG8_SB(1, 1), b3 + hstep, voffB);
            PG8_WAIT_V(6); PG8_BAR; PG8_MMA(1, 1, At, B1); PG8_BAR;
            }
        }
        if constexpr (ALIGN_EPI) { if (wr == 0) PG8_BAR; }
        if constexpr (!Epi::AFTER_DRAIN) { E(acc, cur, wr, wc, fr, fq); S.done(cur); }
        if (!has_next) break;
#pragma unroll
        for (int a = 0; a < 2; ++a)
#pragma unroll
            for (int b = 0; b < 2; ++b)
#pragma unroll
                for (int m = 0; m < 4; ++m)
#pragma unroll
                    for (int n = 0; n < 2; ++n) acc[a][b][m][n] = (f32x4){0.f, 0.f, 0.f, 0.f};
        cur = nxt; cA = nA; cB = nB; ++ui;
        if constexpr (ALIGN_EPI) { if (wr == 1) PG8_BAR; }
    }
    PG8_WAIT_V(0);
    if constexpr (!ALIGN_EPI) { if (wr == 0) PG8_BAR; }
    PG8_BAR;
    if constexpr (Epi::AFTER_DRAIN) { E.fused(acc, cur, wr, wc, fr, fq, lds, wid, lane); S.done(cur); }
#undef PG8_SA
#undef PG8_SB
#undef PG8_STAGE
#undef PG8_LDA
#undef PG8_LDB
#undef PG8_MMA
#undef PG8_WAIT_V
#undef PG8_WAIT_L
#undef PG8_BAR
#undef PG8_SCHED
}
}

constexpr int NMIXW = 4864;
struct P2Body {
    const Frame* Fp;
    __device__ __forceinline__ void operator()(int m, int n, const f32x4 v) const {
        const Frame& F = *Fp;
        if (n >= NMIXP) return;
        *(u32x2*)(F.PROJ + (size_t)m * NMIXP + n) = pk4(v);
        if (n >= C_K && n < C_QI) {
            float* o = (n < C_V) ? (m < NTP ? F.out + O_KP + (size_t)m * 128 + (n - C_K) : F.out + O_KS + (size_t)(m - NTP) * 128 + (n - C_K))
                                 : (m < NTP ? F.out + O_VP + (size_t)m * 128 + (n - C_V) : F.out + O_VS + (size_t)(m - NTP) * 128 + (n - C_V));
            *(f32x4*)o = v;
            if (n >= C_V && m < NTP) {
                bf16_t* vt = (bf16_t*)(F.ws + WS_VT) + ((size_t)((m >> 11) * 2 + ((n - C_V) >> 6)) * 64 + ((n - C_V) & 63)) * SEQ + (m & 2047);
                vt[0] = f2bf(v[0]); vt[SEQ] = f2bf(v[1]); vt[2 * SEQ] = f2bf(v[2]); vt[3 * SEQ] = f2bf(v[3]);
            }
        } else if (n >= C_KI && n < C_BG) {
            float* o = m < NTP ? F.out + O_KIP + (size_t)m * 64 + (n - C_KI) : F.out + O_KIS + (size_t)(m - NTP) * 64 + (n - C_KI);
            *(f32x4*)o = v;
        } else if (n == C_WI) {
            *(f32x4*)(F.WI + (size_t)m * 4) = v;
        } else if (n >= C_CG && n < C_GA) {
            const int tt = (m < NTP) ? (m & 2047) - (SEQ - 2) : ((m - NTP) & 7) - (TS - 2);
            if (tt >= 0) {
                const int rowi = (m < NTP) ? (m >> 11) * 2 + tt : 2 * NB_P + ((m - NTP) >> 3) * 2 + tt;
                *(f32x4*)((float*)(F.ws + WS_CGX) + (size_t)rowi * 1024 + (n - C_CG)) = v;
            }
        }
    }
};
__device__ __forceinline__ void p2_gemm_in(const Frame& F) {
    pg8::Gemm g{F.H1, F.WIN, NT, NMIXW, D};
    pg8::StaticOrder S; S.init(NT, NMIXW, F.G, F.bid);
    pg8::EpiRC<P2Body> E{P2Body{&F}};
    pg8::gemm_phase<pg8::EpiRC<P2Body>, pg8::StaticOrder, true, true>(F.lds, g, S, E);
}

constexpr int SROW = 2052;
__device__ __forceinline__ int wave_sum_i(int v) {
#pragma unroll
    for (int o = 32; o >= 1; o >>= 1) v += __shfl_xor(v, o);
    return v;
}
__device__ __forceinline__ void cnt_ge(int& c, unsigned u, unsigned t) { asm("v_cmp_ge_u32_e32 vcc, %1, %2\n\tv_addc_co_u32_e32 %0, vcc, 0, %0, vcc" : "+v"(c) : "v"(u), "v"(t) : "vcc"); }
__device__ __forceinline__ void cnt_gt(int& c, unsigned u, unsigned t) { asm("v_cmp_gt_u32_e32 vcc, %1, %2\n\tv_addc_co_u32_e32 %0, vcc, 0, %0, vcc" : "+v"(c) : "v"(u), "v"(t) : "vcc"); }
__device__ __forceinline__ void cnt_eq(int& c, unsigned u, unsigned t) { asm("v_cmp_eq_u32_e32 vcc, %1, %2\n\tv_addc_co_u32_e32 %0, vcc, 0, %0, vcc" : "+v"(c) : "v"(u), "v"(t) : "vcc"); }
__device__ __forceinline__ void cnt_lt4(int& cl, unsigned u0, unsigned u1, unsigned u2, unsigned u3, unsigned t) {
    int d0, d1, d2, d3;
    asm("v_sub_u32 %1, %5, %9\n\tv_sub_u32 %2, %6, %9\n\tv_sub_u32 %3, %7, %9\n\tv_sub_u32 %4, %8, %9\n\t"
        "v_lshrrev_b32 %1, 31, %1\n\tv_lshrrev_b32 %2, 31, %2\n\tv_lshrrev_b32 %3, 31, %3\n\tv_lshrrev_b32 %4, 31, %4\n\t"
        "v_add3_u32 %0, %0, %1, %2\n\tv_add3_u32 %0, %0, %3, %4"
        : "+v"(cl), "=&v"(d0), "=&v"(d1), "=&v"(d2), "=&v"(d3) : "v"(u0), "v"(u1), "v"(u2), "v"(u3), "v"(t));
}
__device__ __forceinline__ void cnt_eq_pos(int& c, unsigned u, unsigned t, int L) {
    int tmp;
    asm("v_cmp_eq_u32_e32 vcc, %2, %3\n\tv_cndmask_b32_e32 %1, %5, %4, vcc\n\tv_cmp_lt_i32_e32 vcc, 0, %1\n\tv_addc_co_u32_e32 %0, vcc, 0, %0, vcc"
        : "+v"(c), "=&v"(tmp) : "v"(u), "v"(t), "v"(L), "v"(0x80000000) : "vcc");
}
__device__ __forceinline__ int wave_sum_i_dpp(int v) {
    v += __builtin_amdgcn_update_dpp(0, v, 0xB1, 0xF, 0xF, false);
    v += __builtin_amdgcn_update_dpp(0, v, 0x4E, 0xF, 0xF, false);
    v += __builtin_amdgcn_update_dpp(0, v, 0x141, 0xF, 0xF, false);
    v += __builtin_amdgcn_update_dpp(0, v, 0x140, 0xF, 0xF, false);
    v += __builtin_amdgcn_update_dpp(0, v, 0x142, 0xA, 0xF, false);
    v += __builtin_amdgcn_update_dpp(0, v, 0x143, 0xC, 0xF, false);
    return __builtin_amdgcn_readlane(v, 63);
}
template <int NV> __device__ __forceinline__ void select_threshold(const unsigned (&u)[NV], int ksel, int idx_bits, int lane, unsigned& T_out, int& Jx_out, int& ngt_out) {
    unsigned T = 0;
#pragma unroll 1
    for (int bit = 31; bit >= 0; --bit) {
        const unsigned cand = T | (1u << bit);
        int c = 0;
#pragma unroll
        for (int i = 0; i < NV; ++i) cnt_ge(c, u[i], cand);
        c = wave_sum_i_dpp(c);
        if (c >= ksel) T = cand;
    }
    int cg = 0, ce = 0;
#pragma unroll
    for (int i = 0; i < NV; ++i) { cnt_gt(cg, u[i], T); cnt_eq(ce, u[i], T); }
    const int ngt = wave_sum_i_dpp(cg), neq = wave_sum_i_dpp(ce);
    const int need = ksel - ngt;
    int Jx = 0x3FFFFFFF;
    if (need < neq) {
        int Jb = 0;
#pragma unroll 1
        for (int bit = idx_bits - 1; bit >= 0; --bit) {
            const int cand = Jb | (1 << bit);
            const int L = cand - lane;
            int c = 0;
#pragma unroll
            for (int i = 0; i < NV; ++i) cnt_eq_pos(c, u[i], T, L - 64 * i);
            c = wave_sum_i_dpp(c);
            if (c < need) Jb = cand;
        }
        Jx = Jb + 1;
    }
    T_out = T; Jx_out = Jx; ngt_out = ngt;
}
template <int NV> __device__ __forceinline__ void select_threshold2(const unsigned (&ua)[NV], const unsigned (&ub)[NV], int ksel, int idx_bits, int lane, int ng,
                                                                   unsigned& Ta_out, int& Jxa_out, unsigned& Tb_out, int& Jxb_out) {
    unsigned Ta = 0, Tb = 0;
    bool da = false, db = false;
#pragma unroll 1
    for (int bit = 30; bit >= 0 && !(da && db); --bit) {
        const unsigned ca = da ? Ta : (Ta | (1u << bit)), cb = db ? Tb : (Tb | (1u << bit));
        int la = 0, lb = 0;
#pragma unroll
        for (int i = 0; i < NV; i += 4) { if (i < 4 * ng) { cnt_lt4(la, ua[i], ua[i + 1], ua[i + 2], ua[i + 3], ca); cnt_lt4(lb, ub[i], ub[i + 1], ub[i + 2], ub[i + 3], cb); } }
        const int na = ng * 256 - wave_sum_i_dpp(la), nb = ng * 256 - wave_sum_i_dpp(lb);
        if (!da && na >= ksel) { Ta = ca; da = (na == ksel); }
        if (!db && nb >= ksel) { Tb = cb; db = (nb == ksel); }
    }
    int ga = 0, ea = 0, gb = 0, eb = 0;
#pragma unroll
    for (int i = 0; i < NV; ++i) { cnt_gt(ga, ua[i], Ta); cnt_eq(ea, ua[i], Ta); cnt_gt(gb, ub[i], Tb); cnt_eq(eb, ub[i], Tb); }
    const int needa = ksel - wave_sum_i_dpp(ga), neqa = wave_sum_i_dpp(ea), needb = ksel - wave_sum_i_dpp(gb), neqb = wave_sum_i_dpp(eb);
    int Jxa = 0x3FFFFFFF, Jxb = 0x3FFFFFFF;
    if (needa < neqa) {
        int Jb = 0;
#pragma unroll 1
        for (int bit = idx_bits - 1; bit >= 0; --bit) {
            const int cand = Jb | (1 << bit); const int L = cand - lane; int c = 0;
#pragma unroll
            for (int i = 0; i < NV; ++i) cnt_eq_pos(c, ua[i], Ta, L - 64 * i);
            if (wave_sum_i_dpp(c) < needa) Jb = cand;
        }
        Jxa = Jb + 1;
    }
    if (needb < neqb) {
        int Jb = 0;
#pragma unroll 1
        for (int bit = idx_bits - 1; bit >= 0; --bit) {
            const int cand = Jb | (1 << bit); const int L = cand - lane; int c = 0;
#pragma unroll
            for (int i = 0; i < NV; ++i) cnt_eq_pos(c, ub[i], Tb, L - 64 * i);
            if (wave_sum_i_dpp(c) < needb) Jb = cand;
        }
        Jxb = Jb + 1;
    }
    Ta_out = Ta; Jxa_out = Jxa; Tb_out = Tb; Jxb_out = Jxb;
}
template <int NV> __device__ __forceinline__ void select_topk(const unsigned (&u)[NV], int ksel, int idx_bits, int* sel, int lane) {
    unsigned T; int Jx, ngt;
    select_threshold<NV>(u, ksel, idx_bits, lane, T, Jx, ngt);
    const int L = Jx - lane;
    int cg = 0, ct = 0;
#pragma unroll
    for (int i = 0; i < NV; ++i) { cnt_gt(cg, u[i], T); cnt_eq_pos(ct, u[i], T, L - 64 * i); }
    int ig = cg, it = ct;
#pragma unroll
    for (int o = 1; o < 64; o <<= 1) { const int a = __shfl_up(ig, o), b2 = __shfl_up(it, o); if (lane >= o) { ig += a; it += b2; } }
    int pg = ig - cg, pt = ngt + it - ct;
    int ev = lane, Lr = L;
#pragma unroll
    for (int i = 0; i < NV; ++i) {
        if (u[i] > T) { sel[pg] = ev; ++pg; }
        else if (u[i] == T && Lr > 0) { sel[pt] = ev; ++pt; }
        asm volatile("v_add_u32 %0, 64, %0\n\tv_add_u32 %1, -64, %1" : "+v"(ev), "+v"(Lr));
    }
}

constexpr int PU_MB = 16 * SROW * 4;
constexpr int PU_RB = PU_MB + 16 * 64 * 4;
constexpr int PU_BT = PU_RB + 1024;
constexpr int PU_QT = PU_BT + 512, PU_QROW = 1040;
__device__ __forceinline__ int kappa32(int r) { return (r & 0x13) | ((r & 4) << 1) | ((r & 8) >> 1); }
__device__ __forceinline__ void p3_prompt_fused_unit(const Frame& F, const bf16_t* VT, int b, int qt) {
    LAS float* S = (LAS float*)F.lds;
    LAS unsigned* MB = (LAS unsigned*)(F.lds + PU_MB);
    LAS float* RB = (LAS float*)(F.lds + PU_RB);
    LAS int* BT = (LAS int*)(F.lds + PU_BT);
    const int lane = F.lane;
    const int q0 = qt * 16; const size_t tok0 = (size_t)b * SEQ;
    __syncthreads();
    for (int ch = F.tid; ch < 16 * 64; ch += NTHREADS) {
        const u32x4 qv = *(const u32x4*)(F.PROJ + (tok0 + q0 + (ch >> 6)) * NMIXP + C_Q + (ch & 63) * 8);
        constexpr float QS = ATTN_SCALE * 1.4426950408889634f;
        *(LAS u32x4*)(F.lds + PU_QT + (ch >> 6) * PU_QROW + (ch & 63) * 16) = (u32x4){cvt_pk_bf16(bflo(qv[0]) * QS, bfhi(qv[0]) * QS), cvt_pk_bf16(bflo(qv[1]) * QS, bfhi(qv[1]) * QS),
                                                                                    cvt_pk_bf16(bflo(qv[2]) * QS, bfhi(qv[2]) * QS), cvt_pk_bf16(bflo(qv[3]) * QS, bfhi(qv[3]) * QS)};
    }
    {
        const int r = lane & 15, q4 = lane >> 4;
        bf16x8 A[4][2];
#pragma unroll
        for (int hh = 0; hh < 4; ++hh)
#pragma unroll
            for (int s2 = 0; s2 < 2; ++s2) A[hh][s2] = *(const bf16x8*)(F.PROJ + (tok0 + q0 + r) * NMIXP + C_QI + hh * 64 + s2 * 32 + q4 * 8);
        float wv[4][4];
#pragma unroll
        for (int g = 0; g < 4; ++g) { const f32x4 w4 = *(const f32x4*)(F.WI + (tok0 + q0 + 4 * q4 + g) * 4);
#pragma unroll
            for (int hh = 0; hh < 4; ++hh) wv[g][hh] = w4[hh] * IDX_SCALE; }
        const int nkt = qt + 1;
        bf16x8 Bn[2][2];
        {
            const int t0 = 2 * F.wave;
#pragma unroll
            for (int p = 0; p < 2; ++p)
#pragma unroll
                for (int s2 = 0; s2 < 2; ++s2) { const int key = (t0 + p < nkt ? t0 + p : 0) * 16 + r; Bn[p][s2] = *(const bf16x8*)(F.PROJ + (tok0 + key) * NMIXP + C_KI + s2 * 32 + q4 * 8); }
        }
#pragma unroll 1
        for (int t0 = 2 * F.wave; t0 < nkt; t0 += 16) {
            bf16x8 B[2][2] = {{Bn[0][0], Bn[0][1]}, {Bn[1][0], Bn[1][1]}};
            {
                const int tn = t0 + 16;
#pragma unroll
                for (int p = 0; p < 2; ++p)
#pragma unroll
                    for (int s2 = 0; s2 < 2; ++s2) { const int key = (tn + p < nkt ? tn + p : 0) * 16 + r; Bn[p][s2] = *(const bf16x8*)(F.PROJ + (tok0 + key) * NMIXP + C_KI + s2 * 32 + q4 * 8); }
            }
#pragma unroll
            for (int p = 0; p < 2; ++p) {
                if (t0 + p >= nkt) continue;
                float sc[4] = {0.f, 0.f, 0.f, 0.f};
#pragma unroll
                for (int hh = 0; hh < 4; ++hh) {
                    f32x4 c = {0.f, 0.f, 0.f, 0.f};
                    c = __builtin_amdgcn_mfma_f32_16x16x32_bf16(A[hh][0], B[p][0], c, 0, 0, 0);
                    c = __builtin_amdgcn_mfma_f32_16x16x32_bf16(A[hh][1], B[p][1], c, 0, 0, 0);
#pragma unroll
                    for (int g = 0; g < 4; ++g) sc[g] += fmaxf(c[g], 0.f) * wv[g][hh];
                }
#pragma unroll
                for (int g = 0; g < 4; ++g) S[(4 * q4 + g) * SROW + (t0 + p) * 16 + r] = sc[g];
            }
        }
    }
    __syncthreads();
    {
        const int rowa = F.wave * 2, rowb = rowa + 1;
        const int nva = q0 + rowa + 1, nvb = nva + 1;
        if (nvb <= NSEL) {
#pragma unroll
            for (int i = 0; i < 32; ++i) {
                const unsigned long long ma = __ballot(lane + 64 * i < nva), mb = __ballot(lane + 64 * i < nvb);
                if (lane == 0) { MB[rowa * 64 + 2 * i] = (unsigned)ma; MB[rowa * 64 + 2 * i + 1] = (unsigned)(ma >> 32); MB[rowb * 64 + 2 * i] = (unsigned)mb; MB[rowb * 64 + 2 * i + 1] = (unsigned)(mb >> 32); }
            }
        } else {
            unsigned ua[32], ub[32];
#pragma unroll
            for (int i = 0; i < 32; ++i) { const int j = lane + 64 * i; ua[i] = (j < nva) ? (f2ord(S[rowa * SROW + j]) >> 1) : 0u; ub[i] = (j < nvb) ? (f2ord(S[rowb * SROW + j]) >> 1) : 0u; }
            unsigned Ta, Tb; int Jxa, Jxb;
            select_threshold2<32>(ua, ub, NSEL, 11, lane, (nvb + 255) >> 8, Ta, Jxa, Tb, Jxb);
            const int La = Jxa - lane, Lb = Jxb - lane;
#pragma unroll
            for (int i = 0; i < 32; ++i) {
                const bool ta = (ua[i] > Ta) || (ua[i] == Ta && (La - 64 * i) > 0), tb = (ub[i] > Tb) || (ub[i] == Tb && (Lb - 64 * i) > 0);
                const unsigned long long ma = __ballot(ta), mb = __ballot(tb);
                if (lane == 0) { MB[rowa * 64 + 2 * i] = (unsigned)ma; MB[rowa * 64 + 2 * i + 1] = (unsigned)(ma >> 32); MB[rowb * 64 + 2 * i] = (unsigned)mb; MB[rowb * 64 + 2 * i + 1] = (unsigned)(mb >> 32); }
            }
        }
    }
    __syncthreads();
    {
        const int g = F.wave & 1, kq = F.wave >> 1;
        const int c = lane & 31, h = lane >> 5;
        const int hd = g * 4 + (c & 3);
        LAS const unsigned char* Qb = F.lds + PU_QT + (c >> 2) * PU_QROW + (hd * 64 + h * 8) * 2;
        constexpr float L2E = 1.4426950408889634f;
        const float b31 = RB[31 * 8 + hd] * L2E;
        const int ntile = ((q0 + 15) >> 5) + 1;
        const bf16_t* Kb = F.PROJ + (tok0 + kappa32(c)) * NMIXP + C_K + g * 64 + h * 8;
        const bf16_t* Vb = VT + ((size_t)((b * 2 + g) * 64 + c)) * SEQ + h * 8;
        f32x16 O[2][2];
#pragma unroll
        for (int rt = 0; rt < 2; ++rt)
#pragma unroll
            for (int d = 0; d < 2; ++d)
#pragma unroll
                for (int e = 0; e < 16; ++e) O[rt][d][e] = 0.f;
        float lsum[2] = {0.f, 0.f};
        bf16x8 Kn[4];
        {
            const int key0 = (kq < ntile ? kq : 0) * 32;
#pragma unroll
            for (int s4 = 0; s4 < 4; ++s4) Kn[s4] = *(const bf16x8*)(Kb + (size_t)key0 * NMIXP + s4 * 16);
        }
#pragma unroll 1
        for (int kt = kq; kt < ntile; kt += 4) {
            const int key0 = kt * 32;
            bf16x8 Kf[4] = {Kn[0], Kn[1], Kn[2], Kn[3]}, Vf[2][2];
#pragma unroll
            for (int d = 0; d < 2; ++d)
#pragma unroll
                for (int s2 = 0; s2 < 2; ++s2) Vf[d][s2] = *(const bf16x8*)(Vb + (size_t)(32 * d) * SEQ + key0 + 16 * s2);
            {
                const int keyn = (kt + 4 < ntile ? kt + 4 : 0) * 32;
#pragma unroll
                for (int s4 = 0; s4 < 4; ++s4) Kn[s4] = *(const bf16x8*)(Kb + (size_t)keyn * NMIXP + s4 * 16);
            }
#pragma unroll
            for (int rt = 0; rt < 2; ++rt) {
                const int ql = rt * 8 + (c >> 2), q = q0 + ql;
                f32x16 X;
#pragma unroll
                for (int e = 0; e < 16; ++e) X[e] = 0.f;
#pragma unroll
                for (int s4 = 0; s4 < 4; ++s4) X = __builtin_amdgcn_mfma_f32_32x32x16_bf16(Kf[s4], *(LAS const bf16x8*)(Qb + rt * 8 * PU_QROW + s4 * 32), X, 0, 0, 0);
                const unsigned word = MB[ql * 64 + kt];
                const unsigned bits = ((word >> (8 * h)) & 0xFFu) | (((word >> (16 + 8 * h)) & 0xFFu) << 8);
                const bool nearT = (q0 + rt * 8) - (key0 + 31) < 113;
#pragma unroll
                for (int s2 = 0; s2 < 2; ++s2) {
                    float P[8];
                    if (nearT) {
#pragma unroll
                        for (int e8 = 0; e8 < 8; ++e8) {
                            const int e = 8 * s2 + e8;
                            const int key = key0 + e8 + 16 * s2 + 8 * h;
                            int dist = q - key; dist = dist < 0 ? 0 : (dist > 127 ? 127 : dist);
                            const float bias = RB[BT[dist] * 8 + hd] * L2E;
                            const float lg = fminf(X[e] + bias, 86.f);
                            P[e8] = __int_as_float(__float_as_int(__builtin_amdgcn_exp2f(lg)) & __builtin_amdgcn_sbfe((int)bits, e, 1));
                        }
                    } else {
#pragma unroll
                        for (int e8 = 0; e8 < 8; ++e8) {
                            const int e = 8 * s2 + e8;
                            const float lg = fminf(X[e] + b31, 86.f);
                            P[e8] = __int_as_float(__float_as_int(__builtin_amdgcn_exp2f(lg)) & __builtin_amdgcn_sbfe((int)bits, e, 1));
                        }
                    }
#pragma unroll
                    for (int e8 = 0; e8 < 8; ++e8) lsum[rt] += P[e8];
                    const u32x4 pk = (u32x4){cvt_pk_bf16(P[0], P[1]), cvt_pk_bf16(P[2], P[3]), cvt_pk_bf16(P[4], P[5]), cvt_pk_bf16(P[6], P[7])};
                    bf16x8 Pf; __builtin_memcpy(&Pf, &pk, 16);
                    O[rt][0] = __builtin_amdgcn_mfma_f32_32x32x16_bf16(Vf[0][s2], Pf, O[rt][0], 0, 0, 0);
                    O[rt][1] = __builtin_amdgcn_mfma_f32_32x32x16_bf16(Vf[1][s2], Pf, O[rt][1], 0, 0, 0);
                }
                __builtin_amdgcn_sched_barrier(0);
            }
        }
        LAS float* CB = (LAS float*)F.lds + (g * 3 + (kq > 0 ? kq - 1 : 0)) * (66 * 64);
        __syncthreads();
        if (kq > 0) {
#pragma unroll
            for (int rt = 0; rt < 2; ++rt) {
#pragma unroll
                for (int d = 0; d < 2; ++d)
#pragma unroll
                    for (int e = 0; e < 16; ++e) CB[((rt * 2 + d) * 16 + e) * 64 + lane] = O[rt][d][e];
                CB[(64 + rt) * 64 + lane] = lsum[rt];
            }
        }
        __syncthreads();
        if (kq == 0) {
#pragma unroll 1
            for (int p = 0; p < 3; ++p) {
                LAS const float* CP = (LAS const float*)F.lds + (g * 3 + p) * (66 * 64);
#pragma unroll
                for (int rt = 0; rt < 2; ++rt) {
#pragma unroll
                    for (int d = 0; d < 2; ++d)
#pragma unroll
                        for (int e = 0; e < 16; ++e) O[rt][d][e] += CP[((rt * 2 + d) * 16 + e) * 64 + lane];
                    lsum[rt] += CP[(64 + rt) * 64 + lane];
                }
            }
#pragma unroll
            for (int rt = 0; rt < 2; ++rt) {
                float l = lsum[rt]; l += __shfl_xor(l, 32);
                const float inv = 1.f / l;
                bf16_t* orow = F.OATT + (tok0 + q0 + rt * 8 + (c >> 2)) * 512 + hd * 64;
#pragma unroll
                for (int a4 = 0; a4 < 4; ++a4) {
                    const f32x4 v0 = (f32x4){O[rt][0][4 * a4], O[rt][0][4 * a4 + 1], O[rt][0][4 * a4 + 2], O[rt][0][4 * a4 + 3]} * inv;
                    const f32x4 v1 = (f32x4){O[rt][1][4 * a4], O[rt][1][4 * a4 + 1], O[rt][1][4 * a4 + 2], O[rt][1][4 * a4 + 3]} * inv;
                    *(u32x2*)(orow + 8 * a4 + 4 * h) = pk4(v0);
                    *(u32x2*)(orow + 32 + 8 * a4 + 4 * h) = pk4(v1);
                }
            }
        }
    }
}

__device__ __forceinline__ void p3_sample_score_unit(const Frame& F, float* SS, int b, int ch) {
    const int lane = F.lane, r = lane & 31, h = lane >> 5;
    bf16x8 A[4];
    { const int q = r >> 2, hh = r & 3;
#pragma unroll
      for (int s4 = 0; s4 < 4; ++s4) A[s4] = *(const bf16x8*)(F.PROJ + (size_t)(NTP + b * TS + q) * NMIXP + C_QI + hh * 64 + s4 * 16 + h * 8); }
    float wv[4][4];
#pragma unroll
    for (int g = 0; g < 4; ++g) { const f32x4 w4 = *(const f32x4*)(F.WI + (size_t)(NTP + b * TS + 2 * g + h) * 4);
#pragma unroll
        for (int hh = 0; hh < 4; ++hh) wv[g][hh] = w4[hh] * IDX_SCALE; }
    f32x4 kn[8];
    { const int key0 = ch * 1024 + F.wave * 32; const int page = F.page_table[b * NPAGES + (key0 >> 7)];
      const float* kr = F.cache_ki + ((size_t)page * PAGE + (key0 & 127) + r) * 64 + h * 8;
#pragma unroll
      for (int s4 = 0; s4 < 4; ++s4) { kn[2 * s4] = *(const f32x4*)(kr + s4 * 16); kn[2 * s4 + 1] = *(const f32x4*)(kr + s4 * 16 + 4); } }
#pragma unroll 1
    for (int tl = F.wave; tl < 32; tl += 8) {
        const int key0 = ch * 1024 + tl * 32;
        f32x4 kc[8];
#pragma unroll
        for (int i = 0; i < 8; ++i) kc[i] = kn[i];
        if (tl + 8 < 32) {
            const int keyn = key0 + 256; const int page = F.page_table[b * NPAGES + (keyn >> 7)];
            const float* kr = F.cache_ki + ((size_t)page * PAGE + (keyn & 127) + r) * 64 + h * 8;
#pragma unroll
            for (int s4 = 0; s4 < 4; ++s4) { kn[2 * s4] = *(const f32x4*)(kr + s4 * 16); kn[2 * s4 + 1] = *(const f32x4*)(kr + s4 * 16 + 4); }
        }
        f32x16 c;
#pragma unroll
        for (int e = 0; e < 16; ++e) c[e] = 0.f;
#pragma unroll
        for (int s4 = 0; s4 < 4; ++s4) {
            const f32x4 lo = kc[2 * s4], hi = kc[2 * s4 + 1];
            const u32x4 pk = (u32x4){cvt_pk_bf16(lo[0], lo[1]), cvt_pk_bf16(lo[2], lo[3]), cvt_pk_bf16(hi[0], hi[1]), cvt_pk_bf16(hi[2], hi[3])};
            bf16x8 Bf; __builtin_memcpy(&Bf, &pk, 16);
            c = __builtin_amdgcn_mfma_f32_32x32x16_bf16(A[s4], Bf, c, 0, 0, 0);
        }
#pragma unroll
        for (int g = 0; g < 4; ++g) {
            float sc = 0.f;
#pragma unroll
            for (int hh = 0; hh < 4; ++hh) sc += fmaxf(c[4 * g + hh], 0.f) * wv[g][hh];
            SS[(size_t)(b * TS + 2 * g + h) * PAST + key0 + r] = sc;
        }
    }
}
__device__ __forceinline__ void p3_index(const Frame& F) {
    constexpr int NSU = NB_S * 8;
    const int nunits = NSU + NB_P * (SEQ / 16);
    float* SS = (float*)(F.ws + WS_SS);
    const bf16_t* VT = (const bf16_t*)(F.ws + WS_VT);
    __syncthreads();
    if (F.tid < 256) ((LAS float*)(F.lds + PU_RB))[F.tid] = F.rel_bias[F.tid];
    if (F.tid < 128) ((LAS int*)(F.lds + PU_BT))[F.tid] = t5_bucket(F.tid);
    __syncthreads();
    for (int it = F.bid; it < nunits; it += F.G) {
        if (it < NSU) { p3_sample_score_unit(F, SS, it >> 3, it & 7); continue; }
        const int i = it - NSU; const int b = i & 7, sl = (i >> 3) & 31, rnd = i >> 8;
        const int qt = rnd == 0 ? 127 - sl : (rnd == 1 ? 64 + sl : (rnd == 2 ? 63 - sl : sl));
        p3_prompt_fused_unit(F, VT, b, qt);
    }
}

constexpr int SQ_CNT = 0;
constexpr int SQ_SEL = 1024;
constexpr int SQ_Q = 2048;
constexpr int SQ_P = 4096;
constexpr int SQ_RB = 16384;
constexpr int SQ_BT = 17408;
__device__ __forceinline__ int wg_sum8(const Frame& F, LAS unsigned* slot, int v) {
    if (F.lane == 0) slot[F.wave] = (unsigned)v;
    __syncthreads();
    int t = 0;
#pragma unroll
    for (int w = 0; w < 8; ++w) t += (int)slot[w];
    return t;
}
__device__ __forceinline__ void p4_sample_query_unit(const Frame& F, const float* SS, int b, int t) {
    const int lane = F.lane, w = F.wave;
    LAS unsigned* CNT = (LAS unsigned*)(F.lds + SQ_CNT);
    LAS int* SELL = (LAS int*)(F.lds + SQ_SEL);
    LAS unsigned* QL = (LAS unsigned*)(F.lds + SQ_Q);
    LAS float* PL = (LAS float*)(F.lds + SQ_P) + w * 256;
    LAS float* RB = (LAS float*)(F.lds + SQ_RB);
    LAS int* BT = (LAS int*)(F.lds + SQ_BT);
    const int tok = NTP + b * TS + t;
    __syncthreads();
    if (F.tid < 256) QL[F.tid] = ((const unsigned*)(F.PROJ + (size_t)tok * NMIXP + C_Q))[F.tid];
    unsigned u[17];
    { const float* srow = SS + (size_t)(b * TS + t) * PAST + w * 1024;
#pragma unroll
      for (int i = 0; i < 16; ++i) u[i] = f2ord(srow[64 * i + lane]); }
    u[16] = 0u;
    if (w == 7) {
        float sc = 0.f;
        if (lane < TS) {
            const bf16_t* kn = F.PROJ + (size_t)(NTP + b * TS + lane) * NMIXP + C_KI;
            const bf16_t* qn = F.PROJ + (size_t)tok * NMIXP + C_QI;
            int vz; asm volatile("v_mov_b32 %0, 0" : "=v"(vz));
            const f32x4 w4 = *(const f32x4*)(F.WI + (size_t)tok * 4 + vz);
#pragma unroll 1
            for (int hh = 0; hh < 4; ++hh) {
                float d = 0.f;
#pragma unroll 8
                for (int e = 0; e < 64; ++e) d += bf2f(qn[hh * 64 + e]) * bf2f(kn[e]);
                sc += fmaxf(d, 0.f) * (w4[hh] * IDX_SCALE);
            }
        }
        u[16] = (lane < TS && lane <= t) ? f2ord(sc) : 0u;
    }
    unsigned T = 0;
#pragma unroll 1
    for (int bit = 31; bit >= 0; --bit) {
        const unsigned cand = T | (1u << bit);
        int c = 0;
#pragma unroll
        for (int i = 0; i < 17; ++i) cnt_ge(c, u[i], cand);
        c = wg_sum8(F, CNT + (bit & 1) * 24, wave_sum_i_dpp(c));
        if (c >= NSEL) T = cand;
        if (c == NSEL) break;
    }
    int cg = 0, ce = 0;
#pragma unroll
    for (int i = 0; i < 17; ++i) { cnt_gt(cg, u[i], T); cnt_eq(ce, u[i], T); }
    const int cgw = wave_sum_i_dpp(cg);
    const int ngt = wg_sum8(F, CNT + 8, cgw);
    const int neq = wg_sum8(F, CNT + 16, wave_sum_i_dpp(ce));
    const int need = NSEL - ngt;
    int Jx = 0x3FFFFFFF;
    if (need < neq) {
        int Jb = 0;
#pragma unroll 1
        for (int bit = 13; bit >= 0; --bit) {
            const int cand = Jb | (1 << bit);
            const int L = cand - lane - 1024 * w;
            int c = 0;
#pragma unroll
            for (int i = 0; i < 17; ++i) cnt_eq_pos(c, u[i], T, L - 64 * i);
            c = wg_sum8(F, CNT + (bit & 1) * 24, wave_sum_i_dpp(c));
            if (c < need) Jb = cand;
        }
        Jx = Jb + 1;
    }
    {
        const int L = Jx - lane - 1024 * w;
        int ct = 0;
#pragma unroll
        for (int i = 0; i < 17; ++i) cnt_eq_pos(ct, u[i], T, L - 64 * i);
        const int ctw = wave_sum_i_dpp(ct);
        __syncthreads();
        if (lane == 0) { CNT[w] = (unsigned)cgw; CNT[8 + w] = (unsigned)ctw; }
        __syncthreads();
        int bg = 0, bt = ngt;
#pragma unroll
        for (int ww = 0; ww < 8; ++ww) { if (ww < w) { bg += (int)CNT[ww]; bt += (int)CNT[8 + ww]; } }
        int ig = cg, it2 = ct;
#pragma unroll
        for (int o = 1; o < 64; o <<= 1) { const int a = __shfl_up(ig, o), b2 = __shfl_up(it2, o); if (lane >= o) { ig += a; it2 += b2; } }
        int pg = bg + ig - cg, pt = bt + it2 - ct;
        int ev = 1024 * w + lane, Lr = L;
#pragma unroll
        for (int i = 0; i < 17; ++i) {
            if (u[i] > T) { SELL[pg] = ev; ++pg; }
            else if (u[i] == T && Lr > 0) { SELL[pt] = ev; ++pt; }
            asm volatile("v_add_u32 %0, 64, %0\n\tv_add_u32 %1, -64, %1" : "+v"(ev), "+v"(Lr));
        }
    }
    __syncthreads();
    {
        const int hd = w, g = w >> 2, qpos = PAST + t;
        float lg[4];
#pragma unroll 2
        for (int i = 0; i < 4; ++i) {
            const int sraw = SELL[lane + 64 * i];
            const float* kr;
            if (sraw < PAST) { const int page = F.page_table[b * NPAGES + (sraw >> 7)]; kr = F.cache_k + ((size_t)page * PAGE + (sraw & 127)) * 128 + g * 64; }
            else kr = F.out + O_KS + (size_t)(b * TS + (sraw - PAST)) * 128 + g * 64;
            float a0 = 0.f, a1 = 0.f;
#pragma unroll
            for (int c = 0; c < 16; ++c) {
                const f32x4 kv = *(const f32x4*)(kr + c * 4);
                const unsigned q0 = QL[hd * 32 + c * 2], q1 = QL[hd * 32 + c * 2 + 1];
                a0 += bflo(q0) * kv[0] + bfhi(q0) * kv[1]; a1 += bflo(q1) * kv[2] + bfhi(q1) * kv[3];
            }
            const int dist = qpos - sraw; const int bk = dist < 128 ? BT[dist] : 31;
            lg[i] = (a0 + a1) * ATTN_SCALE + RB[bk * 8 + hd];
        }
        float m = fmaxf(fmaxf(lg[0], lg[1]), fmaxf(lg[2], lg[3])); m = wave_max(m);
        float sm = 0.f;
#pragma unroll
        for (int i = 0; i < 4; ++i) { lg[i] = __expf(lg[i] - m); sm += lg[i]; }
        const float inv = 1.f / wave_sum_dpp(sm);
#pragma unroll
        for (int i = 0; i < 4; ++i) PL[lane + 64 * i] = lg[i] * inv;
        const int dq = lane & 15, ks = lane >> 4;
        f32x4 o4 = {0.f, 0.f, 0.f, 0.f};
#pragma unroll 1
        for (int j0 = 0; j0 < 256; j0 += 64) {
            f32x4 vv[16]; float pp[16];
#pragma unroll
            for (int jj = 0; jj < 16; ++jj) {
                const int j = j0 + jj * 4 + ks;
                const int sraw = SELL[j]; pp[jj] = PL[j];
                const float* vr;
                if (sraw < PAST) { const int page = F.page_table[b * NPAGES + (sraw >> 7)]; vr = F.cache_v + ((size_t)page * PAGE + (sraw & 127)) * 128 + g * 64; }
                else vr = F.out + O_VS + (size_t)(b * TS + (sraw - PAST)) * 128 + g * 64;
                vv[jj] = *(const f32x4*)(vr + 4 * dq);
            }
#pragma unroll
            for (int jj = 0; jj < 16; ++jj) o4 += vv[jj] * pp[jj];
        }
#pragma unroll
        for (int e = 0; e < 4; ++e) { o4[e] += __shfl_xor(o4[e], 16); o4[e] += __shfl_xor(o4[e], 32); }
        if (ks == 0) *(u32x2*)(F.OATT + (size_t)tok * 512 + hd * 64 + 4 * dq) = pk4(o4);
    }
}
__device__ __forceinline__ void p4_attention(const Frame& F) {
    const float* SS = (const float*)(F.ws + WS_SS);
    __syncthreads();
    if (F.tid < 256) ((LAS float*)(F.lds + SQ_RB))[F.tid] = F.rel_bias[F.tid];
    if (F.tid < 128) ((LAS int*)(F.lds + SQ_BT))[F.tid] = t5_bucket(F.tid);
    __syncthreads();
    for (int it = F.bid; it < NTS; it += F.G) p4_sample_query_unit(F, SS, it >> 3, it & 7);
    {
        const int c0 = F.lane * 8;
        float cw0[8], cw1[8], cw2[8], cbv[8];
#pragma unroll
        for (int e = 0; e < 8; ++e) { cw0[e] = F.conv_w[c0 + e]; cw1[e] = F.conv_w[512 + c0 + e]; cw2[e] = F.conv_w[1024 + c0 + e]; cbv[e] = F.conv_b[c0 + e]; }
        const int stride = F.G * 8;
        u32x4 n_cg[3], n_xi[3], n_bg;
        auto fetch = [&](int m) {
#pragma unroll
            for (int d = 0; d < 3; ++d) { const int mm = (m - d >= 0) ? m - d : 0; n_cg[d] = *(const u32x4*)(F.PROJ + (size_t)mm * NMIXP + C_CG + c0); n_xi[d] = *(const u32x4*)(F.PROJ + (size_t)mm * NMIXP + C_XIN + c0); }
            n_bg = *(const u32x4*)(F.PROJ + (size_t)m * NMIXP + C_BG + c0);
        };
        { const int m = F.bid * 8 + F.wave; fetch(m < NT ? m : 0); }
        for (int m = F.bid * 8 + F.wave; m < NT; m += stride) {
            u32x4 cg[3], xi[3]; const u32x4 bg = n_bg;
#pragma unroll
            for (int d = 0; d < 3; ++d) { cg[d] = n_cg[d]; xi[d] = n_xi[d]; }
            fetch(m + stride < NT ? m + stride : m);
            int t, T_, bsm; if (m < NTP) { t = m & 2047; T_ = SEQ; bsm = m >> 11; } else { t = (m - NTP) & 7; T_ = TS; bsm = (m - NTP) >> 3; }
            float u[3][8];
#pragma unroll
            for (int d = 0; d < 3; ++d) {
                if (t - d >= 0) {
#pragma unroll
                    for (int e = 0; e < 4; ++e) { u[d][2 * e] = bflo(cg[d][e]) * bflo(xi[d][e]); u[d][2 * e + 1] = bfhi(cg[d][e]) * bfhi(xi[d][e]); }
                } else if (m >= NTP) {
                    const float* pv = F.state_conv + ((size_t)bsm * 2 + (2 + t - d)) * 512 + c0;
#pragma unroll
                    for (int e = 0; e < 8; ++e) u[d][e] = pv[e];
                } else {
#pragma unroll
                    for (int e = 0; e < 8; ++e) u[d][e] = 0.f;
                }
            }
            float y[8];
#pragma unroll
            for (int e = 0; e < 8; ++e) {
                const float yy = cbv[e] + cw0[e] * u[2][e] + cw1[e] * u[1][e] + cw2[e] * u[0][e];
                const float bgv = (e & 1) ? bfhi(bg[e >> 1]) : bflo(bg[e >> 1]);
                y[e] = bgv * yy;
            }
            *(u32x4*)(F.OCONV + (size_t)m * 512 + c0) = (u32x4){cvt_pk_bf16(y[0], y[1]), cvt_pk_bf16(y[2], y[3]), cvt_pk_bf16(y[4], y[5]), cvt_pk_bf16(y[6], y[7])};
            if (t >= T_ - 2) {
                float* o = (m < NTP ? F.out + O_CP : F.out + O_CS) + ((size_t)bsm * 2 + (t - (T_ - 2))) * 512 + c0;
                const int rowi = (m < NTP) ? bsm * 2 + (t - (T_ - 2)) : 2 * NB_P + bsm * 2 + (t - (T_ - 2));
                const float* cx = (const float*)(F.ws + WS_CGX) + (size_t)rowi * 1024 + c0;
                const f32x4 ca = *(const f32x4*)cx, cb2 = *(const f32x4*)(cx + 4), xa = *(const f32x4*)(cx + 512), xb = *(const f32x4*)(cx + 516);
                *(f32x4*)o = ca * xa; *(f32x4*)(o + 4) = cb2 * xb;
            }
        }
    }
}

#define P5_EPI(A1, A2) { \
            const f32x4 va = ACC4(A1), vc = ACC4(A2); \
            const u32x2 ga = *(const u32x2*)(F.PROJ + (size_t)m * NMIXP + C_GA + n), gb = *(const u32x2*)(F.PROJ + (size_t)m * NMIXP + C_GB + n); \
            f32x4 o; \
            o[0] = sigmoidf_(bflo(ga[0])) * va[0] + sigmoidf_(bflo(gb[0])) * vc[0]; \
            o[1] = sigmoidf_(bfhi(ga[0])) * va[1] + sigmoidf_(bfhi(gb[0])) * vc[1]; \
            o[2] = sigmoidf_(bflo(ga[1])) * va[2] + sigmoidf_(bflo(gb[1])) * vc[2]; \
            o[3] = sigmoidf_(bfhi(ga[1])) * va[3] + sigmoidf_(bfhi(gb[1])) * vc[3]; \
            *(u32x2*)(F.MERGED + (size_t)m * D + n) = pk4(o); }
struct P5aBody {
    const Frame* Fp;
    __device__ __forceinline__ void operator()(int m, int n, const f32x4 v) const { *(u32x2*)(Fp->MERGED + (size_t)m * D + n) = pk4(v); }
};
struct P5bBody {
    const Frame* Fp;
    __device__ __forceinline__ void operator()(int m, int n, const f32x4 v) const {
        const Frame& F = *Fp;
        const u32x2 ga = *(const u32x2*)(F.PROJ + (size_t)m * NMIXP + C_GA + n), gb = *(const u32x2*)(F.PROJ + (size_t)m * NMIXP + C_GB + n);
        const u32x2 pa = *(const u32x2*)(F.MERGED + (size_t)m * D + n);
        const f32x4 o = (f32x4){sigmoidf_(bflo(ga[0])) * bflo(pa[0]) + sigmoidf_(bflo(gb[0])) * v[0], sigmoidf_(bfhi(ga[0])) * bfhi(pa[0]) + sigmoidf_(bfhi(gb[0])) * v[1],
                                sigmoidf_(bflo(ga[1])) * bflo(pa[1]) + sigmoidf_(bflo(gb[1])) * v[2], sigmoidf_(bfhi(ga[1])) * bfhi(pa[1]) + sigmoidf_(bfhi(gb[1])) * v[3]};
        *(u32x2*)(F.MERGED + (size_t)m * D + n) = pk4(o);
    }
};
__device__ __forceinline__ void p5_gemm_merge(const Frame& F) {
    {
        pg8::StaticOrder S; S.init(NTP, D, F.G, F.bid);
        { pg8::Gemm g{F.OATT, F.WOA, NTP, D, 512}; pg8::EpiRC<P5aBody> E{P5aBody{&F}}; pg8::gemm_phase<pg8::EpiRC<P5aBody>, pg8::StaticOrder, true, true>(F.lds, g, S, E); }
        asm volatile("s_waitcnt vmcnt(0)" ::: "memory"); __syncthreads();
        { pg8::Gemm g{F.OCONV, F.WOC, NTP, D, 512}; pg8::EpiRC<P5bBody> E{P5bBody{&F}}; pg8::gemm_phase<pg8::EpiRC<P5bBody>, pg8::StaticOrder, true, true>(F.lds, g, S, E); }
    }
    for (int sl = F.bid; sl < NTS / 8 * (D / BN); sl += F.G) {
        const int m0 = NTP + (sl >> 3) * 8, n0 = (sl & 7) * BN;
        f32x16 s1[1][1], s2[1][1];
        gemm_slice8(F, s1, F.OATT, 512, F.WOA, 512, 512, m0, n0);
        gemm_slice8(F, s2, F.OCONV, 512, F.WOC, 512, 512, m0, n0);
        SLICE_EPI_LOOP(P5_EPI(s1, s2))
    }
}
#define P6_EPI(A1) { \
            const f32x4 v = ACC4(A1); \
            const f32x4 xv = *(const f32x4*)(x_row(F, m) + n); \
            const f32x4 g1 = *(const f32x4*)(F.MOD + (size_t)mod_row(m) * 6144 + 2048 + n); \
            *(f32x4*)(F.T1 + (size_t)m * D + n) = xv * DN_ALPHA + g1 * v; }
struct P6Body {
    const Frame* Fp;
    __device__ __forceinline__ void operator()(int m, int n, const f32x4 v) const {
        const Frame& F = *Fp;
        const f32x4 xv = *(const f32x4*)(F.x_p + (size_t)m * D + n);
        const f32x4 g1 = *(const f32x4*)(F.MOD + (size_t)(m >> 11) * 6144 + 2048 + n);
        *(f32x4*)(F.T1 + (size_t)m * D + n) = xv * DN_ALPHA + g1 * v;
    }
};
__device__ __forceinline__ void p6_gemm_out(const Frame& F) {
    {
        pg8::Gemm g{F.MERGED, F.WOUT, NTP, D, D}; pg8::StaticOrder S; S.init(NTP, D, F.G, F.bid);
        pg8::EpiRC<P6Body> E{P6Body{&F}}; pg8::gemm_phase<pg8::EpiRC<P6Body>, pg8::StaticOrder, true, true>(F.lds, g, S, E);
    }
    for (int sl = F.bid; sl < NTS / 8 * (D / BN); sl += F.G) {
        const int m0 = NTP + (sl >> 3) * 8, n0 = (sl & 7) * BN;
        f32x16 s1[1][1];
        gemm_slice8(F, s1, F.MERGED, D, F.WOUT, D, D, m0, n0);
        SLICE_EPI_LOOP(P6_EPI(s1))
    }
}
__device__ __forceinline__ void p7_ln1(const Frame& F) {
    f32x4 lg[4], lb[4];
#pragma unroll
    for (int i = 0; i < 4; ++i) { const int e = (i >> 1) * 512 + F.lane * 8 + (i & 1) * 4; lg[i] = *(const f32x4*)(F.ln1_g + e); lb[i] = *(const f32x4*)(F.ln1_b + e); }
    const int stride = F.G * 8;
    f32x4 vn[4], scn[4], shn[4];
    {
        const int m = F.bid * 8 + F.wave; const float* mr = F.MOD + (size_t)mod_row(m < NT ? m : 0) * 6144;
#pragma unroll
        for (int i = 0; i < 4; ++i) { const int e = (i >> 1) * 512 + F.lane * 8 + (i & 1) * 4; vn[i] = *(const f32x4*)(F.T1 + (size_t)(m < NT ? m : 0) * D + e); scn[i] = *(const f32x4*)(mr + 4096 + e); shn[i] = *(const f32x4*)(mr + 3072 + e); }
    }
    for (int m = F.bid * 8 + F.wave; m < NT; m += stride) {
        float* tr = F.T1 + (size_t)m * D;
        f32x4 v[4], sc2[4], sh2[4]; float s = 0.f;
#pragma unroll
        for (int i = 0; i < 4; ++i) { v[i] = vn[i]; sc2[i] = scn[i]; sh2[i] = shn[i]; s += v[i][0] + v[i][1] + v[i][2] + v[i][3]; }
        {
            const int mn = (m + stride < NT) ? m + stride : m; const float* mrn = F.MOD + (size_t)mod_row(mn) * 6144;
#pragma unroll
            for (int i = 0; i < 4; ++i) { const int e = (i >> 1) * 512 + F.lane * 8 + (i & 1) * 4; vn[i] = *(const f32x4*)(F.T1 + (size_t)mn * D + e); scn[i] = *(const f32x4*)(mrn + 4096 + e); shn[i] = *(const f32x4*)(mrn + 3072 + e); }
        }
        const float mean = wave_sum(s) * (1.f / D);
        float q = 0.f;
#pragma unroll
        for (int i = 0; i < 4; ++i) { v[i] = v[i] - mean; q += v[i][0] * v[i][0] + v[i][1] * v[i][1] + v[i][2] * v[i][2] + v[i][3] * v[i][3]; }
        const float rstd = rsqrtf(wave_sum(q) * (1.f / D) + LN_EPS);
        f32x4 hv[2][2];
#pragma unroll
        for (int hlf = 0; hlf < 2; ++hlf) {
            const int e = hlf * 512 + F.lane * 8;
            f32x4 a = v[2 * hlf] * rstd * lg[2 * hlf] + lb[2 * hlf];
            f32x4 b = v[2 * hlf + 1] * rstd * lg[2 * hlf + 1] + lb[2 * hlf + 1];
            *(f32x4*)(tr + e) = a; *(f32x4*)(tr + e + 4) = b;
            const f32x4 ha = a * (sc2[2 * hlf] + 1.f) + sh2[2 * hlf];
            const f32x4 hb = b * (sc2[2 * hlf + 1] + 1.f) + sh2[2 * hlf + 1];
            *(u32x4*)(F.H2 + (size_t)m * D + e) = (u32x4){cvt_pk_bf16(ha[0], ha[1]), cvt_pk_bf16(ha[2], ha[3]), cvt_pk_bf16(hb[0], hb[1]), cvt_pk_bf16(hb[2], hb[3])};
            hv[hlf][0] = ha; hv[hlf][1] = hb;
        }
        float am = 0.f;
#pragma unroll
        for (int i = 0; i < 2; ++i)
#pragma unroll
            for (int j = 0; j < 2; ++j)
#pragma unroll
                for (int e = 0; e < 4; ++e) am = fmaxf(am, fabsf(hv[i][j][e]));
        am = wave_max(am);
        const float sc = am > 0.f ? 224.f / am : 1.f;
#pragma unroll
        for (int hlf = 0; hlf < 2; ++hlf) {
            int w0 = 0, w1 = 0;
            w0 = __builtin_amdgcn_cvt_pk_fp8_f32(hv[hlf][0][0] * sc, hv[hlf][0][1] * sc, w0, false); w0 = __builtin_amdgcn_cvt_pk_fp8_f32(hv[hlf][0][2] * sc, hv[hlf][0][3] * sc, w0, true);
            w1 = __builtin_amdgcn_cvt_pk_fp8_f32(hv[hlf][1][0] * sc, hv[hlf][1][1] * sc, w1, false); w1 = __builtin_amdgcn_cvt_pk_fp8_f32(hv[hlf][1][2] * sc, hv[hlf][1][3] * sc, w1, true);
            *(u32x2*)(F.ws + WS_H8 + (size_t)m * D + hlf * 512 + F.lane * 8) = (u32x2){(unsigned)w0, (unsigned)w1};
        }
        if (F.lane == 0) ((float*)(F.ws + WS_SH))[m] = am > 0.f ? am * (1.f / 224.f) : 1.f;
    }
}
struct P8Body {
    const Frame* Fp;
    __device__ __forceinline__ void operator()(int m, int n, const f32x4 v) const { *(u32x2*)(Fp->QP + (size_t)m * D + n) = pk4(v); }
};
__device__ __forceinline__ void p8_gemm_q(const Frame& F) {
    {
        pg8::Gemm g{F.H2, F.WQ, NTP, D, D}; pg8::StaticOrder S; S.init(NTP, D, F.G, F.bid);
        pg8::EpiRC<P8Body> E{P8Body{&F}}; pg8::gemm_phase<pg8::EpiRC<P8Body>, pg8::StaticOrder, true, true>(F.lds, g, S, E);
    }
    for (int sl = F.bid; sl < NTS / 8 * (D / BN); sl += F.G) {
        const int m0 = NTP + (sl >> 3) * 8, n0 = (sl & 7) * BN;
        f32x16 s1[1][1];
        gemm_slice8(F, s1, F.H2, D, F.WQ, D, D, m0, n0);
        SLICE_EPI_LOOP({ *(u32x2*)(F.QP + (size_t)m * D + n) = pk4(ACC4(s1)); })
    }
}
constexpr int PR_ROW = 129;
__device__ __forceinline__ void p9_route(const Frame& F) {
    LAS float* SC = (LAS float*)F.lds;
    LAS float* TV = (LAS float*)(F.lds + 32 * 8 * PR_ROW * 4);
    LAS unsigned char* TI = (LAS unsigned char*)(F.lds + 32 * 8 * PR_ROW * 4 + 256 * 17 * 4);
    const int lane = F.lane, r = lane & 31, h = lane >> 5;
    const int nunits = (NT / 32) * 2;
    for (int it = F.bid; it < nunits; it += F.G) {
        const int tok0 = (it >> 1) * 32, hg = it & 1;
        __syncthreads();
        {
            const int head = hg * 4 + (F.wave >> 1), half = F.wave & 1;
            const bf16_t* KK = half ? F.K2 : F.K1;
            bf16x8 Bq[4];
#pragma unroll
            for (int s = 0; s < 4; ++s) Bq[s] = *(const bf16x8*)(F.QP + (size_t)(tok0 + r) * D + head * 128 + half * 64 + s * 16 + h * 8);
#pragma unroll
            for (int kt = 0; kt < 4; ++kt) {
                f32x16 c;
#pragma unroll
                for (int e = 0; e < 16; ++e) c[e] = 0.f;
#pragma unroll
                for (int s = 0; s < 4; ++s) {
                    const bf16x8 Ak = *(const bf16x8*)(KK + (size_t)(kt * 32 + r) * 64 + s * 16 + h * 8);
                    c = __builtin_amdgcn_mfma_f32_32x32x16_bf16(Ak, Bq[s], c, 0, 0, 0);
                }
#pragma unroll
                for (int e = 0; e < 16; ++e) { const int key = kt * 32 + (e & 3) + 8 * (e >> 2) + 4 * h; SC[(r * 8 + F.wave) * PR_ROW + key] = c[e]; }
            }
        }
        __syncthreads();
        {
            const int rowi = F.tid >> 1, hf = F.tid & 1;
            LAS float* row = SC + rowi * PR_ROW;
            LAS float* rh = row + 64 * hf;
            float gm[8];
#pragma unroll
            for (int gidx = 0; gidx < 8; ++gidx) {
                float m = rh[gidx * 8];
#pragma unroll
                for (int k = 1; k < 8; ++k) m = fmaxf(m, rh[gidx * 8 + k]);
                gm[gidx] = m;
            }
            float ov[16]; int oi[16];
#pragma unroll
            for (int p = 0; p < 16; ++p) {
                float best = gm[0]; int bg = 0;
#pragma unroll
                for (int gidx = 1; gidx < 8; ++gidx) { const bool gt = gm[gidx] > best; best = gt ? gm[gidx] : best; bg = gt ? gidx : bg; }
                float v[8];
#pragma unroll
                for (int k = 0; k < 8; ++k) v[k] = rh[bg * 8 + k];
                int bk = 7;
#pragma unroll
                for (int k = 6; k >= 0; --k) bk = (v[k] == best) ? k : bk;
                float nm = -INFINITY;
#pragma unroll
                for (int k = 0; k < 8; ++k) nm = fmaxf(nm, (k == bk) ? -INFINITY : v[k]);
                rh[bg * 8 + bk] = -INFINITY;
#pragma unroll
                for (int gidx = 0; gidx < 8; ++gidx) gm[gidx] = (gidx == bg) ? nm : gm[gidx];
                ov[p] = best; oi[p] = 64 * hf + bg * 8 + bk;
            }
#pragma unroll
            for (int p = 0; p < 16; ++p) { rh[p] = ov[p]; rh[16 + p] = __int_as_float(oi[p]); }
            if (hf == 0) {
                int pa = 0, pb = 0;
#pragma unroll 1
                for (int p = 0; p < 16; ++p) {
                    const float va = row[pa], vb = row[64 + pb];
                    const bool ta = va >= vb;
                    TV[rowi * 17 + p] = ta ? va : vb;
                    TI[rowi * 17 + p] = (unsigned char)__float_as_int(ta ? row[16 + pa] : row[64 + 16 + pb]);
                    pa += ta ? 1 : 0; pb += ta ? 0 : 1;
                }
            }
        }
        __syncthreads();
        if (F.tid < 128) {
            const int tk = F.tid >> 2, hs = F.tid & 3;
            const int r1 = (tk * 8 + hs * 2) * 17, r2 = r1 + 17;
            float c[16];
            { const float v20 = TV[r2];
#pragma unroll
              for (int i = 0; i < 16; ++i) c[i] = TV[r1 + i] + v20; }
            unsigned long long ptrs = 0ull;
            float sv[16]; int se[16];
#pragma unroll
            for (int p = 0; p < 16; ++p) {
                float best = c[0]; int bi = 0;
#pragma unroll
                for (int i = 1; i < 16; ++i) { const bool gt = c[i] > best; best = gt ? c[i] : best; bi = gt ? i : bi; }
                const int bj = (int)((ptrs >> (4 * bi)) & 15ull);
                sv[p] = best; se[p] = (int)TI[r1 + bi] * 128 + (int)TI[r2 + bj];
                const float nv = (bj < 15) ? TV[r1 + bi] + TV[r2 + bj + 1] : -INFINITY;
                ptrs += (bj < 15) ? (1ull << (4 * bi)) : 0ull;
#pragma unroll
                for (int i = 0; i < 16; ++i) c[i] = (i == bi) ? nv : c[i];
            }
            const float mx0 = sv[0]; float den = 0.f;
#pragma unroll
            for (int p = 0; p < 16; ++p) { sv[p] = __expf(sv[p] - mx0); den += sv[p]; }
            const float dinv = 1.f / den;
            const int head = hg * 4 + hs;
            int* eo = F.EIDX + (size_t)(tok0 + tk) * NEXP_SEL + head * 16; float* go = F.GW + (size_t)(tok0 + tk) * NEXP_SEL + head * 16;
#pragma unroll
            for (int p = 0; p < 16; ++p) { eo[p] = se[p]; go[p] = sv[p] * dinv; }
        }
    }
}

constexpr int TPW = 65, PAIRS_MAX = 9 * 128, PK = 4;
constexpr int P10_HROW = 1024 + 64;
constexpr int P10_H = 0;
constexpr int P10_SH = 32 * P10_HROW;
constexpr int P10_VROW = 2048 + 64;
constexpr int P10_STG = P10_SH + 128;
constexpr int P10_HIST = P10_STG + 8 * 4 * P10_VROW;
typedef short s16x4 __attribute__((ext_vector_type(4)));
__device__ __forceinline__ long pack64(unsigned lo, unsigned hi) { return (long)(((unsigned long long)hi << 32) | (unsigned long long)lo); }
__device__ __forceinline__ void fp8x16_to_bf16(const u32x4 v, u32x4& lo, u32x4& hi) {
    unsigned o[8];
#pragma unroll
    for (int i = 0; i < 4; ++i) {
        const f32x2_t a = __builtin_amdgcn_cvt_pk_f32_fp8((int)v[i], false), b2 = __builtin_amdgcn_cvt_pk_f32_fp8((int)v[i], true);
        o[2 * i] = cvt_pk_bf16(a[0], a[1]); o[2 * i + 1] = cvt_pk_bf16(b2[0], b2[1]);
    }
    lo = (u32x4){o[0], o[1], o[2], o[3]}; hi = (u32x4){o[4], o[5], o[6], o[7]};
}
__device__ __forceinline__ void p10_peer(const Frame& F) {
    const int lane = F.lane, w = F.wave;
    unsigned char* ws = F.ws;
    const unsigned char* PU8 = ws + WS_PU8; const unsigned char* PV8 = ws + WS_PV8;
    const float* SU = (const float*)(ws + WS_SU); const float* SV = (const float*)(ws + WS_SV);
    const unsigned char* H8 = ws + WS_H8; const float* SH = (const float*)(ws + WS_SH);
  for (int blk = F.bid; blk < NT / TPW; blk += F.G) {
    const int tok0 = blk * TPW;
    LAS unsigned* hist = (LAS unsigned*)(F.lds + P10_HIST) + w * 128;
    LAS unsigned char* stg = F.lds + P10_STG + w * (4 * P10_VROW);
    LAS float* SHl = (LAS float*)(F.lds + P10_SH);
    unsigned* SE0 = (unsigned*)(ws + WS_SE) + ((size_t)blk * 8 + w) * PAIRS_MAX;
    float* SG0 = (float*)(ws + WS_SG) + ((size_t)blk * 8 + w) * PAIRS_MAX;
    const int ntok = (w == 0) ? 9 : 8;
    const int r16 = lane & 15, q4 = lane >> 4;
#pragma unroll 1
    for (int pass = 0; pass < 3; ++pass) {
        const int kbase = pass * PK, nk = (ntok - kbase < PK) ? (ntok - kbase > 0 ? ntok - kbase : 0) : PK, npairs = nk * 128;
        __syncthreads();
        for (int c = F.tid; c < 32 * 64; c += NTHREADS) {
            const int row = c >> 6, tl = 32 * pass + row;
            if (tl < TPW) *(LAS u32x4*)(F.lds + P10_H + row * P10_HROW + (c & 63) * 16) = *(const u32x4*)(H8 + (size_t)(tok0 + tl) * D + (size_t)(c & 63) * 16);
        }
        if (F.tid < 32 && 32 * pass + F.tid < TPW) SHl[F.tid] = SH[tok0 + 32 * pass + F.tid];
        __syncthreads();
        if (nk <= 0) continue;
        unsigned* SE = SE0 + pass * (PK * 128); float* SG = SG0 + pass * (PK * 128);
        hist[lane] = 0u; hist[lane + 64] = 0u;
        int ex[8];
#pragma unroll
        for (int i = 0; i < 8; ++i) {
            const int p = lane + 64 * i;
            ex[i] = -1;
            if (p < npairs) { ex[i] = F.EIDX[(size_t)(tok0 + w + 8 * (kbase + (p >> 7))) * NEXP_SEL + (p & 127)]; atomicAdd((unsigned*)&hist[ex[i] >> 7], 1u); }
        }
        {
            const unsigned c0 = hist[2 * lane], c1 = hist[2 * lane + 1];
            unsigned incl = c0 + c1;
#pragma unroll
            for (int o = 1; o < 64; o <<= 1) { const unsigned t = __shfl_up(incl, o); if (lane >= o) incl += t; }
            const unsigned excl = incl - (c0 + c1);
            hist[2 * lane] = excl; hist[2 * lane + 1] = excl + c0;
        }
#pragma unroll
        for (int i = 0; i < 8; ++i) {
            const int p = lane + 64 * i;
            if (p < npairs) {
                const unsigned pos = atomicAdd((unsigned*)&hist[ex[i] >> 7], 1u);
                SE[pos] = (unsigned)ex[i] | ((unsigned)(p >> 7) << 14);
                SG[pos] = F.GW[(size_t)(tok0 + w + 8 * (kbase + (p >> 7))) * NEXP_SEL + (p & 127)];
            }
        }
        asm volatile("s_waitcnt vmcnt(0)" ::: "memory");
        f32x4 acc[16];
#pragma unroll
        for (int c = 0; c < 16; ++c) acc[c] = (f32x4){0.f, 0.f, 0.f, 0.f};
#pragma unroll 1
        for (int c0 = 0; c0 < npairs; c0 += 64) {
            const int wv = (int)SE[c0 + lane]; const int gv = __float_as_int(SG[c0 + lane]);
#pragma unroll 1
            for (int j0 = 0; j0 < 64; j0 += 16) {
                const int wr = __shfl(wv, j0 + r16);
                const int er = wr & 16383, sr = wr >> 14;
                const float gr = __int_as_float(__shfl(gv, j0 + r16));
                const unsigned char* ur = PU8 + (size_t)er * D + q4 * 16;
                u32x4 Ub[16];
#pragma unroll
                for (int t = 0; t < 16; ++t) Ub[t] = *(const u32x4*)(ur + t * 64);
                const float suv = SU[er], svv = SV[er];
                u32x4 V8[2][4];
#pragma unroll
                for (int k = 0; k < 4; ++k) V8[0][k] = *(const u32x4*)(PV8 + (size_t)(__builtin_amdgcn_readlane(wv, j0 + k) & 16383) * D + lane * 16);
                LAS const unsigned char* hr = F.lds + P10_H + (w + 8 * sr) * P10_HROW + q4 * 16;
                const float shv = SHl[w + 8 * sr];
                f32x4 C0 = {0.f, 0.f, 0.f, 0.f}, C1 = {0.f, 0.f, 0.f, 0.f};
#pragma unroll
                for (int t = 0; t < 16; ++t) {
                    const u32x4 hh = *(LAS const u32x4*)(hr + t * 64);
                    C0 = __builtin_amdgcn_mfma_f32_16x16x32_fp8_fp8(pack64(hh[0], hh[1]), pack64(Ub[t][0], Ub[t][1]), C0, 0, 0, 0);
                    C1 = __builtin_amdgcn_mfma_f32_16x16x32_fp8_fp8(pack64(hh[2], hh[3]), pack64(Ub[t][2], Ub[t][3]), C1, 0, 0, 0);
                }
                C0 = C0 + C1;
                const int rsel = lane & 3;
                const float dv = (rsel == 0 ? C0[0] : (rsel == 1 ? C0[1] : (rsel == 2 ? C0[2] : C0[3]))) * (suv * shv);
                const int actv = __float_as_int(gelu_tanh(dv) * (gr * svv));
#pragma unroll
                for (int sg = 0; sg < 4; ++sg) {
                    if (sg + 1 < 4) {
#pragma unroll
                        for (int k = 0; k < 4; ++k) V8[(sg + 1) & 1][k] = *(const u32x4*)(PV8 + (size_t)(__builtin_amdgcn_readlane(wv, j0 + 4 * (sg + 1) + k) & 16383) * D + lane * 16);
                    }
#pragma unroll
                    for (int k = 0; k < 4; ++k) {
                        u32x4 lo, hi; fp8x16_to_bf16(V8[sg & 1][k], lo, hi);
                        *(LAS u32x4*)(stg + k * P10_VROW + lane * 32) = lo;
                        *(LAS u32x4*)(stg + k * P10_VROW + lane * 32 + 16) = hi;
                    }
                    float a4[4];
#pragma unroll
                    for (int k = 0; k < 4; ++k) {
                        const int p = 4 * sg + k;
                        const float actk = __int_as_float(__builtin_amdgcn_readlane(actv, 16 * (p >> 2) + p));
                        const int slot = __builtin_amdgcn_readlane(wv, j0 + p) >> 14;
                        a4[k] = (slot == (lane & 3)) ? actk : 0.f;
                    }
                    const u32x2 apk = (u32x2){cvt_pk_bf16(a4[0], a4[1]), cvt_pk_bf16(a4[2], a4[3])};
                    s16x4 Aop; __builtin_memcpy(&Aop, &apk, 8);
                    LAS const unsigned char* tb = stg + ((lane & 15) >> 2) * P10_VROW + ((lane >> 4) * 16 + (lane & 3) * 4) * 2;
#pragma unroll
                    for (int c = 0; c < 16; ++c) {
                        const s16x4 Bop = __builtin_amdgcn_ds_read_tr16_b64_v4i16((LAS s16x4*)(tb + c * 128));
                        acc[c] = __builtin_amdgcn_mfma_f32_4x4x4bf16_1k(Aop, Bop, acc[c], 0, 0, 0);
                    }
                }
            }
        }
#pragma unroll
        for (int k = 0; k < PK; ++k) {
            if (k >= nk) continue;
            const int m = tok0 + w + 8 * (kbase + k);
            const float* x1 = F.T1 + (size_t)m * D; const float* mr = F.MOD + (size_t)mod_row(m) * 6144 + 5120;
            float tv[16]; float s = 0.f;
#pragma unroll
            for (int c = 0; c < 16; ++c) { const float t = x1[c * 64 + lane] * DN_ALPHA + mr[c * 64 + lane] * acc[c][k]; tv[c] = t; s += t; }
            const float mean = wave_sum(s) * (1.f / D);
            float q = 0.f;
#pragma unroll
            for (int c = 0; c < 16; ++c) { tv[c] -= mean; q += tv[c] * tv[c]; }
            const float rstd = rsqrtf(wave_sum(q) * (1.f / D) + LN_EPS);
            float* yo = (m < NTP) ? F.out + O_YP + (size_t)m * D : F.out + O_YS + (size_t)(m - NTP) * D;
#pragma unroll
            for (int c = 0; c < 16; ++c) yo[c * 64 + lane] = tv[c] * rstd * F.ln2_g[c * 64 + lane] + F.ln2_b[c * 64 + lane];
        }
    }
  }
}

constexpr int N_PHASES = 11;
__global__ void __launch_bounds__(NTHREADS, 2) fwd_kernel(Args args) {
    extern __shared__ __attribute__((aligned(16))) unsigned char lds_raw[];
    Frame F;
    F.lds = (LAS unsigned char*)lds_raw;
    F.tid = threadIdx.x; F.lane = F.tid & 63; F.wave = __builtin_amdgcn_readfirstlane(F.tid >> 6); F.G = gridDim.x; F.bid = blockIdx.x;
    F.x_p = (const float*)args.in[0]; F.x_s = (const float*)args.in[1]; F.c_p = (const float*)args.in[2]; F.c_s = (const float*)args.in[3];
    F.cache_k = (const float*)args.in[4]; F.cache_v = (const float*)args.in[5]; F.cache_ki = (const float*)args.in[6]; F.state_conv = (const float*)args.in[7];
    F.page_table = (const int*)args.in[8]; F.rel_bias = (const float*)args.in[9]; F.w_ada = (const float*)args.in[10]; F.b_ada = (const float*)args.in[11];
    F.w_in = (const float*)args.in[12]; F.conv_w = (const float*)args.in[13]; F.conv_b = (const float*)args.in[14]; F.w_o_attn = (const float*)args.in[15];
    F.w_o_conv = (const float*)args.in[16]; F.w_out = (const float*)args.in[17]; F.ln1_g = (const float*)args.in[18]; F.ln1_b = (const float*)args.in[19];
    F.ln2_g = (const float*)args.in[20]; F.ln2_b = (const float*)args.in[21]; F.peer_wq = (const float*)args.in[22]; F.peer_k1 = (const float*)args.in[23];
    F.peer_k2 = (const float*)args.in[24]; F.peer_u = (const float*)args.in[25]; F.peer_v = (const float*)args.in[26];
    F.out = args.out;
    unsigned char* ws = args.ws; F.ws = ws;
    F.MOD = (float*)(ws + WS_MOD); F.WIN = (bf16_t*)(ws + WS_WIN); F.WOA = (bf16_t*)(ws + WS_WOA); F.WOC = (bf16_t*)(ws + WS_WOC);
    F.WOUT = (bf16_t*)(ws + WS_WOUT); F.WQ = (bf16_t*)(ws + WS_WQ); F.K1 = (bf16_t*)(ws + WS_K1); F.K2 = (bf16_t*)(ws + WS_K2);
    F.PU = (bf16_t*)(ws + WS_PU); F.PV = (bf16_t*)(ws + WS_PV); F.H1 = (bf16_t*)(ws + WS_H1); F.PROJ = (bf16_t*)(ws + WS_PROJ);
    F.WI = (float*)(ws + WS_WI); F.SEL = (int*)(ws + WS_SEL); F.OATT = (bf16_t*)(ws + WS_OATT); F.OCONV = (bf16_t*)(ws + WS_OCONV);
    F.MERGED = (bf16_t*)(ws + WS_MERGED); F.T1 = (float*)(ws + WS_T1); F.H2 = (bf16_t*)(ws + WS_H2); F.QP = (bf16_t*)(ws + WS_QP);
    F.EIDX = (int*)(ws + WS_EIDX); F.GW = (float*)(ws + WS_GW);
    volatile LAS unsigned* misc = (volatile LAS unsigned*)(F.lds + LDS_MISC);
    if (F.tid < 16) misc[F.tid] = 0u;
    __syncthreads();
    XcdBarrier bar; bar.bar = (unsigned*)(ws + WS_CTL); bar.x = 0; bar.st = misc;
    const int lo = args.ph_lo, hi = args.ph_hi;
    if (hi - lo > 1) bar = xcd_barrier_post((unsigned*)(ws + WS_CTL), misc);
#define IN(k) (lo <= (k) && (k) < hi)
#define SEAM(k) do { if (IN(k) && IN((k) + 1)) xcd_barrier(bar); } while (0)
    if (IN(0)) p0_prologue(F);       SEAM(0);
    if (IN(1)) p1_modulate(F);       SEAM(1);
    if (IN(2)) p2_gemm_in(F);        SEAM(2);
    if (IN(3)) p3_index(F);          SEAM(3);
    if (IN(4)) p4_attention(F);      SEAM(4);
    if (IN(5)) p5_gemm_merge(F);     SEAM(5);
    if (IN(6)) p6_gemm_out(F);       SEAM(6);
    if (IN(7)) p7_ln1(F);            SEAM(7);
    if (IN(8)) p8_gemm_q(F);         SEAM(8);
    if (IN(9)) p9_route(F);          SEAM(9);
    if (IN(10)) p10_peer(F);
#undef IN
#undef SEAM
}

extern "C" void kernel_launch(void* const* d_in, const int* in_sizes, int n_in, void* d_out, int out_size, void* d_ws, size_t ws_size, hipStream_t stream) {
    static int grid = 0;
    if (grid == 0) {
        if (n_in != 27 || (size_t)out_size != O_END || ws_size < WS_END) { fprintf(stderr, "kernel_launch: unexpected shapes (n_in %d out %d ws %zu)\n", n_in, out_size, ws_size); grid = -1; return; }
        int dev = 0, cus = 0;
        if (hipGetDevice(&dev) != hipSuccess || hipDeviceGetAttribute(&cus, hipDeviceAttributeMultiprocessorCount, dev) != hipSuccess) { grid = -1; return; }
        if (hipFuncSetAttribute((const void*)fwd_kernel, hipFuncAttributeMaxDynamicSharedMemorySize, LDS_BYTES) != hipSuccess) { fprintf(stderr, "kernel_launch: hipFuncSetAttribute failed\n"); grid = -1; return; }
        (void)hipGetLastError();
        grid = cus;
    }
    if (grid < 0) return;
    (void)hipMemsetAsync((char*)d_ws + WS_CTL, 0, CTL_ZERO_BYTES, stream);
    Args a{};
    for (int i = 0; i < 27; ++i) a.in[i] = d_in[i];
    a.out = (float*)d_out; a.ws = (unsigned char*)d_ws;
#if N_LAUNCHES == 1
    a.ph_lo = 0; a.ph_hi = N_PHASES;
    hipLaunchKernelGGL(fwd_kernel, dim3(grid), dim3(NTHREADS), LDS_BYTES, stream, a);
#else
    for (int p = 0; p < N_PHASES; ++p) { a.ph_lo = p; a.ph_hi = p + 1; hipLaunchKernelGGL(fwd_kernel, dim3(grid), dim3(NTHREADS), LDS_BYTES, stream, a); }
#endif
}
```

```cpp
#include <hip/hip_runtime.h>
#include <cstdio>
#include <cstdint>

#ifndef N_LAUNCHES
#define N_LAUNCHES 1
#endif

typedef unsigned short bf16_t;
typedef short bf16x8 __attribute__((ext_vector_type(8)));
typedef float f32x4 __attribute__((ext_vector_type(4)));
typedef float f32x16 __attribute__((ext_vector_type(16)));
typedef unsigned u32x4 __attribute__((ext_vector_type(4)));
typedef unsigned u32x2 __attribute__((ext_vector_type(2)));
#define LAS __attribute__((address_space(3)))

constexpr int D = 1024, NB_P = 8, SEQ = 2048, NB_S = 32, TS = 8, PAST = 8192, PAGE = 128, NPAGES = 64;
constexpr int NTP = NB_P * SEQ;
constexpr int NTS = NB_S * TS;
constexpr int NT = NTP + NTS;
constexpr int NMIX = 4676, NMIXP = 4736;
constexpr int C_Q = 0, C_K = 512, C_V = 640, C_QI = 768, C_KI = 1024, C_BG = 1088, C_CG = 1600, C_XIN = 2112, C_GA = 2624, C_GB = 3648, C_WI = 4672;
constexpr int NSEL = 256;
constexpr float ATTN_SCALE = 0.125f, IDX_SCALE = 0.0625f;
constexpr float DN_ALPHA = 1.189207115002721f, LN_EPS = 1e-5f;
constexpr int NEXP_SEL = 128;

constexpr size_t O_YP = 0, O_YS = 16777216, O_KP = 17039360, O_VP = 19136512, O_KIP = 21233664, O_CP = 22282240,
                 O_KS = 22290432, O_VS = 22323200, O_KIS = 22355968, O_CS = 22372352, O_END = 22405120;

constexpr size_t MB = 1048576;
constexpr size_t WS_CTL = 0, WS_MOD = 1 * MB, WS_WIN = 2 * MB, WS_WOA = 12 * MB, WS_WOC = 13 * MB, WS_WOUT = 14 * MB, WS_WQ = 16 * MB,
                 WS_K1 = 18 * MB, WS_K2 = 18 * MB + 65536, WS_PU = 20 * MB, WS_PV = 52 * MB, WS_H1 = 84 * MB, WS_PROJ = 118 * MB,
                 WS_WI = 270 * MB, WS_SEL = 271 * MB, WS_OATT = 288 * MB, WS_OCONV = 305 * MB, WS_MERGED = 322 * MB, WS_T1 = 355 * MB,
                 WS_H2 = 420 * MB, WS_QP = 453 * MB, WS_EIDX = 486 * MB, WS_GW = 495 * MB, WS_SS = 504 * MB, WS_SE = 513 * MB, WS_SG = 523 * MB, WS_VT = 533 * MB, WS_CGX = 538 * MB, WS_END = 539 * MB;
constexpr size_t WS_PU8 = WS_PU, WS_PV8 = WS_PU + 16 * MB, WS_SU = WS_PV, WS_SV = WS_PV + 65536, WS_H8 = WS_PV + 1 * MB, WS_SH = WS_PV + 20 * MB;
constexpr int CTL_ZERO_BYTES = 65536;

constexpr int NTHREADS = 512;
constexpr int LDS_BYTES = 160 * 1024 - 512;
constexpr int LDS_MISC = LDS_BYTES - 64;

__device__ __forceinline__ float bf2f(bf16_t b) { return __uint_as_float(((unsigned)b) << 16); }
__device__ __forceinline__ float bflo(unsigned p) { return __uint_as_float(p << 16); }
__device__ __forceinline__ float bfhi(unsigned p) { return __uint_as_float(p & 0xFFFF0000u); }
typedef __bf16 bf16x2_t __attribute__((ext_vector_type(2)));
typedef float f32x2_t __attribute__((ext_vector_type(2)));
__device__ __forceinline__ unsigned cvt_pk_bf16(float lo, float hi) { const f32x2_t f = {lo, hi}; const bf16x2_t b = __builtin_convertvector(f, bf16x2_t); unsigned r; __builtin_memcpy(&r, &b, 4); return r; }
__device__ __forceinline__ bf16_t f2bf(float f) { return (bf16_t)(cvt_pk_bf16(f, 0.f) & 0xFFFFu); }
__device__ __forceinline__ float wave_sum(float v) {
#pragma unroll
    for (int o = 32; o >= 1; o >>= 1) v += __shfl_xor(v, o);
    return v;
}
__device__ __forceinline__ float wave_sum_dpp(float v) {
    int x;
    x = __builtin_amdgcn_update_dpp(0, __float_as_int(v), 0xB1, 0xF, 0xF, false);  v += __int_as_float(x);
    x = __builtin_amdgcn_update_dpp(0, __float_as_int(v), 0x4E, 0xF, 0xF, false);  v += __int_as_float(x);
    x = __builtin_amdgcn_update_dpp(0, __float_as_int(v), 0x141, 0xF, 0xF, false); v += __int_as_float(x);
    x = __builtin_amdgcn_update_dpp(0, __float_as_int(v), 0x140, 0xF, 0xF, false); v += __int_as_float(x);
    x = __builtin_amdgcn_update_dpp(0, __float_as_int(v), 0x142, 0xA, 0xF, false); v += __int_as_float(x);
    x = __builtin_amdgcn_update_dpp(0, __float_as_int(v), 0x143, 0xC, 0xF, false); v += __int_as_float(x);
    return __int_as_float(__builtin_amdgcn_readlane(__float_as_int(v), 63));
}
__device__ __forceinline__ float wave_max(float v) {
#pragma unroll
    for (int o = 32; o >= 1; o >>= 1) v = fmaxf(v, __shfl_xor(v, o));
    return v;
}
__device__ __forceinline__ float sigmoidf_(float x) { return 1.f / (1.f + __expf(-x)); }
__device__ __forceinline__ float gelu_tanh(float a) {
    const float z = 0.7978845608028654f * (a + 0.044715f * a * a * a);
    const float e = __expf(2.f * z);
    const float t = 1.f - 2.f * __builtin_amdgcn_rcpf(e + 1.f);
    return 0.5f * a * (1.f + t);
}
__device__ __forceinline__ unsigned f2ord(float f) { const unsigned u = __float_as_uint(f); return (u & 0x80000000u) ? ~u : (u | 0x80000000u); }
__device__ __forceinline__ int t5_bucket(int n) {
    if (n < 16) return n;
    int b = 16;
    b += (n >= 19) + (n >= 21) + (n >= 24) + (n >= 27) + (n >= 31) + (n >= 35) + (n >= 40) + (n >= 46) + (n >= 52) + (n >= 59) + (n >= 67) + (n >= 77) + (n >= 87) + (n >= 99) + (n >= 113);
    return b;
}

#define XB_TMO      128
#define XB_XCNT(j)  (256  + 64 * (j))
#define XB_XSUB(j)  (1280 + 64 * (j))
#define XB_XGEN(j)  (2304 + 64 * (j))
#define XB_TOP      3328
#define XB_TOPGEN   3392
#define XCD_BAR_WORDS 3456
#define XB_SPIN_CAP (1u << 18)
__device__ __forceinline__ unsigned xb_ld(unsigned* p)              { return __hip_atomic_load(p, __ATOMIC_RELAXED, __HIP_MEMORY_SCOPE_AGENT); }
__device__ __forceinline__ unsigned xb_add(unsigned* p, unsigned v) { return __hip_atomic_fetch_add(p, v, __ATOMIC_RELAXED, __HIP_MEMORY_SCOPE_AGENT); }
__device__ __forceinline__ unsigned xb_xcc_id() { return (unsigned)__builtin_amdgcn_s_getreg((3 << 11) | 20) & 0xFu; }
#define XB_SPIN(cond, bar) do { unsigned _sp = 0; while (cond) { __builtin_amdgcn_s_sleep(1); \
    if ((++_sp & 255u) == 0u) { if (xb_ld(&(bar)[XB_TMO])) break; if (_sp > XB_SPIN_CAP) { atomicAdd(&(bar)[XB_TMO], 1u); break; } } } } while (0)
struct XcdBarrier { unsigned* bar; unsigned x; volatile LAS unsigned* st; };
__device__ __forceinline__ XcdBarrier xcd_barrier_post(unsigned* bar, volatile LAS unsigned* st) {
    XcdBarrier b; b.bar = bar; b.x = xb_xcc_id(); b.st = st;
    if (threadIdx.x == 0) (void)xb_add(&bar[XB_XCNT(b.x)], 1u);
    return b;
}
__device__ __forceinline__ void xcd_barrier_complete(unsigned* bar, unsigned x, unsigned& nloc, unsigned& nx) {
    const unsigned G = gridDim.x * gridDim.y * gridDim.z;
    unsigned sum, cnt, mine, sp = 0u;
    for (;;) {
        sum = 0u; cnt = 0u; mine = 0u;
#pragma unroll
        for (unsigned j = 0; j < 16; ++j) { const unsigned c = xb_ld(&bar[XB_XCNT(j)]); sum += c; cnt += (c > 0u) ? 1u : 0u; mine = (j == x) ? c : mine; }
        if (sum == G) break;
        __builtin_amdgcn_s_sleep(1);
        if ((++sp & 255u) == 0u) { if (xb_ld(&bar[XB_TMO])) break; if (sp > XB_SPIN_CAP) { atomicAdd(&bar[XB_TMO], 1u); break; } }
    }
    nloc = mine > 0u ? mine : 1u; nx = cnt > 0u ? cnt : 1u;
}
__device__ __forceinline__ void xcd_barrier(const XcdBarrier& b) {
    asm volatile("s_waitcnt vmcnt(0)" ::: "memory");
    __syncthreads();
    if (threadIdx.x == 0) {
        unsigned* bar = b.bar;
        __builtin_amdgcn_s_waitcnt(0);
        unsigned nloc = b.st[0], nx = b.st[1];
        if (nloc == 0u) { xcd_barrier_complete(bar, b.x, nloc, nx); b.st[0] = nloc; b.st[1] = nx; }
        const unsigned old = xb_add(&bar[XB_XSUB(b.x)], 1u);
        const unsigned gen = old / nloc;
        if (old + 1u == (gen + 1u) * nloc) {
            __builtin_amdgcn_fence(__ATOMIC_RELEASE, "agent");
            asm volatile("s_waitcnt vmcnt(0)" ::: "memory");
            const unsigned og = xb_add(&bar[XB_TOP], 1u);
            const unsigned tg = og / nx;
            if (og + 1u == (tg + 1u) * nx) xb_add(&bar[XB_TOPGEN], 1u);
            else XB_SPIN(xb_ld(&bar[XB_TOPGEN]) == tg, bar);
            __builtin_amdgcn_fence(__ATOMIC_ACQUIRE, "agent");
            xb_add(&bar[XB_XGEN(b.x)], 1u);
            asm volatile("s_waitcnt vmcnt(0)" ::: "memory");
        } else {
            XB_SPIN(xb_ld(&bar[XB_XGEN(b.x)]) == gen, bar);
            __builtin_amdgcn_fence(__ATOMIC_ACQUIRE, "agent");
            asm volatile("s_waitcnt vmcnt(0)" ::: "memory");
        }
    }
    __syncthreads();
}

struct Args { const void* in[27]; float* out; unsigned char* ws; int ph_lo, ph_hi; };
struct Core { LAS unsigned char* lds; int tid, lane, wave, G, bid; };
struct Frame {
    LAS unsigned char* lds;
    int tid, lane, wave, G, bid;
    const float *x_p, *x_s, *c_p, *c_s, *cache_k, *cache_v, *cache_ki, *state_conv, *rel_bias, *w_ada, *b_ada, *w_in, *conv_w, *conv_b,
                *w_o_attn, *w_o_conv, *w_out, *ln1_g, *ln1_b, *ln2_g, *ln2_b, *peer_wq, *peer_k1, *peer_k2, *peer_u, *peer_v;
    const int* page_table;
    float* out; unsigned char* ws;
    float* MOD; bf16_t *WIN, *WOA, *WOC, *WOUT, *WQ, *K1, *K2, *PU, *PV, *H1, *PROJ, *OATT, *OCONV, *MERGED, *H2, *QP;
    float *WI, *T1, *GW; int *SEL, *EIDX;
};
constexpr int LDS_PTAB = LDS_BYTES - 512;
__device__ __forceinline__ unsigned char* ldptr(const Core& C, int k) {
    LAS const unsigned* p = (LAS const unsigned*)(C.lds + LDS_PTAB) + 2 * k;
    const unsigned lo = __builtin_amdgcn_readfirstlane(p[0]), hi = __builtin_amdgcn_readfirstlane(p[1]);
    return (unsigned char*)(((unsigned long long)hi << 32) | (unsigned long long)lo);
}
__device__ __forceinline__ void load_frame(Frame& F, const Core& C) {
    F.lds = C.lds; F.tid = C.tid; F.lane = C.lane; F.wave = C.wave; F.G = C.G; F.bid = C.bid;
    F.x_p = (const float*)ldptr(C, 0); F.x_s = (const float*)ldptr(C, 1); F.c_p = (const float*)ldptr(C, 2); F.c_s = (const float*)ldptr(C, 3);
    F.cache_k = (const float*)ldptr(C, 4); F.cache_v = (const float*)ldptr(C, 5); F.cache_ki = (const float*)ldptr(C, 6); F.state_conv = (const float*)ldptr(C, 7);
    F.page_table = (const int*)ldptr(C, 8); F.rel_bias = (const float*)ldptr(C, 9); F.w_ada = (const float*)ldptr(C, 10); F.b_ada = (const float*)ldptr(C, 11);
    F.w_in = (const float*)ldptr(C, 12); F.conv_w = (const float*)ldptr(C, 13); F.conv_b = (const float*)ldptr(C, 14); F.w_o_attn = (const float*)ldptr(C, 15);
    F.w_o_conv = (const float*)ldptr(C, 16); F.w_out = (const float*)ldptr(C, 17); F.ln1_g = (const float*)ldptr(C, 18); F.ln1_b = (const float*)ldptr(C, 19);
    F.ln2_g = (const float*)ldptr(C, 20); F.ln2_b = (const float*)ldptr(C, 21); F.peer_wq = (const float*)ldptr(C, 22); F.peer_k1 = (const float*)ldptr(C, 23);
    F.peer_k2 = (const float*)ldptr(C, 24); F.peer_u = (const float*)ldptr(C, 25); F.peer_v = (const float*)ldptr(C, 26);
    F.out = (float*)ldptr(C, 27);
    unsigned char* ws = ldptr(C, 28);
    F.MOD = (float*)(ws + WS_MOD); F.WIN = (bf16_t*)(ws + WS_WIN); F.WOA = (bf16_t*)(ws + WS_WOA); F.WOC = (bf16_t*)(ws + WS_WOC);
    F.WOUT = (bf16_t*)(ws + WS_WOUT); F.WQ = (bf16_t*)(ws + WS_WQ); F.K1 = (bf16_t*)(ws + WS_K1); F.K2 = (bf16_t*)(ws + WS_K2);
    F.PU = (bf16_t*)(ws + WS_PU); F.PV = (bf16_t*)(ws + WS_PV); F.H1 = (bf16_t*)(ws + WS_H1); F.PROJ = (bf16_t*)(ws + WS_PROJ);
    F.WI = (float*)(ws + WS_WI); F.SEL = (int*)(ws + WS_SEL); F.OATT = (bf16_t*)(ws + WS_OATT); F.OCONV = (bf16_t*)(ws + WS_OCONV);
    F.MERGED = (bf16_t*)(ws + WS_MERGED); F.T1 = (float*)(ws + WS_T1); F.H2 = (bf16_t*)(ws + WS_H2); F.QP = (bf16_t*)(ws + WS_QP);
    F.EIDX = (int*)(ws + WS_EIDX); F.GW = (float*)(ws + WS_GW);
}
__device__ __forceinline__ const float* x_row(const Frame& F, int m) { return m < NTP ? F.x_p + (size_t)m * D : F.x_s + (size_t)(m - NTP) * D; }
__device__ __forceinline__ int mod_row(int m) { return m < NTP ? (m >> 11) : NB_P + ((m - NTP) >> 3); }

constexpr int P0_MOD_ITEMS = 96;
constexpr int P0_T_WIN = 16 * 74, P0_T_WOA = 8 * 16, P0_T_WOC = 8 * 16, P0_T_WOUT = 16 * 16, P0_T_WQ = 16 * 16;
constexpr int P0_T_ITEMS = P0_T_WIN + P0_T_WOA + P0_T_WOC + P0_T_WOUT + P0_T_WQ;
constexpr int P0_CVT_ITEMS = 2 * (16384 * 1024 / 8192);
constexpr int P0_MISC_ITEMS = 1;
constexpr int P0_ITEMS = P0_MOD_ITEMS + P0_T_ITEMS + P0_CVT_ITEMS + P0_MISC_ITEMS;

__device__ __forceinline__ void p0_mod_item(const Frame& F, int ng) {
    LAS float* cs = (LAS float*)F.lds;
    LAS float* red = (LAS float*)(F.lds + 40 * 256 * 4);
    float acc[40];
#pragma unroll
    for (int r = 0; r < 40; ++r) acc[r] = 0.f;
    const int n = ng * 64 + F.lane;
    for (int kc = 0; kc < 4; ++kc) {
        __syncthreads();
#pragma unroll 1
        for (int hb = 0; hb < 2; ++hb) {
            float cv[10];
#pragma unroll
            for (int i = 0; i < 10; ++i) { const int e = F.tid + (hb * 10 + i) * NTHREADS; const int r = e >> 8, k = e & 255; cv[i] = (r < 8) ? F.c_p[r * D + kc * 256 + k] : F.c_s[(r - 8) * D + kc * 256 + k]; }
#pragma unroll
            for (int i = 0; i < 10; ++i) cs[F.tid + (hb * 10 + i) * NTHREADS] = cv[i];
        }
        __syncthreads();
        float wvv[32];
#pragma unroll
        for (int kk = 0; kk < 32; ++kk) wvv[kk] = F.w_ada[(size_t)(kc * 256 + F.wave * 32 + kk) * 6144 + n];
#pragma unroll
        for (int kk = 0; kk < 32; ++kk) {
            const int kl = F.wave * 32 + kk;
#pragma unroll
            for (int r = 0; r < 40; ++r) acc[r] += cs[r * 256 + kl] * wvv[kk];
        }
    }
#pragma unroll
    for (int r = 0; r < 40; ++r) red[(F.wave * 40 + r) * 64 + F.lane] = acc[r];
    __syncthreads();
    for (int e = F.tid; e < 40 * 64; e += NTHREADS) {
        const int r = e >> 6, l = e & 63; float s = F.b_ada[ng * 64 + l];
#pragma unroll
        for (int w = 0; w < 8; ++w) s += red[(w * 40 + r) * 64 + l];
        F.MOD[r * 6144 + ng * 64 + l] = s;
    }
    __syncthreads();
}
__device__ __forceinline__ void p0_transpose_tile(const Frame& F, const float* W, int N, int K, bf16_t* Wt, int kt, int nt, bool permute) {
    LAS bf16_t* tile = (LAS bf16_t*)F.lds;
    __syncthreads();
    { const int k = F.tid >> 3, c0 = (F.tid & 7) * 8;
      const float* rp = W + (size_t)(kt * 64 + k) * N + nt * 64 + c0;
      const f32x4 z = {0.f, 0.f, 0.f, 0.f};
      const f32x4 v0 = (nt * 64 + c0 < N) ? *(const f32x4*)rp : z, v1 = (nt * 64 + c0 + 4 < N) ? *(const f32x4*)(rp + 4) : z;
#pragma unroll
      for (int j = 0; j < 4; ++j) { tile[k * 66 + c0 + j] = f2bf(v0[j]); tile[k * 66 + c0 + 4 + j] = f2bf(v1[j]); } }
    __syncthreads();
    { const int nl = F.tid >> 3, k0 = (F.tid & 7) * 8; const int n = nt * 64 + nl;
      if (n < N) {
          int nd = n; if (permute) nd = (n < 1024) ? n : (n < 1028 ? C_WI + (n - 1024) : n - 4);
          unsigned p[4];
#pragma unroll
          for (int j = 0; j < 4; ++j) p[j] = (unsigned)tile[(k0 + 2 * j) * 66 + nl] | ((unsigned)tile[(k0 + 2 * j + 1) * 66 + nl] << 16);
          *(u32x4*)(Wt + (size_t)nd * K + kt * 64 + k0) = (u32x4){p[0], p[1], p[2], p[3]};
      } }
}
constexpr int P0_CVT32_ITEMS = 2 * (16384 / 32);
constexpr int P0_OTHER = P0_T_ITEMS + P0_CVT32_ITEMS + 1;
__device__ __forceinline__ void p0_other_item(const Frame& F, int i) {
    if (i < P0_T_ITEMS) {
        if (i < P0_T_WIN) { p0_transpose_tile(F, F.w_in, NMIX, D, F.WIN, i / 74, i % 74, true); return; }
        i -= P0_T_WIN;
        if (i < P0_T_WOA) { p0_transpose_tile(F, F.w_o_attn, D, 512, F.WOA, i / 16, i % 16, false); return; }
        i -= P0_T_WOA;
        if (i < P0_T_WOC) { p0_transpose_tile(F, F.w_o_conv, D, 512, F.WOC, i / 16, i % 16, false); return; }
        i -= P0_T_WOC;
        if (i < P0_T_WOUT) { p0_transpose_tile(F, F.w_out, D, D, F.WOUT, i / 16, i % 16, false); return; }
        i -= P0_T_WOUT;
        p0_transpose_tile(F, F.peer_wq, D, D, F.WQ, i / 16, i % 16, false); return;
    }
    i -= P0_T_ITEMS;
    if (i < P0_CVT32_ITEMS) {
        const float* src = (i < 512) ? F.peer_u : F.peer_v;
        unsigned char* dst = F.ws + ((i < 512) ? WS_PU8 : WS_PV8); float* sinv = (float*)(F.ws + ((i < 512) ? WS_SU : WS_SV));
        const int row0 = (i & 511) * 32 + F.wave * 4;
        f32x4 v[4][4];
#pragma unroll
        for (int rr = 0; rr < 4; ++rr)
#pragma unroll
            for (int q = 0; q < 4; ++q) v[rr][q] = *(const f32x4*)(src + (size_t)(row0 + rr) * D + F.lane * 16 + q * 4);
#pragma unroll
        for (int rr = 0; rr < 4; ++rr) {
            float am = 0.f;
#pragma unroll
            for (int q = 0; q < 4; ++q)
#pragma unroll
                for (int e = 0; e < 4; ++e) am = fmaxf(am, fabsf(v[rr][q][e]));
            am = wave_max(am);
            const float sc = am > 0.f ? 224.f / am : 1.f;
            unsigned wd[4];
#pragma unroll
            for (int q = 0; q < 4; ++q) { int t = 0; t = __builtin_amdgcn_cvt_pk_fp8_f32(v[rr][q][0] * sc, v[rr][q][1] * sc, t, false); t = __builtin_amdgcn_cvt_pk_fp8_f32(v[rr][q][2] * sc, v[rr][q][3] * sc, t, true); wd[q] = (unsigned)t; }
            *(u32x4*)(dst + (size_t)(row0 + rr) * D + F.lane * 16) = (u32x4){wd[0], wd[1], wd[2], wd[3]};
            if (F.lane == 0) sinv[row0 + rr] = am > 0.f ? am * (1.f / 224.f) : 1.f;
        }
        return;
    }
    for (int e = F.tid; e < (4864 - NMIX) * D; e += NTHREADS) F.WIN[(size_t)NMIX * D + e] = 0;
    for (int e = F.tid; e < 128 * 64; e += NTHREADS) { F.K1[e] = f2bf(F.peer_k1[e]); F.K2[e] = f2bf(F.peer_k2[e]); }
}
__device__ __forceinline__ void p0_prologue(const Frame& F) {
    constexpr int NMODWG = P0_MOD_ITEMS, HEAD = 8;
    if (F.G <= NMODWG) {
        for (int it = F.bid; it < P0_MOD_ITEMS + P0_OTHER; it += F.G) { if (it < P0_MOD_ITEMS) p0_mod_item(F, it); else p0_other_item(F, it - P0_MOD_ITEMS); }
        return;
    }
    const int nfree = F.G - NMODWG;
    int head_items = HEAD * nfree; if (head_items > P0_OTHER) head_items = P0_OTHER;
    if (F.bid < NMODWG) p0_mod_item(F, F.bid);
    else for (int j = F.bid - NMODWG; j < head_items; j += nfree) p0_other_item(F, j);
    for (int j = head_items + F.bid; j < P0_OTHER; j += F.G) p0_other_item(F, j);
}

__device__ __forceinline__ void p1_modulate(const Frame& F) {
    const int stride = F.G * 8;
    for (int m0 = F.bid * 8 + F.wave; m0 < NT; m0 += 2 * stride) {
        f32x4 xv[2][4], sv[2][4], hv[2][4];
#pragma unroll
        for (int rr = 0; rr < 2; ++rr) {
            const int m = (m0 + rr * stride < NT) ? m0 + rr * stride : m0;
            const float* xr = x_row(F, m); const float* mr = F.MOD + (size_t)mod_row(m) * 6144;
#pragma unroll
            for (int q = 0; q < 4; ++q) {
                const int e = (q >> 1) * 512 + F.lane * 8 + (q & 1) * 4;
                xv[rr][q] = *(const f32x4*)(xr + e); sv[rr][q] = *(const f32x4*)(mr + 1024 + e); hv[rr][q] = *(const f32x4*)(mr + e);
            }
        }
#pragma unroll
        for (int rr = 0; rr < 2; ++rr) {
            const int m = m0 + rr * stride;
            if (m >= NT) continue;
#pragma unroll
            for (int hlf = 0; hlf < 2; ++hlf) {
                const f32x4 a = xv[rr][2 * hlf] * (sv[rr][2 * hlf] + 1.f) + hv[rr][2 * hlf], b2 = xv[rr][2 * hlf + 1] * (sv[rr][2 * hlf + 1] + 1.f) + hv[rr][2 * hlf + 1];
                *(u32x4*)(F.H1 + (size_t)m * D + hlf * 512 + F.lane * 8) = (u32x4){cvt_pk_bf16(a[0], a[1]), cvt_pk_bf16(a[2], a[3]), cvt_pk_bf16(b2[0], b2[1]), cvt_pk_bf16(b2[2], b2[3])};
            }
        }
    }
}

constexpr int BM = 256, BN = 128, BK = 64;
constexpr int XPANEL = BM * 32 + 32, WPANEL = BN * 32 + 32;
constexpr int XSTAGE = 4 * XPANEL, WSTAGE = 4 * WPANEL, GSTAGE = XSTAGE + WSTAGE;
__device__ __forceinline__ void gemm_accum(const Frame& F, f32x16 (&acc)[2][2], const bf16_t* __restrict__ X, int ldx, const bf16_t* __restrict__ W, int ldw, int K, int m0, int n0) {
    const int tid = F.tid, lane = F.lane, r = lane & 31, h = lane >> 5, wm = F.wave >> 1, wn = F.wave & 1;
    u32x4 xr[4], wr[2];
    const int nk = K / BK;
    const int crow = tid >> 3, ckc = tid & 7;
    const bf16_t* xg = X + (size_t)(m0 + crow) * ldx + ckc * 8;
    const bf16_t* wg = W + (size_t)(n0 + crow) * ldw + ckc * 8;
    const int ldso = (ckc >> 1) * 1  ;
    const int xoff = ldso * XPANEL + crow * 32 + (ckc & 1) * 16;
    const int woff = ldso * WPANEL + crow * 32 + (ckc & 1) * 16;
#pragma unroll
    for (int i = 0; i < 4; ++i) xr[i] = *(const u32x4*)(xg + (size_t)(64 * i) * ldx);
#pragma unroll
    for (int i = 0; i < 2; ++i) wr[i] = *(const u32x4*)(wg + (size_t)(64 * i) * ldw);
    __syncthreads();
    for (int kt = 0; kt < nk; ++kt) {
        LAS unsigned char* st = F.lds + (kt & 1) * GSTAGE;
#pragma unroll
        for (int i = 0; i < 4; ++i) *(LAS u32x4*)(st + xoff + i * 64 * 32) = xr[i];
#pragma unroll
        for (int i = 0; i < 2; ++i) *(LAS u32x4*)(st + XSTAGE + woff + i * 64 * 32) = wr[i];
        __syncthreads();
        if (kt + 1 < nk) {
#pragma unroll
            for (int i = 0; i < 4; ++i) xr[i] = *(const u32x4*)(xg + (size_t)(64 * i) * ldx + (kt + 1) * BK);
#pragma unroll
            for (int i = 0; i < 2; ++i) wr[i] = *(const u32x4*)(wg + (size_t)(64 * i) * ldw + (kt + 1) * BK);
        }
#pragma unroll
        for (int s = 0; s < 4; ++s) {
            bf16x8 a[2], b[2];
#pragma unroll
            for (int ni = 0; ni < 2; ++ni) a[ni] = *(LAS bf16x8*)(st + XSTAGE + s * WPANEL + (wn * 64 + ni * 32 + r) * 32 + h * 16);
#pragma unroll
            for (int mi = 0; mi < 2; ++mi) b[mi] = *(LAS bf16x8*)(st + s * XPANEL + (wm * 64 + mi * 32 + r) * 32 + h * 16);
#pragma unroll
            for (int mi = 0; mi < 2; ++mi)
#pragma unroll
                for (int ni = 0; ni < 2; ++ni) acc[mi][ni] = __builtin_amdgcn_mfma_f32_32x32x16_bf16(a[ni], b[mi], acc[mi][ni], 0, 0, 0);
        }
    }
}
#define GEMM_EPI_LOOP(...) \
    { const int r_ = F.lane & 31, h_ = F.lane >> 5, wm_ = F.wave >> 1, wn_ = F.wave & 1; \
      _Pragma("unroll") for (int mi = 0; mi < 2; ++mi) _Pragma("unroll") for (int ni = 0; ni < 2; ++ni) _Pragma("unroll") for (int g = 0; g < 4; ++g) { \
          const int m = m0 + wm_ * 64 + mi * 32 + r_; const int n = n0 + wn_ * 64 + ni * 32 + 8 * g + 4 * h_; __VA_ARGS__ } }
#define ACC4(A) ((f32x4){A[mi][ni][4 * g], A[mi][ni][4 * g + 1], A[mi][ni][4 * g + 2], A[mi][ni][4 * g + 3]})
__device__ __forceinline__ void zero_acc(f32x16 (&acc)[2][2]) {
#pragma unroll
    for (int mi = 0; mi < 2; ++mi)
#pragma unroll
        for (int ni = 0; ni < 2; ++ni)
#pragma unroll
            for (int e = 0; e < 16; ++e) acc[mi][ni][e] = 0.f;
}
__device__ __forceinline__ u32x2 pk4(const f32x4 v) { return (u32x2){cvt_pk_bf16(v[0], v[1]), cvt_pk_bf16(v[2], v[3])}; }

__device__ __forceinline__ void gemm_slice8(const Frame& F, f32x16 (&sacc)[1][1], const bf16_t* __restrict__ X, int ldx, const bf16_t* __restrict__ W, int ldw, int K, int m0, int n0) {
    const int r = F.lane & 31, h = F.lane >> 5, wq = F.wave & 3, kh = F.wave >> 2;
    const bf16_t* wp = W + (size_t)(n0 + 32 * wq + r) * ldw + kh * (K / 2) + h * 8;
    const bf16_t* xp = X + (size_t)(m0 + (r & 7)) * ldx + kh * (K / 2) + h * 8;
    f32x16 c;
#pragma unroll
    for (int e = 0; e < 16; ++e) c[e] = 0.f;
#pragma unroll 1
    for (int k0 = 0; k0 < K / 2; k0 += 128) {
        bf16x8 a[8], b[8];
#pragma unroll
        for (int t = 0; t < 8; ++t) { a[t] = *(const bf16x8*)(wp + k0 + t * 16); b[t] = *(const bf16x8*)(xp + k0 + t * 16); }
#pragma unroll
        for (int t = 0; t < 8; ++t) c = __builtin_amdgcn_mfma_f32_32x32x16_bf16(a[t], b[t], c, 0, 0, 0);
    }
    LAS float* cb = (LAS float*)F.lds + wq * (16 * 64);
    __syncthreads();
    if (kh == 1) {
#pragma unroll
        for (int e = 0; e < 16; ++e) cb[e * 64 + F.lane] = c[e];
    }
    __syncthreads();
    if (kh == 0) {
#pragma unroll
        for (int e = 0; e < 16; ++e) c[e] += cb[e * 64 + F.lane];
    }
    sacc[0][0] = c;
}
#define SLICE_EPI_LOOP(...) \
    if (F.wave < 4 && (F.lane & 31) < 8) { const int h_ = F.lane >> 5, wq_ = F.wave & 3; constexpr int mi = 0, ni = 0; \
      _Pragma("unroll") for (int g = 0; g < 4; ++g) { const int m = m0 + (F.lane & 31); const int n = n0 + wq_ * 32 + 8 * g + 4 * h_; __VA_ARGS__ } }

namespace pg8 {
#define PG8_LAS __attribute__((address_space(3)))
typedef unsigned short bf16_t;
typedef short bf16x8 __attribute__((ext_vector_type(8)));
typedef float f32x4 __attribute__((ext_vector_type(4)));
typedef unsigned u32x4 __attribute__((ext_vector_type(4)));
constexpr int BM = 256, BK = 64, HALF = 128, HTB = HALF * BK * 2  , STAGE_BYTES = 8 * HTB, NXCD = 8, WGM = 8;

__host__ __device__ __forceinline__ int lds_byte(int r, int c) { const int st = (r >> 4) * 2 + (c >> 5), rr = r & 15, cc = c & 31, ob = rr * 64 + cc * 2; return st * 1024 + (ob ^ (((ob >> 9) & 1) << 5)); }
__host__ __device__ __forceinline__ void stage_rc(int b, int& R, int& C) { const int st = b / 1024, sb = b % 1024, swz = sb ^ (((sb >> 9) & 1) << 5); R = (st >> 1) * 16 + swz / 64; C = (st & 1) * 32 + (swz % 64) / 2; }
__host__ __device__ __forceinline__ int perm32(int rho) { const int n = rho >> 4, i = rho & 15; return 8 * (i >> 2) + 4 * n + (i & 3); }

struct Unit { int pm, pn; };
struct Gemm { const bf16_t* A; const bf16_t* Bt; int M, N, K; };

struct StaticOrder {
    int nM, nN, nwg, G, c;
    __host__ __device__ void init(int M, int N, int G_, int c_) { nM = M / BM; nN = N / BM; nwg = nM * nN; G = G_; c = c_; }
    __host__ __device__ bool next(int i, Unit& u) const {
        const long L = (long)i * G + c; if (L >= nwg) return false;
        int wgid = (int)L; { const int q = nwg / NXCD, r = nwg % NXCD, xcd = wgid % NXCD, off = wgid / NXCD; wgid = (xcd < r ? xcd * (q + 1) : r * (q + 1) + (xcd - r) * q) + off; }
        const int nig = WGM * nN, gid = wgid / nig, fm = gid * WGM, gsz = (nM - fm) < WGM ? (nM - fm) : WGM;
        u.pm = fm + ((wgid % nig) % gsz); u.pn = (wgid % nig) / gsz; return true;
    }
    __device__ __forceinline__ void a_ready(const Unit&) const {}
    __device__ __forceinline__ void done(const Unit&) const {}
};

template <class Body> struct EpiRC {
    static constexpr bool PERM = false, AFTER_DRAIN = false;
    Body body;
    __device__ __forceinline__ void operator()(const f32x4 (&acc)[2][2][4][2], const Unit& u, int wr, int wc, int fr, int fq) const {
#pragma unroll
        for (int ai = 0; ai < 2; ++ai)
#pragma unroll
            for (int m = 0; m < 4; ++m) {
                const int row = u.pm * BM + ai * HALF + wr * 64 + m * 16 + fr;
#pragma unroll
                for (int bj = 0; bj < 2; ++bj)
#pragma unroll
                    for (int n = 0; n < 2; ++n) body(row, u.pn * BM + bj * HALF + wc * 32 + n * 16 + 4 * fq, acc[ai][bj][m][n]);
            }
    }
};
template <class Epi, class Sched, bool ALIGN_EPI = false, bool SP2 = false>
__device__ __forceinline__ void gemm_phase(PG8_LAS unsigned char* lds, const Gemm g, const Sched& S, const Epi& E) {
    const int tid = threadIdx.x, wid = __builtin_amdgcn_readfirstlane(tid >> 6), lane = tid & 63, wr = wid >> 2, wc = wid & 3, fr = lane & 15, fq = lane >> 4;
    const int K = g.K, nt = K / BK;
    unsigned voffA[2], voffB[2];
#pragma unroll
    for (int i = 0; i < 2; ++i) { int R, C; stage_rc(tid * 16 + i * 8192, R, C); const int Rb = Epi::PERM ? ((R & ~31) + perm32(R & 31)) : R;
        voffA[i] = (unsigned)(R * K + C) * 2u; voffB[i] = (unsigned)(Rb * K + C) * 2u; }
    const size_t kstep = (size_t)(BK * 2);
    const size_t hstep = (size_t)HALF * K * 2;
    const size_t tstep = 2 * hstep;
    const unsigned ldsw = (unsigned)wid * 1024u;
    const int aoff = lds_byte(wr * 64 + fr, fq * 8), boff = lds_byte(wc * 32 + fr, fq * 8);
#define PG8_SA(b, h) (((b) * 2 + (h)) * HTB)
#define PG8_SB(b, h) ((4 + (b) * 2 + (h)) * HTB)
#define PG8_STAGE(bufoff, gbase, voff) do { _Pragma("unroll") for (int _i = 0; _i < 2; ++_i) \
        __builtin_amdgcn_global_load_lds((const unsigned*)((const char*)(gbase) + (voff)[_i]), (PG8_LAS unsigned*)(lds + (bufoff) + ldsw + _i * 8192), 16, 0, 0); } while (0)
#define PG8_LDA(dst, b, h) do { _Pragma("unroll") for (int m = 0; m < 4; ++m) _Pragma("unroll") for (int k = 0; k < 2; ++k) dst[m][k] = *(const PG8_LAS bf16x8*)(lds + PG8_SA(b, h) + aoff + m * 2048 + k * 1024); } while (0)
#define PG8_LDB(dst, b, h) do { _Pragma("unroll") for (int n = 0; n < 2; ++n) _Pragma("unroll") for (int k = 0; k < 2; ++k) dst[n][k] = *(const PG8_LAS bf16x8*)(lds + PG8_SB(b, h) + boff + n * 2048 + k * 1024); } while (0)
#define PG8_MMA(ai, bj, At, Bt) do { __builtin_amdgcn_s_setprio(1); _Pragma("unroll") for (int m = 0; m < 4; ++m) _Pragma("unroll") for (int n = 0; n < 2; ++n) _Pragma("unroll") for (int k = 0; k < 2; ++k) \
        acc[ai][bj][m][n] = __builtin_amdgcn_mfma_f32_16x16x32_bf16(Bt[n][k], At[m][k], acc[ai][bj][m][n], 0, 0, 0); __builtin_amdgcn_s_setprio(0); } while (0)
#define PG8_WAIT_V(n) asm volatile("s_waitcnt vmcnt(" #n ")" ::: "memory")
#define PG8_WAIT_L(n) asm volatile("s_waitcnt lgkmcnt(" #n ")" ::: "memory")
#define PG8_BAR __builtin_amdgcn_s_barrier()
#define PG8_SCHED __builtin_amdgcn_sched_barrier(0)
    Unit cur, nxt; int ui = 0;
    if (!S.next(0, cur)) return;
    f32x4 acc[2][2][4][2];
#pragma unroll
    for (int a = 0; a < 2; ++a)
#pragma unroll
        for (int b = 0; b < 2; ++b)
#pragma unroll
            for (int m = 0; m < 4; ++m)
#pragma unroll
                for (int n = 0; n < 2; ++n) acc[a][b][m][n] = (f32x4){0.f, 0.f, 0.f, 0.f};
    bf16x8 At[4][2], B0[2][2], B1[2][2];
    const char* cA = (const char*)g.A + (size_t)cur.pm * tstep; const char* cB = (const char*)g.Bt + (size_t)cur.pn * tstep;
    S.a_ready(cur);
    if constexpr (SP2) {
        PG8_STAGE(PG8_SB(0, 0), cB, voffB); PG8_STAGE(PG8_SB(0, 1), cB + hstep, voffB); PG8_STAGE(PG8_SA(0, 0), cA, voffA); PG8_STAGE(PG8_SA(0, 1), cA + hstep, voffA);
        if (wr == 1) PG8_BAR;
        PG8_WAIT_V(2); PG8_BAR;
        PG8_STAGE(PG8_SB(1, 0), cB + kstep, voffB); PG8_STAGE(PG8_SA(1, 0), cA + kstep, voffA); PG8_STAGE(PG8_SB(1, 1), cB + hstep + kstep, voffB);
        PG8_WAIT_V(6); PG8_BAR;
    } else {
        PG8_STAGE(PG8_SB(0, 0), cB, voffB); PG8_STAGE(PG8_SA(0, 0), cA, voffA); PG8_STAGE(PG8_SB(0, 1), cB + hstep, voffB); PG8_STAGE(PG8_SA(0, 1), cA + hstep, voffA);
        if (wr == 1) PG8_BAR;
        PG8_WAIT_V(4); PG8_BAR;
        PG8_STAGE(PG8_SB(1, 0), cB + kstep, voffB); PG8_STAGE(PG8_SA(1, 0), cA + kstep, voffA); PG8_STAGE(PG8_SB(1, 1), cB + hstep + kstep, voffB);
        PG8_WAIT_V(6); PG8_BAR;
    }
    for (;;) {
        const bool has_next = S.next(ui + 1, nxt);
        const char* nA = has_next ? (const char*)g.A + (size_t)nxt.pm * tstep : cA; const char* nB = has_next ? (const char*)g.Bt + (size_t)nxt.pn * tstep : cB;
        for (int t = 0; t < nt; t += 2) {
            const bool last = (t == nt - 2);
            const char* a1 = cA + (size_t)(t + 1) * kstep;
            const char* a2 = last ? nA : cA + (size_t)(t + 2) * kstep; const char* b2 = last ? nB : cB + (size_t)(t + 2) * kstep;
            const char* a3 = a2 + kstep; const char* b3 = b2 + kstep;
            if (last && has_next) S.a_ready(nxt);
            if constexpr (SP2) {
            PG8_LDB(B0, 0, 0); PG8_LDB(B1, 0, 1); PG8_SCHED; PG8_LDA(At, 0, 0); PG8_STAGE(PG8_SA(1, 1), a1 + hstep, voffA);
            PG8_WAIT_V(8); PG8_WAIT_L(0); PG8_BAR; PG8_MMA(0, 0, At, B0); PG8_MMA(0, 1, At, B1); PG8_BAR; PG8_SCHED;
            PG8_LDA(At, 0, 1); PG8_STAGE(PG8_SB(0, 0), b2, voffB); PG8_STAGE(PG8_SB(0, 1), b2 + hstep, voffB); PG8_STAGE(PG8_SA(0, 0), a2, voffA);
            PG8_WAIT_V(8); PG8_WAIT_L(0); PG8_BAR; PG8_MMA(1, 0, At, B0); PG8_MMA(1, 1, At, B1); PG8_BAR; PG8_SCHED;
            PG8_LDB(B0, 1, 0); PG8_LDB(B1, 1, 1); PG8_SCHED; PG8_LDA(At, 1, 0); PG8_STAGE(PG8_SA(0, 1), a2 + hstep, voffA);
            PG8_WAIT_V(8); PG8_WAIT_L(0); PG8_BAR; PG8_MMA(0, 0, At, B0); PG8_MMA(0, 1, At, B1); PG8_BAR; PG8_SCHED;
            PG8_LDA(At, 1, 1); PG8_STAGE(PG8_SB(1, 0), b3, voffB); PG8_STAGE(PG8_SB(1, 1), b3 + hstep, voffB); PG8_STAGE(PG8_SA(1, 0), a3, voffA);
            PG8_WAIT_V(8); PG8_WAIT_L(0); PG8_BAR; PG8_MMA(1, 0, At, B0); PG8_MMA(1, 1, At, B1); PG8_BAR; PG8_SCHED;
            } else {
            PG8_LDB(B0, 0, 0); PG8_SCHED; PG8_LDA(At, 0, 0); PG8_STAGE(PG8_SA(1, 1), a1 + hstep, voffA);
            PG8_WAIT_L(8); PG8_BAR; PG8_WAIT_L(0); PG8_MMA(0, 0, At, B0); PG8_BAR; PG8_SCHED;
            PG8_LDB(B1, 0, 1); PG8_STAGE(PG8_SB(0, 0), b2, voffB);
            PG8_BAR; PG8_WAIT_L(0); PG8_MMA(0, 1, At, B1); PG8_BAR;
            PG8_LDA(At, 0, 1); PG8_STAGE(PG8_SA(0, 0), a2, voffA);
            PG8_BAR; PG8_WAIT_L(0); PG8_MMA(1, 0, At, B0); PG8_BAR; PG8_SCHED;
            PG8_STAGE(PG8_SB(0, 1), b2 + hstep, voffB);
            PG8_WAIT_V(6); PG8_BAR; PG8_MMA(1, 1, At, B1); PG8_BAR;
            PG8_LDB(B0, 1, 0); PG8_SCHED; PG8_LDA(At, 1, 0); PG8_STAGE(PG8_SA(0, 1), a2 + hstep, voffA);
            PG8_WAIT_L(8); PG8_BAR; PG8_WAIT_L(0); PG8_MMA(0, 0, At, B0); PG8_BAR; PG8_SCHED;
            PG8_LDB(B1, 1, 1); PG8_STAGE(PG8_SB(1, 0), b3, voffB);
            PG8_BAR; PG8_WAIT_L(0); PG8_MMA(0, 1, At, B1); PG8_BAR;
            PG8_LDA(At, 1, 1); PG8_STAGE(PG8_SA(1, 0), a3, voffA);
            PG8_BAR; PG8_WAIT_L(0); PG8_MMA(1, 0, At, B0); PG8_BAR; PG8_SCHED;
            PG8_STAGE(PG8_SB(1, 1), b3 + hstep, voffB);
            PG8_WAIT_V(6); PG8_BAR; PG8_MMA(1, 1, At, B1); PG8_BAR;
            }
        }
        if constexpr (ALIGN_EPI) { if (wr == 0) PG8_BAR; }
        if constexpr (!Epi::AFTER_DRAIN) { E(acc, cur, wr, wc, fr, fq); S.done(cur); }
        if (!has_next) break;
#pragma unroll
        for (int a = 0; a < 2; ++a)
#pragma unroll
            for (int b = 0; b < 2; ++b)
#pragma unroll
                for (int m = 0; m < 4; ++m)
#pragma unroll
                    for (int n = 0; n < 2; ++n) acc[a][b][m][n] = (f32x4){0.f, 0.f, 0.f, 0.f};
        cur = nxt; cA = nA; cB = nB; ++ui;
        if constexpr (ALIGN_EPI) { if (wr == 1) PG8_BAR; }
    }
    PG8_WAIT_V(0);
    if constexpr (!ALIGN_EPI) { if (wr == 0) PG8_BAR; }
    PG8_BAR;
    if constexpr (Epi::AFTER_DRAIN) { E.fused(acc, cur, wr, wc, fr, fq, lds, wid, lane); S.done(cur); }
#undef PG8_SA
#undef PG8_SB
#undef PG8_STAGE
#undef PG8_LDA
#undef PG8_LDB
#undef PG8_MMA
#undef PG8_WAIT_V
#undef PG8_WAIT_L
#undef PG8_BAR
#undef PG8_SCHED
}
}

constexpr int NMIXW = 4864;
struct P2Body {
    const Frame* Fp;
    __device__ __forceinline__ void operator()(int m, int n, const f32x4 v) const {
        const Frame& F = *Fp;
        if (n >= NMIXP) return;
        *(u32x2*)(F.PROJ + (size_t)m * NMIXP + n) = pk4(v);
        if (n >= C_K && n < C_QI) {
            float* o = (n < C_V) ? (m < NTP ? F.out + O_KP + (size_t)m * 128 + (n - C_K) : F.out + O_KS + (size_t)(m - NTP) * 128 + (n - C_K))
                                 : (m < NTP ? F.out + O_VP + (size_t)m * 128 + (n - C_V) : F.out + O_VS + (size_t)(m - NTP) * 128 + (n - C_V));
            *(f32x4*)o = v;
            if (n >= C_V && m < NTP) {
                bf16_t* vt = (bf16_t*)(F.ws + WS_VT) + ((size_t)((m >> 11) * 2 + ((n - C_V) >> 6)) * 64 + ((n - C_V) & 63)) * SEQ + (m & 2047);
                vt[0] = f2bf(v[0]); vt[SEQ] = f2bf(v[1]); vt[2 * SEQ] = f2bf(v[2]); vt[3 * SEQ] = f2bf(v[3]);
            }
        } else if (n >= C_KI && n < C_BG) {
            float* o = m < NTP ? F.out + O_KIP + (size_t)m * 64 + (n - C_KI) : F.out + O_KIS + (size_t)(m - NTP) * 64 + (n - C_KI);
            *(f32x4*)o = v;
        } else if (n == C_WI) {
            *(f32x4*)(F.WI + (size_t)m * 4) = v;
        } else if (n >= C_CG && n < C_GA) {
            const int tt = (m < NTP) ? (m & 2047) - (SEQ - 2) : ((m - NTP) & 7) - (TS - 2);
            if (tt >= 0) {
                const int rowi = (m < NTP) ? (m >> 11) * 2 + tt : 2 * NB_P + ((m - NTP) >> 3) * 2 + tt;
                *(f32x4*)((float*)(F.ws + WS_CGX) + (size_t)rowi * 1024 + (n - C_CG)) = v;
            }
        }
    }
};
__device__ __forceinline__ void p2_gemm_in(const Frame& F) {
    pg8::Gemm g{F.H1, F.WIN, NT, NMIXW, D};
    pg8::StaticOrder S; S.init(NT, NMIXW, F.G, F.bid);
    pg8::EpiRC<P2Body> E{P2Body{&F}};
    pg8::gemm_phase<pg8::EpiRC<P2Body>, pg8::StaticOrder, true, true>(F.lds, g, S, E);
}

constexpr int SROW = 2052;
__device__ __forceinline__ int wave_sum_i(int v) {
#pragma unroll
    for (int o = 32; o >= 1; o >>= 1) v += __shfl_xor(v, o);
    return v;
}
__device__ __forceinline__ void cnt_ge(int& c, unsigned u, unsigned t) { asm("v_cmp_ge_u32_e32 vcc, %1, %2\n\tv_addc_co_u32_e32 %0, vcc, 0, %0, vcc" : "+v"(c) : "v"(u), "v"(t) : "vcc"); }
__device__ __forceinline__ void cnt_gt(int& c, unsigned u, unsigned t) { asm("v_cmp_gt_u32_e32 vcc, %1, %2\n\tv_addc_co_u32_e32 %0, vcc, 0, %0, vcc" : "+v"(c) : "v"(u), "v"(t) : "vcc"); }
__device__ __forceinline__ void cnt_eq(int& c, unsigned u, unsigned t) { asm("v_cmp_eq_u32_e32 vcc, %1, %2\n\tv_addc_co_u32_e32 %0, vcc, 0, %0, vcc" : "+v"(c) : "v"(u), "v"(t) : "vcc"); }
__device__ __forceinline__ void cnt_lt4(int& cl, unsigned u0, unsigned u1, unsigned u2, unsigned u3, unsigned t) {
    int d0, d1, d2, d3;
    asm("v_sub_u32 %1, %5, %9\n\tv_sub_u32 %2, %6, %9\n\tv_sub_u32 %3, %7, %9\n\tv_sub_u32 %4, %8, %9\n\t"
        "v_lshrrev_b32 %1, 31, %1\n\tv_lshrrev_b32 %2, 31, %2\n\tv_lshrrev_b32 %3, 31, %3\n\tv_lshrrev_b32 %4, 31, %4\n\t"
        "v_add3_u32 %0, %0, %1, %2\n\tv_add3_u32 %0, %0, %3, %4"
        : "+v"(cl), "=&v"(d0), "=&v"(d1), "=&v"(d2), "=&v"(d3) : "v"(u0), "v"(u1), "v"(u2), "v"(u3), "v"(t));
}
__device__ __forceinline__ void cnt_eq_pos(int& c, unsigned u, unsigned t, int L) {
    int tmp;
    asm("v_cmp_eq_u32_e32 vcc, %2, %3\n\tv_cndmask_b32_e32 %1, %5, %4, vcc\n\tv_cmp_lt_i32_e32 vcc, 0, %1\n\tv_addc_co_u32_e32 %0, vcc, 0, %0, vcc"
        : "+v"(c), "=&v"(tmp) : "v"(u), "v"(t), "v"(L), "v"(0x80000000) : "vcc");
}
__device__ __forceinline__ int wave_sum_i_dpp(int v) {
    v += __builtin_amdgcn_update_dpp(0, v, 0xB1, 0xF, 0xF, false);
    v += __builtin_amdgcn_update_dpp(0, v, 0x4E, 0xF, 0xF, false);
    v += __builtin_amdgcn_update_dpp(0, v, 0x141, 0xF, 0xF, false);
    v += __builtin_amdgcn_update_dpp(0, v, 0x140, 0xF, 0xF, false);
    v += __builtin_amdgcn_update_dpp(0, v, 0x142, 0xA, 0xF, false);
    v += __builtin_amdgcn_update_dpp(0, v, 0x143, 0xC, 0xF, false);
    return __builtin_amdgcn_readlane(v, 63);
}
template <int NV> __device__ __forceinline__ void select_threshold(const unsigned (&u)[NV], int ksel, int idx_bits, int lane, unsigned& T_out, int& Jx_out, int& ngt_out) {
    unsigned T = 0;
#pragma unroll 1
    for (int bit = 31; bit >= 0; --bit) {
        const unsigned cand = T | (1u << bit);
        int c = 0;
#pragma unroll
        for (int i = 0; i < NV; ++i) cnt_ge(c, u[i], cand);
        c = wave_sum_i_dpp(c);
        if (c >= ksel) T = cand;
    }
    int cg = 0, ce = 0;
#pragma unroll
    for (int i = 0; i < NV; ++i) { cnt_gt(cg, u[i], T); cnt_eq(ce, u[i], T); }
    const int ngt = wave_sum_i_dpp(cg), neq = wave_sum_i_dpp(ce);
    const int need = ksel - ngt;
    int Jx = 0x3FFFFFFF;
    if (need < neq) {
        int Jb = 0;
#pragma unroll 1
        for (int bit = idx_bits - 1; bit >= 0; --bit) {
            const int cand = Jb | (1 << bit);
            const int L = cand - lane;
            int c = 0;
#pragma unroll
            for (int i = 0; i < NV; ++i) cnt_eq_pos(c, u[i], T, L - 64 * i);
            c = wave_sum_i_dpp(c);
            if (c < need) Jb = cand;
        }
        Jx = Jb + 1;
    }
    T_out = T; Jx_out = Jx; ngt_out = ngt;
}
template <int NV> __device__ __forceinline__ void select_threshold2(const unsigned (&ua)[NV], const unsigned (&ub)[NV], int ksel, int idx_bits, int lane, int ng,
                                                                   unsigned& Ta_out, int& Jxa_out, unsigned& Tb_out, int& Jxb_out) {
    unsigned Ta = 0, Tb = 0;
    bool da = false, db = false;
#pragma unroll 1
    for (int bit = 30; bit >= 0 && !(da && db); --bit) {
        const unsigned ca = da ? Ta : (Ta | (1u << bit)), cb = db ? Tb : (Tb | (1u << bit));
        int la = 0, lb = 0;
#pragma unroll
        for (int i = 0; i < NV; i += 4) { if (i < 4 * ng) { cnt_lt4(la, ua[i], ua[i + 1], ua[i + 2], ua[i + 3], ca); cnt_lt4(lb, ub[i], ub[i + 1], ub[i + 2], ub[i + 3], cb); } }
        const int na = ng * 256 - wave_sum_i_dpp(la), nb = ng * 256 - wave_sum_i_dpp(lb);
        if (!da && na >= ksel) { Ta = ca; da = (na == ksel); }
        if (!db && nb >= ksel) { Tb = cb; db = (nb == ksel); }
    }
    int ga = 0, ea = 0, gb = 0, eb = 0;
#pragma unroll
    for (int i = 0; i < NV; ++i) { cnt_gt(ga, ua[i], Ta); cnt_eq(ea, ua[i], Ta); cnt_gt(gb, ub[i], Tb); cnt_eq(eb, ub[i], Tb); }
    const int needa = ksel - wave_sum_i_dpp(ga), neqa = wave_sum_i_dpp(ea), needb = ksel - wave_sum_i_dpp(gb), neqb = wave_sum_i_dpp(eb);
    int Jxa = 0x3FFFFFFF, Jxb = 0x3FFFFFFF;
    if (needa < neqa) {
        int Jb = 0;
#pragma unroll 1
        for (int bit = idx_bits - 1; bit >= 0; --bit) {
            const int cand = Jb | (1 << bit); const int L = cand - lane; int c = 0;
#pragma unroll
            for (int i = 0; i < NV; ++i) cnt_eq_pos(c, ua[i], Ta, L - 64 * i);
            if (wave_sum_i_dpp(c) < needa) Jb = cand;
        }
        Jxa = Jb + 1;
    }
    if (needb < neqb) {
        int Jb = 0;
#pragma unroll 1
        for (int bit = idx_bits - 1; bit >= 0; --bit) {
            const int cand = Jb | (1 << bit); const int L = cand - lane; int c = 0;
#pragma unroll
            for (int i = 0; i < NV; ++i) cnt_eq_pos(c, ub[i], Tb, L - 64 * i);
            if (wave_sum_i_dpp(c) < needb) Jb = cand;
        }
        Jxb = Jb + 1;
    }
    Ta_out = Ta; Jxa_out = Jxa; Tb_out = Tb; Jxb_out = Jxb;
}
template <int NV> __device__ __forceinline__ void select_topk(const unsigned (&u)[NV], int ksel, int idx_bits, int* sel, int lane) {
    unsigned T; int Jx, ngt;
    select_threshold<NV>(u, ksel, idx_bits, lane, T, Jx, ngt);
    const int L = Jx - lane;
    int cg = 0, ct = 0;
#pragma unroll
    for (int i = 0; i < NV; ++i) { cnt_gt(cg, u[i], T); cnt_eq_pos(ct, u[i], T, L - 64 * i); }
    int ig = cg, it = ct;
#pragma unroll
    for (int o = 1; o < 64; o <<= 1) { const int a = __shfl_up(ig, o), b2 = __shfl_up(it, o); if (lane >= o) { ig += a; it += b2; } }
    int pg = ig - cg, pt = ngt + it - ct;
    int ev = lane, Lr = L;
#pragma unroll
    for (int i = 0; i < NV; ++i) {
        if (u[i] > T) { sel[pg] = ev; ++pg; }
        else if (u[i] == T && Lr > 0) { sel[pt] = ev; ++pt; }
        asm volatile("v_add_u32 %0, 64, %0\n\tv_add_u32 %1, -64, %1" : "+v"(ev), "+v"(Lr));
    }
}

constexpr int PU_MB = 16 * SROW * 4;
constexpr int PU_RB = PU_MB + 16 * 64 * 4;
constexpr int PU_BT = PU_RB + 1024;
constexpr int PU_QT = PU_BT + 512, PU_QROW = 1040;
__device__ __forceinline__ int kappa32(int r) { return (r & 0x13) | ((r & 4) << 1) | ((r & 8) >> 1); }
__device__ __forceinline__ void p3_prompt_fused_unit(const Frame& F, const bf16_t* VT, int b, int qt) {
    LAS float* S = (LAS float*)F.lds;
    LAS unsigned* MB = (LAS unsigned*)(F.lds + PU_MB);
    LAS float* RB = (LAS float*)(F.lds + PU_RB);
    LAS int* BT = (LAS int*)(F.lds + PU_BT);
    const int lane = F.lane;
    const int q0 = qt * 16; const size_t tok0 = (size_t)b * SEQ;
    __syncthreads();
    for (int ch = F.tid; ch < 16 * 64; ch += NTHREADS) {
        const u32x4 qv = *(const u32x4*)(F.PROJ + (tok0 + q0 + (ch >> 6)) * NMIXP + C_Q + (ch & 63) * 8);
        constexpr float QS = ATTN_SCALE * 1.4426950408889634f;
        *(LAS u32x4*)(F.lds + PU_QT + (ch >> 6) * PU_QROW + (ch & 63) * 16) = (u32x4){cvt_pk_bf16(bflo(qv[0]) * QS, bfhi(qv[0]) * QS), cvt_pk_bf16(bflo(qv[1]) * QS, bfhi(qv[1]) * QS),
                                                                                    cvt_pk_bf16(bflo(qv[2]) * QS, bfhi(qv[2]) * QS), cvt_pk_bf16(bflo(qv[3]) * QS, bfhi(qv[3]) * QS)};
    }
    {
        const int r = lane & 15, q4 = lane >> 4;
        bf16x8 A[4][2];
#pragma unroll
        for (int hh = 0; hh < 4; ++hh)
#pragma unroll
            for (int s2 = 0; s2 < 2; ++s2) A[hh][s2] = *(const bf16x8*)(F.PROJ + (tok0 + q0 + r) * NMIXP + C_QI + hh * 64 + s2 * 32 + q4 * 8);
        float wv[4][4];
#pragma unroll
        for (int g = 0; g < 4; ++g) { const f32x4 w4 = *(const f32x4*)(F.WI + (tok0 + q0 + 4 * q4 + g) * 4);
#pragma unroll
            for (int hh = 0; hh < 4; ++hh) wv[g][hh] = w4[hh] * IDX_SCALE; }
        const int nkt = qt + 1;
        bf16x8 Bn[2][2];
        {
            const int t0 = 2 * F.wave;
#pragma unroll
            for (int p = 0; p < 2; ++p)
#pragma unroll
                for (int s2 = 0; s2 < 2; ++s2) { const int key = (t0 + p < nkt ? t0 + p : 0) * 16 + r; Bn[p][s2] = *(const bf16x8*)(F.PROJ + (tok0 + key) * NMIXP + C_KI + s2 * 32 + q4 * 8); }
        }
#pragma unroll 1
        for (int t0 = 2 * F.wave; t0 < nkt; t0 += 16) {
            bf16x8 B[2][2] = {{Bn[0][0], Bn[0][1]}, {Bn[1][0], Bn[1][1]}};
            {
                const int tn = t0 + 16;
#pragma unroll
                for (int p = 0; p < 2; ++p)
#pragma unroll
                    for (int s2 = 0; s2 < 2; ++s2) { const int key = (tn + p < nkt ? tn + p : 0) * 16 + r; Bn[p][s2] = *(const bf16x8*)(F.PROJ + (tok0 + key) * NMIXP + C_KI + s2 * 32 + q4 * 8); }
            }
#pragma unroll
            for (int p = 0; p < 2; ++p) {
                if (t0 + p >= nkt) continue;
                float sc[4] = {0.f, 0.f, 0.f, 0.f};
#pragma unroll
                for (int hh = 0; hh < 4; ++hh) {
                    f32x4 c = {0.f, 0.f, 0.f, 0.f};
                    c = __builtin_amdgcn_mfma_f32_16x16x32_bf16(A[hh][0], B[p][0], c, 0, 0, 0);
                    c = __builtin_amdgcn_mfma_f32_16x16x32_bf16(A[hh][1], B[p][1], c, 0, 0, 0);
#pragma unroll
                    for (int g = 0; g < 4; ++g) sc[g] += fmaxf(c[g], 0.f) * wv[g][hh];
                }
#pragma unroll
                for (int g = 0; g < 4; ++g) S[(4 * q4 + g) * SROW + (t0 + p) * 16 + r] = sc[g];
            }
        }
    }
    __syncthreads();
    {
        const int rowa = F.wave * 2, rowb = rowa + 1;
        const int nva = q0 + rowa + 1, nvb = nva + 1;
        if (nvb <= NSEL) {
#pragma unroll
            for (int i = 0; i < 32; ++i) {
                const unsigned long long ma = __ballot(lane + 64 * i < nva), mb = __ballot(lane + 64 * i < nvb);
                if (lane == 0) { MB[rowa * 64 + 2 * i] = (unsigned)ma; MB[rowa * 64 + 2 * i + 1] = (unsigned)(ma >> 32); MB[rowb * 64 + 2 * i] = (unsigned)mb; MB[rowb * 64 + 2 * i + 1] = (unsigned)(mb >> 32); }
            }
        } else {
            unsigned ua[32], ub[32];
#pragma unroll
            for (int i = 0; i < 32; ++i) { const int j = lane + 64 * i; ua[i] = (j < nva) ? (f2ord(S[rowa * SROW + j]) >> 1) : 0u; ub[i] = (j < nvb) ? (f2ord(S[rowb * SROW + j]) >> 1) : 0u; }
            unsigned Ta, Tb; int Jxa, Jxb;
            select_threshold2<32>(ua, ub, NSEL, 11, lane, (nvb + 255) >> 8, Ta, Jxa, Tb, Jxb);
            const int La = Jxa - lane, Lb = Jxb - lane;
#pragma unroll
            for (int i = 0; i < 32; ++i) {
                const bool ta = (ua[i] > Ta) || (ua[i] == Ta && (La - 64 * i) > 0), tb = (ub[i] > Tb) || (ub[i] == Tb && (Lb - 64 * i) > 0);
                const unsigned long long ma = __ballot(ta), mb = __ballot(tb);
                if (lane == 0) { MB[rowa * 64 + 2 * i] = (unsigned)ma; MB[rowa * 64 + 2 * i + 1] = (unsigned)(ma >> 32); MB[rowb * 64 + 2 * i] = (unsigned)mb; MB[rowb * 64 + 2 * i + 1] = (unsigned)(mb >> 32); }
            }
        }
    }
    __syncthreads();
    {
        const int g = F.wave & 1, kq = F.wave >> 1;
        const int c = lane & 31, h = lane >> 5;
        const int hd = g * 4 + (c & 3);
        LAS const unsigned char* Qb = F.lds + PU_QT + (c >> 2) * PU_QROW + (hd * 64 + h * 8) * 2;
        constexpr float L2E = 1.4426950408889634f;
        const float b31 = RB[31 * 8 + hd] * L2E;
        const int ntile = ((q0 + 15) >> 5) + 1;
        const bf16_t* Kb = F.PROJ + (tok0 + kappa32(c)) * NMIXP + C_K + g * 64 + h * 8;
        const bf16_t* Vb = VT + ((size_t)((b * 2 + g) * 64 + c)) * SEQ + h * 8;
        f32x16 O[2][2];
#pragma unroll
        for (int rt = 0; rt < 2; ++rt)
#pragma unroll
            for (int d = 0; d < 2; ++d)
#pragma unroll
                for (int e = 0; e < 16; ++e) O[rt][d][e] = 0.f;
        float lsum[2] = {0.f, 0.f};
        bf16x8 Kn[4];
        {
            const int key0 = (kq < ntile ? kq : 0) * 32;
#pragma unroll
            for (int s4 = 0; s4 < 4; ++s4) Kn[s4] = *(const bf16x8*)(Kb + (size_t)key0 * NMIXP + s4 * 16);
        }
#pragma unroll 1
        for (int kt = kq; kt < ntile; kt += 4) {
            const int key0 = kt * 32;
            bf16x8 Kf[4] = {Kn[0], Kn[1], Kn[2], Kn[3]}, Vf[2][2];
#pragma unroll
            for (int d = 0; d < 2; ++d)
#pragma unroll
                for (int s2 = 0; s2 < 2; ++s2) Vf[d][s2] = *(const bf16x8*)(Vb + (size_t)(32 * d) * SEQ + key0 + 16 * s2);
            {
                const int keyn = (kt + 4 < ntile ? kt + 4 : 0) * 32;
#pragma unroll
                for (int s4 = 0; s4 < 4; ++s4) Kn[s4] = *(const bf16x8*)(Kb + (size_t)keyn * NMIXP + s4 * 16);
            }
#pragma unroll
            for (int rt = 0; rt < 2; ++rt) {
                const int ql = rt * 8 + (c >> 2), q = q0 + ql;
                f32x16 X;
#pragma unroll
                for (int e = 0; e < 16; ++e) X[e] = 0.f;
#pragma unroll
                for (int s4 = 0; s4 < 4; ++s4) X = __builtin_amdgcn_mfma_f32_32x32x16_bf16(Kf[s4], *(LAS const bf16x8*)(Qb + rt * 8 * PU_QROW + s4 * 32), X, 0, 0, 0);
                const unsigned word = MB[ql * 64 + kt];
                const unsigned bits = ((word >> (8 * h)) & 0xFFu) | (((word >> (16 + 8 * h)) & 0xFFu) << 8);
                const bool nearT = (q0 + rt * 8) - (key0 + 31) < 113;
#pragma unroll
                for (int s2 = 0; s2 < 2; ++s2) {
                    float P[8];
                    if (nearT) {
#pragma unroll
                        for (int e8 = 0; e8 < 8; ++e8) {
                            const int e = 8 * s2 + e8;
                            const int key = key0 + e8 + 16 * s2 + 8 * h;
                            int dist = q - key; dist = dist < 0 ? 0 : (dist > 127 ? 127 : dist);
                            const float bias = RB[BT[dist] * 8 + hd] * L2E;
                            const float lg = fminf(X[e] + bias, 86.f);
                            P[e8] = __int_as_float(__float_as_int(__builtin_amdgcn_exp2f(lg)) & __builtin_amdgcn_sbfe((int)bits, e, 1));
                        }
                    } else {
#pragma unroll
                        for (int e8 = 0; e8 < 8; ++e8) {
                            const int e = 8 * s2 + e8;
                            const float lg = fminf(X[e] + b31, 86.f);
                            P[e8] = __int_as_float(__float_as_int(__builtin_amdgcn_exp2f(lg)) & __builtin_amdgcn_sbfe((int)bits, e, 1));
                        }
                    }
#pragma unroll
                    for (int e8 = 0; e8 < 8; ++e8) lsum[rt] += P[e8];
                    const u32x4 pk = (u32x4){cvt_pk_bf16(P[0], P[1]), cvt_pk_bf16(P[2], P[3]), cvt_pk_bf16(P[4], P[5]), cvt_pk_bf16(P[6], P[7])};
                    bf16x8 Pf; __builtin_memcpy(&Pf, &pk, 16);
                    O[rt][0] = __builtin_amdgcn_mfma_f32_32x32x16_bf16(Vf[0][s2], Pf, O[rt][0], 0, 0, 0);
                    O[rt][1] = __builtin_amdgcn_mfma_f32_32x32x16_bf16(Vf[1][s2], Pf, O[rt][1], 0, 0, 0);
                }
                __builtin_amdgcn_sched_barrier(0);
            }
        }
        LAS float* CB = (LAS float*)F.lds + (g * 3 + (kq > 0 ? kq - 1 : 0)) * (66 * 64);
        __syncthreads();
        if (kq > 0) {
#pragma unroll
            for (int rt = 0; rt < 2; ++rt) {
#pragma unroll
                for (int d = 0; d < 2; ++d)
#pragma unroll
                    for (int e = 0; e < 16; ++e) CB[((rt * 2 + d) * 16 + e) * 64 + lane] = O[rt][d][e];
                CB[(64 + rt) * 64 + lane] = lsum[rt];
            }
        }
        __syncthreads();
        if (kq == 0) {
#pragma unroll 1
            for (int p = 0; p < 3; ++p) {
                LAS const float* CP = (LAS const float*)F.lds + (g * 3 + p) * (66 * 64);
#pragma unroll
                for (int rt = 0; rt < 2; ++rt) {
#pragma unroll
                    for (int d = 0; d < 2; ++d)
#pragma unroll
                        for (int e = 0; e < 16; ++e) O[rt][d][e] += CP[((rt * 2 + d) * 16 + e) * 64 + lane];
                    lsum[rt] += CP[(64 + rt) * 64 + lane];
                }
            }
#pragma unroll
            for (int rt = 0; rt < 2; ++rt) {
                float l = lsum[rt]; l += __shfl_xor(l, 32);
                const float inv = 1.f / l;
                bf16_t* orow = F.OATT + (tok0 + q0 + rt * 8 + (c >> 2)) * 512 + hd * 64;
#pragma unroll
                for (int a4 = 0; a4 < 4; ++a4) {
                    const f32x4 v0 = (f32x4){O[rt][0][4 * a4], O[rt][0][4 * a4 + 1], O[rt][0][4 * a4 + 2], O[rt][0][4 * a4 + 3]} * inv;
                    const f32x4 v1 = (f32x4){O[rt][1][4 * a4], O[rt][1][4 * a4 + 1], O[rt][1][4 * a4 + 2], O[rt][1][4 * a4 + 3]} * inv;
                    *(u32x2*)(orow + 8 * a4 + 4 * h) = pk4(v0);
                    *(u32x2*)(orow + 32 + 8 * a4 + 4 * h) = pk4(v1);
                }
            }
        }
    }
}

__device__ __forceinline__ void p3_sample_score_unit(const Frame& F, float* SS, int b, int ch) {
    const int lane = F.lane, r = lane & 31, h = lane >> 5;
    bf16x8 A[4];
    { const int q = r >> 2, hh = r & 3;
#pragma unroll
      for (int s4 = 0; s4 < 4; ++s4) A[s4] = *(const bf16x8*)(F.PROJ + (size_t)(NTP + b * TS + q) * NMIXP + C_QI + hh * 64 + s4 * 16 + h * 8); }
    float wv[4][4];
#pragma unroll
    for (int g = 0; g < 4; ++g) { const f32x4 w4 = *(const f32x4*)(F.WI + (size_t)(NTP + b * TS + 2 * g + h) * 4);
#pragma unroll
        for (int hh = 0; hh < 4; ++hh) wv[g][hh] = w4[hh] * IDX_SCALE; }
    f32x4 kn[8];
    { const int key0 = ch * 1024 + F.wave * 32; const int page = F.page_table[b * NPAGES + (key0 >> 7)];
      const float* kr = F.cache_ki + ((size_t)page * PAGE + (key0 & 127) + r) * 64 + h * 8;
#pragma unroll
      for (int s4 = 0; s4 < 4; ++s4) { kn[2 * s4] = *(const f32x4*)(kr + s4 * 16); kn[2 * s4 + 1] = *(const f32x4*)(kr + s4 * 16 + 4); } }
#pragma unroll 1
    for (int tl = F.wave; tl < 32; tl += 8) {
        const int key0 = ch * 1024 + tl * 32;
        f32x4 kc[8];
#pragma unroll
        for (int i = 0; i < 8; ++i) kc[i] = kn[i];
        if (tl + 8 < 32) {
            const int keyn = key0 + 256; const int page = F.page_table[b * NPAGES + (keyn >> 7)];
            const float* kr = F.cache_ki + ((size_t)page * PAGE + (keyn & 127) + r) * 64 + h * 8;
#pragma unroll
            for (int s4 = 0; s4 < 4; ++s4) { kn[2 * s4] = *(const f32x4*)(kr + s4 * 16); kn[2 * s4 + 1] = *(const f32x4*)(kr + s4 * 16 + 4); }
        }
        f32x16 c;
#pragma unroll
        for (int e = 0; e < 16; ++e) c[e] = 0.f;
#pragma unroll
        for (int s4 = 0; s4 < 4; ++s4) {
            const f32x4 lo = kc[2 * s4], hi = kc[2 * s4 + 1];
            const u32x4 pk = (u32x4){cvt_pk_bf16(lo[0], lo[1]), cvt_pk_bf16(lo[2], lo[3]), cvt_pk_bf16(hi[0], hi[1]), cvt_pk_bf16(hi[2], hi[3])};
            bf16x8 Bf; __builtin_memcpy(&Bf, &pk, 16);
            c = __builtin_amdgcn_mfma_f32_32x32x16_bf16(A[s4], Bf, c, 0, 0, 0);
        }
#pragma unroll
        for (int g = 0; g < 4; ++g) {
            float sc = 0.f;
#pragma unroll
            for (int hh = 0; hh < 4; ++hh) sc += fmaxf(c[4 * g + hh], 0.f) * wv[g][hh];
            SS[(size_t)(b * TS + 2 * g + h) * PAST + key0 + r] = sc;
        }
    }
}
__device__ __forceinline__ void p3_index(const Frame& F) {
    constexpr int NSU = NB_S * 8;
    const int nunits = NSU + NB_P * (SEQ / 16);
    float* SS = (float*)(F.ws + WS_SS);
    const bf16_t* VT = (const bf16_t*)(F.ws + WS_VT);
    __syncthreads();
    if (F.tid < 256) ((LAS float*)(F.lds + PU_RB))[F.tid] = F.rel_bias[F.tid];
    if (F.tid < 128) ((LAS int*)(F.lds + PU_BT))[F.tid] = t5_bucket(F.tid);
    __syncthreads();
    for (int it = F.bid; it < nunits; it += F.G) {
        if (it < NSU) { p3_sample_score_unit(F, SS, it >> 3, it & 7); continue; }
        const int i = it - NSU; const int b = i & 7, sl = (i >> 3) & 31, rnd = i >> 8;
        const int qt = rnd == 0 ? 127 - sl : (rnd == 1 ? 64 + sl : (rnd == 2 ? 63 - sl : sl));
        p3_prompt_fused_unit(F, VT, b, qt);
    }
}

constexpr int SQ_CNT = 0;
constexpr int SQ_SEL = 1024;
constexpr int SQ_Q = 2048;
constexpr int SQ_P = 4096;
constexpr int SQ_RB = 16384;
constexpr int SQ_BT = 17408;
__device__ __forceinline__ int wg_sum8(const Frame& F, LAS unsigned* slot, int v) {
    if (F.lane == 0) slot[F.wave] = (unsigned)v;
    __syncthreads();
    int t = 0;
#pragma unroll
    for (int w = 0; w < 8; ++w) t += (int)slot[w];
    return t;
}
__device__ __forceinline__ void p4_sample_query_unit(const Frame& F, const float* SS, int b, int t) {
    const int lane = F.lane, w = F.wave;
    LAS unsigned* CNT = (LAS unsigned*)(F.lds + SQ_CNT);
    LAS int* SELL = (LAS int*)(F.lds + SQ_SEL);
    LAS unsigned* QL = (LAS unsigned*)(F.lds + SQ_Q);
    LAS float* PL = (LAS float*)(F.lds + SQ_P) + w * 256;
    LAS float* RB = (LAS float*)(F.lds + SQ_RB);
    LAS int* BT = (LAS int*)(F.lds + SQ_BT);
    const int tok = NTP + b * TS + t;
    __syncthreads();
    if (F.tid < 256) QL[F.tid] = ((const unsigned*)(F.PROJ + (size_t)tok * NMIXP + C_Q))[F.tid];
    unsigned u[17];
    { const float* srow = SS + (size_t)(b * TS + t) * PAST + w * 1024;
#pragma unroll
      for (int i = 0; i < 16; ++i) u[i] = f2ord(srow[64 * i + lane]); }
    u[16] = 0u;
    if (w == 7) {
        const int kj = lane < TS ? lane : 0;
        const bf16_t* kn = F.PROJ + (size_t)(NTP + b * TS + kj) * NMIXP + C_KI;
        const bf16_t* qn = F.PROJ + (size_t)tok * NMIXP + C_QI;
        u32x4 kv[8];
#pragma unroll
        for (int c = 0; c < 8; ++c) kv[c] = *(const u32x4*)(kn + c * 8);
        int vz; asm volatile("v_mov_b32 %0, 0" : "=v"(vz));
        const f32x4 w4 = *(const f32x4*)(F.WI + (size_t)tok * 4 + vz);
        float sc = 0.f;
#pragma unroll
        for (int hh = 0; hh < 4; ++hh) {
            u32x4 qv[8];
#pragma unroll
            for (int c = 0; c < 8; ++c) qv[c] = *(const u32x4*)(qn + hh * 64 + c * 8 + vz);
            float d = 0.f;
#pragma unroll
            for (int c = 0; c < 8; ++c)
#pragma unroll
                for (int e = 0; e < 4; ++e) d += bflo(qv[c][e]) * bflo(kv[c][e]) + bfhi(qv[c][e]) * bfhi(kv[c][e]);
            sc += fmaxf(d, 0.f) * (w4[hh] * IDX_SCALE);
        }
        u[16] = (lane < TS && lane <= t) ? f2ord(sc) : 0u;
    }
    unsigned T = 0;
#pragma unroll 1
    for (int bit = 31; bit >= 0; --bit) {
        const unsigned cand = T | (1u << bit);
        int c = 0;
#pragma unroll
        for (int i = 0; i < 17; ++i) cnt_ge(c, u[i], cand);
        c = wg_sum8(F, CNT + (bit & 1) * 24, wave_sum_i_dpp(c));
        if (c >= NSEL) T = cand;
        if (c == NSEL) break;
    }
    int cg = 0, ce = 0;
#pragma unroll
    for (int i = 0; i < 17; ++i) { cnt_gt(cg, u[i], T); cnt_eq(ce, u[i], T); }
    const int cgw = wave_sum_i_dpp(cg);
    const int ngt = wg_sum8(F, CNT + 8, cgw);
    const int neq = wg_sum8(F, CNT + 16, wave_sum_i_dpp(ce));
    const int need = NSEL - ngt;
    int Jx = 0x3FFFFFFF;
    if (need < neq) {
        int Jb = 0;
#pragma unroll 1
        for (int bit = 13; bit >= 0; --bit) {
            const int cand = Jb | (1 << bit);
            const int L = cand - lane - 1024 * w;
            int c = 0;
#pragma unroll
            for (int i = 0; i < 17; ++i) cnt_eq_pos(c, u[i], T, L - 64 * i);
            c = wg_sum8(F, CNT + (bit & 1) * 24, wave_sum_i_dpp(c));
            if (c < need) Jb = cand;
        }
        Jx = Jb + 1;
    }
    {
        const int L = Jx - lane - 1024 * w;
        int ct = 0;
#pragma unroll
        for (int i = 0; i < 17; ++i) cnt_eq_pos(ct, u[i], T, L - 64 * i);
        const int ctw = wave_sum_i_dpp(ct);
        __syncthreads();
        if (lane == 0) { CNT[w] = (unsigned)cgw; CNT[8 + w] = (unsigned)ctw; }
        __syncthreads();
        int bg = 0, bt = ngt;
#pragma unroll
        for (int ww = 0; ww < 8; ++ww) { if (ww < w) { bg += (int)CNT[ww]; bt += (int)CNT[8 + ww]; } }
        int ig = cg, it2 = ct;
#pragma unroll
        for (int o = 1; o < 64; o <<= 1) { const int a = __shfl_up(ig, o), b2 = __shfl_up(it2, o); if (lane >= o) { ig += a; it2 += b2; } }
        int pg = bg + ig - cg, pt = bt + it2 - ct;
        int ev = 1024 * w + lane, Lr = L;
#pragma unroll
        for (int i = 0; i < 17; ++i) {
            if (u[i] > T) { SELL[pg] = ev; ++pg; }
            else if (u[i] == T && Lr > 0) { SELL[pt] = ev; ++pt; }
            asm volatile("v_add_u32 %0, 64, %0\n\tv_add_u32 %1, -64, %1" : "+v"(ev), "+v"(Lr));
        }
    }
    __syncthreads();
    {
        const int hd = w, g = w >> 2, qpos = PAST + t;
        float lg[4];
#pragma unroll 2
        for (int i = 0; i < 4; ++i) {
            const int sraw = SELL[lane + 64 * i];
            const float* kr;
            if (sraw < PAST) { const int page = F.page_table[b * NPAGES + (sraw >> 7)]; kr = F.cache_k + ((size_t)page * PAGE + (sraw & 127)) * 128 + g * 64; }
            else kr = F.out + O_KS + (size_t)(b * TS + (sraw - PAST)) * 128 + g * 64;
            float a0 = 0.f, a1 = 0.f;
#pragma unroll
            for (int c = 0; c < 16; ++c) {
                const f32x4 kv = *(const f32x4*)(kr + c * 4);
                const unsigned q0 = QL[hd * 32 + c * 2], q1 = QL[hd * 32 + c * 2 + 1];
                a0 += bflo(q0) * kv[0] + bfhi(q0) * kv[1]; a1 += bflo(q1) * kv[2] + bfhi(q1) * kv[3];
            }
            const int dist = qpos - sraw; const int bk = dist < 128 ? BT[dist] : 31;
            lg[i] = (a0 + a1) * ATTN_SCALE + RB[bk * 8 + hd];
        }
        float m = fmaxf(fmaxf(lg[0], lg[1]), fmaxf(lg[2], lg[3])); m = wave_max(m);
        float sm = 0.f;
#pragma unroll
        for (int i = 0; i < 4; ++i) { lg[i] = __expf(lg[i] - m); sm += lg[i]; }
        const float inv = 1.f / wave_sum_dpp(sm);
#pragma unroll
        for (int i = 0; i < 4; ++i) PL[lane + 64 * i] = lg[i] * inv;
        const int dq = lane & 15, ks = lane >> 4;
        f32x4 o4 = {0.f, 0.f, 0.f, 0.f};
#pragma unroll 1
        for (int j0 = 0; j0 < 256; j0 += 64) {
            f32x4 vv[16]; float pp[16];
#pragma unroll
            for (int jj = 0; jj < 16; ++jj) {
                const int j = j0 + jj * 4 + ks;
                const int sraw = SELL[j]; pp[jj] = PL[j];
                const float* vr;
                if (sraw < PAST) { const int page = F.page_table[b * NPAGES + (sraw >> 7)]; vr = F.cache_v + ((size_t)page * PAGE + (sraw & 127)) * 128 + g * 64; }
                else vr = F.out + O_VS + (size_t)(b * TS + (sraw - PAST)) * 128 + g * 64;
                vv[jj] = *(const f32x4*)(vr + 4 * dq);
            }
#pragma unroll
            for (int jj = 0; jj < 16; ++jj) o4 += vv[jj] * pp[jj];
        }
#pragma unroll
        for (int e = 0; e < 4; ++e) { o4[e] += __shfl_xor(o4[e], 16); o4[e] += __shfl_xor(o4[e], 32); }
        if (ks == 0) *(u32x2*)(F.OATT + (size_t)tok * 512 + hd * 64 + 4 * dq) = pk4(o4);
    }
}
__device__ __forceinline__ void p4_attention(const Frame& F) {
    const float* SS = (const float*)(F.ws + WS_SS);
    __syncthreads();
    if (F.tid < 256) ((LAS float*)(F.lds + SQ_RB))[F.tid] = F.rel_bias[F.tid];
    if (F.tid < 128) ((LAS int*)(F.lds + SQ_BT))[F.tid] = t5_bucket(F.tid);
    __syncthreads();
    for (int it = F.bid; it < NTS; it += F.G) p4_sample_query_unit(F, SS, it >> 3, it & 7);
    {
        const int c0 = F.lane * 8;
        float cw0[8], cw1[8], cw2[8], cbv[8];
#pragma unroll
        for (int e = 0; e < 8; ++e) { cw0[e] = F.conv_w[c0 + e]; cw1[e] = F.conv_w[512 + c0 + e]; cw2[e] = F.conv_w[1024 + c0 + e]; cbv[e] = F.conv_b[c0 + e]; }
        const int stride = F.G * 8;
        u32x4 n_cg[3], n_xi[3], n_bg;
        auto fetch = [&](int m) {
#pragma unroll
            for (int d = 0; d < 3; ++d) { const int mm = (m - d >= 0) ? m - d : 0; n_cg[d] = *(const u32x4*)(F.PROJ + (size_t)mm * NMIXP + C_CG + c0); n_xi[d] = *(const u32x4*)(F.PROJ + (size_t)mm * NMIXP + C_XIN + c0); }
            n_bg = *(const u32x4*)(F.PROJ + (size_t)m * NMIXP + C_BG + c0);
        };
        { const int m = F.bid * 8 + F.wave; fetch(m < NT ? m : 0); }
        for (int m = F.bid * 8 + F.wave; m < NT; m += stride) {
            u32x4 cg[3], xi[3]; const u32x4 bg = n_bg;
#pragma unroll
            for (int d = 0; d < 3; ++d) { cg[d] = n_cg[d]; xi[d] = n_xi[d]; }
            fetch(m + stride < NT ? m + stride : m);
            int t, T_, bsm; if (m < NTP) { t = m & 2047; T_ = SEQ; bsm = m >> 11; } else { t = (m - NTP) & 7; T_ = TS; bsm = (m - NTP) >> 3; }
            float u[3][8];
#pragma unroll
            for (int d = 0; d < 3; ++d) {
                if (t - d >= 0) {
#pragma unroll
                    for (int e = 0; e < 4; ++e) { u[d][2 * e] = bflo(cg[d][e]) * bflo(xi[d][e]); u[d][2 * e + 1] = bfhi(cg[d][e]) * bfhi(xi[d][e]); }
                } else if (m >= NTP) {
                    const float* pv = F.state_conv + ((size_t)bsm * 2 + (2 + t - d)) * 512 + c0;
#pragma unroll
                    for (int e = 0; e < 8; ++e) u[d][e] = pv[e];
                } else {
#pragma unroll
                    for (int e = 0; e < 8; ++e) u[d][e] = 0.f;
                }
            }
            float y[8];
#pragma unroll
            for (int e = 0; e < 8; ++e) {
                const float yy = cbv[e] + cw0[e] * u[2][e] + cw1[e] * u[1][e] + cw2[e] * u[0][e];
                const float bgv = (e & 1) ? bfhi(bg[e >> 1]) : bflo(bg[e >> 1]);
                y[e] = bgv * yy;
            }
            *(u32x4*)(F.OCONV + (size_t)m * 512 + c0) = (u32x4){cvt_pk_bf16(y[0], y[1]), cvt_pk_bf16(y[2], y[3]), cvt_pk_bf16(y[4], y[5]), cvt_pk_bf16(y[6], y[7])};
            if (t >= T_ - 2) {
                float* o = (m < NTP ? F.out + O_CP : F.out + O_CS) + ((size_t)bsm * 2 + (t - (T_ - 2))) * 512 + c0;
                const int rowi = (m < NTP) ? bsm * 2 + (t - (T_ - 2)) : 2 * NB_P + bsm * 2 + (t - (T_ - 2));
                const float* cx = (const float*)(F.ws + WS_CGX) + (size_t)rowi * 1024 + c0;
                const f32x4 ca = *(const f32x4*)cx, cb2 = *(const f32x4*)(cx + 4), xa = *(const f32x4*)(cx + 512), xb = *(const f32x4*)(cx + 516);
                *(f32x4*)o = ca * xa; *(f32x4*)(o + 4) = cb2 * xb;
            }
        }
    }
}

#define P5_EPI(A1, A2) { \
            const f32x4 va = ACC4(A1), vc = ACC4(A2); \
            const u32x2 ga = *(const u32x2*)(F.PROJ + (size_t)m * NMIXP + C_GA + n), gb = *(const u32x2*)(F.PROJ + (size_t)m * NMIXP + C_GB + n); \
            f32x4 o; \
            o[0] = sigmoidf_(bflo(ga[0])) * va[0] + sigmoidf_(bflo(gb[0])) * vc[0]; \
            o[1] = sigmoidf_(bfhi(ga[0])) * va[1] + sigmoidf_(bfhi(gb[0])) * vc[1]; \
            o[2] = sigmoidf_(bflo(ga[1])) * va[2] + sigmoidf_(bflo(gb[1])) * vc[2]; \
            o[3] = sigmoidf_(bfhi(ga[1])) * va[3] + sigmoidf_(bfhi(gb[1])) * vc[3]; \
            *(u32x2*)(F.MERGED + (size_t)m * D + n) = pk4(o); }
struct P5aBody {
    const Frame* Fp;
    __device__ __forceinline__ void operator()(int m, int n, const f32x4 v) const { *(u32x2*)(Fp->MERGED + (size_t)m * D + n) = pk4(v); }
};
struct P5bBody {
    const Frame* Fp;
    __device__ __forceinline__ void operator()(int m, int n, const f32x4 v) const {
        const Frame& F = *Fp;
        const u32x2 ga = *(const u32x2*)(F.PROJ + (size_t)m * NMIXP + C_GA + n), gb = *(const u32x2*)(F.PROJ + (size_t)m * NMIXP + C_GB + n);
        const u32x2 pa = *(const u32x2*)(F.MERGED + (size_t)m * D + n);
        const f32x4 o = (f32x4){sigmoidf_(bflo(ga[0])) * bflo(pa[0]) + sigmoidf_(bflo(gb[0])) * v[0], sigmoidf_(bfhi(ga[0])) * bfhi(pa[0]) + sigmoidf_(bfhi(gb[0])) * v[1],
                                sigmoidf_(bflo(ga[1])) * bflo(pa[1]) + sigmoidf_(bflo(gb[1])) * v[2], sigmoidf_(bfhi(ga[1])) * bfhi(pa[1]) + sigmoidf_(bfhi(gb[1])) * v[3]};
        *(u32x2*)(F.MERGED + (size_t)m * D + n) = pk4(o);
    }
};
__device__ __forceinline__ void p5_gemm_merge(const Frame& F) {
    {
        pg8::StaticOrder S; S.init(NTP, D, F.G, F.bid);
        { pg8::Gemm g{F.OATT, F.WOA, NTP, D, 512}; pg8::EpiRC<P5aBody> E{P5aBody{&F}}; pg8::gemm_phase<pg8::EpiRC<P5aBody>, pg8::StaticOrder, true, true>(F.lds, g, S, E); }
        asm volatile("s_waitcnt vmcnt(0)" ::: "memory"); __syncthreads();
        { pg8::Gemm g{F.OCONV, F.WOC, NTP, D, 512}; pg8::EpiRC<P5bBody> E{P5bBody{&F}}; pg8::gemm_phase<pg8::EpiRC<P5bBody>, pg8::StaticOrder, true, true>(F.lds, g, S, E); }
    }
    for (int sl = F.bid; sl < NTS / 8 * (D / BN); sl += F.G) {
        const int m0 = NTP + (sl >> 3) * 8, n0 = (sl & 7) * BN;
        f32x16 s1[1][1], s2[1][1];
        gemm_slice8(F, s1, F.OATT, 512, F.WOA, 512, 512, m0, n0);
        gemm_slice8(F, s2, F.OCONV, 512, F.WOC, 512, 512, m0, n0);
        SLICE_EPI_LOOP(P5_EPI(s1, s2))
    }
}
#define P6_EPI(A1) { \
            const f32x4 v = ACC4(A1); \
            const f32x4 xv = *(const f32x4*)(x_row(F, m) + n); \
            const f32x4 g1 = *(const f32x4*)(F.MOD + (size_t)mod_row(m) * 6144 + 2048 + n); \
            *(f32x4*)(F.T1 + (size_t)m * D + n) = xv * DN_ALPHA + g1 * v; }
struct P6Body {
    const Frame* Fp;
    __device__ __forceinline__ void operator()(int m, int n, const f32x4 v) const {
        const Frame& F = *Fp;
        const f32x4 xv = *(const f32x4*)(F.x_p + (size_t)m * D + n);
        const f32x4 g1 = *(const f32x4*)(F.MOD + (size_t)(m >> 11) * 6144 + 2048 + n);
        *(f32x4*)(F.T1 + (size_t)m * D + n) = xv * DN_ALPHA + g1 * v;
    }
};
__device__ __forceinline__ void p6_gemm_out(const Frame& F) {
    {
        pg8::Gemm g{F.MERGED, F.WOUT, NTP, D, D}; pg8::StaticOrder S; S.init(NTP, D, F.G, F.bid);
        pg8::EpiRC<P6Body> E{P6Body{&F}}; pg8::gemm_phase<pg8::EpiRC<P6Body>, pg8::StaticOrder, true, true>(F.lds, g, S, E);
    }
    for (int sl = F.bid; sl < NTS / 8 * (D / BN); sl += F.G) {
        const int m0 = NTP + (sl >> 3) * 8, n0 = (sl & 7) * BN;
        f32x16 s1[1][1];
        gemm_slice8(F, s1, F.MERGED, D, F.WOUT, D, D, m0, n0);
        SLICE_EPI_LOOP(P6_EPI(s1))
    }
}
__device__ __forceinline__ void p7_ln1(const Frame& F) {
    f32x4 lg[4], lb[4];
#pragma unroll
    for (int i = 0; i < 4; ++i) { const int e = (i >> 1) * 512 + F.lane * 8 + (i & 1) * 4; lg[i] = *(const f32x4*)(F.ln1_g + e); lb[i] = *(const f32x4*)(F.ln1_b + e); }
    const int stride = F.G * 8;
    f32x4 vn[4], scn[4], shn[4];
    {
        const int m = F.bid * 8 + F.wave; const float* mr = F.MOD + (size_t)mod_row(m < NT ? m : 0) * 6144;
#pragma unroll
        for (int i = 0; i < 4; ++i) { const int e = (i >> 1) * 512 + F.lane * 8 + (i & 1) * 4; vn[i] = *(const f32x4*)(F.T1 + (size_t)(m < NT ? m : 0) * D + e); scn[i] = *(const f32x4*)(mr + 4096 + e); shn[i] = *(const f32x4*)(mr + 3072 + e); }
    }
    for (int m = F.bid * 8 + F.wave; m < NT; m += stride) {
        float* tr = F.T1 + (size_t)m * D;
        f32x4 v[4], sc2[4], sh2[4]; float s = 0.f;
#pragma unroll
        for (int i = 0; i < 4; ++i) { v[i] = vn[i]; sc2[i] = scn[i]; sh2[i] = shn[i]; s += v[i][0] + v[i][1] + v[i][2] + v[i][3]; }
        {
            const int mn = (m + stride < NT) ? m + stride : m; const float* mrn = F.MOD + (size_t)mod_row(mn) * 6144;
#pragma unroll
            for (int i = 0; i < 4; ++i) { const int e = (i >> 1) * 512 + F.lane * 8 + (i & 1) * 4; vn[i] = *(const f32x4*)(F.T1 + (size_t)mn * D + e); scn[i] = *(const f32x4*)(mrn + 4096 + e); shn[i] = *(const f32x4*)(mrn + 3072 + e); }
        }
        const float mean = wave_sum(s) * (1.f / D);
        float q = 0.f;
#pragma unroll
        for (int i = 0; i < 4; ++i) { v[i] = v[i] - mean; q += v[i][0] * v[i][0] + v[i][1] * v[i][1] + v[i][2] * v[i][2] + v[i][3] * v[i][3]; }
        const float rstd = rsqrtf(wave_sum(q) * (1.f / D) + LN_EPS);
        f32x4 hv[2][2];
#pragma unroll
        for (int hlf = 0; hlf < 2; ++hlf) {
            const int e = hlf * 512 + F.lane * 8;
            f32x4 a = v[2 * hlf] * rstd * lg[2 * hlf] + lb[2 * hlf];
            f32x4 b = v[2 * hlf + 1] * rstd * lg[2 * hlf + 1] + lb[2 * hlf + 1];
            *(f32x4*)(tr + e) = a; *(f32x4*)(tr + e + 4) = b;
            const f32x4 ha = a * (sc2[2 * hlf] + 1.f) + sh2[2 * hlf];
            const f32x4 hb = b * (sc2[2 * hlf + 1] + 1.f) + sh2[2 * hlf + 1];
            *(u32x4*)(F.H2 + (size_t)m * D + e) = (u32x4){cvt_pk_bf16(ha[0], ha[1]), cvt_pk_bf16(ha[2], ha[3]), cvt_pk_bf16(hb[0], hb[1]), cvt_pk_bf16(hb[2], hb[3])};
            hv[hlf][0] = ha; hv[hlf][1] = hb;
        }
        float am = 0.f;
#pragma unroll
        for (int i = 0; i < 2; ++i)
#pragma unroll
            for (int j = 0; j < 2; ++j)
#pragma unroll
                for (int e = 0; e < 4; ++e) am = fmaxf(am, fabsf(hv[i][j][e]));
        am = wave_max(am);
        const float sc = am > 0.f ? 224.f / am : 1.f;
#pragma unroll
        for (int hlf = 0; hlf < 2; ++hlf) {
            int w0 = 0, w1 = 0;
            w0 = __builtin_amdgcn_cvt_pk_fp8_f32(hv[hlf][0][0] * sc, hv[hlf][0][1] * sc, w0, false); w0 = __builtin_amdgcn_cvt_pk_fp8_f32(hv[hlf][0][2] * sc, hv[hlf][0][3] * sc, w0, true);
            w1 = __builtin_amdgcn_cvt_pk_fp8_f32(hv[hlf][1][0] * sc, hv[hlf][1][1] * sc, w1, false); w1 = __builtin_amdgcn_cvt_pk_fp8_f32(hv[hlf][1][2] * sc, hv[hlf][1][3] * sc, w1, true);
            *(u32x2*)(F.ws + WS_H8 + (size_t)m * D + hlf * 512 + F.lane * 8) = (u32x2){(unsigned)w0, (unsigned)w1};
        }
        if (F.lane == 0) ((float*)(F.ws + WS_SH))[m] = am > 0.f ? am * (1.f / 224.f) : 1.f;
    }
}
struct P8Body {
    const Frame* Fp;
    __device__ __forceinline__ void operator()(int m, int n, const f32x4 v) const { *(u32x2*)(Fp->QP + (size_t)m * D + n) = pk4(v); }
};
__device__ __forceinline__ void p8_gemm_q(const Frame& F) {
    {
        pg8::Gemm g{F.H2, F.WQ, NTP, D, D}; pg8::StaticOrder S; S.init(NTP, D, F.G, F.bid);
        pg8::EpiRC<P8Body> E{P8Body{&F}}; pg8::gemm_phase<pg8::EpiRC<P8Body>, pg8::StaticOrder, true, true>(F.lds, g, S, E);
    }
    for (int sl = F.bid; sl < NTS / 8 * (D / BN); sl += F.G) {
        const int m0 = NTP + (sl >> 3) * 8, n0 = (sl & 7) * BN;
        f32x16 s1[1][1];
        gemm_slice8(F, s1, F.H2, D, F.WQ, D, D, m0, n0);
        SLICE_EPI_LOOP({ *(u32x2*)(F.QP + (size_t)m * D + n) = pk4(ACC4(s1)); })
    }
}
__device__ __forceinline__ void p9_row_top16(LAS float* row, LAS float* TV, LAS unsigned char* TI, int slot) {
    float gm[16];
#pragma unroll
    for (int gidx = 0; gidx < 16; ++gidx) {
        float m = row[gidx * 8];
#pragma unroll
        for (int k = 1; k < 8; ++k) m = fmaxf(m, row[gidx * 8 + k]);
        gm[gidx] = m;
    }
#pragma unroll 1
    for (int p = 0; p < 16; ++p) {
        float best = gm[0]; int bg = 0;
#pragma unroll
        for (int gidx = 1; gidx < 16; ++gidx) { const bool gt = gm[gidx] > best; best = gt ? gm[gidx] : best; bg = gt ? gidx : bg; }
        float v[8];
#pragma unroll
        for (int k = 0; k < 8; ++k) v[k] = row[bg * 8 + k];
        int bk = 7;
#pragma unroll
        for (int k = 6; k >= 0; --k) bk = (v[k] == best) ? k : bk;
        float nm = -INFINITY;
#pragma unroll
        for (int k = 0; k < 8; ++k) nm = fmaxf(nm, (k == bk) ? -INFINITY : v[k]);
        row[bg * 8 + bk] = -INFINITY;
#pragma unroll
        for (int gidx = 0; gidx < 16; ++gidx) gm[gidx] = (gidx == bg) ? nm : gm[gidx];
        TV[slot * 17 + p] = best; TI[slot * 17 + p] = (unsigned char)(bg * 8 + bk);
    }
}
__device__ __forceinline__ void p9_pair_top16(const Frame& F, LAS const float* TV, LAS const unsigned char* TI, int r1, int r2, int tok, int head) {
    float c[16];
    { const float v20 = TV[r2];
#pragma unroll
      for (int i = 0; i < 16; ++i) c[i] = TV[r1 + i] + v20; }
    unsigned long long ptrs = 0ull;
    float sv[16]; int se[16];
#pragma unroll
    for (int p = 0; p < 16; ++p) {
        float best = c[0]; int bi = 0;
#pragma unroll
        for (int i = 1; i < 16; ++i) { const bool gt = c[i] > best; best = gt ? c[i] : best; bi = gt ? i : bi; }
        const int bj = (int)((ptrs >> (4 * bi)) & 15ull);
        sv[p] = best; se[p] = (int)TI[r1 + bi] * 128 + (int)TI[r2 + bj];
        const float nv = (bj < 15) ? TV[r1 + bi] + TV[r2 + bj + 1] : -INFINITY;
        ptrs += (bj < 15) ? (1ull << (4 * bi)) : 0ull;
#pragma unroll
        for (int i = 0; i < 16; ++i) c[i] = (i == bi) ? nv : c[i];
    }
    const float mx0 = sv[0]; float den = 0.f;
#pragma unroll
    for (int p = 0; p < 16; ++p) { sv[p] = __expf(sv[p] - mx0); den += sv[p]; }
    const float dinv = 1.f / den;
    int* eo = F.EIDX + (size_t)tok * NEXP_SEL + head * 16; float* go = F.GW + (size_t)tok * NEXP_SEL + head * 16;
#pragma unroll
    for (int p = 0; p < 16; ++p) { eo[p] = se[p]; go[p] = sv[p] * dinv; }
}
constexpr int PR_ROW = 129, PR_ROWS = 256 + 4;
__device__ __forceinline__ void p9_route(const Frame& F) {
    LAS float* SC = (LAS float*)F.lds;
    LAS float* TV = (LAS float*)(F.lds + PR_ROWS * PR_ROW * 4);
    LAS unsigned char* TI = (LAS unsigned char*)(F.lds + PR_ROWS * PR_ROW * 4 + PR_ROWS * 17 * 4);
    const int lane = F.lane, r = lane & 31, h = lane >> 5;
    const int nunits = (NTP / 32) * 2;
    int k = 0;
    for (int it = F.bid; it < nunits; it += F.G, ++k) {
        const int tok0 = (it >> 1) * 32, hg = it & 1;
        const int ts = NTP + F.bid + F.G * (k >> 2), kh = k & 3;
        const bool has_s = ts < NT;
        __syncthreads();
        {
            const int head = hg * 4 + (F.wave >> 1), half = F.wave & 1;
            const bf16_t* KK = half ? F.K2 : F.K1;
            bf16x8 Bq[4], Bs[4];
#pragma unroll
            for (int s = 0; s < 4; ++s) Bq[s] = *(const bf16x8*)(F.QP + (size_t)(tok0 + r) * D + head * 128 + half * 64 + s * 16 + h * 8);
            const bool swave = has_s && F.wave < 4;
            if (swave) {
#pragma unroll
                for (int s = 0; s < 4; ++s) Bs[s] = *(const bf16x8*)(F.QP + (size_t)ts * D + (2 * kh + (F.wave >> 1)) * 128 + half * 64 + s * 16 + h * 8);
            }
#pragma unroll
            for (int kt = 0; kt < 4; ++kt) {
                f32x16 c, cs;
#pragma unroll
                for (int e = 0; e < 16; ++e) { c[e] = 0.f; cs[e] = 0.f; }
#pragma unroll
                for (int s = 0; s < 4; ++s) {
                    const bf16x8 Ak = *(const bf16x8*)(KK + (size_t)(kt * 32 + r) * 64 + s * 16 + h * 8);
                    c = __builtin_amdgcn_mfma_f32_32x32x16_bf16(Ak, Bq[s], c, 0, 0, 0);
                    if (swave) cs = __builtin_amdgcn_mfma_f32_32x32x16_bf16(Ak, Bs[s], cs, 0, 0, 0);
                }
#pragma unroll
                for (int e = 0; e < 16; ++e) { const int key = kt * 32 + (e & 3) + 8 * (e >> 2) + 4 * h; SC[(r * 8 + F.wave) * PR_ROW + key] = c[e]; }
                if (swave && r == 0) {
#pragma unroll
                    for (int e = 0; e < 16; ++e) { const int key = kt * 32 + (e & 3) + 8 * (e >> 2) + 4 * h; SC[(256 + F.wave) * PR_ROW + key] = cs[e]; }
                }
            }
        }
        __syncthreads();
        if (F.tid < 256 || (has_s && F.tid < 260)) p9_row_top16(SC + F.tid * PR_ROW, TV, TI, F.tid);
        __syncthreads();
        if (F.tid < 128) {
            const int tk = F.tid >> 2, hs = F.tid & 3;
            const int r1 = (tk * 8 + hs * 2) * 17;
            p9_pair_top16(F, TV, TI, r1, r1 + 17, tok0 + tk, hg * 4 + hs);
        } else if (has_s && F.tid < 130) {
            const int hs = F.tid - 128;
            const int r1 = (256 + hs * 2) * 17;
            p9_pair_top16(F, TV, TI, r1, r1 + 17, ts, 2 * kh + hs);
        }
    }
}

constexpr int TPW = 65, PAIRS_MAX = 9 * 128, PK = 4;
constexpr int P10_HROW = 1024 + 64;
constexpr int P10_H = 0;
constexpr int P10_SH = 32 * P10_HROW;
constexpr int P10_VROW = 2048 + 64;
constexpr int P10_STG = P10_SH + 128;
constexpr int P10_HIST = P10_STG + 8 * 4 * P10_VROW;
typedef short s16x4 __attribute__((ext_vector_type(4)));
__device__ __forceinline__ long pack64(unsigned lo, unsigned hi) { return (long)(((unsigned long long)hi << 32) | (unsigned long long)lo); }
__device__ __forceinline__ void fp8x16_to_bf16(const u32x4 v, u32x4& lo, u32x4& hi) {
    unsigned o[8];
#pragma unroll
    for (int i = 0; i < 4; ++i) {
        const f32x2_t a = __builtin_amdgcn_cvt_pk_f32_fp8((int)v[i], false), b2 = __builtin_amdgcn_cvt_pk_f32_fp8((int)v[i], true);
        o[2 * i] = cvt_pk_bf16(a[0], a[1]); o[2 * i + 1] = cvt_pk_bf16(b2[0], b2[1]);
    }
    lo = (u32x4){o[0], o[1], o[2], o[3]}; hi = (u32x4){o[4], o[5], o[6], o[7]};
}
__device__ __forceinline__ void p10_peer(const Frame& F) {
    const int lane = F.lane, w = F.wave;
    unsigned char* ws = F.ws;
    const unsigned char* PU8 = ws + WS_PU8; const unsigned char* PV8 = ws + WS_PV8;
    const float* SU = (const float*)(ws + WS_SU); const float* SV = (const float*)(ws + WS_SV);
    const unsigned char* H8 = ws + WS_H8; const float* SH = (const float*)(ws + WS_SH);
  for (int blk = F.bid; blk < NT / TPW; blk += F.G) {
    const int tok0 = blk * TPW;
    LAS unsigned* hist = (LAS unsigned*)(F.lds + P10_HIST) + w * 128;
    LAS unsigned char* stg = F.lds + P10_STG + w * (4 * P10_VROW);
    LAS float* SHl = (LAS float*)(F.lds + P10_SH);
    unsigned* SE0 = (unsigned*)(ws + WS_SE) + ((size_t)blk * 8 + w) * PAIRS_MAX;
    float* SG0 = (float*)(ws + WS_SG) + ((size_t)blk * 8 + w) * PAIRS_MAX;
    const int ntok = (w == 0) ? 9 : 8;
    const int r16 = lane & 15, q4 = lane >> 4;
#pragma unroll 1
    for (int pass = 0; pass < 3; ++pass) {
        const int kbase = pass * PK, nk = (ntok - kbase < PK) ? (ntok - kbase > 0 ? ntok - kbase : 0) : PK, npairs = nk * 128;
        __syncthreads();
        for (int c = F.tid; c < 32 * 64; c += NTHREADS) {
            const int row = c >> 6, tl = 32 * pass + row;
            if (tl < TPW) *(LAS u32x4*)(F.lds + P10_H + row * P10_HROW + (c & 63) * 16) = *(const u32x4*)(H8 + (size_t)(tok0 + tl) * D + (size_t)(c & 63) * 16);
        }
        if (F.tid < 32 && 32 * pass + F.tid < TPW) SHl[F.tid] = SH[tok0 + 32 * pass + F.tid];
        __syncthreads();
        if (nk <= 0) continue;
        unsigned* SE = SE0 + pass * (PK * 128); float* SG = SG0 + pass * (PK * 128);
        hist[lane] = 0u; hist[lane + 64] = 0u;
        int ex[8];
#pragma unroll
        for (int i = 0; i < 8; ++i) {
            const int p = lane + 64 * i;
            ex[i] = -1;
            if (p < npairs) { ex[i] = F.EIDX[(size_t)(tok0 + w + 8 * (kbase + (p >> 7))) * NEXP_SEL + (p & 127)]; atomicAdd((unsigned*)&hist[ex[i] >> 7], 1u); }
        }
        {
            const unsigned c0 = hist[2 * lane], c1 = hist[2 * lane + 1];
            unsigned incl = c0 + c1;
#pragma unroll
            for (int o = 1; o < 64; o <<= 1) { const unsigned t = __shfl_up(incl, o); if (lane >= o) incl += t; }
            const unsigned excl = incl - (c0 + c1);
            hist[2 * lane] = excl; hist[2 * lane + 1] = excl + c0;
        }
#pragma unroll
        for (int i = 0; i < 8; ++i) {
            const int p = lane + 64 * i;
            if (p < npairs) {
                const unsigned pos = atomicAdd((unsigned*)&hist[ex[i] >> 7], 1u);
                SE[pos] = (unsigned)ex[i] | ((unsigned)(p >> 7) << 14);
                SG[pos] = F.GW[(size_t)(tok0 + w + 8 * (kbase + (p >> 7))) * NEXP_SEL + (p & 127)];
            }
        }
        asm volatile("s_waitcnt vmcnt(0)" ::: "memory");
        f32x4 acc[16];
#pragma unroll
        for (int c = 0; c < 16; ++c) acc[c] = (f32x4){0.f, 0.f, 0.f, 0.f};
#pragma unroll 1
        for (int c0 = 0; c0 < npairs; c0 += 64) {
            const int wv = (int)SE[c0 + lane]; const int gv = __float_as_int(SG[c0 + lane]);
#pragma unroll 1
            for (int j0 = 0; j0 < 64; j0 += 16) {
                const int wr = __shfl(wv, j0 + r16);
                const int er = wr & 16383, sr = wr >> 14;
                const float gr = __int_as_float(__shfl(gv, j0 + r16));
                const unsigned char* ur = PU8 + (size_t)er * D + q4 * 16;
                u32x4 Ub[16];
#pragma unroll
                for (int t = 0; t < 16; ++t) Ub[t] = *(const u32x4*)(ur + t * 64);
                const float suv = SU[er], svv = SV[er];
                u32x4 V8[2][4];
#pragma unroll
                for (int k = 0; k < 4; ++k) V8[0][k] = *(const u32x4*)(PV8 + (size_t)(__builtin_amdgcn_readlane(wv, j0 + k) & 16383) * D + lane * 16);
                LAS const unsigned char* hr = F.lds + P10_H + (w + 8 * sr) * P10_HROW + q4 * 16;
                const float shv = SHl[w + 8 * sr];
                f32x4 C0 = {0.f, 0.f, 0.f, 0.f}, C1 = {0.f, 0.f, 0.f, 0.f};
#pragma unroll
                for (int t = 0; t < 16; ++t) {
                    const u32x4 hh = *(LAS const u32x4*)(hr + t * 64);
                    C0 = __builtin_amdgcn_mfma_f32_16x16x32_fp8_fp8(pack64(hh[0], hh[1]), pack64(Ub[t][0], Ub[t][1]), C0, 0, 0, 0);
                    C1 = __builtin_amdgcn_mfma_f32_16x16x32_fp8_fp8(pack64(hh[2], hh[3]), pack64(Ub[t][2], Ub[t][3]), C1, 0, 0, 0);
                }
                C0 = C0 + C1;
                const int rsel = lane & 3;
                const float dv = (rsel == 0 ? C0[0] : (rsel == 1 ? C0[1] : (rsel == 2 ? C0[2] : C0[3]))) * (suv * shv);
                const int actv = __float_as_int(gelu_tanh(dv) * (gr * svv));
#pragma unroll
                for (int sg = 0; sg < 4; ++sg) {
                    if (sg + 1 < 4) {
#pragma unroll
                        for (int k = 0; k < 4; ++k) V8[(sg + 1) & 1][k] = *(const u32x4*)(PV8 + (size_t)(__builtin_amdgcn_readlane(wv, j0 + 4 * (sg + 1) + k) & 16383) * D + lane * 16);
                    }
#pragma unroll
                    for (int k = 0; k < 4; ++k) {
                        u32x4 lo, hi; fp8x16_to_bf16(V8[sg & 1][k], lo, hi);
                        *(LAS u32x4*)(stg + k * P10_VROW + lane * 32) = lo;
                        *(LAS u32x4*)(stg + k * P10_VROW + lane * 32 + 16) = hi;
                    }
                    float a4[4];
#pragma unroll
                    for (int k = 0; k < 4; ++k) {
                        const int p = 4 * sg + k;
                        const float actk = __int_as_float(__builtin_amdgcn_readlane(actv, 16 * (p >> 2) + p));
                        const int slot = __builtin_amdgcn_readlane(wv, j0 + p) >> 14;
                        a4[k] = (slot == (lane & 3)) ? actk : 0.f;
                    }
                    const u32x2 apk = (u32x2){cvt_pk_bf16(a4[0], a4[1]), cvt_pk_bf16(a4[2], a4[3])};
                    s16x4 Aop; __builtin_memcpy(&Aop, &apk, 8);
                    LAS const unsigned char* tb = stg + ((lane & 15) >> 2) * P10_VROW + ((lane >> 4) * 16 + (lane & 3) * 4) * 2;
#pragma unroll
                    for (int c = 0; c < 16; ++c) {
                        const s16x4 Bop = __builtin_amdgcn_ds_read_tr16_b64_v4i16((LAS s16x4*)(tb + c * 128));
                        acc[c] = __builtin_amdgcn_mfma_f32_4x4x4bf16_1k(Aop, Bop, acc[c], 0, 0, 0);
                    }
                }
            }
        }
#pragma unroll
        for (int k = 0; k < PK; ++k) {
            if (k >= nk) continue;
            const int m = tok0 + w + 8 * (kbase + k);
            const float* x1 = F.T1 + (size_t)m * D; const float* mr = F.MOD + (size_t)mod_row(m) * 6144 + 5120;
            float tv[16]; float s = 0.f;
#pragma unroll
            for (int c = 0; c < 16; ++c) { const float t = x1[c * 64 + lane] * DN_ALPHA + mr[c * 64 + lane] * acc[c][k]; tv[c] = t; s += t; }
            const float mean = wave_sum(s) * (1.f / D);
            float q = 0.f;
#pragma unroll
            for (int c = 0; c < 16; ++c) { tv[c] -= mean; q += tv[c] * tv[c]; }
            const float rstd = rsqrtf(wave_sum(q) * (1.f / D) + LN_EPS);
            float* yo = (m < NTP) ? F.out + O_YP + (size_t)m * D : F.out + O_YS + (size_t)(m - NTP) * D;
#pragma unroll
            for (int c = 0; c < 16; ++c) yo[c * 64 + lane] = tv[c] * rstd * F.ln2_g[c * 64 + lane] + F.ln2_b[c * 64 + lane];
        }
    }
  }
}

constexpr int N_PHASES = 11;
__global__ void __launch_bounds__(NTHREADS, 2) fwd_kernel(Args args) {
    extern __shared__ __attribute__((aligned(16))) unsigned char lds_raw[];
    Frame F;
    F.lds = (LAS unsigned char*)lds_raw;
    F.tid = threadIdx.x; F.lane = F.tid & 63; F.wave = __builtin_amdgcn_readfirstlane(F.tid >> 6); F.G = gridDim.x; F.bid = blockIdx.x;
    F.x_p = (const float*)args.in[0]; F.x_s = (const float*)args.in[1]; F.c_p = (const float*)args.in[2]; F.c_s = (const float*)args.in[3];
    F.cache_k = (const float*)args.in[4]; F.cache_v = (const float*)args.in[5]; F.cache_ki = (const float*)args.in[6]; F.state_conv = (const float*)args.in[7];
    F.page_table = (const int*)args.in[8]; F.rel_bias = (const float*)args.in[9]; F.w_ada = (const float*)args.in[10]; F.b_ada = (const float*)args.in[11];
    F.w_in = (const float*)args.in[12]; F.conv_w = (const float*)args.in[13]; F.conv_b = (const float*)args.in[14]; F.w_o_attn = (const float*)args.in[15];
    F.w_o_conv = (const float*)args.in[16]; F.w_out = (const float*)args.in[17]; F.ln1_g = (const float*)args.in[18]; F.ln1_b = (const float*)args.in[19];
    F.ln2_g = (const float*)args.in[20]; F.ln2_b = (const float*)args.in[21]; F.peer_wq = (const float*)args.in[22]; F.peer_k1 = (const float*)args.in[23];
    F.peer_k2 = (const float*)args.in[24]; F.peer_u = (const float*)args.in[25]; F.peer_v = (const float*)args.in[26];
    F.out = args.out;
    unsigned char* ws = args.ws; F.ws = ws;
    F.MOD = (float*)(ws + WS_MOD); F.WIN = (bf16_t*)(ws + WS_WIN); F.WOA = (bf16_t*)(ws + WS_WOA); F.WOC = (bf16_t*)(ws + WS_WOC);
    F.WOUT = (bf16_t*)(ws + WS_WOUT); F.WQ = (bf16_t*)(ws + WS_WQ); F.K1 = (bf16_t*)(ws + WS_K1); F.K2 = (bf16_t*)(ws + WS_K2);
    F.PU = (bf16_t*)(ws + WS_PU); F.PV = (bf16_t*)(ws + WS_PV); F.H1 = (bf16_t*)(ws + WS_H1); F.PROJ = (bf16_t*)(ws + WS_PROJ);
    F.WI = (float*)(ws + WS_WI); F.SEL = (int*)(ws + WS_SEL); F.OATT = (bf16_t*)(ws + WS_OATT); F.OCONV = (bf16_t*)(ws + WS_OCONV);
    F.MERGED = (bf16_t*)(ws + WS_MERGED); F.T1 = (float*)(ws + WS_T1); F.H2 = (bf16_t*)(ws + WS_H2); F.QP = (bf16_t*)(ws + WS_QP);
    F.EIDX = (int*)(ws + WS_EIDX); F.GW = (float*)(ws + WS_GW);
    volatile LAS unsigned* misc = (volatile LAS unsigned*)(F.lds + LDS_MISC);
    if (F.tid < 16) misc[F.tid] = 0u;
    __syncthreads();
    XcdBarrier bar; bar.bar = (unsigned*)(ws + WS_CTL); bar.x = 0; bar.st = misc;
    const int lo = args.ph_lo, hi = args.ph_hi;
    if (hi - lo > 1) bar = xcd_barrier_post((unsigned*)(ws + WS_CTL), misc);
#define IN(k) (lo <= (k) && (k) < hi)
#define SEAM(k) do { if (IN(k) && IN((k) + 1)) xcd_barrier(bar); } while (0)
    if (IN(0)) p0_prologue(F);       SEAM(0);
    if (IN(1)) p1_modulate(F);       SEAM(1);
    if (IN(2)) p2_gemm_in(F);        SEAM(2);
    if (IN(3)) p3_index(F);          SEAM(3);
    if (IN(4)) p4_attention(F);      SEAM(4);
    if (IN(5)) p5_gemm_merge(F);     SEAM(5);
    if (IN(6)) p6_gemm_out(F);       SEAM(6);
    if (IN(7)) p7_ln1(F);            SEAM(7);
    if (IN(8)) p8_gemm_q(F);         SEAM(8);
    if (IN(9)) p9_route(F);          SEAM(9);
    if (IN(10)) p10_peer(F);
#undef IN
#undef SEAM
}

extern "C" void kernel_launch(void* const* d_in, const int* in_sizes, int n_in, void* d_out, int out_size, void* d_ws, size_t ws_size, hipStream_t stream) {
    static int grid = 0;
    if (grid == 0) {
        if (n_in != 27 || (size_t)out_size != O_END || ws_size < WS_END) { fprintf(stderr, "kernel_launch: unexpected shapes (n_in %d out %d ws %zu)\n", n_in, out_size, ws_size); grid = -1; return; }
        int dev = 0, cus = 0;
        if (hipGetDevice(&dev) != hipSuccess || hipDeviceGetAttribute(&cus, hipDeviceAttributeMultiprocessorCount, dev) != hipSuccess) { grid = -1; return; }
        if (hipFuncSetAttribute((const void*)fwd_kernel, hipFuncAttributeMaxDynamicSharedMemorySize, LDS_BYTES) != hipSuccess) { fprintf(stderr, "kernel_launch: hipFuncSetAttribute failed\n"); grid = -1; return; }
        (void)hipGetLastError();
        grid = cus < 256 ? cus : 256;
    }
    if (grid < 0) return;
    (void)hipMemsetAsync((char*)d_ws + WS_CTL, 0, CTL_ZERO_BYTES, stream);
    Args a{};
    for (int i = 0; i < 27; ++i) a.in[i] = d_in[i];
    a.out = (float*)d_out; a.ws = (unsigned char*)d_ws;
#if N_LAUNCHES == 1
    a.ph_lo = 0; a.ph_hi = N_PHASES;
    hipLaunchKernelGGL(fwd_kernel, dim3(grid), dim3(NTHREADS), LDS_BYTES, stream, a);
#else
    for (int p = 0; p < N_PHASES; ++p) { a.ph_lo = p; a.ph_hi = p + 1; hipLaunchKernelGGL(fwd_kernel, dim3(grid), dim3(NTHREADS), LDS_BYTES, stream, a); }
#endif
}
```

```cpp
#include <hip/hip_runtime.h>
#include <cstdio>
#include <cstdint>

#ifndef N_LAUNCHES
#define N_LAUNCHES 1
#endif

typedef unsigned short bf16_t;
typedef short bf16x8 __attribute__((ext_vector_type(8)));
typedef float f32x4 __attribute__((ext_vector_type(4)));
typedef float f32x16 __attribute__((ext_vector_type(16)));
typedef unsigned u32x4 __attribute__((ext_vector_type(4)));
typedef unsigned u32x2 __attribute__((ext_vector_type(2)));
#define LAS __attribute__((address_space(3)))

constexpr int D = 1024, NB_P = 8, SEQ = 2048, NB_S = 32, TS = 8, PAST = 8192, PAGE = 128, NPAGES = 64;
constexpr int NTP = NB_P * SEQ;
constexpr int NTS = NB_S * TS;
constexpr int NT = NTP + NTS;
constexpr int NMIX = 4676, NMIXP = 4736;
constexpr int C_Q = 0, C_K = 512, C_V = 640, C_QI = 768, C_KI = 1024, C_BG = 1088, C_CG = 1600, C_XIN = 2112, C_GA = 2624, C_GB = 3648, C_WI = 4672;
constexpr int NSEL = 256;
constexpr float ATTN_SCALE = 0.125f, IDX_SCALE = 0.0625f;
constexpr float DN_ALPHA = 1.189207115002721f, LN_EPS = 1e-5f;
constexpr int NEXP_SEL = 128;

constexpr size_t O_YP = 0, O_YS = 16777216, O_KP = 17039360, O_VP = 19136512, O_KIP = 21233664, O_CP = 22282240,
                 O_KS = 22290432, O_VS = 22323200, O_KIS = 22355968, O_CS = 22372352, O_END = 22405120;

constexpr size_t MB = 1048576;
constexpr size_t WS_CTL = 0, WS_MOD = 1 * MB, WS_WIN = 2 * MB, WS_WOA = 12 * MB, WS_WOC = 13 * MB, WS_WOUT = 14 * MB, WS_WQ = 16 * MB,
                 WS_K1 = 18 * MB, WS_K2 = 18 * MB + 65536, WS_PU = 20 * MB, WS_PV = 52 * MB, WS_H1 = 84 * MB, WS_PROJ = 118 * MB,
                 WS_WI = 270 * MB, WS_SEL = 271 * MB, WS_OATT = 288 * MB, WS_OCONV = 305 * MB, WS_MERGED = 322 * MB, WS_T1 = 355 * MB,
                 WS_H2 = 420 * MB, WS_QP = 453 * MB, WS_EIDX = 486 * MB, WS_GW = 495 * MB, WS_SS = 504 * MB, WS_SE = 513 * MB, WS_SG = 523 * MB, WS_VT = 533 * MB, WS_CGX = 538 * MB, WS_END = 539 * MB;
constexpr size_t WS_PU8 = WS_PU, WS_PV8 = WS_PU + 16 * MB, WS_SU = WS_PV, WS_SV = WS_PV + 65536, WS_H8 = WS_PV + 1 * MB, WS_SH = WS_PV + 20 * MB;
constexpr int CTL_ZERO_BYTES = 65536;

constexpr int NTHREADS = 512;
constexpr int LDS_BYTES = 160 * 1024 - 512;
constexpr int LDS_MISC = LDS_BYTES - 64;

__device__ __forceinline__ float bf2f(bf16_t b) { return __uint_as_float(((unsigned)b) << 16); }
__device__ __forceinline__ float bflo(unsigned p) { return __uint_as_float(p << 16); }
__device__ __forceinline__ float bfhi(unsigned p) { return __uint_as_float(p & 0xFFFF0000u); }
typedef __bf16 bf16x2_t __attribute__((ext_vector_type(2)));
typedef float f32x2_t __attribute__((ext_vector_type(2)));
__device__ __forceinline__ unsigned cvt_pk_bf16(float lo, float hi) { const f32x2_t f = {lo, hi}; const bf16x2_t b = __builtin_convertvector(f, bf16x2_t); unsigned r; __builtin_memcpy(&r, &b, 4); return r; }
__device__ __forceinline__ bf16_t f2bf(float f) { return (bf16_t)(cvt_pk_bf16(f, 0.f) & 0xFFFFu); }
__device__ __forceinline__ float wave_sum(float v) {
#pragma unroll
    for (int o = 32; o >= 1; o >>= 1) v += __shfl_xor(v, o);
    return v;
}
__device__ __forceinline__ float wave_sum_dpp(float v) {
    int x;
    x = __builtin_amdgcn_update_dpp(0, __float_as_int(v), 0xB1, 0xF, 0xF, false);  v += __int_as_float(x);
    x = __builtin_amdgcn_update_dpp(0, __float_as_int(v), 0x4E, 0xF, 0xF, false);  v += __int_as_float(x);
    x = __builtin_amdgcn_update_dpp(0, __float_as_int(v), 0x141, 0xF, 0xF, false); v += __int_as_float(x);
    x = __builtin_amdgcn_update_dpp(0, __float_as_int(v), 0x140, 0xF, 0xF, false); v += __int_as_float(x);
    x = __builtin_amdgcn_update_dpp(0, __float_as_int(v), 0x142, 0xA, 0xF, false); v += __int_as_float(x);
    x = __builtin_amdgcn_update_dpp(0, __float_as_int(v), 0x143, 0xC, 0xF, false); v += __int_as_float(x);
    return __int_as_float(__builtin_amdgcn_readlane(__float_as_int(v), 63));
}
__device__ __forceinline__ float wave_max(float v) {
#pragma unroll
    for (int o = 32; o >= 1; o >>= 1) v = fmaxf(v, __shfl_xor(v, o));
    return v;
}
__device__ __forceinline__ float sigmoidf_(float x) { return 1.f / (1.f + __expf(-x)); }
__device__ __forceinline__ float gelu_tanh(float a) {
    const float z = 0.7978845608028654f * (a + 0.044715f * a * a * a);
    const float e = __expf(2.f * z);
    const float t = 1.f - 2.f * __builtin_amdgcn_rcpf(e + 1.f);
    return 0.5f * a * (1.f + t);
}
__device__ __forceinline__ unsigned f2ord(float f) { const unsigned u = __float_as_uint(f); return (u & 0x80000000u) ? ~u : (u | 0x80000000u); }
__device__ __forceinline__ int t5_bucket(int n) {
    if (n < 16) return n;
    int b = 16;
    b += (n >= 19) + (n >= 21) + (n >= 24) + (n >= 27) + (n >= 31) + (n >= 35) + (n >= 40) + (n >= 46) + (n >= 52) + (n >= 59) + (n >= 67) + (n >= 77) + (n >= 87) + (n >= 99) + (n >= 113);
    return b;
}

#define XB_TMO      128
#define XB_XCNT(j)  (256  + 64 * (j))
#define XB_XSUB(j)  (1280 + 64 * (j))
#define XB_XGEN(j)  (2304 + 64 * (j))
#define XB_TOP      3328
#define XB_TOPGEN   3392
#define XCD_BAR_WORDS 3456
#define XB_SPIN_CAP (1u << 18)
__device__ __forceinline__ unsigned xb_ld(unsigned* p)              { return __hip_atomic_load(p, __ATOMIC_RELAXED, __HIP_MEMORY_SCOPE_AGENT); }
__device__ __forceinline__ unsigned xb_add(unsigned* p, unsigned v) { return __hip_atomic_fetch_add(p, v, __ATOMIC_RELAXED, __HIP_MEMORY_SCOPE_AGENT); }
__device__ __forceinline__ unsigned xb_xcc_id() { return (unsigned)__builtin_amdgcn_s_getreg((3 << 11) | 20) & 0xFu; }
#define XB_SPIN(cond, bar) do { unsigned _sp = 0; while (cond) { __builtin_amdgcn_s_sleep(1); \
    if ((++_sp & 255u) == 0u) { if (xb_ld(&(bar)[XB_TMO])) break; if (_sp > XB_SPIN_CAP) { atomicAdd(&(bar)[XB_TMO], 1u); break; } } } } while (0)
struct XcdBarrier { unsigned* bar; unsigned x; volatile LAS unsigned* st; };
__device__ __forceinline__ XcdBarrier xcd_barrier_post(unsigned* bar, volatile LAS unsigned* st) {
    XcdBarrier b; b.bar = bar; b.x = xb_xcc_id(); b.st = st;
    if (threadIdx.x == 0) (void)xb_add(&bar[XB_XCNT(b.x)], 1u);
    return b;
}
__device__ __forceinline__ void xcd_barrier_complete(unsigned* bar, unsigned x, unsigned& nloc, unsigned& nx) {
    const unsigned G = gridDim.x * gridDim.y * gridDim.z;
    unsigned sum, cnt, mine, sp = 0u;
    for (;;) {
        sum = 0u; cnt = 0u; mine = 0u;
#pragma unroll
        for (unsigned j = 0; j < 16; ++j) { const unsigned c = xb_ld(&bar[XB_XCNT(j)]); sum += c; cnt += (c > 0u) ? 1u : 0u; mine = (j == x) ? c : mine; }
        if (sum == G) break;
        __builtin_amdgcn_s_sleep(1);
        if ((++sp & 255u) == 0u) { if (xb_ld(&bar[XB_TMO])) break; if (sp > XB_SPIN_CAP) { atomicAdd(&bar[XB_TMO], 1u); break; } }
    }
    nloc = mine > 0u ? mine : 1u; nx = cnt > 0u ? cnt : 1u;
}
__device__ __forceinline__ void xcd_barrier(const XcdBarrier& b) {
    asm volatile("s_waitcnt vmcnt(0)" ::: "memory");
    __syncthreads();
    if (threadIdx.x == 0) {
        unsigned* bar = b.bar;
        __builtin_amdgcn_s_waitcnt(0);
        unsigned nloc = b.st[0], nx = b.st[1];
        if (nloc == 0u) { xcd_barrier_complete(bar, b.x, nloc, nx); b.st[0] = nloc; b.st[1] = nx; }
        const unsigned old = xb_add(&bar[XB_XSUB(b.x)], 1u);
        const unsigned gen = old / nloc;
        if (old + 1u == (gen + 1u) * nloc) {
            __builtin_amdgcn_fence(__ATOMIC_RELEASE, "agent");
            asm volatile("s_waitcnt vmcnt(0)" ::: "memory");
            const unsigned og = xb_add(&bar[XB_TOP], 1u);
            const unsigned tg = og / nx;
            if (og + 1u == (tg + 1u) * nx) xb_add(&bar[XB_TOPGEN], 1u);
            else XB_SPIN(xb_ld(&bar[XB_TOPGEN]) == tg, bar);
            __builtin_amdgcn_fence(__ATOMIC_ACQUIRE, "agent");
            xb_add(&bar[XB_XGEN(b.x)], 1u);
            asm volatile("s_waitcnt vmcnt(0)" ::: "memory");
        } else {
            XB_SPIN(xb_ld(&bar[XB_XGEN(b.x)]) == gen, bar);
            __builtin_amdgcn_fence(__ATOMIC_ACQUIRE, "agent");
            asm volatile("s_waitcnt vmcnt(0)" ::: "memory");
        }
    }
    __syncthreads();
}

struct Args { const void* in[27]; float* out; unsigned char* ws; int ph_lo, ph_hi; };
struct Core { LAS unsigned char* lds; int tid, lane, wave, G, bid; };
struct Frame {
    LAS unsigned char* lds;
    int tid, lane, wave, G, bid;
    const float *x_p, *x_s, *c_p, *c_s, *cache_k, *cache_v, *cache_ki, *state_conv, *rel_bias, *w_ada, *b_ada, *w_in, *conv_w, *conv_b,
                *w_o_attn, *w_o_conv, *w_out, *ln1_g, *ln1_b, *ln2_g, *ln2_b, *peer_wq, *peer_k1, *peer_k2, *peer_u, *peer_v;
    const int* page_table;
    float* out; unsigned char* ws;
    float* MOD; bf16_t *WIN, *WOA, *WOC, *WOUT, *WQ, *K1, *K2, *PU, *PV, *H1, *PROJ, *OATT, *OCONV, *MERGED, *H2, *QP;
    float *WI, *T1, *GW; int *SEL, *EIDX;
};
constexpr int LDS_PTAB = LDS_BYTES - 512;
__device__ __forceinline__ unsigned char* ldptr(const Core& C, int k) {
    LAS const unsigned* p = (LAS const unsigned*)(C.lds + LDS_PTAB) + 2 * k;
    const unsigned lo = __builtin_amdgcn_readfirstlane(p[0]), hi = __builtin_amdgcn_readfirstlane(p[1]);
    return (unsigned char*)(((unsigned long long)hi << 32) | (unsigned long long)lo);
}
__device__ __forceinline__ void load_frame(Frame& F, const Core& C) {
    F.lds = C.lds; F.tid = C.tid; F.lane = C.lane; F.wave = C.wave; F.G = C.G; F.bid = C.bid;
    F.x_p = (const float*)ldptr(C, 0); F.x_s = (const float*)ldptr(C, 1); F.c_p = (const float*)ldptr(C, 2); F.c_s = (const float*)ldptr(C, 3);
    F.cache_k = (const float*)ldptr(C, 4); F.cache_v = (const float*)ldptr(C, 5); F.cache_ki = (const float*)ldptr(C, 6); F.state_conv = (const float*)ldptr(C, 7);
    F.page_table = (const int*)ldptr(C, 8); F.rel_bias = (const float*)ldptr(C, 9); F.w_ada = (const float*)ldptr(C, 10); F.b_ada = (const float*)ldptr(C, 11);
    F.w_in = (const float*)ldptr(C, 12); F.conv_w = (const float*)ldptr(C, 13); F.conv_b = (const float*)ldptr(C, 14); F.w_o_attn = (const float*)ldptr(C, 15);
    F.w_o_conv = (const float*)ldptr(C, 16); F.w_out = (const float*)ldptr(C, 17); F.ln1_g = (const float*)ldptr(C, 18); F.ln1_b = (const float*)ldptr(C, 19);
    F.ln2_g = (const float*)ldptr(C, 20); F.ln2_b = (const float*)ldptr(C, 21); F.peer_wq = (const float*)ldptr(C, 22); F.peer_k1 = (const float*)ldptr(C, 23);
    F.peer_k2 = (const float*)ldptr(C, 24); F.peer_u = (const float*)ldptr(C, 25); F.peer_v = (const float*)ldptr(C, 26);
    F.out = (float*)ldptr(C, 27);
    unsigned char* ws = ldptr(C, 28);
    F.MOD = (float*)(ws + WS_MOD); F.WIN = (bf16_t*)(ws + WS_WIN); F.WOA = (bf16_t*)(ws + WS_WOA); F.WOC = (bf16_t*)(ws + WS_WOC);
    F.WOUT = (bf16_t*)(ws + WS_WOUT); F.WQ = (bf16_t*)(ws + WS_WQ); F.K1 = (bf16_t*)(ws + WS_K1); F.K2 = (bf16_t*)(ws + WS_K2);
    F.PU = (bf16_t*)(ws + WS_PU); F.PV = (bf16_t*)(ws + WS_PV); F.H1 = (bf16_t*)(ws + WS_H1); F.PROJ = (bf16_t*)(ws + WS_PROJ);
    F.WI = (float*)(ws + WS_WI); F.SEL = (int*)(ws + WS_SEL); F.OATT = (bf16_t*)(ws + WS_OATT); F.OCONV = (bf16_t*)(ws + WS_OCONV);
    F.MERGED = (bf16_t*)(ws + WS_MERGED); F.T1 = (float*)(ws + WS_T1); F.H2 = (bf16_t*)(ws + WS_H2); F.QP = (bf16_t*)(ws + WS_QP);
    F.EIDX = (int*)(ws + WS_EIDX); F.GW = (float*)(ws + WS_GW);
}
__device__ __forceinline__ const float* x_row(const Frame& F, int m) { return m < NTP ? F.x_p + (size_t)m * D : F.x_s + (size_t)(m - NTP) * D; }
__device__ __forceinline__ int mod_row(int m) { return m < NTP ? (m >> 11) : NB_P + ((m - NTP) >> 3); }

constexpr int P0_MOD_ITEMS = 96;
constexpr int P0_T_WIN = 16 * 74, P0_T_WOA = 8 * 16, P0_T_WOC = 8 * 16, P0_T_WOUT = 16 * 16, P0_T_WQ = 16 * 16;
constexpr int P0_T_ITEMS = P0_T_WIN + P0_T_WOA + P0_T_WOC + P0_T_WOUT + P0_T_WQ;
constexpr int P0_CVT_ITEMS = 2 * (16384 * 1024 / 8192);
constexpr int P0_MISC_ITEMS = 1;
constexpr int P0_ITEMS = P0_MOD_ITEMS + P0_T_ITEMS + P0_CVT_ITEMS + P0_MISC_ITEMS;

__device__ __forceinline__ void p0_mod_item(const Frame& F, int ng) {
    LAS float* cs = (LAS float*)F.lds;
    LAS float* red = (LAS float*)(F.lds + 40 * 256 * 4);
    float acc[40];
#pragma unroll
    for (int r = 0; r < 40; ++r) acc[r] = 0.f;
    const int n = ng * 64 + F.lane;
    for (int kc = 0; kc < 4; ++kc) {
        __syncthreads();
#pragma unroll 1
        for (int hb = 0; hb < 2; ++hb) {
            float cv[10];
#pragma unroll
            for (int i = 0; i < 10; ++i) { const int e = F.tid + (hb * 10 + i) * NTHREADS; const int r = e >> 8, k = e & 255; cv[i] = (r < 8) ? F.c_p[r * D + kc * 256 + k] : F.c_s[(r - 8) * D + kc * 256 + k]; }
#pragma unroll
            for (int i = 0; i < 10; ++i) cs[F.tid + (hb * 10 + i) * NTHREADS] = cv[i];
        }
        __syncthreads();
        float wvv[32];
#pragma unroll
        for (int kk = 0; kk < 32; ++kk) wvv[kk] = F.w_ada[(size_t)(kc * 256 + F.wave * 32 + kk) * 6144 + n];
#pragma unroll
        for (int kk = 0; kk < 32; ++kk) {
            const int kl = F.wave * 32 + kk;
#pragma unroll
            for (int r = 0; r < 40; ++r) acc[r] += cs[r * 256 + kl] * wvv[kk];
        }
    }
#pragma unroll
    for (int r = 0; r < 40; ++r) red[(F.wave * 40 + r) * 64 + F.lane] = acc[r];
    __syncthreads();
    for (int e = F.tid; e < 40 * 64; e += NTHREADS) {
        const int r = e >> 6, l = e & 63; float s = F.b_ada[ng * 64 + l];
#pragma unroll
        for (int w = 0; w < 8; ++w) s += red[(w * 40 + r) * 64 + l];
        F.MOD[r * 6144 + ng * 64 + l] = s;
    }
    __syncthreads();
}
__device__ __forceinline__ void p0_transpose_tile(const Frame& F, const float* W, int N, int K, bf16_t* Wt, int kt, int nt, bool permute) {
    LAS bf16_t* tile = (LAS bf16_t*)F.lds;
    __syncthreads();
    { const int k = F.tid >> 3, c0 = (F.tid & 7) * 8;
      const float* rp = W + (size_t)(kt * 64 + k) * N + nt * 64 + c0;
      const f32x4 z = {0.f, 0.f, 0.f, 0.f};
      const f32x4 v0 = (nt * 64 + c0 < N) ? *(const f32x4*)rp : z, v1 = (nt * 64 + c0 + 4 < N) ? *(const f32x4*)(rp + 4) : z;
#pragma unroll
      for (int j = 0; j < 4; ++j) { tile[k * 66 + c0 + j] = f2bf(v0[j]); tile[k * 66 + c0 + 4 + j] = f2bf(v1[j]); } }
    __syncthreads();
    { const int nl = F.tid >> 3, k0 = (F.tid & 7) * 8; const int n = nt * 64 + nl;
      if (n < N) {
          int nd = n; if (permute) nd = (n < 1024) ? n : (n < 1028 ? C_WI + (n - 1024) : n - 4);
          unsigned p[4];
#pragma unroll
          for (int j = 0; j < 4; ++j) p[j] = (unsigned)tile[(k0 + 2 * j) * 66 + nl] | ((unsigned)tile[(k0 + 2 * j + 1) * 66 + nl] << 16);
          *(u32x4*)(Wt + (size_t)nd * K + kt * 64 + k0) = (u32x4){p[0], p[1], p[2], p[3]};
      } }
}
constexpr int P0_CVT32_ITEMS = 2 * (16384 / 32);
constexpr int P0_OTHER = P0_T_ITEMS + P0_CVT32_ITEMS + 1;
__device__ __forceinline__ void p0_other_item(const Frame& F, int i) {
    if (i < P0_T_ITEMS) {
        if (i < P0_T_WIN) { p0_transpose_tile(F, F.w_in, NMIX, D, F.WIN, i / 74, i % 74, true); return; }
        i -= P0_T_WIN;
        if (i < P0_T_WOA) { p0_transpose_tile(F, F.w_o_attn, D, 512, F.WOA, i / 16, i % 16, false); return; }
        i -= P0_T_WOA;
        if (i < P0_T_WOC) { p0_transpose_tile(F, F.w_o_conv, D, 512, F.WOC, i / 16, i % 16, false); return; }
        i -= P0_T_WOC;
        if (i < P0_T_WOUT) { p0_transpose_tile(F, F.w_out, D, D, F.WOUT, i / 16, i % 16, false); return; }
        i -= P0_T_WOUT;
        p0_transpose_tile(F, F.peer_wq, D, D, F.WQ, i / 16, i % 16, false); return;
    }
    i -= P0_T_ITEMS;
    if (i < P0_CVT32_ITEMS) {
        const float* src = (i < 512) ? F.peer_u : F.peer_v;
        unsigned char* dst = F.ws + ((i < 512) ? WS_PU8 : WS_PV8); float* sinv = (float*)(F.ws + ((i < 512) ? WS_SU : WS_SV));
        const int row0 = (i & 511) * 32 + F.wave * 4;
        f32x4 v[4][4];
#pragma unroll
        for (int rr = 0; rr < 4; ++rr)
#pragma unroll
            for (int q = 0; q < 4; ++q) v[rr][q] = *(const f32x4*)(src + (size_t)(row0 + rr) * D + F.lane * 16 + q * 4);
#pragma unroll
        for (int rr = 0; rr < 4; ++rr) {
            float am = 0.f;
#pragma unroll
            for (int q = 0; q < 4; ++q)
#pragma unroll
                for (int e = 0; e < 4; ++e) am = fmaxf(am, fabsf(v[rr][q][e]));
            am = wave_max(am);
            const float sc = am > 0.f ? 224.f / am : 1.f;
            unsigned wd[4];
#pragma unroll
            for (int q = 0; q < 4; ++q) { int t = 0; t = __builtin_amdgcn_cvt_pk_fp8_f32(v[rr][q][0] * sc, v[rr][q][1] * sc, t, false); t = __builtin_amdgcn_cvt_pk_fp8_f32(v[rr][q][2] * sc, v[rr][q][3] * sc, t, true); wd[q] = (unsigned)t; }
            *(u32x4*)(dst + (size_t)(row0 + rr) * D + F.lane * 16) = (u32x4){wd[0], wd[1], wd[2], wd[3]};
            if (F.lane == 0) sinv[row0 + rr] = am > 0.f ? am * (1.f / 224.f) : 1.f;
        }
        return;
    }
    for (int e = F.tid; e < (4864 - NMIX) * D; e += NTHREADS) F.WIN[(size_t)NMIX * D + e] = 0;
    for (int e = F.tid; e < 128 * 64; e += NTHREADS) { F.K1[e] = f2bf(F.peer_k1[e]); F.K2[e] = f2bf(F.peer_k2[e]); }
}
__device__ __forceinline__ void p0_prologue(const Frame& F) {
    constexpr int NMODWG = P0_MOD_ITEMS, HEAD = 8;
    if (F.G <= NMODWG) {
        for (int it = F.bid; it < P0_MOD_ITEMS + P0_OTHER; it += F.G) { if (it < P0_MOD_ITEMS) p0_mod_item(F, it); else p0_other_item(F, it - P0_MOD_ITEMS); }
        return;
    }
    const int nfree = F.G - NMODWG;
    int head_items = HEAD * nfree; if (head_items > P0_OTHER) head_items = P0_OTHER;
    if (F.bid < NMODWG) p0_mod_item(F, F.bid);
    else for (int j = F.bid - NMODWG; j < head_items; j += nfree) p0_other_item(F, j);
    for (int j = head_items + F.bid; j < P0_OTHER; j += F.G) p0_other_item(F, j);
}

__device__ __forceinline__ void p1_modulate(const Frame& F) {
    const int stride = F.G * 8;
    for (int m0 = F.bid * 8 + F.wave; m0 < NT; m0 += 2 * stride) {
        f32x4 xv[2][4], sv[2][4], hv[2][4];
#pragma unroll
        for (int rr = 0; rr < 2; ++rr) {
            const int m = (m0 + rr * stride < NT) ? m0 + rr * stride : m0;
            const float* xr = x_row(F, m); const float* mr = F.MOD + (size_t)mod_row(m) * 6144;
#pragma unroll
            for (int q = 0; q < 4; ++q) {
                const int e = (q >> 1) * 512 + F.lane * 8 + (q & 1) * 4;
                xv[rr][q] = *(const f32x4*)(xr + e); sv[rr][q] = *(const f32x4*)(mr + 1024 + e); hv[rr][q] = *(const f32x4*)(mr + e);
            }
        }
#pragma unroll
        for (int rr = 0; rr < 2; ++rr) {
            const int m = m0 + rr * stride;
            if (m >= NT) continue;
#pragma unroll
            for (int hlf = 0; hlf < 2; ++hlf) {
                const f32x4 a = xv[rr][2 * hlf] * (sv[rr][2 * hlf] + 1.f) + hv[rr][2 * hlf], b2 = xv[rr][2 * hlf + 1] * (sv[rr][2 * hlf + 1] + 1.f) + hv[rr][2 * hlf + 1];
                *(u32x4*)(F.H1 + (size_t)m * D + hlf * 512 + F.lane * 8) = (u32x4){cvt_pk_bf16(a[0], a[1]), cvt_pk_bf16(a[2], a[3]), cvt_pk_bf16(b2[0], b2[1]), cvt_pk_bf16(b2[2], b2[3])};
            }
        }
    }
}

constexpr int BM = 256, BN = 128, BK = 64;
constexpr int XPANEL = BM * 32 + 32, WPANEL = BN * 32 + 32;
constexpr int XSTAGE = 4 * XPANEL, WSTAGE = 4 * WPANEL, GSTAGE = XSTAGE + WSTAGE;
__device__ __forceinline__ void gemm_accum(const Frame& F, f32x16 (&acc)[2][2], const bf16_t* __restrict__ X, int ldx, const bf16_t* __restrict__ W, int ldw, int K, int m0, int n0) {
    const int tid = F.tid, lane = F.lane, r = lane & 31, h = lane >> 5, wm = F.wave >> 1, wn = F.wave & 1;
    u32x4 xr[4], wr[2];
    const int nk = K / BK;
    const int crow = tid >> 3, ckc = tid & 7;
    const bf16_t* xg = X + (size_t)(m0 + crow) * ldx + ckc * 8;
    const bf16_t* wg = W + (size_t)(n0 + crow) * ldw + ckc * 8;
    const int ldso = (ckc >> 1) * 1  ;
    const int xoff = ldso * XPANEL + crow * 32 + (ckc & 1) * 16;
    const int woff = ldso * WPANEL + crow * 32 + (ckc & 1) * 16;
#pragma unroll
    for (int i = 0; i < 4; ++i) xr[i] = *(const u32x4*)(xg + (size_t)(64 * i) * ldx);
#pragma unroll
    for (int i = 0; i < 2; ++i) wr[i] = *(const u32x4*)(wg + (size_t)(64 * i) * ldw);
    __syncthreads();
    for (int kt = 0; kt < nk; ++kt) {
        LAS unsigned char* st = F.lds + (kt & 1) * GSTAGE;
#pragma unroll
        for (int i = 0; i < 4; ++i) *(LAS u32x4*)(st + xoff + i * 64 * 32) = xr[i];
#pragma unroll
        for (int i = 0; i < 2; ++i) *(LAS u32x4*)(st + XSTAGE + woff + i * 64 * 32) = wr[i];
        __syncthreads();
        if (kt + 1 < nk) {
#pragma unroll
            for (int i = 0; i < 4; ++i) xr[i] = *(const u32x4*)(xg + (size_t)(64 * i) * ldx + (kt + 1) * BK);
#pragma unroll
            for (int i = 0; i < 2; ++i) wr[i] = *(const u32x4*)(wg + (size_t)(64 * i) * ldw + (kt + 1) * BK);
        }
#pragma unroll
        for (int s = 0; s < 4; ++s) {
            bf16x8 a[2], b[2];
#pragma unroll
            for (int ni = 0; ni < 2; ++ni) a[ni] = *(LAS bf16x8*)(st + XSTAGE + s * WPANEL + (wn * 64 + ni * 32 + r) * 32 + h * 16);
#pragma unroll
            for (int mi = 0; mi < 2; ++mi) b[mi] = *(LAS bf16x8*)(st + s * XPANEL + (wm * 64 + mi * 32 + r) * 32 + h * 16);
#pragma unroll
            for (int mi = 0; mi < 2; ++mi)
#pragma unroll
                for (int ni = 0; ni < 2; ++ni) acc[mi][ni] = __builtin_amdgcn_mfma_f32_32x32x16_bf16(a[ni], b[mi], acc[mi][ni], 0, 0, 0);
        }
    }
}
#define GEMM_EPI_LOOP(...) \
    { const int r_ = F.lane & 31, h_ = F.lane >> 5, wm_ = F.wave >> 1, wn_ = F.wave & 1; \
      _Pragma("unroll") for (int mi = 0; mi < 2; ++mi) _Pragma("unroll") for (int ni = 0; ni < 2; ++ni) _Pragma("unroll") for (int g = 0; g < 4; ++g) { \
          const int m = m0 + wm_ * 64 + mi * 32 + r_; const int n = n0 + wn_ * 64 + ni * 32 + 8 * g + 4 * h_; __VA_ARGS__ } }
#define ACC4(A) ((f32x4){A[mi][ni][4 * g], A[mi][ni][4 * g + 1], A[mi][ni][4 * g + 2], A[mi][ni][4 * g + 3]})
__device__ __forceinline__ void zero_acc(f32x16 (&acc)[2][2]) {
#pragma unroll
    for (int mi = 0; mi < 2; ++mi)
#pragma unroll
        for (int ni = 0; ni < 2; ++ni)
#pragma unroll
            for (int e = 0; e < 16; ++e) acc[mi][ni][e] = 0.f;
}
__device__ __forceinline__ u32x2 pk4(const f32x4 v) { return (u32x2){cvt_pk_bf16(v[0], v[1]), cvt_pk_bf16(v[2], v[3])}; }

__device__ __forceinline__ void gemm_slice8(const Frame& F, f32x16 (&sacc)[1][1], const bf16_t* __restrict__ X, int ldx, const bf16_t* __restrict__ W, int ldw, int K, int m0, int n0) {
    const int r = F.lane & 31, h = F.lane >> 5, wq = F.wave & 3, kh = F.wave >> 2;
    const bf16_t* wp = W + (size_t)(n0 + 32 * wq + r) * ldw + kh * (K / 2) + h * 8;
    const bf16_t* xp = X + (size_t)(m0 + (r & 7)) * ldx + kh * (K / 2) + h * 8;
    f32x16 c;
#pragma unroll
    for (int e = 0; e < 16; ++e) c[e] = 0.f;
#pragma unroll 1
    for (int k0 = 0; k0 < K / 2; k0 += 128) {
        bf16x8 a[8], b[8];
#pragma unroll
        for (int t = 0; t < 8; ++t) { a[t] = *(const bf16x8*)(wp + k0 + t * 16); b[t] = *(const bf16x8*)(xp + k0 + t * 16); }
#pragma unroll
        for (int t = 0; t < 8; ++t) c = __builtin_amdgcn_mfma_f32_32x32x16_bf16(a[t], b[t], c, 0, 0, 0);
    }
    LAS float* cb = (LAS float*)F.lds + wq * (16 * 64);
    __syncthreads();
    if (kh == 1) {
#pragma unroll
        for (int e = 0; e < 16; ++e) cb[e * 64 + F.lane] = c[e];
    }
    __syncthreads();
    if (kh == 0) {
#pragma unroll
        for (int e = 0; e < 16; ++e) c[e] += cb[e * 64 + F.lane];
    }
    sacc[0][0] = c;
}
#define SLICE_EPI_LOOP(...) \
    if (F.wave < 4 && (F.lane & 31) < 8) { const int h_ = F.lane >> 5, wq_ = F.wave & 3; constexpr int mi = 0, ni = 0; \
      _Pragma("unroll") for (int g = 0; g < 4; ++g) { const int m = m0 + (F.lane & 31); const int n = n0 + wq_ * 32 + 8 * g + 4 * h_; __VA_ARGS__ } }

namespace pg8 {
#define PG8_LAS __attribute__((address_space(3)))
typedef unsigned short bf16_t;
typedef short bf16x8 __attribute__((ext_vector_type(8)));
typedef float f32x4 __attribute__((ext_vector_type(4)));
typedef unsigned u32x4 __attribute__((ext_vector_type(4)));
constexpr int BM = 256, BK = 64, HALF = 128, HTB = HALF * BK * 2  , STAGE_BYTES = 8 * HTB, NXCD = 8, WGM = 8;

__host__ __device__ __forceinline__ int lds_byte(int r, int c) { const int st = (r >> 4) * 2 + (c >> 5), rr = r & 15, cc = c & 31, ob = rr * 64 + cc * 2; return st * 1024 + (ob ^ (((ob >> 9) & 1) << 5)); }
__host__ __device__ __forceinline__ void stage_rc(int b, int& R, int& C) { const int st = b / 1024, sb = b % 1024, swz = sb ^ (((sb >> 9) & 1) << 5); R = (st >> 1) * 16 + swz / 64; C = (st & 1) * 32 + (swz % 64) / 2; }
__host__ __device__ __forceinline__ int perm32(int rho) { const int n = rho >> 4, i = rho & 15; return 8 * (i >> 2) + 4 * n + (i & 3); }

struct Unit { int pm, pn; };
struct Gemm { const bf16_t* A; const bf16_t* Bt; int M, N, K; };

struct StaticOrder {
    int nM, nN, nwg, G, c;
    __host__ __device__ void init(int M, int N, int G_, int c_) { nM = M / BM; nN = N / BM; nwg = nM * nN; G = G_; c = c_; }
    __host__ __device__ bool next(int i, Unit& u) const {
        const long L = (long)i * G + c; if (L >= nwg) return false;
        int wgid = (int)L; { const int q = nwg / NXCD, r = nwg % NXCD, xcd = wgid % NXCD, off = wgid / NXCD; wgid = (xcd < r ? xcd * (q + 1) : r * (q + 1) + (xcd - r) * q) + off; }
        const int nig = WGM * nN, gid = wgid / nig, fm = gid * WGM, gsz = (nM - fm) < WGM ? (nM - fm) : WGM;
        u.pm = fm + ((wgid % nig) % gsz); u.pn = (wgid % nig) / gsz; return true;
    }
    __device__ __forceinline__ void a_ready(const Unit&) const {}
    __device__ __forceinline__ void done(const Unit&) const {}
};

template <class Body> struct EpiRC {
    static constexpr bool PERM = false, AFTER_DRAIN = false;
    Body body;
    __device__ __forceinline__ void operator()(const f32x4 (&acc)[2][2][4][2], const Unit& u, int wr, int wc, int fr, int fq) const {
#pragma unroll
        for (int ai = 0; ai < 2; ++ai)
#pragma unroll
            for (int m = 0; m < 4; ++m) {
                const int row = u.pm * BM + ai * HALF + wr * 64 + m * 16 + fr;
#pragma unroll
                for (int bj = 0; bj < 2; ++bj)
#pragma unroll
                    for (int n = 0; n < 2; ++n) body(row, u.pn * BM + bj * HALF + wc * 32 + n * 16 + 4 * fq, acc[ai][bj][m][n]);
            }
    }
};
template <class Epi, class Sched, bool ALIGN_EPI = false, bool SP2 = false>
__device__ __forceinline__ void gemm_phase(PG8_LAS unsigned char* lds, const Gemm g, const Sched& S, const Epi& E) {
    const int tid = threadIdx.x, wid = __builtin_amdgcn_readfirstlane(tid >> 6), lane = tid & 63, wr = wid >> 2, wc = wid & 3, fr = lane & 15, fq = lane >> 4;
    const int K = g.K, nt = K / BK;
    unsigned voffA[2], voffB[2];
#pragma unroll
    for (int i = 0; i < 2; ++i) { int R, C; stage_rc(tid * 16 + i * 8192, R, C); const int Rb = Epi::PERM ? ((R & ~31) + perm32(R & 31)) : R;
        voffA[i] = (unsigned)(R * K + C) * 2u; voffB[i] = (unsigned)(Rb * K + C) * 2u; }
    const size_t kstep = (size_t)(BK * 2);
    const size_t hstep = (size_t)HALF * K * 2;
    const size_t tstep = 2 * hstep;
    const unsigned ldsw = (unsigned)wid * 1024u;
    const int aoff = lds_byte(wr * 64 + fr, fq * 8), boff = lds_byte(wc * 32 + fr, fq * 8);
#define PG8_SA(b, h) (((b) * 2 + (h)) * HTB)
#define PG8_SB(b, h) ((4 + (b) * 2 + (h)) * HTB)
#define PG8_STAGE(bufoff, gbase, voff) do { _Pragma("unroll") for (int _i = 0; _i < 2; ++_i) \
        __builtin_amdgcn_global_load_lds((const unsigned*)((const char*)(gbase) + (voff)[_i]), (PG8_LAS unsigned*)(lds + (bufoff) + ldsw + _i * 8192), 16, 0, 0); } while (0)
#define PG8_LDA(dst, b, h) do { _Pragma("unroll") for (int m = 0; m < 4; ++m) _Pragma("unroll") for (int k = 0; k < 2; ++k) dst[m][k] = *(const PG8_LAS bf16x8*)(lds + PG8_SA(b, h) + aoff + m * 2048 + k * 1024); } while (0)
#define PG8_LDB(dst, b, h) do { _Pragma("unroll") for (int n = 0; n < 2; ++n) _Pragma("unroll") for (int k = 0; k < 2; ++k) dst[n][k] = *(const PG8_LAS bf16x8*)(lds + PG8_SB(b, h) + boff + n * 2048 + k * 1024); } while (0)
#define PG8_MMA(ai, bj, At, Bt) do { __builtin_amdgcn_s_setprio(1); _Pragma("unroll") for (int m = 0; m < 4; ++m) _Pragma("unroll") for (int n = 0; n < 2; ++n) _Pragma("unroll") for (int k = 0; k < 2; ++k) \
        acc[ai][bj][m][n] = __builtin_amdgcn_mfma_f32_16x16x32_bf16(Bt[n][k], At[m][k], acc[ai][bj][m][n], 0, 0, 0); __builtin_amdgcn_s_setprio(0); } while (0)
#define PG8_WAIT_V(n) asm volatile("s_waitcnt vmcnt(" #n ")" ::: "memory")
#define PG8_WAIT_L(n) asm volatile("s_waitcnt lgkmcnt(" #n ")" ::: "memory")
#define PG8_BAR __builtin_amdgcn_s_barrier()
#define PG8_SCHED __builtin_amdgcn_sched_barrier(0)
    Unit cur, nxt; int ui = 0;
    if (!S.next(0, cur)) return;
    f32x4 acc[2][2][4][2];
#pragma unroll
    for (int a = 0; a < 2; ++a)
#pragma unroll
        for (int b = 0; b < 2; ++b)
#pragma unroll
            for (int m = 0; m < 4; ++m)
#pragma unroll
                for (int n = 0; n < 2; ++n) acc[a][b][m][n] = (f32x4){0.f, 0.f, 0.f, 0.f};
    bf16x8 At[4][2], B0[2][2], B1[2][2];
    const char* cA = (const char*)g.A + (size_t)cur.pm * tstep; const char* cB = (const char*)g.Bt + (size_t)cur.pn * tstep;
    S.a_ready(cur);
    if constexpr (SP2) {
        PG8_STAGE(PG8_SB(0, 0), cB, voffB); PG8_STAGE(PG8_SB(0, 1), cB + hstep, voffB); PG8_STAGE(PG8_SA(0, 0), cA, voffA); PG8_STAGE(PG8_SA(0, 1), cA + hstep, voffA);
        if (wr == 1) PG8_BAR;
        PG8_WAIT_V(2); PG8_BAR;
        PG8_STAGE(PG8_SB(1, 0), cB + kstep, voffB); PG8_STAGE(PG8_SA(1, 0), cA + kstep, voffA); PG8_STAGE(PG8_SB(1, 1), cB + hstep + kstep, voffB);
        PG8_WAIT_V(6); PG8_BAR;
    } else {
        PG8_STAGE(PG8_SB(0, 0), cB, voffB); PG8_STAGE(PG8_SA(0, 0), cA, voffA); PG8_STAGE(PG8_SB(0, 1), cB + hstep, voffB); PG8_STAGE(PG8_SA(0, 1), cA + hstep, voffA);
        if (wr == 1) PG8_BAR;
        PG8_WAIT_V(4); PG8_BAR;
        PG8_STAGE(PG8_SB(1, 0), cB + kstep, voffB); PG8_STAGE(PG8_SA(1, 0), cA + kstep, voffA); PG8_STAGE(PG8_SB(1, 1), cB + hstep + kstep, voffB);
        PG8_WAIT_V(6); PG8_BAR;
    }
    for (;;) {
        const bool has_next = S.next(ui + 1, nxt);
        const char* nA = has_next ? (const char*)g.A + (size_t)nxt.pm * tstep : cA; const char* nB = has_next ? (const char*)g.Bt + (size_t)nxt.pn * tstep : cB;
        for (int t = 0; t < nt; t += 2) {
            const bool last = (t == nt - 2);
            const char* a1 = cA + (size_t)(t + 1) * kstep;
            const char* a2 = last ? nA : cA + (size_t)(t + 2) * kstep; const char* b2 = last ? nB : cB + (size_t)(t + 2) * kstep;
            const char* a3 = a2 + kstep; const char* b3 = b2 + kstep;
            if (last && has_next) S.a_ready(nxt);
            if constexpr (SP2) {
            PG8_LDB(B0, 0, 0); PG8_LDB(B1, 0, 1); PG8_SCHED; PG8_LDA(At, 0, 0); PG8_STAGE(PG8_SA(1, 1), a1 + hstep, voffA);
            PG8_WAIT_V(8); PG8_WAIT_L(0); PG8_BAR; PG8_MMA(0, 0, At, B0); PG8_MMA(0, 1, At, B1); PG8_BAR; PG8_SCHED;
            PG8_LDA(At, 0, 1); PG8_STAGE(PG8_SB(0, 0), b2, voffB); PG8_STAGE(PG8_SB(0, 1), b2 + hstep, voffB); PG8_STAGE(PG8_SA(0, 0), a2, voffA);
            PG8_WAIT_V(8); PG8_WAIT_L(0); PG8_BAR; PG8_MMA(1, 0, At, B0); PG8_MMA(1, 1, At, B1); PG8_BAR; PG8_SCHED;
            PG8_LDB(B0, 1, 0); PG8_LDB(B1, 1, 1); PG8_SCHED; PG8_LDA(At, 1, 0); PG8_STAGE(PG8_SA(0, 1), a2 + hstep, voffA);
            PG8_WAIT_V(8); PG8_WAIT_L(0); PG8_BAR; PG8_MMA(0, 0, At, B0); PG8_MMA(0, 1, At, B1); PG8_BAR; PG8_SCHED;
            PG8_LDA(At, 1, 1); PG8_STAGE(PG8_SB(1, 0), b3, voffB); PG8_STAGE(PG8_SB(1, 1), b3 + hstep, voffB); PG8_STAGE(PG8_SA(1, 0), a3, voffA);
            PG8_WAIT_V(8); PG8_WAIT_L(0); PG8_BAR; PG8_MMA(1, 0, At, B0); PG8_MMA(1, 1, At, B1); PG8_BAR; PG8_SCHED;
            } else {
            PG8_LDB(B0, 0, 0); PG8_SCHED; PG8_LDA(At, 0, 0); PG8_STAGE(PG8_SA(1, 1), a1 + hstep, voffA);
            PG8_WAIT_L(8); PG8_BAR; PG8_WAIT_L(0); PG8_MMA(0, 0, At, B0); PG8_BAR; PG8_SCHED;
            PG8_LDB(B1, 0, 1); PG8_STAGE(PG8_SB(0, 0), b2, voffB);
            PG8_BAR; PG8_WAIT_L(0); PG8_MMA(0, 1, At, B1); PG8_BAR;
            PG8_LDA(At, 0, 1); PG8_STAGE(PG8_SA(0, 0), a2, voffA);
            PG8_BAR; PG8_WAIT_L(0); PG8_MMA(1, 0, At, B0); PG8_BAR; PG8_SCHED;
            PG8_STAGE(PG8_SB(0, 1), b2 + hstep, voffB);
            PG8_WAIT_V(6); PG8_BAR; PG8_MMA(1, 1, At, B1); PG8_BAR;
            PG8_LDB(B0, 1, 0); PG8_SCHED; PG8_LDA(At, 1, 0); PG8_STAGE(PG8_SA(0, 1), a2 + hstep, voffA);
            PG8_WAIT_L(8); PG8_BAR; PG8_WAIT_L(0); PG8_MMA(0, 0, At, B0); PG8_BAR; PG8_SCHED;
            PG8_LDB(B1, 1, 1); PG8_STAGE(PG8_SB(1, 0), b3, voffB);
            PG8_BAR; PG8_WAIT_L(0); PG8_MMA(0, 1, At, B1); PG8_BAR;
            PG8_LDA(At, 1, 1); PG8_STAGE(PG8_SA(1, 0), a3, voffA);
            PG8_BAR; PG8_WAIT_L(0); PG8_MMA(1, 0, At, B0); PG8_BAR; PG8_SCHED;
            PG8_STAGE(PG8_SB(1, 1), b3 + hstep, voffB);
            PG8_WAIT_V(6); PG8_BAR; PG8_MMA(1, 1, At, B1); PG8_BAR;
            }
        }
        if constexpr (ALIGN_EPI) { if (wr == 0) PG8_BAR; }
        if constexpr (!Epi::AFTER_DRAIN) { E(acc, cur, wr, wc, fr, fq); S.done(cur); }
        if (!has_next) break;
#pragma unroll
        for (int a = 0; a < 2; ++a)
#pragma unroll
            for (int b = 0; b < 2; ++b)
#pragma unroll
                for (int m = 0; m < 4; ++m)
#pragma unroll
                    for (int n = 0; n < 2; ++n) acc[a][b][m][n] = (f32x4){0.f, 0.f, 0.f, 0.f};
        cur = nxt; cA = nA; cB = nB; ++ui;
        if constexpr (ALIGN_EPI) { if (wr == 1) PG8_BAR; }
    }
    PG8_WAIT_V(0);
    if constexpr (!ALIGN_EPI) { if (wr == 0) PG8_BAR; }
    PG8_BAR;
    if constexpr (Epi::AFTER_DRAIN) { E.fused(acc, cur, wr, wc, fr, fq, lds, wid, lane); S.done(cur); }
#undef PG8_SA
#undef PG8_SB
#undef PG8_STAGE
#undef PG8_LDA
#undef PG8_LDB
#undef PG8_MMA
#undef PG8_WAIT_V
#undef PG8_WAIT_L
#undef PG8_BAR
#undef PG8_SCHED
}
}

constexpr int NMIXW = 4864;
struct P2Body {
    const Frame* Fp;
    __device__ __forceinline__ void operator()(int m, int n, const f32x4 v) const {
        const Frame& F = *Fp;
        if (n >= NMIXP) return;
        *(u32x2*)(F.PROJ + (size_t)m * NMIXP + n) = pk4(v);
        if (n >= C_K && n < C_QI) {
            float* o = (n < C_V) ? (m < NTP ? F.out + O_KP + (size_t)m * 128 + (n - C_K) : F.out + O_KS + (size_t)(m - NTP) * 128 + (n - C_K))
                                 : (m < NTP ? F.out + O_VP + (size_t)m * 128 + (n - C_V) : F.out + O_VS + (size_t)(m - NTP) * 128 + (n - C_V));
            *(f32x4*)o = v;
            if (n >= C_V && m < NTP) {
                bf16_t* vt = (bf16_t*)(F.ws + WS_VT) + ((size_t)((m >> 11) * 2 + ((n - C_V) >> 6)) * 64 + ((n - C_V) & 63)) * SEQ + (m & 2047);
                vt[0] = f2bf(v[0]); vt[SEQ] = f2bf(v[1]); vt[2 * SEQ] = f2bf(v[2]); vt[3 * SEQ] = f2bf(v[3]);
            }
        } else if (n >= C_KI && n < C_BG) {
            float* o = m < NTP ? F.out + O_KIP + (size_t)m * 64 + (n - C_KI) : F.out + O_KIS + (size_t)(m - NTP) * 64 + (n - C_KI);
            *(f32x4*)o = v;
        } else if (n == C_WI) {
            *(f32x4*)(F.WI + (size_t)m * 4) = v;
        } else if (n >= C_CG && n < C_GA) {
            const int tt = (m < NTP) ? (m & 2047) - (SEQ - 2) : ((m - NTP) & 7) - (TS - 2);
            if (tt >= 0) {
                const int rowi = (m < NTP) ? (m >> 11) * 2 + tt : 2 * NB_P + ((m - NTP) >> 3) * 2 + tt;
                *(f32x4*)((float*)(F.ws + WS_CGX) + (size_t)rowi * 1024 + (n - C_CG)) = v;
            }
        }
    }
};
__device__ __forceinline__ void p2_gemm_in(const Frame& F) {
    pg8::Gemm g{F.H1, F.WIN, NT, NMIXW, D};
    pg8::StaticOrder S; S.init(NT, NMIXW, F.G, F.bid);
    pg8::EpiRC<P2Body> E{P2Body{&F}};
    pg8::gemm_phase<pg8::EpiRC<P2Body>, pg8::StaticOrder, true, true>(F.lds, g, S, E);
}

constexpr int SROW = 2052;
__device__ __forceinline__ int wave_sum_i(int v) {
#pragma unroll
    for (int o = 32; o >= 1; o >>= 1) v += __shfl_xor(v, o);
    return v;
}
__device__ __forceinline__ void cnt_ge(int& c, unsigned u, unsigned t) { asm("v_cmp_ge_u32_e32 vcc, %1, %2\n\tv_addc_co_u32_e32 %0, vcc, 0, %0, vcc" : "+v"(c) : "v"(u), "v"(t) : "vcc"); }
__device__ __forceinline__ void cnt_gt(int& c, unsigned u, unsigned t) { asm("v_cmp_gt_u32_e32 vcc, %1, %2\n\tv_addc_co_u32_e32 %0, vcc, 0, %0, vcc" : "+v"(c) : "v"(u), "v"(t) : "vcc"); }
__device__ __forceinline__ void cnt_eq(int& c, unsigned u, unsigned t) { asm("v_cmp_eq_u32_e32 vcc, %1, %2\n\tv_addc_co_u32_e32 %0, vcc, 0, %0, vcc" : "+v"(c) : "v"(u), "v"(t) : "vcc"); }
__device__ __forceinline__ void cnt_lt4(int& cl, unsigned u0, unsigned u1, unsigned u2, unsigned u3, unsigned t) {
    int d0, d1, d2, d3;
    asm("v_sub_u32 %1, %5, %9\n\tv_sub_u32 %2, %6, %9\n\tv_sub_u32 %3, %7, %9\n\tv_sub_u32 %4, %8, %9\n\t"
        "v_lshrrev_b32 %1, 31, %1\n\tv_lshrrev_b32 %2, 31, %2\n\tv_lshrrev_b32 %3, 31, %3\n\tv_lshrrev_b32 %4, 31, %4\n\t"
        "v_add3_u32 %0, %0, %1, %2\n\tv_add3_u32 %0, %0, %3, %4"
        : "+v"(cl), "=&v"(d0), "=&v"(d1), "=&v"(d2), "=&v"(d3) : "v"(u0), "v"(u1), "v"(u2), "v"(u3), "v"(t));
}
__device__ __forceinline__ void cnt_eq_pos(int& c, unsigned u, unsigned t, int L) {
    int tmp;
    asm("v_cmp_eq_u32_e32 vcc, %2, %3\n\tv_cndmask_b32_e32 %1, %5, %4, vcc\n\tv_cmp_lt_i32_e32 vcc, 0, %1\n\tv_addc_co_u32_e32 %0, vcc, 0, %0, vcc"
        : "+v"(c), "=&v"(tmp) : "v"(u), "v"(t), "v"(L), "v"(0x80000000) : "vcc");
}
__device__ __forceinline__ int wave_sum_i_dpp(int v) {
    v += __builtin_amdgcn_update_dpp(0, v, 0xB1, 0xF, 0xF, false);
    v += __builtin_amdgcn_update_dpp(0, v, 0x4E, 0xF, 0xF, false);
    v += __builtin_amdgcn_update_dpp(0, v, 0x141, 0xF, 0xF, false);
    v += __builtin_amdgcn_update_dpp(0, v, 0x140, 0xF, 0xF, false);
    v += __builtin_amdgcn_update_dpp(0, v, 0x142, 0xA, 0xF, false);
    v += __builtin_amdgcn_update_dpp(0, v, 0x143, 0xC, 0xF, false);
    return __builtin_amdgcn_readlane(v, 63);
}
template <int NV> __device__ __forceinline__ void select_threshold(const unsigned (&u)[NV], int ksel, int idx_bits, int lane, unsigned& T_out, int& Jx_out, int& ngt_out) {
    unsigned T = 0;
#pragma unroll 1
    for (int bit = 31; bit >= 0; --bit) {
        const unsigned cand = T | (1u << bit);
        int c = 0;
#pragma unroll
        for (int i = 0; i < NV; ++i) cnt_ge(c, u[i], cand);
        c = wave_sum_i_dpp(c);
        if (c >= ksel) T = cand;
    }
    int cg = 0, ce = 0;
#pragma unroll
    for (int i = 0; i < NV; ++i) { cnt_gt(cg, u[i], T); cnt_eq(ce, u[i], T); }
    const int ngt = wave_sum_i_dpp(cg), neq = wave_sum_i_dpp(ce);
    const int need = ksel - ngt;
    int Jx = 0x3FFFFFFF;
    if (need < neq) {
        int Jb = 0;
#pragma unroll 1
        for (int bit = idx_bits - 1; bit >= 0; --bit) {
            const int cand = Jb | (1 << bit);
            const int L = cand - lane;
            int c = 0;
#pragma unroll
            for (int i = 0; i < NV; ++i) cnt_eq_pos(c, u[i], T, L - 64 * i);
            c = wave_sum_i_dpp(c);
            if (c < need) Jb = cand;
        }
        Jx = Jb + 1;
    }
    T_out = T; Jx_out = Jx; ngt_out = ngt;
}
template <int NV> __device__ __forceinline__ void select_threshold2(const unsigned (&ua)[NV], const unsigned (&ub)[NV], int ksel, int idx_bits, int lane, int ng,
                                                                   unsigned& Ta_out, int& Jxa_out, unsigned& Tb_out, int& Jxb_out) {
    unsigned Ta = 0, Tb = 0;
    bool da = false, db = false;
#pragma unroll 1
    for (int bit = 30; bit >= 0 && !(da && db); --bit) {
        const unsigned ca = da ? Ta : (Ta | (1u << bit)), cb = db ? Tb : (Tb | (1u << bit));
        int la = 0, lb = 0;
#pragma unroll
        for (int i = 0; i < NV; i += 4) { if (i < 4 * ng) { cnt_lt4(la, ua[i], ua[i + 1], ua[i + 2], ua[i + 3], ca); cnt_lt4(lb, ub[i], ub[i + 1], ub[i + 2], ub[i + 3], cb); } }
        const int na = ng * 256 - wave_sum_i_dpp(la), nb = ng * 256 - wave_sum_i_dpp(lb);
        if (!da && na >= ksel) { Ta = ca; da = (na == ksel); }
        if (!db && nb >= ksel) { Tb = cb; db = (nb == ksel); }
    }
    int ga = 0, ea = 0, gb = 0, eb = 0;
#pragma unroll
    for (int i = 0; i < NV; ++i) { cnt_gt(ga, ua[i], Ta); cnt_eq(ea, ua[i], Ta); cnt_gt(gb, ub[i], Tb); cnt_eq(eb, ub[i], Tb); }
    const int needa = ksel - wave_sum_i_dpp(ga), neqa = wave_sum_i_dpp(ea), needb = ksel - wave_sum_i_dpp(gb), neqb = wave_sum_i_dpp(eb);
    int Jxa = 0x3FFFFFFF, Jxb = 0x3FFFFFFF;
    if (needa < neqa) {
        int Jb = 0;
#pragma unroll 1
        for (int bit = idx_bits - 1; bit >= 0; --bit) {
            const int cand = Jb | (1 << bit); const int L = cand - lane; int c = 0;
#pragma unroll
            for (int i = 0; i < NV; ++i) cnt_eq_pos(c, ua[i], Ta, L - 64 * i);
            if (wave_sum_i_dpp(c) < needa) Jb = cand;
        }
        Jxa = Jb + 1;
    }
    if (needb < neqb) {
        int Jb = 0;
#pragma unroll 1
        for (int bit = idx_bits - 1; bit >= 0; --bit) {
            const int cand = Jb | (1 << bit); const int L = cand - lane; int c = 0;
#pragma unroll
            for (int i = 0; i < NV; ++i) cnt_eq_pos(c, ub[i], Tb, L - 64 * i);
            if (wave_sum_i_dpp(c) < needb) Jb = cand;
        }
        Jxb = Jb + 1;
    }
    Ta_out = Ta; Jxa_out = Jxa; Tb_out = Tb; Jxb_out = Jxb;
}
template <int NV> __device__ __forceinline__ void select_topk(const unsigned (&u)[NV], int ksel, int idx_bits, int* sel, int lane) {
    unsigned T; int Jx, ngt;
    select_threshold<NV>(u, ksel, idx_bits, lane, T, Jx, ngt);
    const int L = Jx - lane;
    int cg = 0, ct = 0;
#pragma unroll
    for (int i = 0; i < NV; ++i) { cnt_gt(cg, u[i], T); cnt_eq_pos(ct, u[i], T, L - 64 * i); }
    int ig = cg, it = ct;
#pragma unroll
    for (int o = 1; o < 64; o <<= 1) { const int a = __shfl_up(ig, o), b2 = __shfl_up(it, o); if (lane >= o) { ig += a; it += b2; } }
    int pg = ig - cg, pt = ngt + it - ct;
    int ev = lane, Lr = L;
#pragma unroll
    for (int i = 0; i < NV; ++i) {
        if (u[i] > T) { sel[pg] = ev; ++pg; }
        else if (u[i] == T && Lr > 0) { sel[pt] = ev; ++pt; }
        asm volatile("v_add_u32 %0, 64, %0\n\tv_add_u32 %1, -64, %1" : "+v"(ev), "+v"(Lr));
    }
}

constexpr int PU_MB = 16 * SROW * 4;
constexpr int PU_RB = PU_MB + 16 * 64 * 4;
constexpr int PU_BT = PU_RB + 1024;
constexpr int PU_QT = PU_BT + 512, PU_QROW = 1040;
__device__ __forceinline__ int kappa32(int r) { return (r & 0x13) | ((r & 4) << 1) | ((r & 8) >> 1); }
__device__ __forceinline__ void p3_prompt_fused_unit(const Frame& F, const bf16_t* VT, int b, int qt) {
    LAS float* S = (LAS float*)F.lds;
    LAS unsigned* MB = (LAS unsigned*)(F.lds + PU_MB);
    LAS float* RB = (LAS float*)(F.lds + PU_RB);
    LAS int* BT = (LAS int*)(F.lds + PU_BT);
    const int lane = F.lane;
    const int q0 = qt * 16; const size_t tok0 = (size_t)b * SEQ;
    __syncthreads();
    for (int ch = F.tid; ch < 16 * 64; ch += NTHREADS) {
        const u32x4 qv = *(const u32x4*)(F.PROJ + (tok0 + q0 + (ch >> 6)) * NMIXP + C_Q + (ch & 63) * 8);
        constexpr float QS = ATTN_SCALE * 1.4426950408889634f;
        *(LAS u32x4*)(F.lds + PU_QT + (ch >> 6) * PU_QROW + (ch & 63) * 16) = (u32x4){cvt_pk_bf16(bflo(qv[0]) * QS, bfhi(qv[0]) * QS), cvt_pk_bf16(bflo(qv[1]) * QS, bfhi(qv[1]) * QS),
                                                                                    cvt_pk_bf16(bflo(qv[2]) * QS, bfhi(qv[2]) * QS), cvt_pk_bf16(bflo(qv[3]) * QS, bfhi(qv[3]) * QS)};
    }
    {
        const int r = lane & 15, q4 = lane >> 4;
        bf16x8 A[4][2];
#pragma unroll
        for (int hh = 0; hh < 4; ++hh)
#pragma unroll
            for (int s2 = 0; s2 < 2; ++s2) A[hh][s2] = *(const bf16x8*)(F.PROJ + (tok0 + q0 + r) * NMIXP + C_QI + hh * 64 + s2 * 32 + q4 * 8);
        float wv[4][4];
#pragma unroll
        for (int g = 0; g < 4; ++g) { const f32x4 w4 = *(const f32x4*)(F.WI + (tok0 + q0 + 4 * q4 + g) * 4);
#pragma unroll
            for (int hh = 0; hh < 4; ++hh) wv[g][hh] = w4[hh] * IDX_SCALE; }
        const int nkt = qt + 1;
        bf16x8 Bn[2][2];
        {
            const int t0 = 2 * F.wave;
#pragma unroll
            for (int p = 0; p < 2; ++p)
#pragma unroll
                for (int s2 = 0; s2 < 2; ++s2) { const int key = (t0 + p < nkt ? t0 + p : 0) * 16 + r; Bn[p][s2] = *(const bf16x8*)(F.PROJ + (tok0 + key) * NMIXP + C_KI + s2 * 32 + q4 * 8); }
        }
#pragma unroll 1
        for (int t0 = 2 * F.wave; t0 < nkt; t0 += 16) {
            bf16x8 B[2][2] = {{Bn[0][0], Bn[0][1]}, {Bn[1][0], Bn[1][1]}};
            {
                const int tn = t0 + 16;
#pragma unroll
                for (int p = 0; p < 2; ++p)
#pragma unroll
                    for (int s2 = 0; s2 < 2; ++s2) { const int key = (tn + p < nkt ? tn + p : 0) * 16 + r; Bn[p][s2] = *(const bf16x8*)(F.PROJ + (tok0 + key) * NMIXP + C_KI + s2 * 32 + q4 * 8); }
            }
#pragma unroll
            for (int p = 0; p < 2; ++p) {
                if (t0 + p >= nkt) continue;
                float sc[4] = {0.f, 0.f, 0.f, 0.f};
#pragma unroll
                for (int hh = 0; hh < 4; ++hh) {
                    f32x4 c = {0.f, 0.f, 0.f, 0.f};
                    c = __builtin_amdgcn_mfma_f32_16x16x32_bf16(A[hh][0], B[p][0], c, 0, 0, 0);
                    c = __builtin_amdgcn_mfma_f32_16x16x32_bf16(A[hh][1], B[p][1], c, 0, 0, 0);
#pragma unroll
                    for (int g = 0; g < 4; ++g) sc[g] += fmaxf(c[g], 0.f) * wv[g][hh];
                }
#pragma unroll
                for (int g = 0; g < 4; ++g) S[(4 * q4 + g) * SROW + (t0 + p) * 16 + r] = sc[g];
            }
        }
    }
    __syncthreads();
    {
        const int rowa = F.wave * 2, rowb = rowa + 1;
        const int nva = q0 + rowa + 1, nvb = nva + 1;
        if (nvb <= NSEL) {
#pragma unroll
            for (int i = 0; i < 32; ++i) {
                const unsigned long long ma = __ballot(lane + 64 * i < nva), mb = __ballot(lane + 64 * i < nvb);
                if (lane == 0) { MB[rowa * 64 + 2 * i] = (unsigned)ma; MB[rowa * 64 + 2 * i + 1] = (unsigned)(ma >> 32); MB[rowb * 64 + 2 * i] = (unsigned)mb; MB[rowb * 64 + 2 * i + 1] = (unsigned)(mb >> 32); }
            }
        } else {
            unsigned ua[32], ub[32];
#pragma unroll
            for (int i = 0; i < 32; ++i) { const int j = lane + 64 * i; ua[i] = (j < nva) ? (f2ord(S[rowa * SROW + j]) >> 1) : 0u; ub[i] = (j < nvb) ? (f2ord(S[rowb * SROW + j]) >> 1) : 0u; }
            unsigned Ta, Tb; int Jxa, Jxb;
            select_threshold2<32>(ua, ub, NSEL, 11, lane, (nvb + 255) >> 8, Ta, Jxa, Tb, Jxb);
            const int La = Jxa - lane, Lb = Jxb - lane;
#pragma unroll
            for (int i = 0; i < 32; ++i) {
                const bool ta = (ua[i] > Ta) || (ua[i] == Ta && (La - 64 * i) > 0), tb = (ub[i] > Tb) || (ub[i] == Tb && (Lb - 64 * i) > 0);
                const unsigned long long ma = __ballot(ta), mb = __ballot(tb);
                if (lane == 0) { MB[rowa * 64 + 2 * i] = (unsigned)ma; MB[rowa * 64 + 2 * i + 1] = (unsigned)(ma >> 32); MB[rowb * 64 + 2 * i] = (unsigned)mb; MB[rowb * 64 + 2 * i + 1] = (unsigned)(mb >> 32); }
            }
        }
    }
    __syncthreads();
    {
        const int g = F.wave & 1, kq = F.wave >> 1;
        const int c = lane & 31, h = lane >> 5;
        const int hd = g * 4 + (c & 3);
        LAS const unsigned char* Qb = F.lds + PU_QT + (c >> 2) * PU_QROW + (hd * 64 + h * 8) * 2;
        constexpr float L2E = 1.4426950408889634f;
        const float b31 = RB[31 * 8 + hd] * L2E;
        const int ntile = ((q0 + 15) >> 5) + 1;
        const bf16_t* Kb = F.PROJ + (tok0 + kappa32(c)) * NMIXP + C_K + g * 64 + h * 8;
        const bf16_t* Vb = VT + ((size_t)((b * 2 + g) * 64 + c)) * SEQ + h * 8;
        f32x16 O[2][2];
#pragma unroll
        for (int rt = 0; rt < 2; ++rt)
#pragma unroll
            for (int d = 0; d < 2; ++d)
#pragma unroll
                for (int e = 0; e < 16; ++e) O[rt][d][e] = 0.f;
        float lsum[2] = {0.f, 0.f};
        bf16x8 Kn[4];
        {
            const int key0 = (kq < ntile ? kq : 0) * 32;
#pragma unroll
            for (int s4 = 0; s4 < 4; ++s4) Kn[s4] = *(const bf16x8*)(Kb + (size_t)key0 * NMIXP + s4 * 16);
        }
#pragma unroll 1
        for (int kt = kq; kt < ntile; kt += 4) {
            const int key0 = kt * 32;
            bf16x8 Kf[4] = {Kn[0], Kn[1], Kn[2], Kn[3]}, Vf[2][2];
#pragma unroll
            for (int d = 0; d < 2; ++d)
#pragma unroll
                for (int s2 = 0; s2 < 2; ++s2) Vf[d][s2] = *(const bf16x8*)(Vb + (size_t)(32 * d) * SEQ + key0 + 16 * s2);
            {
                const int keyn = (kt + 4 < ntile ? kt + 4 : 0) * 32;
#pragma unroll
                for (int s4 = 0; s4 < 4; ++s4) Kn[s4] = *(const bf16x8*)(Kb + (size_t)keyn * NMIXP + s4 * 16);
            }
#pragma unroll
            for (int rt = 0; rt < 2; ++rt) {
                const int ql = rt * 8 + (c >> 2), q = q0 + ql;
                f32x16 X;
#pragma unroll
                for (int e = 0; e < 16; ++e) X[e] = 0.f;
#pragma unroll
                for (int s4 = 0; s4 < 4; ++s4) X = __builtin_amdgcn_mfma_f32_32x32x16_bf16(Kf[s4], *(LAS const bf16x8*)(Qb + rt * 8 * PU_QROW + s4 * 32), X, 0, 0, 0);
                const unsigned word = MB[ql * 64 + kt];
                const unsigned bits = ((word >> (8 * h)) & 0xFFu) | (((word >> (16 + 8 * h)) & 0xFFu) << 8);
                const bool nearT = (q0 + rt * 8) - (key0 + 31) < 113;
#pragma unroll
                for (int s2 = 0; s2 < 2; ++s2) {
                    float P[8];
                    if (nearT) {
#pragma unroll
                        for (int e8 = 0; e8 < 8; ++e8) {
                            const int e = 8 * s2 + e8;
                            const int key = key0 + e8 + 16 * s2 + 8 * h;
                            int dist = q - key; dist = dist < 0 ? 0 : (dist > 127 ? 127 : dist);
                            const float bias = RB[BT[dist] * 8 + hd] * L2E;
                            const float lg = fminf(X[e] + bias, 86.f);
                            P[e8] = __int_as_float(__float_as_int(__builtin_amdgcn_exp2f(lg)) & __builtin_amdgcn_sbfe((int)bits, e, 1));
                        }
                    } else {
#pragma unroll
                        for (int e8 = 0; e8 < 8; ++e8) {
                            const int e = 8 * s2 + e8;
                            const float lg = fminf(X[e] + b31, 86.f);
                            P[e8] = __int_as_float(__float_as_int(__builtin_amdgcn_exp2f(lg)) & __builtin_amdgcn_sbfe((int)bits, e, 1));
                        }
                    }
#pragma unroll
                    for (int e8 = 0; e8 < 8; ++e8) lsum[rt] += P[e8];
                    const u32x4 pk = (u32x4){cvt_pk_bf16(P[0], P[1]), cvt_pk_bf16(P[2], P[3]), cvt_pk_bf16(P[4], P[5]), cvt_pk_bf16(P[6], P[7])};
                    bf16x8 Pf; __builtin_memcpy(&Pf, &pk, 16);
                    O[rt][0] = __builtin_amdgcn_mfma_f32_32x32x16_bf16(Vf[0][s2], Pf, O[rt][0], 0, 0, 0);
                    O[rt][1] = __builtin_amdgcn_mfma_f32_32x32x16_bf16(Vf[1][s2], Pf, O[rt][1], 0, 0, 0);
                }
                __builtin_amdgcn_sched_barrier(0);
            }
        }
        LAS float* CB = (LAS float*)F.lds + (g * 3 + (kq > 0 ? kq - 1 : 0)) * (66 * 64);
        __syncthreads();
        if (kq > 0) {
#pragma unroll
            for (int rt = 0; rt < 2; ++rt) {
#pragma unroll
                for (int d = 0; d < 2; ++d)
#pragma unroll
                    for (int e = 0; e < 16; ++e) CB[((rt * 2 + d) * 16 + e) * 64 + lane] = O[rt][d][e];
                CB[(64 + rt) * 64 + lane] = lsum[rt];
            }
        }
        __syncthreads();
        if (kq == 0) {
#pragma unroll 1
            for (int p = 0; p < 3; ++p) {
                LAS const float* CP = (LAS const float*)F.lds + (g * 3 + p) * (66 * 64);
#pragma unroll
                for (int rt = 0; rt < 2; ++rt) {
#pragma unroll
                    for (int d = 0; d < 2; ++d)
#pragma unroll
                        for (int e = 0; e < 16; ++e) O[rt][d][e] += CP[((rt * 2 + d) * 16 + e) * 64 + lane];
                    lsum[rt] += CP[(64 + rt) * 64 + lane];
                }
            }
#pragma unroll
            for (int rt = 0; rt < 2; ++rt) {
                float l = lsum[rt]; l += __shfl_xor(l, 32);
                const float inv = 1.f / l;
                bf16_t* orow = F.OATT + (tok0 + q0 + rt * 8 + (c >> 2)) * 512 + hd * 64;
#pragma unroll
                for (int a4 = 0; a4 < 4; ++a4) {
                    const f32x4 v0 = (f32x4){O[rt][0][4 * a4], O[rt][0][4 * a4 + 1], O[rt][0][4 * a4 + 2], O[rt][0][4 * a4 + 3]} * inv;
                    const f32x4 v1 = (f32x4){O[rt][1][4 * a4], O[rt][1][4 * a4 + 1], O[rt][1][4 * a4 + 2], O[rt][1][4 * a4 + 3]} * inv;
                    *(u32x2*)(orow + 8 * a4 + 4 * h) = pk4(v0);
                    *(u32x2*)(orow + 32 + 8 * a4 + 4 * h) = pk4(v1);
                }
            }
        }
    }
}

__device__ __forceinline__ void p3_sample_score_unit(const Frame& F, float* SS, int b, int ch) {
    const int lane = F.lane, r = lane & 31, h = lane >> 5;
    bf16x8 A[4];
    { const int q = r >> 2, hh = r & 3;
#pragma unroll
      for (int s4 = 0; s4 < 4; ++s4) A[s4] = *(const bf16x8*)(F.PROJ + (size_t)(NTP + b * TS + q) * NMIXP + C_QI + hh * 64 + s4 * 16 + h * 8); }
    float wv[4][4];
#pragma unroll
    for (int g = 0; g < 4; ++g) { const f32x4 w4 = *(const f32x4*)(F.WI + (size_t)(NTP + b * TS + 2 * g + h) * 4);
#pragma unroll
        for (int hh = 0; hh < 4; ++hh) wv[g][hh] = w4[hh] * IDX_SCALE; }
    f32x4 kn[8];
    { const int key0 = ch * 1024 + F.wave * 32; const int page = F.page_table[b * NPAGES + (key0 >> 7)];
      const float* kr = F.cache_ki + ((size_t)page * PAGE + (key0 & 127) + r) * 64 + h * 8;
#pragma unroll
      for (int s4 = 0; s4 < 4; ++s4) { kn[2 * s4] = *(const f32x4*)(kr + s4 * 16); kn[2 * s4 + 1] = *(const f32x4*)(kr + s4 * 16 + 4); } }
#pragma unroll 1
    for (int tl = F.wave; tl < 32; tl += 8) {
        const int key0 = ch * 1024 + tl * 32;
        f32x4 kc[8];
#pragma unroll
        for (int i = 0; i < 8; ++i) kc[i] = kn[i];
        if (tl + 8 < 32) {
            const int keyn = key0 + 256; const int page = F.page_table[b * NPAGES + (keyn >> 7)];
            const float* kr = F.cache_ki + ((size_t)page * PAGE + (keyn & 127) + r) * 64 + h * 8;
#pragma unroll
            for (int s4 = 0; s4 < 4; ++s4) { kn[2 * s4] = *(const f32x4*)(kr + s4 * 16); kn[2 * s4 + 1] = *(const f32x4*)(kr + s4 * 16 + 4); }
        }
        f32x16 c;
#pragma unroll
        for (int e = 0; e < 16; ++e) c[e] = 0.f;
#pragma unroll
        for (int s4 = 0; s4 < 4; ++s4) {
            const f32x4 lo = kc[2 * s4], hi = kc[2 * s4 + 1];
            const u32x4 pk = (u32x4){cvt_pk_bf16(lo[0], lo[1]), cvt_pk_bf16(lo[2], lo[3]), cvt_pk_bf16(hi[0], hi[1]), cvt_pk_bf16(hi[2], hi[3])};
            bf16x8 Bf; __builtin_memcpy(&Bf, &pk, 16);
            c = __builtin_amdgcn_mfma_f32_32x32x16_bf16(A[s4], Bf, c, 0, 0, 0);
        }
#pragma unroll
        for (int g = 0; g < 4; ++g) {
            float sc = 0.f;
#pragma unroll
            for (int hh = 0; hh < 4; ++hh) sc += fmaxf(c[4 * g + hh], 0.f) * wv[g][hh];
            SS[(size_t)(b * TS + 2 * g + h) * PAST + key0 + r] = sc;
        }
    }
}
__device__ __forceinline__ void p3_index(const Frame& F) {
    constexpr int NSU = NB_S * 8;
    const int nunits = NSU + NB_P * (SEQ / 16);
    float* SS = (float*)(F.ws + WS_SS);
    const bf16_t* VT = (const bf16_t*)(F.ws + WS_VT);
    __syncthreads();
    if (F.tid < 256) ((LAS float*)(F.lds + PU_RB))[F.tid] = F.rel_bias[F.tid];
    if (F.tid < 128) ((LAS int*)(F.lds + PU_BT))[F.tid] = t5_bucket(F.tid);
    __syncthreads();
    for (int it = F.bid; it < nunits; it += F.G) {
        if (it < NSU) { p3_sample_score_unit(F, SS, it >> 3, it & 7); continue; }
        const int i = it - NSU; const int b = i & 7, sl = (i >> 3) & 31, rnd = i >> 8;
        const int qt = rnd == 0 ? 127 - sl : (rnd == 1 ? 64 + sl : (rnd == 2 ? 63 - sl : sl));
        p3_prompt_fused_unit(F, VT, b, qt);
    }
}

constexpr int SQ_CNT = 0;
constexpr int SQ_SEL = 1024;
constexpr int SQ_Q = 2048;
constexpr int SQ_PHYS = 3072;
constexpr int SQ_P = 4096;
constexpr int SQ_RB = 16384;
constexpr int SQ_BT = 17408;
__device__ __forceinline__ int wg_sum8(const Frame& F, LAS unsigned* slot, int v) {
    if (F.lane == 0) slot[F.wave] = (unsigned)v;
    __syncthreads();
    int t = 0;
#pragma unroll
    for (int w = 0; w < 8; ++w) t += (int)slot[w];
    return t;
}
__device__ __forceinline__ void p4_sample_query_unit(const Frame& F, const float* SS, int b, int t) {
    const int lane = F.lane, w = F.wave;
    LAS unsigned* CNT = (LAS unsigned*)(F.lds + SQ_CNT);
    LAS int* SELL = (LAS int*)(F.lds + SQ_SEL);
    LAS unsigned* QL = (LAS unsigned*)(F.lds + SQ_Q);
    LAS float* PL = (LAS float*)(F.lds + SQ_P) + w * 256;
    LAS float* RB = (LAS float*)(F.lds + SQ_RB);
    LAS int* BT = (LAS int*)(F.lds + SQ_BT);
    const int tok = NTP + b * TS + t;
    __syncthreads();
    if (F.tid < 256) QL[F.tid] = ((const unsigned*)(F.PROJ + (size_t)tok * NMIXP + C_Q))[F.tid];
    unsigned u[17];
    { const float* srow = SS + (size_t)(b * TS + t) * PAST + w * 1024;
#pragma unroll
      for (int i = 0; i < 16; ++i) u[i] = f2ord(srow[64 * i + lane]); }
    u[16] = 0u;
    if (w == 7) {
        const int kj = lane < TS ? lane : 0;
        const bf16_t* kn = F.PROJ + (size_t)(NTP + b * TS + kj) * NMIXP + C_KI;
        const bf16_t* qn = F.PROJ + (size_t)tok * NMIXP + C_QI;
        u32x4 kv[8];
#pragma unroll
        for (int c = 0; c < 8; ++c) kv[c] = *(const u32x4*)(kn + c * 8);
        int vz; asm volatile("v_mov_b32 %0, 0" : "=v"(vz));
        const f32x4 w4 = *(const f32x4*)(F.WI + (size_t)tok * 4 + vz);
        float sc = 0.f;
#pragma unroll
        for (int hh = 0; hh < 4; ++hh) {
            u32x4 qv[8];
#pragma unroll
            for (int c = 0; c < 8; ++c) qv[c] = *(const u32x4*)(qn + hh * 64 + c * 8 + vz);
            float d = 0.f;
#pragma unroll
            for (int c = 0; c < 8; ++c)
#pragma unroll
                for (int e = 0; e < 4; ++e) d += bflo(qv[c][e]) * bflo(kv[c][e]) + bfhi(qv[c][e]) * bfhi(kv[c][e]);
            sc += fmaxf(d, 0.f) * (w4[hh] * IDX_SCALE);
        }
        u[16] = (lane < TS && lane <= t) ? f2ord(sc) : 0u;
    }
    unsigned T = 0;
#pragma unroll 1
    for (int bit = 31; bit >= 0; --bit) {
        const unsigned cand = T | (1u << bit);
        int c = 0;
#pragma unroll
        for (int i = 0; i < 17; ++i) cnt_ge(c, u[i], cand);
        c = wg_sum8(F, CNT + (bit & 1) * 24, wave_sum_i_dpp(c));
        if (c >= NSEL) T = cand;
        if (c == NSEL) break;
    }
    int cg = 0, ce = 0;
#pragma unroll
    for (int i = 0; i < 17; ++i) { cnt_gt(cg, u[i], T); cnt_eq(ce, u[i], T); }
    const int cgw = wave_sum_i_dpp(cg);
    const int ngt = wg_sum8(F, CNT + 8, cgw);
    const int neq = wg_sum8(F, CNT + 16, wave_sum_i_dpp(ce));
    const int need = NSEL - ngt;
    int Jx = 0x3FFFFFFF;
    if (need < neq) {
        int Jb = 0;
#pragma unroll 1
        for (int bit = 13; bit >= 0; --bit) {
            const int cand = Jb | (1 << bit);
            const int L = cand - lane - 1024 * w;
            int c = 0;
#pragma unroll
            for (int i = 0; i < 17; ++i) cnt_eq_pos(c, u[i], T, L - 64 * i);
            c = wg_sum8(F, CNT + (bit & 1) * 24, wave_sum_i_dpp(c));
            if (c < need) Jb = cand;
        }
        Jx = Jb + 1;
    }
    {
        const int L = Jx - lane - 1024 * w;
        int ct = 0;
#pragma unroll
        for (int i = 0; i < 17; ++i) cnt_eq_pos(ct, u[i], T, L - 64 * i);
        const int ctw = wave_sum_i_dpp(ct);
        __syncthreads();
        if (lane == 0) { CNT[w] = (unsigned)cgw; CNT[8 + w] = (unsigned)ctw; }
        __syncthreads();
        int bg = 0, bt = ngt;
#pragma unroll
        for (int ww = 0; ww < 8; ++ww) { if (ww < w) { bg += (int)CNT[ww]; bt += (int)CNT[8 + ww]; } }
        int ig = cg, it2 = ct;
#pragma unroll
        for (int o = 1; o < 64; o <<= 1) { const int a = __shfl_up(ig, o), b2 = __shfl_up(it2, o); if (lane >= o) { ig += a; it2 += b2; } }
        int pg = bg + ig - cg, pt = bt + it2 - ct;
        int ev = 1024 * w + lane, Lr = L;
#pragma unroll
        for (int i = 0; i < 17; ++i) {
            if (u[i] > T) { SELL[pg] = ev; ++pg; }
            else if (u[i] == T && Lr > 0) { SELL[pt] = ev; ++pt; }
            asm volatile("v_add_u32 %0, 64, %0\n\tv_add_u32 %1, -64, %1" : "+v"(ev), "+v"(Lr));
        }
    }
    __syncthreads();
    LAS int* PHYS = (LAS int*)(F.lds + SQ_PHYS);
    if (F.tid < 256) { const int sraw = SELL[F.tid]; PHYS[F.tid] = (sraw < PAST) ? F.page_table[b * NPAGES + (sraw >> 7)] * PAGE + (sraw & 127) : -1 - (sraw - PAST); }
    __syncthreads();
    {
        const int hd = w, g = w >> 2, qpos = PAST + t;
        float lg[4];
#pragma unroll 2
        for (int i = 0; i < 4; ++i) {
            const int sraw = SELL[lane + 64 * i], ph = PHYS[lane + 64 * i];
            const float* kr = (ph >= 0) ? F.cache_k + (size_t)ph * 128 + g * 64 : F.out + O_KS + (size_t)(b * TS + (-1 - ph)) * 128 + g * 64;
            float a0 = 0.f, a1 = 0.f;
#pragma unroll
            for (int c = 0; c < 16; ++c) {
                const f32x4 kv = *(const f32x4*)(kr + c * 4);
                const unsigned q0 = QL[hd * 32 + c * 2], q1 = QL[hd * 32 + c * 2 + 1];
                a0 += bflo(q0) * kv[0] + bfhi(q0) * kv[1]; a1 += bflo(q1) * kv[2] + bfhi(q1) * kv[3];
            }
            const int dist = qpos - sraw; const int bk = dist < 128 ? BT[dist] : 31;
            lg[i] = (a0 + a1) * ATTN_SCALE + RB[bk * 8 + hd];
        }
        float m = fmaxf(fmaxf(lg[0], lg[1]), fmaxf(lg[2], lg[3])); m = wave_max(m);
        float sm = 0.f;
#pragma unroll
        for (int i = 0; i < 4; ++i) { lg[i] = __expf(lg[i] - m); sm += lg[i]; }
        const float inv = 1.f / wave_sum_dpp(sm);
#pragma unroll
        for (int i = 0; i < 4; ++i) PL[lane + 64 * i] = lg[i] * inv;
        const int dq = lane & 15, ks = lane >> 4;
        f32x4 o4 = {0.f, 0.f, 0.f, 0.f};
#pragma unroll 1
        for (int j0 = 0; j0 < 256; j0 += 64) {
            f32x4 vv[16]; float pp[16];
#pragma unroll
            for (int jj = 0; jj < 16; ++jj) {
                const int j = j0 + jj * 4 + ks;
                const int ph = PHYS[j]; pp[jj] = PL[j];
                const float* vr = (ph >= 0) ? F.cache_v + (size_t)ph * 128 + g * 64 : F.out + O_VS + (size_t)(b * TS + (-1 - ph)) * 128 + g * 64;
                vv[jj] = *(const f32x4*)(vr + 4 * dq);
            }
#pragma unroll
            for (int jj = 0; jj < 16; ++jj) o4 += vv[jj] * pp[jj];
        }
#pragma unroll
        for (int e = 0; e < 4; ++e) { o4[e] += __shfl_xor(o4[e], 16); o4[e] += __shfl_xor(o4[e], 32); }
        if (ks == 0) *(u32x2*)(F.OATT + (size_t)tok * 512 + hd * 64 + 4 * dq) = pk4(o4);
    }
}
__device__ __forceinline__ void p4_attention(const Frame& F) {
    const float* SS = (const float*)(F.ws + WS_SS);
    __syncthreads();
    if (F.tid < 256) ((LAS float*)(F.lds + SQ_RB))[F.tid] = F.rel_bias[F.tid];
    if (F.tid < 128) ((LAS int*)(F.lds + SQ_BT))[F.tid] = t5_bucket(F.tid);
    __syncthreads();
    for (int it = F.bid; it < NTS; it += F.G) p4_sample_query_unit(F, SS, it >> 3, it & 7);
    {
        const int c0 = F.lane * 8;
        float cw0[8], cw1[8], cw2[8], cbv[8];
#pragma unroll
        for (int e = 0; e < 8; ++e) { cw0[e] = F.conv_w[c0 + e]; cw1[e] = F.conv_w[512 + c0 + e]; cw2[e] = F.conv_w[1024 + c0 + e]; cbv[e] = F.conv_b[c0 + e]; }
        const int stride = F.G * 8;
        u32x4 n_cg[3], n_xi[3], n_bg;
        auto fetch = [&](int m) {
#pragma unroll
            for (int d = 0; d < 3; ++d) { const int mm = (m - d >= 0) ? m - d : 0; n_cg[d] = *(const u32x4*)(F.PROJ + (size_t)mm * NMIXP + C_CG + c0); n_xi[d] = *(const u32x4*)(F.PROJ + (size_t)mm * NMIXP + C_XIN + c0); }
            n_bg = *(const u32x4*)(F.PROJ + (size_t)m * NMIXP + C_BG + c0);
        };
        { const int m = F.bid * 8 + F.wave; fetch(m < NT ? m : 0); }
        for (int m = F.bid * 8 + F.wave; m < NT; m += stride) {
            u32x4 cg[3], xi[3]; const u32x4 bg = n_bg;
#pragma unroll
            for (int d = 0; d < 3; ++d) { cg[d] = n_cg[d]; xi[d] = n_xi[d]; }
            fetch(m + stride < NT ? m + stride : m);
            int t, T_, bsm; if (m < NTP) { t = m & 2047; T_ = SEQ; bsm = m >> 11; } else { t = (m - NTP) & 7; T_ = TS; bsm = (m - NTP) >> 3; }
            float u[3][8];
#pragma unroll
            for (int d = 0; d < 3; ++d) {
                if (t - d >= 0) {
#pragma unroll
                    for (int e = 0; e < 4; ++e) { u[d][2 * e] = bflo(cg[d][e]) * bflo(xi[d][e]); u[d][2 * e + 1] = bfhi(cg[d][e]) * bfhi(xi[d][e]); }
                } else if (m >= NTP) {
                    const float* pv = F.state_conv + ((size_t)bsm * 2 + (2 + t - d)) * 512 + c0;
#pragma unroll
                    for (int e = 0; e < 8; ++e) u[d][e] = pv[e];
                } else {
#pragma unroll
                    for (int e = 0; e < 8; ++e) u[d][e] = 0.f;
                }
            }
            float y[8];
#pragma unroll
            for (int e = 0; e < 8; ++e) {
                const float yy = cbv[e] + cw0[e] * u[2][e] + cw1[e] * u[1][e] + cw2[e] * u[0][e];
                const float bgv = (e & 1) ? bfhi(bg[e >> 1]) : bflo(bg[e >> 1]);
                y[e] = bgv * yy;
            }
            *(u32x4*)(F.OCONV + (size_t)m * 512 + c0) = (u32x4){cvt_pk_bf16(y[0], y[1]), cvt_pk_bf16(y[2], y[3]), cvt_pk_bf16(y[4], y[5]), cvt_pk_bf16(y[6], y[7])};
            if (t >= T_ - 2) {
                float* o = (m < NTP ? F.out + O_CP : F.out + O_CS) + ((size_t)bsm * 2 + (t - (T_ - 2))) * 512 + c0;
                const int rowi = (m < NTP) ? bsm * 2 + (t - (T_ - 2)) : 2 * NB_P + bsm * 2 + (t - (T_ - 2));
                const float* cx = (const float*)(F.ws + WS_CGX) + (size_t)rowi * 1024 + c0;
                const f32x4 ca = *(const f32x4*)cx, cb2 = *(const f32x4*)(cx + 4), xa = *(const f32x4*)(cx + 512), xb = *(const f32x4*)(cx + 516);
                *(f32x4*)o = ca * xa; *(f32x4*)(o + 4) = cb2 * xb;
            }
        }
    }
}

#define P5_EPI(A1, A2) { \
            const f32x4 va = ACC4(A1), vc = ACC4(A2); \
            const u32x2 ga = *(const u32x2*)(F.PROJ + (size_t)m * NMIXP + C_GA + n), gb = *(const u32x2*)(F.PROJ + (size_t)m * NMIXP + C_GB + n); \
            f32x4 o; \
            o[0] = sigmoidf_(bflo(ga[0])) * va[0] + sigmoidf_(bflo(gb[0])) * vc[0]; \
            o[1] = sigmoidf_(bfhi(ga[0])) * va[1] + sigmoidf_(bfhi(gb[0])) * vc[1]; \
            o[2] = sigmoidf_(bflo(ga[1])) * va[2] + sigmoidf_(bflo(gb[1])) * vc[2]; \
            o[3] = sigmoidf_(bfhi(ga[1])) * va[3] + sigmoidf_(bfhi(gb[1])) * vc[3]; \
            *(u32x2*)(F.MERGED + (size_t)m * D + n) = pk4(o); }
struct P5aBody {
    const Frame* Fp;
    __device__ __forceinline__ void operator()(int m, int n, const f32x4 v) const { *(u32x2*)(Fp->MERGED + (size_t)m * D + n) = pk4(v); }
};
struct P5bBody {
    const Frame* Fp;
    __device__ __forceinline__ void operator()(int m, int n, const f32x4 v) const {
        const Frame& F = *Fp;
        const u32x2 ga = *(const u32x2*)(F.PROJ + (size_t)m * NMIXP + C_GA + n), gb = *(const u32x2*)(F.PROJ + (size_t)m * NMIXP + C_GB + n);
        const u32x2 pa = *(const u32x2*)(F.MERGED + (size_t)m * D + n);
        const f32x4 o = (f32x4){sigmoidf_(bflo(ga[0])) * bflo(pa[0]) + sigmoidf_(bflo(gb[0])) * v[0], sigmoidf_(bfhi(ga[0])) * bfhi(pa[0]) + sigmoidf_(bfhi(gb[0])) * v[1],
                                sigmoidf_(bflo(ga[1])) * bflo(pa[1]) + sigmoidf_(bflo(gb[1])) * v[2], sigmoidf_(bfhi(ga[1])) * bfhi(pa[1]) + sigmoidf_(bfhi(gb[1])) * v[3]};
        *(u32x2*)(F.MERGED + (size_t)m * D + n) = pk4(o);
    }
};
__device__ __forceinline__ void p5_gemm_merge(const Frame& F) {
    {
        pg8::StaticOrder S; S.init(NTP, D, F.G, F.bid);
        { pg8::Gemm g{F.OATT, F.WOA, NTP, D, 512}; pg8::EpiRC<P5aBody> E{P5aBody{&F}}; pg8::gemm_phase<pg8::EpiRC<P5aBody>, pg8::StaticOrder, true, true>(F.lds, g, S, E); }
        asm volatile("s_waitcnt vmcnt(0)" ::: "memory"); __syncthreads();
        { pg8::Gemm g{F.OCONV, F.WOC, NTP, D, 512}; pg8::EpiRC<P5bBody> E{P5bBody{&F}}; pg8::gemm_phase<pg8::EpiRC<P5bBody>, pg8::StaticOrder, true, true>(F.lds, g, S, E); }
    }
    for (int sl = F.bid; sl < NTS / 8 * (D / BN); sl += F.G) {
        const int m0 = NTP + (sl >> 3) * 8, n0 = (sl & 7) * BN;
        f32x16 s1[1][1], s2[1][1];
        gemm_slice8(F, s1, F.OATT, 512, F.WOA, 512, 512, m0, n0);
        gemm_slice8(F, s2, F.OCONV, 512, F.WOC, 512, 512, m0, n0);
        SLICE_EPI_LOOP(P5_EPI(s1, s2))
    }
}
#define P6_EPI(A1) { \
            const f32x4 v = ACC4(A1); \
            const f32x4 xv = *(const f32x4*)(x_row(F, m) + n); \
            const f32x4 g1 = *(const f32x4*)(F.MOD + (size_t)mod_row(m) * 6144 + 2048 + n); \
            *(f32x4*)(F.T1 + (size_t)m * D + n) = xv * DN_ALPHA + g1 * v; }
struct P6Body {
    const Frame* Fp;
    __device__ __forceinline__ void operator()(int m, int n, const f32x4 v) const {
        const Frame& F = *Fp;
        const f32x4 xv = *(const f32x4*)(F.x_p + (size_t)m * D + n);
        const f32x4 g1 = *(const f32x4*)(F.MOD + (size_t)(m >> 11) * 6144 + 2048 + n);
        *(f32x4*)(F.T1 + (size_t)m * D + n) = xv * DN_ALPHA + g1 * v;
    }
};
__device__ __forceinline__ void p6_gemm_out(const Frame& F) {
    {
        pg8::Gemm g{F.MERGED, F.WOUT, NTP, D, D}; pg8::StaticOrder S; S.init(NTP, D, F.G, F.bid);
        pg8::EpiRC<P6Body> E{P6Body{&F}}; pg8::gemm_phase<pg8::EpiRC<P6Body>, pg8::StaticOrder, true, true>(F.lds, g, S, E);
    }
    for (int sl = F.bid; sl < NTS / 8 * (D / BN); sl += F.G) {
        const int m0 = NTP + (sl >> 3) * 8, n0 = (sl & 7) * BN;
        f32x16 s1[1][1];
        gemm_slice8(F, s1, F.MERGED, D, F.WOUT, D, D, m0, n0);
        SLICE_EPI_LOOP(P6_EPI(s1))
    }
}
__device__ __forceinline__ void p7_ln1(const Frame& F) {
    f32x4 lg[4], lb[4];
#pragma unroll
    for (int i = 0; i < 4; ++i) { const int e = (i >> 1) * 512 + F.lane * 8 + (i & 1) * 4; lg[i] = *(const f32x4*)(F.ln1_g + e); lb[i] = *(const f32x4*)(F.ln1_b + e); }
    const int stride = F.G * 8;
    f32x4 vn[4], scn[4], shn[4];
    {
        const int m = F.bid * 8 + F.wave; const float* mr = F.MOD + (size_t)mod_row(m < NT ? m : 0) * 6144;
#pragma unroll
        for (int i = 0; i < 4; ++i) { const int e = (i >> 1) * 512 + F.lane * 8 + (i & 1) * 4; vn[i] = *(const f32x4*)(F.T1 + (size_t)(m < NT ? m : 0) * D + e); scn[i] = *(const f32x4*)(mr + 4096 + e); shn[i] = *(const f32x4*)(mr + 3072 + e); }
    }
    for (int m = F.bid * 8 + F.wave; m < NT; m += stride) {
        float* tr = F.T1 + (size_t)m * D;
        f32x4 v[4], sc2[4], sh2[4]; float s = 0.f;
#pragma unroll
        for (int i = 0; i < 4; ++i) { v[i] = vn[i]; sc2[i] = scn[i]; sh2[i] = shn[i]; s += v[i][0] + v[i][1] + v[i][2] + v[i][3]; }
        {
            const int mn = (m + stride < NT) ? m + stride : m; const float* mrn = F.MOD + (size_t)mod_row(mn) * 6144;
#pragma unroll
            for (int i = 0; i < 4; ++i) { const int e = (i >> 1) * 512 + F.lane * 8 + (i & 1) * 4; vn[i] = *(const f32x4*)(F.T1 + (size_t)mn * D + e); scn[i] = *(const f32x4*)(mrn + 4096 + e); shn[i] = *(const f32x4*)(mrn + 3072 + e); }
        }
        const float mean = wave_sum(s) * (1.f / D);
        float q = 0.f;
#pragma unroll
        for (int i = 0; i < 4; ++i) { v[i] = v[i] - mean; q += v[i][0] * v[i][0] + v[i][1] * v[i][1] + v[i][2] * v[i][2] + v[i][3] * v[i][3]; }
        const float rstd = rsqrtf(wave_sum(q) * (1.f / D) + LN_EPS);
        f32x4 hv[2][2];
#pragma unroll
        for (int hlf = 0; hlf < 2; ++hlf) {
            const int e = hlf * 512 + F.lane * 8;
            f32x4 a = v[2 * hlf] * rstd * lg[2 * hlf] + lb[2 * hlf];
            f32x4 b = v[2 * hlf + 1] * rstd * lg[2 * hlf + 1] + lb[2 * hlf + 1];
            *(f32x4*)(tr + e) = a; *(f32x4*)(tr + e + 4) = b;
            const f32x4 ha = a * (sc2[2 * hlf] + 1.f) + sh2[2 * hlf];
            const f32x4 hb = b * (sc2[2 * hlf + 1] + 1.f) + sh2[2 * hlf + 1];
            *(u32x4*)(F.H2 + (size_t)m * D + e) = (u32x4){cvt_pk_bf16(ha[0], ha[1]), cvt_pk_bf16(ha[2], ha[3]), cvt_pk_bf16(hb[0], hb[1]), cvt_pk_bf16(hb[2], hb[3])};
            hv[hlf][0] = ha; hv[hlf][1] = hb;
        }
        float am = 0.f;
#pragma unroll
        for (int i = 0; i < 2; ++i)
#pragma unroll
            for (int j = 0; j < 2; ++j)
#pragma unroll
                for (int e = 0; e < 4; ++e) am = fmaxf(am, fabsf(hv[i][j][e]));
        am = wave_max(am);
        const float sc = am > 0.f ? 224.f / am : 1.f;
#pragma unroll
        for (int hlf = 0; hlf < 2; ++hlf) {
            int w0 = 0, w1 = 0;
            w0 = __builtin_amdgcn_cvt_pk_fp8_f32(hv[hlf][0][0] * sc, hv[hlf][0][1] * sc, w0, false); w0 = __builtin_amdgcn_cvt_pk_fp8_f32(hv[hlf][0][2] * sc, hv[hlf][0][3] * sc, w0, true);
            w1 = __builtin_amdgcn_cvt_pk_fp8_f32(hv[hlf][1][0] * sc, hv[hlf][1][1] * sc, w1, false); w1 = __builtin_amdgcn_cvt_pk_fp8_f32(hv[hlf][1][2] * sc, hv[hlf][1][3] * sc, w1, true);
            *(u32x2*)(F.ws + WS_H8 + (size_t)m * D + hlf * 512 + F.lane * 8) = (u32x2){(unsigned)w0, (unsigned)w1};
        }
        if (F.lane == 0) ((float*)(F.ws + WS_SH))[m] = am > 0.f ? am * (1.f / 224.f) : 1.f;
    }
}
struct P8Body {
    const Frame* Fp;
    __device__ __forceinline__ void operator()(int m, int n, const f32x4 v) const { *(u32x2*)(Fp->QP + (size_t)m * D + n) = pk4(v); }
};
__device__ __forceinline__ void p8_gemm_q(const Frame& F) {
    {
        pg8::Gemm g{F.H2, F.WQ, NTP, D, D}; pg8::StaticOrder S; S.init(NTP, D, F.G, F.bid);
        pg8::EpiRC<P8Body> E{P8Body{&F}}; pg8::gemm_phase<pg8::EpiRC<P8Body>, pg8::StaticOrder, true, true>(F.lds, g, S, E);
    }
    for (int sl = F.bid; sl < NTS / 8 * (D / BN); sl += F.G) {
        const int m0 = NTP + (sl >> 3) * 8, n0 = (sl & 7) * BN;
        f32x16 s1[1][1];
        gemm_slice8(F, s1, F.H2, D, F.WQ, D, D, m0, n0);
        SLICE_EPI_LOOP({ *(u32x2*)(F.QP + (size_t)m * D + n) = pk4(ACC4(s1)); })
    }
}
__device__ __forceinline__ void p9_row_top16(LAS float* row, LAS float* TV, LAS unsigned char* TI, int slot) {
    float gm[16];
#pragma unroll
    for (int gidx = 0; gidx < 16; ++gidx) {
        float m = row[gidx * 8];
#pragma unroll
        for (int k = 1; k < 8; ++k) m = fmaxf(m, row[gidx * 8 + k]);
        gm[gidx] = m;
    }
#pragma unroll 1
    for (int p = 0; p < 16; ++p) {
        float best = gm[0]; int bg = 0;
#pragma unroll
        for (int gidx = 1; gidx < 16; ++gidx) { const bool gt = gm[gidx] > best; best = gt ? gm[gidx] : best; bg = gt ? gidx : bg; }
        float v[8];
#pragma unroll
        for (int k = 0; k < 8; ++k) v[k] = row[bg * 8 + k];
        int bk = 7;
#pragma unroll
        for (int k = 6; k >= 0; --k) bk = (v[k] == best) ? k : bk;
        float nm = -INFINITY;
#pragma unroll
        for (int k = 0; k < 8; ++k) nm = fmaxf(nm, (k == bk) ? -INFINITY : v[k]);
        row[bg * 8 + bk] = -INFINITY;
#pragma unroll
        for (int gidx = 0; gidx < 16; ++gidx) gm[gidx] = (gidx == bg) ? nm : gm[gidx];
        TV[slot * 17 + p] = best; TI[slot * 17 + p] = (unsigned char)(bg * 8 + bk);
    }
}
__device__ __forceinline__ void p9_pair_top16(const Frame& F, LAS const float* TV, LAS const unsigned char* TI, int r1, int r2, int tok, int head) {
    float c[16];
    { const float v20 = TV[r2];
#pragma unroll
      for (int i = 0; i < 16; ++i) c[i] = TV[r1 + i] + v20; }
    unsigned long long ptrs = 0ull;
    float sv[16]; int se[16];
#pragma unroll
    for (int p = 0; p < 16; ++p) {
        float best = c[0]; int bi = 0;
#pragma unroll
        for (int i = 1; i < 16; ++i) { const bool gt = c[i] > best; best = gt ? c[i] : best; bi = gt ? i : bi; }
        const int bj = (int)((ptrs >> (4 * bi)) & 15ull);
        sv[p] = best; se[p] = (int)TI[r1 + bi] * 128 + (int)TI[r2 + bj];
        const float nv = (bj < 15) ? TV[r1 + bi] + TV[r2 + bj + 1] : -INFINITY;
        ptrs += (bj < 15) ? (1ull << (4 * bi)) : 0ull;
#pragma unroll
        for (int i = 0; i < 16; ++i) c[i] = (i == bi) ? nv : c[i];
    }
    const float mx0 = sv[0]; float den = 0.f;
#pragma unroll
    for (int p = 0; p < 16; ++p) { sv[p] = __expf(sv[p] - mx0); den += sv[p]; }
    const float dinv = 1.f / den;
    int* eo = F.EIDX + (size_t)tok * NEXP_SEL + head * 16; float* go = F.GW + (size_t)tok * NEXP_SEL + head * 16;
#pragma unroll
    for (int p = 0; p < 16; ++p) { eo[p] = se[p]; go[p] = sv[p] * dinv; }
}
constexpr int PR_ROW = 129, PR_ROWS = 256 + 4;
__device__ __forceinline__ void p9_route(const Frame& F) {
    LAS float* SC = (LAS float*)F.lds;
    LAS float* TV = (LAS float*)(F.lds + PR_ROWS * PR_ROW * 4);
    LAS unsigned char* TI = (LAS unsigned char*)(F.lds + PR_ROWS * PR_ROW * 4 + PR_ROWS * 17 * 4);
    const int lane = F.lane, r = lane & 31, h = lane >> 5;
    const int nunits = (NTP / 32) * 2;
    int k = 0;
    for (int it = F.bid; it < nunits; it += F.G, ++k) {
        const int tok0 = (it >> 1) * 32, hg = it & 1;
        const int ts = NTP + F.bid + F.G * (k >> 2), kh = k & 3;
        const bool has_s = ts < NT;
        __syncthreads();
        {
            const int head = hg * 4 + (F.wave >> 1), half = F.wave & 1;
            const bf16_t* KK = half ? F.K2 : F.K1;
            bf16x8 Bq[4], Bs[4];
#pragma unroll
            for (int s = 0; s < 4; ++s) Bq[s] = *(const bf16x8*)(F.QP + (size_t)(tok0 + r) * D + head * 128 + half * 64 + s * 16 + h * 8);
            const bool swave = has_s && F.wave < 4;
            if (swave) {
#pragma unroll
                for (int s = 0; s < 4; ++s) Bs[s] = *(const bf16x8*)(F.QP + (size_t)ts * D + (2 * kh + (F.wave >> 1)) * 128 + half * 64 + s * 16 + h * 8);
            }
#pragma unroll
            for (int kt = 0; kt < 4; ++kt) {
                f32x16 c, cs;
#pragma unroll
                for (int e = 0; e < 16; ++e) { c[e] = 0.f; cs[e] = 0.f; }
#pragma unroll
                for (int s = 0; s < 4; ++s) {
                    const bf16x8 Ak = *(const bf16x8*)(KK + (size_t)(kt * 32 + r) * 64 + s * 16 + h * 8);
                    c = __builtin_amdgcn_mfma_f32_32x32x16_bf16(Ak, Bq[s], c, 0, 0, 0);
                    if (swave) cs = __builtin_amdgcn_mfma_f32_32x32x16_bf16(Ak, Bs[s], cs, 0, 0, 0);
                }
#pragma unroll
                for (int e = 0; e < 16; ++e) { const int key = kt * 32 + (e & 3) + 8 * (e >> 2) + 4 * h; SC[(r * 8 + F.wave) * PR_ROW + key] = c[e]; }
                if (swave && r == 0) {
#pragma unroll
                    for (int e = 0; e < 16; ++e) { const int key = kt * 32 + (e & 3) + 8 * (e >> 2) + 4 * h; SC[(256 + F.wave) * PR_ROW + key] = cs[e]; }
                }
            }
        }
        __syncthreads();
        if (F.tid < 256 || (has_s && F.tid < 260)) p9_row_top16(SC + F.tid * PR_ROW, TV, TI, F.tid);
        __syncthreads();
        if (F.tid < 128) {
            const int tk = F.tid >> 2, hs = F.tid & 3;
            const int r1 = (tk * 8 + hs * 2) * 17;
            p9_pair_top16(F, TV, TI, r1, r1 + 17, tok0 + tk, hg * 4 + hs);
        } else if (has_s && F.tid < 130) {
            const int hs = F.tid - 128;
            const int r1 = (256 + hs * 2) * 17;
            p9_pair_top16(F, TV, TI, r1, r1 + 17, ts, 2 * kh + hs);
        }
    }
}

constexpr int TPW = 65, PAIRS_MAX = 9 * 128, PK = 4;
constexpr int P10_HROW = 1024 + 64;
constexpr int P10_H = 0;
constexpr int P10_SH = 32 * P10_HROW;
constexpr int P10_VROW = 2048 + 64;
constexpr int P10_STG = P10_SH + 128;
constexpr int P10_HIST = P10_STG + 8 * 4 * P10_VROW;
typedef short s16x4 __attribute__((ext_vector_type(4)));
__device__ __forceinline__ long pack64(unsigned lo, unsigned hi) { return (long)(((unsigned long long)hi << 32) | (unsigned long long)lo); }
__device__ __forceinline__ void fp8x16_to_bf16(const u32x4 v, u32x4& lo, u32x4& hi) {
    unsigned o[8];
#pragma unroll
    for (int i = 0; i < 4; ++i) {
        const f32x2_t a = __builtin_amdgcn_cvt_pk_f32_fp8((int)v[i], false), b2 = __builtin_amdgcn_cvt_pk_f32_fp8((int)v[i], true);
        o[2 * i] = cvt_pk_bf16(a[0], a[1]); o[2 * i + 1] = cvt_pk_bf16(b2[0], b2[1]);
    }
    lo = (u32x4){o[0], o[1], o[2], o[3]}; hi = (u32x4){o[4], o[5], o[6], o[7]};
}
__device__ __forceinline__ void p10_peer(const Frame& F) {
    const int lane = F.lane, w = F.wave;
    unsigned char* ws = F.ws;
    const unsigned char* PU8 = ws + WS_PU8; const unsigned char* PV8 = ws + WS_PV8;
    const float* SU = (const float*)(ws + WS_SU); const float* SV = (const float*)(ws + WS_SV);
    const unsigned char* H8 = ws + WS_H8; const float* SH = (const float*)(ws + WS_SH);
  for (int blk = F.bid; blk < NT / TPW; blk += F.G) {
    const int tok0 = blk * TPW;
    LAS unsigned* hist = (LAS unsigned*)(F.lds + P10_HIST) + w * 128;
    LAS unsigned char* stg = F.lds + P10_STG + w * (4 * P10_VROW);
    LAS float* SHl = (LAS float*)(F.lds + P10_SH);
    unsigned* SE0 = (unsigned*)(ws + WS_SE) + ((size_t)blk * 8 + w) * PAIRS_MAX;
    float* SG0 = (float*)(ws + WS_SG) + ((size_t)blk * 8 + w) * PAIRS_MAX;
    const int ntok = (w == 0) ? 9 : 8;
    const int r16 = lane & 15, q4 = lane >> 4;
#pragma unroll 1
    for (int pass = 0; pass < 3; ++pass) {
        const int kbase = pass * PK, nk = (ntok - kbase < PK) ? (ntok - kbase > 0 ? ntok - kbase : 0) : PK, npairs = nk * 128;
        __syncthreads();
        for (int c = F.tid; c < 32 * 64; c += NTHREADS) {
            const int row = c >> 6, tl = 32 * pass + row;
            if (tl < TPW) *(LAS u32x4*)(F.lds + P10_H + row * P10_HROW + (c & 63) * 16) = *(const u32x4*)(H8 + (size_t)(tok0 + tl) * D + (size_t)(c & 63) * 16);
        }
        if (F.tid < 32 && 32 * pass + F.tid < TPW) SHl[F.tid] = SH[tok0 + 32 * pass + F.tid];
        __syncthreads();
        if (nk <= 0) continue;
        unsigned* SE = SE0 + pass * (PK * 128); float* SG = SG0 + pass * (PK * 128);
        hist[lane] = 0u; hist[lane + 64] = 0u;
        int ex[8];
#pragma unroll
        for (int i = 0; i < 8; ++i) {
            const int p = lane + 64 * i;
            ex[i] = -1;
            if (p < npairs) { ex[i] = F.EIDX[(size_t)(tok0 + w + 8 * (kbase + (p >> 7))) * NEXP_SEL + (p & 127)]; atomicAdd((unsigned*)&hist[ex[i] >> 7], 1u); }
        }
        {
            const unsigned c0 = hist[2 * lane], c1 = hist[2 * lane + 1];
            unsigned incl = c0 + c1;
#pragma unroll
            for (int o = 1; o < 64; o <<= 1) { const unsigned t = __shfl_up(incl, o); if (lane >= o) incl += t; }
            const unsigned excl = incl - (c0 + c1);
            hist[2 * lane] = excl; hist[2 * lane + 1] = excl + c0;
        }
#pragma unroll
        for (int i = 0; i < 8; ++i) {
            const int p = lane + 64 * i;
            if (p < npairs) {
                const unsigned pos = atomicAdd((unsigned*)&hist[ex[i] >> 7], 1u);
                SE[pos] = (unsigned)ex[i] | ((unsigned)(p >> 7) << 14);
                SG[pos] = F.GW[(size_t)(tok0 + w + 8 * (kbase + (p >> 7))) * NEXP_SEL + (p & 127)];
            }
        }
        asm volatile("s_waitcnt vmcnt(0)" ::: "memory");
        f32x4 acc[16];
#pragma unroll
        for (int c = 0; c < 16; ++c) acc[c] = (f32x4){0.f, 0.f, 0.f, 0.f};
#pragma unroll 1
        for (int c0 = 0; c0 < npairs; c0 += 64) {
            const int wv = (int)SE[c0 + lane]; const int gv = __float_as_int(SG[c0 + lane]);
#pragma unroll 1
            for (int j0 = 0; j0 < 64; j0 += 16) {
                const int wr = __shfl(wv, j0 + r16);
                const int er = wr & 16383, sr = wr >> 14;
                const float gr = __int_as_float(__shfl(gv, j0 + r16));
                const unsigned char* ur = PU8 + (size_t)er * D + q4 * 16;
                u32x4 Ub[16];
#pragma unroll
                for (int t = 0; t < 16; ++t) Ub[t] = *(const u32x4*)(ur + t * 64);
                const float suv = SU[er], svv = SV[er];
                u32x4 V8[2][4];
#pragma unroll
                for (int k = 0; k < 4; ++k) V8[0][k] = *(const u32x4*)(PV8 + (size_t)(__builtin_amdgcn_readlane(wv, j0 + k) & 16383) * D + lane * 16);
                LAS const unsigned char* hr = F.lds + P10_H + (w + 8 * sr) * P10_HROW + q4 * 16;
                const float shv = SHl[w + 8 * sr];
                f32x4 C0 = {0.f, 0.f, 0.f, 0.f}, C1 = {0.f, 0.f, 0.f, 0.f};
#pragma unroll
                for (int t = 0; t < 16; ++t) {
                    const u32x4 hh = *(LAS const u32x4*)(hr + t * 64);
                    C0 = __builtin_amdgcn_mfma_f32_16x16x32_fp8_fp8(pack64(hh[0], hh[1]), pack64(Ub[t][0], Ub[t][1]), C0, 0, 0, 0);
                    C1 = __builtin_amdgcn_mfma_f32_16x16x32_fp8_fp8(pack64(hh[2], hh[3]), pack64(Ub[t][2], Ub[t][3]), C1, 0, 0, 0);
                }
                C0 = C0 + C1;
                const int rsel = lane & 3;
                const float dv = (rsel == 0 ? C0[0] : (rsel == 1 ? C0[1] : (rsel == 2 ? C0[2] : C0[3]))) * (suv * shv);
                const int actv = __float_as_int(gelu_tanh(dv) * (gr * svv));
#pragma unroll
                for (int sg = 0; sg < 4; ++sg) {
                    if (sg + 1 < 4) {
#pragma unroll
                        for (int k = 0; k < 4; ++k) V8[(sg + 1) & 1][k] = *(const u32x4*)(PV8 + (size_t)(__builtin_amdgcn_readlane(wv, j0 + 4 * (sg + 1) + k) & 16383) * D + lane * 16);
                    }
#pragma unroll
                    for (int k = 0; k < 4; ++k) {
                        u32x4 lo, hi; fp8x16_to_bf16(V8[sg & 1][k], lo, hi);
                        *(LAS u32x4*)(stg + k * P10_VROW + lane * 32) = lo;
                        *(LAS u32x4*)(stg + k * P10_VROW + lane * 32 + 16) = hi;
                    }
                    float a4[4];
#pragma unroll
                    for (int k = 0; k < 4; ++k) {
                        const int p = 4 * sg + k;
                        const float actk = __int_as_float(__builtin_amdgcn_readlane(actv, 16 * (p >> 2) + p));
                        const int slot = __builtin_amdgcn_readlane(wv, j0 + p) >> 14;
                        a4[k] = (slot == (lane & 3)) ? actk : 0.f;
                    }
                    const u32x2 apk = (u32x2){cvt_pk_bf16(a4[0], a4[1]), cvt_pk_bf16(a4[2], a4[3])};
                    s16x4 Aop; __builtin_memcpy(&Aop, &apk, 8);
                    LAS const unsigned char* tb = stg + ((lane & 15) >> 2) * P10_VROW + ((lane >> 4) * 16 + (lane & 3) * 4) * 2;
#pragma unroll
                    for (int c = 0; c < 16; ++c) {
                        const s16x4 Bop = __builtin_amdgcn_ds_read_tr16_b64_v4i16((LAS s16x4*)(tb + c * 128));
                        acc[c] = __builtin_amdgcn_mfma_f32_4x4x4bf16_1k(Aop, Bop, acc[c], 0, 0, 0);
                    }
                }
            }
        }
        float x1v[PK][16];
#pragma unroll
        for (int k = 0; k < PK; ++k) {
            const int m = tok0 + w + 8 * (kbase + (k < nk ? k : 0));
#pragma unroll
            for (int c = 0; c < 16; ++c) x1v[k][c] = F.T1[(size_t)m * D + c * 64 + lane];
        }
#pragma unroll
        for (int k = 0; k < PK; ++k) {
            if (k >= nk) continue;
            const int m = tok0 + w + 8 * (kbase + k);
            const float* mr = F.MOD + (size_t)mod_row(m) * 6144 + 5120;
            float tv[16]; float s = 0.f;
#pragma unroll
            for (int c = 0; c < 16; ++c) { const float t = x1v[k][c] * DN_ALPHA + mr[c * 64 + lane] * acc[c][k]; tv[c] = t; s += t; }
            const float mean = wave_sum(s) * (1.f / D);
            float q = 0.f;
#pragma unroll
            for (int c = 0; c < 16; ++c) { tv[c] -= mean; q += tv[c] * tv[c]; }
            const float rstd = rsqrtf(wave_sum(q) * (1.f / D) + LN_EPS);
            float* yo = (m < NTP) ? F.out + O_YP + (size_t)m * D : F.out + O_YS + (size_t)(m - NTP) * D;
#pragma unroll
            for (int c = 0; c < 16; ++c) yo[c * 64 + lane] = tv[c] * rstd * F.ln2_g[c * 64 + lane] + F.ln2_b[c * 64 + lane];
        }
    }
  }
}

constexpr int N_PHASES = 11;
__global__ void __launch_bounds__(NTHREADS, 2) fwd_kernel(Args args) {
    extern __shared__ __attribute__((aligned(16))) unsigned char lds_raw[];
    Frame F;
    F.lds = (LAS unsigned char*)lds_raw;
    F.tid = threadIdx.x; F.lane = F.tid & 63; F.wave = __builtin_amdgcn_readfirstlane(F.tid >> 6); F.G = gridDim.x; F.bid = blockIdx.x;
    F.x_p = (const float*)args.in[0]; F.x_s = (const float*)args.in[1]; F.c_p = (const float*)args.in[2]; F.c_s = (const float*)args.in[3];
    F.cache_k = (const float*)args.in[4]; F.cache_v = (const float*)args.in[5]; F.cache_ki = (const float*)args.in[6]; F.state_conv = (const float*)args.in[7];
    F.page_table = (const int*)args.in[8]; F.rel_bias = (const float*)args.in[9]; F.w_ada = (const float*)args.in[10]; F.b_ada = (const float*)args.in[11];
    F.w_in = (const float*)args.in[12]; F.conv_w = (const float*)args.in[13]; F.conv_b = (const float*)args.in[14]; F.w_o_attn = (const float*)args.in[15];
    F.w_o_conv = (const float*)args.in[16]; F.w_out = (const float*)args.in[17]; F.ln1_g = (const float*)args.in[18]; F.ln1_b = (const float*)args.in[19];
    F.ln2_g = (const float*)args.in[20]; F.ln2_b = (const float*)args.in[21]; F.peer_wq = (const float*)args.in[22]; F.peer_k1 = (const float*)args.in[23];
    F.peer_k2 = (const float*)args.in[24]; F.peer_u = (const float*)args.in[25]; F.peer_v = (const float*)args.in[26];
    F.out = args.out;
    unsigned char* ws = args.ws; F.ws = ws;
    F.MOD = (float*)(ws + WS_MOD); F.WIN = (bf16_t*)(ws + WS_WIN); F.WOA = (bf16_t*)(ws + WS_WOA); F.WOC = (bf16_t*)(ws + WS_WOC);
    F.WOUT = (bf16_t*)(ws + WS_WOUT); F.WQ = (bf16_t*)(ws + WS_WQ); F.K1 = (bf16_t*)(ws + WS_K1); F.K2 = (bf16_t*)(ws + WS_K2);
    F.PU = (bf16_t*)(ws + WS_PU); F.PV = (bf16_t*)(ws + WS_PV); F.H1 = (bf16_t*)(ws + WS_H1); F.PROJ = (bf16_t*)(ws + WS_PROJ);
    F.WI = (float*)(ws + WS_WI); F.SEL = (int*)(ws + WS_SEL); F.OATT = (bf16_t*)(ws + WS_OATT); F.OCONV = (bf16_t*)(ws + WS_OCONV);
    F.MERGED = (bf16_t*)(ws + WS_MERGED); F.T1 = (float*)(ws + WS_T1); F.H2 = (bf16_t*)(ws + WS_H2); F.QP = (bf16_t*)(ws + WS_QP);
    F.EIDX = (int*)(ws + WS_EIDX); F.GW = (float*)(ws + WS_GW);
    volatile LAS unsigned* misc = (volatile LAS unsigned*)(F.lds + LDS_MISC);
    if (F.tid < 16) misc[F.tid] = 0u;
    __syncthreads();
    XcdBarrier bar; bar.bar = (unsigned*)(ws + WS_CTL); bar.x = 0; bar.st = misc;
    const int lo = args.ph_lo, hi = args.ph_hi;
    if (hi - lo > 1) bar = xcd_barrier_post((unsigned*)(ws + WS_CTL), misc);
#define IN(k) (lo <= (k) && (k) < hi)
#define SEAM(k) do { if (IN(k) && IN((k) + 1)) xcd_barrier(bar); } while (0)
    if (IN(0)) p0_prologue(F);       SEAM(0);
    if (IN(1)) p1_modulate(F);       SEAM(1);
    if (IN(2)) p2_gemm_in(F);        SEAM(2);
    if (IN(3)) p3_index(F);          SEAM(3);
    if (IN(4)) p4_attention(F);      SEAM(4);
    if (IN(5)) p5_gemm_merge(F);     SEAM(5);
    if (IN(6)) p6_gemm_out(F);       SEAM(6);
    if (IN(7)) p7_ln1(F);            SEAM(7);
    if (IN(8)) p8_gemm_q(F);         SEAM(8);
    if (IN(9)) p9_route(F);          SEAM(9);
    if (IN(10)) p10_peer(F);
#undef IN
#undef SEAM
}

extern "C" void kernel_launch(void* const* d_in, const int* in_sizes, int n_in, void* d_out, int out_size, void* d_ws, size_t ws_size, hipStream_t stream) {
    static int grid = 0;
    if (grid == 0) {
        if (n_in != 27 || (size_t)out_size != O_END || ws_size < WS_END) { fprintf(stderr, "kernel_launch: unexpected shapes (n_in %d out %d ws %zu)\n", n_in, out_size, ws_size); grid = -1; return; }
        int dev = 0, cus = 0;
        if (hipGetDevice(&dev) != hipSuccess || hipDeviceGetAttribute(&cus, hipDeviceAttributeMultiprocessorCount, dev) != hipSuccess) { grid = -1; return; }
        if (hipFuncSetAttribute((const void*)fwd_kernel, hipFuncAttributeMaxDynamicSharedMemorySize, LDS_BYTES) != hipSuccess) { fprintf(stderr, "kernel_launch: hipFuncSetAttribute failed\n"); grid = -1; return; }
        (void)hipGetLastError();
        grid = cus < 256 ? cus : 256;
    }
    if (grid < 0) return;
    (void)hipMemsetAsync((char*)d_ws + WS_CTL, 0, CTL_ZERO_BYTES, stream);
    Args a{};
    for (int i = 0; i < 27; ++i) a.in[i] = d_in[i];
    a.out = (float*)d_out; a.ws = (unsigned char*)d_ws;
#if N_LAUNCHES == 1
    a.ph_lo = 0; a.ph_hi = N_PHASES;
    hipLaunchKernelGGL(fwd_kernel, dim3(grid), dim3(NTHREADS), LDS_BYTES, stream, a);
#else
    for (int p = 0; p < N_PHASES; ++p) { a.ph_lo = p; a.ph_hi = p + 1; hipLaunchKernelGGL(fwd_kernel, dim3(grid), dim3(NTHREADS), LDS_BYTES, stream, a); }
#endif
}
```

```cpp
#include <hip/hip_runtime.h>
#include <cstdio>
#include <cstdint>

#ifndef N_LAUNCHES
#define N_LAUNCHES 1
#endif

typedef unsigned short bf16_t;
typedef short bf16x8 __attribute__((ext_vector_type(8)));
typedef float f32x4 __attribute__((ext_vector_type(4)));
typedef float f32x16 __attribute__((ext_vector_type(16)));
typedef unsigned u32x4 __attribute__((ext_vector_type(4)));
typedef unsigned u32x2 __attribute__((ext_vector_type(2)));
#define LAS __attribute__((address_space(3)))

constexpr int D = 1024, NB_P = 8, SEQ = 2048, NB_S = 32, TS = 8, PAST = 8192, PAGE = 128, NPAGES = 64;
constexpr int NTP = NB_P * SEQ;
constexpr int NTS = NB_S * TS;
constexpr int NT = NTP + NTS;
constexpr int NMIX = 4676, NMIXP = 4736;
constexpr int C_Q = 0, C_K = 512, C_V = 640, C_QI = 768, C_KI = 1024, C_BG = 1088, C_CG = 1600, C_XIN = 2112, C_GA = 2624, C_GB = 3648, C_WI = 4672;
constexpr int NSEL = 256;
constexpr float ATTN_SCALE = 0.125f, IDX_SCALE = 0.0625f;
constexpr float DN_ALPHA = 1.189207115002721f, LN_EPS = 1e-5f;
constexpr int NEXP_SEL = 128;

constexpr size_t O_YP = 0, O_YS = 16777216, O_KP = 17039360, O_VP = 19136512, O_KIP = 21233664, O_CP = 22282240,
                 O_KS = 22290432, O_VS = 22323200, O_KIS = 22355968, O_CS = 22372352, O_END = 22405120;

constexpr size_t MB = 1048576;
constexpr size_t WS_CTL = 0, WS_MOD = 1 * MB, WS_WIN = 2 * MB, WS_WOA = 12 * MB, WS_WOC = 13 * MB, WS_WOUT = 14 * MB, WS_WQ = 16 * MB,
                 WS_K1 = 18 * MB, WS_K2 = 18 * MB + 65536, WS_PU = 20 * MB, WS_PV = 52 * MB, WS_H1 = 84 * MB, WS_PROJ = 118 * MB,
                 WS_WI = 270 * MB, WS_SEL = 271 * MB, WS_OATT = 288 * MB, WS_OCONV = 305 * MB, WS_MERGED = 322 * MB, WS_T1 = 355 * MB,
                 WS_H2 = 420 * MB, WS_QP = 453 * MB, WS_EIDX = 486 * MB, WS_GW = 495 * MB, WS_SS = 504 * MB, WS_SE = 513 * MB, WS_SG = 523 * MB, WS_VT = 533 * MB, WS_CGX = 538 * MB, WS_END = 539 * MB;
constexpr size_t WS_PU8 = WS_PU, WS_PV8 = WS_PU + 16 * MB, WS_SU = WS_PV, WS_SV = WS_PV + 65536, WS_H8 = WS_PV + 1 * MB, WS_SH = WS_PV + 20 * MB;
constexpr int CTL_ZERO_BYTES = 65536;

constexpr int NTHREADS = 512;
constexpr int LDS_BYTES = 160 * 1024 - 512;
constexpr int LDS_MISC = LDS_BYTES - 64;

__device__ __forceinline__ float bf2f(bf16_t b) { return __uint_as_float(((unsigned)b) << 16); }
__device__ __forceinline__ float bflo(unsigned p) { return __uint_as_float(p << 16); }
__device__ __forceinline__ float bfhi(unsigned p) { return __uint_as_float(p & 0xFFFF0000u); }
typedef __bf16 bf16x2_t __attribute__((ext_vector_type(2)));
typedef float f32x2_t __attribute__((ext_vector_type(2)));
__device__ __forceinline__ unsigned cvt_pk_bf16(float lo, float hi) { const f32x2_t f = {lo, hi}; const bf16x2_t b = __builtin_convertvector(f, bf16x2_t); unsigned r; __builtin_memcpy(&r, &b, 4); return r; }
__device__ __forceinline__ bf16_t f2bf(float f) { return (bf16_t)(cvt_pk_bf16(f, 0.f) & 0xFFFFu); }
__device__ __forceinline__ float wave_sum(float v) {
#pragma unroll
    for (int o = 32; o >= 1; o >>= 1) v += __shfl_xor(v, o);
    return v;
}
__device__ __forceinline__ float wave_sum_dpp(float v) {
    int x;
    x = __builtin_amdgcn_update_dpp(0, __float_as_int(v), 0xB1, 0xF, 0xF, false);  v += __int_as_float(x);
    x = __builtin_amdgcn_update_dpp(0, __float_as_int(v), 0x4E, 0xF, 0xF, false);  v += __int_as_float(x);
    x = __builtin_amdgcn_update_dpp(0, __float_as_int(v), 0x141, 0xF, 0xF, false); v += __int_as_float(x);
    x = __builtin_amdgcn_update_dpp(0, __float_as_int(v), 0x140, 0xF, 0xF, false); v += __int_as_float(x);
    x = __builtin_amdgcn_update_dpp(0, __float_as_int(v), 0x142, 0xA, 0xF, false); v += __int_as_float(x);
    x = __builtin_amdgcn_update_dpp(0, __float_as_int(v), 0x143, 0xC, 0xF, false); v += __int_as_float(x);
    return __int_as_float(__builtin_amdgcn_readlane(__float_as_int(v), 63));
}
__device__ __forceinline__ float wave_max(float v) {
#pragma unroll
    for (int o = 32; o >= 1; o >>= 1) v = fmaxf(v, __shfl_xor(v, o));
    return v;
}
__device__ __forceinline__ float sigmoidf_(float x) { return 1.f / (1.f + __expf(-x)); }
__device__ __forceinline__ float gelu_tanh(float a) {
    const float z = 0.7978845608028654f * (a + 0.044715f * a * a * a);
    const float e = __expf(2.f * z);
    const float t = 1.f - 2.f * __builtin_amdgcn_rcpf(e + 1.f);
    return 0.5f * a * (1.f + t);
}
__device__ __forceinline__ unsigned f2ord(float f) { const unsigned u = __float_as_uint(f); return (u & 0x80000000u) ? ~u : (u | 0x80000000u); }
__device__ __forceinline__ int t5_bucket(int n) {
    if (n < 16) return n;
    int b = 16;
    b += (n >= 19) + (n >= 21) + (n >= 24) + (n >= 27) + (n >= 31) + (n >= 35) + (n >= 40) + (n >= 46) + (n >= 52) + (n >= 59) + (n >= 67) + (n >= 77) + (n >= 87) + (n >= 99) + (n >= 113);
    return b;
}

#define XB_TMO      128
#define XB_XCNT(j)  (256  + 64 * (j))
#define XB_XSUB(j)  (1280 + 64 * (j))
#define XB_XGEN(j)  (2304 + 64 * (j))
#define XB_TOP      3328
#define XB_TOPGEN   3392
#define XCD_BAR_WORDS 3456
#define XB_SPIN_CAP (1u << 18)
__device__ __forceinline__ unsigned xb_ld(unsigned* p)              { return __hip_atomic_load(p, __ATOMIC_RELAXED, __HIP_MEMORY_SCOPE_AGENT); }
__device__ __forceinline__ unsigned xb_add(unsigned* p, unsigned v) { return __hip_atomic_fetch_add(p, v, __ATOMIC_RELAXED, __HIP_MEMORY_SCOPE_AGENT); }
__device__ __forceinline__ unsigned xb_xcc_id() { return (unsigned)__builtin_amdgcn_s_getreg((3 << 11) | 20) & 0xFu; }
#define XB_SPIN(cond, bar) do { unsigned _sp = 0; while (cond) { __builtin_amdgcn_s_sleep(1); \
    if ((++_sp & 255u) == 0u) { if (xb_ld(&(bar)[XB_TMO])) break; if (_sp > XB_SPIN_CAP) { atomicAdd(&(bar)[XB_TMO], 1u); break; } } } } while (0)
struct XcdBarrier { unsigned* bar; unsigned x; volatile LAS unsigned* st; };
__device__ __forceinline__ XcdBarrier xcd_barrier_post(unsigned* bar, volatile LAS unsigned* st) {
    XcdBarrier b; b.bar = bar; b.x = xb_xcc_id(); b.st = st;
    if (threadIdx.x == 0) (void)xb_add(&bar[XB_XCNT(b.x)], 1u);
    return b;
}
__device__ __forceinline__ void xcd_barrier_complete(unsigned* bar, unsigned x, unsigned& nloc, unsigned& nx) {
    const unsigned G = gridDim.x * gridDim.y * gridDim.z;
    unsigned sum, cnt, mine, sp = 0u;
    for (;;) {
        sum = 0u; cnt = 0u; mine = 0u;
#pragma unroll
        for (unsigned j = 0; j < 16; ++j) { const unsigned c = xb_ld(&bar[XB_XCNT(j)]); sum += c; cnt += (c > 0u) ? 1u : 0u; mine = (j == x) ? c : mine; }
        if (sum == G) break;
        __builtin_amdgcn_s_sleep(1);
        if ((++sp & 255u) == 0u) { if (xb_ld(&bar[XB_TMO])) break; if (sp > XB_SPIN_CAP) { atomicAdd(&bar[XB_TMO], 1u); break; } }
    }
    nloc = mine > 0u ? mine : 1u; nx = cnt > 0u ? cnt : 1u;
}
__device__ __forceinline__ void xcd_barrier(const XcdBarrier& b) {
    asm volatile("s_waitcnt vmcnt(0)" ::: "memory");
    __syncthreads();
    if (threadIdx.x == 0) {
        unsigned* bar = b.bar;
        __builtin_amdgcn_s_waitcnt(0);
        unsigned nloc = b.st[0], nx = b.st[1];
        if (nloc == 0u) { xcd_barrier_complete(bar, b.x, nloc, nx); b.st[0] = nloc; b.st[1] = nx; }
        const unsigned old = xb_add(&bar[XB_XSUB(b.x)], 1u);
        const unsigned gen = old / nloc;
        if (old + 1u == (gen + 1u) * nloc) {
            __builtin_amdgcn_fence(__ATOMIC_RELEASE, "agent");
            asm volatile("s_waitcnt vmcnt(0)" ::: "memory");
            const unsigned og = xb_add(&bar[XB_TOP], 1u);
            const unsigned tg = og / nx;
            if (og + 1u == (tg + 1u) * nx) xb_add(&bar[XB_TOPGEN], 1u);
            else XB_SPIN(xb_ld(&bar[XB_TOPGEN]) == tg, bar);
            __builtin_amdgcn_fence(__ATOMIC_ACQUIRE, "agent");
            xb_add(&bar[XB_XGEN(b.x)], 1u);
            asm volatile("s_waitcnt vmcnt(0)" ::: "memory");
        } else {
            XB_SPIN(xb_ld(&bar[XB_XGEN(b.x)]) == gen, bar);
            __builtin_amdgcn_fence(__ATOMIC_ACQUIRE, "agent");
            asm volatile("s_waitcnt vmcnt(0)" ::: "memory");
        }
    }
    __syncthreads();
}

struct Args { const void* in[27]; float* out; unsigned char* ws; int ph_lo, ph_hi; };
struct Core { LAS unsigned char* lds; int tid, lane, wave, G, bid; };
struct Frame {
    LAS unsigned char* lds;
    int tid, lane, wave, G, bid;
    const float *x_p, *x_s, *c_p, *c_s, *cache_k, *cache_v, *cache_ki, *state_conv, *rel_bias, *w_ada, *b_ada, *w_in, *conv_w, *conv_b,
                *w_o_attn, *w_o_conv, *w_out, *ln1_g, *ln1_b, *ln2_g, *ln2_b, *peer_wq, *peer_k1, *peer_k2, *peer_u, *peer_v;
    const int* page_table;
    float* out; unsigned char* ws;
    float* MOD; bf16_t *WIN, *WOA, *WOC, *WOUT, *WQ, *K1, *K2, *PU, *PV, *H1, *PROJ, *OATT, *OCONV, *MERGED, *H2, *QP;
    float *WI, *T1, *GW; int *SEL, *EIDX;
};
constexpr int LDS_PTAB = LDS_BYTES - 512;
__device__ __forceinline__ unsigned char* ldptr(const Core& C, int k) {
    LAS const unsigned* p = (LAS const unsigned*)(C.lds + LDS_PTAB) + 2 * k;
    const unsigned lo = __builtin_amdgcn_readfirstlane(p[0]), hi = __builtin_amdgcn_readfirstlane(p[1]);
    return (unsigned char*)(((unsigned long long)hi << 32) | (unsigned long long)lo);
}
__device__ __forceinline__ void load_frame(Frame& F, const Core& C) {
    F.lds = C.lds; F.tid = C.tid; F.lane = C.lane; F.wave = C.wave; F.G = C.G; F.bid = C.bid;
    F.x_p = (const float*)ldptr(C, 0); F.x_s = (const float*)ldptr(C, 1); F.c_p = (const float*)ldptr(C, 2); F.c_s = (const float*)ldptr(C, 3);
    F.cache_k = (const float*)ldptr(C, 4); F.cache_v = (const float*)ldptr(C, 5); F.cache_ki = (const float*)ldptr(C, 6); F.state_conv = (const float*)ldptr(C, 7);
    F.page_table = (const int*)ldptr(C, 8); F.rel_bias = (const float*)ldptr(C, 9); F.w_ada = (const float*)ldptr(C, 10); F.b_ada = (const float*)ldptr(C, 11);
    F.w_in = (const float*)ldptr(C, 12); F.conv_w = (const float*)ldptr(C, 13); F.conv_b = (const float*)ldptr(C, 14); F.w_o_attn = (const float*)ldptr(C, 15);
    F.w_o_conv = (const float*)ldptr(C, 16); F.w_out = (const float*)ldptr(C, 17); F.ln1_g = (const float*)ldptr(C, 18); F.ln1_b = (const float*)ldptr(C, 19);
    F.ln2_g = (const float*)ldptr(C, 20); F.ln2_b = (const float*)ldptr(C, 21); F.peer_wq = (const float*)ldptr(C, 22); F.peer_k1 = (const float*)ldptr(C, 23);
    F.peer_k2 = (const float*)ldptr(C, 24); F.peer_u = (const float*)ldptr(C, 25); F.peer_v = (const float*)ldptr(C, 26);
    F.out = (float*)ldptr(C, 27);
    unsigned char* ws = ldptr(C, 28);
    F.MOD = (float*)(ws + WS_MOD); F.WIN = (bf16_t*)(ws + WS_WIN); F.WOA = (bf16_t*)(ws + WS_WOA); F.WOC = (bf16_t*)(ws + WS_WOC);
    F.WOUT = (bf16_t*)(ws + WS_WOUT); F.WQ = (bf16_t*)(ws + WS_WQ); F.K1 = (bf16_t*)(ws + WS_K1); F.K2 = (bf16_t*)(ws + WS_K2);
    F.PU = (bf16_t*)(ws + WS_PU); F.PV = (bf16_t*)(ws + WS_PV); F.H1 = (bf16_t*)(ws + WS_H1); F.PROJ = (bf16_t*)(ws + WS_PROJ);
    F.WI = (float*)(ws + WS_WI); F.SEL = (int*)(ws + WS_SEL); F.OATT = (bf16_t*)(ws + WS_OATT); F.OCONV = (bf16_t*)(ws + WS_OCONV);
    F.MERGED = (bf16_t*)(ws + WS_MERGED); F.T1 = (float*)(ws + WS_T1); F.H2 = (bf16_t*)(ws + WS_H2); F.QP = (bf16_t*)(ws + WS_QP);
    F.EIDX = (int*)(ws + WS_EIDX); F.GW = (float*)(ws + WS_GW);
}
__device__ __forceinline__ const float* x_row(const Frame& F, int m) { return m < NTP ? F.x_p + (size_t)m * D : F.x_s + (size_t)(m - NTP) * D; }
__device__ __forceinline__ int mod_row(int m) { return m < NTP ? (m >> 11) : NB_P + ((m - NTP) >> 3); }

constexpr int P0_MOD_ITEMS = 96;
constexpr int P0_T_WIN = 16 * 74, P0_T_WOA = 8 * 16, P0_T_WOC = 8 * 16, P0_T_WOUT = 16 * 16, P0_T_WQ = 16 * 16;
constexpr int P0_T_ITEMS = P0_T_WIN + P0_T_WOA + P0_T_WOC + P0_T_WOUT + P0_T_WQ;
constexpr int P0_CVT_ITEMS = 2 * (16384 * 1024 / 8192);
constexpr int P0_MISC_ITEMS = 1;
constexpr int P0_ITEMS = P0_MOD_ITEMS + P0_T_ITEMS + P0_CVT_ITEMS + P0_MISC_ITEMS;

__device__ __forceinline__ void p0_mod_item(const Frame& F, int ng) {
    LAS float* cs = (LAS float*)F.lds;
    LAS float* red = (LAS float*)(F.lds + 40 * 256 * 4);
    float acc[40];
#pragma unroll
    for (int r = 0; r < 40; ++r) acc[r] = 0.f;
    const int n = ng * 64 + F.lane;
    for (int kc = 0; kc < 4; ++kc) {
        __syncthreads();
#pragma unroll 1
        for (int hb = 0; hb < 2; ++hb) {
            float cv[10];
#pragma unroll
            for (int i = 0; i < 10; ++i) { const int e = F.tid + (hb * 10 + i) * NTHREADS; const int r = e >> 8, k = e & 255; cv[i] = (r < 8) ? F.c_p[r * D + kc * 256 + k] : F.c_s[(r - 8) * D + kc * 256 + k]; }
#pragma unroll
            for (int i = 0; i < 10; ++i) cs[F.tid + (hb * 10 + i) * NTHREADS] = cv[i];
        }
        __syncthreads();
        float wvv[32];
#pragma unroll
        for (int kk = 0; kk < 32; ++kk) wvv[kk] = F.w_ada[(size_t)(kc * 256 + F.wave * 32 + kk) * 6144 + n];
#pragma unroll
        for (int kk = 0; kk < 32; ++kk) {
            const int kl = F.wave * 32 + kk;
#pragma unroll
            for (int r = 0; r < 40; ++r) acc[r] += cs[r * 256 + kl] * wvv[kk];
        }
    }
#pragma unroll
    for (int r = 0; r < 40; ++r) red[(F.wave * 40 + r) * 64 + F.lane] = acc[r];
    __syncthreads();
    for (int e = F.tid; e < 40 * 64; e += NTHREADS) {
        const int r = e >> 6, l = e & 63; float s = F.b_ada[ng * 64 + l];
#pragma unroll
        for (int w = 0; w < 8; ++w) s += red[(w * 40 + r) * 64 + l];
        F.MOD[r * 6144 + ng * 64 + l] = s;
    }
    __syncthreads();
}
__device__ __forceinline__ void p0_transpose_tile(const Frame& F, const float* W, int N, int K, bf16_t* Wt, int kt, int nt, bool permute) {
    LAS bf16_t* tile = (LAS bf16_t*)F.lds;
    __syncthreads();
    { const int k = F.tid >> 3, c0 = (F.tid & 7) * 8;
      const float* rp = W + (size_t)(kt * 64 + k) * N + nt * 64 + c0;
      const f32x4 z = {0.f, 0.f, 0.f, 0.f};
      const f32x4 v0 = (nt * 64 + c0 < N) ? *(const f32x4*)rp : z, v1 = (nt * 64 + c0 + 4 < N) ? *(const f32x4*)(rp + 4) : z;
#pragma unroll
      for (int j = 0; j < 4; ++j) { tile[k * 66 + c0 + j] = f2bf(v0[j]); tile[k * 66 + c0 + 4 + j] = f2bf(v1[j]); } }
    __syncthreads();
    { const int nl = F.tid >> 3, k0 = (F.tid & 7) * 8; const int n = nt * 64 + nl;
      if (n < N) {
          int nd = n; if (permute) nd = (n < 1024) ? n : (n < 1028 ? C_WI + (n - 1024) : n - 4);
          unsigned p[4];
#pragma unroll
          for (int j = 0; j < 4; ++j) p[j] = (unsigned)tile[(k0 + 2 * j) * 66 + nl] | ((unsigned)tile[(k0 + 2 * j + 1) * 66 + nl] << 16);
          *(u32x4*)(Wt + (size_t)nd * K + kt * 64 + k0) = (u32x4){p[0], p[1], p[2], p[3]};
      } }
}
constexpr int P0_CVT32_ITEMS = 2 * (16384 / 32);
constexpr int P0_OTHER = P0_T_ITEMS + P0_CVT32_ITEMS + 1;
__device__ __forceinline__ void p0_other_item(const Frame& F, int i) {
    if (i < P0_T_ITEMS) {
        if (i < P0_T_WIN) { p0_transpose_tile(F, F.w_in, NMIX, D, F.WIN, i / 74, i % 74, true); return; }
        i -= P0_T_WIN;
        if (i < P0_T_WOA) { p0_transpose_tile(F, F.w_o_attn, D, 512, F.WOA, i / 16, i % 16, false); return; }
        i -= P0_T_WOA;
        if (i < P0_T_WOC) { p0_transpose_tile(F, F.w_o_conv, D, 512, F.WOC, i / 16, i % 16, false); return; }
        i -= P0_T_WOC;
        if (i < P0_T_WOUT) { p0_transpose_tile(F, F.w_out, D, D, F.WOUT, i / 16, i % 16, false); return; }
        i -= P0_T_WOUT;
        p0_transpose_tile(F, F.peer_wq, D, D, F.WQ, i / 16, i % 16, false); return;
    }
    i -= P0_T_ITEMS;
    if (i < P0_CVT32_ITEMS) {
        const bool isu = i < 512;
        const float* src = isu ? F.peer_u : F.peer_v;
        unsigned char* dst = F.ws + (isu ? WS_PU8 : WS_PV8); float* sinv = (float*)(F.ws + (isu ? WS_SU : WS_SV));
        const int row0 = (i & 511) * 32 + F.wave * 4;
        float v[4][16];
        if (isu) {
#pragma unroll
            for (int rr = 0; rr < 4; ++rr)
#pragma unroll
                for (int q = 0; q < 4; ++q) {
                    const f32x4 t = *(const f32x4*)(src + (size_t)(row0 + rr) * D + F.lane * 16 + q * 4);
                    v[rr][4 * q] = t[0]; v[rr][4 * q + 1] = t[1]; v[rr][4 * q + 2] = t[2]; v[rr][4 * q + 3] = t[3];
                }
        } else {
#pragma unroll
            for (int rr = 0; rr < 4; ++rr)
#pragma unroll
                for (int c = 0; c < 16; ++c) v[rr][c] = src[(size_t)(row0 + rr) * D + c * 64 + F.lane];
        }
#pragma unroll
        for (int rr = 0; rr < 4; ++rr) {
            float am = 0.f;
#pragma unroll
            for (int c = 0; c < 16; ++c) am = fmaxf(am, fabsf(v[rr][c]));
            am = wave_max(am);
            const float sc = am > 0.f ? 6.f / am : 1.f;
            unsigned w0 = 0u, w1 = 0u;
            w0 = __builtin_amdgcn_cvt_scalef32_pk_fp4_f32(w0, v[rr][0] * sc, v[rr][1] * sc, 1.0f, 0);
            w0 = __builtin_amdgcn_cvt_scalef32_pk_fp4_f32(w0, v[rr][2] * sc, v[rr][3] * sc, 1.0f, 1);
            w0 = __builtin_amdgcn_cvt_scalef32_pk_fp4_f32(w0, v[rr][4] * sc, v[rr][5] * sc, 1.0f, 2);
            w0 = __builtin_amdgcn_cvt_scalef32_pk_fp4_f32(w0, v[rr][6] * sc, v[rr][7] * sc, 1.0f, 3);
            w1 = __builtin_amdgcn_cvt_scalef32_pk_fp4_f32(w1, v[rr][8] * sc, v[rr][9] * sc, 1.0f, 0);
            w1 = __builtin_amdgcn_cvt_scalef32_pk_fp4_f32(w1, v[rr][10] * sc, v[rr][11] * sc, 1.0f, 1);
            w1 = __builtin_amdgcn_cvt_scalef32_pk_fp4_f32(w1, v[rr][12] * sc, v[rr][13] * sc, 1.0f, 2);
            w1 = __builtin_amdgcn_cvt_scalef32_pk_fp4_f32(w1, v[rr][14] * sc, v[rr][15] * sc, 1.0f, 3);
            *(u32x2*)(dst + (size_t)(row0 + rr) * 512 + F.lane * 8) = (u32x2){w0, w1};
            if (F.lane == 0) sinv[row0 + rr] = am > 0.f ? am * (1.f / 6.f) : 1.f;
        }
        return;
    }
    for (int e = F.tid; e < (4864 - NMIX) * D; e += NTHREADS) F.WIN[(size_t)NMIX * D + e] = 0;
    for (int e = F.tid; e < 128 * 64; e += NTHREADS) { F.K1[e] = f2bf(F.peer_k1[e]); F.K2[e] = f2bf(F.peer_k2[e]); }
}
__device__ __forceinline__ void p0_prologue(const Frame& F) {
    constexpr int NMODWG = P0_MOD_ITEMS, HEAD = 8;
    if (F.G <= NMODWG) {
        for (int it = F.bid; it < P0_MOD_ITEMS + P0_OTHER; it += F.G) { if (it < P0_MOD_ITEMS) p0_mod_item(F, it); else p0_other_item(F, it - P0_MOD_ITEMS); }
        return;
    }
    const int nfree = F.G - NMODWG;
    int head_items = HEAD * nfree; if (head_items > P0_OTHER) head_items = P0_OTHER;
    if (F.bid < NMODWG) p0_mod_item(F, F.bid);
    else for (int j = F.bid - NMODWG; j < head_items; j += nfree) p0_other_item(F, j);
    for (int j = head_items + F.bid; j < P0_OTHER; j += F.G) p0_other_item(F, j);
}

__device__ __forceinline__ void p1_modulate(const Frame& F) {
    const int stride = F.G * 8;
    for (int m0 = F.bid * 8 + F.wave; m0 < NT; m0 += 2 * stride) {
        f32x4 xv[2][4], sv[2][4], hv[2][4];
#pragma unroll
        for (int rr = 0; rr < 2; ++rr) {
            const int m = (m0 + rr * stride < NT) ? m0 + rr * stride : m0;
            const float* xr = x_row(F, m); const float* mr = F.MOD + (size_t)mod_row(m) * 6144;
#pragma unroll
            for (int q = 0; q < 4; ++q) {
                const int e = (q >> 1) * 512 + F.lane * 8 + (q & 1) * 4;
                xv[rr][q] = *(const f32x4*)(xr + e); sv[rr][q] = *(const f32x4*)(mr + 1024 + e); hv[rr][q] = *(const f32x4*)(mr + e);
            }
        }
#pragma unroll
        for (int rr = 0; rr < 2; ++rr) {
            const int m = m0 + rr * stride;
            if (m >= NT) continue;
#pragma unroll
            for (int hlf = 0; hlf < 2; ++hlf) {
                const f32x4 a = xv[rr][2 * hlf] * (sv[rr][2 * hlf] + 1.f) + hv[rr][2 * hlf], b2 = xv[rr][2 * hlf + 1] * (sv[rr][2 * hlf + 1] + 1.f) + hv[rr][2 * hlf + 1];
                *(u32x4*)(F.H1 + (size_t)m * D + hlf * 512 + F.lane * 8) = (u32x4){cvt_pk_bf16(a[0], a[1]), cvt_pk_bf16(a[2], a[3]), cvt_pk_bf16(b2[0], b2[1]), cvt_pk_bf16(b2[2], b2[3])};
            }
        }
    }
}

constexpr int BM = 256, BN = 128, BK = 64;
constexpr int XPANEL = BM * 32 + 32, WPANEL = BN * 32 + 32;
constexpr int XSTAGE = 4 * XPANEL, WSTAGE = 4 * WPANEL, GSTAGE = XSTAGE + WSTAGE;
__device__ __forceinline__ void gemm_accum(const Frame& F, f32x16 (&acc)[2][2], const bf16_t* __restrict__ X, int ldx, const bf16_t* __restrict__ W, int ldw, int K, int m0, int n0) {
    const int tid = F.tid, lane = F.lane, r = lane & 31, h = lane >> 5, wm = F.wave >> 1, wn = F.wave & 1;
    u32x4 xr[4], wr[2];
    const int nk = K / BK;
    const int crow = tid >> 3, ckc = tid & 7;
    const bf16_t* xg = X + (size_t)(m0 + crow) * ldx + ckc * 8;
    const bf16_t* wg = W + (size_t)(n0 + crow) * ldw + ckc * 8;
    const int ldso = (ckc >> 1) * 1  ;
    const int xoff = ldso * XPANEL + crow * 32 + (ckc & 1) * 16;
    const int woff = ldso * WPANEL + crow * 32 + (ckc & 1) * 16;
#pragma unroll
    for (int i = 0; i < 4; ++i) xr[i] = *(const u32x4*)(xg + (size_t)(64 * i) * ldx);
#pragma unroll
    for (int i = 0; i < 2; ++i) wr[i] = *(const u32x4*)(wg + (size_t)(64 * i) * ldw);
    __syncthreads();
    for (int kt = 0; kt < nk; ++kt) {
        LAS unsigned char* st = F.lds + (kt & 1) * GSTAGE;
#pragma unroll
        for (int i = 0; i < 4; ++i) *(LAS u32x4*)(st + xoff + i * 64 * 32) = xr[i];
#pragma unroll
        for (int i = 0; i < 2; ++i) *(LAS u32x4*)(st + XSTAGE + woff + i * 64 * 32) = wr[i];
        __syncthreads();
        if (kt + 1 < nk) {
#pragma unroll
            for (int i = 0; i < 4; ++i) xr[i] = *(const u32x4*)(xg + (size_t)(64 * i) * ldx + (kt + 1) * BK);
#pragma unroll
            for (int i = 0; i < 2; ++i) wr[i] = *(const u32x4*)(wg + (size_t)(64 * i) * ldw + (kt + 1) * BK);
        }
#pragma unroll
        for (int s = 0; s < 4; ++s) {
            bf16x8 a[2], b[2];
#pragma unroll
            for (int ni = 0; ni < 2; ++ni) a[ni] = *(LAS bf16x8*)(st + XSTAGE + s * WPANEL + (wn * 64 + ni * 32 + r) * 32 + h * 16);
#pragma unroll
            for (int mi = 0; mi < 2; ++mi) b[mi] = *(LAS bf16x8*)(st + s * XPANEL + (wm * 64 + mi * 32 + r) * 32 + h * 16);
#pragma unroll
            for (int mi = 0; mi < 2; ++mi)
#pragma unroll
                for (int ni = 0; ni < 2; ++ni) acc[mi][ni] = __builtin_amdgcn_mfma_f32_32x32x16_bf16(a[ni], b[mi], acc[mi][ni], 0, 0, 0);
        }
    }
}
#define GEMM_EPI_LOOP(...) \
    { const int r_ = F.lane & 31, h_ = F.lane >> 5, wm_ = F.wave >> 1, wn_ = F.wave & 1; \
      _Pragma("unroll") for (int mi = 0; mi < 2; ++mi) _Pragma("unroll") for (int ni = 0; ni < 2; ++ni) _Pragma("unroll") for (int g = 0; g < 4; ++g) { \
          const int m = m0 + wm_ * 64 + mi * 32 + r_; const int n = n0 + wn_ * 64 + ni * 32 + 8 * g + 4 * h_; __VA_ARGS__ } }
#define ACC4(A) ((f32x4){A[mi][ni][4 * g], A[mi][ni][4 * g + 1], A[mi][ni][4 * g + 2], A[mi][ni][4 * g + 3]})
__device__ __forceinline__ void zero_acc(f32x16 (&acc)[2][2]) {
#pragma unroll
    for (int mi = 0; mi < 2; ++mi)
#pragma unroll
        for (int ni = 0; ni < 2; ++ni)
#pragma unroll
            for (int e = 0; e < 16; ++e) acc[mi][ni][e] = 0.f;
}
__device__ __forceinline__ u32x2 pk4(const f32x4 v) { return (u32x2){cvt_pk_bf16(v[0], v[1]), cvt_pk_bf16(v[2], v[3])}; }

__device__ __forceinline__ void gemm_slice8(const Frame& F, f32x16 (&sacc)[1][1], const bf16_t* __restrict__ X, int ldx, const bf16_t* __restrict__ W, int ldw, int K, int m0, int n0) {
    const int r = F.lane & 31, h = F.lane >> 5, wq = F.wave & 3, kh = F.wave >> 2;
    const bf16_t* wp = W + (size_t)(n0 + 32 * wq + r) * ldw + kh * (K / 2) + h * 8;
    const bf16_t* xp = X + (size_t)(m0 + (r & 7)) * ldx + kh * (K / 2) + h * 8;
    f32x16 c;
#pragma unroll
    for (int e = 0; e < 16; ++e) c[e] = 0.f;
#pragma unroll 1
    for (int k0 = 0; k0 < K / 2; k0 += 128) {
        bf16x8 a[8], b[8];
#pragma unroll
        for (int t = 0; t < 8; ++t) { a[t] = *(const bf16x8*)(wp + k0 + t * 16); b[t] = *(const bf16x8*)(xp + k0 + t * 16); }
#pragma unroll
        for (int t = 0; t < 8; ++t) c = __builtin_amdgcn_mfma_f32_32x32x16_bf16(a[t], b[t], c, 0, 0, 0);
    }
    LAS float* cb = (LAS float*)F.lds + wq * (16 * 64);
    __syncthreads();
    if (kh == 1) {
#pragma unroll
        for (int e = 0; e < 16; ++e) cb[e * 64 + F.lane] = c[e];
    }
    __syncthreads();
    if (kh == 0) {
#pragma unroll
        for (int e = 0; e < 16; ++e) c[e] += cb[e * 64 + F.lane];
    }
    sacc[0][0] = c;
}
#define SLICE_EPI_LOOP(...) \
    if (F.wave < 4 && (F.lane & 31) < 8) { const int h_ = F.lane >> 5, wq_ = F.wave & 3; constexpr int mi = 0, ni = 0; \
      _Pragma("unroll") for (int g = 0; g < 4; ++g) { const int m = m0 + (F.lane & 31); const int n = n0 + wq_ * 32 + 8 * g + 4 * h_; __VA_ARGS__ } }

namespace pg8 {
#define PG8_LAS __attribute__((address_space(3)))
typedef unsigned short bf16_t;
typedef short bf16x8 __attribute__((ext_vector_type(8)));
typedef float f32x4 __attribute__((ext_vector_type(4)));
typedef unsigned u32x4 __attribute__((ext_vector_type(4)));
constexpr int BM = 256, BK = 64, HALF = 128, HTB = HALF * BK * 2  , STAGE_BYTES = 8 * HTB, NXCD = 8, WGM = 8;

__host__ __device__ __forceinline__ int lds_byte(int r, int c) { const int st = (r >> 4) * 2 + (c >> 5), rr = r & 15, cc = c & 31, ob = rr * 64 + cc * 2; return st * 1024 + (ob ^ (((ob >> 9) & 1) << 5)); }
__host__ __device__ __forceinline__ void stage_rc(int b, int& R, int& C) { const int st = b / 1024, sb = b % 1024, swz = sb ^ (((sb >> 9) & 1) << 5); R = (st >> 1) * 16 + swz / 64; C = (st & 1) * 32 + (swz % 64) / 2; }
__host__ __device__ __forceinline__ int perm32(int rho) { const int n = rho >> 4, i = rho & 15; return 8 * (i >> 2) + 4 * n + (i & 3); }

struct Unit { int pm, pn; };
struct Gemm { const bf16_t* A; const bf16_t* Bt; int M, N, K; };

struct StaticOrder {
    int nM, nN, nwg, G, c;
    __host__ __device__ void init(int M, int N, int G_, int c_) { nM = M / BM; nN = N / BM; nwg = nM * nN; G = G_; c = c_; }
    __host__ __device__ bool next(int i, Unit& u) const {
        const long L = (long)i * G + c; if (L >= nwg) return false;
        int wgid = (int)L; { const int q = nwg / NXCD, r = nwg % NXCD, xcd = wgid % NXCD, off = wgid / NXCD; wgid = (xcd < r ? xcd * (q + 1) : r * (q + 1) + (xcd - r) * q) + off; }
        const int nig = WGM * nN, gid = wgid / nig, fm = gid * WGM, gsz = (nM - fm) < WGM ? (nM - fm) : WGM;
        u.pm = fm + ((wgid % nig) % gsz); u.pn = (wgid % nig) / gsz; return true;
    }
    __device__ __forceinline__ void a_ready(const Unit&) const {}
    __device__ __forceinline__ void done(const Unit&) const {}
};

template <class Body> struct EpiRC {
    static constexpr bool PERM = false, AFTER_DRAIN = false;
    Body body;
    __device__ __forceinline__ void operator()(const f32x4 (&acc)[2][2][4][2], const Unit& u, int wr, int wc, int fr, int fq) const {
#pragma unroll
        for (int ai = 0; ai < 2; ++ai)
#pragma unroll
            for (int m = 0; m < 4; ++m) {
                const int row = u.pm * BM + ai * HALF + wr * 64 + m * 16 + fr;
#pragma unroll
                for (int bj = 0; bj < 2; ++bj)
#pragma unroll
                    for (int n = 0; n < 2; ++n) body(row, u.pn * BM + bj * HALF + wc * 32 + n * 16 + 4 * fq, acc[ai][bj][m][n]);
            }
    }
};
template <class Epi, class Sched, bool ALIGN_EPI = false, bool SP2 = false>
__device__ __forceinline__ void gemm_phase(PG8_LAS unsigned char* lds, const Gemm g, const Sched& S, const Epi& E) {
    const int tid = threadIdx.x, wid = __builtin_amdgcn_readfirstlane(tid >> 6), lane = tid & 63, wr = wid >> 2, wc = wid & 3, fr = lane & 15, fq = lane >> 4;
    const int K = g.K, nt = K / BK;
    unsigned voffA[2], voffB[2];
#pragma unroll
    for (int i = 0; i < 2; ++i) { int R, C; stage_rc(tid * 16 + i * 8192, R, C); const int Rb = Epi::PERM ? ((R & ~31) + perm32(R & 31)) : R;
        voffA[i] = (unsigned)(R * K + C) * 2u; voffB[i] = (unsigned)(Rb * K + C) * 2u; }
    const size_t kstep = (size_t)(BK * 2);
    const size_t hstep = (size_t)HALF * K * 2;
    const size_t tstep = 2 * hstep;
    const unsigned ldsw = (unsigned)wid * 1024u;
    const int aoff = lds_byte(wr * 64 + fr, fq * 8), boff = lds_byte(wc * 32 + fr, fq * 8);
#define PG8_SA(b, h) (((b) * 2 + (h)) * HTB)
#define PG8_SB(b, h) ((4 + (b) * 2 + (h)) * HTB)
#define PG8_STAGE(bufoff, gbase, voff) do { _Pragma("unroll") for (int _i = 0; _i < 2; ++_i) \
        __builtin_amdgcn_global_load_lds((const unsigned*)((const char*)(gbase) + (voff)[_i]), (PG8_LAS unsigned*)(lds + (bufoff) + ldsw + _i * 8192), 16, 0, 0); } while (0)
#define PG8_LDA(dst, b, h) do { _Pragma("unroll") for (int m = 0; m < 4; ++m) _Pragma("unroll") for (int k = 0; k < 2; ++k) dst[m][k] = *(const PG8_LAS bf16x8*)(lds + PG8_SA(b, h) + aoff + m * 2048 + k * 1024); } while (0)
#define PG8_LDB(dst, b, h) do { _Pragma("unroll") for (int n = 0; n < 2; ++n) _Pragma("unroll") for (int k = 0; k < 2; ++k) dst[n][k] = *(const PG8_LAS bf16x8*)(lds + PG8_SB(b, h) + boff + n * 2048 + k * 1024); } while (0)
#define PG8_MMA(ai, bj, At, Bt) do { __builtin_amdgcn_s_setprio(1); _Pragma("unroll") for (int m = 0; m < 4; ++m) _Pragma("unroll") for (int n = 0; n < 2; ++n) _Pragma("unroll") for (int k = 0; k < 2; ++k) \
        acc[ai][bj][m][n] = __builtin_amdgcn_mfma_f32_16x16x32_bf16(Bt[n][k], At[m][k], acc[ai][bj][m][n], 0, 0, 0); __builtin_amdgcn_s_setprio(0); } while (0)
#define PG8_WAIT_V(n) asm volatile("s_waitcnt vmcnt(" #n ")" ::: "memory")
#define PG8_WAIT_L(n) asm volatile("s_waitcnt lgkmcnt(" #n ")" ::: "memory")
#define PG8_BAR __builtin_amdgcn_s_barrier()
#define PG8_SCHED __builtin_amdgcn_sched_barrier(0)
    Unit cur, nxt; int ui = 0;
    if (!S.next(0, cur)) return;
    f32x4 acc[2][2][4][2];
#pragma unroll
    for (int a = 0; a < 2; ++a)
#pragma unroll
        for (int b = 0; b < 2; ++b)
#pragma unroll
            for (int m = 0; m < 4; ++m)
#pragma unroll
                for (int n = 0; n < 2; ++n) acc[a][b][m][n] = (f32x4){0.f, 0.f, 0.f, 0.f};
    bf16x8 At[4][2], B0[2][2], B1[2][2];
    const char* cA = (const char*)g.A + (size_t)cur.pm * tstep; const char* cB = (const char*)g.Bt + (size_t)cur.pn * tstep;
    S.a_ready(cur);
    if constexpr (SP2) {
        PG8_STAGE(PG8_SB(0, 0), cB, voffB); PG8_STAGE(PG8_SB(0, 1), cB + hstep, voffB); PG8_STAGE(PG8_SA(0, 0), cA, voffA); PG8_STAGE(PG8_SA(0, 1), cA + hstep, voffA);
        if (wr == 1) PG8_BAR;
        PG8_WAIT_V(2); PG8_BAR;
        PG8_STAGE(PG8_SB(1, 0), cB + kstep, voffB); PG8_STAGE(PG8_SA(1, 0), cA + kstep, voffA); PG8_STAGE(PG8_SB(1, 1), cB + hstep + kstep, voffB);
        PG8_WAIT_V(6); PG8_BAR;
    } else {
        PG8_STAGE(PG8_SB(0, 0), cB, voffB); PG8_STAGE(PG8_SA(0, 0), cA, voffA); PG8_STAGE(PG8_SB(0, 1), cB + hstep, voffB); PG8_STAGE(PG8_SA(0, 1), cA + hstep, voffA);
        if (wr == 1) PG8_BAR;
        PG8_WAIT_V(4); PG8_BAR;
        PG8_STAGE(PG8_SB(1, 0), cB + kstep, voffB); PG8_STAGE(PG8_SA(1, 0), cA + kstep, voffA); PG8_STAGE(PG8_SB(1, 1), cB + hstep + kstep, voffB);
        PG8_WAIT_V(6); PG8_BAR;
    }
    for (;;) {
        const bool has_next = S.next(ui + 1, nxt);
        const char* nA = has_next ? (const char*)g.A + (size_t)nxt.pm * tstep : cA; const char* nB = has_next ? (const char*)g.Bt + (size_t)nxt.pn * tstep : cB;
        for (int t = 0; t < nt; t += 2) {
            const bool last = (t == nt - 2);
            const char* a1 = cA + (size_t)(t + 1) * kstep;
            const char* a2 = last ? nA : cA + (size_t)(t + 2) * kstep; const char* b2 = last ? nB : cB + (size_t)(t + 2) * kstep;
            const char* a3 = a2 + kstep; const char* b3 = b2 + kstep;
            if (last && has_next) S.a_ready(nxt);
            if constexpr (SP2) {
            PG8_LDB(B0, 0, 0); PG8_LDB(B1, 0, 1); PG8_SCHED; PG8_LDA(At, 0, 0); PG8_STAGE(PG8_SA(1, 1), a1 + hstep, voffA);
            PG8_WAIT_V(8); PG8_WAIT_L(0); PG8_BAR; PG8_MMA(0, 0, At, B0); PG8_MMA(0, 1, At, B1); PG8_BAR; PG8_SCHED;
            PG8_LDA(At, 0, 1); PG8_STAGE(PG8_SB(0, 0), b2, voffB); PG8_STAGE(PG8_SB(0, 1), b2 + hstep, voffB); PG8_STAGE(PG8_SA(0, 0), a2, voffA);
            PG8_WAIT_V(8); PG8_WAIT_L(0); PG8_BAR; PG8_MMA(1, 0, At, B0); PG8_MMA(1, 1, At, B1); PG8_BAR; PG8_SCHED;
            PG8_LDB(B0, 1, 0); PG8_LDB(B1, 1, 1); PG8_SCHED; PG8_LDA(At, 1, 0); PG8_STAGE(PG8_SA(0, 1), a2 + hstep, voffA);
            PG8_WAIT_V(8); PG8_WAIT_L(0); PG8_BAR; PG8_MMA(0, 0, At, B0); PG8_MMA(0, 1, At, B1); PG8_BAR; PG8_SCHED;
            PG8_LDA(At, 1, 1); PG8_STAGE(PG8_SB(1, 0), b3, voffB); PG8_STAGE(PG8_SB(1, 1), b3 + hstep, voffB); PG8_STAGE(PG8_SA(1, 0), a3, voffA);
            PG8_WAIT_V(8); PG8_WAIT_L(0); PG8_BAR; PG8_MMA(1, 0, At, B0); PG8_MMA(1, 1, At, B1); PG8_BAR; PG8_SCHED;
            } else {
            PG8_LDB(B0, 0, 0); PG8_SCHED; PG8_LDA(At, 0, 0); PG8_STAGE(PG8_SA(1, 1), a1 + hstep, voffA);
            PG8_WAIT_L(8); PG8_BAR; PG8_WAIT_L(0); PG8_MMA(0, 0, At, B0); PG8_BAR; PG8_SCHED;
            PG8_LDB(B1, 0, 1); PG8_STAGE(PG8_SB(0, 0), b2, voffB);
            PG8_BAR; PG8_WAIT_L(0); PG8_MMA(0, 1, At, B1); PG8_BAR;
            PG8_LDA(At, 0, 1); PG8_STAGE(PG8_SA(0, 0), a2, voffA);
            PG8_BAR; PG8_WAIT_L(0); PG8_MMA(1, 0, At, B0); PG8_BAR; PG8_SCHED;
            PG8_STAGE(PG8_SB(0, 1), b2 + hstep, voffB);
            PG8_WAIT_V(6); PG8_BAR; PG8_MMA(1, 1, At, B1); PG8_BAR;
            PG8_LDB(B0, 1, 0); PG8_SCHED; PG8_LDA(At, 1, 0); PG8_STAGE(PG8_SA(0, 1), a2 + hstep, voffA);
            PG8_WAIT_L(8); PG8_BAR; PG8_WAIT_L(0); PG8_MMA(0, 0, At, B0); PG8_BAR; PG8_SCHED;
            PG8_LDB(B1, 1, 1); PG8_STAGE(PG8_SB(1, 0), b3, voffB);
            PG8_BAR; PG8_WAIT_L(0); PG8_MMA(0, 1, At, B1); PG8_BAR;
            PG8_LDA(At, 1, 1); PG8_STAGE(PG8_SA(1, 0), a3, voffA);
            PG8_BAR; PG8_WAIT_L(0); PG8_MMA(1, 0, At, B0); PG8_BAR; PG8_SCHED;
            PG8_STAGE(PG8_SB(1, 1), b3 + hstep, voffB);
            PG8_WAIT_V(6); PG8_BAR; PG8_MMA(1, 1, At, B1); PG8_BAR;
            }
        }
        if constexpr (ALIGN_EPI) { if (wr == 0) PG8_BAR; }
        if constexpr (!Epi::AFTER_DRAIN) { E(acc, cur, wr, wc, fr, fq); S.done(cur); }
        if (!has_next) break;
#pragma unroll
        for (int a = 0; a < 2; ++a)
#pragma unroll
            for (int b = 0; b < 2; ++b)
#pragma unroll
                for (int m = 0; m < 4; ++m)
#pragma unroll
                    for (int n = 0; n < 2; ++n) acc[a][b][m][n] = (f32x4){0.f, 0.f, 0.f, 0.f};
        cur = nxt; cA = nA; cB = nB; ++ui;
        if constexpr (ALIGN_EPI) { if (wr == 1) PG8_BAR; }
    }
    PG8_WAIT_V(0);
    if constexpr (!ALIGN_EPI) { if (wr == 0) PG8_BAR; }
    PG8_BAR;
    if constexpr (Epi::AFTER_DRAIN) { E.fused(acc, cur, wr, wc, fr, fq, lds, wid, lane); S.done(cur); }
#undef PG8_SA
#undef PG8_SB
#undef PG8_STAGE
#undef PG8_LDA
#undef PG8_LDB
#undef PG8_MMA
#undef PG8_WAIT_V
#undef PG8_WAIT_L
#undef PG8_BAR
#undef PG8_SCHED
}
}

constexpr int NMIXW = 4864;
struct P2Body {
    const Frame* Fp;
    __device__ __forceinline__ void operator()(int m, int n, const f32x4 v) const {
        const Frame& F = *Fp;
        if (n >= NMIXP) return;
        *(u32x2*)(F.PROJ + (size_t)m * NMIXP + n) = pk4(v);
        if (n >= C_K && n < C_QI) {
            float* o = (n < C_V) ? (m < NTP ? F.out + O_KP + (size_t)m * 128 + (n - C_K) : F.out + O_KS + (size_t)(m - NTP) * 128 + (n - C_K))
                                 : (m < NTP ? F.out + O_VP + (size_t)m * 128 + (n - C_V) : F.out + O_VS + (size_t)(m - NTP) * 128 + (n - C_V));
            *(f32x4*)o = v;
            if (n >= C_V && m < NTP) {
                bf16_t* vt = (bf16_t*)(F.ws + WS_VT) + ((size_t)((m >> 11) * 2 + ((n - C_V) >> 6)) * 64 + ((n - C_V) & 63)) * SEQ + (m & 2047);
                vt[0] = f2bf(v[0]); vt[SEQ] = f2bf(v[1]); vt[2 * SEQ] = f2bf(v[2]); vt[3 * SEQ] = f2bf(v[3]);
            }
        } else if (n >= C_KI && n < C_BG) {
            float* o = m < NTP ? F.out + O_KIP + (size_t)m * 64 + (n - C_KI) : F.out + O_KIS + (size_t)(m - NTP) * 64 + (n - C_KI);
            *(f32x4*)o = v;
        } else if (n == C_WI) {
            *(f32x4*)(F.WI + (size_t)m * 4) = v;
        } else if (n >= C_CG && n < C_GA) {
            const int tt = (m < NTP) ? (m & 2047) - (SEQ - 2) : ((m - NTP) & 7) - (TS - 2);
            if (tt >= 0) {
                const int rowi = (m < NTP) ? (m >> 11) * 2 + tt : 2 * NB_P + ((m - NTP) >> 3) * 2 + tt;
                *(f32x4*)((float*)(F.ws + WS_CGX) + (size_t)rowi * 1024 + (n - C_CG)) = v;
            }
        }
    }
};
__device__ __forceinline__ void p2_gemm_in(const Frame& F) {
    pg8::Gemm g{F.H1, F.WIN, NT, NMIXW, D};
    pg8::StaticOrder S; S.init(NT, NMIXW, F.G, F.bid);
    pg8::EpiRC<P2Body> E{P2Body{&F}};
    pg8::gemm_phase<pg8::EpiRC<P2Body>, pg8::StaticOrder, true, true>(F.lds, g, S, E);
}

constexpr int SROW = 2052;
__device__ __forceinline__ int wave_sum_i(int v) {
#pragma unroll
    for (int o = 32; o >= 1; o >>= 1) v += __shfl_xor(v, o);
    return v;
}
__device__ __forceinline__ void cnt_ge(int& c, unsigned u, unsigned t) { asm("v_cmp_ge_u32_e32 vcc, %1, %2\n\tv_addc_co_u32_e32 %0, vcc, 0, %0, vcc" : "+v"(c) : "v"(u), "v"(t) : "vcc"); }
__device__ __forceinline__ void cnt_gt(int& c, unsigned u, unsigned t) { asm("v_cmp_gt_u32_e32 vcc, %1, %2\n\tv_addc_co_u32_e32 %0, vcc, 0, %0, vcc" : "+v"(c) : "v"(u), "v"(t) : "vcc"); }
__device__ __forceinline__ void cnt_eq(int& c, unsigned u, unsigned t) { asm("v_cmp_eq_u32_e32 vcc, %1, %2\n\tv_addc_co_u32_e32 %0, vcc, 0, %0, vcc" : "+v"(c) : "v"(u), "v"(t) : "vcc"); }
__device__ __forceinline__ void cnt_lt4(int& cl, unsigned u0, unsigned u1, unsigned u2, unsigned u3, unsigned t) {
    int d0, d1, d2, d3;
    asm("v_sub_u32 %1, %5, %9\n\tv_sub_u32 %2, %6, %9\n\tv_sub_u32 %3, %7, %9\n\tv_sub_u32 %4, %8, %9\n\t"
        "v_lshrrev_b32 %1, 31, %1\n\tv_lshrrev_b32 %2, 31, %2\n\tv_lshrrev_b32 %3, 31, %3\n\tv_lshrrev_b32 %4, 31, %4\n\t"
        "v_add3_u32 %0, %0, %1, %2\n\tv_add3_u32 %0, %0, %3, %4"
        : "+v"(cl), "=&v"(d0), "=&v"(d1), "=&v"(d2), "=&v"(d3) : "v"(u0), "v"(u1), "v"(u2), "v"(u3), "v"(t));
}
__device__ __forceinline__ void cnt_eq_pos(int& c, unsigned u, unsigned t, int L) {
    int tmp;
    asm("v_cmp_eq_u32_e32 vcc, %2, %3\n\tv_cndmask_b32_e32 %1, %5, %4, vcc\n\tv_cmp_lt_i32_e32 vcc, 0, %1\n\tv_addc_co_u32_e32 %0, vcc, 0, %0, vcc"
        : "+v"(c), "=&v"(tmp) : "v"(u), "v"(t), "v"(L), "v"(0x80000000) : "vcc");
}
__device__ __forceinline__ int wave_sum_i_dpp(int v) {
    v += __builtin_amdgcn_update_dpp(0, v, 0xB1, 0xF, 0xF, false);
    v += __builtin_amdgcn_update_dpp(0, v, 0x4E, 0xF, 0xF, false);
    v += __builtin_amdgcn_update_dpp(0, v, 0x141, 0xF, 0xF, false);
    v += __builtin_amdgcn_update_dpp(0, v, 0x140, 0xF, 0xF, false);
    v += __builtin_amdgcn_update_dpp(0, v, 0x142, 0xA, 0xF, false);
    v += __builtin_amdgcn_update_dpp(0, v, 0x143, 0xC, 0xF, false);
    return __builtin_amdgcn_readlane(v, 63);
}
template <int NV> __device__ __forceinline__ void select_threshold(const unsigned (&u)[NV], int ksel, int idx_bits, int lane, unsigned& T_out, int& Jx_out, int& ngt_out) {
    unsigned T = 0;
#pragma unroll 1
    for (int bit = 31; bit >= 0; --bit) {
        const unsigned cand = T | (1u << bit);
        int c = 0;
#pragma unroll
        for (int i = 0; i < NV; ++i) cnt_ge(c, u[i], cand);
        c = wave_sum_i_dpp(c);
        if (c >= ksel) T = cand;
    }
    int cg = 0, ce = 0;
#pragma unroll
    for (int i = 0; i < NV; ++i) { cnt_gt(cg, u[i], T); cnt_eq(ce, u[i], T); }
    const int ngt = wave_sum_i_dpp(cg), neq = wave_sum_i_dpp(ce);
    const int need = ksel - ngt;
    int Jx = 0x3FFFFFFF;
    if (need < neq) {
        int Jb = 0;
#pragma unroll 1
        for (int bit = idx_bits - 1; bit >= 0; --bit) {
            const int cand = Jb | (1 << bit);
            const int L = cand - lane;
            int c = 0;
#pragma unroll
            for (int i = 0; i < NV; ++i) cnt_eq_pos(c, u[i], T, L - 64 * i);
            c = wave_sum_i_dpp(c);
            if (c < need) Jb = cand;
        }
        Jx = Jb + 1;
    }
    T_out = T; Jx_out = Jx; ngt_out = ngt;
}
template <int NV> __device__ __forceinline__ void select_threshold2(const unsigned (&ua)[NV], const unsigned (&ub)[NV], int ksel, int idx_bits, int lane, int ng,
                                                                   unsigned& Ta_out, int& Jxa_out, unsigned& Tb_out, int& Jxb_out) {
    unsigned Ta = 0, Tb = 0;
    bool da = false, db = false;
#pragma unroll 1
    for (int bit = 30; bit >= 0 && !(da && db); --bit) {
        const unsigned ca = da ? Ta : (Ta | (1u << bit)), cb = db ? Tb : (Tb | (1u << bit));
        int la = 0, lb = 0;
#pragma unroll
        for (int i = 0; i < NV; i += 4) { if (i < 4 * ng) { cnt_lt4(la, ua[i], ua[i + 1], ua[i + 2], ua[i + 3], ca); cnt_lt4(lb, ub[i], ub[i + 1], ub[i + 2], ub[i + 3], cb); } }
        const int na = ng * 256 - wave_sum_i_dpp(la), nb = ng * 256 - wave_sum_i_dpp(lb);
        if (!da && na >= ksel) { Ta = ca; da = (na == ksel); }
        if (!db && nb >= ksel) { Tb = cb; db = (nb == ksel); }
    }
    int ga = 0, ea = 0, gb = 0, eb = 0;
#pragma unroll
    for (int i = 0; i < NV; ++i) { cnt_gt(ga, ua[i], Ta); cnt_eq(ea, ua[i], Ta); cnt_gt(gb, ub[i], Tb); cnt_eq(eb, ub[i], Tb); }
    const int needa = ksel - wave_sum_i_dpp(ga), neqa = wave_sum_i_dpp(ea), needb = ksel - wave_sum_i_dpp(gb), neqb = wave_sum_i_dpp(eb);
    int Jxa = 0x3FFFFFFF, Jxb = 0x3FFFFFFF;
    if (needa < neqa) {
        int Jb = 0;
#pragma unroll 1
        for (int bit = idx_bits - 1; bit >= 0; --bit) {
            const int cand = Jb | (1 << bit); const int L = cand - lane; int c = 0;
#pragma unroll
            for (int i = 0; i < NV; ++i) cnt_eq_pos(c, ua[i], Ta, L - 64 * i);
            if (wave_sum_i_dpp(c) < needa) Jb = cand;
        }
        Jxa = Jb + 1;
    }
    if (needb < neqb) {
        int Jb = 0;
#pragma unroll 1
        for (int bit = idx_bits - 1; bit >= 0; --bit) {
            const int cand = Jb | (1 << bit); const int L = cand - lane; int c = 0;
#pragma unroll
            for (int i = 0; i < NV; ++i) cnt_eq_pos(c, ub[i], Tb, L - 64 * i);
            if (wave_sum_i_dpp(c) < needb) Jb = cand;
        }
        Jxb = Jb + 1;
    }
    Ta_out = Ta; Jxa_out = Jxa; Tb_out = Tb; Jxb_out = Jxb;
}
template <int NV> __device__ __forceinline__ void select_topk(const unsigned (&u)[NV], int ksel, int idx_bits, int* sel, int lane) {
    unsigned T; int Jx, ngt;
    select_threshold<NV>(u, ksel, idx_bits, lane, T, Jx, ngt);
    const int L = Jx - lane;
    int cg = 0, ct = 0;
#pragma unroll
    for (int i = 0; i < NV; ++i) { cnt_gt(cg, u[i], T); cnt_eq_pos(ct, u[i], T, L - 64 * i); }
    int ig = cg, it = ct;
#pragma unroll
    for (int o = 1; o < 64; o <<= 1) { const int a = __shfl_up(ig, o), b2 = __shfl_up(it, o); if (lane >= o) { ig += a; it += b2; } }
    int pg = ig - cg, pt = ngt + it - ct;
    int ev = lane, Lr = L;
#pragma unroll
    for (int i = 0; i < NV; ++i) {
        if (u[i] > T) { sel[pg] = ev; ++pg; }
        else if (u[i] == T && Lr > 0) { sel[pt] = ev; ++pt; }
        asm volatile("v_add_u32 %0, 64, %0\n\tv_add_u32 %1, -64, %1" : "+v"(ev), "+v"(Lr));
    }
}

constexpr int PU_MB = 16 * SROW * 4;
constexpr int PU_RB = PU_MB + 16 * 64 * 4;
constexpr int PU_BT = PU_RB + 1024;
constexpr int PU_QT = PU_BT + 512, PU_QROW = 1040;
__device__ __forceinline__ int kappa32(int r) { return (r & 0x13) | ((r & 4) << 1) | ((r & 8) >> 1); }
__device__ __forceinline__ void p3_prompt_fused_unit(const Frame& F, const bf16_t* VT, int b, int qt) {
    LAS float* S = (LAS float*)F.lds;
    LAS unsigned* MB = (LAS unsigned*)(F.lds + PU_MB);
    LAS float* RB = (LAS float*)(F.lds + PU_RB);
    LAS int* BT = (LAS int*)(F.lds + PU_BT);
    const int lane = F.lane;
    const int q0 = qt * 16; const size_t tok0 = (size_t)b * SEQ;
    __syncthreads();
    for (int ch = F.tid; ch < 16 * 64; ch += NTHREADS) {
        const u32x4 qv = *(const u32x4*)(F.PROJ + (tok0 + q0 + (ch >> 6)) * NMIXP + C_Q + (ch & 63) * 8);
        constexpr float QS = ATTN_SCALE * 1.4426950408889634f;
        *(LAS u32x4*)(F.lds + PU_QT + (ch >> 6) * PU_QROW + (ch & 63) * 16) = (u32x4){cvt_pk_bf16(bflo(qv[0]) * QS, bfhi(qv[0]) * QS), cvt_pk_bf16(bflo(qv[1]) * QS, bfhi(qv[1]) * QS),
                                                                                    cvt_pk_bf16(bflo(qv[2]) * QS, bfhi(qv[2]) * QS), cvt_pk_bf16(bflo(qv[3]) * QS, bfhi(qv[3]) * QS)};
    }
    {
        const int r = lane & 15, q4 = lane >> 4;
        bf16x8 A[4][2];
#pragma unroll
        for (int hh = 0; hh < 4; ++hh)
#pragma unroll
            for (int s2 = 0; s2 < 2; ++s2) A[hh][s2] = *(const bf16x8*)(F.PROJ + (tok0 + q0 + r) * NMIXP + C_QI + hh * 64 + s2 * 32 + q4 * 8);
        float wv[4][4];
#pragma unroll
        for (int g = 0; g < 4; ++g) { const f32x4 w4 = *(const f32x4*)(F.WI + (tok0 + q0 + 4 * q4 + g) * 4);
#pragma unroll
            for (int hh = 0; hh < 4; ++hh) wv[g][hh] = w4[hh] * IDX_SCALE; }
        const int nkt = qt + 1;
        bf16x8 Bn[2][2];
        {
            const int t0 = 2 * F.wave;
#pragma unroll
            for (int p = 0; p < 2; ++p)
#pragma unroll
                for (int s2 = 0; s2 < 2; ++s2) { const int key = (t0 + p < nkt ? t0 + p : 0) * 16 + r; Bn[p][s2] = *(const bf16x8*)(F.PROJ + (tok0 + key) * NMIXP + C_KI + s2 * 32 + q4 * 8); }
        }
#pragma unroll 1
        for (int t0 = 2 * F.wave; t0 < nkt; t0 += 16) {
            bf16x8 B[2][2] = {{Bn[0][0], Bn[0][1]}, {Bn[1][0], Bn[1][1]}};
            {
                const int tn = t0 + 16;
#pragma unroll
                for (int p = 0; p < 2; ++p)
#pragma unroll
                    for (int s2 = 0; s2 < 2; ++s2) { const int key = (tn + p < nkt ? tn + p : 0) * 16 + r; Bn[p][s2] = *(const bf16x8*)(F.PROJ + (tok0 + key) * NMIXP + C_KI + s2 * 32 + q4 * 8); }
            }
#pragma unroll
            for (int p = 0; p < 2; ++p) {
                if (t0 + p >= nkt) continue;
                float sc[4] = {0.f, 0.f, 0.f, 0.f};
#pragma unroll
                for (int hh = 0; hh < 4; ++hh) {
                    f32x4 c = {0.f, 0.f, 0.f, 0.f};
                    c = __builtin_amdgcn_mfma_f32_16x16x32_bf16(A[hh][0], B[p][0], c, 0, 0, 0);
                    c = __builtin_amdgcn_mfma_f32_16x16x32_bf16(A[hh][1], B[p][1], c, 0, 0, 0);
#pragma unroll
                    for (int g = 0; g < 4; ++g) sc[g] += fmaxf(c[g], 0.f) * wv[g][hh];
                }
#pragma unroll
                for (int g = 0; g < 4; ++g) S[(4 * q4 + g) * SROW + (t0 + p) * 16 + r] = sc[g];
            }
        }
    }
    __syncthreads();
    {
        const int rowa = F.wave * 2, rowb = rowa + 1;
        const int nva = q0 + rowa + 1, nvb = nva + 1;
        if (nvb <= NSEL) {
#pragma unroll
            for (int i = 0; i < 32; ++i) {
                const unsigned long long ma = __ballot(lane + 64 * i < nva), mb = __ballot(lane + 64 * i < nvb);
                if (lane == 0) { MB[rowa * 64 + 2 * i] = (unsigned)ma; MB[rowa * 64 + 2 * i + 1] = (unsigned)(ma >> 32); MB[rowb * 64 + 2 * i] = (unsigned)mb; MB[rowb * 64 + 2 * i + 1] = (unsigned)(mb >> 32); }
            }
        } else {
            unsigned ua[32], ub[32];
#pragma unroll
            for (int i = 0; i < 32; ++i) { const int j = lane + 64 * i; ua[i] = (j < nva) ? (f2ord(S[rowa * SROW + j]) >> 1) : 0u; ub[i] = (j < nvb) ? (f2ord(S[rowb * SROW + j]) >> 1) : 0u; }
            unsigned Ta, Tb; int Jxa, Jxb;
            select_threshold2<32>(ua, ub, NSEL, 11, lane, (nvb + 255) >> 8, Ta, Jxa, Tb, Jxb);
            const int La = Jxa - lane, Lb = Jxb - lane;
#pragma unroll
            for (int i = 0; i < 32; ++i) {
                const bool ta = (ua[i] > Ta) || (ua[i] == Ta && (La - 64 * i) > 0), tb = (ub[i] > Tb) || (ub[i] == Tb && (Lb - 64 * i) > 0);
                const unsigned long long ma = __ballot(ta), mb = __ballot(tb);
                if (lane == 0) { MB[rowa * 64 + 2 * i] = (unsigned)ma; MB[rowa * 64 + 2 * i + 1] = (unsigned)(ma >> 32); MB[rowb * 64 + 2 * i] = (unsigned)mb; MB[rowb * 64 + 2 * i + 1] = (unsigned)(mb >> 32); }
            }
        }
    }
    __syncthreads();
    {
        const int g = F.wave & 1, kq = F.wave >> 1;
        const int c = lane & 31, h = lane >> 5;
        const int hd = g * 4 + (c & 3);
        LAS const unsigned char* Qb = F.lds + PU_QT + (c >> 2) * PU_QROW + (hd * 64 + h * 8) * 2;
        constexpr float L2E = 1.4426950408889634f;
        const float b31 = RB[31 * 8 + hd] * L2E;
        const int ntile = ((q0 + 15) >> 5) + 1;
        const bf16_t* Kb = F.PROJ + (tok0 + kappa32(c)) * NMIXP + C_K + g * 64 + h * 8;
        const bf16_t* Vb = VT + ((size_t)((b * 2 + g) * 64 + c)) * SEQ + h * 8;
        f32x16 O[2][2];
#pragma unroll
        for (int rt = 0; rt < 2; ++rt)
#pragma unroll
            for (int d = 0; d < 2; ++d)
#pragma unroll
                for (int e = 0; e < 16; ++e) O[rt][d][e] = 0.f;
        float lsum[2] = {0.f, 0.f};
        bf16x8 Kn[4];
        {
            const int key0 = (kq < ntile ? kq : 0) * 32;
#pragma unroll
            for (int s4 = 0; s4 < 4; ++s4) Kn[s4] = *(const bf16x8*)(Kb + (size_t)key0 * NMIXP + s4 * 16);
        }
#pragma unroll 1
        for (int kt = kq; kt < ntile; kt += 4) {
            const int key0 = kt * 32;
            bf16x8 Kf[4] = {Kn[0], Kn[1], Kn[2], Kn[3]}, Vf[2][2];
#pragma unroll
            for (int d = 0; d < 2; ++d)
#pragma unroll
                for (int s2 = 0; s2 < 2; ++s2) Vf[d][s2] = *(const bf16x8*)(Vb + (size_t)(32 * d) * SEQ + key0 + 16 * s2);
            {
                const int keyn = (kt + 4 < ntile ? kt + 4 : 0) * 32;
#pragma unroll
                for (int s4 = 0; s4 < 4; ++s4) Kn[s4] = *(const bf16x8*)(Kb + (size_t)keyn * NMIXP + s4 * 16);
            }
#pragma unroll
            for (int rt = 0; rt < 2; ++rt) {
                const int ql = rt * 8 + (c >> 2), q = q0 + ql;
                f32x16 X;
#pragma unroll
                for (int e = 0; e < 16; ++e) X[e] = 0.f;
#pragma unroll
                for (int s4 = 0; s4 < 4; ++s4) X = __builtin_amdgcn_mfma_f32_32x32x16_bf16(Kf[s4], *(LAS const bf16x8*)(Qb + rt * 8 * PU_QROW + s4 * 32), X, 0, 0, 0);
                const unsigned word = MB[ql * 64 + kt];
                const unsigned bits = ((word >> (8 * h)) & 0xFFu) | (((word >> (16 + 8 * h)) & 0xFFu) << 8);
                const bool nearT = (q0 + rt * 8) - (key0 + 31) < 113;
#pragma unroll
                for (int s2 = 0; s2 < 2; ++s2) {
                    float P[8];
                    if (nearT) {
#pragma unroll
                        for (int e8 = 0; e8 < 8; ++e8) {
                            const int e = 8 * s2 + e8;
                            const int key = key0 + e8 + 16 * s2 + 8 * h;
                            int dist = q - key; dist = dist < 0 ? 0 : (dist > 127 ? 127 : dist);
                            const float bias = RB[BT[dist] * 8 + hd] * L2E;
                            const float lg = fminf(X[e] + bias, 86.f);
                            P[e8] = __int_as_float(__float_as_int(__builtin_amdgcn_exp2f(lg)) & __builtin_amdgcn_sbfe((int)bits, e, 1));
                        }
                    } else {
#pragma unroll
                        for (int e8 = 0; e8 < 8; ++e8) {
                            const int e = 8 * s2 + e8;
                            const float lg = fminf(X[e] + b31, 86.f);
                            P[e8] = __int_as_float(__float_as_int(__builtin_amdgcn_exp2f(lg)) & __builtin_amdgcn_sbfe((int)bits, e, 1));
                        }
                    }
#pragma unroll
                    for (int e8 = 0; e8 < 8; ++e8) lsum[rt] += P[e8];
                    const u32x4 pk = (u32x4){cvt_pk_bf16(P[0], P[1]), cvt_pk_bf16(P[2], P[3]), cvt_pk_bf16(P[4], P[5]), cvt_pk_bf16(P[6], P[7])};
                    bf16x8 Pf; __builtin_memcpy(&Pf, &pk, 16);
                    O[rt][0] = __builtin_amdgcn_mfma_f32_32x32x16_bf16(Vf[0][s2], Pf, O[rt][0], 0, 0, 0);
                    O[rt][1] = __builtin_amdgcn_mfma_f32_32x32x16_bf16(Vf[1][s2], Pf, O[rt][1], 0, 0, 0);
                }
                __builtin_amdgcn_sched_barrier(0);
            }
        }
        LAS float* CB = (LAS float*)F.lds + (g * 3 + (kq > 0 ? kq - 1 : 0)) * (66 * 64);
        __syncthreads();
        if (kq > 0) {
#pragma unroll
            for (int rt = 0; rt < 2; ++rt) {
#pragma unroll
                for (int d = 0; d < 2; ++d)
#pragma unroll
                    for (int e = 0; e < 16; ++e) CB[((rt * 2 + d) * 16 + e) * 64 + lane] = O[rt][d][e];
                CB[(64 + rt) * 64 + lane] = lsum[rt];
            }
        }
        __syncthreads();
        if (kq == 0) {
#pragma unroll 1
            for (int p = 0; p < 3; ++p) {
                LAS const float* CP = (LAS const float*)F.lds + (g * 3 + p) * (66 * 64);
#pragma unroll
                for (int rt = 0; rt < 2; ++rt) {
#pragma unroll
                    for (int d = 0; d < 2; ++d)
#pragma unroll
                        for (int e = 0; e < 16; ++e) O[rt][d][e] += CP[((rt * 2 + d) * 16 + e) * 64 + lane];
                    lsum[rt] += CP[(64 + rt) * 64 + lane];
                }
            }
#pragma unroll
            for (int rt = 0; rt < 2; ++rt) {
                float l = lsum[rt]; l += __shfl_xor(l, 32);
                const float inv = 1.f / l;
                bf16_t* orow = F.OATT + (tok0 + q0 + rt * 8 + (c >> 2)) * 512 + hd * 64;
#pragma unroll
                for (int a4 = 0; a4 < 4; ++a4) {
                    const f32x4 v0 = (f32x4){O[rt][0][4 * a4], O[rt][0][4 * a4 + 1], O[rt][0][4 * a4 + 2], O[rt][0][4 * a4 + 3]} * inv;
                    const f32x4 v1 = (f32x4){O[rt][1][4 * a4], O[rt][1][4 * a4 + 1], O[rt][1][4 * a4 + 2], O[rt][1][4 * a4 + 3]} * inv;
                    *(u32x2*)(orow + 8 * a4 + 4 * h) = pk4(v0);
                    *(u32x2*)(orow + 32 + 8 * a4 + 4 * h) = pk4(v1);
                }
            }
        }
    }
}

__device__ __forceinline__ void p3_sample_score_unit(const Frame& F, float* SS, int b, int ch) {
    const int lane = F.lane, r = lane & 31, h = lane >> 5;
    bf16x8 A[4];
    { const int q = r >> 2, hh = r & 3;
#pragma unroll
      for (int s4 = 0; s4 < 4; ++s4) A[s4] = *(const bf16x8*)(F.PROJ + (size_t)(NTP + b * TS + q) * NMIXP + C_QI + hh * 64 + s4 * 16 + h * 8); }
    float wv[4][4];
#pragma unroll
    for (int g = 0; g < 4; ++g) { const f32x4 w4 = *(const f32x4*)(F.WI + (size_t)(NTP + b * TS + 2 * g + h) * 4);
#pragma unroll
        for (int hh = 0; hh < 4; ++hh) wv[g][hh] = w4[hh] * IDX_SCALE; }
    f32x4 kn[8];
    { const int key0 = ch * 1024 + F.wave * 32; const int page = F.page_table[b * NPAGES + (key0 >> 7)];
      const float* kr = F.cache_ki + ((size_t)page * PAGE + (key0 & 127) + r) * 64 + h * 8;
#pragma unroll
      for (int s4 = 0; s4 < 4; ++s4) { kn[2 * s4] = *(const f32x4*)(kr + s4 * 16); kn[2 * s4 + 1] = *(const f32x4*)(kr + s4 * 16 + 4); } }
#pragma unroll 1
    for (int tl = F.wave; tl < 32; tl += 8) {
        const int key0 = ch * 1024 + tl * 32;
        f32x4 kc[8];
#pragma unroll
        for (int i = 0; i < 8; ++i) kc[i] = kn[i];
        if (tl + 8 < 32) {
            const int keyn = key0 + 256; const int page = F.page_table[b * NPAGES + (keyn >> 7)];
            const float* kr = F.cache_ki + ((size_t)page * PAGE + (keyn & 127) + r) * 64 + h * 8;
#pragma unroll
            for (int s4 = 0; s4 < 4; ++s4) { kn[2 * s4] = *(const f32x4*)(kr + s4 * 16); kn[2 * s4 + 1] = *(const f32x4*)(kr + s4 * 16 + 4); }
        }
        f32x16 c;
#pragma unroll
        for (int e = 0; e < 16; ++e) c[e] = 0.f;
#pragma unroll
        for (int s4 = 0; s4 < 4; ++s4) {
            const f32x4 lo = kc[2 * s4], hi = kc[2 * s4 + 1];
            const u32x4 pk = (u32x4){cvt_pk_bf16(lo[0], lo[1]), cvt_pk_bf16(lo[2], lo[3]), cvt_pk_bf16(hi[0], hi[1]), cvt_pk_bf16(hi[2], hi[3])};
            bf16x8 Bf; __builtin_memcpy(&Bf, &pk, 16);
            c = __builtin_amdgcn_mfma_f32_32x32x16_bf16(A[s4], Bf, c, 0, 0, 0);
        }
#pragma unroll
        for (int g = 0; g < 4; ++g) {
            float sc = 0.f;
#pragma unroll
            for (int hh = 0; hh < 4; ++hh) sc += fmaxf(c[4 * g + hh], 0.f) * wv[g][hh];
            SS[(size_t)(b * TS + 2 * g + h) * PAST + key0 + r] = sc;
        }
    }
}
__device__ __forceinline__ void p3_index(const Frame& F) {
    constexpr int NSU = NB_S * 8;
    const int nunits = NSU + NB_P * (SEQ / 16);
    float* SS = (float*)(F.ws + WS_SS);
    const bf16_t* VT = (const bf16_t*)(F.ws + WS_VT);
    __syncthreads();
    if (F.tid < 256) ((LAS float*)(F.lds + PU_RB))[F.tid] = F.rel_bias[F.tid];
    if (F.tid < 128) ((LAS int*)(F.lds + PU_BT))[F.tid] = t5_bucket(F.tid);
    __syncthreads();
    for (int it = F.bid; it < nunits; it += F.G) {
        if (it < NSU) { p3_sample_score_unit(F, SS, it >> 3, it & 7); continue; }
        const int i = it - NSU; const int b = i & 7, sl = (i >> 3) & 31, rnd = i >> 8;
        const int qt = rnd == 0 ? 127 - sl : (rnd == 1 ? 64 + sl : (rnd == 2 ? 63 - sl : sl));
        p3_prompt_fused_unit(F, VT, b, qt);
    }
}

constexpr int SQ_CNT = 0;
constexpr int SQ_SEL = 1024;
constexpr int SQ_Q = 2048;
constexpr int SQ_PHYS = 3072;
constexpr int SQ_P = 4096;
constexpr int SQ_RB = 16384;
constexpr int SQ_BT = 17408;
__device__ __forceinline__ int wg_sum8(const Frame& F, LAS unsigned* slot, int v) {
    if (F.lane == 0) slot[F.wave] = (unsigned)v;
    __syncthreads();
    int t = 0;
#pragma unroll
    for (int w = 0; w < 8; ++w) t += (int)slot[w];
    return t;
}
__device__ __forceinline__ void p4_sample_query_unit(const Frame& F, const float* SS, int b, int t) {
    const int lane = F.lane, w = F.wave;
    LAS unsigned* CNT = (LAS unsigned*)(F.lds + SQ_CNT);
    LAS int* SELL = (LAS int*)(F.lds + SQ_SEL);
    LAS unsigned* QL = (LAS unsigned*)(F.lds + SQ_Q);
    LAS float* PL = (LAS float*)(F.lds + SQ_P) + w * 256;
    LAS float* RB = (LAS float*)(F.lds + SQ_RB);
    LAS int* BT = (LAS int*)(F.lds + SQ_BT);
    const int tok = NTP + b * TS + t;
    __syncthreads();
    if (F.tid < 256) QL[F.tid] = ((const unsigned*)(F.PROJ + (size_t)tok * NMIXP + C_Q))[F.tid];
    unsigned u[17];
    { const float* srow = SS + (size_t)(b * TS + t) * PAST + w * 1024;
#pragma unroll
      for (int i = 0; i < 16; ++i) u[i] = f2ord(srow[64 * i + lane]); }
    u[16] = 0u;
    if (w == 7) {
        const int kj = lane < TS ? lane : 0;
        const bf16_t* kn = F.PROJ + (size_t)(NTP + b * TS + kj) * NMIXP + C_KI;
        const bf16_t* qn = F.PROJ + (size_t)tok * NMIXP + C_QI;
        u32x4 kv[8];
#pragma unroll
        for (int c = 0; c < 8; ++c) kv[c] = *(const u32x4*)(kn + c * 8);
        int vz; asm volatile("v_mov_b32 %0, 0" : "=v"(vz));
        const f32x4 w4 = *(const f32x4*)(F.WI + (size_t)tok * 4 + vz);
        float sc = 0.f;
#pragma unroll
        for (int hh = 0; hh < 4; ++hh) {
            u32x4 qv[8];
#pragma unroll
            for (int c = 0; c < 8; ++c) qv[c] = *(const u32x4*)(qn + hh * 64 + c * 8 + vz);
            float d = 0.f;
#pragma unroll
            for (int c = 0; c < 8; ++c)
#pragma unroll
                for (int e = 0; e < 4; ++e) d += bflo(qv[c][e]) * bflo(kv[c][e]) + bfhi(qv[c][e]) * bfhi(kv[c][e]);
            sc += fmaxf(d, 0.f) * (w4[hh] * IDX_SCALE);
        }
        u[16] = (lane < TS && lane <= t) ? f2ord(sc) : 0u;
    }
    unsigned T = 0;
#pragma unroll 1
    for (int bit = 31; bit >= 0; --bit) {
        const unsigned cand = T | (1u << bit);
        int c = 0;
#pragma unroll
        for (int i = 0; i < 17; ++i) cnt_ge(c, u[i], cand);
        c = wg_sum8(F, CNT + (bit & 1) * 24, wave_sum_i_dpp(c));
        if (c >= NSEL) T = cand;
        if (c == NSEL) break;
    }
    int cg = 0, ce = 0;
#pragma unroll
    for (int i = 0; i < 17; ++i) { cnt_gt(cg, u[i], T); cnt_eq(ce, u[i], T); }
    const int cgw = wave_sum_i_dpp(cg);
    const int ngt = wg_sum8(F, CNT + 8, cgw);
    const int neq = wg_sum8(F, CNT + 16, wave_sum_i_dpp(ce));
    const int need = NSEL - ngt;
    int Jx = 0x3FFFFFFF;
    if (need < neq) {
        int Jb = 0;
#pragma unroll 1
        for (int bit = 13; bit >= 0; --bit) {
            const int cand = Jb | (1 << bit);
            const int L = cand - lane - 1024 * w;
            int c = 0;
#pragma unroll
            for (int i = 0; i < 17; ++i) cnt_eq_pos(c, u[i], T, L - 64 * i);
            c = wg_sum8(F, CNT + (bit & 1) * 24, wave_sum_i_dpp(c));
            if (c < need) Jb = cand;
        }
        Jx = Jb + 1;
    }
    {
        const int L = Jx - lane - 1024 * w;
        int ct = 0;
#pragma unroll
        for (int i = 0; i < 17; ++i) cnt_eq_pos(ct, u[i], T, L - 64 * i);
        const int ctw = wave_sum_i_dpp(ct);
        __syncthreads();
        if (lane == 0) { CNT[w] = (unsigned)cgw; CNT[8 + w] = (unsigned)ctw; }
        __syncthreads();
        int bg = 0, bt = ngt;
#pragma unroll
        for (int ww = 0; ww < 8; ++ww) { if (ww < w) { bg += (int)CNT[ww]; bt += (int)CNT[8 + ww]; } }
        int ig = cg, it2 = ct;
#pragma unroll
        for (int o = 1; o < 64; o <<= 1) { const int a = __shfl_up(ig, o), b2 = __shfl_up(it2, o); if (lane >= o) { ig += a; it2 += b2; } }
        int pg = bg + ig - cg, pt = bt + it2 - ct;
        int ev = 1024 * w + lane, Lr = L;
#pragma unroll
        for (int i = 0; i < 17; ++i) {
            if (u[i] > T) { SELL[pg] = ev; ++pg; }
            else if (u[i] == T && Lr > 0) { SELL[pt] = ev; ++pt; }
            asm volatile("v_add_u32 %0, 64, %0\n\tv_add_u32 %1, -64, %1" : "+v"(ev), "+v"(Lr));
        }
    }
    __syncthreads();
    LAS int* PHYS = (LAS int*)(F.lds + SQ_PHYS);
    if (F.tid < 256) { const int sraw = SELL[F.tid]; PHYS[F.tid] = (sraw < PAST) ? F.page_table[b * NPAGES + (sraw >> 7)] * PAGE + (sraw & 127) : -1 - (sraw - PAST); }
    __syncthreads();
    {
        const int hd = w, g = w >> 2, qpos = PAST + t;
        float lg[4];
#pragma unroll 2
        for (int i = 0; i < 4; ++i) {
            const int sraw = SELL[lane + 64 * i], ph = PHYS[lane + 64 * i];
            const float* kr = (ph >= 0) ? F.cache_k + (size_t)ph * 128 + g * 64 : F.out + O_KS + (size_t)(b * TS + (-1 - ph)) * 128 + g * 64;
            float a0 = 0.f, a1 = 0.f;
#pragma unroll
            for (int c = 0; c < 16; ++c) {
                const f32x4 kv = *(const f32x4*)(kr + c * 4);
                const unsigned q0 = QL[hd * 32 + c * 2], q1 = QL[hd * 32 + c * 2 + 1];
                a0 += bflo(q0) * kv[0] + bfhi(q0) * kv[1]; a1 += bflo(q1) * kv[2] + bfhi(q1) * kv[3];
            }
            const int dist = qpos - sraw; const int bk = dist < 128 ? BT[dist] : 31;
            lg[i] = (a0 + a1) * ATTN_SCALE + RB[bk * 8 + hd];
        }
        float m = fmaxf(fmaxf(lg[0], lg[1]), fmaxf(lg[2], lg[3])); m = wave_max(m);
        float sm = 0.f;
#pragma unroll
        for (int i = 0; i < 4; ++i) { lg[i] = __expf(lg[i] - m); sm += lg[i]; }
        const float inv = 1.f / wave_sum_dpp(sm);
#pragma unroll
        for (int i = 0; i < 4; ++i) PL[lane + 64 * i] = lg[i] * inv;
        const int dq = lane & 15, ks = lane >> 4;
        f32x4 o4 = {0.f, 0.f, 0.f, 0.f};
#pragma unroll 1
        for (int j0 = 0; j0 < 256; j0 += 64) {
            f32x4 vv[16]; float pp[16];
#pragma unroll
            for (int jj = 0; jj < 16; ++jj) {
                const int j = j0 + jj * 4 + ks;
                const int ph = PHYS[j]; pp[jj] = PL[j];
                const float* vr = (ph >= 0) ? F.cache_v + (size_t)ph * 128 + g * 64 : F.out + O_VS + (size_t)(b * TS + (-1 - ph)) * 128 + g * 64;
                vv[jj] = *(const f32x4*)(vr + 4 * dq);
            }
#pragma unroll
            for (int jj = 0; jj < 16; ++jj) o4 += vv[jj] * pp[jj];
        }
#pragma unroll
        for (int e = 0; e < 4; ++e) { o4[e] += __shfl_xor(o4[e], 16); o4[e] += __shfl_xor(o4[e], 32); }
        if (ks == 0) *(u32x2*)(F.OATT + (size_t)tok * 512 + hd * 64 + 4 * dq) = pk4(o4);
    }
}
__device__ __forceinline__ void p4_attention(const Frame& F) {
    const float* SS = (const float*)(F.ws + WS_SS);
    __syncthreads();
    if (F.tid < 256) ((LAS float*)(F.lds + SQ_RB))[F.tid] = F.rel_bias[F.tid];
    if (F.tid < 128) ((LAS int*)(F.lds + SQ_BT))[F.tid] = t5_bucket(F.tid);
    __syncthreads();
    for (int it = F.bid; it < NTS; it += F.G) p4_sample_query_unit(F, SS, it >> 3, it & 7);
    {
        const int c0 = F.lane * 8;
        float cw0[8], cw1[8], cw2[8], cbv[8];
#pragma unroll
        for (int e = 0; e < 8; ++e) { cw0[e] = F.conv_w[c0 + e]; cw1[e] = F.conv_w[512 + c0 + e]; cw2[e] = F.conv_w[1024 + c0 + e]; cbv[e] = F.conv_b[c0 + e]; }
        const int stride = F.G * 8;
        u32x4 n_cg[3], n_xi[3], n_bg;
        auto fetch = [&](int m) {
#pragma unroll
            for (int d = 0; d < 3; ++d) { const int mm = (m - d >= 0) ? m - d : 0; n_cg[d] = *(const u32x4*)(F.PROJ + (size_t)mm * NMIXP + C_CG + c0); n_xi[d] = *(const u32x4*)(F.PROJ + (size_t)mm * NMIXP + C_XIN + c0); }
            n_bg = *(const u32x4*)(F.PROJ + (size_t)m * NMIXP + C_BG + c0);
        };
        { const int m = F.bid * 8 + F.wave; fetch(m < NT ? m : 0); }
        for (int m = F.bid * 8 + F.wave; m < NT; m += stride) {
            u32x4 cg[3], xi[3]; const u32x4 bg = n_bg;
#pragma unroll
            for (int d = 0; d < 3; ++d) { cg[d] = n_cg[d]; xi[d] = n_xi[d]; }
            fetch(m + stride < NT ? m + stride : m);
            int t, T_, bsm; if (m < NTP) { t = m & 2047; T_ = SEQ; bsm = m >> 11; } else { t = (m - NTP) & 7; T_ = TS; bsm = (m - NTP) >> 3; }
            float u[3][8];
#pragma unroll
            for (int d = 0; d < 3; ++d) {
                if (t - d >= 0) {
#pragma unroll
                    for (int e = 0; e < 4; ++e) { u[d][2 * e] = bflo(cg[d][e]) * bflo(xi[d][e]); u[d][2 * e + 1] = bfhi(cg[d][e]) * bfhi(xi[d][e]); }
                } else if (m >= NTP) {
                    const float* pv = F.state_conv + ((size_t)bsm * 2 + (2 + t - d)) * 512 + c0;
#pragma unroll
                    for (int e = 0; e < 8; ++e) u[d][e] = pv[e];
                } else {
#pragma unroll
                    for (int e = 0; e < 8; ++e) u[d][e] = 0.f;
                }
            }
            float y[8];
#pragma unroll
            for (int e = 0; e < 8; ++e) {
                const float yy = cbv[e] + cw0[e] * u[2][e] + cw1[e] * u[1][e] + cw2[e] * u[0][e];
                const float bgv = (e & 1) ? bfhi(bg[e >> 1]) : bflo(bg[e >> 1]);
                y[e] = bgv * yy;
            }
            *(u32x4*)(F.OCONV + (size_t)m * 512 + c0) = (u32x4){cvt_pk_bf16(y[0], y[1]), cvt_pk_bf16(y[2], y[3]), cvt_pk_bf16(y[4], y[5]), cvt_pk_bf16(y[6], y[7])};
            if (t >= T_ - 2) {
                float* o = (m < NTP ? F.out + O_CP : F.out + O_CS) + ((size_t)bsm * 2 + (t - (T_ - 2))) * 512 + c0;
                const int rowi = (m < NTP) ? bsm * 2 + (t - (T_ - 2)) : 2 * NB_P + bsm * 2 + (t - (T_ - 2));
                const float* cx = (const float*)(F.ws + WS_CGX) + (size_t)rowi * 1024 + c0;
                const f32x4 ca = *(const f32x4*)cx, cb2 = *(const f32x4*)(cx + 4), xa = *(const f32x4*)(cx + 512), xb = *(const f32x4*)(cx + 516);
                *(f32x4*)o = ca * xa; *(f32x4*)(o + 4) = cb2 * xb;
            }
        }
    }
}

#define P5_EPI(A1, A2) { \
            const f32x4 va = ACC4(A1), vc = ACC4(A2); \
            const u32x2 ga = *(const u32x2*)(F.PROJ + (size_t)m * NMIXP + C_GA + n), gb = *(const u32x2*)(F.PROJ + (size_t)m * NMIXP + C_GB + n); \
            f32x4 o; \
            o[0] = sigmoidf_(bflo(ga[0])) * va[0] + sigmoidf_(bflo(gb[0])) * vc[0]; \
            o[1] = sigmoidf_(bfhi(ga[0])) * va[1] + sigmoidf_(bfhi(gb[0])) * vc[1]; \
            o[2] = sigmoidf_(bflo(ga[1])) * va[2] + sigmoidf_(bflo(gb[1])) * vc[2]; \
            o[3] = sigmoidf_(bfhi(ga[1])) * va[3] + sigmoidf_(bfhi(gb[1])) * vc[3]; \
            *(u32x2*)(F.MERGED + (size_t)m * D + n) = pk4(o); }
struct P5aBody {
    const Frame* Fp;
    __device__ __forceinline__ void operator()(int m, int n, const f32x4 v) const { *(u32x2*)(Fp->MERGED + (size_t)m * D + n) = pk4(v); }
};
struct P5bBody {
    const Frame* Fp;
    __device__ __forceinline__ void operator()(int m, int n, const f32x4 v) const {
        const Frame& F = *Fp;
        const u32x2 ga = *(const u32x2*)(F.PROJ + (size_t)m * NMIXP + C_GA + n), gb = *(const u32x2*)(F.PROJ + (size_t)m * NMIXP + C_GB + n);
        const u32x2 pa = *(const u32x2*)(F.MERGED + (size_t)m * D + n);
        const f32x4 o = (f32x4){sigmoidf_(bflo(ga[0])) * bflo(pa[0]) + sigmoidf_(bflo(gb[0])) * v[0], sigmoidf_(bfhi(ga[0])) * bfhi(pa[0]) + sigmoidf_(bfhi(gb[0])) * v[1],
                                sigmoidf_(bflo(ga[1])) * bflo(pa[1]) + sigmoidf_(bflo(gb[1])) * v[2], sigmoidf_(bfhi(ga[1])) * bfhi(pa[1]) + sigmoidf_(bfhi(gb[1])) * v[3]};
        *(u32x2*)(F.MERGED + (size_t)m * D + n) = pk4(o);
    }
};
__device__ __forceinline__ void p5_gemm_merge(const Frame& F) {
    {
        pg8::StaticOrder S; S.init(NTP, D, F.G, F.bid);
        { pg8::Gemm g{F.OATT, F.WOA, NTP, D, 512}; pg8::EpiRC<P5aBody> E{P5aBody{&F}}; pg8::gemm_phase<pg8::EpiRC<P5aBody>, pg8::StaticOrder, true, true>(F.lds, g, S, E); }
        asm volatile("s_waitcnt vmcnt(0)" ::: "memory"); __syncthreads();
        { pg8::Gemm g{F.OCONV, F.WOC, NTP, D, 512}; pg8::EpiRC<P5bBody> E{P5bBody{&F}}; pg8::gemm_phase<pg8::EpiRC<P5bBody>, pg8::StaticOrder, true, true>(F.lds, g, S, E); }
    }
    for (int sl = F.bid; sl < NTS / 8 * (D / BN); sl += F.G) {
        const int m0 = NTP + (sl >> 3) * 8, n0 = (sl & 7) * BN;
        f32x16 s1[1][1], s2[1][1];
        gemm_slice8(F, s1, F.OATT, 512, F.WOA, 512, 512, m0, n0);
        gemm_slice8(F, s2, F.OCONV, 512, F.WOC, 512, 512, m0, n0);
        SLICE_EPI_LOOP(P5_EPI(s1, s2))
    }
}
#define P6_EPI(A1) { \
            const f32x4 v = ACC4(A1); \
            const f32x4 xv = *(const f32x4*)(x_row(F, m) + n); \
            const f32x4 g1 = *(const f32x4*)(F.MOD + (size_t)mod_row(m) * 6144 + 2048 + n); \
            *(f32x4*)(F.T1 + (size_t)m * D + n) = xv * DN_ALPHA + g1 * v; }
struct P6Body {
    const Frame* Fp;
    __device__ __forceinline__ void operator()(int m, int n, const f32x4 v) const {
        const Frame& F = *Fp;
        const f32x4 xv = *(const f32x4*)(F.x_p + (size_t)m * D + n);
        const f32x4 g1 = *(const f32x4*)(F.MOD + (size_t)(m >> 11) * 6144 + 2048 + n);
        *(f32x4*)(F.T1 + (size_t)m * D + n) = xv * DN_ALPHA + g1 * v;
    }
};
__device__ __forceinline__ void p6_gemm_out(const Frame& F) {
    {
        pg8::Gemm g{F.MERGED, F.WOUT, NTP, D, D}; pg8::StaticOrder S; S.init(NTP, D, F.G, F.bid);
        pg8::EpiRC<P6Body> E{P6Body{&F}}; pg8::gemm_phase<pg8::EpiRC<P6Body>, pg8::StaticOrder, true, true>(F.lds, g, S, E);
    }
    for (int sl = F.bid; sl < NTS / 8 * (D / BN); sl += F.G) {
        const int m0 = NTP + (sl >> 3) * 8, n0 = (sl & 7) * BN;
        f32x16 s1[1][1];
        gemm_slice8(F, s1, F.MERGED, D, F.WOUT, D, D, m0, n0);
        SLICE_EPI_LOOP(P6_EPI(s1))
    }
}
__device__ __forceinline__ void p7_ln1(const Frame& F) {
    f32x4 lg[4], lb[4];
#pragma unroll
    for (int i = 0; i < 4; ++i) { const int e = (i >> 1) * 512 + F.lane * 8 + (i & 1) * 4; lg[i] = *(const f32x4*)(F.ln1_g + e); lb[i] = *(const f32x4*)(F.ln1_b + e); }
    const int stride = F.G * 8;
    f32x4 vn[4], scn[4], shn[4];
    {
        const int m = F.bid * 8 + F.wave; const float* mr = F.MOD + (size_t)mod_row(m < NT ? m : 0) * 6144;
#pragma unroll
        for (int i = 0; i < 4; ++i) { const int e = (i >> 1) * 512 + F.lane * 8 + (i & 1) * 4; vn[i] = *(const f32x4*)(F.T1 + (size_t)(m < NT ? m : 0) * D + e); scn[i] = *(const f32x4*)(mr + 4096 + e); shn[i] = *(const f32x4*)(mr + 3072 + e); }
    }
    for (int m = F.bid * 8 + F.wave; m < NT; m += stride) {
        float* tr = F.T1 + (size_t)m * D;
        f32x4 v[4], sc2[4], sh2[4]; float s = 0.f;
#pragma unroll
        for (int i = 0; i < 4; ++i) { v[i] = vn[i]; sc2[i] = scn[i]; sh2[i] = shn[i]; s += v[i][0] + v[i][1] + v[i][2] + v[i][3]; }
        {
            const int mn = (m + stride < NT) ? m + stride : m; const float* mrn = F.MOD + (size_t)mod_row(mn) * 6144;
#pragma unroll
            for (int i = 0; i < 4; ++i) { const int e = (i >> 1) * 512 + F.lane * 8 + (i & 1) * 4; vn[i] = *(const f32x4*)(F.T1 + (size_t)mn * D + e); scn[i] = *(const f32x4*)(mrn + 4096 + e); shn[i] = *(const f32x4*)(mrn + 3072 + e); }
        }
        const float mean = wave_sum(s) * (1.f / D);
        float q = 0.f;
#pragma unroll
        for (int i = 0; i < 4; ++i) { v[i] = v[i] - mean; q += v[i][0] * v[i][0] + v[i][1] * v[i][1] + v[i][2] * v[i][2] + v[i][3] * v[i][3]; }
        const float rstd = rsqrtf(wave_sum(q) * (1.f / D) + LN_EPS);
        f32x4 hv[2][2];
#pragma unroll
        for (int hlf = 0; hlf < 2; ++hlf) {
            const int e = hlf * 512 + F.lane * 8;
            f32x4 a = v[2 * hlf] * rstd * lg[2 * hlf] + lb[2 * hlf];
            f32x4 b = v[2 * hlf + 1] * rstd * lg[2 * hlf + 1] + lb[2 * hlf + 1];
            *(f32x4*)(tr + e) = a; *(f32x4*)(tr + e + 4) = b;
            const f32x4 ha = a * (sc2[2 * hlf] + 1.f) + sh2[2 * hlf];
            const f32x4 hb = b * (sc2[2 * hlf + 1] + 1.f) + sh2[2 * hlf + 1];
            *(u32x4*)(F.H2 + (size_t)m * D + e) = (u32x4){cvt_pk_bf16(ha[0], ha[1]), cvt_pk_bf16(ha[2], ha[3]), cvt_pk_bf16(hb[0], hb[1]), cvt_pk_bf16(hb[2], hb[3])};
            hv[hlf][0] = ha; hv[hlf][1] = hb;
        }
        float am = 0.f;
#pragma unroll
        for (int i = 0; i < 2; ++i)
#pragma unroll
            for (int j = 0; j < 2; ++j)
#pragma unroll
                for (int e = 0; e < 4; ++e) am = fmaxf(am, fabsf(hv[i][j][e]));
        am = wave_max(am);
        const float sc = am > 0.f ? 224.f / am : 1.f;
#pragma unroll
        for (int hlf = 0; hlf < 2; ++hlf) {
            int w0 = 0, w1 = 0;
            w0 = __builtin_amdgcn_cvt_pk_fp8_f32(hv[hlf][0][0] * sc, hv[hlf][0][1] * sc, w0, false); w0 = __builtin_amdgcn_cvt_pk_fp8_f32(hv[hlf][0][2] * sc, hv[hlf][0][3] * sc, w0, true);
            w1 = __builtin_amdgcn_cvt_pk_fp8_f32(hv[hlf][1][0] * sc, hv[hlf][1][1] * sc, w1, false); w1 = __builtin_amdgcn_cvt_pk_fp8_f32(hv[hlf][1][2] * sc, hv[hlf][1][3] * sc, w1, true);
            *(u32x2*)(F.ws + WS_H8 + (size_t)m * D + hlf * 512 + F.lane * 8) = (u32x2){(unsigned)w0, (unsigned)w1};
        }
        if (F.lane == 0) ((float*)(F.ws + WS_SH))[m] = am > 0.f ? am * (1.f / 224.f) : 1.f;
    }
}
struct P8Body {
    const Frame* Fp;
    __device__ __forceinline__ void operator()(int m, int n, const f32x4 v) const { *(u32x2*)(Fp->QP + (size_t)m * D + n) = pk4(v); }
};
__device__ __forceinline__ void p8_gemm_q(const Frame& F) {
    {
        pg8::Gemm g{F.H2, F.WQ, NTP, D, D}; pg8::StaticOrder S; S.init(NTP, D, F.G, F.bid);
        pg8::EpiRC<P8Body> E{P8Body{&F}}; pg8::gemm_phase<pg8::EpiRC<P8Body>, pg8::StaticOrder, true, true>(F.lds, g, S, E);
    }
    for (int sl = F.bid; sl < NTS / 8 * (D / BN); sl += F.G) {
        const int m0 = NTP + (sl >> 3) * 8, n0 = (sl & 7) * BN;
        f32x16 s1[1][1];
        gemm_slice8(F, s1, F.H2, D, F.WQ, D, D, m0, n0);
        SLICE_EPI_LOOP({ *(u32x2*)(F.QP + (size_t)m * D + n) = pk4(ACC4(s1)); })
    }
}
__device__ __forceinline__ void p9_row_top16(LAS float* row, LAS float* TV, LAS unsigned char* TI, int slot) {
    float gm[16];
#pragma unroll
    for (int gidx = 0; gidx < 16; ++gidx) {
        float m = row[gidx * 8];
#pragma unroll
        for (int k = 1; k < 8; ++k) m = fmaxf(m, row[gidx * 8 + k]);
        gm[gidx] = m;
    }
#pragma unroll 1
    for (int p = 0; p < 16; ++p) {
        float best = gm[0]; int bg = 0;
#pragma unroll
        for (int gidx = 1; gidx < 16; ++gidx) { const bool gt = gm[gidx] > best; best = gt ? gm[gidx] : best; bg = gt ? gidx : bg; }
        float v[8];
#pragma unroll
        for (int k = 0; k < 8; ++k) v[k] = row[bg * 8 + k];
        int bk = 7;
#pragma unroll
        for (int k = 6; k >= 0; --k) bk = (v[k] == best) ? k : bk;
        float nm = -INFINITY;
#pragma unroll
        for (int k = 0; k < 8; ++k) nm = fmaxf(nm, (k == bk) ? -INFINITY : v[k]);
        row[bg * 8 + bk] = -INFINITY;
#pragma unroll
        for (int gidx = 0; gidx < 16; ++gidx) gm[gidx] = (gidx == bg) ? nm : gm[gidx];
        TV[slot * 17 + p] = best; TI[slot * 17 + p] = (unsigned char)(bg * 8 + bk);
    }
}
__device__ __forceinline__ void p9_pair_top16(const Frame& F, LAS const float* TV, LAS const unsigned char* TI, int r1, int r2, int tok, int head) {
    float c[16];
    { const float v20 = TV[r2];
#pragma unroll
      for (int i = 0; i < 16; ++i) c[i] = TV[r1 + i] + v20; }
    unsigned long long ptrs = 0ull;
    float sv[16]; int se[16];
#pragma unroll
    for (int p = 0; p < 16; ++p) {
        float best = c[0]; int bi = 0;
#pragma unroll
        for (int i = 1; i < 16; ++i) { const bool gt = c[i] > best; best = gt ? c[i] : best; bi = gt ? i : bi; }
        const int bj = (int)((ptrs >> (4 * bi)) & 15ull);
        sv[p] = best; se[p] = (int)TI[r1 + bi] * 128 + (int)TI[r2 + bj];
        const float nv = (bj < 15) ? TV[r1 + bi] + TV[r2 + bj + 1] : -INFINITY;
        ptrs += (bj < 15) ? (1ull << (4 * bi)) : 0ull;
#pragma unroll
        for (int i = 0; i < 16; ++i) c[i] = (i == bi) ? nv : c[i];
    }
    const float mx0 = sv[0]; float den = 0.f;
#pragma unroll
    for (int p = 0; p < 16; ++p) { sv[p] = __expf(sv[p] - mx0); den += sv[p]; }
    const float dinv = 1.f / den;
    int* eo = F.EIDX + (size_t)tok * NEXP_SEL + head * 16; float* go = F.GW + (size_t)tok * NEXP_SEL + head * 16;
#pragma unroll
    for (int p = 0; p < 16; ++p) { eo[p] = se[p]; go[p] = sv[p] * dinv; }
}
constexpr int PR_ROW = 129, PR_ROWS = 256 + 4;
__device__ __forceinline__ void p9_route(const Frame& F) {
    LAS float* SC = (LAS float*)F.lds;
    LAS float* TV = (LAS float*)(F.lds + PR_ROWS * PR_ROW * 4);
    LAS unsigned char* TI = (LAS unsigned char*)(F.lds + PR_ROWS * PR_ROW * 4 + PR_ROWS * 17 * 4);
    const int lane = F.lane, r = lane & 31, h = lane >> 5;
    const int nunits = (NTP / 32) * 2;
    int k = 0;
    for (int it = F.bid; it < nunits; it += F.G, ++k) {
        const int tok0 = (it >> 1) * 32, hg = it & 1;
        const int ts = NTP + F.bid + F.G * (k >> 2), kh = k & 3;
        const bool has_s = ts < NT;
        __syncthreads();
        {
            const int head = hg * 4 + (F.wave >> 1), half = F.wave & 1;
            const bf16_t* KK = half ? F.K2 : F.K1;
            bf16x8 Bq[4], Bs[4];
#pragma unroll
            for (int s = 0; s < 4; ++s) Bq[s] = *(const bf16x8*)(F.QP + (size_t)(tok0 + r) * D + head * 128 + half * 64 + s * 16 + h * 8);
            const bool swave = has_s && F.wave < 4;
            if (swave) {
#pragma unroll
                for (int s = 0; s < 4; ++s) Bs[s] = *(const bf16x8*)(F.QP + (size_t)ts * D + (2 * kh + (F.wave >> 1)) * 128 + half * 64 + s * 16 + h * 8);
            }
#pragma unroll
            for (int kt = 0; kt < 4; ++kt) {
                f32x16 c, cs;
#pragma unroll
                for (int e = 0; e < 16; ++e) { c[e] = 0.f; cs[e] = 0.f; }
#pragma unroll
                for (int s = 0; s < 4; ++s) {
                    const bf16x8 Ak = *(const bf16x8*)(KK + (size_t)(kt * 32 + r) * 64 + s * 16 + h * 8);
                    c = __builtin_amdgcn_mfma_f32_32x32x16_bf16(Ak, Bq[s], c, 0, 0, 0);
                    if (swave) cs = __builtin_amdgcn_mfma_f32_32x32x16_bf16(Ak, Bs[s], cs, 0, 0, 0);
                }
#pragma unroll
                for (int e = 0; e < 16; ++e) { const int key = kt * 32 + (e & 3) + 8 * (e >> 2) + 4 * h; SC[(r * 8 + F.wave) * PR_ROW + key] = c[e]; }
                if (swave && r == 0) {
#pragma unroll
                    for (int e = 0; e < 16; ++e) { const int key = kt * 32 + (e & 3) + 8 * (e >> 2) + 4 * h; SC[(256 + F.wave) * PR_ROW + key] = cs[e]; }
                }
            }
        }
        __syncthreads();
        if (F.tid < 256 || (has_s && F.tid < 260)) p9_row_top16(SC + F.tid * PR_ROW, TV, TI, F.tid);
        __syncthreads();
        if (F.tid < 128) {
            const int tk = F.tid >> 2, hs = F.tid & 3;
            const int r1 = (tk * 8 + hs * 2) * 17;
            p9_pair_top16(F, TV, TI, r1, r1 + 17, tok0 + tk, hg * 4 + hs);
        } else if (has_s && F.tid < 130) {
            const int hs = F.tid - 128;
            const int r1 = (256 + hs * 2) * 17;
            p9_pair_top16(F, TV, TI, r1, r1 + 17, ts, 2 * kh + hs);
        }
    }
}

constexpr int TPW = 65, PAIRS_MAX = 9 * 128, PK = 4;
constexpr int P10_HROW = 1024 + 64;
constexpr int P10_H = 0;
constexpr int P10_SH = 32 * P10_HROW;
constexpr int P10_HIST = P10_SH + 128;
typedef int i32x8 __attribute__((ext_vector_type(8)));
__device__ __forceinline__ void p10_peer(const Frame& F) {
    const int lane = F.lane, w = F.wave;
    unsigned char* ws = F.ws;
    const unsigned char* PU8 = ws + WS_PU8; const unsigned char* PV8 = ws + WS_PV8;
    const float* SU = (const float*)(ws + WS_SU); const float* SV = (const float*)(ws + WS_SV);
    const unsigned char* H8 = ws + WS_H8; const float* SH = (const float*)(ws + WS_SH);
  for (int blk = F.bid; blk < NT / TPW; blk += F.G) {
    const int tok0 = blk * TPW;
    LAS unsigned* hist = (LAS unsigned*)(F.lds + P10_HIST) + w * 128;
    LAS float* SHl = (LAS float*)(F.lds + P10_SH);
    unsigned* SE0 = (unsigned*)(ws + WS_SE) + ((size_t)blk * 8 + w) * PAIRS_MAX;
    float* SG0 = (float*)(ws + WS_SG) + ((size_t)blk * 8 + w) * PAIRS_MAX;
    const int ntok = (w == 0) ? 9 : 8;
    const int r16 = lane & 15, q4 = lane >> 4;
#pragma unroll 1
    for (int pass = 0; pass < 3; ++pass) {
        const int kbase = pass * PK, nk = (ntok - kbase < PK) ? (ntok - kbase > 0 ? ntok - kbase : 0) : PK, npairs = nk * 128;
        __syncthreads();
        for (int c = F.tid; c < 32 * 64; c += NTHREADS) {
            const int row = c >> 6, tl = 32 * pass + row;
            if (tl < TPW) *(LAS u32x4*)(F.lds + P10_H + row * P10_HROW + (c & 63) * 16) = *(const u32x4*)(H8 + (size_t)(tok0 + tl) * D + (size_t)(c & 63) * 16);
        }
        if (F.tid < 32 && 32 * pass + F.tid < TPW) SHl[F.tid] = SH[tok0 + 32 * pass + F.tid];
        __syncthreads();
        if (nk <= 0) continue;
        unsigned* SE = SE0 + pass * (PK * 128); float* SG = SG0 + pass * (PK * 128);
        hist[lane] = 0u; hist[lane + 64] = 0u;
        int ex[8];
#pragma unroll
        for (int i = 0; i < 8; ++i) {
            const int p = lane + 64 * i;
            ex[i] = -1;
            if (p < npairs) { ex[i] = F.EIDX[(size_t)(tok0 + w + 8 * (kbase + (p >> 7))) * NEXP_SEL + (p & 127)]; atomicAdd((unsigned*)&hist[ex[i] >> 7], 1u); }
        }
        {
            const unsigned c0 = hist[2 * lane], c1 = hist[2 * lane + 1];
            unsigned incl = c0 + c1;
#pragma unroll
            for (int o = 1; o < 64; o <<= 1) { const unsigned t = __shfl_up(incl, o); if (lane >= o) incl += t; }
            const unsigned excl = incl - (c0 + c1);
            hist[2 * lane] = excl; hist[2 * lane + 1] = excl + c0;
        }
#pragma unroll
        for (int i = 0; i < 8; ++i) {
            const int p = lane + 64 * i;
            if (p < npairs) {
                const unsigned pos = atomicAdd((unsigned*)&hist[ex[i] >> 7], 1u);
                SE[pos] = (unsigned)ex[i] | ((unsigned)(p >> 7) << 14);
                SG[pos] = F.GW[(size_t)(tok0 + w + 8 * (kbase + (p >> 7))) * NEXP_SEL + (p & 127)];
            }
        }
        asm volatile("s_waitcnt vmcnt(0)" ::: "memory");
        f32x4 acc[16];
#pragma unroll
        for (int c = 0; c < 16; ++c) acc[c] = (f32x4){0.f, 0.f, 0.f, 0.f};
        const int ngr = npairs >> 4;
        const unsigned char* up = PU8 + q4 * 16;
        const unsigned char* vp = PV8 + lane * 8;
        int wr = (int)SE[r16]; float gr = SG[r16];
        int wrn = (int)SE[(ngr > 1 ? 16 : 0) + r16]; float grn = SG[(ngr > 1 ? 16 : 0) + r16];
        u32x4 U[8]; u32x2 V[16]; float suv, svv;
        {
            const int er = wr & 16383;
#pragma unroll
            for (int t = 0; t < 8; ++t) U[t] = *(const u32x4*)(up + (size_t)er * 512 + t * 64);
            suv = SU[er]; svv = SV[er];
        }
#pragma unroll
        for (int k = 0; k < 16; ++k) V[k] = *(const u32x2*)(vp + (size_t)(__builtin_amdgcn_readlane(wr, k) & 16383) * 512);
#pragma unroll 1
        for (int gi = 0; gi < ngr; ++gi) {
            const int sr = wr >> 14;
            LAS const unsigned char* hr = F.lds + P10_H + (w + 8 * sr) * P10_HROW + q4 * 16;
            const float shv = SHl[w + 8 * sr];
            f32x4 C0 = {0.f, 0.f, 0.f, 0.f}, C1 = {0.f, 0.f, 0.f, 0.f};
#pragma unroll
            for (int t = 0; t < 8; ++t) {
                const u32x4 h0 = *(LAS const u32x4*)(hr + t * 128), h1 = *(LAS const u32x4*)(hr + t * 128 + 64);
                const i32x8 Aop = {(int)h0[0], (int)h0[1], (int)h0[2], (int)h0[3], (int)h1[0], (int)h1[1], (int)h1[2], (int)h1[3]};
                const i32x8 Bop = {(int)U[t][0], (int)U[t][1], (int)U[t][2], (int)U[t][3], 0, 0, 0, 0};
                if (t & 1) C1 = __builtin_amdgcn_mfma_scale_f32_16x16x128_f8f6f4(Aop, Bop, C1, 0, 4, 0, 0x7f7f7f7f, 0, 0x7f7f7f7f);
                else       C0 = __builtin_amdgcn_mfma_scale_f32_16x16x128_f8f6f4(Aop, Bop, C0, 0, 4, 0, 0x7f7f7f7f, 0, 0x7f7f7f7f);
            }
            C0 = C0 + C1;
            const int rsel = lane & 3;
            const float dv = (rsel == 0 ? C0[0] : (rsel == 1 ? C0[1] : (rsel == 2 ? C0[2] : C0[3]))) * (suv * shv);
            const int actv = __float_as_int(gelu_tanh(dv) * (gr * svv));
            {
                const int er = wrn & 16383;
#pragma unroll
                for (int t = 0; t < 8; ++t) U[t] = *(const u32x4*)(up + (size_t)er * 512 + t * 64);
                suv = SU[er]; svv = SV[er];
            }
            const int g2 = (gi + 2 < ngr) ? gi + 2 : 0;
            const int wr2 = (int)SE[g2 * 16 + r16]; const float gr2 = SG[g2 * 16 + r16];
#pragma unroll
            for (int k = 0; k < 16; ++k) {
                const float actk = __int_as_float(__builtin_amdgcn_readlane(actv, 16 * (k >> 2) + k));
                const int slot = __builtin_amdgcn_readlane(wr, k) >> 14;
                const float aw = (slot == (lane & 3)) ? actk : 0.f;
                const u32x2 vv = V[k];
                V[k] = *(const u32x2*)(vp + (size_t)(__builtin_amdgcn_readlane(wrn, k) & 16383) * 512);
#define P10_VSTEP(J) { const f32x2_t tv = __builtin_amdgcn_cvt_scalef32_pk_f32_fp4(vv[(J) >> 2], 1.0f, (J) & 3); \
                       acc[2 * (J)] = __builtin_amdgcn_mfma_f32_4x4x1f32(aw, tv[0], acc[2 * (J)], 0, 0, 0); \
                       acc[2 * (J) + 1] = __builtin_amdgcn_mfma_f32_4x4x1f32(aw, tv[1], acc[2 * (J) + 1], 0, 0, 0); }
                P10_VSTEP(0) P10_VSTEP(1) P10_VSTEP(2) P10_VSTEP(3) P10_VSTEP(4) P10_VSTEP(5) P10_VSTEP(6) P10_VSTEP(7)
#undef P10_VSTEP
            }
            wr = wrn; gr = grn; wrn = wr2; grn = gr2;
        }
        float x1v[PK][16];
#pragma unroll
        for (int k = 0; k < PK; ++k) {
            const int m = tok0 + w + 8 * (kbase + (k < nk ? k : 0));
#pragma unroll
            for (int c = 0; c < 16; ++c) x1v[k][c] = F.T1[(size_t)m * D + c * 64 + lane];
        }
#pragma unroll
        for (int k = 0; k < PK; ++k) {
            if (k >= nk) continue;
            const int m = tok0 + w + 8 * (kbase + k);
            const float* mr = F.MOD + (size_t)mod_row(m) * 6144 + 5120;
            float tv[16]; float s = 0.f;
#pragma unroll
            for (int c = 0; c < 16; ++c) { const float t = x1v[k][c] * DN_ALPHA + mr[c * 64 + lane] * acc[c][k]; tv[c] = t; s += t; }
            const float mean = wave_sum(s) * (1.f / D);
            float q = 0.f;
#pragma unroll
            for (int c = 0; c < 16; ++c) { tv[c] -= mean; q += tv[c] * tv[c]; }
            const float rstd = rsqrtf(wave_sum(q) * (1.f / D) + LN_EPS);
            float* yo = (m < NTP) ? F.out + O_YP + (size_t)m * D : F.out + O_YS + (size_t)(m - NTP) * D;
#pragma unroll
            for (int c = 0; c < 16; ++c) yo[c * 64 + lane] = tv[c] * rstd * F.ln2_g[c * 64 + lane] + F.ln2_b[c * 64 + lane];
        }
    }
  }
}

constexpr int N_PHASES = 11;
__global__ void __launch_bounds__(NTHREADS, 2) fwd_kernel(Args args) {
    extern __shared__ __attribute__((aligned(16))) unsigned char lds_raw[];
    Frame F;
    F.lds = (LAS unsigned char*)lds_raw;
    F.tid = threadIdx.x; F.lane = F.tid & 63; F.wave = __builtin_amdgcn_readfirstlane(F.tid >> 6); F.G = gridDim.x; F.bid = blockIdx.x;
    F.x_p = (const float*)args.in[0]; F.x_s = (const float*)args.in[1]; F.c_p = (const float*)args.in[2]; F.c_s = (const float*)args.in[3];
    F.cache_k = (const float*)args.in[4]; F.cache_v = (const float*)args.in[5]; F.cache_ki = (const float*)args.in[6]; F.state_conv = (const float*)args.in[7];
    F.page_table = (const int*)args.in[8]; F.rel_bias = (const float*)args.in[9]; F.w_ada = (const float*)args.in[10]; F.b_ada = (const float*)args.in[11];
    F.w_in = (const float*)args.in[12]; F.conv_w = (const float*)args.in[13]; F.conv_b = (const float*)args.in[14]; F.w_o_attn = (const float*)args.in[15];
    F.w_o_conv = (const float*)args.in[16]; F.w_out = (const float*)args.in[17]; F.ln1_g = (const float*)args.in[18]; F.ln1_b = (const float*)args.in[19];
    F.ln2_g = (const float*)args.in[20]; F.ln2_b = (const float*)args.in[21]; F.peer_wq = (const float*)args.in[22]; F.peer_k1 = (const float*)args.in[23];
    F.peer_k2 = (const float*)args.in[24]; F.peer_u = (const float*)args.in[25]; F.peer_v = (const float*)args.in[26];
    F.out = args.out;
    unsigned char* ws = args.ws; F.ws = ws;
    F.MOD = (float*)(ws + WS_MOD); F.WIN = (bf16_t*)(ws + WS_WIN); F.WOA = (bf16_t*)(ws + WS_WOA); F.WOC = (bf16_t*)(ws + WS_WOC);
    F.WOUT = (bf16_t*)(ws + WS_WOUT); F.WQ = (bf16_t*)(ws + WS_WQ); F.K1 = (bf16_t*)(ws + WS_K1); F.K2 = (bf16_t*)(ws + WS_K2);
    F.PU = (bf16_t*)(ws + WS_PU); F.PV = (bf16_t*)(ws + WS_PV); F.H1 = (bf16_t*)(ws + WS_H1); F.PROJ = (bf16_t*)(ws + WS_PROJ);
    F.WI = (float*)(ws + WS_WI); F.SEL = (int*)(ws + WS_SEL); F.OATT = (bf16_t*)(ws + WS_OATT); F.OCONV = (bf16_t*)(ws + WS_OCONV);
    F.MERGED = (bf16_t*)(ws + WS_MERGED); F.T1 = (float*)(ws + WS_T1); F.H2 = (bf16_t*)(ws + WS_H2); F.QP = (bf16_t*)(ws + WS_QP);
    F.EIDX = (int*)(ws + WS_EIDX); F.GW = (float*)(ws + WS_GW);
    volatile LAS unsigned* misc = (volatile LAS unsigned*)(F.lds + LDS_MISC);
    if (F.tid < 16) misc[F.tid] = 0u;
    __syncthreads();
    XcdBarrier bar; bar.bar = (unsigned*)(ws + WS_CTL); bar.x = 0; bar.st = misc;
    const int lo = args.ph_lo, hi = args.ph_hi;
    if (hi - lo > 1) bar = xcd_barrier_post((unsigned*)(ws + WS_CTL), misc);
#define IN(k) (lo <= (k) && (k) < hi)
#define SEAM(k) do { if (IN(k) && IN((k) + 1)) xcd_barrier(bar); } while (0)
    if (IN(0)) p0_prologue(F);       SEAM(0);
    if (IN(1)) p1_modulate(F);       SEAM(1);
    if (IN(2)) p2_gemm_in(F);        SEAM(2);
    if (IN(3)) p3_index(F);          SEAM(3);
    if (IN(4)) p4_attention(F);      SEAM(4);
    if (IN(5)) p5_gemm_merge(F);     SEAM(5);
    if (IN(6)) p6_gemm_out(F);       SEAM(6);
    if (IN(7)) p7_ln1(F);            SEAM(7);
    if (IN(8)) p8_gemm_q(F);         SEAM(8);
    if (IN(9)) p9_route(F);          SEAM(9);
    if (IN(10)) p10_peer(F);
#undef IN
#undef SEAM
}

extern "C" void kernel_launch(void* const* d_in, const int* in_sizes, int n_in, void* d_out, int out_size, void* d_ws, size_t ws_size, hipStream_t stream) {
    static int grid = 0;
    if (grid == 0) {
        if (n_in != 27 || (size_t)out_size != O_END || ws_size < WS_END) { fprintf(stderr, "kernel_launch: unexpected shapes (n_in %d out %d ws %zu)\n", n_in, out_size, ws_size); grid = -1; return; }
        int dev = 0, cus = 0;
        if (hipGetDevice(&dev) != hipSuccess || hipDeviceGetAttribute(&cus, hipDeviceAttributeMultiprocessorCount, dev) != hipSuccess) { grid = -1; return; }
        if (hipFuncSetAttribute((const void*)fwd_kernel, hipFuncAttributeMaxDynamicSharedMemorySize, LDS_BYTES) != hipSuccess) { fprintf(stderr, "kernel_launch: hipFuncSetAttribute failed\n"); grid = -1; return; }
        (void)hipGetLastError();
        grid = cus < 256 ? cus : 256;
    }
    if (grid < 0) return;
    (void)hipMemsetAsync((char*)d_ws + WS_CTL, 0, CTL_ZERO_BYTES, stream);
    Args a{};
    for (int i = 0; i < 27; ++i) a.in[i] = d_in[i];
    a.out = (float*)d_out; a.ws = (unsigned char*)d_ws;
#if N_LAUNCHES == 1
    a.ph_lo = 0; a.ph_hi = N_PHASES;
    hipLaunchKernelGGL(fwd_kernel, dim3(grid), dim3(NTHREADS), LDS_BYTES, stream, a);
#else
    for (int p = 0; p < N_PHASES; ++p) { a.ph_lo = p; a.ph_hi = p + 1; hipLaunchKernelGGL(fwd_kernel, dim3(grid), dim3(NTHREADS), LDS_BYTES, stream, a); }
#endif
}
```

```cpp
#include <hip/hip_runtime.h>
#include <cstdio>
#include <cstdint>

#ifndef N_LAUNCHES
#define N_LAUNCHES 1
#endif

typedef unsigned short bf16_t;
typedef short bf16x8 __attribute__((ext_vector_type(8)));
typedef float f32x4 __attribute__((ext_vector_type(4)));
typedef float f32x16 __attribute__((ext_vector_type(16)));
typedef unsigned u32x4 __attribute__((ext_vector_type(4)));
typedef unsigned u32x2 __attribute__((ext_vector_type(2)));
#define LAS __attribute__((address_space(3)))

constexpr int D = 1024, NB_P = 8, SEQ = 2048, NB_S = 32, TS = 8, PAST = 8192, PAGE = 128, NPAGES = 64;
constexpr int NTP = NB_P * SEQ;
constexpr int NTS = NB_S * TS;
constexpr int NT = NTP + NTS;
constexpr int NMIX = 4676, NMIXP = 4736;
constexpr int C_Q = 0, C_K = 512, C_V = 640, C_QI = 768, C_KI = 1024, C_BG = 1088, C_CG = 1600, C_XIN = 2112, C_GA = 2624, C_GB = 3648, C_WI = 4672;
constexpr int NSEL = 256;
constexpr float ATTN_SCALE = 0.125f, IDX_SCALE = 0.0625f;
constexpr float DN_ALPHA = 1.189207115002721f, LN_EPS = 1e-5f;
constexpr int NEXP_SEL = 128;

constexpr size_t O_YP = 0, O_YS = 16777216, O_KP = 17039360, O_VP = 19136512, O_KIP = 21233664, O_CP = 22282240,
                 O_KS = 22290432, O_VS = 22323200, O_KIS = 22355968, O_CS = 22372352, O_END = 22405120;

constexpr size_t MB = 1048576;
constexpr size_t WS_CTL = 0, WS_MOD = 1 * MB, WS_WIN = 2 * MB, WS_WOA = 12 * MB, WS_WOC = 13 * MB, WS_WOUT = 14 * MB, WS_WQ = 16 * MB,
                 WS_K1 = 18 * MB, WS_K2 = 18 * MB + 65536, WS_PU = 20 * MB, WS_PV = 52 * MB, WS_H1 = 84 * MB, WS_PROJ = 118 * MB,
                 WS_WI = 270 * MB, WS_SEL = 271 * MB, WS_OATT = 288 * MB, WS_OCONV = 305 * MB, WS_MERGED = 322 * MB, WS_T1 = 355 * MB,
                 WS_H2 = 420 * MB, WS_QP = 453 * MB, WS_EIDX = 486 * MB, WS_GW = 495 * MB, WS_SS = 504 * MB, WS_SE = 513 * MB, WS_SG = 523 * MB, WS_VT = 533 * MB, WS_CGX = 538 * MB, WS_END = 539 * MB;
constexpr size_t WS_PU8 = WS_PU, WS_PV8 = WS_PU + 16 * MB, WS_SU = WS_PV, WS_SV = WS_PV + 65536, WS_H8 = WS_PV + 1 * MB, WS_SH = WS_PV + 20 * MB;
constexpr int CTL_ZERO_BYTES = 65536;

constexpr int NTHREADS = 512;
constexpr int LDS_BYTES = 160 * 1024 - 512;
constexpr int LDS_MISC = LDS_BYTES - 64;

__device__ __forceinline__ float bf2f(bf16_t b) { return __uint_as_float(((unsigned)b) << 16); }
__device__ __forceinline__ float bflo(unsigned p) { return __uint_as_float(p << 16); }
__device__ __forceinline__ float bfhi(unsigned p) { return __uint_as_float(p & 0xFFFF0000u); }
typedef __bf16 bf16x2_t __attribute__((ext_vector_type(2)));
typedef float f32x2_t __attribute__((ext_vector_type(2)));
__device__ __forceinline__ unsigned cvt_pk_bf16(float lo, float hi) { const f32x2_t f = {lo, hi}; const bf16x2_t b = __builtin_convertvector(f, bf16x2_t); unsigned r; __builtin_memcpy(&r, &b, 4); return r; }
__device__ __forceinline__ bf16_t f2bf(float f) { return (bf16_t)(cvt_pk_bf16(f, 0.f) & 0xFFFFu); }
__device__ __forceinline__ float wave_sum(float v) {
#pragma unroll
    for (int o = 32; o >= 1; o >>= 1) v += __shfl_xor(v, o);
    return v;
}
__device__ __forceinline__ float wave_sum_dpp(float v) {
    int x;
    x = __builtin_amdgcn_update_dpp(0, __float_as_int(v), 0xB1, 0xF, 0xF, false);  v += __int_as_float(x);
    x = __builtin_amdgcn_update_dpp(0, __float_as_int(v), 0x4E, 0xF, 0xF, false);  v += __int_as_float(x);
    x = __builtin_amdgcn_update_dpp(0, __float_as_int(v), 0x141, 0xF, 0xF, false); v += __int_as_float(x);
    x = __builtin_amdgcn_update_dpp(0, __float_as_int(v), 0x140, 0xF, 0xF, false); v += __int_as_float(x);
    x = __builtin_amdgcn_update_dpp(0, __float_as_int(v), 0x142, 0xA, 0xF, false); v += __int_as_float(x);
    x = __builtin_amdgcn_update_dpp(0, __float_as_int(v), 0x143, 0xC, 0xF, false); v += __int_as_float(x);
    return __int_as_float(__builtin_amdgcn_readlane(__float_as_int(v), 63));
}
__device__ __forceinline__ float wave_max(float v) {
#pragma unroll
    for (int o = 32; o >= 1; o >>= 1) v = fmaxf(v, __shfl_xor(v, o));
    return v;
}
__device__ __forceinline__ float sigmoidf_(float x) { return 1.f / (1.f + __expf(-x)); }
__device__ __forceinline__ float gelu_tanh(float a) {
    const float z = 0.7978845608028654f * (a + 0.044715f * a * a * a);
    const float e = __expf(2.f * z);
    const float t = 1.f - 2.f * __builtin_amdgcn_rcpf(e + 1.f);
    return 0.5f * a * (1.f + t);
}
__device__ __forceinline__ unsigned f2ord(float f) { const unsigned u = __float_as_uint(f); return (u & 0x80000000u) ? ~u : (u | 0x80000000u); }
__device__ __forceinline__ int t5_bucket(int n) {
    if (n < 16) return n;
    int b = 16;
    b += (n >= 19) + (n >= 21) + (n >= 24) + (n >= 27) + (n >= 31) + (n >= 35) + (n >= 40) + (n >= 46) + (n >= 52) + (n >= 59) + (n >= 67) + (n >= 77) + (n >= 87) + (n >= 99) + (n >= 113);
    return b;
}

#define XB_TMO      128
#define XB_XCNT(j)  (256  + 64 * (j))
#define XB_XSUB(j)  (1280 + 64 * (j))
#define XB_XGEN(j)  (2304 + 64 * (j))
#define XB_TOP      3328
#define XB_TOPGEN   3392
#define XCD_BAR_WORDS 3456
#define XB_SPIN_CAP (1u << 18)
__device__ __forceinline__ unsigned xb_ld(unsigned* p)              { return __hip_atomic_load(p, __ATOMIC_RELAXED, __HIP_MEMORY_SCOPE_AGENT); }
__device__ __forceinline__ unsigned xb_add(unsigned* p, unsigned v) { return __hip_atomic_fetch_add(p, v, __ATOMIC_RELAXED, __HIP_MEMORY_SCOPE_AGENT); }
__device__ __forceinline__ unsigned xb_xcc_id() { return (unsigned)__builtin_amdgcn_s_getreg((3 << 11) | 20) & 0xFu; }
#define XB_SPIN(cond, bar) do { unsigned _sp = 0; while (cond) { __builtin_amdgcn_s_sleep(1); \
    if ((++_sp & 255u) == 0u) { if (xb_ld(&(bar)[XB_TMO])) break; if (_sp > XB_SPIN_CAP) { atomicAdd(&(bar)[XB_TMO], 1u); break; } } } } while (0)
struct XcdBarrier { unsigned* bar; unsigned x; volatile LAS unsigned* st; };
__device__ __forceinline__ XcdBarrier xcd_barrier_post(unsigned* bar, volatile LAS unsigned* st) {
    XcdBarrier b; b.bar = bar; b.x = xb_xcc_id(); b.st = st;
    if (threadIdx.x == 0) (void)xb_add(&bar[XB_XCNT(b.x)], 1u);
    return b;
}
__device__ __forceinline__ void xcd_barrier_complete(unsigned* bar, unsigned x, unsigned& nloc, unsigned& nx) {
    const unsigned G = gridDim.x * gridDim.y * gridDim.z;
    unsigned sum, cnt, mine, sp = 0u;
    for (;;) {
        sum = 0u; cnt = 0u; mine = 0u;
#pragma unroll
        for (unsigned j = 0; j < 16; ++j) { const unsigned c = xb_ld(&bar[XB_XCNT(j)]); sum += c; cnt += (c > 0u) ? 1u : 0u; mine = (j == x) ? c : mine; }
        if (sum == G) break;
        __builtin_amdgcn_s_sleep(1);
        if ((++sp & 255u) == 0u) { if (xb_ld(&bar[XB_TMO])) break; if (sp > XB_SPIN_CAP) { atomicAdd(&bar[XB_TMO], 1u); break; } }
    }
    nloc = mine > 0u ? mine : 1u; nx = cnt > 0u ? cnt : 1u;
}
__device__ __forceinline__ void xcd_barrier(const XcdBarrier& b) {
    asm volatile("s_waitcnt vmcnt(0)" ::: "memory");
    __syncthreads();
    if (threadIdx.x == 0) {
        unsigned* bar = b.bar;
        __builtin_amdgcn_s_waitcnt(0);
        unsigned nloc = b.st[0], nx = b.st[1];
        if (nloc == 0u) { xcd_barrier_complete(bar, b.x, nloc, nx); b.st[0] = nloc; b.st[1] = nx; }
        const unsigned old = xb_add(&bar[XB_XSUB(b.x)], 1u);
        const unsigned gen = old / nloc;
        if (old + 1u == (gen + 1u) * nloc) {
            __builtin_amdgcn_fence(__ATOMIC_RELEASE, "agent");
            asm volatile("s_waitcnt vmcnt(0)" ::: "memory");
            const unsigned og = xb_add(&bar[XB_TOP], 1u);
            const unsigned tg = og / nx;
            if (og + 1u == (tg + 1u) * nx) xb_add(&bar[XB_TOPGEN], 1u);
            else XB_SPIN(xb_ld(&bar[XB_TOPGEN]) == tg, bar);
            __builtin_amdgcn_fence(__ATOMIC_ACQUIRE, "agent");
            xb_add(&bar[XB_XGEN(b.x)], 1u);
            asm volatile("s_waitcnt vmcnt(0)" ::: "memory");
        } else {
            XB_SPIN(xb_ld(&bar[XB_XGEN(b.x)]) == gen, bar);
            __builtin_amdgcn_fence(__ATOMIC_ACQUIRE, "agent");
            asm volatile("s_waitcnt vmcnt(0)" ::: "memory");
        }
    }
    __syncthreads();
}

struct Args { const void* in[27]; float* out; unsigned char* ws; int ph_lo, ph_hi; };
struct Core { LAS unsigned char* lds; int tid, lane, wave, G, bid; };
struct Frame {
    LAS unsigned char* lds;
    int tid, lane, wave, G, bid;
    const float *x_p, *x_s, *c_p, *c_s, *cache_k, *cache_v, *cache_ki, *state_conv, *rel_bias, *w_ada, *b_ada, *w_in, *conv_w, *conv_b,
                *w_o_attn, *w_o_conv, *w_out, *ln1_g, *ln1_b, *ln2_g, *ln2_b, *peer_wq, *peer_k1, *peer_k2, *peer_u, *peer_v;
    const int* page_table;
    float* out; unsigned char* ws;
    float* MOD; bf16_t *WIN, *WOA, *WOC, *WOUT, *WQ, *K1, *K2, *PU, *PV, *H1, *PROJ, *OATT, *OCONV, *MERGED, *H2, *QP;
    float *WI, *T1, *GW; int *SEL, *EIDX;
};
constexpr int LDS_PTAB = LDS_BYTES - 512;
__device__ __forceinline__ unsigned char* ldptr(const Core& C, int k) {
    LAS const unsigned* p = (LAS const unsigned*)(C.lds + LDS_PTAB) + 2 * k;
    const unsigned lo = __builtin_amdgcn_readfirstlane(p[0]), hi = __builtin_amdgcn_readfirstlane(p[1]);
    return (unsigned char*)(((unsigned long long)hi << 32) | (unsigned long long)lo);
}
__device__ __forceinline__ void load_frame(Frame& F, const Core& C) {
    F.lds = C.lds; F.tid = C.tid; F.lane = C.lane; F.wave = C.wave; F.G = C.G; F.bid = C.bid;
    F.x_p = (const float*)ldptr(C, 0); F.x_s = (const float*)ldptr(C, 1); F.c_p = (const float*)ldptr(C, 2); F.c_s = (const float*)ldptr(C, 3);
    F.cache_k = (const float*)ldptr(C, 4); F.cache_v = (const float*)ldptr(C, 5); F.cache_ki = (const float*)ldptr(C, 6); F.state_conv = (const float*)ldptr(C, 7);
    F.page_table = (const int*)ldptr(C, 8); F.rel_bias = (const float*)ldptr(C, 9); F.w_ada = (const float*)ldptr(C, 10); F.b_ada = (const float*)ldptr(C, 11);
    F.w_in = (const float*)ldptr(C, 12); F.conv_w = (const float*)ldptr(C, 13); F.conv_b = (const float*)ldptr(C, 14); F.w_o_attn = (const float*)ldptr(C, 15);
    F.w_o_conv = (const float*)ldptr(C, 16); F.w_out = (const float*)ldptr(C, 17); F.ln1_g = (const float*)ldptr(C, 18); F.ln1_b = (const float*)ldptr(C, 19);
    F.ln2_g = (const float*)ldptr(C, 20); F.ln2_b = (const float*)ldptr(C, 21); F.peer_wq = (const float*)ldptr(C, 22); F.peer_k1 = (const float*)ldptr(C, 23);
    F.peer_k2 = (const float*)ldptr(C, 24); F.peer_u = (const float*)ldptr(C, 25); F.peer_v = (const float*)ldptr(C, 26);
    F.out = (float*)ldptr(C, 27);
    unsigned char* ws = ldptr(C, 28);
    F.MOD = (float*)(ws + WS_MOD); F.WIN = (bf16_t*)(ws + WS_WIN); F.WOA = (bf16_t*)(ws + WS_WOA); F.WOC = (bf16_t*)(ws + WS_WOC);
    F.WOUT = (bf16_t*)(ws + WS_WOUT); F.WQ = (bf16_t*)(ws + WS_WQ); F.K1 = (bf16_t*)(ws + WS_K1); F.K2 = (bf16_t*)(ws + WS_K2);
    F.PU = (bf16_t*)(ws + WS_PU); F.PV = (bf16_t*)(ws + WS_PV); F.H1 = (bf16_t*)(ws + WS_H1); F.PROJ = (bf16_t*)(ws + WS_PROJ);
    F.WI = (float*)(ws + WS_WI); F.SEL = (int*)(ws + WS_SEL); F.OATT = (bf16_t*)(ws + WS_OATT); F.OCONV = (bf16_t*)(ws + WS_OCONV);
    F.MERGED = (bf16_t*)(ws + WS_MERGED); F.T1 = (float*)(ws + WS_T1); F.H2 = (bf16_t*)(ws + WS_H2); F.QP = (bf16_t*)(ws + WS_QP);
    F.EIDX = (int*)(ws + WS_EIDX); F.GW = (float*)(ws + WS_GW);
}
__device__ __forceinline__ const float* x_row(const Frame& F, int m) { return m < NTP ? F.x_p + (size_t)m * D : F.x_s + (size_t)(m - NTP) * D; }
__device__ __forceinline__ int mod_row(int m) { return m < NTP ? (m >> 11) : NB_P + ((m - NTP) >> 3); }

constexpr int P0_MOD_ITEMS = 96;
constexpr int P0_T_WIN = 16 * 74, P0_T_WOA = 8 * 16, P0_T_WOC = 8 * 16, P0_T_WOUT = 16 * 16, P0_T_WQ = 16 * 16;
constexpr int P0_T_ITEMS = P0_T_WIN + P0_T_WOA + P0_T_WOC + P0_T_WOUT + P0_T_WQ;
constexpr int P0_CVT_ITEMS = 2 * (16384 * 1024 / 8192);
constexpr int P0_MISC_ITEMS = 1;
constexpr int P0_ITEMS = P0_MOD_ITEMS + P0_T_ITEMS + P0_CVT_ITEMS + P0_MISC_ITEMS;

__device__ __forceinline__ void p0_mod_item(const Frame& F, int ng) {
    LAS float* cs = (LAS float*)F.lds;
    LAS float* red = (LAS float*)(F.lds + 40 * 256 * 4);
    float acc[40];
#pragma unroll
    for (int r = 0; r < 40; ++r) acc[r] = 0.f;
    const int n = ng * 64 + F.lane;
    for (int kc = 0; kc < 4; ++kc) {
        __syncthreads();
#pragma unroll 1
        for (int hb = 0; hb < 2; ++hb) {
            float cv[10];
#pragma unroll
            for (int i = 0; i < 10; ++i) { const int e = F.tid + (hb * 10 + i) * NTHREADS; const int r = e >> 8, k = e & 255; cv[i] = (r < 8) ? F.c_p[r * D + kc * 256 + k] : F.c_s[(r - 8) * D + kc * 256 + k]; }
#pragma unroll
            for (int i = 0; i < 10; ++i) cs[F.tid + (hb * 10 + i) * NTHREADS] = cv[i];
        }
        __syncthreads();
        float wvv[32];
#pragma unroll
        for (int kk = 0; kk < 32; ++kk) wvv[kk] = F.w_ada[(size_t)(kc * 256 + F.wave * 32 + kk) * 6144 + n];
#pragma unroll
        for (int kk = 0; kk < 32; ++kk) {
            const int kl = F.wave * 32 + kk;
#pragma unroll
            for (int r = 0; r < 40; ++r) acc[r] += cs[r * 256 + kl] * wvv[kk];
        }
    }
#pragma unroll
    for (int r = 0; r < 40; ++r) red[(F.wave * 40 + r) * 64 + F.lane] = acc[r];
    __syncthreads();
    for (int e = F.tid; e < 40 * 64; e += NTHREADS) {
        const int r = e >> 6, l = e & 63; float s = F.b_ada[ng * 64 + l];
#pragma unroll
        for (int w = 0; w < 8; ++w) s += red[(w * 40 + r) * 64 + l];
        F.MOD[r * 6144 + ng * 64 + l] = s;
    }
    __syncthreads();
}
__device__ __forceinline__ void p0_transpose_tile(const Frame& F, const float* W, int N, int K, bf16_t* Wt, int kt, int nt, bool permute) {
    LAS bf16_t* tile = (LAS bf16_t*)F.lds;
    __syncthreads();
    { const int k = F.tid >> 3, c0 = (F.tid & 7) * 8;
      const float* rp = W + (size_t)(kt * 64 + k) * N + nt * 64 + c0;
      const f32x4 z = {0.f, 0.f, 0.f, 0.f};
      const f32x4 v0 = (nt * 64 + c0 < N) ? *(const f32x4*)rp : z, v1 = (nt * 64 + c0 + 4 < N) ? *(const f32x4*)(rp + 4) : z;
#pragma unroll
      for (int j = 0; j < 4; ++j) { tile[k * 66 + c0 + j] = f2bf(v0[j]); tile[k * 66 + c0 + 4 + j] = f2bf(v1[j]); } }
    __syncthreads();
    { const int nl = F.tid >> 3, k0 = (F.tid & 7) * 8; const int n = nt * 64 + nl;
      if (n < N) {
          int nd = n; if (permute) nd = (n < 1024) ? n : (n < 1028 ? C_WI + (n - 1024) : n - 4);
          unsigned p[4];
#pragma unroll
          for (int j = 0; j < 4; ++j) p[j] = (unsigned)tile[(k0 + 2 * j) * 66 + nl] | ((unsigned)tile[(k0 + 2 * j + 1) * 66 + nl] << 16);
          *(u32x4*)(Wt + (size_t)nd * K + kt * 64 + k0) = (u32x4){p[0], p[1], p[2], p[3]};
      } }
}
constexpr int P0_CVT32_ITEMS = 2 * (16384 / 32);
constexpr int P0_OTHER = P0_T_ITEMS + P0_CVT32_ITEMS + 1;
__device__ __forceinline__ void p0_other_item(const Frame& F, int i) {
    if (i < P0_T_ITEMS) {
        if (i < P0_T_WIN) { p0_transpose_tile(F, F.w_in, NMIX, D, F.WIN, i / 74, i % 74, true); return; }
        i -= P0_T_WIN;
        if (i < P0_T_WOA) { p0_transpose_tile(F, F.w_o_attn, D, 512, F.WOA, i / 16, i % 16, false); return; }
        i -= P0_T_WOA;
        if (i < P0_T_WOC) { p0_transpose_tile(F, F.w_o_conv, D, 512, F.WOC, i / 16, i % 16, false); return; }
        i -= P0_T_WOC;
        if (i < P0_T_WOUT) { p0_transpose_tile(F, F.w_out, D, D, F.WOUT, i / 16, i % 16, false); return; }
        i -= P0_T_WOUT;
        p0_transpose_tile(F, F.peer_wq, D, D, F.WQ, i / 16, i % 16, false); return;
    }
    i -= P0_T_ITEMS;
    if (i < P0_CVT32_ITEMS) {
        const bool isu = i < 512;
        const float* src = isu ? F.peer_u : F.peer_v;
        unsigned char* dst = F.ws + (isu ? WS_PU8 : WS_PV8); float* sinv = (float*)(F.ws + (isu ? WS_SU : WS_SV));
        const int row0 = (i & 511) * 32 + F.wave * 4;
        float v[4][16];
        if (isu) {
#pragma unroll
            for (int rr = 0; rr < 4; ++rr)
#pragma unroll
                for (int q = 0; q < 4; ++q) {
                    const f32x4 t = *(const f32x4*)(src + (size_t)(row0 + rr) * D + F.lane * 16 + q * 4);
                    v[rr][4 * q] = t[0]; v[rr][4 * q + 1] = t[1]; v[rr][4 * q + 2] = t[2]; v[rr][4 * q + 3] = t[3];
                }
        } else {
#pragma unroll
            for (int rr = 0; rr < 4; ++rr)
#pragma unroll
                for (int c = 0; c < 16; ++c) v[rr][c] = src[(size_t)(row0 + rr) * D + c * 64 + F.lane];
        }
#pragma unroll
        for (int rr = 0; rr < 4; ++rr) {
            float am = 0.f;
#pragma unroll
            for (int c = 0; c < 16; ++c) am = fmaxf(am, fabsf(v[rr][c]));
            am = wave_max(am);
            const float sc = am > 0.f ? 6.f / am : 1.f;
            unsigned w0 = 0u, w1 = 0u;
            w0 = __builtin_amdgcn_cvt_scalef32_pk_fp4_f32(w0, v[rr][0] * sc, v[rr][1] * sc, 1.0f, 0);
            w0 = __builtin_amdgcn_cvt_scalef32_pk_fp4_f32(w0, v[rr][2] * sc, v[rr][3] * sc, 1.0f, 1);
            w0 = __builtin_amdgcn_cvt_scalef32_pk_fp4_f32(w0, v[rr][4] * sc, v[rr][5] * sc, 1.0f, 2);
            w0 = __builtin_amdgcn_cvt_scalef32_pk_fp4_f32(w0, v[rr][6] * sc, v[rr][7] * sc, 1.0f, 3);
            w1 = __builtin_amdgcn_cvt_scalef32_pk_fp4_f32(w1, v[rr][8] * sc, v[rr][9] * sc, 1.0f, 0);
            w1 = __builtin_amdgcn_cvt_scalef32_pk_fp4_f32(w1, v[rr][10] * sc, v[rr][11] * sc, 1.0f, 1);
            w1 = __builtin_amdgcn_cvt_scalef32_pk_fp4_f32(w1, v[rr][12] * sc, v[rr][13] * sc, 1.0f, 2);
            w1 = __builtin_amdgcn_cvt_scalef32_pk_fp4_f32(w1, v[rr][14] * sc, v[rr][15] * sc, 1.0f, 3);
            *(u32x2*)(dst + (size_t)(row0 + rr) * 512 + F.lane * 8) = (u32x2){w0, w1};
            if (F.lane == 0) sinv[row0 + rr] = am > 0.f ? am * (1.f / 6.f) : 1.f;
        }
        return;
    }
    for (int e = F.tid; e < (4864 - NMIX) * D; e += NTHREADS) F.WIN[(size_t)NMIX * D + e] = 0;
    for (int e = F.tid; e < 128 * 64; e += NTHREADS) { F.K1[e] = f2bf(F.peer_k1[e]); F.K2[e] = f2bf(F.peer_k2[e]); }
}
__device__ __forceinline__ void p0_prologue(const Frame& F) {
    constexpr int NMODWG = P0_MOD_ITEMS, HEAD = 8;
    if (F.G <= NMODWG) {
        for (int it = F.bid; it < P0_MOD_ITEMS + P0_OTHER; it += F.G) { if (it < P0_MOD_ITEMS) p0_mod_item(F, it); else p0_other_item(F, it - P0_MOD_ITEMS); }
        return;
    }
    const int nfree = F.G - NMODWG;
    int head_items = HEAD * nfree; if (head_items > P0_OTHER) head_items = P0_OTHER;
    if (F.bid < NMODWG) p0_mod_item(F, F.bid);
    else for (int j = F.bid - NMODWG; j < head_items; j += nfree) p0_other_item(F, j);
    for (int j = head_items + F.bid; j < P0_OTHER; j += F.G) p0_other_item(F, j);
}

__device__ __forceinline__ void p1_modulate(const Frame& F) {
    const int stride = F.G * 8;
    for (int m0 = F.bid * 8 + F.wave; m0 < NT; m0 += 2 * stride) {
        f32x4 xv[2][4], sv[2][4], hv[2][4];
#pragma unroll
        for (int rr = 0; rr < 2; ++rr) {
            const int m = (m0 + rr * stride < NT) ? m0 + rr * stride : m0;
            const float* xr = x_row(F, m); const float* mr = F.MOD + (size_t)mod_row(m) * 6144;
#pragma unroll
            for (int q = 0; q < 4; ++q) {
                const int e = (q >> 1) * 512 + F.lane * 8 + (q & 1) * 4;
                xv[rr][q] = *(const f32x4*)(xr + e); sv[rr][q] = *(const f32x4*)(mr + 1024 + e); hv[rr][q] = *(const f32x4*)(mr + e);
            }
        }
#pragma unroll
        for (int rr = 0; rr < 2; ++rr) {
            const int m = m0 + rr * stride;
            if (m >= NT) continue;
#pragma unroll
            for (int hlf = 0; hlf < 2; ++hlf) {
                const f32x4 a = xv[rr][2 * hlf] * (sv[rr][2 * hlf] + 1.f) + hv[rr][2 * hlf], b2 = xv[rr][2 * hlf + 1] * (sv[rr][2 * hlf + 1] + 1.f) + hv[rr][2 * hlf + 1];
                *(u32x4*)(F.H1 + (size_t)m * D + hlf * 512 + F.lane * 8) = (u32x4){cvt_pk_bf16(a[0], a[1]), cvt_pk_bf16(a[2], a[3]), cvt_pk_bf16(b2[0], b2[1]), cvt_pk_bf16(b2[2], b2[3])};
            }
        }
    }
}

constexpr int BM = 256, BN = 128, BK = 64;
constexpr int XPANEL = BM * 32 + 32, WPANEL = BN * 32 + 32;
constexpr int XSTAGE = 4 * XPANEL, WSTAGE = 4 * WPANEL, GSTAGE = XSTAGE + WSTAGE;
__device__ __forceinline__ void gemm_accum(const Frame& F, f32x16 (&acc)[2][2], const bf16_t* __restrict__ X, int ldx, const bf16_t* __restrict__ W, int ldw, int K, int m0, int n0) {
    const int tid = F.tid, lane = F.lane, r = lane & 31, h = lane >> 5, wm = F.wave >> 1, wn = F.wave & 1;
    u32x4 xr[4], wr[2];
    const int nk = K / BK;
    const int crow = tid >> 3, ckc = tid & 7;
    const bf16_t* xg = X + (size_t)(m0 + crow) * ldx + ckc * 8;
    const bf16_t* wg = W + (size_t)(n0 + crow) * ldw + ckc * 8;
    const int ldso = (ckc >> 1) * 1  ;
    const int xoff = ldso * XPANEL + crow * 32 + (ckc & 1) * 16;
    const int woff = ldso * WPANEL + crow * 32 + (ckc & 1) * 16;
#pragma unroll
    for (int i = 0; i < 4; ++i) xr[i] = *(const u32x4*)(xg + (size_t)(64 * i) * ldx);
#pragma unroll
    for (int i = 0; i < 2; ++i) wr[i] = *(const u32x4*)(wg + (size_t)(64 * i) * ldw);
    __syncthreads();
    for (int kt = 0; kt < nk; ++kt) {
        LAS unsigned char* st = F.lds + (kt & 1) * GSTAGE;
#pragma unroll
        for (int i = 0; i < 4; ++i) *(LAS u32x4*)(st + xoff + i * 64 * 32) = xr[i];
#pragma unroll
        for (int i = 0; i < 2; ++i) *(LAS u32x4*)(st + XSTAGE + woff + i * 64 * 32) = wr[i];
        __syncthreads();
        if (kt + 1 < nk) {
#pragma unroll
            for (int i = 0; i < 4; ++i) xr[i] = *(const u32x4*)(xg + (size_t)(64 * i) * ldx + (kt + 1) * BK);
#pragma unroll
            for (int i = 0; i < 2; ++i) wr[i] = *(const u32x4*)(wg + (size_t)(64 * i) * ldw + (kt + 1) * BK);
        }
#pragma unroll
        for (int s = 0; s < 4; ++s) {
            bf16x8 a[2], b[2];
#pragma unroll
            for (int ni = 0; ni < 2; ++ni) a[ni] = *(LAS bf16x8*)(st + XSTAGE + s * WPANEL + (wn * 64 + ni * 32 + r) * 32 + h * 16);
#pragma unroll
            for (int mi = 0; mi < 2; ++mi) b[mi] = *(LAS bf16x8*)(st + s * XPANEL + (wm * 64 + mi * 32 + r) * 32 + h * 16);
#pragma unroll
            for (int mi = 0; mi < 2; ++mi)
#pragma unroll
                for (int ni = 0; ni < 2; ++ni) acc[mi][ni] = __builtin_amdgcn_mfma_f32_32x32x16_bf16(a[ni], b[mi], acc[mi][ni], 0, 0, 0);
        }
    }
}
#define GEMM_EPI_LOOP(...) \
    { const int r_ = F.lane & 31, h_ = F.lane >> 5, wm_ = F.wave >> 1, wn_ = F.wave & 1; \
      _Pragma("unroll") for (int mi = 0; mi < 2; ++mi) _Pragma("unroll") for (int ni = 0; ni < 2; ++ni) _Pragma("unroll") for (int g = 0; g < 4; ++g) { \
          const int m = m0 + wm_ * 64 + mi * 32 + r_; const int n = n0 + wn_ * 64 + ni * 32 + 8 * g + 4 * h_; __VA_ARGS__ } }
#define ACC4(A) ((f32x4){A[mi][ni][4 * g], A[mi][ni][4 * g + 1], A[mi][ni][4 * g + 2], A[mi][ni][4 * g + 3]})
__device__ __forceinline__ void zero_acc(f32x16 (&acc)[2][2]) {
#pragma unroll
    for (int mi = 0; mi < 2; ++mi)
#pragma unroll
        for (int ni = 0; ni < 2; ++ni)
#pragma unroll
            for (int e = 0; e < 16; ++e) acc[mi][ni][e] = 0.f;
}
__device__ __forceinline__ u32x2 pk4(const f32x4 v) { return (u32x2){cvt_pk_bf16(v[0], v[1]), cvt_pk_bf16(v[2], v[3])}; }

__device__ __forceinline__ void gemm_slice8(const Frame& F, f32x16 (&sacc)[1][1], const bf16_t* __restrict__ X, int ldx, const bf16_t* __restrict__ W, int ldw, int K, int m0, int n0) {
    const int r = F.lane & 31, h = F.lane >> 5, wq = F.wave & 3, kh = F.wave >> 2;
    const bf16_t* wp = W + (size_t)(n0 + 32 * wq + r) * ldw + kh * (K / 2) + h * 8;
    const bf16_t* xp = X + (size_t)(m0 + (r & 7)) * ldx + kh * (K / 2) + h * 8;
    f32x16 c;
#pragma unroll
    for (int e = 0; e < 16; ++e) c[e] = 0.f;
#pragma unroll 1
    for (int k0 = 0; k0 < K / 2; k0 += 128) {
        bf16x8 a[8], b[8];
#pragma unroll
        for (int t = 0; t < 8; ++t) { a[t] = *(const bf16x8*)(wp + k0 + t * 16); b[t] = *(const bf16x8*)(xp + k0 + t * 16); }
#pragma unroll
        for (int t = 0; t < 8; ++t) c = __builtin_amdgcn_mfma_f32_32x32x16_bf16(a[t], b[t], c, 0, 0, 0);
    }
    LAS float* cb = (LAS float*)F.lds + wq * (16 * 64);
    __syncthreads();
    if (kh == 1) {
#pragma unroll
        for (int e = 0; e < 16; ++e) cb[e * 64 + F.lane] = c[e];
    }
    __syncthreads();
    if (kh == 0) {
#pragma unroll
        for (int e = 0; e < 16; ++e) c[e] += cb[e * 64 + F.lane];
    }
    sacc[0][0] = c;
}
#define SLICE_EPI_LOOP(...) \
    if (F.wave < 4 && (F.lane & 31) < 8) { const int h_ = F.lane >> 5, wq_ = F.wave & 3; constexpr int mi = 0, ni = 0; \
      _Pragma("unroll") for (int g = 0; g < 4; ++g) { const int m = m0 + (F.lane & 31); const int n = n0 + wq_ * 32 + 8 * g + 4 * h_; __VA_ARGS__ } }

namespace pg8 {
#define PG8_LAS __attribute__((address_space(3)))
typedef unsigned short bf16_t;
typedef short bf16x8 __attribute__((ext_vector_type(8)));
typedef float f32x4 __attribute__((ext_vector_type(4)));
typedef unsigned u32x4 __attribute__((ext_vector_type(4)));
constexpr int BM = 256, BK = 64, HALF = 128, HTB = HALF * BK * 2  , STAGE_BYTES = 8 * HTB, NXCD = 8, WGM = 8;

__host__ __device__ __forceinline__ int lds_byte(int r, int c) { const int st = (r >> 4) * 2 + (c >> 5), rr = r & 15, cc = c & 31, ob = rr * 64 + cc * 2; return st * 1024 + (ob ^ (((ob >> 9) & 1) << 5)); }
__host__ __device__ __forceinline__ void stage_rc(int b, int& R, int& C) { const int st = b / 1024, sb = b % 1024, swz = sb ^ (((sb >> 9) & 1) << 5); R = (st >> 1) * 16 + swz / 64; C = (st & 1) * 32 + (swz % 64) / 2; }
__host__ __device__ __forceinline__ int perm32(int rho) { const int n = rho >> 4, i = rho & 15; return 8 * (i >> 2) + 4 * n + (i & 3); }

struct Unit { int pm, pn; };
struct Gemm { const bf16_t* A; const bf16_t* Bt; int M, N, K; };

struct StaticOrder {
    int nM, nN, nwg, G, c;
    __host__ __device__ void init(int M, int N, int G_, int c_) { nM = M / BM; nN = N / BM; nwg = nM * nN; G = G_; c = c_; }
    __host__ __device__ bool next(int i, Unit& u) const {
        const long L = (long)i * G + c; if (L >= nwg) return false;
        int wgid = (int)L; { const int q = nwg / NXCD, r = nwg % NXCD, xcd = wgid % NXCD, off = wgid / NXCD; wgid = (xcd < r ? xcd * (q + 1) : r * (q + 1) + (xcd - r) * q) + off; }
        const int nig = WGM * nN, gid = wgid / nig, fm = gid * WGM, gsz = (nM - fm) < WGM ? (nM - fm) : WGM;
        u.pm = fm + ((wgid % nig) % gsz); u.pn = (wgid % nig) / gsz; return true;
    }
    __device__ __forceinline__ void a_ready(const Unit&) const {}
    __device__ __forceinline__ void done(const Unit&) const {}
};

template <class Body> struct EpiRC {
    static constexpr bool PERM = false, AFTER_DRAIN = false;
    Body body;
    __device__ __forceinline__ void operator()(const f32x4 (&acc)[2][2][4][2], const Unit& u, int wr, int wc, int fr, int fq) const {
#pragma unroll
        for (int ai = 0; ai < 2; ++ai)
#pragma unroll
            for (int m = 0; m < 4; ++m) {
                const int row = u.pm * BM + ai * HALF + wr * 64 + m * 16 + fr;
#pragma unroll
                for (int bj = 0; bj < 2; ++bj)
#pragma unroll
                    for (int n = 0; n < 2; ++n) body(row, u.pn * BM + bj * HALF + wc * 32 + n * 16 + 4 * fq, acc[ai][bj][m][n]);
            }
    }
};
template <class Epi, class Sched, bool ALIGN_EPI = false, bool SP2 = false>
__device__ __forceinline__ void gemm_phase(PG8_LAS unsigned char* lds, const Gemm g, const Sched& S, const Epi& E) {
    const int tid = threadIdx.x, wid = __builtin_amdgcn_readfirstlane(tid >> 6), lane = tid & 63, wr = wid >> 2, wc = wid & 3, fr = lane & 15, fq = lane >> 4;
    const int K = g.K, nt = K / BK;
    unsigned voffA[2], voffB[2];
#pragma unroll
    for (int i = 0; i < 2; ++i) { int R, C; stage_rc(tid * 16 + i * 8192, R, C); const int Rb = Epi::PERM ? ((R & ~31) + perm32(R & 31)) : R;
        voffA[i] = (unsigned)(R * K + C) * 2u; voffB[i] = (unsigned)(Rb * K + C) * 2u; }
    const size_t kstep = (size_t)(BK * 2);
    const size_t hstep = (size_t)HALF * K * 2;
    const size_t tstep = 2 * hstep;
    const unsigned ldsw = (unsigned)wid * 1024u;
    const int aoff = lds_byte(wr * 64 + fr, fq * 8), boff = lds_byte(wc * 32 + fr, fq * 8);
#define PG8_SA(b, h) (((b) * 2 + (h)) * HTB)
#define PG8_SB(b, h) ((4 + (b) * 2 + (h)) * HTB)
#define PG8_STAGE(bufoff, gbase, voff) do { _Pragma("unroll") for (int _i = 0; _i < 2; ++_i) \
        __builtin_amdgcn_global_load_lds((const unsigned*)((const char*)(gbase) + (voff)[_i]), (PG8_LAS unsigned*)(lds + (bufoff) + ldsw + _i * 8192), 16, 0, 0); } while (0)
#define PG8_LDA(dst, b, h) do { _Pragma("unroll") for (int m = 0; m < 4; ++m) _Pragma("unroll") for (int k = 0; k < 2; ++k) dst[m][k] = *(const PG8_LAS bf16x8*)(lds + PG8_SA(b, h) + aoff + m * 2048 + k * 1024); } while (0)
#define PG8_LDB(dst, b, h) do { _Pragma("unroll") for (int n = 0; n < 2; ++n) _Pragma("unroll") for (int k = 0; k < 2; ++k) dst[n][k] = *(const PG8_LAS bf16x8*)(lds + PG8_SB(b, h) + boff + n * 2048 + k * 1024); } while (0)
#define PG8_MMA(ai, bj, At, Bt) do { __builtin_amdgcn_s_setprio(1); _Pragma("unroll") for (int m = 0; m < 4; ++m) _Pragma("unroll") for (int n = 0; n < 2; ++n) _Pragma("unroll") for (int k = 0; k < 2; ++k) \
        acc[ai][bj][m][n] = __builtin_amdgcn_mfma_f32_16x16x32_bf16(Bt[n][k], At[m][k], acc[ai][bj][m][n], 0, 0, 0); __builtin_amdgcn_s_setprio(0); } while (0)
#define PG8_WAIT_V(n) asm volatile("s_waitcnt vmcnt(" #n ")" ::: "memory")
#define PG8_WAIT_L(n) asm volatile("s_waitcnt lgkmcnt(" #n ")" ::: "memory")
#define PG8_BAR __builtin_amdgcn_s_barrier()
#define PG8_SCHED __builtin_amdgcn_sched_barrier(0)
    Unit cur, nxt; int ui = 0;
    if (!S.next(0, cur)) return;
    f32x4 acc[2][2][4][2];
#pragma unroll
    for (int a = 0; a < 2; ++a)
#pragma unroll
        for (int b = 0; b < 2; ++b)
#pragma unroll
            for (int m = 0; m < 4; ++m)
#pragma unroll
                for (int n = 0; n < 2; ++n) acc[a][b][m][n] = (f32x4){0.f, 0.f, 0.f, 0.f};
    bf16x8 At[4][2], B0[2][2], B1[2][2];
    const char* cA = (const char*)g.A + (size_t)cur.pm * tstep; const char* cB = (const char*)g.Bt + (size_t)cur.pn * tstep;
    S.a_ready(cur);
    if constexpr (SP2) {
        PG8_STAGE(PG8_SB(0, 0), cB, voffB); PG8_STAGE(PG8_SB(0, 1), cB + hstep, voffB); PG8_STAGE(PG8_SA(0, 0), cA, voffA); PG8_STAGE(PG8_SA(0, 1), cA + hstep, voffA);
        if (wr == 1) PG8_BAR;
        PG8_WAIT_V(2); PG8_BAR;
        PG8_STAGE(PG8_SB(1, 0), cB + kstep, voffB); PG8_STAGE(PG8_SA(1, 0), cA + kstep, voffA); PG8_STAGE(PG8_SB(1, 1), cB + hstep + kstep, voffB);
        PG8_WAIT_V(6); PG8_BAR;
    } else {
        PG8_STAGE(PG8_SB(0, 0), cB, voffB); PG8_STAGE(PG8_SA(0, 0), cA, voffA); PG8_STAGE(PG8_SB(0, 1), cB + hstep, voffB); PG8_STAGE(PG8_SA(0, 1), cA + hstep, voffA);
        if (wr == 1) PG8_BAR;
        PG8_WAIT_V(4); PG8_BAR;
        PG8_STAGE(PG8_SB(1, 0), cB + kstep, voffB); PG8_STAGE(PG8_SA(1, 0), cA + kstep, voffA); PG8_STAGE(PG8_SB(1, 1), cB + hstep + kstep, voffB);
        PG8_WAIT_V(6); PG8_BAR;
    }
    for (;;) {
        const bool has_next = S.next(ui + 1, nxt);
        const char* nA = has_next ? (const char*)g.A + (size_t)nxt.pm * tstep : cA; const char* nB = has_next ? (const char*)g.Bt + (size_t)nxt.pn * tstep : cB;
        for (int t = 0; t < nt; t += 2) {
            const bool last = (t == nt - 2);
            const char* a1 = cA + (size_t)(t + 1) * kstep;
            const char* a2 = last ? nA : cA + (size_t)(t + 2) * kstep; const char* b2 = last ? nB : cB + (size_t)(t + 2) * kstep;
            const char* a3 = a2 + kstep; const char* b3 = b2 + kstep;
            if (last && has_next) S.a_ready(nxt);
            if constexpr (SP2) {
            PG8_LDB(B0, 0, 0); PG8_LDB(B1, 0, 1); PG8_SCHED; PG8_LDA(At, 0, 0); PG8_STAGE(PG8_SA(1, 1), a1 + hstep, voffA);
            PG8_WAIT_V(8); PG8_WAIT_L(0); PG8_BAR; PG8_MMA(0, 0, At, B0); PG8_MMA(0, 1, At, B1); PG8_BAR; PG8_SCHED;
            PG8_LDA(At, 0, 1); PG8_STAGE(PG8_SB(0, 0), b2, voffB); PG8_STAGE(PG8_SB(0, 1), b2 + hstep, voffB); PG8_STAGE(PG8_SA(0, 0), a2, voffA);
            PG8_WAIT_V(8); PG8_WAIT_L(0); PG8_BAR; PG8_MMA(1, 0, At, B0); PG8_MMA(1, 1, At, B1); PG8_BAR; PG8_SCHED;
            PG8_LDB(B0, 1, 0); PG8_LDB(B1, 1, 1); PG8_SCHED; PG8_LDA(At, 1, 0); PG8_STAGE(PG8_SA(0, 1), a2 + hstep, voffA);
            PG8_WAIT_V(8); PG8_WAIT_L(0); PG8_BAR; PG8_MMA(0, 0, At, B0); PG8_MMA(0, 1, At, B1); PG8_BAR; PG8_SCHED;
            PG8_LDA(At, 1, 1); PG8_STAGE(PG8_SB(1, 0), b3, voffB); PG8_STAGE(PG8_SB(1, 1), b3 + hstep, voffB); PG8_STAGE(PG8_SA(1, 0), a3, voffA);
            PG8_WAIT_V(8); PG8_WAIT_L(0); PG8_BAR; PG8_MMA(1, 0, At, B0); PG8_MMA(1, 1, At, B1); PG8_BAR; PG8_SCHED;
            } else {
            PG8_LDB(B0, 0, 0); PG8_SCHED; PG8_LDA(At, 0, 0); PG8_STAGE(PG8_SA(1, 1), a1 + hstep, voffA);
            PG8_WAIT_L(8); PG8_BAR; PG8_WAIT_L(0); PG8_MMA(0, 0, At, B0); PG8_BAR; PG8_SCHED;
            PG8_LDB(B1, 0, 1); PG8_STAGE(PG8_SB(0, 0), b2, voffB);
            PG8_BAR; PG8_WAIT_L(0); PG8_MMA(0, 1, At, B1); PG8_BAR;
            PG8_LDA(At, 0, 1); PG8_STAGE(PG8_SA(0, 0), a2, voffA);
            PG8_BAR; PG8_WAIT_L(0); PG8_MMA(1, 0, At, B0); PG8_BAR; PG8_SCHED;
            PG8_STAGE(PG8_SB(0, 1), b2 + hstep, voffB);
            PG8_WAIT_V(6); PG8_BAR; PG8_MMA(1, 1, At, B1); PG8_BAR;
            PG8_LDB(B0, 1, 0); PG8_SCHED; PG8_LDA(At, 1, 0); PG8_STAGE(PG8_SA(0, 1), a2 + hstep, voffA);
            PG8_WAIT_L(8); PG8_BAR; PG8_WAIT_L(0); PG8_MMA(0, 0, At, B0); PG8_BAR; PG8_SCHED;
            PG8_LDB(B1, 1, 1); PG8_STAGE(PG8_SB(1, 0), b3, voffB);
            PG8_BAR; PG8_WAIT_L(0); PG8_MMA(0, 1, At, B1); PG8_BAR;
            PG8_LDA(At, 1, 1); PG8_STAGE(PG8_SA(1, 0), a3, voffA);
            PG8_BAR; PG8_WAIT_L(0); PG8_MMA(1, 0, At, B0); PG8_BAR; PG8_SCHED;
            PG8_STAGE(PG8_SB(1, 1), b3 + hstep, voffB);
            PG8_WAIT_V(6); PG8_BAR; PG8_MMA(1, 1, At, B1); PG8_BAR;
            }
        }
        if constexpr (ALIGN_EPI) { if (wr == 0) PG8_BAR; }
        if constexpr (!Epi::AFTER_DRAIN) { E(acc, cur, wr, wc, fr, fq); S.done(cur); }
        if (!has_next) break;
#pragma unroll
        for (int a = 0; a < 2; ++a)
#pragma unroll
            for (int b = 0; b < 2; ++b)
#pragma unroll
                for (int m = 0; m < 4; ++m)
#pragma unroll
                    for (int n = 0; n < 2; ++n) acc[a][b][m][n] = (f32x4){0.f, 0.f, 0.f, 0.f};
        cur = nxt; cA = nA; cB = nB; ++ui;
        if constexpr (ALIGN_EPI) { if (wr == 1) PG8_BAR; }
    }
    PG8_WAIT_V(0);
    if constexpr (!ALIGN_EPI) { if (wr == 0) PG8_BAR; }
    PG8_BAR;
    if constexpr (Epi::AFTER_DRAIN) { E.fused(acc, cur, wr, wc, fr, fq, lds, wid, lane); S.done(cur); }
#undef PG8_SA
#undef PG8_SB
#undef PG8_STAGE
#undef PG8_LDA
#undef PG8_LDB
#undef PG8_MMA
#undef PG8_WAIT_V
#undef PG8_WAIT_L
#undef PG8_BAR
#undef PG8_SCHED
}
}

constexpr int NMIXW = 4864;
struct P2Body {
    const Frame* Fp;
    __device__ __forceinline__ void operator()(int m, int n, const f32x4 v) const {
        const Frame& F = *Fp;
        if (n >= NMIXP) return;
        *(u32x2*)(F.PROJ + (size_t)m * NMIXP + n) = pk4(v);
        if (n >= C_K && n < C_QI) {
            float* o = (n < C_V) ? (m < NTP ? F.out + O_KP + (size_t)m * 128 + (n - C_K) : F.out + O_KS + (size_t)(m - NTP) * 128 + (n - C_K))
                                 : (m < NTP ? F.out + O_VP + (size_t)m * 128 + (n - C_V) : F.out + O_VS + (size_t)(m - NTP) * 128 + (n - C_V));
            *(f32x4*)o = v;
            if (n >= C_V && m < NTP) {
                bf16_t* vt = (bf16_t*)(F.ws + WS_VT) + ((size_t)((m >> 11) * 2 + ((n - C_V) >> 6)) * 64 + ((n - C_V) & 63)) * SEQ + (m & 2047);
                vt[0] = f2bf(v[0]); vt[SEQ] = f2bf(v[1]); vt[2 * SEQ] = f2bf(v[2]); vt[3 * SEQ] = f2bf(v[3]);
            }
        } else if (n >= C_KI && n < C_BG) {
            float* o = m < NTP ? F.out + O_KIP + (size_t)m * 64 + (n - C_KI) : F.out + O_KIS + (size_t)(m - NTP) * 64 + (n - C_KI);
            *(f32x4*)o = v;
        } else if (n == C_WI) {
            *(f32x4*)(F.WI + (size_t)m * 4) = v;
        } else if (n >= C_CG && n < C_GA) {
            const int tt = (m < NTP) ? (m & 2047) - (SEQ - 2) : ((m - NTP) & 7) - (TS - 2);
            if (tt >= 0) {
                const int rowi = (m < NTP) ? (m >> 11) * 2 + tt : 2 * NB_P + ((m - NTP) >> 3) * 2 + tt;
                *(f32x4*)((float*)(F.ws + WS_CGX) + (size_t)rowi * 1024 + (n - C_CG)) = v;
            }
        }
    }
};
__device__ __forceinline__ void p2_gemm_in(const Frame& F) {
    pg8::Gemm g{F.H1, F.WIN, NT, NMIXW, D};
    pg8::StaticOrder S; S.init(NT, NMIXW, F.G, F.bid);
    pg8::EpiRC<P2Body> E{P2Body{&F}};
    pg8::gemm_phase<pg8::EpiRC<P2Body>, pg8::StaticOrder, true, true>(F.lds, g, S, E);
}

constexpr int SROW = 2052;
__device__ __forceinline__ int wave_sum_i(int v) {
#pragma unroll
    for (int o = 32; o >= 1; o >>= 1) v += __shfl_xor(v, o);
    return v;
}
__device__ __forceinline__ void cnt_ge(int& c, unsigned u, unsigned t) { asm("v_cmp_ge_u32_e32 vcc, %1, %2\n\tv_addc_co_u32_e32 %0, vcc, 0, %0, vcc" : "+v"(c) : "v"(u), "v"(t) : "vcc"); }
__device__ __forceinline__ void cnt_gt(int& c, unsigned u, unsigned t) { asm("v_cmp_gt_u32_e32 vcc, %1, %2\n\tv_addc_co_u32_e32 %0, vcc, 0, %0, vcc" : "+v"(c) : "v"(u), "v"(t) : "vcc"); }
__device__ __forceinline__ void cnt_eq(int& c, unsigned u, unsigned t) { asm("v_cmp_eq_u32_e32 vcc, %1, %2\n\tv_addc_co_u32_e32 %0, vcc, 0, %0, vcc" : "+v"(c) : "v"(u), "v"(t) : "vcc"); }
__device__ __forceinline__ void cnt_lt4(int& cl, unsigned u0, unsigned u1, unsigned u2, unsigned u3, unsigned t) {
    int d0, d1, d2, d3;
    asm("v_sub_u32 %1, %5, %9\n\tv_sub_u32 %2, %6, %9\n\tv_sub_u32 %3, %7, %9\n\tv_sub_u32 %4, %8, %9\n\t"
        "v_lshrrev_b32 %1, 31, %1\n\tv_lshrrev_b32 %2, 31, %2\n\tv_lshrrev_b32 %3, 31, %3\n\tv_lshrrev_b32 %4, 31, %4\n\t"
        "v_add3_u32 %0, %0, %1, %2\n\tv_add3_u32 %0, %0, %3, %4"
        : "+v"(cl), "=&v"(d0), "=&v"(d1), "=&v"(d2), "=&v"(d3) : "v"(u0), "v"(u1), "v"(u2), "v"(u3), "v"(t));
}
__device__ __forceinline__ void cnt_eq_pos(int& c, unsigned u, unsigned t, int L) {
    int tmp;
    asm("v_cmp_eq_u32_e32 vcc, %2, %3\n\tv_cndmask_b32_e32 %1, %5, %4, vcc\n\tv_cmp_lt_i32_e32 vcc, 0, %1\n\tv_addc_co_u32_e32 %0, vcc, 0, %0, vcc"
        : "+v"(c), "=&v"(tmp) : "v"(u), "v"(t), "v"(L), "v"(0x80000000) : "vcc");
}
__device__ __forceinline__ int wave_sum_i_dpp(int v) {
    v += __builtin_amdgcn_update_dpp(0, v, 0xB1, 0xF, 0xF, false);
    v += __builtin_amdgcn_update_dpp(0, v, 0x4E, 0xF, 0xF, false);
    v += __builtin_amdgcn_update_dpp(0, v, 0x141, 0xF, 0xF, false);
    v += __builtin_amdgcn_update_dpp(0, v, 0x140, 0xF, 0xF, false);
    v += __builtin_amdgcn_update_dpp(0, v, 0x142, 0xA, 0xF, false);
    v += __builtin_amdgcn_update_dpp(0, v, 0x143, 0xC, 0xF, false);
    return __builtin_amdgcn_readlane(v, 63);
}
template <int NV> __device__ __forceinline__ void select_threshold(const unsigned (&u)[NV], int ksel, int idx_bits, int lane, unsigned& T_out, int& Jx_out, int& ngt_out) {
    unsigned T = 0;
#pragma unroll 1
    for (int bit = 31; bit >= 0; --bit) {
        const unsigned cand = T | (1u << bit);
        int c = 0;
#pragma unroll
        for (int i = 0; i < NV; ++i) cnt_ge(c, u[i], cand);
        c = wave_sum_i_dpp(c);
        if (c >= ksel) T = cand;
    }
    int cg = 0, ce = 0;
#pragma unroll
    for (int i = 0; i < NV; ++i) { cnt_gt(cg, u[i], T); cnt_eq(ce, u[i], T); }
    const int ngt = wave_sum_i_dpp(cg), neq = wave_sum_i_dpp(ce);
    const int need = ksel - ngt;
    int Jx = 0x3FFFFFFF;
    if (need < neq) {
        int Jb = 0;
#pragma unroll 1
        for (int bit = idx_bits - 1; bit >= 0; --bit) {
            const int cand = Jb | (1 << bit);
            const int L = cand - lane;
            int c = 0;
#pragma unroll
            for (int i = 0; i < NV; ++i) cnt_eq_pos(c, u[i], T, L - 64 * i);
            c = wave_sum_i_dpp(c);
            if (c < need) Jb = cand;
        }
        Jx = Jb + 1;
    }
    T_out = T; Jx_out = Jx; ngt_out = ngt;
}
template <int NV> __device__ __forceinline__ void select_threshold2(const unsigned (&ua)[NV], const unsigned (&ub)[NV], int ksel, int idx_bits, int lane, int ng,
                                                                   unsigned& Ta_out, int& Jxa_out, unsigned& Tb_out, int& Jxb_out) {
    unsigned Ta = 0, Tb = 0;
    bool da = false, db = false;
#pragma unroll 1
    for (int bit = 30; bit >= 0 && !(da && db); --bit) {
        const unsigned ca = da ? Ta : (Ta | (1u << bit)), cb = db ? Tb : (Tb | (1u << bit));
        int la = 0, lb = 0;
#pragma unroll
        for (int i = 0; i < NV; i += 4) { if (i < 4 * ng) { cnt_lt4(la, ua[i], ua[i + 1], ua[i + 2], ua[i + 3], ca); cnt_lt4(lb, ub[i], ub[i + 1], ub[i + 2], ub[i + 3], cb); } }
        const int na = ng * 256 - wave_sum_i_dpp(la), nb = ng * 256 - wave_sum_i_dpp(lb);
        if (!da && na >= ksel) { Ta = ca; da = (na == ksel); }
        if (!db && nb >= ksel) { Tb = cb; db = (nb == ksel); }
    }
    int ga = 0, ea = 0, gb = 0, eb = 0;
#pragma unroll
    for (int i = 0; i < NV; ++i) { cnt_gt(ga, ua[i], Ta); cnt_eq(ea, ua[i], Ta); cnt_gt(gb, ub[i], Tb); cnt_eq(eb, ub[i], Tb); }
    const int needa = ksel - wave_sum_i_dpp(ga), neqa = wave_sum_i_dpp(ea), needb = ksel - wave_sum_i_dpp(gb), neqb = wave_sum_i_dpp(eb);
    int Jxa = 0x3FFFFFFF, Jxb = 0x3FFFFFFF;
    if (needa < neqa) {
        int Jb = 0;
#pragma unroll 1
        for (int bit = idx_bits - 1; bit >= 0; --bit) {
            const int cand = Jb | (1 << bit); const int L = cand - lane; int c = 0;
#pragma unroll
            for (int i = 0; i < NV; ++i) cnt_eq_pos(c, ua[i], Ta, L - 64 * i);
            if (wave_sum_i_dpp(c) < needa) Jb = cand;
        }
        Jxa = Jb + 1;
    }
    if (needb < neqb) {
        int Jb = 0;
#pragma unroll 1
        for (int bit = idx_bits - 1; bit >= 0; --bit) {
            const int cand = Jb | (1 << bit); const int L = cand - lane; int c = 0;
#pragma unroll
            for (int i = 0; i < NV; ++i) cnt_eq_pos(c, ub[i], Tb, L - 64 * i);
            if (wave_sum_i_dpp(c) < needb) Jb = cand;
        }
        Jxb = Jb + 1;
    }
    Ta_out = Ta; Jxa_out = Jxa; Tb_out = Tb; Jxb_out = Jxb;
}
template <int NV> __device__ __forceinline__ void select_topk(const unsigned (&u)[NV], int ksel, int idx_bits, int* sel, int lane) {
    unsigned T; int Jx, ngt;
    select_threshold<NV>(u, ksel, idx_bits, lane, T, Jx, ngt);
    const int L = Jx - lane;
    int cg = 0, ct = 0;
#pragma unroll
    for (int i = 0; i < NV; ++i) { cnt_gt(cg, u[i], T); cnt_eq_pos(ct, u[i], T, L - 64 * i); }
    int ig = cg, it = ct;
#pragma unroll
    for (int o = 1; o < 64; o <<= 1) { const int a = __shfl_up(ig, o), b2 = __shfl_up(it, o); if (lane >= o) { ig += a; it += b2; } }
    int pg = ig - cg, pt = ngt + it - ct;
    int ev = lane, Lr = L;
#pragma unroll
    for (int i = 0; i < NV; ++i) {
        if (u[i] > T) { sel[pg] = ev; ++pg; }
        else if (u[i] == T && Lr > 0) { sel[pt] = ev; ++pt; }
        asm volatile("v_add_u32 %0, 64, %0\n\tv_add_u32 %1, -64, %1" : "+v"(ev), "+v"(Lr));
    }
}

constexpr int PU_MB = 16 * SROW * 4;
constexpr int PU_RB = PU_MB + 16 * 64 * 4;
constexpr int PU_BT = PU_RB + 1024;
constexpr int PU_QT = PU_BT + 512, PU_QROW = 1040;
__device__ __forceinline__ int kappa32(int r) { return (r & 0x13) | ((r & 4) << 1) | ((r & 8) >> 1); }
__device__ __forceinline__ void p3_prompt_fused_unit(const Frame& F, const bf16_t* VT, int b, int qt) {
    LAS float* S = (LAS float*)F.lds;
    LAS unsigned* MB = (LAS unsigned*)(F.lds + PU_MB);
    LAS float* RB = (LAS float*)(F.lds + PU_RB);
    LAS int* BT = (LAS int*)(F.lds + PU_BT);
    const int lane = F.lane;
    const int q0 = qt * 16; const size_t tok0 = (size_t)b * SEQ;
    __syncthreads();
    for (int ch = F.tid; ch < 16 * 64; ch += NTHREADS) {
        const u32x4 qv = *(const u32x4*)(F.PROJ + (tok0 + q0 + (ch >> 6)) * NMIXP + C_Q + (ch & 63) * 8);
        constexpr float QS = ATTN_SCALE * 1.4426950408889634f;
        *(LAS u32x4*)(F.lds + PU_QT + (ch >> 6) * PU_QROW + (ch & 63) * 16) = (u32x4){cvt_pk_bf16(bflo(qv[0]) * QS, bfhi(qv[0]) * QS), cvt_pk_bf16(bflo(qv[1]) * QS, bfhi(qv[1]) * QS),
                                                                                    cvt_pk_bf16(bflo(qv[2]) * QS, bfhi(qv[2]) * QS), cvt_pk_bf16(bflo(qv[3]) * QS, bfhi(qv[3]) * QS)};
    }
    {
        const int r = lane & 15, q4 = lane >> 4;
        bf16x8 A[4][2];
#pragma unroll
        for (int hh = 0; hh < 4; ++hh)
#pragma unroll
            for (int s2 = 0; s2 < 2; ++s2) A[hh][s2] = *(const bf16x8*)(F.PROJ + (tok0 + q0 + r) * NMIXP + C_QI + hh * 64 + s2 * 32 + q4 * 8);
        float wv[4][4];
#pragma unroll
        for (int g = 0; g < 4; ++g) { const f32x4 w4 = *(const f32x4*)(F.WI + (tok0 + q0 + 4 * q4 + g) * 4);
#pragma unroll
            for (int hh = 0; hh < 4; ++hh) wv[g][hh] = w4[hh] * IDX_SCALE; }
        const int nkt = qt + 1;
        bf16x8 Bn[2][2];
        {
            const int t0 = 2 * F.wave;
#pragma unroll
            for (int p = 0; p < 2; ++p)
#pragma unroll
                for (int s2 = 0; s2 < 2; ++s2) { const int key = (t0 + p < nkt ? t0 + p : 0) * 16 + r; Bn[p][s2] = *(const bf16x8*)(F.PROJ + (tok0 + key) * NMIXP + C_KI + s2 * 32 + q4 * 8); }
        }
#pragma unroll 1
        for (int t0 = 2 * F.wave; t0 < nkt; t0 += 16) {
            bf16x8 B[2][2] = {{Bn[0][0], Bn[0][1]}, {Bn[1][0], Bn[1][1]}};
            {
                const int tn = t0 + 16;
#pragma unroll
                for (int p = 0; p < 2; ++p)
#pragma unroll
                    for (int s2 = 0; s2 < 2; ++s2) { const int key = (tn + p < nkt ? tn + p : 0) * 16 + r; Bn[p][s2] = *(const bf16x8*)(F.PROJ + (tok0 + key) * NMIXP + C_KI + s2 * 32 + q4 * 8); }
            }
#pragma unroll
            for (int p = 0; p < 2; ++p) {
                if (t0 + p >= nkt) continue;
                float sc[4] = {0.f, 0.f, 0.f, 0.f};
#pragma unroll
                for (int hh = 0; hh < 4; ++hh) {
                    f32x4 c = {0.f, 0.f, 0.f, 0.f};
                    c = __builtin_amdgcn_mfma_f32_16x16x32_bf16(A[hh][0], B[p][0], c, 0, 0, 0);
                    c = __builtin_amdgcn_mfma_f32_16x16x32_bf16(A[hh][1], B[p][1], c, 0, 0, 0);
#pragma unroll
                    for (int g = 0; g < 4; ++g) sc[g] += fmaxf(c[g], 0.f) * wv[g][hh];
                }
#pragma unroll
                for (int g = 0; g < 4; ++g) S[(4 * q4 + g) * SROW + (t0 + p) * 16 + r] = sc[g];
            }
        }
    }
    __syncthreads();
    {
        const int rowa = F.wave * 2, rowb = rowa + 1;
        const int nva = q0 + rowa + 1, nvb = nva + 1;
        if (nvb <= NSEL) {
#pragma unroll
            for (int i = 0; i < 32; ++i) {
                const unsigned long long ma = __ballot(lane + 64 * i < nva), mb = __ballot(lane + 64 * i < nvb);
                if (lane == 0) { MB[rowa * 64 + 2 * i] = (unsigned)ma; MB[rowa * 64 + 2 * i + 1] = (unsigned)(ma >> 32); MB[rowb * 64 + 2 * i] = (unsigned)mb; MB[rowb * 64 + 2 * i + 1] = (unsigned)(mb >> 32); }
            }
        } else {
            unsigned ua[32], ub[32];
#pragma unroll
            for (int i = 0; i < 32; ++i) { const int j = lane + 64 * i; ua[i] = (j < nva) ? (f2ord(S[rowa * SROW + j]) >> 1) : 0u; ub[i] = (j < nvb) ? (f2ord(S[rowb * SROW + j]) >> 1) : 0u; }
            unsigned Ta, Tb; int Jxa, Jxb;
            select_threshold2<32>(ua, ub, NSEL, 11, lane, (nvb + 255) >> 8, Ta, Jxa, Tb, Jxb);
            const int La = Jxa - lane, Lb = Jxb - lane;
#pragma unroll
            for (int i = 0; i < 32; ++i) {
                const bool ta = (ua[i] > Ta) || (ua[i] == Ta && (La - 64 * i) > 0), tb = (ub[i] > Tb) || (ub[i] == Tb && (Lb - 64 * i) > 0);
                const unsigned long long ma = __ballot(ta), mb = __ballot(tb);
                if (lane == 0) { MB[rowa * 64 + 2 * i] = (unsigned)ma; MB[rowa * 64 + 2 * i + 1] = (unsigned)(ma >> 32); MB[rowb * 64 + 2 * i] = (unsigned)mb; MB[rowb * 64 + 2 * i + 1] = (unsigned)(mb >> 32); }
            }
        }
    }
    __syncthreads();
    {
        const int g = F.wave & 1, kq = F.wave >> 1;
        const int c = lane & 31, h = lane >> 5;
        const int hd = g * 4 + (c & 3);
        LAS const unsigned char* Qb = F.lds + PU_QT + (c >> 2) * PU_QROW + (hd * 64 + h * 8) * 2;
        constexpr float L2E = 1.4426950408889634f;
        const float b31 = RB[31 * 8 + hd] * L2E;
        const int ntile = ((q0 + 15) >> 5) + 1;
        const bf16_t* Kb = F.PROJ + (tok0 + kappa32(c)) * NMIXP + C_K + g * 64 + h * 8;
        const bf16_t* Vb = VT + ((size_t)((b * 2 + g) * 64 + c)) * SEQ + h * 8;
        f32x16 O[2][2];
#pragma unroll
        for (int rt = 0; rt < 2; ++rt)
#pragma unroll
            for (int d = 0; d < 2; ++d)
#pragma unroll
                for (int e = 0; e < 16; ++e) O[rt][d][e] = 0.f;
        float lsum[2] = {0.f, 0.f};
        bf16x8 Kn[4];
        {
            const int key0 = (kq < ntile ? kq : 0) * 32;
#pragma unroll
            for (int s4 = 0; s4 < 4; ++s4) Kn[s4] = *(const bf16x8*)(Kb + (size_t)key0 * NMIXP + s4 * 16);
        }
#pragma unroll 1
        for (int kt = kq; kt < ntile; kt += 4) {
            const int key0 = kt * 32;
            bf16x8 Kf[4] = {Kn[0], Kn[1], Kn[2], Kn[3]}, Vf[2][2];
#pragma unroll
            for (int d = 0; d < 2; ++d)
#pragma unroll
                for (int s2 = 0; s2 < 2; ++s2) Vf[d][s2] = *(const bf16x8*)(Vb + (size_t)(32 * d) * SEQ + key0 + 16 * s2);
            {
                const int keyn = (kt + 4 < ntile ? kt + 4 : 0) * 32;
#pragma unroll
                for (int s4 = 0; s4 < 4; ++s4) Kn[s4] = *(const bf16x8*)(Kb + (size_t)keyn * NMIXP + s4 * 16);
            }
#pragma unroll
            for (int rt = 0; rt < 2; ++rt) {
                const int ql = rt * 8 + (c >> 2), q = q0 + ql;
                f32x16 X;
#pragma unroll
                for (int e = 0; e < 16; ++e) X[e] = 0.f;
#pragma unroll
                for (int s4 = 0; s4 < 4; ++s4) X = __builtin_amdgcn_mfma_f32_32x32x16_bf16(Kf[s4], *(LAS const bf16x8*)(Qb + rt * 8 * PU_QROW + s4 * 32), X, 0, 0, 0);
                const unsigned word = MB[ql * 64 + kt];
                const unsigned bits = ((word >> (8 * h)) & 0xFFu) | (((word >> (16 + 8 * h)) & 0xFFu) << 8);
                const bool nearT = (q0 + rt * 8) - (key0 + 31) < 113;
#pragma unroll
                for (int s2 = 0; s2 < 2; ++s2) {
                    float P[8];
                    if (nearT) {
#pragma unroll
                        for (int e8 = 0; e8 < 8; ++e8) {
                            const int e = 8 * s2 + e8;
                            const int key = key0 + e8 + 16 * s2 + 8 * h;
                            int dist = q - key; dist = dist < 0 ? 0 : (dist > 127 ? 127 : dist);
                            const float bias = RB[BT[dist] * 8 + hd] * L2E;
                            const float lg = fminf(X[e] + bias, 86.f);
                            P[e8] = __int_as_float(__float_as_int(__builtin_amdgcn_exp2f(lg)) & __builtin_amdgcn_sbfe((int)bits, e, 1));
                        }
                    } else {
#pragma unroll
                        for (int e8 = 0; e8 < 8; ++e8) {
                            const int e = 8 * s2 + e8;
                            const float lg = fminf(X[e] + b31, 86.f);
                            P[e8] = __int_as_float(__float_as_int(__builtin_amdgcn_exp2f(lg)) & __builtin_amdgcn_sbfe((int)bits, e, 1));
                        }
                    }
#pragma unroll
                    for (int e8 = 0; e8 < 8; ++e8) lsum[rt] += P[e8];
                    const u32x4 pk = (u32x4){cvt_pk_bf16(P[0], P[1]), cvt_pk_bf16(P[2], P[3]), cvt_pk_bf16(P[4], P[5]), cvt_pk_bf16(P[6], P[7])};
                    bf16x8 Pf; __builtin_memcpy(&Pf, &pk, 16);
                    O[rt][0] = __builtin_amdgcn_mfma_f32_32x32x16_bf16(Vf[0][s2], Pf, O[rt][0], 0, 0, 0);
                    O[rt][1] = __builtin_amdgcn_mfma_f32_32x32x16_bf16(Vf[1][s2], Pf, O[rt][1], 0, 0, 0);
                }
                __builtin_amdgcn_sched_barrier(0);
            }
        }
        LAS float* CB = (LAS float*)F.lds + (g * 3 + (kq > 0 ? kq - 1 : 0)) * (66 * 64);
        __syncthreads();
        if (kq > 0) {
#pragma unroll
            for (int rt = 0; rt < 2; ++rt) {
#pragma unroll
                for (int d = 0; d < 2; ++d)
#pragma unroll
                    for (int e = 0; e < 16; ++e) CB[((rt * 2 + d) * 16 + e) * 64 + lane] = O[rt][d][e];
                CB[(64 + rt) * 64 + lane] = lsum[rt];
            }
        }
        __syncthreads();
        if (kq == 0) {
#pragma unroll 1
            for (int p = 0; p < 3; ++p) {
                LAS const float* CP = (LAS const float*)F.lds + (g * 3 + p) * (66 * 64);
#pragma unroll
                for (int rt = 0; rt < 2; ++rt) {
#pragma unroll
                    for (int d = 0; d < 2; ++d)
#pragma unroll
                        for (int e = 0; e < 16; ++e) O[rt][d][e] += CP[((rt * 2 + d) * 16 + e) * 64 + lane];
                    lsum[rt] += CP[(64 + rt) * 64 + lane];
                }
            }
#pragma unroll
            for (int rt = 0; rt < 2; ++rt) {
                float l = lsum[rt]; l += __shfl_xor(l, 32);
                const float inv = 1.f / l;
                bf16_t* orow = F.OATT + (tok0 + q0 + rt * 8 + (c >> 2)) * 512 + hd * 64;
#pragma unroll
                for (int a4 = 0; a4 < 4; ++a4) {
                    const f32x4 v0 = (f32x4){O[rt][0][4 * a4], O[rt][0][4 * a4 + 1], O[rt][0][4 * a4 + 2], O[rt][0][4 * a4 + 3]} * inv;
                    const f32x4 v1 = (f32x4){O[rt][1][4 * a4], O[rt][1][4 * a4 + 1], O[rt][1][4 * a4 + 2], O[rt][1][4 * a4 + 3]} * inv;
                    *(u32x2*)(orow + 8 * a4 + 4 * h) = pk4(v0);
                    *(u32x2*)(orow + 32 + 8 * a4 + 4 * h) = pk4(v1);
                }
            }
        }
    }
}

__device__ __forceinline__ void p3_sample_score_unit(const Frame& F, float* SS, int b, int ch) {
    const int lane = F.lane, r = lane & 31, h = lane >> 5;
    bf16x8 A[4];
    { const int q = r >> 2, hh = r & 3;
#pragma unroll
      for (int s4 = 0; s4 < 4; ++s4) A[s4] = *(const bf16x8*)(F.PROJ + (size_t)(NTP + b * TS + q) * NMIXP + C_QI + hh * 64 + s4 * 16 + h * 8); }
    float wv[4][4];
#pragma unroll
    for (int g = 0; g < 4; ++g) { const f32x4 w4 = *(const f32x4*)(F.WI + (size_t)(NTP + b * TS + 2 * g + h) * 4);
#pragma unroll
        for (int hh = 0; hh < 4; ++hh) wv[g][hh] = w4[hh] * IDX_SCALE; }
    f32x4 kn[8];
    { const int key0 = ch * 1024 + F.wave * 32; const int page = F.page_table[b * NPAGES + (key0 >> 7)];
      const float* kr = F.cache_ki + ((size_t)page * PAGE + (key0 & 127) + r) * 64 + h * 8;
#pragma unroll
      for (int s4 = 0; s4 < 4; ++s4) { kn[2 * s4] = *(const f32x4*)(kr + s4 * 16); kn[2 * s4 + 1] = *(const f32x4*)(kr + s4 * 16 + 4); } }
#pragma unroll 1
    for (int tl = F.wave; tl < 32; tl += 8) {
        const int key0 = ch * 1024 + tl * 32;
        f32x4 kc[8];
#pragma unroll
        for (int i = 0; i < 8; ++i) kc[i] = kn[i];
        if (tl + 8 < 32) {
            const int keyn = key0 + 256; const int page = F.page_table[b * NPAGES + (keyn >> 7)];
            const float* kr = F.cache_ki + ((size_t)page * PAGE + (keyn & 127) + r) * 64 + h * 8;
#pragma unroll
            for (int s4 = 0; s4 < 4; ++s4) { kn[2 * s4] = *(const f32x4*)(kr + s4 * 16); kn[2 * s4 + 1] = *(const f32x4*)(kr + s4 * 16 + 4); }
        }
        f32x16 c;
#pragma unroll
        for (int e = 0; e < 16; ++e) c[e] = 0.f;
#pragma unroll
        for (int s4 = 0; s4 < 4; ++s4) {
            const f32x4 lo = kc[2 * s4], hi = kc[2 * s4 + 1];
            const u32x4 pk = (u32x4){cvt_pk_bf16(lo[0], lo[1]), cvt_pk_bf16(lo[2], lo[3]), cvt_pk_bf16(hi[0], hi[1]), cvt_pk_bf16(hi[2], hi[3])};
            bf16x8 Bf; __builtin_memcpy(&Bf, &pk, 16);
            c = __builtin_amdgcn_mfma_f32_32x32x16_bf16(A[s4], Bf, c, 0, 0, 0);
        }
#pragma unroll
        for (int g = 0; g < 4; ++g) {
            float sc = 0.f;
#pragma unroll
            for (int hh = 0; hh < 4; ++hh) sc += fmaxf(c[4 * g + hh], 0.f) * wv[g][hh];
            SS[(size_t)(b * TS + 2 * g + h) * PAST + key0 + r] = sc;
        }
    }
}
__device__ __forceinline__ void p3_index(const Frame& F) {
    constexpr int NSU = NB_S * 8;
    const int nunits = NSU + NB_P * (SEQ / 16);
    float* SS = (float*)(F.ws + WS_SS);
    const bf16_t* VT = (const bf16_t*)(F.ws + WS_VT);
    __syncthreads();
    if (F.tid < 256) ((LAS float*)(F.lds + PU_RB))[F.tid] = F.rel_bias[F.tid];
    if (F.tid < 128) ((LAS int*)(F.lds + PU_BT))[F.tid] = t5_bucket(F.tid);
    __syncthreads();
    for (int it = F.bid; it < nunits; it += F.G) {
        if (it < NSU) { p3_sample_score_unit(F, SS, it >> 3, it & 7); continue; }
        const int i = it - NSU; const int b = i & 7, sl = (i >> 3) & 31, rnd = i >> 8;
        const int qt = rnd == 0 ? 127 - sl : (rnd == 1 ? 64 + sl : (rnd == 2 ? 63 - sl : sl));
        p3_prompt_fused_unit(F, VT, b, qt);
    }
}

constexpr int SQ_CNT = 0;
constexpr int SQ_SEL = 1024;
constexpr int SQ_Q = 2048;
constexpr int SQ_PHYS = 3072;
constexpr int SQ_P = 4096;
constexpr int SQ_RB = 16384;
constexpr int SQ_BT = 17408;
__device__ __forceinline__ int wg_sum8(const Frame& F, LAS unsigned* slot, int v) {
    if (F.lane == 0) slot[F.wave] = (unsigned)v;
    __syncthreads();
    int t = 0;
#pragma unroll
    for (int w = 0; w < 8; ++w) t += (int)slot[w];
    return t;
}
__device__ __forceinline__ void p4_sample_query_unit(const Frame& F, const float* SS, int b, int t) {
    const int lane = F.lane, w = F.wave;
    LAS unsigned* CNT = (LAS unsigned*)(F.lds + SQ_CNT);
    LAS int* SELL = (LAS int*)(F.lds + SQ_SEL);
    LAS unsigned* QL = (LAS unsigned*)(F.lds + SQ_Q);
    LAS float* PL = (LAS float*)(F.lds + SQ_P) + w * 256;
    LAS float* RB = (LAS float*)(F.lds + SQ_RB);
    LAS int* BT = (LAS int*)(F.lds + SQ_BT);
    const int tok = NTP + b * TS + t;
    __syncthreads();
    if (F.tid < 256) QL[F.tid] = ((const unsigned*)(F.PROJ + (size_t)tok * NMIXP + C_Q))[F.tid];
    unsigned u[17];
    { const float* srow = SS + (size_t)(b * TS + t) * PAST + w * 1024;
#pragma unroll
      for (int i = 0; i < 16; ++i) u[i] = f2ord(srow[64 * i + lane]); }
    u[16] = 0u;
    if (w == 7) {
        const int kj = lane < TS ? lane : 0;
        const bf16_t* kn = F.PROJ + (size_t)(NTP + b * TS + kj) * NMIXP + C_KI;
        const bf16_t* qn = F.PROJ + (size_t)tok * NMIXP + C_QI;
        u32x4 kv[8];
#pragma unroll
        for (int c = 0; c < 8; ++c) kv[c] = *(const u32x4*)(kn + c * 8);
        int vz; asm volatile("v_mov_b32 %0, 0" : "=v"(vz));
        const f32x4 w4 = *(const f32x4*)(F.WI + (size_t)tok * 4 + vz);
        float sc = 0.f;
#pragma unroll
        for (int hh = 0; hh < 4; ++hh) {
            u32x4 qv[8];
#pragma unroll
            for (int c = 0; c < 8; ++c) qv[c] = *(const u32x4*)(qn + hh * 64 + c * 8 + vz);
            float d = 0.f;
#pragma unroll
            for (int c = 0; c < 8; ++c)
#pragma unroll
                for (int e = 0; e < 4; ++e) d += bflo(qv[c][e]) * bflo(kv[c][e]) + bfhi(qv[c][e]) * bfhi(kv[c][e]);
            sc += fmaxf(d, 0.f) * (w4[hh] * IDX_SCALE);
        }
        u[16] = (lane < TS && lane <= t) ? f2ord(sc) : 0u;
    }
    unsigned T = 0;
#pragma unroll 1
    for (int bit = 31; bit >= 0; --bit) {
        const unsigned cand = T | (1u << bit);
        int c = 0;
#pragma unroll
        for (int i = 0; i < 17; ++i) cnt_ge(c, u[i], cand);
        c = wg_sum8(F, CNT + (bit & 1) * 24, wave_sum_i_dpp(c));
        if (c >= NSEL) T = cand;
        if (c == NSEL) break;
    }
    int cg = 0, ce = 0;
#pragma unroll
    for (int i = 0; i < 17; ++i) { cnt_gt(cg, u[i], T); cnt_eq(ce, u[i], T); }
    const int cgw = wave_sum_i_dpp(cg);
    const int ngt = wg_sum8(F, CNT + 8, cgw);
    const int neq = wg_sum8(F, CNT + 16, wave_sum_i_dpp(ce));
    const int need = NSEL - ngt;
    int Jx = 0x3FFFFFFF;
    if (need < neq) {
        int Jb = 0;
#pragma unroll 1
        for (int bit = 13; bit >= 0; --bit) {
            const int cand = Jb | (1 << bit);
            const int L = cand - lane - 1024 * w;
            int c = 0;
#pragma unroll
            for (int i = 0; i < 17; ++i) cnt_eq_pos(c, u[i], T, L - 64 * i);
            c = wg_sum8(F, CNT + (bit & 1) * 24, wave_sum_i_dpp(c));
            if (c < need) Jb = cand;
        }
        Jx = Jb + 1;
    }
    {
        const int L = Jx - lane - 1024 * w;
        int ct = 0;
#pragma unroll
        for (int i = 0; i < 17; ++i) cnt_eq_pos(ct, u[i], T, L - 64 * i);
        const int ctw = wave_sum_i_dpp(ct);
        __syncthreads();
        if (lane == 0) { CNT[w] = (unsigned)cgw; CNT[8 + w] = (unsigned)ctw; }
        __syncthreads();
        int bg = 0, bt = ngt;
#pragma unroll
        for (int ww = 0; ww < 8; ++ww) { if (ww < w) { bg += (int)CNT[ww]; bt += (int)CNT[8 + ww]; } }
        int ig = cg, it2 = ct;
#pragma unroll
        for (int o = 1; o < 64; o <<= 1) { const int a = __shfl_up(ig, o), b2 = __shfl_up(it2, o); if (lane >= o) { ig += a; it2 += b2; } }
        int pg = bg + ig - cg, pt = bt + it2 - ct;
        int ev = 1024 * w + lane, Lr = L;
#pragma unroll
        for (int i = 0; i < 17; ++i) {
            if (u[i] > T) { SELL[pg] = ev; ++pg; }
            else if (u[i] == T && Lr > 0) { SELL[pt] = ev; ++pt; }
            asm volatile("v_add_u32 %0, 64, %0\n\tv_add_u32 %1, -64, %1" : "+v"(ev), "+v"(Lr));
        }
    }
    __syncthreads();
    LAS int* PHYS = (LAS int*)(F.lds + SQ_PHYS);
    if (F.tid < 256) { const int sraw = SELL[F.tid]; PHYS[F.tid] = (sraw < PAST) ? F.page_table[b * NPAGES + (sraw >> 7)] * PAGE + (sraw & 127) : -1 - (sraw - PAST); }
    __syncthreads();
    {
        const int hd = w, g = w >> 2, qpos = PAST + t;
        float lg[4];
#pragma unroll 2
        for (int i = 0; i < 4; ++i) {
            const int sraw = SELL[lane + 64 * i], ph = PHYS[lane + 64 * i];
            const float* kr = (ph >= 0) ? F.cache_k + (size_t)ph * 128 + g * 64 : F.out + O_KS + (size_t)(b * TS + (-1 - ph)) * 128 + g * 64;
            float a0 = 0.f, a1 = 0.f;
#pragma unroll
            for (int c = 0; c < 16; ++c) {
                const f32x4 kv = *(const f32x4*)(kr + c * 4);
                const unsigned q0 = QL[hd * 32 + c * 2], q1 = QL[hd * 32 + c * 2 + 1];
                a0 += bflo(q0) * kv[0] + bfhi(q0) * kv[1]; a1 += bflo(q1) * kv[2] + bfhi(q1) * kv[3];
            }
            const int dist = qpos - sraw; const int bk = dist < 128 ? BT[dist] : 31;
            lg[i] = (a0 + a1) * ATTN_SCALE + RB[bk * 8 + hd];
        }
        float m = fmaxf(fmaxf(lg[0], lg[1]), fmaxf(lg[2], lg[3])); m = wave_max(m);
        float sm = 0.f;
#pragma unroll
        for (int i = 0; i < 4; ++i) { lg[i] = __expf(lg[i] - m); sm += lg[i]; }
        const float inv = 1.f / wave_sum_dpp(sm);
#pragma unroll
        for (int i = 0; i < 4; ++i) PL[lane + 64 * i] = lg[i] * inv;
        const int dq = lane & 15, ks = lane >> 4;
        f32x4 o4 = {0.f, 0.f, 0.f, 0.f};
#pragma unroll 1
        for (int j0 = 0; j0 < 256; j0 += 64) {
            f32x4 vv[16]; float pp[16];
#pragma unroll
            for (int jj = 0; jj < 16; ++jj) {
                const int j = j0 + jj * 4 + ks;
                const int ph = PHYS[j]; pp[jj] = PL[j];
                const float* vr = (ph >= 0) ? F.cache_v + (size_t)ph * 128 + g * 64 : F.out + O_VS + (size_t)(b * TS + (-1 - ph)) * 128 + g * 64;
                vv[jj] = *(const f32x4*)(vr + 4 * dq);
            }
#pragma unroll
            for (int jj = 0; jj < 16; ++jj) o4 += vv[jj] * pp[jj];
        }
#pragma unroll
        for (int e = 0; e < 4; ++e) { o4[e] += __shfl_xor(o4[e], 16); o4[e] += __shfl_xor(o4[e], 32); }
        if (ks == 0) *(u32x2*)(F.OATT + (size_t)tok * 512 + hd * 64 + 4 * dq) = pk4(o4);
    }
}
__device__ __forceinline__ void p4_attention(const Frame& F) {
    const float* SS = (const float*)(F.ws + WS_SS);
    __syncthreads();
    if (F.tid < 256) ((LAS float*)(F.lds + SQ_RB))[F.tid] = F.rel_bias[F.tid];
    if (F.tid < 128) ((LAS int*)(F.lds + SQ_BT))[F.tid] = t5_bucket(F.tid);
    __syncthreads();
    for (int it = F.bid; it < NTS; it += F.G) p4_sample_query_unit(F, SS, it >> 3, it & 7);
    {
        const int c0 = F.lane * 8;
        float cw0[8], cw1[8], cw2[8], cbv[8];
#pragma unroll
        for (int e = 0; e < 8; ++e) { cw0[e] = F.conv_w[c0 + e]; cw1[e] = F.conv_w[512 + c0 + e]; cw2[e] = F.conv_w[1024 + c0 + e]; cbv[e] = F.conv_b[c0 + e]; }
        const int stride = F.G * 8;
        u32x4 n_cg[3], n_xi[3], n_bg;
        auto fetch = [&](int m) {
#pragma unroll
            for (int d = 0; d < 3; ++d) { const int mm = (m - d >= 0) ? m - d : 0; n_cg[d] = *(const u32x4*)(F.PROJ + (size_t)mm * NMIXP + C_CG + c0); n_xi[d] = *(const u32x4*)(F.PROJ + (size_t)mm * NMIXP + C_XIN + c0); }
            n_bg = *(const u32x4*)(F.PROJ + (size_t)m * NMIXP + C_BG + c0);
        };
        { const int m = F.bid * 8 + F.wave; fetch(m < NT ? m : 0); }
        for (int m = F.bid * 8 + F.wave; m < NT; m += stride) {
            u32x4 cg[3], xi[3]; const u32x4 bg = n_bg;
#pragma unroll
            for (int d = 0; d < 3; ++d) { cg[d] = n_cg[d]; xi[d] = n_xi[d]; }
            fetch(m + stride < NT ? m + stride : m);
            int t, T_, bsm; if (m < NTP) { t = m & 2047; T_ = SEQ; bsm = m >> 11; } else { t = (m - NTP) & 7; T_ = TS; bsm = (m - NTP) >> 3; }
            float u[3][8];
#pragma unroll
            for (int d = 0; d < 3; ++d) {
                if (t - d >= 0) {
#pragma unroll
                    for (int e = 0; e < 4; ++e) { u[d][2 * e] = bflo(cg[d][e]) * bflo(xi[d][e]); u[d][2 * e + 1] = bfhi(cg[d][e]) * bfhi(xi[d][e]); }
                } else if (m >= NTP) {
                    const float* pv = F.state_conv + ((size_t)bsm * 2 + (2 + t - d)) * 512 + c0;
#pragma unroll
                    for (int e = 0; e < 8; ++e) u[d][e] = pv[e];
                } else {
#pragma unroll
                    for (int e = 0; e < 8; ++e) u[d][e] = 0.f;
                }
            }
            float y[8];
#pragma unroll
            for (int e = 0; e < 8; ++e) {
                const float yy = cbv[e] + cw0[e] * u[2][e] + cw1[e] * u[1][e] + cw2[e] * u[0][e];
                const float bgv = (e & 1) ? bfhi(bg[e >> 1]) : bflo(bg[e >> 1]);
                y[e] = bgv * yy;
            }
            *(u32x4*)(F.OCONV + (size_t)m * 512 + c0) = (u32x4){cvt_pk_bf16(y[0], y[1]), cvt_pk_bf16(y[2], y[3]), cvt_pk_bf16(y[4], y[5]), cvt_pk_bf16(y[6], y[7])};
            if (t >= T_ - 2) {
                float* o = (m < NTP ? F.out + O_CP : F.out + O_CS) + ((size_t)bsm * 2 + (t - (T_ - 2))) * 512 + c0;
                const int rowi = (m < NTP) ? bsm * 2 + (t - (T_ - 2)) : 2 * NB_P + bsm * 2 + (t - (T_ - 2));
                const float* cx = (const float*)(F.ws + WS_CGX) + (size_t)rowi * 1024 + c0;
                const f32x4 ca = *(const f32x4*)cx, cb2 = *(const f32x4*)(cx + 4), xa = *(const f32x4*)(cx + 512), xb = *(const f32x4*)(cx + 516);
                *(f32x4*)o = ca * xa; *(f32x4*)(o + 4) = cb2 * xb;
            }
        }
    }
}

#define P5_EPI(A1, A2) { \
            const f32x4 va = ACC4(A1), vc = ACC4(A2); \
            const u32x2 ga = *(const u32x2*)(F.PROJ + (size_t)m * NMIXP + C_GA + n), gb = *(const u32x2*)(F.PROJ + (size_t)m * NMIXP + C_GB + n); \
            f32x4 o; \
            o[0] = sigmoidf_(bflo(ga[0])) * va[0] + sigmoidf_(bflo(gb[0])) * vc[0]; \
            o[1] = sigmoidf_(bfhi(ga[0])) * va[1] + sigmoidf_(bfhi(gb[0])) * vc[1]; \
            o[2] = sigmoidf_(bflo(ga[1])) * va[2] + sigmoidf_(bflo(gb[1])) * vc[2]; \
            o[3] = sigmoidf_(bfhi(ga[1])) * va[3] + sigmoidf_(bfhi(gb[1])) * vc[3]; \
            *(u32x2*)(F.MERGED + (size_t)m * D + n) = pk4(o); }
struct P5aBody {
    const Frame* Fp;
    __device__ __forceinline__ void operator()(int m, int n, const f32x4 v) const { *(u32x2*)(Fp->MERGED + (size_t)m * D + n) = pk4(v); }
};
struct P5bBody {
    const Frame* Fp;
    __device__ __forceinline__ void operator()(int m, int n, const f32x4 v) const {
        const Frame& F = *Fp;
        const u32x2 ga = *(const u32x2*)(F.PROJ + (size_t)m * NMIXP + C_GA + n), gb = *(const u32x2*)(F.PROJ + (size_t)m * NMIXP + C_GB + n);
        const u32x2 pa = *(const u32x2*)(F.MERGED + (size_t)m * D + n);
        const f32x4 o = (f32x4){sigmoidf_(bflo(ga[0])) * bflo(pa[0]) + sigmoidf_(bflo(gb[0])) * v[0], sigmoidf_(bfhi(ga[0])) * bfhi(pa[0]) + sigmoidf_(bfhi(gb[0])) * v[1],
                                sigmoidf_(bflo(ga[1])) * bflo(pa[1]) + sigmoidf_(bflo(gb[1])) * v[2], sigmoidf_(bfhi(ga[1])) * bfhi(pa[1]) + sigmoidf_(bfhi(gb[1])) * v[3]};
        *(u32x2*)(F.MERGED + (size_t)m * D + n) = pk4(o);
    }
};
__device__ __forceinline__ void p5_gemm_merge(const Frame& F) {
    {
        pg8::StaticOrder S; S.init(NTP, D, F.G, F.bid);
        { pg8::Gemm g{F.OATT, F.WOA, NTP, D, 512}; pg8::EpiRC<P5aBody> E{P5aBody{&F}}; pg8::gemm_phase<pg8::EpiRC<P5aBody>, pg8::StaticOrder, true, true>(F.lds, g, S, E); }
        asm volatile("s_waitcnt vmcnt(0)" ::: "memory"); __syncthreads();
        { pg8::Gemm g{F.OCONV, F.WOC, NTP, D, 512}; pg8::EpiRC<P5bBody> E{P5bBody{&F}}; pg8::gemm_phase<pg8::EpiRC<P5bBody>, pg8::StaticOrder, true, true>(F.lds, g, S, E); }
    }
    for (int sl = F.bid; sl < NTS / 8 * (D / BN); sl += F.G) {
        const int m0 = NTP + (sl >> 3) * 8, n0 = (sl & 7) * BN;
        f32x16 s1[1][1], s2[1][1];
        gemm_slice8(F, s1, F.OATT, 512, F.WOA, 512, 512, m0, n0);
        gemm_slice8(F, s2, F.OCONV, 512, F.WOC, 512, 512, m0, n0);
        SLICE_EPI_LOOP(P5_EPI(s1, s2))
    }
}
#define P6_EPI(A1) { \
            const f32x4 v = ACC4(A1); \
            const f32x4 xv = *(const f32x4*)(x_row(F, m) + n); \
            const f32x4 g1 = *(const f32x4*)(F.MOD + (size_t)mod_row(m) * 6144 + 2048 + n); \
            *(f32x4*)(F.T1 + (size_t)m * D + n) = xv * DN_ALPHA + g1 * v; }
struct P6Body {
    const Frame* Fp;
    __device__ __forceinline__ void operator()(int m, int n, const f32x4 v) const {
        const Frame& F = *Fp;
        const f32x4 xv = *(const f32x4*)(F.x_p + (size_t)m * D + n);
        const f32x4 g1 = *(const f32x4*)(F.MOD + (size_t)(m >> 11) * 6144 + 2048 + n);
        *(f32x4*)(F.T1 + (size_t)m * D + n) = xv * DN_ALPHA + g1 * v;
    }
};
__device__ __forceinline__ void p6_gemm_out(const Frame& F) {
    {
        pg8::Gemm g{F.MERGED, F.WOUT, NTP, D, D}; pg8::StaticOrder S; S.init(NTP, D, F.G, F.bid);
        pg8::EpiRC<P6Body> E{P6Body{&F}}; pg8::gemm_phase<pg8::EpiRC<P6Body>, pg8::StaticOrder, true, true>(F.lds, g, S, E);
    }
    for (int sl = F.bid; sl < NTS / 8 * (D / BN); sl += F.G) {
        const int m0 = NTP + (sl >> 3) * 8, n0 = (sl & 7) * BN;
        f32x16 s1[1][1];
        gemm_slice8(F, s1, F.MERGED, D, F.WOUT, D, D, m0, n0);
        SLICE_EPI_LOOP(P6_EPI(s1))
    }
}
__device__ __forceinline__ void p7_ln1(const Frame& F) {
    f32x4 lg[4], lb[4];
#pragma unroll
    for (int i = 0; i < 4; ++i) { const int e = (i >> 1) * 512 + F.lane * 8 + (i & 1) * 4; lg[i] = *(const f32x4*)(F.ln1_g + e); lb[i] = *(const f32x4*)(F.ln1_b + e); }
    const int stride = F.G * 8;
    f32x4 vn[4], scn[4], shn[4];
    {
        const int m = F.bid * 8 + F.wave; const float* mr = F.MOD + (size_t)mod_row(m < NT ? m : 0) * 6144;
#pragma unroll
        for (int i = 0; i < 4; ++i) { const int e = (i >> 1) * 512 + F.lane * 8 + (i & 1) * 4; vn[i] = *(const f32x4*)(F.T1 + (size_t)(m < NT ? m : 0) * D + e); scn[i] = *(const f32x4*)(mr + 4096 + e); shn[i] = *(const f32x4*)(mr + 3072 + e); }
    }
    for (int m = F.bid * 8 + F.wave; m < NT; m += stride) {
        float* tr = F.T1 + (size_t)m * D;
        f32x4 v[4], sc2[4], sh2[4]; float s = 0.f;
#pragma unroll
        for (int i = 0; i < 4; ++i) { v[i] = vn[i]; sc2[i] = scn[i]; sh2[i] = shn[i]; s += v[i][0] + v[i][1] + v[i][2] + v[i][3]; }
        {
            const int mn = (m + stride < NT) ? m + stride : m; const float* mrn = F.MOD + (size_t)mod_row(mn) * 6144;
#pragma unroll
            for (int i = 0; i < 4; ++i) { const int e = (i >> 1) * 512 + F.lane * 8 + (i & 1) * 4; vn[i] = *(const f32x4*)(F.T1 + (size_t)mn * D + e); scn[i] = *(const f32x4*)(mrn + 4096 + e); shn[i] = *(const f32x4*)(mrn + 3072 + e); }
        }
        const float mean = wave_sum(s) * (1.f / D);
        float q = 0.f;
#pragma unroll
        for (int i = 0; i < 4; ++i) { v[i] = v[i] - mean; q += v[i][0] * v[i][0] + v[i][1] * v[i][1] + v[i][2] * v[i][2] + v[i][3] * v[i][3]; }
        const float rstd = rsqrtf(wave_sum(q) * (1.f / D) + LN_EPS);
        f32x4 hv[2][2];
#pragma unroll
        for (int hlf = 0; hlf < 2; ++hlf) {
            const int e = hlf * 512 + F.lane * 8;
            f32x4 a = v[2 * hlf] * rstd * lg[2 * hlf] + lb[2 * hlf];
            f32x4 b = v[2 * hlf + 1] * rstd * lg[2 * hlf + 1] + lb[2 * hlf + 1];
            *(f32x4*)(tr + e) = a; *(f32x4*)(tr + e + 4) = b;
            const f32x4 ha = a * (sc2[2 * hlf] + 1.f) + sh2[2 * hlf];
            const f32x4 hb = b * (sc2[2 * hlf + 1] + 1.f) + sh2[2 * hlf + 1];
            *(u32x4*)(F.H2 + (size_t)m * D + e) = (u32x4){cvt_pk_bf16(ha[0], ha[1]), cvt_pk_bf16(ha[2], ha[3]), cvt_pk_bf16(hb[0], hb[1]), cvt_pk_bf16(hb[2], hb[3])};
            hv[hlf][0] = ha; hv[hlf][1] = hb;
        }
        float am = 0.f;
#pragma unroll
        for (int i = 0; i < 2; ++i)
#pragma unroll
            for (int j = 0; j < 2; ++j)
#pragma unroll
                for (int e = 0; e < 4; ++e) am = fmaxf(am, fabsf(hv[i][j][e]));
        am = wave_max(am);
        const float sc = am > 0.f ? 224.f / am : 1.f;
#pragma unroll
        for (int hlf = 0; hlf < 2; ++hlf) {
            int w0 = 0, w1 = 0;
            w0 = __builtin_amdgcn_cvt_pk_fp8_f32(hv[hlf][0][0] * sc, hv[hlf][0][1] * sc, w0, false); w0 = __builtin_amdgcn_cvt_pk_fp8_f32(hv[hlf][0][2] * sc, hv[hlf][0][3] * sc, w0, true);
            w1 = __builtin_amdgcn_cvt_pk_fp8_f32(hv[hlf][1][0] * sc, hv[hlf][1][1] * sc, w1, false); w1 = __builtin_amdgcn_cvt_pk_fp8_f32(hv[hlf][1][2] * sc, hv[hlf][1][3] * sc, w1, true);
            *(u32x2*)(F.ws + WS_H8 + (size_t)m * D + hlf * 512 + F.lane * 8) = (u32x2){(unsigned)w0, (unsigned)w1};
        }
        if (F.lane == 0) ((float*)(F.ws + WS_SH))[m] = am > 0.f ? am * (1.f / 224.f) : 1.f;
    }
}
struct P8Body {
    const Frame* Fp;
    __device__ __forceinline__ void operator()(int m, int n, const f32x4 v) const { *(u32x2*)(Fp->QP + (size_t)m * D + n) = pk4(v); }
};
__device__ __forceinline__ void p8_gemm_q(const Frame& F) {
    {
        pg8::Gemm g{F.H2, F.WQ, NTP, D, D}; pg8::StaticOrder S; S.init(NTP, D, F.G, F.bid);
        pg8::EpiRC<P8Body> E{P8Body{&F}}; pg8::gemm_phase<pg8::EpiRC<P8Body>, pg8::StaticOrder, true, true>(F.lds, g, S, E);
    }
    for (int sl = F.bid; sl < NTS / 8 * (D / BN); sl += F.G) {
        const int m0 = NTP + (sl >> 3) * 8, n0 = (sl & 7) * BN;
        f32x16 s1[1][1];
        gemm_slice8(F, s1, F.H2, D, F.WQ, D, D, m0, n0);
        SLICE_EPI_LOOP({ *(u32x2*)(F.QP + (size_t)m * D + n) = pk4(ACC4(s1)); })
    }
}
__device__ __forceinline__ void p9_row_top16(LAS float* row, LAS float* TV, LAS unsigned char* TI, int slot) {
    float gm[16];
#pragma unroll
    for (int gidx = 0; gidx < 16; ++gidx) {
        float m = row[gidx * 8];
#pragma unroll
        for (int k = 1; k < 8; ++k) m = fmaxf(m, row[gidx * 8 + k]);
        gm[gidx] = m;
    }
#pragma unroll 1
    for (int p = 0; p < 16; ++p) {
        float best = gm[0]; int bg = 0;
#pragma unroll
        for (int gidx = 1; gidx < 16; ++gidx) { const bool gt = gm[gidx] > best; best = gt ? gm[gidx] : best; bg = gt ? gidx : bg; }
        float v[8];
#pragma unroll
        for (int k = 0; k < 8; ++k) v[k] = row[bg * 8 + k];
        int bk = 7;
#pragma unroll
        for (int k = 6; k >= 0; --k) bk = (v[k] == best) ? k : bk;
        float nm = -INFINITY;
#pragma unroll
        for (int k = 0; k < 8; ++k) nm = fmaxf(nm, (k == bk) ? -INFINITY : v[k]);
        row[bg * 8 + bk] = -INFINITY;
#pragma unroll
        for (int gidx = 0; gidx < 16; ++gidx) gm[gidx] = (gidx == bg) ? nm : gm[gidx];
        TV[slot * 17 + p] = best; TI[slot * 17 + p] = (unsigned char)(bg * 8 + bk);
    }
}
__device__ __forceinline__ void p9_pair_top16(const Frame& F, LAS const float* TV, LAS const unsigned char* TI, int r1, int r2, int tok, int head) {
    float c[16];
    { const float v20 = TV[r2];
#pragma unroll
      for (int i = 0; i < 16; ++i) c[i] = TV[r1 + i] + v20; }
    unsigned long long ptrs = 0ull;
    float sv[16]; int se[16];
#pragma unroll
    for (int p = 0; p < 16; ++p) {
        float best = c[0]; int bi = 0;
#pragma unroll
        for (int i = 1; i < 16; ++i) { const bool gt = c[i] > best; best = gt ? c[i] : best; bi = gt ? i : bi; }
        const int bj = (int)((ptrs >> (4 * bi)) & 15ull);
        sv[p] = best; se[p] = (int)TI[r1 + bi] * 128 + (int)TI[r2 + bj];
        const float nv = (bj < 15) ? TV[r1 + bi] + TV[r2 + bj + 1] : -INFINITY;
        ptrs += (bj < 15) ? (1ull << (4 * bi)) : 0ull;
#pragma unroll
        for (int i = 0; i < 16; ++i) c[i] = (i == bi) ? nv : c[i];
    }
    const float mx0 = sv[0]; float den = 0.f;
#pragma unroll
    for (int p = 0; p < 16; ++p) { sv[p] = __expf(sv[p] - mx0); den += sv[p]; }
    const float dinv = 1.f / den;
    int* eo = F.EIDX + (size_t)tok * NEXP_SEL + head * 16; float* go = F.GW + (size_t)tok * NEXP_SEL + head * 16;
#pragma unroll
    for (int p = 0; p < 16; ++p) { eo[p] = se[p]; go[p] = sv[p] * dinv; }
}
constexpr int PR_ROW = 129, PR_ROWS = 256 + 4;
__device__ __forceinline__ void p9_route(const Frame& F) {
    LAS float* SC = (LAS float*)F.lds;
    LAS float* TV = (LAS float*)(F.lds + PR_ROWS * PR_ROW * 4);
    LAS unsigned char* TI = (LAS unsigned char*)(F.lds + PR_ROWS * PR_ROW * 4 + PR_ROWS * 17 * 4);
    const int lane = F.lane, r = lane & 31, h = lane >> 5;
    const int nunits = (NTP / 32) * 2;
    int k = 0;
    for (int it = F.bid; it < nunits; it += F.G, ++k) {
        const int tok0 = (it >> 1) * 32, hg = it & 1;
        const int ts = NTP + F.bid + F.G * (k >> 2), kh = k & 3;
        const bool has_s = ts < NT;
        __syncthreads();
        {
            const int head = hg * 4 + (F.wave >> 1), half = F.wave & 1;
            const bf16_t* KK = half ? F.K2 : F.K1;
            bf16x8 Bq[4], Bs[4];
#pragma unroll
            for (int s = 0; s < 4; ++s) Bq[s] = *(const bf16x8*)(F.QP + (size_t)(tok0 + r) * D + head * 128 + half * 64 + s * 16 + h * 8);
            const bool swave = has_s && F.wave < 4;
            if (swave) {
#pragma unroll
                for (int s = 0; s < 4; ++s) Bs[s] = *(const bf16x8*)(F.QP + (size_t)ts * D + (2 * kh + (F.wave >> 1)) * 128 + half * 64 + s * 16 + h * 8);
            }
#pragma unroll
            for (int kt = 0; kt < 4; ++kt) {
                f32x16 c, cs;
#pragma unroll
                for (int e = 0; e < 16; ++e) { c[e] = 0.f; cs[e] = 0.f; }
#pragma unroll
                for (int s = 0; s < 4; ++s) {
                    const bf16x8 Ak = *(const bf16x8*)(KK + (size_t)(kt * 32 + r) * 64 + s * 16 + h * 8);
                    c = __builtin_amdgcn_mfma_f32_32x32x16_bf16(Ak, Bq[s], c, 0, 0, 0);
                    if (swave) cs = __builtin_amdgcn_mfma_f32_32x32x16_bf16(Ak, Bs[s], cs, 0, 0, 0);
                }
#pragma unroll
                for (int e = 0; e < 16; ++e) { const int key = kt * 32 + (e & 3) + 8 * (e >> 2) + 4 * h; SC[(r * 8 + F.wave) * PR_ROW + key] = c[e]; }
                if (swave && r == 0) {
#pragma unroll
                    for (int e = 0; e < 16; ++e) { const int key = kt * 32 + (e & 3) + 8 * (e >> 2) + 4 * h; SC[(256 + F.wave) * PR_ROW + key] = cs[e]; }
                }
            }
        }
        __syncthreads();
        if (F.tid < 256 || (has_s && F.tid < 260)) p9_row_top16(SC + F.tid * PR_ROW, TV, TI, F.tid);
        __syncthreads();
        if (F.tid < 128) {
            const int tk = F.tid >> 2, hs = F.tid & 3;
            const int r1 = (tk * 8 + hs * 2) * 17;
            p9_pair_top16(F, TV, TI, r1, r1 + 17, tok0 + tk, hg * 4 + hs);
        } else if (has_s && F.tid < 130) {
            const int hs = F.tid - 128;
            const int r1 = (256 + hs * 2) * 17;
            p9_pair_top16(F, TV, TI, r1, r1 + 17, ts, 2 * kh + hs);
        }
    }
}

constexpr int TPW = 65, PAIRS_MAX = 9 * 128, PK = 4;
constexpr int P10_HROW = 1024 + 64;
constexpr int P10_H = 0;
constexpr int P10_SH = 32 * P10_HROW;
constexpr int P10_HIST = P10_SH + 128;
constexpr int P10_LIST = P10_HIST + 8 * 128 * 4;
typedef int i32x8 __attribute__((ext_vector_type(8)));
__device__ __forceinline__ void p10_peer(const Frame& F) {
    const int lane = F.lane, w = F.wave;
    unsigned char* ws = F.ws;
    const unsigned char* PU8 = ws + WS_PU8; const unsigned char* PV8 = ws + WS_PV8;
    const float* SU = (const float*)(ws + WS_SU); const float* SV = (const float*)(ws + WS_SV);
    const unsigned char* H8 = ws + WS_H8; const float* SH = (const float*)(ws + WS_SH);
  for (int blk = F.bid; blk < NT / TPW; blk += F.G) {
    const int tok0 = blk * TPW;
    LAS unsigned* hist = (LAS unsigned*)(F.lds + P10_HIST) + w * 128;
    LAS float* SHl = (LAS float*)(F.lds + P10_SH);
    LAS unsigned* SE = (LAS unsigned*)(F.lds + P10_LIST) + w * 1024; LAS float* SG = (LAS float*)(SE + 512);
    const int ntok = (w == 0) ? 9 : 8;
    const int r16 = lane & 15, q4 = lane >> 4;
#pragma unroll 1
    for (int pass = 0; pass < 3; ++pass) {
        const int kbase = pass * PK, nk = (ntok - kbase < PK) ? (ntok - kbase > 0 ? ntok - kbase : 0) : PK, npairs = nk * 128;
        __syncthreads();
        for (int c = F.tid; c < 32 * 64; c += NTHREADS) {
            const int row = c >> 6, tl = 32 * pass + row;
            if (tl < TPW) *(LAS u32x4*)(F.lds + P10_H + row * P10_HROW + (c & 63) * 16) = *(const u32x4*)(H8 + (size_t)(tok0 + tl) * D + (size_t)(c & 63) * 16);
        }
        if (F.tid < 32 && 32 * pass + F.tid < TPW) SHl[F.tid] = SH[tok0 + 32 * pass + F.tid];
        __syncthreads();
        if (nk <= 0) continue;
        hist[lane] = 0u; hist[lane + 64] = 0u;
        int ex[8];
#pragma unroll
        for (int i = 0; i < 8; ++i) {
            const int p = lane + 64 * i;
            ex[i] = -1;
            if (p < npairs) { ex[i] = F.EIDX[(size_t)(tok0 + w + 8 * (kbase + (p >> 7))) * NEXP_SEL + (p & 127)]; atomicAdd((unsigned*)&hist[ex[i] >> 7], 1u); }
        }
        {
            const unsigned c0 = hist[2 * lane], c1 = hist[2 * lane + 1];
            unsigned incl = c0 + c1;
#pragma unroll
            for (int o = 1; o < 64; o <<= 1) { const unsigned t = __shfl_up(incl, o); if (lane >= o) incl += t; }
            const unsigned excl = incl - (c0 + c1);
            hist[2 * lane] = excl; hist[2 * lane + 1] = excl + c0;
        }
#pragma unroll
        for (int i = 0; i < 8; ++i) {
            const int p = lane + 64 * i;
            if (p < npairs) {
                const unsigned pos = atomicAdd((unsigned*)&hist[ex[i] >> 7], 1u);
                SE[pos] = (unsigned)ex[i] | ((unsigned)(p >> 7) << 14);
                SG[pos] = F.GW[(size_t)(tok0 + w + 8 * (kbase + (p >> 7))) * NEXP_SEL + (p & 127)];
            }
        }
        asm volatile("s_waitcnt vmcnt(0) lgkmcnt(0)" ::: "memory");
        __builtin_amdgcn_wave_barrier();
        f32x4 acc[16];
#pragma unroll
        for (int c = 0; c < 16; ++c) acc[c] = (f32x4){0.f, 0.f, 0.f, 0.f};
        const int ngr = npairs >> 4;
        const unsigned char* up = PU8 + q4 * 16;
        const int voff = lane * 8;
        u32x4 U[8]; u32x2 V[16]; float suv = 0.f, svv = 0.f;
#pragma unroll
        for (int t = 0; t < 8; ++t) U[t] = (u32x4){0u, 0u, 0u, 0u};
#pragma unroll
        for (int k = 0; k < 16; ++k) V[k] = (u32x2){0u, 0u};
#define P10_LOAD_U(WR) { const int er_ = (WR) & 16383; const unsigned char* ua_ = up + (size_t)er_ * 512; const float* sa_ = SU + er_; const float* sb_ = SV + er_; \
            asm volatile("global_load_dwordx4 %0, %1, off" : "+v"(U[0]) : "v"(ua_)); \
            asm volatile("global_load_dwordx4 %0, %1, off offset:64" : "+v"(U[1]) : "v"(ua_)); \
            asm volatile("global_load_dwordx4 %0, %1, off offset:128" : "+v"(U[2]) : "v"(ua_)); \
            asm volatile("global_load_dwordx4 %0, %1, off offset:192" : "+v"(U[3]) : "v"(ua_)); \
            asm volatile("global_load_dwordx4 %0, %1, off offset:256" : "+v"(U[4]) : "v"(ua_)); \
            asm volatile("global_load_dwordx4 %0, %1, off offset:320" : "+v"(U[5]) : "v"(ua_)); \
            asm volatile("global_load_dwordx4 %0, %1, off offset:384" : "+v"(U[6]) : "v"(ua_)); \
            asm volatile("global_load_dwordx4 %0, %1, off offset:448" : "+v"(U[7]) : "v"(ua_)); \
            asm volatile("global_load_dword %0, %1, off" : "+v"(suv) : "v"(sa_)); \
            asm volatile("global_load_dword %0, %1, off" : "+v"(svv) : "v"(sb_)); }
#define P10_LOAD_V(K, WR) { const unsigned char* ra_ = PV8 + (size_t)(__builtin_amdgcn_readlane((WR), (K)) & 16383) * 512; \
            asm volatile("global_load_dwordx2 %0, %1, %2" : "+v"(V[K]) : "v"(voff), "s"(ra_)); }
        int wr = (int)SE[r16]; float gr = SG[r16];
        P10_LOAD_U(wr)
        P10_LOAD_V(0, wr) P10_LOAD_V(1, wr) P10_LOAD_V(2, wr) P10_LOAD_V(3, wr) P10_LOAD_V(4, wr) P10_LOAD_V(5, wr) P10_LOAD_V(6, wr) P10_LOAD_V(7, wr)
        P10_LOAD_V(8, wr) P10_LOAD_V(9, wr) P10_LOAD_V(10, wr) P10_LOAD_V(11, wr) P10_LOAD_V(12, wr) P10_LOAD_V(13, wr) P10_LOAD_V(14, wr) P10_LOAD_V(15, wr)
#pragma unroll 1
        for (int gi = 0; gi < ngr; ++gi) {
            const int gn = (gi + 1 < ngr) ? gi + 1 : 0;
            const int wrn = (int)SE[gn * 16 + r16]; const float grn = SG[gn * 16 + r16];
            const int sr = wr >> 14;
            LAS const unsigned char* hr = F.lds + P10_H + (w + 8 * sr) * P10_HROW + q4 * 16;
            const float shv = SHl[w + 8 * sr];
            asm volatile("s_waitcnt vmcnt(16)" : "+v"(U[0]), "+v"(U[1]), "+v"(U[2]), "+v"(U[3]), "+v"(U[4]), "+v"(U[5]), "+v"(U[6]), "+v"(U[7]), "+v"(suv), "+v"(svv));
            f32x4 C0 = {0.f, 0.f, 0.f, 0.f}, C1 = {0.f, 0.f, 0.f, 0.f};
#pragma unroll
            for (int t = 0; t < 8; ++t) {
                const u32x4 h0 = *(LAS const u32x4*)(hr + t * 128), h1 = *(LAS const u32x4*)(hr + t * 128 + 64);
                const i32x8 Aop = {(int)h0[0], (int)h0[1], (int)h0[2], (int)h0[3], (int)h1[0], (int)h1[1], (int)h1[2], (int)h1[3]};
                const i32x8 Bop = {(int)U[t][0], (int)U[t][1], (int)U[t][2], (int)U[t][3], 0, 0, 0, 0};
                if (t & 1) C1 = __builtin_amdgcn_mfma_scale_f32_16x16x128_f8f6f4(Aop, Bop, C1, 0, 4, 0, 0x7f7f7f7f, 0, 0x7f7f7f7f);
                else       C0 = __builtin_amdgcn_mfma_scale_f32_16x16x128_f8f6f4(Aop, Bop, C0, 0, 4, 0, 0x7f7f7f7f, 0, 0x7f7f7f7f);
            }
            C0 = C0 + C1;
            const int rsel = lane & 3;
            const float dv = (rsel == 0 ? C0[0] : (rsel == 1 ? C0[1] : (rsel == 2 ? C0[2] : C0[3]))) * (suv * shv);
            const int actv = __float_as_int(gelu_tanh(dv) * (gr * svv));
            P10_LOAD_U(wrn)
#define P10_VSTEP(J) { const f32x2_t tv = __builtin_amdgcn_cvt_scalef32_pk_f32_fp4(vv[(J) >> 2], 1.0f, (J) & 3); \
                       acc[2 * (J)] = __builtin_amdgcn_mfma_f32_4x4x1f32(aw, tv[0], acc[2 * (J)], 0, 0, 0); \
                       acc[2 * (J) + 1] = __builtin_amdgcn_mfma_f32_4x4x1f32(aw, tv[1], acc[2 * (J) + 1], 0, 0, 0); }
#define P10_VPAIR(K) { const float actk = __int_as_float(__builtin_amdgcn_readlane(actv, 16 * ((K) >> 2) + (K))); \
                       const int slot = __builtin_amdgcn_readlane(wr, (K)) >> 14; \
                       const float aw = (slot == (lane & 3)) ? actk : 0.f; \
                       asm volatile("s_waitcnt vmcnt(25)" : "+v"(V[K])); \
                       const u32x2 vv = V[K]; \
                       P10_VSTEP(0) P10_VSTEP(1) P10_VSTEP(2) P10_VSTEP(3) P10_VSTEP(4) P10_VSTEP(5) P10_VSTEP(6) P10_VSTEP(7) \
                       P10_LOAD_V(K, wrn) }
            P10_VPAIR(0) P10_VPAIR(1) P10_VPAIR(2) P10_VPAIR(3) P10_VPAIR(4) P10_VPAIR(5) P10_VPAIR(6) P10_VPAIR(7)
            P10_VPAIR(8) P10_VPAIR(9) P10_VPAIR(10) P10_VPAIR(11) P10_VPAIR(12) P10_VPAIR(13) P10_VPAIR(14) P10_VPAIR(15)
#undef P10_VPAIR
#undef P10_VSTEP
            wr = wrn; gr = grn;
        }
        asm volatile("s_waitcnt vmcnt(0)" : "+v"(U[0]), "+v"(U[1]), "+v"(U[2]), "+v"(U[3]), "+v"(U[4]), "+v"(U[5]), "+v"(U[6]), "+v"(U[7]), "+v"(suv), "+v"(svv),
                     "+v"(V[0]), "+v"(V[1]), "+v"(V[2]), "+v"(V[3]), "+v"(V[4]), "+v"(V[5]), "+v"(V[6]), "+v"(V[7]),
                     "+v"(V[8]), "+v"(V[9]), "+v"(V[10]), "+v"(V[11]), "+v"(V[12]), "+v"(V[13]), "+v"(V[14]), "+v"(V[15]));
#undef P10_LOAD_U
#undef P10_LOAD_V
        float x1v[PK][16];
#pragma unroll
        for (int k = 0; k < PK; ++k) {
            const int m = tok0 + w + 8 * (kbase + (k < nk ? k : 0));
#pragma unroll
            for (int c = 0; c < 16; ++c) x1v[k][c] = F.T1[(size_t)m * D + c * 64 + lane];
        }
#pragma unroll
        for (int k = 0; k < PK; ++k) {
            if (k >= nk) continue;
            const int m = tok0 + w + 8 * (kbase + k);
            const float* mr = F.MOD + (size_t)mod_row(m) * 6144 + 5120;
            float tv[16]; float s = 0.f;
#pragma unroll
            for (int c = 0; c < 16; ++c) { const float t = x1v[k][c] * DN_ALPHA + mr[c * 64 + lane] * acc[c][k]; tv[c] = t; s += t; }
            const float mean = wave_sum(s) * (1.f / D);
            float q = 0.f;
#pragma unroll
            for (int c = 0; c < 16; ++c) { tv[c] -= mean; q += tv[c] * tv[c]; }
            const float rstd = rsqrtf(wave_sum(q) * (1.f / D) + LN_EPS);
            float* yo = (m < NTP) ? F.out + O_YP + (size_t)m * D : F.out + O_YS + (size_t)(m - NTP) * D;
#pragma unroll
            for (int c = 0; c < 16; ++c) yo[c * 64 + lane] = tv[c] * rstd * F.ln2_g[c * 64 + lane] + F.ln2_b[c * 64 + lane];
        }
    }
  }
}

constexpr int N_PHASES = 11;
__global__ void __launch_bounds__(NTHREADS, 2) fwd_kernel(Args args) {
    extern __shared__ __attribute__((aligned(16))) unsigned char lds_raw[];
    Frame F;
    F.lds = (LAS unsigned char*)lds_raw;
    F.tid = threadIdx.x; F.lane = F.tid & 63; F.wave = __builtin_amdgcn_readfirstlane(F.tid >> 6); F.G = gridDim.x; F.bid = blockIdx.x;
    F.x_p = (const float*)args.in[0]; F.x_s = (const float*)args.in[1]; F.c_p = (const float*)args.in[2]; F.c_s = (const float*)args.in[3];
    F.cache_k = (const float*)args.in[4]; F.cache_v = (const float*)args.in[5]; F.cache_ki = (const float*)args.in[6]; F.state_conv = (const float*)args.in[7];
    F.page_table = (const int*)args.in[8]; F.rel_bias = (const float*)args.in[9]; F.w_ada = (const float*)args.in[10]; F.b_ada = (const float*)args.in[11];
    F.w_in = (const float*)args.in[12]; F.conv_w = (const float*)args.in[13]; F.conv_b = (const float*)args.in[14]; F.w_o_attn = (const float*)args.in[15];
    F.w_o_conv = (const float*)args.in[16]; F.w_out = (const float*)args.in[17]; F.ln1_g = (const float*)args.in[18]; F.ln1_b = (const float*)args.in[19];
    F.ln2_g = (const float*)args.in[20]; F.ln2_b = (const float*)args.in[21]; F.peer_wq = (const float*)args.in[22]; F.peer_k1 = (const float*)args.in[23];
    F.peer_k2 = (const float*)args.in[24]; F.peer_u = (const float*)args.in[25]; F.peer_v = (const float*)args.in[26];
    F.out = args.out;
    unsigned char* ws = args.ws; F.ws = ws;
    F.MOD = (float*)(ws + WS_MOD); F.WIN = (bf16_t*)(ws + WS_WIN); F.WOA = (bf16_t*)(ws + WS_WOA); F.WOC = (bf16_t*)(ws + WS_WOC);
    F.WOUT = (bf16_t*)(ws + WS_WOUT); F.WQ = (bf16_t*)(ws + WS_WQ); F.K1 = (bf16_t*)(ws + WS_K1); F.K2 = (bf16_t*)(ws + WS_K2);
    F.PU = (bf16_t*)(ws + WS_PU); F.PV = (bf16_t*)(ws + WS_PV); F.H1 = (bf16_t*)(ws + WS_H1); F.PROJ = (bf16_t*)(ws + WS_PROJ);
    F.WI = (float*)(ws + WS_WI); F.SEL = (int*)(ws + WS_SEL); F.OATT = (bf16_t*)(ws + WS_OATT); F.OCONV = (bf16_t*)(ws + WS_OCONV);
    F.MERGED = (bf16_t*)(ws + WS_MERGED); F.T1 = (float*)(ws + WS_T1); F.H2 = (bf16_t*)(ws + WS_H2); F.QP = (bf16_t*)(ws + WS_QP);
    F.EIDX = (int*)(ws + WS_EIDX); F.GW = (float*)(ws + WS_GW);
    volatile LAS unsigned* misc = (volatile LAS unsigned*)(F.lds + LDS_MISC);
    if (F.tid < 16) misc[F.tid] = 0u;
    __syncthreads();
    XcdBarrier bar; bar.bar = (unsigned*)(ws + WS_CTL); bar.x = 0; bar.st = misc;
    const int lo = args.ph_lo, hi = args.ph_hi;
    if (hi - lo > 1) bar = xcd_barrier_post((unsigned*)(ws + WS_CTL), misc);
#define IN(k) (lo <= (k) && (k) < hi)
#define SEAM(k) do { if (IN(k) && IN((k) + 1)) xcd_barrier(bar); } while (0)
    if (IN(0)) p0_prologue(F);       SEAM(0);
    if (IN(1)) p1_modulate(F);       SEAM(1);
    if (IN(2)) p2_gemm_in(F);        SEAM(2);
    if (IN(3)) p3_index(F);          SEAM(3);
    if (IN(4)) p4_attention(F);      SEAM(4);
    if (IN(5)) p5_gemm_merge(F);     SEAM(5);
    if (IN(6)) p6_gemm_out(F);       SEAM(6);
    if (IN(7)) p7_ln1(F);            SEAM(7);
    if (IN(8)) p8_gemm_q(F);         SEAM(8);
    if (IN(9)) p9_route(F);          SEAM(9);
    if (IN(10)) p10_peer(F);
#undef IN
#undef SEAM
}

extern "C" void kernel_launch(void* const* d_in, const int* in_sizes, int n_in, void* d_out, int out_size, void* d_ws, size_t ws_size, hipStream_t stream) {
    static int grid = 0;
    if (grid == 0) {
        if (n_in != 27 || (size_t)out_size != O_END || ws_size < WS_END) { fprintf(stderr, "kernel_launch: unexpected shapes (n_in %d out %d ws %zu)\n", n_in, out_size, ws_size); grid = -1; return; }
        int dev = 0, cus = 0;
        if (hipGetDevice(&dev) != hipSuccess || hipDeviceGetAttribute(&cus, hipDeviceAttributeMultiprocessorCount, dev) != hipSuccess) { grid = -1; return; }
        if (hipFuncSetAttribute((const void*)fwd_kernel, hipFuncAttributeMaxDynamicSharedMemorySize, LDS_BYTES) != hipSuccess) { fprintf(stderr, "kernel_launch: hipFuncSetAttribute failed\n"); grid = -1; return; }
        (void)hipGetLastError();
        grid = cus < 256 ? cus : 256;
    }
    if (grid < 0) return;
    (void)hipMemsetAsync((char*)d_ws + WS_CTL, 0, CTL_ZERO_BYTES, stream);
    Args a{};
    for (int i = 0; i < 27; ++i) a.in[i] = d_in[i];
    a.out = (float*)d_out; a.ws = (unsigned char*)d_ws;
#if N_LAUNCHES == 1
    a.ph_lo = 0; a.ph_hi = N_PHASES;
    hipLaunchKernelGGL(fwd_kernel, dim3(grid), dim3(NTHREADS), LDS_BYTES, stream, a);
#else
    for (int p = 0; p < N_PHASES; ++p) { a.ph_lo = p; a.ph_hi = p + 1; hipLaunchKernelGGL(fwd_kernel, dim3(grid), dim3(NTHREADS), LDS_BYTES, stream, a); }
#endif
}
```

```cpp
#include <hip/hip_runtime.h>
#include <cstdio>
#include <cstdint>

#ifndef N_LAUNCHES
#define N_LAUNCHES 1
#endif

typedef unsigned short bf16_t;
typedef short bf16x8 __attribute__((ext_vector_type(8)));
typedef float f32x4 __attribute__((ext_vector_type(4)));
typedef float f32x16 __attribute__((ext_vector_type(16)));
typedef unsigned u32x4 __attribute__((ext_vector_type(4)));
typedef unsigned u32x2 __attribute__((ext_vector_type(2)));
#define LAS __attribute__((address_space(3)))

constexpr int D = 1024, NB_P = 8, SEQ = 2048, NB_S = 32, TS = 8, PAST = 8192, PAGE = 128, NPAGES = 64;
constexpr int NTP = NB_P * SEQ;
constexpr int NTS = NB_S * TS;
constexpr int NT = NTP + NTS;
constexpr int NMIX = 4676, NMIXP = 4736;
constexpr int C_Q = 0, C_K = 512, C_V = 640, C_QI = 768, C_KI = 1024, C_BG = 1088, C_CG = 1600, C_XIN = 2112, C_GA = 2624, C_GB = 3648, C_WI = 4672;
constexpr int NSEL = 256;
constexpr float ATTN_SCALE = 0.125f, IDX_SCALE = 0.0625f;
constexpr float DN_ALPHA = 1.189207115002721f, LN_EPS = 1e-5f;
constexpr int NEXP_SEL = 128;

constexpr size_t O_YP = 0, O_YS = 16777216, O_KP = 17039360, O_VP = 19136512, O_KIP = 21233664, O_CP = 22282240,
                 O_KS = 22290432, O_VS = 22323200, O_KIS = 22355968, O_CS = 22372352, O_END = 22405120;

constexpr size_t MB = 1048576;
constexpr size_t WS_CTL = 0, WS_MOD = 1 * MB, WS_WIN = 2 * MB, WS_WOA = 12 * MB, WS_WOC = 13 * MB, WS_WOUT = 14 * MB, WS_WQ = 16 * MB,
                 WS_K1 = 18 * MB, WS_K2 = 18 * MB + 65536, WS_PU = 20 * MB, WS_PV = 52 * MB, WS_H1 = 84 * MB, WS_PROJ = 118 * MB,
                 WS_WI = 270 * MB, WS_SEL = 271 * MB, WS_OATT = 288 * MB, WS_OCONV = 305 * MB, WS_MERGED = 322 * MB, WS_T1 = 355 * MB,
                 WS_H2 = 420 * MB, WS_QP = 453 * MB, WS_EIDX = 486 * MB, WS_GW = 495 * MB, WS_SS = 504 * MB, WS_SE = 513 * MB, WS_SG = 523 * MB, WS_VT = 533 * MB, WS_CGX = 538 * MB, WS_END = 539 * MB;
constexpr size_t WS_PU8 = WS_PU, WS_PV8 = WS_PU + 16 * MB, WS_SU = WS_PV, WS_SV = WS_PV + 65536, WS_H8 = WS_PV + 1 * MB, WS_SH = WS_PV + 20 * MB;
constexpr int CTL_ZERO_BYTES = 65536;

constexpr int NTHREADS = 512;
constexpr int LDS_BYTES = 160 * 1024 - 512;
constexpr int LDS_MISC = LDS_BYTES - 64;

__device__ __forceinline__ float bf2f(bf16_t b) { return __uint_as_float(((unsigned)b) << 16); }
__device__ __forceinline__ float bflo(unsigned p) { return __uint_as_float(p << 16); }
__device__ __forceinline__ float bfhi(unsigned p) { return __uint_as_float(p & 0xFFFF0000u); }
typedef __bf16 bf16x2_t __attribute__((ext_vector_type(2)));
typedef float f32x2_t __attribute__((ext_vector_type(2)));
__device__ __forceinline__ unsigned cvt_pk_bf16(float lo, float hi) { const f32x2_t f = {lo, hi}; const bf16x2_t b = __builtin_convertvector(f, bf16x2_t); unsigned r; __builtin_memcpy(&r, &b, 4); return r; }
__device__ __forceinline__ bf16_t f2bf(float f) { return (bf16_t)(cvt_pk_bf16(f, 0.f) & 0xFFFFu); }
__device__ __forceinline__ float wave_sum(float v) {
#pragma unroll
    for (int o = 32; o >= 1; o >>= 1) v += __shfl_xor(v, o);
    return v;
}
__device__ __forceinline__ float wave_sum_dpp(float v) {
    int x;
    x = __builtin_amdgcn_update_dpp(0, __float_as_int(v), 0xB1, 0xF, 0xF, false);  v += __int_as_float(x);
    x = __builtin_amdgcn_update_dpp(0, __float_as_int(v), 0x4E, 0xF, 0xF, false);  v += __int_as_float(x);
    x = __builtin_amdgcn_update_dpp(0, __float_as_int(v), 0x141, 0xF, 0xF, false); v += __int_as_float(x);
    x = __builtin_amdgcn_update_dpp(0, __float_as_int(v), 0x140, 0xF, 0xF, false); v += __int_as_float(x);
    x = __builtin_amdgcn_update_dpp(0, __float_as_int(v), 0x142, 0xA, 0xF, false); v += __int_as_float(x);
    x = __builtin_amdgcn_update_dpp(0, __float_as_int(v), 0x143, 0xC, 0xF, false); v += __int_as_float(x);
    return __int_as_float(__builtin_amdgcn_readlane(__float_as_int(v), 63));
}
__device__ __forceinline__ float wave_max(float v) {
#pragma unroll
    for (int o = 32; o >= 1; o >>= 1) v = fmaxf(v, __shfl_xor(v, o));
    return v;
}
__device__ __forceinline__ float sigmoidf_(float x) { return 1.f / (1.f + __expf(-x)); }
__device__ __forceinline__ float gelu_tanh(float a) {
    const float z = 0.7978845608028654f * (a + 0.044715f * a * a * a);
    const float e = __expf(2.f * z);
    const float t = 1.f - 2.f * __builtin_amdgcn_rcpf(e + 1.f);
    return 0.5f * a * (1.f + t);
}
__device__ __forceinline__ unsigned f2ord(float f) { const unsigned u = __float_as_uint(f); return (u & 0x80000000u) ? ~u : (u | 0x80000000u); }
__device__ __forceinline__ int t5_bucket(int n) {
    if (n < 16) return n;
    int b = 16;
    b += (n >= 19) + (n >= 21) + (n >= 24) + (n >= 27) + (n >= 31) + (n >= 35) + (n >= 40) + (n >= 46) + (n >= 52) + (n >= 59) + (n >= 67) + (n >= 77) + (n >= 87) + (n >= 99) + (n >= 113);
    return b;
}

#define XB_TMO      128
#define XB_XCNT(j)  (256  + 64 * (j))
#define XB_XSUB(j)  (1280 + 64 * (j))
#define XB_XGEN(j)  (2304 + 64 * (j))
#define XB_TOP      3328
#define XB_TOPGEN   3392
#define XCD_BAR_WORDS 3456
#define XB_SPIN_CAP (1u << 18)
__device__ __forceinline__ unsigned xb_ld(unsigned* p)              { return __hip_atomic_load(p, __ATOMIC_RELAXED, __HIP_MEMORY_SCOPE_AGENT); }
__device__ __forceinline__ unsigned xb_add(unsigned* p, unsigned v) { return __hip_atomic_fetch_add(p, v, __ATOMIC_RELAXED, __HIP_MEMORY_SCOPE_AGENT); }
__device__ __forceinline__ unsigned xb_xcc_id() { return (unsigned)__builtin_amdgcn_s_getreg((3 << 11) | 20) & 0xFu; }
#define XB_SPIN(cond, bar) do { unsigned _sp = 0; while (cond) { __builtin_amdgcn_s_sleep(1); \
    if ((++_sp & 255u) == 0u) { if (xb_ld(&(bar)[XB_TMO])) break; if (_sp > XB_SPIN_CAP) { atomicAdd(&(bar)[XB_TMO], 1u); break; } } } } while (0)
struct XcdBarrier { unsigned* bar; unsigned x; volatile LAS unsigned* st; };
__device__ __forceinline__ XcdBarrier xcd_barrier_post(unsigned* bar, volatile LAS unsigned* st) {
    XcdBarrier b; b.bar = bar; b.x = xb_xcc_id(); b.st = st;
    if (threadIdx.x == 0) (void)xb_add(&bar[XB_XCNT(b.x)], 1u);
    return b;
}
__device__ __forceinline__ void xcd_barrier_complete(unsigned* bar, unsigned x, unsigned& nloc, unsigned& nx) {
    const unsigned G = gridDim.x * gridDim.y * gridDim.z;
    unsigned sum, cnt, mine, sp = 0u;
    for (;;) {
        sum = 0u; cnt = 0u; mine = 0u;
#pragma unroll
        for (unsigned j = 0; j < 16; ++j) { const unsigned c = xb_ld(&bar[XB_XCNT(j)]); sum += c; cnt += (c > 0u) ? 1u : 0u; mine = (j == x) ? c : mine; }
        if (sum == G) break;
        __builtin_amdgcn_s_sleep(1);
        if ((++sp & 255u) == 0u) { if (xb_ld(&bar[XB_TMO])) break; if (sp > XB_SPIN_CAP) { atomicAdd(&bar[XB_TMO], 1u); break; } }
    }
    nloc = mine > 0u ? mine : 1u; nx = cnt > 0u ? cnt : 1u;
}
__device__ __forceinline__ void xcd_barrier(const XcdBarrier& b) {
    asm volatile("s_waitcnt vmcnt(0)" ::: "memory");
    __syncthreads();
    if (threadIdx.x == 0) {
        unsigned* bar = b.bar;
        __builtin_amdgcn_s_waitcnt(0);
        unsigned nloc = b.st[0], nx = b.st[1];
        if (nloc == 0u) { xcd_barrier_complete(bar, b.x, nloc, nx); b.st[0] = nloc; b.st[1] = nx; }
        const unsigned old = xb_add(&bar[XB_XSUB(b.x)], 1u);
        const unsigned gen = old / nloc;
        if (old + 1u == (gen + 1u) * nloc) {
            __builtin_amdgcn_fence(__ATOMIC_RELEASE, "agent");
            asm volatile("s_waitcnt vmcnt(0)" ::: "memory");
            const unsigned og = xb_add(&bar[XB_TOP], 1u);
            const unsigned tg = og / nx;
            if (og + 1u == (tg + 1u) * nx) xb_add(&bar[XB_TOPGEN], 1u);
            else XB_SPIN(xb_ld(&bar[XB_TOPGEN]) == tg, bar);
            __builtin_amdgcn_fence(__ATOMIC_ACQUIRE, "agent");
            xb_add(&bar[XB_XGEN(b.x)], 1u);
            asm volatile("s_waitcnt vmcnt(0)" ::: "memory");
        } else {
            XB_SPIN(xb_ld(&bar[XB_XGEN(b.x)]) == gen, bar);
            __builtin_amdgcn_fence(__ATOMIC_ACQUIRE, "agent");
            asm volatile("s_waitcnt vmcnt(0)" ::: "memory");
        }
    }
    __syncthreads();
}

struct Args { const void* in[27]; float* out; unsigned char* ws; int ph_lo, ph_hi; };
struct Core { LAS unsigned char* lds; int tid, lane, wave, G, bid; };
struct Frame {
    LAS unsigned char* lds;
    int tid, lane, wave, G, bid;
    const float *x_p, *x_s, *c_p, *c_s, *cache_k, *cache_v, *cache_ki, *state_conv, *rel_bias, *w_ada, *b_ada, *w_in, *conv_w, *conv_b,
                *w_o_attn, *w_o_conv, *w_out, *ln1_g, *ln1_b, *ln2_g, *ln2_b, *peer_wq, *peer_k1, *peer_k2, *peer_u, *peer_v;
    const int* page_table;
    float* out; unsigned char* ws;
    float* MOD; bf16_t *WIN, *WOA, *WOC, *WOUT, *WQ, *K1, *K2, *PU, *PV, *H1, *PROJ, *OATT, *OCONV, *MERGED, *H2, *QP;
    float *WI, *T1, *GW; int *SEL, *EIDX;
};
constexpr int LDS_PTAB = LDS_BYTES - 512;
__device__ __forceinline__ unsigned char* ldptr(const Core& C, int k) {
    LAS const unsigned* p = (LAS const unsigned*)(C.lds + LDS_PTAB) + 2 * k;
    const unsigned lo = __builtin_amdgcn_readfirstlane(p[0]), hi = __builtin_amdgcn_readfirstlane(p[1]);
    return (unsigned char*)(((unsigned long long)hi << 32) | (unsigned long long)lo);
}
__device__ __forceinline__ void load_frame(Frame& F, const Core& C) {
    F.lds = C.lds; F.tid = C.tid; F.lane = C.lane; F.wave = C.wave; F.G = C.G; F.bid = C.bid;
    F.x_p = (const float*)ldptr(C, 0); F.x_s = (const float*)ldptr(C, 1); F.c_p = (const float*)ldptr(C, 2); F.c_s = (const float*)ldptr(C, 3);
    F.cache_k = (const float*)ldptr(C, 4); F.cache_v = (const float*)ldptr(C, 5); F.cache_ki = (const float*)ldptr(C, 6); F.state_conv = (const float*)ldptr(C, 7);
    F.page_table = (const int*)ldptr(C, 8); F.rel_bias = (const float*)ldptr(C, 9); F.w_ada = (const float*)ldptr(C, 10); F.b_ada = (const float*)ldptr(C, 11);
    F.w_in = (const float*)ldptr(C, 12); F.conv_w = (const float*)ldptr(C, 13); F.conv_b = (const float*)ldptr(C, 14); F.w_o_attn = (const float*)ldptr(C, 15);
    F.w_o_conv = (const float*)ldptr(C, 16); F.w_out = (const float*)ldptr(C, 17); F.ln1_g = (const float*)ldptr(C, 18); F.ln1_b = (const float*)ldptr(C, 19);
    F.ln2_g = (const float*)ldptr(C, 20); F.ln2_b = (const float*)ldptr(C, 21); F.peer_wq = (const float*)ldptr(C, 22); F.peer_k1 = (const float*)ldptr(C, 23);
    F.peer_k2 = (const float*)ldptr(C, 24); F.peer_u = (const float*)ldptr(C, 25); F.peer_v = (const float*)ldptr(C, 26);
    F.out = (float*)ldptr(C, 27);
    unsigned char* ws = ldptr(C, 28);
    F.MOD = (float*)(ws + WS_MOD); F.WIN = (bf16_t*)(ws + WS_WIN); F.WOA = (bf16_t*)(ws + WS_WOA); F.WOC = (bf16_t*)(ws + WS_WOC);
    F.WOUT = (bf16_t*)(ws + WS_WOUT); F.WQ = (bf16_t*)(ws + WS_WQ); F.K1 = (bf16_t*)(ws + WS_K1); F.K2 = (bf16_t*)(ws + WS_K2);
    F.PU = (bf16_t*)(ws + WS_PU); F.PV = (bf16_t*)(ws + WS_PV); F.H1 = (bf16_t*)(ws + WS_H1); F.PROJ = (bf16_t*)(ws + WS_PROJ);
    F.WI = (float*)(ws + WS_WI); F.SEL = (int*)(ws + WS_SEL); F.OATT = (bf16_t*)(ws + WS_OATT); F.OCONV = (bf16_t*)(ws + WS_OCONV);
    F.MERGED = (bf16_t*)(ws + WS_MERGED); F.T1 = (float*)(ws + WS_T1); F.H2 = (bf16_t*)(ws + WS_H2); F.QP = (bf16_t*)(ws + WS_QP);
    F.EIDX = (int*)(ws + WS_EIDX); F.GW = (float*)(ws + WS_GW);
}
__device__ __forceinline__ const float* x_row(const Frame& F, int m) { return m < NTP ? F.x_p + (size_t)m * D : F.x_s + (size_t)(m - NTP) * D; }
__device__ __forceinline__ int mod_row(int m) { return m < NTP ? (m >> 11) : NB_P + ((m - NTP) >> 3); }

constexpr int P0_MOD_ITEMS = 96;
constexpr int P0_T_WIN = 16 * 74, P0_T_WOA = 8 * 16, P0_T_WOC = 8 * 16, P0_T_WOUT = 16 * 16, P0_T_WQ = 16 * 16;
constexpr int P0_T_ITEMS = P0_T_WIN + P0_T_WOA + P0_T_WOC + P0_T_WOUT + P0_T_WQ;
constexpr int P0_CVT_ITEMS = 2 * (16384 * 1024 / 8192);
constexpr int P0_MISC_ITEMS = 1;
constexpr int P0_ITEMS = P0_MOD_ITEMS + P0_T_ITEMS + P0_CVT_ITEMS + P0_MISC_ITEMS;

__device__ __forceinline__ void p0_mod_item(const Frame& F, int ng) {
    LAS float* cs = (LAS float*)F.lds;
    LAS float* red = (LAS float*)(F.lds + 40 * 256 * 4);
    float acc[40];
#pragma unroll
    for (int r = 0; r < 40; ++r) acc[r] = 0.f;
    const int n = ng * 64 + F.lane;
    for (int kc = 0; kc < 4; ++kc) {
        __syncthreads();
#pragma unroll 1
        for (int hb = 0; hb < 2; ++hb) {
            float cv[10];
#pragma unroll
            for (int i = 0; i < 10; ++i) { const int e = F.tid + (hb * 10 + i) * NTHREADS; const int r = e >> 8, k = e & 255; cv[i] = (r < 8) ? F.c_p[r * D + kc * 256 + k] : F.c_s[(r - 8) * D + kc * 256 + k]; }
#pragma unroll
            for (int i = 0; i < 10; ++i) cs[F.tid + (hb * 10 + i) * NTHREADS] = cv[i];
        }
        __syncthreads();
        float wvv[32];
#pragma unroll
        for (int kk = 0; kk < 32; ++kk) wvv[kk] = F.w_ada[(size_t)(kc * 256 + F.wave * 32 + kk) * 6144 + n];
#pragma unroll
        for (int kk = 0; kk < 32; ++kk) {
            const int kl = F.wave * 32 + kk;
#pragma unroll
            for (int r = 0; r < 40; ++r) acc[r] += cs[r * 256 + kl] * wvv[kk];
        }
    }
#pragma unroll
    for (int r = 0; r < 40; ++r) red[(F.wave * 40 + r) * 64 + F.lane] = acc[r];
    __syncthreads();
    for (int e = F.tid; e < 40 * 64; e += NTHREADS) {
        const int r = e >> 6, l = e & 63; float s = F.b_ada[ng * 64 + l];
#pragma unroll
        for (int w = 0; w < 8; ++w) s += red[(w * 40 + r) * 64 + l];
        F.MOD[r * 6144 + ng * 64 + l] = s;
    }
    __syncthreads();
}
__device__ __forceinline__ void p0_transpose_tile(const Frame& F, const float* W, int N, int K, bf16_t* Wt, int kt, int nt, bool permute) {
    LAS bf16_t* tile = (LAS bf16_t*)F.lds;
    __syncthreads();
    { const int k = F.tid >> 3, c0 = (F.tid & 7) * 8;
      const float* rp = W + (size_t)(kt * 64 + k) * N + nt * 64 + c0;
      const f32x4 z = {0.f, 0.f, 0.f, 0.f};
      const f32x4 v0 = (nt * 64 + c0 < N) ? *(const f32x4*)rp : z, v1 = (nt * 64 + c0 + 4 < N) ? *(const f32x4*)(rp + 4) : z;
#pragma unroll
      for (int j = 0; j < 4; ++j) { tile[k * 66 + c0 + j] = f2bf(v0[j]); tile[k * 66 + c0 + 4 + j] = f2bf(v1[j]); } }
    __syncthreads();
    { const int nl = F.tid >> 3, k0 = (F.tid & 7) * 8; const int n = nt * 64 + nl;
      if (n < N) {
          int nd = n; if (permute) nd = (n < 1024) ? n : (n < 1028 ? C_WI + (n - 1024) : n - 4);
          unsigned p[4];
#pragma unroll
          for (int j = 0; j < 4; ++j) p[j] = (unsigned)tile[(k0 + 2 * j) * 66 + nl] | ((unsigned)tile[(k0 + 2 * j + 1) * 66 + nl] << 16);
          *(u32x4*)(Wt + (size_t)nd * K + kt * 64 + k0) = (u32x4){p[0], p[1], p[2], p[3]};
      } }
}
constexpr int P0_CVT32_ITEMS = 2 * (16384 / 32);
constexpr int P0_OTHER = P0_T_ITEMS + P0_CVT32_ITEMS + 1;
__device__ __forceinline__ void p0_other_item(const Frame& F, int i) {
    if (i < P0_T_ITEMS) {
        if (i < P0_T_WIN) { p0_transpose_tile(F, F.w_in, NMIX, D, F.WIN, i / 74, i % 74, true); return; }
        i -= P0_T_WIN;
        if (i < P0_T_WOA) { p0_transpose_tile(F, F.w_o_attn, D, 512, F.WOA, i / 16, i % 16, false); return; }
        i -= P0_T_WOA;
        if (i < P0_T_WOC) { p0_transpose_tile(F, F.w_o_conv, D, 512, F.WOC, i / 16, i % 16, false); return; }
        i -= P0_T_WOC;
        if (i < P0_T_WOUT) { p0_transpose_tile(F, F.w_out, D, D, F.WOUT, i / 16, i % 16, false); return; }
        i -= P0_T_WOUT;
        p0_transpose_tile(F, F.peer_wq, D, D, F.WQ, i / 16, i % 16, false); return;
    }
    i -= P0_T_ITEMS;
    if (i < P0_CVT32_ITEMS) {
        const bool isu = i < 512;
        const float* src = isu ? F.peer_u : F.peer_v;
        unsigned char* dst = F.ws + (isu ? WS_PU8 : WS_PV8); float* sinv = (float*)(F.ws + (isu ? WS_SU : WS_SV));
        const int row0 = (i & 511) * 32 + F.wave * 4;
        float v[4][16];
        if (isu) {
#pragma unroll
            for (int rr = 0; rr < 4; ++rr)
#pragma unroll
                for (int q = 0; q < 4; ++q) {
                    const f32x4 t = *(const f32x4*)(src + (size_t)(row0 + rr) * D + F.lane * 16 + q * 4);
                    v[rr][4 * q] = t[0]; v[rr][4 * q + 1] = t[1]; v[rr][4 * q + 2] = t[2]; v[rr][4 * q + 3] = t[3];
                }
        } else {
#pragma unroll
            for (int rr = 0; rr < 4; ++rr)
#pragma unroll
                for (int c = 0; c < 16; ++c) v[rr][c] = src[(size_t)(row0 + rr) * D + c * 64 + F.lane];
        }
#pragma unroll
        for (int rr = 0; rr < 4; ++rr) {
            float am = 0.f;
#pragma unroll
            for (int c = 0; c < 16; ++c) am = fmaxf(am, fabsf(v[rr][c]));
            am = wave_max(am);
            const float sc = am > 0.f ? 6.f / am : 1.f;
            unsigned w0 = 0u, w1 = 0u;
            w0 = __builtin_amdgcn_cvt_scalef32_pk_fp4_f32(w0, v[rr][0] * sc, v[rr][1] * sc, 1.0f, 0);
            w0 = __builtin_amdgcn_cvt_scalef32_pk_fp4_f32(w0, v[rr][2] * sc, v[rr][3] * sc, 1.0f, 1);
            w0 = __builtin_amdgcn_cvt_scalef32_pk_fp4_f32(w0, v[rr][4] * sc, v[rr][5] * sc, 1.0f, 2);
            w0 = __builtin_amdgcn_cvt_scalef32_pk_fp4_f32(w0, v[rr][6] * sc, v[rr][7] * sc, 1.0f, 3);
            w1 = __builtin_amdgcn_cvt_scalef32_pk_fp4_f32(w1, v[rr][8] * sc, v[rr][9] * sc, 1.0f, 0);
            w1 = __builtin_amdgcn_cvt_scalef32_pk_fp4_f32(w1, v[rr][10] * sc, v[rr][11] * sc, 1.0f, 1);
            w1 = __builtin_amdgcn_cvt_scalef32_pk_fp4_f32(w1, v[rr][12] * sc, v[rr][13] * sc, 1.0f, 2);
            w1 = __builtin_amdgcn_cvt_scalef32_pk_fp4_f32(w1, v[rr][14] * sc, v[rr][15] * sc, 1.0f, 3);
            *(u32x2*)(dst + (size_t)(row0 + rr) * 512 + F.lane * 8) = (u32x2){w0, w1};
            if (F.lane == 0) sinv[row0 + rr] = am > 0.f ? am * (1.f / 6.f) : 1.f;
        }
        return;
    }
    for (int e = F.tid; e < (4864 - NMIX) * D; e += NTHREADS) F.WIN[(size_t)NMIX * D + e] = 0;
    for (int e = F.tid; e < 128 * 64; e += NTHREADS) { F.K1[e] = f2bf(F.peer_k1[e]); F.K2[e] = f2bf(F.peer_k2[e]); }
}
__device__ __forceinline__ void p0_prologue(const Frame& F) {
    constexpr int NMODWG = P0_MOD_ITEMS, HEAD = 8;
    if (F.G <= NMODWG) {
        for (int it = F.bid; it < P0_MOD_ITEMS + P0_OTHER; it += F.G) { if (it < P0_MOD_ITEMS) p0_mod_item(F, it); else p0_other_item(F, it - P0_MOD_ITEMS); }
        return;
    }
    const int nfree = F.G - NMODWG;
    int head_items = HEAD * nfree; if (head_items > P0_OTHER) head_items = P0_OTHER;
    if (F.bid < NMODWG) p0_mod_item(F, F.bid);
    else for (int j = F.bid - NMODWG; j < head_items; j += nfree) p0_other_item(F, j);
    for (int j = head_items + F.bid; j < P0_OTHER; j += F.G) p0_other_item(F, j);
}

__device__ __forceinline__ void p1_modulate(const Frame& F) {
    const int stride = F.G * 8;
    for (int m0 = F.bid * 8 + F.wave; m0 < NT; m0 += 2 * stride) {
        f32x4 xv[2][4], sv[2][4], hv[2][4];
#pragma unroll
        for (int rr = 0; rr < 2; ++rr) {
            const int m = (m0 + rr * stride < NT) ? m0 + rr * stride : m0;
            const float* xr = x_row(F, m); const float* mr = F.MOD + (size_t)mod_row(m) * 6144;
#pragma unroll
            for (int q = 0; q < 4; ++q) {
                const int e = (q >> 1) * 512 + F.lane * 8 + (q & 1) * 4;
                xv[rr][q] = *(const f32x4*)(xr + e); sv[rr][q] = *(const f32x4*)(mr + 1024 + e); hv[rr][q] = *(const f32x4*)(mr + e);
            }
        }
#pragma unroll
        for (int rr = 0; rr < 2; ++rr) {
            const int m = m0 + rr * stride;
            if (m >= NT) continue;
#pragma unroll
            for (int hlf = 0; hlf < 2; ++hlf) {
                const f32x4 a = xv[rr][2 * hlf] * (sv[rr][2 * hlf] + 1.f) + hv[rr][2 * hlf], b2 = xv[rr][2 * hlf + 1] * (sv[rr][2 * hlf + 1] + 1.f) + hv[rr][2 * hlf + 1];
                *(u32x4*)(F.H1 + (size_t)m * D + hlf * 512 + F.lane * 8) = (u32x4){cvt_pk_bf16(a[0], a[1]), cvt_pk_bf16(a[2], a[3]), cvt_pk_bf16(b2[0], b2[1]), cvt_pk_bf16(b2[2], b2[3])};
            }
        }
    }
}

constexpr int BM = 256, BN = 128, BK = 64;
constexpr int XPANEL = BM * 32 + 32, WPANEL = BN * 32 + 32;
constexpr int XSTAGE = 4 * XPANEL, WSTAGE = 4 * WPANEL, GSTAGE = XSTAGE + WSTAGE;
__device__ __forceinline__ void gemm_accum(const Frame& F, f32x16 (&acc)[2][2], const bf16_t* __restrict__ X, int ldx, const bf16_t* __restrict__ W, int ldw, int K, int m0, int n0) {
    const int tid = F.tid, lane = F.lane, r = lane & 31, h = lane >> 5, wm = F.wave >> 1, wn = F.wave & 1;
    u32x4 xr[4], wr[2];
    const int nk = K / BK;
    const int crow = tid >> 3, ckc = tid & 7;
    const bf16_t* xg = X + (size_t)(m0 + crow) * ldx + ckc * 8;
    const bf16_t* wg = W + (size_t)(n0 + crow) * ldw + ckc * 8;
    const int ldso = (ckc >> 1) * 1  ;
    const int xoff = ldso * XPANEL + crow * 32 + (ckc & 1) * 16;
    const int woff = ldso * WPANEL + crow * 32 + (ckc & 1) * 16;
#pragma unroll
    for (int i = 0; i < 4; ++i) xr[i] = *(const u32x4*)(xg + (size_t)(64 * i) * ldx);
#pragma unroll
    for (int i = 0; i < 2; ++i) wr[i] = *(const u32x4*)(wg + (size_t)(64 * i) * ldw);
    __syncthreads();
    for (int kt = 0; kt < nk; ++kt) {
        LAS unsigned char* st = F.lds + (kt & 1) * GSTAGE;
#pragma unroll
        for (int i = 0; i < 4; ++i) *(LAS u32x4*)(st + xoff + i * 64 * 32) = xr[i];
#pragma unroll
        for (int i = 0; i < 2; ++i) *(LAS u32x4*)(st + XSTAGE + woff + i * 64 * 32) = wr[i];
        __syncthreads();
        if (kt + 1 < nk) {
#pragma unroll
            for (int i = 0; i < 4; ++i) xr[i] = *(const u32x4*)(xg + (size_t)(64 * i) * ldx + (kt + 1) * BK);
#pragma unroll
            for (int i = 0; i < 2; ++i) wr[i] = *(const u32x4*)(wg + (size_t)(64 * i) * ldw + (kt + 1) * BK);
        }
#pragma unroll
        for (int s = 0; s < 4; ++s) {
            bf16x8 a[2], b[2];
#pragma unroll
            for (int ni = 0; ni < 2; ++ni) a[ni] = *(LAS bf16x8*)(st + XSTAGE + s * WPANEL + (wn * 64 + ni * 32 + r) * 32 + h * 16);
#pragma unroll
            for (int mi = 0; mi < 2; ++mi) b[mi] = *(LAS bf16x8*)(st + s * XPANEL + (wm * 64 + mi * 32 + r) * 32 + h * 16);
#pragma unroll
            for (int mi = 0; mi < 2; ++mi)
#pragma unroll
                for (int ni = 0; ni < 2; ++ni) acc[mi][ni] = __builtin_amdgcn_mfma_f32_32x32x16_bf16(a[ni], b[mi], acc[mi][ni], 0, 0, 0);
        }
    }
}
#define GEMM_EPI_LOOP(...) \
    { const int r_ = F.lane & 31, h_ = F.lane >> 5, wm_ = F.wave >> 1, wn_ = F.wave & 1; \
      _Pragma("unroll") for (int mi = 0; mi < 2; ++mi) _Pragma("unroll") for (int ni = 0; ni < 2; ++ni) _Pragma("unroll") for (int g = 0; g < 4; ++g) { \
          const int m = m0 + wm_ * 64 + mi * 32 + r_; const int n = n0 + wn_ * 64 + ni * 32 + 8 * g + 4 * h_; __VA_ARGS__ } }
#define ACC4(A) ((f32x4){A[mi][ni][4 * g], A[mi][ni][4 * g + 1], A[mi][ni][4 * g + 2], A[mi][ni][4 * g + 3]})
__device__ __forceinline__ void zero_acc(f32x16 (&acc)[2][2]) {
#pragma unroll
    for (int mi = 0; mi < 2; ++mi)
#pragma unroll
        for (int ni = 0; ni < 2; ++ni)
#pragma unroll
            for (int e = 0; e < 16; ++e) acc[mi][ni][e] = 0.f;
}
__device__ __forceinline__ u32x2 pk4(const f32x4 v) { return (u32x2){cvt_pk_bf16(v[0], v[1]), cvt_pk_bf16(v[2], v[3])}; }

__device__ __forceinline__ void gemm_slice8(const Frame& F, f32x16 (&sacc)[1][1], const bf16_t* __restrict__ X, int ldx, const bf16_t* __restrict__ W, int ldw, int K, int m0, int n0) {
    const int r = F.lane & 31, h = F.lane >> 5, wq = F.wave & 3, kh = F.wave >> 2;
    const bf16_t* wp = W + (size_t)(n0 + 32 * wq + r) * ldw + kh * (K / 2) + h * 8;
    const bf16_t* xp = X + (size_t)(m0 + (r & 7)) * ldx + kh * (K / 2) + h * 8;
    f32x16 c;
#pragma unroll
    for (int e = 0; e < 16; ++e) c[e] = 0.f;
#pragma unroll 1
    for (int k0 = 0; k0 < K / 2; k0 += 128) {
        bf16x8 a[8], b[8];
#pragma unroll
        for (int t = 0; t < 8; ++t) { a[t] = *(const bf16x8*)(wp + k0 + t * 16); b[t] = *(const bf16x8*)(xp + k0 + t * 16); }
#pragma unroll
        for (int t = 0; t < 8; ++t) c = __builtin_amdgcn_mfma_f32_32x32x16_bf16(a[t], b[t], c, 0, 0, 0);
    }
    LAS float* cb = (LAS float*)F.lds + wq * (16 * 64);
    __syncthreads();
    if (kh == 1) {
#pragma unroll
        for (int e = 0; e < 16; ++e) cb[e * 64 + F.lane] = c[e];
    }
    __syncthreads();
    if (kh == 0) {
#pragma unroll
        for (int e = 0; e < 16; ++e) c[e] += cb[e * 64 + F.lane];
    }
    sacc[0][0] = c;
}
#define SLICE_EPI_LOOP(...) \
    if (F.wave < 4 && (F.lane & 31) < 8) { const int h_ = F.lane >> 5, wq_ = F.wave & 3; constexpr int mi = 0, ni = 0; \
      _Pragma("unroll") for (int g = 0; g < 4; ++g) { const int m = m0 + (F.lane & 31); const int n = n0 + wq_ * 32 + 8 * g + 4 * h_; __VA_ARGS__ } }

namespace pg8 {
#define PG8_LAS __attribute__((address_space(3)))
typedef unsigned short bf16_t;
typedef short bf16x8 __attribute__((ext_vector_type(8)));
typedef float f32x4 __attribute__((ext_vector_type(4)));
typedef unsigned u32x4 __attribute__((ext_vector_type(4)));
constexpr int BM = 256, BK = 64, HALF = 128, HTB = HALF * BK * 2  , STAGE_BYTES = 8 * HTB, NXCD = 8, WGM = 8;

__host__ __device__ __forceinline__ int lds_byte(int r, int c) { const int st = (r >> 4) * 2 + (c >> 5), rr = r & 15, cc = c & 31, ob = rr * 64 + cc * 2; return st * 1024 + (ob ^ (((ob >> 9) & 1) << 5)); }
__host__ __device__ __forceinline__ void stage_rc(int b, int& R, int& C) { const int st = b / 1024, sb = b % 1024, swz = sb ^ (((sb >> 9) & 1) << 5); R = (st >> 1) * 16 + swz / 64; C = (st & 1) * 32 + (swz % 64) / 2; }
__host__ __device__ __forceinline__ int perm32(int rho) { const int n = rho >> 4, i = rho & 15; return 8 * (i >> 2) + 4 * n + (i & 3); }

struct Unit { int pm, pn; };
struct Gemm { const bf16_t* A; const bf16_t* Bt; int M, N, K; };

struct StaticOrder {
    int nM, nN, nwg, G, c;
    __host__ __device__ void init(int M, int N, int G_, int c_) { nM = M / BM; nN = N / BM; nwg = nM * nN; G = G_; c = c_; }
    __host__ __device__ bool next(int i, Unit& u) const {
        const long L = (long)i * G + c; if (L >= nwg) return false;
        int wgid = (int)L; { const int q = nwg / NXCD, r = nwg % NXCD, xcd = wgid % NXCD, off = wgid / NXCD; wgid = (xcd < r ? xcd * (q + 1) : r * (q + 1) + (xcd - r) * q) + off; }
        const int nig = WGM * nN, gid = wgid / nig, fm = gid * WGM, gsz = (nM - fm) < WGM ? (nM - fm) : WGM;
        u.pm = fm + ((wgid % nig) % gsz); u.pn = (wgid % nig) / gsz; return true;
    }
    __device__ __forceinline__ void a_ready(const Unit&) const {}
    __device__ __forceinline__ void done(const Unit&) const {}
};

template <class Body> struct EpiRC {
    static constexpr bool PERM = false, AFTER_DRAIN = false;
    Body body;
    __device__ __forceinline__ void operator()(const f32x4 (&acc)[2][2][4][2], const Unit& u, int wr, int wc, int fr, int fq) const {
#pragma unroll
        for (int ai = 0; ai < 2; ++ai)
#pragma unroll
            for (int m = 0; m < 4; ++m) {
                const int row = u.pm * BM + ai * HALF + wr * 64 + m * 16 + fr;
#pragma unroll
                for (int bj = 0; bj < 2; ++bj)
#pragma unroll
                    for (int n = 0; n < 2; ++n) body(row, u.pn * BM + bj * HALF + wc * 32 + n * 16 + 4 * fq, acc[ai][bj][m][n]);
            }
    }
};
template <class Epi, class Sched, bool ALIGN_EPI = false, bool SP2 = false>
__device__ __forceinline__ void gemm_phase(PG8_LAS unsigned char* lds, const Gemm g, const Sched& S, const Epi& E) {
    const int tid = threadIdx.x, wid = __builtin_amdgcn_readfirstlane(tid >> 6), lane = tid & 63, wr = wid >> 2, wc = wid & 3, fr = lane & 15, fq = lane >> 4;
    const int K = g.K, nt = K / BK;
    unsigned voffA[2], voffB[2];
#pragma unroll
    for (int i = 0; i < 2; ++i) { int R, C; stage_rc(tid * 16 + i * 8192, R, C); const int Rb = Epi::PERM ? ((R & ~31) + perm32(R & 31)) : R;
        voffA[i] = (unsigned)(R * K + C) * 2u; voffB[i] = (unsigned)(Rb * K + C) * 2u; }
    const size_t kstep = (size_t)(BK * 2);
    const size_t hstep = (size_t)HALF * K * 2;
    const size_t tstep = 2 * hstep;
    const unsigned ldsw = (unsigned)wid * 1024u;
    const int aoff = lds_byte(wr * 64 + fr, fq * 8), boff = lds_byte(wc * 32 + fr, fq * 8);
#define PG8_SA(b, h) (((b) * 2 + (h)) * HTB)
#define PG8_SB(b, h) ((4 + (b) * 2 + (h)) * HTB)
#define PG8_STAGE(bufoff, gbase, voff) do { _Pragma("unroll") for (int _i = 0; _i < 2; ++_i) \
        __builtin_amdgcn_global_load_lds((const unsigned*)((const char*)(gbase) + (voff)[_i]), (PG8_LAS unsigned*)(lds + (bufoff) + ldsw + _i * 8192), 16, 0, 0); } while (0)
#define PG8_LDA(dst, b, h) do { _Pragma("unroll") for (int m = 0; m < 4; ++m) _Pragma("unroll") for (int k = 0; k < 2; ++k) dst[m][k] = *(const PG8_LAS bf16x8*)(lds + PG8_SA(b, h) + aoff + m * 2048 + k * 1024); } while (0)
#define PG8_LDB(dst, b, h) do { _Pragma("unroll") for (int n = 0; n < 2; ++n) _Pragma("unroll") for (int k = 0; k < 2; ++k) dst[n][k] = *(const PG8_LAS bf16x8*)(lds + PG8_SB(b, h) + boff + n * 2048 + k * 1024); } while (0)
#define PG8_MMA(ai, bj, At, Bt) do { __builtin_amdgcn_s_setprio(1); _Pragma("unroll") for (int m = 0; m < 4; ++m) _Pragma("unroll") for (int n = 0; n < 2; ++n) _Pragma("unroll") for (int k = 0; k < 2; ++k) \
        acc[ai][bj][m][n] = __builtin_amdgcn_mfma_f32_16x16x32_bf16(Bt[n][k], At[m][k], acc[ai][bj][m][n], 0, 0, 0); __builtin_amdgcn_s_setprio(0); } while (0)
#define PG8_WAIT_V(n) asm volatile("s_waitcnt vmcnt(" #n ")" ::: "memory")
#define PG8_WAIT_L(n) asm volatile("s_waitcnt lgkmcnt(" #n ")" ::: "memory")
#define PG8_BAR __builtin_amdgcn_s_barrier()
#define PG8_SCHED __builtin_amdgcn_sched_barrier(0)
    Unit cur, nxt; int ui = 0;
    if (!S.next(0, cur)) return;
    f32x4 acc[2][2][4][2];
#pragma unroll
    for (int a = 0; a < 2; ++a)
#pragma unroll
        for (int b = 0; b < 2; ++b)
#pragma unroll
            for (int m = 0; m < 4; ++m)
#pragma unroll
                for (int n = 0; n < 2; ++n) acc[a][b][m][n] = (f32x4){0.f, 0.f, 0.f, 0.f};
    bf16x8 At[4][2], B0[2][2], B1[2][2];
    const char* cA = (const char*)g.A + (size_t)cur.pm * tstep; const char* cB = (const char*)g.Bt + (size_t)cur.pn * tstep;
    S.a_ready(cur);
    if constexpr (SP2) {
        PG8_STAGE(PG8_SB(0, 0), cB, voffB); PG8_STAGE(PG8_SB(0, 1), cB + hstep, voffB); PG8_STAGE(PG8_SA(0, 0), cA, voffA); PG8_STAGE(PG8_SA(0, 1), cA + hstep, voffA);
        if (wr == 1) PG8_BAR;
        PG8_WAIT_V(2); PG8_BAR;
        PG8_STAGE(PG8_SB(1, 0), cB + kstep, voffB); PG8_STAGE(PG8_SA(1, 0), cA + kstep, voffA); PG8_STAGE(PG8_SB(1, 1), cB + hstep + kstep, voffB);
        PG8_WAIT_V(6); PG8_BAR;
    } else {
        PG8_STAGE(PG8_SB(0, 0), cB, voffB); PG8_STAGE(PG8_SA(0, 0), cA, voffA); PG8_STAGE(PG8_SB(0, 1), cB + hstep, voffB); PG8_STAGE(PG8_SA(0, 1), cA + hstep, voffA);
        if (wr == 1) PG8_BAR;
        PG8_WAIT_V(4); PG8_BAR;
        PG8_STAGE(PG8_SB(1, 0), cB + kstep, voffB); PG8_STAGE(PG8_SA(1, 0), cA + kstep, voffA); PG8_STAGE(PG8_SB(1, 1), cB + hstep + kstep, voffB);
        PG8_WAIT_V(6); PG8_BAR;
    }
    for (;;) {
        const bool has_next = S.next(ui + 1, nxt);
        const char* nA = has_next ? (const char*)g.A + (size_t)nxt.pm * tstep : cA; const char* nB = has_next ? (const char*)g.Bt + (size_t)nxt.pn * tstep : cB;
        for (int t = 0; t < nt; t += 2) {
            const bool last = (t == nt - 2);
            const char* a1 = cA + (size_t)(t + 1) * kstep;
            const char* a2 = last ? nA : cA + (size_t)(t + 2) * kstep; const char* b2 = last ? nB : cB + (size_t)(t + 2) * kstep;
            const char* a3 = a2 + kstep; const char* b3 = b2 + kstep;
            if (last && has_next) S.a_ready(nxt);
            if constexpr (SP2) {
            PG8_LDB(B0, 0, 0); PG8_LDB(B1, 0, 1); PG8_SCHED; PG8_LDA(At, 0, 0); PG8_STAGE(PG8_SA(1, 1), a1 + hstep, voffA);
            PG8_WAIT_V(8); PG8_WAIT_L(0); PG8_BAR; PG8_MMA(0, 0, At, B0); PG8_MMA(0, 1, At, B1); PG8_BAR; PG8_SCHED;
            PG8_LDA(At, 0, 1); PG8_STAGE(PG8_SB(0, 0), b2, voffB); PG8_STAGE(PG8_SB(0, 1), b2 + hstep, voffB); PG8_STAGE(PG8_SA(0, 0), a2, voffA);
            PG8_WAIT_V(8); PG8_WAIT_L(0); PG8_BAR; PG8_MMA(1, 0, At, B0); PG8_MMA(1, 1, At, B1); PG8_BAR; PG8_SCHED;
            PG8_LDB(B0, 1, 0); PG8_LDB(B1, 1, 1); PG8_SCHED; PG8_LDA(At, 1, 0); PG8_STAGE(PG8_SA(0, 1), a2 + hstep, voffA);
            PG8_WAIT_V(8); PG8_WAIT_L(0); PG8_BAR; PG8_MMA(0, 0, At, B0); PG8_MMA(0, 1, At, B1); PG8_BAR; PG8_SCHED;
            PG8_LDA(At, 1, 1); PG8_STAGE(PG8_SB(1, 0), b3, voffB); PG8_STAGE(PG8_SB(1, 1), b3 + hstep, voffB); PG8_STAGE(PG8_SA(1, 0), a3, voffA);
            PG8_WAIT_V(8); PG8_WAIT_L(0); PG8_BAR; PG8_MMA(1, 0, At, B0); PG8_MMA(1, 1, At, B1); PG8_BAR; PG8_SCHED;
            } else {
            PG8_LDB(B0, 0, 0); PG8_SCHED; PG8_LDA(At, 0, 0); PG8_STAGE(PG8_SA(1, 1), a1 + hstep, voffA);
            PG8_WAIT_L(8); PG8_BAR; PG8_WAIT_L(0); PG8_MMA(0, 0, At, B0); PG8_BAR; PG8_SCHED;
            PG8_LDB(B1, 0, 1); PG8_STAGE(PG8_SB(0, 0), b2, voffB);
            PG8_BAR; PG8_WAIT_L(0); PG8_MMA(0, 1, At, B1); PG8_BAR;
            PG8_LDA(At, 0, 1); PG8_STAGE(PG8_SA(0, 0), a2, voffA);
            PG8_BAR; PG8_WAIT_L(0); PG8_MMA(1, 0, At, B0); PG8_BAR; PG8_SCHED;
            PG8_STAGE(PG8_SB(0, 1), b2 + hstep, voffB);
            PG8_WAIT_V(6); PG8_BAR; PG8_MMA(1, 1, At, B1); PG8_BAR;
            PG8_LDB(B0, 1, 0); PG8_SCHED; PG8_LDA(At, 1, 0); PG8_STAGE(PG8_SA(0, 1), a2 + hstep, voffA);
            PG8_WAIT_L(8); PG8_BAR; PG8_WAIT_L(0); PG8_MMA(0, 0, At, B0); PG8_BAR; PG8_SCHED;
            PG8_LDB(B1, 1, 1); PG8_STAGE(PG8_SB(1, 0), b3, voffB);
            PG8_BAR; PG8_WAIT_L(0); PG8_MMA(0, 1, At, B1); PG8_BAR;
            PG8_LDA(At, 1, 1); PG8_STAGE(PG8_SA(1, 0), a3, voffA);
            PG8_BAR; PG8_WAIT_L(0); PG8_MMA(1, 0, At, B0); PG8_BAR; PG8_SCHED;
            PG8_STAGE(PG8_SB(1, 1), b3 + hstep, voffB);
            PG8_WAIT_V(6); PG8_BAR; PG8_MMA(1, 1, At, B1); PG8_BAR;
            }
        }
        if constexpr (ALIGN_EPI) { if (wr == 0) PG8_BAR; }
        if constexpr (!Epi::AFTER_DRAIN) { E(acc, cur, wr, wc, fr, fq); S.done(cur); }
        if (!has_next) break;
#pragma unroll
        for (int a = 0; a < 2; ++a)
#pragma unroll
            for (int b = 0; b < 2; ++b)
#pragma unroll
                for (int m = 0; m < 4; ++m)
#pragma unroll
                    for (int n = 0; n < 2; ++n) acc[a][b][m][n] = (f32x4){0.f, 0.f, 0.f, 0.f};
        cur = nxt; cA = nA; cB = nB; ++ui;
        if constexpr (ALIGN_EPI) { if (wr == 1) PG8_BAR; }
    }
    PG8_WAIT_V(0);
    if constexpr (!ALIGN_EPI) { if (wr == 0) PG8_BAR; }
    PG8_BAR;
    if constexpr (Epi::AFTER_DRAIN) { E.fused(acc, cur, wr, wc, fr, fq, lds, wid, lane); S.done(cur); }
#undef PG8_SA
#undef PG8_SB
#undef PG8_STAGE
#undef PG8_LDA
#undef PG8_LDB
#undef PG8_MMA
#undef PG8_WAIT_V
#undef PG8_WAIT_L
#undef PG8_BAR
#undef PG8_SCHED
}
}

constexpr int NMIXW = 4864;
struct P2Body {
    const Frame* Fp;
    __device__ __forceinline__ void operator()(int m, int n, const f32x4 v) const {
        const Frame& F = *Fp;
        if (n >= NMIXP) return;
        *(u32x2*)(F.PROJ + (size_t)m * NMIXP + n) = pk4(v);
        if (n >= C_K && n < C_QI) {
            float* o = (n < C_V) ? (m < NTP ? F.out + O_KP + (size_t)m * 128 + (n - C_K) : F.out + O_KS + (size_t)(m - NTP) * 128 + (n - C_K))
                                 : (m < NTP ? F.out + O_VP + (size_t)m * 128 + (n - C_V) : F.out + O_VS + (size_t)(m - NTP) * 128 + (n - C_V));
            *(f32x4*)o = v;
            if (n >= C_V && m < NTP) {
                bf16_t* vt = (bf16_t*)(F.ws + WS_VT) + ((size_t)((m >> 11) * 2 + ((n - C_V) >> 6)) * 64 + ((n - C_V) & 63)) * SEQ + (m & 2047);
                vt[0] = f2bf(v[0]); vt[SEQ] = f2bf(v[1]); vt[2 * SEQ] = f2bf(v[2]); vt[3 * SEQ] = f2bf(v[3]);
            }
        } else if (n >= C_KI && n < C_BG) {
            float* o = m < NTP ? F.out + O_KIP + (size_t)m * 64 + (n - C_KI) : F.out + O_KIS + (size_t)(m - NTP) * 64 + (n - C_KI);
            *(f32x4*)o = v;
        } else if (n == C_WI) {
            *(f32x4*)(F.WI + (size_t)m * 4) = v;
        } else if (n >= C_CG && n < C_GA) {
            const int tt = (m < NTP) ? (m & 2047) - (SEQ - 2) : ((m - NTP) & 7) - (TS - 2);
            if (tt >= 0) {
                const int rowi = (m < NTP) ? (m >> 11) * 2 + tt : 2 * NB_P + ((m - NTP) >> 3) * 2 + tt;
                *(f32x4*)((float*)(F.ws + WS_CGX) + (size_t)rowi * 1024 + (n - C_CG)) = v;
            }
        }
    }
};
__device__ __forceinline__ void p2_gemm_in(const Frame& F) {
    pg8::Gemm g{F.H1, F.WIN, NT, NMIXW, D};
    pg8::StaticOrder S; S.init(NT, NMIXW, F.G, F.bid);
    pg8::EpiRC<P2Body> E{P2Body{&F}};
    pg8::gemm_phase<pg8::EpiRC<P2Body>, pg8::StaticOrder, true, true>(F.lds, g, S, E);
}

constexpr int SROW = 2052;
__device__ __forceinline__ int wave_sum_i(int v) {
#pragma unroll
    for (int o = 32; o >= 1; o >>= 1) v += __shfl_xor(v, o);
    return v;
}
__device__ __forceinline__ void cnt_ge(int& c, unsigned u, unsigned t) { asm("v_cmp_ge_u32_e32 vcc, %1, %2\n\tv_addc_co_u32_e32 %0, vcc, 0, %0, vcc" : "+v"(c) : "v"(u), "v"(t) : "vcc"); }
__device__ __forceinline__ void cnt_gt(int& c, unsigned u, unsigned t) { asm("v_cmp_gt_u32_e32 vcc, %1, %2\n\tv_addc_co_u32_e32 %0, vcc, 0, %0, vcc" : "+v"(c) : "v"(u), "v"(t) : "vcc"); }
__device__ __forceinline__ void cnt_eq(int& c, unsigned u, unsigned t) { asm("v_cmp_eq_u32_e32 vcc, %1, %2\n\tv_addc_co_u32_e32 %0, vcc, 0, %0, vcc" : "+v"(c) : "v"(u), "v"(t) : "vcc"); }
__device__ __forceinline__ void cnt_lt4(int& cl, unsigned u0, unsigned u1, unsigned u2, unsigned u3, unsigned t) {
    int d0, d1, d2, d3;
    asm("v_sub_u32 %1, %5, %9\n\tv_sub_u32 %2, %6, %9\n\tv_sub_u32 %3, %7, %9\n\tv_sub_u32 %4, %8, %9\n\t"
        "v_lshrrev_b32 %1, 31, %1\n\tv_lshrrev_b32 %2, 31, %2\n\tv_lshrrev_b32 %3, 31, %3\n\tv_lshrrev_b32 %4, 31, %4\n\t"
        "v_add3_u32 %0, %0, %1, %2\n\tv_add3_u32 %0, %0, %3, %4"
        : "+v"(cl), "=&v"(d0), "=&v"(d1), "=&v"(d2), "=&v"(d3) : "v"(u0), "v"(u1), "v"(u2), "v"(u3), "v"(t));
}
__device__ __forceinline__ void cnt_eq_pos(int& c, unsigned u, unsigned t, int L) {
    int tmp;
    asm("v_cmp_eq_u32_e32 vcc, %2, %3\n\tv_cndmask_b32_e32 %1, %5, %4, vcc\n\tv_cmp_lt_i32_e32 vcc, 0, %1\n\tv_addc_co_u32_e32 %0, vcc, 0, %0, vcc"
        : "+v"(c), "=&v"(tmp) : "v"(u), "v"(t), "v"(L), "v"(0x80000000) : "vcc");
}
__device__ __forceinline__ int wave_sum_i_dpp(int v) {
    v += __builtin_amdgcn_update_dpp(0, v, 0xB1, 0xF, 0xF, false);
    v += __builtin_amdgcn_update_dpp(0, v, 0x4E, 0xF, 0xF, false);
    v += __builtin_amdgcn_update_dpp(0, v, 0x141, 0xF, 0xF, false);
    v += __builtin_amdgcn_update_dpp(0, v, 0x140, 0xF, 0xF, false);
    v += __builtin_amdgcn_update_dpp(0, v, 0x142, 0xA, 0xF, false);
    v += __builtin_amdgcn_update_dpp(0, v, 0x143, 0xC, 0xF, false);
    return __builtin_amdgcn_readlane(v, 63);
}
template <int NV> __device__ __forceinline__ void select_threshold(const unsigned (&u)[NV], int ksel, int idx_bits, int lane, unsigned& T_out, int& Jx_out, int& ngt_out) {
    unsigned T = 0;
#pragma unroll 1
    for (int bit = 31; bit >= 0; --bit) {
        const unsigned cand = T | (1u << bit);
        int c = 0;
#pragma unroll
        for (int i = 0; i < NV; ++i) cnt_ge(c, u[i], cand);
        c = wave_sum_i_dpp(c);
        if (c >= ksel) T = cand;
    }
    int cg = 0, ce = 0;
#pragma unroll
    for (int i = 0; i < NV; ++i) { cnt_gt(cg, u[i], T); cnt_eq(ce, u[i], T); }
    const int ngt = wave_sum_i_dpp(cg), neq = wave_sum_i_dpp(ce);
    const int need = ksel - ngt;
    int Jx = 0x3FFFFFFF;
    if (need < neq) {
        int Jb = 0;
#pragma unroll 1
        for (int bit = idx_bits - 1; bit >= 0; --bit) {
            const int cand = Jb | (1 << bit);
            const int L = cand - lane;
            int c = 0;
#pragma unroll
            for (int i = 0; i < NV; ++i) cnt_eq_pos(c, u[i], T, L - 64 * i);
            c = wave_sum_i_dpp(c);
            if (c < need) Jb = cand;
        }
        Jx = Jb + 1;
    }
    T_out = T; Jx_out = Jx; ngt_out = ngt;
}
template <int NV> __device__ __forceinline__ void select_threshold2(const unsigned (&ua)[NV], const unsigned (&ub)[NV], int ksel, int idx_bits, int lane, int ng,
                                                                   unsigned& Ta_out, int& Jxa_out, unsigned& Tb_out, int& Jxb_out) {
    unsigned Ta = 0, Tb = 0;
    bool da = false, db = false;
#pragma unroll 1
    for (int bit = 30; bit >= 0 && !(da && db); --bit) {
        const unsigned ca = da ? Ta : (Ta | (1u << bit)), cb = db ? Tb : (Tb | (1u << bit));
        int la = 0, lb = 0;
#pragma unroll
        for (int i = 0; i < NV; i += 4) { if (i < 4 * ng) { cnt_lt4(la, ua[i], ua[i + 1], ua[i + 2], ua[i + 3], ca); cnt_lt4(lb, ub[i], ub[i + 1], ub[i + 2], ub[i + 3], cb); } }
        const int na = ng * 256 - wave_sum_i_dpp(la), nb = ng * 256 - wave_sum_i_dpp(lb);
        if (!da && na >= ksel) { Ta = ca; da = (na == ksel); }
        if (!db && nb >= ksel) { Tb = cb; db = (nb == ksel); }
    }
    int ga = 0, ea = 0, gb = 0, eb = 0;
#pragma unroll
    for (int i = 0; i < NV; ++i) { cnt_gt(ga, ua[i], Ta); cnt_eq(ea, ua[i], Ta); cnt_gt(gb, ub[i], Tb); cnt_eq(eb, ub[i], Tb); }
    const int needa = ksel - wave_sum_i_dpp(ga), neqa = wave_sum_i_dpp(ea), needb = ksel - wave_sum_i_dpp(gb), neqb = wave_sum_i_dpp(eb);
    int Jxa = 0x3FFFFFFF, Jxb = 0x3FFFFFFF;
    if (needa < neqa) {
        int Jb = 0;
#pragma unroll 1
        for (int bit = idx_bits - 1; bit >= 0; --bit) {
            const int cand = Jb | (1 << bit); const int L = cand - lane; int c = 0;
#pragma unroll
            for (int i = 0; i < NV; ++i) cnt_eq_pos(c, ua[i], Ta, L - 64 * i);
            if (wave_sum_i_dpp(c) < needa) Jb = cand;
        }
        Jxa = Jb + 1;
    }
    if (needb < neqb) {
        int Jb = 0;
#pragma unroll 1
        for (int bit = idx_bits - 1; bit >= 0; --bit) {
            const int cand = Jb | (1 << bit); const int L = cand - lane; int c = 0;
#pragma unroll
            for (int i = 0; i < NV; ++i) cnt_eq_pos(c, ub[i], Tb, L - 64 * i);
            if (wave_sum_i_dpp(c) < needb) Jb = cand;
        }
        Jxb = Jb + 1;
    }
    Ta_out = Ta; Jxa_out = Jxa; Tb_out = Tb; Jxb_out = Jxb;
}
template <int NV> __device__ __forceinline__ void select_topk(const unsigned (&u)[NV], int ksel, int idx_bits, int* sel, int lane) {
    unsigned T; int Jx, ngt;
    select_threshold<NV>(u, ksel, idx_bits, lane, T, Jx, ngt);
    const int L = Jx - lane;
    int cg = 0, ct = 0;
#pragma unroll
    for (int i = 0; i < NV; ++i) { cnt_gt(cg, u[i], T); cnt_eq_pos(ct, u[i], T, L - 64 * i); }
    int ig = cg, it = ct;
#pragma unroll
    for (int o = 1; o < 64; o <<= 1) { const int a = __shfl_up(ig, o), b2 = __shfl_up(it, o); if (lane >= o) { ig += a; it += b2; } }
    int pg = ig - cg, pt = ngt + it - ct;
    int ev = lane, Lr = L;
#pragma unroll
    for (int i = 0; i < NV; ++i) {
        if (u[i] > T) { sel[pg] = ev; ++pg; }
        else if (u[i] == T && Lr > 0) { sel[pt] = ev; ++pt; }
        asm volatile("v_add_u32 %0, 64, %0\n\tv_add_u32 %1, -64, %1" : "+v"(ev), "+v"(Lr));
    }
}

constexpr int PU_MB = 16 * SROW * 4;
constexpr int PU_RB = PU_MB + 16 * 64 * 4;
constexpr int PU_BT = PU_RB + 1024;
constexpr int PU_QT = PU_BT + 512, PU_QROW = 1040;
__device__ __forceinline__ int kappa32(int r) { return (r & 0x13) | ((r & 4) << 1) | ((r & 8) >> 1); }
__device__ __forceinline__ void p3_prompt_fused_unit(const Frame& F, const bf16_t* VT, int b, int qt) {
    LAS float* S = (LAS float*)F.lds;
    LAS unsigned* MB = (LAS unsigned*)(F.lds + PU_MB);
    LAS float* RB = (LAS float*)(F.lds + PU_RB);
    LAS int* BT = (LAS int*)(F.lds + PU_BT);
    const int lane = F.lane;
    const int q0 = qt * 16; const size_t tok0 = (size_t)b * SEQ;
    __syncthreads();
    for (int ch = F.tid; ch < 16 * 64; ch += NTHREADS) {
        const u32x4 qv = *(const u32x4*)(F.PROJ + (tok0 + q0 + (ch >> 6)) * NMIXP + C_Q + (ch & 63) * 8);
        constexpr float QS = ATTN_SCALE * 1.4426950408889634f;
        *(LAS u32x4*)(F.lds + PU_QT + (ch >> 6) * PU_QROW + (ch & 63) * 16) = (u32x4){cvt_pk_bf16(bflo(qv[0]) * QS, bfhi(qv[0]) * QS), cvt_pk_bf16(bflo(qv[1]) * QS, bfhi(qv[1]) * QS),
                                                                                    cvt_pk_bf16(bflo(qv[2]) * QS, bfhi(qv[2]) * QS), cvt_pk_bf16(bflo(qv[3]) * QS, bfhi(qv[3]) * QS)};
    }
    {
        const int r = lane & 15, q4 = lane >> 4;
        bf16x8 A[4][2];
#pragma unroll
        for (int hh = 0; hh < 4; ++hh)
#pragma unroll
            for (int s2 = 0; s2 < 2; ++s2) A[hh][s2] = *(const bf16x8*)(F.PROJ + (tok0 + q0 + r) * NMIXP + C_QI + hh * 64 + s2 * 32 + q4 * 8);
        float wv[4][4];
#pragma unroll
        for (int g = 0; g < 4; ++g) { const f32x4 w4 = *(const f32x4*)(F.WI + (tok0 + q0 + 4 * q4 + g) * 4);
#pragma unroll
            for (int hh = 0; hh < 4; ++hh) wv[g][hh] = w4[hh] * IDX_SCALE; }
        const int nkt = qt + 1;
        bf16x8 Bn[2][2];
        {
            const int t0 = 2 * F.wave;
#pragma unroll
            for (int p = 0; p < 2; ++p)
#pragma unroll
                for (int s2 = 0; s2 < 2; ++s2) { const int key = (t0 + p < nkt ? t0 + p : 0) * 16 + r; Bn[p][s2] = *(const bf16x8*)(F.PROJ + (tok0 + key) * NMIXP + C_KI + s2 * 32 + q4 * 8); }
        }
#pragma unroll 1
        for (int t0 = 2 * F.wave; t0 < nkt; t0 += 16) {
            bf16x8 B[2][2] = {{Bn[0][0], Bn[0][1]}, {Bn[1][0], Bn[1][1]}};
            {
                const int tn = t0 + 16;
#pragma unroll
                for (int p = 0; p < 2; ++p)
#pragma unroll
                    for (int s2 = 0; s2 < 2; ++s2) { const int key = (tn + p < nkt ? tn + p : 0) * 16 + r; Bn[p][s2] = *(const bf16x8*)(F.PROJ + (tok0 + key) * NMIXP + C_KI + s2 * 32 + q4 * 8); }
            }
#pragma unroll
            for (int p = 0; p < 2; ++p) {
                if (t0 + p >= nkt) continue;
                float sc[4] = {0.f, 0.f, 0.f, 0.f};
#pragma unroll
                for (int hh = 0; hh < 4; ++hh) {
                    f32x4 c = {0.f, 0.f, 0.f, 0.f};
                    c = __builtin_amdgcn_mfma_f32_16x16x32_bf16(A[hh][0], B[p][0], c, 0, 0, 0);
                    c = __builtin_amdgcn_mfma_f32_16x16x32_bf16(A[hh][1], B[p][1], c, 0, 0, 0);
#pragma unroll
                    for (int g = 0; g < 4; ++g) sc[g] += fmaxf(c[g], 0.f) * wv[g][hh];
                }
#pragma unroll
                for (int g = 0; g < 4; ++g) S[(4 * q4 + g) * SROW + (t0 + p) * 16 + r] = sc[g];
            }
        }
    }
    __syncthreads();
    {
        const int rowa = F.wave * 2, rowb = rowa + 1;
        const int nva = q0 + rowa + 1, nvb = nva + 1;
        if (nvb <= NSEL) {
#pragma unroll
            for (int i = 0; i < 32; ++i) {
                const unsigned long long ma = __ballot(lane + 64 * i < nva), mb = __ballot(lane + 64 * i < nvb);
                if (lane == 0) { MB[rowa * 64 + 2 * i] = (unsigned)ma; MB[rowa * 64 + 2 * i + 1] = (unsigned)(ma >> 32); MB[rowb * 64 + 2 * i] = (unsigned)mb; MB[rowb * 64 + 2 * i + 1] = (unsigned)(mb >> 32); }
            }
        } else {
            unsigned ua[32], ub[32];
#pragma unroll
            for (int i = 0; i < 32; ++i) { const int j = lane + 64 * i; ua[i] = (j < nva) ? (f2ord(S[rowa * SROW + j]) >> 1) : 0u; ub[i] = (j < nvb) ? (f2ord(S[rowb * SROW + j]) >> 1) : 0u; }
            unsigned Ta, Tb; int Jxa, Jxb;
            select_threshold2<32>(ua, ub, NSEL, 11, lane, (nvb + 255) >> 8, Ta, Jxa, Tb, Jxb);
            const int La = Jxa - lane, Lb = Jxb - lane;
#pragma unroll
            for (int i = 0; i < 32; ++i) {
                const bool ta = (ua[i] > Ta) || (ua[i] == Ta && (La - 64 * i) > 0), tb = (ub[i] > Tb) || (ub[i] == Tb && (Lb - 64 * i) > 0);
                const unsigned long long ma = __ballot(ta), mb = __ballot(tb);
                if (lane == 0) { MB[rowa * 64 + 2 * i] = (unsigned)ma; MB[rowa * 64 + 2 * i + 1] = (unsigned)(ma >> 32); MB[rowb * 64 + 2 * i] = (unsigned)mb; MB[rowb * 64 + 2 * i + 1] = (unsigned)(mb >> 32); }
            }
        }
    }
    __syncthreads();
    {
        const int g = F.wave & 1, kq = F.wave >> 1;
        const int c = lane & 31, h = lane >> 5;
        const int hd = g * 4 + (c & 3);
        LAS const unsigned char* Qb = F.lds + PU_QT + (c >> 2) * PU_QROW + (hd * 64 + h * 8) * 2;
        constexpr float L2E = 1.4426950408889634f;
        const float b31 = RB[31 * 8 + hd] * L2E;
        const int ntile = ((q0 + 15) >> 5) + 1;
        const bf16_t* Kb = F.PROJ + (tok0 + kappa32(c)) * NMIXP + C_K + g * 64 + h * 8;
        const bf16_t* Vb = VT + ((size_t)((b * 2 + g) * 64 + c)) * SEQ + h * 8;
        f32x16 O[2][2];
#pragma unroll
        for (int rt = 0; rt < 2; ++rt)
#pragma unroll
            for (int d = 0; d < 2; ++d)
#pragma unroll
                for (int e = 0; e < 16; ++e) O[rt][d][e] = 0.f;
        float lsum[2] = {0.f, 0.f};
        bf16x8 Kn[4];
        {
            const int key0 = (kq < ntile ? kq : 0) * 32;
#pragma unroll
            for (int s4 = 0; s4 < 4; ++s4) Kn[s4] = *(const bf16x8*)(Kb + (size_t)key0 * NMIXP + s4 * 16);
        }
#pragma unroll 1
        for (int kt = kq; kt < ntile; kt += 4) {
            const int key0 = kt * 32;
            bf16x8 Kf[4] = {Kn[0], Kn[1], Kn[2], Kn[3]}, Vf[2][2];
#pragma unroll
            for (int d = 0; d < 2; ++d)
#pragma unroll
                for (int s2 = 0; s2 < 2; ++s2) Vf[d][s2] = *(const bf16x8*)(Vb + (size_t)(32 * d) * SEQ + key0 + 16 * s2);
            {
                const int keyn = (kt + 4 < ntile ? kt + 4 : 0) * 32;
#pragma unroll
                for (int s4 = 0; s4 < 4; ++s4) Kn[s4] = *(const bf16x8*)(Kb + (size_t)keyn * NMIXP + s4 * 16);
            }
#pragma unroll
            for (int rt = 0; rt < 2; ++rt) {
                const int ql = rt * 8 + (c >> 2), q = q0 + ql;
                f32x16 X;
#pragma unroll
                for (int e = 0; e < 16; ++e) X[e] = 0.f;
#pragma unroll
                for (int s4 = 0; s4 < 4; ++s4) X = __builtin_amdgcn_mfma_f32_32x32x16_bf16(Kf[s4], *(LAS const bf16x8*)(Qb + rt * 8 * PU_QROW + s4 * 32), X, 0, 0, 0);
                const unsigned word = MB[ql * 64 + kt];
                const unsigned bits = ((word >> (8 * h)) & 0xFFu) | (((word >> (16 + 8 * h)) & 0xFFu) << 8);
                const bool nearT = (q0 + rt * 8) - (key0 + 31) < 113;
#pragma unroll
                for (int s2 = 0; s2 < 2; ++s2) {
                    float P[8];
                    if (nearT) {
#pragma unroll
                        for (int e8 = 0; e8 < 8; ++e8) {
                            const int e = 8 * s2 + e8;
                            const int key = key0 + e8 + 16 * s2 + 8 * h;
                            int dist = q - key; dist = dist < 0 ? 0 : (dist > 127 ? 127 : dist);
                            const float bias = RB[BT[dist] * 8 + hd] * L2E;
                            const float lg = fminf(X[e] + bias, 86.f);
                            P[e8] = __int_as_float(__float_as_int(__builtin_amdgcn_exp2f(lg)) & __builtin_amdgcn_sbfe((int)bits, e, 1));
                        }
                    } else {
#pragma unroll
                        for (int e8 = 0; e8 < 8; ++e8) {
                            const int e = 8 * s2 + e8;
                            const float lg = fminf(X[e] + b31, 86.f);
                            P[e8] = __int_as_float(__float_as_int(__builtin_amdgcn_exp2f(lg)) & __builtin_amdgcn_sbfe((int)bits, e, 1));
                        }
                    }
#pragma unroll
                    for (int e8 = 0; e8 < 8; ++e8) lsum[rt] += P[e8];
                    const u32x4 pk = (u32x4){cvt_pk_bf16(P[0], P[1]), cvt_pk_bf16(P[2], P[3]), cvt_pk_bf16(P[4], P[5]), cvt_pk_bf16(P[6], P[7])};
                    bf16x8 Pf; __builtin_memcpy(&Pf, &pk, 16);
                    O[rt][0] = __builtin_amdgcn_mfma_f32_32x32x16_bf16(Vf[0][s2], Pf, O[rt][0], 0, 0, 0);
                    O[rt][1] = __builtin_amdgcn_mfma_f32_32x32x16_bf16(Vf[1][s2], Pf, O[rt][1], 0, 0, 0);
                }
                __builtin_amdgcn_sched_barrier(0);
            }
        }
        LAS float* CB = (LAS float*)F.lds + (g * 3 + (kq > 0 ? kq - 1 : 0)) * (66 * 64);
        __syncthreads();
        if (kq > 0) {
#pragma unroll
            for (int rt = 0; rt < 2; ++rt) {
#pragma unroll
                for (int d = 0; d < 2; ++d)
#pragma unroll
                    for (int e = 0; e < 16; ++e) CB[((rt * 2 + d) * 16 + e) * 64 + lane] = O[rt][d][e];
                CB[(64 + rt) * 64 + lane] = lsum[rt];
            }
        }
        __syncthreads();
        if (kq == 0) {
#pragma unroll 1
            for (int p = 0; p < 3; ++p) {
                LAS const float* CP = (LAS const float*)F.lds + (g * 3 + p) * (66 * 64);
#pragma unroll
                for (int rt = 0; rt < 2; ++rt) {
#pragma unroll
                    for (int d = 0; d < 2; ++d)
#pragma unroll
                        for (int e = 0; e < 16; ++e) O[rt][d][e] += CP[((rt * 2 + d) * 16 + e) * 64 + lane];
                    lsum[rt] += CP[(64 + rt) * 64 + lane];
                }
            }
#pragma unroll
            for (int rt = 0; rt < 2; ++rt) {
                float l = lsum[rt]; l += __shfl_xor(l, 32);
                const float inv = 1.f / l;
                bf16_t* orow = F.OATT + (tok0 + q0 + rt * 8 + (c >> 2)) * 512 + hd * 64;
#pragma unroll
                for (int a4 = 0; a4 < 4; ++a4) {
                    const f32x4 v0 = (f32x4){O[rt][0][4 * a4], O[rt][0][4 * a4 + 1], O[rt][0][4 * a4 + 2], O[rt][0][4 * a4 + 3]} * inv;
                    const f32x4 v1 = (f32x4){O[rt][1][4 * a4], O[rt][1][4 * a4 + 1], O[rt][1][4 * a4 + 2], O[rt][1][4 * a4 + 3]} * inv;
                    *(u32x2*)(orow + 8 * a4 + 4 * h) = pk4(v0);
                    *(u32x2*)(orow + 32 + 8 * a4 + 4 * h) = pk4(v1);
                }
            }
        }
    }
}

__device__ __forceinline__ void p3_sample_score_unit(const Frame& F, float* SS, int b, int ch) {
    const int lane = F.lane, r = lane & 31, h = lane >> 5;
    bf16x8 A[4];
    { const int q = r >> 2, hh = r & 3;
#pragma unroll
      for (int s4 = 0; s4 < 4; ++s4) A[s4] = *(const bf16x8*)(F.PROJ + (size_t)(NTP + b * TS + q) * NMIXP + C_QI + hh * 64 + s4 * 16 + h * 8); }
    float wv[4][4];
#pragma unroll
    for (int g = 0; g < 4; ++g) { const f32x4 w4 = *(const f32x4*)(F.WI + (size_t)(NTP + b * TS + 2 * g + h) * 4);
#pragma unroll
        for (int hh = 0; hh < 4; ++hh) wv[g][hh] = w4[hh] * IDX_SCALE; }
    f32x4 kn[8];
    { const int key0 = ch * 1024 + F.wave * 32; const int page = F.page_table[b * NPAGES + (key0 >> 7)];
      const float* kr = F.cache_ki + ((size_t)page * PAGE + (key0 & 127) + r) * 64 + h * 8;
#pragma unroll
      for (int s4 = 0; s4 < 4; ++s4) { kn[2 * s4] = *(const f32x4*)(kr + s4 * 16); kn[2 * s4 + 1] = *(const f32x4*)(kr + s4 * 16 + 4); } }
#pragma unroll 1
    for (int tl = F.wave; tl < 32; tl += 8) {
        const int key0 = ch * 1024 + tl * 32;
        f32x4 kc[8];
#pragma unroll
        for (int i = 0; i < 8; ++i) kc[i] = kn[i];
        if (tl + 8 < 32) {
            const int keyn = key0 + 256; const int page = F.page_table[b * NPAGES + (keyn >> 7)];
            const float* kr = F.cache_ki + ((size_t)page * PAGE + (keyn & 127) + r) * 64 + h * 8;
#pragma unroll
            for (int s4 = 0; s4 < 4; ++s4) { kn[2 * s4] = *(const f32x4*)(kr + s4 * 16); kn[2 * s4 + 1] = *(const f32x4*)(kr + s4 * 16 + 4); }
        }
        f32x16 c;
#pragma unroll
        for (int e = 0; e < 16; ++e) c[e] = 0.f;
#pragma unroll
        for (int s4 = 0; s4 < 4; ++s4) {
            const f32x4 lo = kc[2 * s4], hi = kc[2 * s4 + 1];
            const u32x4 pk = (u32x4){cvt_pk_bf16(lo[0], lo[1]), cvt_pk_bf16(lo[2], lo[3]), cvt_pk_bf16(hi[0], hi[1]), cvt_pk_bf16(hi[2], hi[3])};
            bf16x8 Bf; __builtin_memcpy(&Bf, &pk, 16);
            c = __builtin_amdgcn_mfma_f32_32x32x16_bf16(A[s4], Bf, c, 0, 0, 0);
        }
#pragma unroll
        for (int g = 0; g < 4; ++g) {
            float sc = 0.f;
#pragma unroll
            for (int hh = 0; hh < 4; ++hh) sc += fmaxf(c[4 * g + hh], 0.f) * wv[g][hh];
            SS[(size_t)(b * TS + 2 * g + h) * PAST + key0 + r] = sc;
        }
    }
}
__device__ __forceinline__ void p3_index(const Frame& F) {
    constexpr int NSU = NB_S * 8;
    const int nunits = NSU + NB_P * (SEQ / 16);
    float* SS = (float*)(F.ws + WS_SS);
    const bf16_t* VT = (const bf16_t*)(F.ws + WS_VT);
    __syncthreads();
    if (F.tid < 256) ((LAS float*)(F.lds + PU_RB))[F.tid] = F.rel_bias[F.tid];
    if (F.tid < 128) ((LAS int*)(F.lds + PU_BT))[F.tid] = t5_bucket(F.tid);
    __syncthreads();
    for (int it = F.bid; it < nunits; it += F.G) {
        if (it < NSU) { p3_sample_score_unit(F, SS, it >> 3, it & 7); continue; }
        const int i = it - NSU; const int b = i & 7, sl = (i >> 3) & 31, rnd = i >> 8;
        const int qt = rnd == 0 ? 127 - sl : (rnd == 1 ? 64 + sl : (rnd == 2 ? 63 - sl : sl));
        p3_prompt_fused_unit(F, VT, b, qt);
    }
}

constexpr int SQ_CNT = 0;
constexpr int SQ_SEL = 1024;
constexpr int SQ_Q = 2048;
constexpr int SQ_PHYS = 3072;
constexpr int SQ_P = 4096;
constexpr int SQ_RB = 16384;
constexpr int SQ_BT = 17408;
__device__ __forceinline__ int wg_sum8(const Frame& F, LAS unsigned* slot, int v) {
    if (F.lane == 0) slot[F.wave] = (unsigned)v;
    __syncthreads();
    int t = 0;
#pragma unroll
    for (int w = 0; w < 8; ++w) t += (int)slot[w];
    return t;
}
__device__ __forceinline__ void p4_sample_query_unit(const Frame& F, const float* SS, int b, int t) {
    const int lane = F.lane, w = F.wave;
    LAS unsigned* CNT = (LAS unsigned*)(F.lds + SQ_CNT);
    LAS int* SELL = (LAS int*)(F.lds + SQ_SEL);
    LAS unsigned* QL = (LAS unsigned*)(F.lds + SQ_Q);
    LAS float* PL = (LAS float*)(F.lds + SQ_P) + w * 256;
    LAS float* RB = (LAS float*)(F.lds + SQ_RB);
    LAS int* BT = (LAS int*)(F.lds + SQ_BT);
    const int tok = NTP + b * TS + t;
    __syncthreads();
    if (F.tid < 256) QL[F.tid] = ((const unsigned*)(F.PROJ + (size_t)tok * NMIXP + C_Q))[F.tid];
    unsigned u[17];
    { const float* srow = SS + (size_t)(b * TS + t) * PAST + w * 1024;
#pragma unroll
      for (int i = 0; i < 16; ++i) u[i] = f2ord(srow[64 * i + lane]); }
    u[16] = 0u;
    if (w == 7) {
        const int kj = lane < TS ? lane : 0;
        const bf16_t* kn = F.PROJ + (size_t)(NTP + b * TS + kj) * NMIXP + C_KI;
        const bf16_t* qn = F.PROJ + (size_t)tok * NMIXP + C_QI;
        u32x4 kv[8];
#pragma unroll
        for (int c = 0; c < 8; ++c) kv[c] = *(const u32x4*)(kn + c * 8);
        int vz; asm volatile("v_mov_b32 %0, 0" : "=v"(vz));
        const f32x4 w4 = *(const f32x4*)(F.WI + (size_t)tok * 4 + vz);
        float sc = 0.f;
#pragma unroll
        for (int hh = 0; hh < 4; ++hh) {
            u32x4 qv[8];
#pragma unroll
            for (int c = 0; c < 8; ++c) qv[c] = *(const u32x4*)(qn + hh * 64 + c * 8 + vz);
            float d = 0.f;
#pragma unroll
            for (int c = 0; c < 8; ++c)
#pragma unroll
                for (int e = 0; e < 4; ++e) d += bflo(qv[c][e]) * bflo(kv[c][e]) + bfhi(qv[c][e]) * bfhi(kv[c][e]);
            sc += fmaxf(d, 0.f) * (w4[hh] * IDX_SCALE);
        }
        u[16] = (lane < TS && lane <= t) ? f2ord(sc) : 0u;
    }
    unsigned T = 0;
#pragma unroll 1
    for (int bit = 31; bit >= 0; --bit) {
        const unsigned cand = T | (1u << bit);
        int c = 0;
#pragma unroll
        for (int i = 0; i < 17; ++i) cnt_ge(c, u[i], cand);
        c = wg_sum8(F, CNT + (bit & 1) * 24, wave_sum_i_dpp(c));
        if (c >= NSEL) T = cand;
        if (c == NSEL) break;
    }
    int cg = 0, ce = 0;
#pragma unroll
    for (int i = 0; i < 17; ++i) { cnt_gt(cg, u[i], T); cnt_eq(ce, u[i], T); }
    const int cgw = wave_sum_i_dpp(cg);
    const int ngt = wg_sum8(F, CNT + 8, cgw);
    const int neq = wg_sum8(F, CNT + 16, wave_sum_i_dpp(ce));
    const int need = NSEL - ngt;
    int Jx = 0x3FFFFFFF;
    if (need < neq) {
        int Jb = 0;
#pragma unroll 1
        for (int bit = 13; bit >= 0; --bit) {
            const int cand = Jb | (1 << bit);
            const int L = cand - lane - 1024 * w;
            int c = 0;
#pragma unroll
            for (int i = 0; i < 17; ++i) cnt_eq_pos(c, u[i], T, L - 64 * i);
            c = wg_sum8(F, CNT + (bit & 1) * 24, wave_sum_i_dpp(c));
            if (c < need) Jb = cand;
        }
        Jx = Jb + 1;
    }
    {
        const int L = Jx - lane - 1024 * w;
        int ct = 0;
#pragma unroll
        for (int i = 0; i < 17; ++i) cnt_eq_pos(ct, u[i], T, L - 64 * i);
        const int ctw = wave_sum_i_dpp(ct);
        __syncthreads();
        if (lane == 0) { CNT[w] = (unsigned)cgw; CNT[8 + w] = (unsigned)ctw; }
        __syncthreads();
        int bg = 0, bt = ngt;
#pragma unroll
        for (int ww = 0; ww < 8; ++ww) { if (ww < w) { bg += (int)CNT[ww]; bt += (int)CNT[8 + ww]; } }
        int ig = cg, it2 = ct;
#pragma unroll
        for (int o = 1; o < 64; o <<= 1) { const int a = __shfl_up(ig, o), b2 = __shfl_up(it2, o); if (lane >= o) { ig += a; it2 += b2; } }
        int pg = bg + ig - cg, pt = bt + it2 - ct;
        int ev = 1024 * w + lane, Lr = L;
#pragma unroll
        for (int i = 0; i < 17; ++i) {
            if (u[i] > T) { SELL[pg] = ev; ++pg; }
            else if (u[i] == T && Lr > 0) { SELL[pt] = ev; ++pt; }
            asm volatile("v_add_u32 %0, 64, %0\n\tv_add_u32 %1, -64, %1" : "+v"(ev), "+v"(Lr));
        }
    }
    __syncthreads();
    LAS int* PHYS = (LAS int*)(F.lds + SQ_PHYS);
    if (F.tid < 256) { const int sraw = SELL[F.tid]; PHYS[F.tid] = (sraw < PAST) ? F.page_table[b * NPAGES + (sraw >> 7)] * PAGE + (sraw & 127) : -1 - (sraw - PAST); }
    __syncthreads();
    {
        const int hd = w, g = w >> 2, qpos = PAST + t;
        float lg[4];
#pragma unroll 2
        for (int i = 0; i < 4; ++i) {
            const int sraw = SELL[lane + 64 * i], ph = PHYS[lane + 64 * i];
            const float* kr = (ph >= 0) ? F.cache_k + (size_t)ph * 128 + g * 64 : F.out + O_KS + (size_t)(b * TS + (-1 - ph)) * 128 + g * 64;
            float a0 = 0.f, a1 = 0.f;
#pragma unroll
            for (int c = 0; c < 16; ++c) {
                const f32x4 kv = *(const f32x4*)(kr + c * 4);
                const unsigned q0 = QL[hd * 32 + c * 2], q1 = QL[hd * 32 + c * 2 + 1];
                a0 += bflo(q0) * kv[0] + bfhi(q0) * kv[1]; a1 += bflo(q1) * kv[2] + bfhi(q1) * kv[3];
            }
            const int dist = qpos - sraw; const int bk = dist < 128 ? BT[dist] : 31;
            lg[i] = (a0 + a1) * ATTN_SCALE + RB[bk * 8 + hd];
        }
        float m = fmaxf(fmaxf(lg[0], lg[1]), fmaxf(lg[2], lg[3])); m = wave_max(m);
        float sm = 0.f;
#pragma unroll
        for (int i = 0; i < 4; ++i) { lg[i] = __expf(lg[i] - m); sm += lg[i]; }
        const float inv = 1.f / wave_sum_dpp(sm);
#pragma unroll
        for (int i = 0; i < 4; ++i) PL[lane + 64 * i] = lg[i] * inv;
        const int dq = lane & 15, ks = lane >> 4;
        f32x4 o4 = {0.f, 0.f, 0.f, 0.f};
#pragma unroll 1
        for (int j0 = 0; j0 < 256; j0 += 64) {
            f32x4 vv[16]; float pp[16];
#pragma unroll
            for (int jj = 0; jj < 16; ++jj) {
                const int j = j0 + jj * 4 + ks;
                const int ph = PHYS[j]; pp[jj] = PL[j];
                const float* vr = (ph >= 0) ? F.cache_v + (size_t)ph * 128 + g * 64 : F.out + O_VS + (size_t)(b * TS + (-1 - ph)) * 128 + g * 64;
                vv[jj] = *(const f32x4*)(vr + 4 * dq);
            }
#pragma unroll
            for (int jj = 0; jj < 16; ++jj) o4 += vv[jj] * pp[jj];
        }
#pragma unroll
        for (int e = 0; e < 4; ++e) { o4[e] += __shfl_xor(o4[e], 16); o4[e] += __shfl_xor(o4[e], 32); }
        if (ks == 0) *(u32x2*)(F.OATT + (size_t)tok * 512 + hd * 64 + 4 * dq) = pk4(o4);
    }
}
__device__ __forceinline__ void p4_attention(const Frame& F) {
    const float* SS = (const float*)(F.ws + WS_SS);
    __syncthreads();
    if (F.tid < 256) ((LAS float*)(F.lds + SQ_RB))[F.tid] = F.rel_bias[F.tid];
    if (F.tid < 128) ((LAS int*)(F.lds + SQ_BT))[F.tid] = t5_bucket(F.tid);
    __syncthreads();
    for (int it = F.bid; it < NTS; it += F.G) p4_sample_query_unit(F, SS, it >> 3, it & 7);
    {
        const int c0 = F.lane * 8;
        float cw0[8], cw1[8], cw2[8], cbv[8];
#pragma unroll
        for (int e = 0; e < 8; ++e) { cw0[e] = F.conv_w[c0 + e]; cw1[e] = F.conv_w[512 + c0 + e]; cw2[e] = F.conv_w[1024 + c0 + e]; cbv[e] = F.conv_b[c0 + e]; }
        const int stride = F.G * 8;
        u32x4 n_cg[3], n_xi[3], n_bg;
        auto fetch = [&](int m) {
#pragma unroll
            for (int d = 0; d < 3; ++d) { const int mm = (m - d >= 0) ? m - d : 0; n_cg[d] = *(const u32x4*)(F.PROJ + (size_t)mm * NMIXP + C_CG + c0); n_xi[d] = *(const u32x4*)(F.PROJ + (size_t)mm * NMIXP + C_XIN + c0); }
            n_bg = *(const u32x4*)(F.PROJ + (size_t)m * NMIXP + C_BG + c0);
        };
        { const int m = F.bid * 8 + F.wave; fetch(m < NT ? m : 0); }
        for (int m = F.bid * 8 + F.wave; m < NT; m += stride) {
            u32x4 cg[3], xi[3]; const u32x4 bg = n_bg;
#pragma unroll
            for (int d = 0; d < 3; ++d) { cg[d] = n_cg[d]; xi[d] = n_xi[d]; }
            fetch(m + stride < NT ? m + stride : m);
            int t, T_, bsm; if (m < NTP) { t = m & 2047; T_ = SEQ; bsm = m >> 11; } else { t = (m - NTP) & 7; T_ = TS; bsm = (m - NTP) >> 3; }
            float u[3][8];
#pragma unroll
            for (int d = 0; d < 3; ++d) {
                if (t - d >= 0) {
#pragma unroll
                    for (int e = 0; e < 4; ++e) { u[d][2 * e] = bflo(cg[d][e]) * bflo(xi[d][e]); u[d][2 * e + 1] = bfhi(cg[d][e]) * bfhi(xi[d][e]); }
                } else if (m >= NTP) {
                    const float* pv = F.state_conv + ((size_t)bsm * 2 + (2 + t - d)) * 512 + c0;
#pragma unroll
                    for (int e = 0; e < 8; ++e) u[d][e] = pv[e];
                } else {
#pragma unroll
                    for (int e = 0; e < 8; ++e) u[d][e] = 0.f;
                }
            }
            float y[8];
#pragma unroll
            for (int e = 0; e < 8; ++e) {
                const float yy = cbv[e] + cw0[e] * u[2][e] + cw1[e] * u[1][e] + cw2[e] * u[0][e];
                const float bgv = (e & 1) ? bfhi(bg[e >> 1]) : bflo(bg[e >> 1]);
                y[e] = bgv * yy;
            }
            *(u32x4*)(F.OCONV + (size_t)m * 512 + c0) = (u32x4){cvt_pk_bf16(y[0], y[1]), cvt_pk_bf16(y[2], y[3]), cvt_pk_bf16(y[4], y[5]), cvt_pk_bf16(y[6], y[7])};
            if (t >= T_ - 2) {
                float* o = (m < NTP ? F.out + O_CP : F.out + O_CS) + ((size_t)bsm * 2 + (t - (T_ - 2))) * 512 + c0;
                const int rowi = (m < NTP) ? bsm * 2 + (t - (T_ - 2)) : 2 * NB_P + bsm * 2 + (t - (T_ - 2));
                const float* cx = (const float*)(F.ws + WS_CGX) + (size_t)rowi * 1024 + c0;
                const f32x4 ca = *(const f32x4*)cx, cb2 = *(const f32x4*)(cx + 4), xa = *(const f32x4*)(cx + 512), xb = *(const f32x4*)(cx + 516);
                *(f32x4*)o = ca * xa; *(f32x4*)(o + 4) = cb2 * xb;
            }
        }
    }
}

#define P5_EPI(A1, A2) { \
            const f32x4 va = ACC4(A1), vc = ACC4(A2); \
            const u32x2 ga = *(const u32x2*)(F.PROJ + (size_t)m * NMIXP + C_GA + n), gb = *(const u32x2*)(F.PROJ + (size_t)m * NMIXP + C_GB + n); \
            f32x4 o; \
            o[0] = sigmoidf_(bflo(ga[0])) * va[0] + sigmoidf_(bflo(gb[0])) * vc[0]; \
            o[1] = sigmoidf_(bfhi(ga[0])) * va[1] + sigmoidf_(bfhi(gb[0])) * vc[1]; \
            o[2] = sigmoidf_(bflo(ga[1])) * va[2] + sigmoidf_(bflo(gb[1])) * vc[2]; \
            o[3] = sigmoidf_(bfhi(ga[1])) * va[3] + sigmoidf_(bfhi(gb[1])) * vc[3]; \
            *(u32x2*)(F.MERGED + (size_t)m * D + n) = pk4(o); }
struct P5aBody {
    const Frame* Fp;
    __device__ __forceinline__ void operator()(int m, int n, const f32x4 v) const { *(u32x2*)(Fp->MERGED + (size_t)m * D + n) = pk4(v); }
};
struct P5bBody {
    const Frame* Fp;
    __device__ __forceinline__ void operator()(int m, int n, const f32x4 v) const {
        const Frame& F = *Fp;
        const u32x2 ga = *(const u32x2*)(F.PROJ + (size_t)m * NMIXP + C_GA + n), gb = *(const u32x2*)(F.PROJ + (size_t)m * NMIXP + C_GB + n);
        const u32x2 pa = *(const u32x2*)(F.MERGED + (size_t)m * D + n);
        const f32x4 o = (f32x4){sigmoidf_(bflo(ga[0])) * bflo(pa[0]) + sigmoidf_(bflo(gb[0])) * v[0], sigmoidf_(bfhi(ga[0])) * bfhi(pa[0]) + sigmoidf_(bfhi(gb[0])) * v[1],
                                sigmoidf_(bflo(ga[1])) * bflo(pa[1]) + sigmoidf_(bflo(gb[1])) * v[2], sigmoidf_(bfhi(ga[1])) * bfhi(pa[1]) + sigmoidf_(bfhi(gb[1])) * v[3]};
        *(u32x2*)(F.MERGED + (size_t)m * D + n) = pk4(o);
    }
};
__device__ __forceinline__ void p5_gemm_merge(const Frame& F) {
    {
        pg8::StaticOrder S; S.init(NTP, D, F.G, F.bid);
        { pg8::Gemm g{F.OATT, F.WOA, NTP, D, 512}; pg8::EpiRC<P5aBody> E{P5aBody{&F}}; pg8::gemm_phase<pg8::EpiRC<P5aBody>, pg8::StaticOrder, true, true>(F.lds, g, S, E); }
        asm volatile("s_waitcnt vmcnt(0)" ::: "memory"); __syncthreads();
        { pg8::Gemm g{F.OCONV, F.WOC, NTP, D, 512}; pg8::EpiRC<P5bBody> E{P5bBody{&F}}; pg8::gemm_phase<pg8::EpiRC<P5bBody>, pg8::StaticOrder, true, true>(F.lds, g, S, E); }
    }
    for (int sl = F.bid; sl < NTS / 8 * (D / BN); sl += F.G) {
        const int m0 = NTP + (sl >> 3) * 8, n0 = (sl & 7) * BN;
        f32x16 s1[1][1], s2[1][1];
        gemm_slice8(F, s1, F.OATT, 512, F.WOA, 512, 512, m0, n0);
        gemm_slice8(F, s2, F.OCONV, 512, F.WOC, 512, 512, m0, n0);
        SLICE_EPI_LOOP(P5_EPI(s1, s2))
    }
}
#define P6_EPI(A1) { \
            const f32x4 v = ACC4(A1); \
            const f32x4 xv = *(const f32x4*)(x_row(F, m) + n); \
            const f32x4 g1 = *(const f32x4*)(F.MOD + (size_t)mod_row(m) * 6144 + 2048 + n); \
            *(f32x4*)(F.T1 + (size_t)m * D + n) = xv * DN_ALPHA + g1 * v; }
struct P6Body {
    const Frame* Fp;
    __device__ __forceinline__ void operator()(int m, int n, const f32x4 v) const {
        const Frame& F = *Fp;
        const f32x4 xv = *(const f32x4*)(F.x_p + (size_t)m * D + n);
        const f32x4 g1 = *(const f32x4*)(F.MOD + (size_t)(m >> 11) * 6144 + 2048 + n);
        *(f32x4*)(F.T1 + (size_t)m * D + n) = xv * DN_ALPHA + g1 * v;
    }
};
__device__ __forceinline__ void p6_gemm_out(const Frame& F) {
    {
        pg8::Gemm g{F.MERGED, F.WOUT, NTP, D, D}; pg8::StaticOrder S; S.init(NTP, D, F.G, F.bid);
        pg8::EpiRC<P6Body> E{P6Body{&F}}; pg8::gemm_phase<pg8::EpiRC<P6Body>, pg8::StaticOrder, true, true>(F.lds, g, S, E);
    }
    for (int sl = F.bid; sl < NTS / 8 * (D / BN); sl += F.G) {
        const int m0 = NTP + (sl >> 3) * 8, n0 = (sl & 7) * BN;
        f32x16 s1[1][1];
        gemm_slice8(F, s1, F.MERGED, D, F.WOUT, D, D, m0, n0);
        SLICE_EPI_LOOP(P6_EPI(s1))
    }
}
__device__ __forceinline__ void p7_ln1(const Frame& F) {
    f32x4 lg[4], lb[4];
#pragma unroll
    for (int i = 0; i < 4; ++i) { const int e = (i >> 1) * 512 + F.lane * 8 + (i & 1) * 4; lg[i] = *(const f32x4*)(F.ln1_g + e); lb[i] = *(const f32x4*)(F.ln1_b + e); }
    const int stride = F.G * 8;
    f32x4 vn[4], scn[4], shn[4];
    {
        const int m = F.bid * 8 + F.wave; const float* mr = F.MOD + (size_t)mod_row(m < NT ? m : 0) * 6144;
#pragma unroll
        for (int i = 0; i < 4; ++i) { const int e = (i >> 1) * 512 + F.lane * 8 + (i & 1) * 4; vn[i] = *(const f32x4*)(F.T1 + (size_t)(m < NT ? m : 0) * D + e); scn[i] = *(const f32x4*)(mr + 4096 + e); shn[i] = *(const f32x4*)(mr + 3072 + e); }
    }
    for (int m = F.bid * 8 + F.wave; m < NT; m += stride) {
        float* tr = F.T1 + (size_t)m * D;
        f32x4 v[4], sc2[4], sh2[4]; float s = 0.f;
#pragma unroll
        for (int i = 0; i < 4; ++i) { v[i] = vn[i]; sc2[i] = scn[i]; sh2[i] = shn[i]; s += v[i][0] + v[i][1] + v[i][2] + v[i][3]; }
        {
            const int mn = (m + stride < NT) ? m + stride : m; const float* mrn = F.MOD + (size_t)mod_row(mn) * 6144;
#pragma unroll
            for (int i = 0; i < 4; ++i) { const int e = (i >> 1) * 512 + F.lane * 8 + (i & 1) * 4; vn[i] = *(const f32x4*)(F.T1 + (size_t)mn * D + e); scn[i] = *(const f32x4*)(mrn + 4096 + e); shn[i] = *(const f32x4*)(mrn + 3072 + e); }
        }
        const float mean = wave_sum(s) * (1.f / D);
        float q = 0.f;
#pragma unroll
        for (int i = 0; i < 4; ++i) { v[i] = v[i] - mean; q += v[i][0] * v[i][0] + v[i][1] * v[i][1] + v[i][2] * v[i][2] + v[i][3] * v[i][3]; }
        const float rstd = rsqrtf(wave_sum(q) * (1.f / D) + LN_EPS);
        f32x4 hv[2][2];
#pragma unroll
        for (int hlf = 0; hlf < 2; ++hlf) {
            const int e = hlf * 512 + F.lane * 8;
            f32x4 a = v[2 * hlf] * rstd * lg[2 * hlf] + lb[2 * hlf];
            f32x4 b = v[2 * hlf + 1] * rstd * lg[2 * hlf + 1] + lb[2 * hlf + 1];
            *(f32x4*)(tr + e) = a; *(f32x4*)(tr + e + 4) = b;
            const f32x4 ha = a * (sc2[2 * hlf] + 1.f) + sh2[2 * hlf];
            const f32x4 hb = b * (sc2[2 * hlf + 1] + 1.f) + sh2[2 * hlf + 1];
            *(u32x4*)(F.H2 + (size_t)m * D + e) = (u32x4){cvt_pk_bf16(ha[0], ha[1]), cvt_pk_bf16(ha[2], ha[3]), cvt_pk_bf16(hb[0], hb[1]), cvt_pk_bf16(hb[2], hb[3])};
            hv[hlf][0] = ha; hv[hlf][1] = hb;
        }
        float am = 0.f;
#pragma unroll
        for (int i = 0; i < 2; ++i)
#pragma unroll
            for (int j = 0; j < 2; ++j)
#pragma unroll
                for (int e = 0; e < 4; ++e) am = fmaxf(am, fabsf(hv[i][j][e]));
        am = wave_max(am);
        const float sc = am > 0.f ? 224.f / am : 1.f;
#pragma unroll
        for (int hlf = 0; hlf < 2; ++hlf) {
            int w0 = 0, w1 = 0;
            w0 = __builtin_amdgcn_cvt_pk_fp8_f32(hv[hlf][0][0] * sc, hv[hlf][0][1] * sc, w0, false); w0 = __builtin_amdgcn_cvt_pk_fp8_f32(hv[hlf][0][2] * sc, hv[hlf][0][3] * sc, w0, true);
            w1 = __builtin_amdgcn_cvt_pk_fp8_f32(hv[hlf][1][0] * sc, hv[hlf][1][1] * sc, w1, false); w1 = __builtin_amdgcn_cvt_pk_fp8_f32(hv[hlf][1][2] * sc, hv[hlf][1][3] * sc, w1, true);
            *(u32x2*)(F.ws + WS_H8 + (size_t)m * D + hlf * 512 + F.lane * 8) = (u32x2){(unsigned)w0, (unsigned)w1};
        }
        if (F.lane == 0) ((float*)(F.ws + WS_SH))[m] = am > 0.f ? am * (1.f / 224.f) : 1.f;
    }
}
struct P8Body {
    const Frame* Fp;
    __device__ __forceinline__ void operator()(int m, int n, const f32x4 v) const { *(u32x2*)(Fp->QP + (size_t)m * D + n) = pk4(v); }
};
__device__ __forceinline__ void p8_gemm_q(const Frame& F) {
    {
        pg8::Gemm g{F.H2, F.WQ, NTP, D, D}; pg8::StaticOrder S; S.init(NTP, D, F.G, F.bid);
        pg8::EpiRC<P8Body> E{P8Body{&F}}; pg8::gemm_phase<pg8::EpiRC<P8Body>, pg8::StaticOrder, true, true>(F.lds, g, S, E);
    }
    for (int sl = F.bid; sl < NTS / 8 * (D / BN); sl += F.G) {
        const int m0 = NTP + (sl >> 3) * 8, n0 = (sl & 7) * BN;
        f32x16 s1[1][1];
        gemm_slice8(F, s1, F.H2, D, F.WQ, D, D, m0, n0);
        SLICE_EPI_LOOP({ *(u32x2*)(F.QP + (size_t)m * D + n) = pk4(ACC4(s1)); })
    }
}
__device__ __forceinline__ void p9_row_top16(LAS float* row, LAS float* TV, LAS unsigned char* TI, int slot) {
    float gm[16];
#pragma unroll
    for (int gidx = 0; gidx < 16; ++gidx) {
        float m = row[gidx * 8];
#pragma unroll
        for (int k = 1; k < 8; ++k) m = fmaxf(m, row[gidx * 8 + k]);
        gm[gidx] = m;
    }
#pragma unroll 1
    for (int p = 0; p < 16; ++p) {
        float best = gm[0]; int bg = 0;
#pragma unroll
        for (int gidx = 1; gidx < 16; ++gidx) { const bool gt = gm[gidx] > best; best = gt ? gm[gidx] : best; bg = gt ? gidx : bg; }
        float v[8];
#pragma unroll
        for (int k = 0; k < 8; ++k) v[k] = row[bg * 8 + k];
        int bk = 7;
#pragma unroll
        for (int k = 6; k >= 0; --k) bk = (v[k] == best) ? k : bk;
        float nm = -INFINITY;
#pragma unroll
        for (int k = 0; k < 8; ++k) nm = fmaxf(nm, (k == bk) ? -INFINITY : v[k]);
        row[bg * 8 + bk] = -INFINITY;
#pragma unroll
        for (int gidx = 0; gidx < 16; ++gidx) gm[gidx] = (gidx == bg) ? nm : gm[gidx];
        TV[slot * 17 + p] = best; TI[slot * 17 + p] = (unsigned char)(bg * 8 + bk);
    }
}
__device__ __forceinline__ void p9_pair_top16(const Frame& F, LAS const float* TV, LAS const unsigned char* TI, int r1, int r2, int tok, int head) {
    float c[16];
    { const float v20 = TV[r2];
#pragma unroll
      for (int i = 0; i < 16; ++i) c[i] = TV[r1 + i] + v20; }
    unsigned long long ptrs = 0ull;
    float sv[16]; int se[16];
#pragma unroll
    for (int p = 0; p < 16; ++p) {
        float best = c[0]; int bi = 0;
#pragma unroll
        for (int i = 1; i < 16; ++i) { const bool gt = c[i] > best; best = gt ? c[i] : best; bi = gt ? i : bi; }
        const int bj = (int)((ptrs >> (4 * bi)) & 15ull);
        sv[p] = best; se[p] = (int)TI[r1 + bi] * 128 + (int)TI[r2 + bj];
        const float nv = (bj < 15) ? TV[r1 + bi] + TV[r2 + bj + 1] : -INFINITY;
        ptrs += (bj < 15) ? (1ull << (4 * bi)) : 0ull;
#pragma unroll
        for (int i = 0; i < 16; ++i) c[i] = (i == bi) ? nv : c[i];
    }
    const float mx0 = sv[0]; float den = 0.f;
#pragma unroll
    for (int p = 0; p < 16; ++p) { sv[p] = __expf(sv[p] - mx0); den += sv[p]; }
    const float dinv = 1.f / den;
    int* eo = F.EIDX + (size_t)tok * NEXP_SEL + head * 16; float* go = F.GW + (size_t)tok * NEXP_SEL + head * 16;
#pragma unroll
    for (int p = 0; p < 16; ++p) { eo[p] = se[p]; go[p] = sv[p] * dinv; }
}
constexpr int PR_ROW = 129, PR_ROWS = 256 + 4;
__device__ __forceinline__ void p9_route(const Frame& F) {
    LAS float* SC = (LAS float*)F.lds;
    LAS float* TV = (LAS float*)(F.lds + PR_ROWS * PR_ROW * 4);
    LAS unsigned char* TI = (LAS unsigned char*)(F.lds + PR_ROWS * PR_ROW * 4 + PR_ROWS * 17 * 4);
    const int lane = F.lane, r = lane & 31, h = lane >> 5;
    const int nunits = (NTP / 32) * 2;
    int k = 0;
    for (int it = F.bid; it < nunits; it += F.G, ++k) {
        const int tok0 = (it >> 1) * 32, hg = it & 1;
        const int ts = NTP + F.bid + F.G * (k >> 2), kh = k & 3;
        const bool has_s = ts < NT;
        __syncthreads();
        {
            const int head = hg * 4 + (F.wave >> 1), half = F.wave & 1;
            const bf16_t* KK = half ? F.K2 : F.K1;
            bf16x8 Bq[4], Bs[4];
#pragma unroll
            for (int s = 0; s < 4; ++s) Bq[s] = *(const bf16x8*)(F.QP + (size_t)(tok0 + r) * D + head * 128 + half * 64 + s * 16 + h * 8);
            const bool swave = has_s && F.wave < 4;
            if (swave) {
#pragma unroll
                for (int s = 0; s < 4; ++s) Bs[s] = *(const bf16x8*)(F.QP + (size_t)ts * D + (2 * kh + (F.wave >> 1)) * 128 + half * 64 + s * 16 + h * 8);
            }
#pragma unroll
            for (int kt = 0; kt < 4; ++kt) {
                f32x16 c, cs;
#pragma unroll
                for (int e = 0; e < 16; ++e) { c[e] = 0.f; cs[e] = 0.f; }
#pragma unroll
                for (int s = 0; s < 4; ++s) {
                    const bf16x8 Ak = *(const bf16x8*)(KK + (size_t)(kt * 32 + r) * 64 + s * 16 + h * 8);
                    c = __builtin_amdgcn_mfma_f32_32x32x16_bf16(Ak, Bq[s], c, 0, 0, 0);
                    if (swave) cs = __builtin_amdgcn_mfma_f32_32x32x16_bf16(Ak, Bs[s], cs, 0, 0, 0);
                }
#pragma unroll
                for (int e = 0; e < 16; ++e) { const int key = kt * 32 + (e & 3) + 8 * (e >> 2) + 4 * h; SC[(r * 8 + F.wave) * PR_ROW + key] = c[e]; }
                if (swave && r == 0) {
#pragma unroll
                    for (int e = 0; e < 16; ++e) { const int key = kt * 32 + (e & 3) + 8 * (e >> 2) + 4 * h; SC[(256 + F.wave) * PR_ROW + key] = cs[e]; }
                }
            }
        }
        __syncthreads();
        if (F.tid < 256 || (has_s && F.tid < 260)) p9_row_top16(SC + F.tid * PR_ROW, TV, TI, F.tid);
        __syncthreads();
        if (F.tid < 128) {
            const int tk = F.tid >> 2, hs = F.tid & 3;
            const int r1 = (tk * 8 + hs * 2) * 17;
            p9_pair_top16(F, TV, TI, r1, r1 + 17, tok0 + tk, hg * 4 + hs);
        } else if (has_s && F.tid < 130) {
            const int hs = F.tid - 128;
            const int r1 = (256 + hs * 2) * 17;
            p9_pair_top16(F, TV, TI, r1, r1 + 17, ts, 2 * kh + hs);
        }
    }
}

constexpr int TPW = 65, PAIRS_MAX = 9 * 128, PK = 4;
constexpr int P10_HROW = 1024 + 64;
constexpr int P10_H = 0;
constexpr int P10_SH = 32 * P10_HROW;
constexpr int P10_HIST = P10_SH + 128;
constexpr int P10_LIST = P10_HIST + 8 * 128 * 4;
typedef int i32x8 __attribute__((ext_vector_type(8)));
typedef __bf16 bf16x2v __attribute__((ext_vector_type(2)));
typedef short s16x4 __attribute__((ext_vector_type(4)));
__device__ __forceinline__ unsigned bf2u(bf16x2v v) { unsigned r; __builtin_memcpy(&r, &v, 4); return r; }
__device__ __forceinline__ void p10_peer(const Frame& F) {
    const int lane = F.lane, w = F.wave;
    unsigned char* ws = F.ws;
    const unsigned char* PU8 = ws + WS_PU8; const unsigned char* PV8 = ws + WS_PV8;
    const float* SU = (const float*)(ws + WS_SU); const float* SV = (const float*)(ws + WS_SV);
    const unsigned char* H8 = ws + WS_H8; const float* SH = (const float*)(ws + WS_SH);
  for (int blk = F.bid; blk < NT / TPW; blk += F.G) {
    const int tok0 = blk * TPW;
    LAS float* SHl = (LAS float*)(F.lds + P10_SH);
    LAS unsigned* SE = (LAS unsigned*)(F.lds + P10_LIST) + w * 1024; LAS float* SG = (LAS float*)(SE + 512);
    const int ntok = (w == 0) ? 9 : 8;
    const int r16 = lane & 15, q4 = lane >> 4;
#pragma unroll 1
    for (int pass = 0; pass < 3; ++pass) {
        const int kbase = pass * PK, nk = (ntok - kbase < PK) ? (ntok - kbase > 0 ? ntok - kbase : 0) : PK, npairs = nk * 128;
        __syncthreads();
        for (int c = F.tid; c < 32 * 64; c += NTHREADS) {
            const int row = c >> 6, tl = 32 * pass + row;
            if (tl < TPW) *(LAS u32x4*)(F.lds + P10_H + row * P10_HROW + (c & 63) * 16) = *(const u32x4*)(H8 + (size_t)(tok0 + tl) * D + (size_t)(c & 63) * 16);
        }
        if (F.tid < 32 && 32 * pass + F.tid < TPW) SHl[F.tid] = SH[tok0 + 32 * pass + F.tid];
        __syncthreads();
        if (nk <= 0) continue;
#pragma unroll
        for (int i = 0; i < 8; ++i) {
            const int p = lane + 64 * i;
            if (p < npairs) {
                const size_t gi_ = (size_t)(tok0 + w + 8 * (kbase + (p >> 7))) * NEXP_SEL + (p & 127);
                SE[p] = (unsigned)F.EIDX[gi_]; SG[p] = F.GW[gi_];
            }
        }
        asm volatile("s_waitcnt vmcnt(0) lgkmcnt(0)" ::: "memory");
        __builtin_amdgcn_wave_barrier();
        f32x4 acc[4][4];
#pragma unroll
        for (int k = 0; k < 4; ++k)
#pragma unroll
            for (int q = 0; q < 4; ++q) acc[k][q] = (f32x4){0.f, 0.f, 0.f, 0.f};
        const int ngr = npairs >> 4;
        const unsigned char* up = PU8 + q4 * 16;
        const int voff = lane * 8;
        const unsigned am0 = (lane & 3) == 0 ? 0x0000ffffu : ((lane & 3) == 1 ? 0xffff0000u : 0u);
        const unsigned am1 = (lane & 3) == 2 ? 0x0000ffffu : ((lane & 3) == 3 ? 0xffff0000u : 0u);
        u32x4 U[8]; u32x2 V[16]; float suv = 0.f, svv = 0.f;
#pragma unroll
        for (int t = 0; t < 8; ++t) U[t] = (u32x4){0u, 0u, 0u, 0u};
#pragma unroll
        for (int k = 0; k < 16; ++k) V[k] = (u32x2){0u, 0u};
#define P10_LOAD_U(WR) { const int er_ = (WR) & 16383; const unsigned char* ua_ = up + (size_t)er_ * 512; const float* sa_ = SU + er_; const float* sb_ = SV + er_; \
            asm volatile("global_load_dwordx4 %0, %1, off" : "+v"(U[0]) : "v"(ua_)); \
            asm volatile("global_load_dwordx4 %0, %1, off offset:64" : "+v"(U[1]) : "v"(ua_)); \
            asm volatile("global_load_dwordx4 %0, %1, off offset:128" : "+v"(U[2]) : "v"(ua_)); \
            asm volatile("global_load_dwordx4 %0, %1, off offset:192" : "+v"(U[3]) : "v"(ua_)); \
            asm volatile("global_load_dwordx4 %0, %1, off offset:256" : "+v"(U[4]) : "v"(ua_)); \
            asm volatile("global_load_dwordx4 %0, %1, off offset:320" : "+v"(U[5]) : "v"(ua_)); \
            asm volatile("global_load_dwordx4 %0, %1, off offset:384" : "+v"(U[6]) : "v"(ua_)); \
            asm volatile("global_load_dwordx4 %0, %1, off offset:448" : "+v"(U[7]) : "v"(ua_)); \
            asm volatile("global_load_dword %0, %1, off" : "+v"(suv) : "v"(sa_)); \
            asm volatile("global_load_dword %0, %1, off" : "+v"(svv) : "v"(sb_)); }
#define P10_LOAD_V(K, WR) { const unsigned char* ra_ = PV8 + (size_t)(__builtin_amdgcn_readlane((WR), (K)) & 16383) * 512; \
            asm volatile("global_load_dwordx2 %0, %1, %2" : "+v"(V[K]) : "v"(voff), "s"(ra_)); }
        int wr = (int)SE[r16]; float gr = SG[r16];
        P10_LOAD_U(wr)
        P10_LOAD_V(0, wr) P10_LOAD_V(1, wr) P10_LOAD_V(2, wr) P10_LOAD_V(3, wr) P10_LOAD_V(4, wr) P10_LOAD_V(5, wr) P10_LOAD_V(6, wr) P10_LOAD_V(7, wr)
        P10_LOAD_V(8, wr) P10_LOAD_V(9, wr) P10_LOAD_V(10, wr) P10_LOAD_V(11, wr) P10_LOAD_V(12, wr) P10_LOAD_V(13, wr) P10_LOAD_V(14, wr) P10_LOAD_V(15, wr)
#define P10_VQ(Q) { const unsigned b0_ = bf2u(__builtin_amdgcn_cvt_scalef32_pk_bf16_fp4(vv[(Q) >> 1], 1.0f, 2 * ((Q) & 1))); \
                    const unsigned b1_ = bf2u(__builtin_amdgcn_cvt_scalef32_pk_bf16_fp4(vv[(Q) >> 1], 1.0f, 2 * ((Q) & 1) + 1)); \
                    const u32x2 bb_ = {b0_, b1_}; s16x4 Bop_; __builtin_memcpy(&Bop_, &bb_, 8); \
                    acc[slot][Q] = __builtin_amdgcn_mfma_f32_4x4x4bf16_1k(Aop, Bop_, acc[slot][Q], 0, 0, 0); }
#define P10_VPAIR(K) { const float actk = __int_as_float(__builtin_amdgcn_readlane(actv, 16 * ((K) >> 2) + (K))); \
                       const unsigned wb_ = cvt_pk_bf16(actk, actk); \
                       const u32x2 ab_ = {wb_ & am0, wb_ & am1}; s16x4 Aop; __builtin_memcpy(&Aop, &ab_, 8); \
                       asm volatile("s_waitcnt vmcnt(25)" : "+v"(V[K])); \
                       const u32x2 vv = V[K]; \
                       P10_VQ(0) P10_VQ(1) P10_VQ(2) P10_VQ(3) \
                       P10_LOAD_V(K, wrn) }
#pragma unroll
        for (int slot = 0; slot < 4; ++slot) {
            if (slot >= nk) continue;
            LAS const unsigned char* hr0 = F.lds + P10_H + (w + 8 * slot) * P10_HROW + q4 * 16;
            const float shv = SHl[w + 8 * slot];
#pragma unroll 1
            for (int g8 = 0; g8 < 8; ++g8) {
                const int gi = slot * 8 + g8;
                const int gn = (gi + 1 < ngr) ? gi + 1 : 0;
                const int wrn = (int)SE[gn * 16 + r16]; const float grn = SG[gn * 16 + r16];
                LAS const unsigned char* hr = hr0;
                asm volatile("" : "+v"(hr));
                asm volatile("s_waitcnt vmcnt(16)" : "+v"(U[0]), "+v"(U[1]), "+v"(U[2]), "+v"(U[3]), "+v"(U[4]), "+v"(U[5]), "+v"(U[6]), "+v"(U[7]), "+v"(suv), "+v"(svv));
                f32x4 C0 = {0.f, 0.f, 0.f, 0.f}, C1 = {0.f, 0.f, 0.f, 0.f};
#pragma unroll
                for (int t = 0; t < 8; ++t) {
                    const u32x4 h0 = *(LAS const u32x4*)(hr + t * 128), h1 = *(LAS const u32x4*)(hr + t * 128 + 64);
                    const i32x8 Aop = {(int)h0[0], (int)h0[1], (int)h0[2], (int)h0[3], (int)h1[0], (int)h1[1], (int)h1[2], (int)h1[3]};
                    const i32x8 Bop = {(int)U[t][0], (int)U[t][1], (int)U[t][2], (int)U[t][3], 0, 0, 0, 0};
                    if (t & 1) C1 = __builtin_amdgcn_mfma_scale_f32_16x16x128_f8f6f4(Aop, Bop, C1, 0, 4, 0, 0x7f7f7f7f, 0, 0x7f7f7f7f);
                    else       C0 = __builtin_amdgcn_mfma_scale_f32_16x16x128_f8f6f4(Aop, Bop, C0, 0, 4, 0, 0x7f7f7f7f, 0, 0x7f7f7f7f);
                }
                C0 = C0 + C1;
                const int rsel = lane & 3;
                const float dv = (rsel == 0 ? C0[0] : (rsel == 1 ? C0[1] : (rsel == 2 ? C0[2] : C0[3]))) * (suv * shv);
                const int actv = __float_as_int(gelu_tanh(dv) * (gr * svv));
                P10_LOAD_U(wrn)
                P10_VPAIR(0) P10_VPAIR(1) P10_VPAIR(2) P10_VPAIR(3) P10_VPAIR(4) P10_VPAIR(5) P10_VPAIR(6) P10_VPAIR(7)
                P10_VPAIR(8) P10_VPAIR(9) P10_VPAIR(10) P10_VPAIR(11) P10_VPAIR(12) P10_VPAIR(13) P10_VPAIR(14) P10_VPAIR(15)
                wr = wrn; gr = grn;
            }
        }
#undef P10_VPAIR
#undef P10_VQ
        asm volatile("s_waitcnt vmcnt(0)" : "+v"(U[0]), "+v"(U[1]), "+v"(U[2]), "+v"(U[3]), "+v"(U[4]), "+v"(U[5]), "+v"(U[6]), "+v"(U[7]), "+v"(suv), "+v"(svv),
                     "+v"(V[0]), "+v"(V[1]), "+v"(V[2]), "+v"(V[3]), "+v"(V[4]), "+v"(V[5]), "+v"(V[6]), "+v"(V[7]),
                     "+v"(V[8]), "+v"(V[9]), "+v"(V[10]), "+v"(V[11]), "+v"(V[12]), "+v"(V[13]), "+v"(V[14]), "+v"(V[15]));
#undef P10_LOAD_U
#undef P10_LOAD_V
        float x1v[PK][16];
#pragma unroll
        for (int k = 0; k < PK; ++k) {
            const int m = tok0 + w + 8 * (kbase + (k < nk ? k : 0));
#pragma unroll
            for (int c = 0; c < 16; ++c) x1v[k][c] = F.T1[(size_t)m * D + c * 64 + lane];
        }
#pragma unroll
        for (int k = 0; k < PK; ++k) {
            if (k >= nk) continue;
            const int m = tok0 + w + 8 * (kbase + k);
            const float* mr = F.MOD + (size_t)mod_row(m) * 6144 + 5120;
            float tv[16]; float s = 0.f;
#pragma unroll
            for (int c = 0; c < 16; ++c) { const float t = x1v[k][c] * DN_ALPHA + mr[c * 64 + lane] * acc[k][c >> 2][c & 3]; tv[c] = t; s += t; }
            const float mean = wave_sum(s) * (1.f / D);
            float q = 0.f;
#pragma unroll
            for (int c = 0; c < 16; ++c) { tv[c] -= mean; q += tv[c] * tv[c]; }
            const float rstd = rsqrtf(wave_sum(q) * (1.f / D) + LN_EPS);
            float* yo = (m < NTP) ? F.out + O_YP + (size_t)m * D : F.out + O_YS + (size_t)(m - NTP) * D;
#pragma unroll
            for (int c = 0; c < 16; ++c) yo[c * 64 + lane] = tv[c] * rstd * F.ln2_g[c * 64 + lane] + F.ln2_b[c * 64 + lane];
        }
    }
  }
}

constexpr int N_PHASES = 11;
__global__ void __launch_bounds__(NTHREADS, 2) fwd_kernel(Args args) {
    extern __shared__ __attribute__((aligned(16))) unsigned char lds_raw[];
    Frame F;
    F.lds = (LAS unsigned char*)lds_raw;
    F.tid = threadIdx.x; F.lane = F.tid & 63; F.wave = __builtin_amdgcn_readfirstlane(F.tid >> 6); F.G = gridDim.x; F.bid = blockIdx.x;
    F.x_p = (const float*)args.in[0]; F.x_s = (const float*)args.in[1]; F.c_p = (const float*)args.in[2]; F.c_s = (const float*)args.in[3];
    F.cache_k = (const float*)args.in[4]; F.cache_v = (const float*)args.in[5]; F.cache_ki = (const float*)args.in[6]; F.state_conv = (const float*)args.in[7];
    F.page_table = (const int*)args.in[8]; F.rel_bias = (const float*)args.in[9]; F.w_ada = (const float*)args.in[10]; F.b_ada = (const float*)args.in[11];
    F.w_in = (const float*)args.in[12]; F.conv_w = (const float*)args.in[13]; F.conv_b = (const float*)args.in[14]; F.w_o_attn = (const float*)args.in[15];
    F.w_o_conv = (const float*)args.in[16]; F.w_out = (const float*)args.in[17]; F.ln1_g = (const float*)args.in[18]; F.ln1_b = (const float*)args.in[19];
    F.ln2_g = (const float*)args.in[20]; F.ln2_b = (const float*)args.in[21]; F.peer_wq = (const float*)args.in[22]; F.peer_k1 = (const float*)args.in[23];
    F.peer_k2 = (const float*)args.in[24]; F.peer_u = (const float*)args.in[25]; F.peer_v = (const float*)args.in[26];
    F.out = args.out;
    unsigned char* ws = args.ws; F.ws = ws;
    F.MOD = (float*)(ws + WS_MOD); F.WIN = (bf16_t*)(ws + WS_WIN); F.WOA = (bf16_t*)(ws + WS_WOA); F.WOC = (bf16_t*)(ws + WS_WOC);
    F.WOUT = (bf16_t*)(ws + WS_WOUT); F.WQ = (bf16_t*)(ws + WS_WQ); F.K1 = (bf16_t*)(ws + WS_K1); F.K2 = (bf16_t*)(ws + WS_K2);
    F.PU = (bf16_t*)(ws + WS_PU); F.PV = (bf16_t*)(ws + WS_PV); F.H1 = (bf16_t*)(ws + WS_H1); F.PROJ = (bf16_t*)(ws + WS_PROJ);
    F.WI = (float*)(ws + WS_WI); F.SEL = (int*)(ws + WS_SEL); F.OATT = (bf16_t*)(ws + WS_OATT); F.OCONV = (bf16_t*)(ws + WS_OCONV);
    F.MERGED = (bf16_t*)(ws + WS_MERGED); F.T1 = (float*)(ws + WS_T1); F.H2 = (bf16_t*)(ws + WS_H2); F.QP = (bf16_t*)(ws + WS_QP);
    F.EIDX = (int*)(ws + WS_EIDX); F.GW = (float*)(ws + WS_GW);
    volatile LAS unsigned* misc = (volatile LAS unsigned*)(F.lds + LDS_MISC);
    if (F.tid < 16) misc[F.tid] = 0u;
    __syncthreads();
    XcdBarrier bar; bar.bar = (unsigned*)(ws + WS_CTL); bar.x = 0; bar.st = misc;
    const int lo = args.ph_lo, hi = args.ph_hi;
    if (hi - lo > 1) bar = xcd_barrier_post((unsigned*)(ws + WS_CTL), misc);
#define IN(k) (lo <= (k) && (k) < hi)
#define SEAM(k) do { if (IN(k) && IN((k) + 1)) xcd_barrier(bar); } while (0)
    if (IN(0)) p0_prologue(F);       SEAM(0);
    if (IN(1)) p1_modulate(F);       SEAM(1);
    if (IN(2)) p2_gemm_in(F);        SEAM(2);
    if (IN(3)) p3_index(F);          SEAM(3);
    if (IN(4)) p4_attention(F);      SEAM(4);
    if (IN(5)) p5_gemm_merge(F);     SEAM(5);
    if (IN(6)) p6_gemm_out(F);       SEAM(6);
    if (IN(7)) p7_ln1(F);            SEAM(7);
    if (IN(8)) p8_gemm_q(F);         SEAM(8);
    if (IN(9)) p9_route(F);          SEAM(9);
    if (IN(10)) p10_peer(F);
#undef IN
#undef SEAM
}

extern "C" void kernel_launch(void* const* d_in, const int* in_sizes, int n_in, void* d_out, int out_size, void* d_ws, size_t ws_size, hipStream_t stream) {
    static int grid = 0;
    if (grid == 0) {
        if (n_in != 27 || (size_t)out_size != O_END || ws_size < WS_END) { fprintf(stderr, "kernel_launch: unexpected shapes (n_in %d out %d ws %zu)\n", n_in, out_size, ws_size); grid = -1; return; }
        int dev = 0, cus = 0;
        if (hipGetDevice(&dev) != hipSuccess || hipDeviceGetAttribute(&cus, hipDeviceAttributeMultiprocessorCount, dev) != hipSuccess) { grid = -1; return; }
        if (hipFuncSetAttribute((const void*)fwd_kernel, hipFuncAttributeMaxDynamicSharedMemorySize, LDS_BYTES) != hipSuccess) { fprintf(stderr, "kernel_launch: hipFuncSetAttribute failed\n"); grid = -1; return; }
        (void)hipGetLastError();
        grid = cus < 256 ? cus : 256;
    }
    if (grid < 0) return;
    (void)hipMemsetAsync((char*)d_ws + WS_CTL, 0, CTL_ZERO_BYTES, stream);
    Args a{};
    for (int i = 0; i < 27; ++i) a.in[i] = d_in[i];
    a.out = (float*)d_out; a.ws = (unsigned char*)d_ws;
#if N_LAUNCHES == 1
    a.ph_lo = 0; a.ph_hi = N_PHASES;
    hipLaunchKernelGGL(fwd_kernel, dim3(grid), dim3(NTHREADS), LDS_BYTES, stream, a);
#else
    for (int p = 0; p < N_PHASES; ++p) { a.ph_lo = p; a.ph_hi = p + 1; hipLaunchKernelGGL(fwd_kernel, dim3(grid), dim3(NTHREADS), LDS_BYTES, stream, a); }
#endif
}
```

```cpp
#include <hip/hip_runtime.h>
#include <cstdio>
#include <cstdint>

#ifndef N_LAUNCHES
#define N_LAUNCHES 1
#endif

typedef unsigned short bf16_t;
typedef short bf16x8 __attribute__((ext_vector_type(8)));
typedef float f32x4 __attribute__((ext_vector_type(4)));
typedef float f32x16 __attribute__((ext_vector_type(16)));
typedef unsigned u32x4 __attribute__((ext_vector_type(4)));
typedef unsigned u32x2 __attribute__((ext_vector_type(2)));
#define LAS __attribute__((address_space(3)))

constexpr int D = 1024, NB_P = 8, SEQ = 2048, NB_S = 32, TS = 8, PAST = 8192, PAGE = 128, NPAGES = 64;
constexpr int NTP = NB_P * SEQ;
constexpr int NTS = NB_S * TS;
constexpr int NT = NTP + NTS;
constexpr int NMIX = 4676, NMIXP = 4736;
constexpr int C_Q = 0, C_K = 512, C_V = 640, C_QI = 768, C_KI = 1024, C_BG = 1088, C_CG = 1600, C_XIN = 2112, C_GA = 2624, C_GB = 3648, C_WI = 4672;
constexpr int NSEL = 256;
constexpr float ATTN_SCALE = 0.125f, IDX_SCALE = 0.0625f;
constexpr float DN_ALPHA = 1.189207115002721f, LN_EPS = 1e-5f;
constexpr int NEXP_SEL = 128;

constexpr size_t O_YP = 0, O_YS = 16777216, O_KP = 17039360, O_VP = 19136512, O_KIP = 21233664, O_CP = 22282240,
                 O_KS = 22290432, O_VS = 22323200, O_KIS = 22355968, O_CS = 22372352, O_END = 22405120;

constexpr size_t MB = 1048576;
constexpr size_t WS_CTL = 0, WS_MOD = 1 * MB, WS_WIN = 2 * MB, WS_WOA = 12 * MB, WS_WOC = 13 * MB, WS_WOUT = 14 * MB, WS_WQ = 16 * MB,
                 WS_K1 = 18 * MB, WS_K2 = 18 * MB + 65536, WS_PU = 20 * MB, WS_PV = 52 * MB, WS_H1 = 84 * MB, WS_PROJ = 118 * MB,
                 WS_WI = 270 * MB, WS_SEL = 271 * MB, WS_OATT = 288 * MB, WS_OCONV = 305 * MB, WS_MERGED = 322 * MB, WS_T1 = 355 * MB,
                 WS_H2 = 420 * MB, WS_QP = 453 * MB, WS_EIDX = 486 * MB, WS_GW = 495 * MB, WS_SS = 504 * MB, WS_SE = 513 * MB, WS_SG = 523 * MB, WS_VT = 533 * MB, WS_CGX = 538 * MB, WS_END = 539 * MB;
constexpr size_t WS_PU8 = WS_PU, WS_PV8 = WS_PU + 16 * MB, WS_SU = WS_PV, WS_SV = WS_PV + 65536, WS_H8 = WS_PV + 1 * MB, WS_SH = WS_PV + 20 * MB;
constexpr int CTL_ZERO_BYTES = 65536;

constexpr int NTHREADS = 512;
constexpr int LDS_BYTES = 160 * 1024 - 512;
constexpr int LDS_MISC = LDS_BYTES - 64;

__device__ __forceinline__ float bf2f(bf16_t b) { return __uint_as_float(((unsigned)b) << 16); }
__device__ __forceinline__ float bflo(unsigned p) { return __uint_as_float(p << 16); }
__device__ __forceinline__ float bfhi(unsigned p) { return __uint_as_float(p & 0xFFFF0000u); }
typedef __bf16 bf16x2_t __attribute__((ext_vector_type(2)));
typedef float f32x2_t __attribute__((ext_vector_type(2)));
__device__ __forceinline__ unsigned cvt_pk_bf16(float lo, float hi) { const f32x2_t f = {lo, hi}; const bf16x2_t b = __builtin_convertvector(f, bf16x2_t); unsigned r; __builtin_memcpy(&r, &b, 4); return r; }
__device__ __forceinline__ bf16_t f2bf(float f) { return (bf16_t)(cvt_pk_bf16(f, 0.f) & 0xFFFFu); }
__device__ __forceinline__ float wave_sum(float v) {
#pragma unroll
    for (int o = 32; o >= 1; o >>= 1) v += __shfl_xor(v, o);
    return v;
}
__device__ __forceinline__ float wave_sum_dpp(float v) {
    int x;
    x = __builtin_amdgcn_update_dpp(0, __float_as_int(v), 0xB1, 0xF, 0xF, false);  v += __int_as_float(x);
    x = __builtin_amdgcn_update_dpp(0, __float_as_int(v), 0x4E, 0xF, 0xF, false);  v += __int_as_float(x);
    x = __builtin_amdgcn_update_dpp(0, __float_as_int(v), 0x141, 0xF, 0xF, false); v += __int_as_float(x);
    x = __builtin_amdgcn_update_dpp(0, __float_as_int(v), 0x140, 0xF, 0xF, false); v += __int_as_float(x);
    x = __builtin_amdgcn_update_dpp(0, __float_as_int(v), 0x142, 0xA, 0xF, false); v += __int_as_float(x);
    x = __builtin_amdgcn_update_dpp(0, __float_as_int(v), 0x143, 0xC, 0xF, false); v += __int_as_float(x);
    return __int_as_float(__builtin_amdgcn_readlane(__float_as_int(v), 63));
}
__device__ __forceinline__ float wave_max(float v) {
#pragma unroll
    for (int o = 32; o >= 1; o >>= 1) v = fmaxf(v, __shfl_xor(v, o));
    return v;
}
__device__ __forceinline__ float sigmoidf_(float x) { return 1.f / (1.f + __expf(-x)); }
__device__ __forceinline__ float gelu_tanh(float a) {
    const float z = 0.7978845608028654f * (a + 0.044715f * a * a * a);
    const float e = __expf(2.f * z);
    const float t = 1.f - 2.f * __builtin_amdgcn_rcpf(e + 1.f);
    return 0.5f * a * (1.f + t);
}
__device__ __forceinline__ unsigned f2ord(float f) { const unsigned u = __float_as_uint(f); return (u & 0x80000000u) ? ~u : (u | 0x80000000u); }
__device__ __forceinline__ int t5_bucket(int n) {
    if (n < 16) return n;
    int b = 16;
    b += (n >= 19) + (n >= 21) + (n >= 24) + (n >= 27) + (n >= 31) + (n >= 35) + (n >= 40) + (n >= 46) + (n >= 52) + (n >= 59) + (n >= 67) + (n >= 77) + (n >= 87) + (n >= 99) + (n >= 113);
    return b;
}

#define XB_TMO      128
#define XB_XCNT(j)  (256  + 64 * (j))
#define XB_XSUB(j)  (1280 + 64 * (j))
#define XB_XGEN(j)  (2304 + 64 * (j))
#define XB_TOP      3328
#define XB_TOPGEN   3392
#define XCD_BAR_WORDS 3456
#define XB_SPIN_CAP (1u << 18)
__device__ __forceinline__ unsigned xb_ld(unsigned* p)              { return __hip_atomic_load(p, __ATOMIC_RELAXED, __HIP_MEMORY_SCOPE_AGENT); }
__device__ __forceinline__ unsigned xb_add(unsigned* p, unsigned v) { return __hip_atomic_fetch_add(p, v, __ATOMIC_RELAXED, __HIP_MEMORY_SCOPE_AGENT); }
__device__ __forceinline__ unsigned xb_xcc_id() { return (unsigned)__builtin_amdgcn_s_getreg((3 << 11) | 20) & 0xFu; }
#define XB_SPIN(cond, bar) do { unsigned _sp = 0; while (cond) { __builtin_amdgcn_s_sleep(1); \
    if ((++_sp & 255u) == 0u) { if (xb_ld(&(bar)[XB_TMO])) break; if (_sp > XB_SPIN_CAP) { atomicAdd(&(bar)[XB_TMO], 1u); break; } } } } while (0)
struct XcdBarrier { unsigned* bar; unsigned x; volatile LAS unsigned* st; };
__device__ __forceinline__ XcdBarrier xcd_barrier_post(unsigned* bar, volatile LAS unsigned* st) {
    XcdBarrier b; b.bar = bar; b.x = xb_xcc_id(); b.st = st;
    if (threadIdx.x == 0) (void)xb_add(&bar[XB_XCNT(b.x)], 1u);
    return b;
}
__device__ __forceinline__ void xcd_barrier_complete(unsigned* bar, unsigned x, unsigned& nloc, unsigned& nx) {
    const unsigned G = gridDim.x * gridDim.y * gridDim.z;
    unsigned sum, cnt, mine, sp = 0u;
    for (;;) {
        sum = 0u; cnt = 0u; mine = 0u;
#pragma unroll
        for (unsigned j = 0; j < 16; ++j) { const unsigned c = xb_ld(&bar[XB_XCNT(j)]); sum += c; cnt += (c > 0u) ? 1u : 0u; mine = (j == x) ? c : mine; }
        if (sum == G) break;
        __builtin_amdgcn_s_sleep(1);
        if ((++sp & 255u) == 0u) { if (xb_ld(&bar[XB_TMO])) break; if (sp > XB_SPIN_CAP) { atomicAdd(&bar[XB_TMO], 1u); break; } }
    }
    nloc = mine > 0u ? mine : 1u; nx = cnt > 0u ? cnt : 1u;
}
__device__ __forceinline__ void xcd_barrier(const XcdBarrier& b) {
    asm volatile("s_waitcnt vmcnt(0)" ::: "memory");
    __syncthreads();
    if (threadIdx.x == 0) {
        unsigned* bar = b.bar;
        __builtin_amdgcn_s_waitcnt(0);
        unsigned nloc = b.st[0], nx = b.st[1];
        if (nloc == 0u) { xcd_barrier_complete(bar, b.x, nloc, nx); b.st[0] = nloc; b.st[1] = nx; }
        const unsigned old = xb_add(&bar[XB_XSUB(b.x)], 1u);
        const unsigned gen = old / nloc;
        if (old + 1u == (gen + 1u) * nloc) {
            __builtin_amdgcn_fence(__ATOMIC_RELEASE, "agent");
            asm volatile("s_waitcnt vmcnt(0)" ::: "memory");
            const unsigned og = xb_add(&bar[XB_TOP], 1u);
            const unsigned tg = og / nx;
            if (og + 1u == (tg + 1u) * nx) xb_add(&bar[XB_TOPGEN], 1u);
            else XB_SPIN(xb_ld(&bar[XB_TOPGEN]) == tg, bar);
            __builtin_amdgcn_fence(__ATOMIC_ACQUIRE, "agent");
            xb_add(&bar[XB_XGEN(b.x)], 1u);
            asm volatile("s_waitcnt vmcnt(0)" ::: "memory");
        } else {
            XB_SPIN(xb_ld(&bar[XB_XGEN(b.x)]) == gen, bar);
            __builtin_amdgcn_fence(__ATOMIC_ACQUIRE, "agent");
            asm volatile("s_waitcnt vmcnt(0)" ::: "memory");
        }
    }
    __syncthreads();
}

struct Args { const void* in[27]; float* out; unsigned char* ws; int ph_lo, ph_hi; };
struct Core { LAS unsigned char* lds; int tid, lane, wave, G, bid; };
struct Frame {
    LAS unsigned char* lds;
    int tid, lane, wave, G, bid;
    const float *x_p, *x_s, *c_p, *c_s, *cache_k, *cache_v, *cache_ki, *state_conv, *rel_bias, *w_ada, *b_ada, *w_in, *conv_w, *conv_b,
                *w_o_attn, *w_o_conv, *w_out, *ln1_g, *ln1_b, *ln2_g, *ln2_b, *peer_wq, *peer_k1, *peer_k2, *peer_u, *peer_v;
    const int* page_table;
    float* out; unsigned char* ws;
    float* MOD; bf16_t *WIN, *WOA, *WOC, *WOUT, *WQ, *K1, *K2, *PU, *PV, *H1, *PROJ, *OATT, *OCONV, *MERGED, *H2, *QP;
    float *WI, *T1, *GW; int *SEL, *EIDX;
};
constexpr int LDS_PTAB = LDS_BYTES - 512;
__device__ __forceinline__ unsigned char* ldptr(const Core& C, int k) {
    LAS const unsigned* p = (LAS const unsigned*)(C.lds + LDS_PTAB) + 2 * k;
    const unsigned lo = __builtin_amdgcn_readfirstlane(p[0]), hi = __builtin_amdgcn_readfirstlane(p[1]);
    return (unsigned char*)(((unsigned long long)hi << 32) | (unsigned long long)lo);
}
__device__ __forceinline__ void load_frame(Frame& F, const Core& C) {
    F.lds = C.lds; F.tid = C.tid; F.lane = C.lane; F.wave = C.wave; F.G = C.G; F.bid = C.bid;
    F.x_p = (const float*)ldptr(C, 0); F.x_s = (const float*)ldptr(C, 1); F.c_p = (const float*)ldptr(C, 2); F.c_s = (const float*)ldptr(C, 3);
    F.cache_k = (const float*)ldptr(C, 4); F.cache_v = (const float*)ldptr(C, 5); F.cache_ki = (const float*)ldptr(C, 6); F.state_conv = (const float*)ldptr(C, 7);
    F.page_table = (const int*)ldptr(C, 8); F.rel_bias = (const float*)ldptr(C, 9); F.w_ada = (const float*)ldptr(C, 10); F.b_ada = (const float*)ldptr(C, 11);
    F.w_in = (const float*)ldptr(C, 12); F.conv_w = (const float*)ldptr(C, 13); F.conv_b = (const float*)ldptr(C, 14); F.w_o_attn = (const float*)ldptr(C, 15);
    F.w_o_conv = (const float*)ldptr(C, 16); F.w_out = (const float*)ldptr(C, 17); F.ln1_g = (const float*)ldptr(C, 18); F.ln1_b = (const float*)ldptr(C, 19);
    F.ln2_g = (const float*)ldptr(C, 20); F.ln2_b = (const float*)ldptr(C, 21); F.peer_wq = (const float*)ldptr(C, 22); F.peer_k1 = (const float*)ldptr(C, 23);
    F.peer_k2 = (const float*)ldptr(C, 24); F.peer_u = (const float*)ldptr(C, 25); F.peer_v = (const float*)ldptr(C, 26);
    F.out = (float*)ldptr(C, 27);
    unsigned char* ws = ldptr(C, 28);
    F.MOD = (float*)(ws + WS_MOD); F.WIN = (bf16_t*)(ws + WS_WIN); F.WOA = (bf16_t*)(ws + WS_WOA); F.WOC = (bf16_t*)(ws + WS_WOC);
    F.WOUT = (bf16_t*)(ws + WS_WOUT); F.WQ = (bf16_t*)(ws + WS_WQ); F.K1 = (bf16_t*)(ws + WS_K1); F.K2 = (bf16_t*)(ws + WS_K2);
    F.PU = (bf16_t*)(ws + WS_PU); F.PV = (bf16_t*)(ws + WS_PV); F.H1 = (bf16_t*)(ws + WS_H1); F.PROJ = (bf16_t*)(ws + WS_PROJ);
    F.WI = (float*)(ws + WS_WI); F.SEL = (int*)(ws + WS_SEL); F.OATT = (bf16_t*)(ws + WS_OATT); F.OCONV = (bf16_t*)(ws + WS_OCONV);
    F.MERGED = (bf16_t*)(ws + WS_MERGED); F.T1 = (float*)(ws + WS_T1); F.H2 = (bf16_t*)(ws + WS_H2); F.QP = (bf16_t*)(ws + WS_QP);
    F.EIDX = (int*)(ws + WS_EIDX); F.GW = (float*)(ws + WS_GW);
}
__device__ __forceinline__ const float* x_row(const Frame& F, int m) { return m < NTP ? F.x_p + (size_t)m * D : F.x_s + (size_t)(m - NTP) * D; }
__device__ __forceinline__ int mod_row(int m) { return m < NTP ? (m >> 11) : NB_P + ((m - NTP) >> 3); }

constexpr int P0_MOD_ITEMS = 96;
constexpr int P0_T_WIN = 16 * 74, P0_T_WOA = 8 * 16, P0_T_WOC = 8 * 16, P0_T_WOUT = 16 * 16, P0_T_WQ = 16 * 16;
constexpr int P0_T_ITEMS = P0_T_WIN + P0_T_WOA + P0_T_WOC + P0_T_WOUT + P0_T_WQ;
constexpr int P0_CVT_ITEMS = 2 * (16384 * 1024 / 8192);
constexpr int P0_MISC_ITEMS = 1;
constexpr int P0_ITEMS = P0_MOD_ITEMS + P0_T_ITEMS + P0_CVT_ITEMS + P0_MISC_ITEMS;

__device__ __forceinline__ void p0_mod_item(const Frame& F, int ng) {
    LAS float* cs = (LAS float*)F.lds;
    LAS float* red = (LAS float*)(F.lds + 40 * 256 * 4);
    float acc[40];
#pragma unroll
    for (int r = 0; r < 40; ++r) acc[r] = 0.f;
    const int n = ng * 64 + F.lane;
    for (int kc = 0; kc < 4; ++kc) {
        __syncthreads();
#pragma unroll 1
        for (int hb = 0; hb < 2; ++hb) {
            float cv[10];
#pragma unroll
            for (int i = 0; i < 10; ++i) { const int e = F.tid + (hb * 10 + i) * NTHREADS; const int r = e >> 8, k = e & 255; cv[i] = (r < 8) ? F.c_p[r * D + kc * 256 + k] : F.c_s[(r - 8) * D + kc * 256 + k]; }
#pragma unroll
            for (int i = 0; i < 10; ++i) cs[F.tid + (hb * 10 + i) * NTHREADS] = cv[i];
        }
        __syncthreads();
        float wvv[32];
#pragma unroll
        for (int kk = 0; kk < 32; ++kk) wvv[kk] = F.w_ada[(size_t)(kc * 256 + F.wave * 32 + kk) * 6144 + n];
#pragma unroll
        for (int kk = 0; kk < 32; ++kk) {
            const int kl = F.wave * 32 + kk;
#pragma unroll
            for (int r = 0; r < 40; ++r) acc[r] += cs[r * 256 + kl] * wvv[kk];
        }
    }
#pragma unroll
    for (int r = 0; r < 40; ++r) red[(F.wave * 40 + r) * 64 + F.lane] = acc[r];
    __syncthreads();
    for (int e = F.tid; e < 40 * 64; e += NTHREADS) {
        const int r = e >> 6, l = e & 63; float s = F.b_ada[ng * 64 + l];
#pragma unroll
        for (int w = 0; w < 8; ++w) s += red[(w * 40 + r) * 64 + l];
        F.MOD[r * 6144 + ng * 64 + l] = s;
    }
    __syncthreads();
}
__device__ __forceinline__ void p0_transpose_tile(const Frame& F, const float* W, int N, int K, bf16_t* Wt, int kt, int nt, bool permute) {
    LAS bf16_t* tile = (LAS bf16_t*)F.lds;
    __syncthreads();
    { const int k = F.tid >> 3, c0 = (F.tid & 7) * 8;
      const float* rp = W + (size_t)(kt * 64 + k) * N + nt * 64 + c0;
      const f32x4 z = {0.f, 0.f, 0.f, 0.f};
      const f32x4 v0 = (nt * 64 + c0 < N) ? *(const f32x4*)rp : z, v1 = (nt * 64 + c0 + 4 < N) ? *(const f32x4*)(rp + 4) : z;
#pragma unroll
      for (int j = 0; j < 4; ++j) { tile[k * 66 + c0 + j] = f2bf(v0[j]); tile[k * 66 + c0 + 4 + j] = f2bf(v1[j]); } }
    __syncthreads();
    { const int nl = F.tid >> 3, k0 = (F.tid & 7) * 8; const int n = nt * 64 + nl;
      if (n < N) {
          int nd = n; if (permute) nd = (n < 1024) ? n : (n < 1028 ? C_WI + (n - 1024) : n - 4);
          unsigned p[4];
#pragma unroll
          for (int j = 0; j < 4; ++j) p[j] = (unsigned)tile[(k0 + 2 * j) * 66 + nl] | ((unsigned)tile[(k0 + 2 * j + 1) * 66 + nl] << 16);
          *(u32x4*)(Wt + (size_t)nd * K + kt * 64 + k0) = (u32x4){p[0], p[1], p[2], p[3]};
      } }
}
constexpr int P0_CVT32_ITEMS = 2 * (16384 / 32);
constexpr int P0_OTHER = P0_T_ITEMS + P0_CVT32_ITEMS + 1;
__device__ __forceinline__ void p0_other_item(const Frame& F, int i) {
    if (i < P0_T_ITEMS) {
        if (i < P0_T_WIN) { p0_transpose_tile(F, F.w_in, NMIX, D, F.WIN, i / 74, i % 74, true); return; }
        i -= P0_T_WIN;
        if (i < P0_T_WOA) { p0_transpose_tile(F, F.w_o_attn, D, 512, F.WOA, i / 16, i % 16, false); return; }
        i -= P0_T_WOA;
        if (i < P0_T_WOC) { p0_transpose_tile(F, F.w_o_conv, D, 512, F.WOC, i / 16, i % 16, false); return; }
        i -= P0_T_WOC;
        if (i < P0_T_WOUT) { p0_transpose_tile(F, F.w_out, D, D, F.WOUT, i / 16, i % 16, false); return; }
        i -= P0_T_WOUT;
        p0_transpose_tile(F, F.peer_wq, D, D, F.WQ, i / 16, i % 16, false); return;
    }
    i -= P0_T_ITEMS;
    if (i < P0_CVT32_ITEMS) {
        const bool isu = i < 512;
        const float* src = isu ? F.peer_u : F.peer_v;
        unsigned char* dst = F.ws + (isu ? WS_PU8 : WS_PV8); float* sinv = (float*)(F.ws + (isu ? WS_SU : WS_SV));
        const int row0 = (i & 511) * 32 + F.wave * 4;
        float v[4][16];
        if (isu) {
#pragma unroll
            for (int rr = 0; rr < 4; ++rr)
#pragma unroll
                for (int q = 0; q < 4; ++q) {
                    const f32x4 t = *(const f32x4*)(src + (size_t)(row0 + rr) * D + F.lane * 16 + q * 4);
                    v[rr][4 * q] = t[0]; v[rr][4 * q + 1] = t[1]; v[rr][4 * q + 2] = t[2]; v[rr][4 * q + 3] = t[3];
                }
        } else {
#pragma unroll
            for (int rr = 0; rr < 4; ++rr)
#pragma unroll
                for (int c = 0; c < 16; ++c) v[rr][c] = src[(size_t)(row0 + rr) * D + c * 64 + F.lane];
        }
#pragma unroll
        for (int rr = 0; rr < 4; ++rr) {
            float am = 0.f;
#pragma unroll
            for (int c = 0; c < 16; ++c) am = fmaxf(am, fabsf(v[rr][c]));
            am = wave_max(am);
            const float sc = am > 0.f ? 6.f / am : 1.f;
            unsigned w0 = 0u, w1 = 0u;
            w0 = __builtin_amdgcn_cvt_scalef32_pk_fp4_f32(w0, v[rr][0] * sc, v[rr][1] * sc, 1.0f, 0);
            w0 = __builtin_amdgcn_cvt_scalef32_pk_fp4_f32(w0, v[rr][2] * sc, v[rr][3] * sc, 1.0f, 1);
            w0 = __builtin_amdgcn_cvt_scalef32_pk_fp4_f32(w0, v[rr][4] * sc, v[rr][5] * sc, 1.0f, 2);
            w0 = __builtin_amdgcn_cvt_scalef32_pk_fp4_f32(w0, v[rr][6] * sc, v[rr][7] * sc, 1.0f, 3);
            w1 = __builtin_amdgcn_cvt_scalef32_pk_fp4_f32(w1, v[rr][8] * sc, v[rr][9] * sc, 1.0f, 0);
            w1 = __builtin_amdgcn_cvt_scalef32_pk_fp4_f32(w1, v[rr][10] * sc, v[rr][11] * sc, 1.0f, 1);
            w1 = __builtin_amdgcn_cvt_scalef32_pk_fp4_f32(w1, v[rr][12] * sc, v[rr][13] * sc, 1.0f, 2);
            w1 = __builtin_amdgcn_cvt_scalef32_pk_fp4_f32(w1, v[rr][14] * sc, v[rr][15] * sc, 1.0f, 3);
            *(u32x2*)(dst + (size_t)(row0 + rr) * 512 + F.lane * 8) = (u32x2){w0, w1};
            if (F.lane == 0) sinv[row0 + rr] = am > 0.f ? am * (1.f / 6.f) : 1.f;
        }
        return;
    }
    for (int e = F.tid; e < (4864 - NMIX) * D; e += NTHREADS) F.WIN[(size_t)NMIX * D + e] = 0;
    for (int e = F.tid; e < 128 * 64; e += NTHREADS) { F.K1[e] = f2bf(F.peer_k1[e]); F.K2[e] = f2bf(F.peer_k2[e]); }
}
__device__ __forceinline__ void p0_prologue(const Frame& F) {
    constexpr int NMODWG = P0_MOD_ITEMS, HEAD = 8;
    if (F.G <= NMODWG) {
        for (int it = F.bid; it < P0_MOD_ITEMS + P0_OTHER; it += F.G) { if (it < P0_MOD_ITEMS) p0_mod_item(F, it); else p0_other_item(F, it - P0_MOD_ITEMS); }
        return;
    }
    const int nfree = F.G - NMODWG;
    int head_items = HEAD * nfree; if (head_items > P0_OTHER) head_items = P0_OTHER;
    if (F.bid < NMODWG) p0_mod_item(F, F.bid);
    else for (int j = F.bid - NMODWG; j < head_items; j += nfree) p0_other_item(F, j);
    for (int j = head_items + F.bid; j < P0_OTHER; j += F.G) p0_other_item(F, j);
}

__device__ __forceinline__ void p1_modulate(const Frame& F) {
    const int stride = F.G * 8;
    for (int m0 = F.bid * 8 + F.wave; m0 < NT; m0 += 2 * stride) {
        f32x4 xv[2][4], sv[2][4], hv[2][4];
#pragma unroll
        for (int rr = 0; rr < 2; ++rr) {
            const int m = (m0 + rr * stride < NT) ? m0 + rr * stride : m0;
            const float* xr = x_row(F, m); const float* mr = F.MOD + (size_t)mod_row(m) * 6144;
#pragma unroll
            for (int q = 0; q < 4; ++q) {
                const int e = (q >> 1) * 512 + F.lane * 8 + (q & 1) * 4;
                xv[rr][q] = *(const f32x4*)(xr + e); sv[rr][q] = *(const f32x4*)(mr + 1024 + e); hv[rr][q] = *(const f32x4*)(mr + e);
            }
        }
#pragma unroll
        for (int rr = 0; rr < 2; ++rr) {
            const int m = m0 + rr * stride;
            if (m >= NT) continue;
#pragma unroll
            for (int hlf = 0; hlf < 2; ++hlf) {
                const f32x4 a = xv[rr][2 * hlf] * (sv[rr][2 * hlf] + 1.f) + hv[rr][2 * hlf], b2 = xv[rr][2 * hlf + 1] * (sv[rr][2 * hlf + 1] + 1.f) + hv[rr][2 * hlf + 1];
                *(u32x4*)(F.H1 + (size_t)m * D + hlf * 512 + F.lane * 8) = (u32x4){cvt_pk_bf16(a[0], a[1]), cvt_pk_bf16(a[2], a[3]), cvt_pk_bf16(b2[0], b2[1]), cvt_pk_bf16(b2[2], b2[3])};
            }
        }
    }
}

constexpr int BM = 256, BN = 128, BK = 64;
constexpr int XPANEL = BM * 32 + 32, WPANEL = BN * 32 + 32;
constexpr int XSTAGE = 4 * XPANEL, WSTAGE = 4 * WPANEL, GSTAGE = XSTAGE + WSTAGE;
__device__ __forceinline__ void gemm_accum(const Frame& F, f32x16 (&acc)[2][2], const bf16_t* __restrict__ X, int ldx, const bf16_t* __restrict__ W, int ldw, int K, int m0, int n0) {
    const int tid = F.tid, lane = F.lane, r = lane & 31, h = lane >> 5, wm = F.wave >> 1, wn = F.wave & 1;
    u32x4 xr[4], wr[2];
    const int nk = K / BK;
    const int crow = tid >> 3, ckc = tid & 7;
    const bf16_t* xg = X + (size_t)(m0 + crow) * ldx + ckc * 8;
    const bf16_t* wg = W + (size_t)(n0 + crow) * ldw + ckc * 8;
    const int ldso = (ckc >> 1) * 1  ;
    const int xoff = ldso * XPANEL + crow * 32 + (ckc & 1) * 16;
    const int woff = ldso * WPANEL + crow * 32 + (ckc & 1) * 16;
#pragma unroll
    for (int i = 0; i < 4; ++i) xr[i] = *(const u32x4*)(xg + (size_t)(64 * i) * ldx);
#pragma unroll
    for (int i = 0; i < 2; ++i) wr[i] = *(const u32x4*)(wg + (size_t)(64 * i) * ldw);
    __syncthreads();
    for (int kt = 0; kt < nk; ++kt) {
        LAS unsigned char* st = F.lds + (kt & 1) * GSTAGE;
#pragma unroll
        for (int i = 0; i < 4; ++i) *(LAS u32x4*)(st + xoff + i * 64 * 32) = xr[i];
#pragma unroll
        for (int i = 0; i < 2; ++i) *(LAS u32x4*)(st + XSTAGE + woff + i * 64 * 32) = wr[i];
        __syncthreads();
        if (kt + 1 < nk) {
#pragma unroll
            for (int i = 0; i < 4; ++i) xr[i] = *(const u32x4*)(xg + (size_t)(64 * i) * ldx + (kt + 1) * BK);
#pragma unroll
            for (int i = 0; i < 2; ++i) wr[i] = *(const u32x4*)(wg + (size_t)(64 * i) * ldw + (kt + 1) * BK);
        }
#pragma unroll
        for (int s = 0; s < 4; ++s) {
            bf16x8 a[2], b[2];
#pragma unroll
            for (int ni = 0; ni < 2; ++ni) a[ni] = *(LAS bf16x8*)(st + XSTAGE + s * WPANEL + (wn * 64 + ni * 32 + r) * 32 + h * 16);
#pragma unroll
            for (int mi = 0; mi < 2; ++mi) b[mi] = *(LAS bf16x8*)(st + s * XPANEL + (wm * 64 + mi * 32 + r) * 32 + h * 16);
#pragma unroll
            for (int mi = 0; mi < 2; ++mi)
#pragma unroll
                for (int ni = 0; ni < 2; ++ni) acc[mi][ni] = __builtin_amdgcn_mfma_f32_32x32x16_bf16(a[ni], b[mi], acc[mi][ni], 0, 0, 0);
        }
    }
}
#define GEMM_EPI_LOOP(...) \
    { const int r_ = F.lane & 31, h_ = F.lane >> 5, wm_ = F.wave >> 1, wn_ = F.wave & 1; \
      _Pragma("unroll") for (int mi = 0; mi < 2; ++mi) _Pragma("unroll") for (int ni = 0; ni < 2; ++ni) _Pragma("unroll") for (int g = 0; g < 4; ++g) { \
          const int m = m0 + wm_ * 64 + mi * 32 + r_; const int n = n0 + wn_ * 64 + ni * 32 + 8 * g + 4 * h_; __VA_ARGS__ } }
#define ACC4(A) ((f32x4){A[mi][ni][4 * g], A[mi][ni][4 * g + 1], A[mi][ni][4 * g + 2], A[mi][ni][4 * g + 3]})
__device__ __forceinline__ void zero_acc(f32x16 (&acc)[2][2]) {
#pragma unroll
    for (int mi = 0; mi < 2; ++mi)
#pragma unroll
        for (int ni = 0; ni < 2; ++ni)
#pragma unroll
            for (int e = 0; e < 16; ++e) acc[mi][ni][e] = 0.f;
}
__device__ __forceinline__ u32x2 pk4(const f32x4 v) { return (u32x2){cvt_pk_bf16(v[0], v[1]), cvt_pk_bf16(v[2], v[3])}; }

__device__ __forceinline__ void gemm_slice8(const Frame& F, f32x16 (&sacc)[1][1], const bf16_t* __restrict__ X, int ldx, const bf16_t* __restrict__ W, int ldw, int K, int m0, int n0) {
    const int r = F.lane & 31, h = F.lane >> 5, wq = F.wave & 3, kh = F.wave >> 2;
    const bf16_t* wp = W + (size_t)(n0 + 32 * wq + r) * ldw + kh * (K / 2) + h * 8;
    const bf16_t* xp = X + (size_t)(m0 + (r & 7)) * ldx + kh * (K / 2) + h * 8;
    f32x16 c;
#pragma unroll
    for (int e = 0; e < 16; ++e) c[e] = 0.f;
#pragma unroll 1
    for (int k0 = 0; k0 < K / 2; k0 += 128) {
        bf16x8 a[8], b[8];
#pragma unroll
        for (int t = 0; t < 8; ++t) { a[t] = *(const bf16x8*)(wp + k0 + t * 16); b[t] = *(const bf16x8*)(xp + k0 + t * 16); }
#pragma unroll
        for (int t = 0; t < 8; ++t) c = __builtin_amdgcn_mfma_f32_32x32x16_bf16(a[t], b[t], c, 0, 0, 0);
    }
    LAS float* cb = (LAS float*)F.lds + wq * (16 * 64);
    __syncthreads();
    if (kh == 1) {
#pragma unroll
        for (int e = 0; e < 16; ++e) cb[e * 64 + F.lane] = c[e];
    }
    __syncthreads();
    if (kh == 0) {
#pragma unroll
        for (int e = 0; e < 16; ++e) c[e] += cb[e * 64 + F.lane];
    }
    sacc[0][0] = c;
}
#define SLICE_EPI_LOOP(...) \
    if (F.wave < 4 && (F.lane & 31) < 8) { const int h_ = F.lane >> 5, wq_ = F.wave & 3; constexpr int mi = 0, ni = 0; \
      _Pragma("unroll") for (int g = 0; g < 4; ++g) { const int m = m0 + (F.lane & 31); const int n = n0 + wq_ * 32 + 8 * g + 4 * h_; __VA_ARGS__ } }

namespace pg8 {
#define PG8_LAS __attribute__((address_space(3)))
typedef unsigned short bf16_t;
typedef short bf16x8 __attribute__((ext_vector_type(8)));
typedef float f32x4 __attribute__((ext_vector_type(4)));
typedef unsigned u32x4 __attribute__((ext_vector_type(4)));
constexpr int BM = 256, BK = 64, HALF = 128, HTB = HALF * BK * 2  , STAGE_BYTES = 8 * HTB, NXCD = 8, WGM = 8;

__host__ __device__ __forceinline__ int lds_byte(int r, int c) { const int st = (r >> 4) * 2 + (c >> 5), rr = r & 15, cc = c & 31, ob = rr * 64 + cc * 2; return st * 1024 + (ob ^ (((ob >> 9) & 1) << 5)); }
__host__ __device__ __forceinline__ void stage_rc(int b, int& R, int& C) { const int st = b / 1024, sb = b % 1024, swz = sb ^ (((sb >> 9) & 1) << 5); R = (st >> 1) * 16 + swz / 64; C = (st & 1) * 32 + (swz % 64) / 2; }
__host__ __device__ __forceinline__ int perm32(int rho) { const int n = rho >> 4, i = rho & 15; return 8 * (i >> 2) + 4 * n + (i & 3); }

struct Unit { int pm, pn; };
struct Gemm { const bf16_t* A; const bf16_t* Bt; int M, N, K; };

struct StaticOrder {
    int nM, nN, nwg, G, c;
    __host__ __device__ void init(int M, int N, int G_, int c_) { nM = M / BM; nN = N / BM; nwg = nM * nN; G = G_; c = c_; }
    __host__ __device__ bool next(int i, Unit& u) const {
        const long L = (long)i * G + c; if (L >= nwg) return false;
        int wgid = (int)L; { const int q = nwg / NXCD, r = nwg % NXCD, xcd = wgid % NXCD, off = wgid / NXCD; wgid = (xcd < r ? xcd * (q + 1) : r * (q + 1) + (xcd - r) * q) + off; }
        const int nig = WGM * nN, gid = wgid / nig, fm = gid * WGM, gsz = (nM - fm) < WGM ? (nM - fm) : WGM;
        u.pm = fm + ((wgid % nig) % gsz); u.pn = (wgid % nig) / gsz; return true;
    }
    __device__ __forceinline__ void a_ready(const Unit&) const {}
    __device__ __forceinline__ void done(const Unit&) const {}
};

template <class Body> struct EpiRC {
    static constexpr bool PERM = false, AFTER_DRAIN = false;
    Body body;
    __device__ __forceinline__ void operator()(const f32x4 (&acc)[2][2][4][2], const Unit& u, int wr, int wc, int fr, int fq) const {
#pragma unroll
        for (int ai = 0; ai < 2; ++ai)
#pragma unroll
            for (int m = 0; m < 4; ++m) {
                const int row = u.pm * BM + ai * HALF + wr * 64 + m * 16 + fr;
#pragma unroll
                for (int bj = 0; bj < 2; ++bj)
#pragma unroll
                    for (int n = 0; n < 2; ++n) body(row, u.pn * BM + bj * HALF + wc * 32 + n * 16 + 4 * fq, acc[ai][bj][m][n]);
            }
    }
};
template <class Epi, class Sched, bool ALIGN_EPI = false, bool SP2 = false>
__device__ __forceinline__ void gemm_phase(PG8_LAS unsigned char* lds, const Gemm g, const Sched& S, const Epi& E) {
    const int tid = threadIdx.x, wid = __builtin_amdgcn_readfirstlane(tid >> 6), lane = tid & 63, wr = wid >> 2, wc = wid & 3, fr = lane & 15, fq = lane >> 4;
    const int K = g.K, nt = K / BK;
    unsigned voffA[2], voffB[2];
#pragma unroll
    for (int i = 0; i < 2; ++i) { int R, C; stage_rc(tid * 16 + i * 8192, R, C); const int Rb = Epi::PERM ? ((R & ~31) + perm32(R & 31)) : R;
        voffA[i] = (unsigned)(R * K + C) * 2u; voffB[i] = (unsigned)(Rb * K + C) * 2u; }
    const size_t kstep = (size_t)(BK * 2);
    const size_t hstep = (size_t)HALF * K * 2;
    const size_t tstep = 2 * hstep;
    const unsigned ldsw = (unsigned)wid * 1024u;
    const int aoff = lds_byte(wr * 64 + fr, fq * 8), boff = lds_byte(wc * 32 + fr, fq * 8);
#define PG8_SA(b, h) (((b) * 2 + (h)) * HTB)
#define PG8_SB(b, h) ((4 + (b) * 2 + (h)) * HTB)
#define PG8_STAGE(bufoff, gbase, voff) do { _Pragma("unroll") for (int _i = 0; _i < 2; ++_i) \
        __builtin_amdgcn_global_load_lds((const unsigned*)((const char*)(gbase) + (voff)[_i]), (PG8_LAS unsigned*)(lds + (bufoff) + ldsw + _i * 8192), 16, 0, 0); } while (0)
#define PG8_LDA(dst, b, h) do { _Pragma("unroll") for (int m = 0; m < 4; ++m) _Pragma("unroll") for (int k = 0; k < 2; ++k) dst[m][k] = *(const PG8_LAS bf16x8*)(lds + PG8_SA(b, h) + aoff + m * 2048 + k * 1024); } while (0)
#define PG8_LDB(dst, b, h) do { _Pragma("unroll") for (int n = 0; n < 2; ++n) _Pragma("unroll") for (int k = 0; k < 2; ++k) dst[n][k] = *(const PG8_LAS bf16x8*)(lds + PG8_SB(b, h) + boff + n * 2048 + k * 1024); } while (0)
#define PG8_MMA(ai, bj, At, Bt) do { __builtin_amdgcn_s_setprio(1); _Pragma("unroll") for (int m = 0; m < 4; ++m) _Pragma("unroll") for (int n = 0; n < 2; ++n) _Pragma("unroll") for (int k = 0; k < 2; ++k) \
        acc[ai][bj][m][n] = __builtin_amdgcn_mfma_f32_16x16x32_bf16(Bt[n][k], At[m][k], acc[ai][bj][m][n], 0, 0, 0); __builtin_amdgcn_s_setprio(0); } while (0)
#define PG8_WAIT_V(n) asm volatile("s_waitcnt vmcnt(" #n ")" ::: "memory")
#define PG8_WAIT_L(n) asm volatile("s_waitcnt lgkmcnt(" #n ")" ::: "memory")
#define PG8_BAR __builtin_amdgcn_s_barrier()
#define PG8_SCHED __builtin_amdgcn_sched_barrier(0)
    Unit cur, nxt; int ui = 0;
    if (!S.next(0, cur)) return;
    f32x4 acc[2][2][4][2];
#pragma unroll
    for (int a = 0; a < 2; ++a)
#pragma unroll
        for (int b = 0; b < 2; ++b)
#pragma unroll
            for (int m = 0; m < 4; ++m)
#pragma unroll
                for (int n = 0; n < 2; ++n) acc[a][b][m][n] = (f32x4){0.f, 0.f, 0.f, 0.f};
    bf16x8 At[4][2], B0[2][2], B1[2][2];
    const char* cA = (const char*)g.A + (size_t)cur.pm * tstep; const char* cB = (const char*)g.Bt + (size_t)cur.pn * tstep;
    S.a_ready(cur);
    if constexpr (SP2) {
        PG8_STAGE(PG8_SB(0, 0), cB, voffB); PG8_STAGE(PG8_SB(0, 1), cB + hstep, voffB); PG8_STAGE(PG8_SA(0, 0), cA, voffA); PG8_STAGE(PG8_SA(0, 1), cA + hstep, voffA);
        if (wr == 1) PG8_BAR;
        PG8_WAIT_V(2); PG8_BAR;
        PG8_STAGE(PG8_SB(1, 0), cB + kstep, voffB); PG8_STAGE(PG8_SA(1, 0), cA + kstep, voffA); PG8_STAGE(PG8_SB(1, 1), cB + hstep + kstep, voffB);
        PG8_WAIT_V(6); PG8_BAR;
    } else {
        PG8_STAGE(PG8_SB(0, 0), cB, voffB); PG8_STAGE(PG8_SA(0, 0), cA, voffA); PG8_STAGE(PG8_SB(0, 1), cB + hstep, voffB); PG8_STAGE(PG8_SA(0, 1), cA + hstep, voffA);
        if (wr == 1) PG8_BAR;
        PG8_WAIT_V(4); PG8_BAR;
        PG8_STAGE(PG8_SB(1, 0), cB + kstep, voffB); PG8_STAGE(PG8_SA(1, 0), cA + kstep, voffA); PG8_STAGE(PG8_SB(1, 1), cB + hstep + kstep, voffB);
        PG8_WAIT_V(6); PG8_BAR;
    }
    for (;;) {
        const bool has_next = S.next(ui + 1, nxt);
        const char* nA = has_next ? (const char*)g.A + (size_t)nxt.pm * tstep : cA; const char* nB = has_next ? (const char*)g.Bt + (size_t)nxt.pn * tstep : cB;
        for (int t = 0; t < nt; t += 2) {
            const bool last = (t == nt - 2);
            const char* a1 = cA + (size_t)(t + 1) * kstep;
            const char* a2 = last ? nA : cA + (size_t)(t + 2) * kstep; const char* b2 = last ? nB : cB + (size_t)(t + 2) * kstep;
            const char* a3 = a2 + kstep; const char* b3 = b2 + kstep;
            if (last && has_next) S.a_ready(nxt);
            if constexpr (SP2) {
            PG8_LDB(B0, 0, 0); PG8_LDB(B1, 0, 1); PG8_SCHED; PG8_LDA(At, 0, 0); PG8_STAGE(PG8_SA(1, 1), a1 + hstep, voffA);
            PG8_WAIT_V(8); PG8_WAIT_L(0); PG8_BAR; PG8_MMA(0, 0, At, B0); PG8_MMA(0, 1, At, B1); PG8_BAR; PG8_SCHED;
            PG8_LDA(At, 0, 1); PG8_STAGE(PG8_SB(0, 0), b2, voffB); PG8_STAGE(PG8_SB(0, 1), b2 + hstep, voffB); PG8_STAGE(PG8_SA(0, 0), a2, voffA);
            PG8_WAIT_V(8); PG8_WAIT_L(0); PG8_BAR; PG8_MMA(1, 0, At, B0); PG8_MMA(1, 1, At, B1); PG8_BAR; PG8_SCHED;
            PG8_LDB(B0, 1, 0); PG8_LDB(B1, 1, 1); PG8_SCHED; PG8_LDA(At, 1, 0); PG8_STAGE(PG8_SA(0, 1), a2 + hstep, voffA);
            PG8_WAIT_V(8); PG8_WAIT_L(0); PG8_BAR; PG8_MMA(0, 0, At, B0); PG8_MMA(0, 1, At, B1); PG8_BAR; PG8_SCHED;
            PG8_LDA(At, 1, 1); PG8_STAGE(PG8_SB(1, 0), b3, voffB); PG8_STAGE(PG8_SB(1, 1), b3 + hstep, voffB); PG8_STAGE(PG8_SA(1, 0), a3, voffA);
            PG8_WAIT_V(8); PG8_WAIT_L(0); PG8_BAR; PG8_MMA(1, 0, At, B0); PG8_MMA(1, 1, At, B1); PG8_BAR; PG8_SCHED;
            } else {
            PG8_LDB(B0, 0, 0); PG8_SCHED; PG8_LDA(At, 0, 0); PG8_STAGE(PG8_SA(1, 1), a1 + hstep, voffA);
            PG8_WAIT_L(8); PG8_BAR; PG8_WAIT_L(0); PG8_MMA(0, 0, At, B0); PG8_BAR; PG8_SCHED;
            PG8_LDB(B1, 0, 1); PG8_STAGE(PG8_SB(0, 0), b2, voffB);
            PG8_BAR; PG8_WAIT_L(0); PG8_MMA(0, 1, At, B1); PG8_BAR;
            PG8_LDA(At, 0, 1); PG8_STAGE(PG8_SA(0, 0), a2, voffA);
            PG8_BAR; PG8_WAIT_L(0); PG8_MMA(1, 0, At, B0); PG8_BAR; PG8_SCHED;
            PG8_STAGE(PG8_SB(0, 1), b2 + hstep, voffB);
            PG8_WAIT_V(6); PG8_BAR; PG8_MMA(1, 1, At, B1); PG8_BAR;
            PG8_LDB(B0, 1, 0); PG8_SCHED; PG8_LDA(At, 1, 0); PG8_STAGE(PG8_SA(0, 1), a2 + hstep, voffA);
            PG8_WAIT_L(8); PG8_BAR; PG8_WAIT_L(0); PG8_MMA(0, 0, At, B0); PG8_BAR; PG8_SCHED;
            PG8_LDB(B1, 1, 1); PG8_STAGE(PG8_SB(1, 0), b3, voffB);
            PG8_BAR; PG8_WAIT_L(0); PG8_MMA(0, 1, At, B1); PG8_BAR;
            PG8_LDA(At, 1, 1); PG8_STAGE(PG8_SA(1, 0), a3, voffA);
            PG8_BAR; PG8_WAIT_L(0); PG8_MMA(1, 0, At, B0); PG8_BAR; PG8_SCHED;
            PG8_STAGE(PG8_SB(1, 1), b3 + hstep, voffB);
            PG8_WAIT_V(6); PG8_BAR; PG8_MMA(1, 1, At, B1); PG8_BAR;
            }
        }
        if constexpr (ALIGN_EPI) { if (wr == 0) PG8_BAR; }
        if constexpr (!Epi::AFTER_DRAIN) { E(acc, cur, wr, wc, fr, fq); S.done(cur); }
        if (!has_next) break;
#pragma unroll
        for (int a = 0; a < 2; ++a)
#pragma unroll
            for (int b = 0; b < 2; ++b)
#pragma unroll
                for (int m = 0; m < 4; ++m)
#pragma unroll
                    for (int n = 0; n < 2; ++n) acc[a][b][m][n] = (f32x4){0.f, 0.f, 0.f, 0.f};
        cur = nxt; cA = nA; cB = nB; ++ui;
        if constexpr (ALIGN_EPI) { if (wr == 1) PG8_BAR; }
    }
    PG8_WAIT_V(0);
    if constexpr (!ALIGN_EPI) { if (wr == 0) PG8_BAR; }
    PG8_BAR;
    if constexpr (Epi::AFTER_DRAIN) { E.fused(acc, cur, wr, wc, fr, fq, lds, wid, lane); S.done(cur); }
#undef PG8_SA
#undef PG8_SB
#undef PG8_STAGE
#undef PG8_LDA
#undef PG8_LDB
#undef PG8_MMA
#undef PG8_WAIT_V
#undef PG8_WAIT_L
#undef PG8_BAR
#undef PG8_SCHED
}
}

constexpr int NMIXW = 4864;
struct P2Body {
    const Frame* Fp;
    __device__ __forceinline__ void operator()(int m, int n, const f32x4 v) const {
        const Frame& F = *Fp;
        if (n >= NMIXP) return;
        *(u32x2*)(F.PROJ + (size_t)m * NMIXP + n) = pk4(v);
        if (n >= C_K && n < C_QI) {
            float* o = (n < C_V) ? (m < NTP ? F.out + O_KP + (size_t)m * 128 + (n - C_K) : F.out + O_KS + (size_t)(m - NTP) * 128 + (n - C_K))
                                 : (m < NTP ? F.out + O_VP + (size_t)m * 128 + (n - C_V) : F.out + O_VS + (size_t)(m - NTP) * 128 + (n - C_V));
            *(f32x4*)o = v;
            if (n >= C_V && m < NTP) {
                bf16_t* vt = (bf16_t*)(F.ws + WS_VT) + ((size_t)((m >> 11) * 2 + ((n - C_V) >> 6)) * 64 + ((n - C_V) & 63)) * SEQ + (m & 2047);
                vt[0] = f2bf(v[0]); vt[SEQ] = f2bf(v[1]); vt[2 * SEQ] = f2bf(v[2]); vt[3 * SEQ] = f2bf(v[3]);
            }
        } else if (n >= C_KI && n < C_BG) {
            float* o = m < NTP ? F.out + O_KIP + (size_t)m * 64 + (n - C_KI) : F.out + O_KIS + (size_t)(m - NTP) * 64 + (n - C_KI);
            *(f32x4*)o = v;
        } else if (n == C_WI) {
            *(f32x4*)(F.WI + (size_t)m * 4) = v;
        } else if (n >= C_CG && n < C_GA) {
            const int tt = (m < NTP) ? (m & 2047) - (SEQ - 2) : ((m - NTP) & 7) - (TS - 2);
            if (tt >= 0) {
                const int rowi = (m < NTP) ? (m >> 11) * 2 + tt : 2 * NB_P + ((m - NTP) >> 3) * 2 + tt;
                *(f32x4*)((float*)(F.ws + WS_CGX) + (size_t)rowi * 1024 + (n - C_CG)) = v;
            }
        }
    }
};
__device__ __forceinline__ void p2_gemm_in(const Frame& F) {
    pg8::Gemm g{F.H1, F.WIN, NT, NMIXW, D};
    pg8::StaticOrder S; S.init(NT, NMIXW, F.G, F.bid);
    pg8::EpiRC<P2Body> E{P2Body{&F}};
    pg8::gemm_phase<pg8::EpiRC<P2Body>, pg8::StaticOrder, true, true>(F.lds, g, S, E);
}

constexpr int SROW = 2052;
__device__ __forceinline__ int wave_sum_i(int v) {
#pragma unroll
    for (int o = 32; o >= 1; o >>= 1) v += __shfl_xor(v, o);
    return v;
}
__device__ __forceinline__ void cnt_ge(int& c, unsigned u, unsigned t) { asm("v_cmp_ge_u32_e32 vcc, %1, %2\n\tv_addc_co_u32_e32 %0, vcc, 0, %0, vcc" : "+v"(c) : "v"(u), "v"(t) : "vcc"); }
__device__ __forceinline__ void cnt_gt(int& c, unsigned u, unsigned t) { asm("v_cmp_gt_u32_e32 vcc, %1, %2\n\tv_addc_co_u32_e32 %0, vcc, 0, %0, vcc" : "+v"(c) : "v"(u), "v"(t) : "vcc"); }
__device__ __forceinline__ void cnt_eq(int& c, unsigned u, unsigned t) { asm("v_cmp_eq_u32_e32 vcc, %1, %2\n\tv_addc_co_u32_e32 %0, vcc, 0, %0, vcc" : "+v"(c) : "v"(u), "v"(t) : "vcc"); }
__device__ __forceinline__ void cnt_lt4(int& cl, unsigned u0, unsigned u1, unsigned u2, unsigned u3, unsigned t) {
    int d0, d1, d2, d3;
    asm("v_sub_u32 %1, %5, %9\n\tv_sub_u32 %2, %6, %9\n\tv_sub_u32 %3, %7, %9\n\tv_sub_u32 %4, %8, %9\n\t"
        "v_lshrrev_b32 %1, 31, %1\n\tv_lshrrev_b32 %2, 31, %2\n\tv_lshrrev_b32 %3, 31, %3\n\tv_lshrrev_b32 %4, 31, %4\n\t"
        "v_add3_u32 %0, %0, %1, %2\n\tv_add3_u32 %0, %0, %3, %4"
        : "+v"(cl), "=&v"(d0), "=&v"(d1), "=&v"(d2), "=&v"(d3) : "v"(u0), "v"(u1), "v"(u2), "v"(u3), "v"(t));
}
__device__ __forceinline__ void cnt_eq_pos(int& c, unsigned u, unsigned t, int L) {
    int tmp;
    asm("v_cmp_eq_u32_e32 vcc, %2, %3\n\tv_cndmask_b32_e32 %1, %5, %4, vcc\n\tv_cmp_lt_i32_e32 vcc, 0, %1\n\tv_addc_co_u32_e32 %0, vcc, 0, %0, vcc"
        : "+v"(c), "=&v"(tmp) : "v"(u), "v"(t), "v"(L), "v"(0x80000000) : "vcc");
}
__device__ __forceinline__ int wave_sum_i_dpp(int v) {
    v += __builtin_amdgcn_update_dpp(0, v, 0xB1, 0xF, 0xF, false);
    v += __builtin_amdgcn_update_dpp(0, v, 0x4E, 0xF, 0xF, false);
    v += __builtin_amdgcn_update_dpp(0, v, 0x141, 0xF, 0xF, false);
    v += __builtin_amdgcn_update_dpp(0, v, 0x140, 0xF, 0xF, false);
    v += __builtin_amdgcn_update_dpp(0, v, 0x142, 0xA, 0xF, false);
    v += __builtin_amdgcn_update_dpp(0, v, 0x143, 0xC, 0xF, false);
    return __builtin_amdgcn_readlane(v, 63);
}
template <int NV> __device__ __forceinline__ void select_threshold(const unsigned (&u)[NV], int ksel, int idx_bits, int lane, unsigned& T_out, int& Jx_out, int& ngt_out) {
    unsigned T = 0;
#pragma unroll 1
    for (int bit = 31; bit >= 0; --bit) {
        const unsigned cand = T | (1u << bit);
        int c = 0;
#pragma unroll
        for (int i = 0; i < NV; ++i) cnt_ge(c, u[i], cand);
        c = wave_sum_i_dpp(c);
        if (c >= ksel) T = cand;
    }
    int cg = 0, ce = 0;
#pragma unroll
    for (int i = 0; i < NV; ++i) { cnt_gt(cg, u[i], T); cnt_eq(ce, u[i], T); }
    const int ngt = wave_sum_i_dpp(cg), neq = wave_sum_i_dpp(ce);
    const int need = ksel - ngt;
    int Jx = 0x3FFFFFFF;
    if (need < neq) {
        int Jb = 0;
#pragma unroll 1
        for (int bit = idx_bits - 1; bit >= 0; --bit) {
            const int cand = Jb | (1 << bit);
            const int L = cand - lane;
            int c = 0;
#pragma unroll
            for (int i = 0; i < NV; ++i) cnt_eq_pos(c, u[i], T, L - 64 * i);
            c = wave_sum_i_dpp(c);
            if (c < need) Jb = cand;
        }
        Jx = Jb + 1;
    }
    T_out = T; Jx_out = Jx; ngt_out = ngt;
}
template <int NV> __device__ __forceinline__ void select_threshold2(const unsigned (&ua)[NV], const unsigned (&ub)[NV], int ksel, int idx_bits, int lane, int ng,
                                                                   unsigned& Ta_out, int& Jxa_out, unsigned& Tb_out, int& Jxb_out) {
    unsigned Ta = 0, Tb = 0;
    bool da = false, db = false;
#pragma unroll 1
    for (int bit = 30; bit >= 0 && !(da && db); --bit) {
        const unsigned ca = da ? Ta : (Ta | (1u << bit)), cb = db ? Tb : (Tb | (1u << bit));
        int la = 0, lb = 0;
#pragma unroll
        for (int i = 0; i < NV; i += 4) { if (i < 4 * ng) { cnt_lt4(la, ua[i], ua[i + 1], ua[i + 2], ua[i + 3], ca); cnt_lt4(lb, ub[i], ub[i + 1], ub[i + 2], ub[i + 3], cb); } }
        const int na = ng * 256 - wave_sum_i_dpp(la), nb = ng * 256 - wave_sum_i_dpp(lb);
        if (!da && na >= ksel) { Ta = ca; da = (na == ksel); }
        if (!db && nb >= ksel) { Tb = cb; db = (nb == ksel); }
    }
    int ga = 0, ea = 0, gb = 0, eb = 0;
#pragma unroll
    for (int i = 0; i < NV; ++i) { cnt_gt(ga, ua[i], Ta); cnt_eq(ea, ua[i], Ta); cnt_gt(gb, ub[i], Tb); cnt_eq(eb, ub[i], Tb); }
    const int needa = ksel - wave_sum_i_dpp(ga), neqa = wave_sum_i_dpp(ea), needb = ksel - wave_sum_i_dpp(gb), neqb = wave_sum_i_dpp(eb);
    int Jxa = 0x3FFFFFFF, Jxb = 0x3FFFFFFF;
    if (needa < neqa) {
        int Jb = 0;
#pragma unroll 1
        for (int bit = idx_bits - 1; bit >= 0; --bit) {
            const int cand = Jb | (1 << bit); const int L = cand - lane; int c = 0;
#pragma unroll
            for (int i = 0; i < NV; ++i) cnt_eq_pos(c, ua[i], Ta, L - 64 * i);
            if (wave_sum_i_dpp(c) < needa) Jb = cand;
        }
        Jxa = Jb + 1;
    }
    if (needb < neqb) {
        int Jb = 0;
#pragma unroll 1
        for (int bit = idx_bits - 1; bit >= 0; --bit) {
            const int cand = Jb | (1 << bit); const int L = cand - lane; int c = 0;
#pragma unroll
            for (int i = 0; i < NV; ++i) cnt_eq_pos(c, ub[i], Tb, L - 64 * i);
            if (wave_sum_i_dpp(c) < needb) Jb = cand;
        }
        Jxb = Jb + 1;
    }
    Ta_out = Ta; Jxa_out = Jxa; Tb_out = Tb; Jxb_out = Jxb;
}
template <int NV> __device__ __forceinline__ void select_topk(const unsigned (&u)[NV], int ksel, int idx_bits, int* sel, int lane) {
    unsigned T; int Jx, ngt;
    select_threshold<NV>(u, ksel, idx_bits, lane, T, Jx, ngt);
    const int L = Jx - lane;
    int cg = 0, ct = 0;
#pragma unroll
    for (int i = 0; i < NV; ++i) { cnt_gt(cg, u[i], T); cnt_eq_pos(ct, u[i], T, L - 64 * i); }
    int ig = cg, it = ct;
#pragma unroll
    for (int o = 1; o < 64; o <<= 1) { const int a = __shfl_up(ig, o), b2 = __shfl_up(it, o); if (lane >= o) { ig += a; it += b2; } }
    int pg = ig - cg, pt = ngt + it - ct;
    int ev = lane, Lr = L;
#pragma unroll
    for (int i = 0; i < NV; ++i) {
        if (u[i] > T) { sel[pg] = ev; ++pg; }
        else if (u[i] == T && Lr > 0) { sel[pt] = ev; ++pt; }
        asm volatile("v_add_u32 %0, 64, %0\n\tv_add_u32 %1, -64, %1" : "+v"(ev), "+v"(Lr));
    }
}

constexpr int PU_MB = 16 * SROW * 4;
constexpr int PU_RB = PU_MB + 16 * 64 * 4;
constexpr int PU_BT = PU_RB + 1024;
constexpr int PU_QT = PU_BT + 512, PU_QROW = 1040;
__device__ __forceinline__ int kappa32(int r) { return (r & 0x13) | ((r & 4) << 1) | ((r & 8) >> 1); }
__device__ __forceinline__ void p3_prompt_fused_unit(const Frame& F, const bf16_t* VT, int b, int qt) {
    LAS float* S = (LAS float*)F.lds;
    LAS unsigned* MB = (LAS unsigned*)(F.lds + PU_MB);
    LAS float* RB = (LAS float*)(F.lds + PU_RB);
    LAS int* BT = (LAS int*)(F.lds + PU_BT);
    const int lane = F.lane;
    const int q0 = qt * 16; const size_t tok0 = (size_t)b * SEQ;
    __syncthreads();
    for (int ch = F.tid; ch < 16 * 64; ch += NTHREADS) {
        const u32x4 qv = *(const u32x4*)(F.PROJ + (tok0 + q0 + (ch >> 6)) * NMIXP + C_Q + (ch & 63) * 8);
        constexpr float QS = ATTN_SCALE * 1.4426950408889634f;
        *(LAS u32x4*)(F.lds + PU_QT + (ch >> 6) * PU_QROW + (ch & 63) * 16) = (u32x4){cvt_pk_bf16(bflo(qv[0]) * QS, bfhi(qv[0]) * QS), cvt_pk_bf16(bflo(qv[1]) * QS, bfhi(qv[1]) * QS),
                                                                                    cvt_pk_bf16(bflo(qv[2]) * QS, bfhi(qv[2]) * QS), cvt_pk_bf16(bflo(qv[3]) * QS, bfhi(qv[3]) * QS)};
    }
    {
        const int r = lane & 15, q4 = lane >> 4;
        bf16x8 A[4][2];
#pragma unroll
        for (int hh = 0; hh < 4; ++hh)
#pragma unroll
            for (int s2 = 0; s2 < 2; ++s2) A[hh][s2] = *(const bf16x8*)(F.PROJ + (tok0 + q0 + r) * NMIXP + C_QI + hh * 64 + s2 * 32 + q4 * 8);
        float wv[4][4];
#pragma unroll
        for (int g = 0; g < 4; ++g) { const f32x4 w4 = *(const f32x4*)(F.WI + (tok0 + q0 + 4 * q4 + g) * 4);
#pragma unroll
            for (int hh = 0; hh < 4; ++hh) wv[g][hh] = w4[hh] * IDX_SCALE; }
        const int nkt = qt + 1;
        bf16x8 Bn[2][2];
        {
            const int t0 = 2 * F.wave;
#pragma unroll
            for (int p = 0; p < 2; ++p)
#pragma unroll
                for (int s2 = 0; s2 < 2; ++s2) { const int key = (t0 + p < nkt ? t0 + p : 0) * 16 + r; Bn[p][s2] = *(const bf16x8*)(F.PROJ + (tok0 + key) * NMIXP + C_KI + s2 * 32 + q4 * 8); }
        }
#pragma unroll 1
        for (int t0 = 2 * F.wave; t0 < nkt; t0 += 16) {
            bf16x8 B[2][2] = {{Bn[0][0], Bn[0][1]}, {Bn[1][0], Bn[1][1]}};
            {
                const int tn = t0 + 16;
#pragma unroll
                for (int p = 0; p < 2; ++p)
#pragma unroll
                    for (int s2 = 0; s2 < 2; ++s2) { const int key = (tn + p < nkt ? tn + p : 0) * 16 + r; Bn[p][s2] = *(const bf16x8*)(F.PROJ + (tok0 + key) * NMIXP + C_KI + s2 * 32 + q4 * 8); }
            }
#pragma unroll
            for (int p = 0; p < 2; ++p) {
                if (t0 + p >= nkt) continue;
                float sc[4] = {0.f, 0.f, 0.f, 0.f};
#pragma unroll
                for (int hh = 0; hh < 4; ++hh) {
                    f32x4 c = {0.f, 0.f, 0.f, 0.f};
                    c = __builtin_amdgcn_mfma_f32_16x16x32_bf16(A[hh][0], B[p][0], c, 0, 0, 0);
                    c = __builtin_amdgcn_mfma_f32_16x16x32_bf16(A[hh][1], B[p][1], c, 0, 0, 0);
#pragma unroll
                    for (int g = 0; g < 4; ++g) sc[g] += fmaxf(c[g], 0.f) * wv[g][hh];
                }
#pragma unroll
                for (int g = 0; g < 4; ++g) S[(4 * q4 + g) * SROW + (t0 + p) * 16 + r] = sc[g];
            }
        }
    }
    __syncthreads();
    {
        const int rowa = F.wave * 2, rowb = rowa + 1;
        const int nva = q0 + rowa + 1, nvb = nva + 1;
        if (nvb <= NSEL) {
#pragma unroll
            for (int i = 0; i < 32; ++i) {
                const unsigned long long ma = __ballot(lane + 64 * i < nva), mb = __ballot(lane + 64 * i < nvb);
                if (lane == 0) { MB[rowa * 64 + 2 * i] = (unsigned)ma; MB[rowa * 64 + 2 * i + 1] = (unsigned)(ma >> 32); MB[rowb * 64 + 2 * i] = (unsigned)mb; MB[rowb * 64 + 2 * i + 1] = (unsigned)(mb >> 32); }
            }
        } else {
            unsigned ua[32], ub[32];
#pragma unroll
            for (int i = 0; i < 32; ++i) { const int j = lane + 64 * i; ua[i] = (j < nva) ? (f2ord(S[rowa * SROW + j]) >> 1) : 0u; ub[i] = (j < nvb) ? (f2ord(S[rowb * SROW + j]) >> 1) : 0u; }
            unsigned Ta, Tb; int Jxa, Jxb;
            select_threshold2<32>(ua, ub, NSEL, 11, lane, (nvb + 255) >> 8, Ta, Jxa, Tb, Jxb);
            const int La = Jxa - lane, Lb = Jxb - lane;
#pragma unroll
            for (int i = 0; i < 32; ++i) {
                const bool ta = (ua[i] > Ta) || (ua[i] == Ta && (La - 64 * i) > 0), tb = (ub[i] > Tb) || (ub[i] == Tb && (Lb - 64 * i) > 0);
                const unsigned long long ma = __ballot(ta), mb = __ballot(tb);
                if (lane == 0) { MB[rowa * 64 + 2 * i] = (unsigned)ma; MB[rowa * 64 + 2 * i + 1] = (unsigned)(ma >> 32); MB[rowb * 64 + 2 * i] = (unsigned)mb; MB[rowb * 64 + 2 * i + 1] = (unsigned)(mb >> 32); }
            }
        }
    }
    __syncthreads();
    {
        const int g = F.wave & 1, kq = F.wave >> 1;
        const int c = lane & 31, h = lane >> 5;
        const int hd = g * 4 + (c & 3);
        LAS const unsigned char* Qb = F.lds + PU_QT + (c >> 2) * PU_QROW + (hd * 64 + h * 8) * 2;
        constexpr float L2E = 1.4426950408889634f;
        const float b31 = RB[31 * 8 + hd] * L2E;
        const int ntile = ((q0 + 15) >> 5) + 1;
        const bf16_t* Kb = F.PROJ + (tok0 + kappa32(c)) * NMIXP + C_K + g * 64 + h * 8;
        const bf16_t* Vb = VT + ((size_t)((b * 2 + g) * 64 + c)) * SEQ + h * 8;
        f32x16 O[2][2];
#pragma unroll
        for (int rt = 0; rt < 2; ++rt)
#pragma unroll
            for (int d = 0; d < 2; ++d)
#pragma unroll
                for (int e = 0; e < 16; ++e) O[rt][d][e] = 0.f;
        float lsum[2] = {0.f, 0.f};
        bf16x8 Kn[4];
        {
            const int key0 = (kq < ntile ? kq : 0) * 32;
#pragma unroll
            for (int s4 = 0; s4 < 4; ++s4) Kn[s4] = *(const bf16x8*)(Kb + (size_t)key0 * NMIXP + s4 * 16);
        }
#pragma unroll 1
        for (int kt = kq; kt < ntile; kt += 4) {
            const int key0 = kt * 32;
            bf16x8 Kf[4] = {Kn[0], Kn[1], Kn[2], Kn[3]}, Vf[2][2];
#pragma unroll
            for (int d = 0; d < 2; ++d)
#pragma unroll
                for (int s2 = 0; s2 < 2; ++s2) Vf[d][s2] = *(const bf16x8*)(Vb + (size_t)(32 * d) * SEQ + key0 + 16 * s2);
            {
                const int keyn = (kt + 4 < ntile ? kt + 4 : 0) * 32;
#pragma unroll
                for (int s4 = 0; s4 < 4; ++s4) Kn[s4] = *(const bf16x8*)(Kb + (size_t)keyn * NMIXP + s4 * 16);
            }
#pragma unroll
            for (int rt = 0; rt < 2; ++rt) {
                const int ql = rt * 8 + (c >> 2), q = q0 + ql;
                f32x16 X;
#pragma unroll
                for (int e = 0; e < 16; ++e) X[e] = 0.f;
#pragma unroll
                for (int s4 = 0; s4 < 4; ++s4) X = __builtin_amdgcn_mfma_f32_32x32x16_bf16(Kf[s4], *(LAS const bf16x8*)(Qb + rt * 8 * PU_QROW + s4 * 32), X, 0, 0, 0);
                const unsigned word = MB[ql * 64 + kt];
                const unsigned bits = ((word >> (8 * h)) & 0xFFu) | (((word >> (16 + 8 * h)) & 0xFFu) << 8);
                const bool nearT = (q0 + rt * 8) - (key0 + 31) < 113;
#pragma unroll
                for (int s2 = 0; s2 < 2; ++s2) {
                    float P[8];
                    if (nearT) {
#pragma unroll
                        for (int e8 = 0; e8 < 8; ++e8) {
                            const int e = 8 * s2 + e8;
                            const int key = key0 + e8 + 16 * s2 + 8 * h;
                            int dist = q - key; dist = dist < 0 ? 0 : (dist > 127 ? 127 : dist);
                            const float bias = RB[BT[dist] * 8 + hd] * L2E;
                            const float lg = fminf(X[e] + bias, 86.f);
                            P[e8] = __int_as_float(__float_as_int(__builtin_amdgcn_exp2f(lg)) & __builtin_amdgcn_sbfe((int)bits, e, 1));
                        }
                    } else {
#pragma unroll
                        for (int e8 = 0; e8 < 8; ++e8) {
                            const int e = 8 * s2 + e8;
                            const float lg = fminf(X[e] + b31, 86.f);
                            P[e8] = __int_as_float(__float_as_int(__builtin_amdgcn_exp2f(lg)) & __builtin_amdgcn_sbfe((int)bits, e, 1));
                        }
                    }
#pragma unroll
                    for (int e8 = 0; e8 < 8; ++e8) lsum[rt] += P[e8];
                    const u32x4 pk = (u32x4){cvt_pk_bf16(P[0], P[1]), cvt_pk_bf16(P[2], P[3]), cvt_pk_bf16(P[4], P[5]), cvt_pk_bf16(P[6], P[7])};
                    bf16x8 Pf; __builtin_memcpy(&Pf, &pk, 16);
                    O[rt][0] = __builtin_amdgcn_mfma_f32_32x32x16_bf16(Vf[0][s2], Pf, O[rt][0], 0, 0, 0);
                    O[rt][1] = __builtin_amdgcn_mfma_f32_32x32x16_bf16(Vf[1][s2], Pf, O[rt][1], 0, 0, 0);
                }
                __builtin_amdgcn_sched_barrier(0);
            }
        }
        LAS float* CB = (LAS float*)F.lds + (g * 3 + (kq > 0 ? kq - 1 : 0)) * (66 * 64);
        __syncthreads();
        if (kq > 0) {
#pragma unroll
            for (int rt = 0; rt < 2; ++rt) {
#pragma unroll
                for (int d = 0; d < 2; ++d)
#pragma unroll
                    for (int e = 0; e < 16; ++e) CB[((rt * 2 + d) * 16 + e) * 64 + lane] = O[rt][d][e];
                CB[(64 + rt) * 64 + lane] = lsum[rt];
            }
        }
        __syncthreads();
        if (kq == 0) {
#pragma unroll 1
            for (int p = 0; p < 3; ++p) {
                LAS const float* CP = (LAS const float*)F.lds + (g * 3 + p) * (66 * 64);
#pragma unroll
                for (int rt = 0; rt < 2; ++rt) {
#pragma unroll
                    for (int d = 0; d < 2; ++d)
#pragma unroll
                        for (int e = 0; e < 16; ++e) O[rt][d][e] += CP[((rt * 2 + d) * 16 + e) * 64 + lane];
                    lsum[rt] += CP[(64 + rt) * 64 + lane];
                }
            }
#pragma unroll
            for (int rt = 0; rt < 2; ++rt) {
                float l = lsum[rt]; l += __shfl_xor(l, 32);
                const float inv = 1.f / l;
                bf16_t* orow = F.OATT + (tok0 + q0 + rt * 8 + (c >> 2)) * 512 + hd * 64;
#pragma unroll
                for (int a4 = 0; a4 < 4; ++a4) {
                    const f32x4 v0 = (f32x4){O[rt][0][4 * a4], O[rt][0][4 * a4 + 1], O[rt][0][4 * a4 + 2], O[rt][0][4 * a4 + 3]} * inv;
                    const f32x4 v1 = (f32x4){O[rt][1][4 * a4], O[rt][1][4 * a4 + 1], O[rt][1][4 * a4 + 2], O[rt][1][4 * a4 + 3]} * inv;
                    *(u32x2*)(orow + 8 * a4 + 4 * h) = pk4(v0);
                    *(u32x2*)(orow + 32 + 8 * a4 + 4 * h) = pk4(v1);
                }
            }
        }
    }
}

__device__ __forceinline__ void p3_sample_score_unit(const Frame& F, float* SS, int b, int ch) {
    const int lane = F.lane, r = lane & 31, h = lane >> 5;
    bf16x8 A[4];
    { const int q = r >> 2, hh = r & 3;
#pragma unroll
      for (int s4 = 0; s4 < 4; ++s4) A[s4] = *(const bf16x8*)(F.PROJ + (size_t)(NTP + b * TS + q) * NMIXP + C_QI + hh * 64 + s4 * 16 + h * 8); }
    float wv[4][4];
#pragma unroll
    for (int g = 0; g < 4; ++g) { const f32x4 w4 = *(const f32x4*)(F.WI + (size_t)(NTP + b * TS + 2 * g + h) * 4);
#pragma unroll
        for (int hh = 0; hh < 4; ++hh) wv[g][hh] = w4[hh] * IDX_SCALE; }
    f32x4 kn[8];
    { const int key0 = ch * 1024 + F.wave * 32; const int page = F.page_table[b * NPAGES + (key0 >> 7)];
      const float* kr = F.cache_ki + ((size_t)page * PAGE + (key0 & 127) + r) * 64 + h * 8;
#pragma unroll
      for (int s4 = 0; s4 < 4; ++s4) { kn[2 * s4] = *(const f32x4*)(kr + s4 * 16); kn[2 * s4 + 1] = *(const f32x4*)(kr + s4 * 16 + 4); } }
#pragma unroll 1
    for (int tl = F.wave; tl < 32; tl += 8) {
        const int key0 = ch * 1024 + tl * 32;
        f32x4 kc[8];
#pragma unroll
        for (int i = 0; i < 8; ++i) kc[i] = kn[i];
        if (tl + 8 < 32) {
            const int keyn = key0 + 256; const int page = F.page_table[b * NPAGES + (keyn >> 7)];
            const float* kr = F.cache_ki + ((size_t)page * PAGE + (keyn & 127) + r) * 64 + h * 8;
#pragma unroll
            for (int s4 = 0; s4 < 4; ++s4) { kn[2 * s4] = *(const f32x4*)(kr + s4 * 16); kn[2 * s4 + 1] = *(const f32x4*)(kr + s4 * 16 + 4); }
        }
        f32x16 c;
#pragma unroll
        for (int e = 0; e < 16; ++e) c[e] = 0.f;
#pragma unroll
        for (int s4 = 0; s4 < 4; ++s4) {
            const f32x4 lo = kc[2 * s4], hi = kc[2 * s4 + 1];
            const u32x4 pk = (u32x4){cvt_pk_bf16(lo[0], lo[1]), cvt_pk_bf16(lo[2], lo[3]), cvt_pk_bf16(hi[0], hi[1]), cvt_pk_bf16(hi[2], hi[3])};
            bf16x8 Bf; __builtin_memcpy(&Bf, &pk, 16);
            c = __builtin_amdgcn_mfma_f32_32x32x16_bf16(A[s4], Bf, c, 0, 0, 0);
        }
#pragma unroll
        for (int g = 0; g < 4; ++g) {
            float sc = 0.f;
#pragma unroll
            for (int hh = 0; hh < 4; ++hh) sc += fmaxf(c[4 * g + hh], 0.f) * wv[g][hh];
            SS[(size_t)(b * TS + 2 * g + h) * PAST + key0 + r] = sc;
        }
    }
}
__device__ __forceinline__ void p3_index(const Frame& F) {
    constexpr int NSU = NB_S * 8;
    const int nunits = NSU + NB_P * (SEQ / 16);
    float* SS = (float*)(F.ws + WS_SS);
    const bf16_t* VT = (const bf16_t*)(F.ws + WS_VT);
    __syncthreads();
    if (F.tid < 256) ((LAS float*)(F.lds + PU_RB))[F.tid] = F.rel_bias[F.tid];
    if (F.tid < 128) ((LAS int*)(F.lds + PU_BT))[F.tid] = t5_bucket(F.tid);
    __syncthreads();
    for (int it = F.bid; it < nunits; it += F.G) {
        if (it < NSU) { p3_sample_score_unit(F, SS, it >> 3, it & 7); continue; }
        const int i = it - NSU; const int b = i & 7, sl = (i >> 3) & 31, rnd = i >> 8;
        const int qt = rnd == 0 ? 127 - sl : (rnd == 1 ? 64 + sl : (rnd == 2 ? 63 - sl : sl));
        p3_prompt_fused_unit(F, VT, b, qt);
    }
}

constexpr int SQ_CNT = 0;
constexpr int SQ_SEL = 1024;
constexpr int SQ_Q = 2048;
constexpr int SQ_PHYS = 3072;
constexpr int SQ_P = 4096;
constexpr int SQ_RB = 16384;
constexpr int SQ_BT = 17408;
__device__ __forceinline__ int wg_sum8(const Frame& F, LAS unsigned* slot, int v) {
    if (F.lane == 0) slot[F.wave] = (unsigned)v;
    __syncthreads();
    int t = 0;
#pragma unroll
    for (int w = 0; w < 8; ++w) t += (int)slot[w];
    return t;
}
__device__ __forceinline__ void p4_sample_query_unit(const Frame& F, const float* SS, int b, int t) {
    const int lane = F.lane, w = F.wave;
    LAS unsigned* CNT = (LAS unsigned*)(F.lds + SQ_CNT);
    LAS int* SELL = (LAS int*)(F.lds + SQ_SEL);
    LAS unsigned* QL = (LAS unsigned*)(F.lds + SQ_Q);
    LAS float* PL = (LAS float*)(F.lds + SQ_P) + w * 256;
    LAS float* RB = (LAS float*)(F.lds + SQ_RB);
    LAS int* BT = (LAS int*)(F.lds + SQ_BT);
    const int tok = NTP + b * TS + t;
    __syncthreads();
    if (F.tid < 256) QL[F.tid] = ((const unsigned*)(F.PROJ + (size_t)tok * NMIXP + C_Q))[F.tid];
    unsigned u[17];
    { const float* srow = SS + (size_t)(b * TS + t) * PAST + w * 1024;
#pragma unroll
      for (int i = 0; i < 16; ++i) u[i] = f2ord(srow[64 * i + lane]); }
    u[16] = 0u;
    if (w == 7) {
        const int kj = lane < TS ? lane : 0;
        const bf16_t* kn = F.PROJ + (size_t)(NTP + b * TS + kj) * NMIXP + C_KI;
        const bf16_t* qn = F.PROJ + (size_t)tok * NMIXP + C_QI;
        u32x4 kv[8];
#pragma unroll
        for (int c = 0; c < 8; ++c) kv[c] = *(const u32x4*)(kn + c * 8);
        int vz; asm volatile("v_mov_b32 %0, 0" : "=v"(vz));
        const f32x4 w4 = *(const f32x4*)(F.WI + (size_t)tok * 4 + vz);
        float sc = 0.f;
#pragma unroll
        for (int hh = 0; hh < 4; ++hh) {
            u32x4 qv[8];
#pragma unroll
            for (int c = 0; c < 8; ++c) qv[c] = *(const u32x4*)(qn + hh * 64 + c * 8 + vz);
            float d = 0.f;
#pragma unroll
            for (int c = 0; c < 8; ++c)
#pragma unroll
                for (int e = 0; e < 4; ++e) d += bflo(qv[c][e]) * bflo(kv[c][e]) + bfhi(qv[c][e]) * bfhi(kv[c][e]);
            sc += fmaxf(d, 0.f) * (w4[hh] * IDX_SCALE);
        }
        u[16] = (lane < TS && lane <= t) ? f2ord(sc) : 0u;
    }
    unsigned T = 0;
#pragma unroll 1
    for (int bit = 31; bit >= 0; --bit) {
        const unsigned cand = T | (1u << bit);
        int c = 0;
#pragma unroll
        for (int i = 0; i < 17; ++i) cnt_ge(c, u[i], cand);
        c = wg_sum8(F, CNT + (bit & 1) * 24, wave_sum_i_dpp(c));
        if (c >= NSEL) T = cand;
        if (c == NSEL) break;
    }
    int cg = 0, ce = 0;
#pragma unroll
    for (int i = 0; i < 17; ++i) { cnt_gt(cg, u[i], T); cnt_eq(ce, u[i], T); }
    const int cgw = wave_sum_i_dpp(cg);
    const int ngt = wg_sum8(F, CNT + 8, cgw);
    const int neq = wg_sum8(F, CNT + 16, wave_sum_i_dpp(ce));
    const int need = NSEL - ngt;
    int Jx = 0x3FFFFFFF;
    if (need < neq) {
        int Jb = 0;
#pragma unroll 1
        for (int bit = 13; bit >= 0; --bit) {
            const int cand = Jb | (1 << bit);
            const int L = cand - lane - 1024 * w;
            int c = 0;
#pragma unroll
            for (int i = 0; i < 17; ++i) cnt_eq_pos(c, u[i], T, L - 64 * i);
            c = wg_sum8(F, CNT + (bit & 1) * 24, wave_sum_i_dpp(c));
            if (c < need) Jb = cand;
        }
        Jx = Jb + 1;
    }
    {
        const int L = Jx - lane - 1024 * w;
        int ct = 0;
#pragma unroll
        for (int i = 0; i < 17; ++i) cnt_eq_pos(ct, u[i], T, L - 64 * i);
        const int ctw = wave_sum_i_dpp(ct);
        __syncthreads();
        if (lane == 0) { CNT[w] = (unsigned)cgw; CNT[8 + w] = (unsigned)ctw; }
        __syncthreads();
        int bg = 0, bt = ngt;
#pragma unroll
        for (int ww = 0; ww < 8; ++ww) { if (ww < w) { bg += (int)CNT[ww]; bt += (int)CNT[8 + ww]; } }
        int ig = cg, it2 = ct;
#pragma unroll
        for (int o = 1; o < 64; o <<= 1) { const int a = __shfl_up(ig, o), b2 = __shfl_up(it2, o); if (lane >= o) { ig += a; it2 += b2; } }
        int pg = bg + ig - cg, pt = bt + it2 - ct;
        int ev = 1024 * w + lane, Lr = L;
#pragma unroll
        for (int i = 0; i < 17; ++i) {
            if (u[i] > T) { SELL[pg] = ev; ++pg; }
            else if (u[i] == T && Lr > 0) { SELL[pt] = ev; ++pt; }
            asm volatile("v_add_u32 %0, 64, %0\n\tv_add_u32 %1, -64, %1" : "+v"(ev), "+v"(Lr));
        }
    }
    __syncthreads();
    LAS int* PHYS = (LAS int*)(F.lds + SQ_PHYS);
    if (F.tid < 256) { const int sraw = SELL[F.tid]; PHYS[F.tid] = (sraw < PAST) ? F.page_table[b * NPAGES + (sraw >> 7)] * PAGE + (sraw & 127) : -1 - (sraw - PAST); }
    __syncthreads();
    {
        const int hd = w, g = w >> 2, qpos = PAST + t;
        float lg[4];
#pragma unroll 2
        for (int i = 0; i < 4; ++i) {
            const int sraw = SELL[lane + 64 * i], ph = PHYS[lane + 64 * i];
            const float* kr = (ph >= 0) ? F.cache_k + (size_t)ph * 128 + g * 64 : F.out + O_KS + (size_t)(b * TS + (-1 - ph)) * 128 + g * 64;
            float a0 = 0.f, a1 = 0.f;
#pragma unroll
            for (int c = 0; c < 16; ++c) {
                const f32x4 kv = *(const f32x4*)(kr + c * 4);
                const unsigned q0 = QL[hd * 32 + c * 2], q1 = QL[hd * 32 + c * 2 + 1];
                a0 += bflo(q0) * kv[0] + bfhi(q0) * kv[1]; a1 += bflo(q1) * kv[2] + bfhi(q1) * kv[3];
            }
            const int dist = qpos - sraw; const int bk = dist < 128 ? BT[dist] : 31;
            lg[i] = (a0 + a1) * ATTN_SCALE + RB[bk * 8 + hd];
        }
        float m = fmaxf(fmaxf(lg[0], lg[1]), fmaxf(lg[2], lg[3])); m = wave_max(m);
        float sm = 0.f;
#pragma unroll
        for (int i = 0; i < 4; ++i) { lg[i] = __expf(lg[i] - m); sm += lg[i]; }
        const float inv = 1.f / wave_sum_dpp(sm);
#pragma unroll
        for (int i = 0; i < 4; ++i) PL[lane + 64 * i] = lg[i] * inv;
        const int dq = lane & 15, ks = lane >> 4;
        f32x4 o4 = {0.f, 0.f, 0.f, 0.f};
#pragma unroll 1
        for (int j0 = 0; j0 < 256; j0 += 64) {
            f32x4 vv[16]; float pp[16];
#pragma unroll
            for (int jj = 0; jj < 16; ++jj) {
                const int j = j0 + jj * 4 + ks;
                const int ph = PHYS[j]; pp[jj] = PL[j];
                const float* vr = (ph >= 0) ? F.cache_v + (size_t)ph * 128 + g * 64 : F.out + O_VS + (size_t)(b * TS + (-1 - ph)) * 128 + g * 64;
                vv[jj] = *(const f32x4*)(vr + 4 * dq);
            }
#pragma unroll
            for (int jj = 0; jj < 16; ++jj) o4 += vv[jj] * pp[jj];
        }
#pragma unroll
        for (int e = 0; e < 4; ++e) { o4[e] += __shfl_xor(o4[e], 16); o4[e] += __shfl_xor(o4[e], 32); }
        if (ks == 0) *(u32x2*)(F.OATT + (size_t)tok * 512 + hd * 64 + 4 * dq) = pk4(o4);
    }
}
__device__ __forceinline__ void p4_attention(const Frame& F) {
    const float* SS = (const float*)(F.ws + WS_SS);
    __syncthreads();
    if (F.tid < 256) ((LAS float*)(F.lds + SQ_RB))[F.tid] = F.rel_bias[F.tid];
    if (F.tid < 128) ((LAS int*)(F.lds + SQ_BT))[F.tid] = t5_bucket(F.tid);
    __syncthreads();
    for (int it = F.bid; it < NTS; it += F.G) p4_sample_query_unit(F, SS, it >> 3, it & 7);
    {
        const int c0 = F.lane * 8;
        float cw0[8], cw1[8], cw2[8], cbv[8];
#pragma unroll
        for (int e = 0; e < 8; ++e) { cw0[e] = F.conv_w[c0 + e]; cw1[e] = F.conv_w[512 + c0 + e]; cw2[e] = F.conv_w[1024 + c0 + e]; cbv[e] = F.conv_b[c0 + e]; }
        const int stride = F.G * 8;
        u32x4 n_cg[3], n_xi[3], n_bg;
        auto fetch = [&](int m) {
#pragma unroll
            for (int d = 0; d < 3; ++d) { const int mm = (m - d >= 0) ? m - d : 0; n_cg[d] = *(const u32x4*)(F.PROJ + (size_t)mm * NMIXP + C_CG + c0); n_xi[d] = *(const u32x4*)(F.PROJ + (size_t)mm * NMIXP + C_XIN + c0); }
            n_bg = *(const u32x4*)(F.PROJ + (size_t)m * NMIXP + C_BG + c0);
        };
        { const int m = F.bid * 8 + F.wave; fetch(m < NT ? m : 0); }
        for (int m = F.bid * 8 + F.wave; m < NT; m += stride) {
            u32x4 cg[3], xi[3]; const u32x4 bg = n_bg;
#pragma unroll
            for (int d = 0; d < 3; ++d) { cg[d] = n_cg[d]; xi[d] = n_xi[d]; }
            fetch(m + stride < NT ? m + stride : m);
            int t, T_, bsm; if (m < NTP) { t = m & 2047; T_ = SEQ; bsm = m >> 11; } else { t = (m - NTP) & 7; T_ = TS; bsm = (m - NTP) >> 3; }
            float u[3][8];
#pragma unroll
            for (int d = 0; d < 3; ++d) {
                if (t - d >= 0) {
#pragma unroll
                    for (int e = 0; e < 4; ++e) { u[d][2 * e] = bflo(cg[d][e]) * bflo(xi[d][e]); u[d][2 * e + 1] = bfhi(cg[d][e]) * bfhi(xi[d][e]); }
                } else if (m >= NTP) {
                    const float* pv = F.state_conv + ((size_t)bsm * 2 + (2 + t - d)) * 512 + c0;
#pragma unroll
                    for (int e = 0; e < 8; ++e) u[d][e] = pv[e];
                } else {
#pragma unroll
                    for (int e = 0; e < 8; ++e) u[d][e] = 0.f;
                }
            }
            float y[8];
#pragma unroll
            for (int e = 0; e < 8; ++e) {
                const float yy = cbv[e] + cw0[e] * u[2][e] + cw1[e] * u[1][e] + cw2[e] * u[0][e];
                const float bgv = (e & 1) ? bfhi(bg[e >> 1]) : bflo(bg[e >> 1]);
                y[e] = bgv * yy;
            }
            *(u32x4*)(F.OCONV + (size_t)m * 512 + c0) = (u32x4){cvt_pk_bf16(y[0], y[1]), cvt_pk_bf16(y[2], y[3]), cvt_pk_bf16(y[4], y[5]), cvt_pk_bf16(y[6], y[7])};
            if (t >= T_ - 2) {
                float* o = (m < NTP ? F.out + O_CP : F.out + O_CS) + ((size_t)bsm * 2 + (t - (T_ - 2))) * 512 + c0;
                const int rowi = (m < NTP) ? bsm * 2 + (t - (T_ - 2)) : 2 * NB_P + bsm * 2 + (t - (T_ - 2));
                const float* cx = (const float*)(F.ws + WS_CGX) + (size_t)rowi * 1024 + c0;
                const f32x4 ca = *(const f32x4*)cx, cb2 = *(const f32x4*)(cx + 4), xa = *(const f32x4*)(cx + 512), xb = *(const f32x4*)(cx + 516);
                *(f32x4*)o = ca * xa; *(f32x4*)(o + 4) = cb2 * xb;
            }
        }
    }
}

#define P5_EPI(A1, A2) { \
            const f32x4 va = ACC4(A1), vc = ACC4(A2); \
            const u32x2 ga = *(const u32x2*)(F.PROJ + (size_t)m * NMIXP + C_GA + n), gb = *(const u32x2*)(F.PROJ + (size_t)m * NMIXP + C_GB + n); \
            f32x4 o; \
            o[0] = sigmoidf_(bflo(ga[0])) * va[0] + sigmoidf_(bflo(gb[0])) * vc[0]; \
            o[1] = sigmoidf_(bfhi(ga[0])) * va[1] + sigmoidf_(bfhi(gb[0])) * vc[1]; \
            o[2] = sigmoidf_(bflo(ga[1])) * va[2] + sigmoidf_(bflo(gb[1])) * vc[2]; \
            o[3] = sigmoidf_(bfhi(ga[1])) * va[3] + sigmoidf_(bfhi(gb[1])) * vc[3]; \
            *(u32x2*)(F.MERGED + (size_t)m * D + n) = pk4(o); }
struct P5aBody {
    const Frame* Fp;
    __device__ __forceinline__ void operator()(int m, int n, const f32x4 v) const { *(u32x2*)(Fp->MERGED + (size_t)m * D + n) = pk4(v); }
};
struct P5bBody {
    const Frame* Fp;
    __device__ __forceinline__ void operator()(int m, int n, const f32x4 v) const {
        const Frame& F = *Fp;
        const u32x2 ga = *(const u32x2*)(F.PROJ + (size_t)m * NMIXP + C_GA + n), gb = *(const u32x2*)(F.PROJ + (size_t)m * NMIXP + C_GB + n);
        const u32x2 pa = *(const u32x2*)(F.MERGED + (size_t)m * D + n);
        const f32x4 o = (f32x4){sigmoidf_(bflo(ga[0])) * bflo(pa[0]) + sigmoidf_(bflo(gb[0])) * v[0], sigmoidf_(bfhi(ga[0])) * bfhi(pa[0]) + sigmoidf_(bfhi(gb[0])) * v[1],
                                sigmoidf_(bflo(ga[1])) * bflo(pa[1]) + sigmoidf_(bflo(gb[1])) * v[2], sigmoidf_(bfhi(ga[1])) * bfhi(pa[1]) + sigmoidf_(bfhi(gb[1])) * v[3]};
        *(u32x2*)(F.MERGED + (size_t)m * D + n) = pk4(o);
    }
};
__device__ __forceinline__ void p5_gemm_merge(const Frame& F) {
    {
        pg8::StaticOrder S; S.init(NTP, D, F.G, F.bid);
        { pg8::Gemm g{F.OATT, F.WOA, NTP, D, 512}; pg8::EpiRC<P5aBody> E{P5aBody{&F}}; pg8::gemm_phase<pg8::EpiRC<P5aBody>, pg8::StaticOrder, true, true>(F.lds, g, S, E); }
        asm volatile("s_waitcnt vmcnt(0)" ::: "memory"); __syncthreads();
        { pg8::Gemm g{F.OCONV, F.WOC, NTP, D, 512}; pg8::EpiRC<P5bBody> E{P5bBody{&F}}; pg8::gemm_phase<pg8::EpiRC<P5bBody>, pg8::StaticOrder, true, true>(F.lds, g, S, E); }
    }
    for (int sl = F.bid; sl < NTS / 8 * (D / BN); sl += F.G) {
        const int m0 = NTP + (sl >> 3) * 8, n0 = (sl & 7) * BN;
        f32x16 s1[1][1], s2[1][1];
        gemm_slice8(F, s1, F.OATT, 512, F.WOA, 512, 512, m0, n0);
        gemm_slice8(F, s2, F.OCONV, 512, F.WOC, 512, 512, m0, n0);
        SLICE_EPI_LOOP(P5_EPI(s1, s2))
    }
}
#define P6_EPI(A1) { \
            const f32x4 v = ACC4(A1); \
            const f32x4 xv = *(const f32x4*)(x_row(F, m) + n); \
            const f32x4 g1 = *(const f32x4*)(F.MOD + (size_t)mod_row(m) * 6144 + 2048 + n); \
            *(f32x4*)(F.T1 + (size_t)m * D + n) = xv * DN_ALPHA + g1 * v; }
struct P6Body {
    const Frame* Fp;
    __device__ __forceinline__ void operator()(int m, int n, const f32x4 v) const {
        const Frame& F = *Fp;
        const f32x4 xv = *(const f32x4*)(F.x_p + (size_t)m * D + n);
        const f32x4 g1 = *(const f32x4*)(F.MOD + (size_t)(m >> 11) * 6144 + 2048 + n);
        *(f32x4*)(F.T1 + (size_t)m * D + n) = xv * DN_ALPHA + g1 * v;
    }
};
__device__ __forceinline__ void p6_gemm_out(const Frame& F) {
    {
        pg8::Gemm g{F.MERGED, F.WOUT, NTP, D, D}; pg8::StaticOrder S; S.init(NTP, D, F.G, F.bid);
        pg8::EpiRC<P6Body> E{P6Body{&F}}; pg8::gemm_phase<pg8::EpiRC<P6Body>, pg8::StaticOrder, true, true>(F.lds, g, S, E);
    }
    for (int sl = F.bid; sl < NTS / 8 * (D / BN); sl += F.G) {
        const int m0 = NTP + (sl >> 3) * 8, n0 = (sl & 7) * BN;
        f32x16 s1[1][1];
        gemm_slice8(F, s1, F.MERGED, D, F.WOUT, D, D, m0, n0);
        SLICE_EPI_LOOP(P6_EPI(s1))
    }
}
__device__ __forceinline__ void p7_ln1(const Frame& F) {
    f32x4 lg[4], lb[4];
#pragma unroll
    for (int i = 0; i < 4; ++i) { const int e = (i >> 1) * 512 + F.lane * 8 + (i & 1) * 4; lg[i] = *(const f32x4*)(F.ln1_g + e); lb[i] = *(const f32x4*)(F.ln1_b + e); }
    const int stride = F.G * 8;
    f32x4 vn[4], scn[4], shn[4];
    {
        const int m = F.bid * 8 + F.wave; const float* mr = F.MOD + (size_t)mod_row(m < NT ? m : 0) * 6144;
#pragma unroll
        for (int i = 0; i < 4; ++i) { const int e = (i >> 1) * 512 + F.lane * 8 + (i & 1) * 4; vn[i] = *(const f32x4*)(F.T1 + (size_t)(m < NT ? m : 0) * D + e); scn[i] = *(const f32x4*)(mr + 4096 + e); shn[i] = *(const f32x4*)(mr + 3072 + e); }
    }
    for (int m = F.bid * 8 + F.wave; m < NT; m += stride) {
        float* tr = F.T1 + (size_t)m * D;
        f32x4 v[4], sc2[4], sh2[4]; float s = 0.f;
#pragma unroll
        for (int i = 0; i < 4; ++i) { v[i] = vn[i]; sc2[i] = scn[i]; sh2[i] = shn[i]; s += v[i][0] + v[i][1] + v[i][2] + v[i][3]; }
        {
            const int mn = (m + stride < NT) ? m + stride : m; const float* mrn = F.MOD + (size_t)mod_row(mn) * 6144;
#pragma unroll
            for (int i = 0; i < 4; ++i) { const int e = (i >> 1) * 512 + F.lane * 8 + (i & 1) * 4; vn[i] = *(const f32x4*)(F.T1 + (size_t)mn * D + e); scn[i] = *(const f32x4*)(mrn + 4096 + e); shn[i] = *(const f32x4*)(mrn + 3072 + e); }
        }
        const float mean = wave_sum(s) * (1.f / D);
        float q = 0.f;
#pragma unroll
        for (int i = 0; i < 4; ++i) { v[i] = v[i] - mean; q += v[i][0] * v[i][0] + v[i][1] * v[i][1] + v[i][2] * v[i][2] + v[i][3] * v[i][3]; }
        const float rstd = rsqrtf(wave_sum(q) * (1.f / D) + LN_EPS);
        f32x4 hv[2][2];
#pragma unroll
        for (int hlf = 0; hlf < 2; ++hlf) {
            const int e = hlf * 512 + F.lane * 8;
            f32x4 a = v[2 * hlf] * rstd * lg[2 * hlf] + lb[2 * hlf];
            f32x4 b = v[2 * hlf + 1] * rstd * lg[2 * hlf + 1] + lb[2 * hlf + 1];
            *(f32x4*)(tr + e) = a; *(f32x4*)(tr + e + 4) = b;
            const f32x4 ha = a * (sc2[2 * hlf] + 1.f) + sh2[2 * hlf];
            const f32x4 hb = b * (sc2[2 * hlf + 1] + 1.f) + sh2[2 * hlf + 1];
            *(u32x4*)(F.H2 + (size_t)m * D + e) = (u32x4){cvt_pk_bf16(ha[0], ha[1]), cvt_pk_bf16(ha[2], ha[3]), cvt_pk_bf16(hb[0], hb[1]), cvt_pk_bf16(hb[2], hb[3])};
            hv[hlf][0] = ha; hv[hlf][1] = hb;
        }
        float am = 0.f;
#pragma unroll
        for (int i = 0; i < 2; ++i)
#pragma unroll
            for (int j = 0; j < 2; ++j)
#pragma unroll
                for (int e = 0; e < 4; ++e) am = fmaxf(am, fabsf(hv[i][j][e]));
        am = wave_max(am);
        const float sc = am > 0.f ? 224.f / am : 1.f;
#pragma unroll
        for (int hlf = 0; hlf < 2; ++hlf) {
            int w0 = 0, w1 = 0;
            w0 = __builtin_amdgcn_cvt_pk_fp8_f32(hv[hlf][0][0] * sc, hv[hlf][0][1] * sc, w0, false); w0 = __builtin_amdgcn_cvt_pk_fp8_f32(hv[hlf][0][2] * sc, hv[hlf][0][3] * sc, w0, true);
            w1 = __builtin_amdgcn_cvt_pk_fp8_f32(hv[hlf][1][0] * sc, hv[hlf][1][1] * sc, w1, false); w1 = __builtin_amdgcn_cvt_pk_fp8_f32(hv[hlf][1][2] * sc, hv[hlf][1][3] * sc, w1, true);
            *(u32x2*)(F.ws + WS_H8 + (size_t)m * D + hlf * 512 + F.lane * 8) = (u32x2){(unsigned)w0, (unsigned)w1};
        }
        if (F.lane == 0) ((float*)(F.ws + WS_SH))[m] = am > 0.f ? am * (1.f / 224.f) : 1.f;
    }
}
struct P8Body {
    const Frame* Fp;
    __device__ __forceinline__ void operator()(int m, int n, const f32x4 v) const { *(u32x2*)(Fp->QP + (size_t)m * D + n) = pk4(v); }
};
__device__ __forceinline__ void p8_gemm_q(const Frame& F) {
    {
        pg8::Gemm g{F.H2, F.WQ, NTP, D, D}; pg8::StaticOrder S; S.init(NTP, D, F.G, F.bid);
        pg8::EpiRC<P8Body> E{P8Body{&F}}; pg8::gemm_phase<pg8::EpiRC<P8Body>, pg8::StaticOrder, true, true>(F.lds, g, S, E);
    }
    for (int sl = F.bid; sl < NTS / 8 * (D / BN); sl += F.G) {
        const int m0 = NTP + (sl >> 3) * 8, n0 = (sl & 7) * BN;
        f32x16 s1[1][1];
        gemm_slice8(F, s1, F.H2, D, F.WQ, D, D, m0, n0);
        SLICE_EPI_LOOP({ *(u32x2*)(F.QP + (size_t)m * D + n) = pk4(ACC4(s1)); })
    }
}
__device__ __forceinline__ void p9_row_top16(LAS float* row, LAS float* TV, LAS unsigned char* TI, int slot) {
    float gm[16];
#pragma unroll
    for (int gidx = 0; gidx < 16; ++gidx) {
        float m = row[gidx * 8];
#pragma unroll
        for (int k = 1; k < 8; ++k) m = fmaxf(m, row[gidx * 8 + k]);
        gm[gidx] = m;
    }
#pragma unroll 1
    for (int p = 0; p < 16; ++p) {
        float best = gm[0]; int bg = 0;
#pragma unroll
        for (int gidx = 1; gidx < 16; ++gidx) { const bool gt = gm[gidx] > best; best = gt ? gm[gidx] : best; bg = gt ? gidx : bg; }
        float v[8];
#pragma unroll
        for (int k = 0; k < 8; ++k) v[k] = row[bg * 8 + k];
        int bk = 7;
#pragma unroll
        for (int k = 6; k >= 0; --k) bk = (v[k] == best) ? k : bk;
        float nm = -INFINITY;
#pragma unroll
        for (int k = 0; k < 8; ++k) nm = fmaxf(nm, (k == bk) ? -INFINITY : v[k]);
        row[bg * 8 + bk] = -INFINITY;
#pragma unroll
        for (int gidx = 0; gidx < 16; ++gidx) gm[gidx] = (gidx == bg) ? nm : gm[gidx];
        TV[slot * 17 + p] = best; TI[slot * 17 + p] = (unsigned char)(bg * 8 + bk);
    }
}
__device__ __forceinline__ void p9_pair_top16(const Frame& F, LAS const float* TV, LAS const unsigned char* TI, int r1, int r2, int tok, int head) {
    float c[16];
    { const float v20 = TV[r2];
#pragma unroll
      for (int i = 0; i < 16; ++i) c[i] = TV[r1 + i] + v20; }
    unsigned long long ptrs = 0ull;
    float sv[16]; int se[16];
#pragma unroll
    for (int p = 0; p < 16; ++p) {
        float best = c[0]; int bi = 0;
#pragma unroll
        for (int i = 1; i < 16; ++i) { const bool gt = c[i] > best; best = gt ? c[i] : best; bi = gt ? i : bi; }
        const int bj = (int)((ptrs >> (4 * bi)) & 15ull);
        sv[p] = best; se[p] = (int)TI[r1 + bi] * 128 + (int)TI[r2 + bj];
        const float nv = (bj < 15) ? TV[r1 + bi] + TV[r2 + bj + 1] : -INFINITY;
        ptrs += (bj < 15) ? (1ull << (4 * bi)) : 0ull;
#pragma unroll
        for (int i = 0; i < 16; ++i) c[i] = (i == bi) ? nv : c[i];
    }
    const float mx0 = sv[0]; float den = 0.f;
#pragma unroll
    for (int p = 0; p < 16; ++p) { sv[p] = __expf(sv[p] - mx0); den += sv[p]; }
    const float dinv = 1.f / den;
    int* eo = F.EIDX + (size_t)tok * NEXP_SEL + head * 16; float* go = F.GW + (size_t)tok * NEXP_SEL + head * 16;
#pragma unroll
    for (int p = 0; p < 16; ++p) { eo[p] = se[p]; go[p] = sv[p] * dinv; }
}
constexpr int PR_ROW = 129, PR_ROWS = 256 + 4;
__device__ __forceinline__ void p9_route(const Frame& F) {
    LAS float* SC = (LAS float*)F.lds;
    LAS float* TV = (LAS float*)(F.lds + PR_ROWS * PR_ROW * 4);
    LAS unsigned char* TI = (LAS unsigned char*)(F.lds + PR_ROWS * PR_ROW * 4 + PR_ROWS * 17 * 4);
    const int lane = F.lane, r = lane & 31, h = lane >> 5;
    const int nunits = (NTP / 32) * 2;
    bf16x8 AkR[4][4];
    {
        const bf16_t* KK = (F.wave & 1) ? F.K2 : F.K1;
#pragma unroll
        for (int kt = 0; kt < 4; ++kt)
#pragma unroll
            for (int s = 0; s < 4; ++s) AkR[kt][s] = *(const bf16x8*)(KK + (size_t)(kt * 32 + r) * 64 + s * 16 + h * 8);
    }
    int k = 0;
    for (int it = F.bid; it < nunits; it += F.G, ++k) {
        const int tok0 = (it >> 1) * 32, hg = it & 1;
        const int ts = NTP + F.bid + F.G * (k >> 2), kh = k & 3;
        const bool has_s = ts < NT;
        __syncthreads();
        {
            const int head = hg * 4 + (F.wave >> 1), half = F.wave & 1;
            bf16x8 Bq[4], Bs[4];
#pragma unroll
            for (int s = 0; s < 4; ++s) Bq[s] = *(const bf16x8*)(F.QP + (size_t)(tok0 + r) * D + head * 128 + half * 64 + s * 16 + h * 8);
            const bool swave = has_s && F.wave < 4;
            if (swave) {
#pragma unroll
                for (int s = 0; s < 4; ++s) Bs[s] = *(const bf16x8*)(F.QP + (size_t)ts * D + (2 * kh + (F.wave >> 1)) * 128 + half * 64 + s * 16 + h * 8);
            }
#pragma unroll
            for (int kt = 0; kt < 4; ++kt) {
                f32x16 c, cs;
#pragma unroll
                for (int e = 0; e < 16; ++e) { c[e] = 0.f; cs[e] = 0.f; }
#pragma unroll
                for (int s = 0; s < 4; ++s) {
                    c = __builtin_amdgcn_mfma_f32_32x32x16_bf16(AkR[kt][s], Bq[s], c, 0, 0, 0);
                    if (swave) cs = __builtin_amdgcn_mfma_f32_32x32x16_bf16(AkR[kt][s], Bs[s], cs, 0, 0, 0);
                }
#pragma unroll
                for (int e = 0; e < 16; ++e) { const int key = kt * 32 + (e & 3) + 8 * (e >> 2) + 4 * h; SC[(F.wave * 32 + r) * PR_ROW + key] = c[e]; }
                if (swave && r == 0) {
#pragma unroll
                    for (int e = 0; e < 16; ++e) { const int key = kt * 32 + (e & 3) + 8 * (e >> 2) + 4 * h; SC[(256 + F.wave) * PR_ROW + key] = cs[e]; }
                }
            }
        }
        __syncthreads();
        if (F.tid < 256 || (has_s && F.tid < 260)) p9_row_top16(SC + F.tid * PR_ROW, TV, TI, F.tid);
        __syncthreads();
        if (F.tid < 128) {
            const int tk = F.tid >> 2, hs = F.tid & 3;
            const int r1 = (hs * 64 + tk) * 17;
            p9_pair_top16(F, TV, TI, r1, r1 + 32 * 17, tok0 + tk, hg * 4 + hs);
        } else if (has_s && F.tid < 130) {
            const int hs = F.tid - 128;
            const int r1 = (256 + hs * 2) * 17;
            p9_pair_top16(F, TV, TI, r1, r1 + 17, ts, 2 * kh + hs);
        }
    }
}

constexpr int TPW = 65, PAIRS_MAX = 9 * 128, PK = 4;
constexpr int P10_HROW = 1024 + 64;
constexpr int P10_H = 0;
constexpr int P10_SH = 32 * P10_HROW;
constexpr int P10_HIST = P10_SH + 128;
constexpr int P10_LIST = P10_HIST + 8 * 128 * 4;
typedef int i32x8 __attribute__((ext_vector_type(8)));
typedef __bf16 bf16x2v __attribute__((ext_vector_type(2)));
typedef short s16x4 __attribute__((ext_vector_type(4)));
__device__ __forceinline__ unsigned bf2u(bf16x2v v) { unsigned r; __builtin_memcpy(&r, &v, 4); return r; }
__device__ __forceinline__ void p10_peer(const Frame& F) {
    const int lane = F.lane, w = F.wave;
    unsigned char* ws = F.ws;
    const unsigned char* PU8 = ws + WS_PU8; const unsigned char* PV8 = ws + WS_PV8;
    const float* SU = (const float*)(ws + WS_SU); const float* SV = (const float*)(ws + WS_SV);
    const unsigned char* H8 = ws + WS_H8; const float* SH = (const float*)(ws + WS_SH);
  for (int blk = F.bid; blk < NT / TPW; blk += F.G) {
    const int tok0 = blk * TPW;
    LAS float* SHl = (LAS float*)(F.lds + P10_SH);
    LAS unsigned* SE = (LAS unsigned*)(F.lds + P10_LIST) + w * 1024; LAS float* SG = (LAS float*)(SE + 512);
    const int ntok = (w == 0) ? 9 : 8;
    const int r16 = lane & 15, q4 = lane >> 4;
#pragma unroll 1
    for (int pass = 0; pass < 3; ++pass) {
        const int kbase = pass * PK, nk = (ntok - kbase < PK) ? (ntok - kbase > 0 ? ntok - kbase : 0) : PK, npairs = nk * 128;
        __syncthreads();
        for (int c = F.tid; c < 32 * 64; c += NTHREADS) {
            const int row = c >> 6, tl = 32 * pass + row;
            if (tl < TPW) *(LAS u32x4*)(F.lds + P10_H + row * P10_HROW + (c & 63) * 16) = *(const u32x4*)(H8 + (size_t)(tok0 + tl) * D + (size_t)(c & 63) * 16);
        }
        if (F.tid < 32 && 32 * pass + F.tid < TPW) SHl[F.tid] = SH[tok0 + 32 * pass + F.tid];
        __syncthreads();
        if (nk <= 0) continue;
#pragma unroll
        for (int i = 0; i < 8; ++i) {
            const int p = lane + 64 * i;
            if (p < npairs) {
                const size_t gi_ = (size_t)(tok0 + w + 8 * (kbase + (p >> 7))) * NEXP_SEL + (p & 127);
                SE[p] = (unsigned)F.EIDX[gi_]; SG[p] = F.GW[gi_];
            }
        }
        asm volatile("s_waitcnt vmcnt(0) lgkmcnt(0)" ::: "memory");
        __builtin_amdgcn_wave_barrier();
        f32x4 acc[4][4];
#pragma unroll
        for (int k = 0; k < 4; ++k)
#pragma unroll
            for (int q = 0; q < 4; ++q) acc[k][q] = (f32x4){0.f, 0.f, 0.f, 0.f};
        const int ngr = npairs >> 4;
        const unsigned char* up = PU8 + q4 * 16;
        const int voff = lane * 8;
        const unsigned am0 = (lane & 3) == 0 ? 0x0000ffffu : ((lane & 3) == 1 ? 0xffff0000u : 0u);
        const unsigned am1 = (lane & 3) == 2 ? 0x0000ffffu : ((lane & 3) == 3 ? 0xffff0000u : 0u);
        u32x4 U[8]; u32x2 V[16]; float suv = 0.f, svv = 0.f;
#pragma unroll
        for (int t = 0; t < 8; ++t) U[t] = (u32x4){0u, 0u, 0u, 0u};
#pragma unroll
        for (int k = 0; k < 16; ++k) V[k] = (u32x2){0u, 0u};
#define P10_LOAD_U(WR) { const int er_ = (WR) & 16383; const unsigned char* ua_ = up + (size_t)er_ * 512; const float* sa_ = SU + er_; const float* sb_ = SV + er_; \
            asm volatile("global_load_dwordx4 %0, %1, off" : "+v"(U[0]) : "v"(ua_)); \
            asm volatile("global_load_dwordx4 %0, %1, off offset:64" : "+v"(U[1]) : "v"(ua_)); \
            asm volatile("global_load_dwordx4 %0, %1, off offset:128" : "+v"(U[2]) : "v"(ua_)); \
            asm volatile("global_load_dwordx4 %0, %1, off offset:192" : "+v"(U[3]) : "v"(ua_)); \
            asm volatile("global_load_dwordx4 %0, %1, off offset:256" : "+v"(U[4]) : "v"(ua_)); \
            asm volatile("global_load_dwordx4 %0, %1, off offset:320" : "+v"(U[5]) : "v"(ua_)); \
            asm volatile("global_load_dwordx4 %0, %1, off offset:384" : "+v"(U[6]) : "v"(ua_)); \
            asm volatile("global_load_dwordx4 %0, %1, off offset:448" : "+v"(U[7]) : "v"(ua_)); \
            asm volatile("global_load_dword %0, %1, off" : "+v"(suv) : "v"(sa_)); \
            asm volatile("global_load_dword %0, %1, off" : "+v"(svv) : "v"(sb_)); }
#define P10_LOAD_V(K, WR) { const unsigned char* ra_ = PV8 + (size_t)(__builtin_amdgcn_readlane((WR), (K)) & 16383) * 512; \
            asm volatile("global_load_dwordx2 %0, %1, %2" : "+v"(V[K]) : "v"(voff), "s"(ra_)); }
        int wr = (int)SE[r16]; float gr = SG[r16];
        P10_LOAD_U(wr)
        P10_LOAD_V(0, wr) P10_LOAD_V(1, wr) P10_LOAD_V(2, wr) P10_LOAD_V(3, wr) P10_LOAD_V(4, wr) P10_LOAD_V(5, wr) P10_LOAD_V(6, wr) P10_LOAD_V(7, wr)
        P10_LOAD_V(8, wr) P10_LOAD_V(9, wr) P10_LOAD_V(10, wr) P10_LOAD_V(11, wr) P10_LOAD_V(12, wr) P10_LOAD_V(13, wr) P10_LOAD_V(14, wr) P10_LOAD_V(15, wr)
#define P10_VQ(Q) { const unsigned b0_ = bf2u(__builtin_amdgcn_cvt_scalef32_pk_bf16_fp4(vv[(Q) >> 1], 1.0f, 2 * ((Q) & 1))); \
                    const unsigned b1_ = bf2u(__builtin_amdgcn_cvt_scalef32_pk_bf16_fp4(vv[(Q) >> 1], 1.0f, 2 * ((Q) & 1) + 1)); \
                    const u32x2 bb_ = {b0_, b1_}; s16x4 Bop_; __builtin_memcpy(&Bop_, &bb_, 8); \
                    acc[slot][Q] = __builtin_amdgcn_mfma_f32_4x4x4bf16_1k(Aop, Bop_, acc[slot][Q], 0, 0, 0); }
#define P10_VPAIR(K) { const float actk = __int_as_float(__builtin_amdgcn_readlane(actv, 16 * ((K) >> 2) + (K))); \
                       const unsigned wb_ = cvt_pk_bf16(actk, actk); \
                       const u32x2 ab_ = {wb_ & am0, wb_ & am1}; s16x4 Aop; __builtin_memcpy(&Aop, &ab_, 8); \
                       asm volatile("s_waitcnt vmcnt(25)" : "+v"(V[K])); \
                       const u32x2 vv = V[K]; \
                       P10_VQ(0) P10_VQ(1) P10_VQ(2) P10_VQ(3) \
                       P10_LOAD_V(K, wrn) }
#pragma unroll
        for (int slot = 0; slot < 4; ++slot) {
            if (slot >= nk) continue;
            LAS const unsigned char* hr0 = F.lds + P10_H + (w + 8 * slot) * P10_HROW + q4 * 16;
            const float shv = SHl[w + 8 * slot];
#pragma unroll 1
            for (int g8 = 0; g8 < 8; ++g8) {
                const int gi = slot * 8 + g8;
                const int gn = (gi + 1 < ngr) ? gi + 1 : 0;
                const int wrn = (int)SE[gn * 16 + r16]; const float grn = SG[gn * 16 + r16];
                LAS const unsigned char* hr = hr0;
                asm volatile("" : "+v"(hr));
                asm volatile("s_waitcnt vmcnt(16)" : "+v"(U[0]), "+v"(U[1]), "+v"(U[2]), "+v"(U[3]), "+v"(U[4]), "+v"(U[5]), "+v"(U[6]), "+v"(U[7]), "+v"(suv), "+v"(svv));
                f32x4 C0 = {0.f, 0.f, 0.f, 0.f}, C1 = {0.f, 0.f, 0.f, 0.f};
#pragma unroll
                for (int t = 0; t < 8; ++t) {
                    const u32x4 h0 = *(LAS const u32x4*)(hr + t * 128), h1 = *(LAS const u32x4*)(hr + t * 128 + 64);
                    const i32x8 Aop = {(int)h0[0], (int)h0[1], (int)h0[2], (int)h0[3], (int)h1[0], (int)h1[1], (int)h1[2], (int)h1[3]};
                    const i32x8 Bop = {(int)U[t][0], (int)U[t][1], (int)U[t][2], (int)U[t][3], 0, 0, 0, 0};
                    if (t & 1) C1 = __builtin_amdgcn_mfma_scale_f32_16x16x128_f8f6f4(Aop, Bop, C1, 0, 4, 0, 0x7f7f7f7f, 0, 0x7f7f7f7f);
                    else       C0 = __builtin_amdgcn_mfma_scale_f32_16x16x128_f8f6f4(Aop, Bop, C0, 0, 4, 0, 0x7f7f7f7f, 0, 0x7f7f7f7f);
                }
                C0 = C0 + C1;
                const int rsel = lane & 3;
                const float dv = (rsel == 0 ? C0[0] : (rsel == 1 ? C0[1] : (rsel == 2 ? C0[2] : C0[3]))) * (suv * shv);
                const int actv = __float_as_int(gelu_tanh(dv) * (gr * svv));
                P10_LOAD_U(wrn)
                P10_VPAIR(0) P10_VPAIR(1) P10_VPAIR(2) P10_VPAIR(3) P10_VPAIR(4) P10_VPAIR(5) P10_VPAIR(6) P10_VPAIR(7)
                P10_VPAIR(8) P10_VPAIR(9) P10_VPAIR(10) P10_VPAIR(11) P10_VPAIR(12) P10_VPAIR(13) P10_VPAIR(14) P10_VPAIR(15)
                wr = wrn; gr = grn;
            }
        }
#undef P10_VPAIR
#undef P10_VQ
        asm volatile("s_waitcnt vmcnt(0)" : "+v"(U[0]), "+v"(U[1]), "+v"(U[2]), "+v"(U[3]), "+v"(U[4]), "+v"(U[5]), "+v"(U[6]), "+v"(U[7]), "+v"(suv), "+v"(svv),
                     "+v"(V[0]), "+v"(V[1]), "+v"(V[2]), "+v"(V[3]), "+v"(V[4]), "+v"(V[5]), "+v"(V[6]), "+v"(V[7]),
                     "+v"(V[8]), "+v"(V[9]), "+v"(V[10]), "+v"(V[11]), "+v"(V[12]), "+v"(V[13]), "+v"(V[14]), "+v"(V[15]));
#undef P10_LOAD_U
#undef P10_LOAD_V
        float x1v[PK][16];
#pragma unroll
        for (int k = 0; k < PK; ++k) {
            const int m = tok0 + w + 8 * (kbase + (k < nk ? k : 0));
#pragma unroll
            for (int c = 0; c < 16; ++c) x1v[k][c] = F.T1[(size_t)m * D + c * 64 + lane];
        }
#pragma unroll
        for (int k = 0; k < PK; ++k) {
            if (k >= nk) continue;
            const int m = tok0 + w + 8 * (kbase + k);
            const float* mr = F.MOD + (size_t)mod_row(m) * 6144 + 5120;
            float tv[16]; float s = 0.f;
#pragma unroll
            for (int c = 0; c < 16; ++c) { const float t = x1v[k][c] * DN_ALPHA + mr[c * 64 + lane] * acc[k][c >> 2][c & 3]; tv[c] = t; s += t; }
            const float mean = wave_sum(s) * (1.f / D);
            float q = 0.f;
#pragma unroll
            for (int c = 0; c < 16; ++c) { tv[c] -= mean; q += tv[c] * tv[c]; }
            const float rstd = rsqrtf(wave_sum(q) * (1.f / D) + LN_EPS);
            float* yo = (m < NTP) ? F.out + O_YP + (size_t)m * D : F.out + O_YS + (size_t)(m - NTP) * D;
#pragma unroll
            for (int c = 0; c < 16; ++c) yo[c * 64 + lane] = tv[c] * rstd * F.ln2_g[c * 64 + lane] + F.ln2_b[c * 64 + lane];
        }
    }
  }
}

constexpr int N_PHASES = 11;
__global__ void __launch_bounds__(NTHREADS, 2) fwd_kernel(Args args) {
    extern __shared__ __attribute__((aligned(16))) unsigned char lds_raw[];
    Frame F;
    F.lds = (LAS unsigned char*)lds_raw;
    F.tid = threadIdx.x; F.lane = F.tid & 63; F.wave = __builtin_amdgcn_readfirstlane(F.tid >> 6); F.G = gridDim.x; F.bid = blockIdx.x;
    F.x_p = (const float*)args.in[0]; F.x_s = (const float*)args.in[1]; F.c_p = (const float*)args.in[2]; F.c_s = (const float*)args.in[3];
    F.cache_k = (const float*)args.in[4]; F.cache_v = (const float*)args.in[5]; F.cache_ki = (const float*)args.in[6]; F.state_conv = (const float*)args.in[7];
    F.page_table = (const int*)args.in[8]; F.rel_bias = (const float*)args.in[9]; F.w_ada = (const float*)args.in[10]; F.b_ada = (const float*)args.in[11];
    F.w_in = (const float*)args.in[12]; F.conv_w = (const float*)args.in[13]; F.conv_b = (const float*)args.in[14]; F.w_o_attn = (const float*)args.in[15];
    F.w_o_conv = (const float*)args.in[16]; F.w_out = (const float*)args.in[17]; F.ln1_g = (const float*)args.in[18]; F.ln1_b = (const float*)args.in[19];
    F.ln2_g = (const float*)args.in[20]; F.ln2_b = (const float*)args.in[21]; F.peer_wq = (const float*)args.in[22]; F.peer_k1 = (const float*)args.in[23];
    F.peer_k2 = (const float*)args.in[24]; F.peer_u = (const float*)args.in[25]; F.peer_v = (const float*)args.in[26];
    F.out = args.out;
    unsigned char* ws = args.ws; F.ws = ws;
    F.MOD = (float*)(ws + WS_MOD); F.WIN = (bf16_t*)(ws + WS_WIN); F.WOA = (bf16_t*)(ws + WS_WOA); F.WOC = (bf16_t*)(ws + WS_WOC);
    F.WOUT = (bf16_t*)(ws + WS_WOUT); F.WQ = (bf16_t*)(ws + WS_WQ); F.K1 = (bf16_t*)(ws + WS_K1); F.K2 = (bf16_t*)(ws + WS_K2);
    F.PU = (bf16_t*)(ws + WS_PU); F.PV = (bf16_t*)(ws + WS_PV); F.H1 = (bf16_t*)(ws + WS_H1); F.PROJ = (bf16_t*)(ws + WS_PROJ);
    F.WI = (float*)(ws + WS_WI); F.SEL = (int*)(ws + WS_SEL); F.OATT = (bf16_t*)(ws + WS_OATT); F.OCONV = (bf16_t*)(ws + WS_OCONV);
    F.MERGED = (bf16_t*)(ws + WS_MERGED); F.T1 = (float*)(ws + WS_T1); F.H2 = (bf16_t*)(ws + WS_H2); F.QP = (bf16_t*)(ws + WS_QP);
    F.EIDX = (int*)(ws + WS_EIDX); F.GW = (float*)(ws + WS_GW);
    volatile LAS unsigned* misc = (volatile LAS unsigned*)(F.lds + LDS_MISC);
    if (F.tid < 16) misc[F.tid] = 0u;
    __syncthreads();
    XcdBarrier bar; bar.bar = (unsigned*)(ws + WS_CTL); bar.x = 0; bar.st = misc;
    const int lo = args.ph_lo, hi = args.ph_hi;
    if (hi - lo > 1) bar = xcd_barrier_post((unsigned*)(ws + WS_CTL), misc);
#define IN(k) (lo <= (k) && (k) < hi)
#define SEAM(k) do { if (IN(k) && IN((k) + 1)) xcd_barrier(bar); } while (0)
    if (IN(0)) p0_prologue(F);       SEAM(0);
    if (IN(1)) p1_modulate(F);       SEAM(1);
    if (IN(2)) p2_gemm_in(F);        SEAM(2);
    if (IN(3)) p3_index(F);          SEAM(3);
    if (IN(4)) p4_attention(F);      SEAM(4);
    if (IN(5)) p5_gemm_merge(F);     SEAM(5);
    if (IN(6)) p6_gemm_out(F);       SEAM(6);
    if (IN(7)) p7_ln1(F);            SEAM(7);
    if (IN(8)) p8_gemm_q(F);         SEAM(8);
    if (IN(9)) p9_route(F);          SEAM(9);
    if (IN(10)) p10_peer(F);
#undef IN
#undef SEAM
}

extern "C" void kernel_launch(void* const* d_in, const int* in_sizes, int n_in, void* d_out, int out_size, void* d_ws, size_t ws_size, hipStream_t stream) {
    static int grid = 0;
    if (grid == 0) {
        if (n_in != 27 || (size_t)out_size != O_END || ws_size < WS_END) { fprintf(stderr, "kernel_launch: unexpected shapes (n_in %d out %d ws %zu)\n", n_in, out_size, ws_size); grid = -1; return; }
        int dev = 0, cus = 0;
        if (hipGetDevice(&dev) != hipSuccess || hipDeviceGetAttribute(&cus, hipDeviceAttributeMultiprocessorCount, dev) != hipSuccess) { grid = -1; return; }
        if (hipFuncSetAttribute((const void*)fwd_kernel, hipFuncAttributeMaxDynamicSharedMemorySize, LDS_BYTES) != hipSuccess) { fprintf(stderr, "kernel_launch: hipFuncSetAttribute failed\n"); grid = -1; return; }
        (void)hipGetLastError();
        grid = cus < 256 ? cus : 256;
    }
    if (grid < 0) return;
    (void)hipMemsetAsync((char*)d_ws + WS_CTL, 0, CTL_ZERO_BYTES, stream);
    Args a{};
    for (int i = 0; i < 27; ++i) a.in[i] = d_in[i];
    a.out = (float*)d_out; a.ws = (unsigned char*)d_ws;
#if N_LAUNCHES == 1
    a.ph_lo = 0; a.ph_hi = N_PHASES;
    hipLaunchKernelGGL(fwd_kernel, dim3(grid), dim3(NTHREADS), LDS_BYTES, stream, a);
#else
    for (int p = 0; p < N_PHASES; ++p) { a.ph_lo = p; a.ph_hi = p + 1; hipLaunchKernelGGL(fwd_kernel, dim3(grid), dim3(NTHREADS), LDS_BYTES, stream, a); }
#endif
}
```

```cpp
#include <hip/hip_runtime.h>
#include <cstdio>
#include <cstdint>

#ifndef N_LAUNCHES
#define N_LAUNCHES 1
#endif

typedef unsigned short bf16_t;
typedef short bf16x8 __attribute__((ext_vector_type(8)));
typedef float f32x4 __attribute__((ext_vector_type(4)));
typedef float f32x16 __attribute__((ext_vector_type(16)));
typedef unsigned u32x4 __attribute__((ext_vector_type(4)));
typedef unsigned u32x2 __attribute__((ext_vector_type(2)));
#define LAS __attribute__((address_space(3)))

constexpr int D = 1024, NB_P = 8, SEQ = 2048, NB_S = 32, TS = 8, PAST = 8192, PAGE = 128, NPAGES = 64;
constexpr int NTP = NB_P * SEQ;
constexpr int NTS = NB_S * TS;
constexpr int NT = NTP + NTS;
constexpr int NMIX = 4676, NMIXP = 4736;
constexpr int C_Q = 0, C_K = 512, C_V = 640, C_QI = 768, C_KI = 1024, C_BG = 1088, C_CG = 1600, C_XIN = 2112, C_GA = 2624, C_GB = 3648, C_WI = 4672;
constexpr int NSEL = 256;
constexpr float ATTN_SCALE = 0.125f, IDX_SCALE = 0.0625f;
constexpr float DN_ALPHA = 1.189207115002721f, LN_EPS = 1e-5f;
constexpr int NEXP_SEL = 128;

constexpr size_t O_YP = 0, O_YS = 16777216, O_KP = 17039360, O_VP = 19136512, O_KIP = 21233664, O_CP = 22282240,
                 O_KS = 22290432, O_VS = 22323200, O_KIS = 22355968, O_CS = 22372352, O_END = 22405120;

constexpr size_t MB = 1048576;
constexpr size_t WS_CTL = 0, WS_MOD = 1 * MB, WS_WIN = 2 * MB, WS_WOA = 12 * MB, WS_WOC = 13 * MB, WS_WOUT = 14 * MB, WS_WQ = 16 * MB,
                 WS_K1 = 18 * MB, WS_K2 = 18 * MB + 65536, WS_PU = 20 * MB, WS_PV = 52 * MB, WS_H1 = 84 * MB, WS_PROJ = 118 * MB,
                 WS_WI = 270 * MB, WS_SEL = 271 * MB, WS_OATT = 288 * MB, WS_OCONV = 305 * MB, WS_MERGED = 322 * MB, WS_T1 = 355 * MB,
                 WS_H2 = 420 * MB, WS_QP = 453 * MB, WS_EIDX = 486 * MB, WS_GW = 495 * MB, WS_SS = 504 * MB, WS_SE = 513 * MB, WS_SG = 523 * MB, WS_VT = 533 * MB, WS_CGX = 538 * MB, WS_END = 539 * MB;
constexpr size_t WS_PU8 = WS_PU, WS_PV8 = WS_PU + 16 * MB, WS_SU = WS_PV, WS_SV = WS_PV + 65536, WS_H8 = WS_PV + 1 * MB, WS_SH = WS_PV + 20 * MB;
constexpr int CTL_ZERO_BYTES = 65536;

constexpr int NTHREADS = 512;
constexpr int LDS_BYTES = 160 * 1024 - 512;
constexpr int LDS_MISC = LDS_BYTES - 64;

__device__ __forceinline__ float bf2f(bf16_t b) { return __uint_as_float(((unsigned)b) << 16); }
__device__ __forceinline__ float bflo(unsigned p) { return __uint_as_float(p << 16); }
__device__ __forceinline__ float bfhi(unsigned p) { return __uint_as_float(p & 0xFFFF0000u); }
typedef __bf16 bf16x2_t __attribute__((ext_vector_type(2)));
typedef float f32x2_t __attribute__((ext_vector_type(2)));
__device__ __forceinline__ unsigned cvt_pk_bf16(float lo, float hi) { const f32x2_t f = {lo, hi}; const bf16x2_t b = __builtin_convertvector(f, bf16x2_t); unsigned r; __builtin_memcpy(&r, &b, 4); return r; }
__device__ __forceinline__ bf16_t f2bf(float f) { return (bf16_t)(cvt_pk_bf16(f, 0.f) & 0xFFFFu); }
__device__ __forceinline__ float wave_sum(float v) {
#pragma unroll
    for (int o = 32; o >= 1; o >>= 1) v += __shfl_xor(v, o);
    return v;
}
__device__ __forceinline__ float wave_sum_dpp(float v) {
    int x;
    x = __builtin_amdgcn_update_dpp(0, __float_as_int(v), 0xB1, 0xF, 0xF, false);  v += __int_as_float(x);
    x = __builtin_amdgcn_update_dpp(0, __float_as_int(v), 0x4E, 0xF, 0xF, false);  v += __int_as_float(x);
    x = __builtin_amdgcn_update_dpp(0, __float_as_int(v), 0x141, 0xF, 0xF, false); v += __int_as_float(x);
    x = __builtin_amdgcn_update_dpp(0, __float_as_int(v), 0x140, 0xF, 0xF, false); v += __int_as_float(x);
    x = __builtin_amdgcn_update_dpp(0, __float_as_int(v), 0x142, 0xA, 0xF, false); v += __int_as_float(x);
    x = __builtin_amdgcn_update_dpp(0, __float_as_int(v), 0x143, 0xC, 0xF, false); v += __int_as_float(x);
    return __int_as_float(__builtin_amdgcn_readlane(__float_as_int(v), 63));
}
__device__ __forceinline__ float wave_max(float v) {
#pragma unroll
    for (int o = 32; o >= 1; o >>= 1) v = fmaxf(v, __shfl_xor(v, o));
    return v;
}
__device__ __forceinline__ float sigmoidf_(float x) { return 1.f / (1.f + __expf(-x)); }
__device__ __forceinline__ float gelu_tanh(float a) {
    const float z = 0.7978845608028654f * (a + 0.044715f * a * a * a);
    const float e = __expf(2.f * z);
    const float t = 1.f - 2.f * __builtin_amdgcn_rcpf(e + 1.f);
    return 0.5f * a * (1.f + t);
}
__device__ __forceinline__ unsigned f2ord(float f) { const unsigned u = __float_as_uint(f); return (u & 0x80000000u) ? ~u : (u | 0x80000000u); }
__device__ __forceinline__ int t5_bucket(int n) {
    if (n < 16) return n;
    int b = 16;
    b += (n >= 19) + (n >= 21) + (n >= 24) + (n >= 27) + (n >= 31) + (n >= 35) + (n >= 40) + (n >= 46) + (n >= 52) + (n >= 59) + (n >= 67) + (n >= 77) + (n >= 87) + (n >= 99) + (n >= 113);
    return b;
}

#define XB_TMO      128
#define XB_XCNT(j)  (256  + 64 * (j))
#define XB_XSUB(j)  (1280 + 64 * (j))
#define XB_XGEN(j)  (2304 + 64 * (j))
#define XB_TOP      3328
#define XB_TOPGEN   3392
#define XCD_BAR_WORDS 3456
#define XB_SPIN_CAP (1u << 18)
__device__ __forceinline__ unsigned xb_ld(unsigned* p)              { return __hip_atomic_load(p, __ATOMIC_RELAXED, __HIP_MEMORY_SCOPE_AGENT); }
__device__ __forceinline__ unsigned xb_add(unsigned* p, unsigned v) { return __hip_atomic_fetch_add(p, v, __ATOMIC_RELAXED, __HIP_MEMORY_SCOPE_AGENT); }
__device__ __forceinline__ unsigned xb_xcc_id() { return (unsigned)__builtin_amdgcn_s_getreg((3 << 11) | 20) & 0xFu; }
#define XB_SPIN(cond, bar) do { unsigned _sp = 0; while (cond) { __builtin_amdgcn_s_sleep(1); \
    if ((++_sp & 255u) == 0u) { if (xb_ld(&(bar)[XB_TMO])) break; if (_sp > XB_SPIN_CAP) { atomicAdd(&(bar)[XB_TMO], 1u); break; } } } } while (0)
struct XcdBarrier { unsigned* bar; unsigned x; volatile LAS unsigned* st; };
__device__ __forceinline__ XcdBarrier xcd_barrier_post(unsigned* bar, volatile LAS unsigned* st) {
    XcdBarrier b; b.bar = bar; b.x = xb_xcc_id(); b.st = st;
    if (threadIdx.x == 0) (void)xb_add(&bar[XB_XCNT(b.x)], 1u);
    return b;
}
__device__ __forceinline__ void xcd_barrier_complete(unsigned* bar, unsigned x, unsigned& nloc, unsigned& nx) {
    const unsigned G = gridDim.x * gridDim.y * gridDim.z;
    unsigned sum, cnt, mine, sp = 0u;
    for (;;) {
        sum = 0u; cnt = 0u; mine = 0u;
#pragma unroll
        for (unsigned j = 0; j < 16; ++j) { const unsigned c = xb_ld(&bar[XB_XCNT(j)]); sum += c; cnt += (c > 0u) ? 1u : 0u; mine = (j == x) ? c : mine; }
        if (sum == G) break;
        __builtin_amdgcn_s_sleep(1);
        if ((++sp & 255u) == 0u) { if (xb_ld(&bar[XB_TMO])) break; if (sp > XB_SPIN_CAP) { atomicAdd(&bar[XB_TMO], 1u); break; } }
    }
    nloc = mine > 0u ? mine : 1u; nx = cnt > 0u ? cnt : 1u;
}
__device__ __forceinline__ void xcd_barrier(const XcdBarrier& b) {
    asm volatile("s_waitcnt vmcnt(0)" ::: "memory");
    __syncthreads();
    if (threadIdx.x == 0) {
        unsigned* bar = b.bar;
        __builtin_amdgcn_s_waitcnt(0);
        unsigned nloc = b.st[0], nx = b.st[1];
        if (nloc == 0u) { xcd_barrier_complete(bar, b.x, nloc, nx); b.st[0] = nloc; b.st[1] = nx; }
        const unsigned old = xb_add(&bar[XB_XSUB(b.x)], 1u);
        const unsigned gen = old / nloc;
        if (old + 1u == (gen + 1u) * nloc) {
            __builtin_amdgcn_fence(__ATOMIC_RELEASE, "agent");
            asm volatile("s_waitcnt vmcnt(0)" ::: "memory");
            const unsigned og = xb_add(&bar[XB_TOP], 1u);
            const unsigned tg = og / nx;
            if (og + 1u == (tg + 1u) * nx) xb_add(&bar[XB_TOPGEN], 1u);
            else XB_SPIN(xb_ld(&bar[XB_TOPGEN]) == tg, bar);
            __builtin_amdgcn_fence(__ATOMIC_ACQUIRE, "agent");
            xb_add(&bar[XB_XGEN(b.x)], 1u);
            asm volatile("s_waitcnt vmcnt(0)" ::: "memory");
        } else {
            XB_SPIN(xb_ld(&bar[XB_XGEN(b.x)]) == gen, bar);
            __builtin_amdgcn_fence(__ATOMIC_ACQUIRE, "agent");
            asm volatile("s_waitcnt vmcnt(0)" ::: "memory");
        }
    }
    __syncthreads();
}

struct Args { const void* in[27]; float* out; unsigned char* ws; int ph_lo, ph_hi; };
struct Core { LAS unsigned char* lds; int tid, lane, wave, G, bid; };
struct Frame {
    LAS unsigned char* lds;
    int tid, lane, wave, G, bid;
    const float *x_p, *x_s, *c_p, *c_s, *cache_k, *cache_v, *cache_ki, *state_conv, *rel_bias, *w_ada, *b_ada, *w_in, *conv_w, *conv_b,
                *w_o_attn, *w_o_conv, *w_out, *ln1_g, *ln1_b, *ln2_g, *ln2_b, *peer_wq, *peer_k1, *peer_k2, *peer_u, *peer_v;
    const int* page_table;
    float* out; unsigned char* ws;
    float* MOD; bf16_t *WIN, *WOA, *WOC, *WOUT, *WQ, *K1, *K2, *PU, *PV, *H1, *PROJ, *OATT, *OCONV, *MERGED, *H2, *QP;
    float *WI, *T1, *GW; int *SEL, *EIDX;
};
constexpr int LDS_PTAB = LDS_BYTES - 512;
__device__ __forceinline__ unsigned char* ldptr(const Core& C, int k) {
    LAS const unsigned* p = (LAS const unsigned*)(C.lds + LDS_PTAB) + 2 * k;
    const unsigned lo = __builtin_amdgcn_readfirstlane(p[0]), hi = __builtin_amdgcn_readfirstlane(p[1]);
    return (unsigned char*)(((unsigned long long)hi << 32) | (unsigned long long)lo);
}
__device__ __forceinline__ void load_frame(Frame& F, const Core& C) {
    F.lds = C.lds; F.tid = C.tid; F.lane = C.lane; F.wave = C.wave; F.G = C.G; F.bid = C.bid;
    F.x_p = (const float*)ldptr(C, 0); F.x_s = (const float*)ldptr(C, 1); F.c_p = (const float*)ldptr(C, 2); F.c_s = (const float*)ldptr(C, 3);
    F.cache_k = (const float*)ldptr(C, 4); F.cache_v = (const float*)ldptr(C, 5); F.cache_ki = (const float*)ldptr(C, 6); F.state_conv = (const float*)ldptr(C, 7);
    F.page_table = (const int*)ldptr(C, 8); F.rel_bias = (const float*)ldptr(C, 9); F.w_ada = (const float*)ldptr(C, 10); F.b_ada = (const float*)ldptr(C, 11);
    F.w_in = (const float*)ldptr(C, 12); F.conv_w = (const float*)ldptr(C, 13); F.conv_b = (const float*)ldptr(C, 14); F.w_o_attn = (const float*)ldptr(C, 15);
    F.w_o_conv = (const float*)ldptr(C, 16); F.w_out = (const float*)ldptr(C, 17); F.ln1_g = (const float*)ldptr(C, 18); F.ln1_b = (const float*)ldptr(C, 19);
    F.ln2_g = (const float*)ldptr(C, 20); F.ln2_b = (const float*)ldptr(C, 21); F.peer_wq = (const float*)ldptr(C, 22); F.peer_k1 = (const float*)ldptr(C, 23);
    F.peer_k2 = (const float*)ldptr(C, 24); F.peer_u = (const float*)ldptr(C, 25); F.peer_v = (const float*)ldptr(C, 26);
    F.out = (float*)ldptr(C, 27);
    unsigned char* ws = ldptr(C, 28);
    F.MOD = (float*)(ws + WS_MOD); F.WIN = (bf16_t*)(ws + WS_WIN); F.WOA = (bf16_t*)(ws + WS_WOA); F.WOC = (bf16_t*)(ws + WS_WOC);
    F.WOUT = (bf16_t*)(ws + WS_WOUT); F.WQ = (bf16_t*)(ws + WS_WQ); F.K1 = (bf16_t*)(ws + WS_K1); F.K2 = (bf16_t*)(ws + WS_K2);
    F.PU = (bf16_t*)(ws + WS_PU); F.PV = (bf16_t*)(ws + WS_PV); F.H1 = (bf16_t*)(ws + WS_H1); F.PROJ = (bf16_t*)(ws + WS_PROJ);
    F.WI = (float*)(ws + WS_WI); F.SEL = (int*)(ws + WS_SEL); F.OATT = (bf16_t*)(ws + WS_OATT); F.OCONV = (bf16_t*)(ws + WS_OCONV);
    F.MERGED = (bf16_t*)(ws + WS_MERGED); F.T1 = (float*)(ws + WS_T1); F.H2 = (bf16_t*)(ws + WS_H2); F.QP = (bf16_t*)(ws + WS_QP);
    F.EIDX = (int*)(ws + WS_EIDX); F.GW = (float*)(ws + WS_GW);
}
__device__ __forceinline__ const float* x_row(const Frame& F, int m) { return m < NTP ? F.x_p + (size_t)m * D : F.x_s + (size_t)(m - NTP) * D; }
__device__ __forceinline__ int mod_row(int m) { return m < NTP ? (m >> 11) : NB_P + ((m - NTP) >> 3); }

constexpr int P0_MOD_ITEMS = 96;
constexpr int P0_T_WIN = 16 * 74, P0_T_WOA = 8 * 16, P0_T_WOC = 8 * 16, P0_T_WOUT = 16 * 16, P0_T_WQ = 16 * 16;
constexpr int P0_T_ITEMS = P0_T_WIN + P0_T_WOA + P0_T_WOC + P0_T_WOUT + P0_T_WQ;
constexpr int P0_CVT_ITEMS = 2 * (16384 * 1024 / 8192);
constexpr int P0_MISC_ITEMS = 1;
constexpr int P0_ITEMS = P0_MOD_ITEMS + P0_T_ITEMS + P0_CVT_ITEMS + P0_MISC_ITEMS;

__device__ __forceinline__ void p0_mod_item(const Frame& F, int ng) {
    LAS float* cs = (LAS float*)F.lds;
    LAS float* red = (LAS float*)(F.lds + 40 * 256 * 4);
    float acc[40];
#pragma unroll
    for (int r = 0; r < 40; ++r) acc[r] = 0.f;
    const int n = ng * 64 + F.lane;
    for (int kc = 0; kc < 4; ++kc) {
        __syncthreads();
#pragma unroll 1
        for (int hb = 0; hb < 2; ++hb) {
            float cv[10];
#pragma unroll
            for (int i = 0; i < 10; ++i) { const int e = F.tid + (hb * 10 + i) * NTHREADS; const int r = e >> 8, k = e & 255; cv[i] = (r < 8) ? F.c_p[r * D + kc * 256 + k] : F.c_s[(r - 8) * D + kc * 256 + k]; }
#pragma unroll
            for (int i = 0; i < 10; ++i) cs[F.tid + (hb * 10 + i) * NTHREADS] = cv[i];
        }
        __syncthreads();
        float wvv[32];
#pragma unroll
        for (int kk = 0; kk < 32; ++kk) wvv[kk] = F.w_ada[(size_t)(kc * 256 + F.wave * 32 + kk) * 6144 + n];
#pragma unroll
        for (int kk = 0; kk < 32; ++kk) {
            const int kl = F.wave * 32 + kk;
#pragma unroll
            for (int r = 0; r < 40; ++r) acc[r] += cs[r * 256 + kl] * wvv[kk];
        }
    }
#pragma unroll
    for (int r = 0; r < 40; ++r) red[(F.wave * 40 + r) * 64 + F.lane] = acc[r];
    __syncthreads();
    for (int e = F.tid; e < 40 * 64; e += NTHREADS) {
        const int r = e >> 6, l = e & 63; float s = F.b_ada[ng * 64 + l];
#pragma unroll
        for (int w = 0; w < 8; ++w) s += red[(w * 40 + r) * 64 + l];
        F.MOD[r * 6144 + ng * 64 + l] = s;
    }
    __syncthreads();
}
__device__ __forceinline__ void p0_transpose_tile(const Frame& F, const float* W, int N, int K, bf16_t* Wt, int kt, int nt, bool permute) {
    LAS bf16_t* tile = (LAS bf16_t*)F.lds;
    __syncthreads();
    { const int k = F.tid >> 3, c0 = (F.tid & 7) * 8;
      const float* rp = W + (size_t)(kt * 64 + k) * N + nt * 64 + c0;
      const f32x4 z = {0.f, 0.f, 0.f, 0.f};
      const f32x4 v0 = (nt * 64 + c0 < N) ? *(const f32x4*)rp : z, v1 = (nt * 64 + c0 + 4 < N) ? *(const f32x4*)(rp + 4) : z;
#pragma unroll
      for (int j = 0; j < 4; ++j) { tile[k * 66 + c0 + j] = f2bf(v0[j]); tile[k * 66 + c0 + 4 + j] = f2bf(v1[j]); } }
    __syncthreads();
    { const int nl = F.tid >> 3, k0 = (F.tid & 7) * 8; const int n = nt * 64 + nl;
      if (n < N) {
          int nd = n; if (permute) nd = (n < 1024) ? n : (n < 1028 ? C_WI + (n - 1024) : n - 4);
          unsigned p[4];
#pragma unroll
          for (int j = 0; j < 4; ++j) p[j] = (unsigned)tile[(k0 + 2 * j) * 66 + nl] | ((unsigned)tile[(k0 + 2 * j + 1) * 66 + nl] << 16);
          *(u32x4*)(Wt + (size_t)nd * K + kt * 64 + k0) = (u32x4){p[0], p[1], p[2], p[3]};
      } }
}
__device__ __forceinline__ void peer_cvt_rows4(const Frame& F, bool isu, int row0) {
        const float* src = isu ? F.peer_u : F.peer_v;
        unsigned char* dst = F.ws + (isu ? WS_PU8 : WS_PV8); float* sinv = (float*)(F.ws + (isu ? WS_SU : WS_SV));
        float v[4][16];
        if (isu) {
#pragma unroll
            for (int rr = 0; rr < 4; ++rr)
#pragma unroll
                for (int q = 0; q < 4; ++q) {
                    const f32x4 t = *(const f32x4*)(src + (size_t)(row0 + rr) * D + F.lane * 16 + q * 4);
                    v[rr][4 * q] = t[0]; v[rr][4 * q + 1] = t[1]; v[rr][4 * q + 2] = t[2]; v[rr][4 * q + 3] = t[3];
                }
        } else {
#pragma unroll
            for (int rr = 0; rr < 4; ++rr)
#pragma unroll
                for (int c = 0; c < 16; ++c) v[rr][c] = src[(size_t)(row0 + rr) * D + c * 64 + F.lane];
        }
#pragma unroll
        for (int rr = 0; rr < 4; ++rr) {
            float am = 0.f;
#pragma unroll
            for (int c = 0; c < 16; ++c) am = fmaxf(am, fabsf(v[rr][c]));
            am = wave_max(am);
            const float sc = am > 0.f ? 6.f / am : 1.f;
            unsigned w0 = 0u, w1 = 0u;
            w0 = __builtin_amdgcn_cvt_scalef32_pk_fp4_f32(w0, v[rr][0] * sc, v[rr][1] * sc, 1.0f, 0);
            w0 = __builtin_amdgcn_cvt_scalef32_pk_fp4_f32(w0, v[rr][2] * sc, v[rr][3] * sc, 1.0f, 1);
            w0 = __builtin_amdgcn_cvt_scalef32_pk_fp4_f32(w0, v[rr][4] * sc, v[rr][5] * sc, 1.0f, 2);
            w0 = __builtin_amdgcn_cvt_scalef32_pk_fp4_f32(w0, v[rr][6] * sc, v[rr][7] * sc, 1.0f, 3);
            w1 = __builtin_amdgcn_cvt_scalef32_pk_fp4_f32(w1, v[rr][8] * sc, v[rr][9] * sc, 1.0f, 0);
            w1 = __builtin_amdgcn_cvt_scalef32_pk_fp4_f32(w1, v[rr][10] * sc, v[rr][11] * sc, 1.0f, 1);
            w1 = __builtin_amdgcn_cvt_scalef32_pk_fp4_f32(w1, v[rr][12] * sc, v[rr][13] * sc, 1.0f, 2);
            w1 = __builtin_amdgcn_cvt_scalef32_pk_fp4_f32(w1, v[rr][14] * sc, v[rr][15] * sc, 1.0f, 3);
            *(u32x2*)(dst + (size_t)(row0 + rr) * 512 + F.lane * 8) = (u32x2){w0, w1};
            if (F.lane == 0) sinv[row0 + rr] = am > 0.f ? am * (1.f / 6.f) : 1.f;
        }
}
constexpr int P0_OTHER = P0_T_ITEMS + 1;
constexpr int CVT_CHUNKS = 2 * 16384 / 4;
__device__ __forceinline__ void p0_other_item(const Frame& F, int i) {
    if (i < P0_T_ITEMS) {
        if (i < P0_T_WIN) { p0_transpose_tile(F, F.w_in, NMIX, D, F.WIN, i / 74, i % 74, true); return; }
        i -= P0_T_WIN;
        if (i < P0_T_WOA) { p0_transpose_tile(F, F.w_o_attn, D, 512, F.WOA, i / 16, i % 16, false); return; }
        i -= P0_T_WOA;
        if (i < P0_T_WOC) { p0_transpose_tile(F, F.w_o_conv, D, 512, F.WOC, i / 16, i % 16, false); return; }
        i -= P0_T_WOC;
        if (i < P0_T_WOUT) { p0_transpose_tile(F, F.w_out, D, D, F.WOUT, i / 16, i % 16, false); return; }
        i -= P0_T_WOUT;
        p0_transpose_tile(F, F.peer_wq, D, D, F.WQ, i / 16, i % 16, false); return;
    }
    i -= P0_T_ITEMS;
    for (int e = F.tid; e < (4864 - NMIX) * D; e += NTHREADS) F.WIN[(size_t)NMIX * D + e] = 0;
    for (int e = F.tid; e < 128 * 64; e += NTHREADS) { F.K1[e] = f2bf(F.peer_k1[e]); F.K2[e] = f2bf(F.peer_k2[e]); }
}
__device__ __forceinline__ void p0_prologue(const Frame& F) {
    constexpr int NMODWG = P0_MOD_ITEMS, HEAD = 14;
    if (F.G <= NMODWG) {
        for (int it = F.bid; it < P0_MOD_ITEMS + P0_OTHER; it += F.G) { if (it < P0_MOD_ITEMS) p0_mod_item(F, it); else p0_other_item(F, it - P0_MOD_ITEMS); }
        return;
    }
    const int nfree = F.G - NMODWG;
    int head_items = HEAD * nfree; if (head_items > P0_OTHER) head_items = P0_OTHER;
    if (F.bid < NMODWG) p0_mod_item(F, F.bid);
    else for (int j = F.bid - NMODWG; j < head_items; j += nfree) p0_other_item(F, j);
    for (int j = head_items + F.bid; j < P0_OTHER; j += F.G) p0_other_item(F, j);
}

__device__ __forceinline__ void p1_modulate(const Frame& F) {
    const int stride = F.G * 8;
    for (int m0 = F.bid * 8 + F.wave; m0 < NT; m0 += 2 * stride) {
        f32x4 xv[2][4], sv[2][4], hv[2][4];
#pragma unroll
        for (int rr = 0; rr < 2; ++rr) {
            const int m = (m0 + rr * stride < NT) ? m0 + rr * stride : m0;
            const float* xr = x_row(F, m); const float* mr = F.MOD + (size_t)mod_row(m) * 6144;
#pragma unroll
            for (int q = 0; q < 4; ++q) {
                const int e = (q >> 1) * 512 + F.lane * 8 + (q & 1) * 4;
                xv[rr][q] = *(const f32x4*)(xr + e); sv[rr][q] = *(const f32x4*)(mr + 1024 + e); hv[rr][q] = *(const f32x4*)(mr + e);
            }
        }
#pragma unroll
        for (int rr = 0; rr < 2; ++rr) {
            const int m = m0 + rr * stride;
            if (m >= NT) continue;
#pragma unroll
            for (int hlf = 0; hlf < 2; ++hlf) {
                const f32x4 a = xv[rr][2 * hlf] * (sv[rr][2 * hlf] + 1.f) + hv[rr][2 * hlf], b2 = xv[rr][2 * hlf + 1] * (sv[rr][2 * hlf + 1] + 1.f) + hv[rr][2 * hlf + 1];
                *(u32x4*)(F.H1 + (size_t)m * D + hlf * 512 + F.lane * 8) = (u32x4){cvt_pk_bf16(a[0], a[1]), cvt_pk_bf16(a[2], a[3]), cvt_pk_bf16(b2[0], b2[1]), cvt_pk_bf16(b2[2], b2[3])};
            }
        }
    }
}

constexpr int BM = 256, BN = 128, BK = 64;
constexpr int XPANEL = BM * 32 + 32, WPANEL = BN * 32 + 32;
constexpr int XSTAGE = 4 * XPANEL, WSTAGE = 4 * WPANEL, GSTAGE = XSTAGE + WSTAGE;
__device__ __forceinline__ void gemm_accum(const Frame& F, f32x16 (&acc)[2][2], const bf16_t* __restrict__ X, int ldx, const bf16_t* __restrict__ W, int ldw, int K, int m0, int n0) {
    const int tid = F.tid, lane = F.lane, r = lane & 31, h = lane >> 5, wm = F.wave >> 1, wn = F.wave & 1;
    u32x4 xr[4], wr[2];
    const int nk = K / BK;
    const int crow = tid >> 3, ckc = tid & 7;
    const bf16_t* xg = X + (size_t)(m0 + crow) * ldx + ckc * 8;
    const bf16_t* wg = W + (size_t)(n0 + crow) * ldw + ckc * 8;
    const int ldso = (ckc >> 1) * 1  ;
    const int xoff = ldso * XPANEL + crow * 32 + (ckc & 1) * 16;
    const int woff = ldso * WPANEL + crow * 32 + (ckc & 1) * 16;
#pragma unroll
    for (int i = 0; i < 4; ++i) xr[i] = *(const u32x4*)(xg + (size_t)(64 * i) * ldx);
#pragma unroll
    for (int i = 0; i < 2; ++i) wr[i] = *(const u32x4*)(wg + (size_t)(64 * i) * ldw);
    __syncthreads();
    for (int kt = 0; kt < nk; ++kt) {
        LAS unsigned char* st = F.lds + (kt & 1) * GSTAGE;
#pragma unroll
        for (int i = 0; i < 4; ++i) *(LAS u32x4*)(st + xoff + i * 64 * 32) = xr[i];
#pragma unroll
        for (int i = 0; i < 2; ++i) *(LAS u32x4*)(st + XSTAGE + woff + i * 64 * 32) = wr[i];
        __syncthreads();
        if (kt + 1 < nk) {
#pragma unroll
            for (int i = 0; i < 4; ++i) xr[i] = *(const u32x4*)(xg + (size_t)(64 * i) * ldx + (kt + 1) * BK);
#pragma unroll
            for (int i = 0; i < 2; ++i) wr[i] = *(const u32x4*)(wg + (size_t)(64 * i) * ldw + (kt + 1) * BK);
        }
#pragma unroll
        for (int s = 0; s < 4; ++s) {
            bf16x8 a[2], b[2];
#pragma unroll
            for (int ni = 0; ni < 2; ++ni) a[ni] = *(LAS bf16x8*)(st + XSTAGE + s * WPANEL + (wn * 64 + ni * 32 + r) * 32 + h * 16);
#pragma unroll
            for (int mi = 0; mi < 2; ++mi) b[mi] = *(LAS bf16x8*)(st + s * XPANEL + (wm * 64 + mi * 32 + r) * 32 + h * 16);
#pragma unroll
            for (int mi = 0; mi < 2; ++mi)
#pragma unroll
                for (int ni = 0; ni < 2; ++ni) acc[mi][ni] = __builtin_amdgcn_mfma_f32_32x32x16_bf16(a[ni], b[mi], acc[mi][ni], 0, 0, 0);
        }
    }
}
#define GEMM_EPI_LOOP(...) \
    { const int r_ = F.lane & 31, h_ = F.lane >> 5, wm_ = F.wave >> 1, wn_ = F.wave & 1; \
      _Pragma("unroll") for (int mi = 0; mi < 2; ++mi) _Pragma("unroll") for (int ni = 0; ni < 2; ++ni) _Pragma("unroll") for (int g = 0; g < 4; ++g) { \
          const int m = m0 + wm_ * 64 + mi * 32 + r_; const int n = n0 + wn_ * 64 + ni * 32 + 8 * g + 4 * h_; __VA_ARGS__ } }
#define ACC4(A) ((f32x4){A[mi][ni][4 * g], A[mi][ni][4 * g + 1], A[mi][ni][4 * g + 2], A[mi][ni][4 * g + 3]})
__device__ __forceinline__ void zero_acc(f32x16 (&acc)[2][2]) {
#pragma unroll
    for (int mi = 0; mi < 2; ++mi)
#pragma unroll
        for (int ni = 0; ni < 2; ++ni)
#pragma unroll
            for (int e = 0; e < 16; ++e) acc[mi][ni][e] = 0.f;
}
__device__ __forceinline__ u32x2 pk4(const f32x4 v) { return (u32x2){cvt_pk_bf16(v[0], v[1]), cvt_pk_bf16(v[2], v[3])}; }

__device__ __forceinline__ void gemm_slice8(const Frame& F, f32x16 (&sacc)[1][1], const bf16_t* __restrict__ X, int ldx, const bf16_t* __restrict__ W, int ldw, int K, int m0, int n0) {
    const int r = F.lane & 31, h = F.lane >> 5, wq = F.wave & 3, kh = F.wave >> 2;
    const bf16_t* wp = W + (size_t)(n0 + 32 * wq + r) * ldw + kh * (K / 2) + h * 8;
    const bf16_t* xp = X + (size_t)(m0 + (r & 7)) * ldx + kh * (K / 2) + h * 8;
    f32x16 c;
#pragma unroll
    for (int e = 0; e < 16; ++e) c[e] = 0.f;
#pragma unroll 1
    for (int k0 = 0; k0 < K / 2; k0 += 128) {
        bf16x8 a[8], b[8];
#pragma unroll
        for (int t = 0; t < 8; ++t) { a[t] = *(const bf16x8*)(wp + k0 + t * 16); b[t] = *(const bf16x8*)(xp + k0 + t * 16); }
#pragma unroll
        for (int t = 0; t < 8; ++t) c = __builtin_amdgcn_mfma_f32_32x32x16_bf16(a[t], b[t], c, 0, 0, 0);
    }
    LAS float* cb = (LAS float*)F.lds + wq * (16 * 64);
    __syncthreads();
    if (kh == 1) {
#pragma unroll
        for (int e = 0; e < 16; ++e) cb[e * 64 + F.lane] = c[e];
    }
    __syncthreads();
    if (kh == 0) {
#pragma unroll
        for (int e = 0; e < 16; ++e) c[e] += cb[e * 64 + F.lane];
    }
    sacc[0][0] = c;
}
#define SLICE_EPI_LOOP(...) \
    if (F.wave < 4 && (F.lane & 31) < 8) { const int h_ = F.lane >> 5, wq_ = F.wave & 3; constexpr int mi = 0, ni = 0; \
      _Pragma("unroll") for (int g = 0; g < 4; ++g) { const int m = m0 + (F.lane & 31); const int n = n0 + wq_ * 32 + 8 * g + 4 * h_; __VA_ARGS__ } }

namespace pg8 {
#define PG8_LAS __attribute__((address_space(3)))
typedef unsigned short bf16_t;
typedef short bf16x8 __attribute__((ext_vector_type(8)));
typedef float f32x4 __attribute__((ext_vector_type(4)));
typedef unsigned u32x4 __attribute__((ext_vector_type(4)));
constexpr int BM = 256, BK = 64, HALF = 128, HTB = HALF * BK * 2  , STAGE_BYTES = 8 * HTB, NXCD = 8, WGM = 8;

__host__ __device__ __forceinline__ int lds_byte(int r, int c) { const int st = (r >> 4) * 2 + (c >> 5), rr = r & 15, cc = c & 31, ob = rr * 64 + cc * 2; return st * 1024 + (ob ^ (((ob >> 9) & 1) << 5)); }
__host__ __device__ __forceinline__ void stage_rc(int b, int& R, int& C) { const int st = b / 1024, sb = b % 1024, swz = sb ^ (((sb >> 9) & 1) << 5); R = (st >> 1) * 16 + swz / 64; C = (st & 1) * 32 + (swz % 64) / 2; }
__host__ __device__ __forceinline__ int perm32(int rho) { const int n = rho >> 4, i = rho & 15; return 8 * (i >> 2) + 4 * n + (i & 3); }

struct Unit { int pm, pn; };
struct Gemm { const bf16_t* A; const bf16_t* Bt; int M, N, K; };

struct StaticOrder {
    int nM, nN, nwg, G, c;
    __host__ __device__ void init(int M, int N, int G_, int c_) { nM = M / BM; nN = N / BM; nwg = nM * nN; G = G_; c = c_; }
    __host__ __device__ bool next(int i, Unit& u) const {
        const long L = (long)i * G + c; if (L >= nwg) return false;
        int wgid = (int)L; { const int q = nwg / NXCD, r = nwg % NXCD, xcd = wgid % NXCD, off = wgid / NXCD; wgid = (xcd < r ? xcd * (q + 1) : r * (q + 1) + (xcd - r) * q) + off; }
        const int nig = WGM * nN, gid = wgid / nig, fm = gid * WGM, gsz = (nM - fm) < WGM ? (nM - fm) : WGM;
        u.pm = fm + ((wgid % nig) % gsz); u.pn = (wgid % nig) / gsz; return true;
    }
    __device__ __forceinline__ void a_ready(const Unit&) const {}
    __device__ __forceinline__ void done(const Unit&) const {}
};

template <class Body> struct EpiRC {
    static constexpr bool PERM = false, AFTER_DRAIN = false;
    Body body;
    __device__ __forceinline__ void operator()(const f32x4 (&acc)[2][2][4][2], const Unit& u, int wr, int wc, int fr, int fq) const {
#pragma unroll
        for (int ai = 0; ai < 2; ++ai)
#pragma unroll
            for (int m = 0; m < 4; ++m) {
                const int row = u.pm * BM + ai * HALF + wr * 64 + m * 16 + fr;
#pragma unroll
                for (int bj = 0; bj < 2; ++bj)
#pragma unroll
                    for (int n = 0; n < 2; ++n) body(row, u.pn * BM + bj * HALF + wc * 32 + n * 16 + 4 * fq, acc[ai][bj][m][n]);
            }
    }
};
template <class Epi, class Sched, bool ALIGN_EPI = false, bool SP2 = false>
__device__ __forceinline__ void gemm_phase(PG8_LAS unsigned char* lds, const Gemm g, const Sched& S, const Epi& E) {
    const int tid = threadIdx.x, wid = __builtin_amdgcn_readfirstlane(tid >> 6), lane = tid & 63, wr = wid >> 2, wc = wid & 3, fr = lane & 15, fq = lane >> 4;
    const int K = g.K, nt = K / BK;
    unsigned voffA[2], voffB[2];
#pragma unroll
    for (int i = 0; i < 2; ++i) { int R, C; stage_rc(tid * 16 + i * 8192, R, C); const int Rb = Epi::PERM ? ((R & ~31) + perm32(R & 31)) : R;
        voffA[i] = (unsigned)(R * K + C) * 2u; voffB[i] = (unsigned)(Rb * K + C) * 2u; }
    const size_t kstep = (size_t)(BK * 2);
    const size_t hstep = (size_t)HALF * K * 2;
    const size_t tstep = 2 * hstep;
    const unsigned ldsw = (unsigned)wid * 1024u;
    const int aoff = lds_byte(wr * 64 + fr, fq * 8), boff = lds_byte(wc * 32 + fr, fq * 8);
#define PG8_SA(b, h) (((b) * 2 + (h)) * HTB)
#define PG8_SB(b, h) ((4 + (b) * 2 + (h)) * HTB)
#define PG8_STAGE(bufoff, gbase, voff) do { _Pragma("unroll") for (int _i = 0; _i < 2; ++_i) \
        __builtin_amdgcn_global_load_lds((const unsigned*)((const char*)(gbase) + (voff)[_i]), (PG8_LAS unsigned*)(lds + (bufoff) + ldsw + _i * 8192), 16, 0, 0); } while (0)
#define PG8_LDA(dst, b, h) do { _Pragma("unroll") for (int m = 0; m < 4; ++m) _Pragma("unroll") for (int k = 0; k < 2; ++k) dst[m][k] = *(const PG8_LAS bf16x8*)(lds + PG8_SA(b, h) + aoff + m * 2048 + k * 1024); } while (0)
#define PG8_LDB(dst, b, h) do { _Pragma("unroll") for (int n = 0; n < 2; ++n) _Pragma("unroll") for (int k = 0; k < 2; ++k) dst[n][k] = *(const PG8_LAS bf16x8*)(lds + PG8_SB(b, h) + boff + n * 2048 + k * 1024); } while (0)
#define PG8_MMA(ai, bj, At, Bt) do { __builtin_amdgcn_s_setprio(1); _Pragma("unroll") for (int m = 0; m < 4; ++m) _Pragma("unroll") for (int n = 0; n < 2; ++n) _Pragma("unroll") for (int k = 0; k < 2; ++k) \
        acc[ai][bj][m][n] = __builtin_amdgcn_mfma_f32_16x16x32_bf16(Bt[n][k], At[m][k], acc[ai][bj][m][n], 0, 0, 0); __builtin_amdgcn_s_setprio(0); } while (0)
#define PG8_WAIT_V(n) asm volatile("s_waitcnt vmcnt(" #n ")" ::: "memory")
#define PG8_WAIT_L(n) asm volatile("s_waitcnt lgkmcnt(" #n ")" ::: "memory")
#define PG8_BAR __builtin_amdgcn_s_barrier()
#define PG8_SCHED __builtin_amdgcn_sched_barrier(0)
    Unit cur, nxt; int ui = 0;
    if (!S.next(0, cur)) return;
    f32x4 acc[2][2][4][2];
#pragma unroll
    for (int a = 0; a < 2; ++a)
#pragma unroll
        for (int b = 0; b < 2; ++b)
#pragma unroll
            for (int m = 0; m < 4; ++m)
#pragma unroll
                for (int n = 0; n < 2; ++n) acc[a][b][m][n] = (f32x4){0.f, 0.f, 0.f, 0.f};
    bf16x8 At[4][2], B0[2][2], B1[2][2];
    const char* cA = (const char*)g.A + (size_t)cur.pm * tstep; const char* cB = (const char*)g.Bt + (size_t)cur.pn * tstep;
    S.a_ready(cur);
    if constexpr (SP2) {
        PG8_STAGE(PG8_SB(0, 0), cB, voffB); PG8_STAGE(PG8_SB(0, 1), cB + hstep, voffB); PG8_STAGE(PG8_SA(0, 0), cA, voffA); PG8_STAGE(PG8_SA(0, 1), cA + hstep, voffA);
        if (wr == 1) PG8_BAR;
        PG8_WAIT_V(2); PG8_BAR;
        PG8_STAGE(PG8_SB(1, 0), cB + kstep, voffB); PG8_STAGE(PG8_SA(1, 0), cA + kstep, voffA); PG8_STAGE(PG8_SB(1, 1), cB + hstep + kstep, voffB);
        PG8_WAIT_V(6); PG8_BAR;
    } else {
        PG8_STAGE(PG8_SB(0, 0), cB, voffB); PG8_STAGE(PG8_SA(0, 0), cA, voffA); PG8_STAGE(PG8_SB(0, 1), cB + hstep, voffB); PG8_STAGE(PG8_SA(0, 1), cA + hstep, voffA);
        if (wr == 1) PG8_BAR;
        PG8_WAIT_V(4); PG8_BAR;
        PG8_STAGE(PG8_SB(1, 0), cB + kstep, voffB); PG8_STAGE(PG8_SA(1, 0), cA + kstep, voffA); PG8_STAGE(PG8_SB(1, 1), cB + hstep + kstep, voffB);
        PG8_WAIT_V(6); PG8_BAR;
    }
    for (;;) {
        const bool has_next = S.next(ui + 1, nxt);
        const char* nA = has_next ? (const char*)g.A + (size_t)nxt.pm * tstep : cA; const char* nB = has_next ? (const char*)g.Bt + (size_t)nxt.pn * tstep : cB;
        for (int t = 0; t < nt; t += 2) {
            const bool last = (t == nt - 2);
            const char* a1 = cA + (size_t)(t + 1) * kstep;
            const char* a2 = last ? nA : cA + (size_t)(t + 2) * kstep; const char* b2 = last ? nB : cB + (size_t)(t + 2) * kstep;
            const char* a3 = a2 + kstep; const char* b3 = b2 + kstep;
            if (last && has_next) S.a_ready(nxt);
            if constexpr (SP2) {
            PG8_LDB(B0, 0, 0); PG8_LDB(B1, 0, 1); PG8_SCHED; PG8_LDA(At, 0, 0); PG8_STAGE(PG8_SA(1, 1), a1 + hstep, voffA);
            PG8_WAIT_V(8); PG8_WAIT_L(0); PG8_BAR; PG8_MMA(0, 0, At, B0); PG8_MMA(0, 1, At, B1); PG8_BAR; PG8_SCHED;
            PG8_LDA(At, 0, 1); PG8_STAGE(PG8_SB(0, 0), b2, voffB); PG8_STAGE(PG8_SB(0, 1), b2 + hstep, voffB); PG8_STAGE(PG8_SA(0, 0), a2, voffA);
            PG8_WAIT_V(8); PG8_WAIT_L(0); PG8_BAR; PG8_MMA(1, 0, At, B0); PG8_MMA(1, 1, At, B1); PG8_BAR; PG8_SCHED;
            PG8_LDB(B0, 1, 0); PG8_LDB(B1, 1, 1); PG8_SCHED; PG8_LDA(At, 1, 0); PG8_STAGE(PG8_SA(0, 1), a2 + hstep, voffA);
            PG8_WAIT_V(8); PG8_WAIT_L(0); PG8_BAR; PG8_MMA(0, 0, At, B0); PG8_MMA(0, 1, At, B1); PG8_BAR; PG8_SCHED;
            PG8_LDA(At, 1, 1); PG8_STAGE(PG8_SB(1, 0), b3, voffB); PG8_STAGE(PG8_SB(1, 1), b3 + hstep, voffB); PG8_STAGE(PG8_SA(1, 0), a3, voffA);
            PG8_WAIT_V(8); PG8_WAIT_L(0); PG8_BAR; PG8_MMA(1, 0, At, B0); PG8_MMA(1, 1, At, B1); PG8_BAR; PG8_SCHED;
            } else {
            PG8_LDB(B0, 0, 0); PG8_SCHED; PG8_LDA(At, 0, 0); PG8_STAGE(PG8_SA(1, 1), a1 + hstep, voffA);
            PG8_WAIT_L(8); PG8_BAR; PG8_WAIT_L(0); PG8_MMA(0, 0, At, B0); PG8_BAR; PG8_SCHED;
            PG8_LDB(B1, 0, 1); PG8_STAGE(PG8_SB(0, 0), b2, voffB);
            PG8_BAR; PG8_WAIT_L(0); PG8_MMA(0, 1, At, B1); PG8_BAR;
            PG8_LDA(At, 0, 1); PG8_STAGE(PG8_SA(0, 0), a2, voffA);
            PG8_BAR; PG8_WAIT_L(0); PG8_MMA(1, 0, At, B0); PG8_BAR; PG8_SCHED;
            PG8_STAGE(PG8_SB(0, 1), b2 + hstep, voffB);
            PG8_WAIT_V(6); PG8_BAR; PG8_MMA(1, 1, At, B1); PG8_BAR;
            PG8_LDB(B0, 1, 0); PG8_SCHED; PG8_LDA(At, 1, 0); PG8_STAGE(PG8_SA(0, 1), a2 + hstep, voffA);
            PG8_WAIT_L(8); PG8_BAR; PG8_WAIT_L(0); PG8_MMA(0, 0, At, B0); PG8_BAR; PG8_SCHED;
            PG8_LDB(B1, 1, 1); PG8_STAGE(PG8_SB(1, 0), b3, voffB);
            PG8_BAR; PG8_WAIT_L(0); PG8_MMA(0, 1, At, B1); PG8_BAR;
            PG8_LDA(At, 1, 1); PG8_STAGE(PG8_SA(1, 0), a3, voffA);
            PG8_BAR; PG8_WAIT_L(0); PG8_MMA(1, 0, At, B0); PG8_BAR; PG8_SCHED;
            PG8_STAGE(PG8_SB(1, 1), b3 + hstep, voffB);
            PG8_WAIT_V(6); PG8_BAR; PG8_MMA(1, 1, At, B1); PG8_BAR;
            }
        }
        if constexpr (ALIGN_EPI) { if (wr == 0) PG8_BAR; }
        if constexpr (!Epi::AFTER_DRAIN) { E(acc, cur, wr, wc, fr, fq); S.done(cur); }
        if (!has_next) break;
#pragma unroll
        for (int a = 0; a < 2; ++a)
#pragma unroll
            for (int b = 0; b < 2; ++b)
#pragma unroll
                for (int m = 0; m < 4; ++m)
#pragma unroll
                    for (int n = 0; n < 2; ++n) acc[a][b][m][n] = (f32x4){0.f, 0.f, 0.f, 0.f};
        cur = nxt; cA = nA; cB = nB; ++ui;
        if constexpr (ALIGN_EPI) { if (wr == 1) PG8_BAR; }
    }
    PG8_WAIT_V(0);
    if constexpr (!ALIGN_EPI) { if (wr == 0) PG8_BAR; }
    PG8_BAR;
    if constexpr (Epi::AFTER_DRAIN) { E.fused(acc, cur, wr, wc, fr, fq, lds, wid, lane); S.done(cur); }
#undef PG8_SA
#undef PG8_SB
#undef PG8_STAGE
#undef PG8_LDA
#undef PG8_LDB
#undef PG8_MMA
#undef PG8_WAIT_V
#undef PG8_WAIT_L
#undef PG8_BAR
#undef PG8_SCHED
}
}

constexpr int NMIXW = 4864;
struct P2Body {
    const Frame* Fp;
    __device__ __forceinline__ void operator()(int m, int n, const f32x4 v) const {
        const Frame& F = *Fp;
        if (n >= NMIXP) return;
        *(u32x2*)(F.PROJ + (size_t)m * NMIXP + n) = pk4(v);
        if (n >= C_K && n < C_QI) {
            float* o = (n < C_V) ? (m < NTP ? F.out + O_KP + (size_t)m * 128 + (n - C_K) : F.out + O_KS + (size_t)(m - NTP) * 128 + (n - C_K))
                                 : (m < NTP ? F.out + O_VP + (size_t)m * 128 + (n - C_V) : F.out + O_VS + (size_t)(m - NTP) * 128 + (n - C_V));
            *(f32x4*)o = v;
            if (n >= C_V && m < NTP) {
                bf16_t* vt = (bf16_t*)(F.ws + WS_VT) + ((size_t)((m >> 11) * 2 + ((n - C_V) >> 6)) * 64 + ((n - C_V) & 63)) * SEQ + (m & 2047);
                vt[0] = f2bf(v[0]); vt[SEQ] = f2bf(v[1]); vt[2 * SEQ] = f2bf(v[2]); vt[3 * SEQ] = f2bf(v[3]);
            }
        } else if (n >= C_KI && n < C_BG) {
            float* o = m < NTP ? F.out + O_KIP + (size_t)m * 64 + (n - C_KI) : F.out + O_KIS + (size_t)(m - NTP) * 64 + (n - C_KI);
            *(f32x4*)o = v;
        } else if (n == C_WI) {
            *(f32x4*)(F.WI + (size_t)m * 4) = v;
        } else if (n >= C_CG && n < C_GA) {
            const int tt = (m < NTP) ? (m & 2047) - (SEQ - 2) : ((m - NTP) & 7) - (TS - 2);
            if (tt >= 0) {
                const int rowi = (m < NTP) ? (m >> 11) * 2 + tt : 2 * NB_P + ((m - NTP) >> 3) * 2 + tt;
                *(f32x4*)((float*)(F.ws + WS_CGX) + (size_t)rowi * 1024 + (n - C_CG)) = v;
            }
        }
    }
};
__device__ __forceinline__ void p2_gemm_in(const Frame& F) {
    pg8::Gemm g{F.H1, F.WIN, NT, NMIXW, D};
    pg8::StaticOrder S; S.init(NT, NMIXW, F.G, F.bid);
    pg8::EpiRC<P2Body> E{P2Body{&F}};
    pg8::gemm_phase<pg8::EpiRC<P2Body>, pg8::StaticOrder, true, true>(F.lds, g, S, E);
}

constexpr int SROW = 2052;
__device__ __forceinline__ int wave_sum_i(int v) {
#pragma unroll
    for (int o = 32; o >= 1; o >>= 1) v += __shfl_xor(v, o);
    return v;
}
__device__ __forceinline__ void cnt_ge(int& c, unsigned u, unsigned t) { asm("v_cmp_ge_u32_e32 vcc, %1, %2\n\tv_addc_co_u32_e32 %0, vcc, 0, %0, vcc" : "+v"(c) : "v"(u), "v"(t) : "vcc"); }
__device__ __forceinline__ void cnt_gt(int& c, unsigned u, unsigned t) { asm("v_cmp_gt_u32_e32 vcc, %1, %2\n\tv_addc_co_u32_e32 %0, vcc, 0, %0, vcc" : "+v"(c) : "v"(u), "v"(t) : "vcc"); }
__device__ __forceinline__ void cnt_eq(int& c, unsigned u, unsigned t) { asm("v_cmp_eq_u32_e32 vcc, %1, %2\n\tv_addc_co_u32_e32 %0, vcc, 0, %0, vcc" : "+v"(c) : "v"(u), "v"(t) : "vcc"); }
__device__ __forceinline__ void cnt_lt4(int& cl, unsigned u0, unsigned u1, unsigned u2, unsigned u3, unsigned t) {
    int d0, d1, d2, d3;
    asm("v_sub_u32 %1, %5, %9\n\tv_sub_u32 %2, %6, %9\n\tv_sub_u32 %3, %7, %9\n\tv_sub_u32 %4, %8, %9\n\t"
        "v_lshrrev_b32 %1, 31, %1\n\tv_lshrrev_b32 %2, 31, %2\n\tv_lshrrev_b32 %3, 31, %3\n\tv_lshrrev_b32 %4, 31, %4\n\t"
        "v_add3_u32 %0, %0, %1, %2\n\tv_add3_u32 %0, %0, %3, %4"
        : "+v"(cl), "=&v"(d0), "=&v"(d1), "=&v"(d2), "=&v"(d3) : "v"(u0), "v"(u1), "v"(u2), "v"(u3), "v"(t));
}
__device__ __forceinline__ void cnt_eq_pos(int& c, unsigned u, unsigned t, int L) {
    int tmp;
    asm("v_cmp_eq_u32_e32 vcc, %2, %3\n\tv_cndmask_b32_e32 %1, %5, %4, vcc\n\tv_cmp_lt_i32_e32 vcc, 0, %1\n\tv_addc_co_u32_e32 %0, vcc, 0, %0, vcc"
        : "+v"(c), "=&v"(tmp) : "v"(u), "v"(t), "v"(L), "v"(0x80000000) : "vcc");
}
__device__ __forceinline__ int wave_sum_i_dpp(int v) {
    v += __builtin_amdgcn_update_dpp(0, v, 0xB1, 0xF, 0xF, false);
    v += __builtin_amdgcn_update_dpp(0, v, 0x4E, 0xF, 0xF, false);
    v += __builtin_amdgcn_update_dpp(0, v, 0x141, 0xF, 0xF, false);
    v += __builtin_amdgcn_update_dpp(0, v, 0x140, 0xF, 0xF, false);
    v += __builtin_amdgcn_update_dpp(0, v, 0x142, 0xA, 0xF, false);
    v += __builtin_amdgcn_update_dpp(0, v, 0x143, 0xC, 0xF, false);
    return __builtin_amdgcn_readlane(v, 63);
}
template <int NV> __device__ __forceinline__ void select_threshold(const unsigned (&u)[NV], int ksel, int idx_bits, int lane, unsigned& T_out, int& Jx_out, int& ngt_out) {
    unsigned T = 0;
#pragma unroll 1
    for (int bit = 31; bit >= 0; --bit) {
        const unsigned cand = T | (1u << bit);
        int c = 0;
#pragma unroll
        for (int i = 0; i < NV; ++i) cnt_ge(c, u[i], cand);
        c = wave_sum_i_dpp(c);
        if (c >= ksel) T = cand;
    }
    int cg = 0, ce = 0;
#pragma unroll
    for (int i = 0; i < NV; ++i) { cnt_gt(cg, u[i], T); cnt_eq(ce, u[i], T); }
    const int ngt = wave_sum_i_dpp(cg), neq = wave_sum_i_dpp(ce);
    const int need = ksel - ngt;
    int Jx = 0x3FFFFFFF;
    if (need < neq) {
        int Jb = 0;
#pragma unroll 1
        for (int bit = idx_bits - 1; bit >= 0; --bit) {
            const int cand = Jb | (1 << bit);
            const int L = cand - lane;
            int c = 0;
#pragma unroll
            for (int i = 0; i < NV; ++i) cnt_eq_pos(c, u[i], T, L - 64 * i);
            c = wave_sum_i_dpp(c);
            if (c < need) Jb = cand;
        }
        Jx = Jb + 1;
    }
    T_out = T; Jx_out = Jx; ngt_out = ngt;
}
template <int NV> __device__ __forceinline__ void select_threshold2(const unsigned (&ua)[NV], const unsigned (&ub)[NV], int ksel, int idx_bits, int lane, int ng,
                                                                   unsigned& Ta_out, int& Jxa_out, unsigned& Tb_out, int& Jxb_out) {
    unsigned Ta = 0, Tb = 0;
    bool da = false, db = false;
#pragma unroll 1
    for (int bit = 30; bit >= 0 && !(da && db); --bit) {
        const unsigned ca = da ? Ta : (Ta | (1u << bit)), cb = db ? Tb : (Tb | (1u << bit));
        int la = 0, lb = 0;
#pragma unroll
        for (int i = 0; i < NV; i += 4) { if (i < 4 * ng) { cnt_lt4(la, ua[i], ua[i + 1], ua[i + 2], ua[i + 3], ca); cnt_lt4(lb, ub[i], ub[i + 1], ub[i + 2], ub[i + 3], cb); } }
        const int na = ng * 256 - wave_sum_i_dpp(la), nb = ng * 256 - wave_sum_i_dpp(lb);
        if (!da && na >= ksel) { Ta = ca; da = (na == ksel); }
        if (!db && nb >= ksel) { Tb = cb; db = (nb == ksel); }
    }
    int ga = 0, ea = 0, gb = 0, eb = 0;
#pragma unroll
    for (int i = 0; i < NV; ++i) { cnt_gt(ga, ua[i], Ta); cnt_eq(ea, ua[i], Ta); cnt_gt(gb, ub[i], Tb); cnt_eq(eb, ub[i], Tb); }
    const int needa = ksel - wave_sum_i_dpp(ga), neqa = wave_sum_i_dpp(ea), needb = ksel - wave_sum_i_dpp(gb), neqb = wave_sum_i_dpp(eb);
    int Jxa = 0x3FFFFFFF, Jxb = 0x3FFFFFFF;
    if (needa < neqa) {
        int Jb = 0;
#pragma unroll 1
        for (int bit = idx_bits - 1; bit >= 0; --bit) {
            const int cand = Jb | (1 << bit); const int L = cand - lane; int c = 0;
#pragma unroll
            for (int i = 0; i < NV; ++i) cnt_eq_pos(c, ua[i], Ta, L - 64 * i);
            if (wave_sum_i_dpp(c) < needa) Jb = cand;
        }
        Jxa = Jb + 1;
    }
    if (needb < neqb) {
        int Jb = 0;
#pragma unroll 1
        for (int bit = idx_bits - 1; bit >= 0; --bit) {
            const int cand = Jb | (1 << bit); const int L = cand - lane; int c = 0;
#pragma unroll
            for (int i = 0; i < NV; ++i) cnt_eq_pos(c, ub[i], Tb, L - 64 * i);
            if (wave_sum_i_dpp(c) < needb) Jb = cand;
        }
        Jxb = Jb + 1;
    }
    Ta_out = Ta; Jxa_out = Jxa; Tb_out = Tb; Jxb_out = Jxb;
}
template <int NV> __device__ __forceinline__ void select_topk(const unsigned (&u)[NV], int ksel, int idx_bits, int* sel, int lane) {
    unsigned T; int Jx, ngt;
    select_threshold<NV>(u, ksel, idx_bits, lane, T, Jx, ngt);
    const int L = Jx - lane;
    int cg = 0, ct = 0;
#pragma unroll
    for (int i = 0; i < NV; ++i) { cnt_gt(cg, u[i], T); cnt_eq_pos(ct, u[i], T, L - 64 * i); }
    int ig = cg, it = ct;
#pragma unroll
    for (int o = 1; o < 64; o <<= 1) { const int a = __shfl_up(ig, o), b2 = __shfl_up(it, o); if (lane >= o) { ig += a; it += b2; } }
    int pg = ig - cg, pt = ngt + it - ct;
    int ev = lane, Lr = L;
#pragma unroll
    for (int i = 0; i < NV; ++i) {
        if (u[i] > T) { sel[pg] = ev; ++pg; }
        else if (u[i] == T && Lr > 0) { sel[pt] = ev; ++pt; }
        asm volatile("v_add_u32 %0, 64, %0\n\tv_add_u32 %1, -64, %1" : "+v"(ev), "+v"(Lr));
    }
}

constexpr int PU_MB = 16 * SROW * 4;
constexpr int PU_RB = PU_MB + 16 * 64 * 4;
constexpr int PU_BT = PU_RB + 1024;
constexpr int PU_QT = PU_BT + 512, PU_QROW = 1040;
__device__ __forceinline__ int kappa32(int r) { return (r & 0x13) | ((r & 4) << 1) | ((r & 8) >> 1); }
__device__ __forceinline__ void p3_prompt_fused_unit(const Frame& F, const bf16_t* VT, int b, int qt) {
    LAS float* S = (LAS float*)F.lds;
    LAS unsigned* MB = (LAS unsigned*)(F.lds + PU_MB);
    LAS float* RB = (LAS float*)(F.lds + PU_RB);
    LAS int* BT = (LAS int*)(F.lds + PU_BT);
    const int lane = F.lane;
    const int q0 = qt * 16; const size_t tok0 = (size_t)b * SEQ;
    __syncthreads();
    for (int ch = F.tid; ch < 16 * 64; ch += NTHREADS) {
        const u32x4 qv = *(const u32x4*)(F.PROJ + (tok0 + q0 + (ch >> 6)) * NMIXP + C_Q + (ch & 63) * 8);
        constexpr float QS = ATTN_SCALE * 1.4426950408889634f;
        *(LAS u32x4*)(F.lds + PU_QT + (ch >> 6) * PU_QROW + (ch & 63) * 16) = (u32x4){cvt_pk_bf16(bflo(qv[0]) * QS, bfhi(qv[0]) * QS), cvt_pk_bf16(bflo(qv[1]) * QS, bfhi(qv[1]) * QS),
                                                                                    cvt_pk_bf16(bflo(qv[2]) * QS, bfhi(qv[2]) * QS), cvt_pk_bf16(bflo(qv[3]) * QS, bfhi(qv[3]) * QS)};
    }
    {
        const int r = lane & 15, q4 = lane >> 4;
        bf16x8 A[4][2];
#pragma unroll
        for (int hh = 0; hh < 4; ++hh)
#pragma unroll
            for (int s2 = 0; s2 < 2; ++s2) A[hh][s2] = *(const bf16x8*)(F.PROJ + (tok0 + q0 + r) * NMIXP + C_QI + hh * 64 + s2 * 32 + q4 * 8);
        float wv[4][4];
#pragma unroll
        for (int g = 0; g < 4; ++g) { const f32x4 w4 = *(const f32x4*)(F.WI + (tok0 + q0 + 4 * q4 + g) * 4);
#pragma unroll
            for (int hh = 0; hh < 4; ++hh) wv[g][hh] = w4[hh] * IDX_SCALE; }
        const int nkt = qt + 1;
        bf16x8 Bn[2][2];
        {
            const int t0 = 2 * F.wave;
#pragma unroll
            for (int p = 0; p < 2; ++p)
#pragma unroll
                for (int s2 = 0; s2 < 2; ++s2) { const int key = (t0 + p < nkt ? t0 + p : 0) * 16 + r; Bn[p][s2] = *(const bf16x8*)(F.PROJ + (tok0 + key) * NMIXP + C_KI + s2 * 32 + q4 * 8); }
        }
#pragma unroll 1
        for (int t0 = 2 * F.wave; t0 < nkt; t0 += 16) {
            bf16x8 B[2][2] = {{Bn[0][0], Bn[0][1]}, {Bn[1][0], Bn[1][1]}};
            {
                const int tn = t0 + 16;
#pragma unroll
                for (int p = 0; p < 2; ++p)
#pragma unroll
                    for (int s2 = 0; s2 < 2; ++s2) { const int key = (tn + p < nkt ? tn + p : 0) * 16 + r; Bn[p][s2] = *(const bf16x8*)(F.PROJ + (tok0 + key) * NMIXP + C_KI + s2 * 32 + q4 * 8); }
            }
#pragma unroll
            for (int p = 0; p < 2; ++p) {
                if (t0 + p >= nkt) continue;
                float sc[4] = {0.f, 0.f, 0.f, 0.f};
#pragma unroll
                for (int hh = 0; hh < 4; ++hh) {
                    f32x4 c = {0.f, 0.f, 0.f, 0.f};
                    c = __builtin_amdgcn_mfma_f32_16x16x32_bf16(A[hh][0], B[p][0], c, 0, 0, 0);
                    c = __builtin_amdgcn_mfma_f32_16x16x32_bf16(A[hh][1], B[p][1], c, 0, 0, 0);
#pragma unroll
                    for (int g = 0; g < 4; ++g) sc[g] += fmaxf(c[g], 0.f) * wv[g][hh];
                }
#pragma unroll
                for (int g = 0; g < 4; ++g) S[(4 * q4 + g) * SROW + (t0 + p) * 16 + r] = sc[g];
            }
        }
    }
    __syncthreads();
    {
        const int rowa = F.wave * 2, rowb = rowa + 1;
        const int nva = q0 + rowa + 1, nvb = nva + 1;
        if (nvb <= NSEL) {
#pragma unroll
            for (int i = 0; i < 32; ++i) {
                const unsigned long long ma = __ballot(lane + 64 * i < nva), mb = __ballot(lane + 64 * i < nvb);
                if (lane == 0) { MB[rowa * 64 + 2 * i] = (unsigned)ma; MB[rowa * 64 + 2 * i + 1] = (unsigned)(ma >> 32); MB[rowb * 64 + 2 * i] = (unsigned)mb; MB[rowb * 64 + 2 * i + 1] = (unsigned)(mb >> 32); }
            }
        } else {
            unsigned ua[32], ub[32];
#pragma unroll
            for (int i = 0; i < 32; ++i) { const int j = lane + 64 * i; ua[i] = (j < nva) ? (f2ord(S[rowa * SROW + j]) >> 1) : 0u; ub[i] = (j < nvb) ? (f2ord(S[rowb * SROW + j]) >> 1) : 0u; }
            unsigned Ta, Tb; int Jxa, Jxb;
            select_threshold2<32>(ua, ub, NSEL, 11, lane, (nvb + 255) >> 8, Ta, Jxa, Tb, Jxb);
            const int La = Jxa - lane, Lb = Jxb - lane;
#pragma unroll
            for (int i = 0; i < 32; ++i) {
                const bool ta = (ua[i] > Ta) || (ua[i] == Ta && (La - 64 * i) > 0), tb = (ub[i] > Tb) || (ub[i] == Tb && (Lb - 64 * i) > 0);
                const unsigned long long ma = __ballot(ta), mb = __ballot(tb);
                if (lane == 0) { MB[rowa * 64 + 2 * i] = (unsigned)ma; MB[rowa * 64 + 2 * i + 1] = (unsigned)(ma >> 32); MB[rowb * 64 + 2 * i] = (unsigned)mb; MB[rowb * 64 + 2 * i + 1] = (unsigned)(mb >> 32); }
            }
        }
    }
    __syncthreads();
    {
        const int g = F.wave & 1, kq = F.wave >> 1;
        const int c = lane & 31, h = lane >> 5;
        const int hd = g * 4 + (c & 3);
        LAS const unsigned char* Qb = F.lds + PU_QT + (c >> 2) * PU_QROW + (hd * 64 + h * 8) * 2;
        constexpr float L2E = 1.4426950408889634f;
        const float b31 = RB[31 * 8 + hd] * L2E;
        const int ntile = ((q0 + 15) >> 5) + 1;
        const bf16_t* Kb = F.PROJ + (tok0 + kappa32(c)) * NMIXP + C_K + g * 64 + h * 8;
        const bf16_t* Vb = VT + ((size_t)((b * 2 + g) * 64 + c)) * SEQ + h * 8;
        f32x16 O[2][2];
#pragma unroll
        for (int rt = 0; rt < 2; ++rt)
#pragma unroll
            for (int d = 0; d < 2; ++d)
#pragma unroll
                for (int e = 0; e < 16; ++e) O[rt][d][e] = 0.f;
        float lsum[2] = {0.f, 0.f};
        bf16x8 Kn[4];
        {
            const int key0 = (kq < ntile ? kq : 0) * 32;
#pragma unroll
            for (int s4 = 0; s4 < 4; ++s4) Kn[s4] = *(const bf16x8*)(Kb + (size_t)key0 * NMIXP + s4 * 16);
        }
#pragma unroll 1
        for (int kt = kq; kt < ntile; kt += 4) {
            const int key0 = kt * 32;
            bf16x8 Kf[4] = {Kn[0], Kn[1], Kn[2], Kn[3]}, Vf[2][2];
#pragma unroll
            for (int d = 0; d < 2; ++d)
#pragma unroll
                for (int s2 = 0; s2 < 2; ++s2) Vf[d][s2] = *(const bf16x8*)(Vb + (size_t)(32 * d) * SEQ + key0 + 16 * s2);
            {
                const int keyn = (kt + 4 < ntile ? kt + 4 : 0) * 32;
#pragma unroll
                for (int s4 = 0; s4 < 4; ++s4) Kn[s4] = *(const bf16x8*)(Kb + (size_t)keyn * NMIXP + s4 * 16);
            }
#pragma unroll
            for (int rt = 0; rt < 2; ++rt) {
                const int ql = rt * 8 + (c >> 2), q = q0 + ql;
                f32x16 X;
#pragma unroll
                for (int e = 0; e < 16; ++e) X[e] = 0.f;
#pragma unroll
                for (int s4 = 0; s4 < 4; ++s4) X = __builtin_amdgcn_mfma_f32_32x32x16_bf16(Kf[s4], *(LAS const bf16x8*)(Qb + rt * 8 * PU_QROW + s4 * 32), X, 0, 0, 0);
                const unsigned word = MB[ql * 64 + kt];
                const unsigned bits = ((word >> (8 * h)) & 0xFFu) | (((word >> (16 + 8 * h)) & 0xFFu) << 8);
                const bool nearT = (q0 + rt * 8) - (key0 + 31) < 113;
#pragma unroll
                for (int s2 = 0; s2 < 2; ++s2) {
                    float P[8];
                    if (nearT) {
#pragma unroll
                        for (int e8 = 0; e8 < 8; ++e8) {
                            const int e = 8 * s2 + e8;
                            const int key = key0 + e8 + 16 * s2 + 8 * h;
                            int dist = q - key; dist = dist < 0 ? 0 : (dist > 127 ? 127 : dist);
                            const float bias = RB[BT[dist] * 8 + hd] * L2E;
                            const float lg = fminf(X[e] + bias, 86.f);
                            P[e8] = __int_as_float(__float_as_int(__builtin_amdgcn_exp2f(lg)) & __builtin_amdgcn_sbfe((int)bits, e, 1));
                        }
                    } else {
#pragma unroll
                        for (int e8 = 0; e8 < 8; ++e8) {
                            const int e = 8 * s2 + e8;
                            const float lg = fminf(X[e] + b31, 86.f);
                            P[e8] = __int_as_float(__float_as_int(__builtin_amdgcn_exp2f(lg)) & __builtin_amdgcn_sbfe((int)bits, e, 1));
                        }
                    }
#pragma unroll
                    for (int e8 = 0; e8 < 8; ++e8) lsum[rt] += P[e8];
                    const u32x4 pk = (u32x4){cvt_pk_bf16(P[0], P[1]), cvt_pk_bf16(P[2], P[3]), cvt_pk_bf16(P[4], P[5]), cvt_pk_bf16(P[6], P[7])};
                    bf16x8 Pf; __builtin_memcpy(&Pf, &pk, 16);
                    O[rt][0] = __builtin_amdgcn_mfma_f32_32x32x16_bf16(Vf[0][s2], Pf, O[rt][0], 0, 0, 0);
                    O[rt][1] = __builtin_amdgcn_mfma_f32_32x32x16_bf16(Vf[1][s2], Pf, O[rt][1], 0, 0, 0);
                }
                __builtin_amdgcn_sched_barrier(0);
            }
        }
        LAS float* CB = (LAS float*)F.lds + (g * 3 + (kq > 0 ? kq - 1 : 0)) * (66 * 64);
        __syncthreads();
        if (kq > 0) {
#pragma unroll
            for (int rt = 0; rt < 2; ++rt) {
#pragma unroll
                for (int d = 0; d < 2; ++d)
#pragma unroll
                    for (int e = 0; e < 16; ++e) CB[((rt * 2 + d) * 16 + e) * 64 + lane] = O[rt][d][e];
                CB[(64 + rt) * 64 + lane] = lsum[rt];
            }
        }
        __syncthreads();
        if (kq == 0) {
#pragma unroll 1
            for (int p = 0; p < 3; ++p) {
                LAS const float* CP = (LAS const float*)F.lds + (g * 3 + p) * (66 * 64);
#pragma unroll
                for (int rt = 0; rt < 2; ++rt) {
#pragma unroll
                    for (int d = 0; d < 2; ++d)
#pragma unroll
                        for (int e = 0; e < 16; ++e) O[rt][d][e] += CP[((rt * 2 + d) * 16 + e) * 64 + lane];
                    lsum[rt] += CP[(64 + rt) * 64 + lane];
                }
            }
#pragma unroll
            for (int rt = 0; rt < 2; ++rt) {
                float l = lsum[rt]; l += __shfl_xor(l, 32);
                const float inv = 1.f / l;
                bf16_t* orow = F.OATT + (tok0 + q0 + rt * 8 + (c >> 2)) * 512 + hd * 64;
#pragma unroll
                for (int a4 = 0; a4 < 4; ++a4) {
                    const f32x4 v0 = (f32x4){O[rt][0][4 * a4], O[rt][0][4 * a4 + 1], O[rt][0][4 * a4 + 2], O[rt][0][4 * a4 + 3]} * inv;
                    const f32x4 v1 = (f32x4){O[rt][1][4 * a4], O[rt][1][4 * a4 + 1], O[rt][1][4 * a4 + 2], O[rt][1][4 * a4 + 3]} * inv;
                    *(u32x2*)(orow + 8 * a4 + 4 * h) = pk4(v0);
                    *(u32x2*)(orow + 32 + 8 * a4 + 4 * h) = pk4(v1);
                }
            }
        }
    }
}

__device__ __forceinline__ void p3_sample_score_unit(const Frame& F, float* SS, int b, int ch) {
    const int lane = F.lane, r = lane & 31, h = lane >> 5;
    bf16x8 A[4];
    { const int q = r >> 2, hh = r & 3;
#pragma unroll
      for (int s4 = 0; s4 < 4; ++s4) A[s4] = *(const bf16x8*)(F.PROJ + (size_t)(NTP + b * TS + q) * NMIXP + C_QI + hh * 64 + s4 * 16 + h * 8); }
    float wv[4][4];
#pragma unroll
    for (int g = 0; g < 4; ++g) { const f32x4 w4 = *(const f32x4*)(F.WI + (size_t)(NTP + b * TS + 2 * g + h) * 4);
#pragma unroll
        for (int hh = 0; hh < 4; ++hh) wv[g][hh] = w4[hh] * IDX_SCALE; }
    f32x4 kn[8];
    { const int key0 = ch * 1024 + F.wave * 32; const int page = F.page_table[b * NPAGES + (key0 >> 7)];
      const float* kr = F.cache_ki + ((size_t)page * PAGE + (key0 & 127) + r) * 64 + h * 8;
#pragma unroll
      for (int s4 = 0; s4 < 4; ++s4) { kn[2 * s4] = *(const f32x4*)(kr + s4 * 16); kn[2 * s4 + 1] = *(const f32x4*)(kr + s4 * 16 + 4); } }
#pragma unroll 1
    for (int tl = F.wave; tl < 32; tl += 8) {
        const int key0 = ch * 1024 + tl * 32;
        f32x4 kc[8];
#pragma unroll
        for (int i = 0; i < 8; ++i) kc[i] = kn[i];
        if (tl + 8 < 32) {
            const int keyn = key0 + 256; const int page = F.page_table[b * NPAGES + (keyn >> 7)];
            const float* kr = F.cache_ki + ((size_t)page * PAGE + (keyn & 127) + r) * 64 + h * 8;
#pragma unroll
            for (int s4 = 0; s4 < 4; ++s4) { kn[2 * s4] = *(const f32x4*)(kr + s4 * 16); kn[2 * s4 + 1] = *(const f32x4*)(kr + s4 * 16 + 4); }
        }
        f32x16 c;
#pragma unroll
        for (int e = 0; e < 16; ++e) c[e] = 0.f;
#pragma unroll
        for (int s4 = 0; s4 < 4; ++s4) {
            const f32x4 lo = kc[2 * s4], hi = kc[2 * s4 + 1];
            const u32x4 pk = (u32x4){cvt_pk_bf16(lo[0], lo[1]), cvt_pk_bf16(lo[2], lo[3]), cvt_pk_bf16(hi[0], hi[1]), cvt_pk_bf16(hi[2], hi[3])};
            bf16x8 Bf; __builtin_memcpy(&Bf, &pk, 16);
            c = __builtin_amdgcn_mfma_f32_32x32x16_bf16(A[s4], Bf, c, 0, 0, 0);
        }
#pragma unroll
        for (int g = 0; g < 4; ++g) {
            float sc = 0.f;
#pragma unroll
            for (int hh = 0; hh < 4; ++hh) sc += fmaxf(c[4 * g + hh], 0.f) * wv[g][hh];
            SS[(size_t)(b * TS + 2 * g + h) * PAST + key0 + r] = sc;
        }
    }
}
__device__ __forceinline__ void p3_index(const Frame& F) {
    constexpr int NSU = NB_S * 8;
    const int nunits = NSU + NB_P * (SEQ / 16);
    float* SS = (float*)(F.ws + WS_SS);
    const bf16_t* VT = (const bf16_t*)(F.ws + WS_VT);
    __syncthreads();
    if (F.tid < 256) ((LAS float*)(F.lds + PU_RB))[F.tid] = F.rel_bias[F.tid];
    if (F.tid < 128) ((LAS int*)(F.lds + PU_BT))[F.tid] = t5_bucket(F.tid);
    __syncthreads();
    for (int it = F.bid; it < nunits; it += F.G) {
        if (it < NSU) { p3_sample_score_unit(F, SS, it >> 3, it & 7); continue; }
        const int i = it - NSU; const int b = i & 7, sl = (i >> 3) & 31, rnd = i >> 8;
        const int qt = rnd == 0 ? 127 - sl : (rnd == 1 ? 64 + sl : (rnd == 2 ? 63 - sl : sl));
        p3_prompt_fused_unit(F, VT, b, qt);
    }
}

constexpr int SQ_CNT = 0;
constexpr int SQ_SEL = 1024;
constexpr int SQ_Q = 2048;
constexpr int SQ_PHYS = 3072;
constexpr int SQ_P = 4096;
constexpr int SQ_RB = 16384;
constexpr int SQ_BT = 17408;
__device__ __forceinline__ int wg_sum8(const Frame& F, LAS unsigned* slot, int v) {
    if (F.lane == 0) slot[F.wave] = (unsigned)v;
    __syncthreads();
    int t = 0;
#pragma unroll
    for (int w = 0; w < 8; ++w) t += (int)slot[w];
    return t;
}
__device__ __forceinline__ void p4_sample_query_unit(const Frame& F, const float* SS, int b, int t) {
    const int lane = F.lane, w = F.wave;
    LAS unsigned* CNT = (LAS unsigned*)(F.lds + SQ_CNT);
    LAS int* SELL = (LAS int*)(F.lds + SQ_SEL);
    LAS unsigned* QL = (LAS unsigned*)(F.lds + SQ_Q);
    LAS float* PL = (LAS float*)(F.lds + SQ_P) + w * 256;
    LAS float* RB = (LAS float*)(F.lds + SQ_RB);
    LAS int* BT = (LAS int*)(F.lds + SQ_BT);
    const int tok = NTP + b * TS + t;
    __syncthreads();
    if (F.tid < 256) QL[F.tid] = ((const unsigned*)(F.PROJ + (size_t)tok * NMIXP + C_Q))[F.tid];
    unsigned u[17];
    { const float* srow = SS + (size_t)(b * TS + t) * PAST + w * 1024;
#pragma unroll
      for (int i = 0; i < 16; ++i) u[i] = f2ord(srow[64 * i + lane]); }
    u[16] = 0u;
    if (w == 7) {
        const int kj = lane < TS ? lane : 0;
        const bf16_t* kn = F.PROJ + (size_t)(NTP + b * TS + kj) * NMIXP + C_KI;
        const bf16_t* qn = F.PROJ + (size_t)tok * NMIXP + C_QI;
        u32x4 kv[8];
#pragma unroll
        for (int c = 0; c < 8; ++c) kv[c] = *(const u32x4*)(kn + c * 8);
        int vz; asm volatile("v_mov_b32 %0, 0" : "=v"(vz));
        const f32x4 w4 = *(const f32x4*)(F.WI + (size_t)tok * 4 + vz);
        float sc = 0.f;
#pragma unroll
        for (int hh = 0; hh < 4; ++hh) {
            u32x4 qv[8];
#pragma unroll
            for (int c = 0; c < 8; ++c) qv[c] = *(const u32x4*)(qn + hh * 64 + c * 8 + vz);
            float d = 0.f;
#pragma unroll
            for (int c = 0; c < 8; ++c)
#pragma unroll
                for (int e = 0; e < 4; ++e) d += bflo(qv[c][e]) * bflo(kv[c][e]) + bfhi(qv[c][e]) * bfhi(kv[c][e]);
            sc += fmaxf(d, 0.f) * (w4[hh] * IDX_SCALE);
        }
        u[16] = (lane < TS && lane <= t) ? f2ord(sc) : 0u;
    }
    unsigned T = 0;
#pragma unroll 1
    for (int bit = 31; bit >= 0; --bit) {
        const unsigned cand = T | (1u << bit);
        int c = 0;
#pragma unroll
        for (int i = 0; i < 17; ++i) cnt_ge(c, u[i], cand);
        c = wg_sum8(F, CNT + (bit & 1) * 24, wave_sum_i_dpp(c));
        if (c >= NSEL) T = cand;
        if (c == NSEL) break;
    }
    int cg = 0, ce = 0;
#pragma unroll
    for (int i = 0; i < 17; ++i) { cnt_gt(cg, u[i], T); cnt_eq(ce, u[i], T); }
    const int cgw = wave_sum_i_dpp(cg);
    const int ngt = wg_sum8(F, CNT + 8, cgw);
    const int neq = wg_sum8(F, CNT + 16, wave_sum_i_dpp(ce));
    const int need = NSEL - ngt;
    int Jx = 0x3FFFFFFF;
    if (need < neq) {
        int Jb = 0;
#pragma unroll 1
        for (int bit = 13; bit >= 0; --bit) {
            const int cand = Jb | (1 << bit);
            const int L = cand - lane - 1024 * w;
            int c = 0;
#pragma unroll
            for (int i = 0; i < 17; ++i) cnt_eq_pos(c, u[i], T, L - 64 * i);
            c = wg_sum8(F, CNT + (bit & 1) * 24, wave_sum_i_dpp(c));
            if (c < need) Jb = cand;
        }
        Jx = Jb + 1;
    }
    {
        const int L = Jx - lane - 1024 * w;
        int ct = 0;
#pragma unroll
        for (int i = 0; i < 17; ++i) cnt_eq_pos(ct, u[i], T, L - 64 * i);
        const int ctw = wave_sum_i_dpp(ct);
        __syncthreads();
        if (lane == 0) { CNT[w] = (unsigned)cgw; CNT[8 + w] = (unsigned)ctw; }
        __syncthreads();
        int bg = 0, bt = ngt;
#pragma unroll
        for (int ww = 0; ww < 8; ++ww) { if (ww < w) { bg += (int)CNT[ww]; bt += (int)CNT[8 + ww]; } }
        int ig = cg, it2 = ct;
#pragma unroll
        for (int o = 1; o < 64; o <<= 1) { const int a = __shfl_up(ig, o), b2 = __shfl_up(it2, o); if (lane >= o) { ig += a; it2 += b2; } }
        int pg = bg + ig - cg, pt = bt + it2 - ct;
        int ev = 1024 * w + lane, Lr = L;
#pragma unroll
        for (int i = 0; i < 17; ++i) {
            if (u[i] > T) { SELL[pg] = ev; ++pg; }
            else if (u[i] == T && Lr > 0) { SELL[pt] = ev; ++pt; }
            asm volatile("v_add_u32 %0, 64, %0\n\tv_add_u32 %1, -64, %1" : "+v"(ev), "+v"(Lr));
        }
    }
    __syncthreads();
    LAS int* PHYS = (LAS int*)(F.lds + SQ_PHYS);
    if (F.tid < 256) { const int sraw = SELL[F.tid]; PHYS[F.tid] = (sraw < PAST) ? F.page_table[b * NPAGES + (sraw >> 7)] * PAGE + (sraw & 127) : -1 - (sraw - PAST); }
    __syncthreads();
    {
        const int hd = w, g = w >> 2, qpos = PAST + t;
        float lg[4];
#pragma unroll 2
        for (int i = 0; i < 4; ++i) {
            const int sraw = SELL[lane + 64 * i], ph = PHYS[lane + 64 * i];
            const float* kr = (ph >= 0) ? F.cache_k + (size_t)ph * 128 + g * 64 : F.out + O_KS + (size_t)(b * TS + (-1 - ph)) * 128 + g * 64;
            float a0 = 0.f, a1 = 0.f;
#pragma unroll
            for (int c = 0; c < 16; ++c) {
                const f32x4 kv = *(const f32x4*)(kr + c * 4);
                const unsigned q0 = QL[hd * 32 + c * 2], q1 = QL[hd * 32 + c * 2 + 1];
                a0 += bflo(q0) * kv[0] + bfhi(q0) * kv[1]; a1 += bflo(q1) * kv[2] + bfhi(q1) * kv[3];
            }
            const int dist = qpos - sraw; const int bk = dist < 128 ? BT[dist] : 31;
            lg[i] = (a0 + a1) * ATTN_SCALE + RB[bk * 8 + hd];
        }
        float m = fmaxf(fmaxf(lg[0], lg[1]), fmaxf(lg[2], lg[3])); m = wave_max(m);
        float sm = 0.f;
#pragma unroll
        for (int i = 0; i < 4; ++i) { lg[i] = __expf(lg[i] - m); sm += lg[i]; }
        const float inv = 1.f / wave_sum_dpp(sm);
#pragma unroll
        for (int i = 0; i < 4; ++i) PL[lane + 64 * i] = lg[i] * inv;
        const int dq = lane & 15, ks = lane >> 4;
        f32x4 o4 = {0.f, 0.f, 0.f, 0.f};
#pragma unroll 1
        for (int j0 = 0; j0 < 256; j0 += 64) {
            f32x4 vv[16]; float pp[16];
#pragma unroll
            for (int jj = 0; jj < 16; ++jj) {
                const int j = j0 + jj * 4 + ks;
                const int ph = PHYS[j]; pp[jj] = PL[j];
                const float* vr = (ph >= 0) ? F.cache_v + (size_t)ph * 128 + g * 64 : F.out + O_VS + (size_t)(b * TS + (-1 - ph)) * 128 + g * 64;
                vv[jj] = *(const f32x4*)(vr + 4 * dq);
            }
#pragma unroll
            for (int jj = 0; jj < 16; ++jj) o4 += vv[jj] * pp[jj];
        }
#pragma unroll
        for (int e = 0; e < 4; ++e) { o4[e] += __shfl_xor(o4[e], 16); o4[e] += __shfl_xor(o4[e], 32); }
        if (ks == 0) *(u32x2*)(F.OATT + (size_t)tok * 512 + hd * 64 + 4 * dq) = pk4(o4);
    }
}
__device__ __forceinline__ void p4_attention(const Frame& F) {
    const float* SS = (const float*)(F.ws + WS_SS);
    __syncthreads();
    if (F.tid < 256) ((LAS float*)(F.lds + SQ_RB))[F.tid] = F.rel_bias[F.tid];
    if (F.tid < 128) ((LAS int*)(F.lds + SQ_BT))[F.tid] = t5_bucket(F.tid);
    __syncthreads();
    for (int it = F.bid; it < NTS; it += F.G) p4_sample_query_unit(F, SS, it >> 3, it & 7);
    {
        const int c0 = F.lane * 8;
        float cw0[8], cw1[8], cw2[8], cbv[8];
#pragma unroll
        for (int e = 0; e < 8; ++e) { cw0[e] = F.conv_w[c0 + e]; cw1[e] = F.conv_w[512 + c0 + e]; cw2[e] = F.conv_w[1024 + c0 + e]; cbv[e] = F.conv_b[c0 + e]; }
        const int stride = F.G * 8;
        u32x4 n_cg[3], n_xi[3], n_bg;
        auto fetch = [&](int m) {
#pragma unroll
            for (int d = 0; d < 3; ++d) { const int mm = (m - d >= 0) ? m - d : 0; n_cg[d] = *(const u32x4*)(F.PROJ + (size_t)mm * NMIXP + C_CG + c0); n_xi[d] = *(const u32x4*)(F.PROJ + (size_t)mm * NMIXP + C_XIN + c0); }
            n_bg = *(const u32x4*)(F.PROJ + (size_t)m * NMIXP + C_BG + c0);
        };
        { const int m = F.bid * 8 + F.wave; fetch(m < NT ? m : 0); }
        for (int m = F.bid * 8 + F.wave; m < NT; m += stride) {
            u32x4 cg[3], xi[3]; const u32x4 bg = n_bg;
#pragma unroll
            for (int d = 0; d < 3; ++d) { cg[d] = n_cg[d]; xi[d] = n_xi[d]; }
            fetch(m + stride < NT ? m + stride : m);
            int t, T_, bsm; if (m < NTP) { t = m & 2047; T_ = SEQ; bsm = m >> 11; } else { t = (m - NTP) & 7; T_ = TS; bsm = (m - NTP) >> 3; }
            float u[3][8];
#pragma unroll
            for (int d = 0; d < 3; ++d) {
                if (t - d >= 0) {
#pragma unroll
                    for (int e = 0; e < 4; ++e) { u[d][2 * e] = bflo(cg[d][e]) * bflo(xi[d][e]); u[d][2 * e + 1] = bfhi(cg[d][e]) * bfhi(xi[d][e]); }
                } else if (m >= NTP) {
                    const float* pv = F.state_conv + ((size_t)bsm * 2 + (2 + t - d)) * 512 + c0;
#pragma unroll
                    for (int e = 0; e < 8; ++e) u[d][e] = pv[e];
                } else {
#pragma unroll
                    for (int e = 0; e < 8; ++e) u[d][e] = 0.f;
                }
            }
            float y[8];
#pragma unroll
            for (int e = 0; e < 8; ++e) {
                const float yy = cbv[e] + cw0[e] * u[2][e] + cw1[e] * u[1][e] + cw2[e] * u[0][e];
                const float bgv = (e & 1) ? bfhi(bg[e >> 1]) : bflo(bg[e >> 1]);
                y[e] = bgv * yy;
            }
            *(u32x4*)(F.OCONV + (size_t)m * 512 + c0) = (u32x4){cvt_pk_bf16(y[0], y[1]), cvt_pk_bf16(y[2], y[3]), cvt_pk_bf16(y[4], y[5]), cvt_pk_bf16(y[6], y[7])};
            if (t >= T_ - 2) {
                float* o = (m < NTP ? F.out + O_CP : F.out + O_CS) + ((size_t)bsm * 2 + (t - (T_ - 2))) * 512 + c0;
                const int rowi = (m < NTP) ? bsm * 2 + (t - (T_ - 2)) : 2 * NB_P + bsm * 2 + (t - (T_ - 2));
                const float* cx = (const float*)(F.ws + WS_CGX) + (size_t)rowi * 1024 + c0;
                const f32x4 ca = *(const f32x4*)cx, cb2 = *(const f32x4*)(cx + 4), xa = *(const f32x4*)(cx + 512), xb = *(const f32x4*)(cx + 516);
                *(f32x4*)o = ca * xa; *(f32x4*)(o + 4) = cb2 * xb;
            }
        }
    }
}

#define P5_EPI(A1, A2) { \
            const f32x4 va = ACC4(A1), vc = ACC4(A2); \
            const u32x2 ga = *(const u32x2*)(F.PROJ + (size_t)m * NMIXP + C_GA + n), gb = *(const u32x2*)(F.PROJ + (size_t)m * NMIXP + C_GB + n); \
            f32x4 o; \
            o[0] = sigmoidf_(bflo(ga[0])) * va[0] + sigmoidf_(bflo(gb[0])) * vc[0]; \
            o[1] = sigmoidf_(bfhi(ga[0])) * va[1] + sigmoidf_(bfhi(gb[0])) * vc[1]; \
            o[2] = sigmoidf_(bflo(ga[1])) * va[2] + sigmoidf_(bflo(gb[1])) * vc[2]; \
            o[3] = sigmoidf_(bfhi(ga[1])) * va[3] + sigmoidf_(bfhi(gb[1])) * vc[3]; \
            *(u32x2*)(F.MERGED + (size_t)m * D + n) = pk4(o); }
struct P5aBody {
    const Frame* Fp;
    __device__ __forceinline__ void operator()(int m, int n, const f32x4 v) const { *(u32x2*)(Fp->MERGED + (size_t)m * D + n) = pk4(v); }
};
struct P5bBody {
    const Frame* Fp;
    __device__ __forceinline__ void operator()(int m, int n, const f32x4 v) const {
        const Frame& F = *Fp;
        const u32x2 ga = *(const u32x2*)(F.PROJ + (size_t)m * NMIXP + C_GA + n), gb = *(const u32x2*)(F.PROJ + (size_t)m * NMIXP + C_GB + n);
        const u32x2 pa = *(const u32x2*)(F.MERGED + (size_t)m * D + n);
        const f32x4 o = (f32x4){sigmoidf_(bflo(ga[0])) * bflo(pa[0]) + sigmoidf_(bflo(gb[0])) * v[0], sigmoidf_(bfhi(ga[0])) * bfhi(pa[0]) + sigmoidf_(bfhi(gb[0])) * v[1],
                                sigmoidf_(bflo(ga[1])) * bflo(pa[1]) + sigmoidf_(bflo(gb[1])) * v[2], sigmoidf_(bfhi(ga[1])) * bfhi(pa[1]) + sigmoidf_(bfhi(gb[1])) * v[3]};
        *(u32x2*)(F.MERGED + (size_t)m * D + n) = pk4(o);
    }
};
__device__ __forceinline__ void p5_gemm_merge(const Frame& F) {
    {
        pg8::StaticOrder S; S.init(NTP, D, F.G, F.bid);
        { pg8::Gemm g{F.OATT, F.WOA, NTP, D, 512}; pg8::EpiRC<P5aBody> E{P5aBody{&F}}; pg8::gemm_phase<pg8::EpiRC<P5aBody>, pg8::StaticOrder, true, true>(F.lds, g, S, E); }
        asm volatile("s_waitcnt vmcnt(0)" ::: "memory"); __syncthreads();
        { pg8::Gemm g{F.OCONV, F.WOC, NTP, D, 512}; pg8::EpiRC<P5bBody> E{P5bBody{&F}}; pg8::gemm_phase<pg8::EpiRC<P5bBody>, pg8::StaticOrder, true, true>(F.lds, g, S, E); }
    }
    for (int sl = F.bid; sl < NTS / 8 * (D / BN); sl += F.G) {
        const int m0 = NTP + (sl >> 3) * 8, n0 = (sl & 7) * BN;
        f32x16 s1[1][1], s2[1][1];
        gemm_slice8(F, s1, F.OATT, 512, F.WOA, 512, 512, m0, n0);
        gemm_slice8(F, s2, F.OCONV, 512, F.WOC, 512, 512, m0, n0);
        SLICE_EPI_LOOP(P5_EPI(s1, s2))
    }
}
#define P6_EPI(A1) { \
            const f32x4 v = ACC4(A1); \
            const f32x4 xv = *(const f32x4*)(x_row(F, m) + n); \
            const f32x4 g1 = *(const f32x4*)(F.MOD + (size_t)mod_row(m) * 6144 + 2048 + n); \
            *(f32x4*)(F.T1 + (size_t)m * D + n) = xv * DN_ALPHA + g1 * v; }
struct P6Body {
    const Frame* Fp;
    __device__ __forceinline__ void operator()(int m, int n, const f32x4 v) const {
        const Frame& F = *Fp;
        const f32x4 xv = *(const f32x4*)(F.x_p + (size_t)m * D + n);
        const f32x4 g1 = *(const f32x4*)(F.MOD + (size_t)(m >> 11) * 6144 + 2048 + n);
        *(f32x4*)(F.T1 + (size_t)m * D + n) = xv * DN_ALPHA + g1 * v;
    }
};
__device__ __forceinline__ void p6_gemm_out(const Frame& F) {
    {
        pg8::Gemm g{F.MERGED, F.WOUT, NTP, D, D}; pg8::StaticOrder S; S.init(NTP, D, F.G, F.bid);
        pg8::EpiRC<P6Body> E{P6Body{&F}}; pg8::gemm_phase<pg8::EpiRC<P6Body>, pg8::StaticOrder, true, true>(F.lds, g, S, E);
    }
    for (int sl = F.bid; sl < NTS / 8 * (D / BN); sl += F.G) {
        const int m0 = NTP + (sl >> 3) * 8, n0 = (sl & 7) * BN;
        f32x16 s1[1][1];
        gemm_slice8(F, s1, F.MERGED, D, F.WOUT, D, D, m0, n0);
        SLICE_EPI_LOOP(P6_EPI(s1))
    }
}
__device__ __forceinline__ void p7_ln1(const Frame& F) {
    f32x4 lg[4], lb[4];
#pragma unroll
    for (int i = 0; i < 4; ++i) { const int e = (i >> 1) * 512 + F.lane * 8 + (i & 1) * 4; lg[i] = *(const f32x4*)(F.ln1_g + e); lb[i] = *(const f32x4*)(F.ln1_b + e); }
    const int stride = F.G * 8;
    f32x4 vn[4], scn[4], shn[4];
    {
        const int m = F.bid * 8 + F.wave; const float* mr = F.MOD + (size_t)mod_row(m < NT ? m : 0) * 6144;
#pragma unroll
        for (int i = 0; i < 4; ++i) { const int e = (i >> 1) * 512 + F.lane * 8 + (i & 1) * 4; vn[i] = *(const f32x4*)(F.T1 + (size_t)(m < NT ? m : 0) * D + e); scn[i] = *(const f32x4*)(mr + 4096 + e); shn[i] = *(const f32x4*)(mr + 3072 + e); }
    }
    for (int m = F.bid * 8 + F.wave; m < NT; m += stride) {
        float* tr = F.T1 + (size_t)m * D;
        f32x4 v[4], sc2[4], sh2[4]; float s = 0.f;
#pragma unroll
        for (int i = 0; i < 4; ++i) { v[i] = vn[i]; sc2[i] = scn[i]; sh2[i] = shn[i]; s += v[i][0] + v[i][1] + v[i][2] + v[i][3]; }
        {
            const int mn = (m + stride < NT) ? m + stride : m; const float* mrn = F.MOD + (size_t)mod_row(mn) * 6144;
#pragma unroll
            for (int i = 0; i < 4; ++i) { const int e = (i >> 1) * 512 + F.lane * 8 + (i & 1) * 4; vn[i] = *(const f32x4*)(F.T1 + (size_t)mn * D + e); scn[i] = *(const f32x4*)(mrn + 4096 + e); shn[i] = *(const f32x4*)(mrn + 3072 + e); }
        }
        const float mean = wave_sum(s) * (1.f / D);
        float q = 0.f;
#pragma unroll
        for (int i = 0; i < 4; ++i) { v[i] = v[i] - mean; q += v[i][0] * v[i][0] + v[i][1] * v[i][1] + v[i][2] * v[i][2] + v[i][3] * v[i][3]; }
        const float rstd = rsqrtf(wave_sum(q) * (1.f / D) + LN_EPS);
        f32x4 hv[2][2];
#pragma unroll
        for (int hlf = 0; hlf < 2; ++hlf) {
            const int e = hlf * 512 + F.lane * 8;
            f32x4 a = v[2 * hlf] * rstd * lg[2 * hlf] + lb[2 * hlf];
            f32x4 b = v[2 * hlf + 1] * rstd * lg[2 * hlf + 1] + lb[2 * hlf + 1];
            *(f32x4*)(tr + e) = a; *(f32x4*)(tr + e + 4) = b;
            const f32x4 ha = a * (sc2[2 * hlf] + 1.f) + sh2[2 * hlf];
            const f32x4 hb = b * (sc2[2 * hlf + 1] + 1.f) + sh2[2 * hlf + 1];
            *(u32x4*)(F.H2 + (size_t)m * D + e) = (u32x4){cvt_pk_bf16(ha[0], ha[1]), cvt_pk_bf16(ha[2], ha[3]), cvt_pk_bf16(hb[0], hb[1]), cvt_pk_bf16(hb[2], hb[3])};
            hv[hlf][0] = ha; hv[hlf][1] = hb;
        }
        float am = 0.f;
#pragma unroll
        for (int i = 0; i < 2; ++i)
#pragma unroll
            for (int j = 0; j < 2; ++j)
#pragma unroll
                for (int e = 0; e < 4; ++e) am = fmaxf(am, fabsf(hv[i][j][e]));
        am = wave_max(am);
        const float sc = am > 0.f ? 224.f / am : 1.f;
#pragma unroll
        for (int hlf = 0; hlf < 2; ++hlf) {
            int w0 = 0, w1 = 0;
            w0 = __builtin_amdgcn_cvt_pk_fp8_f32(hv[hlf][0][0] * sc, hv[hlf][0][1] * sc, w0, false); w0 = __builtin_amdgcn_cvt_pk_fp8_f32(hv[hlf][0][2] * sc, hv[hlf][0][3] * sc, w0, true);
            w1 = __builtin_amdgcn_cvt_pk_fp8_f32(hv[hlf][1][0] * sc, hv[hlf][1][1] * sc, w1, false); w1 = __builtin_amdgcn_cvt_pk_fp8_f32(hv[hlf][1][2] * sc, hv[hlf][1][3] * sc, w1, true);
            *(u32x2*)(F.ws + WS_H8 + (size_t)m * D + hlf * 512 + F.lane * 8) = (u32x2){(unsigned)w0, (unsigned)w1};
        }
        if (F.lane == 0) ((float*)(F.ws + WS_SH))[m] = am > 0.f ? am * (1.f / 224.f) : 1.f;
    }
}
struct P8Body {
    const Frame* Fp;
    __device__ __forceinline__ void operator()(int m, int n, const f32x4 v) const { *(u32x2*)(Fp->QP + (size_t)m * D + n) = pk4(v); }
};
__device__ __forceinline__ void p8_gemm_q(const Frame& F) {
    {
        pg8::Gemm g{F.H2, F.WQ, NTP, D, D}; pg8::StaticOrder S; S.init(NTP, D, F.G, F.bid);
        pg8::EpiRC<P8Body> E{P8Body{&F}}; pg8::gemm_phase<pg8::EpiRC<P8Body>, pg8::StaticOrder, true, true>(F.lds, g, S, E);
    }
    for (int sl = F.bid; sl < NTS / 8 * (D / BN); sl += F.G) {
        const int m0 = NTP + (sl >> 3) * 8, n0 = (sl & 7) * BN;
        f32x16 s1[1][1];
        gemm_slice8(F, s1, F.H2, D, F.WQ, D, D, m0, n0);
        SLICE_EPI_LOOP({ *(u32x2*)(F.QP + (size_t)m * D + n) = pk4(ACC4(s1)); })
    }
}
__device__ __forceinline__ void p9_row_top16(LAS float* row, LAS float* TV, LAS unsigned char* TI, int slot) {
    float gm[16];
#pragma unroll
    for (int gidx = 0; gidx < 16; ++gidx) {
        float m = row[gidx * 8];
#pragma unroll
        for (int k = 1; k < 8; ++k) m = fmaxf(m, row[gidx * 8 + k]);
        gm[gidx] = m;
    }
#pragma unroll 1
    for (int p = 0; p < 16; ++p) {
        float best = gm[0]; int bg = 0;
#pragma unroll
        for (int gidx = 1; gidx < 16; ++gidx) { const bool gt = gm[gidx] > best; best = gt ? gm[gidx] : best; bg = gt ? gidx : bg; }
        float v[8];
#pragma unroll
        for (int k = 0; k < 8; ++k) v[k] = row[bg * 8 + k];
        int bk = 7;
#pragma unroll
        for (int k = 6; k >= 0; --k) bk = (v[k] == best) ? k : bk;
        float nm = -INFINITY;
#pragma unroll
        for (int k = 0; k < 8; ++k) nm = fmaxf(nm, (k == bk) ? -INFINITY : v[k]);
        row[bg * 8 + bk] = -INFINITY;
#pragma unroll
        for (int gidx = 0; gidx < 16; ++gidx) gm[gidx] = (gidx == bg) ? nm : gm[gidx];
        TV[slot * 17 + p] = best; TI[slot * 17 + p] = (unsigned char)(bg * 8 + bk);
    }
}
__device__ __forceinline__ void p9_pair_top16(const Frame& F, LAS const float* TV, LAS const unsigned char* TI, int r1, int r2, int tok, int head) {
    float c[16];
    { const float v20 = TV[r2];
#pragma unroll
      for (int i = 0; i < 16; ++i) c[i] = TV[r1 + i] + v20; }
    unsigned long long ptrs = 0ull;
    float sv[16]; int se[16];
#pragma unroll
    for (int p = 0; p < 16; ++p) {
        float best = c[0]; int bi = 0;
#pragma unroll
        for (int i = 1; i < 16; ++i) { const bool gt = c[i] > best; best = gt ? c[i] : best; bi = gt ? i : bi; }
        const int bj = (int)((ptrs >> (4 * bi)) & 15ull);
        sv[p] = best; se[p] = (int)TI[r1 + bi] * 128 + (int)TI[r2 + bj];
        const float nv = (bj < 15) ? TV[r1 + bi] + TV[r2 + bj + 1] : -INFINITY;
        ptrs += (bj < 15) ? (1ull << (4 * bi)) : 0ull;
#pragma unroll
        for (int i = 0; i < 16; ++i) c[i] = (i == bi) ? nv : c[i];
    }
    const float mx0 = sv[0]; float den = 0.f;
#pragma unroll
    for (int p = 0; p < 16; ++p) { sv[p] = __expf(sv[p] - mx0); den += sv[p]; }
    const float dinv = 1.f / den;
    int* eo = F.EIDX + (size_t)tok * NEXP_SEL + head * 16; float* go = F.GW + (size_t)tok * NEXP_SEL + head * 16;
#pragma unroll
    for (int p = 0; p < 16; ++p) { eo[p] = se[p]; go[p] = sv[p] * dinv; }
}
constexpr int PR_ROW = 129, PR_ROWS = 256 + 4;
__device__ __forceinline__ void p9_route(const Frame& F) {
    LAS float* SC = (LAS float*)F.lds;
    LAS float* TV = (LAS float*)(F.lds + PR_ROWS * PR_ROW * 4);
    LAS unsigned char* TI = (LAS unsigned char*)(F.lds + PR_ROWS * PR_ROW * 4 + PR_ROWS * 17 * 4);
    const int lane = F.lane, r = lane & 31, h = lane >> 5;
    const int nunits = (NTP / 32) * 2;
    bf16x8 AkR[4][4];
    {
        const bf16_t* KK = (F.wave & 1) ? F.K2 : F.K1;
#pragma unroll
        for (int kt = 0; kt < 4; ++kt)
#pragma unroll
            for (int s = 0; s < 4; ++s) AkR[kt][s] = *(const bf16x8*)(KK + (size_t)(kt * 32 + r) * 64 + s * 16 + h * 8);
    }
    int k = 0;
    for (int it = F.bid; it < nunits; it += F.G, ++k) {
        const int tok0 = (it >> 1) * 32, hg = it & 1;
        const int ts = NTP + F.bid + F.G * (k >> 2), kh = k & 3;
        const bool has_s = ts < NT;
        __syncthreads();
        {
            const int head = hg * 4 + (F.wave >> 1), half = F.wave & 1;
            bf16x8 Bq[4], Bs[4];
#pragma unroll
            for (int s = 0; s < 4; ++s) Bq[s] = *(const bf16x8*)(F.QP + (size_t)(tok0 + r) * D + head * 128 + half * 64 + s * 16 + h * 8);
            const bool swave = has_s && F.wave < 4;
            if (swave) {
#pragma unroll
                for (int s = 0; s < 4; ++s) Bs[s] = *(const bf16x8*)(F.QP + (size_t)ts * D + (2 * kh + (F.wave >> 1)) * 128 + half * 64 + s * 16 + h * 8);
            }
#pragma unroll
            for (int kt = 0; kt < 4; ++kt) {
                f32x16 c, cs;
#pragma unroll
                for (int e = 0; e < 16; ++e) { c[e] = 0.f; cs[e] = 0.f; }
#pragma unroll
                for (int s = 0; s < 4; ++s) {
                    c = __builtin_amdgcn_mfma_f32_32x32x16_bf16(AkR[kt][s], Bq[s], c, 0, 0, 0);
                    if (swave) cs = __builtin_amdgcn_mfma_f32_32x32x16_bf16(AkR[kt][s], Bs[s], cs, 0, 0, 0);
                }
#pragma unroll
                for (int e = 0; e < 16; ++e) { const int key = kt * 32 + (e & 3) + 8 * (e >> 2) + 4 * h; SC[(F.wave * 32 + r) * PR_ROW + key] = c[e]; }
                if (swave && r == 0) {
#pragma unroll
                    for (int e = 0; e < 16; ++e) { const int key = kt * 32 + (e & 3) + 8 * (e >> 2) + 4 * h; SC[(256 + F.wave) * PR_ROW + key] = cs[e]; }
                }
            }
        }
        __syncthreads();
        if (F.tid < 256 || (has_s && F.tid < 260)) p9_row_top16(SC + F.tid * PR_ROW, TV, TI, F.tid);
        if (F.wave >= 5) { const int j = F.bid + F.G * (k * 8 + (F.wave - 5)); if (j < CVT_CHUNKS) peer_cvt_rows4(F, j < CVT_CHUNKS / 2, (j & (CVT_CHUNKS / 2 - 1)) * 4); }
        __syncthreads();
        if (F.wave >= 3) { const int j = F.bid + F.G * (k * 8 + 3 + (F.wave - 3)); if (j < CVT_CHUNKS) peer_cvt_rows4(F, j < CVT_CHUNKS / 2, (j & (CVT_CHUNKS / 2 - 1)) * 4); }
        if (F.tid < 128) {
            const int tk = F.tid >> 2, hs = F.tid & 3;
            const int r1 = (hs * 64 + tk) * 17;
            p9_pair_top16(F, TV, TI, r1, r1 + 32 * 17, tok0 + tk, hg * 4 + hs);
        } else if (has_s && F.tid < 130) {
            const int hs = F.tid - 128;
            const int r1 = (256 + hs * 2) * 17;
            p9_pair_top16(F, TV, TI, r1, r1 + 17, ts, 2 * kh + hs);
        }
    }
    for (int i = k * 8 + F.wave; F.bid + F.G * i < CVT_CHUNKS; i += 8) { const int j = F.bid + F.G * i; peer_cvt_rows4(F, j < CVT_CHUNKS / 2, (j & (CVT_CHUNKS / 2 - 1)) * 4); }
}

constexpr int TPW = 65, PAIRS_MAX = 9 * 128, PK = 4;
constexpr int P10_HROW = 1024 + 64;
constexpr int P10_H = 0;
constexpr int P10_SH = 32 * P10_HROW;
constexpr int P10_HIST = P10_SH + 128;
constexpr int P10_LIST = P10_HIST + 8 * 128 * 4;
typedef int i32x8 __attribute__((ext_vector_type(8)));
typedef __bf16 bf16x2v __attribute__((ext_vector_type(2)));
typedef short s16x4 __attribute__((ext_vector_type(4)));
__device__ __forceinline__ unsigned bf2u(bf16x2v v) { unsigned r; __builtin_memcpy(&r, &v, 4); return r; }
__device__ __forceinline__ void p10_peer(const Frame& F) {
    const int lane = F.lane, w = F.wave;
    unsigned char* ws = F.ws;
    const unsigned char* PU8 = ws + WS_PU8; const unsigned char* PV8 = ws + WS_PV8;
    const float* SU = (const float*)(ws + WS_SU); const float* SV = (const float*)(ws + WS_SV);
    const unsigned char* H8 = ws + WS_H8; const float* SH = (const float*)(ws + WS_SH);
  for (int blk = F.bid; blk < NT / TPW; blk += F.G) {
    const int tok0 = blk * TPW;
    LAS float* SHl = (LAS float*)(F.lds + P10_SH);
    LAS unsigned* SE = (LAS unsigned*)(F.lds + P10_LIST) + w * 1024; LAS float* SG = (LAS float*)(SE + 512);
    const int ntok = (w == 0) ? 9 : 8;
    const int r16 = lane & 15, q4 = lane >> 4;
#pragma unroll 1
    for (int pass = 0; pass < 3; ++pass) {
        const int kbase = pass * PK, nk = (ntok - kbase < PK) ? (ntok - kbase > 0 ? ntok - kbase : 0) : PK, npairs = nk * 128;
        __syncthreads();
        for (int c = F.tid; c < 32 * 64; c += NTHREADS) {
            const int row = c >> 6, tl = 32 * pass + row;
            if (tl < TPW) *(LAS u32x4*)(F.lds + P10_H + row * P10_HROW + (c & 63) * 16) = *(const u32x4*)(H8 + (size_t)(tok0 + tl) * D + (size_t)(c & 63) * 16);
        }
        if (F.tid < 32 && 32 * pass + F.tid < TPW) SHl[F.tid] = SH[tok0 + 32 * pass + F.tid];
        __syncthreads();
        if (nk <= 0) continue;
#pragma unroll
        for (int i = 0; i < 8; ++i) {
            const int p = lane + 64 * i;
            if (p < npairs) {
                const size_t gi_ = (size_t)(tok0 + w + 8 * (kbase + (p >> 7))) * NEXP_SEL + (p & 127);
                SE[p] = (unsigned)F.EIDX[gi_]; SG[p] = F.GW[gi_];
            }
        }
        asm volatile("s_waitcnt vmcnt(0) lgkmcnt(0)" ::: "memory");
        __builtin_amdgcn_wave_barrier();
        f32x4 acc[4][4];
#pragma unroll
        for (int k = 0; k < 4; ++k)
#pragma unroll
            for (int q = 0; q < 4; ++q) acc[k][q] = (f32x4){0.f, 0.f, 0.f, 0.f};
        const int ngr = npairs >> 4;
        const unsigned char* up = PU8 + q4 * 16;
        const int voff = lane * 8;
        const unsigned am0 = (lane & 3) == 0 ? 0x0000ffffu : ((lane & 3) == 1 ? 0xffff0000u : 0u);
        const unsigned am1 = (lane & 3) == 2 ? 0x0000ffffu : ((lane & 3) == 3 ? 0xffff0000u : 0u);
        u32x4 U[8]; u32x2 V[16]; float suv = 0.f, svv = 0.f;
#pragma unroll
        for (int t = 0; t < 8; ++t) U[t] = (u32x4){0u, 0u, 0u, 0u};
#pragma unroll
        for (int k = 0; k < 16; ++k) V[k] = (u32x2){0u, 0u};
#define P10_LOAD_U(WR) { const int er_ = (WR) & 16383; const unsigned char* ua_ = up + (size_t)er_ * 512; const float* sa_ = SU + er_; const float* sb_ = SV + er_; \
            asm volatile("global_load_dwordx4 %0, %1, off" : "+v"(U[0]) : "v"(ua_)); \
            asm volatile("global_load_dwordx4 %0, %1, off offset:64" : "+v"(U[1]) : "v"(ua_)); \
            asm volatile("global_load_dwordx4 %0, %1, off offset:128" : "+v"(U[2]) : "v"(ua_)); \
            asm volatile("global_load_dwordx4 %0, %1, off offset:192" : "+v"(U[3]) : "v"(ua_)); \
            asm volatile("global_load_dwordx4 %0, %1, off offset:256" : "+v"(U[4]) : "v"(ua_)); \
            asm volatile("global_load_dwordx4 %0, %1, off offset:320" : "+v"(U[5]) : "v"(ua_)); \
            asm volatile("global_load_dwordx4 %0, %1, off offset:384" : "+v"(U[6]) : "v"(ua_)); \
            asm volatile("global_load_dwordx4 %0, %1, off offset:448" : "+v"(U[7]) : "v"(ua_)); \
            asm volatile("global_load_dword %0, %1, off" : "+v"(suv) : "v"(sa_)); \
            asm volatile("global_load_dword %0, %1, off" : "+v"(svv) : "v"(sb_)); }
#define P10_LOAD_V(K, WR) { const unsigned char* ra_ = PV8 + (size_t)(__builtin_amdgcn_readlane((WR), (K)) & 16383) * 512; \
            asm volatile("global_load_dwordx2 %0, %1, %2" : "+v"(V[K]) : "v"(voff), "s"(ra_)); }
        int wr = (int)SE[r16]; float gr = SG[r16];
        P10_LOAD_U(wr)
        P10_LOAD_V(0, wr) P10_LOAD_V(1, wr) P10_LOAD_V(2, wr) P10_LOAD_V(3, wr) P10_LOAD_V(4, wr) P10_LOAD_V(5, wr) P10_LOAD_V(6, wr) P10_LOAD_V(7, wr)
        P10_LOAD_V(8, wr) P10_LOAD_V(9, wr) P10_LOAD_V(10, wr) P10_LOAD_V(11, wr) P10_LOAD_V(12, wr) P10_LOAD_V(13, wr) P10_LOAD_V(14, wr) P10_LOAD_V(15, wr)
#define P10_VQ(Q) { const unsigned b0_ = bf2u(__builtin_amdgcn_cvt_scalef32_pk_bf16_fp4(vv[(Q) >> 1], 1.0f, 2 * ((Q) & 1))); \
                    const unsigned b1_ = bf2u(__builtin_amdgcn_cvt_scalef32_pk_bf16_fp4(vv[(Q) >> 1], 1.0f, 2 * ((Q) & 1) + 1)); \
                    const u32x2 bb_ = {b0_, b1_}; s16x4 Bop_; __builtin_memcpy(&Bop_, &bb_, 8); \
                    acc[slot][Q] = __builtin_amdgcn_mfma_f32_4x4x4bf16_1k(Aop, Bop_, acc[slot][Q], 0, 0, 0); }
#define P10_VPAIR(K) { const float actk = __int_as_float(__builtin_amdgcn_readlane(actv, 16 * ((K) >> 2) + (K))); \
                       const unsigned wb_ = cvt_pk_bf16(actk, actk); \
                       const u32x2 ab_ = {wb_ & am0, wb_ & am1}; s16x4 Aop; __builtin_memcpy(&Aop, &ab_, 8); \
                       asm volatile("s_waitcnt vmcnt(25)" : "+v"(V[K])); \
                       const u32x2 vv = V[K]; \
                       P10_VQ(0) P10_VQ(1) P10_VQ(2) P10_VQ(3) \
                       P10_LOAD_V(K, wrn) }
#pragma unroll
        for (int slot = 0; slot < 4; ++slot) {
            if (slot >= nk) continue;
            LAS const unsigned char* hr0 = F.lds + P10_H + (w + 8 * slot) * P10_HROW + q4 * 16;
            const float shv = SHl[w + 8 * slot];
#pragma unroll 1
            for (int g8 = 0; g8 < 8; ++g8) {
                const int gi = slot * 8 + g8;
                const int gn = (gi + 1 < ngr) ? gi + 1 : 0;
                const int wrn = (int)SE[gn * 16 + r16]; const float grn = SG[gn * 16 + r16];
                LAS const unsigned char* hr = hr0;
                asm volatile("" : "+v"(hr));
                asm volatile("s_waitcnt vmcnt(16)" : "+v"(U[0]), "+v"(U[1]), "+v"(U[2]), "+v"(U[3]), "+v"(U[4]), "+v"(U[5]), "+v"(U[6]), "+v"(U[7]), "+v"(suv), "+v"(svv));
                f32x4 C0 = {0.f, 0.f, 0.f, 0.f}, C1 = {0.f, 0.f, 0.f, 0.f};
#pragma unroll
                for (int t = 0; t < 8; ++t) {
                    const u32x4 h0 = *(LAS const u32x4*)(hr + t * 128), h1 = *(LAS const u32x4*)(hr + t * 128 + 64);
                    const i32x8 Aop = {(int)h0[0], (int)h0[1], (int)h0[2], (int)h0[3], (int)h1[0], (int)h1[1], (int)h1[2], (int)h1[3]};
                    const i32x8 Bop = {(int)U[t][0], (int)U[t][1], (int)U[t][2], (int)U[t][3], 0, 0, 0, 0};
                    if (t & 1) C1 = __builtin_amdgcn_mfma_scale_f32_16x16x128_f8f6f4(Aop, Bop, C1, 0, 4, 0, 0x7f7f7f7f, 0, 0x7f7f7f7f);
                    else       C0 = __builtin_amdgcn_mfma_scale_f32_16x16x128_f8f6f4(Aop, Bop, C0, 0, 4, 0, 0x7f7f7f7f, 0, 0x7f7f7f7f);
                }
                C0 = C0 + C1;
                const int rsel = lane & 3;
                const float dv = (rsel == 0 ? C0[0] : (rsel == 1 ? C0[1] : (rsel == 2 ? C0[2] : C0[3]))) * (suv * shv);
                const int actv = __float_as_int(gelu_tanh(dv) * (gr * svv));
                P10_LOAD_U(wrn)
                P10_VPAIR(0) P10_VPAIR(1) P10_VPAIR(2) P10_VPAIR(3) P10_VPAIR(4) P10_VPAIR(5) P10_VPAIR(6) P10_VPAIR(7)
                P10_VPAIR(8) P10_VPAIR(9) P10_VPAIR(10) P10_VPAIR(11) P10_VPAIR(12) P10_VPAIR(13) P10_VPAIR(14) P10_VPAIR(15)
                wr = wrn; gr = grn;
            }
        }
#undef P10_VPAIR
#undef P10_VQ
        asm volatile("s_waitcnt vmcnt(0)" : "+v"(U[0]), "+v"(U[1]), "+v"(U[2]), "+v"(U[3]), "+v"(U[4]), "+v"(U[5]), "+v"(U[6]), "+v"(U[7]), "+v"(suv), "+v"(svv),
                     "+v"(V[0]), "+v"(V[1]), "+v"(V[2]), "+v"(V[3]), "+v"(V[4]), "+v"(V[5]), "+v"(V[6]), "+v"(V[7]),
                     "+v"(V[8]), "+v"(V[9]), "+v"(V[10]), "+v"(V[11]), "+v"(V[12]), "+v"(V[13]), "+v"(V[14]), "+v"(V[15]));
#undef P10_LOAD_U
#undef P10_LOAD_V
        float x1v[PK][16];
#pragma unroll
        for (int k = 0; k < PK; ++k) {
            const int m = tok0 + w + 8 * (kbase + (k < nk ? k : 0));
#pragma unroll
            for (int c = 0; c < 16; ++c) x1v[k][c] = F.T1[(size_t)m * D + c * 64 + lane];
        }
#pragma unroll
        for (int k = 0; k < PK; ++k) {
            if (k >= nk) continue;
            const int m = tok0 + w + 8 * (kbase + k);
            const float* mr = F.MOD + (size_t)mod_row(m) * 6144 + 5120;
            float tv[16]; float s = 0.f;
#pragma unroll
            for (int c = 0; c < 16; ++c) { const float t = x1v[k][c] * DN_ALPHA + mr[c * 64 + lane] * acc[k][c >> 2][c & 3]; tv[c] = t; s += t; }
            const float mean = wave_sum(s) * (1.f / D);
            float q = 0.f;
#pragma unroll
            for (int c = 0; c < 16; ++c) { tv[c] -= mean; q += tv[c] * tv[c]; }
            const float rstd = rsqrtf(wave_sum(q) * (1.f / D) + LN_EPS);
            float* yo = (m < NTP) ? F.out + O_YP + (size_t)m * D : F.out + O_YS + (size_t)(m - NTP) * D;
#pragma unroll
            for (int c = 0; c < 16; ++c) yo[c * 64 + lane] = tv[c] * rstd * F.ln2_g[c * 64 + lane] + F.ln2_b[c * 64 + lane];
        }
    }
  }
}

constexpr int N_PHASES = 11;
__global__ void __launch_bounds__(NTHREADS, 2) fwd_kernel(Args args) {
    extern __shared__ __attribute__((aligned(16))) unsigned char lds_raw[];
    Frame F;
    F.lds = (LAS unsigned char*)lds_raw;
    F.tid = threadIdx.x; F.lane = F.tid & 63; F.wave = __builtin_amdgcn_readfirstlane(F.tid >> 6); F.G = gridDim.x; F.bid = blockIdx.x;
    F.x_p = (const float*)args.in[0]; F.x_s = (const float*)args.in[1]; F.c_p = (const float*)args.in[2]; F.c_s = (const float*)args.in[3];
    F.cache_k = (const float*)args.in[4]; F.cache_v = (const float*)args.in[5]; F.cache_ki = (const float*)args.in[6]; F.state_conv = (const float*)args.in[7];
    F.page_table = (const int*)args.in[8]; F.rel_bias = (const float*)args.in[9]; F.w_ada = (const float*)args.in[10]; F.b_ada = (const float*)args.in[11];
    F.w_in = (const float*)args.in[12]; F.conv_w = (const float*)args.in[13]; F.conv_b = (const float*)args.in[14]; F.w_o_attn = (const float*)args.in[15];
    F.w_o_conv = (const float*)args.in[16]; F.w_out = (const float*)args.in[17]; F.ln1_g = (const float*)args.in[18]; F.ln1_b = (const float*)args.in[19];
    F.ln2_g = (const float*)args.in[20]; F.ln2_b = (const float*)args.in[21]; F.peer_wq = (const float*)args.in[22]; F.peer_k1 = (const float*)args.in[23];
    F.peer_k2 = (const float*)args.in[24]; F.peer_u = (const float*)args.in[25]; F.peer_v = (const float*)args.in[26];
    F.out = args.out;
    unsigned char* ws = args.ws; F.ws = ws;
    F.MOD = (float*)(ws + WS_MOD); F.WIN = (bf16_t*)(ws + WS_WIN); F.WOA = (bf16_t*)(ws + WS_WOA); F.WOC = (bf16_t*)(ws + WS_WOC);
    F.WOUT = (bf16_t*)(ws + WS_WOUT); F.WQ = (bf16_t*)(ws + WS_WQ); F.K1 = (bf16_t*)(ws + WS_K1); F.K2 = (bf16_t*)(ws + WS_K2);
    F.PU = (bf16_t*)(ws + WS_PU); F.PV = (bf16_t*)(ws + WS_PV); F.H1 = (bf16_t*)(ws + WS_H1); F.PROJ = (bf16_t*)(ws + WS_PROJ);
    F.WI = (float*)(ws + WS_WI); F.SEL = (int*)(ws + WS_SEL); F.OATT = (bf16_t*)(ws + WS_OATT); F.OCONV = (bf16_t*)(ws + WS_OCONV);
    F.MERGED = (bf16_t*)(ws + WS_MERGED); F.T1 = (float*)(ws + WS_T1); F.H2 = (bf16_t*)(ws + WS_H2); F.QP = (bf16_t*)(ws + WS_QP);
    F.EIDX = (int*)(ws + WS_EIDX); F.GW = (float*)(ws + WS_GW);
    volatile LAS unsigned* misc = (volatile LAS unsigned*)(F.lds + LDS_MISC);
    if (F.tid < 16) misc[F.tid] = 0u;
    __syncthreads();
    XcdBarrier bar; bar.bar = (unsigned*)(ws + WS_CTL); bar.x = 0; bar.st = misc;
    const int lo = args.ph_lo, hi = args.ph_hi;
    if (hi - lo > 1) bar = xcd_barrier_post((unsigned*)(ws + WS_CTL), misc);
#define IN(k) (lo <= (k) && (k) < hi)
#define SEAM(k) do { if (IN(k) && IN((k) + 1)) xcd_barrier(bar); } while (0)
    if (IN(0)) p0_prologue(F);       SEAM(0);
    if (IN(1)) p1_modulate(F);       SEAM(1);
    if (IN(2)) p2_gemm_in(F);        SEAM(2);
    if (IN(3)) p3_index(F);          SEAM(3);
    if (IN(4)) p4_attention(F);      SEAM(4);
    if (IN(5)) p5_gemm_merge(F);     SEAM(5);
    if (IN(6)) p6_gemm_out(F);       SEAM(6);
    if (IN(7)) p7_ln1(F);            SEAM(7);
    if (IN(8)) p8_gemm_q(F);         SEAM(8);
    if (IN(9)) p9_route(F);          SEAM(9);
    if (IN(10)) p10_peer(F);
#undef IN
#undef SEAM
}

extern "C" void kernel_launch(void* const* d_in, const int* in_sizes, int n_in, void* d_out, int out_size, void* d_ws, size_t ws_size, hipStream_t stream) {
    static int grid = 0;
    if (grid == 0) {
        if (n_in != 27 || (size_t)out_size != O_END || ws_size < WS_END) { fprintf(stderr, "kernel_launch: unexpected shapes (n_in %d out %d ws %zu)\n", n_in, out_size, ws_size); grid = -1; return; }
        int dev = 0, cus = 0;
        if (hipGetDevice(&dev) != hipSuccess || hipDeviceGetAttribute(&cus, hipDeviceAttributeMultiprocessorCount, dev) != hipSuccess) { grid = -1; return; }
        if (hipFuncSetAttribute((const void*)fwd_kernel, hipFuncAttributeMaxDynamicSharedMemorySize, LDS_BYTES) != hipSuccess) { fprintf(stderr, "kernel_launch: hipFuncSetAttribute failed\n"); grid = -1; return; }
        (void)hipGetLastError();
        grid = cus < 256 ? cus : 256;
    }
    if (grid < 0) return;
    (void)hipMemsetAsync((char*)d_ws + WS_CTL, 0, CTL_ZERO_BYTES, stream);
    Args a{};
    for (int i = 0; i < 27; ++i) a.in[i] = d_in[i];
    a.out = (float*)d_out; a.ws = (unsigned char*)d_ws;
#if N_LAUNCHES == 1
    a.ph_lo = 0; a.ph_hi = N_PHASES;
    hipLaunchKernelGGL(fwd_kernel, dim3(grid), dim3(NTHREADS), LDS_BYTES, stream, a);
#else
    for (int p = 0; p < N_PHASES; ++p) { a.ph_lo = p; a.ph_hi = p + 1; hipLaunchKernelGGL(fwd_kernel, dim3(grid), dim3(NTHREADS), LDS_BYTES, stream, a); }
#endif
}
```

```cpp
#include <hip/hip_runtime.h>
#include <cstdio>
#include <cstdint>

#ifndef N_LAUNCHES
#define N_LAUNCHES 1
#endif

typedef unsigned short bf16_t;
typedef short bf16x8 __attribute__((ext_vector_type(8)));
typedef float f32x4 __attribute__((ext_vector_type(4)));
typedef float f32x16 __attribute__((ext_vector_type(16)));
typedef unsigned u32x4 __attribute__((ext_vector_type(4)));
typedef unsigned u32x2 __attribute__((ext_vector_type(2)));
#define LAS __attribute__((address_space(3)))

constexpr int D = 1024, NB_P = 8, SEQ = 2048, NB_S = 32, TS = 8, PAST = 8192, PAGE = 128, NPAGES = 64;
constexpr int NTP = NB_P * SEQ;
constexpr int NTS = NB_S * TS;
constexpr int NT = NTP + NTS;
constexpr int NMIX = 4676, NMIXP = 4736;
constexpr int C_Q = 0, C_K = 512, C_V = 640, C_QI = 768, C_KI = 1024, C_BG = 1088, C_CG = 1600, C_XIN = 2112, C_GA = 2624, C_GB = 3648, C_WI = 4672;
constexpr int NSEL = 256;
constexpr float ATTN_SCALE = 0.125f, IDX_SCALE = 0.0625f;
constexpr float DN_ALPHA = 1.189207115002721f, LN_EPS = 1e-5f;
constexpr int NEXP_SEL = 128;

constexpr size_t O_YP = 0, O_YS = 16777216, O_KP = 17039360, O_VP = 19136512, O_KIP = 21233664, O_CP = 22282240,
                 O_KS = 22290432, O_VS = 22323200, O_KIS = 22355968, O_CS = 22372352, O_END = 22405120;

constexpr size_t MB = 1048576;
constexpr size_t WS_CTL = 0, WS_MOD = 1 * MB, WS_WIN = 2 * MB, WS_WOA = 12 * MB, WS_WOC = 13 * MB, WS_WOUT = 14 * MB, WS_WQ = 16 * MB,
                 WS_K1 = 18 * MB, WS_K2 = 18 * MB + 65536, WS_PU = 20 * MB, WS_PV = 52 * MB, WS_H1 = 84 * MB, WS_PROJ = 118 * MB,
                 WS_WI = 270 * MB, WS_SEL = 271 * MB, WS_OATT = 288 * MB, WS_OCONV = 305 * MB, WS_MERGED = 322 * MB, WS_T1 = 355 * MB,
                 WS_H2 = 420 * MB, WS_QP = 453 * MB, WS_EIDX = 486 * MB, WS_GW = 495 * MB, WS_SS = 504 * MB, WS_SE = 513 * MB, WS_SG = 523 * MB, WS_VT = 533 * MB, WS_CGX = 538 * MB, WS_END = 539 * MB;
constexpr size_t WS_PU8 = WS_PU, WS_PV8 = WS_PU + 16 * MB, WS_SU = WS_PV, WS_SV = WS_PV + 65536, WS_H8 = WS_PV + 1 * MB, WS_SH = WS_PV + 20 * MB;
constexpr int CTL_ZERO_BYTES = 65536;

constexpr int NTHREADS = 512;
constexpr int LDS_BYTES = 160 * 1024 - 512;
constexpr int LDS_MISC = LDS_BYTES - 64;

__device__ __forceinline__ float bf2f(bf16_t b) { return __uint_as_float(((unsigned)b) << 16); }
__device__ __forceinline__ float bflo(unsigned p) { return __uint_as_float(p << 16); }
__device__ __forceinline__ float bfhi(unsigned p) { return __uint_as_float(p & 0xFFFF0000u); }
typedef __bf16 bf16x2_t __attribute__((ext_vector_type(2)));
typedef float f32x2_t __attribute__((ext_vector_type(2)));
__device__ __forceinline__ unsigned cvt_pk_bf16(float lo, float hi) { const f32x2_t f = {lo, hi}; const bf16x2_t b = __builtin_convertvector(f, bf16x2_t); unsigned r; __builtin_memcpy(&r, &b, 4); return r; }
__device__ __forceinline__ bf16_t f2bf(float f) { return (bf16_t)(cvt_pk_bf16(f, 0.f) & 0xFFFFu); }
__device__ __forceinline__ float wave_sum(float v) {
#pragma unroll
    for (int o = 32; o >= 1; o >>= 1) v += __shfl_xor(v, o);
    return v;
}
__device__ __forceinline__ float wave_sum_dpp(float v) {
    int x;
    x = __builtin_amdgcn_update_dpp(0, __float_as_int(v), 0xB1, 0xF, 0xF, false);  v += __int_as_float(x);
    x = __builtin_amdgcn_update_dpp(0, __float_as_int(v), 0x4E, 0xF, 0xF, false);  v += __int_as_float(x);
    x = __builtin_amdgcn_update_dpp(0, __float_as_int(v), 0x141, 0xF, 0xF, false); v += __int_as_float(x);
    x = __builtin_amdgcn_update_dpp(0, __float_as_int(v), 0x140, 0xF, 0xF, false); v += __int_as_float(x);
    x = __builtin_amdgcn_update_dpp(0, __float_as_int(v), 0x142, 0xA, 0xF, false); v += __int_as_float(x);
    x = __builtin_amdgcn_update_dpp(0, __float_as_int(v), 0x143, 0xC, 0xF, false); v += __int_as_float(x);
    return __int_as_float(__builtin_amdgcn_readlane(__float_as_int(v), 63));
}
__device__ __forceinline__ float wave_max(float v) {
#pragma unroll
    for (int o = 32; o >= 1; o >>= 1) v = fmaxf(v, __shfl_xor(v, o));
    return v;
}
__device__ __forceinline__ float sigmoidf_(float x) { return 1.f / (1.f + __expf(-x)); }
__device__ __forceinline__ float gelu_tanh(float a) {
    const float z = 0.7978845608028654f * (a + 0.044715f * a * a * a);
    const float e = __expf(2.f * z);
    const float t = 1.f - 2.f * __builtin_amdgcn_rcpf(e + 1.f);
    return 0.5f * a * (1.f + t);
}
__device__ __forceinline__ unsigned f2ord(float f) { const unsigned u = __float_as_uint(f); return (u & 0x80000000u) ? ~u : (u | 0x80000000u); }
__device__ __forceinline__ int t5_bucket(int n) {
    if (n < 16) return n;
    int b = 16;
    b += (n >= 19) + (n >= 21) + (n >= 24) + (n >= 27) + (n >= 31) + (n >= 35) + (n >= 40) + (n >= 46) + (n >= 52) + (n >= 59) + (n >= 67) + (n >= 77) + (n >= 87) + (n >= 99) + (n >= 113);
    return b;
}

#define XB_TMO      128
#define XB_XCNT(j)  (256  + 64 * (j))
#define XB_XSUB(j)  (1280 + 64 * (j))
#define XB_XGEN(j)  (2304 + 64 * (j))
#define XB_TOP      3328
#define XB_TOPGEN   3392
#define XCD_BAR_WORDS 3456
#define XB_SPIN_CAP (1u << 18)
__device__ __forceinline__ unsigned xb_ld(unsigned* p)              { return __hip_atomic_load(p, __ATOMIC_RELAXED, __HIP_MEMORY_SCOPE_AGENT); }
__device__ __forceinline__ unsigned xb_add(unsigned* p, unsigned v) { return __hip_atomic_fetch_add(p, v, __ATOMIC_RELAXED, __HIP_MEMORY_SCOPE_AGENT); }
__device__ __forceinline__ unsigned xb_xcc_id() { return (unsigned)__builtin_amdgcn_s_getreg((3 << 11) | 20) & 0xFu; }
#define XB_SPIN(cond, bar) do { unsigned _sp = 0; while (cond) { __builtin_amdgcn_s_sleep(1); \
    if ((++_sp & 255u) == 0u) { if (xb_ld(&(bar)[XB_TMO])) break; if (_sp > XB_SPIN_CAP) { atomicAdd(&(bar)[XB_TMO], 1u); break; } } } } while (0)
struct XcdBarrier { unsigned* bar; unsigned x; volatile LAS unsigned* st; };
__device__ __forceinline__ XcdBarrier xcd_barrier_post(unsigned* bar, volatile LAS unsigned* st) {
    XcdBarrier b; b.bar = bar; b.x = xb_xcc_id(); b.st = st;
    if (threadIdx.x == 0) (void)xb_add(&bar[XB_XCNT(b.x)], 1u);
    return b;
}
__device__ __forceinline__ void xcd_barrier_complete(unsigned* bar, unsigned x, unsigned& nloc, unsigned& nx) {
    const unsigned G = gridDim.x * gridDim.y * gridDim.z;
    unsigned sum, cnt, mine, sp = 0u;
    for (;;) {
        sum = 0u; cnt = 0u; mine = 0u;
#pragma unroll
        for (unsigned j = 0; j < 16; ++j) { const unsigned c = xb_ld(&bar[XB_XCNT(j)]); sum += c; cnt += (c > 0u) ? 1u : 0u; mine = (j == x) ? c : mine; }
        if (sum == G) break;
        __builtin_amdgcn_s_sleep(1);
        if ((++sp & 255u) == 0u) { if (xb_ld(&bar[XB_TMO])) break; if (sp > XB_SPIN_CAP) { atomicAdd(&bar[XB_TMO], 1u); break; } }
    }
    nloc = mine > 0u ? mine : 1u; nx = cnt > 0u ? cnt : 1u;
}
__device__ __forceinline__ void xcd_barrier(const XcdBarrier& b) {
    asm volatile("s_waitcnt vmcnt(0)" ::: "memory");
    __syncthreads();
    if (threadIdx.x == 0) {
        unsigned* bar = b.bar;
        __builtin_amdgcn_s_waitcnt(0);
        unsigned nloc = b.st[0], nx = b.st[1];
        if (nloc == 0u) { xcd_barrier_complete(bar, b.x, nloc, nx); b.st[0] = nloc; b.st[1] = nx; }
        const unsigned old = xb_add(&bar[XB_XSUB(b.x)], 1u);
        const unsigned gen = old / nloc;
        if (old + 1u == (gen + 1u) * nloc) {
            __builtin_amdgcn_fence(__ATOMIC_RELEASE, "agent");
            asm volatile("s_waitcnt vmcnt(0)" ::: "memory");
            const unsigned og = xb_add(&bar[XB_TOP], 1u);
            const unsigned tg = og / nx;
            if (og + 1u == (tg + 1u) * nx) xb_add(&bar[XB_TOPGEN], 1u);
            else XB_SPIN(xb_ld(&bar[XB_TOPGEN]) == tg, bar);
            __builtin_amdgcn_fence(__ATOMIC_ACQUIRE, "agent");
            xb_add(&bar[XB_XGEN(b.x)], 1u);
            asm volatile("s_waitcnt vmcnt(0)" ::: "memory");
        } else {
            XB_SPIN(xb_ld(&bar[XB_XGEN(b.x)]) == gen, bar);
            __builtin_amdgcn_fence(__ATOMIC_ACQUIRE, "agent");
            asm volatile("s_waitcnt vmcnt(0)" ::: "memory");
        }
    }
    __syncthreads();
}

struct Args { const void* in[27]; float* out; unsigned char* ws; int ph_lo, ph_hi; };
struct Core { LAS unsigned char* lds; int tid, lane, wave, G, bid; };
struct Frame {
    LAS unsigned char* lds;
    int tid, lane, wave, G, bid;
    const float *x_p, *x_s, *c_p, *c_s, *cache_k, *cache_v, *cache_ki, *state_conv, *rel_bias, *w_ada, *b_ada, *w_in, *conv_w, *conv_b,
                *w_o_attn, *w_o_conv, *w_out, *ln1_g, *ln1_b, *ln2_g, *ln2_b, *peer_wq, *peer_k1, *peer_k2, *peer_u, *peer_v;
    const int* page_table;
    float* out; unsigned char* ws;
    float* MOD; bf16_t *WIN, *WOA, *WOC, *WOUT, *WQ, *K1, *K2, *PU, *PV, *H1, *PROJ, *OATT, *OCONV, *MERGED, *H2, *QP;
    float *WI, *T1, *GW; int *SEL, *EIDX;
};
constexpr int LDS_PTAB = LDS_BYTES - 512;
__device__ __forceinline__ unsigned char* ldptr(const Core& C, int k) {
    LAS const unsigned* p = (LAS const unsigned*)(C.lds + LDS_PTAB) + 2 * k;
    const unsigned lo = __builtin_amdgcn_readfirstlane(p[0]), hi = __builtin_amdgcn_readfirstlane(p[1]);
    return (unsigned char*)(((unsigned long long)hi << 32) | (unsigned long long)lo);
}
__device__ __forceinline__ void load_frame(Frame& F, const Core& C) {
    F.lds = C.lds; F.tid = C.tid; F.lane = C.lane; F.wave = C.wave; F.G = C.G; F.bid = C.bid;
    F.x_p = (const float*)ldptr(C, 0); F.x_s = (const float*)ldptr(C, 1); F.c_p = (const float*)ldptr(C, 2); F.c_s = (const float*)ldptr(C, 3);
    F.cache_k = (const float*)ldptr(C, 4); F.cache_v = (const float*)ldptr(C, 5); F.cache_ki = (const float*)ldptr(C, 6); F.state_conv = (const float*)ldptr(C, 7);
    F.page_table = (const int*)ldptr(C, 8); F.rel_bias = (const float*)ldptr(C, 9); F.w_ada = (const float*)ldptr(C, 10); F.b_ada = (const float*)ldptr(C, 11);
    F.w_in = (const float*)ldptr(C, 12); F.conv_w = (const float*)ldptr(C, 13); F.conv_b = (const float*)ldptr(C, 14); F.w_o_attn = (const float*)ldptr(C, 15);
    F.w_o_conv = (const float*)ldptr(C, 16); F.w_out = (const float*)ldptr(C, 17); F.ln1_g = (const float*)ldptr(C, 18); F.ln1_b = (const float*)ldptr(C, 19);
    F.ln2_g = (const float*)ldptr(C, 20); F.ln2_b = (const float*)ldptr(C, 21); F.peer_wq = (const float*)ldptr(C, 22); F.peer_k1 = (const float*)ldptr(C, 23);
    F.peer_k2 = (const float*)ldptr(C, 24); F.peer_u = (const float*)ldptr(C, 25); F.peer_v = (const float*)ldptr(C, 26);
    F.out = (float*)ldptr(C, 27);
    unsigned char* ws = ldptr(C, 28);
    F.MOD = (float*)(ws + WS_MOD); F.WIN = (bf16_t*)(ws + WS_WIN); F.WOA = (bf16_t*)(ws + WS_WOA); F.WOC = (bf16_t*)(ws + WS_WOC);
    F.WOUT = (bf16_t*)(ws + WS_WOUT); F.WQ = (bf16_t*)(ws + WS_WQ); F.K1 = (bf16_t*)(ws + WS_K1); F.K2 = (bf16_t*)(ws + WS_K2);
    F.PU = (bf16_t*)(ws + WS_PU); F.PV = (bf16_t*)(ws + WS_PV); F.H1 = (bf16_t*)(ws + WS_H1); F.PROJ = (bf16_t*)(ws + WS_PROJ);
    F.WI = (float*)(ws + WS_WI); F.SEL = (int*)(ws + WS_SEL); F.OATT = (bf16_t*)(ws + WS_OATT); F.OCONV = (bf16_t*)(ws + WS_OCONV);
    F.MERGED = (bf16_t*)(ws + WS_MERGED); F.T1 = (float*)(ws + WS_T1); F.H2 = (bf16_t*)(ws + WS_H2); F.QP = (bf16_t*)(ws + WS_QP);
    F.EIDX = (int*)(ws + WS_EIDX); F.GW = (float*)(ws + WS_GW);
}
__device__ __forceinline__ const float* x_row(const Frame& F, int m) { return m < NTP ? F.x_p + (size_t)m * D : F.x_s + (size_t)(m - NTP) * D; }
__device__ __forceinline__ int mod_row(int m) { return m < NTP ? (m >> 11) : NB_P + ((m - NTP) >> 3); }

constexpr int P0_MOD_ITEMS = 96;
constexpr int P0_T_WIN = 16 * 74, P0_T_WOA = 8 * 16, P0_T_WOC = 8 * 16, P0_T_WOUT = 16 * 16, P0_T_WQ = 16 * 16;
constexpr int P0_T_ITEMS = P0_T_WIN + P0_T_WOA + P0_T_WOC + P0_T_WOUT + P0_T_WQ;
constexpr int P0_CVT_ITEMS = 2 * (16384 * 1024 / 8192);
constexpr int P0_MISC_ITEMS = 1;
constexpr int P0_ITEMS = P0_MOD_ITEMS + P0_T_ITEMS + P0_CVT_ITEMS + P0_MISC_ITEMS;

__device__ __forceinline__ void p0_mod_item(const Frame& F, int ng) {
    LAS float* cs = (LAS float*)F.lds;
    LAS float* red = (LAS float*)(F.lds + 40 * 256 * 4);
    float acc[40];
#pragma unroll
    for (int r = 0; r < 40; ++r) acc[r] = 0.f;
    const int n = ng * 64 + F.lane;
    for (int kc = 0; kc < 4; ++kc) {
        __syncthreads();
#pragma unroll 1
        for (int hb = 0; hb < 2; ++hb) {
            float cv[10];
#pragma unroll
            for (int i = 0; i < 10; ++i) { const int e = F.tid + (hb * 10 + i) * NTHREADS; const int r = e >> 8, k = e & 255; cv[i] = (r < 8) ? F.c_p[r * D + kc * 256 + k] : F.c_s[(r - 8) * D + kc * 256 + k]; }
#pragma unroll
            for (int i = 0; i < 10; ++i) cs[F.tid + (hb * 10 + i) * NTHREADS] = cv[i];
        }
        __syncthreads();
        float wvv[32];
#pragma unroll
        for (int kk = 0; kk < 32; ++kk) wvv[kk] = F.w_ada[(size_t)(kc * 256 + F.wave * 32 + kk) * 6144 + n];
#pragma unroll
        for (int kk = 0; kk < 32; ++kk) {
            const int kl = F.wave * 32 + kk;
#pragma unroll
            for (int r = 0; r < 40; ++r) acc[r] += cs[r * 256 + kl] * wvv[kk];
        }
    }
#pragma unroll
    for (int r = 0; r < 40; ++r) red[(F.wave * 40 + r) * 64 + F.lane] = acc[r];
    __syncthreads();
    for (int e = F.tid; e < 40 * 64; e += NTHREADS) {
        const int r = e >> 6, l = e & 63; float s = F.b_ada[ng * 64 + l];
#pragma unroll
        for (int w = 0; w < 8; ++w) s += red[(w * 40 + r) * 64 + l];
        F.MOD[r * 6144 + ng * 64 + l] = s;
    }
    __syncthreads();
}
__device__ __forceinline__ void p0_transpose_tile(const Frame& F, const float* W, int N, int K, bf16_t* Wt, int kt, int nt, bool permute) {
    LAS bf16_t* tile = (LAS bf16_t*)F.lds;
    __syncthreads();
    { const int k = F.tid >> 3, c0 = (F.tid & 7) * 8;
      const float* rp = W + (size_t)(kt * 64 + k) * N + nt * 64 + c0;
      const f32x4 z = {0.f, 0.f, 0.f, 0.f};
      const f32x4 v0 = (nt * 64 + c0 < N) ? *(const f32x4*)rp : z, v1 = (nt * 64 + c0 + 4 < N) ? *(const f32x4*)(rp + 4) : z;
#pragma unroll
      for (int j = 0; j < 4; ++j) { tile[k * 66 + c0 + j] = f2bf(v0[j]); tile[k * 66 + c0 + 4 + j] = f2bf(v1[j]); } }
    __syncthreads();
    { const int nl = F.tid >> 3, k0 = (F.tid & 7) * 8; const int n = nt * 64 + nl;
      if (n < N) {
          int nd = n; if (permute) nd = (n < 1024) ? n : (n < 1028 ? C_WI + (n - 1024) : n - 4);
          unsigned p[4];
#pragma unroll
          for (int j = 0; j < 4; ++j) p[j] = (unsigned)tile[(k0 + 2 * j) * 66 + nl] | ((unsigned)tile[(k0 + 2 * j + 1) * 66 + nl] << 16);
          *(u32x4*)(Wt + (size_t)nd * K + kt * 64 + k0) = (u32x4){p[0], p[1], p[2], p[3]};
      } }
}
__device__ __forceinline__ void peer_cvt_rows4(const Frame& F, bool isu, int row0) {
        const float* src = isu ? F.peer_u : F.peer_v;
        unsigned char* dst = F.ws + (isu ? WS_PU8 : WS_PV8); float* sinv = (float*)(F.ws + (isu ? WS_SU : WS_SV));
        float v[4][16];
        if (isu) {
#pragma unroll
            for (int rr = 0; rr < 4; ++rr)
#pragma unroll
                for (int q = 0; q < 4; ++q) {
                    const f32x4 t = *(const f32x4*)(src + (size_t)(row0 + rr) * D + F.lane * 16 + q * 4);
                    v[rr][4 * q] = t[0]; v[rr][4 * q + 1] = t[1]; v[rr][4 * q + 2] = t[2]; v[rr][4 * q + 3] = t[3];
                }
        } else {
#pragma unroll
            for (int rr = 0; rr < 4; ++rr)
#pragma unroll
                for (int c = 0; c < 16; ++c) v[rr][c] = src[(size_t)(row0 + rr) * D + c * 64 + F.lane];
        }
#pragma unroll
        for (int rr = 0; rr < 4; ++rr) {
            float am = 0.f;
#pragma unroll
            for (int c = 0; c < 16; ++c) am = fmaxf(am, fabsf(v[rr][c]));
            am = wave_max(am);
            const float sc = am > 0.f ? 6.f / am : 1.f;
            unsigned w0 = 0u, w1 = 0u;
            w0 = __builtin_amdgcn_cvt_scalef32_pk_fp4_f32(w0, v[rr][0] * sc, v[rr][1] * sc, 1.0f, 0);
            w0 = __builtin_amdgcn_cvt_scalef32_pk_fp4_f32(w0, v[rr][2] * sc, v[rr][3] * sc, 1.0f, 1);
            w0 = __builtin_amdgcn_cvt_scalef32_pk_fp4_f32(w0, v[rr][4] * sc, v[rr][5] * sc, 1.0f, 2);
            w0 = __builtin_amdgcn_cvt_scalef32_pk_fp4_f32(w0, v[rr][6] * sc, v[rr][7] * sc, 1.0f, 3);
            w1 = __builtin_amdgcn_cvt_scalef32_pk_fp4_f32(w1, v[rr][8] * sc, v[rr][9] * sc, 1.0f, 0);
            w1 = __builtin_amdgcn_cvt_scalef32_pk_fp4_f32(w1, v[rr][10] * sc, v[rr][11] * sc, 1.0f, 1);
            w1 = __builtin_amdgcn_cvt_scalef32_pk_fp4_f32(w1, v[rr][12] * sc, v[rr][13] * sc, 1.0f, 2);
            w1 = __builtin_amdgcn_cvt_scalef32_pk_fp4_f32(w1, v[rr][14] * sc, v[rr][15] * sc, 1.0f, 3);
            *(u32x2*)(dst + (size_t)(row0 + rr) * 512 + F.lane * 8) = (u32x2){w0, w1};
            if (F.lane == 0) sinv[row0 + rr] = am > 0.f ? am * (1.f / 6.f) : 1.f;
        }
}
constexpr int P0_OTHER = P0_T_ITEMS + 1;
constexpr int CVT_CHUNKS = 2 * 16384 / 4;
__device__ __forceinline__ void p0_other_item(const Frame& F, int i) {
    if (i < P0_T_ITEMS) {
        if (i < P0_T_WIN) { p0_transpose_tile(F, F.w_in, NMIX, D, F.WIN, i / 74, i % 74, true); return; }
        i -= P0_T_WIN;
        if (i < P0_T_WOA) { p0_transpose_tile(F, F.w_o_attn, D, 512, F.WOA, i / 16, i % 16, false); return; }
        i -= P0_T_WOA;
        if (i < P0_T_WOC) { p0_transpose_tile(F, F.w_o_conv, D, 512, F.WOC, i / 16, i % 16, false); return; }
        i -= P0_T_WOC;
        if (i < P0_T_WOUT) { p0_transpose_tile(F, F.w_out, D, D, F.WOUT, i / 16, i % 16, false); return; }
        i -= P0_T_WOUT;
        p0_transpose_tile(F, F.peer_wq, D, D, F.WQ, i / 16, i % 16, false); return;
    }
    i -= P0_T_ITEMS;
    for (int e = F.tid; e < (4864 - NMIX) * D; e += NTHREADS) F.WIN[(size_t)NMIX * D + e] = 0;
    for (int e = F.tid; e < 128 * 64; e += NTHREADS) { F.K1[e] = f2bf(F.peer_k1[e]); F.K2[e] = f2bf(F.peer_k2[e]); }
}
struct P0Tile { const float* W; bf16_t* Wt; int N, K, kt, nt; bool permute; };
__device__ __forceinline__ P0Tile p0_tile(const Frame& F, int i) {
    if (i < P0_T_WIN) return P0Tile{F.w_in, F.WIN, NMIX, D, i / 74, i % 74, true};
    i -= P0_T_WIN;
    if (i < P0_T_WOA) return P0Tile{F.w_o_attn, F.WOA, D, 512, i / 16, i % 16, false};
    i -= P0_T_WOA;
    if (i < P0_T_WOC) return P0Tile{F.w_o_conv, F.WOC, D, 512, i / 16, i % 16, false};
    i -= P0_T_WOC;
    if (i < P0_T_WOUT) return P0Tile{F.w_out, F.WOUT, D, D, i / 16, i % 16, false};
    i -= P0_T_WOUT;
    return P0Tile{F.peer_wq, F.WQ, D, D, i / 16, i % 16, false};
}
__device__ __forceinline__ void p0_tile_load(const Frame& F, const P0Tile& t, f32x4& v0, f32x4& v1) {
    const int k = F.tid >> 3, c0 = (F.tid & 7) * 8;
    const float* rp = t.W + (size_t)(t.kt * 64 + k) * t.N + t.nt * 64 + c0;
    const f32x4 z = {0.f, 0.f, 0.f, 0.f};
    v0 = (t.nt * 64 + c0 < t.N) ? *(const f32x4*)rp : z; v1 = (t.nt * 64 + c0 + 4 < t.N) ? *(const f32x4*)(rp + 4) : z;
}
__device__ __forceinline__ void p0_tile_finish(const Frame& F, const P0Tile& t, const f32x4 v0, const f32x4 v1) {
    LAS bf16_t* tile = (LAS bf16_t*)F.lds;
    asm volatile("s_waitcnt lgkmcnt(0)" ::: "memory"); __builtin_amdgcn_s_barrier();
    { const int k = F.tid >> 3, c0 = (F.tid & 7) * 8;
#pragma unroll
      for (int j = 0; j < 4; ++j) { tile[k * 66 + c0 + j] = f2bf(v0[j]); tile[k * 66 + c0 + 4 + j] = f2bf(v1[j]); } }
    asm volatile("s_waitcnt lgkmcnt(0)" ::: "memory"); __builtin_amdgcn_s_barrier();
    { const int nl = F.tid >> 3, k0 = (F.tid & 7) * 8; const int n = t.nt * 64 + nl;
      if (n < t.N) {
          int nd = n; if (t.permute) nd = (n < 1024) ? n : (n < 1028 ? C_WI + (n - 1024) : n - 4);
          unsigned p[4];
#pragma unroll
          for (int j = 0; j < 4; ++j) p[j] = (unsigned)tile[(k0 + 2 * j) * 66 + nl] | ((unsigned)tile[(k0 + 2 * j + 1) * 66 + nl] << 16);
          *(u32x4*)(t.Wt + (size_t)nd * t.K + t.kt * 64 + k0) = (u32x4){p[0], p[1], p[2], p[3]};
      } }
}
__device__ __forceinline__ void p0_prologue(const Frame& F) {
    constexpr int NMODWG = P0_MOD_ITEMS;
    if (F.G <= NMODWG) {
        for (int it = F.bid; it < P0_MOD_ITEMS + P0_OTHER; it += F.G) { if (it < P0_MOD_ITEMS) p0_mod_item(F, it); else p0_other_item(F, it - P0_MOD_ITEMS); }
        return;
    }
    if (F.bid < NMODWG) { p0_mod_item(F, F.bid); return; }
    const int nfree = F.G - NMODWG;
    int j = F.bid - NMODWG;
    __syncthreads();
    if (j < P0_T_ITEMS) {
        P0Tile cur = p0_tile(F, j); f32x4 a0, a1; p0_tile_load(F, cur, a0, a1);
        for (;;) {
            const int jn = j + nfree; const bool more = jn < P0_T_ITEMS;
            P0Tile nxt = p0_tile(F, more ? jn : j); f32x4 b0, b1; p0_tile_load(F, nxt, b0, b1);
            p0_tile_finish(F, cur, a0, a1);
            if (!more) break;
            cur = nxt; a0 = b0; a1 = b1; j = jn;
        }
        j += nfree;
    }
    __syncthreads();
    if (j == P0_T_ITEMS) p0_other_item(F, j);
}

__device__ __forceinline__ void p1_modulate(const Frame& F) {
    const int stride = F.G * 8;
    for (int m0 = F.bid * 8 + F.wave; m0 < NT; m0 += 2 * stride) {
        f32x4 xv[2][4], sv[2][4], hv[2][4];
#pragma unroll
        for (int rr = 0; rr < 2; ++rr) {
            const int m = (m0 + rr * stride < NT) ? m0 + rr * stride : m0;
            const float* xr = x_row(F, m); const float* mr = F.MOD + (size_t)mod_row(m) * 6144;
#pragma unroll
            for (int q = 0; q < 4; ++q) {
                const int e = (q >> 1) * 512 + F.lane * 8 + (q & 1) * 4;
                xv[rr][q] = *(const f32x4*)(xr + e); sv[rr][q] = *(const f32x4*)(mr + 1024 + e); hv[rr][q] = *(const f32x4*)(mr + e);
            }
        }
#pragma unroll
        for (int rr = 0; rr < 2; ++rr) {
            const int m = m0 + rr * stride;
            if (m >= NT) continue;
#pragma unroll
            for (int hlf = 0; hlf < 2; ++hlf) {
                const f32x4 a = xv[rr][2 * hlf] * (sv[rr][2 * hlf] + 1.f) + hv[rr][2 * hlf], b2 = xv[rr][2 * hlf + 1] * (sv[rr][2 * hlf + 1] + 1.f) + hv[rr][2 * hlf + 1];
                *(u32x4*)(F.H1 + (size_t)m * D + hlf * 512 + F.lane * 8) = (u32x4){cvt_pk_bf16(a[0], a[1]), cvt_pk_bf16(a[2], a[3]), cvt_pk_bf16(b2[0], b2[1]), cvt_pk_bf16(b2[2], b2[3])};
            }
        }
    }
}

constexpr int BM = 256, BN = 128, BK = 64;
constexpr int XPANEL = BM * 32 + 32, WPANEL = BN * 32 + 32;
constexpr int XSTAGE = 4 * XPANEL, WSTAGE = 4 * WPANEL, GSTAGE = XSTAGE + WSTAGE;
__device__ __forceinline__ void gemm_accum(const Frame& F, f32x16 (&acc)[2][2], const bf16_t* __restrict__ X, int ldx, const bf16_t* __restrict__ W, int ldw, int K, int m0, int n0) {
    const int tid = F.tid, lane = F.lane, r = lane & 31, h = lane >> 5, wm = F.wave >> 1, wn = F.wave & 1;
    u32x4 xr[4], wr[2];
    const int nk = K / BK;
    const int crow = tid >> 3, ckc = tid & 7;
    const bf16_t* xg = X + (size_t)(m0 + crow) * ldx + ckc * 8;
    const bf16_t* wg = W + (size_t)(n0 + crow) * ldw + ckc * 8;
    const int ldso = (ckc >> 1) * 1  ;
    const int xoff = ldso * XPANEL + crow * 32 + (ckc & 1) * 16;
    const int woff = ldso * WPANEL + crow * 32 + (ckc & 1) * 16;
#pragma unroll
    for (int i = 0; i < 4; ++i) xr[i] = *(const u32x4*)(xg + (size_t)(64 * i) * ldx);
#pragma unroll
    for (int i = 0; i < 2; ++i) wr[i] = *(const u32x4*)(wg + (size_t)(64 * i) * ldw);
    __syncthreads();
    for (int kt = 0; kt < nk; ++kt) {
        LAS unsigned char* st = F.lds + (kt & 1) * GSTAGE;
#pragma unroll
        for (int i = 0; i < 4; ++i) *(LAS u32x4*)(st + xoff + i * 64 * 32) = xr[i];
#pragma unroll
        for (int i = 0; i < 2; ++i) *(LAS u32x4*)(st + XSTAGE + woff + i * 64 * 32) = wr[i];
        __syncthreads();
        if (kt + 1 < nk) {
#pragma unroll
            for (int i = 0; i < 4; ++i) xr[i] = *(const u32x4*)(xg + (size_t)(64 * i) * ldx + (kt + 1) * BK);
#pragma unroll
            for (int i = 0; i < 2; ++i) wr[i] = *(const u32x4*)(wg + (size_t)(64 * i) * ldw + (kt + 1) * BK);
        }
#pragma unroll
        for (int s = 0; s < 4; ++s) {
            bf16x8 a[2], b[2];
#pragma unroll
            for (int ni = 0; ni < 2; ++ni) a[ni] = *(LAS bf16x8*)(st + XSTAGE + s * WPANEL + (wn * 64 + ni * 32 + r) * 32 + h * 16);
#pragma unroll
            for (int mi = 0; mi < 2; ++mi) b[mi] = *(LAS bf16x8*)(st + s * XPANEL + (wm * 64 + mi * 32 + r) * 32 + h * 16);
#pragma unroll
            for (int mi = 0; mi < 2; ++mi)
#pragma unroll
                for (int ni = 0; ni < 2; ++ni) acc[mi][ni] = __builtin_amdgcn_mfma_f32_32x32x16_bf16(a[ni], b[mi], acc[mi][ni], 0, 0, 0);
        }
    }
}
#define GEMM_EPI_LOOP(...) \
    { const int r_ = F.lane & 31, h_ = F.lane >> 5, wm_ = F.wave >> 1, wn_ = F.wave & 1; \
      _Pragma("unroll") for (int mi = 0; mi < 2; ++mi) _Pragma("unroll") for (int ni = 0; ni < 2; ++ni) _Pragma("unroll") for (int g = 0; g < 4; ++g) { \
          const int m = m0 + wm_ * 64 + mi * 32 + r_; const int n = n0 + wn_ * 64 + ni * 32 + 8 * g + 4 * h_; __VA_ARGS__ } }
#define ACC4(A) ((f32x4){A[mi][ni][4 * g], A[mi][ni][4 * g + 1], A[mi][ni][4 * g + 2], A[mi][ni][4 * g + 3]})
__device__ __forceinline__ void zero_acc(f32x16 (&acc)[2][2]) {
#pragma unroll
    for (int mi = 0; mi < 2; ++mi)
#pragma unroll
        for (int ni = 0; ni < 2; ++ni)
#pragma unroll
            for (int e = 0; e < 16; ++e) acc[mi][ni][e] = 0.f;
}
__device__ __forceinline__ u32x2 pk4(const f32x4 v) { return (u32x2){cvt_pk_bf16(v[0], v[1]), cvt_pk_bf16(v[2], v[3])}; }

__device__ __forceinline__ void gemm_slice8(const Frame& F, f32x16 (&sacc)[1][1], const bf16_t* __restrict__ X, int ldx, const bf16_t* __restrict__ W, int ldw, int K, int m0, int n0) {
    const int r = F.lane & 31, h = F.lane >> 5, wq = F.wave & 3, kh = F.wave >> 2;
    const bf16_t* wp = W + (size_t)(n0 + 32 * wq + r) * ldw + kh * (K / 2) + h * 8;
    const bf16_t* xp = X + (size_t)(m0 + (r & 7)) * ldx + kh * (K / 2) + h * 8;
    f32x16 c;
#pragma unroll
    for (int e = 0; e < 16; ++e) c[e] = 0.f;
#pragma unroll 1
    for (int k0 = 0; k0 < K / 2; k0 += 128) {
        bf16x8 a[8], b[8];
#pragma unroll
        for (int t = 0; t < 8; ++t) { a[t] = *(const bf16x8*)(wp + k0 + t * 16); b[t] = *(const bf16x8*)(xp + k0 + t * 16); }
#pragma unroll
        for (int t = 0; t < 8; ++t) c = __builtin_amdgcn_mfma_f32_32x32x16_bf16(a[t], b[t], c, 0, 0, 0);
    }
    LAS float* cb = (LAS float*)F.lds + wq * (16 * 64);
    __syncthreads();
    if (kh == 1) {
#pragma unroll
        for (int e = 0; e < 16; ++e) cb[e * 64 + F.lane] = c[e];
    }
    __syncthreads();
    if (kh == 0) {
#pragma unroll
        for (int e = 0; e < 16; ++e) c[e] += cb[e * 64 + F.lane];
    }
    sacc[0][0] = c;
}
#define SLICE_EPI_LOOP(...) \
    if (F.wave < 4 && (F.lane & 31) < 8) { const int h_ = F.lane >> 5, wq_ = F.wave & 3; constexpr int mi = 0, ni = 0; \
      _Pragma("unroll") for (int g = 0; g < 4; ++g) { const int m = m0 + (F.lane & 31); const int n = n0 + wq_ * 32 + 8 * g + 4 * h_; __VA_ARGS__ } }

namespace pg8 {
#define PG8_LAS __attribute__((address_space(3)))
typedef unsigned short bf16_t;
typedef short bf16x8 __attribute__((ext_vector_type(8)));
typedef float f32x4 __attribute__((ext_vector_type(4)));
typedef unsigned u32x4 __attribute__((ext_vector_type(4)));
constexpr int BM = 256, BK = 64, HALF = 128, HTB = HALF * BK * 2  , STAGE_BYTES = 8 * HTB, NXCD = 8, WGM = 8;

__host__ __device__ __forceinline__ int lds_byte(int r, int c) { const int st = (r >> 4) * 2 + (c >> 5), rr = r & 15, cc = c & 31, ob = rr * 64 + cc * 2; return st * 1024 + (ob ^ (((ob >> 9) & 1) << 5)); }
__host__ __device__ __forceinline__ void stage_rc(int b, int& R, int& C) { const int st = b / 1024, sb = b % 1024, swz = sb ^ (((sb >> 9) & 1) << 5); R = (st >> 1) * 16 + swz / 64; C = (st & 1) * 32 + (swz % 64) / 2; }
__host__ __device__ __forceinline__ int perm32(int rho) { const int n = rho >> 4, i = rho & 15; return 8 * (i >> 2) + 4 * n + (i & 3); }

struct Unit { int pm, pn; };
struct Gemm { const bf16_t* A; const bf16_t* Bt; int M, N, K; };

struct StaticOrder {
    int nM, nN, nwg, G, c;
    __host__ __device__ void init(int M, int N, int G_, int c_) { nM = M / BM; nN = N / BM; nwg = nM * nN; G = G_; c = c_; }
    __host__ __device__ bool next(int i, Unit& u) const {
        const long L = (long)i * G + c; if (L >= nwg) return false;
        int wgid = (int)L; { const int q = nwg / NXCD, r = nwg % NXCD, xcd = wgid % NXCD, off = wgid / NXCD; wgid = (xcd < r ? xcd * (q + 1) : r * (q + 1) + (xcd - r) * q) + off; }
        const int nig = WGM * nN, gid = wgid / nig, fm = gid * WGM, gsz = (nM - fm) < WGM ? (nM - fm) : WGM;
        u.pm = fm + ((wgid % nig) % gsz); u.pn = (wgid % nig) / gsz; return true;
    }
    __device__ __forceinline__ void a_ready(const Unit&) const {}
    __device__ __forceinline__ void done(const Unit&) const {}
};

template <class Body> struct EpiRC {
    static constexpr bool PERM = false, AFTER_DRAIN = false;
    Body body;
    __device__ __forceinline__ void operator()(const f32x4 (&acc)[2][2][4][2], const Unit& u, int wr, int wc, int fr, int fq) const {
#pragma unroll
        for (int ai = 0; ai < 2; ++ai)
#pragma unroll
            for (int m = 0; m < 4; ++m) {
                const int row = u.pm * BM + ai * HALF + wr * 64 + m * 16 + fr;
#pragma unroll
                for (int bj = 0; bj < 2; ++bj)
#pragma unroll
                    for (int n = 0; n < 2; ++n) body(row, u.pn * BM + bj * HALF + wc * 32 + n * 16 + 4 * fq, acc[ai][bj][m][n]);
            }
    }
};
template <class Epi, class Sched, bool ALIGN_EPI = false, bool SP2 = false>
__device__ __forceinline__ void gemm_phase(PG8_LAS unsigned char* lds, const Gemm g, const Sched& S, const Epi& E) {
    const int tid = threadIdx.x, wid = __builtin_amdgcn_readfirstlane(tid >> 6), lane = tid & 63, wr = wid >> 2, wc = wid & 3, fr = lane & 15, fq = lane >> 4;
    const int K = g.K, nt = K / BK;
    unsigned voffA[2], voffB[2];
#pragma unroll
    for (int i = 0; i < 2; ++i) { int R, C; stage_rc(tid * 16 + i * 8192, R, C); const int Rb = Epi::PERM ? ((R & ~31) + perm32(R & 31)) : R;
        voffA[i] = (unsigned)(R * K + C) * 2u; voffB[i] = (unsigned)(Rb * K + C) * 2u; }
    const size_t kstep = (size_t)(BK * 2);
    const size_t hstep = (size_t)HALF * K * 2;
    const size_t tstep = 2 * hstep;
    const unsigned ldsw = (unsigned)wid * 1024u;
    const int aoff = lds_byte(wr * 64 + fr, fq * 8), boff = lds_byte(wc * 32 + fr, fq * 8);
#define PG8_SA(b, h) (((b) * 2 + (h)) * HTB)
#define PG8_SB(b, h) ((4 + (b) * 2 + (h)) * HTB)
#define PG8_STAGE(bufoff, gbase, voff) do { _Pragma("unroll") for (int _i = 0; _i < 2; ++_i) \
        __builtin_amdgcn_global_load_lds((const unsigned*)((const char*)(gbase) + (voff)[_i]), (PG8_LAS unsigned*)(lds + (bufoff) + ldsw + _i * 8192), 16, 0, 0); } while (0)
#define PG8_LDA(dst, b, h) do { _Pragma("unroll") for (int m = 0; m < 4; ++m) _Pragma("unroll") for (int k = 0; k < 2; ++k) dst[m][k] = *(const PG8_LAS bf16x8*)(lds + PG8_SA(b, h) + aoff + m * 2048 + k * 1024); } while (0)
#define PG8_LDB(dst, b, h) do { _Pragma("unroll") for (int n = 0; n < 2; ++n) _Pragma("unroll") for (int k = 0; k < 2; ++k) dst[n][k] = *(const PG8_LAS bf16x8*)(lds + PG8_SB(b, h) + boff + n * 2048 + k * 1024); } while (0)
#define PG8_MMA(ai, bj, At, Bt) do { __builtin_amdgcn_s_setprio(1); _Pragma("unroll") for (int m = 0; m < 4; ++m) _Pragma("unroll") for (int n = 0; n < 2; ++n) _Pragma("unroll") for (int k = 0; k < 2; ++k) \
        acc[ai][bj][m][n] = __builtin_amdgcn_mfma_f32_16x16x32_bf16(Bt[n][k], At[m][k], acc[ai][bj][m][n], 0, 0, 0); __builtin_amdgcn_s_setprio(0); } while (0)
#define PG8_WAIT_V(n) asm volatile("s_waitcnt vmcnt(" #n ")" ::: "memory")
#define PG8_WAIT_L(n) asm volatile("s_waitcnt lgkmcnt(" #n ")" ::: "memory")
#define PG8_BAR __builtin_amdgcn_s_barrier()
#define PG8_SCHED __builtin_amdgcn_sched_barrier(0)
    Unit cur, nxt; int ui = 0;
    if (!S.next(0, cur)) return;
    f32x4 acc[2][2][4][2];
#pragma unroll
    for (int a = 0; a < 2; ++a)
#pragma unroll
        for (int b = 0; b < 2; ++b)
#pragma unroll
            for (int m = 0; m < 4; ++m)
#pragma unroll
                for (int n = 0; n < 2; ++n) acc[a][b][m][n] = (f32x4){0.f, 0.f, 0.f, 0.f};
    bf16x8 At[4][2], B0[2][2], B1[2][2];
    const char* cA = (const char*)g.A + (size_t)cur.pm * tstep; const char* cB = (const char*)g.Bt + (size_t)cur.pn * tstep;
    S.a_ready(cur);
    if constexpr (SP2) {
        PG8_STAGE(PG8_SB(0, 0), cB, voffB); PG8_STAGE(PG8_SB(0, 1), cB + hstep, voffB); PG8_STAGE(PG8_SA(0, 0), cA, voffA); PG8_STAGE(PG8_SA(0, 1), cA + hstep, voffA);
        if (wr == 1) PG8_BAR;
        PG8_WAIT_V(2); PG8_BAR;
        PG8_STAGE(PG8_SB(1, 0), cB + kstep, voffB); PG8_STAGE(PG8_SA(1, 0), cA + kstep, voffA); PG8_STAGE(PG8_SB(1, 1), cB + hstep + kstep, voffB);
        PG8_WAIT_V(6); PG8_BAR;
    } else {
        PG8_STAGE(PG8_SB(0, 0), cB, voffB); PG8_STAGE(PG8_SA(0, 0), cA, voffA); PG8_STAGE(PG8_SB(0, 1), cB + hstep, voffB); PG8_STAGE(PG8_SA(0, 1), cA + hstep, voffA);
        if (wr == 1) PG8_BAR;
        PG8_WAIT_V(4); PG8_BAR;
        PG8_STAGE(PG8_SB(1, 0), cB + kstep, voffB); PG8_STAGE(PG8_SA(1, 0), cA + kstep, voffA); PG8_STAGE(PG8_SB(1, 1), cB + hstep + kstep, voffB);
        PG8_WAIT_V(6); PG8_BAR;
    }
    for (;;) {
        const bool has_next = S.next(ui + 1, nxt);
        const char* nA = has_next ? (const char*)g.A + (size_t)nxt.pm * tstep : cA; const char* nB = has_next ? (const char*)g.Bt + (size_t)nxt.pn * tstep : cB;
        for (int t = 0; t < nt; t += 2) {
            const bool last = (t == nt - 2);
            const char* a1 = cA + (size_t)(t + 1) * kstep;
            const char* a2 = last ? nA : cA + (size_t)(t + 2) * kstep; const char* b2 = last ? nB : cB + (size_t)(t + 2) * kstep;
            const char* a3 = a2 + kstep; const char* b3 = b2 + kstep;
            if (last && has_next) S.a_ready(nxt);
            if constexpr (SP2) {
            PG8_LDB(B0, 0, 0); PG8_LDB(B1, 0, 1); PG8_SCHED; PG8_LDA(At, 0, 0); PG8_STAGE(PG8_SA(1, 1), a1 + hstep, voffA);
            PG8_WAIT_V(8); PG8_WAIT_L(0); PG8_BAR; PG8_MMA(0, 0, At, B0); PG8_MMA(0, 1, At, B1); PG8_BAR; PG8_SCHED;
            PG8_LDA(At, 0, 1); PG8_STAGE(PG8_SB(0, 0), b2, voffB); PG8_STAGE(PG8_SB(0, 1), b2 + hstep, voffB); PG8_STAGE(PG8_SA(0, 0), a2, voffA);
            PG8_WAIT_V(8); PG8_WAIT_L(0); PG8_BAR; PG8_MMA(1, 0, At, B0); PG8_MMA(1, 1, At, B1); PG8_BAR; PG8_SCHED;
            PG8_LDB(B0, 1, 0); PG8_LDB(B1, 1, 1); PG8_SCHED; PG8_LDA(At, 1, 0); PG8_STAGE(PG8_SA(0, 1), a2 + hstep, voffA);
            PG8_WAIT_V(8); PG8_WAIT_L(0); PG8_BAR; PG8_MMA(0, 0, At, B0); PG8_MMA(0, 1, At, B1); PG8_BAR; PG8_SCHED;
            PG8_LDA(At, 1, 1); PG8_STAGE(PG8_SB(1, 0), b3, voffB); PG8_STAGE(PG8_SB(1, 1), b3 + hstep, voffB); PG8_STAGE(PG8_SA(1, 0), a3, voffA);
            PG8_WAIT_V(8); PG8_WAIT_L(0); PG8_BAR; PG8_MMA(1, 0, At, B0); PG8_MMA(1, 1, At, B1); PG8_BAR; PG8_SCHED;
            } else {
            PG8_LDB(B0, 0, 0); PG8_SCHED; PG8_LDA(At, 0, 0); PG8_STAGE(PG8_SA(1, 1), a1 + hstep, voffA);
            PG8_WAIT_L(8); PG8_BAR; PG8_WAIT_L(0); PG8_MMA(0, 0, At, B0); PG8_BAR; PG8_SCHED;
            PG8_LDB(B1, 0, 1); PG8_STAGE(PG8_SB(0, 0), b2, voffB);
            PG8_BAR; PG8_WAIT_L(0); PG8_MMA(0, 1, At, B1); PG8_BAR;
            PG8_LDA(At, 0, 1); PG8_STAGE(PG8_SA(0, 0), a2, voffA);
            PG8_BAR; PG8_WAIT_L(0); PG8_MMA(1, 0, At, B0); PG8_BAR; PG8_SCHED;
            PG8_STAGE(PG8_SB(0, 1), b2 + hstep, voffB);
            PG8_WAIT_V(6); PG8_BAR; PG8_MMA(1, 1, At, B1); PG8_BAR;
            PG8_LDB(B0, 1, 0); PG8_SCHED; PG8_LDA(At, 1, 0); PG8_STAGE(PG8_SA(0, 1), a2 + hstep, voffA);
            PG8_WAIT_L(8); PG8_BAR; PG8_WAIT_L(0); PG8_MMA(0, 0, At, B0); PG8_BAR; PG8_SCHED;
            PG8_LDB(B1, 1, 1); PG8_STAGE(PG8_SB(1, 0), b3, voffB);
            PG8_BAR; PG8_WAIT_L(0); PG8_MMA(0, 1, At, B1); PG8_BAR;
            PG8_LDA(At, 1, 1); PG8_STAGE(PG8_SA(1, 0), a3, voffA);
            PG8_BAR; PG8_WAIT_L(0); PG8_MMA(1, 0, At, B0); PG8_BAR; PG8_SCHED;
            PG8_STAGE(PG8_SB(1, 1), b3 + hstep, voffB);
            PG8_WAIT_V(6); PG8_BAR; PG8_MMA(1, 1, At, B1); PG8_BAR;
            }
        }
        if constexpr (ALIGN_EPI) { if (wr == 0) PG8_BAR; }
        if constexpr (!Epi::AFTER_DRAIN) { E(acc, cur, wr, wc, fr, fq); S.done(cur); }
        if (!has_next) break;
#pragma unroll
        for (int a = 0; a < 2; ++a)
#pragma unroll
            for (int b = 0; b < 2; ++b)
#pragma unroll
                for (int m = 0; m < 4; ++m)
#pragma unroll
                    for (int n = 0; n < 2; ++n) acc[a][b][m][n] = (f32x4){0.f, 0.f, 0.f, 0.f};
        cur = nxt; cA = nA; cB = nB; ++ui;
        if constexpr (ALIGN_EPI) { if (wr == 1) PG8_BAR; }
    }
    PG8_WAIT_V(0);
    if constexpr (!ALIGN_EPI) { if (wr == 0) PG8_BAR; }
    PG8_BAR;
    if constexpr (Epi::AFTER_DRAIN) { E.fused(acc, cur, wr, wc, fr, fq, lds, wid, lane); S.done(cur); }
#undef PG8_SA
#undef PG8_SB
#undef PG8_STAGE
#undef PG8_LDA
#undef PG8_LDB
#undef PG8_MMA
#undef PG8_WAIT_V
#undef PG8_WAIT_L
#undef PG8_BAR
#undef PG8_SCHED
}
}

constexpr int NMIXW = 4864;
struct P2Body {
    const Frame* Fp;
    __device__ __forceinline__ void operator()(int m, int n, const f32x4 v) const {
        const Frame& F = *Fp;
        if (n >= NMIXP) return;
        *(u32x2*)(F.PROJ + (size_t)m * NMIXP + n) = pk4(v);
        if (n >= C_K && n < C_QI) {
            float* o = (n < C_V) ? (m < NTP ? F.out + O_KP + (size_t)m * 128 + (n - C_K) : F.out + O_KS + (size_t)(m - NTP) * 128 + (n - C_K))
                                 : (m < NTP ? F.out + O_VP + (size_t)m * 128 + (n - C_V) : F.out + O_VS + (size_t)(m - NTP) * 128 + (n - C_V));
            *(f32x4*)o = v;
            if (n >= C_V && m < NTP) {
                bf16_t* vt = (bf16_t*)(F.ws + WS_VT) + ((size_t)((m >> 11) * 2 + ((n - C_V) >> 6)) * 64 + ((n - C_V) & 63)) * SEQ + (m & 2047);
                vt[0] = f2bf(v[0]); vt[SEQ] = f2bf(v[1]); vt[2 * SEQ] = f2bf(v[2]); vt[3 * SEQ] = f2bf(v[3]);
            }
        } else if (n >= C_KI && n < C_BG) {
            float* o = m < NTP ? F.out + O_KIP + (size_t)m * 64 + (n - C_KI) : F.out + O_KIS + (size_t)(m - NTP) * 64 + (n - C_KI);
            *(f32x4*)o = v;
        } else if (n == C_WI) {
            *(f32x4*)(F.WI + (size_t)m * 4) = v;
        } else if (n >= C_CG && n < C_GA) {
            const int tt = (m < NTP) ? (m & 2047) - (SEQ - 2) : ((m - NTP) & 7) - (TS - 2);
            if (tt >= 0) {
                const int rowi = (m < NTP) ? (m >> 11) * 2 + tt : 2 * NB_P + ((m - NTP) >> 3) * 2 + tt;
                *(f32x4*)((float*)(F.ws + WS_CGX) + (size_t)rowi * 1024 + (n - C_CG)) = v;
            }
        }
    }
};
__device__ __forceinline__ void p2_gemm_in(const Frame& F) {
    pg8::Gemm g{F.H1, F.WIN, NT, NMIXW, D};
    pg8::StaticOrder S; S.init(NT, NMIXW, F.G, F.bid);
    pg8::EpiRC<P2Body> E{P2Body{&F}};
    pg8::gemm_phase<pg8::EpiRC<P2Body>, pg8::StaticOrder, true, true>(F.lds, g, S, E);
}

constexpr int SROW = 2052;
__device__ __forceinline__ int wave_sum_i(int v) {
#pragma unroll
    for (int o = 32; o >= 1; o >>= 1) v += __shfl_xor(v, o);
    return v;
}
__device__ __forceinline__ void cnt_ge(int& c, unsigned u, unsigned t) { asm("v_cmp_ge_u32_e32 vcc, %1, %2\n\tv_addc_co_u32_e32 %0, vcc, 0, %0, vcc" : "+v"(c) : "v"(u), "v"(t) : "vcc"); }
__device__ __forceinline__ void cnt_gt(int& c, unsigned u, unsigned t) { asm("v_cmp_gt_u32_e32 vcc, %1, %2\n\tv_addc_co_u32_e32 %0, vcc, 0, %0, vcc" : "+v"(c) : "v"(u), "v"(t) : "vcc"); }
__device__ __forceinline__ void cnt_eq(int& c, unsigned u, unsigned t) { asm("v_cmp_eq_u32_e32 vcc, %1, %2\n\tv_addc_co_u32_e32 %0, vcc, 0, %0, vcc" : "+v"(c) : "v"(u), "v"(t) : "vcc"); }
__device__ __forceinline__ void cnt_lt4(int& cl, unsigned u0, unsigned u1, unsigned u2, unsigned u3, unsigned t) {
    int d0, d1, d2, d3;
    asm("v_sub_u32 %1, %5, %9\n\tv_sub_u32 %2, %6, %9\n\tv_sub_u32 %3, %7, %9\n\tv_sub_u32 %4, %8, %9\n\t"
        "v_lshrrev_b32 %1, 31, %1\n\tv_lshrrev_b32 %2, 31, %2\n\tv_lshrrev_b32 %3, 31, %3\n\tv_lshrrev_b32 %4, 31, %4\n\t"
        "v_add3_u32 %0, %0, %1, %2\n\tv_add3_u32 %0, %0, %3, %4"
        : "+v"(cl), "=&v"(d0), "=&v"(d1), "=&v"(d2), "=&v"(d3) : "v"(u0), "v"(u1), "v"(u2), "v"(u3), "v"(t));
}
__device__ __forceinline__ void cnt_eq_pos(int& c, unsigned u, unsigned t, int L) {
    int tmp;
    asm("v_cmp_eq_u32_e32 vcc, %2, %3\n\tv_cndmask_b32_e32 %1, %5, %4, vcc\n\tv_cmp_lt_i32_e32 vcc, 0, %1\n\tv_addc_co_u32_e32 %0, vcc, 0, %0, vcc"
        : "+v"(c), "=&v"(tmp) : "v"(u), "v"(t), "v"(L), "v"(0x80000000) : "vcc");
}
__device__ __forceinline__ int wave_sum_i_dpp(int v) {
    v += __builtin_amdgcn_update_dpp(0, v, 0xB1, 0xF, 0xF, false);
    v += __builtin_amdgcn_update_dpp(0, v, 0x4E, 0xF, 0xF, false);
    v += __builtin_amdgcn_update_dpp(0, v, 0x141, 0xF, 0xF, false);
    v += __builtin_amdgcn_update_dpp(0, v, 0x140, 0xF, 0xF, false);
    v += __builtin_amdgcn_update_dpp(0, v, 0x142, 0xA, 0xF, false);
    v += __builtin_amdgcn_update_dpp(0, v, 0x143, 0xC, 0xF, false);
    return __builtin_amdgcn_readlane(v, 63);
}
template <int NV> __device__ __forceinline__ void select_threshold(const unsigned (&u)[NV], int ksel, int idx_bits, int lane, unsigned& T_out, int& Jx_out, int& ngt_out) {
    unsigned T = 0;
#pragma unroll 1
    for (int bit = 31; bit >= 0; --bit) {
        const unsigned cand = T | (1u << bit);
        int c = 0;
#pragma unroll
        for (int i = 0; i < NV; ++i) cnt_ge(c, u[i], cand);
        c = wave_sum_i_dpp(c);
        if (c >= ksel) T = cand;
    }
    int cg = 0, ce = 0;
#pragma unroll
    for (int i = 0; i < NV; ++i) { cnt_gt(cg, u[i], T); cnt_eq(ce, u[i], T); }
    const int ngt = wave_sum_i_dpp(cg), neq = wave_sum_i_dpp(ce);
    const int need = ksel - ngt;
    int Jx = 0x3FFFFFFF;
    if (need < neq) {
        int Jb = 0;
#pragma unroll 1
        for (int bit = idx_bits - 1; bit >= 0; --bit) {
            const int cand = Jb | (1 << bit);
            const int L = cand - lane;
            int c = 0;
#pragma unroll
            for (int i = 0; i < NV; ++i) cnt_eq_pos(c, u[i], T, L - 64 * i);
            c = wave_sum_i_dpp(c);
            if (c < need) Jb = cand;
        }
        Jx = Jb + 1;
    }
    T_out = T; Jx_out = Jx; ngt_out = ngt;
}
template <int NV> __device__ __forceinline__ void select_threshold2(const unsigned (&ua)[NV], const unsigned (&ub)[NV], int ksel, int idx_bits, int lane, int ng,
                                                                   unsigned& Ta_out, int& Jxa_out, unsigned& Tb_out, int& Jxb_out) {
    unsigned Ta = 0, Tb = 0;
    bool da = false, db = false;
#pragma unroll 1
    for (int bit = 30; bit >= 0 && !(da && db); --bit) {
        const unsigned ca = da ? Ta : (Ta | (1u << bit)), cb = db ? Tb : (Tb | (1u << bit));
        int la = 0, lb = 0;
#pragma unroll
        for (int i = 0; i < NV; i += 4) { if (i < 4 * ng) { cnt_lt4(la, ua[i], ua[i + 1], ua[i + 2], ua[i + 3], ca); cnt_lt4(lb, ub[i], ub[i + 1], ub[i + 2], ub[i + 3], cb); } }
        const int na = ng * 256 - wave_sum_i_dpp(la), nb = ng * 256 - wave_sum_i_dpp(lb);
        if (!da && na >= ksel) { Ta = ca; da = (na == ksel); }
        if (!db && nb >= ksel) { Tb = cb; db = (nb == ksel); }
    }
    int ga = 0, ea = 0, gb = 0, eb = 0;
#pragma unroll
    for (int i = 0; i < NV; ++i) { cnt_gt(ga, ua[i], Ta); cnt_eq(ea, ua[i], Ta); cnt_gt(gb, ub[i], Tb); cnt_eq(eb, ub[i], Tb); }
    const int needa = ksel - wave_sum_i_dpp(ga), neqa = wave_sum_i_dpp(ea), needb = ksel - wave_sum_i_dpp(gb), neqb = wave_sum_i_dpp(eb);
    int Jxa = 0x3FFFFFFF, Jxb = 0x3FFFFFFF;
    if (needa < neqa) {
        int Jb = 0;
#pragma unroll 1
        for (int bit = idx_bits - 1; bit >= 0; --bit) {
            const int cand = Jb | (1 << bit); const int L = cand - lane; int c = 0;
#pragma unroll
            for (int i = 0; i < NV; ++i) cnt_eq_pos(c, ua[i], Ta, L - 64 * i);
            if (wave_sum_i_dpp(c) < needa) Jb = cand;
        }
        Jxa = Jb + 1;
    }
    if (needb < neqb) {
        int Jb = 0;
#pragma unroll 1
        for (int bit = idx_bits - 1; bit >= 0; --bit) {
            const int cand = Jb | (1 << bit); const int L = cand - lane; int c = 0;
#pragma unroll
            for (int i = 0; i < NV; ++i) cnt_eq_pos(c, ub[i], Tb, L - 64 * i);
            if (wave_sum_i_dpp(c) < needb) Jb = cand;
        }
        Jxb = Jb + 1;
    }
    Ta_out = Ta; Jxa_out = Jxa; Tb_out = Tb; Jxb_out = Jxb;
}
template <int NV> __device__ __forceinline__ void select_topk(const unsigned (&u)[NV], int ksel, int idx_bits, int* sel, int lane) {
    unsigned T; int Jx, ngt;
    select_threshold<NV>(u, ksel, idx_bits, lane, T, Jx, ngt);
    const int L = Jx - lane;
    int cg = 0, ct = 0;
#pragma unroll
    for (int i = 0; i < NV; ++i) { cnt_gt(cg, u[i], T); cnt_eq_pos(ct, u[i], T, L - 64 * i); }
    int ig = cg, it = ct;
#pragma unroll
    for (int o = 1; o < 64; o <<= 1) { const int a = __shfl_up(ig, o), b2 = __shfl_up(it, o); if (lane >= o) { ig += a; it += b2; } }
    int pg = ig - cg, pt = ngt + it - ct;
    int ev = lane, Lr = L;
#pragma unroll
    for (int i = 0; i < NV; ++i) {
        if (u[i] > T) { sel[pg] = ev; ++pg; }
        else if (u[i] == T && Lr > 0) { sel[pt] = ev; ++pt; }
        asm volatile("v_add_u32 %0, 64, %0\n\tv_add_u32 %1, -64, %1" : "+v"(ev), "+v"(Lr));
    }
}

constexpr int PU_MB = 16 * SROW * 4;
constexpr int PU_RB = PU_MB + 16 * 64 * 4;
constexpr int PU_BT = PU_RB + 1024;
constexpr int PU_QT = PU_BT + 512, PU_QROW = 1040;
__device__ __forceinline__ int kappa32(int r) { return (r & 0x13) | ((r & 4) << 1) | ((r & 8) >> 1); }
__device__ __forceinline__ void p3_prompt_fused_unit(const Frame& F, const bf16_t* VT, int b, int qt) {
    LAS float* S = (LAS float*)F.lds;
    LAS unsigned* MB = (LAS unsigned*)(F.lds + PU_MB);
    LAS float* RB = (LAS float*)(F.lds + PU_RB);
    LAS int* BT = (LAS int*)(F.lds + PU_BT);
    const int lane = F.lane;
    const int q0 = qt * 16; const size_t tok0 = (size_t)b * SEQ;
    __syncthreads();
    for (int ch = F.tid; ch < 16 * 64; ch += NTHREADS) {
        const u32x4 qv = *(const u32x4*)(F.PROJ + (tok0 + q0 + (ch >> 6)) * NMIXP + C_Q + (ch & 63) * 8);
        constexpr float QS = ATTN_SCALE * 1.4426950408889634f;
        *(LAS u32x4*)(F.lds + PU_QT + (ch >> 6) * PU_QROW + (ch & 63) * 16) = (u32x4){cvt_pk_bf16(bflo(qv[0]) * QS, bfhi(qv[0]) * QS), cvt_pk_bf16(bflo(qv[1]) * QS, bfhi(qv[1]) * QS),
                                                                                    cvt_pk_bf16(bflo(qv[2]) * QS, bfhi(qv[2]) * QS), cvt_pk_bf16(bflo(qv[3]) * QS, bfhi(qv[3]) * QS)};
    }
    {
        const int r = lane & 15, q4 = lane >> 4;
        bf16x8 A[4][2];
#pragma unroll
        for (int hh = 0; hh < 4; ++hh)
#pragma unroll
            for (int s2 = 0; s2 < 2; ++s2) A[hh][s2] = *(const bf16x8*)(F.PROJ + (tok0 + q0 + r) * NMIXP + C_QI + hh * 64 + s2 * 32 + q4 * 8);
        float wv[4][4];
#pragma unroll
        for (int g = 0; g < 4; ++g) { const f32x4 w4 = *(const f32x4*)(F.WI + (tok0 + q0 + 4 * q4 + g) * 4);
#pragma unroll
            for (int hh = 0; hh < 4; ++hh) wv[g][hh] = w4[hh] * IDX_SCALE; }
        const int nkt = qt + 1;
        bf16x8 Bn[2][2];
        {
            const int t0 = 2 * F.wave;
#pragma unroll
            for (int p = 0; p < 2; ++p)
#pragma unroll
                for (int s2 = 0; s2 < 2; ++s2) { const int key = (t0 + p < nkt ? t0 + p : 0) * 16 + r; Bn[p][s2] = *(const bf16x8*)(F.PROJ + (tok0 + key) * NMIXP + C_KI + s2 * 32 + q4 * 8); }
        }
#pragma unroll 1
        for (int t0 = 2 * F.wave; t0 < nkt; t0 += 16) {
            bf16x8 B[2][2] = {{Bn[0][0], Bn[0][1]}, {Bn[1][0], Bn[1][1]}};
            {
                const int tn = t0 + 16;
#pragma unroll
                for (int p = 0; p < 2; ++p)
#pragma unroll
                    for (int s2 = 0; s2 < 2; ++s2) { const int key = (tn + p < nkt ? tn + p : 0) * 16 + r; Bn[p][s2] = *(const bf16x8*)(F.PROJ + (tok0 + key) * NMIXP + C_KI + s2 * 32 + q4 * 8); }
            }
#pragma unroll
            for (int p = 0; p < 2; ++p) {
                if (t0 + p >= nkt) continue;
                float sc[4] = {0.f, 0.f, 0.f, 0.f};
#pragma unroll
                for (int hh = 0; hh < 4; ++hh) {
                    f32x4 c = {0.f, 0.f, 0.f, 0.f};
                    c = __builtin_amdgcn_mfma_f32_16x16x32_bf16(A[hh][0], B[p][0], c, 0, 0, 0);
                    c = __builtin_amdgcn_mfma_f32_16x16x32_bf16(A[hh][1], B[p][1], c, 0, 0, 0);
#pragma unroll
                    for (int g = 0; g < 4; ++g) sc[g] += fmaxf(c[g], 0.f) * wv[g][hh];
                }
#pragma unroll
                for (int g = 0; g < 4; ++g) S[(4 * q4 + g) * SROW + (t0 + p) * 16 + r] = sc[g];
            }
        }
    }
    __syncthreads();
    {
        const int rowa = F.wave * 2, rowb = rowa + 1;
        const int nva = q0 + rowa + 1, nvb = nva + 1;
        if (nvb <= NSEL) {
#pragma unroll
            for (int i = 0; i < 32; ++i) {
                const unsigned long long ma = __ballot(lane + 64 * i < nva), mb = __ballot(lane + 64 * i < nvb);
                if (lane == 0) { MB[rowa * 64 + 2 * i] = (unsigned)ma; MB[rowa * 64 + 2 * i + 1] = (unsigned)(ma >> 32); MB[rowb * 64 + 2 * i] = (unsigned)mb; MB[rowb * 64 + 2 * i + 1] = (unsigned)(mb >> 32); }
            }
        } else {
            unsigned ua[32], ub[32];
#pragma unroll
            for (int i = 0; i < 32; ++i) { const int j = lane + 64 * i; ua[i] = (j < nva) ? (f2ord(S[rowa * SROW + j]) >> 1) : 0u; ub[i] = (j < nvb) ? (f2ord(S[rowb * SROW + j]) >> 1) : 0u; }
            unsigned Ta, Tb; int Jxa, Jxb;
            select_threshold2<32>(ua, ub, NSEL, 11, lane, (nvb + 255) >> 8, Ta, Jxa, Tb, Jxb);
            const int La = Jxa - lane, Lb = Jxb - lane;
#pragma unroll
            for (int i = 0; i < 32; ++i) {
                const bool ta = (ua[i] > Ta) || (ua[i] == Ta && (La - 64 * i) > 0), tb = (ub[i] > Tb) || (ub[i] == Tb && (Lb - 64 * i) > 0);
                const unsigned long long ma = __ballot(ta), mb = __ballot(tb);
                if (lane == 0) { MB[rowa * 64 + 2 * i] = (unsigned)ma; MB[rowa * 64 + 2 * i + 1] = (unsigned)(ma >> 32); MB[rowb * 64 + 2 * i] = (unsigned)mb; MB[rowb * 64 + 2 * i + 1] = (unsigned)(mb >> 32); }
            }
        }
    }
    __syncthreads();
    {
        const int g = F.wave & 1, kq = F.wave >> 1;
        const int c = lane & 31, h = lane >> 5;
        const int hd = g * 4 + (c & 3);
        LAS const unsigned char* Qb = F.lds + PU_QT + (c >> 2) * PU_QROW + (hd * 64 + h * 8) * 2;
        constexpr float L2E = 1.4426950408889634f;
        const float b31 = RB[31 * 8 + hd] * L2E;
        const int ntile = ((q0 + 15) >> 5) + 1;
        const bf16_t* Kb = F.PROJ + (tok0 + kappa32(c)) * NMIXP + C_K + g * 64 + h * 8;
        const bf16_t* Vb = VT + ((size_t)((b * 2 + g) * 64 + c)) * SEQ + h * 8;
        f32x16 O[2][2];
#pragma unroll
        for (int rt = 0; rt < 2; ++rt)
#pragma unroll
            for (int d = 0; d < 2; ++d)
#pragma unroll
                for (int e = 0; e < 16; ++e) O[rt][d][e] = 0.f;
        float lsum[2] = {0.f, 0.f};
        bf16x8 Kn[4];
        {
            const int key0 = (kq < ntile ? kq : 0) * 32;
#pragma unroll
            for (int s4 = 0; s4 < 4; ++s4) Kn[s4] = *(const bf16x8*)(Kb + (size_t)key0 * NMIXP + s4 * 16);
        }
#pragma unroll 1
        for (int kt = kq; kt < ntile; kt += 4) {
            const int key0 = kt * 32;
            bf16x8 Kf[4] = {Kn[0], Kn[1], Kn[2], Kn[3]}, Vf[2][2];
#pragma unroll
            for (int d = 0; d < 2; ++d)
#pragma unroll
                for (int s2 = 0; s2 < 2; ++s2) Vf[d][s2] = *(const bf16x8*)(Vb + (size_t)(32 * d) * SEQ + key0 + 16 * s2);
            {
                const int keyn = (kt + 4 < ntile ? kt + 4 : 0) * 32;
#pragma unroll
                for (int s4 = 0; s4 < 4; ++s4) Kn[s4] = *(const bf16x8*)(Kb + (size_t)keyn * NMIXP + s4 * 16);
            }
#pragma unroll
            for (int rt = 0; rt < 2; ++rt) {
                const int ql = rt * 8 + (c >> 2), q = q0 + ql;
                f32x16 X;
#pragma unroll
                for (int e = 0; e < 16; ++e) X[e] = 0.f;
#pragma unroll
                for (int s4 = 0; s4 < 4; ++s4) X = __builtin_amdgcn_mfma_f32_32x32x16_bf16(Kf[s4], *(LAS const bf16x8*)(Qb + rt * 8 * PU_QROW + s4 * 32), X, 0, 0, 0);
                const unsigned word = MB[ql * 64 + kt];
                const unsigned bits = ((word >> (8 * h)) & 0xFFu) | (((word >> (16 + 8 * h)) & 0xFFu) << 8);
                const bool nearT = (q0 + rt * 8) - (key0 + 31) < 113;
#pragma unroll
                for (int s2 = 0; s2 < 2; ++s2) {
                    float P[8];
                    if (nearT) {
#pragma unroll
                        for (int e8 = 0; e8 < 8; ++e8) {
                            const int e = 8 * s2 + e8;
                            const int key = key0 + e8 + 16 * s2 + 8 * h;
                            int dist = q - key; dist = dist < 0 ? 0 : (dist > 127 ? 127 : dist);
                            const float bias = RB[BT[dist] * 8 + hd] * L2E;
                            const float lg = fminf(X[e] + bias, 86.f);
                            P[e8] = __int_as_float(__float_as_int(__builtin_amdgcn_exp2f(lg)) & __builtin_amdgcn_sbfe((int)bits, e, 1));
                        }
                    } else {
#pragma unroll
                        for (int e8 = 0; e8 < 8; ++e8) {
                            const int e = 8 * s2 + e8;
                            const float lg = fminf(X[e] + b31, 86.f);
                            P[e8] = __int_as_float(__float_as_int(__builtin_amdgcn_exp2f(lg)) & __builtin_amdgcn_sbfe((int)bits, e, 1));
                        }
                    }
#pragma unroll
                    for (int e8 = 0; e8 < 8; ++e8) lsum[rt] += P[e8];
                    const u32x4 pk = (u32x4){cvt_pk_bf16(P[0], P[1]), cvt_pk_bf16(P[2], P[3]), cvt_pk_bf16(P[4], P[5]), cvt_pk_bf16(P[6], P[7])};
                    bf16x8 Pf; __builtin_memcpy(&Pf, &pk, 16);
                    O[rt][0] = __builtin_amdgcn_mfma_f32_32x32x16_bf16(Vf[0][s2], Pf, O[rt][0], 0, 0, 0);
                    O[rt][1] = __builtin_amdgcn_mfma_f32_32x32x16_bf16(Vf[1][s2], Pf, O[rt][1], 0, 0, 0);
                }
                __builtin_amdgcn_sched_barrier(0);
            }
        }
        LAS float* CB = (LAS float*)F.lds + (g * 3 + (kq > 0 ? kq - 1 : 0)) * (66 * 64);
        __syncthreads();
        if (kq > 0) {
#pragma unroll
            for (int rt = 0; rt < 2; ++rt) {
#pragma unroll
                for (int d = 0; d < 2; ++d)
#pragma unroll
                    for (int e = 0; e < 16; ++e) CB[((rt * 2 + d) * 16 + e) * 64 + lane] = O[rt][d][e];
                CB[(64 + rt) * 64 + lane] = lsum[rt];
            }
        }
        __syncthreads();
        if (kq == 0) {
#pragma unroll 1
            for (int p = 0; p < 3; ++p) {
                LAS const float* CP = (LAS const float*)F.lds + (g * 3 + p) * (66 * 64);
#pragma unroll
                for (int rt = 0; rt < 2; ++rt) {
#pragma unroll
                    for (int d = 0; d < 2; ++d)
#pragma unroll
                        for (int e = 0; e < 16; ++e) O[rt][d][e] += CP[((rt * 2 + d) * 16 + e) * 64 + lane];
                    lsum[rt] += CP[(64 + rt) * 64 + lane];
                }
            }
#pragma unroll
            for (int rt = 0; rt < 2; ++rt) {
                float l = lsum[rt]; l += __shfl_xor(l, 32);
                const float inv = 1.f / l;
                bf16_t* orow = F.OATT + (tok0 + q0 + rt * 8 + (c >> 2)) * 512 + hd * 64;
#pragma unroll
                for (int a4 = 0; a4 < 4; ++a4) {
                    const f32x4 v0 = (f32x4){O[rt][0][4 * a4], O[rt][0][4 * a4 + 1], O[rt][0][4 * a4 + 2], O[rt][0][4 * a4 + 3]} * inv;
                    const f32x4 v1 = (f32x4){O[rt][1][4 * a4], O[rt][1][4 * a4 + 1], O[rt][1][4 * a4 + 2], O[rt][1][4 * a4 + 3]} * inv;
                    *(u32x2*)(orow + 8 * a4 + 4 * h) = pk4(v0);
                    *(u32x2*)(orow + 32 + 8 * a4 + 4 * h) = pk4(v1);
                }
            }
        }
    }
}

__device__ __forceinline__ void p3_sample_score_unit(const Frame& F, float* SS, int b, int ch) {
    const int lane = F.lane, r = lane & 31, h = lane >> 5;
    bf16x8 A[4];
    { const int q = r >> 2, hh = r & 3;
#pragma unroll
      for (int s4 = 0; s4 < 4; ++s4) A[s4] = *(const bf16x8*)(F.PROJ + (size_t)(NTP + b * TS + q) * NMIXP + C_QI + hh * 64 + s4 * 16 + h * 8); }
    float wv[4][4];
#pragma unroll
    for (int g = 0; g < 4; ++g) { const f32x4 w4 = *(const f32x4*)(F.WI + (size_t)(NTP + b * TS + 2 * g + h) * 4);
#pragma unroll
        for (int hh = 0; hh < 4; ++hh) wv[g][hh] = w4[hh] * IDX_SCALE; }
    f32x4 kn[8];
    { const int key0 = ch * 1024 + F.wave * 32; const int page = F.page_table[b * NPAGES + (key0 >> 7)];
      const float* kr = F.cache_ki + ((size_t)page * PAGE + (key0 & 127) + r) * 64 + h * 8;
#pragma unroll
      for (int s4 = 0; s4 < 4; ++s4) { kn[2 * s4] = *(const f32x4*)(kr + s4 * 16); kn[2 * s4 + 1] = *(const f32x4*)(kr + s4 * 16 + 4); } }
#pragma unroll 1
    for (int tl = F.wave; tl < 32; tl += 8) {
        const int key0 = ch * 1024 + tl * 32;
        f32x4 kc[8];
#pragma unroll
        for (int i = 0; i < 8; ++i) kc[i] = kn[i];
        if (tl + 8 < 32) {
            const int keyn = key0 + 256; const int page = F.page_table[b * NPAGES + (keyn >> 7)];
            const float* kr = F.cache_ki + ((size_t)page * PAGE + (keyn & 127) + r) * 64 + h * 8;
#pragma unroll
            for (int s4 = 0; s4 < 4; ++s4) { kn[2 * s4] = *(const f32x4*)(kr + s4 * 16); kn[2 * s4 + 1] = *(const f32x4*)(kr + s4 * 16 + 4); }
        }
        f32x16 c;
#pragma unroll
        for (int e = 0; e < 16; ++e) c[e] = 0.f;
#pragma unroll
        for (int s4 = 0; s4 < 4; ++s4) {
            const f32x4 lo = kc[2 * s4], hi = kc[2 * s4 + 1];
            const u32x4 pk = (u32x4){cvt_pk_bf16(lo[0], lo[1]), cvt_pk_bf16(lo[2], lo[3]), cvt_pk_bf16(hi[0], hi[1]), cvt_pk_bf16(hi[2], hi[3])};
            bf16x8 Bf; __builtin_memcpy(&Bf, &pk, 16);
            c = __builtin_amdgcn_mfma_f32_32x32x16_bf16(A[s4], Bf, c, 0, 0, 0);
        }
#pragma unroll
        for (int g = 0; g < 4; ++g) {
            float sc = 0.f;
#pragma unroll
            for (int hh = 0; hh < 4; ++hh) sc += fmaxf(c[4 * g + hh], 0.f) * wv[g][hh];
            SS[(size_t)(b * TS + 2 * g + h) * PAST + key0 + r] = sc;
        }
    }
}
__device__ __forceinline__ void p3_index(const Frame& F) {
    constexpr int NSU = NB_S * 8;
    const int nunits = NSU + NB_P * (SEQ / 16);
    float* SS = (float*)(F.ws + WS_SS);
    const bf16_t* VT = (const bf16_t*)(F.ws + WS_VT);
    __syncthreads();
    if (F.tid < 256) ((LAS float*)(F.lds + PU_RB))[F.tid] = F.rel_bias[F.tid];
    if (F.tid < 128) ((LAS int*)(F.lds + PU_BT))[F.tid] = t5_bucket(F.tid);
    __syncthreads();
    for (int it = F.bid; it < nunits; it += F.G) {
        if (it < NSU) { p3_sample_score_unit(F, SS, it >> 3, it & 7); continue; }
        const int i = it - NSU; const int b = i & 7, sl = (i >> 3) & 31, rnd = i >> 8;
        const int qt = rnd == 0 ? 127 - sl : (rnd == 1 ? 64 + sl : (rnd == 2 ? 63 - sl : sl));
        p3_prompt_fused_unit(F, VT, b, qt);
    }
}

constexpr int SQ_CNT = 0;
constexpr int SQ_SEL = 1024;
constexpr int SQ_Q = 2048;
constexpr int SQ_PHYS = 3072;
constexpr int SQ_P = 4096;
constexpr int SQ_RB = 16384;
constexpr int SQ_BT = 17408;
__device__ __forceinline__ int wg_sum8(const Frame& F, LAS unsigned* slot, int v) {
    if (F.lane == 0) slot[F.wave] = (unsigned)v;
    __syncthreads();
    int t = 0;
#pragma unroll
    for (int w = 0; w < 8; ++w) t += (int)slot[w];
    return t;
}
__device__ __forceinline__ void p4_sample_query_unit(const Frame& F, const float* SS, int b, int t) {
    const int lane = F.lane, w = F.wave;
    LAS unsigned* CNT = (LAS unsigned*)(F.lds + SQ_CNT);
    LAS int* SELL = (LAS int*)(F.lds + SQ_SEL);
    LAS unsigned* QL = (LAS unsigned*)(F.lds + SQ_Q);
    LAS float* PL = (LAS float*)(F.lds + SQ_P) + w * 256;
    LAS float* RB = (LAS float*)(F.lds + SQ_RB);
    LAS int* BT = (LAS int*)(F.lds + SQ_BT);
    const int tok = NTP + b * TS + t;
    __syncthreads();
    if (F.tid < 256) QL[F.tid] = ((const unsigned*)(F.PROJ + (size_t)tok * NMIXP + C_Q))[F.tid];
    unsigned u[17];
    { const float* srow = SS + (size_t)(b * TS + t) * PAST + w * 1024;
#pragma unroll
      for (int i = 0; i < 16; ++i) u[i] = f2ord(srow[64 * i + lane]); }
    u[16] = 0u;
    if (w == 7) {
        const int kj = lane < TS ? lane : 0;
        const bf16_t* kn = F.PROJ + (size_t)(NTP + b * TS + kj) * NMIXP + C_KI;
        const bf16_t* qn = F.PROJ + (size_t)tok * NMIXP + C_QI;
        u32x4 kv[8];
#pragma unroll
        for (int c = 0; c < 8; ++c) kv[c] = *(const u32x4*)(kn + c * 8);
        int vz; asm volatile("v_mov_b32 %0, 0" : "=v"(vz));
        const f32x4 w4 = *(const f32x4*)(F.WI + (size_t)tok * 4 + vz);
        float sc = 0.f;
#pragma unroll
        for (int hh = 0; hh < 4; ++hh) {
            u32x4 qv[8];
#pragma unroll
            for (int c = 0; c < 8; ++c) qv[c] = *(const u32x4*)(qn + hh * 64 + c * 8 + vz);
            float d = 0.f;
#pragma unroll
            for (int c = 0; c < 8; ++c)
#pragma unroll
                for (int e = 0; e < 4; ++e) d += bflo(qv[c][e]) * bflo(kv[c][e]) + bfhi(qv[c][e]) * bfhi(kv[c][e]);
            sc += fmaxf(d, 0.f) * (w4[hh] * IDX_SCALE);
        }
        u[16] = (lane < TS && lane <= t) ? f2ord(sc) : 0u;
    }
    unsigned T = 0;
#pragma unroll 1
    for (int bit = 31; bit >= 0; --bit) {
        const unsigned cand = T | (1u << bit);
        int c = 0;
#pragma unroll
        for (int i = 0; i < 17; ++i) cnt_ge(c, u[i], cand);
        c = wg_sum8(F, CNT + (bit & 1) * 24, wave_sum_i_dpp(c));
        if (c >= NSEL) T = cand;
        if (c == NSEL) break;
    }
    int cg = 0, ce = 0;
#pragma unroll
    for (int i = 0; i < 17; ++i) { cnt_gt(cg, u[i], T); cnt_eq(ce, u[i], T); }
    const int cgw = wave_sum_i_dpp(cg);
    const int ngt = wg_sum8(F, CNT + 8, cgw);
    const int neq = wg_sum8(F, CNT + 16, wave_sum_i_dpp(ce));
    const int need = NSEL - ngt;
    int Jx = 0x3FFFFFFF;
    if (need < neq) {
        int Jb = 0;
#pragma unroll 1
        for (int bit = 13; bit >= 0; --bit) {
            const int cand = Jb | (1 << bit);
            const int L = cand - lane - 1024 * w;
            int c = 0;
#pragma unroll
            for (int i = 0; i < 17; ++i) cnt_eq_pos(c, u[i], T, L - 64 * i);
            c = wg_sum8(F, CNT + (bit & 1) * 24, wave_sum_i_dpp(c));
            if (c < need) Jb = cand;
        }
        Jx = Jb + 1;
    }
    {
        const int L = Jx - lane - 1024 * w;
        int ct = 0;
#pragma unroll
        for (int i = 0; i < 17; ++i) cnt_eq_pos(ct, u[i], T, L - 64 * i);
        const int ctw = wave_sum_i_dpp(ct);
        __syncthreads();
        if (lane == 0) { CNT[w] = (unsigned)cgw; CNT[8 + w] = (unsigned)ctw; }
        __syncthreads();
        int bg = 0, bt = ngt;
#pragma unroll
        for (int ww = 0; ww < 8; ++ww) { if (ww < w) { bg += (int)CNT[ww]; bt += (int)CNT[8 + ww]; } }
        int ig = cg, it2 = ct;
#pragma unroll
        for (int o = 1; o < 64; o <<= 1) { const int a = __shfl_up(ig, o), b2 = __shfl_up(it2, o); if (lane >= o) { ig += a; it2 += b2; } }
        int pg = bg + ig - cg, pt = bt + it2 - ct;
        int ev = 1024 * w + lane, Lr = L;
#pragma unroll
        for (int i = 0; i < 17; ++i) {
            if (u[i] > T) { SELL[pg] = ev; ++pg; }
            else if (u[i] == T && Lr > 0) { SELL[pt] = ev; ++pt; }
            asm volatile("v_add_u32 %0, 64, %0\n\tv_add_u32 %1, -64, %1" : "+v"(ev), "+v"(Lr));
        }
    }
    __syncthreads();
    LAS int* PHYS = (LAS int*)(F.lds + SQ_PHYS);
    if (F.tid < 256) { const int sraw = SELL[F.tid]; PHYS[F.tid] = (sraw < PAST) ? F.page_table[b * NPAGES + (sraw >> 7)] * PAGE + (sraw & 127) : -1 - (sraw - PAST); }
    __syncthreads();
    {
        const int hd = w, g = w >> 2, qpos = PAST + t;
        float lg[4];
#pragma unroll 2
        for (int i = 0; i < 4; ++i) {
            const int sraw = SELL[lane + 64 * i], ph = PHYS[lane + 64 * i];
            const float* kr = (ph >= 0) ? F.cache_k + (size_t)ph * 128 + g * 64 : F.out + O_KS + (size_t)(b * TS + (-1 - ph)) * 128 + g * 64;
            float a0 = 0.f, a1 = 0.f;
#pragma unroll
            for (int c = 0; c < 16; ++c) {
                const f32x4 kv = *(const f32x4*)(kr + c * 4);
                const unsigned q0 = QL[hd * 32 + c * 2], q1 = QL[hd * 32 + c * 2 + 1];
                a0 += bflo(q0) * kv[0] + bfhi(q0) * kv[1]; a1 += bflo(q1) * kv[2] + bfhi(q1) * kv[3];
            }
            const int dist = qpos - sraw; const int bk = dist < 128 ? BT[dist] : 31;
            lg[i] = (a0 + a1) * ATTN_SCALE + RB[bk * 8 + hd];
        }
        float m = fmaxf(fmaxf(lg[0], lg[1]), fmaxf(lg[2], lg[3])); m = wave_max(m);
        float sm = 0.f;
#pragma unroll
        for (int i = 0; i < 4; ++i) { lg[i] = __expf(lg[i] - m); sm += lg[i]; }
        const float inv = 1.f / wave_sum_dpp(sm);
#pragma unroll
        for (int i = 0; i < 4; ++i) PL[lane + 64 * i] = lg[i] * inv;
        const int dq = lane & 15, ks = lane >> 4;
        f32x4 o4 = {0.f, 0.f, 0.f, 0.f};
#pragma unroll 1
        for (int j0 = 0; j0 < 256; j0 += 64) {
            f32x4 vv[16]; float pp[16];
#pragma unroll
            for (int jj = 0; jj < 16; ++jj) {
                const int j = j0 + jj * 4 + ks;
                const int ph = PHYS[j]; pp[jj] = PL[j];
                const float* vr = (ph >= 0) ? F.cache_v + (size_t)ph * 128 + g * 64 : F.out + O_VS + (size_t)(b * TS + (-1 - ph)) * 128 + g * 64;
                vv[jj] = *(const f32x4*)(vr + 4 * dq);
            }
#pragma unroll
            for (int jj = 0; jj < 16; ++jj) o4 += vv[jj] * pp[jj];
        }
#pragma unroll
        for (int e = 0; e < 4; ++e) { o4[e] += __shfl_xor(o4[e], 16); o4[e] += __shfl_xor(o4[e], 32); }
        if (ks == 0) *(u32x2*)(F.OATT + (size_t)tok * 512 + hd * 64 + 4 * dq) = pk4(o4);
    }
}
__device__ __forceinline__ void p4_attention(const Frame& F) {
    const float* SS = (const float*)(F.ws + WS_SS);
    __syncthreads();
    if (F.tid < 256) ((LAS float*)(F.lds + SQ_RB))[F.tid] = F.rel_bias[F.tid];
    if (F.tid < 128) ((LAS int*)(F.lds + SQ_BT))[F.tid] = t5_bucket(F.tid);
    __syncthreads();
    for (int it = F.bid; it < NTS; it += F.G) p4_sample_query_unit(F, SS, it >> 3, it & 7);
    {
        const int c0 = F.lane * 8;
        float cw0[8], cw1[8], cw2[8], cbv[8];
#pragma unroll
        for (int e = 0; e < 8; ++e) { cw0[e] = F.conv_w[c0 + e]; cw1[e] = F.conv_w[512 + c0 + e]; cw2[e] = F.conv_w[1024 + c0 + e]; cbv[e] = F.conv_b[c0 + e]; }
        const int stride = F.G * 8;
        u32x4 n_cg[3], n_xi[3], n_bg;
        auto fetch = [&](int m) {
#pragma unroll
            for (int d = 0; d < 3; ++d) { const int mm = (m - d >= 0) ? m - d : 0; n_cg[d] = *(const u32x4*)(F.PROJ + (size_t)mm * NMIXP + C_CG + c0); n_xi[d] = *(const u32x4*)(F.PROJ + (size_t)mm * NMIXP + C_XIN + c0); }
            n_bg = *(const u32x4*)(F.PROJ + (size_t)m * NMIXP + C_BG + c0);
        };
        { const int m = F.bid * 8 + F.wave; fetch(m < NT ? m : 0); }
        for (int m = F.bid * 8 + F.wave; m < NT; m += stride) {
            u32x4 cg[3], xi[3]; const u32x4 bg = n_bg;
#pragma unroll
            for (int d = 0; d < 3; ++d) { cg[d] = n_cg[d]; xi[d] = n_xi[d]; }
            fetch(m + stride < NT ? m + stride : m);
            int t, T_, bsm; if (m < NTP) { t = m & 2047; T_ = SEQ; bsm = m >> 11; } else { t = (m - NTP) & 7; T_ = TS; bsm = (m - NTP) >> 3; }
            float u[3][8];
#pragma unroll
            for (int d = 0; d < 3; ++d) {
                if (t - d >= 0) {
#pragma unroll
                    for (int e = 0; e < 4; ++e) { u[d][2 * e] = bflo(cg[d][e]) * bflo(xi[d][e]); u[d][2 * e + 1] = bfhi(cg[d][e]) * bfhi(xi[d][e]); }
                } else if (m >= NTP) {
                    const float* pv = F.state_conv + ((size_t)bsm * 2 + (2 + t - d)) * 512 + c0;
#pragma unroll
                    for (int e = 0; e < 8; ++e) u[d][e] = pv[e];
                } else {
#pragma unroll
                    for (int e = 0; e < 8; ++e) u[d][e] = 0.f;
                }
            }
            float y[8];
#pragma unroll
            for (int e = 0; e < 8; ++e) {
                const float yy = cbv[e] + cw0[e] * u[2][e] + cw1[e] * u[1][e] + cw2[e] * u[0][e];
                const float bgv = (e & 1) ? bfhi(bg[e >> 1]) : bflo(bg[e >> 1]);
                y[e] = bgv * yy;
            }
            *(u32x4*)(F.OCONV + (size_t)m * 512 + c0) = (u32x4){cvt_pk_bf16(y[0], y[1]), cvt_pk_bf16(y[2], y[3]), cvt_pk_bf16(y[4], y[5]), cvt_pk_bf16(y[6], y[7])};
            if (t >= T_ - 2) {
                float* o = (m < NTP ? F.out + O_CP : F.out + O_CS) + ((size_t)bsm * 2 + (t - (T_ - 2))) * 512 + c0;
                const int rowi = (m < NTP) ? bsm * 2 + (t - (T_ - 2)) : 2 * NB_P + bsm * 2 + (t - (T_ - 2));
                const float* cx = (const float*)(F.ws + WS_CGX) + (size_t)rowi * 1024 + c0;
                const f32x4 ca = *(const f32x4*)cx, cb2 = *(const f32x4*)(cx + 4), xa = *(const f32x4*)(cx + 512), xb = *(const f32x4*)(cx + 516);
                *(f32x4*)o = ca * xa; *(f32x4*)(o + 4) = cb2 * xb;
            }
        }
    }
}

#define P5_EPI(A1, A2) { \
            const f32x4 va = ACC4(A1), vc = ACC4(A2); \
            const u32x2 ga = *(const u32x2*)(F.PROJ + (size_t)m * NMIXP + C_GA + n), gb = *(const u32x2*)(F.PROJ + (size_t)m * NMIXP + C_GB + n); \
            f32x4 o; \
            o[0] = sigmoidf_(bflo(ga[0])) * va[0] + sigmoidf_(bflo(gb[0])) * vc[0]; \
            o[1] = sigmoidf_(bfhi(ga[0])) * va[1] + sigmoidf_(bfhi(gb[0])) * vc[1]; \
            o[2] = sigmoidf_(bflo(ga[1])) * va[2] + sigmoidf_(bflo(gb[1])) * vc[2]; \
            o[3] = sigmoidf_(bfhi(ga[1])) * va[3] + sigmoidf_(bfhi(gb[1])) * vc[3]; \
            *(u32x2*)(F.MERGED + (size_t)m * D + n) = pk4(o); }
struct P5aBody {
    const Frame* Fp;
    __device__ __forceinline__ void operator()(int m, int n, const f32x4 v) const { *(u32x2*)(Fp->MERGED + (size_t)m * D + n) = pk4(v); }
};
struct P5bBody {
    const Frame* Fp;
    __device__ __forceinline__ void operator()(int m, int n, const f32x4 v) const {
        const Frame& F = *Fp;
        const u32x2 ga = *(const u32x2*)(F.PROJ + (size_t)m * NMIXP + C_GA + n), gb = *(const u32x2*)(F.PROJ + (size_t)m * NMIXP + C_GB + n);
        const u32x2 pa = *(const u32x2*)(F.MERGED + (size_t)m * D + n);
        const f32x4 o = (f32x4){sigmoidf_(bflo(ga[0])) * bflo(pa[0]) + sigmoidf_(bflo(gb[0])) * v[0], sigmoidf_(bfhi(ga[0])) * bfhi(pa[0]) + sigmoidf_(bfhi(gb[0])) * v[1],
                                sigmoidf_(bflo(ga[1])) * bflo(pa[1]) + sigmoidf_(bflo(gb[1])) * v[2], sigmoidf_(bfhi(ga[1])) * bfhi(pa[1]) + sigmoidf_(bfhi(gb[1])) * v[3]};
        *(u32x2*)(F.MERGED + (size_t)m * D + n) = pk4(o);
    }
};
__device__ __forceinline__ void p5_gemm_merge(const Frame& F) {
    {
        pg8::StaticOrder S; S.init(NTP, D, F.G, F.bid);
        { pg8::Gemm g{F.OATT, F.WOA, NTP, D, 512}; pg8::EpiRC<P5aBody> E{P5aBody{&F}}; pg8::gemm_phase<pg8::EpiRC<P5aBody>, pg8::StaticOrder, true, true>(F.lds, g, S, E); }
        asm volatile("s_waitcnt vmcnt(0)" ::: "memory"); __syncthreads();
        { pg8::Gemm g{F.OCONV, F.WOC, NTP, D, 512}; pg8::EpiRC<P5bBody> E{P5bBody{&F}}; pg8::gemm_phase<pg8::EpiRC<P5bBody>, pg8::StaticOrder, true, true>(F.lds, g, S, E); }
    }
    for (int sl = F.bid; sl < NTS / 8 * (D / BN); sl += F.G) {
        const int m0 = NTP + (sl >> 3) * 8, n0 = (sl & 7) * BN;
        f32x16 s1[1][1], s2[1][1];
        gemm_slice8(F, s1, F.OATT, 512, F.WOA, 512, 512, m0, n0);
        gemm_slice8(F, s2, F.OCONV, 512, F.WOC, 512, 512, m0, n0);
        SLICE_EPI_LOOP(P5_EPI(s1, s2))
    }
}
#define P6_EPI(A1) { \
            const f32x4 v = ACC4(A1); \
            const f32x4 xv = *(const f32x4*)(x_row(F, m) + n); \
            const f32x4 g1 = *(const f32x4*)(F.MOD + (size_t)mod_row(m) * 6144 + 2048 + n); \
            *(f32x4*)(F.T1 + (size_t)m * D + n) = xv * DN_ALPHA + g1 * v; }
struct P6Body {
    const Frame* Fp;
    __device__ __forceinline__ void operator()(int m, int n, const f32x4 v) const {
        const Frame& F = *Fp;
        const f32x4 xv = *(const f32x4*)(F.x_p + (size_t)m * D + n);
        const f32x4 g1 = *(const f32x4*)(F.MOD + (size_t)(m >> 11) * 6144 + 2048 + n);
        *(f32x4*)(F.T1 + (size_t)m * D + n) = xv * DN_ALPHA + g1 * v;
    }
};
__device__ __forceinline__ void p6_gemm_out(const Frame& F) {
    {
        pg8::Gemm g{F.MERGED, F.WOUT, NTP, D, D}; pg8::StaticOrder S; S.init(NTP, D, F.G, F.bid);
        pg8::EpiRC<P6Body> E{P6Body{&F}}; pg8::gemm_phase<pg8::EpiRC<P6Body>, pg8::StaticOrder, true, true>(F.lds, g, S, E);
    }
    for (int sl = F.bid; sl < NTS / 8 * (D / BN); sl += F.G) {
        const int m0 = NTP + (sl >> 3) * 8, n0 = (sl & 7) * BN;
        f32x16 s1[1][1];
        gemm_slice8(F, s1, F.MERGED, D, F.WOUT, D, D, m0, n0);
        SLICE_EPI_LOOP(P6_EPI(s1))
    }
}
__device__ __forceinline__ void p7_ln1(const Frame& F) {
    f32x4 lg[4], lb[4];
#pragma unroll
    for (int i = 0; i < 4; ++i) { const int e = (i >> 1) * 512 + F.lane * 8 + (i & 1) * 4; lg[i] = *(const f32x4*)(F.ln1_g + e); lb[i] = *(const f32x4*)(F.ln1_b + e); }
    const int stride = F.G * 8;
    f32x4 vn[4], scn[4], shn[4];
    {
        const int m = F.bid * 8 + F.wave; const float* mr = F.MOD + (size_t)mod_row(m < NT ? m : 0) * 6144;
#pragma unroll
        for (int i = 0; i < 4; ++i) { const int e = (i >> 1) * 512 + F.lane * 8 + (i & 1) * 4; vn[i] = *(const f32x4*)(F.T1 + (size_t)(m < NT ? m : 0) * D + e); scn[i] = *(const f32x4*)(mr + 4096 + e); shn[i] = *(const f32x4*)(mr + 3072 + e); }
    }
    for (int m = F.bid * 8 + F.wave; m < NT; m += stride) {
        float* tr = F.T1 + (size_t)m * D;
        f32x4 v[4], sc2[4], sh2[4]; float s = 0.f;
#pragma unroll
        for (int i = 0; i < 4; ++i) { v[i] = vn[i]; sc2[i] = scn[i]; sh2[i] = shn[i]; s += v[i][0] + v[i][1] + v[i][2] + v[i][3]; }
        {
            const int mn = (m + stride < NT) ? m + stride : m; const float* mrn = F.MOD + (size_t)mod_row(mn) * 6144;
#pragma unroll
            for (int i = 0; i < 4; ++i) { const int e = (i >> 1) * 512 + F.lane * 8 + (i & 1) * 4; vn[i] = *(const f32x4*)(F.T1 + (size_t)mn * D + e); scn[i] = *(const f32x4*)(mrn + 4096 + e); shn[i] = *(const f32x4*)(mrn + 3072 + e); }
        }
        const float mean = wave_sum(s) * (1.f / D);
        float q = 0.f;
#pragma unroll
        for (int i = 0; i < 4; ++i) { v[i] = v[i] - mean; q += v[i][0] * v[i][0] + v[i][1] * v[i][1] + v[i][2] * v[i][2] + v[i][3] * v[i][3]; }
        const float rstd = rsqrtf(wave_sum(q) * (1.f / D) + LN_EPS);
        f32x4 hv[2][2];
#pragma unroll
        for (int hlf = 0; hlf < 2; ++hlf) {
            const int e = hlf * 512 + F.lane * 8;
            f32x4 a = v[2 * hlf] * rstd * lg[2 * hlf] + lb[2 * hlf];
            f32x4 b = v[2 * hlf + 1] * rstd * lg[2 * hlf + 1] + lb[2 * hlf + 1];
            *(f32x4*)(tr + e) = a; *(f32x4*)(tr + e + 4) = b;
            const f32x4 ha = a * (sc2[2 * hlf] + 1.f) + sh2[2 * hlf];
            const f32x4 hb = b * (sc2[2 * hlf + 1] + 1.f) + sh2[2 * hlf + 1];
            *(u32x4*)(F.H2 + (size_t)m * D + e) = (u32x4){cvt_pk_bf16(ha[0], ha[1]), cvt_pk_bf16(ha[2], ha[3]), cvt_pk_bf16(hb[0], hb[1]), cvt_pk_bf16(hb[2], hb[3])};
            hv[hlf][0] = ha; hv[hlf][1] = hb;
        }
        float am = 0.f;
#pragma unroll
        for (int i = 0; i < 2; ++i)
#pragma unroll
            for (int j = 0; j < 2; ++j)
#pragma unroll
                for (int e = 0; e < 4; ++e) am = fmaxf(am, fabsf(hv[i][j][e]));
        am = wave_max(am);
        const float sc = am > 0.f ? 224.f / am : 1.f;
#pragma unroll
        for (int hlf = 0; hlf < 2; ++hlf) {
            int w0 = 0, w1 = 0;
            w0 = __builtin_amdgcn_cvt_pk_fp8_f32(hv[hlf][0][0] * sc, hv[hlf][0][1] * sc, w0, false); w0 = __builtin_amdgcn_cvt_pk_fp8_f32(hv[hlf][0][2] * sc, hv[hlf][0][3] * sc, w0, true);
            w1 = __builtin_amdgcn_cvt_pk_fp8_f32(hv[hlf][1][0] * sc, hv[hlf][1][1] * sc, w1, false); w1 = __builtin_amdgcn_cvt_pk_fp8_f32(hv[hlf][1][2] * sc, hv[hlf][1][3] * sc, w1, true);
            *(u32x2*)(F.ws + WS_H8 + (size_t)m * D + hlf * 512 + F.lane * 8) = (u32x2){(unsigned)w0, (unsigned)w1};
        }
        if (F.lane == 0) ((float*)(F.ws + WS_SH))[m] = am > 0.f ? am * (1.f / 224.f) : 1.f;
    }
}
struct P8Body {
    const Frame* Fp;
    __device__ __forceinline__ void operator()(int m, int n, const f32x4 v) const { *(u32x2*)(Fp->QP + (size_t)m * D + n) = pk4(v); }
};
__device__ __forceinline__ void p8_gemm_q(const Frame& F) {
    {
        pg8::Gemm g{F.H2, F.WQ, NTP, D, D}; pg8::StaticOrder S; S.init(NTP, D, F.G, F.bid);
        pg8::EpiRC<P8Body> E{P8Body{&F}}; pg8::gemm_phase<pg8::EpiRC<P8Body>, pg8::StaticOrder, true, true>(F.lds, g, S, E);
    }
    for (int sl = F.bid; sl < NTS / 8 * (D / BN); sl += F.G) {
        const int m0 = NTP + (sl >> 3) * 8, n0 = (sl & 7) * BN;
        f32x16 s1[1][1];
        gemm_slice8(F, s1, F.H2, D, F.WQ, D, D, m0, n0);
        SLICE_EPI_LOOP({ *(u32x2*)(F.QP + (size_t)m * D + n) = pk4(ACC4(s1)); })
    }
}
__device__ __forceinline__ void p9_row_top16(LAS float* row, LAS float* TV, LAS unsigned char* TI, int slot) {
    float gm[16];
#pragma unroll
    for (int gidx = 0; gidx < 16; ++gidx) {
        float m = row[gidx * 8];
#pragma unroll
        for (int k = 1; k < 8; ++k) m = fmaxf(m, row[gidx * 8 + k]);
        gm[gidx] = m;
    }
#pragma unroll 1
    for (int p = 0; p < 16; ++p) {
        float best = gm[0]; int bg = 0;
#pragma unroll
        for (int gidx = 1; gidx < 16; ++gidx) { const bool gt = gm[gidx] > best; best = gt ? gm[gidx] : best; bg = gt ? gidx : bg; }
        float v[8];
#pragma unroll
        for (int k = 0; k < 8; ++k) v[k] = row[bg * 8 + k];
        int bk = 7;
#pragma unroll
        for (int k = 6; k >= 0; --k) bk = (v[k] == best) ? k : bk;
        float nm = -INFINITY;
#pragma unroll
        for (int k = 0; k < 8; ++k) nm = fmaxf(nm, (k == bk) ? -INFINITY : v[k]);
        row[bg * 8 + bk] = -INFINITY;
#pragma unroll
        for (int gidx = 0; gidx < 16; ++gidx) gm[gidx] = (gidx == bg) ? nm : gm[gidx];
        TV[slot * 17 + p] = best; TI[slot * 17 + p] = (unsigned char)(bg * 8 + bk);
    }
}
__device__ __forceinline__ void p9_pair_top16(const Frame& F, LAS const float* TV, LAS const unsigned char* TI, int r1, int r2, int tok, int head) {
    float c[16];
    { const float v20 = TV[r2];
#pragma unroll
      for (int i = 0; i < 16; ++i) c[i] = TV[r1 + i] + v20; }
    unsigned long long ptrs = 0ull;
    float sv[16]; int se[16];
#pragma unroll
    for (int p = 0; p < 16; ++p) {
        float best = c[0]; int bi = 0;
#pragma unroll
        for (int i = 1; i < 16; ++i) { const bool gt = c[i] > best; best = gt ? c[i] : best; bi = gt ? i : bi; }
        const int bj = (int)((ptrs >> (4 * bi)) & 15ull);
        sv[p] = best; se[p] = (int)TI[r1 + bi] * 128 + (int)TI[r2 + bj];
        const float nv = (bj < 15) ? TV[r1 + bi] + TV[r2 + bj + 1] : -INFINITY;
        ptrs += (bj < 15) ? (1ull << (4 * bi)) : 0ull;
#pragma unroll
        for (int i = 0; i < 16; ++i) c[i] = (i == bi) ? nv : c[i];
    }
    const float mx0 = sv[0]; float den = 0.f;
#pragma unroll
    for (int p = 0; p < 16; ++p) { sv[p] = __expf(sv[p] - mx0); den += sv[p]; }
    const float dinv = 1.f / den;
    int* eo = F.EIDX + (size_t)tok * NEXP_SEL + head * 16; float* go = F.GW + (size_t)tok * NEXP_SEL + head * 16;
#pragma unroll
    for (int p = 0; p < 16; ++p) { eo[p] = se[p]; go[p] = sv[p] * dinv; }
}
constexpr int PR_ROW = 129, PR_ROWS = 256 + 4;
__device__ __forceinline__ void p9_route(const Frame& F) {
    LAS float* SC = (LAS float*)F.lds;
    LAS float* TV = (LAS float*)(F.lds + PR_ROWS * PR_ROW * 4);
    LAS unsigned char* TI = (LAS unsigned char*)(F.lds + PR_ROWS * PR_ROW * 4 + PR_ROWS * 17 * 4);
    const int lane = F.lane, r = lane & 31, h = lane >> 5;
    const int nunits = (NTP / 32) * 2;
    bf16x8 AkR[4][4];
    {
        const bf16_t* KK = (F.wave & 1) ? F.K2 : F.K1;
#pragma unroll
        for (int kt = 0; kt < 4; ++kt)
#pragma unroll
            for (int s = 0; s < 4; ++s) AkR[kt][s] = *(const bf16x8*)(KK + (size_t)(kt * 32 + r) * 64 + s * 16 + h * 8);
    }
    int k = 0;
    for (int it = F.bid; it < nunits; it += F.G, ++k) {
        const int tok0 = (it >> 1) * 32, hg = it & 1;
        const int ts = NTP + F.bid + F.G * (k >> 2), kh = k & 3;
        const bool has_s = ts < NT;
        __syncthreads();
        {
            const int head = hg * 4 + (F.wave >> 1), half = F.wave & 1;
            bf16x8 Bq[4], Bs[4];
#pragma unroll
            for (int s = 0; s < 4; ++s) Bq[s] = *(const bf16x8*)(F.QP + (size_t)(tok0 + r) * D + head * 128 + half * 64 + s * 16 + h * 8);
            const bool swave = has_s && F.wave < 4;
            if (swave) {
#pragma unroll
                for (int s = 0; s < 4; ++s) Bs[s] = *(const bf16x8*)(F.QP + (size_t)ts * D + (2 * kh + (F.wave >> 1)) * 128 + half * 64 + s * 16 + h * 8);
            }
#pragma unroll
            for (int kt = 0; kt < 4; ++kt) {
                f32x16 c, cs;
#pragma unroll
                for (int e = 0; e < 16; ++e) { c[e] = 0.f; cs[e] = 0.f; }
#pragma unroll
                for (int s = 0; s < 4; ++s) {
                    c = __builtin_amdgcn_mfma_f32_32x32x16_bf16(AkR[kt][s], Bq[s], c, 0, 0, 0);
                    if (swave) cs = __builtin_amdgcn_mfma_f32_32x32x16_bf16(AkR[kt][s], Bs[s], cs, 0, 0, 0);
                }
#pragma unroll
                for (int e = 0; e < 16; ++e) { const int key = kt * 32 + (e & 3) + 8 * (e >> 2) + 4 * h; SC[(F.wave * 32 + r) * PR_ROW + key] = c[e]; }
                if (swave && r == 0) {
#pragma unroll
                    for (int e = 0; e < 16; ++e) { const int key = kt * 32 + (e & 3) + 8 * (e >> 2) + 4 * h; SC[(256 + F.wave) * PR_ROW + key] = cs[e]; }
                }
            }
        }
        __syncthreads();
        if (F.tid < 256 || (has_s && F.tid < 260)) p9_row_top16(SC + F.tid * PR_ROW, TV, TI, F.tid);
        if (F.wave >= 5) { const int j = F.bid + F.G * (k * 8 + (F.wave - 5)); if (j < CVT_CHUNKS) peer_cvt_rows4(F, j < CVT_CHUNKS / 2, (j & (CVT_CHUNKS / 2 - 1)) * 4); }
        __syncthreads();
        if (F.wave >= 3) { const int j = F.bid + F.G * (k * 8 + 3 + (F.wave - 3)); if (j < CVT_CHUNKS) peer_cvt_rows4(F, j < CVT_CHUNKS / 2, (j & (CVT_CHUNKS / 2 - 1)) * 4); }
        if (F.tid < 128) {
            const int tk = F.tid >> 2, hs = F.tid & 3;
            const int r1 = (hs * 64 + tk) * 17;
            p9_pair_top16(F, TV, TI, r1, r1 + 32 * 17, tok0 + tk, hg * 4 + hs);
        } else if (has_s && F.tid < 130) {
            const int hs = F.tid - 128;
            const int r1 = (256 + hs * 2) * 17;
            p9_pair_top16(F, TV, TI, r1, r1 + 17, ts, 2 * kh + hs);
        }
    }
    for (int i = k * 8 + F.wave; F.bid + F.G * i < CVT_CHUNKS; i += 8) { const int j = F.bid + F.G * i; peer_cvt_rows4(F, j < CVT_CHUNKS / 2, (j & (CVT_CHUNKS / 2 - 1)) * 4); }
}

constexpr int TPW = 65, PAIRS_MAX = 9 * 128, PK = 4;
constexpr int P10_HROW = 1024 + 64;
constexpr int P10_H = 0;
constexpr int P10_SH = 32 * P10_HROW;
constexpr int P10_HIST = P10_SH + 128;
constexpr int P10_LIST = P10_HIST + 8 * 128 * 4;
typedef int i32x8 __attribute__((ext_vector_type(8)));
typedef __bf16 bf16x2v __attribute__((ext_vector_type(2)));
typedef short s16x4 __attribute__((ext_vector_type(4)));
__device__ __forceinline__ unsigned bf2u(bf16x2v v) { unsigned r; __builtin_memcpy(&r, &v, 4); return r; }
__device__ __forceinline__ void p10_peer(const Frame& F) {
    const int lane = F.lane, w = F.wave;
    unsigned char* ws = F.ws;
    const unsigned char* PU8 = ws + WS_PU8; const unsigned char* PV8 = ws + WS_PV8;
    const float* SU = (const float*)(ws + WS_SU); const float* SV = (const float*)(ws + WS_SV);
    const unsigned char* H8 = ws + WS_H8; const float* SH = (const float*)(ws + WS_SH);
  for (int blk = F.bid; blk < NT / TPW; blk += F.G) {
    const int tok0 = blk * TPW;
    LAS float* SHl = (LAS float*)(F.lds + P10_SH);
    LAS unsigned* SE = (LAS unsigned*)(F.lds + P10_LIST) + w * 1024; LAS float* SG = (LAS float*)(SE + 512);
    const int ntok = (w == 0) ? 9 : 8;
    const int r16 = lane & 15, q4 = lane >> 4;
#pragma unroll 1
    for (int pass = 0; pass < 3; ++pass) {
        const int kbase = pass * PK, nk = (ntok - kbase < PK) ? (ntok - kbase > 0 ? ntok - kbase : 0) : PK, npairs = nk * 128;
        __syncthreads();
        for (int c = F.tid; c < 32 * 64; c += NTHREADS) {
            const int row = c >> 6, tl = 32 * pass + row;
            if (tl < TPW) *(LAS u32x4*)(F.lds + P10_H + row * P10_HROW + (c & 63) * 16) = *(const u32x4*)(H8 + (size_t)(tok0 + tl) * D + (size_t)(c & 63) * 16);
        }
        if (F.tid < 32 && 32 * pass + F.tid < TPW) SHl[F.tid] = SH[tok0 + 32 * pass + F.tid];
        __syncthreads();
        if (nk <= 0) continue;
#pragma unroll
        for (int i = 0; i < 8; ++i) {
            const int p = lane + 64 * i;
            if (p < npairs) {
                const size_t gi_ = (size_t)(tok0 + w + 8 * (kbase + (p >> 7))) * NEXP_SEL + (p & 127);
                SE[p] = (unsigned)F.EIDX[gi_]; SG[p] = F.GW[gi_];
            }
        }
        asm volatile("s_waitcnt vmcnt(0) lgkmcnt(0)" ::: "memory");
        __builtin_amdgcn_wave_barrier();
        f32x4 acc[4][4];
#pragma unroll
        for (int k = 0; k < 4; ++k)
#pragma unroll
            for (int q = 0; q < 4; ++q) acc[k][q] = (f32x4){0.f, 0.f, 0.f, 0.f};
        const int ngr = npairs >> 4;
        const unsigned char* up = PU8 + q4 * 16;
        const int voff = lane * 8;
        const unsigned am0 = (lane & 3) == 0 ? 0x0000ffffu : ((lane & 3) == 1 ? 0xffff0000u : 0u);
        const unsigned am1 = (lane & 3) == 2 ? 0x0000ffffu : ((lane & 3) == 3 ? 0xffff0000u : 0u);
        u32x4 U[8]; u32x2 V[16]; float suv = 0.f, svv = 0.f;
#pragma unroll
        for (int t = 0; t < 8; ++t) U[t] = (u32x4){0u, 0u, 0u, 0u};
#pragma unroll
        for (int k = 0; k < 16; ++k) V[k] = (u32x2){0u, 0u};
#define P10_LOAD_U(WR) { const int er_ = (WR) & 16383; const unsigned char* ua_ = up + (size_t)er_ * 512; const float* sa_ = SU + er_; const float* sb_ = SV + er_; \
            asm volatile("global_load_dwordx4 %0, %1, off" : "+v"(U[0]) : "v"(ua_)); \
            asm volatile("global_load_dwordx4 %0, %1, off offset:64" : "+v"(U[1]) : "v"(ua_)); \
            asm volatile("global_load_dwordx4 %0, %1, off offset:128" : "+v"(U[2]) : "v"(ua_)); \
            asm volatile("global_load_dwordx4 %0, %1, off offset:192" : "+v"(U[3]) : "v"(ua_)); \
            asm volatile("global_load_dwordx4 %0, %1, off offset:256" : "+v"(U[4]) : "v"(ua_)); \
            asm volatile("global_load_dwordx4 %0, %1, off offset:320" : "+v"(U[5]) : "v"(ua_)); \
            asm volatile("global_load_dwordx4 %0, %1, off offset:384" : "+v"(U[6]) : "v"(ua_)); \
            asm volatile("global_load_dwordx4 %0, %1, off offset:448" : "+v"(U[7]) : "v"(ua_)); \
            asm volatile("global_load_dword %0, %1, off" : "+v"(suv) : "v"(sa_)); \
            asm volatile("global_load_dword %0, %1, off" : "+v"(svv) : "v"(sb_)); }
#define P10_LOAD_V(K, WR) { const unsigned char* ra_ = PV8 + (size_t)(__builtin_amdgcn_readlane((WR), (K)) & 16383) * 512; \
            asm volatile("global_load_dwordx2 %0, %1, %2" : "+v"(V[K]) : "v"(voff), "s"(ra_)); }
        int wr = (int)SE[r16]; float gr = SG[r16];
        P10_LOAD_U(wr)
        P10_LOAD_V(0, wr) P10_LOAD_V(1, wr) P10_LOAD_V(2, wr) P10_LOAD_V(3, wr) P10_LOAD_V(4, wr) P10_LOAD_V(5, wr) P10_LOAD_V(6, wr) P10_LOAD_V(7, wr)
        P10_LOAD_V(8, wr) P10_LOAD_V(9, wr) P10_LOAD_V(10, wr) P10_LOAD_V(11, wr) P10_LOAD_V(12, wr) P10_LOAD_V(13, wr) P10_LOAD_V(14, wr) P10_LOAD_V(15, wr)
#define P10_VQ(Q) { const unsigned b0_ = bf2u(__builtin_amdgcn_cvt_scalef32_pk_bf16_fp4(vv[(Q) >> 1], 1.0f, 2 * ((Q) & 1))); \
                    const unsigned b1_ = bf2u(__builtin_amdgcn_cvt_scalef32_pk_bf16_fp4(vv[(Q) >> 1], 1.0f, 2 * ((Q) & 1) + 1)); \
                    const u32x2 bb_ = {b0_, b1_}; s16x4 Bop_; __builtin_memcpy(&Bop_, &bb_, 8); \
                    acc[slot][Q] = __builtin_amdgcn_mfma_f32_4x4x4bf16_1k(Aop, Bop_, acc[slot][Q], 0, 0, 0); }
#define P10_VPAIR(K) { const float actk = __int_as_float(__builtin_amdgcn_readlane(actv, 16 * ((K) >> 2) + (K))); \
                       const unsigned wb_ = cvt_pk_bf16(actk, actk); \
                       const u32x2 ab_ = {wb_ & am0, wb_ & am1}; s16x4 Aop; __builtin_memcpy(&Aop, &ab_, 8); \
                       asm volatile("s_waitcnt vmcnt(25)" : "+v"(V[K])); \
                       const u32x2 vv = V[K]; \
                       P10_VQ(0) P10_VQ(1) P10_VQ(2) P10_VQ(3) \
                       P10_LOAD_V(K, wrn) }
#pragma unroll
        for (int slot = 0; slot < 4; ++slot) {
            if (slot >= nk) continue;
            LAS const unsigned char* hr0 = F.lds + P10_H + (w + 8 * slot) * P10_HROW + q4 * 16;
            const float shv = SHl[w + 8 * slot];
#pragma unroll 1
            for (int g8 = 0; g8 < 8; ++g8) {
                const int gi = slot * 8 + g8;
                const int gn = (gi + 1 < ngr) ? gi + 1 : 0;
                const int wrn = (int)SE[gn * 16 + r16]; const float grn = SG[gn * 16 + r16];
                LAS const unsigned char* hr = hr0;
                asm volatile("" : "+v"(hr));
                asm volatile("s_waitcnt vmcnt(16)" : "+v"(U[0]), "+v"(U[1]), "+v"(U[2]), "+v"(U[3]), "+v"(U[4]), "+v"(U[5]), "+v"(U[6]), "+v"(U[7]), "+v"(suv), "+v"(svv));
                f32x4 C0 = {0.f, 0.f, 0.f, 0.f}, C1 = {0.f, 0.f, 0.f, 0.f};
#pragma unroll
                for (int t = 0; t < 8; ++t) {
                    const u32x4 h0 = *(LAS const u32x4*)(hr + t * 128), h1 = *(LAS const u32x4*)(hr + t * 128 + 64);
                    const i32x8 Aop = {(int)h0[0], (int)h0[1], (int)h0[2], (int)h0[3], (int)h1[0], (int)h1[1], (int)h1[2], (int)h1[3]};
                    const i32x8 Bop = {(int)U[t][0], (int)U[t][1], (int)U[t][2], (int)U[t][3], 0, 0, 0, 0};
                    if (t & 1) C1 = __builtin_amdgcn_mfma_scale_f32_16x16x128_f8f6f4(Aop, Bop, C1, 0, 4, 0, 0x7f7f7f7f, 0, 0x7f7f7f7f);
                    else       C0 = __builtin_amdgcn_mfma_scale_f32_16x16x128_f8f6f4(Aop, Bop, C0, 0, 4, 0, 0x7f7f7f7f, 0, 0x7f7f7f7f);
                }
                C0 = C0 + C1;
                const int rsel = lane & 3;
                const float dv = (rsel == 0 ? C0[0] : (rsel == 1 ? C0[1] : (rsel == 2 ? C0[2] : C0[3]))) * (suv * shv);
                const int actv = __float_as_int(gelu_tanh(dv) * (gr * svv));
                P10_LOAD_U(wrn)
                P10_VPAIR(0) P10_VPAIR(1) P10_VPAIR(2) P10_VPAIR(3) P10_VPAIR(4) P10_VPAIR(5) P10_VPAIR(6) P10_VPAIR(7)
                P10_VPAIR(8) P10_VPAIR(9) P10_VPAIR(10) P10_VPAIR(11) P10_VPAIR(12) P10_VPAIR(13) P10_VPAIR(14) P10_VPAIR(15)
                wr = wrn; gr = grn;
            }
        }
#undef P10_VPAIR
#undef P10_VQ
        asm volatile("s_waitcnt vmcnt(0)" : "+v"(U[0]), "+v"(U[1]), "+v"(U[2]), "+v"(U[3]), "+v"(U[4]), "+v"(U[5]), "+v"(U[6]), "+v"(U[7]), "+v"(suv), "+v"(svv),
                     "+v"(V[0]), "+v"(V[1]), "+v"(V[2]), "+v"(V[3]), "+v"(V[4]), "+v"(V[5]), "+v"(V[6]), "+v"(V[7]),
                     "+v"(V[8]), "+v"(V[9]), "+v"(V[10]), "+v"(V[11]), "+v"(V[12]), "+v"(V[13]), "+v"(V[14]), "+v"(V[15]));
#undef P10_LOAD_U
#undef P10_LOAD_V
        float x1v[PK][16];
#pragma unroll
        for (int k = 0; k < PK; ++k) {
            const int m = tok0 + w + 8 * (kbase + (k < nk ? k : 0));
#pragma unroll
            for (int c = 0; c < 16; ++c) x1v[k][c] = F.T1[(size_t)m * D + c * 64 + lane];
        }
#pragma unroll
        for (int k = 0; k < PK; ++k) {
            if (k >= nk) continue;
            const int m = tok0 + w + 8 * (kbase + k);
            const float* mr = F.MOD + (size_t)mod_row(m) * 6144 + 5120;
            float tv[16]; float s = 0.f;
#pragma unroll
            for (int c = 0; c < 16; ++c) { const float t = x1v[k][c] * DN_ALPHA + mr[c * 64 + lane] * acc[k][c >> 2][c & 3]; tv[c] = t; s += t; }
            const float mean = wave_sum(s) * (1.f / D);
            float q = 0.f;
#pragma unroll
            for (int c = 0; c < 16; ++c) { tv[c] -= mean; q += tv[c] * tv[c]; }
            const float rstd = rsqrtf(wave_sum(q) * (1.f / D) + LN_EPS);
            float* yo = (m < NTP) ? F.out + O_YP + (size_t)m * D : F.out + O_YS + (size_t)(m - NTP) * D;
#pragma unroll
            for (int c = 0; c < 16; ++c) yo[c * 64 + lane] = tv[c] * rstd * F.ln2_g[c * 64 + lane] + F.ln2_b[c * 64 + lane];
        }
    }
  }
}

constexpr int N_PHASES = 11;
__global__ void __launch_bounds__(NTHREADS, 2) fwd_kernel(Args args) {
    extern __shared__ __attribute__((aligned(16))) unsigned char lds_raw[];
    Frame F;
    F.lds = (LAS unsigned char*)lds_raw;
    F.tid = threadIdx.x; F.lane = F.tid & 63; F.wave = __builtin_amdgcn_readfirstlane(F.tid >> 6); F.G = gridDim.x; F.bid = blockIdx.x;
    F.x_p = (const float*)args.in[0]; F.x_s = (const float*)args.in[1]; F.c_p = (const float*)args.in[2]; F.c_s = (const float*)args.in[3];
    F.cache_k = (const float*)args.in[4]; F.cache_v = (const float*)args.in[5]; F.cache_ki = (const float*)args.in[6]; F.state_conv = (const float*)args.in[7];
    F.page_table = (const int*)args.in[8]; F.rel_bias = (const float*)args.in[9]; F.w_ada = (const float*)args.in[10]; F.b_ada = (const float*)args.in[11];
    F.w_in = (const float*)args.in[12]; F.conv_w = (const float*)args.in[13]; F.conv_b = (const float*)args.in[14]; F.w_o_attn = (const float*)args.in[15];
    F.w_o_conv = (const float*)args.in[16]; F.w_out = (const float*)args.in[17]; F.ln1_g = (const float*)args.in[18]; F.ln1_b = (const float*)args.in[19];
    F.ln2_g = (const float*)args.in[20]; F.ln2_b = (const float*)args.in[21]; F.peer_wq = (const float*)args.in[22]; F.peer_k1 = (const float*)args.in[23];
    F.peer_k2 = (const float*)args.in[24]; F.peer_u = (const float*)args.in[25]; F.peer_v = (const float*)args.in[26];
    F.out = args.out;
    unsigned char* ws = args.ws; F.ws = ws;
    F.MOD = (float*)(ws + WS_MOD); F.WIN = (bf16_t*)(ws + WS_WIN); F.WOA = (bf16_t*)(ws + WS_WOA); F.WOC = (bf16_t*)(ws + WS_WOC);
    F.WOUT = (bf16_t*)(ws + WS_WOUT); F.WQ = (bf16_t*)(ws + WS_WQ); F.K1 = (bf16_t*)(ws + WS_K1); F.K2 = (bf16_t*)(ws + WS_K2);
    F.PU = (bf16_t*)(ws + WS_PU); F.PV = (bf16_t*)(ws + WS_PV); F.H1 = (bf16_t*)(ws + WS_H1); F.PROJ = (bf16_t*)(ws + WS_PROJ);
    F.WI = (float*)(ws + WS_WI); F.SEL = (int*)(ws + WS_SEL); F.OATT = (bf16_t*)(ws + WS_OATT); F.OCONV = (bf16_t*)(ws + WS_OCONV);
    F.MERGED = (bf16_t*)(ws + WS_MERGED); F.T1 = (float*)(ws + WS_T1); F.H2 = (bf16_t*)(ws + WS_H2); F.QP = (bf16_t*)(ws + WS_QP);
    F.EIDX = (int*)(ws + WS_EIDX); F.GW = (float*)(ws + WS_GW);
    volatile LAS unsigned* misc = (volatile LAS unsigned*)(F.lds + LDS_MISC);
    if (F.tid < 16) misc[F.tid] = 0u;
    __syncthreads();
    XcdBarrier bar; bar.bar = (unsigned*)(ws + WS_CTL); bar.x = 0; bar.st = misc;
    const int lo = args.ph_lo, hi = args.ph_hi;
    if (hi - lo > 1) bar = xcd_barrier_post((unsigned*)(ws + WS_CTL), misc);
#define IN(k) (lo <= (k) && (k) < hi)
#define SEAM(k) do { if (IN(k) && IN((k) + 1)) xcd_barrier(bar); } while (0)
    if (IN(0)) p0_prologue(F);       SEAM(0);
    if (IN(1)) p1_modulate(F);       SEAM(1);
    if (IN(2)) p2_gemm_in(F);        SEAM(2);
    if (IN(3)) p3_index(F);          SEAM(3);
    if (IN(4)) p4_attention(F);      SEAM(4);
    if (IN(5)) p5_gemm_merge(F);     SEAM(5);
    if (IN(6)) p6_gemm_out(F);       SEAM(6);
    if (IN(7)) p7_ln1(F);            SEAM(7);
    if (IN(8)) p8_gemm_q(F);         SEAM(8);
    if (IN(9)) p9_route(F);          SEAM(9);
    if (IN(10)) p10_peer(F);
#undef IN
#undef SEAM
}

extern "C" void kernel_launch(void* const* d_in, const int* in_sizes, int n_in, void* d_out, int out_size, void* d_ws, size_t ws_size, hipStream_t stream) {
    static int grid = 0;
    if (grid == 0) {
        if (n_in != 27 || (size_t)out_size != O_END || ws_size < WS_END) { fprintf(stderr, "kernel_launch: unexpected shapes (n_in %d out %d ws %zu)\n", n_in, out_size, ws_size); grid = -1; return; }
        int dev = 0, cus = 0;
        if (hipGetDevice(&dev) != hipSuccess || hipDeviceGetAttribute(&cus, hipDeviceAttributeMultiprocessorCount, dev) != hipSuccess) { grid = -1; return; }
        if (hipFuncSetAttribute((const void*)fwd_kernel, hipFuncAttributeMaxDynamicSharedMemorySize, LDS_BYTES) != hipSuccess) { fprintf(stderr, "kernel_launch: hipFuncSetAttribute failed\n"); grid = -1; return; }
        (void)hipGetLastError();
        grid = cus < 256 ? cus : 256;
    }
    if (grid < 0) return;
    (void)hipMemsetAsync((char*)d_ws + WS_CTL, 0, CTL_ZERO_BYTES, stream);
    Args a{};
    for (int i = 0; i < 27; ++i) a.in[i] = d_in[i];
    a.out = (float*)d_out; a.ws = (unsigned char*)d_ws;
#if N_LAUNCHES == 1
    a.ph_lo = 0; a.ph_hi = N_PHASES;
    hipLaunchKernelGGL(fwd_kernel, dim3(grid), dim3(NTHREADS), LDS_BYTES, stream, a);
#else
    for (int p = 0; p < N_PHASES; ++p) { a.ph_lo = p; a.ph_hi = p + 1; hipLaunchKernelGGL(fwd_kernel, dim3(grid), dim3(NTHREADS), LDS_BYTES, stream, a); }
#endif
}
```

```cpp
#include <hip/hip_runtime.h>
#include <cstdio>
#include <cstdint>

#ifndef N_LAUNCHES
#define N_LAUNCHES 1
#endif

typedef unsigned short bf16_t;
typedef short bf16x8 __attribute__((ext_vector_type(8)));
typedef float f32x4 __attribute__((ext_vector_type(4)));
typedef float f32x16 __attribute__((ext_vector_type(16)));
typedef unsigned u32x4 __attribute__((ext_vector_type(4)));
typedef unsigned u32x2 __attribute__((ext_vector_type(2)));
#define LAS __attribute__((address_space(3)))

constexpr int D = 1024, NB_P = 8, SEQ = 2048, NB_S = 32, TS = 8, PAST = 8192, PAGE = 128, NPAGES = 64;
constexpr int NTP = NB_P * SEQ;
constexpr int NTS = NB_S * TS;
constexpr int NT = NTP + NTS;
constexpr int NMIX = 4676, NMIXP = 4736;
constexpr int C_Q = 0, C_K = 512, C_V = 640, C_QI = 768, C_KI = 1024, C_BG = 1088, C_CG = 1600, C_XIN = 2112, C_GA = 2624, C_GB = 3648, C_WI = 4672;
constexpr int NSEL = 256;
constexpr float ATTN_SCALE = 0.125f, IDX_SCALE = 0.0625f;
constexpr float DN_ALPHA = 1.189207115002721f, LN_EPS = 1e-5f;
constexpr int NEXP_SEL = 128;

constexpr size_t O_YP = 0, O_YS = 16777216, O_KP = 17039360, O_VP = 19136512, O_KIP = 21233664, O_CP = 22282240,
                 O_KS = 22290432, O_VS = 22323200, O_KIS = 22355968, O_CS = 22372352, O_END = 22405120;

constexpr size_t MB = 1048576;
constexpr size_t WS_CTL = 0, WS_MOD = 1 * MB, WS_WIN = 2 * MB, WS_WOA = 12 * MB, WS_WOC = 13 * MB, WS_WOUT = 14 * MB, WS_WQ = 16 * MB,
                 WS_K1 = 18 * MB, WS_K2 = 18 * MB + 65536, WS_PU = 20 * MB, WS_PV = 52 * MB, WS_H1 = 84 * MB, WS_PROJ = 118 * MB,
                 WS_WI = 270 * MB, WS_SEL = 271 * MB, WS_OATT = 288 * MB, WS_OCONV = 305 * MB, WS_MERGED = 322 * MB, WS_T1 = 355 * MB,
                 WS_H2 = 420 * MB, WS_QP = 453 * MB, WS_EIDX = 486 * MB, WS_GW = 495 * MB, WS_SS = 504 * MB, WS_SE = 513 * MB, WS_SG = 523 * MB, WS_VT = 533 * MB, WS_CGX = 538 * MB, WS_END = 539 * MB;
constexpr size_t WS_PU8 = WS_PU, WS_PV8 = WS_PU + 16 * MB, WS_SU = WS_PV, WS_SV = WS_PV + 65536, WS_H8 = WS_PV + 1 * MB, WS_SH = WS_PV + 20 * MB;
constexpr int CTL_ZERO_BYTES = 65536;

constexpr int NTHREADS = 512;
constexpr int LDS_BYTES = 160 * 1024 - 512;
constexpr int LDS_MISC = LDS_BYTES - 64;

__device__ __forceinline__ float bf2f(bf16_t b) { return __uint_as_float(((unsigned)b) << 16); }
__device__ __forceinline__ float bflo(unsigned p) { return __uint_as_float(p << 16); }
__device__ __forceinline__ float bfhi(unsigned p) { return __uint_as_float(p & 0xFFFF0000u); }
typedef __bf16 bf16x2_t __attribute__((ext_vector_type(2)));
typedef float f32x2_t __attribute__((ext_vector_type(2)));
__device__ __forceinline__ unsigned cvt_pk_bf16(float lo, float hi) { const f32x2_t f = {lo, hi}; const bf16x2_t b = __builtin_convertvector(f, bf16x2_t); unsigned r; __builtin_memcpy(&r, &b, 4); return r; }
__device__ __forceinline__ bf16_t f2bf(float f) { return (bf16_t)(cvt_pk_bf16(f, 0.f) & 0xFFFFu); }
__device__ __forceinline__ float wave_sum(float v) {
#pragma unroll
    for (int o = 32; o >= 1; o >>= 1) v += __shfl_xor(v, o);
    return v;
}
__device__ __forceinline__ float wave_sum_dpp(float v) {
    int x;
    x = __builtin_amdgcn_update_dpp(0, __float_as_int(v), 0xB1, 0xF, 0xF, false);  v += __int_as_float(x);
    x = __builtin_amdgcn_update_dpp(0, __float_as_int(v), 0x4E, 0xF, 0xF, false);  v += __int_as_float(x);
    x = __builtin_amdgcn_update_dpp(0, __float_as_int(v), 0x141, 0xF, 0xF, false); v += __int_as_float(x);
    x = __builtin_amdgcn_update_dpp(0, __float_as_int(v), 0x140, 0xF, 0xF, false); v += __int_as_float(x);
    x = __builtin_amdgcn_update_dpp(0, __float_as_int(v), 0x142, 0xA, 0xF, false); v += __int_as_float(x);
    x = __builtin_amdgcn_update_dpp(0, __float_as_int(v), 0x143, 0xC, 0xF, false); v += __int_as_float(x);
    return __int_as_float(__builtin_amdgcn_readlane(__float_as_int(v), 63));
}
__device__ __forceinline__ float wave_max(float v) {
#pragma unroll
    for (int o = 32; o >= 1; o >>= 1) v = fmaxf(v, __shfl_xor(v, o));
    return v;
}
__device__ __forceinline__ float sigmoidf_(float x) { return 1.f / (1.f + __expf(-x)); }
__device__ __forceinline__ float gelu_tanh(float a) {
    const float z = 0.7978845608028654f * (a + 0.044715f * a * a * a);
    const float e = __expf(2.f * z);
    const float t = 1.f - 2.f * __builtin_amdgcn_rcpf(e + 1.f);
    return 0.5f * a * (1.f + t);
}
__device__ __forceinline__ unsigned f2ord(float f) { const unsigned u = __float_as_uint(f); return (u & 0x80000000u) ? ~u : (u | 0x80000000u); }
__device__ __forceinline__ int t5_bucket(int n) {
    if (n < 16) return n;
    int b = 16;
    b += (n >= 19) + (n >= 21) + (n >= 24) + (n >= 27) + (n >= 31) + (n >= 35) + (n >= 40) + (n >= 46) + (n >= 52) + (n >= 59) + (n >= 67) + (n >= 77) + (n >= 87) + (n >= 99) + (n >= 113);
    return b;
}

#define XB_TMO      128
#define XB_XCNT(j)  (256  + 64 * (j))
#define XB_XSUB(j)  (1280 + 64 * (j))
#define XB_XGEN(j)  (2304 + 64 * (j))
#define XB_TOP      3328
#define XB_TOPGEN   3392
#define XCD_BAR_WORDS 3456
#define XB_SPIN_CAP (1u << 18)
__device__ __forceinline__ unsigned xb_ld(unsigned* p)              { return __hip_atomic_load(p, __ATOMIC_RELAXED, __HIP_MEMORY_SCOPE_AGENT); }
__device__ __forceinline__ unsigned xb_add(unsigned* p, unsigned v) { return __hip_atomic_fetch_add(p, v, __ATOMIC_RELAXED, __HIP_MEMORY_SCOPE_AGENT); }
__device__ __forceinline__ unsigned xb_xcc_id() { return (unsigned)__builtin_amdgcn_s_getreg((3 << 11) | 20) & 0xFu; }
#define XB_SPIN(cond, bar) do { unsigned _sp = 0; while (cond) { __builtin_amdgcn_s_sleep(1); \
    if ((++_sp & 255u) == 0u) { if (xb_ld(&(bar)[XB_TMO])) break; if (_sp > XB_SPIN_CAP) { atomicAdd(&(bar)[XB_TMO], 1u); break; } } } } while (0)
struct XcdBarrier { unsigned* bar; unsigned x; volatile LAS unsigned* st; };
__device__ __forceinline__ XcdBarrier xcd_barrier_post(unsigned* bar, volatile LAS unsigned* st) {
    XcdBarrier b; b.bar = bar; b.x = xb_xcc_id(); b.st = st;
    if (threadIdx.x == 0) (void)xb_add(&bar[XB_XCNT(b.x)], 1u);
    return b;
}
__device__ __forceinline__ void xcd_barrier_complete(unsigned* bar, unsigned x, unsigned& nloc, unsigned& nx) {
    const unsigned G = gridDim.x * gridDim.y * gridDim.z;
    unsigned sum, cnt, mine, sp = 0u;
    for (;;) {
        sum = 0u; cnt = 0u; mine = 0u;
#pragma unroll
        for (unsigned j = 0; j < 16; ++j) { const unsigned c = xb_ld(&bar[XB_XCNT(j)]); sum += c; cnt += (c > 0u) ? 1u : 0u; mine = (j == x) ? c : mine; }
        if (sum == G) break;
        __builtin_amdgcn_s_sleep(1);
        if ((++sp & 255u) == 0u) { if (xb_ld(&bar[XB_TMO])) break; if (sp > XB_SPIN_CAP) { atomicAdd(&bar[XB_TMO], 1u); break; } }
    }
    nloc = mine > 0u ? mine : 1u; nx = cnt > 0u ? cnt : 1u;
}
__device__ __forceinline__ void xcd_barrier(const XcdBarrier& b) {
    asm volatile("s_waitcnt vmcnt(0)" ::: "memory");
    __syncthreads();
    if (threadIdx.x == 0) {
        unsigned* bar = b.bar;
        __builtin_amdgcn_s_waitcnt(0);
        unsigned nloc = b.st[0], nx = b.st[1];
        if (nloc == 0u) { xcd_barrier_complete(bar, b.x, nloc, nx); b.st[0] = nloc; b.st[1] = nx; }
        const unsigned old = xb_add(&bar[XB_XSUB(b.x)], 1u);
        const unsigned gen = old / nloc;
        if (old + 1u == (gen + 1u) * nloc) {
            __builtin_amdgcn_fence(__ATOMIC_RELEASE, "agent");
            asm volatile("s_waitcnt vmcnt(0)" ::: "memory");
            const unsigned og = xb_add(&bar[XB_TOP], 1u);
            const unsigned tg = og / nx;
            if (og + 1u == (tg + 1u) * nx) xb_add(&bar[XB_TOPGEN], 1u);
            else XB_SPIN(xb_ld(&bar[XB_TOPGEN]) == tg, bar);
            __builtin_amdgcn_fence(__ATOMIC_ACQUIRE, "agent");
            xb_add(&bar[XB_XGEN(b.x)], 1u);
            asm volatile("s_waitcnt vmcnt(0)" ::: "memory");
        } else {
            XB_SPIN(xb_ld(&bar[XB_XGEN(b.x)]) == gen, bar);
            __builtin_amdgcn_fence(__ATOMIC_ACQUIRE, "agent");
            asm volatile("s_waitcnt vmcnt(0)" ::: "memory");
        }
    }
    __syncthreads();
}

struct Args { const void* in[27]; float* out; unsigned char* ws; int ph_lo, ph_hi; };
struct Core { LAS unsigned char* lds; int tid, lane, wave, G, bid; };
struct Frame {
    LAS unsigned char* lds;
    int tid, lane, wave, G, bid;
    const float *x_p, *x_s, *c_p, *c_s, *cache_k, *cache_v, *cache_ki, *state_conv, *rel_bias, *w_ada, *b_ada, *w_in, *conv_w, *conv_b,
                *w_o_attn, *w_o_conv, *w_out, *ln1_g, *ln1_b, *ln2_g, *ln2_b, *peer_wq, *peer_k1, *peer_k2, *peer_u, *peer_v;
    const int* page_table;
    float* out; unsigned char* ws;
    float* MOD; bf16_t *WIN, *WOA, *WOC, *WOUT, *WQ, *K1, *K2, *PU, *PV, *H1, *PROJ, *OATT, *OCONV, *MERGED, *H2, *QP;
    float *WI, *T1, *GW; int *SEL, *EIDX;
};
constexpr int LDS_PTAB = LDS_BYTES - 512;
__device__ __forceinline__ unsigned char* ldptr(const Core& C, int k) {
    LAS const unsigned* p = (LAS const unsigned*)(C.lds + LDS_PTAB) + 2 * k;
    const unsigned lo = __builtin_amdgcn_readfirstlane(p[0]), hi = __builtin_amdgcn_readfirstlane(p[1]);
    return (unsigned char*)(((unsigned long long)hi << 32) | (unsigned long long)lo);
}
__device__ __forceinline__ void load_frame(Frame& F, const Core& C) {
    F.lds = C.lds; F.tid = C.tid; F.lane = C.lane; F.wave = C.wave; F.G = C.G; F.bid = C.bid;
    F.x_p = (const float*)ldptr(C, 0); F.x_s = (const float*)ldptr(C, 1); F.c_p = (const float*)ldptr(C, 2); F.c_s = (const float*)ldptr(C, 3);
    F.cache_k = (const float*)ldptr(C, 4); F.cache_v = (const float*)ldptr(C, 5); F.cache_ki = (const float*)ldptr(C, 6); F.state_conv = (const float*)ldptr(C, 7);
    F.page_table = (const int*)ldptr(C, 8); F.rel_bias = (const float*)ldptr(C, 9); F.w_ada = (const float*)ldptr(C, 10); F.b_ada = (const float*)ldptr(C, 11);
    F.w_in = (const float*)ldptr(C, 12); F.conv_w = (const float*)ldptr(C, 13); F.conv_b = (const float*)ldptr(C, 14); F.w_o_attn = (const float*)ldptr(C, 15);
    F.w_o_conv = (const float*)ldptr(C, 16); F.w_out = (const float*)ldptr(C, 17); F.ln1_g = (const float*)ldptr(C, 18); F.ln1_b = (const float*)ldptr(C, 19);
    F.ln2_g = (const float*)ldptr(C, 20); F.ln2_b = (const float*)ldptr(C, 21); F.peer_wq = (const float*)ldptr(C, 22); F.peer_k1 = (const float*)ldptr(C, 23);
    F.peer_k2 = (const float*)ldptr(C, 24); F.peer_u = (const float*)ldptr(C, 25); F.peer_v = (const float*)ldptr(C, 26);
    F.out = (float*)ldptr(C, 27);
    unsigned char* ws = ldptr(C, 28);
    F.MOD = (float*)(ws + WS_MOD); F.WIN = (bf16_t*)(ws + WS_WIN); F.WOA = (bf16_t*)(ws + WS_WOA); F.WOC = (bf16_t*)(ws + WS_WOC);
    F.WOUT = (bf16_t*)(ws + WS_WOUT); F.WQ = (bf16_t*)(ws + WS_WQ); F.K1 = (bf16_t*)(ws + WS_K1); F.K2 = (bf16_t*)(ws + WS_K2);
    F.PU = (bf16_t*)(ws + WS_PU); F.PV = (bf16_t*)(ws + WS_PV); F.H1 = (bf16_t*)(ws + WS_H1); F.PROJ = (bf16_t*)(ws + WS_PROJ);
    F.WI = (float*)(ws + WS_WI); F.SEL = (int*)(ws + WS_SEL); F.OATT = (bf16_t*)(ws + WS_OATT); F.OCONV = (bf16_t*)(ws + WS_OCONV);
    F.MERGED = (bf16_t*)(ws + WS_MERGED); F.T1 = (float*)(ws + WS_T1); F.H2 = (bf16_t*)(ws + WS_H2); F.QP = (bf16_t*)(ws + WS_QP);
    F.EIDX = (int*)(ws + WS_EIDX); F.GW = (float*)(ws + WS_GW);
}
__device__ __forceinline__ const float* x_row(const Frame& F, int m) { return m < NTP ? F.x_p + (size_t)m * D : F.x_s + (size_t)(m - NTP) * D; }
__device__ __forceinline__ int mod_row(int m) { return m < NTP ? (m >> 11) : NB_P + ((m - NTP) >> 3); }

constexpr int P0_MOD_ITEMS = 96;
constexpr int P0_T_WIN = 16 * 74, P0_T_WOA = 8 * 16, P0_T_WOC = 8 * 16, P0_T_WOUT = 16 * 16, P0_T_WQ = 16 * 16;
constexpr int P0_T_ITEMS = P0_T_WIN + P0_T_WOA + P0_T_WOC + P0_T_WOUT + P0_T_WQ;
constexpr int P0_CVT_ITEMS = 2 * (16384 * 1024 / 8192);
constexpr int P0_MISC_ITEMS = 1;
constexpr int P0_ITEMS = P0_MOD_ITEMS + P0_T_ITEMS + P0_CVT_ITEMS + P0_MISC_ITEMS;

__device__ __forceinline__ void p0_mod_item(const Frame& F, int ng) {
    LAS float* cs = (LAS float*)F.lds;
    LAS float* red = (LAS float*)(F.lds + 40 * 256 * 4);
    float acc[40];
#pragma unroll
    for (int r = 0; r < 40; ++r) acc[r] = 0.f;
    const int n = ng * 64 + F.lane;
    for (int kc = 0; kc < 4; ++kc) {
        __syncthreads();
#pragma unroll 1
        for (int hb = 0; hb < 2; ++hb) {
            float cv[10];
#pragma unroll
            for (int i = 0; i < 10; ++i) { const int e = F.tid + (hb * 10 + i) * NTHREADS; const int r = e >> 8, k = e & 255; cv[i] = (r < 8) ? F.c_p[r * D + kc * 256 + k] : F.c_s[(r - 8) * D + kc * 256 + k]; }
#pragma unroll
            for (int i = 0; i < 10; ++i) cs[F.tid + (hb * 10 + i) * NTHREADS] = cv[i];
        }
        __syncthreads();
        float wvv[32];
#pragma unroll
        for (int kk = 0; kk < 32; ++kk) wvv[kk] = F.w_ada[(size_t)(kc * 256 + F.wave * 32 + kk) * 6144 + n];
#pragma unroll
        for (int kk = 0; kk < 32; ++kk) {
            const int kl = F.wave * 32 + kk;
#pragma unroll
            for (int r = 0; r < 40; ++r) acc[r] += cs[r * 256 + kl] * wvv[kk];
        }
    }
#pragma unroll
    for (int r = 0; r < 40; ++r) red[(F.wave * 40 + r) * 64 + F.lane] = acc[r];
    __syncthreads();
    for (int e = F.tid; e < 40 * 64; e += NTHREADS) {
        const int r = e >> 6, l = e & 63; float s = F.b_ada[ng * 64 + l];
#pragma unroll
        for (int w = 0; w < 8; ++w) s += red[(w * 40 + r) * 64 + l];
        F.MOD[r * 6144 + ng * 64 + l] = s;
    }
    __syncthreads();
}
__device__ __forceinline__ void p0_transpose_tile(const Frame& F, const float* W, int N, int K, bf16_t* Wt, int kt, int nt, bool permute) {
    LAS bf16_t* tile = (LAS bf16_t*)F.lds;
    __syncthreads();
    { const int k = F.tid >> 3, c0 = (F.tid & 7) * 8;
      const float* rp = W + (size_t)(kt * 64 + k) * N + nt * 64 + c0;
      const f32x4 z = {0.f, 0.f, 0.f, 0.f};
      const f32x4 v0 = (nt * 64 + c0 < N) ? *(const f32x4*)rp : z, v1 = (nt * 64 + c0 + 4 < N) ? *(const f32x4*)(rp + 4) : z;
#pragma unroll
      for (int j = 0; j < 4; ++j) { tile[k * 66 + c0 + j] = f2bf(v0[j]); tile[k * 66 + c0 + 4 + j] = f2bf(v1[j]); } }
    __syncthreads();
    { const int nl = F.tid >> 3, k0 = (F.tid & 7) * 8; const int n = nt * 64 + nl;
      if (n < N) {
          int nd = n; if (permute) nd = (n < 1024) ? n : (n < 1028 ? C_WI + (n - 1024) : n - 4);
          unsigned p[4];
#pragma unroll
          for (int j = 0; j < 4; ++j) p[j] = (unsigned)tile[(k0 + 2 * j) * 66 + nl] | ((unsigned)tile[(k0 + 2 * j + 1) * 66 + nl] << 16);
          *(u32x4*)(Wt + (size_t)nd * K + kt * 64 + k0) = (u32x4){p[0], p[1], p[2], p[3]};
      } }
}
__device__ __forceinline__ void peer_cvt_rows4(const Frame& F, bool isu, int row0) {
        const float* src = isu ? F.peer_u : F.peer_v;
        unsigned char* dst = F.ws + (isu ? WS_PU8 : WS_PV8); float* sinv = (float*)(F.ws + (isu ? WS_SU : WS_SV));
        float v[4][16];
        if (isu) {
#pragma unroll
            for (int rr = 0; rr < 4; ++rr)
#pragma unroll
                for (int q = 0; q < 4; ++q) {
                    const f32x4 t = *(const f32x4*)(src + (size_t)(row0 + rr) * D + F.lane * 16 + q * 4);
                    v[rr][4 * q] = t[0]; v[rr][4 * q + 1] = t[1]; v[rr][4 * q + 2] = t[2]; v[rr][4 * q + 3] = t[3];
                }
        } else {
#pragma unroll
            for (int rr = 0; rr < 4; ++rr)
#pragma unroll
                for (int c = 0; c < 16; ++c) v[rr][c] = src[(size_t)(row0 + rr) * D + c * 64 + F.lane];
        }
#pragma unroll
        for (int rr = 0; rr < 4; ++rr) {
            float am = 0.f;
#pragma unroll
            for (int c = 0; c < 16; ++c) am = fmaxf(am, fabsf(v[rr][c]));
            am = wave_max(am);
            const float sc = am > 0.f ? 6.f / am : 1.f;
            unsigned w0 = 0u, w1 = 0u;
            w0 = __builtin_amdgcn_cvt_scalef32_pk_fp4_f32(w0, v[rr][0] * sc, v[rr][1] * sc, 1.0f, 0);
            w0 = __builtin_amdgcn_cvt_scalef32_pk_fp4_f32(w0, v[rr][2] * sc, v[rr][3] * sc, 1.0f, 1);
            w0 = __builtin_amdgcn_cvt_scalef32_pk_fp4_f32(w0, v[rr][4] * sc, v[rr][5] * sc, 1.0f, 2);
            w0 = __builtin_amdgcn_cvt_scalef32_pk_fp4_f32(w0, v[rr][6] * sc, v[rr][7] * sc, 1.0f, 3);
            w1 = __builtin_amdgcn_cvt_scalef32_pk_fp4_f32(w1, v[rr][8] * sc, v[rr][9] * sc, 1.0f, 0);
            w1 = __builtin_amdgcn_cvt_scalef32_pk_fp4_f32(w1, v[rr][10] * sc, v[rr][11] * sc, 1.0f, 1);
            w1 = __builtin_amdgcn_cvt_scalef32_pk_fp4_f32(w1, v[rr][12] * sc, v[rr][13] * sc, 1.0f, 2);
            w1 = __builtin_amdgcn_cvt_scalef32_pk_fp4_f32(w1, v[rr][14] * sc, v[rr][15] * sc, 1.0f, 3);
            *(u32x2*)(dst + (size_t)(row0 + rr) * 512 + F.lane * 8) = (u32x2){w0, w1};
            if (F.lane == 0) sinv[row0 + rr] = am > 0.f ? am * (1.f / 6.f) : 1.f;
        }
}
constexpr int P0_OTHER = P0_T_ITEMS + 1;
constexpr int CVT_CHUNKS = 2 * 16384 / 4;
__device__ __forceinline__ void p0_other_item(const Frame& F, int i) {
    if (i < P0_T_ITEMS) {
        if (i < P0_T_WIN) { p0_transpose_tile(F, F.w_in, NMIX, D, F.WIN, i / 74, i % 74, true); return; }
        i -= P0_T_WIN;
        if (i < P0_T_WOA) { p0_transpose_tile(F, F.w_o_attn, D, 512, F.WOA, i / 16, i % 16, false); return; }
        i -= P0_T_WOA;
        if (i < P0_T_WOC) { p0_transpose_tile(F, F.w_o_conv, D, 512, F.WOC, i / 16, i % 16, false); return; }
        i -= P0_T_WOC;
        if (i < P0_T_WOUT) { p0_transpose_tile(F, F.w_out, D, D, F.WOUT, i / 16, i % 16, false); return; }
        i -= P0_T_WOUT;
        p0_transpose_tile(F, F.peer_wq, D, D, F.WQ, i / 16, i % 16, false); return;
    }
    i -= P0_T_ITEMS;
    for (int e = F.tid; e < (4864 - NMIX) * D; e += NTHREADS) F.WIN[(size_t)NMIX * D + e] = 0;
    for (int e = F.tid; e < 128 * 64; e += NTHREADS) { F.K1[e] = f2bf(F.peer_k1[e]); F.K2[e] = f2bf(F.peer_k2[e]); }
}
struct P0Tile { const float* W; bf16_t* Wt; int N, K, kt, nt; bool permute; };
__device__ __forceinline__ P0Tile p0_tile(const Frame& F, int i) {
    if (i < P0_T_WIN) return P0Tile{F.w_in, F.WIN, NMIX, D, i / 74, i % 74, true};
    i -= P0_T_WIN;
    if (i < P0_T_WOA) return P0Tile{F.w_o_attn, F.WOA, D, 512, i / 16, i % 16, false};
    i -= P0_T_WOA;
    if (i < P0_T_WOC) return P0Tile{F.w_o_conv, F.WOC, D, 512, i / 16, i % 16, false};
    i -= P0_T_WOC;
    if (i < P0_T_WOUT) return P0Tile{F.w_out, F.WOUT, D, D, i / 16, i % 16, false};
    i -= P0_T_WOUT;
    return P0Tile{F.peer_wq, F.WQ, D, D, i / 16, i % 16, false};
}
__device__ __forceinline__ void p0_tile_load(const Frame& F, const P0Tile& t, f32x4& v0, f32x4& v1) {
    const int k = F.tid >> 3, c0 = (F.tid & 7) * 8;
    const float* rp = t.W + (size_t)(t.kt * 64 + k) * t.N + t.nt * 64 + c0;
    const f32x4 z = {0.f, 0.f, 0.f, 0.f};
    v0 = (t.nt * 64 + c0 < t.N) ? *(const f32x4*)rp : z; v1 = (t.nt * 64 + c0 + 4 < t.N) ? *(const f32x4*)(rp + 4) : z;
}
__device__ __forceinline__ void p0_tile_finish(const Frame& F, const P0Tile& t, const f32x4 v0, const f32x4 v1) {
    LAS bf16_t* tile = (LAS bf16_t*)F.lds;
    asm volatile("s_waitcnt lgkmcnt(0)" ::: "memory"); __builtin_amdgcn_s_barrier();
    { const int k = F.tid >> 3, c0 = (F.tid & 7) * 8;
#pragma unroll
      for (int j = 0; j < 4; ++j) { tile[k * 66 + c0 + j] = f2bf(v0[j]); tile[k * 66 + c0 + 4 + j] = f2bf(v1[j]); } }
    asm volatile("s_waitcnt lgkmcnt(0)" ::: "memory"); __builtin_amdgcn_s_barrier();
    { const int nl = F.tid >> 3, k0 = (F.tid & 7) * 8; const int n = t.nt * 64 + nl;
      if (n < t.N) {
          int nd = n; if (t.permute) nd = (n < 1024) ? n : (n < 1028 ? C_WI + (n - 1024) : n - 4);
          unsigned p[4];
#pragma unroll
          for (int j = 0; j < 4; ++j) p[j] = (unsigned)tile[(k0 + 2 * j) * 66 + nl] | ((unsigned)tile[(k0 + 2 * j + 1) * 66 + nl] << 16);
          *(u32x4*)(t.Wt + (size_t)nd * t.K + t.kt * 64 + k0) = (u32x4){p[0], p[1], p[2], p[3]};
      } }
}
__device__ __forceinline__ void p0_prologue(const Frame& F) {
    constexpr int NMODWG = P0_MOD_ITEMS;
    if (F.G <= NMODWG) {
        for (int it = F.bid; it < P0_MOD_ITEMS + P0_OTHER; it += F.G) { if (it < P0_MOD_ITEMS) p0_mod_item(F, it); else p0_other_item(F, it - P0_MOD_ITEMS); }
        return;
    }
    if (F.bid < NMODWG) { p0_mod_item(F, F.bid); return; }
    const int nfree = F.G - NMODWG;
    int j = F.bid - NMODWG;
    __syncthreads();
    if (j < P0_T_ITEMS) {
        P0Tile cur = p0_tile(F, j); f32x4 a0, a1; p0_tile_load(F, cur, a0, a1);
        for (;;) {
            const int jn = j + nfree; const bool more = jn < P0_T_ITEMS;
            P0Tile nxt = p0_tile(F, more ? jn : j); f32x4 b0, b1; p0_tile_load(F, nxt, b0, b1);
            p0_tile_finish(F, cur, a0, a1);
            if (!more) break;
            cur = nxt; a0 = b0; a1 = b1; j = jn;
        }
        j += nfree;
    }
    __syncthreads();
    if (j == P0_T_ITEMS) p0_other_item(F, j);
}

__device__ __forceinline__ void p1_modulate(const Frame& F) {
    const int stride = F.G * 8;
    for (int m0 = F.bid * 8 + F.wave; m0 < NT; m0 += 2 * stride) {
        f32x4 xv[2][4], sv[2][4], hv[2][4];
#pragma unroll
        for (int rr = 0; rr < 2; ++rr) {
            const int m = (m0 + rr * stride < NT) ? m0 + rr * stride : m0;
            const float* xr = x_row(F, m); const float* mr = F.MOD + (size_t)mod_row(m) * 6144;
#pragma unroll
            for (int q = 0; q < 4; ++q) {
                const int e = (q >> 1) * 512 + F.lane * 8 + (q & 1) * 4;
                xv[rr][q] = *(const f32x4*)(xr + e); sv[rr][q] = *(const f32x4*)(mr + 1024 + e); hv[rr][q] = *(const f32x4*)(mr + e);
            }
        }
#pragma unroll
        for (int rr = 0; rr < 2; ++rr) {
            const int m = m0 + rr * stride;
            if (m >= NT) continue;
#pragma unroll
            for (int hlf = 0; hlf < 2; ++hlf) {
                const f32x4 a = xv[rr][2 * hlf] * (sv[rr][2 * hlf] + 1.f) + hv[rr][2 * hlf], b2 = xv[rr][2 * hlf + 1] * (sv[rr][2 * hlf + 1] + 1.f) + hv[rr][2 * hlf + 1];
                *(u32x4*)(F.H1 + (size_t)m * D + hlf * 512 + F.lane * 8) = (u32x4){cvt_pk_bf16(a[0], a[1]), cvt_pk_bf16(a[2], a[3]), cvt_pk_bf16(b2[0], b2[1]), cvt_pk_bf16(b2[2], b2[3])};
            }
        }
    }
}

constexpr int BM = 256, BN = 128, BK = 64;
constexpr int XPANEL = BM * 32 + 32, WPANEL = BN * 32 + 32;
constexpr int XSTAGE = 4 * XPANEL, WSTAGE = 4 * WPANEL, GSTAGE = XSTAGE + WSTAGE;
__device__ __forceinline__ void gemm_accum(const Frame& F, f32x16 (&acc)[2][2], const bf16_t* __restrict__ X, int ldx, const bf16_t* __restrict__ W, int ldw, int K, int m0, int n0) {
    const int tid = F.tid, lane = F.lane, r = lane & 31, h = lane >> 5, wm = F.wave >> 1, wn = F.wave & 1;
    u32x4 xr[4], wr[2];
    const int nk = K / BK;
    const int crow = tid >> 3, ckc = tid & 7;
    const bf16_t* xg = X + (size_t)(m0 + crow) * ldx + ckc * 8;
    const bf16_t* wg = W + (size_t)(n0 + crow) * ldw + ckc * 8;
    const int ldso = (ckc >> 1) * 1  ;
    const int xoff = ldso * XPANEL + crow * 32 + (ckc & 1) * 16;
    const int woff = ldso * WPANEL + crow * 32 + (ckc & 1) * 16;
#pragma unroll
    for (int i = 0; i < 4; ++i) xr[i] = *(const u32x4*)(xg + (size_t)(64 * i) * ldx);
#pragma unroll
    for (int i = 0; i < 2; ++i) wr[i] = *(const u32x4*)(wg + (size_t)(64 * i) * ldw);
    __syncthreads();
    for (int kt = 0; kt < nk; ++kt) {
        LAS unsigned char* st = F.lds + (kt & 1) * GSTAGE;
#pragma unroll
        for (int i = 0; i < 4; ++i) *(LAS u32x4*)(st + xoff + i * 64 * 32) = xr[i];
#pragma unroll
        for (int i = 0; i < 2; ++i) *(LAS u32x4*)(st + XSTAGE + woff + i * 64 * 32) = wr[i];
        __syncthreads();
        if (kt + 1 < nk) {
#pragma unroll
            for (int i = 0; i < 4; ++i) xr[i] = *(const u32x4*)(xg + (size_t)(64 * i) * ldx + (kt + 1) * BK);
#pragma unroll
            for (int i = 0; i < 2; ++i) wr[i] = *(const u32x4*)(wg + (size_t)(64 * i) * ldw + (kt + 1) * BK);
        }
#pragma unroll
        for (int s = 0; s < 4; ++s) {
            bf16x8 a[2], b[2];
#pragma unroll
            for (int ni = 0; ni < 2; ++ni) a[ni] = *(LAS bf16x8*)(st + XSTAGE + s * WPANEL + (wn * 64 + ni * 32 + r) * 32 + h * 16);
#pragma unroll
            for (int mi = 0; mi < 2; ++mi) b[mi] = *(LAS bf16x8*)(st + s * XPANEL + (wm * 64 + mi * 32 + r) * 32 + h * 16);
#pragma unroll
            for (int mi = 0; mi < 2; ++mi)
#pragma unroll
                for (int ni = 0; ni < 2; ++ni) acc[mi][ni] = __builtin_amdgcn_mfma_f32_32x32x16_bf16(a[ni], b[mi], acc[mi][ni], 0, 0, 0);
        }
    }
}
#define GEMM_EPI_LOOP(...) \
    { const int r_ = F.lane & 31, h_ = F.lane >> 5, wm_ = F.wave >> 1, wn_ = F.wave & 1; \
      _Pragma("unroll") for (int mi = 0; mi < 2; ++mi) _Pragma("unroll") for (int ni = 0; ni < 2; ++ni) _Pragma("unroll") for (int g = 0; g < 4; ++g) { \
          const int m = m0 + wm_ * 64 + mi * 32 + r_; const int n = n0 + wn_ * 64 + ni * 32 + 8 * g + 4 * h_; __VA_ARGS__ } }
#define ACC4(A) ((f32x4){A[mi][ni][4 * g], A[mi][ni][4 * g + 1], A[mi][ni][4 * g + 2], A[mi][ni][4 * g + 3]})
__device__ __forceinline__ void zero_acc(f32x16 (&acc)[2][2]) {
#pragma unroll
    for (int mi = 0; mi < 2; ++mi)
#pragma unroll
        for (int ni = 0; ni < 2; ++ni)
#pragma unroll
            for (int e = 0; e < 16; ++e) acc[mi][ni][e] = 0.f;
}
__device__ __forceinline__ u32x2 pk4(const f32x4 v) { return (u32x2){cvt_pk_bf16(v[0], v[1]), cvt_pk_bf16(v[2], v[3])}; }

__device__ __forceinline__ void gemm_slice8(const Frame& F, f32x16 (&sacc)[1][1], const bf16_t* __restrict__ X, int ldx, const bf16_t* __restrict__ W, int ldw, int K, int m0, int n0) {
    const int r = F.lane & 31, h = F.lane >> 5, wq = F.wave & 3, kh = F.wave >> 2;
    const bf16_t* wp = W + (size_t)(n0 + 32 * wq + r) * ldw + kh * (K / 2) + h * 8;
    const bf16_t* xp = X + (size_t)(m0 + (r & 7)) * ldx + kh * (K / 2) + h * 8;
    f32x16 c;
#pragma unroll
    for (int e = 0; e < 16; ++e) c[e] = 0.f;
#pragma unroll 1
    for (int k0 = 0; k0 < K / 2; k0 += 128) {
        bf16x8 a[8], b[8];
#pragma unroll
        for (int t = 0; t < 8; ++t) { a[t] = *(const bf16x8*)(wp + k0 + t * 16); b[t] = *(const bf16x8*)(xp + k0 + t * 16); }
#pragma unroll
        for (int t = 0; t < 8; ++t) c = __builtin_amdgcn_mfma_f32_32x32x16_bf16(a[t], b[t], c, 0, 0, 0);
    }
    LAS float* cb = (LAS float*)F.lds + wq * (16 * 64);
    __syncthreads();
    if (kh == 1) {
#pragma unroll
        for (int e = 0; e < 16; ++e) cb[e * 64 + F.lane] = c[e];
    }
    __syncthreads();
    if (kh == 0) {
#pragma unroll
        for (int e = 0; e < 16; ++e) c[e] += cb[e * 64 + F.lane];
    }
    sacc[0][0] = c;
}
#define SLICE_EPI_LOOP(...) \
    if (F.wave < 4 && (F.lane & 31) < 8) { const int h_ = F.lane >> 5, wq_ = F.wave & 3; constexpr int mi = 0, ni = 0; \
      _Pragma("unroll") for (int g = 0; g < 4; ++g) { const int m = m0 + (F.lane & 31); const int n = n0 + wq_ * 32 + 8 * g + 4 * h_; __VA_ARGS__ } }

namespace pg8 {
#define PG8_LAS __attribute__((address_space(3)))
typedef unsigned short bf16_t;
typedef short bf16x8 __attribute__((ext_vector_type(8)));
typedef float f32x4 __attribute__((ext_vector_type(4)));
typedef unsigned u32x4 __attribute__((ext_vector_type(4)));
constexpr int BM = 256, BK = 64, HALF = 128, HTB = HALF * BK * 2  , STAGE_BYTES = 8 * HTB, NXCD = 8, WGM = 8;

__host__ __device__ __forceinline__ int lds_byte(int r, int c) { const int st = (r >> 4) * 2 + (c >> 5), rr = r & 15, cc = c & 31, ob = rr * 64 + cc * 2; return st * 1024 + (ob ^ (((ob >> 9) & 1) << 5)); }
__host__ __device__ __forceinline__ void stage_rc(int b, int& R, int& C) { const int st = b / 1024, sb = b % 1024, swz = sb ^ (((sb >> 9) & 1) << 5); R = (st >> 1) * 16 + swz / 64; C = (st & 1) * 32 + (swz % 64) / 2; }
__host__ __device__ __forceinline__ int perm32(int rho) { const int n = rho >> 4, i = rho & 15; return 8 * (i >> 2) + 4 * n + (i & 3); }

struct Unit { int pm, pn; };
struct Gemm { const bf16_t* A; const bf16_t* Bt; int M, N, K; };

struct StaticOrder {
    int nM, nN, nwg, G, c;
    __host__ __device__ void init(int M, int N, int G_, int c_) { nM = M / BM; nN = N / BM; nwg = nM * nN; G = G_; c = c_; }
    __host__ __device__ bool next(int i, Unit& u) const {
        const long L = (long)i * G + c; if (L >= nwg) return false;
        int wgid = (int)L; { const int q = nwg / NXCD, r = nwg % NXCD, xcd = wgid % NXCD, off = wgid / NXCD; wgid = (xcd < r ? xcd * (q + 1) : r * (q + 1) + (xcd - r) * q) + off; }
        const int nig = WGM * nN, gid = wgid / nig, fm = gid * WGM, gsz = (nM - fm) < WGM ? (nM - fm) : WGM;
        u.pm = fm + ((wgid % nig) % gsz); u.pn = (wgid % nig) / gsz; return true;
    }
    __device__ __forceinline__ void a_ready(const Unit&) const {}
    __device__ __forceinline__ void done(const Unit&) const {}
};

template <class Body> struct EpiRC {
    static constexpr bool PERM = false, AFTER_DRAIN = false;
    Body body;
    __device__ __forceinline__ void operator()(const f32x4 (&acc)[2][2][4][2], const Unit& u, int wr, int wc, int fr, int fq) const {
#pragma unroll
        for (int ai = 0; ai < 2; ++ai)
#pragma unroll
            for (int m = 0; m < 4; ++m) {
                const int row = u.pm * BM + ai * HALF + wr * 64 + m * 16 + fr;
#pragma unroll
                for (int bj = 0; bj < 2; ++bj)
#pragma unroll
                    for (int n = 0; n < 2; ++n) body(row, u.pn * BM + bj * HALF + wc * 32 + n * 16 + 4 * fq, acc[ai][bj][m][n]);
            }
    }
};
template <class Epi, class Sched, bool ALIGN_EPI = false, bool SP2 = false>
__device__ __forceinline__ void gemm_phase(PG8_LAS unsigned char* lds, const Gemm g, const Sched& S, const Epi& E) {
    const int tid = threadIdx.x, wid = __builtin_amdgcn_readfirstlane(tid >> 6), lane = tid & 63, wr = wid >> 2, wc = wid & 3, fr = lane & 15, fq = lane >> 4;
    const int K = g.K, nt = K / BK;
    unsigned voffA[2], voffB[2];
#pragma unroll
    for (int i = 0; i < 2; ++i) { int R, C; stage_rc(tid * 16 + i * 8192, R, C); const int Rb = Epi::PERM ? ((R & ~31) + perm32(R & 31)) : R;
        voffA[i] = (unsigned)(R * K + C) * 2u; voffB[i] = (unsigned)(Rb * K + C) * 2u; }
    const size_t kstep = (size_t)(BK * 2);
    const size_t hstep = (size_t)HALF * K * 2;
    const size_t tstep = 2 * hstep;
    const unsigned ldsw = (unsigned)wid * 1024u;
    const int aoff = lds_byte(wr * 64 + fr, fq * 8), boff = lds_byte(wc * 32 + fr, fq * 8);
#define PG8_SA(b, h) (((b) * 2 + (h)) * HTB)
#define PG8_SB(b, h) ((4 + (b) * 2 + (h)) * HTB)
#define PG8_STAGE(bufoff, gbase, voff) do { _Pragma("unroll") for (int _i = 0; _i < 2; ++_i) \
        __builtin_amdgcn_global_load_lds((const unsigned*)((const char*)(gbase) + (voff)[_i]), (PG8_LAS unsigned*)(lds + (bufoff) + ldsw + _i * 8192), 16, 0, 0); } while (0)
#define PG8_LDA(dst, b, h) do { _Pragma("unroll") for (int m = 0; m < 4; ++m) _Pragma("unroll") for (int k = 0; k < 2; ++k) dst[m][k] = *(const PG8_LAS bf16x8*)(lds + PG8_SA(b, h) + aoff + m * 2048 + k * 1024); } while (0)
#define PG8_LDB(dst, b, h) do { _Pragma("unroll") for (int n = 0; n < 2; ++n) _Pragma("unroll") for (int k = 0; k < 2; ++k) dst[n][k] = *(const PG8_LAS bf16x8*)(lds + PG8_SB(b, h) + boff + n * 2048 + k * 1024); } while (0)
#define PG8_MMA(ai, bj, At, Bt) do { __builtin_amdgcn_s_setprio(1); _Pragma("unroll") for (int m = 0; m < 4; ++m) _Pragma("unroll") for (int n = 0; n < 2; ++n) _Pragma("unroll") for (int k = 0; k < 2; ++k) \
        acc[ai][bj][m][n] = __builtin_amdgcn_mfma_f32_16x16x32_bf16(Bt[n][k], At[m][k], acc[ai][bj][m][n], 0, 0, 0); __builtin_amdgcn_s_setprio(0); } while (0)
#define PG8_WAIT_V(n) asm volatile("s_waitcnt vmcnt(" #n ")" ::: "memory")
#define PG8_WAIT_L(n) asm volatile("s_waitcnt lgkmcnt(" #n ")" ::: "memory")
#define PG8_BAR __builtin_amdgcn_s_barrier()
#define PG8_SCHED __builtin_amdgcn_sched_barrier(0)
    Unit cur, nxt; int ui = 0;
    if (!S.next(0, cur)) return;
    f32x4 acc[2][2][4][2];
#pragma unroll
    for (int a = 0; a < 2; ++a)
#pragma unroll
        for (int b = 0; b < 2; ++b)
#pragma unroll
            for (int m = 0; m < 4; ++m)
#pragma unroll
                for (int n = 0; n < 2; ++n) acc[a][b][m][n] = (f32x4){0.f, 0.f, 0.f, 0.f};
    bf16x8 At[4][2], B0[2][2], B1[2][2];
    const char* cA = (const char*)g.A + (size_t)cur.pm * tstep; const char* cB = (const char*)g.Bt + (size_t)cur.pn * tstep;
    S.a_ready(cur);
    if constexpr (SP2) {
        PG8_STAGE(PG8_SB(0, 0), cB, voffB); PG8_STAGE(PG8_SB(0, 1), cB + hstep, voffB); PG8_STAGE(PG8_SA(0, 0), cA, voffA); PG8_STAGE(PG8_SA(0, 1), cA + hstep, voffA);
        if (wr == 1) PG8_BAR;
        PG8_WAIT_V(2); PG8_BAR;
        PG8_STAGE(PG8_SB(1, 0), cB + kstep, voffB); PG8_STAGE(PG8_SA(1, 0), cA + kstep, voffA); PG8_STAGE(PG8_SB(1, 1), cB + hstep + kstep, voffB);
        PG8_WAIT_V(6); PG8_BAR;
    } else {
        PG8_STAGE(PG8_SB(0, 0), cB, voffB); PG8_STAGE(PG8_SA(0, 0), cA, voffA); PG8_STAGE(PG8_SB(0, 1), cB + hstep, voffB); PG8_STAGE(PG8_SA(0, 1), cA + hstep, voffA);
        if (wr == 1) PG8_BAR;
        PG8_WAIT_V(4); PG8_BAR;
        PG8_STAGE(PG8_SB(1, 0), cB + kstep, voffB); PG8_STAGE(PG8_SA(1, 0), cA + kstep, voffA); PG8_STAGE(PG8_SB(1, 1), cB + hstep + kstep, voffB);
        PG8_WAIT_V(6); PG8_BAR;
    }
    for (;;) {
        const bool has_next = S.next(ui + 1, nxt);
        const char* nA = has_next ? (const char*)g.A + (size_t)nxt.pm * tstep : cA; const char* nB = has_next ? (const char*)g.Bt + (size_t)nxt.pn * tstep : cB;
        for (int t = 0; t < nt; t += 2) {
            const bool last = (t == nt - 2);
            const char* a1 = cA + (size_t)(t + 1) * kstep;
            const char* a2 = last ? nA : cA + (size_t)(t + 2) * kstep; const char* b2 = last ? nB : cB + (size_t)(t + 2) * kstep;
            const char* a3 = a2 + kstep; const char* b3 = b2 + kstep;
            if (last && has_next) S.a_ready(nxt);
            if constexpr (SP2) {
            PG8_LDB(B0, 0, 0); PG8_LDB(B1, 0, 1); PG8_SCHED; PG8_LDA(At, 0, 0); PG8_STAGE(PG8_SA(1, 1), a1 + hstep, voffA);
            PG8_WAIT_V(8); PG8_WAIT_L(0); PG8_BAR; PG8_MMA(0, 0, At, B0); PG8_MMA(0, 1, At, B1); PG8_BAR; PG8_SCHED;
            PG8_LDA(At, 0, 1); PG8_STAGE(PG8_SB(0, 0), b2, voffB); PG8_STAGE(PG8_SB(0, 1), b2 + hstep, voffB); PG8_STAGE(PG8_SA(0, 0), a2, voffA);
            PG8_WAIT_V(8); PG8_WAIT_L(0); PG8_BAR; PG8_MMA(1, 0, At, B0); PG8_MMA(1, 1, At, B1); PG8_BAR; PG8_SCHED;
            PG8_LDB(B0, 1, 0); PG8_LDB(B1, 1, 1); PG8_SCHED; PG8_LDA(At, 1, 0); PG8_STAGE(PG8_SA(0, 1), a2 + hstep, voffA);
            PG8_WAIT_V(8); PG8_WAIT_L(0); PG8_BAR; PG8_MMA(0, 0, At, B0); PG8_MMA(0, 1, At, B1); PG8_BAR; PG8_SCHED;
            PG8_LDA(At, 1, 1); PG8_STAGE(PG8_SB(1, 0), b3, voffB); PG8_STAGE(PG8_SB(1, 1), b3 + hstep, voffB); PG8_STAGE(PG8_SA(1, 0), a3, voffA);
            PG8_WAIT_V(8); PG8_WAIT_L(0); PG8_BAR; PG8_MMA(1, 0, At, B0); PG8_MMA(1, 1, At, B1); PG8_BAR; PG8_SCHED;
            } else {
            PG8_LDB(B0, 0, 0); PG8_SCHED; PG8_LDA(At, 0, 0); PG8_STAGE(PG8_SA(1, 1), a1 + hstep, voffA);
            PG8_WAIT_L(8); PG8_BAR; PG8_WAIT_L(0); PG8_MMA(0, 0, At, B0); PG8_BAR; PG8_SCHED;
            PG8_LDB(B1, 0, 1); PG8_STAGE(PG8_SB(0, 0), b2, voffB);
            PG8_BAR; PG8_WAIT_L(0); PG8_MMA(0, 1, At, B1); PG8_BAR;
            PG8_LDA(At, 0, 1); PG8_STAGE(PG8_SA(0, 0), a2, voffA);
            PG8_BAR; PG8_WAIT_L(0); PG8_MMA(1, 0, At, B0); PG8_BAR; PG8_SCHED;
            PG8_STAGE(PG8_SB(0, 1), b2 + hstep, voffB);
            PG8_WAIT_V(6); PG8_BAR; PG8_MMA(1, 1, At, B1); PG8_BAR;
            PG8_LDB(B0, 1, 0); PG8_SCHED; PG8_LDA(At, 1, 0); PG8_STAGE(PG8_SA(0, 1), a2 + hstep, voffA);
            PG8_WAIT_L(8); PG8_BAR; PG8_WAIT_L(0); PG8_MMA(0, 0, At, B0); PG8_BAR; PG8_SCHED;
            PG8_LDB(B1, 1, 1); PG8_STAGE(PG8_SB(1, 0), b3, voffB);
            PG8_BAR; PG8_WAIT_L(0); PG8_MMA(0, 1, At, B1); PG8_BAR;
            PG8_LDA(At, 1, 1); PG8_STAGE(PG8_SA(1, 0), a3, voffA);
            PG8_BAR; PG8_WAIT_L(0); PG8_MMA(1, 0, At, B0); PG8_BAR; PG8_SCHED;
            PG8_STAGE(PG8_SB(1, 1), b3 + hstep, voffB);
            PG8_WAIT_V(6); PG8_BAR; PG8_MMA(1, 1, At, B1); PG8_BAR;
            }
        }
        if constexpr (ALIGN_EPI) { if (wr == 0) PG8_BAR; }
        if constexpr (!Epi::AFTER_DRAIN) { E(acc, cur, wr, wc, fr, fq); S.done(cur); }
        if (!has_next) break;
#pragma unroll
        for (int a = 0; a < 2; ++a)
#pragma unroll
            for (int b = 0; b < 2; ++b)
#pragma unroll
                for (int m = 0; m < 4; ++m)
#pragma unroll
                    for (int n = 0; n < 2; ++n) acc[a][b][m][n] = (f32x4){0.f, 0.f, 0.f, 0.f};
        cur = nxt; cA = nA; cB = nB; ++ui;
        if constexpr (ALIGN_EPI) { if (wr == 1) PG8_BAR; }
    }
    PG8_WAIT_V(0);
    if constexpr (!ALIGN_EPI) { if (wr == 0) PG8_BAR; }
    PG8_BAR;
    if constexpr (Epi::AFTER_DRAIN) { E.fused(acc, cur, wr, wc, fr, fq, lds, wid, lane); S.done(cur); }
#undef PG8_SA
#undef PG8_SB
#undef PG8_STAGE
#undef PG8_LDA
#undef PG8_LDB
#undef PG8_MMA
#undef PG8_WAIT_V
#undef PG8_WAIT_L
#undef PG8_BAR
#undef PG8_SCHED
}
}

constexpr int NMIXW = 4864;
struct P2Body {
    const Frame* Fp;
    __device__ __forceinline__ void operator()(int m, int n, const f32x4 v) const {
        const Frame& F = *Fp;
        if (n >= NMIXP) return;
        *(u32x2*)(F.PROJ + (size_t)m * NMIXP + n) = pk4(v);
        if (n >= C_K && n < C_QI) {
            float* o = (n < C_V) ? (m < NTP ? F.out + O_KP + (size_t)m * 128 + (n - C_K) : F.out + O_KS + (size_t)(m - NTP) * 128 + (n - C_K))
                                 : (m < NTP ? F.out + O_VP + (size_t)m * 128 + (n - C_V) : F.out + O_VS + (size_t)(m - NTP) * 128 + (n - C_V));
            *(f32x4*)o = v;
            if (n >= C_V && m < NTP) {
                bf16_t* vt = (bf16_t*)(F.ws + WS_VT) + ((size_t)((m >> 11) * 2 + ((n - C_V) >> 6)) * 64 + ((n - C_V) & 63)) * SEQ + (m & 2047);
                vt[0] = f2bf(v[0]); vt[SEQ] = f2bf(v[1]); vt[2 * SEQ] = f2bf(v[2]); vt[3 * SEQ] = f2bf(v[3]);
            }
        } else if (n >= C_KI && n < C_BG) {
            float* o = m < NTP ? F.out + O_KIP + (size_t)m * 64 + (n - C_KI) : F.out + O_KIS + (size_t)(m - NTP) * 64 + (n - C_KI);
            *(f32x4*)o = v;
        } else if (n == C_WI) {
            *(f32x4*)(F.WI + (size_t)m * 4) = v;
        } else if (n >= C_CG && n < C_GA) {
            const int tt = (m < NTP) ? (m & 2047) - (SEQ - 2) : ((m - NTP) & 7) - (TS - 2);
            if (tt >= 0) {
                const int rowi = (m < NTP) ? (m >> 11) * 2 + tt : 2 * NB_P + ((m - NTP) >> 3) * 2 + tt;
                *(f32x4*)((float*)(F.ws + WS_CGX) + (size_t)rowi * 1024 + (n - C_CG)) = v;
            }
        }
    }
};
__device__ __forceinline__ void p2_gemm_in(const Frame& F) {
    pg8::Gemm g{F.H1, F.WIN, NT, NMIXW, D};
    pg8::StaticOrder S; S.init(NT, NMIXW, F.G, F.bid);
    pg8::EpiRC<P2Body> E{P2Body{&F}};
    pg8::gemm_phase<pg8::EpiRC<P2Body>, pg8::StaticOrder, true, true>(F.lds, g, S, E);
}

constexpr int SROW = 2052;
__device__ __forceinline__ int wave_sum_i(int v) {
#pragma unroll
    for (int o = 32; o >= 1; o >>= 1) v += __shfl_xor(v, o);
    return v;
}
__device__ __forceinline__ void cnt_ge(int& c, unsigned u, unsigned t) { asm("v_cmp_ge_u32_e32 vcc, %1, %2\n\tv_addc_co_u32_e32 %0, vcc, 0, %0, vcc" : "+v"(c) : "v"(u), "v"(t) : "vcc"); }
__device__ __forceinline__ void cnt_gt(int& c, unsigned u, unsigned t) { asm("v_cmp_gt_u32_e32 vcc, %1, %2\n\tv_addc_co_u32_e32 %0, vcc, 0, %0, vcc" : "+v"(c) : "v"(u), "v"(t) : "vcc"); }
__device__ __forceinline__ void cnt_eq(int& c, unsigned u, unsigned t) { asm("v_cmp_eq_u32_e32 vcc, %1, %2\n\tv_addc_co_u32_e32 %0, vcc, 0, %0, vcc" : "+v"(c) : "v"(u), "v"(t) : "vcc"); }
__device__ __forceinline__ void cnt_lt4(int& cl, unsigned u0, unsigned u1, unsigned u2, unsigned u3, unsigned t) {
    int d0, d1, d2, d3;
    asm("v_sub_u32 %1, %5, %9\n\tv_sub_u32 %2, %6, %9\n\tv_sub_u32 %3, %7, %9\n\tv_sub_u32 %4, %8, %9\n\t"
        "v_lshrrev_b32 %1, 31, %1\n\tv_lshrrev_b32 %2, 31, %2\n\tv_lshrrev_b32 %3, 31, %3\n\tv_lshrrev_b32 %4, 31, %4\n\t"
        "v_add3_u32 %0, %0, %1, %2\n\tv_add3_u32 %0, %0, %3, %4"
        : "+v"(cl), "=&v"(d0), "=&v"(d1), "=&v"(d2), "=&v"(d3) : "v"(u0), "v"(u1), "v"(u2), "v"(u3), "v"(t));
}
__device__ __forceinline__ void cnt_eq_pos(int& c, unsigned u, unsigned t, int L) {
    int tmp;
    asm("v_cmp_eq_u32_e32 vcc, %2, %3\n\tv_cndmask_b32_e32 %1, %5, %4, vcc\n\tv_cmp_lt_i32_e32 vcc, 0, %1\n\tv_addc_co_u32_e32 %0, vcc, 0, %0, vcc"
        : "+v"(c), "=&v"(tmp) : "v"(u), "v"(t), "v"(L), "v"(0x80000000) : "vcc");
}
__device__ __forceinline__ int wave_sum_i_dpp(int v) {
    v += __builtin_amdgcn_update_dpp(0, v, 0xB1, 0xF, 0xF, false);
    v += __builtin_amdgcn_update_dpp(0, v, 0x4E, 0xF, 0xF, false);
    v += __builtin_amdgcn_update_dpp(0, v, 0x141, 0xF, 0xF, false);
    v += __builtin_amdgcn_update_dpp(0, v, 0x140, 0xF, 0xF, false);
    v += __builtin_amdgcn_update_dpp(0, v, 0x142, 0xA, 0xF, false);
    v += __builtin_amdgcn_update_dpp(0, v, 0x143, 0xC, 0xF, false);
    return __builtin_amdgcn_readlane(v, 63);
}
template <int NV> __device__ __forceinline__ void select_threshold(const unsigned (&u)[NV], int ksel, int idx_bits, int lane, unsigned& T_out, int& Jx_out, int& ngt_out) {
    unsigned T = 0;
#pragma unroll 1
    for (int bit = 31; bit >= 0; --bit) {
        const unsigned cand = T | (1u << bit);
        int c = 0;
#pragma unroll
        for (int i = 0; i < NV; ++i) cnt_ge(c, u[i], cand);
        c = wave_sum_i_dpp(c);
        if (c >= ksel) T = cand;
    }
    int cg = 0, ce = 0;
#pragma unroll
    for (int i = 0; i < NV; ++i) { cnt_gt(cg, u[i], T); cnt_eq(ce, u[i], T); }
    const int ngt = wave_sum_i_dpp(cg), neq = wave_sum_i_dpp(ce);
    const int need = ksel - ngt;
    int Jx = 0x3FFFFFFF;
    if (need < neq) {
        int Jb = 0;
#pragma unroll 1
        for (int bit = idx_bits - 1; bit >= 0; --bit) {
            const int cand = Jb | (1 << bit);
            const int L = cand - lane;
            int c = 0;
#pragma unroll
            for (int i = 0; i < NV; ++i) cnt_eq_pos(c, u[i], T, L - 64 * i);
            c = wave_sum_i_dpp(c);
            if (c < need) Jb = cand;
        }
        Jx = Jb + 1;
    }
    T_out = T; Jx_out = Jx; ngt_out = ngt;
}
template <int NV> __device__ __forceinline__ void select_threshold2(const unsigned (&ua)[NV], const unsigned (&ub)[NV], int ksel, int idx_bits, int lane, int ng,
                                                                   unsigned& Ta_out, int& Jxa_out, unsigned& Tb_out, int& Jxb_out) {
    unsigned Ta = 0, Tb = 0;
    bool da = false, db = false;
#pragma unroll 1
    for (int bit = 30; bit >= 0 && !(da && db); --bit) {
        const unsigned ca = da ? Ta : (Ta | (1u << bit)), cb = db ? Tb : (Tb | (1u << bit));
        int la = 0, lb = 0;
#pragma unroll
        for (int i = 0; i < NV; i += 4) { if (i < 4 * ng) { cnt_lt4(la, ua[i], ua[i + 1], ua[i + 2], ua[i + 3], ca); cnt_lt4(lb, ub[i], ub[i + 1], ub[i + 2], ub[i + 3], cb); } }
        const int na = ng * 256 - wave_sum_i_dpp(la), nb = ng * 256 - wave_sum_i_dpp(lb);
        if (!da && na >= ksel) { Ta = ca; da = (na == ksel); }
        if (!db && nb >= ksel) { Tb = cb; db = (nb == ksel); }
    }
    int ga = 0, ea = 0, gb = 0, eb = 0;
#pragma unroll
    for (int i = 0; i < NV; ++i) { cnt_gt(ga, ua[i], Ta); cnt_eq(ea, ua[i], Ta); cnt_gt(gb, ub[i], Tb); cnt_eq(eb, ub[i], Tb); }
    const int needa = ksel - wave_sum_i_dpp(ga), neqa = wave_sum_i_dpp(ea), needb = ksel - wave_sum_i_dpp(gb), neqb = wave_sum_i_dpp(eb);
    int Jxa = 0x3FFFFFFF, Jxb = 0x3FFFFFFF;
    if (needa < neqa) {
        int Jb = 0;
#pragma unroll 1
        for (int bit = idx_bits - 1; bit >= 0; --bit) {
            const int cand = Jb | (1 << bit); const int L = cand - lane; int c = 0;
#pragma unroll
            for (int i = 0; i < NV; ++i) cnt_eq_pos(c, ua[i], Ta, L - 64 * i);
            if (wave_sum_i_dpp(c) < needa) Jb = cand;
        }
        Jxa = Jb + 1;
    }
    if (needb < neqb) {
        int Jb = 0;
#pragma unroll 1
        for (int bit = idx_bits - 1; bit >= 0; --bit) {
            const int cand = Jb | (1 << bit); const int L = cand - lane; int c = 0;
#pragma unroll
            for (int i = 0; i < NV; ++i) cnt_eq_pos(c, ub[i], Tb, L - 64 * i);
            if (wave_sum_i_dpp(c) < needb) Jb = cand;
        }
        Jxb = Jb + 1;
    }
    Ta_out = Ta; Jxa_out = Jxa; Tb_out = Tb; Jxb_out = Jxb;
}
template <int NV> __device__ __forceinline__ void select_topk(const unsigned (&u)[NV], int ksel, int idx_bits, int* sel, int lane) {
    unsigned T; int Jx, ngt;
    select_threshold<NV>(u, ksel, idx_bits, lane, T, Jx, ngt);
    const int L = Jx - lane;
    int cg = 0, ct = 0;
#pragma unroll
    for (int i = 0; i < NV; ++i) { cnt_gt(cg, u[i], T); cnt_eq_pos(ct, u[i], T, L - 64 * i); }
    int ig = cg, it = ct;
#pragma unroll
    for (int o = 1; o < 64; o <<= 1) { const int a = __shfl_up(ig, o), b2 = __shfl_up(it, o); if (lane >= o) { ig += a; it += b2; } }
    int pg = ig - cg, pt = ngt + it - ct;
    int ev = lane, Lr = L;
#pragma unroll
    for (int i = 0; i < NV; ++i) {
        if (u[i] > T) { sel[pg] = ev; ++pg; }
        else if (u[i] == T && Lr > 0) { sel[pt] = ev; ++pt; }
        asm volatile("v_add_u32 %0, 64, %0\n\tv_add_u32 %1, -64, %1" : "+v"(ev), "+v"(Lr));
    }
}

constexpr int PU_MB = 16 * SROW * 4;
constexpr int PU_RB = PU_MB + 16 * 64 * 4;
constexpr int PU_BT = PU_RB + 1024;
constexpr int PU_QT = PU_BT + 512, PU_QROW = 1040;
__device__ __forceinline__ int kappa32(int r) { return (r & 0x13) | ((r & 4) << 1) | ((r & 8) >> 1); }
__device__ __forceinline__ void p3_prompt_fused_unit(const Frame& F, const bf16_t* VT, int b, int qt) {
    LAS float* S = (LAS float*)F.lds;
    LAS unsigned* MB = (LAS unsigned*)(F.lds + PU_MB);
    LAS float* RB = (LAS float*)(F.lds + PU_RB);
    LAS int* BT = (LAS int*)(F.lds + PU_BT);
    const int lane = F.lane;
    const int q0 = qt * 16; const size_t tok0 = (size_t)b * SEQ;
    __syncthreads();
    for (int ch = F.tid; ch < 16 * 64; ch += NTHREADS) {
        const u32x4 qv = *(const u32x4*)(F.PROJ + (tok0 + q0 + (ch >> 6)) * NMIXP + C_Q + (ch & 63) * 8);
        constexpr float QS = ATTN_SCALE * 1.4426950408889634f;
        *(LAS u32x4*)(F.lds + PU_QT + (ch >> 6) * PU_QROW + (ch & 63) * 16) = (u32x4){cvt_pk_bf16(bflo(qv[0]) * QS, bfhi(qv[0]) * QS), cvt_pk_bf16(bflo(qv[1]) * QS, bfhi(qv[1]) * QS),
                                                                                    cvt_pk_bf16(bflo(qv[2]) * QS, bfhi(qv[2]) * QS), cvt_pk_bf16(bflo(qv[3]) * QS, bfhi(qv[3]) * QS)};
    }
    {
        const int r = lane & 15, q4 = lane >> 4;
        bf16x8 A[4][2];
#pragma unroll
        for (int hh = 0; hh < 4; ++hh)
#pragma unroll
            for (int s2 = 0; s2 < 2; ++s2) A[hh][s2] = *(const bf16x8*)(F.PROJ + (tok0 + q0 + r) * NMIXP + C_QI + hh * 64 + s2 * 32 + q4 * 8);
        float wv[4][4];
#pragma unroll
        for (int g = 0; g < 4; ++g) { const f32x4 w4 = *(const f32x4*)(F.WI + (tok0 + q0 + 4 * q4 + g) * 4);
#pragma unroll
            for (int hh = 0; hh < 4; ++hh) wv[g][hh] = w4[hh] * IDX_SCALE; }
        const int nkt = qt + 1;
        bf16x8 Bn[2][2];
        {
            const int t0 = 2 * F.wave;
#pragma unroll
            for (int p = 0; p < 2; ++p)
#pragma unroll
                for (int s2 = 0; s2 < 2; ++s2) { const int key = (t0 + p < nkt ? t0 + p : 0) * 16 + r; Bn[p][s2] = *(const bf16x8*)(F.PROJ + (tok0 + key) * NMIXP + C_KI + s2 * 32 + q4 * 8); }
        }
#pragma unroll 1
        for (int t0 = 2 * F.wave; t0 < nkt; t0 += 16) {
            bf16x8 B[2][2] = {{Bn[0][0], Bn[0][1]}, {Bn[1][0], Bn[1][1]}};
            {
                const int tn = t0 + 16;
#pragma unroll
                for (int p = 0; p < 2; ++p)
#pragma unroll
                    for (int s2 = 0; s2 < 2; ++s2) { const int key = (tn + p < nkt ? tn + p : 0) * 16 + r; Bn[p][s2] = *(const bf16x8*)(F.PROJ + (tok0 + key) * NMIXP + C_KI + s2 * 32 + q4 * 8); }
            }
#pragma unroll
            for (int p = 0; p < 2; ++p) {
                if (t0 + p >= nkt) continue;
                float sc[4] = {0.f, 0.f, 0.f, 0.f};
#pragma unroll
                for (int hh = 0; hh < 4; ++hh) {
                    f32x4 c = {0.f, 0.f, 0.f, 0.f};
                    c = __builtin_amdgcn_mfma_f32_16x16x32_bf16(A[hh][0], B[p][0], c, 0, 0, 0);
                    c = __builtin_amdgcn_mfma_f32_16x16x32_bf16(A[hh][1], B[p][1], c, 0, 0, 0);
#pragma unroll
                    for (int g = 0; g < 4; ++g) sc[g] += fmaxf(c[g], 0.f) * wv[g][hh];
                }
#pragma unroll
                for (int g = 0; g < 4; ++g) S[(4 * q4 + g) * SROW + (t0 + p) * 16 + r] = sc[g];
            }
        }
    }
    __syncthreads();
    {
        const int rowa = F.wave * 2, rowb = rowa + 1;
        const int nva = q0 + rowa + 1, nvb = nva + 1;
        if (nvb <= NSEL) {
#pragma unroll
            for (int i = 0; i < 32; ++i) {
                const unsigned long long ma = __ballot(lane + 64 * i < nva), mb = __ballot(lane + 64 * i < nvb);
                if (lane == 0) { MB[rowa * 64 + 2 * i] = (unsigned)ma; MB[rowa * 64 + 2 * i + 1] = (unsigned)(ma >> 32); MB[rowb * 64 + 2 * i] = (unsigned)mb; MB[rowb * 64 + 2 * i + 1] = (unsigned)(mb >> 32); }
            }
        } else {
            unsigned ua[32], ub[32];
#pragma unroll
            for (int i = 0; i < 32; ++i) { const int j = lane + 64 * i; ua[i] = (j < nva) ? (f2ord(S[rowa * SROW + j]) >> 1) : 0u; ub[i] = (j < nvb) ? (f2ord(S[rowb * SROW + j]) >> 1) : 0u; }
            unsigned Ta, Tb; int Jxa, Jxb;
            select_threshold2<32>(ua, ub, NSEL, 11, lane, (nvb + 255) >> 8, Ta, Jxa, Tb, Jxb);
            const int La = Jxa - lane, Lb = Jxb - lane;
#pragma unroll
            for (int i = 0; i < 32; ++i) {
                const bool ta = (ua[i] > Ta) || (ua[i] == Ta && (La - 64 * i) > 0), tb = (ub[i] > Tb) || (ub[i] == Tb && (Lb - 64 * i) > 0);
                const unsigned long long ma = __ballot(ta), mb = __ballot(tb);
                if (lane == 0) { MB[rowa * 64 + 2 * i] = (unsigned)ma; MB[rowa * 64 + 2 * i + 1] = (unsigned)(ma >> 32); MB[rowb * 64 + 2 * i] = (unsigned)mb; MB[rowb * 64 + 2 * i + 1] = (unsigned)(mb >> 32); }
            }
        }
    }
    __syncthreads();
    {
        const int g = F.wave & 1, kq = F.wave >> 1;
        const int c = lane & 31, h = lane >> 5;
        const int hd = g * 4 + (c & 3);
        LAS const unsigned char* Qb = F.lds + PU_QT + (c >> 2) * PU_QROW + (hd * 64 + h * 8) * 2;
        constexpr float L2E = 1.4426950408889634f;
        const float b31 = RB[31 * 8 + hd] * L2E;
        const int ntile = ((q0 + 15) >> 5) + 1;
        const bf16_t* Kb = F.PROJ + (tok0 + kappa32(c)) * NMIXP + C_K + g * 64 + h * 8;
        const bf16_t* Vb = VT + ((size_t)((b * 2 + g) * 64 + c)) * SEQ + h * 8;
        f32x16 O[2][2];
#pragma unroll
        for (int rt = 0; rt < 2; ++rt)
#pragma unroll
            for (int d = 0; d < 2; ++d)
#pragma unroll
                for (int e = 0; e < 16; ++e) O[rt][d][e] = 0.f;
        float lsum[2] = {0.f, 0.f};
        bf16x8 Kn[4];
        {
            const int key0 = (kq < ntile ? kq : 0) * 32;
#pragma unroll
            for (int s4 = 0; s4 < 4; ++s4) Kn[s4] = *(const bf16x8*)(Kb + (size_t)key0 * NMIXP + s4 * 16);
        }
#pragma unroll 1
        for (int kt = kq; kt < ntile; kt += 4) {
            const int key0 = kt * 32;
            bf16x8 Kf[4] = {Kn[0], Kn[1], Kn[2], Kn[3]}, Vf[2][2];
#pragma unroll
            for (int d = 0; d < 2; ++d)
#pragma unroll
                for (int s2 = 0; s2 < 2; ++s2) Vf[d][s2] = *(const bf16x8*)(Vb + (size_t)(32 * d) * SEQ + key0 + 16 * s2);
            {
                const int keyn = (kt + 4 < ntile ? kt + 4 : 0) * 32;
#pragma unroll
                for (int s4 = 0; s4 < 4; ++s4) Kn[s4] = *(const bf16x8*)(Kb + (size_t)keyn * NMIXP + s4 * 16);
            }
#pragma unroll
            for (int rt = 0; rt < 2; ++rt) {
                const int ql = rt * 8 + (c >> 2), q = q0 + ql;
                f32x16 X;
#pragma unroll
                for (int e = 0; e < 16; ++e) X[e] = 0.f;
#pragma unroll
                for (int s4 = 0; s4 < 4; ++s4) X = __builtin_amdgcn_mfma_f32_32x32x16_bf16(Kf[s4], *(LAS const bf16x8*)(Qb + rt * 8 * PU_QROW + s4 * 32), X, 0, 0, 0);
                const unsigned word = MB[ql * 64 + kt];
                const unsigned bits = ((word >> (8 * h)) & 0xFFu) | (((word >> (16 + 8 * h)) & 0xFFu) << 8);
                const bool nearT = (q0 + rt * 8) - (key0 + 31) < 113;
#pragma unroll
                for (int s2 = 0; s2 < 2; ++s2) {
                    float P[8];
                    if (nearT) {
#pragma unroll
                        for (int e8 = 0; e8 < 8; ++e8) {
                            const int e = 8 * s2 + e8;
                            const int key = key0 + e8 + 16 * s2 + 8 * h;
                            int dist = q - key; dist = dist < 0 ? 0 : (dist > 127 ? 127 : dist);
                            const float bias = RB[BT[dist] * 8 + hd] * L2E;
                            const float lg = fminf(X[e] + bias, 86.f);
                            P[e8] = __int_as_float(__float_as_int(__builtin_amdgcn_exp2f(lg)) & __builtin_amdgcn_sbfe((int)bits, e, 1));
                        }
                    } else {
#pragma unroll
                        for (int e8 = 0; e8 < 8; ++e8) {
                            const int e = 8 * s2 + e8;
                            const float lg = fminf(X[e] + b31, 86.f);
                            P[e8] = __int_as_float(__float_as_int(__builtin_amdgcn_exp2f(lg)) & __builtin_amdgcn_sbfe((int)bits, e, 1));
                        }
                    }
#pragma unroll
                    for (int e8 = 0; e8 < 8; ++e8) lsum[rt] += P[e8];
                    const u32x4 pk = (u32x4){cvt_pk_bf16(P[0], P[1]), cvt_pk_bf16(P[2], P[3]), cvt_pk_bf16(P[4], P[5]), cvt_pk_bf16(P[6], P[7])};
                    bf16x8 Pf; __builtin_memcpy(&Pf, &pk, 16);
                    O[rt][0] = __builtin_amdgcn_mfma_f32_32x32x16_bf16(Vf[0][s2], Pf, O[rt][0], 0, 0, 0);
                    O[rt][1] = __builtin_amdgcn_mfma_f32_32x32x16_bf16(Vf[1][s2], Pf, O[rt][1], 0, 0, 0);
                }
                __builtin_amdgcn_sched_barrier(0);
            }
        }
        LAS float* CB = (LAS float*)F.lds + (g * 3 + (kq > 0 ? kq - 1 : 0)) * (66 * 64);
        __syncthreads();
        if (kq > 0) {
#pragma unroll
            for (int rt = 0; rt < 2; ++rt) {
#pragma unroll
                for (int d = 0; d < 2; ++d)
#pragma unroll
                    for (int e = 0; e < 16; ++e) CB[((rt * 2 + d) * 16 + e) * 64 + lane] = O[rt][d][e];
                CB[(64 + rt) * 64 + lane] = lsum[rt];
            }
        }
        __syncthreads();
        if (kq == 0) {
#pragma unroll 1
            for (int p = 0; p < 3; ++p) {
                LAS const float* CP = (LAS const float*)F.lds + (g * 3 + p) * (66 * 64);
#pragma unroll
                for (int rt = 0; rt < 2; ++rt) {
#pragma unroll
                    for (int d = 0; d < 2; ++d)
#pragma unroll
                        for (int e = 0; e < 16; ++e) O[rt][d][e] += CP[((rt * 2 + d) * 16 + e) * 64 + lane];
                    lsum[rt] += CP[(64 + rt) * 64 + lane];
                }
            }
#pragma unroll
            for (int rt = 0; rt < 2; ++rt) {
                float l = lsum[rt]; l += __shfl_xor(l, 32);
                const float inv = 1.f / l;
                bf16_t* orow = F.OATT + (tok0 + q0 + rt * 8 + (c >> 2)) * 512 + hd * 64;
#pragma unroll
                for (int a4 = 0; a4 < 4; ++a4) {
                    const f32x4 v0 = (f32x4){O[rt][0][4 * a4], O[rt][0][4 * a4 + 1], O[rt][0][4 * a4 + 2], O[rt][0][4 * a4 + 3]} * inv;
                    const f32x4 v1 = (f32x4){O[rt][1][4 * a4], O[rt][1][4 * a4 + 1], O[rt][1][4 * a4 + 2], O[rt][1][4 * a4 + 3]} * inv;
                    *(u32x2*)(orow + 8 * a4 + 4 * h) = pk4(v0);
                    *(u32x2*)(orow + 32 + 8 * a4 + 4 * h) = pk4(v1);
                }
            }
        }
    }
}

__device__ __forceinline__ void p3_sample_score_unit(const Frame& F, float* SS, int b, int ch) {
    const int lane = F.lane, r = lane & 31, h = lane >> 5;
    bf16x8 A[4];
    { const int q = r >> 2, hh = r & 3;
#pragma unroll
      for (int s4 = 0; s4 < 4; ++s4) A[s4] = *(const bf16x8*)(F.PROJ + (size_t)(NTP + b * TS + q) * NMIXP + C_QI + hh * 64 + s4 * 16 + h * 8); }
    float wv[4][4];
#pragma unroll
    for (int g = 0; g < 4; ++g) { const f32x4 w4 = *(const f32x4*)(F.WI + (size_t)(NTP + b * TS + 2 * g + h) * 4);
#pragma unroll
        for (int hh = 0; hh < 4; ++hh) wv[g][hh] = w4[hh] * IDX_SCALE; }
    f32x4 kn[8];
    { const int key0 = ch * 1024 + F.wave * 32; const int page = F.page_table[b * NPAGES + (key0 >> 7)];
      const float* kr = F.cache_ki + ((size_t)page * PAGE + (key0 & 127) + r) * 64 + h * 8;
#pragma unroll
      for (int s4 = 0; s4 < 4; ++s4) { kn[2 * s4] = *(const f32x4*)(kr + s4 * 16); kn[2 * s4 + 1] = *(const f32x4*)(kr + s4 * 16 + 4); } }
#pragma unroll 1
    for (int tl = F.wave; tl < 32; tl += 8) {
        const int key0 = ch * 1024 + tl * 32;
        f32x4 kc[8];
#pragma unroll
        for (int i = 0; i < 8; ++i) kc[i] = kn[i];
        if (tl + 8 < 32) {
            const int keyn = key0 + 256; const int page = F.page_table[b * NPAGES + (keyn >> 7)];
            const float* kr = F.cache_ki + ((size_t)page * PAGE + (keyn & 127) + r) * 64 + h * 8;
#pragma unroll
            for (int s4 = 0; s4 < 4; ++s4) { kn[2 * s4] = *(const f32x4*)(kr + s4 * 16); kn[2 * s4 + 1] = *(const f32x4*)(kr + s4 * 16 + 4); }
        }
        f32x16 c;
#pragma unroll
        for (int e = 0; e < 16; ++e) c[e] = 0.f;
#pragma unroll
        for (int s4 = 0; s4 < 4; ++s4) {
            const f32x4 lo = kc[2 * s4], hi = kc[2 * s4 + 1];
            const u32x4 pk = (u32x4){cvt_pk_bf16(lo[0], lo[1]), cvt_pk_bf16(lo[2], lo[3]), cvt_pk_bf16(hi[0], hi[1]), cvt_pk_bf16(hi[2], hi[3])};
            bf16x8 Bf; __builtin_memcpy(&Bf, &pk, 16);
            c = __builtin_amdgcn_mfma_f32_32x32x16_bf16(A[s4], Bf, c, 0, 0, 0);
        }
#pragma unroll
        for (int g = 0; g < 4; ++g) {
            float sc = 0.f;
#pragma unroll
            for (int hh = 0; hh < 4; ++hh) sc += fmaxf(c[4 * g + hh], 0.f) * wv[g][hh];
            SS[(size_t)(b * TS + 2 * g + h) * PAST + key0 + r] = sc;
        }
    }
}
__device__ __forceinline__ void p3_index(const Frame& F) {
    constexpr int NSU = NB_S * 8;
    const int nunits = NSU + NB_P * (SEQ / 16);
    float* SS = (float*)(F.ws + WS_SS);
    const bf16_t* VT = (const bf16_t*)(F.ws + WS_VT);
    __syncthreads();
    if (F.tid < 256) ((LAS float*)(F.lds + PU_RB))[F.tid] = F.rel_bias[F.tid];
    if (F.tid < 128) ((LAS int*)(F.lds + PU_BT))[F.tid] = t5_bucket(F.tid);
    __syncthreads();
    for (int it = F.bid; it < nunits; it += F.G) {
        if (it < NSU) { p3_sample_score_unit(F, SS, it >> 3, it & 7); continue; }
        const int i = it - NSU; const int b = i & 7, sl = (i >> 3) & 31, rnd = i >> 8;
        const int qt = rnd == 0 ? 127 - sl : (rnd == 1 ? 64 + sl : (rnd == 2 ? 63 - sl : sl));
        p3_prompt_fused_unit(F, VT, b, qt);
    }
}

constexpr int SQ_CNT = 0;
constexpr int SQ_SEL = 1024;
constexpr int SQ_Q = 2048;
constexpr int SQ_PHYS = 3072;
constexpr int SQ_P = 4096;
constexpr int SQ_RB = 16384;
constexpr int SQ_BT = 17408;
__device__ __forceinline__ int wg_sum8(const Frame& F, LAS unsigned* slot, int v) {
    if (F.lane == 0) slot[F.wave] = (unsigned)v;
    __syncthreads();
    int t = 0;
#pragma unroll
    for (int w = 0; w < 8; ++w) t += (int)slot[w];
    return t;
}
__device__ __forceinline__ void p4_sample_query_unit(const Frame& F, const float* SS, int b, int t) {
    const int lane = F.lane, w = F.wave;
    LAS unsigned* CNT = (LAS unsigned*)(F.lds + SQ_CNT);
    LAS int* SELL = (LAS int*)(F.lds + SQ_SEL);
    LAS unsigned* QL = (LAS unsigned*)(F.lds + SQ_Q);
    LAS float* PL = (LAS float*)(F.lds + SQ_P) + w * 256;
    LAS float* RB = (LAS float*)(F.lds + SQ_RB);
    LAS int* BT = (LAS int*)(F.lds + SQ_BT);
    const int tok = NTP + b * TS + t;
    __syncthreads();
    if (F.tid < 256) QL[F.tid] = ((const unsigned*)(F.PROJ + (size_t)tok * NMIXP + C_Q))[F.tid];
    unsigned u[17];
    { const float* srow = SS + (size_t)(b * TS + t) * PAST + w * 1024;
#pragma unroll
      for (int i = 0; i < 16; ++i) u[i] = f2ord(srow[64 * i + lane]); }
    u[16] = 0u;
    if (w == 7) {
        const int kj = lane < TS ? lane : 0;
        const bf16_t* kn = F.PROJ + (size_t)(NTP + b * TS + kj) * NMIXP + C_KI;
        const bf16_t* qn = F.PROJ + (size_t)tok * NMIXP + C_QI;
        u32x4 kv[8];
#pragma unroll
        for (int c = 0; c < 8; ++c) kv[c] = *(const u32x4*)(kn + c * 8);
        int vz; asm volatile("v_mov_b32 %0, 0" : "=v"(vz));
        const f32x4 w4 = *(const f32x4*)(F.WI + (size_t)tok * 4 + vz);
        float sc = 0.f;
#pragma unroll
        for (int hh = 0; hh < 4; ++hh) {
            u32x4 qv[8];
#pragma unroll
            for (int c = 0; c < 8; ++c) qv[c] = *(const u32x4*)(qn + hh * 64 + c * 8 + vz);
            float d = 0.f;
#pragma unroll
            for (int c = 0; c < 8; ++c)
#pragma unroll
                for (int e = 0; e < 4; ++e) d += bflo(qv[c][e]) * bflo(kv[c][e]) + bfhi(qv[c][e]) * bfhi(kv[c][e]);
            sc += fmaxf(d, 0.f) * (w4[hh] * IDX_SCALE);
        }
        u[16] = (lane < TS && lane <= t) ? f2ord(sc) : 0u;
    }
    unsigned T = 0;
#pragma unroll 1
    for (int bit = 31; bit >= 0; --bit) {
        const unsigned cand = T | (1u << bit);
        int c = 0;
#pragma unroll
        for (int i = 0; i < 17; ++i) cnt_ge(c, u[i], cand);
        c = wg_sum8(F, CNT + (bit & 1) * 24, wave_sum_i_dpp(c));
        if (c >= NSEL) T = cand;
        if (c == NSEL) break;
    }
    int cg = 0, ce = 0;
#pragma unroll
    for (int i = 0; i < 17; ++i) { cnt_gt(cg, u[i], T); cnt_eq(ce, u[i], T); }
    const int cgw = wave_sum_i_dpp(cg);
    const int ngt = wg_sum8(F, CNT + 8, cgw);
    const int neq = wg_sum8(F, CNT + 16, wave_sum_i_dpp(ce));
    const int need = NSEL - ngt;
    int Jx = 0x3FFFFFFF;
    if (need < neq) {
        int Jb = 0;
#pragma unroll 1
        for (int bit = 13; bit >= 0; --bit) {
            const int cand = Jb | (1 << bit);
            const int L = cand - lane - 1024 * w;
            int c = 0;
#pragma unroll
            for (int i = 0; i < 17; ++i) cnt_eq_pos(c, u[i], T, L - 64 * i);
            c = wg_sum8(F, CNT + (bit & 1) * 24, wave_sum_i_dpp(c));
            if (c < need) Jb = cand;
        }
        Jx = Jb + 1;
    }
    {
        const int L = Jx - lane - 1024 * w;
        int ct = 0;
#pragma unroll
        for (int i = 0; i < 17; ++i) cnt_eq_pos(ct, u[i], T, L - 64 * i);
        const int ctw = wave_sum_i_dpp(ct);
        __syncthreads();
        if (lane == 0) { CNT[w] = (unsigned)cgw; CNT[8 + w] = (unsigned)ctw; }
        __syncthreads();
        int bg = 0, bt = ngt;
#pragma unroll
        for (int ww = 0; ww < 8; ++ww) { if (ww < w) { bg += (int)CNT[ww]; bt += (int)CNT[8 + ww]; } }
        int ig = cg, it2 = ct;
#pragma unroll
        for (int o = 1; o < 64; o <<= 1) { const int a = __shfl_up(ig, o), b2 = __shfl_up(it2, o); if (lane >= o) { ig += a; it2 += b2; } }
        int pg = bg + ig - cg, pt = bt + it2 - ct;
        int ev = 1024 * w + lane, Lr = L;
#pragma unroll
        for (int i = 0; i < 17; ++i) {
            if (u[i] > T) { SELL[pg] = ev; ++pg; }
            else if (u[i] == T && Lr > 0) { SELL[pt] = ev; ++pt; }
            asm volatile("v_add_u32 %0, 64, %0\n\tv_add_u32 %1, -64, %1" : "+v"(ev), "+v"(Lr));
        }
    }
    __syncthreads();
    LAS int* PHYS = (LAS int*)(F.lds + SQ_PHYS);
    if (F.tid < 256) { const int sraw = SELL[F.tid]; PHYS[F.tid] = (sraw < PAST) ? F.page_table[b * NPAGES + (sraw >> 7)] * PAGE + (sraw & 127) : -1 - (sraw - PAST); }
    __syncthreads();
    {
        const int hd = w, g = w >> 2, qpos = PAST + t;
        float lg[4];
#pragma unroll 2
        for (int i = 0; i < 4; ++i) {
            const int sraw = SELL[lane + 64 * i], ph = PHYS[lane + 64 * i];
            const float* kr = (ph >= 0) ? F.cache_k + (size_t)ph * 128 + g * 64 : F.out + O_KS + (size_t)(b * TS + (-1 - ph)) * 128 + g * 64;
            float a0 = 0.f, a1 = 0.f;
#pragma unroll
            for (int c = 0; c < 16; ++c) {
                const f32x4 kv = *(const f32x4*)(kr + c * 4);
                const unsigned q0 = QL[hd * 32 + c * 2], q1 = QL[hd * 32 + c * 2 + 1];
                a0 += bflo(q0) * kv[0] + bfhi(q0) * kv[1]; a1 += bflo(q1) * kv[2] + bfhi(q1) * kv[3];
            }
            const int dist = qpos - sraw; const int bk = dist < 128 ? BT[dist] : 31;
            lg[i] = (a0 + a1) * ATTN_SCALE + RB[bk * 8 + hd];
        }
        float m = fmaxf(fmaxf(lg[0], lg[1]), fmaxf(lg[2], lg[3])); m = wave_max(m);
        float sm = 0.f;
#pragma unroll
        for (int i = 0; i < 4; ++i) { lg[i] = __expf(lg[i] - m); sm += lg[i]; }
        const float inv = 1.f / wave_sum_dpp(sm);
#pragma unroll
        for (int i = 0; i < 4; ++i) PL[lane + 64 * i] = lg[i] * inv;
        const int dq = lane & 15, ks = lane >> 4;
        f32x4 o4 = {0.f, 0.f, 0.f, 0.f};
#pragma unroll 1
        for (int j0 = 0; j0 < 256; j0 += 64) {
            f32x4 vv[16]; float pp[16];
#pragma unroll
            for (int jj = 0; jj < 16; ++jj) {
                const int j = j0 + jj * 4 + ks;
                const int ph = PHYS[j]; pp[jj] = PL[j];
                const float* vr = (ph >= 0) ? F.cache_v + (size_t)ph * 128 + g * 64 : F.out + O_VS + (size_t)(b * TS + (-1 - ph)) * 128 + g * 64;
                vv[jj] = *(const f32x4*)(vr + 4 * dq);
            }
#pragma unroll
            for (int jj = 0; jj < 16; ++jj) o4 += vv[jj] * pp[jj];
        }
#pragma unroll
        for (int e = 0; e < 4; ++e) { o4[e] += __shfl_xor(o4[e], 16); o4[e] += __shfl_xor(o4[e], 32); }
        if (ks == 0) *(u32x2*)(F.OATT + (size_t)tok * 512 + hd * 64 + 4 * dq) = pk4(o4);
    }
}
__device__ __forceinline__ void p4_attention(const Frame& F) {
    const float* SS = (const float*)(F.ws + WS_SS);
    __syncthreads();
    if (F.tid < 256) ((LAS float*)(F.lds + SQ_RB))[F.tid] = F.rel_bias[F.tid];
    if (F.tid < 128) ((LAS int*)(F.lds + SQ_BT))[F.tid] = t5_bucket(F.tid);
    __syncthreads();
    for (int it = F.bid; it < NTS; it += F.G) p4_sample_query_unit(F, SS, it >> 3, it & 7);
    {
        const int c0 = F.lane * 8;
        float cw0[8], cw1[8], cw2[8], cbv[8];
#pragma unroll
        for (int e = 0; e < 8; ++e) { cw0[e] = F.conv_w[c0 + e]; cw1[e] = F.conv_w[512 + c0 + e]; cw2[e] = F.conv_w[1024 + c0 + e]; cbv[e] = F.conv_b[c0 + e]; }
        const int stride = F.G * 8;
        u32x4 n_cg[3], n_xi[3], n_bg;
        auto fetch = [&](int m) {
#pragma unroll
            for (int d = 0; d < 3; ++d) { const int mm = (m - d >= 0) ? m - d : 0; n_cg[d] = *(const u32x4*)(F.PROJ + (size_t)mm * NMIXP + C_CG + c0); n_xi[d] = *(const u32x4*)(F.PROJ + (size_t)mm * NMIXP + C_XIN + c0); }
            n_bg = *(const u32x4*)(F.PROJ + (size_t)m * NMIXP + C_BG + c0);
        };
        { const int m = F.bid * 8 + F.wave; fetch(m < NT ? m : 0); }
        for (int m = F.bid * 8 + F.wave; m < NT; m += stride) {
            u32x4 cg[3], xi[3]; const u32x4 bg = n_bg;
#pragma unroll
            for (int d = 0; d < 3; ++d) { cg[d] = n_cg[d]; xi[d] = n_xi[d]; }
            fetch(m + stride < NT ? m + stride : m);
            int t, T_, bsm; if (m < NTP) { t = m & 2047; T_ = SEQ; bsm = m >> 11; } else { t = (m - NTP) & 7; T_ = TS; bsm = (m - NTP) >> 3; }
            float u[3][8];
#pragma unroll
            for (int d = 0; d < 3; ++d) {
                if (t - d >= 0) {
#pragma unroll
                    for (int e = 0; e < 4; ++e) { u[d][2 * e] = bflo(cg[d][e]) * bflo(xi[d][e]); u[d][2 * e + 1] = bfhi(cg[d][e]) * bfhi(xi[d][e]); }
                } else if (m >= NTP) {
                    const float* pv = F.state_conv + ((size_t)bsm * 2 + (2 + t - d)) * 512 + c0;
#pragma unroll
                    for (int e = 0; e < 8; ++e) u[d][e] = pv[e];
                } else {
#pragma unroll
                    for (int e = 0; e < 8; ++e) u[d][e] = 0.f;
                }
            }
            float y[8];
#pragma unroll
            for (int e = 0; e < 8; ++e) {
                const float yy = cbv[e] + cw0[e] * u[2][e] + cw1[e] * u[1][e] + cw2[e] * u[0][e];
                const float bgv = (e & 1) ? bfhi(bg[e >> 1]) : bflo(bg[e >> 1]);
                y[e] = bgv * yy;
            }
            *(u32x4*)(F.OCONV + (size_t)m * 512 + c0) = (u32x4){cvt_pk_bf16(y[0], y[1]), cvt_pk_bf16(y[2], y[3]), cvt_pk_bf16(y[4], y[5]), cvt_pk_bf16(y[6], y[7])};
            if (t >= T_ - 2) {
                float* o = (m < NTP ? F.out + O_CP : F.out + O_CS) + ((size_t)bsm * 2 + (t - (T_ - 2))) * 512 + c0;
                const int rowi = (m < NTP) ? bsm * 2 + (t - (T_ - 2)) : 2 * NB_P + bsm * 2 + (t - (T_ - 2));
                const float* cx = (const float*)(F.ws + WS_CGX) + (size_t)rowi * 1024 + c0;
                const f32x4 ca = *(const f32x4*)cx, cb2 = *(const f32x4*)(cx + 4), xa = *(const f32x4*)(cx + 512), xb = *(const f32x4*)(cx + 516);
                *(f32x4*)o = ca * xa; *(f32x4*)(o + 4) = cb2 * xb;
            }
        }
    }
}

#define P5_EPI(A1, A2) { \
            const f32x4 va = ACC4(A1), vc = ACC4(A2); \
            const u32x2 ga = *(const u32x2*)(F.PROJ + (size_t)m * NMIXP + C_GA + n), gb = *(const u32x2*)(F.PROJ + (size_t)m * NMIXP + C_GB + n); \
            f32x4 o; \
            o[0] = sigmoidf_(bflo(ga[0])) * va[0] + sigmoidf_(bflo(gb[0])) * vc[0]; \
            o[1] = sigmoidf_(bfhi(ga[0])) * va[1] + sigmoidf_(bfhi(gb[0])) * vc[1]; \
            o[2] = sigmoidf_(bflo(ga[1])) * va[2] + sigmoidf_(bflo(gb[1])) * vc[2]; \
            o[3] = sigmoidf_(bfhi(ga[1])) * va[3] + sigmoidf_(bfhi(gb[1])) * vc[3]; \
            *(u32x2*)(F.MERGED + (size_t)m * D + n) = pk4(o); }
struct P5aBody {
    const Frame* Fp;
    __device__ __forceinline__ void operator()(int m, int n, const f32x4 v) const { *(u32x2*)(Fp->MERGED + (size_t)m * D + n) = pk4(v); }
};
struct P5bBody {
    const Frame* Fp;
    __device__ __forceinline__ void operator()(int m, int n, const f32x4 v) const {
        const Frame& F = *Fp;
        const u32x2 ga = *(const u32x2*)(F.PROJ + (size_t)m * NMIXP + C_GA + n), gb = *(const u32x2*)(F.PROJ + (size_t)m * NMIXP + C_GB + n);
        const u32x2 pa = *(const u32x2*)(F.MERGED + (size_t)m * D + n);
        const f32x4 o = (f32x4){sigmoidf_(bflo(ga[0])) * bflo(pa[0]) + sigmoidf_(bflo(gb[0])) * v[0], sigmoidf_(bfhi(ga[0])) * bfhi(pa[0]) + sigmoidf_(bfhi(gb[0])) * v[1],
                                sigmoidf_(bflo(ga[1])) * bflo(pa[1]) + sigmoidf_(bflo(gb[1])) * v[2], sigmoidf_(bfhi(ga[1])) * bfhi(pa[1]) + sigmoidf_(bfhi(gb[1])) * v[3]};
        *(u32x2*)(F.MERGED + (size_t)m * D + n) = pk4(o);
    }
};
__device__ __forceinline__ void p5_gemm_merge(const Frame& F) {
    {
        pg8::StaticOrder S; S.init(NTP, D, F.G, F.bid);
        { pg8::Gemm g{F.OATT, F.WOA, NTP, D, 512}; pg8::EpiRC<P5aBody> E{P5aBody{&F}}; pg8::gemm_phase<pg8::EpiRC<P5aBody>, pg8::StaticOrder, true, true>(F.lds, g, S, E); }
        asm volatile("s_waitcnt vmcnt(0)" ::: "memory"); __syncthreads();
        { pg8::Gemm g{F.OCONV, F.WOC, NTP, D, 512}; pg8::EpiRC<P5bBody> E{P5bBody{&F}}; pg8::gemm_phase<pg8::EpiRC<P5bBody>, pg8::StaticOrder, true, true>(F.lds, g, S, E); }
    }
    for (int sl = F.bid; sl < NTS / 8 * (D / BN); sl += F.G) {
        const int m0 = NTP + (sl >> 3) * 8, n0 = (sl & 7) * BN;
        f32x16 s1[1][1], s2[1][1];
        gemm_slice8(F, s1, F.OATT, 512, F.WOA, 512, 512, m0, n0);
        gemm_slice8(F, s2, F.OCONV, 512, F.WOC, 512, 512, m0, n0);
        SLICE_EPI_LOOP(P5_EPI(s1, s2))
    }
}
#define P6_EPI(A1) { \
            const f32x4 v = ACC4(A1); \
            const f32x4 xv = *(const f32x4*)(x_row(F, m) + n); \
            const f32x4 g1 = *(const f32x4*)(F.MOD + (size_t)mod_row(m) * 6144 + 2048 + n); \
            *(f32x4*)(F.T1 + (size_t)m * D + n) = xv * DN_ALPHA + g1 * v; }
struct P6Body {
    const Frame* Fp;
    __device__ __forceinline__ void operator()(int m, int n, const f32x4 v) const {
        const Frame& F = *Fp;
        const f32x4 xv = *(const f32x4*)(F.x_p + (size_t)m * D + n);
        const f32x4 g1 = *(const f32x4*)(F.MOD + (size_t)(m >> 11) * 6144 + 2048 + n);
        *(f32x4*)(F.T1 + (size_t)m * D + n) = xv * DN_ALPHA + g1 * v;
    }
};
__device__ __forceinline__ void p6_gemm_out(const Frame& F) {
    {
        pg8::Gemm g{F.MERGED, F.WOUT, NTP, D, D}; pg8::StaticOrder S; S.init(NTP, D, F.G, F.bid);
        pg8::EpiRC<P6Body> E{P6Body{&F}}; pg8::gemm_phase<pg8::EpiRC<P6Body>, pg8::StaticOrder, true, true>(F.lds, g, S, E);
    }
    for (int sl = F.bid; sl < NTS / 8 * (D / BN); sl += F.G) {
        const int m0 = NTP + (sl >> 3) * 8, n0 = (sl & 7) * BN;
        f32x16 s1[1][1];
        gemm_slice8(F, s1, F.MERGED, D, F.WOUT, D, D, m0, n0);
        SLICE_EPI_LOOP(P6_EPI(s1))
    }
}
__device__ __forceinline__ void p7_ln1(const Frame& F) {
    f32x4 lg[4], lb[4];
#pragma unroll
    for (int i = 0; i < 4; ++i) { const int e = (i >> 1) * 512 + F.lane * 8 + (i & 1) * 4; lg[i] = *(const f32x4*)(F.ln1_g + e); lb[i] = *(const f32x4*)(F.ln1_b + e); }
    const int stride = F.G * 8;
    f32x4 vn[4], scn[4], shn[4];
    {
        const int m = F.bid * 8 + F.wave; const float* mr = F.MOD + (size_t)mod_row(m < NT ? m : 0) * 6144;
#pragma unroll
        for (int i = 0; i < 4; ++i) { const int e = (i >> 1) * 512 + F.lane * 8 + (i & 1) * 4; vn[i] = *(const f32x4*)(F.T1 + (size_t)(m < NT ? m : 0) * D + e); scn[i] = *(const f32x4*)(mr + 4096 + e); shn[i] = *(const f32x4*)(mr + 3072 + e); }
    }
    for (int m = F.bid * 8 + F.wave; m < NT; m += stride) {
        float* tr = F.T1 + (size_t)m * D;
        f32x4 v[4], sc2[4], sh2[4]; float s = 0.f;
#pragma unroll
        for (int i = 0; i < 4; ++i) { v[i] = vn[i]; sc2[i] = scn[i]; sh2[i] = shn[i]; s += v[i][0] + v[i][1] + v[i][2] + v[i][3]; }
        {
            const int mn = (m + stride < NT) ? m + stride : m; const float* mrn = F.MOD + (size_t)mod_row(mn) * 6144;
#pragma unroll
            for (int i = 0; i < 4; ++i) { const int e = (i >> 1) * 512 + F.lane * 8 + (i & 1) * 4; vn[i] = *(const f32x4*)(F.T1 + (size_t)mn * D + e); scn[i] = *(const f32x4*)(mrn + 4096 + e); shn[i] = *(const f32x4*)(mrn + 3072 + e); }
        }
        const float mean = wave_sum(s) * (1.f / D);
        float q = 0.f;
#pragma unroll
        for (int i = 0; i < 4; ++i) { v[i] = v[i] - mean; q += v[i][0] * v[i][0] + v[i][1] * v[i][1] + v[i][2] * v[i][2] + v[i][3] * v[i][3]; }
        const float rstd = rsqrtf(wave_sum(q) * (1.f / D) + LN_EPS);
        f32x4 hv[2][2];
#pragma unroll
        for (int hlf = 0; hlf < 2; ++hlf) {
            const int e = hlf * 512 + F.lane * 8;
            f32x4 a = v[2 * hlf] * rstd * lg[2 * hlf] + lb[2 * hlf];
            f32x4 b = v[2 * hlf + 1] * rstd * lg[2 * hlf + 1] + lb[2 * hlf + 1];
            *(f32x4*)(tr + e) = a; *(f32x4*)(tr + e + 4) = b;
            const f32x4 ha = a * (sc2[2 * hlf] + 1.f) + sh2[2 * hlf];
            const f32x4 hb = b * (sc2[2 * hlf + 1] + 1.f) + sh2[2 * hlf + 1];
            *(u32x4*)(F.H2 + (size_t)m * D + e) = (u32x4){cvt_pk_bf16(ha[0], ha[1]), cvt_pk_bf16(ha[2], ha[3]), cvt_pk_bf16(hb[0], hb[1]), cvt_pk_bf16(hb[2], hb[3])};
            hv[hlf][0] = ha; hv[hlf][1] = hb;
        }
        float am = 0.f;
#pragma unroll
        for (int i = 0; i < 2; ++i)
#pragma unroll
            for (int j = 0; j < 2; ++j)
#pragma unroll
                for (int e = 0; e < 4; ++e) am = fmaxf(am, fabsf(hv[i][j][e]));
        am = wave_max(am);
        const float sc = am > 0.f ? 224.f / am : 1.f;
#pragma unroll
        for (int hlf = 0; hlf < 2; ++hlf) {
            int w0 = 0, w1 = 0;
            w0 = __builtin_amdgcn_cvt_pk_fp8_f32(hv[hlf][0][0] * sc, hv[hlf][0][1] * sc, w0, false); w0 = __builtin_amdgcn_cvt_pk_fp8_f32(hv[hlf][0][2] * sc, hv[hlf][0][3] * sc, w0, true);
            w1 = __builtin_amdgcn_cvt_pk_fp8_f32(hv[hlf][1][0] * sc, hv[hlf][1][1] * sc, w1, false); w1 = __builtin_amdgcn_cvt_pk_fp8_f32(hv[hlf][1][2] * sc, hv[hlf][1][3] * sc, w1, true);
            *(u32x2*)(F.ws + WS_H8 + (size_t)m * D + hlf * 512 + F.lane * 8) = (u32x2){(unsigned)w0, (unsigned)w1};
        }
        if (F.lane == 0) ((float*)(F.ws + WS_SH))[m] = am > 0.f ? am * (1.f / 224.f) : 1.f;
    }
}
struct P8Body {
    const Frame* Fp;
    __device__ __forceinline__ void operator()(int m, int n, const f32x4 v) const { *(u32x2*)(Fp->QP + (size_t)m * D + n) = pk4(v); }
};
__device__ __forceinline__ void p8_gemm_q(const Frame& F) {
    {
        pg8::Gemm g{F.H2, F.WQ, NTP, D, D}; pg8::StaticOrder S; S.init(NTP, D, F.G, F.bid);
        pg8::EpiRC<P8Body> E{P8Body{&F}}; pg8::gemm_phase<pg8::EpiRC<P8Body>, pg8::StaticOrder, true, true>(F.lds, g, S, E);
    }
    for (int sl = F.bid; sl < NTS / 8 * (D / BN); sl += F.G) {
        const int m0 = NTP + (sl >> 3) * 8, n0 = (sl & 7) * BN;
        f32x16 s1[1][1];
        gemm_slice8(F, s1, F.H2, D, F.WQ, D, D, m0, n0);
        SLICE_EPI_LOOP({ *(u32x2*)(F.QP + (size_t)m * D + n) = pk4(ACC4(s1)); })
    }
}
__device__ __forceinline__ void p9_row_top16(LAS float* row, LAS float* TV, LAS unsigned char* TI, int slot) {
    float gm[16];
#pragma unroll
    for (int gidx = 0; gidx < 16; ++gidx) {
        float m = row[gidx * 8];
#pragma unroll
        for (int k = 1; k < 8; ++k) m = fmaxf(m, row[gidx * 8 + k]);
        gm[gidx] = m;
    }
#pragma unroll 1
    for (int p = 0; p < 16; ++p) {
        float best = gm[0]; int bg = 0;
#pragma unroll
        for (int gidx = 1; gidx < 16; ++gidx) { const bool gt = gm[gidx] > best; best = gt ? gm[gidx] : best; bg = gt ? gidx : bg; }
        float v[8];
#pragma unroll
        for (int k = 0; k < 8; ++k) v[k] = row[bg * 8 + k];
        int bk = 7;
#pragma unroll
        for (int k = 6; k >= 0; --k) bk = (v[k] == best) ? k : bk;
        float nm = -INFINITY;
#pragma unroll
        for (int k = 0; k < 8; ++k) nm = fmaxf(nm, (k == bk) ? -INFINITY : v[k]);
        row[bg * 8 + bk] = -INFINITY;
#pragma unroll
        for (int gidx = 0; gidx < 16; ++gidx) gm[gidx] = (gidx == bg) ? nm : gm[gidx];
        TV[slot * 17 + p] = best; TI[slot * 17 + p] = (unsigned char)(bg * 8 + bk);
    }
}
__device__ __forceinline__ void p9_pair_top16(const Frame& F, LAS const float* TV, LAS const unsigned char* TI, int r1, int r2, int tok, int head) {
    float c[16];
    { const float v20 = TV[r2];
#pragma unroll
      for (int i = 0; i < 16; ++i) c[i] = TV[r1 + i] + v20; }
    unsigned long long ptrs = 0ull;
    float sv[16]; int se[16];
#pragma unroll
    for (int p = 0; p < 16; ++p) {
        float best = c[0]; int bi = 0;
#pragma unroll
        for (int i = 1; i < 16; ++i) { const bool gt = c[i] > best; best = gt ? c[i] : best; bi = gt ? i : bi; }
        const int bj = (int)((ptrs >> (4 * bi)) & 15ull);
        sv[p] = best; se[p] = (int)TI[r1 + bi] * 128 + (int)TI[r2 + bj];
        const float nv = (bj < 15) ? TV[r1 + bi] + TV[r2 + bj + 1] : -INFINITY;
        ptrs += (bj < 15) ? (1ull << (4 * bi)) : 0ull;
#pragma unroll
        for (int i = 0; i < 16; ++i) c[i] = (i == bi) ? nv : c[i];
    }
    const float mx0 = sv[0]; float den = 0.f;
#pragma unroll
    for (int p = 0; p < 16; ++p) { sv[p] = __expf(sv[p] - mx0); den += sv[p]; }
    const float dinv = 1.f / den;
    int* eo = F.EIDX + (size_t)tok * NEXP_SEL + head * 16; float* go = F.GW + (size_t)tok * NEXP_SEL + head * 16;
#pragma unroll
    for (int p = 0; p < 16; ++p) { eo[p] = se[p]; go[p] = sv[p] * dinv; }
}
constexpr int PR_ROW = 129, PR_ROWS = 256 + 4;
__device__ __forceinline__ void p9_route(const Frame& F) {
    LAS float* SC = (LAS float*)F.lds;
    LAS float* TV = (LAS float*)(F.lds + PR_ROWS * PR_ROW * 4);
    LAS unsigned char* TI = (LAS unsigned char*)(F.lds + PR_ROWS * PR_ROW * 4 + PR_ROWS * 17 * 4);
    const int lane = F.lane, r = lane & 31, h = lane >> 5;
    const int nunits = (NTP / 32) * 2;
    bf16x8 AkR[4][4];
    {
        const bf16_t* KK = (F.wave & 1) ? F.K2 : F.K1;
#pragma unroll
        for (int kt = 0; kt < 4; ++kt)
#pragma unroll
            for (int s = 0; s < 4; ++s) AkR[kt][s] = *(const bf16x8*)(KK + (size_t)(kt * 32 + r) * 64 + s * 16 + h * 8);
    }
    int k = 0;
    for (int it = F.bid; it < nunits; it += F.G, ++k) {
        const int tok0 = (it >> 1) * 32, hg = it & 1;
        const int ts = NTP + F.bid + F.G * (k >> 2), kh = k & 3;
        const bool has_s = ts < NT;
        __syncthreads();
        {
            const int head = hg * 4 + (F.wave >> 1), half = F.wave & 1;
            bf16x8 Bq[4], Bs[4];
#pragma unroll
            for (int s = 0; s < 4; ++s) Bq[s] = *(const bf16x8*)(F.QP + (size_t)(tok0 + r) * D + head * 128 + half * 64 + s * 16 + h * 8);
            const bool swave = has_s && F.wave < 4;
            if (swave) {
#pragma unroll
                for (int s = 0; s < 4; ++s) Bs[s] = *(const bf16x8*)(F.QP + (size_t)ts * D + (2 * kh + (F.wave >> 1)) * 128 + half * 64 + s * 16 + h * 8);
            }
#pragma unroll
            for (int kt = 0; kt < 4; ++kt) {
                f32x16 c, cs;
#pragma unroll
                for (int e = 0; e < 16; ++e) { c[e] = 0.f; cs[e] = 0.f; }
#pragma unroll
                for (int s = 0; s < 4; ++s) {
                    c = __builtin_amdgcn_mfma_f32_32x32x16_bf16(AkR[kt][s], Bq[s], c, 0, 0, 0);
                    if (swave) cs = __builtin_amdgcn_mfma_f32_32x32x16_bf16(AkR[kt][s], Bs[s], cs, 0, 0, 0);
                }
#pragma unroll
                for (int e = 0; e < 16; ++e) { const int key = kt * 32 + (e & 3) + 8 * (e >> 2) + 4 * h; SC[(F.wave * 32 + r) * PR_ROW + key] = c[e]; }
                if (swave && r == 0) {
#pragma unroll
                    for (int e = 0; e < 16; ++e) { const int key = kt * 32 + (e & 3) + 8 * (e >> 2) + 4 * h; SC[(256 + F.wave) * PR_ROW + key] = cs[e]; }
                }
            }
        }
        __syncthreads();
        if (F.tid < 256 || (has_s && F.tid < 260)) p9_row_top16(SC + F.tid * PR_ROW, TV, TI, F.tid);
        if (F.wave >= 5) { const int j = F.bid + F.G * (k * 8 + (F.wave - 5)); if (j < CVT_CHUNKS) peer_cvt_rows4(F, j < CVT_CHUNKS / 2, (j & (CVT_CHUNKS / 2 - 1)) * 4); }
        __syncthreads();
        if (F.wave >= 3) { const int j = F.bid + F.G * (k * 8 + 3 + (F.wave - 3)); if (j < CVT_CHUNKS) peer_cvt_rows4(F, j < CVT_CHUNKS / 2, (j & (CVT_CHUNKS / 2 - 1)) * 4); }
        if (F.tid < 128) {
            const int tk = F.tid >> 2, hs = F.tid & 3;
            const int r1 = (hs * 64 + tk) * 17;
            p9_pair_top16(F, TV, TI, r1, r1 + 32 * 17, tok0 + tk, hg * 4 + hs);
        } else if (has_s && F.tid < 130) {
            const int hs = F.tid - 128;
            const int r1 = (256 + hs * 2) * 17;
            p9_pair_top16(F, TV, TI, r1, r1 + 17, ts, 2 * kh + hs);
        }
    }
    for (int i = k * 8 + F.wave; F.bid + F.G * i < CVT_CHUNKS; i += 8) { const int j = F.bid + F.G * i; peer_cvt_rows4(F, j < CVT_CHUNKS / 2, (j & (CVT_CHUNKS / 2 - 1)) * 4); }
}

constexpr int TPW = 65, PAIRS_MAX = 9 * 128, PK = 4;
constexpr int P10_HROW = 1024 + 64;
constexpr int P10_H = 0;
constexpr int P10_SH = 32 * P10_HROW;
constexpr int P10_HIST = P10_SH + 128;
constexpr int P10_LIST = P10_HIST + 8 * 128 * 4;
typedef int i32x8 __attribute__((ext_vector_type(8)));
typedef __bf16 bf16x2v __attribute__((ext_vector_type(2)));
typedef short s16x4 __attribute__((ext_vector_type(4)));
__device__ __forceinline__ unsigned bf2u(bf16x2v v) { unsigned r; __builtin_memcpy(&r, &v, 4); return r; }
__device__ __forceinline__ void p10_peer(const Frame& F) {
    const int lane = F.lane, w = F.wave;
    unsigned char* ws = F.ws;
    const unsigned char* PU8 = ws + WS_PU8; const unsigned char* PV8 = ws + WS_PV8;
    const float* SU = (const float*)(ws + WS_SU); const float* SV = (const float*)(ws + WS_SV);
    const unsigned char* H8 = ws + WS_H8; const float* SH = (const float*)(ws + WS_SH);
  for (int blk = F.bid; blk < NT / TPW; blk += F.G) {
    const int tok0 = blk * TPW;
    LAS float* SHl = (LAS float*)(F.lds + P10_SH);
    LAS unsigned* SE = (LAS unsigned*)(F.lds + P10_LIST) + w * 1024; LAS float* SG = (LAS float*)(SE + 512);
    const int ntok = 8;
    const int r16 = lane & 15, q4 = lane >> 4;
#pragma unroll 1
    for (int pass = 0; pass < 2; ++pass) {
        const int kbase = pass * PK, nk = (ntok - kbase < PK) ? (ntok - kbase > 0 ? ntok - kbase : 0) : PK, npairs = nk * 128;
        __syncthreads();
        for (int c = F.tid; c < 32 * 64; c += NTHREADS) {
            const int row = c >> 6, tl = 32 * pass + row;
            if (tl < TPW) *(LAS u32x4*)(F.lds + P10_H + row * P10_HROW + (c & 63) * 16) = *(const u32x4*)(H8 + (size_t)(tok0 + tl) * D + (size_t)(c & 63) * 16);
        }
        if (F.tid < 32 && 32 * pass + F.tid < TPW) SHl[F.tid] = SH[tok0 + 32 * pass + F.tid];
        __syncthreads();
        if (nk <= 0) continue;
#pragma unroll
        for (int i = 0; i < 8; ++i) {
            const int p = lane + 64 * i;
            if (p < npairs) {
                const size_t gi_ = (size_t)(tok0 + w + 8 * (kbase + (p >> 7))) * NEXP_SEL + (p & 127);
                SE[p] = (unsigned)F.EIDX[gi_]; SG[p] = F.GW[gi_];
            }
        }
        asm volatile("s_waitcnt vmcnt(0) lgkmcnt(0)" ::: "memory");
        __builtin_amdgcn_wave_barrier();
        f32x4 acc[4][4];
#pragma unroll
        for (int k = 0; k < 4; ++k)
#pragma unroll
            for (int q = 0; q < 4; ++q) acc[k][q] = (f32x4){0.f, 0.f, 0.f, 0.f};
        const int ngr = npairs >> 4;
        const unsigned char* up = PU8 + q4 * 16;
        const int voff = lane * 8;
        const unsigned am0 = (lane & 3) == 0 ? 0x0000ffffu : ((lane & 3) == 1 ? 0xffff0000u : 0u);
        const unsigned am1 = (lane & 3) == 2 ? 0x0000ffffu : ((lane & 3) == 3 ? 0xffff0000u : 0u);
        u32x4 U[8]; u32x2 V[16]; float suv = 0.f, svv = 0.f;
#pragma unroll
        for (int t = 0; t < 8; ++t) U[t] = (u32x4){0u, 0u, 0u, 0u};
#pragma unroll
        for (int k = 0; k < 16; ++k) V[k] = (u32x2){0u, 0u};
#define P10_LOAD_U(WR) { const int er_ = (WR) & 16383; const unsigned char* ua_ = up + (size_t)er_ * 512; const float* sa_ = SU + er_; const float* sb_ = SV + er_; \
            asm volatile("global_load_dwordx4 %0, %1, off" : "+v"(U[0]) : "v"(ua_)); \
            asm volatile("global_load_dwordx4 %0, %1, off offset:64" : "+v"(U[1]) : "v"(ua_)); \
            asm volatile("global_load_dwordx4 %0, %1, off offset:128" : "+v"(U[2]) : "v"(ua_)); \
            asm volatile("global_load_dwordx4 %0, %1, off offset:192" : "+v"(U[3]) : "v"(ua_)); \
            asm volatile("global_load_dwordx4 %0, %1, off offset:256" : "+v"(U[4]) : "v"(ua_)); \
            asm volatile("global_load_dwordx4 %0, %1, off offset:320" : "+v"(U[5]) : "v"(ua_)); \
            asm volatile("global_load_dwordx4 %0, %1, off offset:384" : "+v"(U[6]) : "v"(ua_)); \
            asm volatile("global_load_dwordx4 %0, %1, off offset:448" : "+v"(U[7]) : "v"(ua_)); \
            asm volatile("global_load_dword %0, %1, off" : "+v"(suv) : "v"(sa_)); \
            asm volatile("global_load_dword %0, %1, off" : "+v"(svv) : "v"(sb_)); }
#define P10_LOAD_V(K, WR) { const unsigned char* ra_ = PV8 + (size_t)(__builtin_amdgcn_readlane((WR), (K)) & 16383) * 512; \
            asm volatile("global_load_dwordx2 %0, %1, %2" : "+v"(V[K]) : "v"(voff), "s"(ra_)); }
        int wr = (int)SE[r16]; float gr = SG[r16];
        P10_LOAD_U(wr)
        P10_LOAD_V(0, wr) P10_LOAD_V(1, wr) P10_LOAD_V(2, wr) P10_LOAD_V(3, wr) P10_LOAD_V(4, wr) P10_LOAD_V(5, wr) P10_LOAD_V(6, wr) P10_LOAD_V(7, wr)
        P10_LOAD_V(8, wr) P10_LOAD_V(9, wr) P10_LOAD_V(10, wr) P10_LOAD_V(11, wr) P10_LOAD_V(12, wr) P10_LOAD_V(13, wr) P10_LOAD_V(14, wr) P10_LOAD_V(15, wr)
#define P10_VQ(Q) { const unsigned b0_ = bf2u(__builtin_amdgcn_cvt_scalef32_pk_bf16_fp4(vv[(Q) >> 1], 1.0f, 2 * ((Q) & 1))); \
                    const unsigned b1_ = bf2u(__builtin_amdgcn_cvt_scalef32_pk_bf16_fp4(vv[(Q) >> 1], 1.0f, 2 * ((Q) & 1) + 1)); \
                    const u32x2 bb_ = {b0_, b1_}; s16x4 Bop_; __builtin_memcpy(&Bop_, &bb_, 8); \
                    acc[slot][Q] = __builtin_amdgcn_mfma_f32_4x4x4bf16_1k(Aop, Bop_, acc[slot][Q], 0, 0, 0); }
#define P10_VPAIR(K) { const float actk = __int_as_float(__builtin_amdgcn_readlane(actv, 16 * ((K) >> 2) + (K))); \
                       const unsigned wb_ = cvt_pk_bf16(actk, actk); \
                       const u32x2 ab_ = {wb_ & am0, wb_ & am1}; s16x4 Aop; __builtin_memcpy(&Aop, &ab_, 8); \
                       asm volatile("s_waitcnt vmcnt(25)" : "+v"(V[K])); \
                       const u32x2 vv = V[K]; \
                       P10_VQ(0) P10_VQ(1) P10_VQ(2) P10_VQ(3) \
                       P10_LOAD_V(K, wrn) }
#pragma unroll
        for (int slot = 0; slot < 4; ++slot) {
            if (slot >= nk) continue;
            LAS const unsigned char* hr0 = F.lds + P10_H + (w + 8 * slot) * P10_HROW + q4 * 16;
            const float shv = SHl[w + 8 * slot];
#pragma unroll 1
            for (int g8 = 0; g8 < 8; ++g8) {
                const int gi = slot * 8 + g8;
                const int gn = (gi + 1 < ngr) ? gi + 1 : 0;
                const int wrn = (int)SE[gn * 16 + r16]; const float grn = SG[gn * 16 + r16];
                LAS const unsigned char* hr = hr0;
                asm volatile("" : "+v"(hr));
                asm volatile("s_waitcnt vmcnt(16)" : "+v"(U[0]), "+v"(U[1]), "+v"(U[2]), "+v"(U[3]), "+v"(U[4]), "+v"(U[5]), "+v"(U[6]), "+v"(U[7]), "+v"(suv), "+v"(svv));
                f32x4 C0 = {0.f, 0.f, 0.f, 0.f}, C1 = {0.f, 0.f, 0.f, 0.f};
#pragma unroll
                for (int t = 0; t < 8; ++t) {
                    const u32x4 h0 = *(LAS const u32x4*)(hr + t * 128), h1 = *(LAS const u32x4*)(hr + t * 128 + 64);
                    const i32x8 Aop = {(int)h0[0], (int)h0[1], (int)h0[2], (int)h0[3], (int)h1[0], (int)h1[1], (int)h1[2], (int)h1[3]};
                    const i32x8 Bop = {(int)U[t][0], (int)U[t][1], (int)U[t][2], (int)U[t][3], 0, 0, 0, 0};
                    if (t & 1) C1 = __builtin_amdgcn_mfma_scale_f32_16x16x128_f8f6f4(Aop, Bop, C1, 0, 4, 0, 0x7f7f7f7f, 0, 0x7f7f7f7f);
                    else       C0 = __builtin_amdgcn_mfma_scale_f32_16x16x128_f8f6f4(Aop, Bop, C0, 0, 4, 0, 0x7f7f7f7f, 0, 0x7f7f7f7f);
                }
                C0 = C0 + C1;
                const int rsel = lane & 3;
                const float dv = (rsel == 0 ? C0[0] : (rsel == 1 ? C0[1] : (rsel == 2 ? C0[2] : C0[3]))) * (suv * shv);
                const int actv = __float_as_int(gelu_tanh(dv) * (gr * svv));
                P10_LOAD_U(wrn)
                P10_VPAIR(0) P10_VPAIR(1) P10_VPAIR(2) P10_VPAIR(3) P10_VPAIR(4) P10_VPAIR(5) P10_VPAIR(6) P10_VPAIR(7)
                P10_VPAIR(8) P10_VPAIR(9) P10_VPAIR(10) P10_VPAIR(11) P10_VPAIR(12) P10_VPAIR(13) P10_VPAIR(14) P10_VPAIR(15)
                wr = wrn; gr = grn;
            }
        }
#undef P10_VPAIR
#undef P10_VQ
        asm volatile("s_waitcnt vmcnt(0)" : "+v"(U[0]), "+v"(U[1]), "+v"(U[2]), "+v"(U[3]), "+v"(U[4]), "+v"(U[5]), "+v"(U[6]), "+v"(U[7]), "+v"(suv), "+v"(svv),
                     "+v"(V[0]), "+v"(V[1]), "+v"(V[2]), "+v"(V[3]), "+v"(V[4]), "+v"(V[5]), "+v"(V[6]), "+v"(V[7]),
                     "+v"(V[8]), "+v"(V[9]), "+v"(V[10]), "+v"(V[11]), "+v"(V[12]), "+v"(V[13]), "+v"(V[14]), "+v"(V[15]));
#undef P10_LOAD_U
#undef P10_LOAD_V
        float x1v[PK][16];
#pragma unroll
        for (int k = 0; k < PK; ++k) {
            const int m = tok0 + w + 8 * (kbase + (k < nk ? k : 0));
#pragma unroll
            for (int c = 0; c < 16; ++c) x1v[k][c] = F.T1[(size_t)m * D + c * 64 + lane];
        }
#pragma unroll
        for (int k = 0; k < PK; ++k) {
            if (k >= nk) continue;
            const int m = tok0 + w + 8 * (kbase + k);
            const float* mr = F.MOD + (size_t)mod_row(m) * 6144 + 5120;
            float tv[16]; float s = 0.f;
#pragma unroll
            for (int c = 0; c < 16; ++c) { const float t = x1v[k][c] * DN_ALPHA + mr[c * 64 + lane] * acc[k][c >> 2][c & 3]; tv[c] = t; s += t; }
            const float mean = wave_sum(s) * (1.f / D);
            float q = 0.f;
#pragma unroll
            for (int c = 0; c < 16; ++c) { tv[c] -= mean; q += tv[c] * tv[c]; }
            const float rstd = rsqrtf(wave_sum(q) * (1.f / D) + LN_EPS);
            float* yo = (m < NTP) ? F.out + O_YP + (size_t)m * D : F.out + O_YS + (size_t)(m - NTP) * D;
#pragma unroll
            for (int c = 0; c < 16; ++c) yo[c * 64 + lane] = tv[c] * rstd * F.ln2_g[c * 64 + lane] + F.ln2_b[c * 64 + lane];
        }
    }
    {
        const int tok = tok0 + 64;
        LAS float* PART = (LAS float*)(F.lds + P10_LIST);
        __syncthreads();
        if (F.tid < 64) *(LAS u32x4*)(F.lds + P10_H + F.tid * 16) = *(const u32x4*)(H8 + (size_t)tok * D + (size_t)F.tid * 16);
        __syncthreads();
        const float shx = SH[tok];
        const int wrx = F.EIDX[(size_t)tok * NEXP_SEL + 16 * w + r16]; const float grx = F.GW[(size_t)tok * NEXP_SEL + 16 * w + r16];
        u32x4 Ux[8]; u32x2 Vx[16];
        const unsigned char* upx = PU8 + (size_t)wrx * 512 + q4 * 16;
#pragma unroll
        for (int t = 0; t < 8; ++t) Ux[t] = *(const u32x4*)(upx + t * 64);
        const float sux = SU[wrx], svx = SV[wrx];
#pragma unroll
        for (int k = 0; k < 16; ++k) Vx[k] = *(const u32x2*)(PV8 + (size_t)__builtin_amdgcn_readlane(wrx, k) * 512 + lane * 8);
        LAS const unsigned char* hrx = F.lds + P10_H + q4 * 16;
        f32x4 C0 = {0.f, 0.f, 0.f, 0.f}, C1 = {0.f, 0.f, 0.f, 0.f};
#pragma unroll
        for (int t = 0; t < 8; ++t) {
            const u32x4 h0 = *(LAS const u32x4*)(hrx + t * 128), h1 = *(LAS const u32x4*)(hrx + t * 128 + 64);
            const i32x8 Aop = {(int)h0[0], (int)h0[1], (int)h0[2], (int)h0[3], (int)h1[0], (int)h1[1], (int)h1[2], (int)h1[3]};
            const i32x8 Bop = {(int)Ux[t][0], (int)Ux[t][1], (int)Ux[t][2], (int)Ux[t][3], 0, 0, 0, 0};
            if (t & 1) C1 = __builtin_amdgcn_mfma_scale_f32_16x16x128_f8f6f4(Aop, Bop, C1, 0, 4, 0, 0x7f7f7f7f, 0, 0x7f7f7f7f);
            else       C0 = __builtin_amdgcn_mfma_scale_f32_16x16x128_f8f6f4(Aop, Bop, C0, 0, 4, 0, 0x7f7f7f7f, 0, 0x7f7f7f7f);
        }
        C0 = C0 + C1;
        const int rselx = lane & 3;
        const float dvx = (rselx == 0 ? C0[0] : (rselx == 1 ? C0[1] : (rselx == 2 ? C0[2] : C0[3]))) * (sux * shx);
        const int actx = __float_as_int(gelu_tanh(dvx) * (grx * svx));
        const unsigned amx0 = (lane & 3) == 0 ? 0x0000ffffu : ((lane & 3) == 1 ? 0xffff0000u : 0u);
        const unsigned amx1 = (lane & 3) == 2 ? 0x0000ffffu : ((lane & 3) == 3 ? 0xffff0000u : 0u);
        f32x4 ax[4];
#pragma unroll
        for (int q = 0; q < 4; ++q) ax[q] = (f32x4){0.f, 0.f, 0.f, 0.f};
#define P10_XQ(Q) { const unsigned b0_ = bf2u(__builtin_amdgcn_cvt_scalef32_pk_bf16_fp4(vv[(Q) >> 1], 1.0f, 2 * ((Q) & 1))); \
                    const unsigned b1_ = bf2u(__builtin_amdgcn_cvt_scalef32_pk_bf16_fp4(vv[(Q) >> 1], 1.0f, 2 * ((Q) & 1) + 1)); \
                    const u32x2 bb_ = {b0_, b1_}; s16x4 Bop_; __builtin_memcpy(&Bop_, &bb_, 8); \
                    ax[Q] = __builtin_amdgcn_mfma_f32_4x4x4bf16_1k(Aop, Bop_, ax[Q], 0, 0, 0); }
#pragma unroll
        for (int k = 0; k < 16; ++k) {
            const float actk = __int_as_float(__builtin_amdgcn_readlane(actx, 16 * (k >> 2) + k));
            const unsigned wb_ = cvt_pk_bf16(actk, actk);
            const u32x2 ab_ = {wb_ & amx0, wb_ & amx1}; s16x4 Aop; __builtin_memcpy(&Aop, &ab_, 8);
            const u32x2 vv = Vx[k];
            P10_XQ(0) P10_XQ(1) P10_XQ(2) P10_XQ(3)
        }
#undef P10_XQ
#pragma unroll
        for (int q = 0; q < 4; ++q)
#pragma unroll
            for (int i = 0; i < 4; ++i) PART[w * 1024 + (4 * q + i) * 64 + lane] = ax[q][i];
        __syncthreads();
        if (w == 0) {
            const int m = tok;
            const float* mr = F.MOD + (size_t)mod_row(m) * 6144 + 5120;
            float tv[16]; float s_ = 0.f;
#pragma unroll
            for (int c = 0; c < 16; ++c) {
                float pe = 0.f;
#pragma unroll
                for (int ww = 0; ww < 8; ++ww) pe += PART[ww * 1024 + c * 64 + lane];
                const float t = F.T1[(size_t)m * D + c * 64 + lane] * DN_ALPHA + mr[c * 64 + lane] * pe; tv[c] = t; s_ += t;
            }
            const float mean = wave_sum(s_) * (1.f / D);
            float q_ = 0.f;
#pragma unroll
            for (int c = 0; c < 16; ++c) { tv[c] -= mean; q_ += tv[c] * tv[c]; }
            const float rstd = rsqrtf(wave_sum(q_) * (1.f / D) + LN_EPS);
            float* yo = (m < NTP) ? F.out + O_YP + (size_t)m * D : F.out + O_YS + (size_t)(m - NTP) * D;
#pragma unroll
            for (int c = 0; c < 16; ++c) yo[c * 64 + lane] = tv[c] * rstd * F.ln2_g[c * 64 + lane] + F.ln2_b[c * 64 + lane];
        }
    }
  }
}

constexpr int N_PHASES = 11;
__global__ void __launch_bounds__(NTHREADS, 2) fwd_kernel(Args args) {
    extern __shared__ __attribute__((aligned(16))) unsigned char lds_raw[];
    Frame F;
    F.lds = (LAS unsigned char*)lds_raw;
    F.tid = threadIdx.x; F.lane = F.tid & 63; F.wave = __builtin_amdgcn_readfirstlane(F.tid >> 6); F.G = gridDim.x; F.bid = blockIdx.x;
    F.x_p = (const float*)args.in[0]; F.x_s = (const float*)args.in[1]; F.c_p = (const float*)args.in[2]; F.c_s = (const float*)args.in[3];
    F.cache_k = (const float*)args.in[4]; F.cache_v = (const float*)args.in[5]; F.cache_ki = (const float*)args.in[6]; F.state_conv = (const float*)args.in[7];
    F.page_table = (const int*)args.in[8]; F.rel_bias = (const float*)args.in[9]; F.w_ada = (const float*)args.in[10]; F.b_ada = (const float*)args.in[11];
    F.w_in = (const float*)args.in[12]; F.conv_w = (const float*)args.in[13]; F.conv_b = (const float*)args.in[14]; F.w_o_attn = (const float*)args.in[15];
    F.w_o_conv = (const float*)args.in[16]; F.w_out = (const float*)args.in[17]; F.ln1_g = (const float*)args.in[18]; F.ln1_b = (const float*)args.in[19];
    F.ln2_g = (const float*)args.in[20]; F.ln2_b = (const float*)args.in[21]; F.peer_wq = (const float*)args.in[22]; F.peer_k1 = (const float*)args.in[23];
    F.peer_k2 = (const float*)args.in[24]; F.peer_u = (const float*)args.in[25]; F.peer_v = (const float*)args.in[26];
    F.out = args.out;
    unsigned char* ws = args.ws; F.ws = ws;
    F.MOD = (float*)(ws + WS_MOD); F.WIN = (bf16_t*)(ws + WS_WIN); F.WOA = (bf16_t*)(ws + WS_WOA); F.WOC = (bf16_t*)(ws + WS_WOC);
    F.WOUT = (bf16_t*)(ws + WS_WOUT); F.WQ = (bf16_t*)(ws + WS_WQ); F.K1 = (bf16_t*)(ws + WS_K1); F.K2 = (bf16_t*)(ws + WS_K2);
    F.PU = (bf16_t*)(ws + WS_PU); F.PV = (bf16_t*)(ws + WS_PV); F.H1 = (bf16_t*)(ws + WS_H1); F.PROJ = (bf16_t*)(ws + WS_PROJ);
    F.WI = (float*)(ws + WS_WI); F.SEL = (int*)(ws + WS_SEL); F.OATT = (bf16_t*)(ws + WS_OATT); F.OCONV = (bf16_t*)(ws + WS_OCONV);
    F.MERGED = (bf16_t*)(ws + WS_MERGED); F.T1 = (float*)(ws + WS_T1); F.H2 = (bf16_t*)(ws + WS_H2); F.QP = (bf16_t*)(ws + WS_QP);
    F.EIDX = (int*)(ws + WS_EIDX); F.GW = (float*)(ws + WS_GW);
    volatile LAS unsigned* misc = (volatile LAS unsigned*)(F.lds + LDS_MISC);
    if (F.tid < 16) misc[F.tid] = 0u;
    __syncthreads();
    XcdBarrier bar; bar.bar = (unsigned*)(ws + WS_CTL); bar.x = 0; bar.st = misc;
    const int lo = args.ph_lo, hi = args.ph_hi;
    if (hi - lo > 1) bar = xcd_barrier_post((unsigned*)(ws + WS_CTL), misc);
#define IN(k) (lo <= (k) && (k) < hi)
#define SEAM(k) do { if (IN(k) && IN((k) + 1)) xcd_barrier(bar); } while (0)
    if (IN(0)) p0_prologue(F);       SEAM(0);
    if (IN(1)) p1_modulate(F);       SEAM(1);
    if (IN(2)) p2_gemm_in(F);        SEAM(2);
    if (IN(3)) p3_index(F);          SEAM(3);
    if (IN(4)) p4_attention(F);      SEAM(4);
    if (IN(5)) p5_gemm_merge(F);     SEAM(5);
    if (IN(6)) p6_gemm_out(F);       SEAM(6);
    if (IN(7)) p7_ln1(F);            SEAM(7);
    if (IN(8)) p8_gemm_q(F);         SEAM(8);
    if (IN(9)) p9_route(F);          SEAM(9);
    if (IN(10)) p10_peer(F);
#undef IN
#undef SEAM
}

extern "C" void kernel_launch(void* const* d_in, const int* in_sizes, int n_in, void* d_out, int out_size, void* d_ws, size_t ws_size, hipStream_t stream) {
    static int grid = 0;
    if (grid == 0) {
        if (n_in != 27 || (size_t)out_size != O_END || ws_size < WS_END) { fprintf(stderr, "kernel_launch: unexpected shapes (n_in %d out %d ws %zu)\n", n_in, out_size, ws_size); grid = -1; return; }
        int dev = 0, cus = 0;
        if (hipGetDevice(&dev) != hipSuccess || hipDeviceGetAttribute(&cus, hipDeviceAttributeMultiprocessorCount, dev) != hipSuccess) { grid = -1; return; }
        if (hipFuncSetAttribute((const void*)fwd_kernel, hipFuncAttributeMaxDynamicSharedMemorySize, LDS_BYTES) != hipSuccess) { fprintf(stderr, "kernel_launch: hipFuncSetAttribute failed\n"); grid = -1; return; }
        (void)hipGetLastError();
        grid = cus < 256 ? cus : 256;
    }
    if (grid < 0) return;
    (void)hipMemsetAsync((char*)d_ws + WS_CTL, 0, CTL_ZERO_BYTES, stream);
    Args a{};
    for (int i = 0; i < 27; ++i) a.in[i] = d_in[i];
    a.out = (float*)d_out; a.ws = (unsigned char*)d_ws;
#if N_LAUNCHES == 1
    a.ph_lo = 0; a.ph_hi = N_PHASES;
    hipLaunchKernelGGL(fwd_kernel, dim3(grid), dim3(NTHREADS), LDS_BYTES, stream, a);
#else
    for (int p = 0; p < N_PHASES; ++p) { a.ph_lo = p; a.ph_hi = p + 1; hipLaunchKernelGGL(fwd_kernel, dim3(grid), dim3(NTHREADS), LDS_BYTES, stream, a); }
#endif
}
```
